# Optimizing an MI355X kernel written in HIP

```python
import math
import jax, jax.numpy as jnp
from jax import lax
import numpy as np

D_MODEL = 1024
BATCH = 8
SEQ = 2048
DEPTH = 2

MEM_LEN = 256
HEAD_DIM = 64
DA_HEADS = 4
DA_V_DIM = 2 * HEAD_DIM
GQ_HEADS = 8
GQ_KV_HEADS = 2
GQ_REP = GQ_HEADS // GQ_KV_HEADS
MX_HEADS = 4
MX_HEAD_DIM = 128
BRANCH_W = 512
N_BRANCHES = 3
GRID_W = 64
ROPE_THETA = 10000.0
Q_BLOCK = 128
NORM_EPS = 1e-6
N_GROUPS = 4
EXPERTS_PER_GROUP = 8
N_EXPERTS = N_GROUPS * EXPERTS_PER_GROUP
TOP_K = 2
D_EXPERT = 512
MOE_BLOCK = 128
IN_WIDTHS = (DA_HEADS * 2 * HEAD_DIM,
             DA_HEADS * 2 * HEAD_DIM,
             DA_HEADS * DA_V_DIM,
             GQ_HEADS * HEAD_DIM,
             GQ_KV_HEADS * HEAD_DIM,
             GQ_KV_HEADS * HEAD_DIM,
             MX_HEADS * MX_HEAD_DIM,
             N_BRANCHES * D_MODEL)
D_IN = sum(IN_WIDTHS)

kernel_name = 'hybrid_diffattn_axialgqa_memxattn_hiermoe'

F32 = jnp.float32


def rms_norm(x, g):
    xf = x.astype(F32)
    y = xf * lax.rsqrt(jnp.mean(xf * xf, axis=-1, keepdims=True) + NORM_EPS)
    return (y * g.astype(F32)).astype(x.dtype)


def rope_angles_1d(S):
    pos = jnp.arange(S, dtype=F32)
    inv = ROPE_THETA ** (-jnp.arange(0, HEAD_DIM, 2, dtype=F32) / HEAD_DIM)
    return pos[:, None] * inv[None, :]


def rope_angles_axial(S):
    rows = S // GRID_W
    row = jnp.broadcast_to(jnp.arange(rows, dtype=F32)[:, None], (rows, GRID_W)).reshape(-1)
    col = jnp.broadcast_to(jnp.arange(GRID_W, dtype=F32)[None, :], (rows, GRID_W)).reshape(-1)
    axis_dim = HEAD_DIM // 2
    inv = ROPE_THETA ** (-jnp.arange(0, axis_dim, 2, dtype=F32) / axis_dim)
    return jnp.concatenate([row[:, None] * inv, col[:, None] * inv], axis=-1)


def apply_rope(x, ang):
    S, half = ang.shape
    shape = (S,) + (1,) * (x.ndim - 3) + (half,)
    c = jnp.cos(ang).reshape(shape)
    s = jnp.sin(ang).reshape(shape)
    xf = x.astype(F32)
    x1, x2 = xf[..., :half], xf[..., half:]
    return jnp.concatenate([x1 * c - x2 * s, x2 * c + x1 * s], axis=-1).astype(x.dtype)


def to_blocks(t):
    B, S = t.shape[:2]
    return t.reshape((B, S // Q_BLOCK, Q_BLOCK) + t.shape[2:]).swapaxes(0, 1)


def from_blocks(t):
    nb, B, qb = t.shape[:3]
    return t.swapaxes(0, 1).reshape((B, nb * qb) + t.shape[3:])


def diff_attention(q, k, v, lam):
    scale = HEAD_DIM ** -0.5

    def one_block(qb):
        s = jnp.einsum('bqhcd,bkhcd->bhcqk', qb, k).astype(F32) * scale
        p = jax.nn.softmax(s, axis=-1)
        a = p[:, :, 0] - lam * p[:, :, 1]
        return jnp.einsum('bhqk,bkhe->bqhe', a.astype(v.dtype), v)

    return from_blocks(lax.map(one_block, to_blocks(q)))


def gqa_attention(q, k, v):
    scale = HEAD_DIM ** -0.5

    def one_block(qb):
        s = jnp.einsum('bqnrd,bsnd->bnrqs', qb, k).astype(F32) * scale
        p = jax.nn.softmax(s, axis=-1)
        return jnp.einsum('bnrqs,bsnd->bqnrd', p.astype(v.dtype), v)

    return from_blocks(lax.map(one_block, to_blocks(q)))


def memory_attention(q, k, v):
    s = jnp.einsum('bqhe,bmhe->bhqm', q, k).astype(F32) * (MX_HEAD_DIM ** -0.5)
    p = jax.nn.softmax(s, axis=-1)
    return jnp.einsum('bhqm,bmhe->bqhe', p.astype(v.dtype), v)


def hier_route(t, w_rg, b_rg, w_re, b_re):
    g_prob = jax.nn.softmax((t @ w_rg + b_rg).astype(F32), axis=-1)
    g_idx = jnp.argmax(g_prob, axis=-1)
    g_p = jnp.max(g_prob, axis=-1)
    e_logits = (t @ w_re + b_re).astype(F32).reshape(-1, N_GROUPS, EXPERTS_PER_GROUP)
    in_group = jnp.take_along_axis(e_logits, g_idx[:, None, None], axis=1)[:, 0]
    e_prob = jax.nn.softmax(in_group, axis=-1)
    top_p, top_i = lax.top_k(e_prob, TOP_K)
    top_p = top_p / jnp.sum(top_p, axis=-1, keepdims=True)
    weights = g_p[:, None] * top_p
    experts = (g_idx[:, None] * EXPERTS_PER_GROUP + top_i).astype(jnp.int32)
    return experts, weights


def moe_forward(t, experts, weights, w_gate, w_up, w_down):
    T, D = t.shape
    A = T * TOP_K
    P = A + N_EXPERTS * MOE_BLOCK
    NB = P // MOE_BLOCK
    flat_e = experts.reshape(-1)
    flat_tok = jnp.arange(A, dtype=jnp.int32) // TOP_K
    flat_w = weights.reshape(-1)
    order = jnp.argsort(flat_e)
    se, stok, sw = flat_e[order], flat_tok[order], flat_w[order]
    counts = jnp.bincount(flat_e, length=N_EXPERTS)
    starts = jnp.cumsum(counts) - counts
    padded = (counts + MOE_BLOCK - 1) // MOE_BLOCK * MOE_BLOCK
    pends = jnp.cumsum(padded)
    pstarts = pends - padded
    dest = pstarts[se] + (jnp.arange(A, dtype=jnp.int32) - starts[se])
    buf = jnp.zeros((P, D), t.dtype).at[dest].set(t[stok])
    block_start = jnp.arange(NB, dtype=jnp.int32) * MOE_BLOCK
    block_e = jnp.minimum(jnp.searchsorted(pends, block_start, side='right'), N_EXPERTS - 1)

    def run(args):
        xb, e = args
        hid = jax.nn.silu(xb @ w_gate[e]) * (xb @ w_up[e])
        return hid @ w_down[e]

    ybuf = lax.map(run, (buf.reshape(NB, MOE_BLOCK, D), block_e)).reshape(P, D)
    y = ybuf[dest] * sw[:, None].astype(t.dtype)
    return jax.ops.segment_sum(y, stok, num_segments=T)


def setup_inputs(seed: int = 0) -> dict:
    key = jax.random.key(seed)
    ks = jax.random.split(key, 32)

    def nrm(k, shape, scale):
        return jax.random.normal(k, shape, F32) * scale

    def gain(k, shape):
        return 1.0 + 0.02 * jax.random.normal(k, shape, F32)

    D = D_MODEL
    return {
        'x': nrm(ks[0], (BATCH, SEQ, D), 1.0),
        'mem': nrm(ks[1], (BATCH, MEM_LEN, D), 1.0),
        'mem_norm_g': gain(ks[2], (D,)),
        'w_mem_kv': nrm(ks[3], (D, 2 * MX_HEADS * MX_HEAD_DIM), D ** -0.5),
        'norm1_g': gain(ks[4], (DEPTH, D)),
        'w_in': nrm(ks[5], (DEPTH, D, D_IN), D ** -0.5),
        'lam_q1': nrm(ks[6], (DEPTH, HEAD_DIM), 0.1),
        'lam_k1': nrm(ks[7], (DEPTH, HEAD_DIM), 0.1),
        'lam_q2': nrm(ks[8], (DEPTH, HEAD_DIM), 0.1),
        'lam_k2': nrm(ks[9], (DEPTH, HEAD_DIM), 0.1),
        'subln_g': gain(ks[10], (DEPTH, DA_V_DIM)),
        'q_norm_g': gain(ks[11], (DEPTH, HEAD_DIM)),
        'k_norm_g': gain(ks[12], (DEPTH, HEAD_DIM)),
        'w_up_a': nrm(ks[13], (DEPTH, BRANCH_W, D), BRANCH_W ** -0.5),
        'w_up_b': nrm(ks[14], (DEPTH, BRANCH_W, D), BRANCH_W ** -0.5),
        'w_up_c': nrm(ks[15], (DEPTH, BRANCH_W, D), BRANCH_W ** -0.5),
        'w_out': nrm(ks[16], (DEPTH, D, D), D ** -0.5),
        'norm2_g': gain(ks[17], (DEPTH, D)),
        'w_router_group': nrm(ks[18], (DEPTH, D, N_GROUPS), D ** -0.5),
        'b_router_group': nrm(ks[19], (DEPTH, N_GROUPS), 0.01),
        'w_router_expert': nrm(ks[20], (DEPTH, D, N_EXPERTS), D ** -0.5),
        'b_router_expert': nrm(ks[21], (DEPTH, N_EXPERTS), 0.01),
        'w_exp_gate': nrm(ks[22], (DEPTH, N_EXPERTS, D, D_EXPERT), D ** -0.5),
        'w_exp_up': nrm(ks[23], (DEPTH, N_EXPERTS, D, D_EXPERT), D ** -0.5),
        'w_exp_down': nrm(ks[24], (DEPTH, N_EXPERTS, D_EXPERT, D), D_EXPERT ** -0.5),
        'final_norm_g': gain(ks[25], (D,)),
    }


def reference(x, mem, mem_norm_g, w_mem_kv, norm1_g, w_in, lam_q1, lam_k1, lam_q2, lam_k2,
              subln_g, q_norm_g, k_norm_g, w_up_a, w_up_b, w_up_c, w_out, norm2_g,
              w_router_group, b_router_group, w_router_expert, b_router_expert,
              w_exp_gate, w_exp_up, w_exp_down, final_norm_g):
    B, S, D = x.shape
    ang_1d = rope_angles_1d(S)
    ang_2d = rope_angles_axial(S)
    split_idx = [int(i) for i in np.cumsum(IN_WIDTHS)[:-1]]

    mem_kv = rms_norm(mem, mem_norm_g) @ w_mem_kv
    mk, mv = jnp.split(mem_kv, 2, axis=-1)
    M = mem.shape[1]
    mk = mk.reshape(B, M, MX_HEADS, MX_HEAD_DIM)
    mv = mv.reshape(B, M, MX_HEADS, MX_HEAD_DIM)

    for l in range(DEPTH):
        h = rms_norm(x, norm1_g[l])
        proj = h @ w_in[l]
        aq, ak, av, bq, bk, bv, cq, gl = jnp.split(proj, split_idx, axis=-1)

        lam_init = 0.8 - 0.6 * math.exp(-0.3 * l)
        lam = (jnp.exp(jnp.sum(lam_q1[l].astype(F32) * lam_k1[l].astype(F32)))
               - jnp.exp(jnp.sum(lam_q2[l].astype(F32) * lam_k2[l].astype(F32))) + lam_init)
        aq = apply_rope(aq.reshape(B, S, DA_HEADS, 2, HEAD_DIM), ang_1d)
        ak = apply_rope(ak.reshape(B, S, DA_HEADS, 2, HEAD_DIM), ang_1d)
        av = av.reshape(B, S, DA_HEADS, DA_V_DIM)
        oa = diff_attention(aq, ak, av, lam)
        oa = rms_norm(oa, subln_g[l]) * (1.0 - lam_init)

        bq = apply_rope(rms_norm(bq.reshape(B, S, GQ_HEADS, HEAD_DIM), q_norm_g[l]), ang_2d)
        bk = apply_rope(rms_norm(bk.reshape(B, S, GQ_KV_HEADS, HEAD_DIM), k_norm_g[l]), ang_2d)
        bq = bq.reshape(B, S, GQ_KV_HEADS, GQ_REP, HEAD_DIM)
        bv = bv.reshape(B, S, GQ_KV_HEADS, HEAD_DIM)
        ob = gqa_attention(bq, bk, bv)

        oc = memory_attention(cq.reshape(B, S, MX_HEADS, MX_HEAD_DIM), mk, mv)

        ya = oa.reshape(B, S, BRANCH_W) @ w_up_a[l]
        yb = ob.reshape(B, S, BRANCH_W) @ w_up_b[l]
        yc = oc.reshape(B, S, BRANCH_W) @ w_up_c[l]
        g = jax.nn.sigmoid(gl.astype(F32)).astype(x.dtype).reshape(B, S, N_BRANCHES, D)
        merged = g[:, :, 0] * ya + g[:, :, 1] * yb + g[:, :, 2] * yc
        x = x + merged @ w_out[l]

        h2 = rms_norm(x, norm2_g[l]).reshape(B * S, D)
        experts, weights = hier_route(h2, w_router_group[l], b_router_group[l],
                                      w_router_expert[l], b_router_expert[l])
        y = moe_forward(h2, experts, weights, w_exp_gate[l], w_exp_up[l], w_exp_down[l])
        x = x + y.reshape(B, S, D)

    return rms_norm(x, final_norm_g)
```

```cpp
#include <hip/hip_runtime.h>
#include <cstdint>
#include <cstdio>
#include <cmath>

typedef unsigned short bf16_t;
typedef float f32x4 __attribute__((ext_vector_type(4)));
typedef unsigned u32x4 __attribute__((ext_vector_type(4)));
typedef unsigned u32x2 __attribute__((ext_vector_type(2)));

constexpr int BATCH = 8, SEQ = 2048, DM = 1024, DEPTH = 2, MEM_LEN = 256;
constexpr int M = BATCH * SEQ;
constexpr int MM = BATCH * MEM_LEN;
constexpr int D_IN = 5888;
constexpr int C_AQ = 0, C_AK = 512, C_AV = 1024, C_BQ = 1536, C_BK = 2048, C_BV = 2176, C_CQ = 2304, C_G = 2816;
constexpr int OBR_W = 1536;
constexpr int NEXP = 32, DEXP = 512;
constexpr int MOE_TILE = 256;
constexpr int P_ROWS = M * 2 + NEXP * MOE_TILE;
constexpr int MAX_TILES = P_ROWS / MOE_TILE;
constexpr float EPS = 1e-6f;
constexpr float LOG2E = 1.4426950408889634f;
constexpr float C2_64 = 0.125f * LOG2E;
constexpr float C2_128 = 0.08838834764831845f * LOG2E;

constexpr size_t MiB = 1u << 20;
constexpr size_t WS_CTL = 0;
constexpr size_t WS_ROUTE = 1 * MiB;
constexpr size_t WS_TAB = 2 * MiB;
constexpr size_t WS_MEMKV = 3 * MiB;
constexpr size_t WS_HM = 7 * MiB;
constexpr size_t WS_PROJ = 39 * MiB;
constexpr size_t WS_OBR = 223 * MiB;
constexpr size_t WS_WB = 271 * MiB;
constexpr size_t WS_END = 495 * MiB;
constexpr size_t WS_BUF = WS_PROJ;
constexpr size_t WS_YB = WS_PROJ + 80 * MiB;
constexpr size_t WS_HID = WS_OBR;
constexpr size_t RT_EXP = 0;
constexpr size_t RT_WGT = 128 * 1024;
constexpr size_t RT_RANK = 256 * 1024;
constexpr size_t RT_DEST = 384 * 1024;
constexpr size_t RT_ROWW = 512 * 1024;
constexpr size_t RT_TILE = 700 * 1024;
constexpr int CW_CNT = 0;

__device__ __forceinline__ float bf2f(bf16_t v) { return __uint_as_float(((unsigned)v) << 16); }
__device__ __forceinline__ bf16_t f2bf(float f) { unsigned u = __float_as_uint(f); return (bf16_t)((u + 0x7fffu + ((u >> 16) & 1u)) >> 16); }
__device__ __forceinline__ float wave_sum(float v) {
#pragma unroll
    for (int o = 1; o < 64; o <<= 1) v += __shfl_xor(v, o);
    return v;
}
__device__ __forceinline__ float wave_max(float v) {
#pragma unroll
    for (int o = 1; o < 64; o <<= 1) v = fmaxf(v, __shfl_xor(v, o));
    return v;
}
__device__ __forceinline__ float inv1d(int i) { return exp2f(-(float)i * (13.287712379549449f / 32.f)); }
__device__ __forceinline__ float inv2d(int j) { return exp2f(-(float)j * (13.287712379549449f / 16.f)); }
__device__ __forceinline__ float ang2d(int pos, int i) { return i < 16 ? (float)(pos >> 6) * inv2d(i) : (float)(pos & 63) * inv2d(i - 16); }

__global__ __launch_bounds__(256) void s_rmsnorm(const float* __restrict__ X, const float* __restrict__ g, bf16_t* __restrict__ OUT, int rows) {
    const int lane = threadIdx.x & 63, row = blockIdx.x * 4 + (threadIdx.x >> 6);
    if (row >= rows) return;
    const f32x4* xr = (const f32x4*)(X + (size_t)row * DM);
    f32x4 v[4]; float s = 0.f;
#pragma unroll
    for (int j = 0; j < 4; ++j) { v[j] = xr[lane + 64 * j]; s += v[j].x * v[j].x + v[j].y * v[j].y + v[j].z * v[j].z + v[j].w * v[j].w; }
    const float rs = rsqrtf(wave_sum(s) * (1.f / DM) + EPS);
#pragma unroll
    for (int j = 0; j < 4; ++j) { const f32x4 gg = ((const f32x4*)g)[lane + 64 * j];
        u32x2 o; o.x = f2bf(v[j].x * rs * gg.x) | ((unsigned)f2bf(v[j].y * rs * gg.y) << 16); o.y = f2bf(v[j].z * rs * gg.z) | ((unsigned)f2bf(v[j].w * rs * gg.w) << 16);
        ((u32x2*)(OUT + (size_t)row * DM))[lane + 64 * j] = o; }
}

enum { MD_PROJ = 0, MD_BF16 = 1, MD_GATE = 2, MD_RESID = 3, MD_SILU = 4, MD_ROWSCALE = 5 };
struct SG {
    const bf16_t* A; int lda; const float* W; const float* W2; int ldw; size_t wstride;
    const int* tile_e; const int* ntiles;
    int K; int mode;
    bf16_t* O; int ldo;
    float* Xf;
    const bf16_t* G; int ldg; int first;
    const float* roww;
    const float* qg; const float* kg;
};
__global__ __launch_bounds__(256) void s_gemm(SG p) {
    __shared__ float As[16][68];
    __shared__ float Bs[16][68];
    __shared__ float B2s[16][68];
    __shared__ float Ct[64][65];
    __shared__ float Ct2[64][65];
    const int tid = threadIdx.x, tx = tid & 15, ty = tid >> 4;
    const int gc0 = blockIdx.x * 64, gr0 = blockIdx.y * 64;
    const float* W = p.W; const float* W2 = p.W2;
    if (p.tile_e) { const int t256 = blockIdx.y >> 2; if (t256 >= *p.ntiles) return; const int e = p.tile_e[t256]; W += (size_t)e * p.wstride; if (W2) W2 += (size_t)e * p.wstride; }
    float acc[4][4] = {}, acc2[4][4] = {};
    const int ar = tid >> 2, ak = (tid & 3) * 4;
    const int bk = tid >> 4, bn = (tid & 15) * 4;
    for (int k0 = 0; k0 < p.K; k0 += 16) {
        { const u32x2 a = *(const u32x2*)(p.A + (size_t)(gr0 + ar) * p.lda + k0 + ak);
          As[ak + 0][ar] = __uint_as_float(a.x << 16); As[ak + 1][ar] = __uint_as_float(a.x & 0xffff0000u);
          As[ak + 2][ar] = __uint_as_float(a.y << 16); As[ak + 3][ar] = __uint_as_float(a.y & 0xffff0000u); }
        { const f32x4 b = *(const f32x4*)(W + (size_t)(k0 + bk) * p.ldw + gc0 + bn); Bs[bk][bn] = b.x; Bs[bk][bn + 1] = b.y; Bs[bk][bn + 2] = b.z; Bs[bk][bn + 3] = b.w; }
        if (p.mode == MD_SILU) { const f32x4 b = *(const f32x4*)(W2 + (size_t)(k0 + bk) * p.ldw + gc0 + bn); B2s[bk][bn] = b.x; B2s[bk][bn + 1] = b.y; B2s[bk][bn + 2] = b.z; B2s[bk][bn + 3] = b.w; }
        __syncthreads();
#pragma unroll
        for (int k = 0; k < 16; ++k) {
            float a[4], b[4];
#pragma unroll
            for (int i = 0; i < 4; ++i) { a[i] = As[k][ty * 4 + i]; b[i] = Bs[k][tx * 4 + i]; }
#pragma unroll
            for (int i = 0; i < 4; ++i)
#pragma unroll
                for (int j = 0; j < 4; ++j) acc[i][j] += a[i] * b[j];
            if (p.mode == MD_SILU) {
#pragma unroll
                for (int i = 0; i < 4; ++i) b[i] = B2s[k][tx * 4 + i];
#pragma unroll
                for (int i = 0; i < 4; ++i)
#pragma unroll
                    for (int j = 0; j < 4; ++j) acc2[i][j] += a[i] * b[j];
            }
        }
        __syncthreads();
    }
#pragma unroll
    for (int i = 0; i < 4; ++i)
#pragma unroll
        for (int j = 0; j < 4; ++j) { Ct[ty * 4 + i][tx * 4 + j] = acc[i][j]; Ct2[ty * 4 + i][tx * 4 + j] = acc2[i][j]; }
    __syncthreads();
    const int r = tid >> 2, q = tid & 3; const int grow = gr0 + r;
    if (p.mode == MD_PROJ) {
        const int pos = grow & (SEQ - 1);
        bf16_t* orow = p.O + (size_t)grow * p.ldo + gc0;
        if (gc0 < C_AV) {
            const float sc = gc0 < C_AK ? C2_64 : 1.f;
            for (int j = 0; j < 8; ++j) { const int i = q * 8 + j; const float x1 = Ct[r][i], x2 = Ct[r][i + 32]; float s, c; sincosf((float)pos * inv1d(i), &s, &c);
                orow[i] = f2bf((x1 * c - x2 * s) * sc); orow[i + 32] = f2bf((x2 * c + x1 * s) * sc); }
        } else if ((gc0 >= C_BQ && gc0 < C_BV)) {
            const bool isq = gc0 < C_BK; const float* g = isq ? p.qg : p.kg; const float sc = isq ? C2_64 : 1.f;
            float ss = 0.f; for (int d = 0; d < 64; ++d) ss += Ct[r][d] * Ct[r][d];
            const float rs = rsqrtf(ss * (1.f / 64.f) + EPS);
            for (int j = 0; j < 8; ++j) { const int i = q * 8 + j; const float x1 = Ct[r][i] * rs * g[i], x2 = Ct[r][i + 32] * rs * g[i + 32]; float s, c; sincosf(ang2d(pos, i), &s, &c);
                orow[i] = f2bf((x1 * c - x2 * s) * sc); orow[i + 32] = f2bf((x2 * c + x1 * s) * sc); }
        } else if (gc0 >= C_G) {
            for (int j = 0; j < 16; ++j) { const int c = q * 16 + j; orow[c] = f2bf(1.f / (1.f + __expf(-Ct[r][c]))); }
        } else {
            const float sc = (gc0 >= C_CQ) ? C2_128 : 1.f;
            for (int j = 0; j < 16; ++j) { const int c = q * 16 + j; orow[c] = f2bf(Ct[r][c] * sc); }
        }
    } else if (p.mode == MD_BF16) {
        for (int j = 0; j < 16; ++j) { const int c = q * 16 + j; p.O[(size_t)grow * p.ldo + gc0 + c] = f2bf(Ct[r][c]); }
    } else if (p.mode == MD_GATE) {
        for (int j = 0; j < 16; ++j) { const int c = q * 16 + j; const float gv = bf2f(p.G[(size_t)grow * p.ldg + gc0 + c]);
            bf16_t* o = p.O + (size_t)grow * p.ldo + gc0 + c; const float prev = p.first ? 0.f : bf2f(*o); *o = f2bf(prev + gv * Ct[r][c]); }
    } else if (p.mode == MD_RESID) {
        for (int j = 0; j < 16; ++j) { const int c = q * 16 + j; p.Xf[(size_t)grow * DM + gc0 + c] += Ct[r][c]; }
    } else if (p.mode == MD_SILU) {
        for (int j = 0; j < 16; ++j) { const int c = q * 16 + j; const float gq = Ct[r][c], u = Ct2[r][c]; p.O[(size_t)grow * p.ldo + gc0 + c] = f2bf(gq / (1.f + __expf(-gq)) * u); }
    } else if (p.mode == MD_ROWSCALE) {
        const float w = p.roww[grow];
        for (int j = 0; j < 16; ++j) { const int c = q * 16 + j; p.O[(size_t)grow * p.ldo + gc0 + c] = f2bf(Ct[r][c] * w); }
    }
}

template <int DQK, int DV, int NKT>
__device__ __forceinline__ void attn_row(const bf16_t* q, const bf16_t* K, int ldk, const bf16_t* V, int ldv, float* qs, float* ps, int lane, float (&o)[2]) {
    for (int d = lane; d < DQK; d += 64) qs[d] = bf2f(q[d]);
    __syncthreads();
    float sc[NKT]; float m = -INFINITY;
#pragma unroll
    for (int i = 0; i < NKT; ++i) {
        const bf16_t* kr = K + (size_t)(i * 64 + lane) * ldk; float s = 0.f;
#pragma unroll
        for (int d0 = 0; d0 < DQK / 8; ++d0) { const u32x4 w = *(const u32x4*)(kr + d0 * 8);
            s += qs[d0 * 8 + 0] * __uint_as_float(w.x << 16) + qs[d0 * 8 + 1] * __uint_as_float(w.x & 0xffff0000u) + qs[d0 * 8 + 2] * __uint_as_float(w.y << 16) + qs[d0 * 8 + 3] * __uint_as_float(w.y & 0xffff0000u)
               + qs[d0 * 8 + 4] * __uint_as_float(w.z << 16) + qs[d0 * 8 + 5] * __uint_as_float(w.z & 0xffff0000u) + qs[d0 * 8 + 6] * __uint_as_float(w.w << 16) + qs[d0 * 8 + 7] * __uint_as_float(w.w & 0xffff0000u); }
        sc[i] = s; m = fmaxf(m, s);
    }
    m = wave_max(m); float l = 0.f;
#pragma unroll
    for (int i = 0; i < NKT; ++i) { const float pv = exp2f(sc[i] - m); l += pv; ps[i * 64 + lane] = pv; }
    l = wave_sum(l);
    __syncthreads();
    float a0 = 0.f, a1 = 0.f;
#pragma unroll 4
    for (int j = 0; j < NKT * 64; ++j) { const float pv = ps[j]; a0 += pv * bf2f(V[(size_t)j * ldv + lane]); if (DV == 128) a1 += pv * bf2f(V[(size_t)j * ldv + 64 + lane]); }
    o[0] = a0 / l; o[1] = a1 / l;
    __syncthreads();
}
__global__ __launch_bounds__(256) void s_attn_b(const bf16_t* __restrict__ PROJ, bf16_t* __restrict__ OBR) {
    __shared__ float qs_[4][128]; __shared__ float ps_[4][2048];
    const int w = threadIdx.x >> 6, lane = threadIdx.x & 63, row = blockIdx.x * 4 + w, qh = blockIdx.y, b = row / SEQ;
    const bf16_t* kv = PROJ + (size_t)b * SEQ * D_IN;
    float o[2];
    attn_row<64, 64, 32>(PROJ + (size_t)row * D_IN + C_BQ + qh * 64, kv + C_BK + (qh >> 2) * 64, D_IN, kv + C_BV + (qh >> 2) * 64, D_IN, qs_[w], ps_[w], lane, o);
    OBR[(size_t)row * OBR_W + 512 + qh * 64 + lane] = f2bf(o[0]);
}
__global__ __launch_bounds__(256) void s_attn_c(const bf16_t* __restrict__ PROJ, const bf16_t* __restrict__ MEMKV, bf16_t* __restrict__ OBR) {
    __shared__ float qs_[4][128]; __shared__ float ps_[4][256];
    const int w = threadIdx.x >> 6, lane = threadIdx.x & 63, row = blockIdx.x * 4 + w, h = blockIdx.y, b = row / SEQ;
    const bf16_t* kv = MEMKV + (size_t)b * MEM_LEN * 1024;
    float o[2];
    attn_row<128, 128, 4>(PROJ + (size_t)row * D_IN + C_CQ + h * 128, kv + h * 128, 1024, kv + 512 + h * 128, 1024, qs_[w], ps_[w], lane, o);
    OBR[(size_t)row * OBR_W + 1024 + h * 128 + lane] = f2bf(o[0]);
    OBR[(size_t)row * OBR_W + 1024 + h * 128 + 64 + lane] = f2bf(o[1]);
}
__global__ __launch_bounds__(256) void s_attn_a(const bf16_t* __restrict__ PROJ, bf16_t* __restrict__ OBR, const float* lq1, const float* lk1, const float* lq2, const float* lk2,
                                                const float* subg, float lam_init) {
    __shared__ float qs_[4][128]; __shared__ float ps_[4][2048];
    const int w = threadIdx.x >> 6, lane = threadIdx.x & 63, row = blockIdx.x * 4 + w, h = blockIdx.y, b = row / SEQ;
    const float lam = __expf(wave_sum(lq1[lane] * lk1[lane])) - __expf(wave_sum(lq2[lane] * lk2[lane])) + lam_init;
    const bf16_t* kv = PROJ + (size_t)b * SEQ * D_IN;
    float o0[2], o1[2];
    attn_row<64, 128, 32>(PROJ + (size_t)row * D_IN + C_AQ + h * 128, kv + C_AK + h * 128, D_IN, kv + C_AV + h * 128, D_IN, qs_[w], ps_[w], lane, o0);
    attn_row<64, 128, 32>(PROJ + (size_t)row * D_IN + C_AQ + h * 128 + 64, kv + C_AK + h * 128 + 64, D_IN, kv + C_AV + h * 128, D_IN, qs_[w], ps_[w], lane, o1);
    const float c0 = o0[0] - lam * o1[0], c1 = o0[1] - lam * o1[1];
    const float rs = rsqrtf(wave_sum(c0 * c0 + c1 * c1) * (1.f / 128.f) + EPS) * (1.f - lam_init);
    OBR[(size_t)row * OBR_W + h * 128 + lane] = f2bf(c0 * rs * subg[lane]);
    OBR[(size_t)row * OBR_W + h * 128 + 64 + lane] = f2bf(c1 * rs * subg[64 + lane]);
}

__global__ __launch_bounds__(256) void s_norm_route(const float* __restrict__ X, const float* __restrict__ g, bf16_t* __restrict__ H2, const float* __restrict__ wrg, const float* __restrict__ brg,
                                                    const float* __restrict__ wre, const float* __restrict__ bre, int* __restrict__ experts, float* __restrict__ weights, int* __restrict__ rank, unsigned* __restrict__ cnt) {
    const int lane = threadIdx.x & 63, row = blockIdx.x * 4 + (threadIdx.x >> 6);
    const f32x4* xr = (const f32x4*)(X + (size_t)row * DM);
    f32x4 v[4]; float s = 0.f;
#pragma unroll
    for (int j = 0; j < 4; ++j) { v[j] = xr[lane + 64 * j]; s += v[j].x * v[j].x + v[j].y * v[j].y + v[j].z * v[j].z + v[j].w * v[j].w; }
    const float rs = rsqrtf(wave_sum(s) * (1.f / DM) + EPS);
    float acc[36];
#pragma unroll
    for (int e = 0; e < 36; ++e) acc[e] = 0.f;
#pragma unroll
    for (int j = 0; j < 4; ++j) { const f32x4 gg = ((const f32x4*)g)[lane + 64 * j];
        float h[4] = {v[j].x * rs * gg.x, v[j].y * rs * gg.y, v[j].z * rs * gg.z, v[j].w * rs * gg.w};
        u32x2 o; o.x = f2bf(h[0]) | ((unsigned)f2bf(h[1]) << 16); o.y = f2bf(h[2]) | ((unsigned)f2bf(h[3]) << 16);
        ((u32x2*)(H2 + (size_t)row * DM))[lane + 64 * j] = o;
#pragma unroll
        for (int i = 0; i < 4; ++i) { const int k = (lane + 64 * j) * 4 + i;
            const f32x4 wg = *(const f32x4*)(wrg + (size_t)k * 4);
            acc[0] += h[i] * wg.x; acc[1] += h[i] * wg.y; acc[2] += h[i] * wg.z; acc[3] += h[i] * wg.w;
#pragma unroll
            for (int e4 = 0; e4 < 8; ++e4) { const f32x4 we = *(const f32x4*)(wre + (size_t)k * 32 + e4 * 4);
                acc[4 + e4 * 4 + 0] += h[i] * we.x; acc[4 + e4 * 4 + 1] += h[i] * we.y; acc[4 + e4 * 4 + 2] += h[i] * we.z; acc[4 + e4 * 4 + 3] += h[i] * we.w; }
        }
    }
#pragma unroll
    for (int e = 0; e < 36; ++e) acc[e] = wave_sum(acc[e]);
    if (lane == 0) {
        int gi = 0; float gm = acc[0] + brg[0];
        for (int i = 1; i < 4; ++i) { const float l = acc[i] + brg[i]; if (l > gm) { gm = l; gi = i; } }
        float gs = 0.f; for (int i = 0; i < 4; ++i) gs += __expf(acc[i] + brg[i] - gm);
        const float gp = 1.f / gs;
        float el[8];
#pragma unroll
        for (int i = 0; i < 8; ++i) el[i] = 0.f;
#pragma unroll
        for (int gq = 0; gq < 4; ++gq) if (gq == gi) {
#pragma unroll
            for (int i = 0; i < 8; ++i) el[i] = acc[4 + gq * 8 + i] + bre[gq * 8 + i]; }
        int i0 = 0; float l0 = el[0];
#pragma unroll
        for (int i = 1; i < 8; ++i) if (el[i] > l0) { l0 = el[i]; i0 = i; }
        int i1 = -1; float l1 = -INFINITY;
#pragma unroll
        for (int i = 0; i < 8; ++i) if (i != i0 && el[i] > l1) { l1 = el[i]; i1 = i; }
        const float p1 = __expf(l1 - l0), inv = 1.f / (1.f + p1);
        const int e0 = gi * 8 + i0, e1 = gi * 8 + i1;
        experts[row * 2] = e0; experts[row * 2 + 1] = e1;
        weights[row * 2] = gp * inv; weights[row * 2 + 1] = gp * p1 * inv;
        rank[row * 2] = (int)atomicAdd(cnt + e0, 1u); rank[row * 2 + 1] = (int)atomicAdd(cnt + e1, 1u);
    }
}
__global__ void s_dispatch(const unsigned* __restrict__ cnt, int* __restrict__ tile_tab) {
    if (threadIdx.x == 0) {
        int off = 0, nt = 0;
        for (int e = 0; e < NEXP; ++e) { const int c = (int)cnt[e], t = (c + MOE_TILE - 1) / MOE_TILE; tile_tab[260 + e] = off; for (int i = 0; i < t; ++i) tile_tab[nt++] = e; off += t * MOE_TILE; }
        tile_tab[256] = nt;
    }
}
__global__ __launch_bounds__(256) void s_gather(const bf16_t* __restrict__ H2, const int* __restrict__ experts, const float* __restrict__ weights, const int* __restrict__ rank, const int* __restrict__ tile_tab,
                                                bf16_t* __restrict__ BUF, float* __restrict__ roww, int* __restrict__ dest) {
    const int lane = threadIdx.x & 63, a = blockIdx.x * 4 + (threadIdx.x >> 6);
    const int tok = a >> 1, e = experts[a], d = tile_tab[260 + e] + rank[a];
    const u32x4* src = (const u32x4*)(H2 + (size_t)tok * DM); u32x4* dst = (u32x4*)(BUF + (size_t)d * DM);
    dst[lane] = src[lane]; dst[lane + 64] = src[lane + 64];
    if (lane == 0) { roww[d] = weights[a]; dest[a] = d; }
}
__global__ __launch_bounds__(256) void s_combine_norm(float* __restrict__ X, const bf16_t* __restrict__ YB, const int* __restrict__ dest, const float* __restrict__ g, bf16_t* __restrict__ H, float* __restrict__ OUT) {
    const int lane = threadIdx.x & 63, row = blockIdx.x * 4 + (threadIdx.x >> 6);
    const int d0 = dest[row * 2], d1 = dest[row * 2 + 1];
    f32x4* xr = (f32x4*)(X + (size_t)row * DM);
    f32x4 v[4]; float s = 0.f;
#pragma unroll
    for (int j = 0; j < 4; ++j) { v[j] = xr[lane + 64 * j];
        const u32x2 a = ((const u32x2*)(YB + (size_t)d0 * DM))[lane + 64 * j], b = ((const u32x2*)(YB + (size_t)d1 * DM))[lane + 64 * j];
        v[j].x += __uint_as_float(a.x << 16) + __uint_as_float(b.x << 16); v[j].y += __uint_as_float(a.x & 0xffff0000u) + __uint_as_float(b.x & 0xffff0000u);
        v[j].z += __uint_as_float(a.y << 16) + __uint_as_float(b.y << 16); v[j].w += __uint_as_float(a.y & 0xffff0000u) + __uint_as_float(b.y & 0xffff0000u);
        s += v[j].x * v[j].x + v[j].y * v[j].y + v[j].z * v[j].z + v[j].w * v[j].w; }
    const float rs = rsqrtf(wave_sum(s) * (1.f / DM) + EPS);
#pragma unroll
    for (int j = 0; j < 4; ++j) { const f32x4 gg = ((const f32x4*)g)[lane + 64 * j];
        if (H) { xr[lane + 64 * j] = v[j];
            u32x2 o; o.x = f2bf(v[j].x * rs * gg.x) | ((unsigned)f2bf(v[j].y * rs * gg.y) << 16); o.y = f2bf(v[j].z * rs * gg.z) | ((unsigned)f2bf(v[j].w * rs * gg.w) << 16);
            ((u32x2*)(H + (size_t)row * DM))[lane + 64 * j] = o; }
        else { f32x4 o; o.x = v[j].x * rs * gg.x; o.y = v[j].y * rs * gg.y; o.z = v[j].z * rs * gg.z; o.w = v[j].w * rs * gg.w; ((f32x4*)(OUT + (size_t)row * DM))[lane + 64 * j] = o; }
    }
}

extern "C" void kernel_launch(void* const* d_in, const int* in_sizes, int n_in, void* d_out, int out_size, void* d_ws, size_t ws_size, hipStream_t stream) {
    if (n_in != 26 || out_size != M * DM || ws_size < WS_END) { fprintf(stderr, "kernel_launch: unexpected shapes n_in %d out %d ws %zu\n", n_in, out_size, ws_size); return; }
    const float* x = (const float*)d_in[0]; const float* mem = (const float*)d_in[1]; const float* mem_g = (const float*)d_in[2]; const float* w_memkv = (const float*)d_in[3];
    const float* norm1_g = (const float*)d_in[4]; const float* w_in = (const float*)d_in[5];
    const float* lq1 = (const float*)d_in[6]; const float* lk1 = (const float*)d_in[7]; const float* lq2 = (const float*)d_in[8]; const float* lk2 = (const float*)d_in[9];
    const float* subln_g = (const float*)d_in[10]; const float* qn_g = (const float*)d_in[11]; const float* kn_g = (const float*)d_in[12];
    const float* w_up[3] = {(const float*)d_in[13], (const float*)d_in[14], (const float*)d_in[15]}; const float* w_out = (const float*)d_in[16];
    const float* norm2_g = (const float*)d_in[17]; const float* w_rg = (const float*)d_in[18]; const float* b_rg = (const float*)d_in[19]; const float* w_re = (const float*)d_in[20]; const float* b_re = (const float*)d_in[21];
    const float* w_eg = (const float*)d_in[22]; const float* w_eu = (const float*)d_in[23]; const float* w_ed = (const float*)d_in[24]; const float* final_g = (const float*)d_in[25];
    unsigned char* ws = (unsigned char*)d_ws; float* X = (float*)d_out;
    unsigned* ctl = (unsigned*)(ws + WS_CTL);
    bf16_t* MEMKV = (bf16_t*)(ws + WS_MEMKV); bf16_t* HM = (bf16_t*)(ws + WS_HM); bf16_t* PROJ = (bf16_t*)(ws + WS_PROJ); bf16_t* OBR = (bf16_t*)(ws + WS_OBR);
    bf16_t* BUF = (bf16_t*)(ws + WS_BUF); bf16_t* YB = (bf16_t*)(ws + WS_YB); bf16_t* HID = (bf16_t*)(ws + WS_HID);
    int* experts = (int*)(ws + WS_ROUTE + RT_EXP); float* weights = (float*)(ws + WS_ROUTE + RT_WGT); int* rank = (int*)(ws + WS_ROUTE + RT_RANK); int* dest = (int*)(ws + WS_ROUTE + RT_DEST);
    float* roww = (float*)(ws + WS_ROUTE + RT_ROWW); int* tile_tab = (int*)(ws + WS_ROUTE + RT_TILE);

    hipMemcpyAsync(X, x, (size_t)M * DM * 4, hipMemcpyDeviceToDevice, stream);
    s_rmsnorm<<<MM / 4, 256, 0, stream>>>(mem, mem_g, OBR, MM);
    { SG p{}; p.A = OBR; p.lda = DM; p.W = w_memkv; p.ldw = 1024; p.K = DM; p.mode = MD_BF16; p.O = MEMKV; p.ldo = 1024; s_gemm<<<dim3(1024 / 64, MM / 64), 256, 0, stream>>>(p); }
    s_rmsnorm<<<M / 4, 256, 0, stream>>>(X, norm1_g, HM, M);
    for (int l = 0; l < DEPTH; ++l) {
        const float lam_init = 0.8f - 0.6f * expf(-0.3f * (float)l);
        { SG p{}; p.A = HM; p.lda = DM; p.W = w_in + (size_t)l * DM * D_IN; p.ldw = D_IN; p.K = DM; p.mode = MD_PROJ; p.O = PROJ; p.ldo = D_IN; p.qg = qn_g + l * 64; p.kg = kn_g + l * 64;
          s_gemm<<<dim3(D_IN / 64, M / 64), 256, 0, stream>>>(p); }
        s_attn_a<<<dim3(M / 4, 4), 256, 0, stream>>>(PROJ, OBR, lq1 + l * 64, lk1 + l * 64, lq2 + l * 64, lk2 + l * 64, subln_g + l * 128, lam_init);
        s_attn_b<<<dim3(M / 4, 8), 256, 0, stream>>>(PROJ, OBR);
        s_attn_c<<<dim3(M / 4, 4), 256, 0, stream>>>(PROJ, MEMKV, OBR);
        for (int i = 0; i < 3; ++i) { SG p{}; p.A = OBR + 512 * i; p.lda = OBR_W; p.W = w_up[i] + (size_t)l * 512 * DM; p.ldw = DM; p.K = 512; p.mode = MD_GATE; p.O = HM; p.ldo = DM; p.G = PROJ + C_G + 1024 * i; p.ldg = D_IN; p.first = (i == 0);
            s_gemm<<<dim3(DM / 64, M / 64), 256, 0, stream>>>(p); }
        { SG p{}; p.A = HM; p.lda = DM; p.W = w_out + (size_t)l * DM * DM; p.ldw = DM; p.K = DM; p.mode = MD_RESID; p.Xf = X; s_gemm<<<dim3(DM / 64, M / 64), 256, 0, stream>>>(p); }
        hipMemsetAsync(ctl, 0, 4096, stream);
        s_norm_route<<<M / 4, 256, 0, stream>>>(X, norm2_g + l * DM, HM, w_rg + (size_t)l * DM * 4, b_rg + l * 4, w_re + (size_t)l * DM * 32, b_re + l * 32, experts, weights, rank, ctl + CW_CNT);
        s_dispatch<<<1, 64, 0, stream>>>(ctl + CW_CNT, tile_tab);
        s_gather<<<M * 2 / 4, 256, 0, stream>>>(HM, experts, weights, rank, tile_tab, BUF, roww, dest);
        { SG p{}; p.A = BUF; p.lda = DM; p.W = w_eg + (size_t)l * NEXP * DM * DEXP; p.W2 = w_eu + (size_t)l * NEXP * DM * DEXP; p.ldw = DEXP; p.wstride = (size_t)DM * DEXP; p.tile_e = tile_tab; p.ntiles = tile_tab + 256;
          p.K = DM; p.mode = MD_SILU; p.O = HID; p.ldo = DEXP; s_gemm<<<dim3(DEXP / 64, P_ROWS / 64), 256, 0, stream>>>(p); }
        { SG p{}; p.A = HID; p.lda = DEXP; p.W = w_ed + (size_t)l * NEXP * DEXP * DM; p.ldw = DM; p.wstride = (size_t)DEXP * DM; p.tile_e = tile_tab; p.ntiles = tile_tab + 256;
          p.K = DEXP; p.mode = MD_ROWSCALE; p.O = YB; p.ldo = DM; p.roww = roww; s_gemm<<<dim3(DM / 64, P_ROWS / 64), 256, 0, stream>>>(p); }
        if (l + 1 < DEPTH) s_combine_norm<<<M / 4, 256, 0, stream>>>(X, YB, dest, norm1_g + (l + 1) * DM, HM, nullptr);
        else s_combine_norm<<<M / 4, 256, 0, stream>>>(X, YB, dest, final_g, nullptr, X);
    }
}
```

```cpp
#include <hip/hip_runtime.h>
#include <cstdint>
#include <cstdio>
#include <cmath>

typedef unsigned short bf16_t;
typedef float f32x4 __attribute__((ext_vector_type(4)));
typedef unsigned u32x4 __attribute__((ext_vector_type(4)));
typedef unsigned u32x2 __attribute__((ext_vector_type(2)));

constexpr int BATCH = 8, SEQ = 2048, DM = 1024, DEPTH = 2, MEM_LEN = 256;
constexpr int M = BATCH * SEQ;
constexpr int MM = BATCH * MEM_LEN;
constexpr int D_IN = 5888;
constexpr int C_AQ = 0, C_AK = 512, C_AV = 1024, C_BQ = 1536, C_BK = 2048, C_BV = 2176, C_CQ = 2304, C_G = 2816;
constexpr int OBR_W = 1536;
constexpr int NEXP = 32, DEXP = 512;
constexpr int MOE_TILE = 256;
constexpr int P_ROWS = M * 2 + NEXP * MOE_TILE;
constexpr int MAX_TILES = P_ROWS / MOE_TILE;
constexpr float EPS = 1e-6f;
constexpr float LOG2E = 1.4426950408889634f;
constexpr float C2_64 = 0.125f * LOG2E;
constexpr float C2_128 = 0.08838834764831845f * LOG2E;

constexpr size_t MiB = 1u << 20;
constexpr size_t WS_CTL = 0;
constexpr size_t WS_ROUTE = 1 * MiB;
constexpr size_t WS_TAB = 2 * MiB;
constexpr size_t WS_MEMKV = 3 * MiB;
constexpr size_t WS_HM = 7 * MiB;
constexpr size_t WS_PROJ = 39 * MiB;
constexpr size_t WS_OBR = 223 * MiB;
constexpr size_t WS_WB = 271 * MiB;
constexpr size_t WS_END = 499 * MiB;
constexpr size_t WS_BUF = WS_PROJ;
constexpr size_t WS_YB = WS_PROJ + 80 * MiB;
constexpr size_t WS_HID = WS_OBR;
constexpr size_t RT_EXP = 0;
constexpr size_t RT_WGT = 128 * 1024;
constexpr size_t RT_RANK = 256 * 1024;
constexpr size_t RT_DEST = 384 * 1024;
constexpr size_t RT_ROWW = 512 * 1024;
constexpr size_t RT_TILE = 700 * 1024;
constexpr int CW_CNT = 0;

__device__ __forceinline__ float bf2f(bf16_t v) { return __uint_as_float(((unsigned)v) << 16); }
__device__ __forceinline__ bf16_t f2bf(float f) { unsigned u = __float_as_uint(f); return (bf16_t)((u + 0x7fffu + ((u >> 16) & 1u)) >> 16); }
__device__ __forceinline__ float wave_sum(float v) {
#pragma unroll
    for (int o = 1; o < 64; o <<= 1) v += __shfl_xor(v, o);
    return v;
}
__device__ __forceinline__ float wave_max(float v) {
#pragma unroll
    for (int o = 1; o < 64; o <<= 1) v = fmaxf(v, __shfl_xor(v, o));
    return v;
}
__device__ __forceinline__ float inv1d(int i) { return exp2f(-(float)i * (13.287712379549449f / 32.f)); }
__device__ __forceinline__ float inv2d(int j) { return exp2f(-(float)j * (13.287712379549449f / 16.f)); }
__device__ __forceinline__ float ang2d(int pos, int i) { return i < 16 ? (float)(pos >> 6) * inv2d(i) : (float)(pos & 63) * inv2d(i - 16); }

__global__ __launch_bounds__(256) void s_rmsnorm(const float* __restrict__ X, const float* __restrict__ g, bf16_t* __restrict__ OUT, int rows) {
    const int lane = threadIdx.x & 63, row = blockIdx.x * 4 + (threadIdx.x >> 6);
    if (row >= rows) return;
    const f32x4* xr = (const f32x4*)(X + (size_t)row * DM);
    f32x4 v[4]; float s = 0.f;
#pragma unroll
    for (int j = 0; j < 4; ++j) { v[j] = xr[lane + 64 * j]; s += v[j].x * v[j].x + v[j].y * v[j].y + v[j].z * v[j].z + v[j].w * v[j].w; }
    const float rs = rsqrtf(wave_sum(s) * (1.f / DM) + EPS);
#pragma unroll
    for (int j = 0; j < 4; ++j) { const f32x4 gg = ((const f32x4*)g)[lane + 64 * j];
        u32x2 o; o.x = f2bf(v[j].x * rs * gg.x) | ((unsigned)f2bf(v[j].y * rs * gg.y) << 16); o.y = f2bf(v[j].z * rs * gg.z) | ((unsigned)f2bf(v[j].w * rs * gg.w) << 16);
        ((u32x2*)(OUT + (size_t)row * DM))[lane + 64 * j] = o; }
}

enum { MD_PROJ = 0, MD_BF16 = 1, MD_GATE = 2, MD_RESID = 3, MD_SILU = 4, MD_ROWSCALE = 5 };
struct SG {
    const bf16_t* A; int lda; const float* W; const float* W2; int ldw; size_t wstride;
    const int* tile_e; const int* ntiles;
    int K; int mode;
    bf16_t* O; int ldo;
    float* Xf;
    const bf16_t* G; int ldg; int first;
    const float* roww;
    const float* qg; const float* kg;
};
__global__ __launch_bounds__(256) void s_gemm(SG p) {
    __shared__ float As[16][68];
    __shared__ float Bs[16][68];
    __shared__ float B2s[16][68];
    __shared__ float Ct[64][65];
    __shared__ float Ct2[64][65];
    const int tid = threadIdx.x, tx = tid & 15, ty = tid >> 4;
    const int gc0 = blockIdx.x * 64, gr0 = blockIdx.y * 64;
    const float* W = p.W; const float* W2 = p.W2;
    if (p.tile_e) { const int t256 = blockIdx.y >> 2; if (t256 >= *p.ntiles) return; const int e = p.tile_e[t256]; W += (size_t)e * p.wstride; if (W2) W2 += (size_t)e * p.wstride; }
    float acc[4][4] = {}, acc2[4][4] = {};
    const int ar = tid >> 2, ak = (tid & 3) * 4;
    const int bk = tid >> 4, bn = (tid & 15) * 4;
    for (int k0 = 0; k0 < p.K; k0 += 16) {
        { const u32x2 a = *(const u32x2*)(p.A + (size_t)(gr0 + ar) * p.lda + k0 + ak);
          As[ak + 0][ar] = __uint_as_float(a.x << 16); As[ak + 1][ar] = __uint_as_float(a.x & 0xffff0000u);
          As[ak + 2][ar] = __uint_as_float(a.y << 16); As[ak + 3][ar] = __uint_as_float(a.y & 0xffff0000u); }
        { const f32x4 b = *(const f32x4*)(W + (size_t)(k0 + bk) * p.ldw + gc0 + bn); Bs[bk][bn] = b.x; Bs[bk][bn + 1] = b.y; Bs[bk][bn + 2] = b.z; Bs[bk][bn + 3] = b.w; }
        if (p.mode == MD_SILU) { const f32x4 b = *(const f32x4*)(W2 + (size_t)(k0 + bk) * p.ldw + gc0 + bn); B2s[bk][bn] = b.x; B2s[bk][bn + 1] = b.y; B2s[bk][bn + 2] = b.z; B2s[bk][bn + 3] = b.w; }
        __syncthreads();
#pragma unroll
        for (int k = 0; k < 16; ++k) {
            float a[4], b[4];
#pragma unroll
            for (int i = 0; i < 4; ++i) { a[i] = As[k][ty * 4 + i]; b[i] = Bs[k][tx * 4 + i]; }
#pragma unroll
            for (int i = 0; i < 4; ++i)
#pragma unroll
                for (int j = 0; j < 4; ++j) acc[i][j] += a[i] * b[j];
            if (p.mode == MD_SILU) {
#pragma unroll
                for (int i = 0; i < 4; ++i) b[i] = B2s[k][tx * 4 + i];
#pragma unroll
                for (int i = 0; i < 4; ++i)
#pragma unroll
                    for (int j = 0; j < 4; ++j) acc2[i][j] += a[i] * b[j];
            }
        }
        __syncthreads();
    }
#pragma unroll
    for (int i = 0; i < 4; ++i)
#pragma unroll
        for (int j = 0; j < 4; ++j) { Ct[ty * 4 + i][tx * 4 + j] = acc[i][j]; Ct2[ty * 4 + i][tx * 4 + j] = acc2[i][j]; }
    __syncthreads();
    const int r = tid >> 2, q = tid & 3; const int grow = gr0 + r;
    if (p.mode == MD_PROJ) {
        const int pos = grow & (SEQ - 1);
        bf16_t* orow = p.O + (size_t)grow * p.ldo + gc0;
        if (gc0 < C_AV) {
            const float sc = gc0 < C_AK ? C2_64 : 1.f;
            for (int j = 0; j < 8; ++j) { const int i = q * 8 + j; const float x1 = Ct[r][i], x2 = Ct[r][i + 32]; float s, c; sincosf((float)pos * inv1d(i), &s, &c);
                orow[i] = f2bf((x1 * c - x2 * s) * sc); orow[i + 32] = f2bf((x2 * c + x1 * s) * sc); }
        } else if ((gc0 >= C_BQ && gc0 < C_BV)) {
            const bool isq = gc0 < C_BK; const float* g = isq ? p.qg : p.kg; const float sc = isq ? C2_64 : 1.f;
            float ss = 0.f; for (int d = 0; d < 64; ++d) ss += Ct[r][d] * Ct[r][d];
            const float rs = rsqrtf(ss * (1.f / 64.f) + EPS);
            for (int j = 0; j < 8; ++j) { const int i = q * 8 + j; const float x1 = Ct[r][i] * rs * g[i], x2 = Ct[r][i + 32] * rs * g[i + 32]; float s, c; sincosf(ang2d(pos, i), &s, &c);
                orow[i] = f2bf((x1 * c - x2 * s) * sc); orow[i + 32] = f2bf((x2 * c + x1 * s) * sc); }
        } else if (gc0 >= C_G) {
            for (int j = 0; j < 16; ++j) { const int c = q * 16 + j; orow[c] = f2bf(1.f / (1.f + __expf(-Ct[r][c]))); }
        } else {
            const float sc = (gc0 >= C_CQ) ? C2_128 : 1.f;
            for (int j = 0; j < 16; ++j) { const int c = q * 16 + j; orow[c] = f2bf(Ct[r][c] * sc); }
        }
    } else if (p.mode == MD_BF16) {
        for (int j = 0; j < 16; ++j) { const int c = q * 16 + j; p.O[(size_t)grow * p.ldo + gc0 + c] = f2bf(Ct[r][c]); }
    } else if (p.mode == MD_GATE) {
        for (int j = 0; j < 16; ++j) { const int c = q * 16 + j; const float gv = bf2f(p.G[(size_t)grow * p.ldg + gc0 + c]);
            bf16_t* o = p.O + (size_t)grow * p.ldo + gc0 + c; const float prev = p.first ? 0.f : bf2f(*o); *o = f2bf(prev + gv * Ct[r][c]); }
    } else if (p.mode == MD_RESID) {
        for (int j = 0; j < 16; ++j) { const int c = q * 16 + j; p.Xf[(size_t)grow * DM + gc0 + c] += Ct[r][c]; }
    } else if (p.mode == MD_SILU) {
        for (int j = 0; j < 16; ++j) { const int c = q * 16 + j; const float gq = Ct[r][c], u = Ct2[r][c]; p.O[(size_t)grow * p.ldo + gc0 + c] = f2bf(gq / (1.f + __expf(-gq)) * u); }
    } else if (p.mode == MD_ROWSCALE) {
        const float w = p.roww[grow];
        for (int j = 0; j < 16; ++j) { const int c = q * 16 + j; p.O[(size_t)grow * p.ldo + gc0 + c] = f2bf(Ct[r][c] * w); }
    }
}

template <int DQK, int DV, int NKT>
__device__ __forceinline__ void attn_row(const bf16_t* q, const bf16_t* K, int ldk, const bf16_t* V, int ldv, float* qs, float* ps, int lane, float (&o)[2]) {
    for (int d = lane; d < DQK; d += 64) qs[d] = bf2f(q[d]);
    __syncthreads();
    float sc[NKT]; float m = -INFINITY;
#pragma unroll
    for (int i = 0; i < NKT; ++i) {
        const bf16_t* kr = K + (size_t)(i * 64 + lane) * ldk; float s = 0.f;
#pragma unroll
        for (int d0 = 0; d0 < DQK / 8; ++d0) { const u32x4 w = *(const u32x4*)(kr + d0 * 8);
            s += qs[d0 * 8 + 0] * __uint_as_float(w.x << 16) + qs[d0 * 8 + 1] * __uint_as_float(w.x & 0xffff0000u) + qs[d0 * 8 + 2] * __uint_as_float(w.y << 16) + qs[d0 * 8 + 3] * __uint_as_float(w.y & 0xffff0000u)
               + qs[d0 * 8 + 4] * __uint_as_float(w.z << 16) + qs[d0 * 8 + 5] * __uint_as_float(w.z & 0xffff0000u) + qs[d0 * 8 + 6] * __uint_as_float(w.w << 16) + qs[d0 * 8 + 7] * __uint_as_float(w.w & 0xffff0000u); }
        sc[i] = s; m = fmaxf(m, s);
    }
    m = wave_max(m); float l = 0.f;
#pragma unroll
    for (int i = 0; i < NKT; ++i) { const float pv = exp2f(sc[i] - m); l += pv; ps[i * 64 + lane] = pv; }
    l = wave_sum(l);
    __syncthreads();
    float a0 = 0.f, a1 = 0.f;
#pragma unroll 4
    for (int j = 0; j < NKT * 64; ++j) { const float pv = ps[j]; a0 += pv * bf2f(V[(size_t)j * ldv + lane]); if (DV == 128) a1 += pv * bf2f(V[(size_t)j * ldv + 64 + lane]); }
    o[0] = a0 / l; o[1] = a1 / l;
    __syncthreads();
}
__global__ __launch_bounds__(256) void s_attn_b(const bf16_t* __restrict__ PROJ, bf16_t* __restrict__ OBR) {
    __shared__ float qs_[4][128]; __shared__ float ps_[4][2048];
    const int w = threadIdx.x >> 6, lane = threadIdx.x & 63, row = blockIdx.x * 4 + w, qh = blockIdx.y, b = row / SEQ;
    const bf16_t* kv = PROJ + (size_t)b * SEQ * D_IN;
    float o[2];
    attn_row<64, 64, 32>(PROJ + (size_t)row * D_IN + C_BQ + qh * 64, kv + C_BK + (qh >> 2) * 64, D_IN, kv + C_BV + (qh >> 2) * 64, D_IN, qs_[w], ps_[w], lane, o);
    OBR[(size_t)row * OBR_W + 512 + qh * 64 + lane] = f2bf(o[0]);
}
__global__ __launch_bounds__(256) void s_attn_c(const bf16_t* __restrict__ PROJ, const bf16_t* __restrict__ MEMKV, bf16_t* __restrict__ OBR) {
    __shared__ float qs_[4][128]; __shared__ float ps_[4][256];
    const int w = threadIdx.x >> 6, lane = threadIdx.x & 63, row = blockIdx.x * 4 + w, h = blockIdx.y, b = row / SEQ;
    const bf16_t* kv = MEMKV + (size_t)b * MEM_LEN * 1024;
    float o[2];
    attn_row<128, 128, 4>(PROJ + (size_t)row * D_IN + C_CQ + h * 128, kv + h * 128, 1024, kv + 512 + h * 128, 1024, qs_[w], ps_[w], lane, o);
    OBR[(size_t)row * OBR_W + 1024 + h * 128 + lane] = f2bf(o[0]);
    OBR[(size_t)row * OBR_W + 1024 + h * 128 + 64 + lane] = f2bf(o[1]);
}
__global__ __launch_bounds__(256) void s_attn_a(const bf16_t* __restrict__ PROJ, bf16_t* __restrict__ OBR, const float* lq1, const float* lk1, const float* lq2, const float* lk2,
                                                const float* subg, float lam_init) {
    __shared__ float qs_[4][128]; __shared__ float ps_[4][2048];
    const int w = threadIdx.x >> 6, lane = threadIdx.x & 63, row = blockIdx.x * 4 + w, h = blockIdx.y, b = row / SEQ;
    const float lam = __expf(wave_sum(lq1[lane] * lk1[lane])) - __expf(wave_sum(lq2[lane] * lk2[lane])) + lam_init;
    const bf16_t* kv = PROJ + (size_t)b * SEQ * D_IN;
    float o0[2], o1[2];
    attn_row<64, 128, 32>(PROJ + (size_t)row * D_IN + C_AQ + h * 128, kv + C_AK + h * 128, D_IN, kv + C_AV + h * 128, D_IN, qs_[w], ps_[w], lane, o0);
    attn_row<64, 128, 32>(PROJ + (size_t)row * D_IN + C_AQ + h * 128 + 64, kv + C_AK + h * 128 + 64, D_IN, kv + C_AV + h * 128, D_IN, qs_[w], ps_[w], lane, o1);
    const float c0 = o0[0] - lam * o1[0], c1 = o0[1] - lam * o1[1];
    const float rs = rsqrtf(wave_sum(c0 * c0 + c1 * c1) * (1.f / 128.f) + EPS) * (1.f - lam_init);
    OBR[(size_t)row * OBR_W + h * 128 + lane] = f2bf(c0 * rs * subg[lane]);
    OBR[(size_t)row * OBR_W + h * 128 + 64 + lane] = f2bf(c1 * rs * subg[64 + lane]);
}

__global__ __launch_bounds__(256) void s_norm_route(const float* __restrict__ X, const float* __restrict__ g, bf16_t* __restrict__ H2, const float* __restrict__ wrg, const float* __restrict__ brg,
                                                    const float* __restrict__ wre, const float* __restrict__ bre, int* __restrict__ experts, float* __restrict__ weights, int* __restrict__ rank, unsigned* __restrict__ cnt) {
    const int lane = threadIdx.x & 63, row = blockIdx.x * 4 + (threadIdx.x >> 6);
    const f32x4* xr = (const f32x4*)(X + (size_t)row * DM);
    f32x4 v[4]; float s = 0.f;
#pragma unroll
    for (int j = 0; j < 4; ++j) { v[j] = xr[lane + 64 * j]; s += v[j].x * v[j].x + v[j].y * v[j].y + v[j].z * v[j].z + v[j].w * v[j].w; }
    const float rs = rsqrtf(wave_sum(s) * (1.f / DM) + EPS);
    float acc[36];
#pragma unroll
    for (int e = 0; e < 36; ++e) acc[e] = 0.f;
#pragma unroll
    for (int j = 0; j < 4; ++j) { const f32x4 gg = ((const f32x4*)g)[lane + 64 * j];
        float h[4] = {v[j].x * rs * gg.x, v[j].y * rs * gg.y, v[j].z * rs * gg.z, v[j].w * rs * gg.w};
        u32x2 o; o.x = f2bf(h[0]) | ((unsigned)f2bf(h[1]) << 16); o.y = f2bf(h[2]) | ((unsigned)f2bf(h[3]) << 16);
        ((u32x2*)(H2 + (size_t)row * DM))[lane + 64 * j] = o;
#pragma unroll
        for (int i = 0; i < 4; ++i) { const int k = (lane + 64 * j) * 4 + i;
            const f32x4 wg = *(const f32x4*)(wrg + (size_t)k * 4);
            acc[0] += h[i] * wg.x; acc[1] += h[i] * wg.y; acc[2] += h[i] * wg.z; acc[3] += h[i] * wg.w;
#pragma unroll
            for (int e4 = 0; e4 < 8; ++e4) { const f32x4 we = *(const f32x4*)(wre + (size_t)k * 32 + e4 * 4);
                acc[4 + e4 * 4 + 0] += h[i] * we.x; acc[4 + e4 * 4 + 1] += h[i] * we.y; acc[4 + e4 * 4 + 2] += h[i] * we.z; acc[4 + e4 * 4 + 3] += h[i] * we.w; }
        }
    }
#pragma unroll
    for (int e = 0; e < 36; ++e) acc[e] = wave_sum(acc[e]);
    if (lane == 0) {
        int gi = 0; float gm = acc[0] + brg[0];
        for (int i = 1; i < 4; ++i) { const float l = acc[i] + brg[i]; if (l > gm) { gm = l; gi = i; } }
        float gs = 0.f; for (int i = 0; i < 4; ++i) gs += __expf(acc[i] + brg[i] - gm);
        const float gp = 1.f / gs;
        float el[8];
#pragma unroll
        for (int i = 0; i < 8; ++i) el[i] = 0.f;
#pragma unroll
        for (int gq = 0; gq < 4; ++gq) if (gq == gi) {
#pragma unroll
            for (int i = 0; i < 8; ++i) el[i] = acc[4 + gq * 8 + i] + bre[gq * 8 + i]; }
        int i0 = 0; float l0 = el[0];
#pragma unroll
        for (int i = 1; i < 8; ++i) if (el[i] > l0) { l0 = el[i]; i0 = i; }
        int i1 = -1; float l1 = -INFINITY;
#pragma unroll
        for (int i = 0; i < 8; ++i) if (i != i0 && el[i] > l1) { l1 = el[i]; i1 = i; }
        const float p1 = __expf(l1 - l0), inv = 1.f / (1.f + p1);
        const int e0 = gi * 8 + i0, e1 = gi * 8 + i1;
        experts[row * 2] = e0; experts[row * 2 + 1] = e1;
        weights[row * 2] = gp * inv; weights[row * 2 + 1] = gp * p1 * inv;
        rank[row * 2] = (int)atomicAdd(cnt + e0, 1u); rank[row * 2 + 1] = (int)atomicAdd(cnt + e1, 1u);
    }
}
__global__ void s_dispatch(const unsigned* __restrict__ cnt, int* __restrict__ tile_tab) {
    if (threadIdx.x == 0) {
        int off = 0, nt = 0;
        for (int e = 0; e < NEXP; ++e) { const int c = (int)cnt[e], t = (c + MOE_TILE - 1) / MOE_TILE; tile_tab[260 + e] = off; for (int i = 0; i < t; ++i) tile_tab[nt++] = e; off += t * MOE_TILE; }
        tile_tab[256] = nt;
    }
}
__global__ __launch_bounds__(256) void s_gather(const bf16_t* __restrict__ H2, const int* __restrict__ experts, const float* __restrict__ weights, const int* __restrict__ rank, const int* __restrict__ tile_tab,
                                                bf16_t* __restrict__ BUF, float* __restrict__ roww, int* __restrict__ dest) {
    const int lane = threadIdx.x & 63, a = blockIdx.x * 4 + (threadIdx.x >> 6);
    const int tok = a >> 1, e = experts[a], d = tile_tab[260 + e] + rank[a];
    const u32x4* src = (const u32x4*)(H2 + (size_t)tok * DM); u32x4* dst = (u32x4*)(BUF + (size_t)d * DM);
    dst[lane] = src[lane]; dst[lane + 64] = src[lane + 64];
    if (lane == 0) { roww[d] = weights[a]; dest[a] = d; }
}
__global__ __launch_bounds__(256) void s_combine_norm(float* __restrict__ X, const bf16_t* __restrict__ YB, const int* __restrict__ dest, const float* __restrict__ g, bf16_t* __restrict__ H, float* __restrict__ OUT) {
    const int lane = threadIdx.x & 63, row = blockIdx.x * 4 + (threadIdx.x >> 6);
    const int d0 = dest[row * 2], d1 = dest[row * 2 + 1];
    f32x4* xr = (f32x4*)(X + (size_t)row * DM);
    f32x4 v[4]; float s = 0.f;
#pragma unroll
    for (int j = 0; j < 4; ++j) { v[j] = xr[lane + 64 * j];
        const u32x2 a = ((const u32x2*)(YB + (size_t)d0 * DM))[lane + 64 * j], b = ((const u32x2*)(YB + (size_t)d1 * DM))[lane + 64 * j];
        v[j].x += __uint_as_float(a.x << 16) + __uint_as_float(b.x << 16); v[j].y += __uint_as_float(a.x & 0xffff0000u) + __uint_as_float(b.x & 0xffff0000u);
        v[j].z += __uint_as_float(a.y << 16) + __uint_as_float(b.y << 16); v[j].w += __uint_as_float(a.y & 0xffff0000u) + __uint_as_float(b.y & 0xffff0000u);
        s += v[j].x * v[j].x + v[j].y * v[j].y + v[j].z * v[j].z + v[j].w * v[j].w; }
    const float rs = rsqrtf(wave_sum(s) * (1.f / DM) + EPS);
#pragma unroll
    for (int j = 0; j < 4; ++j) { const f32x4 gg = ((const f32x4*)g)[lane + 64 * j];
        if (H) { xr[lane + 64 * j] = v[j];
            u32x2 o; o.x = f2bf(v[j].x * rs * gg.x) | ((unsigned)f2bf(v[j].y * rs * gg.y) << 16); o.y = f2bf(v[j].z * rs * gg.z) | ((unsigned)f2bf(v[j].w * rs * gg.w) << 16);
            ((u32x2*)(H + (size_t)row * DM))[lane + 64 * j] = o; }
        else { f32x4 o; o.x = v[j].x * rs * gg.x; o.y = v[j].y * rs * gg.y; o.z = v[j].z * rs * gg.z; o.w = v[j].w * rs * gg.w; ((f32x4*)(OUT + (size_t)row * DM))[lane + 64 * j] = o; }
    }
}

#define LAS __attribute__((address_space(3)))
#define GAS __attribute__((address_space(1)))
typedef short bf16x8 __attribute__((ext_vector_type(8)));
typedef short s16x4 __attribute__((ext_vector_type(4)));
typedef float f32x16 __attribute__((ext_vector_type(16)));
typedef float f32x2 __attribute__((ext_vector_type(2)));

constexpr size_t WB_IN = 0, WB_UP = 6029312, WB_OUT = WB_UP + 1572864, WB_GU = WB_OUT + 1048576, WB_DN = WB_GU + 33554432, WB_LAYER = WB_DN + 16777216;
constexpr size_t WB_MEMKV = 2 * WB_LAYER;
static_assert(WS_WB + (WB_MEMKV + 1048576) * 2 <= WS_END, "weight copies fit");
constexpr int N_PHASES = 19;

__device__ __forceinline__ unsigned cvt_pk_bf16(float lo, float hi) { unsigned r; asm volatile("v_cvt_pk_bf16_f32 %0, %1, %2" : "=v"(r) : "v"(lo), "v"(hi)); return r; }
__device__ __forceinline__ float fast_sigmoid(float v) { return __builtin_amdgcn_rcpf(1.f + __builtin_amdgcn_exp2f(-v * LOG2E)); }

namespace pg8 {
#define PG8_LAS LAS
constexpr int BM = 256, BK = 64, HALF = 128, HTB = HALF * BK * 2, STAGE_BYTES = 8 * HTB, NXCD = 8, WGM = 8;
__host__ __device__ __forceinline__ int lds_byte(int r, int c) { const int st = (r >> 4) * 2 + (c >> 5), rr = r & 15, cc = c & 31, ob = rr * 64 + cc * 2; return st * 1024 + (ob ^ (((ob >> 9) & 1) << 5)); }
__host__ __device__ __forceinline__ void stage_rc(int b, int& R, int& C) { const int st = b / 1024, sb = b % 1024, swz = sb ^ (((sb >> 9) & 1) << 5); R = (st >> 1) * 16 + swz / 64; C = (st & 1) * 32 + (swz % 64) / 2; }
__host__ __device__ __forceinline__ int perm32(int rho) { const int n = rho >> 4, i = rho & 15; return 8 * (i >> 2) + 4 * n + (i & 3); }

struct Unit { int pm, pn, sub; const char* a; const char* b; };
struct Gemm { int lda; int K; };
__device__ __forceinline__ void tile_order(int L, int nM, int nN, int& pm, int& pn) {
    const int nwg = nM * nN; int wgid = L; { const int q = nwg / NXCD, r = nwg % NXCD, xcd = wgid % NXCD, off = wgid / NXCD; wgid = (xcd < r ? xcd * (q + 1) : r * (q + 1) + (xcd - r) * q) + off; }
    const int nig = WGM * nN, gid = wgid / nig, fm = gid * WGM, gsz = (nM - fm) < WGM ? (nM - fm) : WGM;
    pm = fm + ((wgid % nig) % gsz); pn = (wgid % nig) / gsz;
}
__device__ __forceinline__ u32x4 pack8(const f32x4& v0, const f32x4& v1) { u32x4 w; w.x = cvt_pk_bf16(v0[0], v0[1]); w.y = cvt_pk_bf16(v0[2], v0[3]); w.z = cvt_pk_bf16(v1[0], v1[1]); w.w = cvt_pk_bf16(v1[2], v1[3]); return w; }
__device__ __forceinline__ void unpack8(const u32x4& w, f32x4& v0, f32x4& v1) {
    v0[0] = __uint_as_float(w.x << 16); v0[1] = __uint_as_float(w.x & 0xffff0000u); v0[2] = __uint_as_float(w.y << 16); v0[3] = __uint_as_float(w.y & 0xffff0000u);
    v1[0] = __uint_as_float(w.z << 16); v1[1] = __uint_as_float(w.z & 0xffff0000u); v1[2] = __uint_as_float(w.w << 16); v1[3] = __uint_as_float(w.w & 0xffff0000u); }

struct EpiProj {
    static constexpr bool PERM = true, AFTER_DRAIN = false;
    bf16_t* PROJ; bf16_t* MEMKV; const float* tab1; const float* tab2; const float* qg; const float* kg;
    __device__ __forceinline__ void operator()(const f32x4 (&acc)[2][2][4][2], const Unit& u, int wr, int wc, int fr, int fq) const {
        const int colt = u.pn * 256, dcol = colt + wc * 64 + fq * 8, row0 = u.pm * 256 + wr * 64 + fr;
        if (u.sub == 1) {
#pragma unroll
            for (int ai = 0; ai < 2; ++ai)
#pragma unroll
                for (int m = 0; m < 4; ++m) { bf16_t* rowp = MEMKV + (size_t)(row0 + ai * 128 + m * 16) * 1024 + dcol;
#pragma unroll
                    for (int bj = 0; bj < 2; ++bj) *(u32x4*)(rowp + bj * 32) = pack8(acc[ai][bj][m][0], acc[ai][bj][m][1]); }
            return;
        }
        int mode = 0; float sc = 1.f; const float* g = qg;
        if (colt < C_AV) { mode = 1; if (colt < C_AK) sc = C2_64; }
        else if (colt < C_BQ) mode = 0;
        else if (colt < C_BK) { mode = 2; sc = C2_64; }
        else if (colt < C_CQ) { if (wc < 2) { mode = 2; g = kg; } }
        else if (colt < C_G) sc = C2_128;
        else mode = 3;
        f32x4 gv[2][2];
        if (mode == 2) {
#pragma unroll
            for (int bj = 0; bj < 2; ++bj)
#pragma unroll
                for (int n = 0; n < 2; ++n) gv[bj][n] = *(const f32x4*)(g + bj * 32 + fq * 8 + n * 4);
        }
#pragma unroll
        for (int ai = 0; ai < 2; ++ai)
#pragma unroll
            for (int m = 0; m < 4; ++m) {
                const int row = row0 + ai * 128 + m * 16, pos = row & (SEQ - 1);
                f32x4 v[2][2] = {{acc[ai][0][m][0], acc[ai][0][m][1]}, {acc[ai][1][m][0], acc[ai][1][m][1]}};
                if (mode == 2) {
                    float ss = 0.f;
#pragma unroll
                    for (int bj = 0; bj < 2; ++bj)
#pragma unroll
                        for (int n = 0; n < 2; ++n) ss += (v[bj][n][0] * v[bj][n][0] + v[bj][n][1] * v[bj][n][1]) + (v[bj][n][2] * v[bj][n][2] + v[bj][n][3] * v[bj][n][3]);
                    ss += __shfl_xor(ss, 16); ss += __shfl_xor(ss, 32);
                    const float rs = rsqrtf(ss * (1.f / 64.f) + EPS);
#pragma unroll
                    for (int bj = 0; bj < 2; ++bj)
#pragma unroll
                        for (int n = 0; n < 2; ++n) v[bj][n] = v[bj][n] * rs * gv[bj][n];
                }
                if (mode == 1 || mode == 2) {
                    const float* tb = (mode == 1 ? tab1 : tab2) + ((size_t)pos * 32 + fq * 8) * 2;
#pragma unroll
                    for (int n = 0; n < 2; ++n) { const f32x4 t0 = *(const f32x4*)(tb + n * 8), t1 = *(const f32x4*)(tb + n * 8 + 4);
                        const float cs[4] = {t0[0], t0[2], t1[0], t1[2]}, sn[4] = {t0[1], t0[3], t1[1], t1[3]};
#pragma unroll
                        for (int e = 0; e < 4; ++e) { const float x1 = v[0][n][e], x2 = v[1][n][e]; v[0][n][e] = x1 * cs[e] - x2 * sn[e]; v[1][n][e] = x2 * cs[e] + x1 * sn[e]; } }
                }
                if (mode == 3) {
#pragma unroll
                    for (int bj = 0; bj < 2; ++bj)
#pragma unroll
                        for (int n = 0; n < 2; ++n)
#pragma unroll
                            for (int e = 0; e < 4; ++e) v[bj][n][e] = fast_sigmoid(v[bj][n][e]);
                }
                bf16_t* rowp = PROJ + (size_t)row * D_IN + dcol;
#pragma unroll
                for (int bj = 0; bj < 2; ++bj) *(u32x4*)(rowp + bj * 32) = pack8(v[bj][0] * sc, v[bj][1] * sc);
            }
    }
};
struct EpiGate {
    static constexpr bool PERM = true, AFTER_DRAIN = false;
    bf16_t* MERGED; const bf16_t* PROJ;
    __device__ __forceinline__ void operator()(const f32x4 (&acc)[2][2][4][2], const Unit& u, int wr, int wc, int fr, int fq) const {
        const int col0 = u.pn * 256 + wc * 32 + fq * 8, row0 = u.pm * 256 + wr * 64 + fr;
#pragma unroll
        for (int ai = 0; ai < 2; ++ai)
#pragma unroll
            for (int m = 0; m < 4; ++m) { const int row = row0 + ai * 128 + m * 16;
                const bf16_t* gp = PROJ + (size_t)row * D_IN + C_G + u.sub * 1024 + col0; bf16_t* op = MERGED + (size_t)row * DM + col0;
#pragma unroll
                for (int bj = 0; bj < 2; ++bj) { f32x4 g0, g1, o0 = {0.f, 0.f, 0.f, 0.f}, o1 = {0.f, 0.f, 0.f, 0.f};
                    unpack8(*(const u32x4*)(gp + bj * 128), g0, g1);
                    if (u.sub != 0) unpack8(*(const u32x4*)(op + bj * 128), o0, o1);
                    o0 += g0 * acc[ai][bj][m][0]; o1 += g1 * acc[ai][bj][m][1];
                    *(u32x4*)(op + bj * 128) = pack8(o0, o1); } }
    }
};
struct EpiResid {
    static constexpr bool PERM = true, AFTER_DRAIN = false;
    float* X;
    __device__ __forceinline__ void operator()(const f32x4 (&acc)[2][2][4][2], const Unit& u, int wr, int wc, int fr, int fq) const {
        const int col0 = u.pn * 256 + wc * 32 + fq * 8, row0 = u.pm * 256 + wr * 64 + fr;
#pragma unroll
        for (int ai = 0; ai < 2; ++ai)
#pragma unroll
            for (int m = 0; m < 4; ++m) { float* xp = X + (size_t)(row0 + ai * 128 + m * 16) * DM + col0;
#pragma unroll
                for (int bj = 0; bj < 2; ++bj) { f32x4* p = (f32x4*)(xp + bj * 128); const f32x4 a = p[0], b = p[1]; p[0] = a + acc[ai][bj][m][0]; p[1] = b + acc[ai][bj][m][1]; } }
    }
};
struct EpiSilu {
    static constexpr bool PERM = true, AFTER_DRAIN = false;
    bf16_t* HID;
    __device__ __forceinline__ void operator()(const f32x4 (&acc)[2][2][4][2], const Unit& u, int wr, int wc, int fr, int fq) const {
        const int col0 = u.pn * 128 + wc * 32 + fq * 8, row0 = u.pm * 256 + wr * 64 + fr;
#pragma unroll
        for (int ai = 0; ai < 2; ++ai)
#pragma unroll
            for (int m = 0; m < 4; ++m) { f32x4 h[2];
#pragma unroll
                for (int n = 0; n < 2; ++n)
#pragma unroll
                    for (int e = 0; e < 4; ++e) { const float gq = acc[ai][0][m][n][e]; h[n][e] = gq * fast_sigmoid(gq) * acc[ai][1][m][n][e]; }
                *(u32x4*)(HID + (size_t)(row0 + ai * 128 + m * 16) * DEXP + col0) = pack8(h[0], h[1]); }
    }
};
struct EpiRowScale {
    static constexpr bool PERM = true, AFTER_DRAIN = false;
    bf16_t* YB; const float* roww;
    __device__ __forceinline__ void operator()(const f32x4 (&acc)[2][2][4][2], const Unit& u, int wr, int wc, int fr, int fq) const {
        const int col0 = u.pn * 256 + wc * 32 + fq * 8, row0 = u.pm * 256 + wr * 64 + fr;
#pragma unroll
        for (int ai = 0; ai < 2; ++ai)
#pragma unroll
            for (int m = 0; m < 4; ++m) { const int row = row0 + ai * 128 + m * 16; const float w = roww[row]; bf16_t* op = YB + (size_t)row * DM + col0;
#pragma unroll
                for (int bj = 0; bj < 2; ++bj) *(u32x4*)(op + bj * 128) = pack8(acc[ai][bj][m][0] * w, acc[ai][bj][m][1] * w); }
    }
};
struct SchedProj {
    int c, G, nmain, ntotal; const char* A; const char* B; const char* Am; const char* Bm;
    __device__ __forceinline__ bool next(int i, Unit& u) const {
        const long L = (long)i * G + c; if (L >= ntotal) return false;
        if (L < nmain) { tile_order((int)L, M / 256, D_IN / 256, u.pm, u.pn); u.sub = 0; u.a = A + (size_t)u.pm * (256 * DM * 2); u.b = B + (size_t)u.pn * (256 * DM * 2); }
        else { const int r = (int)L - nmain; u.pm = r >> 2; u.pn = r & 3; u.sub = 1; u.a = Am + (size_t)u.pm * (256 * DM * 2); u.b = Bm + (size_t)u.pn * (256 * DM * 2); }
        return true; }
    __device__ __forceinline__ void a_ready(const Unit&) const {}
    __device__ __forceinline__ void done(const Unit&) const {}
};
struct SchedGate {
    int c, G; const char* OBRp; const char* WUP;
    __device__ __forceinline__ bool next(int i, Unit& u) const {
        const int t = c + G * (i / 3); if (t >= 256) return false;
        tile_order(t, M / 256, 4, u.pm, u.pn); u.sub = i % 3;
        u.a = OBRp + ((size_t)u.pm * 256 * OBR_W + 512 * u.sub) * 2; u.b = WUP + ((size_t)u.sub * 1024 * 512 + (size_t)u.pn * 256 * 512) * 2; return true; }
    __device__ __forceinline__ void a_ready(const Unit&) const {}
    __device__ __forceinline__ void done(const Unit&) const {}
};
struct SchedPlain {
    int c, G, nM; const char* A; const char* B; size_t a_tile, b_tile;
    __device__ __forceinline__ bool next(int i, Unit& u) const {
        const long L = (long)i * G + c; if (L >= (long)nM * 4) return false;
        tile_order((int)L, nM, 4, u.pm, u.pn); u.sub = 0; u.a = A + (size_t)u.pm * a_tile; u.b = B + (size_t)u.pn * b_tile; return true; }
    __device__ __forceinline__ void a_ready(const Unit&) const {}
    __device__ __forceinline__ void done(const Unit&) const {}
};
struct SchedMoe {
    int c, G, ntiles; const int* tile_e; const char* A; const char* B; size_t a_tile, b_exp, b_tile;
    __device__ __forceinline__ bool next(int i, Unit& u) const {
        const long L = (long)i * G + c; if (L >= (long)ntiles * 4) return false;
        u.pm = (int)(L >> 2); u.pn = (int)(L & 3); u.sub = 0; const int e = tile_e[u.pm];
        u.a = A + (size_t)u.pm * a_tile; u.b = B + (size_t)e * b_exp + (size_t)u.pn * b_tile; return true; }
    __device__ __forceinline__ void a_ready(const Unit&) const {}
    __device__ __forceinline__ void done(const Unit&) const {}
};

template <class Epi, class Sched, bool ALIGN_EPI = false, bool SP2 = false>
__device__ __forceinline__ void gemm_phase(PG8_LAS unsigned char* lds, const Gemm g, const Sched& S, const Epi& E) {
    int tid_ = threadIdx.x; asm volatile("" : "+v"(tid_));
    const int tid = tid_, wid = __builtin_amdgcn_readfirstlane(tid >> 6), lane = tid & 63, wr = wid >> 2, wc = wid & 3, fr = lane & 15, fq = lane >> 4;
    const int K = g.K, nt = K / BK;
    unsigned voffA[2], voffB[2];
#pragma unroll
    for (int i = 0; i < 2; ++i) { int R, C; stage_rc(tid * 16 + i * 8192, R, C); const int Rb = Epi::PERM ? ((R & ~31) + perm32(R & 31)) : R;
        voffA[i] = (unsigned)(R * g.lda + C) * 2u; voffB[i] = (unsigned)(Rb * K + C) * 2u; }
    const size_t kstep = (size_t)(BK * 2);
    const size_t hstepA = (size_t)HALF * g.lda * 2, hstepB = (size_t)HALF * K * 2;
    const unsigned ldsw = (unsigned)wid * 1024u;
    const int aoff = lds_byte(wr * 64 + fr, fq * 8), boff = lds_byte(wc * 32 + fr, fq * 8);
#define PG8_SA(b, h) (((b) * 2 + (h)) * HTB)
#define PG8_SB(b, h) ((4 + (b) * 2 + (h)) * HTB)
#define PG8_STAGE(bufoff, gbase, voff) do { _Pragma("unroll") for (int _i = 0; _i < 2; ++_i) \
        __builtin_amdgcn_global_load_lds((const unsigned*)((const char*)(gbase) + (voff)[_i]), (PG8_LAS unsigned*)(lds + (bufoff) + ldsw + _i * 8192), 16, 0, 0); } while (0)
#define PG8_LDA(dst, b, h) do { _Pragma("unroll") for (int m = 0; m < 4; ++m) _Pragma("unroll") for (int k = 0; k < 2; ++k) dst[m][k] = *(const PG8_LAS bf16x8*)(lds + PG8_SA(b, h) + aoff + m * 2048 + k * 1024); } while (0)
#define PG8_LDB(dst, b, h) do { _Pragma("unroll") for (int n = 0; n < 2; ++n) _Pragma("unroll") for (int k = 0; k < 2; ++k) dst[n][k] = *(const PG8_LAS bf16x8*)(lds + PG8_SB(b, h) + boff + n * 2048 + k * 1024); } while (0)
#define PG8_MMA(ai, bj, At, Bt) do { __builtin_amdgcn_s_setprio(1); _Pragma("unroll") for (int m = 0; m < 4; ++m) _Pragma("unroll") for (int n = 0; n < 2; ++n) _Pragma("unroll") for (int k = 0; k < 2; ++k) \
        acc[ai][bj][m][n] = __builtin_amdgcn_mfma_f32_16x16x32_bf16(Bt[n][k], At[m][k], acc[ai][bj][m][n], 0, 0, 0); __builtin_amdgcn_s_setprio(0); } while (0)
#define PG8_WAIT_V(n) asm volatile("s_waitcnt vmcnt(" #n ")" ::: "memory")
#define PG8_WAIT_L(n) asm volatile("s_waitcnt lgkmcnt(" #n ")" ::: "memory")
#define PG8_BAR __builtin_amdgcn_s_barrier()
#define PG8_SCHED __builtin_amdgcn_sched_barrier(0)
    Unit cur, nxt; int ui = 0;
    if (!S.next(0, cur)) return;
    f32x4 acc[2][2][4][2];
#pragma unroll
    for (int a = 0; a < 2; ++a)
#pragma unroll
        for (int b = 0; b < 2; ++b)
#pragma unroll
            for (int m = 0; m < 4; ++m)
#pragma unroll
                for (int n = 0; n < 2; ++n) acc[a][b][m][n] = (f32x4){0.f, 0.f, 0.f, 0.f};
    bf16x8 At[4][2], B0[2][2], B1[2][2];
    const char* cA = cur.a; const char* cB = cur.b;
    S.a_ready(cur);
    if constexpr (SP2) {
        PG8_STAGE(PG8_SB(0, 0), cB, voffB); PG8_STAGE(PG8_SB(0, 1), cB + hstepB, voffB); PG8_STAGE(PG8_SA(0, 0), cA, voffA); PG8_STAGE(PG8_SA(0, 1), cA + hstepA, voffA);
        if (wr == 1) PG8_BAR;
        PG8_WAIT_V(2); PG8_BAR;
        PG8_STAGE(PG8_SB(1, 0), cB + kstep, voffB); PG8_STAGE(PG8_SA(1, 0), cA + kstep, voffA); PG8_STAGE(PG8_SB(1, 1), cB + hstepB + kstep, voffB);
        PG8_WAIT_V(6); PG8_BAR;
    } else {
        PG8_STAGE(PG8_SB(0, 0), cB, voffB); PG8_STAGE(PG8_SA(0, 0), cA, voffA); PG8_STAGE(PG8_SB(0, 1), cB + hstepB, voffB); PG8_STAGE(PG8_SA(0, 1), cA + hstepA, voffA);
        if (wr == 1) PG8_BAR;
        PG8_WAIT_V(4); PG8_BAR;
        PG8_STAGE(PG8_SB(1, 0), cB + kstep, voffB); PG8_STAGE(PG8_SA(1, 0), cA + kstep, voffA); PG8_STAGE(PG8_SB(1, 1), cB + hstepB + kstep, voffB);
        PG8_WAIT_V(6); PG8_BAR;
    }
    for (;;) {
        const bool has_next = S.next(ui + 1, nxt);
        const char* nA = has_next ? nxt.a : cA; const char* nB = has_next ? nxt.b : cB;
        for (int t = 0; t < nt; t += 2) {
            const bool last = (t == nt - 2);
            const char* a1 = cA + (size_t)(t + 1) * kstep;
            const char* a2 = last ? nA : cA + (size_t)(t + 2) * kstep; const char* b2 = last ? nB : cB + (size_t)(t + 2) * kstep;
            const char* a3 = a2 + kstep; const char* b3 = b2 + kstep;
            if (last && has_next) S.a_ready(nxt);
            if constexpr (SP2) {
            PG8_LDB(B0, 0, 0); PG8_LDB(B1, 0, 1); PG8_SCHED; PG8_LDA(At, 0, 0); PG8_STAGE(PG8_SA(1, 1), a1 + hstepA, voffA);
            PG8_WAIT_V(8); PG8_WAIT_L(0); PG8_BAR; PG8_MMA(0, 0, At, B0); PG8_MMA(0, 1, At, B1); PG8_BAR; PG8_SCHED;
            PG8_LDA(At, 0, 1); PG8_STAGE(PG8_SB(0, 0), b2, voffB); PG8_STAGE(PG8_SB(0, 1), b2 + hstepB, voffB); PG8_STAGE(PG8_SA(0, 0), a2, voffA);
            PG8_WAIT_V(8); PG8_WAIT_L(0); PG8_BAR; PG8_MMA(1, 0, At, B0); PG8_MMA(1, 1, At, B1); PG8_BAR; PG8_SCHED;
            PG8_LDB(B0, 1, 0); PG8_LDB(B1, 1, 1); PG8_SCHED; PG8_LDA(At, 1, 0); PG8_STAGE(PG8_SA(0, 1), a2 + hstepA, voffA);
            PG8_WAIT_V(8); PG8_WAIT_L(0); PG8_BAR; PG8_MMA(0, 0, At, B0); PG8_MMA(0, 1, At, B1); PG8_BAR; PG8_SCHED;
            PG8_LDA(At, 1, 1); PG8_STAGE(PG8_SB(1, 0), b3, voffB); PG8_STAGE(PG8_SB(1, 1), b3 + hstepB, voffB); PG8_STAGE(PG8_SA(1, 0), a3, voffA);
            PG8_WAIT_V(8); PG8_WAIT_L(0); PG8_BAR; PG8_MMA(1, 0, At, B0); PG8_MMA(1, 1, At, B1); PG8_BAR; PG8_SCHED;
            } else {
            PG8_LDB(B0, 0, 0); PG8_SCHED; PG8_LDA(At, 0, 0); PG8_STAGE(PG8_SA(1, 1), a1 + hstepA, voffA);
            PG8_WAIT_L(8); PG8_BAR; PG8_WAIT_L(0); PG8_MMA(0, 0, At, B0); PG8_BAR; PG8_SCHED;
            PG8_LDB(B1, 0, 1); PG8_STAGE(PG8_SB(0, 0), b2, voffB);
            PG8_BAR; PG8_WAIT_L(0); PG8_MMA(0, 1, At, B1); PG8_BAR;
            PG8_LDA(At, 0, 1); PG8_STAGE(PG8_SA(0, 0), a2, voffA);
            PG8_BAR; PG8_WAIT_L(0); PG8_MMA(1, 0, At, B0); PG8_BAR; PG8_SCHED;
            PG8_STAGE(PG8_SB(0, 1), b2 + hstepB, voffB);
            PG8_WAIT_V(6); PG8_BAR; PG8_MMA(1, 1, At, B1); PG8_BAR;
            PG8_LDB(B0, 1, 0); PG8_SCHED; PG8_LDA(At, 1, 0); PG8_STAGE(PG8_SA(0, 1), a2 + hstepA, voffA);
            PG8_WAIT_L(8); PG8_BAR; PG8_WAIT_L(0); PG8_MMA(0, 0, At, B0); PG8_BAR; PG8_SCHED;
            PG8_LDB(B1, 1, 1); PG8_STAGE(PG8_SB(1, 0), b3, voffB);
            PG8_BAR; PG8_WAIT_L(0); PG8_MMA(0, 1, At, B1); PG8_BAR;
            PG8_LDA(At, 1, 1); PG8_STAGE(PG8_SA(1, 0), a3, voffA);
            PG8_BAR; PG8_WAIT_L(0); PG8_MMA(1, 0, At, B0); PG8_BAR; PG8_SCHED;
            PG8_STAGE(PG8_SB(1, 1), b3 + hstepB, voffB);
            PG8_WAIT_V(6); PG8_BAR; PG8_MMA(1, 1, At, B1); PG8_BAR;
            }
        }
        if constexpr (ALIGN_EPI) { if (wr == 0) PG8_BAR; }
        if constexpr (!Epi::AFTER_DRAIN) { E(acc, cur, wr, wc, fr, fq); S.done(cur); }
        if (!has_next) break;
#pragma unroll
        for (int a = 0; a < 2; ++a)
#pragma unroll
            for (int b = 0; b < 2; ++b)
#pragma unroll
                for (int m = 0; m < 4; ++m)
#pragma unroll
                    for (int n = 0; n < 2; ++n) acc[a][b][m][n] = (f32x4){0.f, 0.f, 0.f, 0.f};
        cur = nxt; cA = nA; cB = nB; ++ui;
        if constexpr (ALIGN_EPI) { if (wr == 1) PG8_BAR; }
    }
    PG8_WAIT_V(0);
    if constexpr (!ALIGN_EPI) { if (wr == 0) PG8_BAR; }
    PG8_BAR;
    if constexpr (Epi::AFTER_DRAIN) { E.fused(acc, cur, wr, wc, fr, fq, lds, wid, lane); S.done(cur); }
#undef PG8_SA
#undef PG8_SB
#undef PG8_STAGE
#undef PG8_LDA
#undef PG8_LDB
#undef PG8_MMA
#undef PG8_WAIT_V
#undef PG8_WAIT_L
#undef PG8_BAR
#undef PG8_SCHED
}
}

namespace att {
constexpr int NW = 8, QBLK = 32, KVBLK = 64;
constexpr float THR = 8.f;
#define ATT_SBAR() __builtin_amdgcn_sched_barrier(0)
__device__ __forceinline__ int crow(int r, int hi) { return (r & 3) + 8 * (r >> 2) + 4 * hi; }
template <int D> __device__ __forceinline__ int kswz(int row, int colB) { return D == 128 ? row * 256 + (colB ^ ((row & 7) << 4)) : row * 128 + (colB ^ (((row >> 1) & 7) << 4)); }
template <int DV> __device__ __forceinline__ int v_st(int k, int c) { const int kk = (k & ~0xC) | ((k & 4) << 1) | ((k & 8) >> 1); return ((kk >> 3) * (DV / 32) + (c >> 5)) * 512 + ((kk & 7) * 32 + (c & 31)) * 2; }
__device__ __forceinline__ int v_rd_base(int lane) { return ((lane & 3) << 3) | (((lane >> 2) & 3) << 6) | (((lane >> 4) & 1) << 5) | (((lane >> 5) & 1) << 8); }
template <int DV> constexpr int v_rd_off(int d0, int ks, int half) { return d0 * 512 + ks * (DV / 32) * 1024 + half * (DV / 32) * 512; }
template <int OFF> __device__ __forceinline__ s16x4 tr_read(int vb) { s16x4 r; asm volatile("ds_read_b64_tr_b16 %0, %1 offset:%2" : "=&v"(r) : "v"(vb), "i"(OFF) : "memory"); return r; }

__device__ __forceinline__ void partialSM(f32x16& p0, f32x16& p1, float& m_reg, float& mn, float& alpha) {
    float pmax = p0[0];
#pragma unroll
    for (int r = 1; r < 16; ++r) pmax = fmaxf(pmax, p0[r]);
#pragma unroll
    for (int r = 0; r < 16; ++r) pmax = fmaxf(pmax, p1[r]);
    { auto rr = __builtin_amdgcn_permlane32_swap(__float_as_uint(pmax), __float_as_uint(pmax), false, false); pmax = fmaxf(__uint_as_float(rr[0]), __uint_as_float(rr[1])); }
    if (__builtin_expect(__all(pmax - m_reg <= THR), 1)) { mn = m_reg; alpha = 1.f; }
    else { mn = fmaxf(m_reg, pmax); alpha = __builtin_amdgcn_exp2f(m_reg - mn); m_reg = mn; }
#pragma unroll
    for (int r = 0; r < 16; ++r) { p0[r] -= mn; p1[r] -= mn; }
#pragma unroll
    for (int r = 0; r < 16; ++r) p0[r] = __builtin_amdgcn_exp2f(p0[r]);
}
__device__ __forceinline__ void finishSM(f32x16& p0, f32x16& p1, float alpha, float& l_reg, bf16x8& pa0, bf16x8& pa1, bf16x8& pa2, bf16x8& pa3) {
#pragma unroll
    for (int r = 0; r < 16; ++r) p1[r] = __builtin_amdgcn_exp2f(p1[r]);
    float ps = 0;
#pragma unroll
    for (int r = 0; r < 16; ++r) ps += p0[r];
#pragma unroll
    for (int r = 0; r < 16; ++r) ps += p1[r];
    { auto rr = __builtin_amdgcn_permlane32_swap(__float_as_uint(ps), __float_as_uint(ps), false, false); ps = __uint_as_float(rr[0]) + __uint_as_float(rr[1]); }
    l_reg = l_reg * alpha + ps;
#define ATT_PK4(P, BASE, OUT) do { unsigned a0 = cvt_pk_bf16(P[BASE + 0], P[BASE + 1]), a1 = cvt_pk_bf16(P[BASE + 2], P[BASE + 3]);   \
    unsigned b0 = cvt_pk_bf16(P[BASE + 4], P[BASE + 5]), b1 = cvt_pk_bf16(P[BASE + 6], P[BASE + 7]);                              \
    auto r0 = __builtin_amdgcn_permlane32_swap(a0, b0, false, false); auto r1 = __builtin_amdgcn_permlane32_swap(a1, b1, false, false); \
    u32x4 w = {r0[0], r1[0], r0[1], r1[1]}; OUT = *reinterpret_cast<bf16x8*>(&w); } while (0)
    ATT_PK4(p0, 0, pa0); ATT_PK4(p0, 8, pa1); ATT_PK4(p1, 0, pa2); ATT_PK4(p1, 8, pa3);
#undef ATT_PK4
}
template <int DQK> __device__ __forceinline__ void qkt(f32x16& p0, f32x16& p1, const char* Ks, const bf16x8* qr, int r32, int hi) {
    p0 = f32x16{}; p1 = f32x16{};
#pragma unroll
    for (int d0 = 0; d0 < DQK / 16; ++d0) { const int cb = (d0 * 16 + hi * 8) * 2;
        const bf16x8 b0 = *reinterpret_cast<const bf16x8*>(Ks + kswz<DQK>(r32, cb));
        const bf16x8 b1 = *reinterpret_cast<const bf16x8*>(Ks + kswz<DQK>(32 + r32, cb));
        p0 = __builtin_amdgcn_mfma_f32_32x32x16_bf16(b0, qr[d0], p0, 0, 0, 0);
        p1 = __builtin_amdgcn_mfma_f32_32x32x16_bf16(b1, qr[d0], p1, 0, 0, 0); }
}
template <int DV, int D0> __device__ __forceinline__ void pv_one(f32x16& od, int vb, bf16x8 pa0, bf16x8 pa1, bf16x8 pa2, bf16x8 pa3) {
    const s16x4 l0 = tr_read<v_rd_off<DV>(D0, 0, 0)>(vb), h0 = tr_read<v_rd_off<DV>(D0, 0, 1)>(vb), l1 = tr_read<v_rd_off<DV>(D0, 1, 0)>(vb), h1 = tr_read<v_rd_off<DV>(D0, 1, 1)>(vb);
    const s16x4 l2 = tr_read<v_rd_off<DV>(D0, 2, 0)>(vb), h2 = tr_read<v_rd_off<DV>(D0, 2, 1)>(vb), l3 = tr_read<v_rd_off<DV>(D0, 3, 0)>(vb), h3 = tr_read<v_rd_off<DV>(D0, 3, 1)>(vb);
    asm volatile("s_waitcnt lgkmcnt(0)" ::: "memory"); ATT_SBAR();
#define ATT_PK(L, H) (bf16x8){L[0], L[1], L[2], L[3], H[0], H[1], H[2], H[3]}
    od = __builtin_amdgcn_mfma_f32_32x32x16_bf16(pa0, ATT_PK(l0, h0), od, 0, 0, 0);
    od = __builtin_amdgcn_mfma_f32_32x32x16_bf16(pa1, ATT_PK(l1, h1), od, 0, 0, 0);
    od = __builtin_amdgcn_mfma_f32_32x32x16_bf16(pa2, ATT_PK(l2, h2), od, 0, 0, 0);
    od = __builtin_amdgcn_mfma_f32_32x32x16_bf16(pa3, ATT_PK(l3, h3), od, 0, 0, 0);
#undef ATT_PK
}
template <int DV> __device__ __forceinline__ void pv_all(f32x16 (&o)[DV / 32], int vb, bf16x8 pa0, bf16x8 pa1, bf16x8 pa2, bf16x8 pa3) {
    pv_one<DV, 0>(o[0], vb, pa0, pa1, pa2, pa3); pv_one<DV, 1>(o[1], vb, pa0, pa1, pa2, pa3);
    if constexpr (DV == 128) { pv_one<DV, 2>(o[2], vb, pa0, pa1, pa2, pa3); pv_one<DV, 3>(o[3], vb, pa0, pa1, pa2, pa3); }
}
template <int DQK, int DV> struct Lay { static constexpr int SHM_V = 64 * DV * 2, SHM_K = 64 * DQK * 2, OFF_V = 0, OFF_K = 2 * SHM_V, OFF_WS = OFF_K + 2 * SHM_K, OFF_STASH = OFF_WS + NW * 64 * 4; };

template <int DQK, int DV, int LDQ, int LDK, int LDV>
__device__ __forceinline__ void attn_pass(const bf16_t* __restrict__ Qb, const bf16_t* __restrict__ Kh, const bf16_t* __restrict__ Vh, int nkeys, char* lds, f32x16 (&o)[DV / 32], float (&rli)[16]) {
    using L = Lay<DQK, DV>;
    constexpr int NLK = DQK / 64, NLV = DV / 64;
    int tid_ = threadIdx.x; asm volatile("" : "+v"(tid_));
    const int tid = tid_, wid = tid >> 6, lane = tid & 63, r32 = lane & 31, hi = lane >> 5;
    char* V_lds = lds + L::OFF_V; char* K_lds = lds + L::OFF_K;
    float* ws = (float*)(lds + L::OFF_WS) + wid * 64; float* li_l = ws; float* al_l = ws + 32;
    float m_reg = -1e30f, l_reg = 0.f; bf16x8 qr[DQK / 16];
#pragma unroll
    for (int d = 0; d < DV / 32; ++d) o[d] = f32x16{};
    const bf16_t* Qw = Qb + (size_t)(wid * QBLK + r32) * LDQ + hi * 8;
#pragma unroll
    for (int d0 = 0; d0 < DQK / 16; ++d0) qr[d0] = *reinterpret_cast<const bf16x8*>(Qw + d0 * 16);
    const int krow = DQK == 128 ? (tid >> 4) : (tid >> 3), kcol = DQK == 128 ? (tid & 15) * 8 : (tid & 7) * 8;
    const int vrow = DV == 128 ? (tid >> 4) : (tid >> 3), vcol = DV == 128 ? (tid & 15) * 8 : (tid & 7) * 8;
    const int vb0 = (int)(uintptr_t)V_lds + v_rd_base(lane);
    bf16x8 vsE[NLV], ksE[NLK], vsO[NLV], ksO[NLK];
#define ATT_SLOAD(VS, KS, k0) do { _Pragma("unroll") for (int i_ = 0; i_ < NLV; ++i_) VS[i_] = *reinterpret_cast<const bf16x8*>(&Vh[(size_t)((k0) + vrow + 32 * i_) * LDV + vcol]); \
    _Pragma("unroll") for (int i_ = 0; i_ < NLK; ++i_) KS[i_] = *reinterpret_cast<const bf16x8*>(&Kh[(size_t)((k0) + krow + 32 * i_) * LDK + kcol]); } while (0)
#define ATT_SWRITE(b, VS, KS) do { _Pragma("unroll") for (int i_ = 0; i_ < NLV; ++i_) *(bf16x8*)(V_lds + (b) * L::SHM_V + v_st<DV>(vrow + 32 * i_, vcol)) = VS[i_]; \
    _Pragma("unroll") for (int i_ = 0; i_ < NLK; ++i_) *(bf16x8*)(K_lds + (b) * L::SHM_K + kswz<DQK>(krow + 32 * i_, kcol * 2)) = KS[i_]; } while (0)
#define ATT_SWAIT() do { if constexpr (NLK + NLV == 4) asm volatile("s_waitcnt vmcnt(4)" ::: "memory"); else if constexpr (NLK + NLV == 3) asm volatile("s_waitcnt vmcnt(3)" ::: "memory"); else asm volatile("s_waitcnt vmcnt(2)" ::: "memory"); } while (0)
#define ATT_RESC(a) do { if (__any((a) < 1.f)) { if (hi == 0) al_l[r32] = (a); asm volatile("s_waitcnt lgkmcnt(0)" ::: "memory"); \
    _Pragma("unroll") for (int d = 0; d < DV / 32; ++d) _Pragma("unroll") for (int r = 0; r < 16; ++r) o[d][r] *= al_l[crow(r, hi)]; } } while (0)
    f32x16 pA0, pA1, pB0, pB1; float mnA, mnB, alA, alB; bf16x8 pa0, pa1, pa2, pa3; const int NT = nkeys / KVBLK;
    __syncthreads();
    ATT_SLOAD(vsE, ksE, 0); asm volatile("s_waitcnt vmcnt(0)" ::: "memory"); ATT_SWRITE(0, vsE, ksE); __syncthreads();
    qkt<DQK>(pA0, pA1, K_lds, qr, r32, hi); partialSM(pA0, pA1, m_reg, mnA, alA);
    ATT_SLOAD(vsO, ksO, KVBLK); if (2 < NT) ATT_SLOAD(vsE, ksE, 2 * KVBLK);
    ATT_SWAIT(); ATT_SWRITE(1, vsO, ksO); __syncthreads();
    for (int j = 1; j + 1 < NT; j += 2) {
        ATT_SBAR(); qkt<DQK>(pB0, pB1, K_lds + L::SHM_K, qr, r32, hi);
        finishSM(pA0, pA1, alA, l_reg, pa0, pa1, pa2, pa3); ATT_SBAR();
        ATT_SLOAD(vsO, ksO, (j + 2) * KVBLK); ATT_SBAR();
        pv_all<DV>(o, vb0, pa0, pa1, pa2, pa3); partialSM(pB0, pB1, m_reg, mnB, alB);
        __syncthreads(); ATT_SWAIT(); ATT_SWRITE(0, vsE, ksE);
        ATT_RESC(alB); __syncthreads();
        ATT_SBAR(); qkt<DQK>(pA0, pA1, K_lds, qr, r32, hi);
        finishSM(pB0, pB1, alB, l_reg, pa0, pa1, pa2, pa3); ATT_SBAR();
        if (j + 3 < NT) ATT_SLOAD(vsE, ksE, (j + 3) * KVBLK); ATT_SBAR();
        pv_all<DV>(o, vb0 + L::SHM_V, pa0, pa1, pa2, pa3); partialSM(pA0, pA1, m_reg, mnA, alA);
        __syncthreads(); ATT_SWAIT(); ATT_SWRITE(1, vsO, ksO);
        ATT_RESC(alA); __syncthreads();
    }
    ATT_SBAR(); qkt<DQK>(pB0, pB1, K_lds + L::SHM_K, qr, r32, hi);
    finishSM(pA0, pA1, alA, l_reg, pa0, pa1, pa2, pa3); ATT_SBAR();
    pv_all<DV>(o, vb0, pa0, pa1, pa2, pa3); partialSM(pB0, pB1, m_reg, mnB, alB);
    __syncthreads(); ATT_RESC(alB);
    finishSM(pB0, pB1, alB, l_reg, pa0, pa1, pa2, pa3); ATT_SBAR();
    pv_all<DV>(o, vb0 + L::SHM_V, pa0, pa1, pa2, pa3);
    if (hi == 0) li_l[r32] = l_reg; asm volatile("s_waitcnt lgkmcnt(0)" ::: "memory");
#pragma unroll
    for (int r = 0; r < 16; ++r) rli[r] = __builtin_amdgcn_rcpf(li_l[crow(r, hi)]);
#undef ATT_SLOAD
#undef ATT_SWRITE
#undef ATT_SWAIT
#undef ATT_RESC
}
template <int DV, int LDO> __device__ __forceinline__ void store_o(bf16_t* Ob, const f32x16 (&o)[DV / 32], const float (&rli)[16]) {
    int tid_ = threadIdx.x; asm volatile("" : "+v"(tid_));
    const int tid = tid_, wid = tid >> 6, lane = tid & 63, r32 = lane & 31, hi = lane >> 5;
    bf16_t* Ow = Ob + (size_t)(wid * QBLK) * LDO;
#pragma unroll
    for (int r = 0; r < 16; ++r) { const int orow = crow(r, hi);
#pragma unroll
        for (int d0 = 0; d0 < DV / 32; ++d0) Ow[(size_t)orow * LDO + d0 * 32 + r32] = f2bf(o[d0][r] * rli[r]); }
}
__device__ __forceinline__ void unit_a(const bf16_t* PROJ, bf16_t* OBR, int b, int h, int qb, float lam, float lam_init, const float* subg, char* lds) {
    using L = Lay<64, 128>;
    int tid_ = threadIdx.x; asm volatile("" : "+v"(tid_));
    const int tid = tid_, wid = tid >> 6, lane = tid & 63, r32 = lane & 31, hi = lane >> 5;
    const bf16_t* kv = PROJ + (size_t)b * SEQ * D_IN; const size_t qrow = (size_t)b * SEQ + qb * 256;
    unsigned* stash = (unsigned*)(lds + L::OFF_STASH) + wid * 2048 + lane;
    f32x16 o[4]; float rli[16];
#pragma unroll 1
    for (int c = 0; c < 2; ++c) {
        attn_pass<64, 128, D_IN, D_IN, D_IN>(PROJ + qrow * D_IN + C_AQ + h * 128 + c * 64, kv + C_AK + h * 128 + c * 64, kv + C_AV + h * 128, SEQ, lds, o, rli);
        if (c == 0) {
#pragma unroll
            for (int d0 = 0; d0 < 4; ++d0)
#pragma unroll
                for (int r = 0; r < 16; r += 2) stash[(d0 * 8 + (r >> 1)) * 64] = cvt_pk_bf16(o[d0][r] * rli[r], o[d0][r + 1] * rli[r + 1]);
        }
    }
    asm volatile("s_waitcnt lgkmcnt(0)" ::: "memory");
    float ss[16];
#pragma unroll
    for (int r = 0; r < 16; ++r) ss[r] = 0.f;
#pragma unroll
    for (int d0 = 0; d0 < 4; ++d0)
#pragma unroll
        for (int r = 0; r < 16; r += 2) { const unsigned w = stash[(d0 * 8 + (r >> 1)) * 64];
            const float c0 = __uint_as_float(w << 16) - lam * o[d0][r] * rli[r], c1 = __uint_as_float(w & 0xffff0000u) - lam * o[d0][r + 1] * rli[r + 1];
            o[d0][r] = c0; o[d0][r + 1] = c1; ss[r] += c0 * c0; ss[r + 1] += c1 * c1; }
#pragma unroll
    for (int r = 0; r < 16; ++r) { float s = ss[r]; s += __shfl_xor(s, 1); s += __shfl_xor(s, 2); s += __shfl_xor(s, 4); s += __shfl_xor(s, 8); s += __shfl_xor(s, 16);
        ss[r] = rsqrtf(s * (1.f / 128.f) + EPS) * (1.f - lam_init); }
    bf16_t* Ow = OBR + (qrow + wid * QBLK) * OBR_W + h * 128;
#pragma unroll
    for (int d0 = 0; d0 < 4; ++d0) { const float g = subg[d0 * 32 + r32];
#pragma unroll
        for (int r = 0; r < 16; ++r) Ow[(size_t)crow(r, hi) * OBR_W + d0 * 32 + r32] = f2bf(o[d0][r] * ss[r] * g); }
}
__device__ __forceinline__ void unit_b(const bf16_t* PROJ, bf16_t* OBR, int b, int qh, int qb, char* lds) {
    const bf16_t* kv = PROJ + (size_t)b * SEQ * D_IN; const size_t qrow = (size_t)b * SEQ + qb * 256;
    f32x16 o[2]; float rli[16];
    attn_pass<64, 64, D_IN, D_IN, D_IN>(PROJ + qrow * D_IN + C_BQ + qh * 64, kv + C_BK + (qh >> 2) * 64, kv + C_BV + (qh >> 2) * 64, SEQ, lds, o, rli);
    store_o<64, OBR_W>(OBR + qrow * OBR_W + 512 + qh * 64, o, rli);
}
__device__ __forceinline__ void unit_c(const bf16_t* PROJ, const bf16_t* MEMKV, bf16_t* OBR, int b, int h, int qb, char* lds) {
    const bf16_t* kv = MEMKV + (size_t)b * MEM_LEN * 1024; const size_t qrow = (size_t)b * SEQ + qb * 256;
    f32x16 o[4]; float rli[16];
    attn_pass<128, 128, D_IN, 1024, 1024>(PROJ + qrow * D_IN + C_CQ + h * 128, kv + h * 128, kv + 512 + h * 128, MEM_LEN, lds, o, rli);
    store_o<128, OBR_W>(OBR + qrow * OBR_W + 1024 + h * 128, o, rli);
}
#undef ATT_SBAR
}

__device__ __forceinline__ void row_rmsnorm(const float* __restrict__ xrow, const float* __restrict__ g, bf16_t* __restrict__ orow, float* __restrict__ xcopy, int lane) {
    const f32x4* xr = (const f32x4*)xrow; f32x4 v[4]; float s = 0.f;
#pragma unroll
    for (int j = 0; j < 4; ++j) { v[j] = xr[lane + 64 * j]; s += v[j].x * v[j].x + v[j].y * v[j].y + v[j].z * v[j].z + v[j].w * v[j].w; }
    const float rs = rsqrtf(wave_sum(s) * (1.f / DM) + EPS);
#pragma unroll
    for (int j = 0; j < 4; ++j) { const f32x4 gg = ((const f32x4*)g)[lane + 64 * j];
        if (xcopy) ((f32x4*)xcopy)[lane + 64 * j] = v[j];
        u32x2 o; o.x = cvt_pk_bf16(v[j].x * rs * gg.x, v[j].y * rs * gg.y); o.y = cvt_pk_bf16(v[j].z * rs * gg.z, v[j].w * rs * gg.w);
        ((u32x2*)orow)[lane + 64 * j] = o; }
}
__device__ __forceinline__ void row_norm_route(const float* __restrict__ X, const float* __restrict__ g, bf16_t* __restrict__ H2, const float* __restrict__ wrg, const float* __restrict__ brg,
                                               const float* __restrict__ wre, const float* __restrict__ bre, int* __restrict__ experts, float* __restrict__ weights, int* __restrict__ rank, unsigned* __restrict__ cnt, int row, int lane) {
    const f32x4* xr = (const f32x4*)(X + (size_t)row * DM);
    float s = 0.f;
#pragma unroll
    for (int j = 0; j < 4; ++j) { const f32x4 v = xr[lane + 64 * j]; s += v.x * v.x + v.y * v.y + v.z * v.z + v.w * v.w; }
    const float rs = rsqrtf(wave_sum(s) * (1.f / DM) + EPS);
    float acc[36];
#pragma unroll
    for (int e = 0; e < 36; ++e) acc[e] = 0.f;
#pragma unroll 1
    for (int j = 0; j < 4; ++j) { const int c4 = lane + 64 * j; const f32x4 gg = ((const f32x4*)g)[c4], v = xr[c4];
        float h[4] = {v.x * rs * gg.x, v.y * rs * gg.y, v.z * rs * gg.z, v.w * rs * gg.w};
        u32x2 o; o.x = cvt_pk_bf16(h[0], h[1]); o.y = cvt_pk_bf16(h[2], h[3]);
        ((u32x2*)(H2 + (size_t)row * DM))[c4] = o;
        const float* wgp = wrg + (size_t)c4 * 16; const float* wep = wre + (size_t)c4 * 128;
#pragma unroll
        for (int i = 0; i < 4; ++i) {
            const f32x4 wg = *(const f32x4*)(wgp + i * 4);
            acc[0] += h[i] * wg.x; acc[1] += h[i] * wg.y; acc[2] += h[i] * wg.z; acc[3] += h[i] * wg.w;
#pragma unroll
            for (int e4 = 0; e4 < 8; ++e4) { const f32x4 we = *(const f32x4*)(wep + i * 32 + e4 * 4);
                acc[4 + e4 * 4 + 0] += h[i] * we.x; acc[4 + e4 * 4 + 1] += h[i] * we.y; acc[4 + e4 * 4 + 2] += h[i] * we.z; acc[4 + e4 * 4 + 3] += h[i] * we.w; }
        }
    }
#pragma unroll
    for (int e = 0; e < 36; ++e) acc[e] = wave_sum(acc[e]);
    if (lane == 0) {
        int gi = 0; float gm = acc[0] + brg[0];
#pragma unroll
        for (int i = 1; i < 4; ++i) { const float l = acc[i] + brg[i]; if (l > gm) { gm = l; gi = i; } }
        float gs = 0.f;
#pragma unroll
        for (int i = 0; i < 4; ++i) gs += __expf(acc[i] + brg[i] - gm);
        const float gp = 1.f / gs;
        float el[8];
#pragma unroll
        for (int i = 0; i < 8; ++i) el[i] = 0.f;
#pragma unroll
        for (int gq = 0; gq < 4; ++gq) if (gq == gi) {
#pragma unroll
            for (int i = 0; i < 8; ++i) el[i] = acc[4 + gq * 8 + i] + bre[gq * 8 + i]; }
        int i0 = 0; float l0 = el[0];
#pragma unroll
        for (int i = 1; i < 8; ++i) if (el[i] > l0) { l0 = el[i]; i0 = i; }
        int i1 = -1; float l1 = -INFINITY;
#pragma unroll
        for (int i = 0; i < 8; ++i) if (i != i0 && el[i] > l1) { l1 = el[i]; i1 = i; }
        const float p1 = __expf(l1 - l0), inv = 1.f / (1.f + p1);
        const int e0 = gi * 8 + i0, e1 = gi * 8 + i1;
        experts[row * 2] = e0; experts[row * 2 + 1] = e1;
        weights[row * 2] = gp * inv; weights[row * 2 + 1] = gp * p1 * inv;
        rank[row * 2] = (int)atomicAdd(cnt + e0, 1u); rank[row * 2 + 1] = (int)atomicAdd(cnt + e1, 1u);
    }
}
__device__ __forceinline__ void row_combine_norm(float* __restrict__ X, const bf16_t* __restrict__ YB, const int* __restrict__ dest, const float* __restrict__ g, bf16_t* __restrict__ H, float* __restrict__ OUT, int row, int lane, bool poison) {
    const int d0 = dest[row * 2], d1 = dest[row * 2 + 1];
    f32x4* xr = (f32x4*)(X + (size_t)row * DM);
    f32x4 v[4]; float s = 0.f;
#pragma unroll
    for (int j = 0; j < 4; ++j) { v[j] = xr[lane + 64 * j];
        const u32x2 a = ((const u32x2*)(YB + (size_t)d0 * DM))[lane + 64 * j], b = ((const u32x2*)(YB + (size_t)d1 * DM))[lane + 64 * j];
        v[j].x += __uint_as_float(a.x << 16) + __uint_as_float(b.x << 16); v[j].y += __uint_as_float(a.x & 0xffff0000u) + __uint_as_float(b.x & 0xffff0000u);
        v[j].z += __uint_as_float(a.y << 16) + __uint_as_float(b.y << 16); v[j].w += __uint_as_float(a.y & 0xffff0000u) + __uint_as_float(b.y & 0xffff0000u);
        s += v[j].x * v[j].x + v[j].y * v[j].y + v[j].z * v[j].z + v[j].w * v[j].w; }
    float rs = rsqrtf(wave_sum(s) * (1.f / DM) + EPS);
    if (poison) rs = __builtin_nanf("");
#pragma unroll
    for (int j = 0; j < 4; ++j) { const f32x4 gg = ((const f32x4*)g)[lane + 64 * j];
        if (H) { xr[lane + 64 * j] = v[j];
            u32x2 o; o.x = cvt_pk_bf16(v[j].x * rs * gg.x, v[j].y * rs * gg.y); o.y = cvt_pk_bf16(v[j].z * rs * gg.z, v[j].w * rs * gg.w);
            ((u32x2*)(H + (size_t)row * DM))[lane + 64 * j] = o; }
        else { f32x4 o; o.x = v[j].x * rs * gg.x; o.y = v[j].y * rs * gg.y; o.z = v[j].z * rs * gg.z; o.w = v[j].w * rs * gg.w; ((f32x4*)(OUT + (size_t)row * DM))[lane + 64 * j] = o; }
    }
}
__device__ __forceinline__ void p0_transpose_item(const float* __restrict__ W, int ldw, int src_col0, int k0, int K, bf16_t* __restrict__ WT, int dst_row0, LAS float* scr, int lane) {
#pragma unroll 8
    for (int i = 0; i < 32; ++i) { const int kk = 2 * i + (lane >> 5); scr[kk * 33 + (lane & 31)] = W[(size_t)(k0 + kk) * ldw + src_col0 + (lane & 31)]; }
    asm volatile("s_waitcnt lgkmcnt(0)" ::: "memory");
    const int c = lane & 7;
#pragma unroll
    for (int j = 0; j < 4; ++j) { const int n = (lane >> 3) + 8 * j; const LAS float* s = scr + (8 * c) * 33 + n;
        u32x4 o; o.x = cvt_pk_bf16(s[0 * 33], s[1 * 33]); o.y = cvt_pk_bf16(s[2 * 33], s[3 * 33]); o.z = cvt_pk_bf16(s[4 * 33], s[5 * 33]); o.w = cvt_pk_bf16(s[6 * 33], s[7 * 33]);
        *(u32x4*)(WT + (size_t)(dst_row0 + n) * K + k0 + 8 * c) = o; }
    asm volatile("s_waitcnt lgkmcnt(0)" ::: "memory");
}

#define XB_TMO      128
#define XB_XCNT(j)  (256  + 64 * (j))
#define XB_XSUB(j)  (1280 + 64 * (j))
#define XB_XGEN(j)  (2304 + 64 * (j))
#define XB_TOP      3328
#define XB_TOPGEN   3392
#define XCD_BAR_WORDS 3456
#define XB_SPIN_CAP (1u << 18)

__device__ __forceinline__ unsigned xb_ld(unsigned* p)              { return __hip_atomic_load(p, __ATOMIC_RELAXED, __HIP_MEMORY_SCOPE_AGENT); }
__device__ __forceinline__ unsigned xb_add(unsigned* p, unsigned v) { return __hip_atomic_fetch_add(p, v, __ATOMIC_RELAXED, __HIP_MEMORY_SCOPE_AGENT); }
__device__ __forceinline__ unsigned xb_xcc_id() { return (unsigned)__builtin_amdgcn_s_getreg((3 << 11) | 20) & 0xFu; }
#define XB_SPIN(cond, bar) do { unsigned _sp = 0; while (cond) { __builtin_amdgcn_s_sleep(1); \
    if ((++_sp & 255u) == 0u) { if (xb_ld(&(bar)[XB_TMO])) break; if (_sp > XB_SPIN_CAP) { atomicAdd(&(bar)[XB_TMO], 1u); break; } } } } while (0)

struct XcdBarrier {
    unsigned* bar; unsigned x;
    volatile LAS unsigned* st;
};

__device__ __forceinline__ XcdBarrier xcd_barrier_post(unsigned* bar, volatile LAS unsigned* st) {
    XcdBarrier b; b.bar = bar; b.x = xb_xcc_id(); b.st = st;
    if (threadIdx.x == 0) (void)xb_add(&bar[XB_XCNT(b.x)], 1u);
    return b;
}
__device__ __forceinline__ void xcd_barrier_complete(unsigned* bar, unsigned x, unsigned& nloc, unsigned& nx) {
    const unsigned G = gridDim.x * gridDim.y * gridDim.z;
    unsigned sum, cnt, mine, sp = 0u;
    for (;;) {
        sum = 0u; cnt = 0u; mine = 0u;
#pragma unroll
        for (unsigned j = 0; j < 16; ++j) { const unsigned c = xb_ld(&bar[XB_XCNT(j)]); sum += c; cnt += (c > 0u) ? 1u : 0u; mine = (j == x) ? c : mine; }
        if (sum == G) break;
        __builtin_amdgcn_s_sleep(1);
        if ((++sp & 255u) == 0u) { if (xb_ld(&bar[XB_TMO])) break; if (sp > XB_SPIN_CAP) { atomicAdd(&bar[XB_TMO], 1u); break; } }
    }
    nloc = mine > 0u ? mine : 1u; nx = cnt > 0u ? cnt : 1u;
}

__device__ __forceinline__ void xcd_barrier(const XcdBarrier& b) {
    asm volatile("s_waitcnt vmcnt(0)" ::: "memory");
    __syncthreads();
    if (threadIdx.x == 0) {
        unsigned* bar = b.bar;
        __builtin_amdgcn_s_waitcnt(0);
        unsigned nloc = b.st[0], nx = b.st[1];
        if (nloc == 0u) { xcd_barrier_complete(bar, b.x, nloc, nx); b.st[0] = nloc; b.st[1] = nx; }
        const unsigned old = xb_add(&bar[XB_XSUB(b.x)], 1u);
        const unsigned gen = old / nloc;
        if (old + 1u == (gen + 1u) * nloc) {
            __builtin_amdgcn_fence(__ATOMIC_RELEASE, "agent");
            asm volatile("s_waitcnt vmcnt(0)" ::: "memory");
            const unsigned og = xb_add(&bar[XB_TOP], 1u);
            const unsigned tg = og / nx;
            if (og + 1u == (tg + 1u) * nx) xb_add(&bar[XB_TOPGEN], 1u);
            else XB_SPIN(xb_ld(&bar[XB_TOPGEN]) == tg, bar);
            __builtin_amdgcn_fence(__ATOMIC_ACQUIRE, "agent");
            xb_add(&bar[XB_XGEN(b.x)], 1u);
            asm volatile("s_waitcnt vmcnt(0)" ::: "memory");
        } else {
            XB_SPIN(xb_ld(&bar[XB_XGEN(b.x)]) == gen, bar);
            __builtin_amdgcn_fence(__ATOMIC_ACQUIRE, "agent");
            asm volatile("s_waitcnt vmcnt(0)" ::: "memory");
        }
    }
    __syncthreads();
}
constexpr int NWAVES = 8;
constexpr int RING_BYTES = 131072, LDSCTL_OFF = RING_BYTES, LDS_BYTES = 147456;
constexpr int CW_BAR = 4096, BAR_REGION = 4096;
static_assert(XCD_BAR_WORDS <= BAR_REGION && (CW_BAR + (N_PHASES + 1) * BAR_REGION) * 4 <= (int)MiB, "barrier regions inside the memset region");
static_assert(pg8::STAGE_BYTES <= RING_BYTES && att::Lay<64, 128>::OFF_STASH + 65536 <= RING_BYTES && att::Lay<128, 128>::OFF_WS + 2048 <= RING_BYTES, "LDS map");

struct Args { const float* in[26]; float* out; unsigned char* ws; int ph_lo, ph_hi, li, pad; };

__global__ void __launch_bounds__(NWAVES * 64, 2) mk_fwd(Args args) {
    extern __shared__ __attribute__((aligned(16))) unsigned char lds[];
    const int tid0 = threadIdx.x, lane0 = tid0 & 63, wave = __builtin_amdgcn_readfirstlane(tid0 >> 6);
    const int G = gridDim.x, bx = blockIdx.x, vcu = (G % 8 == 0) ? (bx % 8) * (G / 8) + bx / 8 : bx;
    LAS unsigned char* ldsl = (LAS unsigned char*)lds;
    volatile LAS unsigned* MISC = (volatile LAS unsigned*)(ldsl + LDSCTL_OFF);
    for (int u = tid0; u < (LDS_BYTES - LDSCTL_OFF) / 4; u += NWAVES * 64) ((LAS unsigned*)(ldsl + LDSCTL_OFF))[u] = 0u;
    __syncthreads();
    unsigned char* ws = args.ws;
    unsigned* ctl = (unsigned*)(ws + WS_CTL);
    XcdBarrier bar = xcd_barrier_post(ctl + CW_BAR + args.li * BAR_REGION, MISC + 8);
    const float* x = args.in[0]; const float* mem = args.in[1]; const float* mem_g = args.in[2]; const float* w_memkv = args.in[3];
    const float* norm1_g = args.in[4]; const float* w_in = args.in[5];
    const float* lq1 = args.in[6]; const float* lk1 = args.in[7]; const float* lq2 = args.in[8]; const float* lk2 = args.in[9];
    const float* subln_g = args.in[10]; const float* qn_g = args.in[11]; const float* kn_g = args.in[12];
    const float* w_out = args.in[16];
    const float* norm2_g = args.in[17]; const float* w_rg = args.in[18]; const float* b_rg = args.in[19]; const float* w_re = args.in[20]; const float* b_re = args.in[21];
    const float* w_eg = args.in[22]; const float* w_eu = args.in[23]; const float* w_ed = args.in[24]; const float* final_g = args.in[25];
    float* X = args.out;
    bf16_t* MEMKV = (bf16_t*)(ws + WS_MEMKV); bf16_t* HM = (bf16_t*)(ws + WS_HM); bf16_t* PROJ = (bf16_t*)(ws + WS_PROJ); bf16_t* OBR = (bf16_t*)(ws + WS_OBR);
    bf16_t* BUF = (bf16_t*)(ws + WS_BUF); bf16_t* YB = (bf16_t*)(ws + WS_YB); bf16_t* HID = (bf16_t*)(ws + WS_HID); bf16_t* HMEM = OBR;
    bf16_t* WB = (bf16_t*)(ws + WS_WB);
    float* tab1 = (float*)(ws + WS_TAB); float* tab2 = tab1 + SEQ * 32 * 2;
    int* experts = (int*)(ws + WS_ROUTE + RT_EXP); float* weights = (float*)(ws + WS_ROUTE + RT_WGT); int* rank = (int*)(ws + WS_ROUTE + RT_RANK); int* dest = (int*)(ws + WS_ROUTE + RT_DEST);
    float* roww = (float*)(ws + WS_ROUTE + RT_ROWW); int* tile_tab = (int*)(ws + WS_ROUTE + RT_TILE);
    const int gw = bx * NWAVES + wave, NGW = G * NWAVES;
    const int lo = args.ph_lo, hi = args.ph_hi;
#ifndef STAGE_MASK
#define STAGE_MASK 0x3FFu
#endif
#define IN(k) (lo <= (k) && (k) < hi)
#define ST(s) ((STAGE_MASK >> (s)) & 1u)
#define SEAM(k) do { if (IN(k) && IN((k) + 1)) xcd_barrier(bar); } while (0)

    if (ST(0) && IN(0)) {
        int lane = lane0, tid = tid0; asm volatile("" : "+v"(lane), "+v"(tid));
        LAS float* scr = (LAS float*)(ldsl + wave * 16384);
        for (int it = gw; it < 58112; it += NGW) {
            const float* src; int ldw, K, src_col0, dst_row0, kb; bf16_t* dst;
            if (it < 57600) {
                const int l = it / 28800; int r = it % 28800; bf16_t* WBl = WB + (size_t)l * WB_LAYER;
                if (r < 2944) { kb = r / 184; const int tb = r % 184, pn = tb >> 3, bj = (tb >> 2) & 1, wc = tb & 3; src = w_in + (size_t)l * DM * D_IN; ldw = D_IN; K = DM; src_col0 = 256 * pn + 64 * wc + 32 * bj; dst_row0 = 32 * tb; dst = WBl + WB_IN; }
                else if (r < 3712) { r -= 2944; const int i = r >> 8; r &= 255; kb = r >> 5; const int tb = r & 31; src = args.in[13 + i] + (size_t)l * 512 * DM; ldw = DM; K = 512; src_col0 = 32 * tb; dst_row0 = 32 * tb; dst = WBl + WB_UP + (size_t)i * 1024 * 512; }
                else if (r < 4224) { r -= 3712; kb = r >> 5; const int tb = r & 31; src = w_out + (size_t)l * DM * DM; ldw = DM; K = DM; src_col0 = 32 * tb; dst_row0 = 32 * tb; dst = WBl + WB_OUT; }
                else if (r < 20608) { r -= 4224; const int e = r >> 9; r &= 511; kb = r >> 5; const int tb = r & 31, pn = tb >> 3, s = (tb >> 2) & 1, jb = tb & 3;
                    src = (s ? w_eu : w_eg) + (size_t)(l * NEXP + e) * DM * DEXP; ldw = DEXP; K = DM; src_col0 = 128 * pn + 32 * jb; dst_row0 = 32 * tb; dst = WBl + WB_GU + (size_t)e * 1024 * 1024; }
                else { r -= 20608; const int e = r >> 8; r &= 255; kb = r >> 5; const int tb = r & 31; src = w_ed + (size_t)(l * NEXP + e) * DEXP * DM; ldw = DM; K = DEXP; src_col0 = 32 * tb; dst_row0 = 32 * tb; dst = WBl + WB_DN + (size_t)e * 1024 * 512; }
            } else { const int r = it - 57600; kb = r >> 5; const int tb = r & 31, pn = tb >> 3, bj = (tb >> 2) & 1, wc = tb & 3; src = w_memkv; ldw = 1024; K = DM; src_col0 = 256 * pn + 64 * wc + 32 * bj; dst_row0 = 32 * tb; dst = WB + WB_MEMKV; }
            p0_transpose_item(src, ldw, src_col0, kb * 64, K, dst, dst_row0, scr, lane);
        }
        for (int idx = bx * (NWAVES * 64) + tid; idx < SEQ * 32; idx += G * NWAVES * 64) { const int pos = idx >> 5, i = idx & 31; float s, c;
            sincosf((float)pos * inv1d(i), &s, &c); tab1[idx * 2] = c; tab1[idx * 2 + 1] = s;
            sincosf(ang2d(pos, i), &s, &c); tab2[idx * 2] = c; tab2[idx * 2 + 1] = s; }
        for (int m = gw; m < M; m += NGW) row_rmsnorm(x + (size_t)m * DM, norm1_g, HM + (size_t)m * DM, X + (size_t)m * DM, lane);
        for (int m = gw; m < MM; m += NGW) row_rmsnorm(mem + (size_t)m * DM, mem_g, HMEM + (size_t)m * DM, nullptr, lane);
    }
    SEAM(0);
#pragma unroll 1
    for (int l = 0; l < DEPTH; ++l) {
        const int pb = 1 + 9 * l;
        const bf16_t* WBl = WB + (size_t)l * WB_LAYER;
        if (ST(1) && IN(pb + 0)) {
            pg8::Gemm g{DM, DM};
            pg8::SchedProj S{bx, G, 1472, l == 0 ? 1504 : 1472, (const char*)HM, (const char*)(WBl + WB_IN), (const char*)HMEM, (const char*)(WB + WB_MEMKV)};
            pg8::EpiProj E{PROJ, MEMKV, tab1, tab2, qn_g + l * 64, kn_g + l * 64};
            pg8::gemm_phase<pg8::EpiProj, pg8::SchedProj, true, true>(ldsl, g, S, E);
        }
        SEAM(pb + 0);
        if (ST(2) && IN(pb + 1)) {
            int lane = lane0; asm volatile("" : "+v"(lane));
            const float lam_init = 0.8f - 0.6f * __expf(-0.3f * (float)l);
            const float lam = __expf(wave_sum(lq1[l * 64 + lane] * lk1[l * 64 + lane])) - __expf(wave_sum(lq2[l * 64 + lane] * lk2[l * 64 + lane])) + lam_init;
            for (int j = vcu; j < 256; j += G) {
#ifndef ATT_SKIP_A
                att::unit_a(PROJ, OBR, j >> 5, (j >> 3) & 3, j & 7, lam, lam_init, subln_g + l * 128, (char*)lds);
#endif
#ifndef ATT_SKIP_B
#pragma unroll 1
                for (int t = 0; t < 2; ++t) { const int idx = 2 * j + t; att::unit_b(PROJ, OBR, idx >> 6, (idx >> 3) & 7, idx & 7, (char*)lds); }
#endif
#ifndef ATT_SKIP_C
                att::unit_c(PROJ, MEMKV, OBR, j >> 5, (j >> 3) & 3, j & 7, (char*)lds);
#endif
            }
            __syncthreads();
        }
        SEAM(pb + 1);
        if (ST(3) && IN(pb + 2)) {
            pg8::Gemm g{OBR_W, 512};
            pg8::SchedGate S{bx, G, (const char*)OBR, (const char*)(WBl + WB_UP)};
            pg8::EpiGate E{HM, PROJ};
            pg8::gemm_phase<pg8::EpiGate, pg8::SchedGate, true, true>(ldsl, g, S, E);
        }
        SEAM(pb + 2);
        if (ST(4) && IN(pb + 3)) {
            pg8::Gemm g{DM, DM};
            pg8::SchedPlain S{bx, G, M / 256, (const char*)HM, (const char*)(WBl + WB_OUT), (size_t)256 * DM * 2, (size_t)256 * DM * 2};
            pg8::EpiResid E{X};
            pg8::gemm_phase<pg8::EpiResid, pg8::SchedPlain, true, true>(ldsl, g, S, E);
        }
        SEAM(pb + 3);
        if (ST(5) && IN(pb + 4)) {
            int lane = lane0; asm volatile("" : "+v"(lane));
            for (int m = gw; m < M; m += NGW)
                row_norm_route(X, norm2_g + l * DM, HM, w_rg + (size_t)l * DM * 4, b_rg + l * 4, w_re + (size_t)l * DM * 32, b_re + l * 32, experts, weights, rank, ctl + CW_CNT + 32 * l, m, lane);
        }
        SEAM(pb + 4);
        if (ST(6) && IN(pb + 5)) {
            int lane = lane0, tid = tid0; asm volatile("" : "+v"(lane), "+v"(tid));
            volatile LAS int* pst = (volatile LAS int*)(MISC + 32);
            if (tid == 0) { int off = 0, nt = 0;
                for (int e = 0; e < NEXP; ++e) { const int c = (int)__hip_atomic_load(ctl + CW_CNT + 32 * l + e, __ATOMIC_RELAXED, __HIP_MEMORY_SCOPE_AGENT), t = (c + MOE_TILE - 1) / MOE_TILE; pst[e] = off;
                    if (bx == 0) { tile_tab[260 + e] = off; for (int i = 0; i < t; ++i) tile_tab[nt + i] = e; }
                    nt += t; off += t * MOE_TILE; }
                if (bx == 0) tile_tab[256] = nt; }
            __syncthreads();
            for (int a = gw; a < 2 * M; a += NGW) { const int tok = a >> 1, e = experts[a], d = pst[e] + rank[a];
                const u32x4* src = (const u32x4*)(HM + (size_t)tok * DM); u32x4* dst = (u32x4*)(BUF + (size_t)d * DM);
                dst[lane] = src[lane]; dst[lane + 64] = src[lane + 64];
                if (lane == 0) { roww[d] = weights[a]; dest[a] = d; } }
        }
        SEAM(pb + 5);
        if (ST(7) && IN(pb + 6)) {
            const int ntiles = __builtin_amdgcn_readfirstlane(tile_tab[256]);
            pg8::Gemm g{DM, DM};
            pg8::SchedMoe S{bx, G, ntiles, tile_tab, (const char*)BUF, (const char*)(WBl + WB_GU), (size_t)256 * DM * 2, (size_t)1024 * 1024 * 2, (size_t)256 * DM * 2};
            pg8::EpiSilu E{HID};
            pg8::gemm_phase<pg8::EpiSilu, pg8::SchedMoe, true, true>(ldsl, g, S, E);
        }
        SEAM(pb + 6);
        if (ST(8) && IN(pb + 7)) {
            const int ntiles = __builtin_amdgcn_readfirstlane(tile_tab[256]);
            pg8::Gemm g{DEXP, DEXP};
            pg8::SchedMoe S{bx, G, ntiles, tile_tab, (const char*)HID, (const char*)(WBl + WB_DN), (size_t)256 * DEXP * 2, (size_t)1024 * 512 * 2, (size_t)256 * DEXP * 2};
            pg8::EpiRowScale E{YB, roww};
            pg8::gemm_phase<pg8::EpiRowScale, pg8::SchedMoe, true, true>(ldsl, g, S, E);
        }
        SEAM(pb + 7);
        if (ST(9) && IN(pb + 8)) {
            int lane = lane0; asm volatile("" : "+v"(lane));
            const bool last = (l == DEPTH - 1);
            const bool poison = last && (__hip_atomic_load(ctl + CW_BAR + args.li * BAR_REGION + XB_TMO, __ATOMIC_RELAXED, __HIP_MEMORY_SCOPE_AGENT) != 0u);
            for (int m = gw; m < M; m += NGW) row_combine_norm(X, YB, dest, last ? final_g : norm1_g + (l + 1) * DM, last ? nullptr : HM, X, m, lane, poison);
        }
        SEAM(pb + 8);
    }
#undef IN
#undef SEAM
}

#ifndef FAST_MASK
#define FAST_MASK 0x7FFFFu
#endif
extern "C" void kernel_launch(void* const* d_in, const int* in_sizes, int n_in, void* d_out, int out_size, void* d_ws, size_t ws_size, hipStream_t stream) {
    if (n_in != 26 || out_size != M * DM || ws_size < WS_END) { fprintf(stderr, "kernel_launch: unexpected shapes n_in %d out %d ws %zu (need %zu)\n", n_in, out_size, ws_size, (size_t)WS_END); return; }
    static int grid = 0;
    if (grid == 0) {
        int dev = 0, cus = 0;
        if (hipGetDevice(&dev) != hipSuccess || hipDeviceGetAttribute(&cus, hipDeviceAttributeMultiprocessorCount, dev) != hipSuccess) { grid = -1; return; }
        if (hipFuncSetAttribute((const void*)mk_fwd, hipFuncAttributeMaxDynamicSharedMemorySize, LDS_BYTES) != hipSuccess) { fprintf(stderr, "kernel_launch: hipFuncSetAttribute failed\n"); grid = -1; return; }
        int per_cu = 0;
        if (hipOccupancyMaxActiveBlocksPerMultiprocessor(&per_cu, (const void*)mk_fwd, NWAVES * 64, LDS_BYTES) != hipSuccess || per_cu < 1) fprintf(stderr, "kernel_launch: occupancy query says %d\n", per_cu);
        (void)hipGetLastError();
        grid = cus;
    }
    if (grid < 0) return;
    const float* x = (const float*)d_in[0]; const float* mem = (const float*)d_in[1]; const float* mem_g = (const float*)d_in[2]; const float* w_memkv = (const float*)d_in[3];
    const float* norm1_g = (const float*)d_in[4]; const float* w_in = (const float*)d_in[5];
    const float* lq1 = (const float*)d_in[6]; const float* lk1 = (const float*)d_in[7]; const float* lq2 = (const float*)d_in[8]; const float* lk2 = (const float*)d_in[9];
    const float* subln_g = (const float*)d_in[10]; const float* qn_g = (const float*)d_in[11]; const float* kn_g = (const float*)d_in[12];
    const float* w_up[3] = {(const float*)d_in[13], (const float*)d_in[14], (const float*)d_in[15]}; const float* w_out = (const float*)d_in[16];
    const float* norm2_g = (const float*)d_in[17]; const float* w_rg = (const float*)d_in[18]; const float* b_rg = (const float*)d_in[19]; const float* w_re = (const float*)d_in[20]; const float* b_re = (const float*)d_in[21];
    const float* w_eg = (const float*)d_in[22]; const float* w_eu = (const float*)d_in[23]; const float* w_ed = (const float*)d_in[24]; const float* final_g = (const float*)d_in[25];
    unsigned char* ws = (unsigned char*)d_ws; float* X = (float*)d_out;
    unsigned* ctl = (unsigned*)(ws + WS_CTL);
    bf16_t* MEMKV = (bf16_t*)(ws + WS_MEMKV); bf16_t* HM = (bf16_t*)(ws + WS_HM); bf16_t* PROJ = (bf16_t*)(ws + WS_PROJ); bf16_t* OBR = (bf16_t*)(ws + WS_OBR);
    bf16_t* BUF = (bf16_t*)(ws + WS_BUF); bf16_t* YB = (bf16_t*)(ws + WS_YB); bf16_t* HID = (bf16_t*)(ws + WS_HID);
    int* experts = (int*)(ws + WS_ROUTE + RT_EXP); float* weights = (float*)(ws + WS_ROUTE + RT_WGT); int* rank = (int*)(ws + WS_ROUTE + RT_RANK); int* dest = (int*)(ws + WS_ROUTE + RT_DEST);
    float* roww = (float*)(ws + WS_ROUTE + RT_ROWW); int* tile_tab = (int*)(ws + WS_ROUTE + RT_TILE);

    (void)hipMemsetAsync(ctl, 0, MiB, stream);
    unsigned mask = FAST_MASK; if (mask) mask |= 1u;
    Args a{};
    for (int i = 0; i < 26; ++i) a.in[i] = (const float*)d_in[i];
    a.out = X; a.ws = ws;
    int li = 0;
    for (int k = 0; k < N_PHASES;) {
        if ((mask >> k) & 1u) {
            int k2 = k; while (k2 < N_PHASES && ((mask >> k2) & 1u)) ++k2;
            a.ph_lo = k; a.ph_hi = k2; a.li = li++; a.pad = 0;
            hipLaunchKernelGGL(mk_fwd, dim3(grid), dim3(NWAVES * 64), LDS_BYTES, stream, a);
            k = k2; continue;
        }
        if (k == 0) {
            (void)hipMemcpyAsync(X, x, (size_t)M * DM * 4, hipMemcpyDeviceToDevice, stream);
            s_rmsnorm<<<MM / 4, 256, 0, stream>>>(mem, mem_g, OBR, MM);
            s_rmsnorm<<<M / 4, 256, 0, stream>>>(X, norm1_g, HM, M);
        } else {
            const int l = (k - 1) / 9, s = (k - 1) % 9; const float lam_init = 0.8f - 0.6f * expf(-0.3f * (float)l);
            switch (s) {
            case 0:
                if (l == 0) { SG p{}; p.A = OBR; p.lda = DM; p.W = w_memkv; p.ldw = 1024; p.K = DM; p.mode = MD_BF16; p.O = MEMKV; p.ldo = 1024; s_gemm<<<dim3(1024 / 64, MM / 64), 256, 0, stream>>>(p); }
                { SG p{}; p.A = HM; p.lda = DM; p.W = w_in + (size_t)l * DM * D_IN; p.ldw = D_IN; p.K = DM; p.mode = MD_PROJ; p.O = PROJ; p.ldo = D_IN; p.qg = qn_g + l * 64; p.kg = kn_g + l * 64;
                  s_gemm<<<dim3(D_IN / 64, M / 64), 256, 0, stream>>>(p); }
                break;
            case 1:
                s_attn_a<<<dim3(M / 4, 4), 256, 0, stream>>>(PROJ, OBR, lq1 + l * 64, lk1 + l * 64, lq2 + l * 64, lk2 + l * 64, subln_g + l * 128, lam_init);
                s_attn_b<<<dim3(M / 4, 8), 256, 0, stream>>>(PROJ, OBR);
                s_attn_c<<<dim3(M / 4, 4), 256, 0, stream>>>(PROJ, MEMKV, OBR);
                break;
            case 2:
                for (int i = 0; i < 3; ++i) { SG p{}; p.A = OBR + 512 * i; p.lda = OBR_W; p.W = w_up[i] + (size_t)l * 512 * DM; p.ldw = DM; p.K = 512; p.mode = MD_GATE; p.O = HM; p.ldo = DM; p.G = PROJ + C_G + 1024 * i; p.ldg = D_IN; p.first = (i == 0);
                    s_gemm<<<dim3(DM / 64, M / 64), 256, 0, stream>>>(p); }
                break;
            case 3:
                { SG p{}; p.A = HM; p.lda = DM; p.W = w_out + (size_t)l * DM * DM; p.ldw = DM; p.K = DM; p.mode = MD_RESID; p.Xf = X; s_gemm<<<dim3(DM / 64, M / 64), 256, 0, stream>>>(p); }
                break;
            case 4:
                s_norm_route<<<M / 4, 256, 0, stream>>>(X, norm2_g + l * DM, HM, w_rg + (size_t)l * DM * 4, b_rg + l * 4, w_re + (size_t)l * DM * 32, b_re + l * 32, experts, weights, rank, ctl + CW_CNT + 32 * l);
                break;
            case 5:
                s_dispatch<<<1, 64, 0, stream>>>(ctl + CW_CNT + 32 * l, tile_tab);
                s_gather<<<M * 2 / 4, 256, 0, stream>>>(HM, experts, weights, rank, tile_tab, BUF, roww, dest);
                break;
            case 6:
                { SG p{}; p.A = BUF; p.lda = DM; p.W = w_eg + (size_t)l * NEXP * DM * DEXP; p.W2 = w_eu + (size_t)l * NEXP * DM * DEXP; p.ldw = DEXP; p.wstride = (size_t)DM * DEXP; p.tile_e = tile_tab; p.ntiles = tile_tab + 256;
                  p.K = DM; p.mode = MD_SILU; p.O = HID; p.ldo = DEXP; s_gemm<<<dim3(DEXP / 64, P_ROWS / 64), 256, 0, stream>>>(p); }
                break;
            case 7:
                { SG p{}; p.A = HID; p.lda = DEXP; p.W = w_ed + (size_t)l * NEXP * DEXP * DM; p.ldw = DM; p.wstride = (size_t)DEXP * DM; p.tile_e = tile_tab; p.ntiles = tile_tab + 256;
                  p.K = DEXP; p.mode = MD_ROWSCALE; p.O = YB; p.ldo = DM; p.roww = roww; s_gemm<<<dim3(DM / 64, P_ROWS / 64), 256, 0, stream>>>(p); }
                break;
            default:
                if (l + 1 < DEPTH) s_combine_norm<<<M / 4, 256, 0, stream>>>(X, YB, dest, norm1_g + (l + 1) * DM, HM, nullptr);
                else s_combine_norm<<<M / 4, 256, 0, stream>>>(X, YB, dest, final_g, nullptr, X);
                break;
            }
        }
        ++k;
    }
}
```

```cpp
#include <hip/hip_runtime.h>
#include <cstdint>
#include <cstdio>
#include <cmath>

typedef unsigned short bf16_t;
typedef float f32x4 __attribute__((ext_vector_type(4)));
typedef unsigned u32x4 __attribute__((ext_vector_type(4)));
typedef unsigned u32x2 __attribute__((ext_vector_type(2)));

constexpr int BATCH = 8, SEQ = 2048, DM = 1024, DEPTH = 2, MEM_LEN = 256;
constexpr int M = BATCH * SEQ;
constexpr int MM = BATCH * MEM_LEN;
constexpr int D_IN = 5888;
constexpr int C_AQ = 0, C_AK = 512, C_AV = 1024, C_BQ = 1536, C_BK = 2048, C_BV = 2176, C_CQ = 2304, C_G = 2816;
constexpr int OBR_W = 1536;
constexpr int NEXP = 32, DEXP = 512;
constexpr int MOE_TILE = 256;
constexpr int P_ROWS = M * 2 + NEXP * MOE_TILE;
constexpr int MAX_TILES = P_ROWS / MOE_TILE;
constexpr float EPS = 1e-6f;
constexpr float LOG2E = 1.4426950408889634f;
constexpr float C2_64 = 0.125f * LOG2E;
constexpr float C2_128 = 0.08838834764831845f * LOG2E;

constexpr size_t MiB = 1u << 20;
constexpr size_t WS_CTL = 0;
constexpr size_t WS_ROUTE = 1 * MiB;
constexpr size_t WS_TAB = 2 * MiB;
constexpr size_t WS_MEMKV = 3 * MiB;
constexpr size_t WS_HM = 7 * MiB;
constexpr size_t WS_PROJ = 39 * MiB;
constexpr size_t WS_OBR = 223 * MiB;
constexpr size_t WS_WB = 271 * MiB;
constexpr size_t WS_END = 499 * MiB;
constexpr size_t WS_BUF = WS_PROJ;
constexpr size_t WS_YB = WS_PROJ + 80 * MiB;
constexpr size_t WS_HID = WS_OBR;
constexpr size_t RT_EXP = 0;
constexpr size_t RT_WGT = 128 * 1024;
constexpr size_t RT_RANK = 256 * 1024;
constexpr size_t RT_DEST = 384 * 1024;
constexpr size_t RT_ROWW = 512 * 1024;
constexpr size_t RT_TILE = 700 * 1024;
constexpr size_t RT_RSTD = 768 * 1024;
constexpr int CW_CNT = 0;

__device__ __forceinline__ float bf2f(bf16_t v) { return __uint_as_float(((unsigned)v) << 16); }
__device__ __forceinline__ bf16_t f2bf(float f) { unsigned u = __float_as_uint(f); return (bf16_t)((u + 0x7fffu + ((u >> 16) & 1u)) >> 16); }
__device__ __forceinline__ float wave_sum(float v) {
#pragma unroll
    for (int o = 1; o < 64; o <<= 1) v += __shfl_xor(v, o);
    return v;
}
__device__ __forceinline__ float wave_max(float v) {
#pragma unroll
    for (int o = 1; o < 64; o <<= 1) v = fmaxf(v, __shfl_xor(v, o));
    return v;
}
__device__ __forceinline__ float inv1d(int i) { return exp2f(-(float)i * (13.287712379549449f / 32.f)); }
__device__ __forceinline__ float inv2d(int j) { return exp2f(-(float)j * (13.287712379549449f / 16.f)); }
__device__ __forceinline__ float ang2d(int pos, int i) { return i < 16 ? (float)(pos >> 6) * inv2d(i) : (float)(pos & 63) * inv2d(i - 16); }

__global__ __launch_bounds__(256) void s_rmsnorm(const float* __restrict__ X, const float* __restrict__ g, bf16_t* __restrict__ OUT, int rows) {
    const int lane = threadIdx.x & 63, row = blockIdx.x * 4 + (threadIdx.x >> 6);
    if (row >= rows) return;
    const f32x4* xr = (const f32x4*)(X + (size_t)row * DM);
    f32x4 v[4]; float s = 0.f;
#pragma unroll
    for (int j = 0; j < 4; ++j) { v[j] = xr[lane + 64 * j]; s += v[j].x * v[j].x + v[j].y * v[j].y + v[j].z * v[j].z + v[j].w * v[j].w; }
    const float rs = rsqrtf(wave_sum(s) * (1.f / DM) + EPS);
#pragma unroll
    for (int j = 0; j < 4; ++j) { const f32x4 gg = ((const f32x4*)g)[lane + 64 * j];
        u32x2 o; o.x = f2bf(v[j].x * rs * gg.x) | ((unsigned)f2bf(v[j].y * rs * gg.y) << 16); o.y = f2bf(v[j].z * rs * gg.z) | ((unsigned)f2bf(v[j].w * rs * gg.w) << 16);
        ((u32x2*)(OUT + (size_t)row * DM))[lane + 64 * j] = o; }
}

enum { MD_PROJ = 0, MD_BF16 = 1, MD_GATE = 2, MD_RESID = 3, MD_SILU = 4, MD_ROWSCALE = 5 };
struct SG {
    const bf16_t* A; int lda; const float* W; const float* W2; int ldw; size_t wstride;
    const int* tile_e; const int* ntiles;
    int K; int mode;
    bf16_t* O; int ldo;
    float* Xf;
    const bf16_t* G; int ldg; int first;
    const float* roww;
    const float* qg; const float* kg;
};
__global__ __launch_bounds__(256) void s_gemm(SG p) {
    __shared__ float As[16][68];
    __shared__ float Bs[16][68];
    __shared__ float B2s[16][68];
    __shared__ float Ct[64][65];
    __shared__ float Ct2[64][65];
    const int tid = threadIdx.x, tx = tid & 15, ty = tid >> 4;
    const int gc0 = blockIdx.x * 64, gr0 = blockIdx.y * 64;
    const float* W = p.W; const float* W2 = p.W2;
    if (p.tile_e) { const int t256 = blockIdx.y >> 2; if (t256 >= *p.ntiles) return; const int e = p.tile_e[t256]; W += (size_t)e * p.wstride; if (W2) W2 += (size_t)e * p.wstride; }
    float acc[4][4] = {}, acc2[4][4] = {};
    const int ar = tid >> 2, ak = (tid & 3) * 4;
    const int bk = tid >> 4, bn = (tid & 15) * 4;
    for (int k0 = 0; k0 < p.K; k0 += 16) {
        { const u32x2 a = *(const u32x2*)(p.A + (size_t)(gr0 + ar) * p.lda + k0 + ak);
          As[ak + 0][ar] = __uint_as_float(a.x << 16); As[ak + 1][ar] = __uint_as_float(a.x & 0xffff0000u);
          As[ak + 2][ar] = __uint_as_float(a.y << 16); As[ak + 3][ar] = __uint_as_float(a.y & 0xffff0000u); }
        { const f32x4 b = *(const f32x4*)(W + (size_t)(k0 + bk) * p.ldw + gc0 + bn); Bs[bk][bn] = b.x; Bs[bk][bn + 1] = b.y; Bs[bk][bn + 2] = b.z; Bs[bk][bn + 3] = b.w; }
        if (p.mode == MD_SILU) { const f32x4 b = *(const f32x4*)(W2 + (size_t)(k0 + bk) * p.ldw + gc0 + bn); B2s[bk][bn] = b.x; B2s[bk][bn + 1] = b.y; B2s[bk][bn + 2] = b.z; B2s[bk][bn + 3] = b.w; }
        __syncthreads();
#pragma unroll
        for (int k = 0; k < 16; ++k) {
            float a[4], b[4];
#pragma unroll
            for (int i = 0; i < 4; ++i) { a[i] = As[k][ty * 4 + i]; b[i] = Bs[k][tx * 4 + i]; }
#pragma unroll
            for (int i = 0; i < 4; ++i)
#pragma unroll
                for (int j = 0; j < 4; ++j) acc[i][j] += a[i] * b[j];
            if (p.mode == MD_SILU) {
#pragma unroll
                for (int i = 0; i < 4; ++i) b[i] = B2s[k][tx * 4 + i];
#pragma unroll
                for (int i = 0; i < 4; ++i)
#pragma unroll
                    for (int j = 0; j < 4; ++j) acc2[i][j] += a[i] * b[j];
            }
        }
        __syncthreads();
    }
#pragma unroll
    for (int i = 0; i < 4; ++i)
#pragma unroll
        for (int j = 0; j < 4; ++j) { Ct[ty * 4 + i][tx * 4 + j] = acc[i][j]; Ct2[ty * 4 + i][tx * 4 + j] = acc2[i][j]; }
    __syncthreads();
    const int r = tid >> 2, q = tid & 3; const int grow = gr0 + r;
    if (p.mode == MD_PROJ) {
        const int pos = grow & (SEQ - 1);
        bf16_t* orow = p.O + (size_t)grow * p.ldo + gc0;
        if (gc0 < C_AV) {
            const float sc = gc0 < C_AK ? C2_64 : 1.f;
            for (int j = 0; j < 8; ++j) { const int i = q * 8 + j; const float x1 = Ct[r][i], x2 = Ct[r][i + 32]; float s, c; sincosf((float)pos * inv1d(i), &s, &c);
                orow[i] = f2bf((x1 * c - x2 * s) * sc); orow[i + 32] = f2bf((x2 * c + x1 * s) * sc); }
        } else if ((gc0 >= C_BQ && gc0 < C_BV)) {
            const bool isq = gc0 < C_BK; const float* g = isq ? p.qg : p.kg; const float sc = isq ? C2_64 : 1.f;
            float ss = 0.f; for (int d = 0; d < 64; ++d) ss += Ct[r][d] * Ct[r][d];
            const float rs = rsqrtf(ss * (1.f / 64.f) + EPS);
            for (int j = 0; j < 8; ++j) { const int i = q * 8 + j; const float x1 = Ct[r][i] * rs * g[i], x2 = Ct[r][i + 32] * rs * g[i + 32]; float s, c; sincosf(ang2d(pos, i), &s, &c);
                orow[i] = f2bf((x1 * c - x2 * s) * sc); orow[i + 32] = f2bf((x2 * c + x1 * s) * sc); }
        } else if (gc0 >= C_G) {
            for (int j = 0; j < 16; ++j) { const int c = q * 16 + j; orow[c] = f2bf(1.f / (1.f + __expf(-Ct[r][c]))); }
        } else {
            const float sc = (gc0 >= C_CQ) ? C2_128 : 1.f;
            for (int j = 0; j < 16; ++j) { const int c = q * 16 + j; orow[c] = f2bf(Ct[r][c] * sc); }
        }
    } else if (p.mode == MD_BF16) {
        for (int j = 0; j < 16; ++j) { const int c = q * 16 + j; p.O[(size_t)grow * p.ldo + gc0 + c] = f2bf(Ct[r][c]); }
    } else if (p.mode == MD_GATE) {
        for (int j = 0; j < 16; ++j) { const int c = q * 16 + j; const float gv = bf2f(p.G[(size_t)grow * p.ldg + gc0 + c]);
            bf16_t* o = p.O + (size_t)grow * p.ldo + gc0 + c; const float prev = p.first ? 0.f : bf2f(*o); *o = f2bf(prev + gv * Ct[r][c]); }
    } else if (p.mode == MD_RESID) {
        for (int j = 0; j < 16; ++j) { const int c = q * 16 + j; p.Xf[(size_t)grow * DM + gc0 + c] += Ct[r][c]; }
    } else if (p.mode == MD_SILU) {
        for (int j = 0; j < 16; ++j) { const int c = q * 16 + j; const float gq = Ct[r][c], u = Ct2[r][c]; p.O[(size_t)grow * p.ldo + gc0 + c] = f2bf(gq / (1.f + __expf(-gq)) * u); }
    } else if (p.mode == MD_ROWSCALE) {
        const float w = p.roww[grow];
        for (int j = 0; j < 16; ++j) { const int c = q * 16 + j; p.O[(size_t)grow * p.ldo + gc0 + c] = f2bf(Ct[r][c] * w); }
    }
}

template <int DQK, int DV, int NKT>
__device__ __forceinline__ void attn_row(const bf16_t* q, const bf16_t* K, int ldk, const bf16_t* V, int ldv, float* qs, float* ps, int lane, float (&o)[2]) {
    for (int d = lane; d < DQK; d += 64) qs[d] = bf2f(q[d]);
    __syncthreads();
    float sc[NKT]; float m = -INFINITY;
#pragma unroll
    for (int i = 0; i < NKT; ++i) {
        const bf16_t* kr = K + (size_t)(i * 64 + lane) * ldk; float s = 0.f;
#pragma unroll
        for (int d0 = 0; d0 < DQK / 8; ++d0) { const u32x4 w = *(const u32x4*)(kr + d0 * 8);
            s += qs[d0 * 8 + 0] * __uint_as_float(w.x << 16) + qs[d0 * 8 + 1] * __uint_as_float(w.x & 0xffff0000u) + qs[d0 * 8 + 2] * __uint_as_float(w.y << 16) + qs[d0 * 8 + 3] * __uint_as_float(w.y & 0xffff0000u)
               + qs[d0 * 8 + 4] * __uint_as_float(w.z << 16) + qs[d0 * 8 + 5] * __uint_as_float(w.z & 0xffff0000u) + qs[d0 * 8 + 6] * __uint_as_float(w.w << 16) + qs[d0 * 8 + 7] * __uint_as_float(w.w & 0xffff0000u); }
        sc[i] = s; m = fmaxf(m, s);
    }
    m = wave_max(m); float l = 0.f;
#pragma unroll
    for (int i = 0; i < NKT; ++i) { const float pv = exp2f(sc[i] - m); l += pv; ps[i * 64 + lane] = pv; }
    l = wave_sum(l);
    __syncthreads();
    float a0 = 0.f, a1 = 0.f;
#pragma unroll 4
    for (int j = 0; j < NKT * 64; ++j) { const float pv = ps[j]; a0 += pv * bf2f(V[(size_t)j * ldv + lane]); if (DV == 128) a1 += pv * bf2f(V[(size_t)j * ldv + 64 + lane]); }
    o[0] = a0 / l; o[1] = a1 / l;
    __syncthreads();
}
__global__ __launch_bounds__(256) void s_attn_b(const bf16_t* __restrict__ PROJ, bf16_t* __restrict__ OBR) {
    __shared__ float qs_[4][128]; __shared__ float ps_[4][2048];
    const int w = threadIdx.x >> 6, lane = threadIdx.x & 63, row = blockIdx.x * 4 + w, qh = blockIdx.y, b = row / SEQ;
    const bf16_t* kv = PROJ + (size_t)b * SEQ * D_IN;
    float o[2];
    attn_row<64, 64, 32>(PROJ + (size_t)row * D_IN + C_BQ + qh * 64, kv + C_BK + (qh >> 2) * 64, D_IN, kv + C_BV + (qh >> 2) * 64, D_IN, qs_[w], ps_[w], lane, o);
    OBR[(size_t)row * OBR_W + 512 + qh * 64 + lane] = f2bf(o[0]);
}
__global__ __launch_bounds__(256) void s_attn_c(const bf16_t* __restrict__ PROJ, const bf16_t* __restrict__ MEMKV, bf16_t* __restrict__ OBR) {
    __shared__ float qs_[4][128]; __shared__ float ps_[4][256];
    const int w = threadIdx.x >> 6, lane = threadIdx.x & 63, row = blockIdx.x * 4 + w, h = blockIdx.y, b = row / SEQ;
    const bf16_t* kv = MEMKV + (size_t)b * MEM_LEN * 1024;
    float o[2];
    attn_row<128, 128, 4>(PROJ + (size_t)row * D_IN + C_CQ + h * 128, kv + h * 128, 1024, kv + 512 + h * 128, 1024, qs_[w], ps_[w], lane, o);
    OBR[(size_t)row * OBR_W + 1024 + h * 128 + lane] = f2bf(o[0]);
    OBR[(size_t)row * OBR_W + 1024 + h * 128 + 64 + lane] = f2bf(o[1]);
}
__global__ __launch_bounds__(256) void s_attn_a(const bf16_t* __restrict__ PROJ, bf16_t* __restrict__ OBR, const float* lq1, const float* lk1, const float* lq2, const float* lk2,
                                                const float* subg, float lam_init) {
    __shared__ float qs_[4][128]; __shared__ float ps_[4][2048];
    const int w = threadIdx.x >> 6, lane = threadIdx.x & 63, row = blockIdx.x * 4 + w, h = blockIdx.y, b = row / SEQ;
    const float lam = __expf(wave_sum(lq1[lane] * lk1[lane])) - __expf(wave_sum(lq2[lane] * lk2[lane])) + lam_init;
    const bf16_t* kv = PROJ + (size_t)b * SEQ * D_IN;
    float o0[2], o1[2];
    attn_row<64, 128, 32>(PROJ + (size_t)row * D_IN + C_AQ + h * 128, kv + C_AK + h * 128, D_IN, kv + C_AV + h * 128, D_IN, qs_[w], ps_[w], lane, o0);
    attn_row<64, 128, 32>(PROJ + (size_t)row * D_IN + C_AQ + h * 128 + 64, kv + C_AK + h * 128 + 64, D_IN, kv + C_AV + h * 128, D_IN, qs_[w], ps_[w], lane, o1);
    const float c0 = o0[0] - lam * o1[0], c1 = o0[1] - lam * o1[1];
    const float rs = rsqrtf(wave_sum(c0 * c0 + c1 * c1) * (1.f / 128.f) + EPS) * (1.f - lam_init);
    OBR[(size_t)row * OBR_W + h * 128 + lane] = f2bf(c0 * rs * subg[lane]);
    OBR[(size_t)row * OBR_W + h * 128 + 64 + lane] = f2bf(c1 * rs * subg[64 + lane]);
}

__global__ __launch_bounds__(256) void s_norm_route(const float* __restrict__ X, const float* __restrict__ g, bf16_t* __restrict__ H2, const float* __restrict__ wrg, const float* __restrict__ brg,
                                                    const float* __restrict__ wre, const float* __restrict__ bre, int* __restrict__ experts, float* __restrict__ weights, int* __restrict__ rank, unsigned* __restrict__ cnt, float* __restrict__ rstd) {
    const int lane = threadIdx.x & 63, row = blockIdx.x * 4 + (threadIdx.x >> 6);
    const f32x4* xr = (const f32x4*)(X + (size_t)row * DM);
    f32x4 v[4]; float s = 0.f;
#pragma unroll
    for (int j = 0; j < 4; ++j) { v[j] = xr[lane + 64 * j]; s += v[j].x * v[j].x + v[j].y * v[j].y + v[j].z * v[j].z + v[j].w * v[j].w; }
    const float rs = rsqrtf(wave_sum(s) * (1.f / DM) + EPS);
    float acc[36];
#pragma unroll
    for (int e = 0; e < 36; ++e) acc[e] = 0.f;
#pragma unroll
    for (int j = 0; j < 4; ++j) { const f32x4 gg = ((const f32x4*)g)[lane + 64 * j];
        float h[4] = {v[j].x * rs * gg.x, v[j].y * rs * gg.y, v[j].z * rs * gg.z, v[j].w * rs * gg.w};
        u32x2 o; o.x = f2bf(h[0]) | ((unsigned)f2bf(h[1]) << 16); o.y = f2bf(h[2]) | ((unsigned)f2bf(h[3]) << 16);
        ((u32x2*)(H2 + (size_t)row * DM))[lane + 64 * j] = o;
#pragma unroll
        for (int i = 0; i < 4; ++i) { const int k = (lane + 64 * j) * 4 + i;
            const f32x4 wg = *(const f32x4*)(wrg + (size_t)k * 4);
            acc[0] += h[i] * wg.x; acc[1] += h[i] * wg.y; acc[2] += h[i] * wg.z; acc[3] += h[i] * wg.w;
#pragma unroll
            for (int e4 = 0; e4 < 8; ++e4) { const f32x4 we = *(const f32x4*)(wre + (size_t)k * 32 + e4 * 4);
                acc[4 + e4 * 4 + 0] += h[i] * we.x; acc[4 + e4 * 4 + 1] += h[i] * we.y; acc[4 + e4 * 4 + 2] += h[i] * we.z; acc[4 + e4 * 4 + 3] += h[i] * we.w; }
        }
    }
#pragma unroll
    for (int e = 0; e < 36; ++e) acc[e] = wave_sum(acc[e]);
    if (lane == 0) {
        rstd[row] = rs;
        int gi = 0; float gm = acc[0] + brg[0];
        for (int i = 1; i < 4; ++i) { const float l = acc[i] + brg[i]; if (l > gm) { gm = l; gi = i; } }
        float gs = 0.f; for (int i = 0; i < 4; ++i) gs += __expf(acc[i] + brg[i] - gm);
        const float gp = 1.f / gs;
        float el[8];
#pragma unroll
        for (int i = 0; i < 8; ++i) el[i] = 0.f;
#pragma unroll
        for (int gq = 0; gq < 4; ++gq) if (gq == gi) {
#pragma unroll
            for (int i = 0; i < 8; ++i) el[i] = acc[4 + gq * 8 + i] + bre[gq * 8 + i]; }
        int i0 = 0; float l0 = el[0];
#pragma unroll
        for (int i = 1; i < 8; ++i) if (el[i] > l0) { l0 = el[i]; i0 = i; }
        int i1 = -1; float l1 = -INFINITY;
#pragma unroll
        for (int i = 0; i < 8; ++i) if (i != i0 && el[i] > l1) { l1 = el[i]; i1 = i; }
        const float p1 = __expf(l1 - l0), inv = 1.f / (1.f + p1);
        const int e0 = gi * 8 + i0, e1 = gi * 8 + i1;
        experts[row * 2] = e0; experts[row * 2 + 1] = e1;
        weights[row * 2] = gp * inv; weights[row * 2 + 1] = gp * p1 * inv;
        rank[row * 2] = (int)atomicAdd(cnt + e0, 1u); rank[row * 2 + 1] = (int)atomicAdd(cnt + e1, 1u);
    }
}
__global__ void s_dispatch(const unsigned* __restrict__ cnt, int* __restrict__ tile_tab) {
    if (threadIdx.x == 0) {
        int off = 0, nt = 0;
        for (int e = 0; e < NEXP; ++e) { const int c = (int)cnt[e], t = (c + MOE_TILE - 1) / MOE_TILE; tile_tab[260 + e] = off; for (int i = 0; i < t; ++i) tile_tab[nt++] = e; off += t * MOE_TILE; }
        tile_tab[256] = nt;
    }
}
__global__ __launch_bounds__(256) void s_gather(const float* __restrict__ X, const float* __restrict__ rstd, const float* __restrict__ g, const int* __restrict__ experts, const float* __restrict__ weights, const int* __restrict__ rank, const int* __restrict__ tile_tab,
                                                bf16_t* __restrict__ BUF, float* __restrict__ roww, int* __restrict__ dest) {
    const int lane = threadIdx.x & 63, a = blockIdx.x * 4 + (threadIdx.x >> 6);
    const int tok = a >> 1, e = experts[a], d = tile_tab[260 + e] + rank[a]; const float rs = rstd[tok];
    const f32x4* xr = (const f32x4*)(X + (size_t)tok * DM);
    for (int j = 0; j < 4; ++j) { const f32x4 v = xr[lane + 64 * j], gg = ((const f32x4*)g)[lane + 64 * j];
        u32x2 o; o.x = f2bf(v.x * rs * gg.x) | ((unsigned)f2bf(v.y * rs * gg.y) << 16); o.y = f2bf(v.z * rs * gg.z) | ((unsigned)f2bf(v.w * rs * gg.w) << 16);
        ((u32x2*)(BUF + (size_t)d * DM))[lane + 64 * j] = o; }
    if (lane == 0) { roww[d] = weights[a]; dest[a] = d; }
}
__global__ __launch_bounds__(256) void s_combine_norm(float* __restrict__ X, const bf16_t* __restrict__ YB, const int* __restrict__ dest, const float* __restrict__ g, bf16_t* __restrict__ H, float* __restrict__ OUT) {
    const int lane = threadIdx.x & 63, row = blockIdx.x * 4 + (threadIdx.x >> 6);
    const int d0 = dest[row * 2], d1 = dest[row * 2 + 1];
    f32x4* xr = (f32x4*)(X + (size_t)row * DM);
    f32x4 v[4]; float s = 0.f;
#pragma unroll
    for (int j = 0; j < 4; ++j) { v[j] = xr[lane + 64 * j];
        const u32x2 a = ((const u32x2*)(YB + (size_t)d0 * DM))[lane + 64 * j], b = ((const u32x2*)(YB + (size_t)d1 * DM))[lane + 64 * j];
        v[j].x += __uint_as_float(a.x << 16) + __uint_as_float(b.x << 16); v[j].y += __uint_as_float(a.x & 0xffff0000u) + __uint_as_float(b.x & 0xffff0000u);
        v[j].z += __uint_as_float(a.y << 16) + __uint_as_float(b.y << 16); v[j].w += __uint_as_float(a.y & 0xffff0000u) + __uint_as_float(b.y & 0xffff0000u);
        s += v[j].x * v[j].x + v[j].y * v[j].y + v[j].z * v[j].z + v[j].w * v[j].w; }
    const float rs = rsqrtf(wave_sum(s) * (1.f / DM) + EPS);
#pragma unroll
    for (int j = 0; j < 4; ++j) { const f32x4 gg = ((const f32x4*)g)[lane + 64 * j];
        if (H) { xr[lane + 64 * j] = v[j];
            u32x2 o; o.x = f2bf(v[j].x * rs * gg.x) | ((unsigned)f2bf(v[j].y * rs * gg.y) << 16); o.y = f2bf(v[j].z * rs * gg.z) | ((unsigned)f2bf(v[j].w * rs * gg.w) << 16);
            ((u32x2*)(H + (size_t)row * DM))[lane + 64 * j] = o; }
        else { f32x4 o; o.x = v[j].x * rs * gg.x; o.y = v[j].y * rs * gg.y; o.z = v[j].z * rs * gg.z; o.w = v[j].w * rs * gg.w; ((f32x4*)(OUT + (size_t)row * DM))[lane + 64 * j] = o; }
    }
}

#define LAS __attribute__((address_space(3)))
#define GAS __attribute__((address_space(1)))
typedef short bf16x8 __attribute__((ext_vector_type(8)));
typedef short s16x4 __attribute__((ext_vector_type(4)));
typedef float f32x16 __attribute__((ext_vector_type(16)));
typedef float f32x2 __attribute__((ext_vector_type(2)));

constexpr size_t WB_IN = 0, WB_UP = 6029312, WB_OUT = WB_UP + 1572864, WB_GU = WB_OUT + 1048576, WB_DN = WB_GU + 33554432, WB_LAYER = WB_DN + 16777216;
constexpr size_t WB_MEMKV = 2 * WB_LAYER;
constexpr size_t WB_RT = WB_MEMKV + 1048576;
static_assert(WS_WB + (WB_RT + 2 * 2 * 48 * 1024) * 2 <= WS_END, "weight copies fit");
constexpr int N_PHASES = 19;

__device__ __forceinline__ unsigned cvt_pk_bf16(float lo, float hi) { unsigned r; asm volatile("v_cvt_pk_bf16_f32 %0, %1, %2" : "=v"(r) : "v"(lo), "v"(hi)); return r; }
__device__ __forceinline__ float fast_sigmoid(float v) { return __builtin_amdgcn_rcpf(1.f + __builtin_amdgcn_exp2f(-v * LOG2E)); }

namespace pg8 {
#define PG8_LAS LAS
constexpr int BM = 256, BK = 64, HALF = 128, HTB = HALF * BK * 2, STAGE_BYTES = 8 * HTB, NXCD = 8, WGM = 8;
__host__ __device__ __forceinline__ int lds_byte(int r, int c) { const int st = (r >> 4) * 2 + (c >> 5), rr = r & 15, cc = c & 31, ob = rr * 64 + cc * 2; return st * 1024 + (ob ^ (((ob >> 9) & 1) << 5)); }
__host__ __device__ __forceinline__ void stage_rc(int b, int& R, int& C) { const int st = b / 1024, sb = b % 1024, swz = sb ^ (((sb >> 9) & 1) << 5); R = (st >> 1) * 16 + swz / 64; C = (st & 1) * 32 + (swz % 64) / 2; }
__host__ __device__ __forceinline__ int perm32(int rho) { const int n = rho >> 4, i = rho & 15; return 8 * (i >> 2) + 4 * n + (i & 3); }

struct Unit { int pm, pn, sub; const char* a; const char* b; };
struct Gemm { int lda; int K; };
__device__ __forceinline__ void tile_order(int L, int nM, int nN, int& pm, int& pn) {
    const int nwg = nM * nN; int wgid = L; { const int q = nwg / NXCD, r = nwg % NXCD, xcd = wgid % NXCD, off = wgid / NXCD; wgid = (xcd < r ? xcd * (q + 1) : r * (q + 1) + (xcd - r) * q) + off; }
    const int nig = WGM * nN, gid = wgid / nig, fm = gid * WGM, gsz = (nM - fm) < WGM ? (nM - fm) : WGM;
    pm = fm + ((wgid % nig) % gsz); pn = (wgid % nig) / gsz;
}
__device__ __forceinline__ u32x4 pack8(const f32x4& v0, const f32x4& v1) { u32x4 w; w.x = cvt_pk_bf16(v0[0], v0[1]); w.y = cvt_pk_bf16(v0[2], v0[3]); w.z = cvt_pk_bf16(v1[0], v1[1]); w.w = cvt_pk_bf16(v1[2], v1[3]); return w; }
__device__ __forceinline__ void unpack8(const u32x4& w, f32x4& v0, f32x4& v1) {
    v0[0] = __uint_as_float(w.x << 16); v0[1] = __uint_as_float(w.x & 0xffff0000u); v0[2] = __uint_as_float(w.y << 16); v0[3] = __uint_as_float(w.y & 0xffff0000u);
    v1[0] = __uint_as_float(w.z << 16); v1[1] = __uint_as_float(w.z & 0xffff0000u); v1[2] = __uint_as_float(w.w << 16); v1[3] = __uint_as_float(w.w & 0xffff0000u); }

struct EpiProj {
    static constexpr bool PERM = true, AFTER_DRAIN = false;
    bf16_t* PROJ; bf16_t* MEMKV; const float* tab1; const float* tab2; const float* qg; const float* kg;
    __device__ __forceinline__ void operator()(const f32x4 (&acc)[2][2][4][2], const Unit& u, int wr, int wc, int fr, int fq) const {
        const int colt = u.pn * 256, dcol = colt + wc * 64 + fq * 8, row0 = u.pm * 256 + wr * 64 + fr;
        if (u.sub == 1) {
#pragma unroll
            for (int ai = 0; ai < 2; ++ai)
#pragma unroll
                for (int m = 0; m < 4; ++m) { bf16_t* rowp = MEMKV + (size_t)(row0 + ai * 128 + m * 16) * 1024 + dcol;
#pragma unroll
                    for (int bj = 0; bj < 2; ++bj) *(u32x4*)(rowp + bj * 32) = pack8(acc[ai][bj][m][0], acc[ai][bj][m][1]); }
            return;
        }
        int mode = 0; float sc = 1.f; const float* g = qg;
        if (colt < C_AV) { mode = 1; if (colt < C_AK) sc = C2_64; }
        else if (colt < C_BQ) mode = 0;
        else if (colt < C_BK) { mode = 2; sc = C2_64; }
        else if (colt < C_CQ) { if (wc < 2) { mode = 2; g = kg; } }
        else if (colt < C_G) sc = C2_128;
        else mode = 3;
        f32x4 gv[2][2];
        if (mode == 2) {
#pragma unroll
            for (int bj = 0; bj < 2; ++bj)
#pragma unroll
                for (int n = 0; n < 2; ++n) gv[bj][n] = *(const f32x4*)(g + bj * 32 + fq * 8 + n * 4);
        }
#pragma unroll
        for (int ai = 0; ai < 2; ++ai)
#pragma unroll
            for (int m = 0; m < 4; ++m) {
                const int row = row0 + ai * 128 + m * 16, pos = row & (SEQ - 1);
                f32x4 v[2][2] = {{acc[ai][0][m][0], acc[ai][0][m][1]}, {acc[ai][1][m][0], acc[ai][1][m][1]}};
                if (mode == 2) {
                    float ss = 0.f;
#pragma unroll
                    for (int bj = 0; bj < 2; ++bj)
#pragma unroll
                        for (int n = 0; n < 2; ++n) ss += (v[bj][n][0] * v[bj][n][0] + v[bj][n][1] * v[bj][n][1]) + (v[bj][n][2] * v[bj][n][2] + v[bj][n][3] * v[bj][n][3]);
                    ss += __shfl_xor(ss, 16); ss += __shfl_xor(ss, 32);
                    const float rs = rsqrtf(ss * (1.f / 64.f) + EPS);
#pragma unroll
                    for (int bj = 0; bj < 2; ++bj)
#pragma unroll
                        for (int n = 0; n < 2; ++n) v[bj][n] = v[bj][n] * rs * gv[bj][n];
                }
                if (mode == 1 || mode == 2) {
                    const float* tb = (mode == 1 ? tab1 : tab2) + ((size_t)pos * 32 + fq * 8) * 2;
#pragma unroll
                    for (int n = 0; n < 2; ++n) { const f32x4 t0 = *(const f32x4*)(tb + n * 8), t1 = *(const f32x4*)(tb + n * 8 + 4);
                        const float cs[4] = {t0[0], t0[2], t1[0], t1[2]}, sn[4] = {t0[1], t0[3], t1[1], t1[3]};
#pragma unroll
                        for (int e = 0; e < 4; ++e) { const float x1 = v[0][n][e], x2 = v[1][n][e]; v[0][n][e] = x1 * cs[e] - x2 * sn[e]; v[1][n][e] = x2 * cs[e] + x1 * sn[e]; } }
                }
                if (mode == 3) {
#pragma unroll
                    for (int bj = 0; bj < 2; ++bj)
#pragma unroll
                        for (int n = 0; n < 2; ++n)
#pragma unroll
                            for (int e = 0; e < 4; ++e) v[bj][n][e] = fast_sigmoid(v[bj][n][e]);
                }
                bf16_t* rowp = PROJ + (size_t)row * D_IN + dcol;
#pragma unroll
                for (int bj = 0; bj < 2; ++bj) *(u32x4*)(rowp + bj * 32) = pack8(v[bj][0] * sc, v[bj][1] * sc);
            }
    }
};
struct EpiGate {
    static constexpr bool PERM = true, AFTER_DRAIN = false;
    bf16_t* MERGED; const bf16_t* PROJ;
    __device__ __forceinline__ void operator()(const f32x4 (&acc)[2][2][4][2], const Unit& u, int wr, int wc, int fr, int fq) const {
        const int col0 = u.pn * 256 + wc * 32 + fq * 8, row0 = u.pm * 256 + wr * 64 + fr;
#pragma unroll
        for (int ai = 0; ai < 2; ++ai)
#pragma unroll
            for (int m = 0; m < 4; ++m) { const int row = row0 + ai * 128 + m * 16;
                const bf16_t* gp = PROJ + (size_t)row * D_IN + C_G + u.sub * 1024 + col0; bf16_t* op = MERGED + (size_t)row * DM + col0;
#pragma unroll
                for (int bj = 0; bj < 2; ++bj) { f32x4 g0, g1, o0 = {0.f, 0.f, 0.f, 0.f}, o1 = {0.f, 0.f, 0.f, 0.f};
                    unpack8(*(const u32x4*)(gp + bj * 128), g0, g1);
                    if (u.sub != 0) unpack8(*(const u32x4*)(op + bj * 128), o0, o1);
                    o0 += g0 * acc[ai][bj][m][0]; o1 += g1 * acc[ai][bj][m][1];
                    *(u32x4*)(op + bj * 128) = pack8(o0, o1); } }
    }
};
struct EpiResid {
    static constexpr bool PERM = true, AFTER_DRAIN = false;
    float* X;
    __device__ __forceinline__ void operator()(const f32x4 (&acc)[2][2][4][2], const Unit& u, int wr, int wc, int fr, int fq) const {
        const int col0 = u.pn * 256 + wc * 32 + fq * 8, row0 = u.pm * 256 + wr * 64 + fr;
#pragma unroll
        for (int ai = 0; ai < 2; ++ai)
#pragma unroll
            for (int m = 0; m < 4; ++m) { float* xp = X + (size_t)(row0 + ai * 128 + m * 16) * DM + col0;
#pragma unroll
                for (int bj = 0; bj < 2; ++bj) { f32x4* p = (f32x4*)(xp + bj * 128); const f32x4 a = p[0], b = p[1]; p[0] = a + acc[ai][bj][m][0]; p[1] = b + acc[ai][bj][m][1]; } }
    }
};
struct EpiSilu {
    static constexpr bool PERM = true, AFTER_DRAIN = false;
    bf16_t* HID;
    __device__ __forceinline__ void operator()(const f32x4 (&acc)[2][2][4][2], const Unit& u, int wr, int wc, int fr, int fq) const {
        const int col0 = u.pn * 128 + wc * 32 + fq * 8, row0 = u.pm * 256 + wr * 64 + fr;
#pragma unroll
        for (int ai = 0; ai < 2; ++ai)
#pragma unroll
            for (int m = 0; m < 4; ++m) { f32x4 h[2];
#pragma unroll
                for (int n = 0; n < 2; ++n)
#pragma unroll
                    for (int e = 0; e < 4; ++e) { const float gq = acc[ai][0][m][n][e]; h[n][e] = gq * fast_sigmoid(gq) * acc[ai][1][m][n][e]; }
                *(u32x4*)(HID + (size_t)(row0 + ai * 128 + m * 16) * DEXP + col0) = pack8(h[0], h[1]); }
    }
};
struct EpiRowScale {
    static constexpr bool PERM = true, AFTER_DRAIN = false;
    bf16_t* YB; const float* roww;
    __device__ __forceinline__ void operator()(const f32x4 (&acc)[2][2][4][2], const Unit& u, int wr, int wc, int fr, int fq) const {
        const int col0 = u.pn * 256 + wc * 32 + fq * 8, row0 = u.pm * 256 + wr * 64 + fr;
#pragma unroll
        for (int ai = 0; ai < 2; ++ai)
#pragma unroll
            for (int m = 0; m < 4; ++m) { const int row = row0 + ai * 128 + m * 16; const float w = roww[row]; bf16_t* op = YB + (size_t)row * DM + col0;
#pragma unroll
                for (int bj = 0; bj < 2; ++bj) *(u32x4*)(op + bj * 128) = pack8(acc[ai][bj][m][0] * w, acc[ai][bj][m][1] * w); }
    }
};
struct SchedProj {
    int c, G, nmain, ntotal; const char* A; const char* B; const char* Am; const char* Bm;
    __device__ __forceinline__ bool next(int i, Unit& u) const {
        const long L = (long)i * G + c; if (L >= ntotal) return false;
        if (L < nmain) { tile_order((int)L, M / 256, D_IN / 256, u.pm, u.pn); u.sub = 0; u.a = A + (size_t)u.pm * (256 * DM * 2); u.b = B + (size_t)u.pn * (256 * DM * 2); }
        else { const int r = (int)L - nmain; u.pm = r >> 2; u.pn = r & 3; u.sub = 1; u.a = Am + (size_t)u.pm * (256 * DM * 2); u.b = Bm + (size_t)u.pn * (256 * DM * 2); }
        return true; }
    __device__ __forceinline__ void a_ready(const Unit&) const {}
    __device__ __forceinline__ void done(const Unit&) const {}
};
struct SchedGate {
    int c, G; const char* OBRp; const char* WUP;
    __device__ __forceinline__ bool next(int i, Unit& u) const {
        const int t = c + G * (i / 3); if (t >= 256) return false;
        tile_order(t, M / 256, 4, u.pm, u.pn); u.sub = i % 3;
        u.a = OBRp + ((size_t)u.pm * 256 * OBR_W + 512 * u.sub) * 2; u.b = WUP + ((size_t)u.sub * 1024 * 512 + (size_t)u.pn * 256 * 512) * 2; return true; }
    __device__ __forceinline__ void a_ready(const Unit&) const {}
    __device__ __forceinline__ void done(const Unit&) const {}
};
struct SchedPlain {
    int c, G, nM; const char* A; const char* B; size_t a_tile, b_tile;
    __device__ __forceinline__ bool next(int i, Unit& u) const {
        const long L = (long)i * G + c; if (L >= (long)nM * 4) return false;
        tile_order((int)L, nM, 4, u.pm, u.pn); u.sub = 0; u.a = A + (size_t)u.pm * a_tile; u.b = B + (size_t)u.pn * b_tile; return true; }
    __device__ __forceinline__ void a_ready(const Unit&) const {}
    __device__ __forceinline__ void done(const Unit&) const {}
};
struct SchedMoe {
    int c, G, ntiles; const int* tile_e; const char* A; const char* B; size_t a_tile, b_exp, b_tile;
    __device__ __forceinline__ bool next(int i, Unit& u) const {
        const long L = (long)i * G + c; if (L >= (long)ntiles * 4) return false;
        u.pm = (int)(L >> 2); u.pn = (int)(L & 3); u.sub = 0; const int e = tile_e[u.pm];
        u.a = A + (size_t)u.pm * a_tile; u.b = B + (size_t)e * b_exp + (size_t)u.pn * b_tile; return true; }
    __device__ __forceinline__ void a_ready(const Unit&) const {}
    __device__ __forceinline__ void done(const Unit&) const {}
};

template <class Epi, class Sched, bool ALIGN_EPI = false, bool SP2 = false>
__device__ __forceinline__ void gemm_phase(PG8_LAS unsigned char* lds, const Gemm g, const Sched& S, const Epi& E) {
    int tid_ = threadIdx.x; asm volatile("" : "+v"(tid_));
    const int tid = tid_, wid = __builtin_amdgcn_readfirstlane(tid >> 6), lane = tid & 63, wr = wid >> 2, wc = wid & 3, fr = lane & 15, fq = lane >> 4;
    const int K = g.K, nt = K / BK;
    unsigned voffA[2], voffB[2];
#pragma unroll
    for (int i = 0; i < 2; ++i) { int R, C; stage_rc(tid * 16 + i * 8192, R, C); const int Rb = Epi::PERM ? ((R & ~31) + perm32(R & 31)) : R;
        voffA[i] = (unsigned)(R * g.lda + C) * 2u; voffB[i] = (unsigned)(Rb * K + C) * 2u; }
    const size_t kstep = (size_t)(BK * 2);
    const size_t hstepA = (size_t)HALF * g.lda * 2, hstepB = (size_t)HALF * K * 2;
    const unsigned ldsw = (unsigned)wid * 1024u;
    const int aoff = lds_byte(wr * 64 + fr, fq * 8), boff = lds_byte(wc * 32 + fr, fq * 8);
#define PG8_SA(b, h) (((b) * 2 + (h)) * HTB)
#define PG8_SB(b, h) ((4 + (b) * 2 + (h)) * HTB)
#define PG8_STAGE(bufoff, gbase, voff) do { _Pragma("unroll") for (int _i = 0; _i < 2; ++_i) \
        __builtin_amdgcn_global_load_lds((const unsigned*)((const char*)(gbase) + (voff)[_i]), (PG8_LAS unsigned*)(lds + (bufoff) + ldsw + _i * 8192), 16, 0, 0); } while (0)
#define PG8_LDA(dst, b, h) do { _Pragma("unroll") for (int m = 0; m < 4; ++m) _Pragma("unroll") for (int k = 0; k < 2; ++k) dst[m][k] = *(const PG8_LAS bf16x8*)(lds + PG8_SA(b, h) + aoff + m * 2048 + k * 1024); } while (0)
#define PG8_LDB(dst, b, h) do { _Pragma("unroll") for (int n = 0; n < 2; ++n) _Pragma("unroll") for (int k = 0; k < 2; ++k) dst[n][k] = *(const PG8_LAS bf16x8*)(lds + PG8_SB(b, h) + boff + n * 2048 + k * 1024); } while (0)
#define PG8_MMA(ai, bj, At, Bt) do { __builtin_amdgcn_s_setprio(1); _Pragma("unroll") for (int m = 0; m < 4; ++m) _Pragma("unroll") for (int n = 0; n < 2; ++n) _Pragma("unroll") for (int k = 0; k < 2; ++k) \
        acc[ai][bj][m][n] = __builtin_amdgcn_mfma_f32_16x16x32_bf16(Bt[n][k], At[m][k], acc[ai][bj][m][n], 0, 0, 0); __builtin_amdgcn_s_setprio(0); } while (0)
#define PG8_WAIT_V(n) asm volatile("s_waitcnt vmcnt(" #n ")" ::: "memory")
#define PG8_WAIT_L(n) asm volatile("s_waitcnt lgkmcnt(" #n ")" ::: "memory")
#define PG8_BAR __builtin_amdgcn_s_barrier()
#define PG8_SCHED __builtin_amdgcn_sched_barrier(0)
    Unit cur, nxt; int ui = 0;
    if (!S.next(0, cur)) return;
    f32x4 acc[2][2][4][2];
#pragma unroll
    for (int a = 0; a < 2; ++a)
#pragma unroll
        for (int b = 0; b < 2; ++b)
#pragma unroll
            for (int m = 0; m < 4; ++m)
#pragma unroll
                for (int n = 0; n < 2; ++n) acc[a][b][m][n] = (f32x4){0.f, 0.f, 0.f, 0.f};
    bf16x8 At[4][2], B0[2][2], B1[2][2];
    const char* cA = cur.a; const char* cB = cur.b;
    S.a_ready(cur);
    if constexpr (SP2) {
        PG8_STAGE(PG8_SB(0, 0), cB, voffB); PG8_STAGE(PG8_SB(0, 1), cB + hstepB, voffB); PG8_STAGE(PG8_SA(0, 0), cA, voffA); PG8_STAGE(PG8_SA(0, 1), cA + hstepA, voffA);
        if (wr == 1) PG8_BAR;
        PG8_WAIT_V(2); PG8_BAR;
        PG8_STAGE(PG8_SB(1, 0), cB + kstep, voffB); PG8_STAGE(PG8_SA(1, 0), cA + kstep, voffA); PG8_STAGE(PG8_SB(1, 1), cB + hstepB + kstep, voffB);
        PG8_WAIT_V(6); PG8_BAR;
    } else {
        PG8_STAGE(PG8_SB(0, 0), cB, voffB); PG8_STAGE(PG8_SA(0, 0), cA, voffA); PG8_STAGE(PG8_SB(0, 1), cB + hstepB, voffB); PG8_STAGE(PG8_SA(0, 1), cA + hstepA, voffA);
        if (wr == 1) PG8_BAR;
        PG8_WAIT_V(4); PG8_BAR;
        PG8_STAGE(PG8_SB(1, 0), cB + kstep, voffB); PG8_STAGE(PG8_SA(1, 0), cA + kstep, voffA); PG8_STAGE(PG8_SB(1, 1), cB + hstepB + kstep, voffB);
        PG8_WAIT_V(6); PG8_BAR;
    }
    for (;;) {
        const bool has_next = S.next(ui + 1, nxt);
        const char* nA = has_next ? nxt.a : cA; const char* nB = has_next ? nxt.b : cB;
        for (int t = 0; t < nt; t += 2) {
            const bool last = (t == nt - 2);
            const char* a1 = cA + (size_t)(t + 1) * kstep;
            const char* a2 = last ? nA : cA + (size_t)(t + 2) * kstep; const char* b2 = last ? nB : cB + (size_t)(t + 2) * kstep;
            const char* a3 = a2 + kstep; const char* b3 = b2 + kstep;
            if (last && has_next) S.a_ready(nxt);
            if constexpr (SP2) {
            PG8_LDB(B0, 0, 0); PG8_LDB(B1, 0, 1); PG8_SCHED; PG8_LDA(At, 0, 0); PG8_STAGE(PG8_SA(1, 1), a1 + hstepA, voffA);
            PG8_WAIT_V(8); PG8_WAIT_L(0); PG8_BAR; PG8_MMA(0, 0, At, B0); PG8_MMA(0, 1, At, B1); PG8_BAR; PG8_SCHED;
            PG8_LDA(At, 0, 1); PG8_STAGE(PG8_SB(0, 0), b2, voffB); PG8_STAGE(PG8_SB(0, 1), b2 + hstepB, voffB); PG8_STAGE(PG8_SA(0, 0), a2, voffA);
            PG8_WAIT_V(8); PG8_WAIT_L(0); PG8_BAR; PG8_MMA(1, 0, At, B0); PG8_MMA(1, 1, At, B1); PG8_BAR; PG8_SCHED;
            PG8_LDB(B0, 1, 0); PG8_LDB(B1, 1, 1); PG8_SCHED; PG8_LDA(At, 1, 0); PG8_STAGE(PG8_SA(0, 1), a2 + hstepA, voffA);
            PG8_WAIT_V(8); PG8_WAIT_L(0); PG8_BAR; PG8_MMA(0, 0, At, B0); PG8_MMA(0, 1, At, B1); PG8_BAR; PG8_SCHED;
            PG8_LDA(At, 1, 1); PG8_STAGE(PG8_SB(1, 0), b3, voffB); PG8_STAGE(PG8_SB(1, 1), b3 + hstepB, voffB); PG8_STAGE(PG8_SA(1, 0), a3, voffA);
            PG8_WAIT_V(8); PG8_WAIT_L(0); PG8_BAR; PG8_MMA(1, 0, At, B0); PG8_MMA(1, 1, At, B1); PG8_BAR; PG8_SCHED;
            } else {
            PG8_LDB(B0, 0, 0); PG8_SCHED; PG8_LDA(At, 0, 0); PG8_STAGE(PG8_SA(1, 1), a1 + hstepA, voffA);
            PG8_WAIT_L(8); PG8_BAR; PG8_WAIT_L(0); PG8_MMA(0, 0, At, B0); PG8_BAR; PG8_SCHED;
            PG8_LDB(B1, 0, 1); PG8_STAGE(PG8_SB(0, 0), b2, voffB);
            PG8_BAR; PG8_WAIT_L(0); PG8_MMA(0, 1, At, B1); PG8_BAR;
            PG8_LDA(At, 0, 1); PG8_STAGE(PG8_SA(0, 0), a2, voffA);
            PG8_BAR; PG8_WAIT_L(0); PG8_MMA(1, 0, At, B0); PG8_BAR; PG8_SCHED;
            PG8_STAGE(PG8_SB(0, 1), b2 + hstepB, voffB);
            PG8_WAIT_V(6); PG8_BAR; PG8_MMA(1, 1, At, B1); PG8_BAR;
            PG8_LDB(B0, 1, 0); PG8_SCHED; PG8_LDA(At, 1, 0); PG8_STAGE(PG8_SA(0, 1), a2 + hstepA, voffA);
            PG8_WAIT_L(8); PG8_BAR; PG8_WAIT_L(0); PG8_MMA(0, 0, At, B0); PG8_BAR; PG8_SCHED;
            PG8_LDB(B1, 1, 1); PG8_STAGE(PG8_SB(1, 0), b3, voffB);
            PG8_BAR; PG8_WAIT_L(0); PG8_MMA(0, 1, At, B1); PG8_BAR;
            PG8_LDA(At, 1, 1); PG8_STAGE(PG8_SA(1, 0), a3, voffA);
            PG8_BAR; PG8_WAIT_L(0); PG8_MMA(1, 0, At, B0); PG8_BAR; PG8_SCHED;
            PG8_STAGE(PG8_SB(1, 1), b3 + hstepB, voffB);
            PG8_WAIT_V(6); PG8_BAR; PG8_MMA(1, 1, At, B1); PG8_BAR;
            }
        }
        if constexpr (ALIGN_EPI) { if (wr == 0) PG8_BAR; }
        if constexpr (!Epi::AFTER_DRAIN) { E(acc, cur, wr, wc, fr, fq); S.done(cur); }
        if (!has_next) break;
#pragma unroll
        for (int a = 0; a < 2; ++a)
#pragma unroll
            for (int b = 0; b < 2; ++b)
#pragma unroll
                for (int m = 0; m < 4; ++m)
#pragma unroll
                    for (int n = 0; n < 2; ++n) acc[a][b][m][n] = (f32x4){0.f, 0.f, 0.f, 0.f};
        cur = nxt; cA = nA; cB = nB; ++ui;
        if constexpr (ALIGN_EPI) { if (wr == 1) PG8_BAR; }
    }
    PG8_WAIT_V(0);
    if constexpr (!ALIGN_EPI) { if (wr == 0) PG8_BAR; }
    PG8_BAR;
    if constexpr (Epi::AFTER_DRAIN) { E.fused(acc, cur, wr, wc, fr, fq, lds, wid, lane); S.done(cur); }
#undef PG8_SA
#undef PG8_SB
#undef PG8_STAGE
#undef PG8_LDA
#undef PG8_LDB
#undef PG8_MMA
#undef PG8_WAIT_V
#undef PG8_WAIT_L
#undef PG8_BAR
#undef PG8_SCHED
}
}

namespace att {
constexpr int NW = 8, QBLK = 32, KVBLK = 64;
constexpr float THR = 8.f;
#define ATT_SBAR() __builtin_amdgcn_sched_barrier(0)
__device__ __forceinline__ int crow(int r, int hi) { return (r & 3) + 8 * (r >> 2) + 4 * hi; }
template <int D> __device__ __forceinline__ int kswz(int row, int colB) { return D == 128 ? row * 256 + (colB ^ ((row & 7) << 4)) : row * 128 + (colB ^ (((row >> 1) & 7) << 4)); }
template <int DV> __device__ __forceinline__ int v_st(int k, int c) { const int kk = (k & ~0xC) | ((k & 4) << 1) | ((k & 8) >> 1); return ((kk >> 3) * (DV / 32) + (c >> 5)) * 512 + ((kk & 7) * 32 + (c & 31)) * 2; }
__device__ __forceinline__ int v_rd_base(int lane) { return ((lane & 3) << 3) | (((lane >> 2) & 3) << 6) | (((lane >> 4) & 1) << 5) | (((lane >> 5) & 1) << 8); }
template <int DV> constexpr int v_rd_off(int d0, int ks, int half) { return d0 * 512 + ks * (DV / 32) * 1024 + half * (DV / 32) * 512; }
template <int OFF> __device__ __forceinline__ s16x4 tr_read(int vb) { s16x4 r; asm volatile("ds_read_b64_tr_b16 %0, %1 offset:%2" : "=&v"(r) : "v"(vb), "i"(OFF) : "memory"); return r; }

__device__ __forceinline__ void partialSM(f32x16& p0, f32x16& p1, float& m_reg, float& mn, float& alpha) {
    float pmax = p0[0];
#pragma unroll
    for (int r = 1; r < 16; ++r) pmax = fmaxf(pmax, p0[r]);
#pragma unroll
    for (int r = 0; r < 16; ++r) pmax = fmaxf(pmax, p1[r]);
    { auto rr = __builtin_amdgcn_permlane32_swap(__float_as_uint(pmax), __float_as_uint(pmax), false, false); pmax = fmaxf(__uint_as_float(rr[0]), __uint_as_float(rr[1])); }
    if (__builtin_expect(__all(pmax - m_reg <= THR), 1)) { mn = m_reg; alpha = 1.f; }
    else { mn = fmaxf(m_reg, pmax); alpha = __builtin_amdgcn_exp2f(m_reg - mn); m_reg = mn; }
#pragma unroll
    for (int r = 0; r < 16; ++r) { p0[r] -= mn; p1[r] -= mn; }
#pragma unroll
    for (int r = 0; r < 16; ++r) p0[r] = __builtin_amdgcn_exp2f(p0[r]);
}
__device__ __forceinline__ void finishSM(f32x16& p0, f32x16& p1, float alpha, float& l_reg, bf16x8& pa0, bf16x8& pa1, bf16x8& pa2, bf16x8& pa3) {
#pragma unroll
    for (int r = 0; r < 16; ++r) p1[r] = __builtin_amdgcn_exp2f(p1[r]);
    float ps = 0;
#pragma unroll
    for (int r = 0; r < 16; ++r) ps += p0[r];
#pragma unroll
    for (int r = 0; r < 16; ++r) ps += p1[r];
    { auto rr = __builtin_amdgcn_permlane32_swap(__float_as_uint(ps), __float_as_uint(ps), false, false); ps = __uint_as_float(rr[0]) + __uint_as_float(rr[1]); }
    l_reg = l_reg * alpha + ps;
#define ATT_PK4(P, BASE, OUT) do { unsigned a0 = cvt_pk_bf16(P[BASE + 0], P[BASE + 1]), a1 = cvt_pk_bf16(P[BASE + 2], P[BASE + 3]);   \
    unsigned b0 = cvt_pk_bf16(P[BASE + 4], P[BASE + 5]), b1 = cvt_pk_bf16(P[BASE + 6], P[BASE + 7]);                              \
    auto r0 = __builtin_amdgcn_permlane32_swap(a0, b0, false, false); auto r1 = __builtin_amdgcn_permlane32_swap(a1, b1, false, false); \
    u32x4 w = {r0[0], r1[0], r0[1], r1[1]}; OUT = *reinterpret_cast<bf16x8*>(&w); } while (0)
    ATT_PK4(p0, 0, pa0); ATT_PK4(p0, 8, pa1); ATT_PK4(p1, 0, pa2); ATT_PK4(p1, 8, pa3);
#undef ATT_PK4
}
template <int DQK> __device__ __forceinline__ void qkt(f32x16& p0, f32x16& p1, const char* Ks, const bf16x8* qr, int r32, int hi) {
    p0 = f32x16{}; p1 = f32x16{};
#pragma unroll
    for (int d0 = 0; d0 < DQK / 16; ++d0) { const int cb = (d0 * 16 + hi * 8) * 2;
        const bf16x8 b0 = *reinterpret_cast<const bf16x8*>(Ks + kswz<DQK>(r32, cb));
        const bf16x8 b1 = *reinterpret_cast<const bf16x8*>(Ks + kswz<DQK>(32 + r32, cb));
        p0 = __builtin_amdgcn_mfma_f32_32x32x16_bf16(b0, qr[d0], p0, 0, 0, 0);
        p1 = __builtin_amdgcn_mfma_f32_32x32x16_bf16(b1, qr[d0], p1, 0, 0, 0); }
}
template <int DV, int D0> __device__ __forceinline__ void pv_one(f32x16& od, int vb, bf16x8 pa0, bf16x8 pa1, bf16x8 pa2, bf16x8 pa3) {
    const s16x4 l0 = tr_read<v_rd_off<DV>(D0, 0, 0)>(vb), h0 = tr_read<v_rd_off<DV>(D0, 0, 1)>(vb), l1 = tr_read<v_rd_off<DV>(D0, 1, 0)>(vb), h1 = tr_read<v_rd_off<DV>(D0, 1, 1)>(vb);
    const s16x4 l2 = tr_read<v_rd_off<DV>(D0, 2, 0)>(vb), h2 = tr_read<v_rd_off<DV>(D0, 2, 1)>(vb), l3 = tr_read<v_rd_off<DV>(D0, 3, 0)>(vb), h3 = tr_read<v_rd_off<DV>(D0, 3, 1)>(vb);
    asm volatile("s_waitcnt lgkmcnt(0)" ::: "memory"); ATT_SBAR();
#define ATT_PK(L, H) (bf16x8){L[0], L[1], L[2], L[3], H[0], H[1], H[2], H[3]}
    od = __builtin_amdgcn_mfma_f32_32x32x16_bf16(pa0, ATT_PK(l0, h0), od, 0, 0, 0);
    od = __builtin_amdgcn_mfma_f32_32x32x16_bf16(pa1, ATT_PK(l1, h1), od, 0, 0, 0);
    od = __builtin_amdgcn_mfma_f32_32x32x16_bf16(pa2, ATT_PK(l2, h2), od, 0, 0, 0);
    od = __builtin_amdgcn_mfma_f32_32x32x16_bf16(pa3, ATT_PK(l3, h3), od, 0, 0, 0);
#undef ATT_PK
}
template <int DV> __device__ __forceinline__ void pv_all(f32x16 (&o)[DV / 32], int vb, bf16x8 pa0, bf16x8 pa1, bf16x8 pa2, bf16x8 pa3) {
    pv_one<DV, 0>(o[0], vb, pa0, pa1, pa2, pa3); pv_one<DV, 1>(o[1], vb, pa0, pa1, pa2, pa3);
    if constexpr (DV == 128) { pv_one<DV, 2>(o[2], vb, pa0, pa1, pa2, pa3); pv_one<DV, 3>(o[3], vb, pa0, pa1, pa2, pa3); }
}
template <int DQK, int DV> struct Lay { static constexpr int SHM_V = 64 * DV * 2, SHM_K = 64 * DQK * 2, OFF_V = 0, OFF_K = 2 * SHM_V, OFF_WS = OFF_K + 2 * SHM_K, OFF_STASH = OFF_WS + NW * 64 * 4; };

template <int DQK, int DV, int LDQ, int LDK, int LDV>
__device__ __forceinline__ void attn_pass(const bf16_t* __restrict__ Qb, const bf16_t* __restrict__ Kh, const bf16_t* __restrict__ Vh, int nkeys, char* lds, f32x16 (&o)[DV / 32], float (&rli)[16]) {
    using L = Lay<DQK, DV>;
    constexpr int NLK = DQK / 64, NLV = DV / 64;
    int tid_ = threadIdx.x; asm volatile("" : "+v"(tid_));
    const int tid = tid_, wid = tid >> 6, lane = tid & 63, r32 = lane & 31, hi = lane >> 5;
    char* V_lds = lds + L::OFF_V; char* K_lds = lds + L::OFF_K;
    float* ws = (float*)(lds + L::OFF_WS) + wid * 64; float* li_l = ws; float* al_l = ws + 32;
    float m_reg = -1e30f, l_reg = 0.f; bf16x8 qr[DQK / 16];
#pragma unroll
    for (int d = 0; d < DV / 32; ++d) o[d] = f32x16{};
    const bf16_t* Qw = Qb + (size_t)(wid * QBLK + r32) * LDQ + hi * 8;
#pragma unroll
    for (int d0 = 0; d0 < DQK / 16; ++d0) qr[d0] = *reinterpret_cast<const bf16x8*>(Qw + d0 * 16);
    const int krow = DQK == 128 ? (tid >> 4) : (tid >> 3), kcol = DQK == 128 ? (tid & 15) * 8 : (tid & 7) * 8;
    const int vrow = DV == 128 ? (tid >> 4) : (tid >> 3), vcol = DV == 128 ? (tid & 15) * 8 : (tid & 7) * 8;
    const int vb0 = (int)(uintptr_t)V_lds + v_rd_base(lane);
    bf16x8 vsE[NLV], ksE[NLK], vsO[NLV], ksO[NLK];
#define ATT_SLOAD(VS, KS, k0) do { _Pragma("unroll") for (int i_ = 0; i_ < NLV; ++i_) VS[i_] = *reinterpret_cast<const bf16x8*>(&Vh[(size_t)((k0) + vrow + 32 * i_) * LDV + vcol]); \
    _Pragma("unroll") for (int i_ = 0; i_ < NLK; ++i_) KS[i_] = *reinterpret_cast<const bf16x8*>(&Kh[(size_t)((k0) + krow + 32 * i_) * LDK + kcol]); } while (0)
#define ATT_SWRITE(b, VS, KS) do { _Pragma("unroll") for (int i_ = 0; i_ < NLV; ++i_) *(bf16x8*)(V_lds + (b) * L::SHM_V + v_st<DV>(vrow + 32 * i_, vcol)) = VS[i_]; \
    _Pragma("unroll") for (int i_ = 0; i_ < NLK; ++i_) *(bf16x8*)(K_lds + (b) * L::SHM_K + kswz<DQK>(krow + 32 * i_, kcol * 2)) = KS[i_]; } while (0)
#define ATT_SWAIT() do { if constexpr (NLK + NLV == 4) asm volatile("s_waitcnt vmcnt(4)" ::: "memory"); else if constexpr (NLK + NLV == 3) asm volatile("s_waitcnt vmcnt(3)" ::: "memory"); else asm volatile("s_waitcnt vmcnt(2)" ::: "memory"); } while (0)
#define ATT_RESC(a) do { if (__any((a) < 1.f)) { if (hi == 0) al_l[r32] = (a); asm volatile("s_waitcnt lgkmcnt(0)" ::: "memory"); \
    _Pragma("unroll") for (int d = 0; d < DV / 32; ++d) _Pragma("unroll") for (int r = 0; r < 16; ++r) o[d][r] *= al_l[crow(r, hi)]; } } while (0)
    f32x16 pA0, pA1, pB0, pB1; float mnA, mnB, alA, alB; bf16x8 pa0, pa1, pa2, pa3; const int NT = nkeys / KVBLK;
    __syncthreads();
    ATT_SLOAD(vsE, ksE, 0); asm volatile("s_waitcnt vmcnt(0)" ::: "memory"); ATT_SWRITE(0, vsE, ksE); __syncthreads();
    qkt<DQK>(pA0, pA1, K_lds, qr, r32, hi); partialSM(pA0, pA1, m_reg, mnA, alA);
    ATT_SLOAD(vsO, ksO, KVBLK); if (2 < NT) ATT_SLOAD(vsE, ksE, 2 * KVBLK);
    ATT_SWAIT(); ATT_SWRITE(1, vsO, ksO); __syncthreads();
    for (int j = 1; j + 1 < NT; j += 2) {
        ATT_SBAR(); qkt<DQK>(pB0, pB1, K_lds + L::SHM_K, qr, r32, hi);
        finishSM(pA0, pA1, alA, l_reg, pa0, pa1, pa2, pa3); ATT_SBAR();
        ATT_SLOAD(vsO, ksO, (j + 2) * KVBLK); ATT_SBAR();
        pv_all<DV>(o, vb0, pa0, pa1, pa2, pa3); partialSM(pB0, pB1, m_reg, mnB, alB);
        __syncthreads(); ATT_SWAIT(); ATT_SWRITE(0, vsE, ksE);
        ATT_RESC(alB); __syncthreads();
        ATT_SBAR(); qkt<DQK>(pA0, pA1, K_lds, qr, r32, hi);
        finishSM(pB0, pB1, alB, l_reg, pa0, pa1, pa2, pa3); ATT_SBAR();
        if (j + 3 < NT) ATT_SLOAD(vsE, ksE, (j + 3) * KVBLK); ATT_SBAR();
        pv_all<DV>(o, vb0 + L::SHM_V, pa0, pa1, pa2, pa3); partialSM(pA0, pA1, m_reg, mnA, alA);
        __syncthreads(); ATT_SWAIT(); ATT_SWRITE(1, vsO, ksO);
        ATT_RESC(alA); __syncthreads();
    }
    ATT_SBAR(); qkt<DQK>(pB0, pB1, K_lds + L::SHM_K, qr, r32, hi);
    finishSM(pA0, pA1, alA, l_reg, pa0, pa1, pa2, pa3); ATT_SBAR();
    pv_all<DV>(o, vb0, pa0, pa1, pa2, pa3); partialSM(pB0, pB1, m_reg, mnB, alB);
    __syncthreads(); ATT_RESC(alB);
    finishSM(pB0, pB1, alB, l_reg, pa0, pa1, pa2, pa3); ATT_SBAR();
    pv_all<DV>(o, vb0 + L::SHM_V, pa0, pa1, pa2, pa3);
    if (hi == 0) li_l[r32] = l_reg; asm volatile("s_waitcnt lgkmcnt(0)" ::: "memory");
#pragma unroll
    for (int r = 0; r < 16; ++r) rli[r] = __builtin_amdgcn_rcpf(li_l[crow(r, hi)]);
#undef ATT_SLOAD
#undef ATT_SWRITE
#undef ATT_SWAIT
#undef ATT_RESC
}
template <int DV, int LDO> __device__ __forceinline__ void store_o(bf16_t* Ob, const f32x16 (&o)[DV / 32], const float (&rli)[16]) {
    int tid_ = threadIdx.x; asm volatile("" : "+v"(tid_));
    const int tid = tid_, wid = tid >> 6, lane = tid & 63, r32 = lane & 31, hi = lane >> 5;
    bf16_t* Ow = Ob + (size_t)(wid * QBLK) * LDO;
#pragma unroll
    for (int r = 0; r < 16; ++r) { const int orow = crow(r, hi);
#pragma unroll
        for (int d0 = 0; d0 < DV / 32; ++d0) Ow[(size_t)orow * LDO + d0 * 32 + r32] = f2bf(o[d0][r] * rli[r]); }
}
__device__ __forceinline__ void unit_a(const bf16_t* PROJ, bf16_t* OBR, int b, int h, int qb, float lam, float lam_init, const float* subg, char* lds) {
    using L = Lay<64, 128>;
    int tid_ = threadIdx.x; asm volatile("" : "+v"(tid_));
    const int tid = tid_, wid = tid >> 6, lane = tid & 63, r32 = lane & 31, hi = lane >> 5;
    const bf16_t* kv = PROJ + (size_t)b * SEQ * D_IN; const size_t qrow = (size_t)b * SEQ + qb * 256;
    unsigned* stash = (unsigned*)(lds + L::OFF_STASH) + wid * 2048 + lane;
    f32x16 o[4]; float rli[16];
#pragma unroll 1
    for (int c = 0; c < 2; ++c) {
        attn_pass<64, 128, D_IN, D_IN, D_IN>(PROJ + qrow * D_IN + C_AQ + h * 128 + c * 64, kv + C_AK + h * 128 + c * 64, kv + C_AV + h * 128, SEQ, lds, o, rli);
        if (c == 0) {
#pragma unroll
            for (int d0 = 0; d0 < 4; ++d0)
#pragma unroll
                for (int r = 0; r < 16; r += 2) stash[(d0 * 8 + (r >> 1)) * 64] = cvt_pk_bf16(o[d0][r] * rli[r], o[d0][r + 1] * rli[r + 1]);
        }
    }
    asm volatile("s_waitcnt lgkmcnt(0)" ::: "memory");
    float ss[16];
#pragma unroll
    for (int r = 0; r < 16; ++r) ss[r] = 0.f;
#pragma unroll
    for (int d0 = 0; d0 < 4; ++d0)
#pragma unroll
        for (int r = 0; r < 16; r += 2) { const unsigned w = stash[(d0 * 8 + (r >> 1)) * 64];
            const float c0 = __uint_as_float(w << 16) - lam * o[d0][r] * rli[r], c1 = __uint_as_float(w & 0xffff0000u) - lam * o[d0][r + 1] * rli[r + 1];
            o[d0][r] = c0; o[d0][r + 1] = c1; ss[r] += c0 * c0; ss[r + 1] += c1 * c1; }
#pragma unroll
    for (int r = 0; r < 16; ++r) { float s = ss[r]; s += __shfl_xor(s, 1); s += __shfl_xor(s, 2); s += __shfl_xor(s, 4); s += __shfl_xor(s, 8); s += __shfl_xor(s, 16);
        ss[r] = rsqrtf(s * (1.f / 128.f) + EPS) * (1.f - lam_init); }
    bf16_t* Ow = OBR + (qrow + wid * QBLK) * OBR_W + h * 128;
#pragma unroll
    for (int d0 = 0; d0 < 4; ++d0) { const float g = subg[d0 * 32 + r32];
#pragma unroll
        for (int r = 0; r < 16; ++r) Ow[(size_t)crow(r, hi) * OBR_W + d0 * 32 + r32] = f2bf(o[d0][r] * ss[r] * g); }
}
__device__ __forceinline__ void unit_b(const bf16_t* PROJ, bf16_t* OBR, int b, int qh, int qb, char* lds) {
    const bf16_t* kv = PROJ + (size_t)b * SEQ * D_IN; const size_t qrow = (size_t)b * SEQ + qb * 256;
    f32x16 o[2]; float rli[16];
    attn_pass<64, 64, D_IN, D_IN, D_IN>(PROJ + qrow * D_IN + C_BQ + qh * 64, kv + C_BK + (qh >> 2) * 64, kv + C_BV + (qh >> 2) * 64, SEQ, lds, o, rli);
    store_o<64, OBR_W>(OBR + qrow * OBR_W + 512 + qh * 64, o, rli);
}
__device__ __forceinline__ void unit_c(const bf16_t* PROJ, const bf16_t* MEMKV, bf16_t* OBR, int b, int h, int qb, char* lds) {
    const bf16_t* kv = MEMKV + (size_t)b * MEM_LEN * 1024; const size_t qrow = (size_t)b * SEQ + qb * 256;
    f32x16 o[4]; float rli[16];
    attn_pass<128, 128, D_IN, 1024, 1024>(PROJ + qrow * D_IN + C_CQ + h * 128, kv + h * 128, kv + 512 + h * 128, MEM_LEN, lds, o, rli);
    store_o<128, OBR_W>(OBR + qrow * OBR_W + 1024 + h * 128, o, rli);
}
#undef ATT_SBAR
}

__device__ __forceinline__ void row_rmsnorm(const float* __restrict__ xrow, const float* __restrict__ g, bf16_t* __restrict__ orow, float* __restrict__ xcopy, int lane) {
    const f32x4* xr = (const f32x4*)xrow; f32x4 v[4]; float s = 0.f;
#pragma unroll
    for (int j = 0; j < 4; ++j) { v[j] = xr[lane + 64 * j]; s += v[j].x * v[j].x + v[j].y * v[j].y + v[j].z * v[j].z + v[j].w * v[j].w; }
    const float rs = rsqrtf(wave_sum(s) * (1.f / DM) + EPS);
#pragma unroll
    for (int j = 0; j < 4; ++j) { const f32x4 gg = ((const f32x4*)g)[lane + 64 * j];
        if (xcopy) ((f32x4*)xcopy)[lane + 64 * j] = v[j];
        u32x2 o; o.x = cvt_pk_bf16(v[j].x * rs * gg.x, v[j].y * rs * gg.y); o.y = cvt_pk_bf16(v[j].z * rs * gg.z, v[j].w * rs * gg.w);
        ((u32x2*)orow)[lane + 64 * j] = o; }
}
__device__ __forceinline__ void route_block(const float* __restrict__ X, const bf16_t* __restrict__ rt_tab, const float* __restrict__ brg, const float* __restrict__ bre, int* __restrict__ experts, float* __restrict__ weights,
                                            int* __restrict__ rank, unsigned* __restrict__ cnt, float* __restrict__ rstd, int rb, const bf16x8 (&Bh)[3][4], const bf16x8 (&Bl)[3][4], LAS float* slab, int tid, int wave) {
    const int lane = tid & 63, r = lane & 15, kq = lane >> 4;
    LAS float* ssq = slab + 8 * 64 * 48;
#pragma unroll 1
    for (int rt = 0; rt < 4; ++rt) {
        const float* xp = X + (size_t)(rb * 64 + rt * 16 + r) * DM + 128 * wave + 8 * kq;
        f32x4 acc[3]; float ss = 0.f;
#pragma unroll
        for (int t = 0; t < 3; ++t) acc[t] = (f32x4){0.f, 0.f, 0.f, 0.f};
#pragma unroll
        for (int sI = 0; sI < 4; ++sI) {
            const f32x4 a0 = *(const f32x4*)(xp + 32 * sI), a1 = *(const f32x4*)(xp + 32 * sI + 4);
            ss += (a0[0] * a0[0] + a0[1] * a0[1]) + (a0[2] * a0[2] + a0[3] * a0[3]) + (a1[0] * a1[0] + a1[1] * a1[1]) + (a1[2] * a1[2] + a1[3] * a1[3]);
            u32x4 hw, lw;
            hw.x = cvt_pk_bf16(a0[0], a0[1]); hw.y = cvt_pk_bf16(a0[2], a0[3]); hw.z = cvt_pk_bf16(a1[0], a1[1]); hw.w = cvt_pk_bf16(a1[2], a1[3]);
            lw.x = cvt_pk_bf16(a0[0] - __uint_as_float(hw.x << 16), a0[1] - __uint_as_float(hw.x & 0xffff0000u)); lw.y = cvt_pk_bf16(a0[2] - __uint_as_float(hw.y << 16), a0[3] - __uint_as_float(hw.y & 0xffff0000u));
            lw.z = cvt_pk_bf16(a1[0] - __uint_as_float(hw.z << 16), a1[1] - __uint_as_float(hw.z & 0xffff0000u)); lw.w = cvt_pk_bf16(a1[2] - __uint_as_float(hw.w << 16), a1[3] - __uint_as_float(hw.w & 0xffff0000u));
            const bf16x8 Ah = __builtin_bit_cast(bf16x8, hw), Al = __builtin_bit_cast(bf16x8, lw);
#pragma unroll
            for (int t = 0; t < 3; ++t) {
                acc[t] = __builtin_amdgcn_mfma_f32_16x16x32_bf16(Ah, Bh[t][sI], acc[t], 0, 0, 0);
                acc[t] = __builtin_amdgcn_mfma_f32_16x16x32_bf16(Al, Bh[t][sI], acc[t], 0, 0, 0);
                acc[t] = __builtin_amdgcn_mfma_f32_16x16x32_bf16(Ah, Bl[t][sI], acc[t], 0, 0, 0);
            }
        }
        ss += __shfl_xor(ss, 16); ss += __shfl_xor(ss, 32);
        if (kq == 0) ssq[wave * 64 + rt * 16 + r] = ss;
#pragma unroll
        for (int t = 0; t < 3; ++t)
#pragma unroll
            for (int e = 0; e < 4; ++e) slab[(wave * 64 + rt * 16 + 4 * kq + e) * 48 + 16 * t + r] = acc[t][e];
    }
    __syncthreads();
    if (tid < 64) {
        const int row = rb * 64 + tid;
        float lg[36]; float ss = 0.f;
#pragma unroll
        for (int c = 0; c < 36; ++c) lg[c] = 0.f;
#pragma unroll 1
        for (int w = 0; w < 8; ++w) { ss += ssq[w * 64 + tid];
#pragma unroll
            for (int c = 0; c < 36; ++c) lg[c] += slab[(w * 64 + tid) * 48 + c]; }
        const float rs = rsqrtf(ss * (1.f / DM) + EPS);
        rstd[row] = rs;
        int gi = 0; float gm = lg[0] * rs + brg[0];
#pragma unroll
        for (int i = 1; i < 4; ++i) { const float l = lg[i] * rs + brg[i]; if (l > gm) { gm = l; gi = i; } }
        float gs = 0.f;
#pragma unroll
        for (int i = 0; i < 4; ++i) gs += __expf(lg[i] * rs + brg[i] - gm);
        const float gp = 1.f / gs;
        float el[8];
#pragma unroll
        for (int i = 0; i < 8; ++i) el[i] = 0.f;
#pragma unroll
        for (int gq = 0; gq < 4; ++gq) if (gq == gi) {
#pragma unroll
            for (int i = 0; i < 8; ++i) el[i] = lg[4 + gq * 8 + i] * rs + bre[gq * 8 + i]; }
        int i0 = 0; float l0 = el[0];
#pragma unroll
        for (int i = 1; i < 8; ++i) if (el[i] > l0) { l0 = el[i]; i0 = i; }
        int i1 = -1; float l1 = -INFINITY;
#pragma unroll
        for (int i = 0; i < 8; ++i) if (i != i0 && el[i] > l1) { l1 = el[i]; i1 = i; }
        const float p1 = __expf(l1 - l0), inv = 1.f / (1.f + p1);
        const int e0 = gi * 8 + i0, e1 = gi * 8 + i1;
        experts[row * 2] = e0; experts[row * 2 + 1] = e1;
        weights[row * 2] = gp * inv; weights[row * 2 + 1] = gp * p1 * inv;
        rank[row * 2] = (int)atomicAdd(cnt + e0, 1u); rank[row * 2 + 1] = (int)atomicAdd(cnt + e1, 1u);
    }
    __syncthreads();
}
__device__ __forceinline__ void row_combine_norm(float* __restrict__ X, const bf16_t* __restrict__ YB, const int* __restrict__ dest, const float* __restrict__ g, bf16_t* __restrict__ H, float* __restrict__ OUT, int row, int lane, bool poison) {
    const int d0 = dest[row * 2], d1 = dest[row * 2 + 1];
    f32x4* xr = (f32x4*)(X + (size_t)row * DM);
    f32x4 v[4]; float s = 0.f;
#pragma unroll
    for (int j = 0; j < 4; ++j) { v[j] = xr[lane + 64 * j];
        const u32x2 a = ((const u32x2*)(YB + (size_t)d0 * DM))[lane + 64 * j], b = ((const u32x2*)(YB + (size_t)d1 * DM))[lane + 64 * j];
        v[j].x += __uint_as_float(a.x << 16) + __uint_as_float(b.x << 16); v[j].y += __uint_as_float(a.x & 0xffff0000u) + __uint_as_float(b.x & 0xffff0000u);
        v[j].z += __uint_as_float(a.y << 16) + __uint_as_float(b.y << 16); v[j].w += __uint_as_float(a.y & 0xffff0000u) + __uint_as_float(b.y & 0xffff0000u);
        s += v[j].x * v[j].x + v[j].y * v[j].y + v[j].z * v[j].z + v[j].w * v[j].w; }
    float rs = rsqrtf(wave_sum(s) * (1.f / DM) + EPS);
    if (poison) rs = __builtin_nanf("");
#pragma unroll
    for (int j = 0; j < 4; ++j) { const f32x4 gg = ((const f32x4*)g)[lane + 64 * j];
        if (H) { xr[lane + 64 * j] = v[j];
            u32x2 o; o.x = cvt_pk_bf16(v[j].x * rs * gg.x, v[j].y * rs * gg.y); o.y = cvt_pk_bf16(v[j].z * rs * gg.z, v[j].w * rs * gg.w);
            ((u32x2*)(H + (size_t)row * DM))[lane + 64 * j] = o; }
        else { f32x4 o; o.x = v[j].x * rs * gg.x; o.y = v[j].y * rs * gg.y; o.z = v[j].z * rs * gg.z; o.w = v[j].w * rs * gg.w; ((f32x4*)(OUT + (size_t)row * DM))[lane + 64 * j] = o; }
    }
}
__device__ __forceinline__ void p0_transpose_item(const float* __restrict__ W, int ldw, int src_col0, int k0, int K, bf16_t* __restrict__ WT, int dst_row0, LAS float* scr, int lane) {
#pragma unroll 8
    for (int i = 0; i < 32; ++i) { const int kk = 2 * i + (lane >> 5); scr[kk * 33 + (lane & 31)] = W[(size_t)(k0 + kk) * ldw + src_col0 + (lane & 31)]; }
    asm volatile("s_waitcnt lgkmcnt(0)" ::: "memory");
    const int c = lane & 7;
#pragma unroll
    for (int j = 0; j < 4; ++j) { const int n = (lane >> 3) + 8 * j; const LAS float* s = scr + (8 * c) * 33 + n;
        u32x4 o; o.x = cvt_pk_bf16(s[0 * 33], s[1 * 33]); o.y = cvt_pk_bf16(s[2 * 33], s[3 * 33]); o.z = cvt_pk_bf16(s[4 * 33], s[5 * 33]); o.w = cvt_pk_bf16(s[6 * 33], s[7 * 33]);
        *(u32x4*)(WT + (size_t)(dst_row0 + n) * K + k0 + 8 * c) = o; }
    asm volatile("s_waitcnt lgkmcnt(0)" ::: "memory");
}

#define XB_TMO      128
#define XB_XCNT(j)  (256  + 64 * (j))
#define XB_XSUB(j)  (1280 + 64 * (j))
#define XB_XGEN(j)  (2304 + 64 * (j))
#define XB_TOP      3328
#define XB_TOPGEN   3392
#define XCD_BAR_WORDS 3456
#define XB_SPIN_CAP (1u << 18)

__device__ __forceinline__ unsigned xb_ld(unsigned* p)              { return __hip_atomic_load(p, __ATOMIC_RELAXED, __HIP_MEMORY_SCOPE_AGENT); }
__device__ __forceinline__ unsigned xb_add(unsigned* p, unsigned v) { return __hip_atomic_fetch_add(p, v, __ATOMIC_RELAXED, __HIP_MEMORY_SCOPE_AGENT); }
__device__ __forceinline__ unsigned xb_xcc_id() { return (unsigned)__builtin_amdgcn_s_getreg((3 << 11) | 20) & 0xFu; }
#define XB_SPIN(cond, bar) do { unsigned _sp = 0; while (cond) { __builtin_amdgcn_s_sleep(1); \
    if ((++_sp & 255u) == 0u) { if (xb_ld(&(bar)[XB_TMO])) break; if (_sp > XB_SPIN_CAP) { atomicAdd(&(bar)[XB_TMO], 1u); break; } } } } while (0)

struct XcdBarrier {
    unsigned* bar; unsigned x;
    volatile LAS unsigned* st;
};

__device__ __forceinline__ XcdBarrier xcd_barrier_post(unsigned* bar, volatile LAS unsigned* st) {
    XcdBarrier b; b.bar = bar; b.x = xb_xcc_id(); b.st = st;
    if (threadIdx.x == 0) (void)xb_add(&bar[XB_XCNT(b.x)], 1u);
    return b;
}
__device__ __forceinline__ void xcd_barrier_complete(unsigned* bar, unsigned x, unsigned& nloc, unsigned& nx) {
    const unsigned G = gridDim.x * gridDim.y * gridDim.z;
    unsigned sum, cnt, mine, sp = 0u;
    for (;;) {
        sum = 0u; cnt = 0u; mine = 0u;
#pragma unroll
        for (unsigned j = 0; j < 16; ++j) { const unsigned c = xb_ld(&bar[XB_XCNT(j)]); sum += c; cnt += (c > 0u) ? 1u : 0u; mine = (j == x) ? c : mine; }
        if (sum == G) break;
        __builtin_amdgcn_s_sleep(1);
        if ((++sp & 255u) == 0u) { if (xb_ld(&bar[XB_TMO])) break; if (sp > XB_SPIN_CAP) { atomicAdd(&bar[XB_TMO], 1u); break; } }
    }
    nloc = mine > 0u ? mine : 1u; nx = cnt > 0u ? cnt : 1u;
}

__device__ __forceinline__ void xcd_barrier(const XcdBarrier& b) {
    asm volatile("s_waitcnt vmcnt(0)" ::: "memory");
    __syncthreads();
    if (threadIdx.x == 0) {
        unsigned* bar = b.bar;
        __builtin_amdgcn_s_waitcnt(0);
        unsigned nloc = b.st[0], nx = b.st[1];
        if (nloc == 0u) { xcd_barrier_complete(bar, b.x, nloc, nx); b.st[0] = nloc; b.st[1] = nx; }
        const unsigned old = xb_add(&bar[XB_XSUB(b.x)], 1u);
        const unsigned gen = old / nloc;
        if (old + 1u == (gen + 1u) * nloc) {
            __builtin_amdgcn_fence(__ATOMIC_RELEASE, "agent");
            asm volatile("s_waitcnt vmcnt(0)" ::: "memory");
            const unsigned og = xb_add(&bar[XB_TOP], 1u);
            const unsigned tg = og / nx;
            if (og + 1u == (tg + 1u) * nx) xb_add(&bar[XB_TOPGEN], 1u);
            else XB_SPIN(xb_ld(&bar[XB_TOPGEN]) == tg, bar);
            __builtin_amdgcn_fence(__ATOMIC_ACQUIRE, "agent");
            xb_add(&bar[XB_XGEN(b.x)], 1u);
            asm volatile("s_waitcnt vmcnt(0)" ::: "memory");
        } else {
            XB_SPIN(xb_ld(&bar[XB_XGEN(b.x)]) == gen, bar);
            __builtin_amdgcn_fence(__ATOMIC_ACQUIRE, "agent");
            asm volatile("s_waitcnt vmcnt(0)" ::: "memory");
        }
    }
    __syncthreads();
}
constexpr int NWAVES = 8;
constexpr int RING_BYTES = 131072, LDSCTL_OFF = RING_BYTES, LDS_BYTES = 147456;
constexpr int CW_BAR = 4096, BAR_REGION = 4096;
static_assert(XCD_BAR_WORDS <= BAR_REGION && (CW_BAR + (N_PHASES + 1) * BAR_REGION) * 4 <= (int)MiB, "barrier regions inside the memset region");
static_assert(pg8::STAGE_BYTES <= RING_BYTES && att::Lay<64, 128>::OFF_STASH + 65536 <= RING_BYTES && att::Lay<128, 128>::OFF_WS + 2048 <= RING_BYTES, "LDS map");

struct Args { const float* in[26]; float* out; unsigned char* ws; int ph_lo, ph_hi, li, pad; };

__global__ void __launch_bounds__(NWAVES * 64, 2) mk_fwd(Args args) {
    extern __shared__ __attribute__((aligned(16))) unsigned char lds[];
    const int tid0 = threadIdx.x, lane0 = tid0 & 63, wave = __builtin_amdgcn_readfirstlane(tid0 >> 6);
    const int G = gridDim.x, bx = blockIdx.x, vcu = (G % 8 == 0) ? (bx % 8) * (G / 8) + bx / 8 : bx;
    LAS unsigned char* ldsl = (LAS unsigned char*)lds;
    volatile LAS unsigned* MISC = (volatile LAS unsigned*)(ldsl + LDSCTL_OFF);
    for (int u = tid0; u < (LDS_BYTES - LDSCTL_OFF) / 4; u += NWAVES * 64) ((LAS unsigned*)(ldsl + LDSCTL_OFF))[u] = 0u;
    __syncthreads();
    unsigned char* ws = args.ws;
    unsigned* ctl = (unsigned*)(ws + WS_CTL);
    XcdBarrier bar = xcd_barrier_post(ctl + CW_BAR + args.li * BAR_REGION, MISC + 8);
    const float* x = args.in[0]; const float* mem = args.in[1]; const float* mem_g = args.in[2]; const float* w_memkv = args.in[3];
    const float* norm1_g = args.in[4]; const float* w_in = args.in[5];
    const float* lq1 = args.in[6]; const float* lk1 = args.in[7]; const float* lq2 = args.in[8]; const float* lk2 = args.in[9];
    const float* subln_g = args.in[10]; const float* qn_g = args.in[11]; const float* kn_g = args.in[12];
    const float* w_out = args.in[16];
    const float* norm2_g = args.in[17]; const float* w_rg = args.in[18]; const float* b_rg = args.in[19]; const float* w_re = args.in[20]; const float* b_re = args.in[21];
    const float* w_eg = args.in[22]; const float* w_eu = args.in[23]; const float* w_ed = args.in[24]; const float* final_g = args.in[25];
    float* X = args.out;
    bf16_t* MEMKV = (bf16_t*)(ws + WS_MEMKV); bf16_t* HM = (bf16_t*)(ws + WS_HM); bf16_t* PROJ = (bf16_t*)(ws + WS_PROJ); bf16_t* OBR = (bf16_t*)(ws + WS_OBR);
    bf16_t* BUF = (bf16_t*)(ws + WS_BUF); bf16_t* YB = (bf16_t*)(ws + WS_YB); bf16_t* HID = (bf16_t*)(ws + WS_HID); bf16_t* HMEM = OBR;
    bf16_t* WB = (bf16_t*)(ws + WS_WB);
    float* tab1 = (float*)(ws + WS_TAB); float* tab2 = tab1 + SEQ * 32 * 2;
    int* experts = (int*)(ws + WS_ROUTE + RT_EXP); float* weights = (float*)(ws + WS_ROUTE + RT_WGT); int* rank = (int*)(ws + WS_ROUTE + RT_RANK); int* dest = (int*)(ws + WS_ROUTE + RT_DEST);
    float* roww = (float*)(ws + WS_ROUTE + RT_ROWW); int* tile_tab = (int*)(ws + WS_ROUTE + RT_TILE); float* rstd = (float*)(ws + WS_ROUTE + RT_RSTD);
    const int gw = bx * NWAVES + wave, NGW = G * NWAVES;
    const int lo = args.ph_lo, hi = args.ph_hi;
#ifndef STAGE_MASK
#define STAGE_MASK 0x3FFu
#endif
#define IN(k) (lo <= (k) && (k) < hi)
#define ST(s) ((STAGE_MASK >> (s)) & 1u)
#ifndef REP_MASK
#define REP_MASK 0u
#endif
#define NREP(s) (((REP_MASK >> (s)) & 1u) ? 2 : 1)
#define SEAM(k) do { if (IN(k) && IN((k) + 1)) xcd_barrier(bar); } while (0)

    if (ST(0) && IN(0))
  for (int rep_ = 0; rep_ < NREP(0); ++rep_) {
        int lane = lane0, tid = tid0; asm volatile("" : "+v"(lane), "+v"(tid));
        LAS float* scr = (LAS float*)(ldsl + wave * 16384);
        for (int it = gw; it < 58112; it += NGW) {
            const float* src; int ldw, K, src_col0, dst_row0, kb; bf16_t* dst;
            if (it < 57600) {
                const int l = it / 28800; int r = it % 28800; bf16_t* WBl = WB + (size_t)l * WB_LAYER;
                if (r < 2944) { kb = r / 184; const int tb = r % 184, pn = tb >> 3, bj = (tb >> 2) & 1, wc = tb & 3; src = w_in + (size_t)l * DM * D_IN; ldw = D_IN; K = DM; src_col0 = 256 * pn + 64 * wc + 32 * bj; dst_row0 = 32 * tb; dst = WBl + WB_IN; }
                else if (r < 3712) { r -= 2944; const int i = r >> 8; r &= 255; kb = r >> 5; const int tb = r & 31; src = args.in[13 + i] + (size_t)l * 512 * DM; ldw = DM; K = 512; src_col0 = 32 * tb; dst_row0 = 32 * tb; dst = WBl + WB_UP + (size_t)i * 1024 * 512; }
                else if (r < 4224) { r -= 3712; kb = r >> 5; const int tb = r & 31; src = w_out + (size_t)l * DM * DM; ldw = DM; K = DM; src_col0 = 32 * tb; dst_row0 = 32 * tb; dst = WBl + WB_OUT; }
                else if (r < 20608) { r -= 4224; const int e = r >> 9; r &= 511; kb = r >> 5; const int tb = r & 31, pn = tb >> 3, s = (tb >> 2) & 1, jb = tb & 3;
                    src = (s ? w_eu : w_eg) + (size_t)(l * NEXP + e) * DM * DEXP; ldw = DEXP; K = DM; src_col0 = 128 * pn + 32 * jb; dst_row0 = 32 * tb; dst = WBl + WB_GU + (size_t)e * 1024 * 1024; }
                else { r -= 20608; const int e = r >> 8; r &= 255; kb = r >> 5; const int tb = r & 31; src = w_ed + (size_t)(l * NEXP + e) * DEXP * DM; ldw = DM; K = DEXP; src_col0 = 32 * tb; dst_row0 = 32 * tb; dst = WBl + WB_DN + (size_t)e * 1024 * 512; }
            } else { const int r = it - 57600; kb = r >> 5; const int tb = r & 31, pn = tb >> 3, bj = (tb >> 2) & 1, wc = tb & 3; src = w_memkv; ldw = 1024; K = DM; src_col0 = 256 * pn + 64 * wc + 32 * bj; dst_row0 = 32 * tb; dst = WB + WB_MEMKV; }
            p0_transpose_item(src, ldw, src_col0, kb * 64, K, dst, dst_row0, scr, lane);
        }
        for (int idx = bx * (NWAVES * 64) + tid; idx < SEQ * 32; idx += G * NWAVES * 64) { const int pos = idx >> 5, i = idx & 31; float s, c;
            sincosf((float)pos * inv1d(i), &s, &c); tab1[idx * 2] = c; tab1[idx * 2 + 1] = s;
            sincosf(ang2d(pos, i), &s, &c); tab2[idx * 2] = c; tab2[idx * 2 + 1] = s; }
        for (int idx = bx * (NWAVES * 64) + tid; idx < DEPTH * 48 * 1024; idx += G * NWAVES * 64) { const int l = idx / (48 * 1024), c = (idx >> 10) % 48, k = idx & 1023;
            const float w = c < 4 ? w_rg[((size_t)l * DM + k) * 4 + c] : c < 36 ? w_re[((size_t)l * DM + k) * 32 + (c - 4)] : 0.f, v = w * norm2_g[l * DM + k];
            const bf16_t h = f2bf(v); bf16_t* t = WB + WB_RT + (size_t)l * 2 * 48 * 1024 + (size_t)c * 1024 + k; t[0] = h; t[48 * 1024] = f2bf(v - bf2f(h)); }
        for (int m = gw; m < M; m += NGW) row_rmsnorm(x + (size_t)m * DM, norm1_g, HM + (size_t)m * DM, X + (size_t)m * DM, lane);
        for (int m = gw; m < MM; m += NGW) row_rmsnorm(mem + (size_t)m * DM, mem_g, HMEM + (size_t)m * DM, nullptr, lane);
    }
    SEAM(0);
#pragma unroll 1
    for (int l = 0; l < DEPTH; ++l) {
        const int pb = 1 + 9 * l;
        const bf16_t* WBl = WB + (size_t)l * WB_LAYER;
        if (ST(1) && IN(pb + 0))
      for (int rep_ = 0; rep_ < NREP(1); ++rep_) {
            pg8::Gemm g{DM, DM};
            pg8::SchedProj S{bx, G, 1472, l == 0 ? 1504 : 1472, (const char*)HM, (const char*)(WBl + WB_IN), (const char*)HMEM, (const char*)(WB + WB_MEMKV)};
            pg8::EpiProj E{PROJ, MEMKV, tab1, tab2, qn_g + l * 64, kn_g + l * 64};
            pg8::gemm_phase<pg8::EpiProj, pg8::SchedProj, true, true>(ldsl, g, S, E);
        }
        SEAM(pb + 0);
        if (ST(2) && IN(pb + 1))
      for (int rep_ = 0; rep_ < NREP(2); ++rep_) {
            int lane = lane0; asm volatile("" : "+v"(lane));
            const float lam_init = 0.8f - 0.6f * __expf(-0.3f * (float)l);
            const float lam = __expf(wave_sum(lq1[l * 64 + lane] * lk1[l * 64 + lane])) - __expf(wave_sum(lq2[l * 64 + lane] * lk2[l * 64 + lane])) + lam_init;
            for (int j = vcu; j < 256; j += G) {
#ifndef ATT_SKIP_A
                att::unit_a(PROJ, OBR, j >> 5, (j >> 3) & 3, j & 7, lam, lam_init, subln_g + l * 128, (char*)lds);
#endif
#ifndef ATT_SKIP_B
#pragma unroll 1
                for (int t = 0; t < 2; ++t) { const int idx = 2 * j + t; att::unit_b(PROJ, OBR, idx >> 6, (idx >> 3) & 7, idx & 7, (char*)lds); }
#endif
#ifndef ATT_SKIP_C
                att::unit_c(PROJ, MEMKV, OBR, j >> 5, (j >> 3) & 3, j & 7, (char*)lds);
#endif
            }
            __syncthreads();
        }
        SEAM(pb + 1);
        if (ST(3) && IN(pb + 2))
      for (int rep_ = 0; rep_ < NREP(3); ++rep_) {
            pg8::Gemm g{OBR_W, 512};
            pg8::SchedGate S{bx, G, (const char*)OBR, (const char*)(WBl + WB_UP)};
            pg8::EpiGate E{HM, PROJ};
            pg8::gemm_phase<pg8::EpiGate, pg8::SchedGate, true, true>(ldsl, g, S, E);
        }
        SEAM(pb + 2);
        if (ST(4) && IN(pb + 3)) {
            pg8::Gemm g{DM, DM};
            pg8::SchedPlain S{bx, G, M / 256, (const char*)HM, (const char*)(WBl + WB_OUT), (size_t)256 * DM * 2, (size_t)256 * DM * 2};
            pg8::EpiResid E{X};
            pg8::gemm_phase<pg8::EpiResid, pg8::SchedPlain, true, true>(ldsl, g, S, E);
        }
        SEAM(pb + 3);
        if (ST(5) && IN(pb + 4)) {
            int tid = tid0; asm volatile("" : "+v"(tid));
            const int lane = tid & 63;
            const bf16_t* tab = WB + WB_RT + (size_t)l * 2 * 48 * 1024 + (size_t)(lane & 15) * 1024 + 128 * wave + 8 * (lane >> 4);
            bf16x8 Bh[3][4], Bl[3][4];
#pragma unroll
            for (int t = 0; t < 3; ++t)
#pragma unroll
                for (int sI = 0; sI < 4; ++sI) { Bh[t][sI] = *(const bf16x8*)(tab + (size_t)t * 16 * 1024 + 32 * sI); Bl[t][sI] = *(const bf16x8*)(tab + (size_t)(48 + t * 16) * 1024 + 32 * sI); }
            for (int rb = bx; rb < M / 64; rb += G)
                route_block(X, tab, b_rg + l * 4, b_re + l * 32, experts, weights, rank, ctl + CW_CNT + 32 * l, rstd, rb, Bh, Bl, (LAS float*)ldsl, tid, wave);
        }
        SEAM(pb + 4);
        if (ST(6) && IN(pb + 5)) {
            int lane = lane0, tid = tid0; asm volatile("" : "+v"(lane), "+v"(tid));
            volatile LAS int* pst = (volatile LAS int*)(MISC + 32);
            if (tid == 0) { int off = 0, nt = 0;
                for (int e = 0; e < NEXP; ++e) { const int c = (int)__hip_atomic_load(ctl + CW_CNT + 32 * l + e, __ATOMIC_RELAXED, __HIP_MEMORY_SCOPE_AGENT), t = (c + MOE_TILE - 1) / MOE_TILE; pst[e] = off;
                    if (bx == 0) { tile_tab[260 + e] = off; for (int i = 0; i < t; ++i) tile_tab[nt + i] = e; }
                    nt += t; off += t * MOE_TILE; }
                if (bx == 0) tile_tab[256] = nt; }
            __syncthreads();
            for (int a = gw; a < 2 * M; a += NGW) { const int tok = a >> 1, e = experts[a], d = pst[e] + rank[a]; const float rs = rstd[tok];
                const f32x4* xr = (const f32x4*)(X + (size_t)tok * DM); const f32x4* gr = (const f32x4*)(norm2_g + l * DM); u32x2* dst = (u32x2*)(BUF + (size_t)d * DM);
#pragma unroll
                for (int j = 0; j < 4; ++j) { const f32x4 v = xr[lane + 64 * j], gg = gr[lane + 64 * j];
                    u32x2 o; o.x = cvt_pk_bf16(v.x * rs * gg.x, v.y * rs * gg.y); o.y = cvt_pk_bf16(v.z * rs * gg.z, v.w * rs * gg.w); dst[lane + 64 * j] = o; }
                if (lane == 0) { roww[d] = weights[a]; dest[a] = d; } }
        }
        SEAM(pb + 5);
        if (ST(7) && IN(pb + 6))
      for (int rep_ = 0; rep_ < NREP(7); ++rep_) {
            const int ntiles = __builtin_amdgcn_readfirstlane(tile_tab[256]);
            pg8::Gemm g{DM, DM};
            pg8::SchedMoe S{bx, G, ntiles, tile_tab, (const char*)BUF, (const char*)(WBl + WB_GU), (size_t)256 * DM * 2, (size_t)1024 * 1024 * 2, (size_t)256 * DM * 2};
            pg8::EpiSilu E{HID};
            pg8::gemm_phase<pg8::EpiSilu, pg8::SchedMoe, true, true>(ldsl, g, S, E);
        }
        SEAM(pb + 6);
        if (ST(8) && IN(pb + 7))
      for (int rep_ = 0; rep_ < NREP(8); ++rep_) {
            const int ntiles = __builtin_amdgcn_readfirstlane(tile_tab[256]);
            pg8::Gemm g{DEXP, DEXP};
            pg8::SchedMoe S{bx, G, ntiles, tile_tab, (const char*)HID, (const char*)(WBl + WB_DN), (size_t)256 * DEXP * 2, (size_t)1024 * 512 * 2, (size_t)256 * DEXP * 2};
            pg8::EpiRowScale E{YB, roww};
            pg8::gemm_phase<pg8::EpiRowScale, pg8::SchedMoe, true, true>(ldsl, g, S, E);
        }
        SEAM(pb + 7);
        if (ST(9) && IN(pb + 8)) {
            int lane = lane0; asm volatile("" : "+v"(lane));
            const bool last = (l == DEPTH - 1);
            const bool poison = last && (__hip_atomic_load(ctl + CW_BAR + args.li * BAR_REGION + XB_TMO, __ATOMIC_RELAXED, __HIP_MEMORY_SCOPE_AGENT) != 0u);
            for (int m = gw; m < M; m += NGW) row_combine_norm(X, YB, dest, last ? final_g : norm1_g + (l + 1) * DM, last ? nullptr : HM, X, m, lane, poison);
        }
        SEAM(pb + 8);
    }
#undef IN
#undef SEAM
}

#ifndef FAST_MASK
#define FAST_MASK 0x7FFFFu
#endif
extern "C" void kernel_launch(void* const* d_in, const int* in_sizes, int n_in, void* d_out, int out_size, void* d_ws, size_t ws_size, hipStream_t stream) {
    if (n_in != 26 || out_size != M * DM || ws_size < WS_END) { fprintf(stderr, "kernel_launch: unexpected shapes n_in %d out %d ws %zu (need %zu)\n", n_in, out_size, ws_size, (size_t)WS_END); return; }
    static int grid = 0;
    if (grid == 0) {
        int dev = 0, cus = 0;
        if (hipGetDevice(&dev) != hipSuccess || hipDeviceGetAttribute(&cus, hipDeviceAttributeMultiprocessorCount, dev) != hipSuccess) { grid = -1; return; }
        if (hipFuncSetAttribute((const void*)mk_fwd, hipFuncAttributeMaxDynamicSharedMemorySize, LDS_BYTES) != hipSuccess) { fprintf(stderr, "kernel_launch: hipFuncSetAttribute failed\n"); grid = -1; return; }
        int per_cu = 0;
        if (hipOccupancyMaxActiveBlocksPerMultiprocessor(&per_cu, (const void*)mk_fwd, NWAVES * 64, LDS_BYTES) != hipSuccess || per_cu < 1) fprintf(stderr, "kernel_launch: occupancy query says %d\n", per_cu);
        (void)hipGetLastError();
        grid = cus;
    }
    if (grid < 0) return;
    const float* x = (const float*)d_in[0]; const float* mem = (const float*)d_in[1]; const float* mem_g = (const float*)d_in[2]; const float* w_memkv = (const float*)d_in[3];
    const float* norm1_g = (const float*)d_in[4]; const float* w_in = (const float*)d_in[5];
    const float* lq1 = (const float*)d_in[6]; const float* lk1 = (const float*)d_in[7]; const float* lq2 = (const float*)d_in[8]; const float* lk2 = (const float*)d_in[9];
    const float* subln_g = (const float*)d_in[10]; const float* qn_g = (const float*)d_in[11]; const float* kn_g = (const float*)d_in[12];
    const float* w_up[3] = {(const float*)d_in[13], (const float*)d_in[14], (const float*)d_in[15]}; const float* w_out = (const float*)d_in[16];
    const float* norm2_g = (const float*)d_in[17]; const float* w_rg = (const float*)d_in[18]; const float* b_rg = (const float*)d_in[19]; const float* w_re = (const float*)d_in[20]; const float* b_re = (const float*)d_in[21];
    const float* w_eg = (const float*)d_in[22]; const float* w_eu = (const float*)d_in[23]; const float* w_ed = (const float*)d_in[24]; const float* final_g = (const float*)d_in[25];
    unsigned char* ws = (unsigned char*)d_ws; float* X = (float*)d_out;
    unsigned* ctl = (unsigned*)(ws + WS_CTL);
    bf16_t* MEMKV = (bf16_t*)(ws + WS_MEMKV); bf16_t* HM = (bf16_t*)(ws + WS_HM); bf16_t* PROJ = (bf16_t*)(ws + WS_PROJ); bf16_t* OBR = (bf16_t*)(ws + WS_OBR);
    bf16_t* BUF = (bf16_t*)(ws + WS_BUF); bf16_t* YB = (bf16_t*)(ws + WS_YB); bf16_t* HID = (bf16_t*)(ws + WS_HID);
    int* experts = (int*)(ws + WS_ROUTE + RT_EXP); float* weights = (float*)(ws + WS_ROUTE + RT_WGT); int* rank = (int*)(ws + WS_ROUTE + RT_RANK); int* dest = (int*)(ws + WS_ROUTE + RT_DEST);
    float* roww = (float*)(ws + WS_ROUTE + RT_ROWW); int* tile_tab = (int*)(ws + WS_ROUTE + RT_TILE); float* rstd = (float*)(ws + WS_ROUTE + RT_RSTD);

    (void)hipMemsetAsync(ctl, 0, MiB, stream);
    unsigned mask = FAST_MASK; if (mask) mask |= 1u;
    Args a{};
    for (int i = 0; i < 26; ++i) a.in[i] = (const float*)d_in[i];
    a.out = X; a.ws = ws;
    int li = 0;
    for (int k = 0; k < N_PHASES;) {
        if ((mask >> k) & 1u) {
            int k2 = k; while (k2 < N_PHASES && ((mask >> k2) & 1u)) ++k2;
            a.ph_lo = k; a.ph_hi = k2; a.li = li++; a.pad = 0;
            hipLaunchKernelGGL(mk_fwd, dim3(grid), dim3(NWAVES * 64), LDS_BYTES, stream, a);
            k = k2; continue;
        }
        if (k == 0) {
            (void)hipMemcpyAsync(X, x, (size_t)M * DM * 4, hipMemcpyDeviceToDevice, stream);
            s_rmsnorm<<<MM / 4, 256, 0, stream>>>(mem, mem_g, OBR, MM);
            s_rmsnorm<<<M / 4, 256, 0, stream>>>(X, norm1_g, HM, M);
        } else {
            const int l = (k - 1) / 9, s = (k - 1) % 9; const float lam_init = 0.8f - 0.6f * expf(-0.3f * (float)l);
            switch (s) {
            case 0:
                if (l == 0) { SG p{}; p.A = OBR; p.lda = DM; p.W = w_memkv; p.ldw = 1024; p.K = DM; p.mode = MD_BF16; p.O = MEMKV; p.ldo = 1024; s_gemm<<<dim3(1024 / 64, MM / 64), 256, 0, stream>>>(p); }
                { SG p{}; p.A = HM; p.lda = DM; p.W = w_in + (size_t)l * DM * D_IN; p.ldw = D_IN; p.K = DM; p.mode = MD_PROJ; p.O = PROJ; p.ldo = D_IN; p.qg = qn_g + l * 64; p.kg = kn_g + l * 64;
                  s_gemm<<<dim3(D_IN / 64, M / 64), 256, 0, stream>>>(p); }
                break;
            case 1:
                s_attn_a<<<dim3(M / 4, 4), 256, 0, stream>>>(PROJ, OBR, lq1 + l * 64, lk1 + l * 64, lq2 + l * 64, lk2 + l * 64, subln_g + l * 128, lam_init);
                s_attn_b<<<dim3(M / 4, 8), 256, 0, stream>>>(PROJ, OBR);
                s_attn_c<<<dim3(M / 4, 4), 256, 0, stream>>>(PROJ, MEMKV, OBR);
                break;
            case 2:
                for (int i = 0; i < 3; ++i) { SG p{}; p.A = OBR + 512 * i; p.lda = OBR_W; p.W = w_up[i] + (size_t)l * 512 * DM; p.ldw = DM; p.K = 512; p.mode = MD_GATE; p.O = HM; p.ldo = DM; p.G = PROJ + C_G + 1024 * i; p.ldg = D_IN; p.first = (i == 0);
                    s_gemm<<<dim3(DM / 64, M / 64), 256, 0, stream>>>(p); }
                break;
            case 3:
                { SG p{}; p.A = HM; p.lda = DM; p.W = w_out + (size_t)l * DM * DM; p.ldw = DM; p.K = DM; p.mode = MD_RESID; p.Xf = X; s_gemm<<<dim3(DM / 64, M / 64), 256, 0, stream>>>(p); }
                break;
            case 4:
                s_norm_route<<<M / 4, 256, 0, stream>>>(X, norm2_g + l * DM, HM, w_rg + (size_t)l * DM * 4, b_rg + l * 4, w_re + (size_t)l * DM * 32, b_re + l * 32, experts, weights, rank, ctl + CW_CNT + 32 * l, rstd);
                break;
            case 5:
                s_dispatch<<<1, 64, 0, stream>>>(ctl + CW_CNT + 32 * l, tile_tab);
                s_gather<<<M * 2 / 4, 256, 0, stream>>>(X, rstd, norm2_g + l * DM, experts, weights, rank, tile_tab, BUF, roww, dest);
                break;
            case 6:
                { SG p{}; p.A = BUF; p.lda = DM; p.W = w_eg + (size_t)l * NEXP * DM * DEXP; p.W2 = w_eu + (size_t)l * NEXP * DM * DEXP; p.ldw = DEXP; p.wstride = (size_t)DM * DEXP; p.tile_e = tile_tab; p.ntiles = tile_tab + 256;
                  p.K = DM; p.mode = MD_SILU; p.O = HID; p.ldo = DEXP; s_gemm<<<dim3(DEXP / 64, P_ROWS / 64), 256, 0, stream>>>(p); }
                break;
            case 7:
                { SG p{}; p.A = HID; p.lda = DEXP; p.W = w_ed + (size_t)l * NEXP * DEXP * DM; p.ldw = DM; p.wstride = (size_t)DEXP * DM; p.tile_e = tile_tab; p.ntiles = tile_tab + 256;
                  p.K = DEXP; p.mode = MD_ROWSCALE; p.O = YB; p.ldo = DM; p.roww = roww; s_gemm<<<dim3(DM / 64, P_ROWS / 64), 256, 0, stream>>>(p); }
                break;
            default:
                if (l + 1 < DEPTH) s_combine_norm<<<M / 4, 256, 0, stream>>>(X, YB, dest, norm1_g + (l + 1) * DM, HM, nullptr);
                else s_combine_norm<<<M / 4, 256, 0, stream>>>(X, YB, dest, final_g, nullptr, X);
                break;
            }
        }
        ++k;
    }
}
```

```cpp
#include <hip/hip_runtime.h>
#include <cstdint>
#include <cstdio>
#include <cmath>

typedef unsigned short bf16_t;
typedef float f32x4 __attribute__((ext_vector_type(4)));
typedef unsigned u32x4 __attribute__((ext_vector_type(4)));
typedef unsigned u32x2 __attribute__((ext_vector_type(2)));

constexpr int BATCH = 8, SEQ = 2048, DM = 1024, DEPTH = 2, MEM_LEN = 256;
constexpr int M = BATCH * SEQ;
constexpr int MM = BATCH * MEM_LEN;
constexpr int D_IN = 5888;
constexpr int C_AQ = 0, C_AK = 512, C_AV = 1024, C_BQ = 1536, C_BK = 2048, C_BV = 2176, C_CQ = 2304, C_G = 2816;
constexpr int OBR_W = 1536;
constexpr int NEXP = 32, DEXP = 512;
constexpr int MOE_TILE = 256;
constexpr int P_ROWS = M * 2 + NEXP * MOE_TILE;
constexpr int MAX_TILES = P_ROWS / MOE_TILE;
constexpr float EPS = 1e-6f;
constexpr float LOG2E = 1.4426950408889634f;
constexpr float C2_64 = 0.125f * LOG2E;
constexpr float C2_128 = 0.08838834764831845f * LOG2E;

constexpr size_t MiB = 1u << 20;
constexpr size_t WS_CTL = 0;
constexpr size_t WS_ROUTE = 1 * MiB;
constexpr size_t WS_TAB = 2 * MiB;
constexpr size_t WS_MEMKV = 3 * MiB;
constexpr size_t WS_HM = 7 * MiB;
constexpr size_t WS_PROJ = 39 * MiB;
constexpr size_t WS_OBR = 223 * MiB;
constexpr size_t WS_WB = 271 * MiB;
constexpr size_t WS_END = 499 * MiB;
constexpr size_t WS_BUF = WS_PROJ;
constexpr size_t WS_YB = WS_PROJ + 80 * MiB;
constexpr size_t WS_HID = WS_OBR;
constexpr size_t RT_EXP = 0;
constexpr size_t RT_WGT = 128 * 1024;
constexpr size_t RT_RANK = 256 * 1024;
constexpr size_t RT_DEST = 384 * 1024;
constexpr size_t RT_ROWW = 512 * 1024;
constexpr size_t RT_TILE = 700 * 1024;
constexpr size_t RT_RSTD = 768 * 1024;
constexpr int CW_CNT = 0;

__device__ __forceinline__ float bf2f(bf16_t v) { return __uint_as_float(((unsigned)v) << 16); }
__device__ __forceinline__ bf16_t f2bf(float f) { unsigned u = __float_as_uint(f); return (bf16_t)((u + 0x7fffu + ((u >> 16) & 1u)) >> 16); }
__device__ __forceinline__ float wave_sum(float v) {
#pragma unroll
    for (int o = 1; o < 64; o <<= 1) v += __shfl_xor(v, o);
    return v;
}
__device__ __forceinline__ float wave_max(float v) {
#pragma unroll
    for (int o = 1; o < 64; o <<= 1) v = fmaxf(v, __shfl_xor(v, o));
    return v;
}
__device__ __forceinline__ float inv1d(int i) { return exp2f(-(float)i * (13.287712379549449f / 32.f)); }
__device__ __forceinline__ float inv2d(int j) { return exp2f(-(float)j * (13.287712379549449f / 16.f)); }
__device__ __forceinline__ float ang2d(int pos, int i) { return i < 16 ? (float)(pos >> 6) * inv2d(i) : (float)(pos & 63) * inv2d(i - 16); }

__global__ __launch_bounds__(256) void s_rmsnorm(const float* __restrict__ X, const float* __restrict__ g, bf16_t* __restrict__ OUT, int rows) {
    const int lane = threadIdx.x & 63, row = blockIdx.x * 4 + (threadIdx.x >> 6);
    if (row >= rows) return;
    const f32x4* xr = (const f32x4*)(X + (size_t)row * DM);
    f32x4 v[4]; float s = 0.f;
#pragma unroll
    for (int j = 0; j < 4; ++j) { v[j] = xr[lane + 64 * j]; s += v[j].x * v[j].x + v[j].y * v[j].y + v[j].z * v[j].z + v[j].w * v[j].w; }
    const float rs = rsqrtf(wave_sum(s) * (1.f / DM) + EPS);
#pragma unroll
    for (int j = 0; j < 4; ++j) { const f32x4 gg = ((const f32x4*)g)[lane + 64 * j];
        u32x2 o; o.x = f2bf(v[j].x * rs * gg.x) | ((unsigned)f2bf(v[j].y * rs * gg.y) << 16); o.y = f2bf(v[j].z * rs * gg.z) | ((unsigned)f2bf(v[j].w * rs * gg.w) << 16);
        ((u32x2*)(OUT + (size_t)row * DM))[lane + 64 * j] = o; }
}

enum { MD_PROJ = 0, MD_BF16 = 1, MD_GATE = 2, MD_RESID = 3, MD_SILU = 4, MD_ROWSCALE = 5 };
struct SG {
    const bf16_t* A; int lda; const float* W; const float* W2; int ldw; size_t wstride;
    const int* tile_e; const int* ntiles;
    int K; int mode;
    bf16_t* O; int ldo;
    float* Xf;
    const bf16_t* G; int ldg; int first;
    const float* roww;
    const float* qg; const float* kg;
};
__global__ __launch_bounds__(256) void s_gemm(SG p) {
    __shared__ float As[16][68];
    __shared__ float Bs[16][68];
    __shared__ float B2s[16][68];
    __shared__ float Ct[64][65];
    __shared__ float Ct2[64][65];
    const int tid = threadIdx.x, tx = tid & 15, ty = tid >> 4;
    const int gc0 = blockIdx.x * 64, gr0 = blockIdx.y * 64;
    const float* W = p.W; const float* W2 = p.W2;
    if (p.tile_e) { const int t256 = blockIdx.y >> 2; if (t256 >= *p.ntiles) return; const int e = p.tile_e[t256]; W += (size_t)e * p.wstride; if (W2) W2 += (size_t)e * p.wstride; }
    float acc[4][4] = {}, acc2[4][4] = {};
    const int ar = tid >> 2, ak = (tid & 3) * 4;
    const int bk = tid >> 4, bn = (tid & 15) * 4;
    for (int k0 = 0; k0 < p.K; k0 += 16) {
        { const u32x2 a = *(const u32x2*)(p.A + (size_t)(gr0 + ar) * p.lda + k0 + ak);
          As[ak + 0][ar] = __uint_as_float(a.x << 16); As[ak + 1][ar] = __uint_as_float(a.x & 0xffff0000u);
          As[ak + 2][ar] = __uint_as_float(a.y << 16); As[ak + 3][ar] = __uint_as_float(a.y & 0xffff0000u); }
        { const f32x4 b = *(const f32x4*)(W + (size_t)(k0 + bk) * p.ldw + gc0 + bn); Bs[bk][bn] = b.x; Bs[bk][bn + 1] = b.y; Bs[bk][bn + 2] = b.z; Bs[bk][bn + 3] = b.w; }
        if (p.mode == MD_SILU) { const f32x4 b = *(const f32x4*)(W2 + (size_t)(k0 + bk) * p.ldw + gc0 + bn); B2s[bk][bn] = b.x; B2s[bk][bn + 1] = b.y; B2s[bk][bn + 2] = b.z; B2s[bk][bn + 3] = b.w; }
        __syncthreads();
#pragma unroll
        for (int k = 0; k < 16; ++k) {
            float a[4], b[4];
#pragma unroll
            for (int i = 0; i < 4; ++i) { a[i] = As[k][ty * 4 + i]; b[i] = Bs[k][tx * 4 + i]; }
#pragma unroll
            for (int i = 0; i < 4; ++i)
#pragma unroll
                for (int j = 0; j < 4; ++j) acc[i][j] += a[i] * b[j];
            if (p.mode == MD_SILU) {
#pragma unroll
                for (int i = 0; i < 4; ++i) b[i] = B2s[k][tx * 4 + i];
#pragma unroll
                for (int i = 0; i < 4; ++i)
#pragma unroll
                    for (int j = 0; j < 4; ++j) acc2[i][j] += a[i] * b[j];
            }
        }
        __syncthreads();
    }
#pragma unroll
    for (int i = 0; i < 4; ++i)
#pragma unroll
        for (int j = 0; j < 4; ++j) { Ct[ty * 4 + i][tx * 4 + j] = acc[i][j]; Ct2[ty * 4 + i][tx * 4 + j] = acc2[i][j]; }
    __syncthreads();
    const int r = tid >> 2, q = tid & 3; const int grow = gr0 + r;
    if (p.mode == MD_PROJ) {
        const int pos = grow & (SEQ - 1);
        bf16_t* orow = p.O + (size_t)grow * p.ldo + gc0;
        if (gc0 < C_AV) {
            const float sc = gc0 < C_AK ? C2_64 : 1.f;
            for (int j = 0; j < 8; ++j) { const int i = q * 8 + j; const float x1 = Ct[r][i], x2 = Ct[r][i + 32]; float s, c; sincosf((float)pos * inv1d(i), &s, &c);
                orow[i] = f2bf((x1 * c - x2 * s) * sc); orow[i + 32] = f2bf((x2 * c + x1 * s) * sc); }
        } else if ((gc0 >= C_BQ && gc0 < C_BV)) {
            const bool isq = gc0 < C_BK; const float* g = isq ? p.qg : p.kg; const float sc = isq ? C2_64 : 1.f;
            float ss = 0.f; for (int d = 0; d < 64; ++d) ss += Ct[r][d] * Ct[r][d];
            const float rs = rsqrtf(ss * (1.f / 64.f) + EPS);
            for (int j = 0; j < 8; ++j) { const int i = q * 8 + j; const float x1 = Ct[r][i] * rs * g[i], x2 = Ct[r][i + 32] * rs * g[i + 32]; float s, c; sincosf(ang2d(pos, i), &s, &c);
                orow[i] = f2bf((x1 * c - x2 * s) * sc); orow[i + 32] = f2bf((x2 * c + x1 * s) * sc); }
        } else if (gc0 >= C_G) {
            for (int j = 0; j < 16; ++j) { const int c = q * 16 + j; orow[c] = f2bf(1.f / (1.f + __expf(-Ct[r][c]))); }
        } else {
            const float sc = (gc0 >= C_CQ) ? C2_128 : 1.f;
            for (int j = 0; j < 16; ++j) { const int c = q * 16 + j; orow[c] = f2bf(Ct[r][c] * sc); }
        }
    } else if (p.mode == MD_BF16) {
        for (int j = 0; j < 16; ++j) { const int c = q * 16 + j; p.O[(size_t)grow * p.ldo + gc0 + c] = f2bf(Ct[r][c]); }
    } else if (p.mode == MD_GATE) {
        for (int j = 0; j < 16; ++j) { const int c = q * 16 + j; const float gv = bf2f(p.G[(size_t)grow * p.ldg + gc0 + c]);
            bf16_t* o = p.O + (size_t)grow * p.ldo + gc0 + c; const float prev = p.first ? 0.f : bf2f(*o); *o = f2bf(prev + gv * Ct[r][c]); }
    } else if (p.mode == MD_RESID) {
        for (int j = 0; j < 16; ++j) { const int c = q * 16 + j; p.Xf[(size_t)grow * DM + gc0 + c] += Ct[r][c]; }
    } else if (p.mode == MD_SILU) {
        for (int j = 0; j < 16; ++j) { const int c = q * 16 + j; const float gq = Ct[r][c], u = Ct2[r][c]; p.O[(size_t)grow * p.ldo + gc0 + c] = f2bf(gq / (1.f + __expf(-gq)) * u); }
    } else if (p.mode == MD_ROWSCALE) {
        const float w = p.roww[grow];
        for (int j = 0; j < 16; ++j) { const int c = q * 16 + j; p.O[(size_t)grow * p.ldo + gc0 + c] = f2bf(Ct[r][c] * w); }
    }
}

template <int DQK, int DV, int NKT>
__device__ __forceinline__ void attn_row(const bf16_t* q, const bf16_t* K, int ldk, const bf16_t* V, int ldv, float* qs, float* ps, int lane, float (&o)[2]) {
    for (int d = lane; d < DQK; d += 64) qs[d] = bf2f(q[d]);
    __syncthreads();
    float sc[NKT]; float m = -INFINITY;
#pragma unroll
    for (int i = 0; i < NKT; ++i) {
        const bf16_t* kr = K + (size_t)(i * 64 + lane) * ldk; float s = 0.f;
#pragma unroll
        for (int d0 = 0; d0 < DQK / 8; ++d0) { const u32x4 w = *(const u32x4*)(kr + d0 * 8);
            s += qs[d0 * 8 + 0] * __uint_as_float(w.x << 16) + qs[d0 * 8 + 1] * __uint_as_float(w.x & 0xffff0000u) + qs[d0 * 8 + 2] * __uint_as_float(w.y << 16) + qs[d0 * 8 + 3] * __uint_as_float(w.y & 0xffff0000u)
               + qs[d0 * 8 + 4] * __uint_as_float(w.z << 16) + qs[d0 * 8 + 5] * __uint_as_float(w.z & 0xffff0000u) + qs[d0 * 8 + 6] * __uint_as_float(w.w << 16) + qs[d0 * 8 + 7] * __uint_as_float(w.w & 0xffff0000u); }
        sc[i] = s; m = fmaxf(m, s);
    }
    m = wave_max(m); float l = 0.f;
#pragma unroll
    for (int i = 0; i < NKT; ++i) { const float pv = exp2f(sc[i] - m); l += pv; ps[i * 64 + lane] = pv; }
    l = wave_sum(l);
    __syncthreads();
    float a0 = 0.f, a1 = 0.f;
#pragma unroll 4
    for (int j = 0; j < NKT * 64; ++j) { const float pv = ps[j]; a0 += pv * bf2f(V[(size_t)j * ldv + lane]); if (DV == 128) a1 += pv * bf2f(V[(size_t)j * ldv + 64 + lane]); }
    o[0] = a0 / l; o[1] = a1 / l;
    __syncthreads();
}
__global__ __launch_bounds__(256) void s_attn_b(const bf16_t* __restrict__ PROJ, bf16_t* __restrict__ OBR) {
    __shared__ float qs_[4][128]; __shared__ float ps_[4][2048];
    const int w = threadIdx.x >> 6, lane = threadIdx.x & 63, row = blockIdx.x * 4 + w, qh = blockIdx.y, b = row / SEQ;
    const bf16_t* kv = PROJ + (size_t)b * SEQ * D_IN;
    float o[2];
    attn_row<64, 64, 32>(PROJ + (size_t)row * D_IN + C_BQ + qh * 64, kv + C_BK + (qh >> 2) * 64, D_IN, kv + C_BV + (qh >> 2) * 64, D_IN, qs_[w], ps_[w], lane, o);
    OBR[(size_t)row * OBR_W + 512 + qh * 64 + lane] = f2bf(o[0]);
}
__global__ __launch_bounds__(256) void s_attn_c(const bf16_t* __restrict__ PROJ, const bf16_t* __restrict__ MEMKV, bf16_t* __restrict__ OBR) {
    __shared__ float qs_[4][128]; __shared__ float ps_[4][256];
    const int w = threadIdx.x >> 6, lane = threadIdx.x & 63, row = blockIdx.x * 4 + w, h = blockIdx.y, b = row / SEQ;
    const bf16_t* kv = MEMKV + (size_t)b * MEM_LEN * 1024;
    float o[2];
    attn_row<128, 128, 4>(PROJ + (size_t)row * D_IN + C_CQ + h * 128, kv + h * 128, 1024, kv + 512 + h * 128, 1024, qs_[w], ps_[w], lane, o);
    OBR[(size_t)row * OBR_W + 1024 + h * 128 + lane] = f2bf(o[0]);
    OBR[(size_t)row * OBR_W + 1024 + h * 128 + 64 + lane] = f2bf(o[1]);
}
__global__ __launch_bounds__(256) void s_attn_a(const bf16_t* __restrict__ PROJ, bf16_t* __restrict__ OBR, const float* lq1, const float* lk1, const float* lq2, const float* lk2,
                                                const float* subg, float lam_init) {
    __shared__ float qs_[4][128]; __shared__ float ps_[4][2048];
    const int w = threadIdx.x >> 6, lane = threadIdx.x & 63, row = blockIdx.x * 4 + w, h = blockIdx.y, b = row / SEQ;
    const float lam = __expf(wave_sum(lq1[lane] * lk1[lane])) - __expf(wave_sum(lq2[lane] * lk2[lane])) + lam_init;
    const bf16_t* kv = PROJ + (size_t)b * SEQ * D_IN;
    float o0[2], o1[2];
    attn_row<64, 128, 32>(PROJ + (size_t)row * D_IN + C_AQ + h * 128, kv + C_AK + h * 128, D_IN, kv + C_AV + h * 128, D_IN, qs_[w], ps_[w], lane, o0);
    attn_row<64, 128, 32>(PROJ + (size_t)row * D_IN + C_AQ + h * 128 + 64, kv + C_AK + h * 128 + 64, D_IN, kv + C_AV + h * 128, D_IN, qs_[w], ps_[w], lane, o1);
    const float c0 = o0[0] - lam * o1[0], c1 = o0[1] - lam * o1[1];
    const float rs = rsqrtf(wave_sum(c0 * c0 + c1 * c1) * (1.f / 128.f) + EPS) * (1.f - lam_init);
    OBR[(size_t)row * OBR_W + h * 128 + lane] = f2bf(c0 * rs * subg[lane]);
    OBR[(size_t)row * OBR_W + h * 128 + 64 + lane] = f2bf(c1 * rs * subg[64 + lane]);
}

__global__ __launch_bounds__(256) void s_norm_route(const float* __restrict__ X, const float* __restrict__ g, bf16_t* __restrict__ H2, const float* __restrict__ wrg, const float* __restrict__ brg,
                                                    const float* __restrict__ wre, const float* __restrict__ bre, int* __restrict__ experts, float* __restrict__ weights, int* __restrict__ rank, unsigned* __restrict__ cnt, float* __restrict__ rstd) {
    const int lane = threadIdx.x & 63, row = blockIdx.x * 4 + (threadIdx.x >> 6);
    const f32x4* xr = (const f32x4*)(X + (size_t)row * DM);
    f32x4 v[4]; float s = 0.f;
#pragma unroll
    for (int j = 0; j < 4; ++j) { v[j] = xr[lane + 64 * j]; s += v[j].x * v[j].x + v[j].y * v[j].y + v[j].z * v[j].z + v[j].w * v[j].w; }
    const float rs = rsqrtf(wave_sum(s) * (1.f / DM) + EPS);
    float acc[36];
#pragma unroll
    for (int e = 0; e < 36; ++e) acc[e] = 0.f;
#pragma unroll
    for (int j = 0; j < 4; ++j) { const f32x4 gg = ((const f32x4*)g)[lane + 64 * j];
        float h[4] = {v[j].x * rs * gg.x, v[j].y * rs * gg.y, v[j].z * rs * gg.z, v[j].w * rs * gg.w};
        u32x2 o; o.x = f2bf(h[0]) | ((unsigned)f2bf(h[1]) << 16); o.y = f2bf(h[2]) | ((unsigned)f2bf(h[3]) << 16);
        ((u32x2*)(H2 + (size_t)row * DM))[lane + 64 * j] = o;
#pragma unroll
        for (int i = 0; i < 4; ++i) { const int k = (lane + 64 * j) * 4 + i;
            const f32x4 wg = *(const f32x4*)(wrg + (size_t)k * 4);
            acc[0] += h[i] * wg.x; acc[1] += h[i] * wg.y; acc[2] += h[i] * wg.z; acc[3] += h[i] * wg.w;
#pragma unroll
            for (int e4 = 0; e4 < 8; ++e4) { const f32x4 we = *(const f32x4*)(wre + (size_t)k * 32 + e4 * 4);
                acc[4 + e4 * 4 + 0] += h[i] * we.x; acc[4 + e4 * 4 + 1] += h[i] * we.y; acc[4 + e4 * 4 + 2] += h[i] * we.z; acc[4 + e4 * 4 + 3] += h[i] * we.w; }
        }
    }
#pragma unroll
    for (int e = 0; e < 36; ++e) acc[e] = wave_sum(acc[e]);
    if (lane == 0) {
        rstd[row] = rs;
        int gi = 0; float gm = acc[0] + brg[0];
        for (int i = 1; i < 4; ++i) { const float l = acc[i] + brg[i]; if (l > gm) { gm = l; gi = i; } }
        float gs = 0.f; for (int i = 0; i < 4; ++i) gs += __expf(acc[i] + brg[i] - gm);
        const float gp = 1.f / gs;
        float el[8];
#pragma unroll
        for (int i = 0; i < 8; ++i) el[i] = 0.f;
#pragma unroll
        for (int gq = 0; gq < 4; ++gq) if (gq == gi) {
#pragma unroll
            for (int i = 0; i < 8; ++i) el[i] = acc[4 + gq * 8 + i] + bre[gq * 8 + i]; }
        int i0 = 0; float l0 = el[0];
#pragma unroll
        for (int i = 1; i < 8; ++i) if (el[i] > l0) { l0 = el[i]; i0 = i; }
        int i1 = -1; float l1 = -INFINITY;
#pragma unroll
        for (int i = 0; i < 8; ++i) if (i != i0 && el[i] > l1) { l1 = el[i]; i1 = i; }
        const float p1 = __expf(l1 - l0), inv = 1.f / (1.f + p1);
        const int e0 = gi * 8 + i0, e1 = gi * 8 + i1;
        experts[row * 2] = e0; experts[row * 2 + 1] = e1;
        weights[row * 2] = gp * inv; weights[row * 2 + 1] = gp * p1 * inv;
        rank[row * 2] = (int)atomicAdd(cnt + e0, 1u); rank[row * 2 + 1] = (int)atomicAdd(cnt + e1, 1u);
    }
}
__global__ void s_dispatch(const unsigned* __restrict__ cnt, int* __restrict__ tile_tab) {
    if (threadIdx.x == 0) {
        int off = 0, nt = 0;
        for (int e = 0; e < NEXP; ++e) { const int c = (int)cnt[e], t = (c + MOE_TILE - 1) / MOE_TILE; tile_tab[260 + e] = off; for (int i = 0; i < t; ++i) tile_tab[nt++] = e; off += t * MOE_TILE; }
        tile_tab[256] = nt;
    }
}
__global__ __launch_bounds__(256) void s_gather(const float* __restrict__ X, const float* __restrict__ rstd, const float* __restrict__ g, const int* __restrict__ experts, const float* __restrict__ weights, const int* __restrict__ rank, const int* __restrict__ tile_tab,
                                                bf16_t* __restrict__ BUF, float* __restrict__ roww, int* __restrict__ dest) {
    const int lane = threadIdx.x & 63, a = blockIdx.x * 4 + (threadIdx.x >> 6);
    const int tok = a >> 1, e = experts[a], d = tile_tab[260 + e] + rank[a]; const float rs = rstd[tok];
    const f32x4* xr = (const f32x4*)(X + (size_t)tok * DM);
    for (int j = 0; j < 4; ++j) { const f32x4 v = xr[lane + 64 * j], gg = ((const f32x4*)g)[lane + 64 * j];
        u32x2 o; o.x = f2bf(v.x * rs * gg.x) | ((unsigned)f2bf(v.y * rs * gg.y) << 16); o.y = f2bf(v.z * rs * gg.z) | ((unsigned)f2bf(v.w * rs * gg.w) << 16);
        ((u32x2*)(BUF + (size_t)d * DM))[lane + 64 * j] = o; }
    if (lane == 0) { roww[d] = weights[a]; dest[a] = d; }
}
__global__ __launch_bounds__(256) void s_combine_norm(float* __restrict__ X, const bf16_t* __restrict__ YB, const int* __restrict__ dest, const float* __restrict__ g, bf16_t* __restrict__ H, float* __restrict__ OUT) {
    const int lane = threadIdx.x & 63, row = blockIdx.x * 4 + (threadIdx.x >> 6);
    const int d0 = dest[row * 2], d1 = dest[row * 2 + 1];
    f32x4* xr = (f32x4*)(X + (size_t)row * DM);
    f32x4 v[4]; float s = 0.f;
#pragma unroll
    for (int j = 0; j < 4; ++j) { v[j] = xr[lane + 64 * j];
        const u32x2 a = ((const u32x2*)(YB + (size_t)d0 * DM))[lane + 64 * j], b = ((const u32x2*)(YB + (size_t)d1 * DM))[lane + 64 * j];
        v[j].x += __uint_as_float(a.x << 16) + __uint_as_float(b.x << 16); v[j].y += __uint_as_float(a.x & 0xffff0000u) + __uint_as_float(b.x & 0xffff0000u);
        v[j].z += __uint_as_float(a.y << 16) + __uint_as_float(b.y << 16); v[j].w += __uint_as_float(a.y & 0xffff0000u) + __uint_as_float(b.y & 0xffff0000u);
        s += v[j].x * v[j].x + v[j].y * v[j].y + v[j].z * v[j].z + v[j].w * v[j].w; }
    const float rs = rsqrtf(wave_sum(s) * (1.f / DM) + EPS);
#pragma unroll
    for (int j = 0; j < 4; ++j) { const f32x4 gg = ((const f32x4*)g)[lane + 64 * j];
        if (H) { xr[lane + 64 * j] = v[j];
            u32x2 o; o.x = f2bf(v[j].x * rs * gg.x) | ((unsigned)f2bf(v[j].y * rs * gg.y) << 16); o.y = f2bf(v[j].z * rs * gg.z) | ((unsigned)f2bf(v[j].w * rs * gg.w) << 16);
            ((u32x2*)(H + (size_t)row * DM))[lane + 64 * j] = o; }
        else { f32x4 o; o.x = v[j].x * rs * gg.x; o.y = v[j].y * rs * gg.y; o.z = v[j].z * rs * gg.z; o.w = v[j].w * rs * gg.w; ((f32x4*)(OUT + (size_t)row * DM))[lane + 64 * j] = o; }
    }
}

#define LAS __attribute__((address_space(3)))
#define GAS __attribute__((address_space(1)))
typedef short bf16x8 __attribute__((ext_vector_type(8)));
typedef short s16x4 __attribute__((ext_vector_type(4)));
typedef float f32x16 __attribute__((ext_vector_type(16)));
typedef float f32x2 __attribute__((ext_vector_type(2)));

constexpr size_t WB_IN = 0, WB_UP = 6029312, WB_OUT = WB_UP + 1572864, WB_GU = WB_OUT + 1048576, WB_DN = WB_GU + 33554432, WB_LAYER = WB_DN + 16777216;
constexpr size_t WB_MEMKV = 2 * WB_LAYER;
constexpr size_t WB_RT = WB_MEMKV + 1048576;
static_assert(WS_WB + (WB_RT + 2 * 2 * 48 * 1024) * 2 <= WS_END, "weight copies fit");
constexpr int N_PHASES = 19;
constexpr int LCAP = 16384;

__device__ __forceinline__ int lane_id() { int r; asm volatile("v_mbcnt_lo_u32_b32 %0, -1, 0\n\tv_mbcnt_hi_u32_b32 %0, -1, %0" : "=v"(r)); return r; }
__device__ __forceinline__ unsigned cvt_pk_bf16(float lo, float hi) { unsigned r; asm volatile("v_cvt_pk_bf16_f32 %0, %1, %2" : "=v"(r) : "v"(lo), "v"(hi)); return r; }
__device__ __forceinline__ float fast_sigmoid(float v) { return __builtin_amdgcn_rcpf(1.f + __builtin_amdgcn_exp2f(-v * LOG2E)); }

namespace pg8 {
#define PG8_LAS LAS
constexpr int BM = 256, BK = 64, HALF = 128, HTB = HALF * BK * 2, STAGE_BYTES = 8 * HTB, NXCD = 8, WGM = 8;
__host__ __device__ __forceinline__ int lds_byte(int r, int c) { const int st = (r >> 4) * 2 + (c >> 5), rr = r & 15, cc = c & 31, ob = rr * 64 + cc * 2; return st * 1024 + (ob ^ (((ob >> 9) & 1) << 5)); }
__host__ __device__ __forceinline__ void stage_rc(int b, int& R, int& C) { const int st = b / 1024, sb = b % 1024, swz = sb ^ (((sb >> 9) & 1) << 5); R = (st >> 1) * 16 + swz / 64; C = (st & 1) * 32 + (swz % 64) / 2; }
__host__ __device__ __forceinline__ int perm32(int rho) { const int n = rho >> 4, i = rho & 15; return 8 * (i >> 2) + 4 * n + (i & 3); }

struct Unit { int pm, pn, sub, ord; const char* a; const char* b; };
struct Gemm { int lda; int K; };
__device__ __forceinline__ void tile_order(int L, int nM, int nN, int& pm, int& pn) {
    const int nwg = nM * nN; int wgid = L; { const int q = nwg / NXCD, r = nwg % NXCD, xcd = wgid % NXCD, off = wgid / NXCD; wgid = (xcd < r ? xcd * (q + 1) : r * (q + 1) + (xcd - r) * q) + off; }
    const int nig = WGM * nN, gid = wgid / nig, fm = gid * WGM, gsz = (nM - fm) < WGM ? (nM - fm) : WGM;
    pm = fm + ((wgid % nig) % gsz); pn = (wgid % nig) / gsz;
}
__device__ __forceinline__ u32x4 pack8(const f32x4& v0, const f32x4& v1) { u32x4 w; w.x = cvt_pk_bf16(v0[0], v0[1]); w.y = cvt_pk_bf16(v0[2], v0[3]); w.z = cvt_pk_bf16(v1[0], v1[1]); w.w = cvt_pk_bf16(v1[2], v1[3]); return w; }
__device__ __forceinline__ void unpack8(const u32x4& w, f32x4& v0, f32x4& v1) {
    v0[0] = __uint_as_float(w.x << 16); v0[1] = __uint_as_float(w.x & 0xffff0000u); v0[2] = __uint_as_float(w.y << 16); v0[3] = __uint_as_float(w.y & 0xffff0000u);
    v1[0] = __uint_as_float(w.z << 16); v1[1] = __uint_as_float(w.z & 0xffff0000u); v1[2] = __uint_as_float(w.w << 16); v1[3] = __uint_as_float(w.w & 0xffff0000u); }

struct EpiProj {
    static constexpr bool PERM = true, AFTER_DRAIN = false;
    bf16_t* PROJ; bf16_t* MEMKV; const float* tab1; const float* tab2; const float* qg; const float* kg;
    __device__ __forceinline__ void operator()(const f32x4 (&acc)[2][2][4][2], const Unit& u, int wr, int wc, int fr, int fq) const {
        const int colt = u.pn * 256, dcol = colt + wc * 64 + fq * 8, row0 = u.pm * 256 + wr * 64 + fr;
        if (u.sub == 1) {
#pragma unroll
            for (int ai = 0; ai < 2; ++ai)
#pragma unroll
                for (int m = 0; m < 4; ++m) { bf16_t* rowp = MEMKV + (size_t)(row0 + ai * 128 + m * 16) * 1024 + dcol;
#pragma unroll
                    for (int bj = 0; bj < 2; ++bj) *(u32x4*)(rowp + bj * 32) = pack8(acc[ai][bj][m][0], acc[ai][bj][m][1]); }
            return;
        }
        int mode = 0; float sc = 1.f; const float* g = qg;
        if (colt < C_AV) { mode = 1; if (colt < C_AK) sc = C2_64; }
        else if (colt < C_BQ) mode = 0;
        else if (colt < C_BK) { mode = 2; sc = C2_64; }
        else if (colt < C_CQ) { if (wc < 2) { mode = 2; g = kg; } }
        else if (colt < C_G) sc = C2_128;
        else mode = 3;
        f32x4 gv[2][2];
        if (mode == 2) {
#pragma unroll
            for (int bj = 0; bj < 2; ++bj)
#pragma unroll
                for (int n = 0; n < 2; ++n) gv[bj][n] = *(const f32x4*)(g + bj * 32 + fq * 8 + n * 4);
        }
#pragma unroll
        for (int ai = 0; ai < 2; ++ai)
#pragma unroll
            for (int m = 0; m < 4; ++m) {
                const int row = row0 + ai * 128 + m * 16, pos = row & (SEQ - 1);
                f32x4 v[2][2] = {{acc[ai][0][m][0], acc[ai][0][m][1]}, {acc[ai][1][m][0], acc[ai][1][m][1]}};
                if (mode == 2) {
                    float ss = 0.f;
#pragma unroll
                    for (int bj = 0; bj < 2; ++bj)
#pragma unroll
                        for (int n = 0; n < 2; ++n) ss += (v[bj][n][0] * v[bj][n][0] + v[bj][n][1] * v[bj][n][1]) + (v[bj][n][2] * v[bj][n][2] + v[bj][n][3] * v[bj][n][3]);
                    ss += __shfl_xor(ss, 16); ss += __shfl_xor(ss, 32);
                    const float rs = rsqrtf(ss * (1.f / 64.f) + EPS);
#pragma unroll
                    for (int bj = 0; bj < 2; ++bj)
#pragma unroll
                        for (int n = 0; n < 2; ++n) v[bj][n] = v[bj][n] * rs * gv[bj][n];
                }
                if (mode == 1 || mode == 2) {
                    const float* tb = (mode == 1 ? tab1 : tab2) + ((size_t)pos * 32 + fq * 8) * 2;
#pragma unroll
                    for (int n = 0; n < 2; ++n) { const f32x4 t0 = *(const f32x4*)(tb + n * 8), t1 = *(const f32x4*)(tb + n * 8 + 4);
                        const float cs[4] = {t0[0], t0[2], t1[0], t1[2]}, sn[4] = {t0[1], t0[3], t1[1], t1[3]};
#pragma unroll
                        for (int e = 0; e < 4; ++e) { const float x1 = v[0][n][e], x2 = v[1][n][e]; v[0][n][e] = x1 * cs[e] - x2 * sn[e]; v[1][n][e] = x2 * cs[e] + x1 * sn[e]; } }
                }
                if (mode == 3) {
#pragma unroll
                    for (int bj = 0; bj < 2; ++bj)
#pragma unroll
                        for (int n = 0; n < 2; ++n)
#pragma unroll
                            for (int e = 0; e < 4; ++e) v[bj][n][e] = fast_sigmoid(v[bj][n][e]);
                }
                bf16_t* rowp = PROJ + (size_t)row * D_IN + dcol;
#pragma unroll
                for (int bj = 0; bj < 2; ++bj) *(u32x4*)(rowp + bj * 32) = pack8(v[bj][0] * sc, v[bj][1] * sc);
            }
    }
};
struct EpiGate {
    static constexpr bool PERM = true, AFTER_DRAIN = false;
    bf16_t* MERGED; const bf16_t* PROJ;
    __device__ __forceinline__ void operator()(const f32x4 (&acc)[2][2][4][2], const Unit& u, int wr, int wc, int fr, int fq) const {
        const int col0 = u.pn * 256 + wc * 32 + fq * 8, row0 = u.pm * 256 + wr * 64 + fr;
#pragma unroll
        for (int ai = 0; ai < 2; ++ai)
#pragma unroll
            for (int m = 0; m < 4; ++m) { const int row = row0 + ai * 128 + m * 16;
                const bf16_t* gp = PROJ + (size_t)row * D_IN + C_G + u.sub * 1024 + col0; bf16_t* op = MERGED + (size_t)row * DM + col0;
#pragma unroll
                for (int bj = 0; bj < 2; ++bj) { f32x4 g0, g1, o0 = {0.f, 0.f, 0.f, 0.f}, o1 = {0.f, 0.f, 0.f, 0.f};
                    unpack8(*(const u32x4*)(gp + bj * 128), g0, g1);
                    if (u.sub != 0) unpack8(*(const u32x4*)(op + bj * 128), o0, o1);
                    o0 += g0 * acc[ai][bj][m][0]; o1 += g1 * acc[ai][bj][m][1];
                    *(u32x4*)(op + bj * 128) = pack8(o0, o1); } }
    }
};
struct EpiResid {
    static constexpr bool PERM = true, AFTER_DRAIN = false;
    const float* Xin; float* X;
    __device__ __forceinline__ void operator()(const f32x4 (&acc)[2][2][4][2], const Unit& u, int wr, int wc, int fr, int fq) const {
        const int col0 = u.pn * 256 + wc * 32 + fq * 8, row0 = u.pm * 256 + wr * 64 + fr;
#pragma unroll
        for (int ai = 0; ai < 2; ++ai)
#pragma unroll
            for (int m = 0; m < 4; ++m) { const size_t off = (size_t)(row0 + ai * 128 + m * 16) * DM + col0;
#pragma unroll
                for (int bj = 0; bj < 2; ++bj) { const f32x4* pi = (const f32x4*)(Xin + off + bj * 128); f32x4* po = (f32x4*)(X + off + bj * 128); const f32x4 a = pi[0], b = pi[1]; po[0] = a + acc[ai][bj][m][0]; po[1] = b + acc[ai][bj][m][1]; } }
    }
};
struct EpiSilu {
    static constexpr bool PERM = true, AFTER_DRAIN = false;
    bf16_t* HID;
    __device__ __forceinline__ void operator()(const f32x4 (&acc)[2][2][4][2], const Unit& u, int wr, int wc, int fr, int fq) const {
        const int col0 = u.pn * 128 + wc * 32 + fq * 8, row0 = u.pm * 256 + wr * 64 + fr;
#pragma unroll
        for (int ai = 0; ai < 2; ++ai)
#pragma unroll
            for (int m = 0; m < 4; ++m) { f32x4 h[2];
#pragma unroll
                for (int n = 0; n < 2; ++n)
#pragma unroll
                    for (int e = 0; e < 4; ++e) { const float gq = acc[ai][0][m][n][e]; h[n][e] = gq * fast_sigmoid(gq) * acc[ai][1][m][n][e]; }
                *(u32x4*)(HID + (size_t)(row0 + ai * 128 + m * 16) * DEXP + col0) = pack8(h[0], h[1]); }
    }
};
struct EpiRowScale {
    static constexpr bool PERM = true, AFTER_DRAIN = false;
    bf16_t* YB; const PG8_LAS float* wtab;
    __device__ __forceinline__ void operator()(const f32x4 (&acc)[2][2][4][2], const Unit& u, int wr, int wc, int fr, int fq) const {
        const int col0 = u.pn * 256 + wc * 32 + fq * 8, rt0 = wr * 64 + fr;
#pragma unroll
        for (int ai = 0; ai < 2; ++ai)
#pragma unroll
            for (int m = 0; m < 4; ++m) { const int rt = rt0 + ai * 128 + m * 16; const float w = wtab[u.ord * 256 + rt]; bf16_t* op = YB + (size_t)(u.pm * 256 + rt) * DM + col0;
#pragma unroll
                for (int bj = 0; bj < 2; ++bj) *(u32x4*)(op + bj * 128) = pack8(acc[ai][bj][m][0] * w, acc[ai][bj][m][1] * w); }
    }
};
struct SchedProj {
    int c, G, nmain, ntotal; const char* A; const char* B; const char* Am; const char* Bm;
    __device__ __forceinline__ bool next(int i, Unit& u) const {
        const long L = (long)i * G + c; if (L >= ntotal) return false;
        u.ord = i;
        if (L < nmain) { tile_order((int)L, M / 256, D_IN / 256, u.pm, u.pn); u.sub = 0; u.a = A + (size_t)u.pm * (256 * DM * 2); u.b = B + (size_t)u.pn * (256 * DM * 2); }
        else { const int r = (int)L - nmain; u.pm = r >> 2; u.pn = r & 3; u.sub = 1; u.a = Am + (size_t)u.pm * (256 * DM * 2); u.b = Bm + (size_t)u.pn * (256 * DM * 2); }
        return true; }
    __device__ __forceinline__ void a_ready(const Unit&) const {}
    __device__ __forceinline__ void done(const Unit&) const {}
};
struct SchedGate {
    int c, G; const char* OBRp; const char* WUP;
    __device__ __forceinline__ bool next(int i, Unit& u) const {
        const int t = c + G * (i / 3); if (t >= 256) return false;
        tile_order(t, M / 256, 4, u.pm, u.pn); u.sub = i % 3; u.ord = i;
        u.a = OBRp + ((size_t)u.pm * 256 * OBR_W + 512 * u.sub) * 2; u.b = WUP + ((size_t)u.sub * 1024 * 512 + (size_t)u.pn * 256 * 512) * 2; return true; }
    __device__ __forceinline__ void a_ready(const Unit&) const {}
    __device__ __forceinline__ void done(const Unit&) const {}
};
struct SchedPlain {
    int c, G, nM; const char* A; const char* B; size_t a_tile, b_tile;
    __device__ __forceinline__ bool next(int i, Unit& u) const {
        const long L = (long)i * G + c; if (L >= (long)nM * 4) return false;
        tile_order((int)L, nM, 4, u.pm, u.pn); u.sub = 0; u.ord = i; u.a = A + (size_t)u.pm * a_tile; u.b = B + (size_t)u.pn * b_tile; return true; }
    __device__ __forceinline__ void a_ready(const Unit&) const {}
    __device__ __forceinline__ void done(const Unit&) const {}
};
struct SchedMoe {
    int c, G, ntiles, gather; const PG8_LAS int* tile_e; const char* A; const char* B; size_t a_tile, b_exp, b_tile;
    __device__ __forceinline__ bool next(int i, Unit& u) const {
        const long L = (long)i * G + c; if (L >= (long)ntiles * 4) return false;
        u.pm = (int)(L >> 2); u.pn = (int)(L & 3); u.sub = 0; u.ord = i; const int e = tile_e[u.pm];
        u.a = gather ? A : A + (size_t)u.pm * a_tile; u.b = B + (size_t)e * b_exp + (size_t)u.pn * b_tile; return true; }
    __device__ __forceinline__ void a_ready(const Unit&) const {}
    __device__ __forceinline__ void done(const Unit&) const {}
};

template <class Epi, class Sched, bool ALIGN_EPI = false, bool SP2 = false, bool GATHER = false>
__device__ __forceinline__ void gemm_phase(PG8_LAS unsigned char* lds, const Gemm g, const Sched& S, const Epi& E, int wave_id, const PG8_LAS unsigned* rowtab = nullptr) {
    static_assert(!GATHER || SP2, "the gathered A path is written for the two-super-phase loop");
    int tid_ = wave_id * 64 + lane_id(); asm volatile("" : "+v"(tid_));
    const int tid = tid_, wid = __builtin_amdgcn_readfirstlane(tid >> 6), lane = tid & 63, wr = wid >> 2, wc = wid & 3, fr = lane & 15, fq = lane >> 4;
    const int K = g.K, nt = K / BK;
    unsigned voffA[2], voffB[2];
#pragma unroll
    for (int i = 0; i < 2; ++i) { int R, C; stage_rc(tid * 16 + i * 8192, R, C); const int Rb = Epi::PERM ? ((R & ~31) + perm32(R & 31)) : R;
        voffA[i] = (unsigned)(R * g.lda + C) * 2u; voffB[i] = (unsigned)(Rb * K + C) * 2u; }
    unsigned gC[2][2] = {{0u, 0u}, {0u, 0u}}, gN[2][2] = {{0u, 0u}, {0u, 0u}};
#define PG8_GROWS(dst, ord) do { if constexpr (GATHER) { _Pragma("unroll") for (int i_ = 0; i_ < 2; ++i_) { int R_, C_; stage_rc((wid * 64 + fq * 16 + fr) * 16 + i_ * 8192, R_, C_);     \
        _Pragma("unroll") for (int h_ = 0; h_ < 2; ++h_) dst[h_][i_] = rowtab[(ord) * 256 + h_ * 128 + R_] + (unsigned)C_ * 2u; } } } while (0)
#define PG8_STAGE_A(bufoff, base, h, use_next) do { if constexpr (GATHER) { unsigned vo_[2]; vo_[0] = (use_next) ? gN[h][0] : gC[h][0]; vo_[1] = (use_next) ? gN[h][1] : gC[h][1]; PG8_STAGE(bufoff, base, vo_); } \
        else { PG8_STAGE(bufoff, (base) + (h) * hstepA, voffA); } } while (0)
    const size_t kstep = (size_t)(BK * 2);
    const size_t hstepA = (size_t)HALF * g.lda * 2, hstepB = (size_t)HALF * K * 2;
    const unsigned ldsw = (unsigned)wid * 1024u;
    const int aoff = lds_byte(wr * 64 + fr, fq * 8), boff = lds_byte(wc * 32 + fr, fq * 8);
#define PG8_SA(b, h) (((b) * 2 + (h)) * HTB)
#define PG8_SB(b, h) ((4 + (b) * 2 + (h)) * HTB)
#define PG8_STAGE(bufoff, gbase, voff) do { _Pragma("unroll") for (int _i = 0; _i < 2; ++_i) \
        __builtin_amdgcn_global_load_lds((const unsigned*)((const char*)(gbase) + (voff)[_i]), (PG8_LAS unsigned*)(lds + (bufoff) + ldsw + _i * 8192), 16, 0, 0); } while (0)
#define PG8_LDA(dst, b, h) do { _Pragma("unroll") for (int m = 0; m < 4; ++m) _Pragma("unroll") for (int k = 0; k < 2; ++k) dst[m][k] = *(const PG8_LAS bf16x8*)(lds + PG8_SA(b, h) + aoff + m * 2048 + k * 1024); } while (0)
#define PG8_LDB(dst, b, h) do { _Pragma("unroll") for (int n = 0; n < 2; ++n) _Pragma("unroll") for (int k = 0; k < 2; ++k) dst[n][k] = *(const PG8_LAS bf16x8*)(lds + PG8_SB(b, h) + boff + n * 2048 + k * 1024); } while (0)
#define PG8_MMA(ai, bj, At, Bt) do { __builtin_amdgcn_s_setprio(1); _Pragma("unroll") for (int m = 0; m < 4; ++m) _Pragma("unroll") for (int n = 0; n < 2; ++n) _Pragma("unroll") for (int k = 0; k < 2; ++k) \
        acc[ai][bj][m][n] = __builtin_amdgcn_mfma_f32_16x16x32_bf16(Bt[n][k], At[m][k], acc[ai][bj][m][n], 0, 0, 0); __builtin_amdgcn_s_setprio(0); } while (0)
#define PG8_WAIT_V(n) asm volatile("s_waitcnt vmcnt(" #n ")" ::: "memory")
#define PG8_WAIT_L(n) asm volatile("s_waitcnt lgkmcnt(" #n ")" ::: "memory")
#define PG8_BAR __builtin_amdgcn_s_barrier()
#define PG8_SCHED __builtin_amdgcn_sched_barrier(0)
    Unit cur, nxt; int ui = 0;
    if (!S.next(0, cur)) return;
    f32x4 acc[2][2][4][2];
#pragma unroll
    for (int a = 0; a < 2; ++a)
#pragma unroll
        for (int b = 0; b < 2; ++b)
#pragma unroll
            for (int m = 0; m < 4; ++m)
#pragma unroll
                for (int n = 0; n < 2; ++n) acc[a][b][m][n] = (f32x4){0.f, 0.f, 0.f, 0.f};
    bf16x8 At[4][2], B0[2][2], B1[2][2];
    const char* cA = cur.a; const char* cB = cur.b;
    S.a_ready(cur);
    if constexpr (SP2) {
        PG8_GROWS(gC, 0);
        PG8_STAGE(PG8_SB(0, 0), cB, voffB); PG8_STAGE(PG8_SB(0, 1), cB + hstepB, voffB); PG8_STAGE_A(PG8_SA(0, 0), cA, 0, false); PG8_STAGE_A(PG8_SA(0, 1), cA, 1, false);
        if (wr == 1) PG8_BAR;
        PG8_WAIT_V(2); PG8_BAR;
        PG8_STAGE(PG8_SB(1, 0), cB + kstep, voffB); PG8_STAGE_A(PG8_SA(1, 0), cA + kstep, 0, false); PG8_STAGE(PG8_SB(1, 1), cB + hstepB + kstep, voffB);
        PG8_WAIT_V(6); PG8_BAR;
    } else {
        PG8_STAGE(PG8_SB(0, 0), cB, voffB); PG8_STAGE(PG8_SA(0, 0), cA, voffA); PG8_STAGE(PG8_SB(0, 1), cB + hstepB, voffB); PG8_STAGE(PG8_SA(0, 1), cA + hstepA, voffA);
        if (wr == 1) PG8_BAR;
        PG8_WAIT_V(4); PG8_BAR;
        PG8_STAGE(PG8_SB(1, 0), cB + kstep, voffB); PG8_STAGE(PG8_SA(1, 0), cA + kstep, voffA); PG8_STAGE(PG8_SB(1, 1), cB + hstepB + kstep, voffB);
        PG8_WAIT_V(6); PG8_BAR;
    }
    for (;;) {
        const bool has_next = S.next(ui + 1, nxt);
        const char* nA = has_next ? nxt.a : cA; const char* nB = has_next ? nxt.b : cB;
        for (int t = 0; t < nt; t += 2) {
            const bool last = (t == nt - 2);
            const char* a1 = cA + (size_t)(t + 1) * kstep;
            const char* a2 = last ? nA : cA + (size_t)(t + 2) * kstep; const char* b2 = last ? nB : cB + (size_t)(t + 2) * kstep;
            const char* a3 = a2 + kstep; const char* b3 = b2 + kstep;
            if (last && has_next) S.a_ready(nxt);
            if constexpr (GATHER) { if (last) { if (has_next) { PG8_GROWS(gN, ui + 1); } else { _Pragma("unroll") for (int h_ = 0; h_ < 2; ++h_) _Pragma("unroll") for (int i_ = 0; i_ < 2; ++i_) gN[h_][i_] = gC[h_][i_]; } } }
            if constexpr (SP2) {
            PG8_LDB(B0, 0, 0); PG8_LDB(B1, 0, 1); PG8_SCHED; PG8_LDA(At, 0, 0); PG8_STAGE_A(PG8_SA(1, 1), a1, 1, false);
            PG8_WAIT_V(8); PG8_WAIT_L(0); PG8_BAR; PG8_MMA(0, 0, At, B0); PG8_MMA(0, 1, At, B1); PG8_BAR; PG8_SCHED;
            PG8_LDA(At, 0, 1); PG8_STAGE(PG8_SB(0, 0), b2, voffB); PG8_STAGE(PG8_SB(0, 1), b2 + hstepB, voffB); PG8_STAGE_A(PG8_SA(0, 0), a2, 0, last);
            PG8_WAIT_V(8); PG8_WAIT_L(0); PG8_BAR; PG8_MMA(1, 0, At, B0); PG8_MMA(1, 1, At, B1); PG8_BAR; PG8_SCHED;
            PG8_LDB(B0, 1, 0); PG8_LDB(B1, 1, 1); PG8_SCHED; PG8_LDA(At, 1, 0); PG8_STAGE_A(PG8_SA(0, 1), a2, 1, last);
            PG8_WAIT_V(8); PG8_WAIT_L(0); PG8_BAR; PG8_MMA(0, 0, At, B0); PG8_MMA(0, 1, At, B1); PG8_BAR; PG8_SCHED;
            PG8_LDA(At, 1, 1); PG8_STAGE(PG8_SB(1, 0), b3, voffB); PG8_STAGE(PG8_SB(1, 1), b3 + hstepB, voffB); PG8_STAGE_A(PG8_SA(1, 0), a3, 0, last);
            PG8_WAIT_V(8); PG8_WAIT_L(0); PG8_BAR; PG8_MMA(1, 0, At, B0); PG8_MMA(1, 1, At, B1); PG8_BAR; PG8_SCHED;
            } else {
            PG8_LDB(B0, 0, 0); PG8_SCHED; PG8_LDA(At, 0, 0); PG8_STAGE(PG8_SA(1, 1), a1 + hstepA, voffA);
            PG8_WAIT_L(8); PG8_BAR; PG8_WAIT_L(0); PG8_MMA(0, 0, At, B0); PG8_BAR; PG8_SCHED;
            PG8_LDB(B1, 0, 1); PG8_STAGE(PG8_SB(0, 0), b2, voffB);
            PG8_BAR; PG8_WAIT_L(0); PG8_MMA(0, 1, At, B1); PG8_BAR;
            PG8_LDA(At, 0, 1); PG8_STAGE(PG8_SA(0, 0), a2, voffA);
            PG8_BAR; PG8_WAIT_L(0); PG8_MMA(1, 0, At, B0); PG8_BAR; PG8_SCHED;
            PG8_STAGE(PG8_SB(0, 1), b2 + hstepB, voffB);
            PG8_WAIT_V(6); PG8_BAR; PG8_MMA(1, 1, At, B1); PG8_BAR;
            PG8_LDB(B0, 1, 0); PG8_SCHED; PG8_LDA(At, 1, 0); PG8_STAGE(PG8_SA(0, 1), a2 + hstepA, voffA);
            PG8_WAIT_L(8); PG8_BAR; PG8_WAIT_L(0); PG8_MMA(0, 0, At, B0); PG8_BAR; PG8_SCHED;
            PG8_LDB(B1, 1, 1); PG8_STAGE(PG8_SB(1, 0), b3, voffB);
            PG8_BAR; PG8_WAIT_L(0); PG8_MMA(0, 1, At, B1); PG8_BAR;
            PG8_LDA(At, 1, 1); PG8_STAGE(PG8_SA(1, 0), a3, voffA);
            PG8_BAR; PG8_WAIT_L(0); PG8_MMA(1, 0, At, B0); PG8_BAR; PG8_SCHED;
            PG8_STAGE(PG8_SB(1, 1), b3 + hstepB, voffB);
            PG8_WAIT_V(6); PG8_BAR; PG8_MMA(1, 1, At, B1); PG8_BAR;
            }
        }
        if constexpr (ALIGN_EPI) { if (wr == 0) PG8_BAR; }
        if constexpr (!Epi::AFTER_DRAIN) { E(acc, cur, wr, wc, fr, fq); S.done(cur); }
        if (!has_next) break;
#pragma unroll
        for (int a = 0; a < 2; ++a)
#pragma unroll
            for (int b = 0; b < 2; ++b)
#pragma unroll
                for (int m = 0; m < 4; ++m)
#pragma unroll
                    for (int n = 0; n < 2; ++n) acc[a][b][m][n] = (f32x4){0.f, 0.f, 0.f, 0.f};
        cur = nxt; cA = nA; cB = nB; ++ui;
        if constexpr (GATHER) { _Pragma("unroll") for (int h_ = 0; h_ < 2; ++h_) _Pragma("unroll") for (int i_ = 0; i_ < 2; ++i_) gC[h_][i_] = gN[h_][i_]; }
        if constexpr (ALIGN_EPI) { if (wr == 1) PG8_BAR; }
    }
    PG8_WAIT_V(0);
    if constexpr (!ALIGN_EPI) { if (wr == 0) PG8_BAR; }
    PG8_BAR;
    if constexpr (Epi::AFTER_DRAIN) { E.fused(acc, cur, wr, wc, fr, fq, lds, wid, lane); S.done(cur); }
#undef PG8_SA
#undef PG8_GROWS
#undef PG8_STAGE_A
#undef PG8_SB
#undef PG8_STAGE
#undef PG8_LDA
#undef PG8_LDB
#undef PG8_MMA
#undef PG8_WAIT_V
#undef PG8_WAIT_L
#undef PG8_BAR
#undef PG8_SCHED
}
}

namespace att {
constexpr int NW = 8, QBLK = 32, KVBLK = 64;
constexpr float THR = 8.f;
#define ATT_SBAR() __builtin_amdgcn_sched_barrier(0)
__device__ __forceinline__ int crow(int r, int hi) { return (r & 3) + 8 * (r >> 2) + 4 * hi; }
template <int D> __device__ __forceinline__ int kswz(int row, int colB) { return D == 128 ? row * 256 + (colB ^ ((row & 7) << 4)) : row * 128 + (colB ^ (((row >> 1) & 7) << 4)); }
template <int DV> __device__ __forceinline__ int v_st(int k, int c) { const int kk = (k & ~0xC) | ((k & 4) << 1) | ((k & 8) >> 1); return ((kk >> 3) * (DV / 32) + (c >> 5)) * 512 + ((kk & 7) * 32 + (c & 31)) * 2; }
__device__ __forceinline__ int v_rd_base(int lane) { return ((lane & 3) << 3) | (((lane >> 2) & 3) << 6) | (((lane >> 4) & 1) << 5) | (((lane >> 5) & 1) << 8); }
template <int DV> constexpr int v_rd_off(int d0, int ks, int half) { return d0 * 512 + ks * (DV / 32) * 1024 + half * (DV / 32) * 512; }
template <int OFF> __device__ __forceinline__ s16x4 tr_read(int vb) { s16x4 r; asm volatile("ds_read_b64_tr_b16 %0, %1 offset:%2" : "=&v"(r) : "v"(vb), "i"(OFF) : "memory"); return r; }

__device__ __forceinline__ void partialSM(f32x16& p0, f32x16& p1, float& m_reg, float& mn, float& alpha) {
    float pmax = p0[0];
#pragma unroll
    for (int r = 1; r < 16; ++r) pmax = fmaxf(pmax, p0[r]);
#pragma unroll
    for (int r = 0; r < 16; ++r) pmax = fmaxf(pmax, p1[r]);
    { auto rr = __builtin_amdgcn_permlane32_swap(__float_as_uint(pmax), __float_as_uint(pmax), false, false); pmax = fmaxf(__uint_as_float(rr[0]), __uint_as_float(rr[1])); }
    if (__builtin_expect(__all(pmax - m_reg <= THR), 1)) { mn = m_reg; alpha = 1.f; }
    else { mn = fmaxf(m_reg, pmax); alpha = __builtin_amdgcn_exp2f(m_reg - mn); m_reg = mn; }
#pragma unroll
    for (int r = 0; r < 16; ++r) { p0[r] -= mn; p1[r] -= mn; }
#pragma unroll
    for (int r = 0; r < 16; ++r) p0[r] = __builtin_amdgcn_exp2f(p0[r]);
}
__device__ __forceinline__ void finishSM(f32x16& p0, f32x16& p1, float alpha, float& l_reg, bf16x8& pa0, bf16x8& pa1, bf16x8& pa2, bf16x8& pa3) {
#pragma unroll
    for (int r = 0; r < 16; ++r) p1[r] = __builtin_amdgcn_exp2f(p1[r]);
    float ps = 0;
#pragma unroll
    for (int r = 0; r < 16; ++r) ps += p0[r];
#pragma unroll
    for (int r = 0; r < 16; ++r) ps += p1[r];
    { auto rr = __builtin_amdgcn_permlane32_swap(__float_as_uint(ps), __float_as_uint(ps), false, false); ps = __uint_as_float(rr[0]) + __uint_as_float(rr[1]); }
    l_reg = l_reg * alpha + ps;
#define ATT_PK4(P, BASE, OUT) do { unsigned a0 = cvt_pk_bf16(P[BASE + 0], P[BASE + 1]), a1 = cvt_pk_bf16(P[BASE + 2], P[BASE + 3]);   \
    unsigned b0 = cvt_pk_bf16(P[BASE + 4], P[BASE + 5]), b1 = cvt_pk_bf16(P[BASE + 6], P[BASE + 7]);                              \
    auto r0 = __builtin_amdgcn_permlane32_swap(a0, b0, false, false); auto r1 = __builtin_amdgcn_permlane32_swap(a1, b1, false, false); \
    u32x4 w = {r0[0], r1[0], r0[1], r1[1]}; OUT = *reinterpret_cast<bf16x8*>(&w); } while (0)
    ATT_PK4(p0, 0, pa0); ATT_PK4(p0, 8, pa1); ATT_PK4(p1, 0, pa2); ATT_PK4(p1, 8, pa3);
#undef ATT_PK4
}
template <int DQK> __device__ __forceinline__ void qkt(f32x16& p0, f32x16& p1, const char* Ks, const bf16x8* qr, int r32, int hi) {
    p0 = f32x16{}; p1 = f32x16{};
#pragma unroll
    for (int d0 = 0; d0 < DQK / 16; ++d0) { const int cb = (d0 * 16 + hi * 8) * 2;
        const bf16x8 b0 = *reinterpret_cast<const bf16x8*>(Ks + kswz<DQK>(r32, cb));
        const bf16x8 b1 = *reinterpret_cast<const bf16x8*>(Ks + kswz<DQK>(32 + r32, cb));
        p0 = __builtin_amdgcn_mfma_f32_32x32x16_bf16(b0, qr[d0], p0, 0, 0, 0);
        p1 = __builtin_amdgcn_mfma_f32_32x32x16_bf16(b1, qr[d0], p1, 0, 0, 0); }
}
template <int DV, int D0> __device__ __forceinline__ void pv_one(f32x16& od, int vb, bf16x8 pa0, bf16x8 pa1, bf16x8 pa2, bf16x8 pa3) {
    const s16x4 l0 = tr_read<v_rd_off<DV>(D0, 0, 0)>(vb), h0 = tr_read<v_rd_off<DV>(D0, 0, 1)>(vb), l1 = tr_read<v_rd_off<DV>(D0, 1, 0)>(vb), h1 = tr_read<v_rd_off<DV>(D0, 1, 1)>(vb);
    const s16x4 l2 = tr_read<v_rd_off<DV>(D0, 2, 0)>(vb), h2 = tr_read<v_rd_off<DV>(D0, 2, 1)>(vb), l3 = tr_read<v_rd_off<DV>(D0, 3, 0)>(vb), h3 = tr_read<v_rd_off<DV>(D0, 3, 1)>(vb);
    asm volatile("s_waitcnt lgkmcnt(0)" ::: "memory"); ATT_SBAR();
#define ATT_PK(L, H) (bf16x8){L[0], L[1], L[2], L[3], H[0], H[1], H[2], H[3]}
    od = __builtin_amdgcn_mfma_f32_32x32x16_bf16(pa0, ATT_PK(l0, h0), od, 0, 0, 0);
    od = __builtin_amdgcn_mfma_f32_32x32x16_bf16(pa1, ATT_PK(l1, h1), od, 0, 0, 0);
    od = __builtin_amdgcn_mfma_f32_32x32x16_bf16(pa2, ATT_PK(l2, h2), od, 0, 0, 0);
    od = __builtin_amdgcn_mfma_f32_32x32x16_bf16(pa3, ATT_PK(l3, h3), od, 0, 0, 0);
#undef ATT_PK
}
template <int DV> __device__ __forceinline__ void pv_all(f32x16 (&o)[DV / 32], int vb, bf16x8 pa0, bf16x8 pa1, bf16x8 pa2, bf16x8 pa3) {
    pv_one<DV, 0>(o[0], vb, pa0, pa1, pa2, pa3); pv_one<DV, 1>(o[1], vb, pa0, pa1, pa2, pa3);
    if constexpr (DV == 128) { pv_one<DV, 2>(o[2], vb, pa0, pa1, pa2, pa3); pv_one<DV, 3>(o[3], vb, pa0, pa1, pa2, pa3); }
}
template <int DQK, int DV> struct Lay { static constexpr int SHM_V = 64 * DV * 2, SHM_K = 64 * DQK * 2, OFF_V = 0, OFF_K = 2 * SHM_V, OFF_WS = OFF_K + 2 * SHM_K, OFF_STASH = OFF_WS + NW * 64 * 4; };

template <int DQK, int DV, int LDQ, int LDK, int LDV>
__device__ __forceinline__ void attn_pass(const bf16_t* __restrict__ Qb, const bf16_t* __restrict__ Kh, const bf16_t* __restrict__ Vh, int nkeys, char* lds, f32x16 (&o)[DV / 32], float (&rli)[16], int wv) {
    using L = Lay<DQK, DV>;
    constexpr int NLK = DQK / 64, NLV = DV / 64;
    int tid_ = wv * 64 + lane_id(); asm volatile("" : "+v"(tid_));
    const int tid = tid_, wid = tid >> 6, lane = tid & 63, r32 = lane & 31, hi = lane >> 5;
    char* V_lds = lds + L::OFF_V; char* K_lds = lds + L::OFF_K;
    float* ws = (float*)(lds + L::OFF_WS) + wid * 64; float* li_l = ws; float* al_l = ws + 32;
    float m_reg = -1e30f, l_reg = 0.f; bf16x8 qr[DQK / 16];
#pragma unroll
    for (int d = 0; d < DV / 32; ++d) o[d] = f32x16{};
    const bf16_t* Qw = Qb + (size_t)(wid * QBLK + r32) * LDQ + hi * 8;
#pragma unroll
    for (int d0 = 0; d0 < DQK / 16; ++d0) qr[d0] = *reinterpret_cast<const bf16x8*>(Qw + d0 * 16);
    const int krow = DQK == 128 ? (tid >> 4) : (tid >> 3), kcol = DQK == 128 ? (tid & 15) * 8 : (tid & 7) * 8;
    const int vrow = DV == 128 ? (tid >> 4) : (tid >> 3), vcol = DV == 128 ? (tid & 15) * 8 : (tid & 7) * 8;
    const int vb0 = (int)(uintptr_t)V_lds + v_rd_base(lane);
    bf16x8 vsE[NLV], ksE[NLK], vsO[NLV], ksO[NLK];
#define ATT_SLOAD(VS, KS, k0) do { _Pragma("unroll") for (int i_ = 0; i_ < NLV; ++i_) VS[i_] = *reinterpret_cast<const bf16x8*>(&Vh[(size_t)((k0) + vrow + 32 * i_) * LDV + vcol]); \
    _Pragma("unroll") for (int i_ = 0; i_ < NLK; ++i_) KS[i_] = *reinterpret_cast<const bf16x8*>(&Kh[(size_t)((k0) + krow + 32 * i_) * LDK + kcol]); } while (0)
#define ATT_SWRITE(b, VS, KS) do { _Pragma("unroll") for (int i_ = 0; i_ < NLV; ++i_) *(bf16x8*)(V_lds + (b) * L::SHM_V + v_st<DV>(vrow + 32 * i_, vcol)) = VS[i_]; \
    _Pragma("unroll") for (int i_ = 0; i_ < NLK; ++i_) *(bf16x8*)(K_lds + (b) * L::SHM_K + kswz<DQK>(krow + 32 * i_, kcol * 2)) = KS[i_]; } while (0)
#define ATT_SWAIT() do { if constexpr (NLK + NLV == 4) asm volatile("s_waitcnt vmcnt(4)" ::: "memory"); else if constexpr (NLK + NLV == 3) asm volatile("s_waitcnt vmcnt(3)" ::: "memory"); else asm volatile("s_waitcnt vmcnt(2)" ::: "memory"); } while (0)
#define ATT_RESC(a) do { if (__any((a) < 1.f)) { if (hi == 0) al_l[r32] = (a); asm volatile("s_waitcnt lgkmcnt(0)" ::: "memory"); \
    _Pragma("unroll") for (int d = 0; d < DV / 32; ++d) _Pragma("unroll") for (int r = 0; r < 16; ++r) o[d][r] *= al_l[crow(r, hi)]; } } while (0)
    f32x16 pA0, pA1, pB0, pB1; float mnA, mnB, alA, alB; bf16x8 pa0, pa1, pa2, pa3; const int NT = nkeys / KVBLK;
    __syncthreads();
    ATT_SLOAD(vsE, ksE, 0); asm volatile("s_waitcnt vmcnt(0)" ::: "memory"); ATT_SWRITE(0, vsE, ksE); __syncthreads();
    qkt<DQK>(pA0, pA1, K_lds, qr, r32, hi); partialSM(pA0, pA1, m_reg, mnA, alA);
    ATT_SLOAD(vsO, ksO, KVBLK); if (2 < NT) ATT_SLOAD(vsE, ksE, 2 * KVBLK);
    ATT_SWAIT(); ATT_SWRITE(1, vsO, ksO); __syncthreads();
    for (int j = 1; j + 1 < NT; j += 2) {
        ATT_SBAR(); qkt<DQK>(pB0, pB1, K_lds + L::SHM_K, qr, r32, hi);
        finishSM(pA0, pA1, alA, l_reg, pa0, pa1, pa2, pa3); ATT_SBAR();
        ATT_SLOAD(vsO, ksO, (j + 2) * KVBLK); ATT_SBAR();
        pv_all<DV>(o, vb0, pa0, pa1, pa2, pa3); partialSM(pB0, pB1, m_reg, mnB, alB);
        __syncthreads(); ATT_SWAIT(); ATT_SWRITE(0, vsE, ksE);
        ATT_RESC(alB); __syncthreads();
        ATT_SBAR(); qkt<DQK>(pA0, pA1, K_lds, qr, r32, hi);
        finishSM(pB0, pB1, alB, l_reg, pa0, pa1, pa2, pa3); ATT_SBAR();
        if (j + 3 < NT) ATT_SLOAD(vsE, ksE, (j + 3) * KVBLK); ATT_SBAR();
        pv_all<DV>(o, vb0 + L::SHM_V, pa0, pa1, pa2, pa3); partialSM(pA0, pA1, m_reg, mnA, alA);
        __syncthreads(); ATT_SWAIT(); ATT_SWRITE(1, vsO, ksO);
        ATT_RESC(alA); __syncthreads();
    }
    ATT_SBAR(); qkt<DQK>(pB0, pB1, K_lds + L::SHM_K, qr, r32, hi);
    finishSM(pA0, pA1, alA, l_reg, pa0, pa1, pa2, pa3); ATT_SBAR();
    pv_all<DV>(o, vb0, pa0, pa1, pa2, pa3); partialSM(pB0, pB1, m_reg, mnB, alB);
    __syncthreads(); ATT_RESC(alB);
    finishSM(pB0, pB1, alB, l_reg, pa0, pa1, pa2, pa3); ATT_SBAR();
    pv_all<DV>(o, vb0 + L::SHM_V, pa0, pa1, pa2, pa3);
    if (hi == 0) li_l[r32] = l_reg; asm volatile("s_waitcnt lgkmcnt(0)" ::: "memory");
#pragma unroll
    for (int r = 0; r < 16; ++r) rli[r] = __builtin_amdgcn_rcpf(li_l[crow(r, hi)]);
#undef ATT_SLOAD
#undef ATT_SWRITE
#undef ATT_SWAIT
#undef ATT_RESC
}
template <int DV, int LDO> __device__ __forceinline__ void store_o(bf16_t* Ob, const f32x16 (&o)[DV / 32], const float (&rli)[16], int wv) {
    int tid_ = wv * 64 + lane_id(); asm volatile("" : "+v"(tid_));
    const int tid = tid_, wid = tid >> 6, lane = tid & 63, r32 = lane & 31, hi = lane >> 5;
    bf16_t* Ow = Ob + (size_t)(wid * QBLK) * LDO;
#pragma unroll
    for (int r = 0; r < 16; ++r) { const int orow = crow(r, hi);
#pragma unroll
        for (int d0 = 0; d0 < DV / 32; ++d0) Ow[(size_t)orow * LDO + d0 * 32 + r32] = f2bf(o[d0][r] * rli[r]); }
}
__device__ __forceinline__ void unit_a(const bf16_t* PROJ, bf16_t* OBR, int b, int h, int qb, float lam, float lam_init, const float* subg, char* lds, int wv) {
    using L = Lay<64, 128>;
    int tid_ = wv * 64 + lane_id(); asm volatile("" : "+v"(tid_));
    const int tid = tid_, wid = tid >> 6, lane = tid & 63, r32 = lane & 31, hi = lane >> 5;
    const bf16_t* kv = PROJ + (size_t)b * SEQ * D_IN; const size_t qrow = (size_t)b * SEQ + qb * 256;
    unsigned* stash = (unsigned*)(lds + L::OFF_STASH) + wid * 2048 + lane;
    f32x16 o[4]; float rli[16];
#pragma unroll 1
    for (int c = 0; c < 2; ++c) {
        attn_pass<64, 128, D_IN, D_IN, D_IN>(PROJ + qrow * D_IN + C_AQ + h * 128 + c * 64, kv + C_AK + h * 128 + c * 64, kv + C_AV + h * 128, SEQ, lds, o, rli, wv);
        if (c == 0) {
#pragma unroll
            for (int d0 = 0; d0 < 4; ++d0)
#pragma unroll
                for (int r = 0; r < 16; r += 2) stash[(d0 * 8 + (r >> 1)) * 64] = cvt_pk_bf16(o[d0][r] * rli[r], o[d0][r + 1] * rli[r + 1]);
        }
    }
    asm volatile("s_waitcnt lgkmcnt(0)" ::: "memory");
    float ss[16];
#pragma unroll
    for (int r = 0; r < 16; ++r) ss[r] = 0.f;
#pragma unroll
    for (int d0 = 0; d0 < 4; ++d0)
#pragma unroll
        for (int r = 0; r < 16; r += 2) { const unsigned w = stash[(d0 * 8 + (r >> 1)) * 64];
            const float c0 = __uint_as_float(w << 16) - lam * o[d0][r] * rli[r], c1 = __uint_as_float(w & 0xffff0000u) - lam * o[d0][r + 1] * rli[r + 1];
            o[d0][r] = c0; o[d0][r + 1] = c1; ss[r] += c0 * c0; ss[r + 1] += c1 * c1; }
#pragma unroll
    for (int r = 0; r < 16; ++r) { float s = ss[r]; s += __shfl_xor(s, 1); s += __shfl_xor(s, 2); s += __shfl_xor(s, 4); s += __shfl_xor(s, 8); s += __shfl_xor(s, 16);
        ss[r] = rsqrtf(s * (1.f / 128.f) + EPS) * (1.f - lam_init); }
    bf16_t* Ow = OBR + (qrow + wid * QBLK) * OBR_W + h * 128;
#pragma unroll
    for (int d0 = 0; d0 < 4; ++d0) { const float g = subg[d0 * 32 + r32];
#pragma unroll
        for (int r = 0; r < 16; ++r) Ow[(size_t)crow(r, hi) * OBR_W + d0 * 32 + r32] = f2bf(o[d0][r] * ss[r] * g); }
}
__device__ __forceinline__ void unit_b(const bf16_t* PROJ, bf16_t* OBR, int b, int qh, int qb, char* lds, int wv) {
    const bf16_t* kv = PROJ + (size_t)b * SEQ * D_IN; const size_t qrow = (size_t)b * SEQ + qb * 256;
    f32x16 o[2]; float rli[16];
    attn_pass<64, 64, D_IN, D_IN, D_IN>(PROJ + qrow * D_IN + C_BQ + qh * 64, kv + C_BK + (qh >> 2) * 64, kv + C_BV + (qh >> 2) * 64, SEQ, lds, o, rli, wv);
    store_o<64, OBR_W>(OBR + qrow * OBR_W + 512 + qh * 64, o, rli, wv);
}
__device__ __forceinline__ void unit_c(const bf16_t* PROJ, const bf16_t* MEMKV, bf16_t* OBR, int b, int h, int qb, char* lds, int wv) {
    const bf16_t* kv = MEMKV + (size_t)b * MEM_LEN * 1024; const size_t qrow = (size_t)b * SEQ + qb * 256;
    f32x16 o[4]; float rli[16];
    attn_pass<128, 128, D_IN, 1024, 1024>(PROJ + qrow * D_IN + C_CQ + h * 128, kv + h * 128, kv + 512 + h * 128, MEM_LEN, lds, o, rli, wv);
    store_o<128, OBR_W>(OBR + qrow * OBR_W + 1024 + h * 128, o, rli, wv);
}
#undef ATT_SBAR
}

__device__ __forceinline__ void row_rmsnorm(const float* __restrict__ xrow, const float* __restrict__ g, bf16_t* __restrict__ orow, float* __restrict__ xcopy, int lane) {
    const f32x4* xr = (const f32x4*)xrow; f32x4 v[4]; float s = 0.f;
#pragma unroll
    for (int j = 0; j < 4; ++j) { v[j] = xr[lane + 64 * j]; s += v[j].x * v[j].x + v[j].y * v[j].y + v[j].z * v[j].z + v[j].w * v[j].w; }
    const float rs = rsqrtf(wave_sum(s) * (1.f / DM) + EPS);
#pragma unroll
    for (int j = 0; j < 4; ++j) { const f32x4 gg = ((const f32x4*)g)[lane + 64 * j];
        if (xcopy) ((f32x4*)xcopy)[lane + 64 * j] = v[j];
        u32x2 o; o.x = cvt_pk_bf16(v[j].x * rs * gg.x, v[j].y * rs * gg.y); o.y = cvt_pk_bf16(v[j].z * rs * gg.z, v[j].w * rs * gg.w);
        ((u32x2*)orow)[lane + 64 * j] = o; }
}
__device__ __forceinline__ void route_block(const float* __restrict__ X, const bf16_t* __restrict__ rt_tab, const float* __restrict__ brg, const float* __restrict__ bre, int* __restrict__ experts, float* __restrict__ weights,
                                            int* __restrict__ rank, unsigned* __restrict__ cnt, float* __restrict__ rstd, int* __restrict__ list, const float* __restrict__ g2, bf16_t* __restrict__ H2, int rb, const bf16x8 (&Bh)[3][4], const bf16x8 (&Bl)[3][4], LAS float* slab, int tid, int wave) {
    const int lane = tid & 63, r = lane & 15, kq = lane >> 4;
    LAS float* ssq = slab + 8 * 64 * 48; LAS float* rs_l = ssq + 8 * 64;
#pragma unroll 1
    for (int rt = 0; rt < 4; ++rt) {
        const float* xp = X + (size_t)(rb * 64 + rt * 16 + r) * DM + 128 * wave + 8 * kq;
        f32x4 acc[3]; float ss = 0.f;
#pragma unroll
        for (int t = 0; t < 3; ++t) acc[t] = (f32x4){0.f, 0.f, 0.f, 0.f};
#pragma unroll
        for (int sI = 0; sI < 4; ++sI) {
            const f32x4 a0 = *(const f32x4*)(xp + 32 * sI), a1 = *(const f32x4*)(xp + 32 * sI + 4);
            ss += (a0[0] * a0[0] + a0[1] * a0[1]) + (a0[2] * a0[2] + a0[3] * a0[3]) + (a1[0] * a1[0] + a1[1] * a1[1]) + (a1[2] * a1[2] + a1[3] * a1[3]);
            u32x4 hw, lw;
            hw.x = cvt_pk_bf16(a0[0], a0[1]); hw.y = cvt_pk_bf16(a0[2], a0[3]); hw.z = cvt_pk_bf16(a1[0], a1[1]); hw.w = cvt_pk_bf16(a1[2], a1[3]);
            lw.x = cvt_pk_bf16(a0[0] - __uint_as_float(hw.x << 16), a0[1] - __uint_as_float(hw.x & 0xffff0000u)); lw.y = cvt_pk_bf16(a0[2] - __uint_as_float(hw.y << 16), a0[3] - __uint_as_float(hw.y & 0xffff0000u));
            lw.z = cvt_pk_bf16(a1[0] - __uint_as_float(hw.z << 16), a1[1] - __uint_as_float(hw.z & 0xffff0000u)); lw.w = cvt_pk_bf16(a1[2] - __uint_as_float(hw.w << 16), a1[3] - __uint_as_float(hw.w & 0xffff0000u));
            const bf16x8 Ah = __builtin_bit_cast(bf16x8, hw), Al = __builtin_bit_cast(bf16x8, lw);
#pragma unroll
            for (int t = 0; t < 3; ++t) {
                acc[t] = __builtin_amdgcn_mfma_f32_16x16x32_bf16(Ah, Bh[t][sI], acc[t], 0, 0, 0);
                acc[t] = __builtin_amdgcn_mfma_f32_16x16x32_bf16(Al, Bh[t][sI], acc[t], 0, 0, 0);
                acc[t] = __builtin_amdgcn_mfma_f32_16x16x32_bf16(Ah, Bl[t][sI], acc[t], 0, 0, 0);
            }
        }
        ss += __shfl_xor(ss, 16); ss += __shfl_xor(ss, 32);
        if (kq == 0) ssq[wave * 64 + rt * 16 + r] = ss;
#pragma unroll
        for (int t = 0; t < 3; ++t)
#pragma unroll
            for (int e = 0; e < 4; ++e) slab[(wave * 64 + rt * 16 + 4 * kq + e) * 48 + 16 * t + r] = acc[t][e];
    }
    __syncthreads();
    if (tid < 64) {
        const int row = rb * 64 + tid;
        float lg[36]; float ss = 0.f;
#pragma unroll
        for (int c = 0; c < 36; ++c) lg[c] = 0.f;
#pragma unroll 1
        for (int w = 0; w < 8; ++w) { ss += ssq[w * 64 + tid];
#pragma unroll
            for (int c = 0; c < 36; ++c) lg[c] += slab[(w * 64 + tid) * 48 + c]; }
        const float rs = rsqrtf(ss * (1.f / DM) + EPS);
        rstd[row] = rs;
        int gi = 0; float gm = lg[0] * rs + brg[0];
#pragma unroll
        for (int i = 1; i < 4; ++i) { const float l = lg[i] * rs + brg[i]; if (l > gm) { gm = l; gi = i; } }
        float gs = 0.f;
#pragma unroll
        for (int i = 0; i < 4; ++i) gs += __expf(lg[i] * rs + brg[i] - gm);
        const float gp = 1.f / gs;
        float el[8];
#pragma unroll
        for (int i = 0; i < 8; ++i) el[i] = 0.f;
#pragma unroll
        for (int gq = 0; gq < 4; ++gq) if (gq == gi) {
#pragma unroll
            for (int i = 0; i < 8; ++i) el[i] = lg[4 + gq * 8 + i] * rs + bre[gq * 8 + i]; }
        int i0 = 0; float l0 = el[0];
#pragma unroll
        for (int i = 1; i < 8; ++i) if (el[i] > l0) { l0 = el[i]; i0 = i; }
        int i1 = -1; float l1 = -INFINITY;
#pragma unroll
        for (int i = 0; i < 8; ++i) if (i != i0 && el[i] > l1) { l1 = el[i]; i1 = i; }
        const float p1 = __expf(l1 - l0), inv = 1.f / (1.f + p1);
        const int e0 = gi * 8 + i0, e1 = gi * 8 + i1;
        experts[row * 2] = e0; experts[row * 2 + 1] = e1;
        weights[row * 2] = gp * inv; weights[row * 2 + 1] = gp * p1 * inv;
        const int r0 = (int)atomicAdd(cnt + e0, 1u), r1 = (int)atomicAdd(cnt + e1, 1u);
        rank[row * 2] = r0; rank[row * 2 + 1] = r1;
        list[e0 * LCAP + r0] = row * 2; list[e1 * LCAP + r1] = row * 2 + 1;
        rs_l[tid] = rs;
    }
    __syncthreads();
#pragma unroll 1
    for (int rr = 0; rr < 8; ++rr) {
        const int row = rb * 64 + wave * 8 + rr; const float rs = rs_l[wave * 8 + rr];
        const f32x4* xr = (const f32x4*)(X + (size_t)row * DM); u32x2* dst = (u32x2*)(H2 + (size_t)row * DM);
#pragma unroll
        for (int j = 0; j < 4; ++j) { const f32x4 v = xr[lane + 64 * j], gg = ((const f32x4*)g2)[lane + 64 * j];
            u32x2 o; o.x = cvt_pk_bf16(v.x * rs * gg.x, v.y * rs * gg.y); o.y = cvt_pk_bf16(v.z * rs * gg.z, v.w * rs * gg.w); dst[lane + 64 * j] = o; }
    }
    __syncthreads();
}
__device__ __forceinline__ void moe_tables(const unsigned* cnt, volatile LAS int* mt, int tid) {
    if (tid == 0) { int off = 0, nt = 0;
        for (int e = 0; e < NEXP; ++e) { const int c = (int)__hip_atomic_load(cnt + e, __ATOMIC_RELAXED, __HIP_MEMORY_SCOPE_AGENT), t = (c + MOE_TILE - 1) / MOE_TILE;
            mt[e] = off; mt[32 + e] = c; mt[64 + e] = nt; for (int i = 0; i < t; ++i) mt[96 + nt + i] = e; nt += t; off += t * MOE_TILE; }
        mt[256] = nt; }
    __syncthreads();
}
__device__ __forceinline__ void moe_rowtabs(volatile LAS int* mt, const int* __restrict__ list, const float* __restrict__ weights, LAS unsigned* rowtab, LAS float* wtab, int bx, int G, int tid) {
    const int ntiles = mt[256];
#pragma unroll 1
    for (int i = 0; i < 4; ++i) { const long L = (long)i * G + bx; if (L >= (long)ntiles * 4) break;
        if (tid < 256) { const int tile = (int)(L >> 2), e = mt[96 + tile], q = (tile - mt[64 + e]) * 256 + tid; const bool valid = q < mt[32 + e];
            const int a = valid ? list[e * LCAP + q] : 0;
            rowtab[i * 256 + tid] = (unsigned)(a >> 1) * (unsigned)(DM * 2); wtab[i * 256 + tid] = valid ? weights[a] : 0.f; } }
    __syncthreads();
}
__device__ __forceinline__ void row_combine_norm(float* __restrict__ X, const bf16_t* __restrict__ YB, const int* __restrict__ dest, const float* __restrict__ g, bf16_t* __restrict__ H, float* __restrict__ OUT, int row, int lane, bool poison, int d0, int d1) {
    f32x4* xr = (f32x4*)(X + (size_t)row * DM);
    f32x4 v[4]; float s = 0.f;
#pragma unroll
    for (int j = 0; j < 4; ++j) { v[j] = xr[lane + 64 * j];
        const u32x2 a = ((const u32x2*)(YB + (size_t)d0 * DM))[lane + 64 * j], b = ((const u32x2*)(YB + (size_t)d1 * DM))[lane + 64 * j];
        v[j].x += __uint_as_float(a.x << 16) + __uint_as_float(b.x << 16); v[j].y += __uint_as_float(a.x & 0xffff0000u) + __uint_as_float(b.x & 0xffff0000u);
        v[j].z += __uint_as_float(a.y << 16) + __uint_as_float(b.y << 16); v[j].w += __uint_as_float(a.y & 0xffff0000u) + __uint_as_float(b.y & 0xffff0000u);
        s += v[j].x * v[j].x + v[j].y * v[j].y + v[j].z * v[j].z + v[j].w * v[j].w; }
    float rs = rsqrtf(wave_sum(s) * (1.f / DM) + EPS);
    if (poison) rs = __builtin_nanf("");
#pragma unroll
    for (int j = 0; j < 4; ++j) { const f32x4 gg = ((const f32x4*)g)[lane + 64 * j];
        if (H) { xr[lane + 64 * j] = v[j];
            u32x2 o; o.x = cvt_pk_bf16(v[j].x * rs * gg.x, v[j].y * rs * gg.y); o.y = cvt_pk_bf16(v[j].z * rs * gg.z, v[j].w * rs * gg.w);
            ((u32x2*)(H + (size_t)row * DM))[lane + 64 * j] = o; }
        else { f32x4 o; o.x = v[j].x * rs * gg.x; o.y = v[j].y * rs * gg.y; o.z = v[j].z * rs * gg.z; o.w = v[j].w * rs * gg.w; ((f32x4*)(OUT + (size_t)row * DM))[lane + 64 * j] = o; }
    }
}
struct TrItem { const float* src; bf16_t* dst; int ldw, K; };
__device__ __forceinline__ void tr_decode(int it, int lane, const float* const* in, bf16_t* WB, const float*& sp, int& ldw, bf16_t*& dp, int& K) {
    const float* src; int segA, segB, kb, tb, dk0 = 0; bf16_t* dst;
    if (it < 28800) {
        const int l = it / 14400; int r = it % 14400; bf16_t* WBl = WB + (size_t)l * WB_LAYER;
        if (r < 1472) { kb = r / 92; tb = r % 92; const int pn = tb >> 2, bj = (tb >> 1) & 1, w0 = 2 * (tb & 1); src = in[5] + (size_t)l * DM * D_IN; ldw = D_IN; K = DM; segA = 256 * pn + 64 * w0 + 32 * bj; segB = segA + 64; dst = WBl + WB_IN; }
        else if (r < 1856) { r -= 1472; const int i = r >> 7; r &= 127; kb = r >> 4; tb = r & 15; src = in[13 + i] + (size_t)l * 512 * DM; ldw = DM; K = 512; segA = 64 * tb; segB = segA + 32; dst = WBl + WB_UP + (size_t)i * 1024 * 512; }
        else if (r < 2112) { r -= 1856; kb = r >> 4; tb = r & 15; src = in[16] + (size_t)l * DM * DM; ldw = DM; K = DM; segA = 64 * tb; segB = segA + 32; dst = WBl + WB_OUT; }
        else if (r < 10304) { r -= 2112; const int e = r >> 8; r &= 255; kb = r >> 4; tb = r & 15; const int pn = tb >> 2, sg = (tb >> 1) & 1, jb = tb & 1;
            src = in[sg ? 23 : 22] + (size_t)(l * NEXP + e) * DM * DEXP; ldw = DEXP; K = DM; segA = 128 * pn + 64 * jb; segB = segA + 32; dst = WBl + WB_GU + (size_t)e * 1024 * 1024; }
        else { r -= 10304; const int e = r >> 7; r &= 127; kb = r >> 4; tb = r & 15; src = in[24] + (size_t)(l * NEXP + e) * DEXP * DM; ldw = DM; K = DEXP; segA = 64 * tb; segB = segA + 32; dst = WBl + WB_DN + (size_t)e * 1024 * 512; }
    } else { const int r = it - 28800; kb = r >> 4; tb = r & 15; const int pn = tb >> 2, bj = (tb >> 1) & 1, w0 = 2 * (tb & 1); src = in[3]; ldw = 1024; K = DM; segA = 256 * pn + 64 * w0 + 32 * bj; segB = segA + 64; dst = WB + WB_MEMKV; }
    const int q = lane & 15;
    sp = src + (size_t)(kb * 64 + (lane >> 4)) * ldw + (q < 8 ? segA + 4 * q : segB + 4 * (q - 8));
    dp = dst + (size_t)(64 * tb + (lane >> 3)) * K + dk0 + kb * 64 + 8 * (lane & 7);
}
__device__ __forceinline__ void tr_load(f32x4 (&v)[16], const float* sp, int ldw) {
#pragma unroll
    for (int i = 0; i < 16; ++i) v[i] = *(const f32x4*)(sp + (size_t)(4 * i) * ldw);
}
__device__ __forceinline__ void tr_store(const f32x4 (&v)[16], bf16_t* dp, int K, LAS float* scr, int lane) {
    const int q = lane & 15, kq = lane >> 4;
#pragma unroll
    for (int i = 0; i < 16; ++i) { LAS float* w = scr + (4 * i + kq) * 65 + 4 * q; w[0] = v[i][0]; w[1] = v[i][1]; w[2] = v[i][2]; w[3] = v[i][3]; }
    asm volatile("s_waitcnt lgkmcnt(0)" ::: "memory");
    const int c = lane & 7, n8 = lane >> 3;
#pragma unroll
    for (int j = 0; j < 8; ++j) { const LAS float* sI = scr + (8 * c) * 65 + n8 + 8 * j;
        u32x4 o; o.x = cvt_pk_bf16(sI[0 * 65], sI[1 * 65]); o.y = cvt_pk_bf16(sI[2 * 65], sI[3 * 65]); o.z = cvt_pk_bf16(sI[4 * 65], sI[5 * 65]); o.w = cvt_pk_bf16(sI[6 * 65], sI[7 * 65]);
        *(u32x4*)(dp + (size_t)(8 * j) * K) = o; }
    asm volatile("s_waitcnt lgkmcnt(0)" ::: "memory");
}

#define XB_TMO      128
#define XB_XCNT(j)  (256  + 64 * (j))
#define XB_XSUB(j)  (1280 + 64 * (j))
#define XB_XGEN(j)  (2304 + 64 * (j))
#define XB_TOP      3328
#define XB_TOPGEN   3392
#define XCD_BAR_WORDS 3456
#define XB_SPIN_CAP (1u << 18)

__device__ __forceinline__ unsigned xb_ld(unsigned* p)              { return __hip_atomic_load(p, __ATOMIC_RELAXED, __HIP_MEMORY_SCOPE_AGENT); }
__device__ __forceinline__ unsigned xb_add(unsigned* p, unsigned v) { return __hip_atomic_fetch_add(p, v, __ATOMIC_RELAXED, __HIP_MEMORY_SCOPE_AGENT); }
__device__ __forceinline__ unsigned xb_xcc_id() { return (unsigned)__builtin_amdgcn_s_getreg((3 << 11) | 20) & 0xFu; }
#define XB_SPIN(cond, bar) do { unsigned _sp = 0; while (cond) { __builtin_amdgcn_s_sleep(1); \
    if ((++_sp & 255u) == 0u) { if (xb_ld(&(bar)[XB_TMO])) break; if (_sp > XB_SPIN_CAP) { atomicAdd(&(bar)[XB_TMO], 1u); break; } } } } while (0)

struct XcdBarrier {
    unsigned* bar; unsigned x; unsigned w0;
    volatile LAS unsigned* st;
};

__device__ __forceinline__ XcdBarrier xcd_barrier_post(unsigned* bar, volatile LAS unsigned* st, unsigned is_wave0) {
    XcdBarrier b; b.bar = bar; b.x = xb_xcc_id(); b.st = st; b.w0 = is_wave0;
    if (is_wave0 && lane_id() == 0) (void)xb_add(&bar[XB_XCNT(b.x)], 1u);
    return b;
}
__device__ __forceinline__ void xcd_barrier_complete(unsigned* bar, unsigned x, unsigned& nloc, unsigned& nx) {
    const unsigned G = gridDim.x * gridDim.y * gridDim.z;
    unsigned sum, cnt, mine, sp = 0u;
    for (;;) {
        sum = 0u; cnt = 0u; mine = 0u;
#pragma unroll
        for (unsigned j = 0; j < 16; ++j) { const unsigned c = xb_ld(&bar[XB_XCNT(j)]); sum += c; cnt += (c > 0u) ? 1u : 0u; mine = (j == x) ? c : mine; }
        if (sum == G) break;
        __builtin_amdgcn_s_sleep(1);
        if ((++sp & 255u) == 0u) { if (xb_ld(&bar[XB_TMO])) break; if (sp > XB_SPIN_CAP) { atomicAdd(&bar[XB_TMO], 1u); break; } }
    }
    nloc = mine > 0u ? mine : 1u; nx = cnt > 0u ? cnt : 1u;
}

__device__ __forceinline__ void xcd_barrier(const XcdBarrier& b) {
    asm volatile("s_waitcnt vmcnt(0)" ::: "memory");
    __syncthreads();
    if (b.w0 && lane_id() == 0) {
        unsigned* bar = b.bar;
        __builtin_amdgcn_s_waitcnt(0);
        unsigned nloc = b.st[0], nx = b.st[1];
        if (nloc == 0u) { xcd_barrier_complete(bar, b.x, nloc, nx); b.st[0] = nloc; b.st[1] = nx; }
        const unsigned old = xb_add(&bar[XB_XSUB(b.x)], 1u);
        const unsigned gen = old / nloc;
        if (old + 1u == (gen + 1u) * nloc) {
            __builtin_amdgcn_fence(__ATOMIC_RELEASE, "agent");
            asm volatile("s_waitcnt vmcnt(0)" ::: "memory");
            const unsigned og = xb_add(&bar[XB_TOP], 1u);
            const unsigned tg = og / nx;
            if (og + 1u == (tg + 1u) * nx) xb_add(&bar[XB_TOPGEN], 1u);
            else XB_SPIN(xb_ld(&bar[XB_TOPGEN]) == tg, bar);
            __builtin_amdgcn_fence(__ATOMIC_ACQUIRE, "agent");
            xb_add(&bar[XB_XGEN(b.x)], 1u);
            asm volatile("s_waitcnt vmcnt(0)" ::: "memory");
        } else {
            XB_SPIN(xb_ld(&bar[XB_XGEN(b.x)]) == gen, bar);
            __builtin_amdgcn_fence(__ATOMIC_ACQUIRE, "agent");
            asm volatile("s_waitcnt vmcnt(0)" ::: "memory");
        }
    }
    __syncthreads();
}
constexpr int NWAVES = 8;
constexpr int RING_BYTES = 131072, LDSCTL_OFF = 135168, LDS_BYTES = 147456;
constexpr int CW_BAR = 4096, BAR_REGION = 4096;
static_assert(XCD_BAR_WORDS <= BAR_REGION && (CW_BAR + (N_PHASES + 1) * BAR_REGION) * 4 <= (int)MiB, "barrier regions inside the memset region");
static_assert(pg8::STAGE_BYTES <= RING_BYTES && att::Lay<64, 128>::OFF_STASH + 65536 <= RING_BYTES && att::Lay<128, 128>::OFF_WS + 2048 <= RING_BYTES, "LDS map");

struct Args { const float* in[26]; float* out; unsigned char* ws; int ph_lo, ph_hi, li, pad; };

__global__ void __launch_bounds__(NWAVES * 64, 2) mk_fwd(Args args) {
    extern __shared__ __attribute__((aligned(16))) unsigned char lds[];
    const int wave = __builtin_amdgcn_readfirstlane((int)threadIdx.x >> 6);
#define lane0 lane_id()
#define tid0 (wave * 64 + lane_id())
    const int G = gridDim.x, bx = blockIdx.x, vcu = (G % 8 == 0) ? (bx % 8) * (G / 8) + bx / 8 : bx;
    LAS unsigned char* ldsl = (LAS unsigned char*)lds;
    volatile LAS unsigned* MISC = (volatile LAS unsigned*)(ldsl + LDSCTL_OFF);
    for (int u = tid0; u < (LDS_BYTES - LDSCTL_OFF) / 4; u += NWAVES * 64) ((LAS unsigned*)(ldsl + LDSCTL_OFF))[u] = 0u;
    __syncthreads();
    unsigned char* ws = args.ws;
    unsigned* ctl = (unsigned*)(ws + WS_CTL);
    XcdBarrier bar = xcd_barrier_post(ctl + CW_BAR + args.li * BAR_REGION, MISC + 8, wave == 0 ? 1u : 0u);
    const float* x = args.in[0]; const float* mem = args.in[1]; const float* mem_g = args.in[2]; const float* w_memkv = args.in[3];
    const float* norm1_g = args.in[4]; const float* w_in = args.in[5];
    const float* lq1 = args.in[6]; const float* lk1 = args.in[7]; const float* lq2 = args.in[8]; const float* lk2 = args.in[9];
    const float* subln_g = args.in[10]; const float* qn_g = args.in[11]; const float* kn_g = args.in[12];
    const float* w_out = args.in[16];
    const float* norm2_g = args.in[17]; const float* w_rg = args.in[18]; const float* b_rg = args.in[19]; const float* w_re = args.in[20]; const float* b_re = args.in[21];
    const float* w_eg = args.in[22]; const float* w_eu = args.in[23]; const float* w_ed = args.in[24]; const float* final_g = args.in[25];
    float* X = args.out;
    bf16_t* MEMKV = (bf16_t*)(ws + WS_MEMKV); bf16_t* HM = (bf16_t*)(ws + WS_HM); bf16_t* PROJ = (bf16_t*)(ws + WS_PROJ); bf16_t* OBR = (bf16_t*)(ws + WS_OBR);
    bf16_t* BUF = (bf16_t*)(ws + WS_BUF); bf16_t* YB = (bf16_t*)(ws + WS_YB); bf16_t* HID = (bf16_t*)(ws + WS_HID); bf16_t* HMEM = OBR;
    bf16_t* WB = (bf16_t*)(ws + WS_WB);
    float* tab1 = (float*)(ws + WS_TAB); float* tab2 = tab1 + SEQ * 32 * 2;
    int* experts = (int*)(ws + WS_ROUTE + RT_EXP); float* weights = (float*)(ws + WS_ROUTE + RT_WGT); int* rank = (int*)(ws + WS_ROUTE + RT_RANK); int* dest = (int*)(ws + WS_ROUTE + RT_DEST);
    float* roww = (float*)(ws + WS_ROUTE + RT_ROWW); int* tile_tab = (int*)(ws + WS_ROUTE + RT_TILE); float* rstd = (float*)(ws + WS_ROUTE + RT_RSTD);
    const int gw = bx * NWAVES + wave, NGW = G * NWAVES;
    const int lo = args.ph_lo, hi = args.ph_hi;
#ifndef STAGE_MASK
#define STAGE_MASK 0x3FFu
#endif
#define IN(k) (lo <= (k) && (k) < hi)
#define ST(s) ((STAGE_MASK >> (s)) & 1u)
#ifndef REP_MASK
#define REP_MASK 0u
#endif
#define NREP(s) (((REP_MASK >> (s)) & 1u) ? 2 : 1)
#ifndef DBL_BAR
#define DBL_BAR 0
#endif
#define SEAM(k) do { if (IN(k) && IN((k) + 1)) { xcd_barrier(bar); if (DBL_BAR) xcd_barrier(bar); } } while (0)

    if (ST(0) && IN(0))
  for (int rep_ = 0; rep_ < NREP(0); ++rep_) {
        int lane = lane0, tid = tid0; asm volatile("" : "+v"(lane), "+v"(tid));
        LAS float* scr = (LAS float*)(ldsl + wave * 16640);
        {   constexpr int NITEMS = 29056;
            f32x4 cur[16], nxt[16]; const float* sp; bf16_t* dp; int ldw, K; const float* sp2; bf16_t* dp2; int ldw2, K2;
            int it = gw;
            if (it < NITEMS) { tr_decode(it, lane, args.in, WB, sp, ldw, dp, K); tr_load(cur, sp, ldw); }
            for (; it < NITEMS; it += NGW) {
                const bool more = it + NGW < NITEMS;
                if (more) { tr_decode(it + NGW, lane, args.in, WB, sp2, ldw2, dp2, K2); tr_load(nxt, sp2, ldw2); }
                tr_store(cur, dp, K, scr, lane);
                if (more) {
#pragma unroll
                    for (int i = 0; i < 16; ++i) cur[i] = nxt[i];
                    dp = dp2; K = K2; }
            }
        }
        for (int idx = bx * (NWAVES * 64) + tid; idx < SEQ * 32; idx += G * NWAVES * 64) { const int pos = idx >> 5, i = idx & 31; float s, c;
            sincosf((float)pos * inv1d(i), &s, &c); tab1[idx * 2] = c; tab1[idx * 2 + 1] = s;
            sincosf(ang2d(pos, i), &s, &c); tab2[idx * 2] = c; tab2[idx * 2 + 1] = s; }
        for (int idx = bx * (NWAVES * 64) + tid; idx < DEPTH * 48 * 1024; idx += G * NWAVES * 64) { const int l = idx / (48 * 1024), c = (idx >> 10) % 48, k = idx & 1023;
            const float w = c < 4 ? w_rg[((size_t)l * DM + k) * 4 + c] : c < 36 ? w_re[((size_t)l * DM + k) * 32 + (c - 4)] : 0.f, v = w * norm2_g[l * DM + k];
            const bf16_t h = f2bf(v); bf16_t* t = WB + WB_RT + (size_t)l * 2 * 48 * 1024 + (size_t)c * 1024 + k; t[0] = h; t[48 * 1024] = f2bf(v - bf2f(h)); }
        for (int m = gw; m < M; m += NGW) row_rmsnorm(x + (size_t)m * DM, norm1_g, HM + (size_t)m * DM, nullptr, lane);
        for (int m = gw; m < MM; m += NGW) row_rmsnorm(mem + (size_t)m * DM, mem_g, HMEM + (size_t)m * DM, nullptr, lane);
    }
    SEAM(0);
#pragma unroll 1
    for (int l = 0; l < DEPTH; ++l) {
        const int pb = 1 + 9 * l;
        const bf16_t* WBl = WB + (size_t)l * WB_LAYER;
        if (ST(1) && IN(pb + 0))
      for (int rep_ = 0; rep_ < NREP(1); ++rep_) {
            pg8::Gemm g{DM, DM};
            pg8::SchedProj S{bx, G, 1472, l == 0 ? 1504 : 1472, (const char*)HM, (const char*)(WBl + WB_IN), (const char*)HMEM, (const char*)(WB + WB_MEMKV)};
            pg8::EpiProj E{PROJ, MEMKV, tab1, tab2, qn_g + l * 64, kn_g + l * 64};
            pg8::gemm_phase<pg8::EpiProj, pg8::SchedProj, true, true>(ldsl, g, S, E, wave);
        }
        SEAM(pb + 0);
        if (ST(2) && IN(pb + 1))
      for (int rep_ = 0; rep_ < NREP(2); ++rep_) {
            int lane = lane0; asm volatile("" : "+v"(lane));
            const float lam_init = 0.8f - 0.6f * __expf(-0.3f * (float)l);
            const float lam = __expf(wave_sum(lq1[l * 64 + lane] * lk1[l * 64 + lane])) - __expf(wave_sum(lq2[l * 64 + lane] * lk2[l * 64 + lane])) + lam_init;
            for (int j = vcu; j < 256; j += G) {
#ifndef ATT_SKIP_A
                att::unit_a(PROJ, OBR, j >> 5, (j >> 3) & 3, j & 7, lam, lam_init, subln_g + l * 128, (char*)lds, wave);
#endif
#ifndef ATT_SKIP_B
#pragma unroll 1
                for (int t = 0; t < 2; ++t) { const int idx = 2 * j + t; att::unit_b(PROJ, OBR, idx >> 6, (idx >> 3) & 7, idx & 7, (char*)lds, wave); }
#endif
#ifndef ATT_SKIP_C
                att::unit_c(PROJ, MEMKV, OBR, j >> 5, (j >> 3) & 3, j & 7, (char*)lds, wave);
#endif
            }
            __syncthreads();
        }
        SEAM(pb + 1);
        if (ST(3) && IN(pb + 2))
      for (int rep_ = 0; rep_ < NREP(3); ++rep_) {
            pg8::Gemm g{OBR_W, 512};
            pg8::SchedGate S{bx, G, (const char*)OBR, (const char*)(WBl + WB_UP)};
            pg8::EpiGate E{HM, PROJ};
            pg8::gemm_phase<pg8::EpiGate, pg8::SchedGate, true, true>(ldsl, g, S, E, wave);
        }
        SEAM(pb + 2);
        if (ST(4) && IN(pb + 3)) {
            pg8::Gemm g{DM, DM};
            pg8::SchedPlain S{bx, G, M / 256, (const char*)HM, (const char*)(WBl + WB_OUT), (size_t)256 * DM * 2, (size_t)256 * DM * 2};
            pg8::EpiResid E{l == 0 ? x : X, X};
            pg8::gemm_phase<pg8::EpiResid, pg8::SchedPlain, true, true>(ldsl, g, S, E, wave);
        }
        SEAM(pb + 3);
        if (ST(5) && IN(pb + 4)) {
            int tid = tid0; asm volatile("" : "+v"(tid));
            const int lane = tid & 63;
            const bf16_t* tab = WB + WB_RT + (size_t)l * 2 * 48 * 1024 + (size_t)(lane & 15) * 1024 + 128 * wave + 8 * (lane >> 4);
            bf16x8 Bh[3][4], Bl[3][4];
#pragma unroll
            for (int t = 0; t < 3; ++t)
#pragma unroll
                for (int sI = 0; sI < 4; ++sI) { Bh[t][sI] = *(const bf16x8*)(tab + (size_t)t * 16 * 1024 + 32 * sI); Bl[t][sI] = *(const bf16x8*)(tab + (size_t)(48 + t * 16) * 1024 + 32 * sI); }
            for (int rb = bx; rb < M / 64; rb += G)
                route_block(X, tab, b_rg + l * 4, b_re + l * 32, experts, weights, rank, ctl + CW_CNT + 32 * l, rstd, (int*)BUF, norm2_g + l * DM, HM, rb, Bh, Bl, (LAS float*)ldsl, tid, wave);
        }
        SEAM(pb + 4);
        volatile LAS int* mt = (volatile LAS int*)(ldsl + LDSCTL_OFF + 256);
        LAS unsigned* rowtab = (LAS unsigned*)(ldsl + LDSCTL_OFF + 2048); LAS float* wtab = (LAS float*)(ldsl + LDSCTL_OFF + 6144);
        if (ST(7) && IN(pb + 6))
      for (int rep_ = 0; rep_ < NREP(7); ++rep_) {
            int tid = tid0; asm volatile("" : "+v"(tid));
            moe_tables(ctl + CW_CNT + 32 * l, mt, tid);
            moe_rowtabs(mt, (const int*)BUF, weights, rowtab, wtab, bx, G, tid);
            const int ntiles = __builtin_amdgcn_readfirstlane(mt[256]);
            pg8::Gemm g{DM, DM};
            pg8::SchedMoe S{bx, G, ntiles, 1, (const LAS int*)(ldsl + LDSCTL_OFF + 256 + 96 * 4), (const char*)HM, (const char*)(WBl + WB_GU), (size_t)0, (size_t)1024 * 1024 * 2, (size_t)256 * DM * 2};
            pg8::EpiSilu E{HID};
            pg8::gemm_phase<pg8::EpiSilu, pg8::SchedMoe, true, true, true>(ldsl, g, S, E, wave, rowtab);
        }
        SEAM(pb + 6);
        if (ST(8) && IN(pb + 7))
      for (int rep_ = 0; rep_ < NREP(8); ++rep_) {
            int tid = tid0; asm volatile("" : "+v"(tid));
            if (!(ST(7) && IN(pb + 6))) { moe_tables(ctl + CW_CNT + 32 * l, mt, tid); moe_rowtabs(mt, (const int*)BUF, weights, rowtab, wtab, bx, G, tid); }
            const int ntiles = __builtin_amdgcn_readfirstlane(mt[256]);
            pg8::Gemm g{DEXP, DEXP};
            pg8::SchedMoe S{bx, G, ntiles, 0, (const LAS int*)(ldsl + LDSCTL_OFF + 256 + 96 * 4), (const char*)HID, (const char*)(WBl + WB_DN), (size_t)256 * DEXP * 2, (size_t)1024 * 512 * 2, (size_t)256 * DEXP * 2};
            pg8::EpiRowScale E{YB, wtab};
            pg8::gemm_phase<pg8::EpiRowScale, pg8::SchedMoe, true, true>(ldsl, g, S, E, wave);
        }
        SEAM(pb + 7);
        if (ST(9) && IN(pb + 8)) {
            int lane = lane0; asm volatile("" : "+v"(lane));
            const bool last = (l == DEPTH - 1);
            const bool poison = last && (__hip_atomic_load(ctl + CW_BAR + args.li * BAR_REGION + XB_TMO, __ATOMIC_RELAXED, __HIP_MEMORY_SCOPE_AGENT) != 0u);
            if (!(ST(7) && IN(pb + 6)) && !(ST(8) && IN(pb + 7))) moe_tables(ctl + CW_CNT + 32 * l, mt, tid0);
            for (int m = gw; m < M; m += NGW) row_combine_norm(X, YB, dest, last ? final_g : norm1_g + (l + 1) * DM, last ? nullptr : HM, X, m, lane, poison, mt[experts[2 * m]] + rank[2 * m], mt[experts[2 * m + 1]] + rank[2 * m + 1]);
        }
        SEAM(pb + 8);
    }
#undef IN
#undef SEAM
#undef lane0
#undef tid0
}

#ifndef FAST_MASK
#define FAST_MASK 0x7FFFFu
#endif
extern "C" void kernel_launch(void* const* d_in, const int* in_sizes, int n_in, void* d_out, int out_size, void* d_ws, size_t ws_size, hipStream_t stream) {
    if (n_in != 26 || out_size != M * DM || ws_size < WS_END) { fprintf(stderr, "kernel_launch: unexpected shapes n_in %d out %d ws %zu (need %zu)\n", n_in, out_size, ws_size, (size_t)WS_END); return; }
    static int grid = 0;
    if (grid == 0) {
        int dev = 0, cus = 0;
        if (hipGetDevice(&dev) != hipSuccess || hipDeviceGetAttribute(&cus, hipDeviceAttributeMultiprocessorCount, dev) != hipSuccess) { grid = -1; return; }
        if (hipFuncSetAttribute((const void*)mk_fwd, hipFuncAttributeMaxDynamicSharedMemorySize, LDS_BYTES) != hipSuccess) { fprintf(stderr, "kernel_launch: hipFuncSetAttribute failed\n"); grid = -1; return; }
        int per_cu = 0;
        if (hipOccupancyMaxActiveBlocksPerMultiprocessor(&per_cu, (const void*)mk_fwd, NWAVES * 64, LDS_BYTES) != hipSuccess || per_cu < 1) fprintf(stderr, "kernel_launch: occupancy query says %d\n", per_cu);
        (void)hipGetLastError();
        grid = cus;
    }
    if (grid < 0) return;
    const float* x = (const float*)d_in[0]; const float* mem = (const float*)d_in[1]; const float* mem_g = (const float*)d_in[2]; const float* w_memkv = (const float*)d_in[3];
    const float* norm1_g = (const float*)d_in[4]; const float* w_in = (const float*)d_in[5];
    const float* lq1 = (const float*)d_in[6]; const float* lk1 = (const float*)d_in[7]; const float* lq2 = (const float*)d_in[8]; const float* lk2 = (const float*)d_in[9];
    const float* subln_g = (const float*)d_in[10]; const float* qn_g = (const float*)d_in[11]; const float* kn_g = (const float*)d_in[12];
    const float* w_up[3] = {(const float*)d_in[13], (const float*)d_in[14], (const float*)d_in[15]}; const float* w_out = (const float*)d_in[16];
    const float* norm2_g = (const float*)d_in[17]; const float* w_rg = (const float*)d_in[18]; const float* b_rg = (const float*)d_in[19]; const float* w_re = (const float*)d_in[20]; const float* b_re = (const float*)d_in[21];
    const float* w_eg = (const float*)d_in[22]; const float* w_eu = (const float*)d_in[23]; const float* w_ed = (const float*)d_in[24]; const float* final_g = (const float*)d_in[25];
    unsigned char* ws = (unsigned char*)d_ws; float* X = (float*)d_out;
    unsigned* ctl = (unsigned*)(ws + WS_CTL);
    bf16_t* MEMKV = (bf16_t*)(ws + WS_MEMKV); bf16_t* HM = (bf16_t*)(ws + WS_HM); bf16_t* PROJ = (bf16_t*)(ws + WS_PROJ); bf16_t* OBR = (bf16_t*)(ws + WS_OBR);
    bf16_t* BUF = (bf16_t*)(ws + WS_BUF); bf16_t* YB = (bf16_t*)(ws + WS_YB); bf16_t* HID = (bf16_t*)(ws + WS_HID);
    int* experts = (int*)(ws + WS_ROUTE + RT_EXP); float* weights = (float*)(ws + WS_ROUTE + RT_WGT); int* rank = (int*)(ws + WS_ROUTE + RT_RANK); int* dest = (int*)(ws + WS_ROUTE + RT_DEST);
    float* roww = (float*)(ws + WS_ROUTE + RT_ROWW); int* tile_tab = (int*)(ws + WS_ROUTE + RT_TILE); float* rstd = (float*)(ws + WS_ROUTE + RT_RSTD);

    (void)hipMemsetAsync(ctl, 0, MiB, stream);
    unsigned mask = FAST_MASK; if (mask) mask |= 1u;
    Args a{};
    for (int i = 0; i < 26; ++i) a.in[i] = (const float*)d_in[i];
    a.out = X; a.ws = ws;
    int li = 0;
    for (int k = 0; k < N_PHASES;) {
        if ((mask >> k) & 1u) {
            int k2 = k; while (k2 < N_PHASES && ((mask >> k2) & 1u)) ++k2;
            a.ph_lo = k; a.ph_hi = k2; a.li = li++; a.pad = 0;
            hipLaunchKernelGGL(mk_fwd, dim3(grid), dim3(NWAVES * 64), LDS_BYTES, stream, a);
            k = k2; continue;
        }
        if (k == 0) {
            (void)hipMemcpyAsync(X, x, (size_t)M * DM * 4, hipMemcpyDeviceToDevice, stream);
            s_rmsnorm<<<MM / 4, 256, 0, stream>>>(mem, mem_g, OBR, MM);
            s_rmsnorm<<<M / 4, 256, 0, stream>>>(X, norm1_g, HM, M);
        } else {
            const int l = (k - 1) / 9, s = (k - 1) % 9; const float lam_init = 0.8f - 0.6f * expf(-0.3f * (float)l);
            switch (s) {
            case 0:
                if (l == 0) { SG p{}; p.A = OBR; p.lda = DM; p.W = w_memkv; p.ldw = 1024; p.K = DM; p.mode = MD_BF16; p.O = MEMKV; p.ldo = 1024; s_gemm<<<dim3(1024 / 64, MM / 64), 256, 0, stream>>>(p); }
                { SG p{}; p.A = HM; p.lda = DM; p.W = w_in + (size_t)l * DM * D_IN; p.ldw = D_IN; p.K = DM; p.mode = MD_PROJ; p.O = PROJ; p.ldo = D_IN; p.qg = qn_g + l * 64; p.kg = kn_g + l * 64;
                  s_gemm<<<dim3(D_IN / 64, M / 64), 256, 0, stream>>>(p); }
                break;
            case 1:
                s_attn_a<<<dim3(M / 4, 4), 256, 0, stream>>>(PROJ, OBR, lq1 + l * 64, lk1 + l * 64, lq2 + l * 64, lk2 + l * 64, subln_g + l * 128, lam_init);
                s_attn_b<<<dim3(M / 4, 8), 256, 0, stream>>>(PROJ, OBR);
                s_attn_c<<<dim3(M / 4, 4), 256, 0, stream>>>(PROJ, MEMKV, OBR);
                break;
            case 2:
                for (int i = 0; i < 3; ++i) { SG p{}; p.A = OBR + 512 * i; p.lda = OBR_W; p.W = w_up[i] + (size_t)l * 512 * DM; p.ldw = DM; p.K = 512; p.mode = MD_GATE; p.O = HM; p.ldo = DM; p.G = PROJ + C_G + 1024 * i; p.ldg = D_IN; p.first = (i == 0);
                    s_gemm<<<dim3(DM / 64, M / 64), 256, 0, stream>>>(p); }
                break;
            case 3:
                if (l == 0 && (mask & 1u)) (void)hipMemcpyAsync(X, x, (size_t)M * DM * 4, hipMemcpyDeviceToDevice, stream);
                { SG p{}; p.A = HM; p.lda = DM; p.W = w_out + (size_t)l * DM * DM; p.ldw = DM; p.K = DM; p.mode = MD_RESID; p.Xf = X; s_gemm<<<dim3(DM / 64, M / 64), 256, 0, stream>>>(p); }
                break;
            case 4:
                s_norm_route<<<M / 4, 256, 0, stream>>>(X, norm2_g + l * DM, HM, w_rg + (size_t)l * DM * 4, b_rg + l * 4, w_re + (size_t)l * DM * 32, b_re + l * 32, experts, weights, rank, ctl + CW_CNT + 32 * l, rstd);
                break;
            case 5:
                s_dispatch<<<1, 64, 0, stream>>>(ctl + CW_CNT + 32 * l, tile_tab);
                s_gather<<<M * 2 / 4, 256, 0, stream>>>(X, rstd, norm2_g + l * DM, experts, weights, rank, tile_tab, BUF, roww, dest);
                break;
            case 6:
                { SG p{}; p.A = BUF; p.lda = DM; p.W = w_eg + (size_t)l * NEXP * DM * DEXP; p.W2 = w_eu + (size_t)l * NEXP * DM * DEXP; p.ldw = DEXP; p.wstride = (size_t)DM * DEXP; p.tile_e = tile_tab; p.ntiles = tile_tab + 256;
                  p.K = DM; p.mode = MD_SILU; p.O = HID; p.ldo = DEXP; s_gemm<<<dim3(DEXP / 64, P_ROWS / 64), 256, 0, stream>>>(p); }
                break;
            case 7:
                { SG p{}; p.A = HID; p.lda = DEXP; p.W = w_ed + (size_t)l * NEXP * DEXP * DM; p.ldw = DM; p.wstride = (size_t)DEXP * DM; p.tile_e = tile_tab; p.ntiles = tile_tab + 256;
                  p.K = DEXP; p.mode = MD_ROWSCALE; p.O = YB; p.ldo = DM; p.roww = roww; s_gemm<<<dim3(DM / 64, P_ROWS / 64), 256, 0, stream>>>(p); }
                break;
            default:
                if (l + 1 < DEPTH) s_combine_norm<<<M / 4, 256, 0, stream>>>(X, YB, dest, norm1_g + (l + 1) * DM, HM, nullptr);
                else s_combine_norm<<<M / 4, 256, 0, stream>>>(X, YB, dest, final_g, nullptr, X);
                break;
            }
        }
        ++k;
    }
}
```

```cpp
#include <hip/hip_runtime.h>
#include <cstdint>
#include <cstdio>
#include <cmath>
#include <cstddef>

typedef unsigned short bf16_t;
typedef float f32x4 __attribute__((ext_vector_type(4)));
typedef unsigned u32x4 __attribute__((ext_vector_type(4)));
typedef unsigned u32x2 __attribute__((ext_vector_type(2)));

constexpr int BATCH = 8, SEQ = 2048, DM = 1024, DEPTH = 2, MEM_LEN = 256;
constexpr int M = BATCH * SEQ;
constexpr int MM = BATCH * MEM_LEN;
constexpr int D_IN = 5888;
constexpr int C_AQ = 0, C_AK = 512, C_AV = 1024, C_BQ = 1536, C_BK = 2048, C_BV = 2176, C_CQ = 2304, C_G = 2816;
constexpr int OBR_W = 1536;
constexpr int NEXP = 32, DEXP = 512;
constexpr int MOE_TILE = 256;
constexpr int P_ROWS = M * 2 + NEXP * MOE_TILE;
constexpr int MAX_TILES = P_ROWS / MOE_TILE;
constexpr float EPS = 1e-6f;
constexpr float LOG2E = 1.4426950408889634f;
constexpr float C2_64 = 0.125f * LOG2E;
constexpr float C2_128 = 0.08838834764831845f * LOG2E;

constexpr size_t MiB = 1u << 20;
constexpr size_t WS_CTL = 0;
constexpr size_t WS_ROUTE = 1 * MiB;
constexpr size_t WS_TAB = 2 * MiB;
constexpr size_t WS_MEMKV = 3 * MiB;
constexpr size_t WS_HM = 7 * MiB;
constexpr size_t WS_PROJ = 39 * MiB;
constexpr size_t WS_OBR = 223 * MiB;
constexpr size_t WS_WB = 271 * MiB;
constexpr size_t WS_END = 499 * MiB;
constexpr size_t WS_BUF = WS_PROJ;
constexpr size_t WS_YB = WS_PROJ + 80 * MiB;
constexpr size_t WS_HID = WS_OBR;
constexpr size_t RT_EXP = 0;
constexpr size_t RT_WGT = 128 * 1024;
constexpr size_t RT_RANK = 256 * 1024;
constexpr size_t RT_DEST = 384 * 1024;
constexpr size_t RT_ROWW = 512 * 1024;
constexpr size_t RT_TILE = 700 * 1024;
constexpr size_t RT_RSTD = 768 * 1024;
constexpr int CW_CNT = 0;
constexpr int CW_TMO = 128;
constexpr int CW_TCNT = 131072;

__device__ __forceinline__ float bf2f(bf16_t v) { return __uint_as_float(((unsigned)v) << 16); }
__device__ __forceinline__ bf16_t f2bf(float f) { unsigned u = __float_as_uint(f); return (bf16_t)((u + 0x7fffu + ((u >> 16) & 1u)) >> 16); }
__device__ __forceinline__ float wave_sum(float v) {
#pragma unroll
    for (int o = 1; o < 64; o <<= 1) v += __shfl_xor(v, o);
    return v;
}
__device__ __forceinline__ float wave_max(float v) {
#pragma unroll
    for (int o = 1; o < 64; o <<= 1) v = fmaxf(v, __shfl_xor(v, o));
    return v;
}
__device__ __forceinline__ float inv1d(int i) { return exp2f(-(float)i * (13.287712379549449f / 32.f)); }
__device__ __forceinline__ float inv2d(int j) { return exp2f(-(float)j * (13.287712379549449f / 16.f)); }
__device__ __forceinline__ float ang2d(int pos, int i) { return i < 16 ? (float)(pos >> 6) * inv2d(i) : (float)(pos & 63) * inv2d(i - 16); }

__global__ __launch_bounds__(256) void s_rmsnorm(const float* __restrict__ X, const float* __restrict__ g, bf16_t* __restrict__ OUT, int rows) {
    const int lane = threadIdx.x & 63, row = blockIdx.x * 4 + (threadIdx.x >> 6);
    if (row >= rows) return;
    const f32x4* xr = (const f32x4*)(X + (size_t)row * DM);
    f32x4 v[4]; float s = 0.f;
#pragma unroll
    for (int j = 0; j < 4; ++j) { v[j] = xr[lane + 64 * j]; s += v[j].x * v[j].x + v[j].y * v[j].y + v[j].z * v[j].z + v[j].w * v[j].w; }
    const float rs = rsqrtf(wave_sum(s) * (1.f / DM) + EPS);
#pragma unroll
    for (int j = 0; j < 4; ++j) { const f32x4 gg = ((const f32x4*)g)[lane + 64 * j];
        u32x2 o; o.x = f2bf(v[j].x * rs * gg.x) | ((unsigned)f2bf(v[j].y * rs * gg.y) << 16); o.y = f2bf(v[j].z * rs * gg.z) | ((unsigned)f2bf(v[j].w * rs * gg.w) << 16);
        ((u32x2*)(OUT + (size_t)row * DM))[lane + 64 * j] = o; }
}

enum { MD_PROJ = 0, MD_BF16 = 1, MD_GATE = 2, MD_RESID = 3, MD_SILU = 4, MD_ROWSCALE = 5 };
struct SG {
    const bf16_t* A; int lda; const float* W; const float* W2; int ldw; size_t wstride;
    const int* tile_e; const int* ntiles;
    int K; int mode;
    bf16_t* O; int ldo;
    float* Xf;
    const bf16_t* G; int ldg; int first;
    const float* roww;
    const float* qg; const float* kg;
};
__global__ __launch_bounds__(256) void s_gemm(SG p) {
    __shared__ float As[16][68];
    __shared__ float Bs[16][68];
    __shared__ float B2s[16][68];
    __shared__ float Ct[64][65];
    __shared__ float Ct2[64][65];
    const int tid = threadIdx.x, tx = tid & 15, ty = tid >> 4;
    const int gc0 = blockIdx.x * 64, gr0 = blockIdx.y * 64;
    const float* W = p.W; const float* W2 = p.W2;
    if (p.tile_e) { const int t256 = blockIdx.y >> 2; if (t256 >= *p.ntiles) return; const int e = p.tile_e[t256]; W += (size_t)e * p.wstride; if (W2) W2 += (size_t)e * p.wstride; }
    float acc[4][4] = {}, acc2[4][4] = {};
    const int ar = tid >> 2, ak = (tid & 3) * 4;
    const int bk = tid >> 4, bn = (tid & 15) * 4;
    for (int k0 = 0; k0 < p.K; k0 += 16) {
        { const u32x2 a = *(const u32x2*)(p.A + (size_t)(gr0 + ar) * p.lda + k0 + ak);
          As[ak + 0][ar] = __uint_as_float(a.x << 16); As[ak + 1][ar] = __uint_as_float(a.x & 0xffff0000u);
          As[ak + 2][ar] = __uint_as_float(a.y << 16); As[ak + 3][ar] = __uint_as_float(a.y & 0xffff0000u); }
        { const f32x4 b = *(const f32x4*)(W + (size_t)(k0 + bk) * p.ldw + gc0 + bn); Bs[bk][bn] = b.x; Bs[bk][bn + 1] = b.y; Bs[bk][bn + 2] = b.z; Bs[bk][bn + 3] = b.w; }
        if (p.mode == MD_SILU) { const f32x4 b = *(const f32x4*)(W2 + (size_t)(k0 + bk) * p.ldw + gc0 + bn); B2s[bk][bn] = b.x; B2s[bk][bn + 1] = b.y; B2s[bk][bn + 2] = b.z; B2s[bk][bn + 3] = b.w; }
        __syncthreads();
#pragma unroll
        for (int k = 0; k < 16; ++k) {
            float a[4], b[4];
#pragma unroll
            for (int i = 0; i < 4; ++i) { a[i] = As[k][ty * 4 + i]; b[i] = Bs[k][tx * 4 + i]; }
#pragma unroll
            for (int i = 0; i < 4; ++i)
#pragma unroll
                for (int j = 0; j < 4; ++j) acc[i][j] += a[i] * b[j];
            if (p.mode == MD_SILU) {
#pragma unroll
                for (int i = 0; i < 4; ++i) b[i] = B2s[k][tx * 4 + i];
#pragma unroll
                for (int i = 0; i < 4; ++i)
#pragma unroll
                    for (int j = 0; j < 4; ++j) acc2[i][j] += a[i] * b[j];
            }
        }
        __syncthreads();
    }
#pragma unroll
    for (int i = 0; i < 4; ++i)
#pragma unroll
        for (int j = 0; j < 4; ++j) { Ct[ty * 4 + i][tx * 4 + j] = acc[i][j]; Ct2[ty * 4 + i][tx * 4 + j] = acc2[i][j]; }
    __syncthreads();
    const int r = tid >> 2, q = tid & 3; const int grow = gr0 + r;
    if (p.mode == MD_PROJ) {
        const int pos = grow & (SEQ - 1);
        bf16_t* orow = p.O + (size_t)grow * p.ldo + gc0;
        if (gc0 < C_AV) {
            const float sc = gc0 < C_AK ? C2_64 : 1.f;
            for (int j = 0; j < 8; ++j) { const int i = q * 8 + j; const float x1 = Ct[r][i], x2 = Ct[r][i + 32]; float s, c; sincosf((float)pos * inv1d(i), &s, &c);
                orow[i] = f2bf((x1 * c - x2 * s) * sc); orow[i + 32] = f2bf((x2 * c + x1 * s) * sc); }
        } else if ((gc0 >= C_BQ && gc0 < C_BV)) {
            const bool isq = gc0 < C_BK; const float* g = isq ? p.qg : p.kg; const float sc = isq ? C2_64 : 1.f;
            float ss = 0.f; for (int d = 0; d < 64; ++d) ss += Ct[r][d] * Ct[r][d];
            const float rs = rsqrtf(ss * (1.f / 64.f) + EPS);
            for (int j = 0; j < 8; ++j) { const int i = q * 8 + j; const float x1 = Ct[r][i] * rs * g[i], x2 = Ct[r][i + 32] * rs * g[i + 32]; float s, c; sincosf(ang2d(pos, i), &s, &c);
                orow[i] = f2bf((x1 * c - x2 * s) * sc); orow[i + 32] = f2bf((x2 * c + x1 * s) * sc); }
        } else if (gc0 >= C_G) {
            for (int j = 0; j < 16; ++j) { const int c = q * 16 + j; orow[c] = f2bf(1.f / (1.f + __expf(-Ct[r][c]))); }
        } else {
            const float sc = (gc0 >= C_CQ) ? C2_128 : 1.f;
            for (int j = 0; j < 16; ++j) { const int c = q * 16 + j; orow[c] = f2bf(Ct[r][c] * sc); }
        }
    } else if (p.mode == MD_BF16) {
        for (int j = 0; j < 16; ++j) { const int c = q * 16 + j; p.O[(size_t)grow * p.ldo + gc0 + c] = f2bf(Ct[r][c]); }
    } else if (p.mode == MD_GATE) {
        for (int j = 0; j < 16; ++j) { const int c = q * 16 + j; const float gv = bf2f(p.G[(size_t)grow * p.ldg + gc0 + c]);
            bf16_t* o = p.O + (size_t)grow * p.ldo + gc0 + c; const float prev = p.first ? 0.f : bf2f(*o); *o = f2bf(prev + gv * Ct[r][c]); }
    } else if (p.mode == MD_RESID) {
        for (int j = 0; j < 16; ++j) { const int c = q * 16 + j; p.Xf[(size_t)grow * DM + gc0 + c] += Ct[r][c]; }
    } else if (p.mode == MD_SILU) {
        for (int j = 0; j < 16; ++j) { const int c = q * 16 + j; const float gq = Ct[r][c], u = Ct2[r][c]; p.O[(size_t)grow * p.ldo + gc0 + c] = f2bf(gq / (1.f + __expf(-gq)) * u); }
    } else if (p.mode == MD_ROWSCALE) {
        const float w = p.roww[grow];
        for (int j = 0; j < 16; ++j) { const int c = q * 16 + j; p.O[(size_t)grow * p.ldo + gc0 + c] = f2bf(Ct[r][c] * w); }
    }
}

template <int DQK, int DV, int NKT>
__device__ __forceinline__ void attn_row(const bf16_t* q, const bf16_t* K, int ldk, const bf16_t* V, int ldv, float* qs, float* ps, int lane, float (&o)[2]) {
    for (int d = lane; d < DQK; d += 64) qs[d] = bf2f(q[d]);
    __syncthreads();
    float sc[NKT]; float m = -INFINITY;
#pragma unroll
    for (int i = 0; i < NKT; ++i) {
        const bf16_t* kr = K + (size_t)(i * 64 + lane) * ldk; float s = 0.f;
#pragma unroll
        for (int d0 = 0; d0 < DQK / 8; ++d0) { const u32x4 w = *(const u32x4*)(kr + d0 * 8);
            s += qs[d0 * 8 + 0] * __uint_as_float(w.x << 16) + qs[d0 * 8 + 1] * __uint_as_float(w.x & 0xffff0000u) + qs[d0 * 8 + 2] * __uint_as_float(w.y << 16) + qs[d0 * 8 + 3] * __uint_as_float(w.y & 0xffff0000u)
               + qs[d0 * 8 + 4] * __uint_as_float(w.z << 16) + qs[d0 * 8 + 5] * __uint_as_float(w.z & 0xffff0000u) + qs[d0 * 8 + 6] * __uint_as_float(w.w << 16) + qs[d0 * 8 + 7] * __uint_as_float(w.w & 0xffff0000u); }
        sc[i] = s; m = fmaxf(m, s);
    }
    m = wave_max(m); float l = 0.f;
#pragma unroll
    for (int i = 0; i < NKT; ++i) { const float pv = exp2f(sc[i] - m); l += pv; ps[i * 64 + lane] = pv; }
    l = wave_sum(l);
    __syncthreads();
    float a0 = 0.f, a1 = 0.f;
#pragma unroll 4
    for (int j = 0; j < NKT * 64; ++j) { const float pv = ps[j]; a0 += pv * bf2f(V[(size_t)j * ldv + lane]); if (DV == 128) a1 += pv * bf2f(V[(size_t)j * ldv + 64 + lane]); }
    o[0] = a0 / l; o[1] = a1 / l;
    __syncthreads();
}
__global__ __launch_bounds__(256) void s_attn_b(const bf16_t* __restrict__ PROJ, bf16_t* __restrict__ OBR) {
    __shared__ float qs_[4][128]; __shared__ float ps_[4][2048];
    const int w = threadIdx.x >> 6, lane = threadIdx.x & 63, row = blockIdx.x * 4 + w, qh = blockIdx.y, b = row / SEQ;
    const bf16_t* kv = PROJ + (size_t)b * SEQ * D_IN;
    float o[2];
    attn_row<64, 64, 32>(PROJ + (size_t)row * D_IN + C_BQ + qh * 64, kv + C_BK + (qh >> 2) * 64, D_IN, kv + C_BV + (qh >> 2) * 64, D_IN, qs_[w], ps_[w], lane, o);
    OBR[(size_t)row * OBR_W + 512 + qh * 64 + lane] = f2bf(o[0]);
}
__global__ __launch_bounds__(256) void s_attn_c(const bf16_t* __restrict__ PROJ, const bf16_t* __restrict__ MEMKV, bf16_t* __restrict__ OBR) {
    __shared__ float qs_[4][128]; __shared__ float ps_[4][256];
    const int w = threadIdx.x >> 6, lane = threadIdx.x & 63, row = blockIdx.x * 4 + w, h = blockIdx.y, b = row / SEQ;
    const bf16_t* kv = MEMKV + (size_t)b * MEM_LEN * 1024;
    float o[2];
    attn_row<128, 128, 4>(PROJ + (size_t)row * D_IN + C_CQ + h * 128, kv + h * 128, 1024, kv + 512 + h * 128, 1024, qs_[w], ps_[w], lane, o);
    OBR[(size_t)row * OBR_W + 1024 + h * 128 + lane] = f2bf(o[0]);
    OBR[(size_t)row * OBR_W + 1024 + h * 128 + 64 + lane] = f2bf(o[1]);
}
__global__ __launch_bounds__(256) void s_attn_a(const bf16_t* __restrict__ PROJ, bf16_t* __restrict__ OBR, const float* lq1, const float* lk1, const float* lq2, const float* lk2,
                                                const float* subg, float lam_init) {
    __shared__ float qs_[4][128]; __shared__ float ps_[4][2048];
    const int w = threadIdx.x >> 6, lane = threadIdx.x & 63, row = blockIdx.x * 4 + w, h = blockIdx.y, b = row / SEQ;
    const float lam = __expf(wave_sum(lq1[lane] * lk1[lane])) - __expf(wave_sum(lq2[lane] * lk2[lane])) + lam_init;
    const bf16_t* kv = PROJ + (size_t)b * SEQ * D_IN;
    float o0[2], o1[2];
    attn_row<64, 128, 32>(PROJ + (size_t)row * D_IN + C_AQ + h * 128, kv + C_AK + h * 128, D_IN, kv + C_AV + h * 128, D_IN, qs_[w], ps_[w], lane, o0);
    attn_row<64, 128, 32>(PROJ + (size_t)row * D_IN + C_AQ + h * 128 + 64, kv + C_AK + h * 128 + 64, D_IN, kv + C_AV + h * 128, D_IN, qs_[w], ps_[w], lane, o1);
    const float c0 = o0[0] - lam * o1[0], c1 = o0[1] - lam * o1[1];
    const float rs = rsqrtf(wave_sum(c0 * c0 + c1 * c1) * (1.f / 128.f) + EPS) * (1.f - lam_init);
    OBR[(size_t)row * OBR_W + h * 128 + lane] = f2bf(c0 * rs * subg[lane]);
    OBR[(size_t)row * OBR_W + h * 128 + 64 + lane] = f2bf(c1 * rs * subg[64 + lane]);
}

__global__ __launch_bounds__(256) void s_norm_route(const float* __restrict__ X, const float* __restrict__ g, bf16_t* __restrict__ H2, const float* __restrict__ wrg, const float* __restrict__ brg,
                                                    const float* __restrict__ wre, const float* __restrict__ bre, int* __restrict__ experts, float* __restrict__ weights, int* __restrict__ rank, unsigned* __restrict__ cnt, float* __restrict__ rstd) {
    const int lane = threadIdx.x & 63, row = blockIdx.x * 4 + (threadIdx.x >> 6);
    const f32x4* xr = (const f32x4*)(X + (size_t)row * DM);
    f32x4 v[4]; float s = 0.f;
#pragma unroll
    for (int j = 0; j < 4; ++j) { v[j] = xr[lane + 64 * j]; s += v[j].x * v[j].x + v[j].y * v[j].y + v[j].z * v[j].z + v[j].w * v[j].w; }
    const float rs = rsqrtf(wave_sum(s) * (1.f / DM) + EPS);
    float acc[36];
#pragma unroll
    for (int e = 0; e < 36; ++e) acc[e] = 0.f;
#pragma unroll
    for (int j = 0; j < 4; ++j) { const f32x4 gg = ((const f32x4*)g)[lane + 64 * j];
        float h[4] = {v[j].x * rs * gg.x, v[j].y * rs * gg.y, v[j].z * rs * gg.z, v[j].w * rs * gg.w};
        u32x2 o; o.x = f2bf(h[0]) | ((unsigned)f2bf(h[1]) << 16); o.y = f2bf(h[2]) | ((unsigned)f2bf(h[3]) << 16);
        ((u32x2*)(H2 + (size_t)row * DM))[lane + 64 * j] = o;
#pragma unroll
        for (int i = 0; i < 4; ++i) { const int k = (lane + 64 * j) * 4 + i;
            const f32x4 wg = *(const f32x4*)(wrg + (size_t)k * 4);
            acc[0] += h[i] * wg.x; acc[1] += h[i] * wg.y; acc[2] += h[i] * wg.z; acc[3] += h[i] * wg.w;
#pragma unroll
            for (int e4 = 0; e4 < 8; ++e4) { const f32x4 we = *(const f32x4*)(wre + (size_t)k * 32 + e4 * 4);
                acc[4 + e4 * 4 + 0] += h[i] * we.x; acc[4 + e4 * 4 + 1] += h[i] * we.y; acc[4 + e4 * 4 + 2] += h[i] * we.z; acc[4 + e4 * 4 + 3] += h[i] * we.w; }
        }
    }
#pragma unroll
    for (int e = 0; e < 36; ++e) acc[e] = wave_sum(acc[e]);
    if (lane == 0) {
        rstd[row] = rs;
        int gi = 0; float gm = acc[0] + brg[0];
        for (int i = 1; i < 4; ++i) { const float l = acc[i] + brg[i]; if (l > gm) { gm = l; gi = i; } }
        float gs = 0.f; for (int i = 0; i < 4; ++i) gs += __expf(acc[i] + brg[i] - gm);
        const float gp = 1.f / gs;
        float el[8];
#pragma unroll
        for (int i = 0; i < 8; ++i) el[i] = 0.f;
#pragma unroll
        for (int gq = 0; gq < 4; ++gq) if (gq == gi) {
#pragma unroll
            for (int i = 0; i < 8; ++i) el[i] = acc[4 + gq * 8 + i] + bre[gq * 8 + i]; }
        int i0 = 0; float l0 = el[0];
#pragma unroll
        for (int i = 1; i < 8; ++i) if (el[i] > l0) { l0 = el[i]; i0 = i; }
        int i1 = -1; float l1 = -INFINITY;
#pragma unroll
        for (int i = 0; i < 8; ++i) if (i != i0 && el[i] > l1) { l1 = el[i]; i1 = i; }
        const float p1 = __expf(l1 - l0), inv = 1.f / (1.f + p1);
        const int e0 = gi * 8 + i0, e1 = gi * 8 + i1;
        experts[row * 2] = e0; experts[row * 2 + 1] = e1;
        weights[row * 2] = gp * inv; weights[row * 2 + 1] = gp * p1 * inv;
        rank[row * 2] = (int)atomicAdd(cnt + e0, 1u); rank[row * 2 + 1] = (int)atomicAdd(cnt + e1, 1u);
    }
}
__global__ void s_dispatch(const unsigned* __restrict__ cnt, int* __restrict__ tile_tab) {
    if (threadIdx.x == 0) {
        int off = 0, nt = 0;
        for (int e = 0; e < NEXP; ++e) { const int c = (int)cnt[e], t = (c + MOE_TILE - 1) / MOE_TILE; tile_tab[260 + e] = off; for (int i = 0; i < t; ++i) tile_tab[nt++] = e; off += t * MOE_TILE; }
        tile_tab[256] = nt;
    }
}
__global__ __launch_bounds__(256) void s_gather(const float* __restrict__ X, const float* __restrict__ rstd, const float* __restrict__ g, const int* __restrict__ experts, const float* __restrict__ weights, const int* __restrict__ rank, const int* __restrict__ tile_tab,
                                                bf16_t* __restrict__ BUF, float* __restrict__ roww, int* __restrict__ dest) {
    const int lane = threadIdx.x & 63, a = blockIdx.x * 4 + (threadIdx.x >> 6);
    const int tok = a >> 1, e = experts[a], d = tile_tab[260 + e] + rank[a]; const float rs = rstd[tok];
    const f32x4* xr = (const f32x4*)(X + (size_t)tok * DM);
    for (int j = 0; j < 4; ++j) { const f32x4 v = xr[lane + 64 * j], gg = ((const f32x4*)g)[lane + 64 * j];
        u32x2 o; o.x = f2bf(v.x * rs * gg.x) | ((unsigned)f2bf(v.y * rs * gg.y) << 16); o.y = f2bf(v.z * rs * gg.z) | ((unsigned)f2bf(v.w * rs * gg.w) << 16);
        ((u32x2*)(BUF + (size_t)d * DM))[lane + 64 * j] = o; }
    if (lane == 0) { roww[d] = weights[a]; dest[a] = d; }
}
__global__ __launch_bounds__(256) void s_combine_norm(float* __restrict__ X, const bf16_t* __restrict__ YB, const int* __restrict__ dest, const float* __restrict__ g, bf16_t* __restrict__ H, float* __restrict__ OUT) {
    const int lane = threadIdx.x & 63, row = blockIdx.x * 4 + (threadIdx.x >> 6);
    const int d0 = dest[row * 2], d1 = dest[row * 2 + 1];
    f32x4* xr = (f32x4*)(X + (size_t)row * DM);
    f32x4 v[4]; float s = 0.f;
#pragma unroll
    for (int j = 0; j < 4; ++j) { v[j] = xr[lane + 64 * j];
        const u32x2 a = ((const u32x2*)(YB + (size_t)d0 * DM))[lane + 64 * j], b = ((const u32x2*)(YB + (size_t)d1 * DM))[lane + 64 * j];
        v[j].x += __uint_as_float(a.x << 16) + __uint_as_float(b.x << 16); v[j].y += __uint_as_float(a.x & 0xffff0000u) + __uint_as_float(b.x & 0xffff0000u);
        v[j].z += __uint_as_float(a.y << 16) + __uint_as_float(b.y << 16); v[j].w += __uint_as_float(a.y & 0xffff0000u) + __uint_as_float(b.y & 0xffff0000u);
        s += v[j].x * v[j].x + v[j].y * v[j].y + v[j].z * v[j].z + v[j].w * v[j].w; }
    const float rs = rsqrtf(wave_sum(s) * (1.f / DM) + EPS);
#pragma unroll
    for (int j = 0; j < 4; ++j) { const f32x4 gg = ((const f32x4*)g)[lane + 64 * j];
        if (H) { xr[lane + 64 * j] = v[j];
            u32x2 o; o.x = f2bf(v[j].x * rs * gg.x) | ((unsigned)f2bf(v[j].y * rs * gg.y) << 16); o.y = f2bf(v[j].z * rs * gg.z) | ((unsigned)f2bf(v[j].w * rs * gg.w) << 16);
            ((u32x2*)(H + (size_t)row * DM))[lane + 64 * j] = o; }
        else { f32x4 o; o.x = v[j].x * rs * gg.x; o.y = v[j].y * rs * gg.y; o.z = v[j].z * rs * gg.z; o.w = v[j].w * rs * gg.w; ((f32x4*)(OUT + (size_t)row * DM))[lane + 64 * j] = o; }
    }
}

#define LAS __attribute__((address_space(3)))
#define GAS __attribute__((address_space(1)))
typedef short bf16x8 __attribute__((ext_vector_type(8)));
typedef short s16x4 __attribute__((ext_vector_type(4)));
typedef float f32x16 __attribute__((ext_vector_type(16)));
typedef float f32x2 __attribute__((ext_vector_type(2)));

constexpr size_t WB_IN = 0, WB_UP = 6029312, WB_OUT = WB_UP + 1572864, WB_GU = WB_OUT + 1048576, WB_DN = WB_GU + 33554432, WB_LAYER = WB_DN + 16777216;
constexpr size_t WB_MEMKV = 2 * WB_LAYER;
constexpr size_t WB_RT = WB_MEMKV + 1048576;
static_assert(WS_WB + (WB_RT + 2 * 2 * 48 * 1024) * 2 <= WS_END, "weight copies fit");
constexpr int N_PHASES = 19;
constexpr int LCAP = 16384;

__device__ __forceinline__ int lane_id() { int r; asm volatile("v_mbcnt_lo_u32_b32 %0, -1, 0\n\tv_mbcnt_hi_u32_b32 %0, -1, %0" : "=v"(r)); return r; }
__device__ __forceinline__ unsigned cvt_pk_bf16(float lo, float hi) { unsigned r; asm volatile("v_cvt_pk_bf16_f32 %0, %1, %2" : "=v"(r) : "v"(lo), "v"(hi)); return r; }
__device__ __forceinline__ float fast_sigmoid(float v) { return __builtin_amdgcn_rcpf(1.f + __builtin_amdgcn_exp2f(-v * LOG2E)); }

namespace pg8 {
#define PG8_LAS LAS
constexpr int BM = 256, BK = 64, HALF = 128, HTB = HALF * BK * 2, STAGE_BYTES = 8 * HTB, NXCD = 8, WGM = 8;
__host__ __device__ __forceinline__ int lds_byte(int r, int c) { const int st = (r >> 4) * 2 + (c >> 5), rr = r & 15, cc = c & 31, ob = rr * 64 + cc * 2; return st * 1024 + (ob ^ (((ob >> 9) & 1) << 5)); }
__host__ __device__ __forceinline__ void stage_rc(int b, int& R, int& C) { const int st = b / 1024, sb = b % 1024, swz = sb ^ (((sb >> 9) & 1) << 5); R = (st >> 1) * 16 + swz / 64; C = (st & 1) * 32 + (swz % 64) / 2; }
__host__ __device__ __forceinline__ int perm32(int rho) { const int n = rho >> 4, i = rho & 15; return 8 * (i >> 2) + 4 * n + (i & 3); }

struct Unit { int pm, pn, sub, ord; const char* a; const char* b; };
struct Gemm { int lda; int K; };
__device__ __forceinline__ void tile_order(int L, int nM, int nN, int& pm, int& pn) {
    const int nwg = nM * nN; int wgid = L; { const int q = nwg / NXCD, r = nwg % NXCD, xcd = wgid % NXCD, off = wgid / NXCD; wgid = (xcd < r ? xcd * (q + 1) : r * (q + 1) + (xcd - r) * q) + off; }
    const int nig = WGM * nN, gid = wgid / nig, fm = gid * WGM, gsz = (nM - fm) < WGM ? (nM - fm) : WGM;
    pm = fm + ((wgid % nig) % gsz); pn = (wgid % nig) / gsz;
}
__device__ __forceinline__ u32x4 pack8(const f32x4& v0, const f32x4& v1) { u32x4 w; w.x = cvt_pk_bf16(v0[0], v0[1]); w.y = cvt_pk_bf16(v0[2], v0[3]); w.z = cvt_pk_bf16(v1[0], v1[1]); w.w = cvt_pk_bf16(v1[2], v1[3]); return w; }
__device__ __forceinline__ void unpack8(const u32x4& w, f32x4& v0, f32x4& v1) {
    v0[0] = __uint_as_float(w.x << 16); v0[1] = __uint_as_float(w.x & 0xffff0000u); v0[2] = __uint_as_float(w.y << 16); v0[3] = __uint_as_float(w.y & 0xffff0000u);
    v1[0] = __uint_as_float(w.z << 16); v1[1] = __uint_as_float(w.z & 0xffff0000u); v1[2] = __uint_as_float(w.w << 16); v1[3] = __uint_as_float(w.w & 0xffff0000u); }

struct EpiProj {
    static constexpr bool PERM = true, AFTER_DRAIN = false;
    bf16_t* PROJ; bf16_t* MEMKV; const float* tab1; const float* tab2; const float* qg; const float* kg;
    __device__ __forceinline__ void operator()(const f32x4 (&acc)[2][2][4][2], const Unit& u, int wr, int wc, int fr, int fq) const {
        const int colt = u.pn * 256, dcol = colt + wc * 64 + fq * 8, row0 = u.pm * 256 + wr * 64 + fr;
        if (u.sub == 1) {
#pragma unroll
            for (int ai = 0; ai < 2; ++ai)
#pragma unroll
                for (int m = 0; m < 4; ++m) { bf16_t* rowp = MEMKV + (size_t)(row0 + ai * 128 + m * 16) * 1024 + dcol;
#pragma unroll
                    for (int bj = 0; bj < 2; ++bj) *(u32x4*)(rowp + bj * 32) = pack8(acc[ai][bj][m][0], acc[ai][bj][m][1]); }
            return;
        }
        int mode = 0; float sc = 1.f; const float* g = qg;
        if (colt < C_AV) { mode = 1; if (colt < C_AK) sc = C2_64; }
        else if (colt < C_BQ) mode = 0;
        else if (colt < C_BK) { mode = 2; sc = C2_64; }
        else if (colt < C_CQ) { if (wc < 2) { mode = 2; g = kg; } }
        else if (colt < C_G) sc = C2_128;
        else mode = 3;
        f32x4 gv[2][2];
        if (mode == 2) {
#pragma unroll
            for (int bj = 0; bj < 2; ++bj)
#pragma unroll
                for (int n = 0; n < 2; ++n) gv[bj][n] = *(const f32x4*)(g + bj * 32 + fq * 8 + n * 4);
        }
#pragma unroll
        for (int ai = 0; ai < 2; ++ai)
#pragma unroll
            for (int m = 0; m < 4; ++m) {
                const int row = row0 + ai * 128 + m * 16, pos = row & (SEQ - 1);
                f32x4 v[2][2] = {{acc[ai][0][m][0], acc[ai][0][m][1]}, {acc[ai][1][m][0], acc[ai][1][m][1]}};
                if (mode == 2) {
                    float ss = 0.f;
#pragma unroll
                    for (int bj = 0; bj < 2; ++bj)
#pragma unroll
                        for (int n = 0; n < 2; ++n) ss += (v[bj][n][0] * v[bj][n][0] + v[bj][n][1] * v[bj][n][1]) + (v[bj][n][2] * v[bj][n][2] + v[bj][n][3] * v[bj][n][3]);
                    ss += __shfl_xor(ss, 16); ss += __shfl_xor(ss, 32);
                    const float rs = rsqrtf(ss * (1.f / 64.f) + EPS);
#pragma unroll
                    for (int bj = 0; bj < 2; ++bj)
#pragma unroll
                        for (int n = 0; n < 2; ++n) v[bj][n] = v[bj][n] * rs * gv[bj][n];
                }
                if (mode == 1 || mode == 2) {
                    const float* tb = (mode == 1 ? tab1 : tab2) + ((size_t)pos * 32 + fq * 8) * 2;
#pragma unroll
                    for (int n = 0; n < 2; ++n) { const f32x4 t0 = *(const f32x4*)(tb + n * 8), t1 = *(const f32x4*)(tb + n * 8 + 4);
                        const float cs[4] = {t0[0], t0[2], t1[0], t1[2]}, sn[4] = {t0[1], t0[3], t1[1], t1[3]};
#pragma unroll
                        for (int e = 0; e < 4; ++e) { const float x1 = v[0][n][e], x2 = v[1][n][e]; v[0][n][e] = x1 * cs[e] - x2 * sn[e]; v[1][n][e] = x2 * cs[e] + x1 * sn[e]; } }
                }
                if (mode == 3) {
#pragma unroll
                    for (int bj = 0; bj < 2; ++bj)
#pragma unroll
                        for (int n = 0; n < 2; ++n)
#pragma unroll
                            for (int e = 0; e < 4; ++e) v[bj][n][e] = fast_sigmoid(v[bj][n][e]);
                }
                bf16_t* rowp = PROJ + (size_t)row * D_IN + dcol;
#pragma unroll
                for (int bj = 0; bj < 2; ++bj) *(u32x4*)(rowp + bj * 32) = pack8(v[bj][0] * sc, v[bj][1] * sc);
            }
    }
};
struct EpiGate {
    static constexpr bool PERM = true, AFTER_DRAIN = false;
    bf16_t* MERGED; const bf16_t* PROJ;
    __device__ __forceinline__ void operator()(const f32x4 (&acc)[2][2][4][2], const Unit& u, int wr, int wc, int fr, int fq) const {
        const int col0 = u.pn * 256 + wc * 32 + fq * 8, row0 = u.pm * 256 + wr * 64 + fr;
#pragma unroll
        for (int ai = 0; ai < 2; ++ai)
#pragma unroll
            for (int m = 0; m < 4; ++m) { const int row = row0 + ai * 128 + m * 16;
                const bf16_t* gp = PROJ + (size_t)row * D_IN + C_G + u.sub * 1024 + col0; bf16_t* op = MERGED + (size_t)row * DM + col0;
#pragma unroll
                for (int bj = 0; bj < 2; ++bj) { f32x4 g0, g1, o0 = {0.f, 0.f, 0.f, 0.f}, o1 = {0.f, 0.f, 0.f, 0.f};
                    unpack8(*(const u32x4*)(gp + bj * 128), g0, g1);
                    if (u.sub != 0) unpack8(*(const u32x4*)(op + bj * 128), o0, o1);
                    o0 += g0 * acc[ai][bj][m][0]; o1 += g1 * acc[ai][bj][m][1];
                    *(u32x4*)(op + bj * 128) = pack8(o0, o1); } }
    }
};
struct EpiResid {
    static constexpr bool PERM = true, AFTER_DRAIN = false;
    const float* Xin; float* X;
    __device__ __forceinline__ void operator()(const f32x4 (&acc)[2][2][4][2], const Unit& u, int wr, int wc, int fr, int fq) const {
        const int col0 = u.pn * 256 + wc * 32 + fq * 8, row0 = u.pm * 256 + wr * 64 + fr;
#pragma unroll
        for (int ai = 0; ai < 2; ++ai)
#pragma unroll
            for (int m = 0; m < 4; ++m) { const size_t off = (size_t)(row0 + ai * 128 + m * 16) * DM + col0;
#pragma unroll
                for (int bj = 0; bj < 2; ++bj) { const f32x4* pi = (const f32x4*)(Xin + off + bj * 128); f32x4* po = (f32x4*)(X + off + bj * 128); const f32x4 a = pi[0], b = pi[1]; po[0] = a + acc[ai][bj][m][0]; po[1] = b + acc[ai][bj][m][1]; } }
    }
};
struct EpiSilu {
    static constexpr bool PERM = true, AFTER_DRAIN = false;
    bf16_t* HID;
    __device__ __forceinline__ void operator()(const f32x4 (&acc)[2][2][4][2], const Unit& u, int wr, int wc, int fr, int fq) const {
        const __amdgpu_buffer_rsrc_t rsrc = __builtin_amdgcn_make_buffer_rsrc((void*)HID, 0, P_ROWS * DEXP * 2, 0x00020000);
        const int col0 = u.pn * 128 + wc * 32 + fq * 8, row0 = u.pm * 256 + wr * 64 + fr;
#pragma unroll
        for (int ai = 0; ai < 2; ++ai)
#pragma unroll
            for (int m = 0; m < 4; ++m) { f32x4 h[2];
#pragma unroll
                for (int n = 0; n < 2; ++n)
#pragma unroll
                    for (int e = 0; e < 4; ++e) { const float gq = acc[ai][0][m][n][e]; h[n][e] = gq * fast_sigmoid(gq) * acc[ai][1][m][n][e]; }
                __builtin_amdgcn_raw_buffer_store_b128(pack8(h[0], h[1]), rsrc, ((row0 + ai * 128 + m * 16) * DEXP + col0) * 2, 0, 16); }
    }
};
struct EpiRowScale {
    static constexpr bool PERM = true, AFTER_DRAIN = false;
    bf16_t* YB; const PG8_LAS float* wtab;
    __device__ __forceinline__ void operator()(const f32x4 (&acc)[2][2][4][2], const Unit& u, int wr, int wc, int fr, int fq) const {
        const int col0 = u.pn * 256 + wc * 32 + fq * 8, rt0 = wr * 64 + fr;
#pragma unroll
        for (int ai = 0; ai < 2; ++ai)
#pragma unroll
            for (int m = 0; m < 4; ++m) { const int rt = rt0 + ai * 128 + m * 16; const float w = wtab[u.ord * 256 + rt]; bf16_t* op = YB + (size_t)(u.pm * 256 + rt) * DM + col0;
#pragma unroll
                for (int bj = 0; bj < 2; ++bj) *(u32x4*)(op + bj * 128) = pack8(acc[ai][bj][m][0] * w, acc[ai][bj][m][1] * w); }
    }
};
struct SchedProj {
    int c, G, nmain, ntotal; const char* A; const char* B; const char* Am; const char* Bm;
    __device__ __forceinline__ bool next(int i, Unit& u) const {
        const long L = (long)i * G + c; if (L >= ntotal) return false;
        u.ord = i;
        if (L < nmain) { tile_order((int)L, M / 256, D_IN / 256, u.pm, u.pn); u.sub = 0; u.a = A + (size_t)u.pm * (256 * DM * 2); u.b = B + (size_t)u.pn * (256 * DM * 2); }
        else { const int r = (int)L - nmain; u.pm = r >> 2; u.pn = r & 3; u.sub = 1; u.a = Am + (size_t)u.pm * (256 * DM * 2); u.b = Bm + (size_t)u.pn * (256 * DM * 2); }
        return true; }
    __device__ __forceinline__ void a_ready(const Unit&) const {}
    __device__ __forceinline__ void done(const Unit&) const {}
};
struct SchedGate {
    int c, G; const char* OBRp; const char* WUP;
    __device__ __forceinline__ bool next(int i, Unit& u) const {
        const int t = c + G * (i / 3); if (t >= 256) return false;
        tile_order(t, M / 256, 4, u.pm, u.pn); u.sub = i % 3; u.ord = i;
        u.a = OBRp + ((size_t)u.pm * 256 * OBR_W + 512 * u.sub) * 2; u.b = WUP + ((size_t)u.sub * 1024 * 512 + (size_t)u.pn * 256 * 512) * 2; return true; }
    __device__ __forceinline__ void a_ready(const Unit&) const {}
    __device__ __forceinline__ void done(const Unit&) const {}
};
struct SchedPlain {
    int c, G, nM; const char* A; const char* B; size_t a_tile, b_tile;
    __device__ __forceinline__ bool next(int i, Unit& u) const {
        const long L = (long)i * G + c; if (L >= (long)nM * 4) return false;
        tile_order((int)L, nM, 4, u.pm, u.pn); u.sub = 0; u.ord = i; u.a = A + (size_t)u.pm * a_tile; u.b = B + (size_t)u.pn * b_tile; return true; }
    __device__ __forceinline__ void a_ready(const Unit&) const {}
    __device__ __forceinline__ void done(const Unit&) const {}
};
struct SchedMoeUp {
    static constexpr size_t b_exp = (size_t)1024 * 1024 * 2, b_tile = (size_t)256 * DM * 2;
    int c, G, ntiles; const PG8_LAS int* tile_e; const char* A; const char* B; unsigned* tcnt;
    __device__ __forceinline__ bool next(int i, Unit& u) const {
        const long L = (long)i * G + c; if (L >= (long)ntiles * 4) return false;
        u.pm = (int)(L >> 2); u.pn = (int)(L & 3); u.sub = 0; u.ord = i; const int e = tile_e[u.pm];
        u.a = A; u.b = B + (size_t)e * b_exp + (size_t)u.pn * b_tile; return true; }
    __device__ __forceinline__ void a_ready(const Unit&) const {}
    __device__ __forceinline__ void done(const Unit& u) const {
        asm volatile("s_waitcnt vmcnt(0)" ::: "memory");
        if (lane_id() == 0) __hip_atomic_fetch_add(tcnt + 64 * u.pm, 1u, __ATOMIC_RELAXED, __HIP_MEMORY_SCOPE_AGENT);
    }
};
__device__ __forceinline__ int moe_down_unit(int c, int i, int rem, int G) {
    const int n0 = G - rem, n1 = rem;
    return c >= rem ? n0 * i + n1 * (i > 1 ? i - 1 : 0) + (c - rem) : n0 * (i + 2) + n1 * i + c;
}
struct SchedMoeDown {
    static constexpr size_t a_tile = (size_t)256 * DEXP * 2, b_exp = (size_t)1024 * 512 * 2, b_tile = (size_t)256 * DEXP * 2;
    int c, G, ntiles, rem, wv; const PG8_LAS int* tile_e; const char* A; const char* B; unsigned* tcnt; unsigned* tmo;
    __device__ __forceinline__ bool next(int i, Unit& u) const {
        const int j = moe_down_unit(c, i, rem, G); if (j >= ntiles * 4) return false;
        u.pm = j >> 2; u.pn = j & 3; u.sub = 0; u.ord = i; const int e = tile_e[u.pm];
        u.a = A + (size_t)u.pm * a_tile; u.b = B + (size_t)e * b_exp + (size_t)u.pn * b_tile; return true; }
    __device__ __forceinline__ void a_ready(const Unit& u) const {
        if (wv == 0) {
            unsigned polls = 0;
            while ((unsigned)__builtin_amdgcn_readfirstlane(__hip_atomic_load(tcnt + 64 * u.pm, __ATOMIC_RELAXED, __HIP_MEMORY_SCOPE_AGENT)) < 32u) {
                if (++polls > (1u << 20)) { if (lane_id() == 0) __hip_atomic_store(tmo, 1u, __ATOMIC_RELAXED, __HIP_MEMORY_SCOPE_AGENT); break; }
                __builtin_amdgcn_s_sleep(2); }
            __builtin_amdgcn_fence(__ATOMIC_ACQUIRE, "agent");
            asm volatile("s_waitcnt vmcnt(0)" ::: "memory");
        }
        asm volatile("" ::: "memory"); __builtin_amdgcn_s_barrier(); asm volatile("" ::: "memory");
    }
    __device__ __forceinline__ void done(const Unit&) const {}
};

template <class Epi, class Sched, bool ALIGN_EPI = false, bool SP2 = false, bool GATHER = false>
__device__ __forceinline__ void gemm_phase(PG8_LAS unsigned char* lds, const Gemm g, const Sched& S, const Epi& E, int wave_id, const PG8_LAS unsigned* rowtab = nullptr) {
    static_assert(!GATHER || SP2, "the gathered A path is written for the two-super-phase loop");
    int tid_ = wave_id * 64 + lane_id(); asm volatile("" : "+v"(tid_));
    const int tid = tid_, wid = __builtin_amdgcn_readfirstlane(tid >> 6), lane = tid & 63, wr = wid >> 2, wc = wid & 3, fr = lane & 15, fq = lane >> 4;
    const int K = g.K, nt = K / BK;
    unsigned voffA[2], voffB[2];
#pragma unroll
    for (int i = 0; i < 2; ++i) { int R, C; stage_rc(tid * 16 + i * 8192, R, C); const int Rb = Epi::PERM ? ((R & ~31) + perm32(R & 31)) : R;
        voffA[i] = (unsigned)(R * g.lda + C) * 2u; voffB[i] = (unsigned)(Rb * K + C) * 2u; }
    unsigned gC[2][2] = {{0u, 0u}, {0u, 0u}}, gN[2][2] = {{0u, 0u}, {0u, 0u}};
#define PG8_GROWS(dst, ord) do { if constexpr (GATHER) { _Pragma("unroll") for (int i_ = 0; i_ < 2; ++i_) { int R_, C_; stage_rc((wid * 64 + fq * 16 + fr) * 16 + i_ * 8192, R_, C_);     \
        _Pragma("unroll") for (int h_ = 0; h_ < 2; ++h_) dst[h_][i_] = rowtab[(ord) * 256 + h_ * 128 + R_] + (unsigned)C_ * 2u; } } } while (0)
#define PG8_STAGE_A(bufoff, base, h, use_next) do { if constexpr (GATHER) { unsigned vo_[2]; vo_[0] = (use_next) ? gN[h][0] : gC[h][0]; vo_[1] = (use_next) ? gN[h][1] : gC[h][1]; PG8_STAGE(bufoff, base, vo_); } \
        else { PG8_STAGE(bufoff, (base) + (h) * hstepA, voffA); } } while (0)
    const size_t kstep = (size_t)(BK * 2);
    const size_t hstepA = (size_t)HALF * g.lda * 2, hstepB = (size_t)HALF * K * 2;
    const unsigned ldsw = (unsigned)wid * 1024u;
    const int aoff = lds_byte(wr * 64 + fr, fq * 8), boff = lds_byte(wc * 32 + fr, fq * 8);
#define PG8_SA(b, h) (((b) * 2 + (h)) * HTB)
#define PG8_SB(b, h) ((4 + (b) * 2 + (h)) * HTB)
#define PG8_STAGE(bufoff, gbase, voff) do { _Pragma("unroll") for (int _i = 0; _i < 2; ++_i) \
        __builtin_amdgcn_global_load_lds((const unsigned*)((const char*)(gbase) + (voff)[_i]), (PG8_LAS unsigned*)(lds + (bufoff) + ldsw + _i * 8192), 16, 0, 0); } while (0)
#define PG8_LDA(dst, b, h) do { _Pragma("unroll") for (int m = 0; m < 4; ++m) _Pragma("unroll") for (int k = 0; k < 2; ++k) dst[m][k] = *(const PG8_LAS bf16x8*)(lds + PG8_SA(b, h) + aoff + m * 2048 + k * 1024); } while (0)
#define PG8_LDB(dst, b, h) do { _Pragma("unroll") for (int n = 0; n < 2; ++n) _Pragma("unroll") for (int k = 0; k < 2; ++k) dst[n][k] = *(const PG8_LAS bf16x8*)(lds + PG8_SB(b, h) + boff + n * 2048 + k * 1024); } while (0)
#define PG8_MMA(ai, bj, At, Bt) do { __builtin_amdgcn_s_setprio(1); _Pragma("unroll") for (int m = 0; m < 4; ++m) _Pragma("unroll") for (int n = 0; n < 2; ++n) _Pragma("unroll") for (int k = 0; k < 2; ++k) \
        acc[ai][bj][m][n] = __builtin_amdgcn_mfma_f32_16x16x32_bf16(Bt[n][k], At[m][k], acc[ai][bj][m][n], 0, 0, 0); __builtin_amdgcn_s_setprio(0); } while (0)
#define PG8_WAIT_V(n) asm volatile("s_waitcnt vmcnt(" #n ")" ::: "memory")
#define PG8_WAIT_L(n) asm volatile("s_waitcnt lgkmcnt(" #n ")" ::: "memory")
#define PG8_BAR __builtin_amdgcn_s_barrier()
#define PG8_SCHED __builtin_amdgcn_sched_barrier(0)
    Unit cur, nxt; int ui = 0;
    if (!S.next(0, cur)) return;
    f32x4 acc[2][2][4][2];
#pragma unroll
    for (int a = 0; a < 2; ++a)
#pragma unroll
        for (int b = 0; b < 2; ++b)
#pragma unroll
            for (int m = 0; m < 4; ++m)
#pragma unroll
                for (int n = 0; n < 2; ++n) acc[a][b][m][n] = (f32x4){0.f, 0.f, 0.f, 0.f};
    bf16x8 At[4][2], B0[2][2], B1[2][2];
    const char* cA = cur.a; const char* cB = cur.b;
    S.a_ready(cur);
    if constexpr (SP2) {
        PG8_GROWS(gC, 0);
        PG8_STAGE(PG8_SB(0, 0), cB, voffB); PG8_STAGE(PG8_SB(0, 1), cB + hstepB, voffB); PG8_STAGE_A(PG8_SA(0, 0), cA, 0, false); PG8_STAGE_A(PG8_SA(0, 1), cA, 1, false);
        if (wr == 1) PG8_BAR;
        PG8_WAIT_V(2); PG8_BAR;
        PG8_STAGE(PG8_SB(1, 0), cB + kstep, voffB); PG8_STAGE_A(PG8_SA(1, 0), cA + kstep, 0, false); PG8_STAGE(PG8_SB(1, 1), cB + hstepB + kstep, voffB);
        PG8_WAIT_V(6); PG8_BAR;
    } else {
        PG8_STAGE(PG8_SB(0, 0), cB, voffB); PG8_STAGE(PG8_SA(0, 0), cA, voffA); PG8_STAGE(PG8_SB(0, 1), cB + hstepB, voffB); PG8_STAGE(PG8_SA(0, 1), cA + hstepA, voffA);
        if (wr == 1) PG8_BAR;
        PG8_WAIT_V(4); PG8_BAR;
        PG8_STAGE(PG8_SB(1, 0), cB + kstep, voffB); PG8_STAGE(PG8_SA(1, 0), cA + kstep, voffA); PG8_STAGE(PG8_SB(1, 1), cB + hstepB + kstep, voffB);
        PG8_WAIT_V(6); PG8_BAR;
    }
    for (;;) {
        const bool has_next = S.next(ui + 1, nxt);
        const char* nA = has_next ? nxt.a : cA; const char* nB = has_next ? nxt.b : cB;
        for (int t = 0; t < nt; t += 2) {
            const bool last = (t == nt - 2);
            const char* a1 = cA + (size_t)(t + 1) * kstep;
            const char* a2 = last ? nA : cA + (size_t)(t + 2) * kstep; const char* b2 = last ? nB : cB + (size_t)(t + 2) * kstep;
            const char* a3 = a2 + kstep; const char* b3 = b2 + kstep;
            if (last && has_next) S.a_ready(nxt);
            if constexpr (GATHER) { if (last) { if (has_next) { PG8_GROWS(gN, ui + 1); } else { _Pragma("unroll") for (int h_ = 0; h_ < 2; ++h_) _Pragma("unroll") for (int i_ = 0; i_ < 2; ++i_) gN[h_][i_] = gC[h_][i_]; } } }
            if constexpr (SP2) {
            PG8_LDB(B0, 0, 0); PG8_LDB(B1, 0, 1); PG8_SCHED; PG8_LDA(At, 0, 0); PG8_STAGE_A(PG8_SA(1, 1), a1, 1, false);
            PG8_WAIT_V(8); PG8_WAIT_L(0); PG8_BAR; PG8_MMA(0, 0, At, B0); PG8_MMA(0, 1, At, B1); PG8_BAR; PG8_SCHED;
            PG8_LDA(At, 0, 1); PG8_STAGE(PG8_SB(0, 0), b2, voffB); PG8_STAGE(PG8_SB(0, 1), b2 + hstepB, voffB); PG8_STAGE_A(PG8_SA(0, 0), a2, 0, last);
            PG8_WAIT_V(8); PG8_WAIT_L(0); PG8_BAR; PG8_MMA(1, 0, At, B0); PG8_MMA(1, 1, At, B1); PG8_BAR; PG8_SCHED;
            PG8_LDB(B0, 1, 0); PG8_LDB(B1, 1, 1); PG8_SCHED; PG8_LDA(At, 1, 0); PG8_STAGE_A(PG8_SA(0, 1), a2, 1, last);
            PG8_WAIT_V(8); PG8_WAIT_L(0); PG8_BAR; PG8_MMA(0, 0, At, B0); PG8_MMA(0, 1, At, B1); PG8_BAR; PG8_SCHED;
            PG8_LDA(At, 1, 1); PG8_STAGE(PG8_SB(1, 0), b3, voffB); PG8_STAGE(PG8_SB(1, 1), b3 + hstepB, voffB); PG8_STAGE_A(PG8_SA(1, 0), a3, 0, last);
            PG8_WAIT_V(8); PG8_WAIT_L(0); PG8_BAR; PG8_MMA(1, 0, At, B0); PG8_MMA(1, 1, At, B1); PG8_BAR; PG8_SCHED;
            } else {
            PG8_LDB(B0, 0, 0); PG8_SCHED; PG8_LDA(At, 0, 0); PG8_STAGE(PG8_SA(1, 1), a1 + hstepA, voffA);
            PG8_WAIT_L(8); PG8_BAR; PG8_WAIT_L(0); PG8_MMA(0, 0, At, B0); PG8_BAR; PG8_SCHED;
            PG8_LDB(B1, 0, 1); PG8_STAGE(PG8_SB(0, 0), b2, voffB);
            PG8_BAR; PG8_WAIT_L(0); PG8_MMA(0, 1, At, B1); PG8_BAR;
            PG8_LDA(At, 0, 1); PG8_STAGE(PG8_SA(0, 0), a2, voffA);
            PG8_BAR; PG8_WAIT_L(0); PG8_MMA(1, 0, At, B0); PG8_BAR; PG8_SCHED;
            PG8_STAGE(PG8_SB(0, 1), b2 + hstepB, voffB);
            PG8_WAIT_V(6); PG8_BAR; PG8_MMA(1, 1, At, B1); PG8_BAR;
            PG8_LDB(B0, 1, 0); PG8_SCHED; PG8_LDA(At, 1, 0); PG8_STAGE(PG8_SA(0, 1), a2 + hstepA, voffA);
            PG8_WAIT_L(8); PG8_BAR; PG8_WAIT_L(0); PG8_MMA(0, 0, At, B0); PG8_BAR; PG8_SCHED;
            PG8_LDB(B1, 1, 1); PG8_STAGE(PG8_SB(1, 0), b3, voffB);
            PG8_BAR; PG8_WAIT_L(0); PG8_MMA(0, 1, At, B1); PG8_BAR;
            PG8_LDA(At, 1, 1); PG8_STAGE(PG8_SA(1, 0), a3, voffA);
            PG8_BAR; PG8_WAIT_L(0); PG8_MMA(1, 0, At, B0); PG8_BAR; PG8_SCHED;
            PG8_STAGE(PG8_SB(1, 1), b3 + hstepB, voffB);
            PG8_WAIT_V(6); PG8_BAR; PG8_MMA(1, 1, At, B1); PG8_BAR;
            }
        }
        if constexpr (ALIGN_EPI) { if (wr == 0) PG8_BAR; }
        if constexpr (!Epi::AFTER_DRAIN) { E(acc, cur, wr, wc, fr, fq); S.done(cur); }
        if (!has_next) break;
#pragma unroll
        for (int a = 0; a < 2; ++a)
#pragma unroll
            for (int b = 0; b < 2; ++b)
#pragma unroll
                for (int m = 0; m < 4; ++m)
#pragma unroll
                    for (int n = 0; n < 2; ++n) acc[a][b][m][n] = (f32x4){0.f, 0.f, 0.f, 0.f};
        cur = nxt; cA = nA; cB = nB; ++ui;
        if constexpr (GATHER) { _Pragma("unroll") for (int h_ = 0; h_ < 2; ++h_) _Pragma("unroll") for (int i_ = 0; i_ < 2; ++i_) gC[h_][i_] = gN[h_][i_]; }
        if constexpr (ALIGN_EPI) { if (wr == 1) PG8_BAR; }
    }
    PG8_WAIT_V(0);
    if constexpr (!ALIGN_EPI) { if (wr == 0) PG8_BAR; }
    PG8_BAR;
    if constexpr (Epi::AFTER_DRAIN) { E.fused(acc, cur, wr, wc, fr, fq, lds, wid, lane); S.done(cur); }
#undef PG8_SA
#undef PG8_GROWS
#undef PG8_STAGE_A
#undef PG8_SB
#undef PG8_STAGE
#undef PG8_LDA
#undef PG8_LDB
#undef PG8_MMA
#undef PG8_WAIT_V
#undef PG8_WAIT_L
#undef PG8_BAR
#undef PG8_SCHED
}
}

namespace att {
constexpr int NW = 8, QBLK = 32, KVBLK = 64;
constexpr float THR = 8.f;
#define ATT_SBAR() __builtin_amdgcn_sched_barrier(0)
__device__ __forceinline__ int crow(int r, int hi) { return (r & 3) + 8 * (r >> 2) + 4 * hi; }
template <int D> __device__ __forceinline__ int kswz(int row, int colB) { return D == 128 ? row * 256 + (colB ^ ((row & 7) << 4)) : row * 128 + (colB ^ (((row >> 1) & 7) << 4)); }
template <int DV> __device__ __forceinline__ int v_st(int k, int c) { const int kk = (k & ~0xC) | ((k & 4) << 1) | ((k & 8) >> 1); return ((kk >> 3) * (DV / 32) + (c >> 5)) * 512 + ((kk & 7) * 32 + (c & 31)) * 2; }
__device__ __forceinline__ int v_rd_base(int lane) { return ((lane & 3) << 3) | (((lane >> 2) & 3) << 6) | (((lane >> 4) & 1) << 5) | (((lane >> 5) & 1) << 8); }
template <int DV> constexpr int v_rd_off(int d0, int ks, int half) { return d0 * 512 + ks * (DV / 32) * 1024 + half * (DV / 32) * 512; }
template <int OFF> __device__ __forceinline__ s16x4 tr_read(int vb) { s16x4 r; asm volatile("ds_read_b64_tr_b16 %0, %1 offset:%2" : "=&v"(r) : "v"(vb), "i"(OFF) : "memory"); return r; }

__device__ __forceinline__ void partialSM(f32x16& p0, f32x16& p1, float& m_reg, float& mn, float& alpha) {
    float pmax = p0[0];
#pragma unroll
    for (int r = 1; r < 16; ++r) pmax = fmaxf(pmax, p0[r]);
#pragma unroll
    for (int r = 0; r < 16; ++r) pmax = fmaxf(pmax, p1[r]);
    { auto rr = __builtin_amdgcn_permlane32_swap(__float_as_uint(pmax), __float_as_uint(pmax), false, false); pmax = fmaxf(__uint_as_float(rr[0]), __uint_as_float(rr[1])); }
    if (__builtin_expect(__all(pmax - m_reg <= THR), 1)) { mn = m_reg; alpha = 1.f; }
    else { mn = fmaxf(m_reg, pmax); alpha = __builtin_amdgcn_exp2f(m_reg - mn); m_reg = mn; }
#pragma unroll
    for (int r = 0; r < 16; ++r) { p0[r] -= mn; p1[r] -= mn; }
#pragma unroll
    for (int r = 0; r < 16; ++r) p0[r] = __builtin_amdgcn_exp2f(p0[r]);
}
__device__ __forceinline__ void finishSM(f32x16& p0, f32x16& p1, float alpha, float& l_reg, bf16x8& pa0, bf16x8& pa1, bf16x8& pa2, bf16x8& pa3) {
#pragma unroll
    for (int r = 0; r < 16; ++r) p1[r] = __builtin_amdgcn_exp2f(p1[r]);
    float ps = 0;
#pragma unroll
    for (int r = 0; r < 16; ++r) ps += p0[r];
#pragma unroll
    for (int r = 0; r < 16; ++r) ps += p1[r];
    { auto rr = __builtin_amdgcn_permlane32_swap(__float_as_uint(ps), __float_as_uint(ps), false, false); ps = __uint_as_float(rr[0]) + __uint_as_float(rr[1]); }
    l_reg = l_reg * alpha + ps;
#define ATT_PK4(P, BASE, OUT) do { unsigned a0 = cvt_pk_bf16(P[BASE + 0], P[BASE + 1]), a1 = cvt_pk_bf16(P[BASE + 2], P[BASE + 3]);   \
    unsigned b0 = cvt_pk_bf16(P[BASE + 4], P[BASE + 5]), b1 = cvt_pk_bf16(P[BASE + 6], P[BASE + 7]);                              \
    auto r0 = __builtin_amdgcn_permlane32_swap(a0, b0, false, false); auto r1 = __builtin_amdgcn_permlane32_swap(a1, b1, false, false); \
    u32x4 w = {r0[0], r1[0], r0[1], r1[1]}; OUT = *reinterpret_cast<bf16x8*>(&w); } while (0)
    ATT_PK4(p0, 0, pa0); ATT_PK4(p0, 8, pa1); ATT_PK4(p1, 0, pa2); ATT_PK4(p1, 8, pa3);
#undef ATT_PK4
}
template <int DQK> __device__ __forceinline__ void qkt(f32x16& p0, f32x16& p1, const char* Ks, const bf16x8* qr, int r32, int hi) {
    p0 = f32x16{}; p1 = f32x16{};
#pragma unroll
    for (int d0 = 0; d0 < DQK / 16; ++d0) { const int cb = (d0 * 16 + hi * 8) * 2;
        const bf16x8 b0 = *reinterpret_cast<const bf16x8*>(Ks + kswz<DQK>(r32, cb));
        const bf16x8 b1 = *reinterpret_cast<const bf16x8*>(Ks + kswz<DQK>(32 + r32, cb));
        p0 = __builtin_amdgcn_mfma_f32_32x32x16_bf16(b0, qr[d0], p0, 0, 0, 0);
        p1 = __builtin_amdgcn_mfma_f32_32x32x16_bf16(b1, qr[d0], p1, 0, 0, 0); }
}
template <int DV, int D0> __device__ __forceinline__ void pv_one(f32x16& od, int vb, bf16x8 pa0, bf16x8 pa1, bf16x8 pa2, bf16x8 pa3) {
    const s16x4 l0 = tr_read<v_rd_off<DV>(D0, 0, 0)>(vb), h0 = tr_read<v_rd_off<DV>(D0, 0, 1)>(vb), l1 = tr_read<v_rd_off<DV>(D0, 1, 0)>(vb), h1 = tr_read<v_rd_off<DV>(D0, 1, 1)>(vb);
    const s16x4 l2 = tr_read<v_rd_off<DV>(D0, 2, 0)>(vb), h2 = tr_read<v_rd_off<DV>(D0, 2, 1)>(vb), l3 = tr_read<v_rd_off<DV>(D0, 3, 0)>(vb), h3 = tr_read<v_rd_off<DV>(D0, 3, 1)>(vb);
    asm volatile("s_waitcnt lgkmcnt(0)" ::: "memory"); ATT_SBAR();
#define ATT_PK(L, H) (bf16x8){L[0], L[1], L[2], L[3], H[0], H[1], H[2], H[3]}
    od = __builtin_amdgcn_mfma_f32_32x32x16_bf16(pa0, ATT_PK(l0, h0), od, 0, 0, 0);
    od = __builtin_amdgcn_mfma_f32_32x32x16_bf16(pa1, ATT_PK(l1, h1), od, 0, 0, 0);
    od = __builtin_amdgcn_mfma_f32_32x32x16_bf16(pa2, ATT_PK(l2, h2), od, 0, 0, 0);
    od = __builtin_amdgcn_mfma_f32_32x32x16_bf16(pa3, ATT_PK(l3, h3), od, 0, 0, 0);
#undef ATT_PK
}
template <int DV> __device__ __forceinline__ void pv_all(f32x16 (&o)[DV / 32], int vb, bf16x8 pa0, bf16x8 pa1, bf16x8 pa2, bf16x8 pa3) {
    pv_one<DV, 0>(o[0], vb, pa0, pa1, pa2, pa3); pv_one<DV, 1>(o[1], vb, pa0, pa1, pa2, pa3);
    if constexpr (DV == 128) { pv_one<DV, 2>(o[2], vb, pa0, pa1, pa2, pa3); pv_one<DV, 3>(o[3], vb, pa0, pa1, pa2, pa3); }
}
template <int DQK, int DV> struct Lay { static constexpr int SHM_V = 64 * DV * 2, SHM_K = 64 * DQK * 2, OFF_V = 0, OFF_K = 2 * SHM_V, OFF_WS = OFF_K + 2 * SHM_K, OFF_STASH = OFF_WS + NW * 64 * 4; };

template <int DQK, int DV, int LDQ, int LDK, int LDV>
__device__ __forceinline__ void attn_pass(const bf16_t* __restrict__ Qb, const bf16_t* __restrict__ Kh, const bf16_t* __restrict__ Vh, int nkeys, char* lds, f32x16 (&o)[DV / 32], float (&rli)[16], int wv) {
    using L = Lay<DQK, DV>;
    constexpr int NLK = DQK / 64, NLV = DV / 64;
    int tid_ = wv * 64 + lane_id(); asm volatile("" : "+v"(tid_));
    const int tid = tid_, wid = tid >> 6, lane = tid & 63, r32 = lane & 31, hi = lane >> 5;
    char* V_lds = lds + L::OFF_V; char* K_lds = lds + L::OFF_K;
    float* ws = (float*)(lds + L::OFF_WS) + wid * 64; float* li_l = ws; float* al_l = ws + 32;
    float m_reg = -1e30f, l_reg = 0.f; bf16x8 qr[DQK / 16];
#pragma unroll
    for (int d = 0; d < DV / 32; ++d) o[d] = f32x16{};
    const bf16_t* Qw = Qb + (size_t)(wid * QBLK + r32) * LDQ + hi * 8;
#pragma unroll
    for (int d0 = 0; d0 < DQK / 16; ++d0) qr[d0] = *reinterpret_cast<const bf16x8*>(Qw + d0 * 16);
    const int krow = DQK == 128 ? (tid >> 4) : (tid >> 3), kcol = DQK == 128 ? (tid & 15) * 8 : (tid & 7) * 8;
    const int vrow = DV == 128 ? (tid >> 4) : (tid >> 3), vcol = DV == 128 ? (tid & 15) * 8 : (tid & 7) * 8;
    const int vb0 = (int)(uintptr_t)V_lds + v_rd_base(lane);
    bf16x8 vsE[NLV], ksE[NLK], vsO[NLV], ksO[NLK];
#define ATT_SLOAD(VS, KS, k0) do { _Pragma("unroll") for (int i_ = 0; i_ < NLV; ++i_) VS[i_] = *reinterpret_cast<const bf16x8*>(&Vh[(size_t)((k0) + vrow + 32 * i_) * LDV + vcol]); \
    _Pragma("unroll") for (int i_ = 0; i_ < NLK; ++i_) KS[i_] = *reinterpret_cast<const bf16x8*>(&Kh[(size_t)((k0) + krow + 32 * i_) * LDK + kcol]); } while (0)
#define ATT_SWRITE(b, VS, KS) do { _Pragma("unroll") for (int i_ = 0; i_ < NLV; ++i_) *(bf16x8*)(V_lds + (b) * L::SHM_V + v_st<DV>(vrow + 32 * i_, vcol)) = VS[i_]; \
    _Pragma("unroll") for (int i_ = 0; i_ < NLK; ++i_) *(bf16x8*)(K_lds + (b) * L::SHM_K + kswz<DQK>(krow + 32 * i_, kcol * 2)) = KS[i_]; } while (0)
#define ATT_SWAIT() do { if constexpr (NLK + NLV == 4) asm volatile("s_waitcnt vmcnt(4)" ::: "memory"); else if constexpr (NLK + NLV == 3) asm volatile("s_waitcnt vmcnt(3)" ::: "memory"); else asm volatile("s_waitcnt vmcnt(2)" ::: "memory"); } while (0)
#define ATT_RESC(a) do { if (__any((a) < 1.f)) { if (hi == 0) al_l[r32] = (a); asm volatile("s_waitcnt lgkmcnt(0)" ::: "memory"); \
    _Pragma("unroll") for (int d = 0; d < DV / 32; ++d) _Pragma("unroll") for (int r = 0; r < 16; ++r) o[d][r] *= al_l[crow(r, hi)]; } } while (0)
    f32x16 pA0, pA1, pB0, pB1; float mnA, mnB, alA, alB; bf16x8 pa0, pa1, pa2, pa3; const int NT = nkeys / KVBLK;
    __syncthreads();
    ATT_SLOAD(vsE, ksE, 0); asm volatile("s_waitcnt vmcnt(0)" ::: "memory"); ATT_SWRITE(0, vsE, ksE); __syncthreads();
    qkt<DQK>(pA0, pA1, K_lds, qr, r32, hi); partialSM(pA0, pA1, m_reg, mnA, alA);
    ATT_SLOAD(vsO, ksO, KVBLK); if (2 < NT) ATT_SLOAD(vsE, ksE, 2 * KVBLK);
    ATT_SWAIT(); ATT_SWRITE(1, vsO, ksO); __syncthreads();
    for (int j = 1; j + 1 < NT; j += 2) {
        ATT_SBAR(); qkt<DQK>(pB0, pB1, K_lds + L::SHM_K, qr, r32, hi);
        finishSM(pA0, pA1, alA, l_reg, pa0, pa1, pa2, pa3); ATT_SBAR();
        ATT_SLOAD(vsO, ksO, (j + 2) * KVBLK); ATT_SBAR();
        pv_all<DV>(o, vb0, pa0, pa1, pa2, pa3); partialSM(pB0, pB1, m_reg, mnB, alB);
        __syncthreads(); ATT_SWAIT(); ATT_SWRITE(0, vsE, ksE);
        ATT_RESC(alB); __syncthreads();
        ATT_SBAR(); qkt<DQK>(pA0, pA1, K_lds, qr, r32, hi);
        finishSM(pB0, pB1, alB, l_reg, pa0, pa1, pa2, pa3); ATT_SBAR();
        if (j + 3 < NT) ATT_SLOAD(vsE, ksE, (j + 3) * KVBLK); ATT_SBAR();
        pv_all<DV>(o, vb0 + L::SHM_V, pa0, pa1, pa2, pa3); partialSM(pA0, pA1, m_reg, mnA, alA);
        __syncthreads(); ATT_SWAIT(); ATT_SWRITE(1, vsO, ksO);
        ATT_RESC(alA); __syncthreads();
    }
    ATT_SBAR(); qkt<DQK>(pB0, pB1, K_lds + L::SHM_K, qr, r32, hi);
    finishSM(pA0, pA1, alA, l_reg, pa0, pa1, pa2, pa3); ATT_SBAR();
    pv_all<DV>(o, vb0, pa0, pa1, pa2, pa3); partialSM(pB0, pB1, m_reg, mnB, alB);
    __syncthreads(); ATT_RESC(alB);
    finishSM(pB0, pB1, alB, l_reg, pa0, pa1, pa2, pa3); ATT_SBAR();
    pv_all<DV>(o, vb0 + L::SHM_V, pa0, pa1, pa2, pa3);
    if (hi == 0) li_l[r32] = l_reg; asm volatile("s_waitcnt lgkmcnt(0)" ::: "memory");
#pragma unroll
    for (int r = 0; r < 16; ++r) rli[r] = __builtin_amdgcn_rcpf(li_l[crow(r, hi)]);
#undef ATT_SLOAD
#undef ATT_SWRITE
#undef ATT_SWAIT
#undef ATT_RESC
}
template <int DV, int LDO> __device__ __forceinline__ void store_o(bf16_t* Ob, const f32x16 (&o)[DV / 32], const float (&rli)[16], int wv) {
    int tid_ = wv * 64 + lane_id(); asm volatile("" : "+v"(tid_));
    const int tid = tid_, wid = tid >> 6, lane = tid & 63, r32 = lane & 31, hi = lane >> 5;
    bf16_t* Ow = Ob + (size_t)(wid * QBLK) * LDO;
#pragma unroll
    for (int r = 0; r < 16; ++r) { const int orow = crow(r, hi);
#pragma unroll
        for (int d0 = 0; d0 < DV / 32; ++d0) Ow[(size_t)orow * LDO + d0 * 32 + r32] = f2bf(o[d0][r] * rli[r]); }
}
__device__ __forceinline__ void unit_a(const bf16_t* PROJ, bf16_t* OBR, int b, int h, int qb, float lam, float lam_init, const float* subg, char* lds, int wv) {
    using L = Lay<64, 128>;
    int tid_ = wv * 64 + lane_id(); asm volatile("" : "+v"(tid_));
    const int tid = tid_, wid = tid >> 6, lane = tid & 63, r32 = lane & 31, hi = lane >> 5;
    const bf16_t* kv = PROJ + (size_t)b * SEQ * D_IN; const size_t qrow = (size_t)b * SEQ + qb * 256;
    unsigned* stash = (unsigned*)(lds + L::OFF_STASH) + wid * 2048 + lane;
    f32x16 o[4]; float rli[16];
#pragma unroll 1
    for (int c = 0; c < 2; ++c) {
        attn_pass<64, 128, D_IN, D_IN, D_IN>(PROJ + qrow * D_IN + C_AQ + h * 128 + c * 64, kv + C_AK + h * 128 + c * 64, kv + C_AV + h * 128, SEQ, lds, o, rli, wv);
        if (c == 0) {
#pragma unroll
            for (int d0 = 0; d0 < 4; ++d0)
#pragma unroll
                for (int r = 0; r < 16; r += 2) stash[(d0 * 8 + (r >> 1)) * 64] = cvt_pk_bf16(o[d0][r] * rli[r], o[d0][r + 1] * rli[r + 1]);
        }
    }
    asm volatile("s_waitcnt lgkmcnt(0)" ::: "memory");
    float ss[16];
#pragma unroll
    for (int r = 0; r < 16; ++r) ss[r] = 0.f;
#pragma unroll
    for (int d0 = 0; d0 < 4; ++d0)
#pragma unroll
        for (int r = 0; r < 16; r += 2) { const unsigned w = stash[(d0 * 8 + (r >> 1)) * 64];
            const float c0 = __uint_as_float(w << 16) - lam * o[d0][r] * rli[r], c1 = __uint_as_float(w & 0xffff0000u) - lam * o[d0][r + 1] * rli[r + 1];
            o[d0][r] = c0; o[d0][r + 1] = c1; ss[r] += c0 * c0; ss[r + 1] += c1 * c1; }
#pragma unroll
    for (int r = 0; r < 16; ++r) { float s = ss[r]; s += __shfl_xor(s, 1); s += __shfl_xor(s, 2); s += __shfl_xor(s, 4); s += __shfl_xor(s, 8); s += __shfl_xor(s, 16);
        ss[r] = rsqrtf(s * (1.f / 128.f) + EPS) * (1.f - lam_init); }
    bf16_t* Ow = OBR + (qrow + wid * QBLK) * OBR_W + h * 128;
#pragma unroll
    for (int d0 = 0; d0 < 4; ++d0) { const float g = subg[d0 * 32 + r32];
#pragma unroll
        for (int r = 0; r < 16; ++r) Ow[(size_t)crow(r, hi) * OBR_W + d0 * 32 + r32] = f2bf(o[d0][r] * ss[r] * g); }
}
__device__ __forceinline__ void unit_b(const bf16_t* PROJ, bf16_t* OBR, int b, int qh, int qb, char* lds, int wv) {
    const bf16_t* kv = PROJ + (size_t)b * SEQ * D_IN; const size_t qrow = (size_t)b * SEQ + qb * 256;
    f32x16 o[2]; float rli[16];
    attn_pass<64, 64, D_IN, D_IN, D_IN>(PROJ + qrow * D_IN + C_BQ + qh * 64, kv + C_BK + (qh >> 2) * 64, kv + C_BV + (qh >> 2) * 64, SEQ, lds, o, rli, wv);
    store_o<64, OBR_W>(OBR + qrow * OBR_W + 512 + qh * 64, o, rli, wv);
}
__device__ __forceinline__ void unit_c(const bf16_t* PROJ, const bf16_t* MEMKV, bf16_t* OBR, int b, int h, int qb, char* lds, int wv) {
    const bf16_t* kv = MEMKV + (size_t)b * MEM_LEN * 1024; const size_t qrow = (size_t)b * SEQ + qb * 256;
    f32x16 o[4]; float rli[16];
    attn_pass<128, 128, D_IN, 1024, 1024>(PROJ + qrow * D_IN + C_CQ + h * 128, kv + h * 128, kv + 512 + h * 128, MEM_LEN, lds, o, rli, wv);
    store_o<128, OBR_W>(OBR + qrow * OBR_W + 1024 + h * 128, o, rli, wv);
}
#undef ATT_SBAR
}

__device__ __forceinline__ void row_rmsnorm(const float* __restrict__ xrow, const float* __restrict__ g, bf16_t* __restrict__ orow, float* __restrict__ xcopy, int lane) {
    const f32x4* xr = (const f32x4*)xrow; f32x4 v[4]; float s = 0.f;
#pragma unroll
    for (int j = 0; j < 4; ++j) { v[j] = xr[lane + 64 * j]; s += v[j].x * v[j].x + v[j].y * v[j].y + v[j].z * v[j].z + v[j].w * v[j].w; }
    const float rs = rsqrtf(wave_sum(s) * (1.f / DM) + EPS);
#pragma unroll
    for (int j = 0; j < 4; ++j) { const f32x4 gg = ((const f32x4*)g)[lane + 64 * j];
        if (xcopy) ((f32x4*)xcopy)[lane + 64 * j] = v[j];
        u32x2 o; o.x = cvt_pk_bf16(v[j].x * rs * gg.x, v[j].y * rs * gg.y); o.y = cvt_pk_bf16(v[j].z * rs * gg.z, v[j].w * rs * gg.w);
        ((u32x2*)orow)[lane + 64 * j] = o; }
}
__device__ __forceinline__ void route_block(const float* __restrict__ X, const bf16_t* __restrict__ rt_tab, const float* __restrict__ brg, const float* __restrict__ bre, int* __restrict__ experts, float* __restrict__ weights,
                                            int* __restrict__ rank, unsigned* __restrict__ cnt, float* __restrict__ rstd, int* __restrict__ list, const float* __restrict__ g2, bf16_t* __restrict__ H2, int rb, const bf16x8 (&Bh)[3][4], const bf16x8 (&Bl)[3][4], LAS float* slab, int tid, int wave) {
    const int lane = tid & 63, r = lane & 15, kq = lane >> 4;
    LAS float* ssq = slab + 8 * 64 * 48; LAS float* rs_l = ssq + 8 * 64;
#pragma unroll 1
    for (int rt = 0; rt < 4; ++rt) {
        const float* xp = X + (size_t)(rb * 64 + rt * 16 + r) * DM + 128 * wave + 8 * kq;
        f32x4 acc[3]; float ss = 0.f;
#pragma unroll
        for (int t = 0; t < 3; ++t) acc[t] = (f32x4){0.f, 0.f, 0.f, 0.f};
#pragma unroll
        for (int sI = 0; sI < 4; ++sI) {
            const f32x4 a0 = *(const f32x4*)(xp + 32 * sI), a1 = *(const f32x4*)(xp + 32 * sI + 4);
            ss += (a0[0] * a0[0] + a0[1] * a0[1]) + (a0[2] * a0[2] + a0[3] * a0[3]) + (a1[0] * a1[0] + a1[1] * a1[1]) + (a1[2] * a1[2] + a1[3] * a1[3]);
            u32x4 hw, lw;
            hw.x = cvt_pk_bf16(a0[0], a0[1]); hw.y = cvt_pk_bf16(a0[2], a0[3]); hw.z = cvt_pk_bf16(a1[0], a1[1]); hw.w = cvt_pk_bf16(a1[2], a1[3]);
            lw.x = cvt_pk_bf16(a0[0] - __uint_as_float(hw.x << 16), a0[1] - __uint_as_float(hw.x & 0xffff0000u)); lw.y = cvt_pk_bf16(a0[2] - __uint_as_float(hw.y << 16), a0[3] - __uint_as_float(hw.y & 0xffff0000u));
            lw.z = cvt_pk_bf16(a1[0] - __uint_as_float(hw.z << 16), a1[1] - __uint_as_float(hw.z & 0xffff0000u)); lw.w = cvt_pk_bf16(a1[2] - __uint_as_float(hw.w << 16), a1[3] - __uint_as_float(hw.w & 0xffff0000u));
            const bf16x8 Ah = __builtin_bit_cast(bf16x8, hw), Al = __builtin_bit_cast(bf16x8, lw);
#pragma unroll
            for (int t = 0; t < 3; ++t) {
                acc[t] = __builtin_amdgcn_mfma_f32_16x16x32_bf16(Ah, Bh[t][sI], acc[t], 0, 0, 0);
                acc[t] = __builtin_amdgcn_mfma_f32_16x16x32_bf16(Al, Bh[t][sI], acc[t], 0, 0, 0);
                acc[t] = __builtin_amdgcn_mfma_f32_16x16x32_bf16(Ah, Bl[t][sI], acc[t], 0, 0, 0);
            }
        }
        ss += __shfl_xor(ss, 16); ss += __shfl_xor(ss, 32);
        if (kq == 0) ssq[wave * 64 + rt * 16 + r] = ss;
#pragma unroll
        for (int t = 0; t < 3; ++t)
#pragma unroll
            for (int e = 0; e < 4; ++e) slab[(wave * 64 + rt * 16 + 4 * kq + e) * 48 + 16 * t + r] = acc[t][e];
    }
    __syncthreads();
    if (tid < 64) {
        const int row = rb * 64 + tid;
        float lg[36]; float ss = 0.f;
#pragma unroll
        for (int c = 0; c < 36; ++c) lg[c] = 0.f;
#pragma unroll 1
        for (int w = 0; w < 8; ++w) { ss += ssq[w * 64 + tid];
#pragma unroll
            for (int c = 0; c < 36; ++c) lg[c] += slab[(w * 64 + tid) * 48 + c]; }
        const float rs = rsqrtf(ss * (1.f / DM) + EPS);
        rstd[row] = rs;
        int gi = 0; float gm = lg[0] * rs + brg[0];
#pragma unroll
        for (int i = 1; i < 4; ++i) { const float l = lg[i] * rs + brg[i]; if (l > gm) { gm = l; gi = i; } }
        float gs = 0.f;
#pragma unroll
        for (int i = 0; i < 4; ++i) gs += __expf(lg[i] * rs + brg[i] - gm);
        const float gp = 1.f / gs;
        float el[8];
#pragma unroll
        for (int i = 0; i < 8; ++i) el[i] = 0.f;
#pragma unroll
        for (int gq = 0; gq < 4; ++gq) if (gq == gi) {
#pragma unroll
            for (int i = 0; i < 8; ++i) el[i] = lg[4 + gq * 8 + i] * rs + bre[gq * 8 + i]; }
        int i0 = 0; float l0 = el[0];
#pragma unroll
        for (int i = 1; i < 8; ++i) if (el[i] > l0) { l0 = el[i]; i0 = i; }
        int i1 = -1; float l1 = -INFINITY;
#pragma unroll
        for (int i = 0; i < 8; ++i) if (i != i0 && el[i] > l1) { l1 = el[i]; i1 = i; }
        const float p1 = __expf(l1 - l0), inv = 1.f / (1.f + p1);
        const int e0 = gi * 8 + i0, e1 = gi * 8 + i1;
        experts[row * 2] = e0; experts[row * 2 + 1] = e1;
        weights[row * 2] = gp * inv; weights[row * 2 + 1] = gp * p1 * inv;
        const int r0 = (int)atomicAdd(cnt + e0, 1u), r1 = (int)atomicAdd(cnt + e1, 1u);
        rank[row * 2] = r0; rank[row * 2 + 1] = r1;
        list[e0 * LCAP + r0] = row * 2; list[e1 * LCAP + r1] = row * 2 + 1;
        rs_l[tid] = rs;
    }
    __syncthreads();
#pragma unroll 1
    for (int rr = 0; rr < 8; ++rr) {
        const int row = rb * 64 + wave * 8 + rr; const float rs = rs_l[wave * 8 + rr];
        const f32x4* xr = (const f32x4*)(X + (size_t)row * DM); u32x2* dst = (u32x2*)(H2 + (size_t)row * DM);
#pragma unroll
        for (int j = 0; j < 4; ++j) { const f32x4 v = xr[lane + 64 * j], gg = ((const f32x4*)g2)[lane + 64 * j];
            u32x2 o; o.x = cvt_pk_bf16(v.x * rs * gg.x, v.y * rs * gg.y); o.y = cvt_pk_bf16(v.z * rs * gg.z, v.w * rs * gg.w); dst[lane + 64 * j] = o; }
    }
    __syncthreads();
}
__device__ __forceinline__ void moe_tables(const unsigned* cnt, volatile LAS int* mt, int tid) {
    if (tid == 0) { int off = 0, nt = 0;
#pragma unroll 1
        for (int e = 0; e < NEXP; ++e) { const int c = (int)__hip_atomic_load(cnt + e, __ATOMIC_RELAXED, __HIP_MEMORY_SCOPE_AGENT), t = (c + MOE_TILE - 1) / MOE_TILE;
            mt[e] = off; mt[32 + e] = c; mt[64 + e] = nt;
#pragma unroll 1
            for (int i = 0; i < t; ++i) mt[96 + nt + i] = e;
            nt += t; off += t * MOE_TILE; }
        mt[256] = nt; }
    __syncthreads();
}
__device__ __forceinline__ void moe_rowtabs(volatile LAS int* mt, const int* __restrict__ list, const float* __restrict__ weights, LAS unsigned* rowtab, LAS float* wtab, int bx, int G, int tid, int up) {
    const int ntiles = mt[256], rem = (ntiles * 4) % G;
#pragma unroll 1
    for (int i = 0; i < 4; ++i) { const long L = up ? (long)i * G + bx : (long)pg8::moe_down_unit(bx, i, rem, G); if (L >= (long)ntiles * 4) break;
        if (tid < 256) { const int tile = (int)(L >> 2), e = mt[96 + tile], q = (tile - mt[64 + e]) * 256 + tid; const bool valid = q < mt[32 + e];
            const int a = valid ? list[e * LCAP + q] : 0;
            if (up) rowtab[i * 256 + tid] = (unsigned)(a >> 1) * (unsigned)(DM * 2); else wtab[i * 256 + tid] = valid ? weights[a] : 0.f; } }
    __syncthreads();
}
__device__ __forceinline__ void row_combine_norm(float* __restrict__ X, const bf16_t* __restrict__ YB, const int* __restrict__ dest, const float* __restrict__ g, bf16_t* __restrict__ H, float* __restrict__ OUT, int row, int lane, bool poison, int d0, int d1) {
    f32x4* xr = (f32x4*)(X + (size_t)row * DM);
    f32x4 v[4]; float s = 0.f;
#pragma unroll
    for (int j = 0; j < 4; ++j) { v[j] = xr[lane + 64 * j];
        const u32x2 a = ((const u32x2*)(YB + (size_t)d0 * DM))[lane + 64 * j], b = ((const u32x2*)(YB + (size_t)d1 * DM))[lane + 64 * j];
        v[j].x += __uint_as_float(a.x << 16) + __uint_as_float(b.x << 16); v[j].y += __uint_as_float(a.x & 0xffff0000u) + __uint_as_float(b.x & 0xffff0000u);
        v[j].z += __uint_as_float(a.y << 16) + __uint_as_float(b.y << 16); v[j].w += __uint_as_float(a.y & 0xffff0000u) + __uint_as_float(b.y & 0xffff0000u);
        s += v[j].x * v[j].x + v[j].y * v[j].y + v[j].z * v[j].z + v[j].w * v[j].w; }
    float rs = rsqrtf(wave_sum(s) * (1.f / DM) + EPS);
    if (poison) rs = __builtin_nanf("");
#pragma unroll
    for (int j = 0; j < 4; ++j) { const f32x4 gg = ((const f32x4*)g)[lane + 64 * j];
        if (H) { xr[lane + 64 * j] = v[j];
            u32x2 o; o.x = cvt_pk_bf16(v[j].x * rs * gg.x, v[j].y * rs * gg.y); o.y = cvt_pk_bf16(v[j].z * rs * gg.z, v[j].w * rs * gg.w);
            ((u32x2*)(H + (size_t)row * DM))[lane + 64 * j] = o; }
        else { f32x4 o; o.x = v[j].x * rs * gg.x; o.y = v[j].y * rs * gg.y; o.z = v[j].z * rs * gg.z; o.w = v[j].w * rs * gg.w; ((f32x4*)(OUT + (size_t)row * DM))[lane + 64 * j] = o; }
    }
}
struct TrItem { const float* src; bf16_t* dst; int ldw, K; };
template <int OFF> __device__ __forceinline__ unsigned long long karg64() { unsigned long long v; asm volatile("s_load_dwordx2 %0, %1, %2\n\ts_waitcnt lgkmcnt(0)" : "=s"(v) : "s"(__builtin_amdgcn_kernarg_segment_ptr()), "n"(OFF)); return v; }
__device__ __forceinline__ unsigned long long karg64d(int off) { unsigned long long v; asm volatile("s_load_dwordx2 %0, %1, %2\n\ts_waitcnt lgkmcnt(0)" : "=s"(v) : "s"(__builtin_amdgcn_kernarg_segment_ptr()), "s"(off)); return v; }
#define TR_IN(k) ((const float*)karg64d(8 * (k)))
__device__ __forceinline__ void tr_decode(int it, int lane, bf16_t* WB, const float*& sp, int& ldw, bf16_t*& dp, int& K) {
    const float* src; int segA, segB, kb, tb, dk0 = 0; bf16_t* dst;
    if (it < 28800) {
        const int l = it / 14400; int r = it % 14400; bf16_t* WBl = WB + (size_t)l * WB_LAYER;
        if (r < 1472) { kb = r / 92; tb = r % 92; const int pn = tb >> 2, bj = (tb >> 1) & 1, w0 = 2 * (tb & 1); src = TR_IN(5) + (size_t)l * DM * D_IN; ldw = D_IN; K = DM; segA = 256 * pn + 64 * w0 + 32 * bj; segB = segA + 64; dst = WBl + WB_IN; }
        else if (r < 1856) { r -= 1472; const int i = r >> 7; r &= 127; kb = r >> 4; tb = r & 15; src = TR_IN(13 + i) + (size_t)l * 512 * DM; ldw = DM; K = 512; segA = 64 * tb; segB = segA + 32; dst = WBl + WB_UP + (size_t)i * 1024 * 512; }
        else if (r < 2112) { r -= 1856; kb = r >> 4; tb = r & 15; src = TR_IN(16) + (size_t)l * DM * DM; ldw = DM; K = DM; segA = 64 * tb; segB = segA + 32; dst = WBl + WB_OUT; }
        else if (r < 10304) { r -= 2112; const int e = r >> 8; r &= 255; kb = r >> 4; tb = r & 15; const int pn = tb >> 2, sg = (tb >> 1) & 1, jb = tb & 1;
            src = TR_IN(sg ? 23 : 22) + (size_t)(l * NEXP + e) * DM * DEXP; ldw = DEXP; K = DM; segA = 128 * pn + 64 * jb; segB = segA + 32; dst = WBl + WB_GU + (size_t)e * 1024 * 1024; }
        else { r -= 10304; const int e = r >> 7; r &= 127; kb = r >> 4; tb = r & 15; src = TR_IN(24) + (size_t)(l * NEXP + e) * DEXP * DM; ldw = DM; K = DEXP; segA = 64 * tb; segB = segA + 32; dst = WBl + WB_DN + (size_t)e * 1024 * 512; }
    } else { const int r = it - 28800; kb = r >> 4; tb = r & 15; const int pn = tb >> 2, bj = (tb >> 1) & 1, w0 = 2 * (tb & 1); src = TR_IN(3); ldw = 1024; K = DM; segA = 256 * pn + 64 * w0 + 32 * bj; segB = segA + 64; dst = WB + WB_MEMKV; }
    const int q = lane & 15;
    sp = src + (size_t)(kb * 64 + (lane >> 4)) * ldw + (q < 8 ? segA + 4 * q : segB + 4 * (q - 8));
    dp = dst + (size_t)(64 * tb + (lane >> 3)) * K + dk0 + kb * 64 + 8 * (lane & 7);
}
__device__ __forceinline__ void tr_load(f32x4 (&v)[16], const float* sp, int ldw) {
#pragma unroll
    for (int i = 0; i < 16; ++i) v[i] = *(const f32x4*)(sp + (size_t)(4 * i) * ldw);
}
__device__ __forceinline__ void tr_store(const f32x4 (&v)[16], bf16_t* dp, int K, LAS float* scr, int lane) {
    const int q = lane & 15, kq = lane >> 4;
#pragma unroll
    for (int i = 0; i < 16; ++i) { LAS float* w = scr + (4 * i + kq) * 65 + 4 * q; w[0] = v[i][0]; w[1] = v[i][1]; w[2] = v[i][2]; w[3] = v[i][3]; }
    asm volatile("s_waitcnt lgkmcnt(0)" ::: "memory");
    const int c = lane & 7, n8 = lane >> 3;
#pragma unroll
    for (int j = 0; j < 8; ++j) { const LAS float* sI = scr + (8 * c) * 65 + n8 + 8 * j;
        u32x4 o; o.x = cvt_pk_bf16(sI[0 * 65], sI[1 * 65]); o.y = cvt_pk_bf16(sI[2 * 65], sI[3 * 65]); o.z = cvt_pk_bf16(sI[4 * 65], sI[5 * 65]); o.w = cvt_pk_bf16(sI[6 * 65], sI[7 * 65]);
        *(u32x4*)(dp + (size_t)(8 * j) * K) = o; }
    asm volatile("s_waitcnt lgkmcnt(0)" ::: "memory");
}

#define XB_TMO      128
#define XB_XCNT(j)  (256  + 64 * (j))
#define XB_XSUB(j)  (1280 + 64 * (j))
#define XB_XGEN(j)  (2304 + 64 * (j))
#define XB_TOP      3328
#define XB_TOPGEN   3392
#define XCD_BAR_WORDS 3456
#define XB_SPIN_CAP (1u << 18)

__device__ __forceinline__ unsigned xb_ld(unsigned* p)              { return __hip_atomic_load(p, __ATOMIC_RELAXED, __HIP_MEMORY_SCOPE_AGENT); }
__device__ __forceinline__ unsigned xb_add(unsigned* p, unsigned v) { return __hip_atomic_fetch_add(p, v, __ATOMIC_RELAXED, __HIP_MEMORY_SCOPE_AGENT); }
__device__ __forceinline__ unsigned xb_xcc_id() { return (unsigned)__builtin_amdgcn_s_getreg((3 << 11) | 20) & 0xFu; }
#define XB_SPIN(cond, bar) do { unsigned _sp = 0; while (cond) { __builtin_amdgcn_s_sleep(1); \
    if ((++_sp & 255u) == 0u) { if (xb_ld(&(bar)[XB_TMO])) break; if (_sp > XB_SPIN_CAP) { atomicAdd(&(bar)[XB_TMO], 1u); break; } } } } while (0)

struct XcdBarrier {
    unsigned* bar; unsigned x; unsigned w0;
    volatile LAS unsigned* st;
};

__device__ __forceinline__ XcdBarrier xcd_barrier_post(unsigned* bar, volatile LAS unsigned* st, unsigned is_wave0) {
    XcdBarrier b; b.bar = bar; b.x = xb_xcc_id(); b.st = st; b.w0 = is_wave0;
    if (is_wave0 && lane_id() == 0) (void)xb_add(&bar[XB_XCNT(b.x)], 1u);
    return b;
}
__device__ __forceinline__ void xcd_barrier_complete(unsigned* bar, unsigned x, unsigned& nloc, unsigned& nx) {
    const unsigned G = gridDim.x * gridDim.y * gridDim.z;
    unsigned sum, cnt, mine, sp = 0u;
    for (;;) {
        sum = 0u; cnt = 0u; mine = 0u;
#pragma unroll
        for (unsigned j = 0; j < 16; ++j) { const unsigned c = xb_ld(&bar[XB_XCNT(j)]); sum += c; cnt += (c > 0u) ? 1u : 0u; mine = (j == x) ? c : mine; }
        if (sum == G) break;
        __builtin_amdgcn_s_sleep(1);
        if ((++sp & 255u) == 0u) { if (xb_ld(&bar[XB_TMO])) break; if (sp > XB_SPIN_CAP) { atomicAdd(&bar[XB_TMO], 1u); break; } }
    }
    nloc = mine > 0u ? mine : 1u; nx = cnt > 0u ? cnt : 1u;
}

__device__ __forceinline__ void xcd_barrier(const XcdBarrier& b) {
    asm volatile("s_waitcnt vmcnt(0)" ::: "memory");
    __syncthreads();
    if (b.w0 && lane_id() == 0) {
        unsigned* bar = b.bar;
        __builtin_amdgcn_s_waitcnt(0);
        unsigned nloc = b.st[0], nx = b.st[1];
        if (nloc == 0u) { xcd_barrier_complete(bar, b.x, nloc, nx); b.st[0] = nloc; b.st[1] = nx; }
        const unsigned old = xb_add(&bar[XB_XSUB(b.x)], 1u);
        const unsigned gen = old / nloc;
        if (old + 1u == (gen + 1u) * nloc) {
            __builtin_amdgcn_fence(__ATOMIC_RELEASE, "agent");
            asm volatile("s_waitcnt vmcnt(0)" ::: "memory");
            const unsigned og = xb_add(&bar[XB_TOP], 1u);
            const unsigned tg = og / nx;
            if (og + 1u == (tg + 1u) * nx) xb_add(&bar[XB_TOPGEN], 1u);
            else XB_SPIN(xb_ld(&bar[XB_TOPGEN]) == tg, bar);
            __builtin_amdgcn_fence(__ATOMIC_ACQUIRE, "agent");
            xb_add(&bar[XB_XGEN(b.x)], 1u);
            asm volatile("s_waitcnt vmcnt(0)" ::: "memory");
        } else {
            XB_SPIN(xb_ld(&bar[XB_XGEN(b.x)]) == gen, bar);
            __builtin_amdgcn_fence(__ATOMIC_ACQUIRE, "agent");
            asm volatile("s_waitcnt vmcnt(0)" ::: "memory");
        }
    }
    __syncthreads();
}
constexpr int NWAVES = 8;
constexpr int RING_BYTES = 131072, LDSCTL_OFF = 135168, LDS_BYTES = 147456;
constexpr int CW_BAR = 4096, BAR_REGION = 4096;
static_assert(XCD_BAR_WORDS <= BAR_REGION && (CW_BAR + (N_PHASES + 1) * BAR_REGION) * 4 <= (int)MiB, "barrier regions inside the memset region");
static_assert(pg8::STAGE_BYTES <= RING_BYTES && att::Lay<64, 128>::OFF_STASH + 65536 <= RING_BYTES && att::Lay<128, 128>::OFF_WS + 2048 <= RING_BYTES, "LDS map");

struct Args { const float* in[26]; float* out; unsigned char* ws; int ph_lo, ph_hi, li, pad; };
#define KIN(k) ((const float*)karg64<8 * (k)>())
#define KOUT ((float*)karg64<208>())
#define KWS ((unsigned char*)karg64<216>())
static_assert(offsetof(Args, out) == 208 && offsetof(Args, ws) == 216 && offsetof(Args, ph_lo) == 224, "Args layout vs the kernarg offsets above");

__global__ void __launch_bounds__(NWAVES * 64, 2) mk_fwd(Args args) {
    extern __shared__ __attribute__((aligned(16))) unsigned char lds[];
    const int wave = __builtin_amdgcn_readfirstlane((int)threadIdx.x >> 6);
#define lane0 lane_id()
#define tid0 (wave * 64 + lane_id())
    const int G = gridDim.x, bx = blockIdx.x, vcu = (G % 8 == 0) ? (bx % 8) * (G / 8) + bx / 8 : bx;
    LAS unsigned char* ldsl = (LAS unsigned char*)lds;
    volatile LAS unsigned* MISC = (volatile LAS unsigned*)(ldsl + LDSCTL_OFF);
    for (int u = tid0; u < (LDS_BYTES - LDSCTL_OFF) / 4; u += NWAVES * 64) ((LAS unsigned*)(ldsl + LDSCTL_OFF))[u] = 0u;
    __syncthreads();
    XcdBarrier bar = xcd_barrier_post((unsigned*)(KWS + WS_CTL) + CW_BAR + args.li * BAR_REGION, MISC + 8, wave == 0 ? 1u : 0u);
#define P_WS unsigned char* ws = KWS; unsigned* ctl = (unsigned*)(ws + WS_CTL); (void)ctl
#define P_ACT bf16_t* MEMKV = (bf16_t*)(ws + WS_MEMKV); bf16_t* HM = (bf16_t*)(ws + WS_HM); bf16_t* PROJ = (bf16_t*)(ws + WS_PROJ); bf16_t* OBR = (bf16_t*)(ws + WS_OBR); bf16_t* HMEM = OBR; \
    bf16_t* BUF = (bf16_t*)(ws + WS_BUF); bf16_t* YB = (bf16_t*)(ws + WS_YB); bf16_t* HID = (bf16_t*)(ws + WS_HID); bf16_t* WB = (bf16_t*)(ws + WS_WB); const bf16_t* WBl = WB + (size_t)l_ * WB_LAYER; \
    (void)MEMKV; (void)HM; (void)PROJ; (void)OBR; (void)HMEM; (void)BUF; (void)YB; (void)HID; (void)WBl
#define P_ROUTE int* experts = (int*)(ws + WS_ROUTE + RT_EXP); float* weights = (float*)(ws + WS_ROUTE + RT_WGT); int* rank = (int*)(ws + WS_ROUTE + RT_RANK); float* rstd = (float*)(ws + WS_ROUTE + RT_RSTD); \
    (void)experts; (void)weights; (void)rank; (void)rstd
    const int gw = bx * NWAVES + wave, NGW = G * NWAVES;
    const int lo = args.ph_lo, hi = args.ph_hi;
#ifndef STAGE_MASK
#define STAGE_MASK 0x3FFu
#endif
#define IN(k) (lo <= (k) && (k) < hi)
#define ST(s) ((STAGE_MASK >> (s)) & 1u)
#ifndef REP_MASK
#define REP_MASK 0u
#endif
#define NREP(s) (((REP_MASK >> (s)) & 1u) ? 2 : 1)
#ifndef DBL_BAR
#define DBL_BAR 0
#endif
#define SEAM(k) do { if (IN(k) && IN((k) + 1)) { xcd_barrier(bar); if (DBL_BAR) xcd_barrier(bar); } } while (0)

    if (ST(0) && IN(0))
  for (int rep_ = 0; rep_ < NREP(0); ++rep_) {
        int lane = lane0, tid = tid0; asm volatile("" : "+v"(lane), "+v"(tid));
        constexpr int l_ = 0; P_WS; P_ACT;
        float* tab1 = (float*)(ws + WS_TAB); float* tab2 = tab1 + SEQ * 32 * 2;
        const float* x = KIN(0); const float* mem = KIN(1); const float* mem_g = KIN(2); const float* norm1_g = KIN(4); const float* norm2_g = KIN(17); const float* w_rg = KIN(18); const float* w_re = KIN(20);
        LAS float* scr = (LAS float*)(ldsl + wave * 16640);
        {   constexpr int NITEMS = 29056;
            f32x4 cur[16], nxt[16]; const float* sp; bf16_t* dp; int ldw, K; const float* sp2; bf16_t* dp2; int ldw2, K2;
            int it = gw;
            if (it < NITEMS) { tr_decode(it, lane, WB, sp, ldw, dp, K); tr_load(cur, sp, ldw); }
            for (; it < NITEMS; it += NGW) {
                const bool more = it + NGW < NITEMS;
                if (more) { tr_decode(it + NGW, lane, WB, sp2, ldw2, dp2, K2); tr_load(nxt, sp2, ldw2); }
                tr_store(cur, dp, K, scr, lane);
                if (more) {
#pragma unroll
                    for (int i = 0; i < 16; ++i) cur[i] = nxt[i];
                    dp = dp2; K = K2; }
            }
        }
        for (int idx = bx * (NWAVES * 64) + tid; idx < SEQ * 32; idx += G * NWAVES * 64) { const int pos = idx >> 5, i = idx & 31; float s, c;
            sincosf((float)pos * inv1d(i), &s, &c); tab1[idx * 2] = c; tab1[idx * 2 + 1] = s;
            sincosf(ang2d(pos, i), &s, &c); tab2[idx * 2] = c; tab2[idx * 2 + 1] = s; }
        for (int idx = bx * (NWAVES * 64) + tid; idx < DEPTH * 48 * 1024; idx += G * NWAVES * 64) { const int l = idx / (48 * 1024), c = (idx >> 10) % 48, k = idx & 1023;
            const float w = c < 4 ? w_rg[((size_t)l * DM + k) * 4 + c] : c < 36 ? w_re[((size_t)l * DM + k) * 32 + (c - 4)] : 0.f, v = w * norm2_g[l * DM + k];
            const bf16_t h = f2bf(v); bf16_t* t = WB + WB_RT + (size_t)l * 2 * 48 * 1024 + (size_t)c * 1024 + k; t[0] = h; t[48 * 1024] = f2bf(v - bf2f(h)); }
        for (int m = gw; m < M; m += NGW) row_rmsnorm(x + (size_t)m * DM, norm1_g, HM + (size_t)m * DM, nullptr, lane);
        for (int m = gw; m < MM; m += NGW) row_rmsnorm(mem + (size_t)m * DM, mem_g, HMEM + (size_t)m * DM, nullptr, lane);
    }
    SEAM(0);
#pragma unroll 1
    for (int l = 0; l < DEPTH; ++l) {
        const int pb = 1 + 9 * l, l_ = l;
        if (ST(1) && IN(pb + 0))
      for (int rep_ = 0; rep_ < NREP(1); ++rep_) {
            P_WS; P_ACT; float* tab1 = (float*)(ws + WS_TAB); float* tab2 = tab1 + SEQ * 32 * 2; const float* qn_g = KIN(11); const float* kn_g = KIN(12);
            pg8::Gemm g{DM, DM};
            pg8::SchedProj S{bx, G, 1472, l == 0 ? 1504 : 1472, (const char*)HM, (const char*)(WBl + WB_IN), (const char*)HMEM, (const char*)(WB + WB_MEMKV)};
            pg8::EpiProj E{PROJ, MEMKV, tab1, tab2, qn_g + l * 64, kn_g + l * 64};
            pg8::gemm_phase<pg8::EpiProj, pg8::SchedProj, true, true>(ldsl, g, S, E, wave);
        }
        SEAM(pb + 0);
        if (ST(2) && IN(pb + 1))
      for (int rep_ = 0; rep_ < NREP(2); ++rep_) {
            int lane = lane0; asm volatile("" : "+v"(lane));
            P_WS; P_ACT; const float* lq1 = KIN(6); const float* lk1 = KIN(7); const float* lq2 = KIN(8); const float* lk2 = KIN(9); const float* subln_g = KIN(10);
            const float lam_init = 0.8f - 0.6f * __expf(-0.3f * (float)l);
            const float lam = __expf(wave_sum(lq1[l * 64 + lane] * lk1[l * 64 + lane])) - __expf(wave_sum(lq2[l * 64 + lane] * lk2[l * 64 + lane])) + lam_init;
            for (int j = vcu; j < 256; j += G) {
#ifndef ATT_SKIP_A
                att::unit_a(PROJ, OBR, j >> 5, (j >> 3) & 3, j & 7, lam, lam_init, subln_g + l * 128, (char*)lds, wave);
#endif
#ifndef ATT_SKIP_B
#pragma unroll 1
                for (int t = 0; t < 2; ++t) { const int idx = 2 * j + t; att::unit_b(PROJ, OBR, idx >> 6, (idx >> 3) & 7, idx & 7, (char*)lds, wave); }
#endif
#ifndef ATT_SKIP_C
                att::unit_c(PROJ, MEMKV, OBR, j >> 5, (j >> 3) & 3, j & 7, (char*)lds, wave);
#endif
            }
            __syncthreads();
        }
        SEAM(pb + 1);
        if (ST(3) && IN(pb + 2))
      for (int rep_ = 0; rep_ < NREP(3); ++rep_) {
            P_WS; P_ACT;
            pg8::Gemm g{OBR_W, 512};
            pg8::SchedGate S{bx, G, (const char*)OBR, (const char*)(WBl + WB_UP)};
            pg8::EpiGate E{HM, PROJ};
            pg8::gemm_phase<pg8::EpiGate, pg8::SchedGate, true, true>(ldsl, g, S, E, wave);
        }
        SEAM(pb + 2);
        if (ST(4) && IN(pb + 3)) {
            P_WS; P_ACT; const float* x = KIN(0); float* X = KOUT;
            pg8::Gemm g{DM, DM};
            pg8::SchedPlain S{bx, G, M / 256, (const char*)HM, (const char*)(WBl + WB_OUT), (size_t)256 * DM * 2, (size_t)256 * DM * 2};
            pg8::EpiResid E{l == 0 ? x : X, X};
            pg8::gemm_phase<pg8::EpiResid, pg8::SchedPlain, true, true>(ldsl, g, S, E, wave);
        }
        SEAM(pb + 3);
        if (ST(5) && IN(pb + 4)) {
            int tid = tid0; asm volatile("" : "+v"(tid));
            const int lane = tid & 63;
            P_WS; P_ACT; P_ROUTE; float* X = KOUT; const float* b_rg = KIN(19); const float* b_re = KIN(21); const float* norm2_g = KIN(17);
            const bf16_t* tab = WB + WB_RT + (size_t)l * 2 * 48 * 1024 + (size_t)(lane & 15) * 1024 + 128 * wave + 8 * (lane >> 4);
            bf16x8 Bh[3][4], Bl[3][4];
#pragma unroll
            for (int t = 0; t < 3; ++t)
#pragma unroll
                for (int sI = 0; sI < 4; ++sI) { Bh[t][sI] = *(const bf16x8*)(tab + (size_t)t * 16 * 1024 + 32 * sI); Bl[t][sI] = *(const bf16x8*)(tab + (size_t)(48 + t * 16) * 1024 + 32 * sI); }
            for (int rb = bx; rb < M / 64; rb += G)
                route_block(X, tab, b_rg + l * 4, b_re + l * 32, experts, weights, rank, ctl + CW_CNT + 32 * l, rstd, (int*)BUF, norm2_g + l * DM, HM, rb, Bh, Bl, (LAS float*)ldsl, tid, wave);
        }
        SEAM(pb + 4);
        volatile LAS int* mt = (volatile LAS int*)(ldsl + LDSCTL_OFF + 256);
        LAS unsigned* rowtab = (LAS unsigned*)(ldsl + LDSCTL_OFF + 2048); LAS float* wtab = (LAS float*)(ldsl + LDSCTL_OFF + 6144);
        if (ST(7) && IN(pb + 6)) {
            int tid = tid0; asm volatile("" : "+v"(tid));
            P_WS; P_ACT; P_ROUTE;
            moe_tables(ctl + CW_CNT + 32 * l, mt, tid);
            moe_rowtabs(mt, (const int*)BUF, weights, rowtab, wtab, bx, G, tid, 1);
            const int ntiles = __builtin_amdgcn_readfirstlane(mt[256]);
            pg8::Gemm g{DM, DM};
            pg8::SchedMoeUp S{bx, G, ntiles, (const LAS int*)(ldsl + LDSCTL_OFF + 256 + 96 * 4), (const char*)HM, (const char*)(WBl + WB_GU), ctl + CW_TCNT + l * 160 * 64};
            pg8::EpiSilu E{HID};
            pg8::gemm_phase<pg8::EpiSilu, pg8::SchedMoeUp, true, true, true>(ldsl, g, S, E, wave, rowtab);
        }
        if (ST(8) && IN(pb + 7)) {
            int tid = tid0; asm volatile("" : "+v"(tid));
            P_WS; P_ACT; P_ROUTE;
            if (!(ST(7) && IN(pb + 6))) moe_tables(ctl + CW_CNT + 32 * l, mt, tid);
            moe_rowtabs(mt, (const int*)BUF, weights, rowtab, wtab, bx, G, tid, 0);
            const int ntiles = __builtin_amdgcn_readfirstlane(mt[256]);
            pg8::Gemm g{DEXP, DEXP};
            pg8::SchedMoeDown S{bx, G, ntiles, (ntiles * 4) % G, wave, (const LAS int*)(ldsl + LDSCTL_OFF + 256 + 96 * 4), (const char*)HID, (const char*)(WBl + WB_DN), ctl + CW_TCNT + l * 160 * 64, ctl + CW_TMO};
            pg8::EpiRowScale E{YB, wtab};
            pg8::gemm_phase<pg8::EpiRowScale, pg8::SchedMoeDown, true, true>(ldsl, g, S, E, wave);
        }
        SEAM(pb + 7);
        if (ST(9) && IN(pb + 8)) {
            int lane = lane0; asm volatile("" : "+v"(lane));
            P_WS; P_ACT; P_ROUTE; float* X = KOUT; const float* norm1_g = KIN(4); const float* final_g = KIN(25); int* dest = nullptr;
            const bool last = (l == DEPTH - 1);
            const bool poison = last && ((__hip_atomic_load(ctl + CW_BAR + args.li * BAR_REGION + XB_TMO, __ATOMIC_RELAXED, __HIP_MEMORY_SCOPE_AGENT) | __hip_atomic_load(ctl + CW_TMO, __ATOMIC_RELAXED, __HIP_MEMORY_SCOPE_AGENT)) != 0u);
            if (!(ST(7) && IN(pb + 6)) && !(ST(8) && IN(pb + 7))) moe_tables(ctl + CW_CNT + 32 * l, mt, tid0);
            for (int m = gw; m < M; m += NGW) row_combine_norm(X, YB, dest, last ? final_g : norm1_g + (l + 1) * DM, last ? nullptr : HM, X, m, lane, poison, mt[experts[2 * m]] + rank[2 * m], mt[experts[2 * m + 1]] + rank[2 * m + 1]);
        }
        SEAM(pb + 8);
    }
#undef IN
#undef SEAM
#undef lane0
#undef tid0
#undef P_WS
#undef P_ACT
#undef P_ROUTE
}

#ifndef FAST_MASK
#define FAST_MASK 0x7FFFFu
#endif
extern "C" void kernel_launch(void* const* d_in, const int* in_sizes, int n_in, void* d_out, int out_size, void* d_ws, size_t ws_size, hipStream_t stream) {
    if (n_in != 26 || out_size != M * DM || ws_size < WS_END) { fprintf(stderr, "kernel_launch: unexpected shapes n_in %d out %d ws %zu (need %zu)\n", n_in, out_size, ws_size, (size_t)WS_END); return; }
    static int grid = 0;
    if (grid == 0) {
        int dev = 0, cus = 0;
        if (hipGetDevice(&dev) != hipSuccess || hipDeviceGetAttribute(&cus, hipDeviceAttributeMultiprocessorCount, dev) != hipSuccess) { grid = -1; return; }
        if (hipFuncSetAttribute((const void*)mk_fwd, hipFuncAttributeMaxDynamicSharedMemorySize, LDS_BYTES) != hipSuccess) { fprintf(stderr, "kernel_launch: hipFuncSetAttribute failed\n"); grid = -1; return; }
        int per_cu = 0;
        if (hipOccupancyMaxActiveBlocksPerMultiprocessor(&per_cu, (const void*)mk_fwd, NWAVES * 64, LDS_BYTES) != hipSuccess || per_cu < 1) fprintf(stderr, "kernel_launch: occupancy query says %d\n", per_cu);
        (void)hipGetLastError();
        grid = cus;
    }
    if (grid < 0) return;
    const float* x = (const float*)d_in[0]; const float* mem = (const float*)d_in[1]; const float* mem_g = (const float*)d_in[2]; const float* w_memkv = (const float*)d_in[3];
    const float* norm1_g = (const float*)d_in[4]; const float* w_in = (const float*)d_in[5];
    const float* lq1 = (const float*)d_in[6]; const float* lk1 = (const float*)d_in[7]; const float* lq2 = (const float*)d_in[8]; const float* lk2 = (const float*)d_in[9];
    const float* subln_g = (const float*)d_in[10]; const float* qn_g = (const float*)d_in[11]; const float* kn_g = (const float*)d_in[12];
    const float* w_up[3] = {(const float*)d_in[13], (const float*)d_in[14], (const float*)d_in[15]}; const float* w_out = (const float*)d_in[16];
    const float* norm2_g = (const float*)d_in[17]; const float* w_rg = (const float*)d_in[18]; const float* b_rg = (const float*)d_in[19]; const float* w_re = (const float*)d_in[20]; const float* b_re = (const float*)d_in[21];
    const float* w_eg = (const float*)d_in[22]; const float* w_eu = (const float*)d_in[23]; const float* w_ed = (const float*)d_in[24]; const float* final_g = (const float*)d_in[25];
    unsigned char* ws = (unsigned char*)d_ws; float* X = (float*)d_out;
    unsigned* ctl = (unsigned*)(ws + WS_CTL);
    bf16_t* MEMKV = (bf16_t*)(ws + WS_MEMKV); bf16_t* HM = (bf16_t*)(ws + WS_HM); bf16_t* PROJ = (bf16_t*)(ws + WS_PROJ); bf16_t* OBR = (bf16_t*)(ws + WS_OBR);
    bf16_t* BUF = (bf16_t*)(ws + WS_BUF); bf16_t* YB = (bf16_t*)(ws + WS_YB); bf16_t* HID = (bf16_t*)(ws + WS_HID);
    int* experts = (int*)(ws + WS_ROUTE + RT_EXP); float* weights = (float*)(ws + WS_ROUTE + RT_WGT); int* rank = (int*)(ws + WS_ROUTE + RT_RANK); int* dest = (int*)(ws + WS_ROUTE + RT_DEST);
    float* roww = (float*)(ws + WS_ROUTE + RT_ROWW); int* tile_tab = (int*)(ws + WS_ROUTE + RT_TILE); float* rstd = (float*)(ws + WS_ROUTE + RT_RSTD);

    (void)hipMemsetAsync(ctl, 0, MiB, stream);
    unsigned mask = FAST_MASK; if (mask) mask |= 1u;
    Args a{};
    for (int i = 0; i < 26; ++i) a.in[i] = (const float*)d_in[i];
    a.out = X; a.ws = ws;
    int li = 0;
    for (int k = 0; k < N_PHASES;) {
        if ((mask >> k) & 1u) {
            int k2 = k; while (k2 < N_PHASES && ((mask >> k2) & 1u)) ++k2;
            a.ph_lo = k; a.ph_hi = k2; a.li = li++; a.pad = 0;
            hipLaunchKernelGGL(mk_fwd, dim3(grid), dim3(NWAVES * 64), LDS_BYTES, stream, a);
            k = k2; continue;
        }
        if (k == 0) {
            (void)hipMemcpyAsync(X, x, (size_t)M * DM * 4, hipMemcpyDeviceToDevice, stream);
            s_rmsnorm<<<MM / 4, 256, 0, stream>>>(mem, mem_g, OBR, MM);
            s_rmsnorm<<<M / 4, 256, 0, stream>>>(X, norm1_g, HM, M);
        } else {
            const int l = (k - 1) / 9, s = (k - 1) % 9; const float lam_init = 0.8f - 0.6f * expf(-0.3f * (float)l);
            switch (s) {
            case 0:
                if (l == 0) { SG p{}; p.A = OBR; p.lda = DM; p.W = w_memkv; p.ldw = 1024; p.K = DM; p.mode = MD_BF16; p.O = MEMKV; p.ldo = 1024; s_gemm<<<dim3(1024 / 64, MM / 64), 256, 0, stream>>>(p); }
                { SG p{}; p.A = HM; p.lda = DM; p.W = w_in + (size_t)l * DM * D_IN; p.ldw = D_IN; p.K = DM; p.mode = MD_PROJ; p.O = PROJ; p.ldo = D_IN; p.qg = qn_g + l * 64; p.kg = kn_g + l * 64;
                  s_gemm<<<dim3(D_IN / 64, M / 64), 256, 0, stream>>>(p); }
                break;
            case 1:
                s_attn_a<<<dim3(M / 4, 4), 256, 0, stream>>>(PROJ, OBR, lq1 + l * 64, lk1 + l * 64, lq2 + l * 64, lk2 + l * 64, subln_g + l * 128, lam_init);
                s_attn_b<<<dim3(M / 4, 8), 256, 0, stream>>>(PROJ, OBR);
                s_attn_c<<<dim3(M / 4, 4), 256, 0, stream>>>(PROJ, MEMKV, OBR);
                break;
            case 2:
                for (int i = 0; i < 3; ++i) { SG p{}; p.A = OBR + 512 * i; p.lda = OBR_W; p.W = w_up[i] + (size_t)l * 512 * DM; p.ldw = DM; p.K = 512; p.mode = MD_GATE; p.O = HM; p.ldo = DM; p.G = PROJ + C_G + 1024 * i; p.ldg = D_IN; p.first = (i == 0);
                    s_gemm<<<dim3(DM / 64, M / 64), 256, 0, stream>>>(p); }
                break;
            case 3:
                if (l == 0 && (mask & 1u)) (void)hipMemcpyAsync(X, x, (size_t)M * DM * 4, hipMemcpyDeviceToDevice, stream);
                { SG p{}; p.A = HM; p.lda = DM; p.W = w_out + (size_t)l * DM * DM; p.ldw = DM; p.K = DM; p.mode = MD_RESID; p.Xf = X; s_gemm<<<dim3(DM / 64, M / 64), 256, 0, stream>>>(p); }
                break;
            case 4:
                s_norm_route<<<M / 4, 256, 0, stream>>>(X, norm2_g + l * DM, HM, w_rg + (size_t)l * DM * 4, b_rg + l * 4, w_re + (size_t)l * DM * 32, b_re + l * 32, experts, weights, rank, ctl + CW_CNT + 32 * l, rstd);
                break;
            case 5:
                s_dispatch<<<1, 64, 0, stream>>>(ctl + CW_CNT + 32 * l, tile_tab);
                s_gather<<<M * 2 / 4, 256, 0, stream>>>(X, rstd, norm2_g + l * DM, experts, weights, rank, tile_tab, BUF, roww, dest);
                break;
            case 6:
                { SG p{}; p.A = BUF; p.lda = DM; p.W = w_eg + (size_t)l * NEXP * DM * DEXP; p.W2 = w_eu + (size_t)l * NEXP * DM * DEXP; p.ldw = DEXP; p.wstride = (size_t)DM * DEXP; p.tile_e = tile_tab; p.ntiles = tile_tab + 256;
                  p.K = DM; p.mode = MD_SILU; p.O = HID; p.ldo = DEXP; s_gemm<<<dim3(DEXP / 64, P_ROWS / 64), 256, 0, stream>>>(p); }
                break;
            case 7:
                { SG p{}; p.A = HID; p.lda = DEXP; p.W = w_ed + (size_t)l * NEXP * DEXP * DM; p.ldw = DM; p.wstride = (size_t)DEXP * DM; p.tile_e = tile_tab; p.ntiles = tile_tab + 256;
                  p.K = DEXP; p.mode = MD_ROWSCALE; p.O = YB; p.ldo = DM; p.roww = roww; s_gemm<<<dim3(DM / 64, P_ROWS / 64), 256, 0, stream>>>(p); }
                break;
            default:
                if (l + 1 < DEPTH) s_combine_norm<<<M / 4, 256, 0, stream>>>(X, YB, dest, norm1_g + (l + 1) * DM, HM, nullptr);
                else s_combine_norm<<<M / 4, 256, 0, stream>>>(X, YB, dest, final_g, nullptr, X);
                break;
            }
        }
        ++k;
    }
}
```

```cpp
#include <hip/hip_runtime.h>
#include <cstdint>
#include <cstdio>
#include <cmath>
#include <cstddef>

typedef unsigned short bf16_t;
typedef float f32x4 __attribute__((ext_vector_type(4)));
typedef unsigned u32x4 __attribute__((ext_vector_type(4)));
typedef unsigned u32x2 __attribute__((ext_vector_type(2)));

constexpr int BATCH = 8, SEQ = 2048, DM = 1024, DEPTH = 2, MEM_LEN = 256;
constexpr int M = BATCH * SEQ;
constexpr int MM = BATCH * MEM_LEN;
constexpr int D_IN = 5888;
constexpr int C_AQ = 0, C_AK = 512, C_AV = 1024, C_BQ = 1536, C_BK = 2048, C_BV = 2176, C_CQ = 2304, C_G = 2816;
constexpr int OBR_W = 1536;
constexpr int NEXP = 32, DEXP = 512;
constexpr int MOE_TILE = 256;
constexpr int P_ROWS = M * 2 + NEXP * MOE_TILE;
constexpr int MAX_TILES = P_ROWS / MOE_TILE;
constexpr float EPS = 1e-6f;
constexpr float LOG2E = 1.4426950408889634f;
constexpr float C2_64 = 0.125f * LOG2E;
constexpr float C2_128 = 0.08838834764831845f * LOG2E;

constexpr size_t MiB = 1u << 20;
constexpr size_t WS_CTL = 0;
constexpr size_t WS_ROUTE = 1 * MiB;
constexpr size_t WS_TAB = 2 * MiB;
constexpr size_t WS_MEMKV = 3 * MiB;
constexpr size_t WS_HM = 7 * MiB;
constexpr size_t WS_PROJ = 39 * MiB;
constexpr size_t WS_OBR = 223 * MiB;
constexpr size_t WS_WB = 271 * MiB;
constexpr size_t WS_END = 499 * MiB;
constexpr size_t WS_BUF = WS_PROJ;
constexpr size_t WS_YB = WS_PROJ + 80 * MiB;
constexpr size_t WS_HID = WS_OBR;
constexpr size_t RT_EXP = 0;
constexpr size_t RT_WGT = 128 * 1024;
constexpr size_t RT_RANK = 256 * 1024;
constexpr size_t RT_DEST = 384 * 1024;
constexpr size_t RT_ROWW = 512 * 1024;
constexpr size_t RT_TILE = 700 * 1024;
constexpr size_t RT_RSTD = 768 * 1024;
constexpr int CW_CNT = 163840;
constexpr int CW_TMO = 128;
constexpr int CW_TCNT = 131072;

__device__ __forceinline__ float bf2f(bf16_t v) { return __uint_as_float(((unsigned)v) << 16); }
__device__ __forceinline__ bf16_t f2bf(float f) { unsigned u = __float_as_uint(f); return (bf16_t)((u + 0x7fffu + ((u >> 16) & 1u)) >> 16); }
__device__ __forceinline__ float wave_sum(float v) {
#pragma unroll
    for (int o = 1; o < 64; o <<= 1) v += __shfl_xor(v, o);
    return v;
}
__device__ __forceinline__ float wave_max(float v) {
#pragma unroll
    for (int o = 1; o < 64; o <<= 1) v = fmaxf(v, __shfl_xor(v, o));
    return v;
}
__device__ __forceinline__ float inv1d(int i) { return exp2f(-(float)i * (13.287712379549449f / 32.f)); }
__device__ __forceinline__ float inv2d(int j) { return exp2f(-(float)j * (13.287712379549449f / 16.f)); }
__device__ __forceinline__ float ang2d(int pos, int i) { return i < 16 ? (float)(pos >> 6) * inv2d(i) : (float)(pos & 63) * inv2d(i - 16); }

__global__ __launch_bounds__(256) void s_rmsnorm(const float* __restrict__ X, const float* __restrict__ g, bf16_t* __restrict__ OUT, int rows) {
    const int lane = threadIdx.x & 63, row = blockIdx.x * 4 + (threadIdx.x >> 6);
    if (row >= rows) return;
    const f32x4* xr = (const f32x4*)(X + (size_t)row * DM);
    f32x4 v[4]; float s = 0.f;
#pragma unroll
    for (int j = 0; j < 4; ++j) { v[j] = xr[lane + 64 * j]; s += v[j].x * v[j].x + v[j].y * v[j].y + v[j].z * v[j].z + v[j].w * v[j].w; }
    const float rs = rsqrtf(wave_sum(s) * (1.f / DM) + EPS);
#pragma unroll
    for (int j = 0; j < 4; ++j) { const f32x4 gg = ((const f32x4*)g)[lane + 64 * j];
        u32x2 o; o.x = f2bf(v[j].x * rs * gg.x) | ((unsigned)f2bf(v[j].y * rs * gg.y) << 16); o.y = f2bf(v[j].z * rs * gg.z) | ((unsigned)f2bf(v[j].w * rs * gg.w) << 16);
        ((u32x2*)(OUT + (size_t)row * DM))[lane + 64 * j] = o; }
}

enum { MD_PROJ = 0, MD_BF16 = 1, MD_GATE = 2, MD_RESID = 3, MD_SILU = 4, MD_ROWSCALE = 5 };
struct SG {
    const bf16_t* A; int lda; const float* W; const float* W2; int ldw; size_t wstride;
    const int* tile_e; const int* ntiles;
    int K; int mode;
    bf16_t* O; int ldo;
    float* Xf;
    const bf16_t* G; int ldg; int first;
    const float* roww;
    const float* qg; const float* kg;
};
__global__ __launch_bounds__(256) void s_gemm(SG p) {
    __shared__ float As[16][68];
    __shared__ float Bs[16][68];
    __shared__ float B2s[16][68];
    __shared__ float Ct[64][65];
    __shared__ float Ct2[64][65];
    const int tid = threadIdx.x, tx = tid & 15, ty = tid >> 4;
    const int gc0 = blockIdx.x * 64, gr0 = blockIdx.y * 64;
    const float* W = p.W; const float* W2 = p.W2;
    if (p.tile_e) { const int t256 = blockIdx.y >> 2; if (t256 >= *p.ntiles) return; const int e = p.tile_e[t256]; W += (size_t)e * p.wstride; if (W2) W2 += (size_t)e * p.wstride; }
    float acc[4][4] = {}, acc2[4][4] = {};
    const int ar = tid >> 2, ak = (tid & 3) * 4;
    const int bk = tid >> 4, bn = (tid & 15) * 4;
    for (int k0 = 0; k0 < p.K; k0 += 16) {
        { const u32x2 a = *(const u32x2*)(p.A + (size_t)(gr0 + ar) * p.lda + k0 + ak);
          As[ak + 0][ar] = __uint_as_float(a.x << 16); As[ak + 1][ar] = __uint_as_float(a.x & 0xffff0000u);
          As[ak + 2][ar] = __uint_as_float(a.y << 16); As[ak + 3][ar] = __uint_as_float(a.y & 0xffff0000u); }
        { const f32x4 b = *(const f32x4*)(W + (size_t)(k0 + bk) * p.ldw + gc0 + bn); Bs[bk][bn] = b.x; Bs[bk][bn + 1] = b.y; Bs[bk][bn + 2] = b.z; Bs[bk][bn + 3] = b.w; }
        if (p.mode == MD_SILU) { const f32x4 b = *(const f32x4*)(W2 + (size_t)(k0 + bk) * p.ldw + gc0 + bn); B2s[bk][bn] = b.x; B2s[bk][bn + 1] = b.y; B2s[bk][bn + 2] = b.z; B2s[bk][bn + 3] = b.w; }
        __syncthreads();
#pragma unroll
        for (int k = 0; k < 16; ++k) {
            float a[4], b[4];
#pragma unroll
            for (int i = 0; i < 4; ++i) { a[i] = As[k][ty * 4 + i]; b[i] = Bs[k][tx * 4 + i]; }
#pragma unroll
            for (int i = 0; i < 4; ++i)
#pragma unroll
                for (int j = 0; j < 4; ++j) acc[i][j] += a[i] * b[j];
            if (p.mode == MD_SILU) {
#pragma unroll
                for (int i = 0; i < 4; ++i) b[i] = B2s[k][tx * 4 + i];
#pragma unroll
                for (int i = 0; i < 4; ++i)
#pragma unroll
                    for (int j = 0; j < 4; ++j) acc2[i][j] += a[i] * b[j];
            }
        }
        __syncthreads();
    }
#pragma unroll
    for (int i = 0; i < 4; ++i)
#pragma unroll
        for (int j = 0; j < 4; ++j) { Ct[ty * 4 + i][tx * 4 + j] = acc[i][j]; Ct2[ty * 4 + i][tx * 4 + j] = acc2[i][j]; }
    __syncthreads();
    const int r = tid >> 2, q = tid & 3; const int grow = gr0 + r;
    if (p.mode == MD_PROJ) {
        const int pos = grow & (SEQ - 1);
        bf16_t* orow = p.O + (size_t)grow * p.ldo + gc0;
        if (gc0 < C_AV) {
            const float sc = gc0 < C_AK ? C2_64 : 1.f;
            for (int j = 0; j < 8; ++j) { const int i = q * 8 + j; const float x1 = Ct[r][i], x2 = Ct[r][i + 32]; float s, c; sincosf((float)pos * inv1d(i), &s, &c);
                orow[i] = f2bf((x1 * c - x2 * s) * sc); orow[i + 32] = f2bf((x2 * c + x1 * s) * sc); }
        } else if ((gc0 >= C_BQ && gc0 < C_BV)) {
            const bool isq = gc0 < C_BK; const float* g = isq ? p.qg : p.kg; const float sc = isq ? C2_64 : 1.f;
            float ss = 0.f; for (int d = 0; d < 64; ++d) ss += Ct[r][d] * Ct[r][d];
            const float rs = rsqrtf(ss * (1.f / 64.f) + EPS);
            for (int j = 0; j < 8; ++j) { const int i = q * 8 + j; const float x1 = Ct[r][i] * rs * g[i], x2 = Ct[r][i + 32] * rs * g[i + 32]; float s, c; sincosf(ang2d(pos, i), &s, &c);
                orow[i] = f2bf((x1 * c - x2 * s) * sc); orow[i + 32] = f2bf((x2 * c + x1 * s) * sc); }
        } else if (gc0 >= C_G) {
            for (int j = 0; j < 16; ++j) { const int c = q * 16 + j; orow[c] = f2bf(1.f / (1.f + __expf(-Ct[r][c]))); }
        } else {
            const float sc = (gc0 >= C_CQ) ? C2_128 : 1.f;
            for (int j = 0; j < 16; ++j) { const int c = q * 16 + j; orow[c] = f2bf(Ct[r][c] * sc); }
        }
    } else if (p.mode == MD_BF16) {
        for (int j = 0; j < 16; ++j) { const int c = q * 16 + j; p.O[(size_t)grow * p.ldo + gc0 + c] = f2bf(Ct[r][c]); }
    } else if (p.mode == MD_GATE) {
        for (int j = 0; j < 16; ++j) { const int c = q * 16 + j; const float gv = bf2f(p.G[(size_t)grow * p.ldg + gc0 + c]);
            bf16_t* o = p.O + (size_t)grow * p.ldo + gc0 + c; const float prev = p.first ? 0.f : bf2f(*o); *o = f2bf(prev + gv * Ct[r][c]); }
    } else if (p.mode == MD_RESID) {
        for (int j = 0; j < 16; ++j) { const int c = q * 16 + j; p.Xf[(size_t)grow * DM + gc0 + c] += Ct[r][c]; }
    } else if (p.mode == MD_SILU) {
        for (int j = 0; j < 16; ++j) { const int c = q * 16 + j; const float gq = Ct[r][c], u = Ct2[r][c]; p.O[(size_t)grow * p.ldo + gc0 + c] = f2bf(gq / (1.f + __expf(-gq)) * u); }
    } else if (p.mode == MD_ROWSCALE) {
        const float w = p.roww[grow];
        for (int j = 0; j < 16; ++j) { const int c = q * 16 + j; p.O[(size_t)grow * p.ldo + gc0 + c] = f2bf(Ct[r][c] * w); }
    }
}

template <int DQK, int DV, int NKT>
__device__ __forceinline__ void attn_row(const bf16_t* q, const bf16_t* K, int ldk, const bf16_t* V, int ldv, float* qs, float* ps, int lane, float (&o)[2]) {
    for (int d = lane; d < DQK; d += 64) qs[d] = bf2f(q[d]);
    __syncthreads();
    float sc[NKT]; float m = -INFINITY;
#pragma unroll
    for (int i = 0; i < NKT; ++i) {
        const bf16_t* kr = K + (size_t)(i * 64 + lane) * ldk; float s = 0.f;
#pragma unroll
        for (int d0 = 0; d0 < DQK / 8; ++d0) { const u32x4 w = *(const u32x4*)(kr + d0 * 8);
            s += qs[d0 * 8 + 0] * __uint_as_float(w.x << 16) + qs[d0 * 8 + 1] * __uint_as_float(w.x & 0xffff0000u) + qs[d0 * 8 + 2] * __uint_as_float(w.y << 16) + qs[d0 * 8 + 3] * __uint_as_float(w.y & 0xffff0000u)
               + qs[d0 * 8 + 4] * __uint_as_float(w.z << 16) + qs[d0 * 8 + 5] * __uint_as_float(w.z & 0xffff0000u) + qs[d0 * 8 + 6] * __uint_as_float(w.w << 16) + qs[d0 * 8 + 7] * __uint_as_float(w.w & 0xffff0000u); }
        sc[i] = s; m = fmaxf(m, s);
    }
    m = wave_max(m); float l = 0.f;
#pragma unroll
    for (int i = 0; i < NKT; ++i) { const float pv = exp2f(sc[i] - m); l += pv; ps[i * 64 + lane] = pv; }
    l = wave_sum(l);
    __syncthreads();
    float a0 = 0.f, a1 = 0.f;
#pragma unroll 4
    for (int j = 0; j < NKT * 64; ++j) { const float pv = ps[j]; a0 += pv * bf2f(V[(size_t)j * ldv + lane]); if (DV == 128) a1 += pv * bf2f(V[(size_t)j * ldv + 64 + lane]); }
    o[0] = a0 / l; o[1] = a1 / l;
    __syncthreads();
}
__global__ __launch_bounds__(256) void s_attn_b(const bf16_t* __restrict__ PROJ, bf16_t* __restrict__ OBR) {
    __shared__ float qs_[4][128]; __shared__ float ps_[4][2048];
    const int w = threadIdx.x >> 6, lane = threadIdx.x & 63, row = blockIdx.x * 4 + w, qh = blockIdx.y, b = row / SEQ;
    const bf16_t* kv = PROJ + (size_t)b * SEQ * D_IN;
    float o[2];
    attn_row<64, 64, 32>(PROJ + (size_t)row * D_IN + C_BQ + qh * 64, kv + C_BK + (qh >> 2) * 64, D_IN, kv + C_BV + (qh >> 2) * 64, D_IN, qs_[w], ps_[w], lane, o);
    OBR[(size_t)row * OBR_W + 512 + qh * 64 + lane] = f2bf(o[0]);
}
__global__ __launch_bounds__(256) void s_attn_c(const bf16_t* __restrict__ PROJ, const bf16_t* __restrict__ MEMKV, bf16_t* __restrict__ OBR) {
    __shared__ float qs_[4][128]; __shared__ float ps_[4][256];
    const int w = threadIdx.x >> 6, lane = threadIdx.x & 63, row = blockIdx.x * 4 + w, h = blockIdx.y, b = row / SEQ;
    const bf16_t* kv = MEMKV + (size_t)b * MEM_LEN * 1024;
    float o[2];
    attn_row<128, 128, 4>(PROJ + (size_t)row * D_IN + C_CQ + h * 128, kv + h * 128, 1024, kv + 512 + h * 128, 1024, qs_[w], ps_[w], lane, o);
    OBR[(size_t)row * OBR_W + 1024 + h * 128 + lane] = f2bf(o[0]);
    OBR[(size_t)row * OBR_W + 1024 + h * 128 + 64 + lane] = f2bf(o[1]);
}
__global__ __launch_bounds__(256) void s_attn_a(const bf16_t* __restrict__ PROJ, bf16_t* __restrict__ OBR, const float* lq1, const float* lk1, const float* lq2, const float* lk2,
                                                const float* subg, float lam_init) {
    __shared__ float qs_[4][128]; __shared__ float ps_[4][2048];
    const int w = threadIdx.x >> 6, lane = threadIdx.x & 63, row = blockIdx.x * 4 + w, h = blockIdx.y, b = row / SEQ;
    const float lam = __expf(wave_sum(lq1[lane] * lk1[lane])) - __expf(wave_sum(lq2[lane] * lk2[lane])) + lam_init;
    const bf16_t* kv = PROJ + (size_t)b * SEQ * D_IN;
    float o0[2], o1[2];
    attn_row<64, 128, 32>(PROJ + (size_t)row * D_IN + C_AQ + h * 128, kv + C_AK + h * 128, D_IN, kv + C_AV + h * 128, D_IN, qs_[w], ps_[w], lane, o0);
    attn_row<64, 128, 32>(PROJ + (size_t)row * D_IN + C_AQ + h * 128 + 64, kv + C_AK + h * 128 + 64, D_IN, kv + C_AV + h * 128, D_IN, qs_[w], ps_[w], lane, o1);
    const float c0 = o0[0] - lam * o1[0], c1 = o0[1] - lam * o1[1];
    const float rs = rsqrtf(wave_sum(c0 * c0 + c1 * c1) * (1.f / 128.f) + EPS) * (1.f - lam_init);
    OBR[(size_t)row * OBR_W + h * 128 + lane] = f2bf(c0 * rs * subg[lane]);
    OBR[(size_t)row * OBR_W + h * 128 + 64 + lane] = f2bf(c1 * rs * subg[64 + lane]);
}

__global__ __launch_bounds__(256) void s_norm_route(const float* __restrict__ X, const float* __restrict__ g, bf16_t* __restrict__ H2, const float* __restrict__ wrg, const float* __restrict__ brg,
                                                    const float* __restrict__ wre, const float* __restrict__ bre, int* __restrict__ experts, float* __restrict__ weights, int* __restrict__ rank, unsigned* __restrict__ cnt, float* __restrict__ rstd) {
    const int lane = threadIdx.x & 63, row = blockIdx.x * 4 + (threadIdx.x >> 6);
    const f32x4* xr = (const f32x4*)(X + (size_t)row * DM);
    f32x4 v[4]; float s = 0.f;
#pragma unroll
    for (int j = 0; j < 4; ++j) { v[j] = xr[lane + 64 * j]; s += v[j].x * v[j].x + v[j].y * v[j].y + v[j].z * v[j].z + v[j].w * v[j].w; }
    const float rs = rsqrtf(wave_sum(s) * (1.f / DM) + EPS);
    float acc[36];
#pragma unroll
    for (int e = 0; e < 36; ++e) acc[e] = 0.f;
#pragma unroll
    for (int j = 0; j < 4; ++j) { const f32x4 gg = ((const f32x4*)g)[lane + 64 * j];
        float h[4] = {v[j].x * rs * gg.x, v[j].y * rs * gg.y, v[j].z * rs * gg.z, v[j].w * rs * gg.w};
        u32x2 o; o.x = f2bf(h[0]) | ((unsigned)f2bf(h[1]) << 16); o.y = f2bf(h[2]) | ((unsigned)f2bf(h[3]) << 16);
        ((u32x2*)(H2 + (size_t)row * DM))[lane + 64 * j] = o;
#pragma unroll
        for (int i = 0; i < 4; ++i) { const int k = (lane + 64 * j) * 4 + i;
            const f32x4 wg = *(const f32x4*)(wrg + (size_t)k * 4);
            acc[0] += h[i] * wg.x; acc[1] += h[i] * wg.y; acc[2] += h[i] * wg.z; acc[3] += h[i] * wg.w;
#pragma unroll
            for (int e4 = 0; e4 < 8; ++e4) { const f32x4 we = *(const f32x4*)(wre + (size_t)k * 32 + e4 * 4);
                acc[4 + e4 * 4 + 0] += h[i] * we.x; acc[4 + e4 * 4 + 1] += h[i] * we.y; acc[4 + e4 * 4 + 2] += h[i] * we.z; acc[4 + e4 * 4 + 3] += h[i] * we.w; }
        }
    }
#pragma unroll
    for (int e = 0; e < 36; ++e) acc[e] = wave_sum(acc[e]);
    if (lane == 0) {
        rstd[row] = rs;
        int gi = 0; float gm = acc[0] + brg[0];
        for (int i = 1; i < 4; ++i) { const float l = acc[i] + brg[i]; if (l > gm) { gm = l; gi = i; } }
        float gs = 0.f; for (int i = 0; i < 4; ++i) gs += __expf(acc[i] + brg[i] - gm);
        const float gp = 1.f / gs;
        float el[8];
#pragma unroll
        for (int i = 0; i < 8; ++i) el[i] = 0.f;
#pragma unroll
        for (int gq = 0; gq < 4; ++gq) if (gq == gi) {
#pragma unroll
            for (int i = 0; i < 8; ++i) el[i] = acc[4 + gq * 8 + i] + bre[gq * 8 + i]; }
        int i0 = 0; float l0 = el[0];
#pragma unroll
        for (int i = 1; i < 8; ++i) if (el[i] > l0) { l0 = el[i]; i0 = i; }
        int i1 = -1; float l1 = -INFINITY;
#pragma unroll
        for (int i = 0; i < 8; ++i) if (i != i0 && el[i] > l1) { l1 = el[i]; i1 = i; }
        const float p1 = __expf(l1 - l0), inv = 1.f / (1.f + p1);
        const int e0 = gi * 8 + i0, e1 = gi * 8 + i1;
        experts[row * 2] = e0; experts[row * 2 + 1] = e1;
        weights[row * 2] = gp * inv; weights[row * 2 + 1] = gp * p1 * inv;
        rank[row * 2] = (int)atomicAdd(cnt + e0, 1u); rank[row * 2 + 1] = (int)atomicAdd(cnt + e1, 1u);
    }
}
__global__ void s_dispatch(const unsigned* __restrict__ cnt, int* __restrict__ tile_tab) {
    if (threadIdx.x == 0) {
        int off = 0, nt = 0;
        for (int e = 0; e < NEXP; ++e) { const int c = (int)cnt[e], t = (c + MOE_TILE - 1) / MOE_TILE; tile_tab[260 + e] = off; for (int i = 0; i < t; ++i) tile_tab[nt++] = e; off += t * MOE_TILE; }
        tile_tab[256] = nt;
    }
}
__global__ __launch_bounds__(256) void s_gather(const float* __restrict__ X, const float* __restrict__ rstd, const float* __restrict__ g, const int* __restrict__ experts, const float* __restrict__ weights, const int* __restrict__ rank, const int* __restrict__ tile_tab,
                                                bf16_t* __restrict__ BUF, float* __restrict__ roww, int* __restrict__ dest) {
    const int lane = threadIdx.x & 63, a = blockIdx.x * 4 + (threadIdx.x >> 6);
    const int tok = a >> 1, e = experts[a], d = tile_tab[260 + e] + rank[a]; const float rs = rstd[tok];
    const f32x4* xr = (const f32x4*)(X + (size_t)tok * DM);
    for (int j = 0; j < 4; ++j) { const f32x4 v = xr[lane + 64 * j], gg = ((const f32x4*)g)[lane + 64 * j];
        u32x2 o; o.x = f2bf(v.x * rs * gg.x) | ((unsigned)f2bf(v.y * rs * gg.y) << 16); o.y = f2bf(v.z * rs * gg.z) | ((unsigned)f2bf(v.w * rs * gg.w) << 16);
        ((u32x2*)(BUF + (size_t)d * DM))[lane + 64 * j] = o; }
    if (lane == 0) { roww[d] = weights[a]; dest[a] = d; }
}
__global__ __launch_bounds__(256) void s_combine_norm(float* __restrict__ X, const bf16_t* __restrict__ YB, const int* __restrict__ dest, const float* __restrict__ g, bf16_t* __restrict__ H, float* __restrict__ OUT) {
    const int lane = threadIdx.x & 63, row = blockIdx.x * 4 + (threadIdx.x >> 6);
    const int d0 = dest[row * 2], d1 = dest[row * 2 + 1];
    f32x4* xr = (f32x4*)(X + (size_t)row * DM);
    f32x4 v[4]; float s = 0.f;
#pragma unroll
    for (int j = 0; j < 4; ++j) { v[j] = xr[lane + 64 * j];
        const u32x2 a = ((const u32x2*)(YB + (size_t)d0 * DM))[lane + 64 * j], b = ((const u32x2*)(YB + (size_t)d1 * DM))[lane + 64 * j];
        v[j].x += __uint_as_float(a.x << 16) + __uint_as_float(b.x << 16); v[j].y += __uint_as_float(a.x & 0xffff0000u) + __uint_as_float(b.x & 0xffff0000u);
        v[j].z += __uint_as_float(a.y << 16) + __uint_as_float(b.y << 16); v[j].w += __uint_as_float(a.y & 0xffff0000u) + __uint_as_float(b.y & 0xffff0000u);
        s += v[j].x * v[j].x + v[j].y * v[j].y + v[j].z * v[j].z + v[j].w * v[j].w; }
    const float rs = rsqrtf(wave_sum(s) * (1.f / DM) + EPS);
#pragma unroll
    for (int j = 0; j < 4; ++j) { const f32x4 gg = ((const f32x4*)g)[lane + 64 * j];
        if (H) { xr[lane + 64 * j] = v[j];
            u32x2 o; o.x = f2bf(v[j].x * rs * gg.x) | ((unsigned)f2bf(v[j].y * rs * gg.y) << 16); o.y = f2bf(v[j].z * rs * gg.z) | ((unsigned)f2bf(v[j].w * rs * gg.w) << 16);
            ((u32x2*)(H + (size_t)row * DM))[lane + 64 * j] = o; }
        else { f32x4 o; o.x = v[j].x * rs * gg.x; o.y = v[j].y * rs * gg.y; o.z = v[j].z * rs * gg.z; o.w = v[j].w * rs * gg.w; ((f32x4*)(OUT + (size_t)row * DM))[lane + 64 * j] = o; }
    }
}

#define LAS __attribute__((address_space(3)))
#define GAS __attribute__((address_space(1)))
typedef short bf16x8 __attribute__((ext_vector_type(8)));
typedef short s16x4 __attribute__((ext_vector_type(4)));
typedef float f32x16 __attribute__((ext_vector_type(16)));
typedef float f32x2 __attribute__((ext_vector_type(2)));

constexpr size_t WB_IN = 0, WB_UP = 6029312, WB_OUT = WB_UP + 1572864, WB_GU = WB_OUT + 1048576, WB_DN = WB_GU + 33554432, WB_LAYER = WB_DN + 16777216;
constexpr size_t WB_MEMKV = 2 * WB_LAYER;
constexpr size_t WB_RT = WB_MEMKV + 1048576;
static_assert(WS_WB + (WB_RT + 2 * 2 * 48 * 1024) * 2 <= WS_END, "weight copies fit");
constexpr int N_PHASES = 19;
constexpr int LCAP = 16384;

__device__ __forceinline__ int lane_id() { int r; asm volatile("v_mbcnt_lo_u32_b32 %0, -1, 0\n\tv_mbcnt_hi_u32_b32 %0, -1, %0" : "=v"(r)); return r; }
__device__ __forceinline__ unsigned cvt_pk_bf16(float lo, float hi) { unsigned r; asm volatile("v_cvt_pk_bf16_f32 %0, %1, %2" : "=v"(r) : "v"(lo), "v"(hi)); return r; }
__device__ __forceinline__ float fast_sigmoid(float v) { return __builtin_amdgcn_rcpf(1.f + __builtin_amdgcn_exp2f(-v * LOG2E)); }

namespace pg8 {
#define PG8_LAS LAS
constexpr int BM = 256, BK = 64, HALF = 128, HTB = HALF * BK * 2, STAGE_BYTES = 8 * HTB, NXCD = 8, WGM = 8;
__host__ __device__ __forceinline__ int lds_byte(int r, int c) { const int st = (r >> 4) * 2 + (c >> 5), rr = r & 15, cc = c & 31, ob = rr * 64 + cc * 2; return st * 1024 + (ob ^ (((ob >> 9) & 1) << 5)); }
__host__ __device__ __forceinline__ void stage_rc(int b, int& R, int& C) { const int st = b / 1024, sb = b % 1024, swz = sb ^ (((sb >> 9) & 1) << 5); R = (st >> 1) * 16 + swz / 64; C = (st & 1) * 32 + (swz % 64) / 2; }
__host__ __device__ __forceinline__ int perm32(int rho) { const int n = rho >> 4, i = rho & 15; return 8 * (i >> 2) + 4 * n + (i & 3); }

struct Unit { int pm, pn, sub, ord; const char* a; const char* b; };
struct Gemm { int lda; int K; };
__device__ __forceinline__ void tile_order(int L, int nM, int nN, int& pm, int& pn) {
    const int nwg = nM * nN; int wgid = L; { const int q = nwg / NXCD, r = nwg % NXCD, xcd = wgid % NXCD, off = wgid / NXCD; wgid = (xcd < r ? xcd * (q + 1) : r * (q + 1) + (xcd - r) * q) + off; }
    const int nig = WGM * nN, gid = wgid / nig, fm = gid * WGM, gsz = (nM - fm) < WGM ? (nM - fm) : WGM;
    pm = fm + ((wgid % nig) % gsz); pn = (wgid % nig) / gsz;
}
__device__ __forceinline__ u32x4 pack8(const f32x4& v0, const f32x4& v1) { u32x4 w; w.x = cvt_pk_bf16(v0[0], v0[1]); w.y = cvt_pk_bf16(v0[2], v0[3]); w.z = cvt_pk_bf16(v1[0], v1[1]); w.w = cvt_pk_bf16(v1[2], v1[3]); return w; }
__device__ __forceinline__ void unpack8(const u32x4& w, f32x4& v0, f32x4& v1) {
    v0[0] = __uint_as_float(w.x << 16); v0[1] = __uint_as_float(w.x & 0xffff0000u); v0[2] = __uint_as_float(w.y << 16); v0[3] = __uint_as_float(w.y & 0xffff0000u);
    v1[0] = __uint_as_float(w.z << 16); v1[1] = __uint_as_float(w.z & 0xffff0000u); v1[2] = __uint_as_float(w.w << 16); v1[3] = __uint_as_float(w.w & 0xffff0000u); }

struct EpiProj {
    static constexpr bool PERM = true, AFTER_DRAIN = false;
    bf16_t* PROJ; bf16_t* MEMKV; const float* tab1; const float* tab2; const float* qg; const float* kg;
    __device__ __forceinline__ void operator()(const f32x4 (&acc)[2][2][4][2], const Unit& u, int wr, int wc, int fr, int fq) const {
        const int colt = u.pn * 256, dcol = colt + wc * 64 + fq * 8, row0 = u.pm * 256 + wr * 64 + fr;
        if (u.sub == 1) {
#pragma unroll
            for (int ai = 0; ai < 2; ++ai)
#pragma unroll
                for (int m = 0; m < 4; ++m) { bf16_t* rowp = MEMKV + (size_t)(row0 + ai * 128 + m * 16) * 1024 + dcol;
#pragma unroll
                    for (int bj = 0; bj < 2; ++bj) *(u32x4*)(rowp + bj * 32) = pack8(acc[ai][bj][m][0], acc[ai][bj][m][1]); }
            return;
        }
        int mode = 0; float sc = 1.f; const float* g = qg;
        if (colt < C_AV) { mode = 1; if (colt < C_AK) sc = C2_64; }
        else if (colt < C_BQ) mode = 0;
        else if (colt < C_BK) { mode = 2; sc = C2_64; }
        else if (colt < C_CQ) { if (wc < 2) { mode = 2; g = kg; } }
        else if (colt < C_G) sc = C2_128;
        else mode = 3;
        f32x4 gv[2][2];
        if (mode == 2) {
#pragma unroll
            for (int bj = 0; bj < 2; ++bj)
#pragma unroll
                for (int n = 0; n < 2; ++n) gv[bj][n] = *(const f32x4*)(g + bj * 32 + fq * 8 + n * 4);
        }
#pragma unroll
        for (int ai = 0; ai < 2; ++ai)
#pragma unroll
            for (int m = 0; m < 4; ++m) {
                const int row = row0 + ai * 128 + m * 16, pos = row & (SEQ - 1);
                f32x4 v[2][2] = {{acc[ai][0][m][0], acc[ai][0][m][1]}, {acc[ai][1][m][0], acc[ai][1][m][1]}};
                if (mode == 2) {
                    float ss = 0.f;
#pragma unroll
                    for (int bj = 0; bj < 2; ++bj)
#pragma unroll
                        for (int n = 0; n < 2; ++n) ss += (v[bj][n][0] * v[bj][n][0] + v[bj][n][1] * v[bj][n][1]) + (v[bj][n][2] * v[bj][n][2] + v[bj][n][3] * v[bj][n][3]);
                    ss += __shfl_xor(ss, 16); ss += __shfl_xor(ss, 32);
                    const float rs = rsqrtf(ss * (1.f / 64.f) + EPS);
#pragma unroll
                    for (int bj = 0; bj < 2; ++bj)
#pragma unroll
                        for (int n = 0; n < 2; ++n) v[bj][n] = v[bj][n] * rs * gv[bj][n];
                }
                if (mode == 1 || mode == 2) {
                    const float* tb = (mode == 1 ? tab1 : tab2) + ((size_t)pos * 32 + fq * 8) * 2;
#pragma unroll
                    for (int n = 0; n < 2; ++n) { const f32x4 t0 = *(const f32x4*)(tb + n * 8), t1 = *(const f32x4*)(tb + n * 8 + 4);
                        const float cs[4] = {t0[0], t0[2], t1[0], t1[2]}, sn[4] = {t0[1], t0[3], t1[1], t1[3]};
#pragma unroll
                        for (int e = 0; e < 4; ++e) { const float x1 = v[0][n][e], x2 = v[1][n][e]; v[0][n][e] = x1 * cs[e] - x2 * sn[e]; v[1][n][e] = x2 * cs[e] + x1 * sn[e]; } }
                }
                if (mode == 3) {
#pragma unroll
                    for (int bj = 0; bj < 2; ++bj)
#pragma unroll
                        for (int n = 0; n < 2; ++n)
#pragma unroll
                            for (int e = 0; e < 4; ++e) v[bj][n][e] = fast_sigmoid(v[bj][n][e]);
                }
                bf16_t* rowp = PROJ + (size_t)row * D_IN + dcol;
#pragma unroll
                for (int bj = 0; bj < 2; ++bj) *(u32x4*)(rowp + bj * 32) = pack8(v[bj][0] * sc, v[bj][1] * sc);
            }
    }
};
struct EpiGate {
    static constexpr bool PERM = true, AFTER_DRAIN = false;
    bf16_t* MERGED; const bf16_t* PROJ;
    __device__ __forceinline__ void operator()(const f32x4 (&acc)[2][2][4][2], const Unit& u, int wr, int wc, int fr, int fq) const {
        const int col0 = u.pn * 256 + wc * 32 + fq * 8, row0 = u.pm * 256 + wr * 64 + fr;
#pragma unroll
        for (int ai = 0; ai < 2; ++ai)
#pragma unroll
            for (int m = 0; m < 4; ++m) { const int row = row0 + ai * 128 + m * 16;
                const bf16_t* gp = PROJ + (size_t)row * D_IN + C_G + u.sub * 1024 + col0; bf16_t* op = MERGED + (size_t)row * DM + col0;
#pragma unroll
                for (int bj = 0; bj < 2; ++bj) { f32x4 g0, g1, o0 = {0.f, 0.f, 0.f, 0.f}, o1 = {0.f, 0.f, 0.f, 0.f};
                    unpack8(*(const u32x4*)(gp + bj * 128), g0, g1);
                    if (u.sub != 0) unpack8(*(const u32x4*)(op + bj * 128), o0, o1);
                    o0 += g0 * acc[ai][bj][m][0]; o1 += g1 * acc[ai][bj][m][1];
                    *(u32x4*)(op + bj * 128) = pack8(o0, o1); } }
    }
};
struct EpiResid {
    static constexpr bool PERM = true, AFTER_DRAIN = false;
    const float* Xin; float* X;
    __device__ __forceinline__ void operator()(const f32x4 (&acc)[2][2][4][2], const Unit& u, int wr, int wc, int fr, int fq) const {
        const int col0 = u.pn * 256 + wc * 32 + fq * 8, row0 = u.pm * 256 + wr * 64 + fr;
#pragma unroll
        for (int ai = 0; ai < 2; ++ai)
#pragma unroll
            for (int m = 0; m < 4; ++m) { const size_t off = (size_t)(row0 + ai * 128 + m * 16) * DM + col0;
#pragma unroll
                for (int bj = 0; bj < 2; ++bj) { const f32x4* pi = (const f32x4*)(Xin + off + bj * 128); f32x4* po = (f32x4*)(X + off + bj * 128); const f32x4 a = pi[0], b = pi[1]; po[0] = a + acc[ai][bj][m][0]; po[1] = b + acc[ai][bj][m][1]; } }
    }
};
struct EpiSilu {
    static constexpr bool PERM = true, AFTER_DRAIN = false;
    bf16_t* HID;
    __device__ __forceinline__ void operator()(const f32x4 (&acc)[2][2][4][2], const Unit& u, int wr, int wc, int fr, int fq) const {
        const __amdgpu_buffer_rsrc_t rsrc = __builtin_amdgcn_make_buffer_rsrc((void*)HID, 0, P_ROWS * DEXP * 2, 0x00020000);
        const int col0 = u.pn * 128 + wc * 32 + fq * 8, row0 = u.pm * 256 + wr * 64 + fr;
#pragma unroll
        for (int ai = 0; ai < 2; ++ai)
#pragma unroll
            for (int m = 0; m < 4; ++m) { f32x4 h[2];
#pragma unroll
                for (int n = 0; n < 2; ++n)
#pragma unroll
                    for (int e = 0; e < 4; ++e) { const float gq = acc[ai][0][m][n][e]; h[n][e] = gq * fast_sigmoid(gq) * acc[ai][1][m][n][e]; }
                __builtin_amdgcn_raw_buffer_store_b128(pack8(h[0], h[1]), rsrc, ((row0 + ai * 128 + m * 16) * DEXP + col0) * 2, 0, 16); }
    }
};
struct EpiRowScale {
    static constexpr bool PERM = true, AFTER_DRAIN = false;
    bf16_t* YB; const PG8_LAS float* wtab;
    __device__ __forceinline__ void operator()(const f32x4 (&acc)[2][2][4][2], const Unit& u, int wr, int wc, int fr, int fq) const {
        const int col0 = u.pn * 256 + wc * 32 + fq * 8, rt0 = wr * 64 + fr;
#pragma unroll
        for (int ai = 0; ai < 2; ++ai)
#pragma unroll
            for (int m = 0; m < 4; ++m) { const int rt = rt0 + ai * 128 + m * 16; const float w = wtab[u.ord * 256 + rt]; bf16_t* op = YB + (size_t)(u.pm * 256 + rt) * DM + col0;
#pragma unroll
                for (int bj = 0; bj < 2; ++bj) *(u32x4*)(op + bj * 128) = pack8(acc[ai][bj][m][0] * w, acc[ai][bj][m][1] * w); }
    }
};
struct SchedProj {
    int c, G, nmain, ntotal; const char* A; const char* B; const char* Am; const char* Bm;
    __device__ __forceinline__ bool next(int i, Unit& u) const {
        const long L = (long)i * G + c; if (L >= ntotal) return false;
        u.ord = i;
        if (L < nmain) { tile_order((int)L, M / 256, D_IN / 256, u.pm, u.pn); u.sub = 0; u.a = A + (size_t)u.pm * (256 * DM * 2); u.b = B + (size_t)u.pn * (256 * DM * 2); }
        else { const int r = (int)L - nmain; u.pm = r >> 2; u.pn = r & 3; u.sub = 1; u.a = Am + (size_t)u.pm * (256 * DM * 2); u.b = Bm + (size_t)u.pn * (256 * DM * 2); }
        return true; }
    __device__ __forceinline__ void a_ready(const Unit&) const {}
    __device__ __forceinline__ void done(const Unit&) const {}
};
struct SchedGate {
    int c, G; const char* OBRp; const char* WUP;
    __device__ __forceinline__ bool next(int i, Unit& u) const {
        const int t = c + G * (i / 3); if (t >= 256) return false;
        tile_order(t, M / 256, 4, u.pm, u.pn); u.sub = i % 3; u.ord = i;
        u.a = OBRp + ((size_t)u.pm * 256 * OBR_W + 512 * u.sub) * 2; u.b = WUP + ((size_t)u.sub * 1024 * 512 + (size_t)u.pn * 256 * 512) * 2; return true; }
    __device__ __forceinline__ void a_ready(const Unit&) const {}
    __device__ __forceinline__ void done(const Unit&) const {}
};
struct SchedPlain {
    int c, G, nM; const char* A; const char* B; size_t a_tile, b_tile;
    __device__ __forceinline__ bool next(int i, Unit& u) const {
        const long L = (long)i * G + c; if (L >= (long)nM * 4) return false;
        tile_order((int)L, nM, 4, u.pm, u.pn); u.sub = 0; u.ord = i; u.a = A + (size_t)u.pm * a_tile; u.b = B + (size_t)u.pn * b_tile; return true; }
    __device__ __forceinline__ void a_ready(const Unit&) const {}
    __device__ __forceinline__ void done(const Unit&) const {}
};
struct SchedMoeUp {
    static constexpr size_t b_exp = (size_t)1024 * 1024 * 2, b_tile = (size_t)256 * DM * 2;
    int c, G, ntiles; const PG8_LAS int* tile_e; const char* A; const char* B; unsigned* tcnt;
    __device__ __forceinline__ bool next(int i, Unit& u) const {
        const long L = (long)i * G + c; if (L >= (long)ntiles * 4) return false;
        u.pm = (int)(L >> 2); u.pn = (int)(L & 3); u.sub = 0; u.ord = i; const int e = tile_e[u.pm];
        u.a = A; u.b = B + (size_t)e * b_exp + (size_t)u.pn * b_tile; return true; }
    __device__ __forceinline__ void a_ready(const Unit&) const {}
    __device__ __forceinline__ void done(const Unit& u) const {
        asm volatile("s_waitcnt vmcnt(0)" ::: "memory");
        if (lane_id() == 0) __hip_atomic_fetch_add(tcnt + 64 * u.pm, 1u, __ATOMIC_RELAXED, __HIP_MEMORY_SCOPE_AGENT);
    }
};
__device__ __forceinline__ int moe_down_unit(int c, int i, int rem, int G) {
    const int n0 = G - rem, n1 = rem;
    return c >= rem ? n0 * i + n1 * (i > 1 ? i - 1 : 0) + (c - rem) : n0 * (i + 2) + n1 * i + c;
}
struct SchedMoeDown {
    static constexpr size_t a_tile = (size_t)256 * DEXP * 2, b_exp = (size_t)1024 * 512 * 2, b_tile = (size_t)256 * DEXP * 2;
    int c, G, ntiles, rem, wv; const PG8_LAS int* tile_e; const char* A; const char* B; unsigned* tcnt; unsigned* tmo;
    __device__ __forceinline__ bool next(int i, Unit& u) const {
        const int j = moe_down_unit(c, i, rem, G); if (j >= ntiles * 4) return false;
        u.pm = j >> 2; u.pn = j & 3; u.sub = 0; u.ord = i; const int e = tile_e[u.pm];
        u.a = A + (size_t)u.pm * a_tile; u.b = B + (size_t)e * b_exp + (size_t)u.pn * b_tile; return true; }
    __device__ __forceinline__ void a_ready(const Unit& u) const {
        if (wv == 0) {
            unsigned polls = 0;
            while ((unsigned)__builtin_amdgcn_readfirstlane(__hip_atomic_load(tcnt + 64 * u.pm, __ATOMIC_RELAXED, __HIP_MEMORY_SCOPE_AGENT)) < 32u) {
                if (++polls > (1u << 20)) { if (lane_id() == 0) __hip_atomic_store(tmo, 1u, __ATOMIC_RELAXED, __HIP_MEMORY_SCOPE_AGENT); break; }
                __builtin_amdgcn_s_sleep(2); }
            __builtin_amdgcn_fence(__ATOMIC_ACQUIRE, "agent");
            asm volatile("s_waitcnt vmcnt(0)" ::: "memory");
        }
        asm volatile("" ::: "memory"); __builtin_amdgcn_s_barrier(); asm volatile("" ::: "memory");
    }
    __device__ __forceinline__ void done(const Unit&) const {}
};

template <class Epi, class Sched, bool ALIGN_EPI = false, bool SP2 = false, bool GATHER = false>
__device__ __forceinline__ void gemm_phase(PG8_LAS unsigned char* lds, const Gemm g, const Sched& S, const Epi& E, int wave_id, const PG8_LAS unsigned* rowtab = nullptr) {
    static_assert(!GATHER || SP2, "the gathered A path is written for the two-super-phase loop");
    int tid_ = wave_id * 64 + lane_id(); asm volatile("" : "+v"(tid_));
    const int tid = tid_, wid = __builtin_amdgcn_readfirstlane(tid >> 6), lane = tid & 63, wr = wid >> 2, wc = wid & 3, fr = lane & 15, fq = lane >> 4;
    const int K = g.K, nt = K / BK;
    unsigned voffA[2], voffB[2];
#pragma unroll
    for (int i = 0; i < 2; ++i) { int R, C; stage_rc(tid * 16 + i * 8192, R, C); const int Rb = Epi::PERM ? ((R & ~31) + perm32(R & 31)) : R;
        voffA[i] = (unsigned)(R * g.lda + C) * 2u; voffB[i] = (unsigned)(Rb * K + C) * 2u; }
    unsigned gC[2][2] = {{0u, 0u}, {0u, 0u}}, gN[2][2] = {{0u, 0u}, {0u, 0u}};
#define PG8_GROWS(dst, ord) do { if constexpr (GATHER) { _Pragma("unroll") for (int i_ = 0; i_ < 2; ++i_) { int R_, C_; stage_rc((wid * 64 + fq * 16 + fr) * 16 + i_ * 8192, R_, C_);     \
        _Pragma("unroll") for (int h_ = 0; h_ < 2; ++h_) dst[h_][i_] = rowtab[(ord) * 256 + h_ * 128 + R_] + (unsigned)C_ * 2u; } } } while (0)
#define PG8_STAGE_A(bufoff, base, h, use_next) do { if constexpr (GATHER) { unsigned vo_[2]; vo_[0] = (use_next) ? gN[h][0] : gC[h][0]; vo_[1] = (use_next) ? gN[h][1] : gC[h][1]; PG8_STAGE(bufoff, base, vo_); } \
        else { PG8_STAGE(bufoff, (base) + (h) * hstepA, voffA); } } while (0)
    const size_t kstep = (size_t)(BK * 2);
    const size_t hstepA = (size_t)HALF * g.lda * 2, hstepB = (size_t)HALF * K * 2;
    const unsigned ldsw = (unsigned)wid * 1024u;
    const int aoff = lds_byte(wr * 64 + fr, fq * 8), boff = lds_byte(wc * 32 + fr, fq * 8);
#define PG8_SA(b, h) (((b) * 2 + (h)) * HTB)
#define PG8_SB(b, h) ((4 + (b) * 2 + (h)) * HTB)
#define PG8_STAGE(bufoff, gbase, voff) do { _Pragma("unroll") for (int _i = 0; _i < 2; ++_i) \
        __builtin_amdgcn_global_load_lds((const unsigned*)((const char*)(gbase) + (voff)[_i]), (PG8_LAS unsigned*)(lds + (bufoff) + ldsw + _i * 8192), 16, 0, 0); } while (0)
#define PG8_LDA(dst, b, h) do { _Pragma("unroll") for (int m = 0; m < 4; ++m) _Pragma("unroll") for (int k = 0; k < 2; ++k) dst[m][k] = *(const PG8_LAS bf16x8*)(lds + PG8_SA(b, h) + aoff + m * 2048 + k * 1024); } while (0)
#define PG8_LDB(dst, b, h) do { _Pragma("unroll") for (int n = 0; n < 2; ++n) _Pragma("unroll") for (int k = 0; k < 2; ++k) dst[n][k] = *(const PG8_LAS bf16x8*)(lds + PG8_SB(b, h) + boff + n * 2048 + k * 1024); } while (0)
#define PG8_MMA(ai, bj, At, Bt) do { __builtin_amdgcn_s_setprio(1); _Pragma("unroll") for (int m = 0; m < 4; ++m) _Pragma("unroll") for (int n = 0; n < 2; ++n) _Pragma("unroll") for (int k = 0; k < 2; ++k) \
        acc[ai][bj][m][n] = __builtin_amdgcn_mfma_f32_16x16x32_bf16(Bt[n][k], At[m][k], acc[ai][bj][m][n], 0, 0, 0); __builtin_amdgcn_s_setprio(0); } while (0)
#define PG8_WAIT_V(n) asm volatile("s_waitcnt vmcnt(" #n ")" ::: "memory")
#define PG8_WAIT_L(n) asm volatile("s_waitcnt lgkmcnt(" #n ")" ::: "memory")
#define PG8_BAR __builtin_amdgcn_s_barrier()
#define PG8_SCHED __builtin_amdgcn_sched_barrier(0)
    Unit cur, nxt; int ui = 0;
    if (!S.next(0, cur)) return;
    f32x4 acc[2][2][4][2];
#pragma unroll
    for (int a = 0; a < 2; ++a)
#pragma unroll
        for (int b = 0; b < 2; ++b)
#pragma unroll
            for (int m = 0; m < 4; ++m)
#pragma unroll
                for (int n = 0; n < 2; ++n) acc[a][b][m][n] = (f32x4){0.f, 0.f, 0.f, 0.f};
    bf16x8 At[4][2], B0[2][2], B1[2][2];
    const char* cA = cur.a; const char* cB = cur.b;
    S.a_ready(cur);
    if constexpr (SP2) {
        PG8_GROWS(gC, 0);
        PG8_STAGE(PG8_SB(0, 0), cB, voffB); PG8_STAGE(PG8_SB(0, 1), cB + hstepB, voffB); PG8_STAGE_A(PG8_SA(0, 0), cA, 0, false); PG8_STAGE_A(PG8_SA(0, 1), cA, 1, false);
        if (wr == 1) PG8_BAR;
        PG8_WAIT_V(2); PG8_BAR;
        PG8_STAGE(PG8_SB(1, 0), cB + kstep, voffB); PG8_STAGE_A(PG8_SA(1, 0), cA + kstep, 0, false); PG8_STAGE(PG8_SB(1, 1), cB + hstepB + kstep, voffB);
        PG8_WAIT_V(6); PG8_BAR;
    } else {
        PG8_STAGE(PG8_SB(0, 0), cB, voffB); PG8_STAGE(PG8_SA(0, 0), cA, voffA); PG8_STAGE(PG8_SB(0, 1), cB + hstepB, voffB); PG8_STAGE(PG8_SA(0, 1), cA + hstepA, voffA);
        if (wr == 1) PG8_BAR;
        PG8_WAIT_V(4); PG8_BAR;
        PG8_STAGE(PG8_SB(1, 0), cB + kstep, voffB); PG8_STAGE(PG8_SA(1, 0), cA + kstep, voffA); PG8_STAGE(PG8_SB(1, 1), cB + hstepB + kstep, voffB);
        PG8_WAIT_V(6); PG8_BAR;
    }
    for (;;) {
        const bool has_next = S.next(ui + 1, nxt);
        const char* nA = has_next ? nxt.a : cA; const char* nB = has_next ? nxt.b : cB;
        for (int t = 0; t < nt; t += 2) {
            const bool last = (t == nt - 2);
            const char* a1 = cA + (size_t)(t + 1) * kstep;
            const char* a2 = last ? nA : cA + (size_t)(t + 2) * kstep; const char* b2 = last ? nB : cB + (size_t)(t + 2) * kstep;
            const char* a3 = a2 + kstep; const char* b3 = b2 + kstep;
            if (last && has_next) S.a_ready(nxt);
            if constexpr (GATHER) { if (last) { if (has_next) { PG8_GROWS(gN, ui + 1); } else { _Pragma("unroll") for (int h_ = 0; h_ < 2; ++h_) _Pragma("unroll") for (int i_ = 0; i_ < 2; ++i_) gN[h_][i_] = gC[h_][i_]; } } }
            if constexpr (SP2) {
            PG8_LDB(B0, 0, 0); PG8_LDB(B1, 0, 1); PG8_SCHED; PG8_LDA(At, 0, 0); PG8_STAGE_A(PG8_SA(1, 1), a1, 1, false);
            PG8_WAIT_V(8); PG8_WAIT_L(0); PG8_BAR; PG8_MMA(0, 0, At, B0); PG8_MMA(0, 1, At, B1); PG8_BAR; PG8_SCHED;
            PG8_LDA(At, 0, 1); PG8_STAGE(PG8_SB(0, 0), b2, voffB); PG8_STAGE(PG8_SB(0, 1), b2 + hstepB, voffB); PG8_STAGE_A(PG8_SA(0, 0), a2, 0, last);
            PG8_WAIT_V(8); PG8_WAIT_L(0); PG8_BAR; PG8_MMA(1, 0, At, B0); PG8_MMA(1, 1, At, B1); PG8_BAR; PG8_SCHED;
            PG8_LDB(B0, 1, 0); PG8_LDB(B1, 1, 1); PG8_SCHED; PG8_LDA(At, 1, 0); PG8_STAGE_A(PG8_SA(0, 1), a2, 1, last);
            PG8_WAIT_V(8); PG8_WAIT_L(0); PG8_BAR; PG8_MMA(0, 0, At, B0); PG8_MMA(0, 1, At, B1); PG8_BAR; PG8_SCHED;
            PG8_LDA(At, 1, 1); PG8_STAGE(PG8_SB(1, 0), b3, voffB); PG8_STAGE(PG8_SB(1, 1), b3 + hstepB, voffB); PG8_STAGE_A(PG8_SA(1, 0), a3, 0, last);
            PG8_WAIT_V(8); PG8_WAIT_L(0); PG8_BAR; PG8_MMA(1, 0, At, B0); PG8_MMA(1, 1, At, B1); PG8_BAR; PG8_SCHED;
            } else {
            PG8_LDB(B0, 0, 0); PG8_SCHED; PG8_LDA(At, 0, 0); PG8_STAGE(PG8_SA(1, 1), a1 + hstepA, voffA);
            PG8_WAIT_L(8); PG8_BAR; PG8_WAIT_L(0); PG8_MMA(0, 0, At, B0); PG8_BAR; PG8_SCHED;
            PG8_LDB(B1, 0, 1); PG8_STAGE(PG8_SB(0, 0), b2, voffB);
            PG8_BAR; PG8_WAIT_L(0); PG8_MMA(0, 1, At, B1); PG8_BAR;
            PG8_LDA(At, 0, 1); PG8_STAGE(PG8_SA(0, 0), a2, voffA);
            PG8_BAR; PG8_WAIT_L(0); PG8_MMA(1, 0, At, B0); PG8_BAR; PG8_SCHED;
            PG8_STAGE(PG8_SB(0, 1), b2 + hstepB, voffB);
            PG8_WAIT_V(6); PG8_BAR; PG8_MMA(1, 1, At, B1); PG8_BAR;
            PG8_LDB(B0, 1, 0); PG8_SCHED; PG8_LDA(At, 1, 0); PG8_STAGE(PG8_SA(0, 1), a2 + hstepA, voffA);
            PG8_WAIT_L(8); PG8_BAR; PG8_WAIT_L(0); PG8_MMA(0, 0, At, B0); PG8_BAR; PG8_SCHED;
            PG8_LDB(B1, 1, 1); PG8_STAGE(PG8_SB(1, 0), b3, voffB);
            PG8_BAR; PG8_WAIT_L(0); PG8_MMA(0, 1, At, B1); PG8_BAR;
            PG8_LDA(At, 1, 1); PG8_STAGE(PG8_SA(1, 0), a3, voffA);
            PG8_BAR; PG8_WAIT_L(0); PG8_MMA(1, 0, At, B0); PG8_BAR; PG8_SCHED;
            PG8_STAGE(PG8_SB(1, 1), b3 + hstepB, voffB);
            PG8_WAIT_V(6); PG8_BAR; PG8_MMA(1, 1, At, B1); PG8_BAR;
            }
        }
        if constexpr (ALIGN_EPI) { if (wr == 0) PG8_BAR; }
        if constexpr (!Epi::AFTER_DRAIN) { E(acc, cur, wr, wc, fr, fq); S.done(cur); }
        if (!has_next) break;
#pragma unroll
        for (int a = 0; a < 2; ++a)
#pragma unroll
            for (int b = 0; b < 2; ++b)
#pragma unroll
                for (int m = 0; m < 4; ++m)
#pragma unroll
                    for (int n = 0; n < 2; ++n) acc[a][b][m][n] = (f32x4){0.f, 0.f, 0.f, 0.f};
        cur = nxt; cA = nA; cB = nB; ++ui;
        if constexpr (GATHER) { _Pragma("unroll") for (int h_ = 0; h_ < 2; ++h_) _Pragma("unroll") for (int i_ = 0; i_ < 2; ++i_) gC[h_][i_] = gN[h_][i_]; }
        if constexpr (ALIGN_EPI) { if (wr == 1) PG8_BAR; }
    }
    PG8_WAIT_V(0);
    if constexpr (!ALIGN_EPI) { if (wr == 0) PG8_BAR; }
    PG8_BAR;
    if constexpr (Epi::AFTER_DRAIN) { E.fused(acc, cur, wr, wc, fr, fq, lds, wid, lane); S.done(cur); }
#undef PG8_SA
#undef PG8_GROWS
#undef PG8_STAGE_A
#undef PG8_SB
#undef PG8_STAGE
#undef PG8_LDA
#undef PG8_LDB
#undef PG8_MMA
#undef PG8_WAIT_V
#undef PG8_WAIT_L
#undef PG8_BAR
#undef PG8_SCHED
}
}

namespace att {
constexpr int NW = 8, QBLK = 32, KVBLK = 64;
constexpr float THR = 8.f;
#define ATT_SBAR() __builtin_amdgcn_sched_barrier(0)
__device__ __forceinline__ int crow(int r, int hi) { return (r & 3) + 8 * (r >> 2) + 4 * hi; }
template <int D> __device__ __forceinline__ int kswz(int row, int colB) { return D == 128 ? row * 256 + (colB ^ ((row & 7) << 4)) : row * 128 + (colB ^ (((row >> 1) & 7) << 4)); }
template <int DV> __device__ __forceinline__ int v_st(int k, int c) { const int kk = (k & ~0xC) | ((k & 4) << 1) | ((k & 8) >> 1); return ((kk >> 3) * (DV / 32) + (c >> 5)) * 512 + ((kk & 7) * 32 + (c & 31)) * 2; }
__device__ __forceinline__ int v_rd_base(int lane) { return ((lane & 3) << 3) | (((lane >> 2) & 3) << 6) | (((lane >> 4) & 1) << 5) | (((lane >> 5) & 1) << 8); }
template <int DV> constexpr int v_rd_off(int d0, int ks, int half) { return d0 * 512 + ks * (DV / 32) * 1024 + half * (DV / 32) * 512; }
template <int OFF> __device__ __forceinline__ s16x4 tr_read(int vb) { s16x4 r; asm volatile("ds_read_b64_tr_b16 %0, %1 offset:%2" : "=&v"(r) : "v"(vb), "i"(OFF) : "memory"); return r; }

__device__ __forceinline__ void partialSM(f32x16& p0, f32x16& p1, float& m_reg, float& mn, float& alpha) {
    float pmax = p0[0];
#pragma unroll
    for (int r = 1; r < 16; ++r) pmax = fmaxf(pmax, p0[r]);
#pragma unroll
    for (int r = 0; r < 16; ++r) pmax = fmaxf(pmax, p1[r]);
    { auto rr = __builtin_amdgcn_permlane32_swap(__float_as_uint(pmax), __float_as_uint(pmax), false, false); pmax = fmaxf(__uint_as_float(rr[0]), __uint_as_float(rr[1])); }
    if (__builtin_expect(__all(pmax - m_reg <= THR), 1)) { mn = m_reg; alpha = 1.f; }
    else { mn = fmaxf(m_reg, pmax); alpha = __builtin_amdgcn_exp2f(m_reg - mn); m_reg = mn; }
#pragma unroll
    for (int r = 0; r < 16; ++r) { p0[r] -= mn; p1[r] -= mn; }
#pragma unroll
    for (int r = 0; r < 16; ++r) p0[r] = __builtin_amdgcn_exp2f(p0[r]);
}
__device__ __forceinline__ void finishSM(f32x16& p0, f32x16& p1, float alpha, float& l_reg, bf16x8& pa0, bf16x8& pa1, bf16x8& pa2, bf16x8& pa3) {
#pragma unroll
    for (int r = 0; r < 16; ++r) p1[r] = __builtin_amdgcn_exp2f(p1[r]);
    float ps = 0;
#pragma unroll
    for (int r = 0; r < 16; ++r) ps += p0[r];
#pragma unroll
    for (int r = 0; r < 16; ++r) ps += p1[r];
    { auto rr = __builtin_amdgcn_permlane32_swap(__float_as_uint(ps), __float_as_uint(ps), false, false); ps = __uint_as_float(rr[0]) + __uint_as_float(rr[1]); }
    l_reg = l_reg * alpha + ps;
#define ATT_PK4(P, BASE, OUT) do { unsigned a0 = cvt_pk_bf16(P[BASE + 0], P[BASE + 1]), a1 = cvt_pk_bf16(P[BASE + 2], P[BASE + 3]);   \
    unsigned b0 = cvt_pk_bf16(P[BASE + 4], P[BASE + 5]), b1 = cvt_pk_bf16(P[BASE + 6], P[BASE + 7]);                              \
    auto r0 = __builtin_amdgcn_permlane32_swap(a0, b0, false, false); auto r1 = __builtin_amdgcn_permlane32_swap(a1, b1, false, false); \
    u32x4 w = {r0[0], r1[0], r0[1], r1[1]}; OUT = *reinterpret_cast<bf16x8*>(&w); } while (0)
    ATT_PK4(p0, 0, pa0); ATT_PK4(p0, 8, pa1); ATT_PK4(p1, 0, pa2); ATT_PK4(p1, 8, pa3);
#undef ATT_PK4
}
template <int DQK> __device__ __forceinline__ void qkt(f32x16& p0, f32x16& p1, const char* Ks, const bf16x8* qr, int r32, int hi) {
    p0 = f32x16{}; p1 = f32x16{};
#pragma unroll
    for (int d0 = 0; d0 < DQK / 16; ++d0) { const int cb = (d0 * 16 + hi * 8) * 2;
        const bf16x8 b0 = *reinterpret_cast<const bf16x8*>(Ks + kswz<DQK>(r32, cb));
        const bf16x8 b1 = *reinterpret_cast<const bf16x8*>(Ks + kswz<DQK>(32 + r32, cb));
        p0 = __builtin_amdgcn_mfma_f32_32x32x16_bf16(b0, qr[d0], p0, 0, 0, 0);
        p1 = __builtin_amdgcn_mfma_f32_32x32x16_bf16(b1, qr[d0], p1, 0, 0, 0); }
}
template <int DV, int D0> __device__ __forceinline__ void pv_one(f32x16& od, int vb, bf16x8 pa0, bf16x8 pa1, bf16x8 pa2, bf16x8 pa3) {
    const s16x4 l0 = tr_read<v_rd_off<DV>(D0, 0, 0)>(vb), h0 = tr_read<v_rd_off<DV>(D0, 0, 1)>(vb), l1 = tr_read<v_rd_off<DV>(D0, 1, 0)>(vb), h1 = tr_read<v_rd_off<DV>(D0, 1, 1)>(vb);
    const s16x4 l2 = tr_read<v_rd_off<DV>(D0, 2, 0)>(vb), h2 = tr_read<v_rd_off<DV>(D0, 2, 1)>(vb), l3 = tr_read<v_rd_off<DV>(D0, 3, 0)>(vb), h3 = tr_read<v_rd_off<DV>(D0, 3, 1)>(vb);
    asm volatile("s_waitcnt lgkmcnt(0)" ::: "memory"); ATT_SBAR();
#define ATT_PK(L, H) (bf16x8){L[0], L[1], L[2], L[3], H[0], H[1], H[2], H[3]}
    od = __builtin_amdgcn_mfma_f32_32x32x16_bf16(pa0, ATT_PK(l0, h0), od, 0, 0, 0);
    od = __builtin_amdgcn_mfma_f32_32x32x16_bf16(pa1, ATT_PK(l1, h1), od, 0, 0, 0);
    od = __builtin_amdgcn_mfma_f32_32x32x16_bf16(pa2, ATT_PK(l2, h2), od, 0, 0, 0);
    od = __builtin_amdgcn_mfma_f32_32x32x16_bf16(pa3, ATT_PK(l3, h3), od, 0, 0, 0);
#undef ATT_PK
}
template <int DV> __device__ __forceinline__ void pv_all(f32x16 (&o)[DV / 32], int vb, bf16x8 pa0, bf16x8 pa1, bf16x8 pa2, bf16x8 pa3) {
    pv_one<DV, 0>(o[0], vb, pa0, pa1, pa2, pa3); pv_one<DV, 1>(o[1], vb, pa0, pa1, pa2, pa3);
    if constexpr (DV == 128) { pv_one<DV, 2>(o[2], vb, pa0, pa1, pa2, pa3); pv_one<DV, 3>(o[3], vb, pa0, pa1, pa2, pa3); }
}
template <int DQK, int DV> struct Lay { static constexpr int SHM_V = 64 * DV * 2, SHM_K = 64 * DQK * 2, OFF_V = 0, OFF_K = 2 * SHM_V, OFF_WS = OFF_K + 2 * SHM_K, OFF_STASH = OFF_WS + NW * 64 * 4; };

template <int DQK, int DV, int LDQ, int LDK, int LDV>
__device__ __forceinline__ void attn_pass(const bf16_t* __restrict__ Qb, const bf16_t* __restrict__ Kh, const bf16_t* __restrict__ Vh, int nkeys, char* lds, f32x16 (&o)[DV / 32], float (&rli)[16], int wv) {
    using L = Lay<DQK, DV>;
    constexpr int NLK = DQK / 64, NLV = DV / 64;
    int tid_ = wv * 64 + lane_id(); asm volatile("" : "+v"(tid_));
    const int tid = tid_, wid = tid >> 6, lane = tid & 63, r32 = lane & 31, hi = lane >> 5;
    char* V_lds = lds + L::OFF_V; char* K_lds = lds + L::OFF_K;
    float* ws = (float*)(lds + L::OFF_WS) + wid * 64; float* li_l = ws; float* al_l = ws + 32;
    float m_reg = -1e30f, l_reg = 0.f; bf16x8 qr[DQK / 16];
#pragma unroll
    for (int d = 0; d < DV / 32; ++d) o[d] = f32x16{};
    const bf16_t* Qw = Qb + (size_t)(wid * QBLK + r32) * LDQ + hi * 8;
#pragma unroll
    for (int d0 = 0; d0 < DQK / 16; ++d0) qr[d0] = *reinterpret_cast<const bf16x8*>(Qw + d0 * 16);
    const int krow = DQK == 128 ? (tid >> 4) : (tid >> 3), kcol = DQK == 128 ? (tid & 15) * 8 : (tid & 7) * 8;
    const int vrow = DV == 128 ? (tid >> 4) : (tid >> 3), vcol = DV == 128 ? (tid & 15) * 8 : (tid & 7) * 8;
    const int vb0 = (int)(uintptr_t)V_lds + v_rd_base(lane);
    bf16x8 vsE[NLV], ksE[NLK], vsO[NLV], ksO[NLK];
#define ATT_SLOAD(VS, KS, k0) do { _Pragma("unroll") for (int i_ = 0; i_ < NLV; ++i_) VS[i_] = *reinterpret_cast<const bf16x8*>(&Vh[(size_t)((k0) + vrow + 32 * i_) * LDV + vcol]); \
    _Pragma("unroll") for (int i_ = 0; i_ < NLK; ++i_) KS[i_] = *reinterpret_cast<const bf16x8*>(&Kh[(size_t)((k0) + krow + 32 * i_) * LDK + kcol]); } while (0)
#define ATT_SWRITE(b, VS, KS) do { _Pragma("unroll") for (int i_ = 0; i_ < NLV; ++i_) *(bf16x8*)(V_lds + (b) * L::SHM_V + v_st<DV>(vrow + 32 * i_, vcol)) = VS[i_]; \
    _Pragma("unroll") for (int i_ = 0; i_ < NLK; ++i_) *(bf16x8*)(K_lds + (b) * L::SHM_K + kswz<DQK>(krow + 32 * i_, kcol * 2)) = KS[i_]; } while (0)
#define ATT_SWAIT() do { if constexpr (NLK + NLV == 4) asm volatile("s_waitcnt vmcnt(4)" ::: "memory"); else if constexpr (NLK + NLV == 3) asm volatile("s_waitcnt vmcnt(3)" ::: "memory"); else asm volatile("s_waitcnt vmcnt(2)" ::: "memory"); } while (0)
#define ATT_RESC(a) do { if (__any((a) < 1.f)) { if (hi == 0) al_l[r32] = (a); asm volatile("s_waitcnt lgkmcnt(0)" ::: "memory"); \
    _Pragma("unroll") for (int d = 0; d < DV / 32; ++d) _Pragma("unroll") for (int r = 0; r < 16; ++r) o[d][r] *= al_l[crow(r, hi)]; } } while (0)
    f32x16 pA0, pA1, pB0, pB1; float mnA, mnB, alA, alB; bf16x8 pa0, pa1, pa2, pa3; const int NT = nkeys / KVBLK;
    __syncthreads();
    ATT_SLOAD(vsE, ksE, 0); asm volatile("s_waitcnt vmcnt(0)" ::: "memory"); ATT_SWRITE(0, vsE, ksE); __syncthreads();
    qkt<DQK>(pA0, pA1, K_lds, qr, r32, hi); partialSM(pA0, pA1, m_reg, mnA, alA);
    ATT_SLOAD(vsO, ksO, KVBLK); if (2 < NT) ATT_SLOAD(vsE, ksE, 2 * KVBLK);
    ATT_SWAIT(); ATT_SWRITE(1, vsO, ksO); __syncthreads();
    for (int j = 1; j + 1 < NT; j += 2) {
        ATT_SBAR(); qkt<DQK>(pB0, pB1, K_lds + L::SHM_K, qr, r32, hi);
        finishSM(pA0, pA1, alA, l_reg, pa0, pa1, pa2, pa3); ATT_SBAR();
        ATT_SLOAD(vsO, ksO, (j + 2) * KVBLK); ATT_SBAR();
        pv_all<DV>(o, vb0, pa0, pa1, pa2, pa3); partialSM(pB0, pB1, m_reg, mnB, alB);
        __syncthreads(); ATT_SWAIT(); ATT_SWRITE(0, vsE, ksE);
        ATT_RESC(alB); __syncthreads();
        ATT_SBAR(); qkt<DQK>(pA0, pA1, K_lds, qr, r32, hi);
        finishSM(pB0, pB1, alB, l_reg, pa0, pa1, pa2, pa3); ATT_SBAR();
        if (j + 3 < NT) ATT_SLOAD(vsE, ksE, (j + 3) * KVBLK); ATT_SBAR();
        pv_all<DV>(o, vb0 + L::SHM_V, pa0, pa1, pa2, pa3); partialSM(pA0, pA1, m_reg, mnA, alA);
        __syncthreads(); ATT_SWAIT(); ATT_SWRITE(1, vsO, ksO);
        ATT_RESC(alA); __syncthreads();
    }
    ATT_SBAR(); qkt<DQK>(pB0, pB1, K_lds + L::SHM_K, qr, r32, hi);
    finishSM(pA0, pA1, alA, l_reg, pa0, pa1, pa2, pa3); ATT_SBAR();
    pv_all<DV>(o, vb0, pa0, pa1, pa2, pa3); partialSM(pB0, pB1, m_reg, mnB, alB);
    __syncthreads(); ATT_RESC(alB);
    finishSM(pB0, pB1, alB, l_reg, pa0, pa1, pa2, pa3); ATT_SBAR();
    pv_all<DV>(o, vb0 + L::SHM_V, pa0, pa1, pa2, pa3);
    if (hi == 0) li_l[r32] = l_reg; asm volatile("s_waitcnt lgkmcnt(0)" ::: "memory");
#pragma unroll
    for (int r = 0; r < 16; ++r) rli[r] = __builtin_amdgcn_rcpf(li_l[crow(r, hi)]);
#undef ATT_SLOAD
#undef ATT_SWRITE
#undef ATT_SWAIT
#undef ATT_RESC
}
template <int DV, int LDO> __device__ __forceinline__ void store_o(bf16_t* Ob, const f32x16 (&o)[DV / 32], const float (&rli)[16], int wv) {
    int tid_ = wv * 64 + lane_id(); asm volatile("" : "+v"(tid_));
    const int tid = tid_, wid = tid >> 6, lane = tid & 63, r32 = lane & 31, hi = lane >> 5;
    bf16_t* Ow = Ob + (size_t)(wid * QBLK) * LDO;
#pragma unroll
    for (int r = 0; r < 16; ++r) { const int orow = crow(r, hi);
#pragma unroll
        for (int d0 = 0; d0 < DV / 32; ++d0) Ow[(size_t)orow * LDO + d0 * 32 + r32] = f2bf(o[d0][r] * rli[r]); }
}
__device__ __forceinline__ void unit_a(const bf16_t* PROJ, bf16_t* OBR, int b, int h, int qb, float lam, float lam_init, const float* subg, char* lds, int wv) {
    using L = Lay<64, 128>;
    int tid_ = wv * 64 + lane_id(); asm volatile("" : "+v"(tid_));
    const int tid = tid_, wid = tid >> 6, lane = tid & 63, r32 = lane & 31, hi = lane >> 5;
    const bf16_t* kv = PROJ + (size_t)b * SEQ * D_IN; const size_t qrow = (size_t)b * SEQ + qb * 256;
    unsigned* stash = (unsigned*)(lds + L::OFF_STASH) + wid * 2048 + lane;
    f32x16 o[4]; float rli[16];
#pragma unroll 1
    for (int c = 0; c < 2; ++c) {
        attn_pass<64, 128, D_IN, D_IN, D_IN>(PROJ + qrow * D_IN + C_AQ + h * 128 + c * 64, kv + C_AK + h * 128 + c * 64, kv + C_AV + h * 128, SEQ, lds, o, rli, wv);
        if (c == 0) {
#pragma unroll
            for (int d0 = 0; d0 < 4; ++d0)
#pragma unroll
                for (int r = 0; r < 16; r += 2) stash[(d0 * 8 + (r >> 1)) * 64] = cvt_pk_bf16(o[d0][r] * rli[r], o[d0][r + 1] * rli[r + 1]);
        }
    }
    asm volatile("s_waitcnt lgkmcnt(0)" ::: "memory");
    float ss[16];
#pragma unroll
    for (int r = 0; r < 16; ++r) ss[r] = 0.f;
#pragma unroll
    for (int d0 = 0; d0 < 4; ++d0)
#pragma unroll
        for (int r = 0; r < 16; r += 2) { const unsigned w = stash[(d0 * 8 + (r >> 1)) * 64];
            const float c0 = __uint_as_float(w << 16) - lam * o[d0][r] * rli[r], c1 = __uint_as_float(w & 0xffff0000u) - lam * o[d0][r + 1] * rli[r + 1];
            o[d0][r] = c0; o[d0][r + 1] = c1; ss[r] += c0 * c0; ss[r + 1] += c1 * c1; }
#pragma unroll
    for (int r = 0; r < 16; ++r) { float s = ss[r]; s += __shfl_xor(s, 1); s += __shfl_xor(s, 2); s += __shfl_xor(s, 4); s += __shfl_xor(s, 8); s += __shfl_xor(s, 16);
        ss[r] = rsqrtf(s * (1.f / 128.f) + EPS) * (1.f - lam_init); }
    bf16_t* Ow = OBR + (qrow + wid * QBLK) * OBR_W + h * 128;
#pragma unroll
    for (int d0 = 0; d0 < 4; ++d0) { const float g = subg[d0 * 32 + r32];
#pragma unroll
        for (int r = 0; r < 16; ++r) Ow[(size_t)crow(r, hi) * OBR_W + d0 * 32 + r32] = f2bf(o[d0][r] * ss[r] * g); }
}
__device__ __forceinline__ void unit_b(const bf16_t* PROJ, bf16_t* OBR, int b, int qh, int qb, char* lds, int wv) {
    const bf16_t* kv = PROJ + (size_t)b * SEQ * D_IN; const size_t qrow = (size_t)b * SEQ + qb * 256;
    f32x16 o[2]; float rli[16];
    attn_pass<64, 64, D_IN, D_IN, D_IN>(PROJ + qrow * D_IN + C_BQ + qh * 64, kv + C_BK + (qh >> 2) * 64, kv + C_BV + (qh >> 2) * 64, SEQ, lds, o, rli, wv);
    store_o<64, OBR_W>(OBR + qrow * OBR_W + 512 + qh * 64, o, rli, wv);
}
__device__ __forceinline__ void unit_c(const bf16_t* PROJ, const bf16_t* MEMKV, bf16_t* OBR, int b, int h, int qb, char* lds, int wv) {
    const bf16_t* kv = MEMKV + (size_t)b * MEM_LEN * 1024; const size_t qrow = (size_t)b * SEQ + qb * 256;
    f32x16 o[4]; float rli[16];
    attn_pass<128, 128, D_IN, 1024, 1024>(PROJ + qrow * D_IN + C_CQ + h * 128, kv + h * 128, kv + 512 + h * 128, MEM_LEN, lds, o, rli, wv);
    store_o<128, OBR_W>(OBR + qrow * OBR_W + 1024 + h * 128, o, rli, wv);
}
#undef ATT_SBAR
}

__device__ __forceinline__ void row_rmsnorm(const float* __restrict__ xrow, const float* __restrict__ g, bf16_t* __restrict__ orow, float* __restrict__ xcopy, int lane) {
    const f32x4* xr = (const f32x4*)xrow; f32x4 v[4]; float s = 0.f;
#pragma unroll
    for (int j = 0; j < 4; ++j) { v[j] = xr[lane + 64 * j]; s += v[j].x * v[j].x + v[j].y * v[j].y + v[j].z * v[j].z + v[j].w * v[j].w; }
    const float rs = rsqrtf(wave_sum(s) * (1.f / DM) + EPS);
#pragma unroll
    for (int j = 0; j < 4; ++j) { const f32x4 gg = ((const f32x4*)g)[lane + 64 * j];
        if (xcopy) ((f32x4*)xcopy)[lane + 64 * j] = v[j];
        u32x2 o; o.x = cvt_pk_bf16(v[j].x * rs * gg.x, v[j].y * rs * gg.y); o.y = cvt_pk_bf16(v[j].z * rs * gg.z, v[j].w * rs * gg.w);
        ((u32x2*)orow)[lane + 64 * j] = o; }
}
__device__ __forceinline__ void route_block(const float* __restrict__ X, const bf16_t* __restrict__ rt_tab, const float* __restrict__ brg, const float* __restrict__ bre, int* __restrict__ experts, float* __restrict__ weights,
                                            int* __restrict__ rank, unsigned* __restrict__ cnt, float* __restrict__ rstd, int* __restrict__ list, const float* __restrict__ g2, bf16_t* __restrict__ H2, int rb, const bf16x8 (&Bh)[3][4], const bf16x8 (&Bl)[3][4], LAS float* slab, int tid, int wave) {
    const int lane = tid & 63, r = lane & 15, kq = lane >> 4;
    LAS float* ssq = slab + 8 * 64 * 48; LAS float* rs_l = ssq + 8 * 64;
#pragma unroll 1
    for (int rt = 0; rt < 4; ++rt) {
        const float* xp = X + (size_t)(rb * 64 + rt * 16 + r) * DM + 128 * wave + 8 * kq;
        f32x4 acc[3]; float ss = 0.f;
#pragma unroll
        for (int t = 0; t < 3; ++t) acc[t] = (f32x4){0.f, 0.f, 0.f, 0.f};
#pragma unroll
        for (int sI = 0; sI < 4; ++sI) {
            const f32x4 a0 = *(const f32x4*)(xp + 32 * sI), a1 = *(const f32x4*)(xp + 32 * sI + 4);
            ss += (a0[0] * a0[0] + a0[1] * a0[1]) + (a0[2] * a0[2] + a0[3] * a0[3]) + (a1[0] * a1[0] + a1[1] * a1[1]) + (a1[2] * a1[2] + a1[3] * a1[3]);
            u32x4 hw, lw;
            hw.x = cvt_pk_bf16(a0[0], a0[1]); hw.y = cvt_pk_bf16(a0[2], a0[3]); hw.z = cvt_pk_bf16(a1[0], a1[1]); hw.w = cvt_pk_bf16(a1[2], a1[3]);
            lw.x = cvt_pk_bf16(a0[0] - __uint_as_float(hw.x << 16), a0[1] - __uint_as_float(hw.x & 0xffff0000u)); lw.y = cvt_pk_bf16(a0[2] - __uint_as_float(hw.y << 16), a0[3] - __uint_as_float(hw.y & 0xffff0000u));
            lw.z = cvt_pk_bf16(a1[0] - __uint_as_float(hw.z << 16), a1[1] - __uint_as_float(hw.z & 0xffff0000u)); lw.w = cvt_pk_bf16(a1[2] - __uint_as_float(hw.w << 16), a1[3] - __uint_as_float(hw.w & 0xffff0000u));
            const bf16x8 Ah = __builtin_bit_cast(bf16x8, hw), Al = __builtin_bit_cast(bf16x8, lw);
#pragma unroll
            for (int t = 0; t < 3; ++t) {
                acc[t] = __builtin_amdgcn_mfma_f32_16x16x32_bf16(Ah, Bh[t][sI], acc[t], 0, 0, 0);
                acc[t] = __builtin_amdgcn_mfma_f32_16x16x32_bf16(Al, Bh[t][sI], acc[t], 0, 0, 0);
                acc[t] = __builtin_amdgcn_mfma_f32_16x16x32_bf16(Ah, Bl[t][sI], acc[t], 0, 0, 0);
            }
        }
        ss += __shfl_xor(ss, 16); ss += __shfl_xor(ss, 32);
        if (kq == 0) ssq[wave * 64 + rt * 16 + r] = ss;
#pragma unroll
        for (int t = 0; t < 3; ++t)
#pragma unroll
            for (int e = 0; e < 4; ++e) slab[(wave * 64 + rt * 16 + 4 * kq + e) * 48 + 16 * t + r] = acc[t][e];
    }
    __syncthreads();
    if (tid < 64) {
        const int row = rb * 64 + tid;
        float lg[36]; float ss = 0.f;
#pragma unroll
        for (int c = 0; c < 36; ++c) lg[c] = 0.f;
#pragma unroll 1
        for (int w = 0; w < 8; ++w) { ss += ssq[w * 64 + tid];
#pragma unroll
            for (int c = 0; c < 36; ++c) lg[c] += slab[(w * 64 + tid) * 48 + c]; }
        const float rs = rsqrtf(ss * (1.f / DM) + EPS);
        rstd[row] = rs;
        int gi = 0; float gm = lg[0] * rs + brg[0];
#pragma unroll
        for (int i = 1; i < 4; ++i) { const float l = lg[i] * rs + brg[i]; if (l > gm) { gm = l; gi = i; } }
        float gs = 0.f;
#pragma unroll
        for (int i = 0; i < 4; ++i) gs += __expf(lg[i] * rs + brg[i] - gm);
        const float gp = 1.f / gs;
        float el[8];
#pragma unroll
        for (int i = 0; i < 8; ++i) el[i] = 0.f;
#pragma unroll
        for (int gq = 0; gq < 4; ++gq) if (gq == gi) {
#pragma unroll
            for (int i = 0; i < 8; ++i) el[i] = lg[4 + gq * 8 + i] * rs + bre[gq * 8 + i]; }
        int i0 = 0; float l0 = el[0];
#pragma unroll
        for (int i = 1; i < 8; ++i) if (el[i] > l0) { l0 = el[i]; i0 = i; }
        int i1 = -1; float l1 = -INFINITY;
#pragma unroll
        for (int i = 0; i < 8; ++i) if (i != i0 && el[i] > l1) { l1 = el[i]; i1 = i; }
        const float p1 = __expf(l1 - l0), inv = 1.f / (1.f + p1);
        const int e0 = gi * 8 + i0, e1 = gi * 8 + i1;
        experts[row * 2] = e0; experts[row * 2 + 1] = e1;
        weights[row * 2] = gp * inv; weights[row * 2 + 1] = gp * p1 * inv;
        LAS unsigned* lc = (LAS unsigned*)(rs_l + 64); LAS unsigned* gb = lc + 32;
        if (tid < 32) lc[tid] = 0u;
        asm volatile("s_waitcnt lgkmcnt(0)" ::: "memory");
        unsigned q0, q1; const unsigned one = 1u, a0_ = (unsigned)(uintptr_t)(lc + e0), a1_ = (unsigned)(uintptr_t)(lc + e1);
        asm volatile("ds_add_rtn_u32 %0, %1, %2\n\ts_waitcnt lgkmcnt(0)" : "=v"(q0) : "v"(a0_), "v"(one) : "memory");
        asm volatile("ds_add_rtn_u32 %0, %1, %2\n\ts_waitcnt lgkmcnt(0)" : "=v"(q1) : "v"(a1_), "v"(one) : "memory");
        if (tid < 32) { const unsigned n = lc[tid]; gb[tid] = n ? atomicAdd(cnt + 64 * tid, n) : 0u; }
        const int r0 = (int)(gb[e0] + q0), r1 = (int)(gb[e1] + q1);
        rank[row * 2] = r0; rank[row * 2 + 1] = r1;
        list[e0 * LCAP + r0] = row * 2; list[e1 * LCAP + r1] = row * 2 + 1;
        rs_l[tid] = rs;
    }
    __syncthreads();
#pragma unroll 1
    for (int rr = 0; rr < 8; ++rr) {
        const int row = rb * 64 + wave * 8 + rr; const float rs = rs_l[wave * 8 + rr];
        const f32x4* xr = (const f32x4*)(X + (size_t)row * DM); u32x2* dst = (u32x2*)(H2 + (size_t)row * DM);
#pragma unroll
        for (int j = 0; j < 4; ++j) { const f32x4 v = xr[lane + 64 * j], gg = ((const f32x4*)g2)[lane + 64 * j];
            u32x2 o; o.x = cvt_pk_bf16(v.x * rs * gg.x, v.y * rs * gg.y); o.y = cvt_pk_bf16(v.z * rs * gg.z, v.w * rs * gg.w); dst[lane + 64 * j] = o; }
    }
    __syncthreads();
}
__device__ __forceinline__ void moe_tables(const unsigned* cnt, volatile LAS int* mt, int tid) {
    if (tid == 0) { int off = 0, nt = 0;
#pragma unroll 1
        for (int e = 0; e < NEXP; ++e) { const int c = (int)__hip_atomic_load(cnt + 64 * e, __ATOMIC_RELAXED, __HIP_MEMORY_SCOPE_AGENT), t = (c + MOE_TILE - 1) / MOE_TILE;
            mt[e] = off; mt[32 + e] = c; mt[64 + e] = nt;
#pragma unroll 1
            for (int i = 0; i < t; ++i) mt[96 + nt + i] = e;
            nt += t; off += t * MOE_TILE; }
        mt[256] = nt; }
    __syncthreads();
}
__device__ __forceinline__ void moe_rowtabs(volatile LAS int* mt, const int* __restrict__ list, const float* __restrict__ weights, LAS unsigned* rowtab, LAS float* wtab, int bx, int G, int tid, int up) {
    const int ntiles = mt[256], rem = (ntiles * 4) % G;
#pragma unroll 1
    for (int i = 0; i < 4; ++i) { const long L = up ? (long)i * G + bx : (long)pg8::moe_down_unit(bx, i, rem, G); if (L >= (long)ntiles * 4) break;
        if (tid < 256) { const int tile = (int)(L >> 2), e = mt[96 + tile], q = (tile - mt[64 + e]) * 256 + tid; const bool valid = q < mt[32 + e];
            const int a = valid ? list[e * LCAP + q] : 0;
            if (up) rowtab[i * 256 + tid] = (unsigned)(a >> 1) * (unsigned)(DM * 2); else wtab[i * 256 + tid] = valid ? weights[a] : 0.f; } }
    __syncthreads();
}
__device__ __forceinline__ void row_combine_norm(float* __restrict__ X, const bf16_t* __restrict__ YB, const int* __restrict__ dest, const float* __restrict__ g, bf16_t* __restrict__ H, float* __restrict__ OUT, int row, int lane, bool poison, int d0, int d1) {
    f32x4* xr = (f32x4*)(X + (size_t)row * DM);
    f32x4 v[4]; float s = 0.f;
#pragma unroll
    for (int j = 0; j < 4; ++j) { v[j] = xr[lane + 64 * j];
        const u32x2 a = ((const u32x2*)(YB + (size_t)d0 * DM))[lane + 64 * j], b = ((const u32x2*)(YB + (size_t)d1 * DM))[lane + 64 * j];
        v[j].x += __uint_as_float(a.x << 16) + __uint_as_float(b.x << 16); v[j].y += __uint_as_float(a.x & 0xffff0000u) + __uint_as_float(b.x & 0xffff0000u);
        v[j].z += __uint_as_float(a.y << 16) + __uint_as_float(b.y << 16); v[j].w += __uint_as_float(a.y & 0xffff0000u) + __uint_as_float(b.y & 0xffff0000u);
        s += v[j].x * v[j].x + v[j].y * v[j].y + v[j].z * v[j].z + v[j].w * v[j].w; }
    float rs = rsqrtf(wave_sum(s) * (1.f / DM) + EPS);
    if (poison) rs = __builtin_nanf("");
#pragma unroll
    for (int j = 0; j < 4; ++j) { const f32x4 gg = ((const f32x4*)g)[lane + 64 * j];
        if (H) { xr[lane + 64 * j] = v[j];
            u32x2 o; o.x = cvt_pk_bf16(v[j].x * rs * gg.x, v[j].y * rs * gg.y); o.y = cvt_pk_bf16(v[j].z * rs * gg.z, v[j].w * rs * gg.w);
            ((u32x2*)(H + (size_t)row * DM))[lane + 64 * j] = o; }
        else { f32x4 o; o.x = v[j].x * rs * gg.x; o.y = v[j].y * rs * gg.y; o.z = v[j].z * rs * gg.z; o.w = v[j].w * rs * gg.w; ((f32x4*)(OUT + (size_t)row * DM))[lane + 64 * j] = o; }
    }
}
struct TrItem { const float* src; bf16_t* dst; int ldw, K; };
template <int OFF> __device__ __forceinline__ unsigned long long karg64() { unsigned long long v; asm volatile("s_load_dwordx2 %0, %1, %2\n\ts_waitcnt lgkmcnt(0)" : "=s"(v) : "s"(__builtin_amdgcn_kernarg_segment_ptr()), "n"(OFF)); return v; }
__device__ __forceinline__ unsigned long long karg64d(int off) { unsigned long long v; asm volatile("s_load_dwordx2 %0, %1, %2\n\ts_waitcnt lgkmcnt(0)" : "=s"(v) : "s"(__builtin_amdgcn_kernarg_segment_ptr()), "s"(off)); return v; }
#define TR_IN(k) ((const float*)karg64d(8 * (k)))
__device__ __forceinline__ void tr_decode(int it, int lane, bf16_t* WB, const float*& sp, int& ldw, bf16_t*& dp, int& K) {
    const float* src; int segA, segB, kb, tb, dk0 = 0; bf16_t* dst;
    if (it < 28800) {
        const int l = it / 14400; int r = it % 14400; bf16_t* WBl = WB + (size_t)l * WB_LAYER;
        if (r < 1472) { kb = r / 92; tb = r % 92; const int pn = tb >> 2, bj = (tb >> 1) & 1, w0 = 2 * (tb & 1); src = TR_IN(5) + (size_t)l * DM * D_IN; ldw = D_IN; K = DM; segA = 256 * pn + 64 * w0 + 32 * bj; segB = segA + 64; dst = WBl + WB_IN; }
        else if (r < 1856) { r -= 1472; const int i = r >> 7; r &= 127; kb = r >> 4; tb = r & 15; src = TR_IN(13 + i) + (size_t)l * 512 * DM; ldw = DM; K = 512; segA = 64 * tb; segB = segA + 32; dst = WBl + WB_UP + (size_t)i * 1024 * 512; }
        else if (r < 2112) { r -= 1856; kb = r >> 4; tb = r & 15; src = TR_IN(16) + (size_t)l * DM * DM; ldw = DM; K = DM; segA = 64 * tb; segB = segA + 32; dst = WBl + WB_OUT; }
        else if (r < 10304) { r -= 2112; const int e = r >> 8; r &= 255; kb = r >> 4; tb = r & 15; const int pn = tb >> 2, sg = (tb >> 1) & 1, jb = tb & 1;
            src = TR_IN(sg ? 23 : 22) + (size_t)(l * NEXP + e) * DM * DEXP; ldw = DEXP; K = DM; segA = 128 * pn + 64 * jb; segB = segA + 32; dst = WBl + WB_GU + (size_t)e * 1024 * 1024; }
        else { r -= 10304; const int e = r >> 7; r &= 127; kb = r >> 4; tb = r & 15; src = TR_IN(24) + (size_t)(l * NEXP + e) * DEXP * DM; ldw = DM; K = DEXP; segA = 64 * tb; segB = segA + 32; dst = WBl + WB_DN + (size_t)e * 1024 * 512; }
    } else { const int r = it - 28800; kb = r >> 4; tb = r & 15; const int pn = tb >> 2, bj = (tb >> 1) & 1, w0 = 2 * (tb & 1); src = TR_IN(3); ldw = 1024; K = DM; segA = 256 * pn + 64 * w0 + 32 * bj; segB = segA + 64; dst = WB + WB_MEMKV; }
    const int q = lane & 15;
    sp = src + (size_t)(kb * 64 + (lane >> 4)) * ldw + (q < 8 ? segA + 4 * q : segB + 4 * (q - 8));
    dp = dst + (size_t)(64 * tb + (lane >> 3)) * K + dk0 + kb * 64 + 8 * (lane & 7);
}
__device__ __forceinline__ void tr_load(f32x4 (&v)[16], const float* sp, int ldw) {
#pragma unroll
    for (int i = 0; i < 16; ++i) v[i] = *(const f32x4*)(sp + (size_t)(4 * i) * ldw);
}
__device__ __forceinline__ void tr_store(const f32x4 (&v)[16], bf16_t* dp, int K, LAS float* scr, int lane) {
    const int q = lane & 15, kq = lane >> 4;
#pragma unroll
    for (int i = 0; i < 16; ++i) { LAS float* w = scr + (4 * i + kq) * 65 + 4 * q; w[0] = v[i][0]; w[1] = v[i][1]; w[2] = v[i][2]; w[3] = v[i][3]; }
    asm volatile("s_waitcnt lgkmcnt(0)" ::: "memory");
    const int c = lane & 7, n8 = lane >> 3;
#pragma unroll
    for (int j = 0; j < 8; ++j) { const LAS float* sI = scr + (8 * c) * 65 + n8 + 8 * j;
        u32x4 o; o.x = cvt_pk_bf16(sI[0 * 65], sI[1 * 65]); o.y = cvt_pk_bf16(sI[2 * 65], sI[3 * 65]); o.z = cvt_pk_bf16(sI[4 * 65], sI[5 * 65]); o.w = cvt_pk_bf16(sI[6 * 65], sI[7 * 65]);
        *(u32x4*)(dp + (size_t)(8 * j) * K) = o; }
    asm volatile("s_waitcnt lgkmcnt(0)" ::: "memory");
}

#define XB_TMO      128
#define XB_XCNT(j)  (256  + 64 * (j))
#define XB_XSUB(j)  (1280 + 64 * (j))
#define XB_XGEN(j)  (2304 + 64 * (j))
#define XB_TOP      3328
#define XB_TOPGEN   3392
#define XCD_BAR_WORDS 3456
#define XB_SPIN_CAP (1u << 18)

__device__ __forceinline__ unsigned xb_ld(unsigned* p)              { return __hip_atomic_load(p, __ATOMIC_RELAXED, __HIP_MEMORY_SCOPE_AGENT); }
__device__ __forceinline__ unsigned xb_add(unsigned* p, unsigned v) { return __hip_atomic_fetch_add(p, v, __ATOMIC_RELAXED, __HIP_MEMORY_SCOPE_AGENT); }
__device__ __forceinline__ unsigned xb_xcc_id() { return (unsigned)__builtin_amdgcn_s_getreg((3 << 11) | 20) & 0xFu; }
#define XB_SPIN(cond, bar) do { unsigned _sp = 0; while (cond) { __builtin_amdgcn_s_sleep(1); \
    if ((++_sp & 255u) == 0u) { if (xb_ld(&(bar)[XB_TMO])) break; if (_sp > XB_SPIN_CAP) { atomicAdd(&(bar)[XB_TMO], 1u); break; } } } } while (0)

struct XcdBarrier {
    unsigned* bar; unsigned x; unsigned w0;
    volatile LAS unsigned* st;
};

__device__ __forceinline__ XcdBarrier xcd_barrier_post(unsigned* bar, volatile LAS unsigned* st, unsigned is_wave0) {
    XcdBarrier b; b.bar = bar; b.x = xb_xcc_id(); b.st = st; b.w0 = is_wave0;
    if (is_wave0 && lane_id() == 0) (void)xb_add(&bar[XB_XCNT(b.x)], 1u);
    return b;
}
__device__ __forceinline__ void xcd_barrier_complete(unsigned* bar, unsigned x, unsigned& nloc, unsigned& nx) {
    const unsigned G = gridDim.x * gridDim.y * gridDim.z;
    unsigned sum, cnt, mine, sp = 0u;
    for (;;) {
        sum = 0u; cnt = 0u; mine = 0u;
#pragma unroll
        for (unsigned j = 0; j < 16; ++j) { const unsigned c = xb_ld(&bar[XB_XCNT(j)]); sum += c; cnt += (c > 0u) ? 1u : 0u; mine = (j == x) ? c : mine; }
        if (sum == G) break;
        __builtin_amdgcn_s_sleep(1);
        if ((++sp & 255u) == 0u) { if (xb_ld(&bar[XB_TMO])) break; if (sp > XB_SPIN_CAP) { atomicAdd(&bar[XB_TMO], 1u); break; } }
    }
    nloc = mine > 0u ? mine : 1u; nx = cnt > 0u ? cnt : 1u;
}

__device__ __forceinline__ void xcd_barrier(const XcdBarrier& b) {
    asm volatile("s_waitcnt vmcnt(0)" ::: "memory");
    __syncthreads();
    if (b.w0 && lane_id() == 0) {
        unsigned* bar = b.bar;
        __builtin_amdgcn_s_waitcnt(0);
        unsigned nloc = b.st[0], nx = b.st[1];
        if (nloc == 0u) { xcd_barrier_complete(bar, b.x, nloc, nx); b.st[0] = nloc; b.st[1] = nx; }
        const unsigned old = xb_add(&bar[XB_XSUB(b.x)], 1u);
        const unsigned gen = old / nloc;
        if (old + 1u == (gen + 1u) * nloc) {
            __builtin_amdgcn_fence(__ATOMIC_RELEASE, "agent");
            asm volatile("s_waitcnt vmcnt(0)" ::: "memory");
            const unsigned og = xb_add(&bar[XB_TOP], 1u);
            const unsigned tg = og / nx;
            if (og + 1u == (tg + 1u) * nx) xb_add(&bar[XB_TOPGEN], 1u);
            else XB_SPIN(xb_ld(&bar[XB_TOPGEN]) == tg, bar);
            __builtin_amdgcn_fence(__ATOMIC_ACQUIRE, "agent");
            xb_add(&bar[XB_XGEN(b.x)], 1u);
            asm volatile("s_waitcnt vmcnt(0)" ::: "memory");
        } else {
            XB_SPIN(xb_ld(&bar[XB_XGEN(b.x)]) == gen, bar);
            __builtin_amdgcn_fence(__ATOMIC_ACQUIRE, "agent");
            asm volatile("s_waitcnt vmcnt(0)" ::: "memory");
        }
    }
    __syncthreads();
}
constexpr int NWAVES = 8;
constexpr int RING_BYTES = 131072, LDSCTL_OFF = 135168, LDS_BYTES = 147456;
constexpr int CW_BAR = 4096, BAR_REGION = 4096;
static_assert(XCD_BAR_WORDS <= BAR_REGION && (CW_BAR + (N_PHASES + 1) * BAR_REGION) * 4 <= (int)MiB, "barrier regions inside the memset region");
static_assert(pg8::STAGE_BYTES <= RING_BYTES && att::Lay<64, 128>::OFF_STASH + 65536 <= RING_BYTES && att::Lay<128, 128>::OFF_WS + 2048 <= RING_BYTES, "LDS map");

struct Args { const float* in[26]; float* out; unsigned char* ws; int ph_lo, ph_hi, li, pad; };
#define KIN(k) ((const float*)karg64<8 * (k)>())
#define KOUT ((float*)karg64<208>())
#define KWS ((unsigned char*)karg64<216>())
static_assert(offsetof(Args, out) == 208 && offsetof(Args, ws) == 216 && offsetof(Args, ph_lo) == 224, "Args layout vs the kernarg offsets above");

__global__ void __launch_bounds__(NWAVES * 64, 2) mk_fwd(Args args) {
    extern __shared__ __attribute__((aligned(16))) unsigned char lds[];
    const int wave = __builtin_amdgcn_readfirstlane((int)threadIdx.x >> 6);
#define lane0 lane_id()
#define tid0 (wave * 64 + lane_id())
    const int G = gridDim.x, bx = blockIdx.x, vcu = (G % 8 == 0) ? (bx % 8) * (G / 8) + bx / 8 : bx;
    LAS unsigned char* ldsl = (LAS unsigned char*)lds;
    volatile LAS unsigned* MISC = (volatile LAS unsigned*)(ldsl + LDSCTL_OFF);
    for (int u = tid0; u < (LDS_BYTES - LDSCTL_OFF) / 4; u += NWAVES * 64) ((LAS unsigned*)(ldsl + LDSCTL_OFF))[u] = 0u;
    __syncthreads();
    XcdBarrier bar = xcd_barrier_post((unsigned*)(KWS + WS_CTL) + CW_BAR + args.li * BAR_REGION, MISC + 8, wave == 0 ? 1u : 0u);
#define P_WS unsigned char* ws = KWS; unsigned* ctl = (unsigned*)(ws + WS_CTL); (void)ctl
#define P_ACT bf16_t* MEMKV = (bf16_t*)(ws + WS_MEMKV); bf16_t* HM = (bf16_t*)(ws + WS_HM); bf16_t* PROJ = (bf16_t*)(ws + WS_PROJ); bf16_t* OBR = (bf16_t*)(ws + WS_OBR); bf16_t* HMEM = OBR; \
    bf16_t* BUF = (bf16_t*)(ws + WS_BUF); bf16_t* YB = (bf16_t*)(ws + WS_YB); bf16_t* HID = (bf16_t*)(ws + WS_HID); bf16_t* WB = (bf16_t*)(ws + WS_WB); const bf16_t* WBl = WB + (size_t)l_ * WB_LAYER; \
    (void)MEMKV; (void)HM; (void)PROJ; (void)OBR; (void)HMEM; (void)BUF; (void)YB; (void)HID; (void)WBl
#define P_ROUTE int* experts = (int*)(ws + WS_ROUTE + RT_EXP); float* weights = (float*)(ws + WS_ROUTE + RT_WGT); int* rank = (int*)(ws + WS_ROUTE + RT_RANK); float* rstd = (float*)(ws + WS_ROUTE + RT_RSTD); \
    (void)experts; (void)weights; (void)rank; (void)rstd
    const int gw = bx * NWAVES + wave, NGW = G * NWAVES;
    const int lo = args.ph_lo, hi = args.ph_hi;
#ifndef STAGE_MASK
#define STAGE_MASK 0x3FFu
#endif
#define IN(k) (lo <= (k) && (k) < hi)
#define ST(s) ((STAGE_MASK >> (s)) & 1u)
#ifndef REP_MASK
#define REP_MASK 0u
#endif
#define NREP(s) (((REP_MASK >> (s)) & 1u) ? 2 : 1)
#ifndef DBL_BAR
#define DBL_BAR 0
#endif
#define SEAM(k) do { if (IN(k) && IN((k) + 1)) { xcd_barrier(bar); if (DBL_BAR) xcd_barrier(bar); } } while (0)

    if (ST(0) && IN(0))
  for (int rep_ = 0; rep_ < NREP(0); ++rep_) {
        int lane = lane0, tid = tid0; asm volatile("" : "+v"(lane), "+v"(tid));
        constexpr int l_ = 0; P_WS; P_ACT;
        float* tab1 = (float*)(ws + WS_TAB); float* tab2 = tab1 + SEQ * 32 * 2;
        const float* x = KIN(0); const float* mem = KIN(1); const float* mem_g = KIN(2); const float* norm1_g = KIN(4); const float* norm2_g = KIN(17); const float* w_rg = KIN(18); const float* w_re = KIN(20);
        LAS float* scr = (LAS float*)(ldsl + wave * 16640);
        {   constexpr int NITEMS = 29056;
            f32x4 cur[16], nxt[16]; const float* sp; bf16_t* dp; int ldw, K; const float* sp2; bf16_t* dp2; int ldw2, K2;
            int it = gw;
            if (it < NITEMS) { tr_decode(it, lane, WB, sp, ldw, dp, K); tr_load(cur, sp, ldw); }
            for (; it < NITEMS; it += NGW) {
                const bool more = it + NGW < NITEMS;
                if (more) { tr_decode(it + NGW, lane, WB, sp2, ldw2, dp2, K2); tr_load(nxt, sp2, ldw2); }
                tr_store(cur, dp, K, scr, lane);
                if (more) {
#pragma unroll
                    for (int i = 0; i < 16; ++i) cur[i] = nxt[i];
                    dp = dp2; K = K2; }
            }
        }
        for (int idx = bx * (NWAVES * 64) + tid; idx < SEQ * 32; idx += G * NWAVES * 64) { const int pos = idx >> 5, i = idx & 31; float s, c;
            sincosf((float)pos * inv1d(i), &s, &c); tab1[idx * 2] = c; tab1[idx * 2 + 1] = s;
            sincosf(ang2d(pos, i), &s, &c); tab2[idx * 2] = c; tab2[idx * 2 + 1] = s; }
        for (int idx = bx * (NWAVES * 64) + tid; idx < DEPTH * 48 * 1024; idx += G * NWAVES * 64) { const int l = idx / (48 * 1024), c = (idx >> 10) % 48, k = idx & 1023;
            const float w = c < 4 ? w_rg[((size_t)l * DM + k) * 4 + c] : c < 36 ? w_re[((size_t)l * DM + k) * 32 + (c - 4)] : 0.f, v = w * norm2_g[l * DM + k];
            const bf16_t h = f2bf(v); bf16_t* t = WB + WB_RT + (size_t)l * 2 * 48 * 1024 + (size_t)c * 1024 + k; t[0] = h; t[48 * 1024] = f2bf(v - bf2f(h)); }
        for (int m = gw; m < M; m += NGW) row_rmsnorm(x + (size_t)m * DM, norm1_g, HM + (size_t)m * DM, nullptr, lane);
        for (int m = gw; m < MM; m += NGW) row_rmsnorm(mem + (size_t)m * DM, mem_g, HMEM + (size_t)m * DM, nullptr, lane);
    }
    SEAM(0);
#pragma unroll 1
    for (int l = 0; l < DEPTH; ++l) {
        const int pb = 1 + 9 * l, l_ = l;
        if (ST(1) && IN(pb + 0))
      for (int rep_ = 0; rep_ < NREP(1); ++rep_) {
            P_WS; P_ACT; float* tab1 = (float*)(ws + WS_TAB); float* tab2 = tab1 + SEQ * 32 * 2; const float* qn_g = KIN(11); const float* kn_g = KIN(12);
            pg8::Gemm g{DM, DM};
            pg8::SchedProj S{bx, G, 1472, l == 0 ? 1504 : 1472, (const char*)HM, (const char*)(WBl + WB_IN), (const char*)HMEM, (const char*)(WB + WB_MEMKV)};
            pg8::EpiProj E{PROJ, MEMKV, tab1, tab2, qn_g + l * 64, kn_g + l * 64};
            pg8::gemm_phase<pg8::EpiProj, pg8::SchedProj, true, true>(ldsl, g, S, E, wave);
        }
        SEAM(pb + 0);
        if (ST(2) && IN(pb + 1))
      for (int rep_ = 0; rep_ < NREP(2); ++rep_) {
            int lane = lane0; asm volatile("" : "+v"(lane));
            P_WS; P_ACT; const float* lq1 = KIN(6); const float* lk1 = KIN(7); const float* lq2 = KIN(8); const float* lk2 = KIN(9); const float* subln_g = KIN(10);
            const float lam_init = 0.8f - 0.6f * __expf(-0.3f * (float)l);
            const float lam = __expf(wave_sum(lq1[l * 64 + lane] * lk1[l * 64 + lane])) - __expf(wave_sum(lq2[l * 64 + lane] * lk2[l * 64 + lane])) + lam_init;
            for (int j = vcu; j < 256; j += G) {
#ifndef ATT_SKIP_A
                att::unit_a(PROJ, OBR, j >> 5, (j >> 3) & 3, j & 7, lam, lam_init, subln_g + l * 128, (char*)lds, wave);
#endif
#ifndef ATT_SKIP_B
#pragma unroll 1
                for (int t = 0; t < 2; ++t) { const int idx = 2 * j + t; att::unit_b(PROJ, OBR, idx >> 6, (idx >> 3) & 7, idx & 7, (char*)lds, wave); }
#endif
#ifndef ATT_SKIP_C
                att::unit_c(PROJ, MEMKV, OBR, j >> 5, (j >> 3) & 3, j & 7, (char*)lds, wave);
#endif
            }
            __syncthreads();
        }
        SEAM(pb + 1);
        if (ST(3) && IN(pb + 2))
      for (int rep_ = 0; rep_ < NREP(3); ++rep_) {
            P_WS; P_ACT;
            pg8::Gemm g{OBR_W, 512};
            pg8::SchedGate S{bx, G, (const char*)OBR, (const char*)(WBl + WB_UP)};
            pg8::EpiGate E{HM, PROJ};
            pg8::gemm_phase<pg8::EpiGate, pg8::SchedGate, true, true>(ldsl, g, S, E, wave);
        }
        SEAM(pb + 2);
        if (ST(4) && IN(pb + 3)) {
            P_WS; P_ACT; const float* x = KIN(0); float* X = KOUT;
            pg8::Gemm g{DM, DM};
            pg8::SchedPlain S{bx, G, M / 256, (const char*)HM, (const char*)(WBl + WB_OUT), (size_t)256 * DM * 2, (size_t)256 * DM * 2};
            pg8::EpiResid E{l == 0 ? x : X, X};
            pg8::gemm_phase<pg8::EpiResid, pg8::SchedPlain, true, true>(ldsl, g, S, E, wave);
        }
        SEAM(pb + 3);
        if (ST(5) && IN(pb + 4)) {
            int tid = tid0; asm volatile("" : "+v"(tid));
            const int lane = tid & 63;
            P_WS; P_ACT; P_ROUTE; float* X = KOUT; const float* b_rg = KIN(19); const float* b_re = KIN(21); const float* norm2_g = KIN(17);
            const bf16_t* tab = WB + WB_RT + (size_t)l * 2 * 48 * 1024 + (size_t)(lane & 15) * 1024 + 128 * wave + 8 * (lane >> 4);
            bf16x8 Bh[3][4], Bl[3][4];
#pragma unroll
            for (int t = 0; t < 3; ++t)
#pragma unroll
                for (int sI = 0; sI < 4; ++sI) { Bh[t][sI] = *(const bf16x8*)(tab + (size_t)t * 16 * 1024 + 32 * sI); Bl[t][sI] = *(const bf16x8*)(tab + (size_t)(48 + t * 16) * 1024 + 32 * sI); }
            for (int rb = bx; rb < M / 64; rb += G)
                route_block(X, tab, b_rg + l * 4, b_re + l * 32, experts, weights, rank, ctl + CW_CNT + 2048 * l, rstd, (int*)BUF, norm2_g + l * DM, HM, rb, Bh, Bl, (LAS float*)ldsl, tid, wave);
        }
        SEAM(pb + 4);
        volatile LAS int* mt = (volatile LAS int*)(ldsl + LDSCTL_OFF + 256);
        LAS unsigned* rowtab = (LAS unsigned*)(ldsl + LDSCTL_OFF + 2048); LAS float* wtab = (LAS float*)(ldsl + LDSCTL_OFF + 6144);
        if (ST(7) && IN(pb + 6)) {
            int tid = tid0; asm volatile("" : "+v"(tid));
            P_WS; P_ACT; P_ROUTE;
            moe_tables(ctl + CW_CNT + 2048 * l, mt, tid);
            moe_rowtabs(mt, (const int*)BUF, weights, rowtab, wtab, bx, G, tid, 1);
            const int ntiles = __builtin_amdgcn_readfirstlane(mt[256]);
            pg8::Gemm g{DM, DM};
            pg8::SchedMoeUp S{bx, G, ntiles, (const LAS int*)(ldsl + LDSCTL_OFF + 256 + 96 * 4), (const char*)HM, (const char*)(WBl + WB_GU), ctl + CW_TCNT + l * 160 * 64};
            pg8::EpiSilu E{HID};
            pg8::gemm_phase<pg8::EpiSilu, pg8::SchedMoeUp, true, true, true>(ldsl, g, S, E, wave, rowtab);
        }
        if (ST(8) && IN(pb + 7)) {
            int tid = tid0; asm volatile("" : "+v"(tid));
            P_WS; P_ACT; P_ROUTE;
            if (!(ST(7) && IN(pb + 6))) moe_tables(ctl + CW_CNT + 2048 * l, mt, tid);
            moe_rowtabs(mt, (const int*)BUF, weights, rowtab, wtab, bx, G, tid, 0);
            const int ntiles = __builtin_amdgcn_readfirstlane(mt[256]);
            pg8::Gemm g{DEXP, DEXP};
            pg8::SchedMoeDown S{bx, G, ntiles, (ntiles * 4) % G, wave, (const LAS int*)(ldsl + LDSCTL_OFF + 256 + 96 * 4), (const char*)HID, (const char*)(WBl + WB_DN), ctl + CW_TCNT + l * 160 * 64, ctl + CW_TMO};
            pg8::EpiRowScale E{YB, wtab};
            pg8::gemm_phase<pg8::EpiRowScale, pg8::SchedMoeDown, true, true>(ldsl, g, S, E, wave);
        }
        SEAM(pb + 7);
        if (ST(9) && IN(pb + 8)) {
            int lane = lane0; asm volatile("" : "+v"(lane));
            P_WS; P_ACT; P_ROUTE; float* X = KOUT; const float* norm1_g = KIN(4); const float* final_g = KIN(25); int* dest = nullptr;
            const bool last = (l == DEPTH - 1);
            const bool poison = last && ((__hip_atomic_load(ctl + CW_BAR + args.li * BAR_REGION + XB_TMO, __ATOMIC_RELAXED, __HIP_MEMORY_SCOPE_AGENT) | __hip_atomic_load(ctl + CW_TMO, __ATOMIC_RELAXED, __HIP_MEMORY_SCOPE_AGENT)) != 0u);
            if (!(ST(7) && IN(pb + 6)) && !(ST(8) && IN(pb + 7))) moe_tables(ctl + CW_CNT + 2048 * l, mt, tid0);
            for (int m = gw; m < M; m += NGW) row_combine_norm(X, YB, dest, last ? final_g : norm1_g + (l + 1) * DM, last ? nullptr : HM, X, m, lane, poison, mt[experts[2 * m]] + rank[2 * m], mt[experts[2 * m + 1]] + rank[2 * m + 1]);
        }
        SEAM(pb + 8);
    }
#undef IN
#undef SEAM
#undef lane0
#undef tid0
#undef P_WS
#undef P_ACT
#undef P_ROUTE
}

#ifndef FAST_MASK
#define FAST_MASK 0x7FFFFu
#endif
extern "C" void kernel_launch(void* const* d_in, const int* in_sizes, int n_in, void* d_out, int out_size, void* d_ws, size_t ws_size, hipStream_t stream) {
    if (n_in != 26 || out_size != M * DM || ws_size < WS_END) { fprintf(stderr, "kernel_launch: unexpected shapes n_in %d out %d ws %zu (need %zu)\n", n_in, out_size, ws_size, (size_t)WS_END); return; }
    static int grid = 0;
    if (grid == 0) {
        int dev = 0, cus = 0;
        if (hipGetDevice(&dev) != hipSuccess || hipDeviceGetAttribute(&cus, hipDeviceAttributeMultiprocessorCount, dev) != hipSuccess) { grid = -1; return; }
        if (hipFuncSetAttribute((const void*)mk_fwd, hipFuncAttributeMaxDynamicSharedMemorySize, LDS_BYTES) != hipSuccess) { fprintf(stderr, "kernel_launch: hipFuncSetAttribute failed\n"); grid = -1; return; }
        int per_cu = 0;
        if (hipOccupancyMaxActiveBlocksPerMultiprocessor(&per_cu, (const void*)mk_fwd, NWAVES * 64, LDS_BYTES) != hipSuccess || per_cu < 1) fprintf(stderr, "kernel_launch: occupancy query says %d\n", per_cu);
        (void)hipGetLastError();
        grid = cus;
    }
    if (grid < 0) return;
    const float* x = (const float*)d_in[0]; const float* mem = (const float*)d_in[1]; const float* mem_g = (const float*)d_in[2]; const float* w_memkv = (const float*)d_in[3];
    const float* norm1_g = (const float*)d_in[4]; const float* w_in = (const float*)d_in[5];
    const float* lq1 = (const float*)d_in[6]; const float* lk1 = (const float*)d_in[7]; const float* lq2 = (const float*)d_in[8]; const float* lk2 = (const float*)d_in[9];
    const float* subln_g = (const float*)d_in[10]; const float* qn_g = (const float*)d_in[11]; const float* kn_g = (const float*)d_in[12];
    const float* w_up[3] = {(const float*)d_in[13], (const float*)d_in[14], (const float*)d_in[15]}; const float* w_out = (const float*)d_in[16];
    const float* norm2_g = (const float*)d_in[17]; const float* w_rg = (const float*)d_in[18]; const float* b_rg = (const float*)d_in[19]; const float* w_re = (const float*)d_in[20]; const float* b_re = (const float*)d_in[21];
    const float* w_eg = (const float*)d_in[22]; const float* w_eu = (const float*)d_in[23]; const float* w_ed = (const float*)d_in[24]; const float* final_g = (const float*)d_in[25];
    unsigned char* ws = (unsigned char*)d_ws; float* X = (float*)d_out;
    unsigned* ctl = (unsigned*)(ws + WS_CTL);
    bf16_t* MEMKV = (bf16_t*)(ws + WS_MEMKV); bf16_t* HM = (bf16_t*)(ws + WS_HM); bf16_t* PROJ = (bf16_t*)(ws + WS_PROJ); bf16_t* OBR = (bf16_t*)(ws + WS_OBR);
    bf16_t* BUF = (bf16_t*)(ws + WS_BUF); bf16_t* YB = (bf16_t*)(ws + WS_YB); bf16_t* HID = (bf16_t*)(ws + WS_HID);
    int* experts = (int*)(ws + WS_ROUTE + RT_EXP); float* weights = (float*)(ws + WS_ROUTE + RT_WGT); int* rank = (int*)(ws + WS_ROUTE + RT_RANK); int* dest = (int*)(ws + WS_ROUTE + RT_DEST);
    float* roww = (float*)(ws + WS_ROUTE + RT_ROWW); int* tile_tab = (int*)(ws + WS_ROUTE + RT_TILE); float* rstd = (float*)(ws + WS_ROUTE + RT_RSTD);

    (void)hipMemsetAsync(ctl, 0, MiB, stream);
    unsigned mask = FAST_MASK; if (mask) mask |= 1u;
    Args a{};
    for (int i = 0; i < 26; ++i) a.in[i] = (const float*)d_in[i];
    a.out = X; a.ws = ws;
    int li = 0;
    for (int k = 0; k < N_PHASES;) {
        if ((mask >> k) & 1u) {
            int k2 = k; while (k2 < N_PHASES && ((mask >> k2) & 1u)) ++k2;
            a.ph_lo = k; a.ph_hi = k2; a.li = li++; a.pad = 0;
            hipLaunchKernelGGL(mk_fwd, dim3(grid), dim3(NWAVES * 64), LDS_BYTES, stream, a);
            k = k2; continue;
        }
        if (k == 0) {
            (void)hipMemcpyAsync(X, x, (size_t)M * DM * 4, hipMemcpyDeviceToDevice, stream);
            s_rmsnorm<<<MM / 4, 256, 0, stream>>>(mem, mem_g, OBR, MM);
            s_rmsnorm<<<M / 4, 256, 0, stream>>>(X, norm1_g, HM, M);
        } else {
            const int l = (k - 1) / 9, s = (k - 1) % 9; const float lam_init = 0.8f - 0.6f * expf(-0.3f * (float)l);
            switch (s) {
            case 0:
                if (l == 0) { SG p{}; p.A = OBR; p.lda = DM; p.W = w_memkv; p.ldw = 1024; p.K = DM; p.mode = MD_BF16; p.O = MEMKV; p.ldo = 1024; s_gemm<<<dim3(1024 / 64, MM / 64), 256, 0, stream>>>(p); }
                { SG p{}; p.A = HM; p.lda = DM; p.W = w_in + (size_t)l * DM * D_IN; p.ldw = D_IN; p.K = DM; p.mode = MD_PROJ; p.O = PROJ; p.ldo = D_IN; p.qg = qn_g + l * 64; p.kg = kn_g + l * 64;
                  s_gemm<<<dim3(D_IN / 64, M / 64), 256, 0, stream>>>(p); }
                break;
            case 1:
                s_attn_a<<<dim3(M / 4, 4), 256, 0, stream>>>(PROJ, OBR, lq1 + l * 64, lk1 + l * 64, lq2 + l * 64, lk2 + l * 64, subln_g + l * 128, lam_init);
                s_attn_b<<<dim3(M / 4, 8), 256, 0, stream>>>(PROJ, OBR);
                s_attn_c<<<dim3(M / 4, 4), 256, 0, stream>>>(PROJ, MEMKV, OBR);
                break;
            case 2:
                for (int i = 0; i < 3; ++i) { SG p{}; p.A = OBR + 512 * i; p.lda = OBR_W; p.W = w_up[i] + (size_t)l * 512 * DM; p.ldw = DM; p.K = 512; p.mode = MD_GATE; p.O = HM; p.ldo = DM; p.G = PROJ + C_G + 1024 * i; p.ldg = D_IN; p.first = (i == 0);
                    s_gemm<<<dim3(DM / 64, M / 64), 256, 0, stream>>>(p); }
                break;
            case 3:
                if (l == 0 && (mask & 1u)) (void)hipMemcpyAsync(X, x, (size_t)M * DM * 4, hipMemcpyDeviceToDevice, stream);
                { SG p{}; p.A = HM; p.lda = DM; p.W = w_out + (size_t)l * DM * DM; p.ldw = DM; p.K = DM; p.mode = MD_RESID; p.Xf = X; s_gemm<<<dim3(DM / 64, M / 64), 256, 0, stream>>>(p); }
                break;
            case 4:
                s_norm_route<<<M / 4, 256, 0, stream>>>(X, norm2_g + l * DM, HM, w_rg + (size_t)l * DM * 4, b_rg + l * 4, w_re + (size_t)l * DM * 32, b_re + l * 32, experts, weights, rank, ctl + 32 * l, rstd);
                break;
            case 5:
                s_dispatch<<<1, 64, 0, stream>>>(ctl + 32 * l, tile_tab);
                s_gather<<<M * 2 / 4, 256, 0, stream>>>(X, rstd, norm2_g + l * DM, experts, weights, rank, tile_tab, BUF, roww, dest);
                break;
            case 6:
                { SG p{}; p.A = BUF; p.lda = DM; p.W = w_eg + (size_t)l * NEXP * DM * DEXP; p.W2 = w_eu + (size_t)l * NEXP * DM * DEXP; p.ldw = DEXP; p.wstride = (size_t)DM * DEXP; p.tile_e = tile_tab; p.ntiles = tile_tab + 256;
                  p.K = DM; p.mode = MD_SILU; p.O = HID; p.ldo = DEXP; s_gemm<<<dim3(DEXP / 64, P_ROWS / 64), 256, 0, stream>>>(p); }
                break;
            case 7:
                { SG p{}; p.A = HID; p.lda = DEXP; p.W = w_ed + (size_t)l * NEXP * DEXP * DM; p.ldw = DM; p.wstride = (size_t)DEXP * DM; p.tile_e = tile_tab; p.ntiles = tile_tab + 256;
                  p.K = DEXP; p.mode = MD_ROWSCALE; p.O = YB; p.ldo = DM; p.roww = roww; s_gemm<<<dim3(DM / 64, P_ROWS / 64), 256, 0, stream>>>(p); }
                break;
            default:
                if (l + 1 < DEPTH) s_combine_norm<<<M / 4, 256, 0, stream>>>(X, YB, dest, norm1_g + (l + 1) * DM, HM, nullptr);
                else s_combine_norm<<<M / 4, 256, 0, stream>>>(X, YB, dest, final_g, nullptr, X);
                break;
            }
        }
        ++k;
    }
}
```

```cpp
#include <hip/hip_runtime.h>
#include <cstdint>
#include <cstdio>
#include <cmath>
#include <cstddef>

typedef unsigned short bf16_t;
typedef float f32x4 __attribute__((ext_vector_type(4)));
typedef unsigned u32x4 __attribute__((ext_vector_type(4)));
typedef unsigned u32x2 __attribute__((ext_vector_type(2)));

constexpr int BATCH = 8, SEQ = 2048, DM = 1024, DEPTH = 2, MEM_LEN = 256;
constexpr int M = BATCH * SEQ;
constexpr int MM = BATCH * MEM_LEN;
constexpr int D_IN = 5888;
constexpr int C_AQ = 0, C_AK = 512, C_AV = 1024, C_BQ = 1536, C_BK = 2048, C_BV = 2176, C_CQ = 2304, C_G = 2816;
constexpr int OBR_W = 1536;
constexpr int NEXP = 32, DEXP = 512;
constexpr int MOE_TILE = 256;
constexpr int P_ROWS = M * 2 + NEXP * MOE_TILE;
constexpr int MAX_TILES = P_ROWS / MOE_TILE;
constexpr float EPS = 1e-6f;
constexpr float LOG2E = 1.4426950408889634f;
constexpr float C2_64 = 0.125f * LOG2E;
constexpr float C2_128 = 0.08838834764831845f * LOG2E;

constexpr size_t MiB = 1u << 20;
constexpr size_t WS_CTL = 0;
constexpr size_t WS_ROUTE = 1 * MiB;
constexpr size_t WS_TAB = 2 * MiB;
constexpr size_t WS_MEMKV = 3 * MiB;
constexpr size_t WS_HM = 7 * MiB;
constexpr size_t WS_PROJ = 39 * MiB;
constexpr size_t WS_OBR = 223 * MiB;
constexpr size_t WS_WB = 271 * MiB;
constexpr size_t WS_END = 499 * MiB;
constexpr size_t WS_BUF = WS_PROJ;
constexpr size_t WS_YB = WS_PROJ + 80 * MiB;
constexpr size_t WS_HID = WS_OBR;
constexpr size_t RT_EXP = 0;
constexpr size_t RT_WGT = 128 * 1024;
constexpr size_t RT_RANK = 256 * 1024;
constexpr size_t RT_DEST = 384 * 1024;
constexpr size_t RT_ROWW = 512 * 1024;
constexpr size_t RT_TILE = 700 * 1024;
constexpr size_t RT_RSTD = 768 * 1024;
constexpr int CW_CNT = 163840;
constexpr int CW_TMO = 128;
constexpr int CW_TCNT = 131072;

__device__ __forceinline__ float bf2f(bf16_t v) { return __uint_as_float(((unsigned)v) << 16); }
__device__ __forceinline__ bf16_t f2bf(float f) { unsigned u = __float_as_uint(f); return (bf16_t)((u + 0x7fffu + ((u >> 16) & 1u)) >> 16); }
__device__ __forceinline__ float wave_sum(float v) {
#pragma unroll
    for (int o = 1; o < 64; o <<= 1) v += __shfl_xor(v, o);
    return v;
}
__device__ __forceinline__ float wave_max(float v) {
#pragma unroll
    for (int o = 1; o < 64; o <<= 1) v = fmaxf(v, __shfl_xor(v, o));
    return v;
}
__device__ __forceinline__ float inv1d(int i) { return exp2f(-(float)i * (13.287712379549449f / 32.f)); }
__device__ __forceinline__ float inv2d(int j) { return exp2f(-(float)j * (13.287712379549449f / 16.f)); }
__device__ __forceinline__ float ang2d(int pos, int i) { return i < 16 ? (float)(pos >> 6) * inv2d(i) : (float)(pos & 63) * inv2d(i - 16); }

__global__ __launch_bounds__(256) void s_rmsnorm(const float* __restrict__ X, const float* __restrict__ g, bf16_t* __restrict__ OUT, int rows) {
    const int lane = threadIdx.x & 63, row = blockIdx.x * 4 + (threadIdx.x >> 6);
    if (row >= rows) return;
    const f32x4* xr = (const f32x4*)(X + (size_t)row * DM);
    f32x4 v[4]; float s = 0.f;
#pragma unroll
    for (int j = 0; j < 4; ++j) { v[j] = xr[lane + 64 * j]; s += v[j].x * v[j].x + v[j].y * v[j].y + v[j].z * v[j].z + v[j].w * v[j].w; }
    const float rs = rsqrtf(wave_sum(s) * (1.f / DM) + EPS);
#pragma unroll
    for (int j = 0; j < 4; ++j) { const f32x4 gg = ((const f32x4*)g)[lane + 64 * j];
        u32x2 o; o.x = f2bf(v[j].x * rs * gg.x) | ((unsigned)f2bf(v[j].y * rs * gg.y) << 16); o.y = f2bf(v[j].z * rs * gg.z) | ((unsigned)f2bf(v[j].w * rs * gg.w) << 16);
        ((u32x2*)(OUT + (size_t)row * DM))[lane + 64 * j] = o; }
}

enum { MD_PROJ = 0, MD_BF16 = 1, MD_GATE = 2, MD_RESID = 3, MD_SILU = 4, MD_ROWSCALE = 5 };
struct SG {
    const bf16_t* A; int lda; const float* W; const float* W2; int ldw; size_t wstride;
    const int* tile_e; const int* ntiles;
    int K; int mode;
    bf16_t* O; int ldo;
    float* Xf;
    const bf16_t* G; int ldg; int first;
    const float* roww;
    const float* qg; const float* kg;
};
__global__ __launch_bounds__(256) void s_gemm(SG p) {
    __shared__ float As[16][68];
    __shared__ float Bs[16][68];
    __shared__ float B2s[16][68];
    __shared__ float Ct[64][65];
    __shared__ float Ct2[64][65];
    const int tid = threadIdx.x, tx = tid & 15, ty = tid >> 4;
    const int gc0 = blockIdx.x * 64, gr0 = blockIdx.y * 64;
    const float* W = p.W; const float* W2 = p.W2;
    if (p.tile_e) { const int t256 = blockIdx.y >> 2; if (t256 >= *p.ntiles) return; const int e = p.tile_e[t256]; W += (size_t)e * p.wstride; if (W2) W2 += (size_t)e * p.wstride; }
    float acc[4][4] = {}, acc2[4][4] = {};
    const int ar = tid >> 2, ak = (tid & 3) * 4;
    const int bk = tid >> 4, bn = (tid & 15) * 4;
    for (int k0 = 0; k0 < p.K; k0 += 16) {
        { const u32x2 a = *(const u32x2*)(p.A + (size_t)(gr0 + ar) * p.lda + k0 + ak);
          As[ak + 0][ar] = __uint_as_float(a.x << 16); As[ak + 1][ar] = __uint_as_float(a.x & 0xffff0000u);
          As[ak + 2][ar] = __uint_as_float(a.y << 16); As[ak + 3][ar] = __uint_as_float(a.y & 0xffff0000u); }
        { const f32x4 b = *(const f32x4*)(W + (size_t)(k0 + bk) * p.ldw + gc0 + bn); Bs[bk][bn] = b.x; Bs[bk][bn + 1] = b.y; Bs[bk][bn + 2] = b.z; Bs[bk][bn + 3] = b.w; }
        if (p.mode == MD_SILU) { const f32x4 b = *(const f32x4*)(W2 + (size_t)(k0 + bk) * p.ldw + gc0 + bn); B2s[bk][bn] = b.x; B2s[bk][bn + 1] = b.y; B2s[bk][bn + 2] = b.z; B2s[bk][bn + 3] = b.w; }
        __syncthreads();
#pragma unroll
        for (int k = 0; k < 16; ++k) {
            float a[4], b[4];
#pragma unroll
            for (int i = 0; i < 4; ++i) { a[i] = As[k][ty * 4 + i]; b[i] = Bs[k][tx * 4 + i]; }
#pragma unroll
            for (int i = 0; i < 4; ++i)
#pragma unroll
                for (int j = 0; j < 4; ++j) acc[i][j] += a[i] * b[j];
            if (p.mode == MD_SILU) {
#pragma unroll
                for (int i = 0; i < 4; ++i) b[i] = B2s[k][tx * 4 + i];
#pragma unroll
                for (int i = 0; i < 4; ++i)
#pragma unroll
                    for (int j = 0; j < 4; ++j) acc2[i][j] += a[i] * b[j];
            }
        }
        __syncthreads();
    }
#pragma unroll
    for (int i = 0; i < 4; ++i)
#pragma unroll
        for (int j = 0; j < 4; ++j) { Ct[ty * 4 + i][tx * 4 + j] = acc[i][j]; Ct2[ty * 4 + i][tx * 4 + j] = acc2[i][j]; }
    __syncthreads();
    const int r = tid >> 2, q = tid & 3; const int grow = gr0 + r;
    if (p.mode == MD_PROJ) {
        const int pos = grow & (SEQ - 1);
        bf16_t* orow = p.O + (size_t)grow * p.ldo + gc0;
        if (gc0 < C_AV) {
            const float sc = gc0 < C_AK ? C2_64 : 1.f;
            for (int j = 0; j < 8; ++j) { const int i = q * 8 + j; const float x1 = Ct[r][i], x2 = Ct[r][i + 32]; float s, c; sincosf((float)pos * inv1d(i), &s, &c);
                orow[i] = f2bf((x1 * c - x2 * s) * sc); orow[i + 32] = f2bf((x2 * c + x1 * s) * sc); }
        } else if ((gc0 >= C_BQ && gc0 < C_BV)) {
            const bool isq = gc0 < C_BK; const float* g = isq ? p.qg : p.kg; const float sc = isq ? C2_64 : 1.f;
            float ss = 0.f; for (int d = 0; d < 64; ++d) ss += Ct[r][d] * Ct[r][d];
            const float rs = rsqrtf(ss * (1.f / 64.f) + EPS);
            for (int j = 0; j < 8; ++j) { const int i = q * 8 + j; const float x1 = Ct[r][i] * rs * g[i], x2 = Ct[r][i + 32] * rs * g[i + 32]; float s, c; sincosf(ang2d(pos, i), &s, &c);
                orow[i] = f2bf((x1 * c - x2 * s) * sc); orow[i + 32] = f2bf((x2 * c + x1 * s) * sc); }
        } else if (gc0 >= C_G) {
            for (int j = 0; j < 16; ++j) { const int c = q * 16 + j; orow[c] = f2bf(1.f / (1.f + __expf(-Ct[r][c]))); }
        } else {
            const float sc = (gc0 >= C_CQ) ? C2_128 : 1.f;
            for (int j = 0; j < 16; ++j) { const int c = q * 16 + j; orow[c] = f2bf(Ct[r][c] * sc); }
        }
    } else if (p.mode == MD_BF16) {
        for (int j = 0; j < 16; ++j) { const int c = q * 16 + j; p.O[(size_t)grow * p.ldo + gc0 + c] = f2bf(Ct[r][c]); }
    } else if (p.mode == MD_GATE) {
        for (int j = 0; j < 16; ++j) { const int c = q * 16 + j; const float gv = bf2f(p.G[(size_t)grow * p.ldg + gc0 + c]);
            bf16_t* o = p.O + (size_t)grow * p.ldo + gc0 + c; const float prev = p.first ? 0.f : bf2f(*o); *o = f2bf(prev + gv * Ct[r][c]); }
    } else if (p.mode == MD_RESID) {
        for (int j = 0; j < 16; ++j) { const int c = q * 16 + j; p.Xf[(size_t)grow * DM + gc0 + c] += Ct[r][c]; }
    } else if (p.mode == MD_SILU) {
        for (int j = 0; j < 16; ++j) { const int c = q * 16 + j; const float gq = Ct[r][c], u = Ct2[r][c]; p.O[(size_t)grow * p.ldo + gc0 + c] = f2bf(gq / (1.f + __expf(-gq)) * u); }
    } else if (p.mode == MD_ROWSCALE) {
        const float w = p.roww[grow];
        for (int j = 0; j < 16; ++j) { const int c = q * 16 + j; p.O[(size_t)grow * p.ldo + gc0 + c] = f2bf(Ct[r][c] * w); }
    }
}

template <int DQK, int DV, int NKT>
__device__ __forceinline__ void attn_row(const bf16_t* q, const bf16_t* K, int ldk, const bf16_t* V, int ldv, float* qs, float* ps, int lane, float (&o)[2]) {
    for (int d = lane; d < DQK; d += 64) qs[d] = bf2f(q[d]);
    __syncthreads();
    float sc[NKT]; float m = -INFINITY;
#pragma unroll
    for (int i = 0; i < NKT; ++i) {
        const bf16_t* kr = K + (size_t)(i * 64 + lane) * ldk; float s = 0.f;
#pragma unroll
        for (int d0 = 0; d0 < DQK / 8; ++d0) { const u32x4 w = *(const u32x4*)(kr + d0 * 8);
            s += qs[d0 * 8 + 0] * __uint_as_float(w.x << 16) + qs[d0 * 8 + 1] * __uint_as_float(w.x & 0xffff0000u) + qs[d0 * 8 + 2] * __uint_as_float(w.y << 16) + qs[d0 * 8 + 3] * __uint_as_float(w.y & 0xffff0000u)
               + qs[d0 * 8 + 4] * __uint_as_float(w.z << 16) + qs[d0 * 8 + 5] * __uint_as_float(w.z & 0xffff0000u) + qs[d0 * 8 + 6] * __uint_as_float(w.w << 16) + qs[d0 * 8 + 7] * __uint_as_float(w.w & 0xffff0000u); }
        sc[i] = s; m = fmaxf(m, s);
    }
    m = wave_max(m); float l = 0.f;
#pragma unroll
    for (int i = 0; i < NKT; ++i) { const float pv = exp2f(sc[i] - m); l += pv; ps[i * 64 + lane] = pv; }
    l = wave_sum(l);
    __syncthreads();
    float a0 = 0.f, a1 = 0.f;
#pragma unroll 4
    for (int j = 0; j < NKT * 64; ++j) { const float pv = ps[j]; a0 += pv * bf2f(V[(size_t)j * ldv + lane]); if (DV == 128) a1 += pv * bf2f(V[(size_t)j * ldv + 64 + lane]); }
    o[0] = a0 / l; o[1] = a1 / l;
    __syncthreads();
}
__global__ __launch_bounds__(256) void s_attn_b(const bf16_t* __restrict__ PROJ, bf16_t* __restrict__ OBR) {
    __shared__ float qs_[4][128]; __shared__ float ps_[4][2048];
    const int w = threadIdx.x >> 6, lane = threadIdx.x & 63, row = blockIdx.x * 4 + w, qh = blockIdx.y, b = row / SEQ;
    const bf16_t* kv = PROJ + (size_t)b * SEQ * D_IN;
    float o[2];
    attn_row<64, 64, 32>(PROJ + (size_t)row * D_IN + C_BQ + qh * 64, kv + C_BK + (qh >> 2) * 64, D_IN, kv + C_BV + (qh >> 2) * 64, D_IN, qs_[w], ps_[w], lane, o);
    OBR[(size_t)row * OBR_W + 512 + qh * 64 + lane] = f2bf(o[0]);
}
__global__ __launch_bounds__(256) void s_attn_c(const bf16_t* __restrict__ PROJ, const bf16_t* __restrict__ MEMKV, bf16_t* __restrict__ OBR) {
    __shared__ float qs_[4][128]; __shared__ float ps_[4][256];
    const int w = threadIdx.x >> 6, lane = threadIdx.x & 63, row = blockIdx.x * 4 + w, h = blockIdx.y, b = row / SEQ;
    const bf16_t* kv = MEMKV + (size_t)b * MEM_LEN * 1024;
    float o[2];
    attn_row<128, 128, 4>(PROJ + (size_t)row * D_IN + C_CQ + h * 128, kv + h * 128, 1024, kv + 512 + h * 128, 1024, qs_[w], ps_[w], lane, o);
    OBR[(size_t)row * OBR_W + 1024 + h * 128 + lane] = f2bf(o[0]);
    OBR[(size_t)row * OBR_W + 1024 + h * 128 + 64 + lane] = f2bf(o[1]);
}
__global__ __launch_bounds__(256) void s_attn_a(const bf16_t* __restrict__ PROJ, bf16_t* __restrict__ OBR, const float* lq1, const float* lk1, const float* lq2, const float* lk2,
                                                const float* subg, float lam_init) {
    __shared__ float qs_[4][128]; __shared__ float ps_[4][2048];
    const int w = threadIdx.x >> 6, lane = threadIdx.x & 63, row = blockIdx.x * 4 + w, h = blockIdx.y, b = row / SEQ;
    const float lam = __expf(wave_sum(lq1[lane] * lk1[lane])) - __expf(wave_sum(lq2[lane] * lk2[lane])) + lam_init;
    const bf16_t* kv = PROJ + (size_t)b * SEQ * D_IN;
    float o0[2], o1[2];
    attn_row<64, 128, 32>(PROJ + (size_t)row * D_IN + C_AQ + h * 128, kv + C_AK + h * 128, D_IN, kv + C_AV + h * 128, D_IN, qs_[w], ps_[w], lane, o0);
    attn_row<64, 128, 32>(PROJ + (size_t)row * D_IN + C_AQ + h * 128 + 64, kv + C_AK + h * 128 + 64, D_IN, kv + C_AV + h * 128, D_IN, qs_[w], ps_[w], lane, o1);
    const float c0 = o0[0] - lam * o1[0], c1 = o0[1] - lam * o1[1];
    const float rs = rsqrtf(wave_sum(c0 * c0 + c1 * c1) * (1.f / 128.f) + EPS) * (1.f - lam_init);
    OBR[(size_t)row * OBR_W + h * 128 + lane] = f2bf(c0 * rs * subg[lane]);
    OBR[(size_t)row * OBR_W + h * 128 + 64 + lane] = f2bf(c1 * rs * subg[64 + lane]);
}

__global__ __launch_bounds__(256) void s_norm_route(const float* __restrict__ X, const float* __restrict__ g, bf16_t* __restrict__ H2, const float* __restrict__ wrg, const float* __restrict__ brg,
                                                    const float* __restrict__ wre, const float* __restrict__ bre, int* __restrict__ experts, float* __restrict__ weights, int* __restrict__ rank, unsigned* __restrict__ cnt, float* __restrict__ rstd) {
    const int lane = threadIdx.x & 63, row = blockIdx.x * 4 + (threadIdx.x >> 6);
    const f32x4* xr = (const f32x4*)(X + (size_t)row * DM);
    f32x4 v[4]; float s = 0.f;
#pragma unroll
    for (int j = 0; j < 4; ++j) { v[j] = xr[lane + 64 * j]; s += v[j].x * v[j].x + v[j].y * v[j].y + v[j].z * v[j].z + v[j].w * v[j].w; }
    const float rs = rsqrtf(wave_sum(s) * (1.f / DM) + EPS);
    float acc[36];
#pragma unroll
    for (int e = 0; e < 36; ++e) acc[e] = 0.f;
#pragma unroll
    for (int j = 0; j < 4; ++j) { const f32x4 gg = ((const f32x4*)g)[lane + 64 * j];
        float h[4] = {v[j].x * rs * gg.x, v[j].y * rs * gg.y, v[j].z * rs * gg.z, v[j].w * rs * gg.w};
        u32x2 o; o.x = f2bf(h[0]) | ((unsigned)f2bf(h[1]) << 16); o.y = f2bf(h[2]) | ((unsigned)f2bf(h[3]) << 16);
        ((u32x2*)(H2 + (size_t)row * DM))[lane + 64 * j] = o;
#pragma unroll
        for (int i = 0; i < 4; ++i) { const int k = (lane + 64 * j) * 4 + i;
            const f32x4 wg = *(const f32x4*)(wrg + (size_t)k * 4);
            acc[0] += h[i] * wg.x; acc[1] += h[i] * wg.y; acc[2] += h[i] * wg.z; acc[3] += h[i] * wg.w;
#pragma unroll
            for (int e4 = 0; e4 < 8; ++e4) { const f32x4 we = *(const f32x4*)(wre + (size_t)k * 32 + e4 * 4);
                acc[4 + e4 * 4 + 0] += h[i] * we.x; acc[4 + e4 * 4 + 1] += h[i] * we.y; acc[4 + e4 * 4 + 2] += h[i] * we.z; acc[4 + e4 * 4 + 3] += h[i] * we.w; }
        }
    }
#pragma unroll
    for (int e = 0; e < 36; ++e) acc[e] = wave_sum(acc[e]);
    if (lane == 0) {
        rstd[row] = rs;
        int gi = 0; float gm = acc[0] + brg[0];
        for (int i = 1; i < 4; ++i) { const float l = acc[i] + brg[i]; if (l > gm) { gm = l; gi = i; } }
        float gs = 0.f; for (int i = 0; i < 4; ++i) gs += __expf(acc[i] + brg[i] - gm);
        const float gp = 1.f / gs;
        float el[8];
#pragma unroll
        for (int i = 0; i < 8; ++i) el[i] = 0.f;
#pragma unroll
        for (int gq = 0; gq < 4; ++gq) if (gq == gi) {
#pragma unroll
            for (int i = 0; i < 8; ++i) el[i] = acc[4 + gq * 8 + i] + bre[gq * 8 + i]; }
        int i0 = 0; float l0 = el[0];
#pragma unroll
        for (int i = 1; i < 8; ++i) if (el[i] > l0) { l0 = el[i]; i0 = i; }
        int i1 = -1; float l1 = -INFINITY;
#pragma unroll
        for (int i = 0; i < 8; ++i) if (i != i0 && el[i] > l1) { l1 = el[i]; i1 = i; }
        const float p1 = __expf(l1 - l0), inv = 1.f / (1.f + p1);
        const int e0 = gi * 8 + i0, e1 = gi * 8 + i1;
        experts[row * 2] = e0; experts[row * 2 + 1] = e1;
        weights[row * 2] = gp * inv; weights[row * 2 + 1] = gp * p1 * inv;
        rank[row * 2] = (int)atomicAdd(cnt + e0, 1u); rank[row * 2 + 1] = (int)atomicAdd(cnt + e1, 1u);
    }
}
__global__ void s_dispatch(const unsigned* __restrict__ cnt, int* __restrict__ tile_tab) {
    if (threadIdx.x == 0) {
        int off = 0, nt = 0;
        for (int e = 0; e < NEXP; ++e) { const int c = (int)cnt[e], t = (c + MOE_TILE - 1) / MOE_TILE; tile_tab[260 + e] = off; for (int i = 0; i < t; ++i) tile_tab[nt++] = e; off += t * MOE_TILE; }
        tile_tab[256] = nt;
    }
}
__global__ __launch_bounds__(256) void s_gather(const float* __restrict__ X, const float* __restrict__ rstd, const float* __restrict__ g, const int* __restrict__ experts, const float* __restrict__ weights, const int* __restrict__ rank, const int* __restrict__ tile_tab,
                                                bf16_t* __restrict__ BUF, float* __restrict__ roww, int* __restrict__ dest) {
    const int lane = threadIdx.x & 63, a = blockIdx.x * 4 + (threadIdx.x >> 6);
    const int tok = a >> 1, e = experts[a], d = tile_tab[260 + e] + rank[a]; const float rs = rstd[tok];
    const f32x4* xr = (const f32x4*)(X + (size_t)tok * DM);
    for (int j = 0; j < 4; ++j) { const f32x4 v = xr[lane + 64 * j], gg = ((const f32x4*)g)[lane + 64 * j];
        u32x2 o; o.x = f2bf(v.x * rs * gg.x) | ((unsigned)f2bf(v.y * rs * gg.y) << 16); o.y = f2bf(v.z * rs * gg.z) | ((unsigned)f2bf(v.w * rs * gg.w) << 16);
        ((u32x2*)(BUF + (size_t)d * DM))[lane + 64 * j] = o; }
    if (lane == 0) { roww[d] = weights[a]; dest[a] = d; }
}
__global__ __launch_bounds__(256) void s_combine_norm(float* __restrict__ X, const bf16_t* __restrict__ YB, const int* __restrict__ dest, const float* __restrict__ g, bf16_t* __restrict__ H, float* __restrict__ OUT) {
    const int lane = threadIdx.x & 63, row = blockIdx.x * 4 + (threadIdx.x >> 6);
    const int d0 = dest[row * 2], d1 = dest[row * 2 + 1];
    f32x4* xr = (f32x4*)(X + (size_t)row * DM);
    f32x4 v[4]; float s = 0.f;
#pragma unroll
    for (int j = 0; j < 4; ++j) { v[j] = xr[lane + 64 * j];
        const u32x2 a = ((const u32x2*)(YB + (size_t)d0 * DM))[lane + 64 * j], b = ((const u32x2*)(YB + (size_t)d1 * DM))[lane + 64 * j];
        v[j].x += __uint_as_float(a.x << 16) + __uint_as_float(b.x << 16); v[j].y += __uint_as_float(a.x & 0xffff0000u) + __uint_as_float(b.x & 0xffff0000u);
        v[j].z += __uint_as_float(a.y << 16) + __uint_as_float(b.y << 16); v[j].w += __uint_as_float(a.y & 0xffff0000u) + __uint_as_float(b.y & 0xffff0000u);
        s += v[j].x * v[j].x + v[j].y * v[j].y + v[j].z * v[j].z + v[j].w * v[j].w; }
    const float rs = rsqrtf(wave_sum(s) * (1.f / DM) + EPS);
#pragma unroll
    for (int j = 0; j < 4; ++j) { const f32x4 gg = ((const f32x4*)g)[lane + 64 * j];
        if (H) { xr[lane + 64 * j] = v[j];
            u32x2 o; o.x = f2bf(v[j].x * rs * gg.x) | ((unsigned)f2bf(v[j].y * rs * gg.y) << 16); o.y = f2bf(v[j].z * rs * gg.z) | ((unsigned)f2bf(v[j].w * rs * gg.w) << 16);
            ((u32x2*)(H + (size_t)row * DM))[lane + 64 * j] = o; }
        else { f32x4 o; o.x = v[j].x * rs * gg.x; o.y = v[j].y * rs * gg.y; o.z = v[j].z * rs * gg.z; o.w = v[j].w * rs * gg.w; ((f32x4*)(OUT + (size_t)row * DM))[lane + 64 * j] = o; }
    }
}

#define LAS __attribute__((address_space(3)))
#define GAS __attribute__((address_space(1)))
typedef short bf16x8 __attribute__((ext_vector_type(8)));
typedef short s16x4 __attribute__((ext_vector_type(4)));
typedef float f32x16 __attribute__((ext_vector_type(16)));
typedef float f32x2 __attribute__((ext_vector_type(2)));

constexpr size_t WB_IN = 0, WB_UP = 6029312, WB_OUT = WB_UP + 1572864, WB_GU = WB_OUT + 1048576, WB_DN = WB_GU + 33554432, WB_LAYER = WB_DN + 16777216;
constexpr size_t WB_MEMKV = 2 * WB_LAYER;
constexpr size_t WB_RT = WB_MEMKV + 1048576;
static_assert(WS_WB + (WB_RT + 2 * 2 * 48 * 1024) * 2 <= WS_END, "weight copies fit");
constexpr int N_PHASES = 19;
constexpr int LCAP = 16384;

__device__ __forceinline__ int lane_id() { int r; asm volatile("v_mbcnt_lo_u32_b32 %0, -1, 0\n\tv_mbcnt_hi_u32_b32 %0, -1, %0" : "=v"(r)); return r; }
__device__ __forceinline__ unsigned cvt_pk_bf16(float lo, float hi) { unsigned r; asm volatile("v_cvt_pk_bf16_f32 %0, %1, %2" : "=v"(r) : "v"(lo), "v"(hi)); return r; }
__device__ __forceinline__ float fast_sigmoid(float v) { return __builtin_amdgcn_rcpf(1.f + __builtin_amdgcn_exp2f(-v * LOG2E)); }

namespace pg8 {
#define PG8_LAS LAS
constexpr int BM = 256, BK = 64, HALF = 128, HTB = HALF * BK * 2, STAGE_BYTES = 8 * HTB, NXCD = 8, WGM = 8;
__host__ __device__ __forceinline__ int lds_byte(int r, int c) { const int st = (r >> 4) * 2 + (c >> 5), rr = r & 15, cc = c & 31, ob = rr * 64 + cc * 2; return st * 1024 + (ob ^ (((ob >> 9) & 1) << 5)); }
__host__ __device__ __forceinline__ void stage_rc(int b, int& R, int& C) { const int st = b / 1024, sb = b % 1024, swz = sb ^ (((sb >> 9) & 1) << 5); R = (st >> 1) * 16 + swz / 64; C = (st & 1) * 32 + (swz % 64) / 2; }
__host__ __device__ __forceinline__ int perm32(int rho) { const int n = rho >> 4, i = rho & 15; return 8 * (i >> 2) + 4 * n + (i & 3); }

struct Unit { int pm, pn, sub, ord; const char* a; const char* b; };
struct Gemm { int lda; int K; };
__device__ __forceinline__ void tile_order(int L, int nM, int nN, int& pm, int& pn) {
    const int nwg = nM * nN; int wgid = L; { const int q = nwg / NXCD, r = nwg % NXCD, xcd = wgid % NXCD, off = wgid / NXCD; wgid = (xcd < r ? xcd * (q + 1) : r * (q + 1) + (xcd - r) * q) + off; }
    const int nig = WGM * nN, gid = wgid / nig, fm = gid * WGM, gsz = (nM - fm) < WGM ? (nM - fm) : WGM;
    pm = fm + ((wgid % nig) % gsz); pn = (wgid % nig) / gsz;
}
__device__ __forceinline__ u32x4 pack8(const f32x4& v0, const f32x4& v1) { u32x4 w; w.x = cvt_pk_bf16(v0[0], v0[1]); w.y = cvt_pk_bf16(v0[2], v0[3]); w.z = cvt_pk_bf16(v1[0], v1[1]); w.w = cvt_pk_bf16(v1[2], v1[3]); return w; }
__device__ __forceinline__ void unpack8(const u32x4& w, f32x4& v0, f32x4& v1) {
    v0[0] = __uint_as_float(w.x << 16); v0[1] = __uint_as_float(w.x & 0xffff0000u); v0[2] = __uint_as_float(w.y << 16); v0[3] = __uint_as_float(w.y & 0xffff0000u);
    v1[0] = __uint_as_float(w.z << 16); v1[1] = __uint_as_float(w.z & 0xffff0000u); v1[2] = __uint_as_float(w.w << 16); v1[3] = __uint_as_float(w.w & 0xffff0000u); }

struct EpiProj {
    static constexpr bool PERM = true, AFTER_DRAIN = false;
    bf16_t* PROJ; bf16_t* MEMKV; const float* tab1; const float* tab2; const float* qg; const float* kg;
    __device__ __forceinline__ void operator()(const f32x4 (&acc)[2][2][4][2], const Unit& u, int wr, int wc, int fr, int fq) const {
        const int colt = u.pn * 256, dcol = colt + wc * 64 + fq * 8, row0 = u.pm * 256 + wr * 64 + fr;
        if (u.sub == 1) {
#pragma unroll
            for (int ai = 0; ai < 2; ++ai)
#pragma unroll
                for (int m = 0; m < 4; ++m) { bf16_t* rowp = MEMKV + (size_t)(row0 + ai * 128 + m * 16) * 1024 + dcol;
#pragma unroll
                    for (int bj = 0; bj < 2; ++bj) *(u32x4*)(rowp + bj * 32) = pack8(acc[ai][bj][m][0], acc[ai][bj][m][1]); }
            return;
        }
        int mode = 0; float sc = 1.f; const float* g = qg;
        if (colt < C_AV) { mode = 1; if (colt < C_AK) sc = C2_64; }
        else if (colt < C_BQ) mode = 0;
        else if (colt < C_BK) { mode = 2; sc = C2_64; }
        else if (colt < C_CQ) { if (wc < 2) { mode = 2; g = kg; } }
        else if (colt < C_G) sc = C2_128;
        else mode = 3;
        f32x4 gv[2][2];
        if (mode == 2) {
#pragma unroll
            for (int bj = 0; bj < 2; ++bj)
#pragma unroll
                for (int n = 0; n < 2; ++n) gv[bj][n] = *(const f32x4*)(g + bj * 32 + fq * 8 + n * 4);
        }
#pragma unroll
        for (int ai = 0; ai < 2; ++ai)
#pragma unroll
            for (int m = 0; m < 4; ++m) {
                const int row = row0 + ai * 128 + m * 16, pos = row & (SEQ - 1);
                f32x4 v[2][2] = {{acc[ai][0][m][0], acc[ai][0][m][1]}, {acc[ai][1][m][0], acc[ai][1][m][1]}};
                if (mode == 2) {
                    float ss = 0.f;
#pragma unroll
                    for (int bj = 0; bj < 2; ++bj)
#pragma unroll
                        for (int n = 0; n < 2; ++n) ss += (v[bj][n][0] * v[bj][n][0] + v[bj][n][1] * v[bj][n][1]) + (v[bj][n][2] * v[bj][n][2] + v[bj][n][3] * v[bj][n][3]);
                    ss += __shfl_xor(ss, 16); ss += __shfl_xor(ss, 32);
                    const float rs = rsqrtf(ss * (1.f / 64.f) + EPS);
#pragma unroll
                    for (int bj = 0; bj < 2; ++bj)
#pragma unroll
                        for (int n = 0; n < 2; ++n) v[bj][n] = v[bj][n] * rs * gv[bj][n];
                }
                if (mode == 1 || mode == 2) {
                    const float* tb = (mode == 1 ? tab1 : tab2) + ((size_t)pos * 32 + fq * 8) * 2;
#pragma unroll
                    for (int n = 0; n < 2; ++n) { const f32x4 t0 = *(const f32x4*)(tb + n * 8), t1 = *(const f32x4*)(tb + n * 8 + 4);
                        const float cs[4] = {t0[0], t0[2], t1[0], t1[2]}, sn[4] = {t0[1], t0[3], t1[1], t1[3]};
#pragma unroll
                        for (int e = 0; e < 4; ++e) { const float x1 = v[0][n][e], x2 = v[1][n][e]; v[0][n][e] = x1 * cs[e] - x2 * sn[e]; v[1][n][e] = x2 * cs[e] + x1 * sn[e]; } }
                }
                if (mode == 3) {
#pragma unroll
                    for (int bj = 0; bj < 2; ++bj)
#pragma unroll
                        for (int n = 0; n < 2; ++n)
#pragma unroll
                            for (int e = 0; e < 4; ++e) v[bj][n][e] = fast_sigmoid(v[bj][n][e]);
                }
                bf16_t* rowp = PROJ + (size_t)row * D_IN + dcol;
#pragma unroll
                for (int bj = 0; bj < 2; ++bj) *(u32x4*)(rowp + bj * 32) = pack8(v[bj][0] * sc, v[bj][1] * sc);
            }
    }
};
struct EpiGate {
    static constexpr bool PERM = true, AFTER_DRAIN = false;
    bf16_t* MERGED; const bf16_t* PROJ;
    __device__ __forceinline__ void operator()(const f32x4 (&acc)[2][2][4][2], const Unit& u, int wr, int wc, int fr, int fq) const {
        const int col0 = u.pn * 256 + wc * 32 + fq * 8, row0 = u.pm * 256 + wr * 64 + fr;
#pragma unroll
        for (int ai = 0; ai < 2; ++ai)
#pragma unroll
            for (int mp = 0; mp < 2; ++mp) {
                u32x4 gq[2][2], oq[2][2];
#pragma unroll
                for (int mi = 0; mi < 2; ++mi) { const int row = row0 + ai * 128 + (mp * 2 + mi) * 16;
                    const bf16_t* gp = PROJ + (size_t)row * D_IN + C_G + u.sub * 1024 + col0; const bf16_t* op = MERGED + (size_t)row * DM + col0;
#pragma unroll
                    for (int bj = 0; bj < 2; ++bj) { gq[mi][bj] = *(const u32x4*)(gp + bj * 128); if (u.sub != 0) oq[mi][bj] = *(const u32x4*)(op + bj * 128); else oq[mi][bj] = (u32x4){0u, 0u, 0u, 0u}; } }
                asm volatile("" ::: "memory");
#pragma unroll
                for (int mi = 0; mi < 2; ++mi) { const int m = mp * 2 + mi; bf16_t* op = MERGED + (size_t)(row0 + ai * 128 + m * 16) * DM + col0;
#pragma unroll
                    for (int bj = 0; bj < 2; ++bj) { f32x4 g0, g1, o0, o1; unpack8(gq[mi][bj], g0, g1); unpack8(oq[mi][bj], o0, o1);
                        o0 += g0 * acc[ai][bj][m][0]; o1 += g1 * acc[ai][bj][m][1];
                        *(u32x4*)(op + bj * 128) = pack8(o0, o1); } }
                asm volatile("" ::: "memory");
            }
    }
};
struct EpiResid {
    static constexpr bool PERM = true, AFTER_DRAIN = false;
    const float* Xin; float* X;
    __device__ __forceinline__ void operator()(const f32x4 (&acc)[2][2][4][2], const Unit& u, int wr, int wc, int fr, int fq) const {
        const int col0 = u.pn * 256 + wc * 32 + fq * 8, row0 = u.pm * 256 + wr * 64 + fr;
#pragma unroll
        for (int ai = 0; ai < 2; ++ai)
#pragma unroll
            for (int mp = 0; mp < 2; ++mp) {
                f32x4 xin[2][2][2];
#pragma unroll
                for (int mi = 0; mi < 2; ++mi) { const size_t off = (size_t)(row0 + ai * 128 + (mp * 2 + mi) * 16) * DM + col0;
#pragma unroll
                    for (int bj = 0; bj < 2; ++bj) { const f32x4* pi = (const f32x4*)(Xin + off + bj * 128); xin[mi][bj][0] = pi[0]; xin[mi][bj][1] = pi[1]; } }
                asm volatile("" ::: "memory");
#pragma unroll
                for (int mi = 0; mi < 2; ++mi) { const int m = mp * 2 + mi; const size_t off = (size_t)(row0 + ai * 128 + m * 16) * DM + col0;
#pragma unroll
                    for (int bj = 0; bj < 2; ++bj) { f32x4* po = (f32x4*)(X + off + bj * 128); po[0] = xin[mi][bj][0] + acc[ai][bj][m][0]; po[1] = xin[mi][bj][1] + acc[ai][bj][m][1]; } }
                asm volatile("" ::: "memory");
            }
    }
};
struct EpiSilu {
    static constexpr bool PERM = true, AFTER_DRAIN = false;
    bf16_t* HID;
    __device__ __forceinline__ void operator()(const f32x4 (&acc)[2][2][4][2], const Unit& u, int wr, int wc, int fr, int fq) const {
        const __amdgpu_buffer_rsrc_t rsrc = __builtin_amdgcn_make_buffer_rsrc((void*)HID, 0, P_ROWS * DEXP * 2, 0x00020000);
        const int col0 = u.pn * 128 + wc * 32 + fq * 8, row0 = u.pm * 256 + wr * 64 + fr;
#pragma unroll
        for (int ai = 0; ai < 2; ++ai)
#pragma unroll
            for (int m = 0; m < 4; ++m) { f32x4 h[2];
#pragma unroll
                for (int n = 0; n < 2; ++n)
#pragma unroll
                    for (int e = 0; e < 4; ++e) { const float gq = acc[ai][0][m][n][e]; h[n][e] = gq * fast_sigmoid(gq) * acc[ai][1][m][n][e]; }
                __builtin_amdgcn_raw_buffer_store_b128(pack8(h[0], h[1]), rsrc, ((row0 + ai * 128 + m * 16) * DEXP + col0) * 2, 0, 16); }
    }
};
struct EpiRowScale {
    static constexpr bool PERM = true, AFTER_DRAIN = false;
    bf16_t* YB; const PG8_LAS float* wtab;
    __device__ __forceinline__ void operator()(const f32x4 (&acc)[2][2][4][2], const Unit& u, int wr, int wc, int fr, int fq) const {
        const int col0 = u.pn * 256 + wc * 32 + fq * 8, rt0 = wr * 64 + fr;
#pragma unroll
        for (int ai = 0; ai < 2; ++ai)
#pragma unroll
            for (int m = 0; m < 4; ++m) { const int rt = rt0 + ai * 128 + m * 16; const float w = wtab[u.ord * 256 + rt]; bf16_t* op = YB + (size_t)(u.pm * 256 + rt) * DM + col0;
#pragma unroll
                for (int bj = 0; bj < 2; ++bj) *(u32x4*)(op + bj * 128) = pack8(acc[ai][bj][m][0] * w, acc[ai][bj][m][1] * w); }
    }
};
struct SchedProj {
    int c, G, nmain, ntotal; const char* A; const char* B; const char* Am; const char* Bm;
    __device__ __forceinline__ bool next(int i, Unit& u) const {
        const long L = (long)i * G + c; if (L >= ntotal) return false;
        u.ord = i;
        if (L < nmain) { tile_order((int)L, M / 256, D_IN / 256, u.pm, u.pn); u.sub = 0; u.a = A + (size_t)u.pm * (256 * DM * 2); u.b = B + (size_t)u.pn * (256 * DM * 2); }
        else { const int r = (int)L - nmain; u.pm = r >> 2; u.pn = r & 3; u.sub = 1; u.a = Am + (size_t)u.pm * (256 * DM * 2); u.b = Bm + (size_t)u.pn * (256 * DM * 2); }
        return true; }
    __device__ __forceinline__ void a_ready(const Unit&) const {}
    __device__ __forceinline__ void done(const Unit&) const {}
};
struct SchedGate {
    int c, G; const char* OBRp; const char* WUP;
    __device__ __forceinline__ bool next(int i, Unit& u) const {
        const int t = c + G * (i / 3); if (t >= 256) return false;
        tile_order(t, M / 256, 4, u.pm, u.pn); u.sub = i % 3; u.ord = i;
        u.a = OBRp + ((size_t)u.pm * 256 * OBR_W + 512 * u.sub) * 2; u.b = WUP + ((size_t)u.sub * 1024 * 512 + (size_t)u.pn * 256 * 512) * 2; return true; }
    __device__ __forceinline__ void a_ready(const Unit&) const {}
    __device__ __forceinline__ void done(const Unit&) const {}
};
struct SchedPlain {
    int c, G, nM; const char* A; const char* B; size_t a_tile, b_tile;
    __device__ __forceinline__ bool next(int i, Unit& u) const {
        const long L = (long)i * G + c; if (L >= (long)nM * 4) return false;
        tile_order((int)L, nM, 4, u.pm, u.pn); u.sub = 0; u.ord = i; u.a = A + (size_t)u.pm * a_tile; u.b = B + (size_t)u.pn * b_tile; return true; }
    __device__ __forceinline__ void a_ready(const Unit&) const {}
    __device__ __forceinline__ void done(const Unit&) const {}
};
struct SchedMoeUp {
    static constexpr size_t b_exp = (size_t)1024 * 1024 * 2, b_tile = (size_t)256 * DM * 2;
    int c, G, ntiles; const PG8_LAS int* tile_e; const char* A; const char* B; unsigned* tcnt;
    __device__ __forceinline__ bool next(int i, Unit& u) const {
        const long L = (long)i * G + c; if (L >= (long)ntiles * 4) return false;
        u.pm = (int)(L >> 2); u.pn = (int)(L & 3); u.sub = 0; u.ord = i; const int e = tile_e[u.pm];
        u.a = A; u.b = B + (size_t)e * b_exp + (size_t)u.pn * b_tile; return true; }
    __device__ __forceinline__ void a_ready(const Unit&) const {}
    __device__ __forceinline__ void done(const Unit& u) const {
        asm volatile("s_waitcnt vmcnt(0)" ::: "memory");
        if (lane_id() == 0) __hip_atomic_fetch_add(tcnt + 64 * u.pm, 1u, __ATOMIC_RELAXED, __HIP_MEMORY_SCOPE_AGENT);
    }
};
__device__ __forceinline__ int moe_down_unit(int c, int i, int rem, int G) {
    const int n0 = G - rem, n1 = rem;
    return c >= rem ? n0 * i + n1 * (i > 1 ? i - 1 : 0) + (c - rem) : n0 * (i + 2) + n1 * i + c;
}
struct SchedMoeDown {
    static constexpr size_t a_tile = (size_t)256 * DEXP * 2, b_exp = (size_t)1024 * 512 * 2, b_tile = (size_t)256 * DEXP * 2;
    int c, G, ntiles, rem, wv; const PG8_LAS int* tile_e; const char* A; const char* B; unsigned* tcnt; unsigned* tmo;
    __device__ __forceinline__ bool next(int i, Unit& u) const {
        const int j = moe_down_unit(c, i, rem, G); if (j >= ntiles * 4) return false;
        u.pm = j >> 2; u.pn = j & 3; u.sub = 0; u.ord = i; const int e = tile_e[u.pm];
        u.a = A + (size_t)u.pm * a_tile; u.b = B + (size_t)e * b_exp + (size_t)u.pn * b_tile; return true; }
    __device__ __forceinline__ void a_ready(const Unit& u) const {
        if (wv == 0) {
            unsigned polls = 0;
            while ((unsigned)__builtin_amdgcn_readfirstlane(__hip_atomic_load(tcnt + 64 * u.pm, __ATOMIC_RELAXED, __HIP_MEMORY_SCOPE_AGENT)) < 32u) {
                if (++polls > (1u << 20)) { if (lane_id() == 0) __hip_atomic_store(tmo, 1u, __ATOMIC_RELAXED, __HIP_MEMORY_SCOPE_AGENT); break; }
                __builtin_amdgcn_s_sleep(2); }
            __builtin_amdgcn_fence(__ATOMIC_ACQUIRE, "agent");
            asm volatile("s_waitcnt vmcnt(0)" ::: "memory");
        }
        asm volatile("" ::: "memory"); __builtin_amdgcn_s_barrier(); asm volatile("" ::: "memory");
    }
    __device__ __forceinline__ void done(const Unit&) const {}
};

template <class Epi, class Sched, bool ALIGN_EPI = false, bool SP2 = false, bool GATHER = false>
__device__ __forceinline__ void gemm_phase(PG8_LAS unsigned char* lds, const Gemm g, const Sched& S, const Epi& E, int wave_id, const PG8_LAS unsigned* rowtab = nullptr) {
    static_assert(!GATHER || SP2, "the gathered A path is written for the two-super-phase loop");
    int tid_ = wave_id * 64 + lane_id(); asm volatile("" : "+v"(tid_));
    const int tid = tid_, wid = __builtin_amdgcn_readfirstlane(tid >> 6), lane = tid & 63, wr = wid >> 2, wc = wid & 3, fr = lane & 15, fq = lane >> 4;
    const int K = g.K, nt = K / BK;
    unsigned voffA[2], voffB[2];
#pragma unroll
    for (int i = 0; i < 2; ++i) { int R, C; stage_rc(tid * 16 + i * 8192, R, C); const int Rb = Epi::PERM ? ((R & ~31) + perm32(R & 31)) : R;
        voffA[i] = (unsigned)(R * g.lda + C) * 2u; voffB[i] = (unsigned)(Rb * K + C) * 2u; }
    unsigned gC[2][2] = {{0u, 0u}, {0u, 0u}}, gN[2][2] = {{0u, 0u}, {0u, 0u}};
#define PG8_GROWS(dst, ord) do { if constexpr (GATHER) { _Pragma("unroll") for (int i_ = 0; i_ < 2; ++i_) { int R_, C_; stage_rc((wid * 64 + fq * 16 + fr) * 16 + i_ * 8192, R_, C_);     \
        _Pragma("unroll") for (int h_ = 0; h_ < 2; ++h_) dst[h_][i_] = rowtab[(ord) * 256 + h_ * 128 + R_] + (unsigned)C_ * 2u; } } } while (0)
#define PG8_STAGE_A(bufoff, base, h, use_next) do { if constexpr (GATHER) { unsigned vo_[2]; vo_[0] = (use_next) ? gN[h][0] : gC[h][0]; vo_[1] = (use_next) ? gN[h][1] : gC[h][1]; PG8_STAGE(bufoff, base, vo_); } \
        else { PG8_STAGE(bufoff, (base) + (h) * hstepA, voffA); } } while (0)
    const size_t kstep = (size_t)(BK * 2);
    const size_t hstepA = (size_t)HALF * g.lda * 2, hstepB = (size_t)HALF * K * 2;
    const unsigned ldsw = (unsigned)wid * 1024u;
    const int aoff = lds_byte(wr * 64 + fr, fq * 8), boff = lds_byte(wc * 32 + fr, fq * 8);
#define PG8_SA(b, h) (((b) * 2 + (h)) * HTB)
#define PG8_SB(b, h) ((4 + (b) * 2 + (h)) * HTB)
#define PG8_STAGE(bufoff, gbase, voff) do { _Pragma("unroll") for (int _i = 0; _i < 2; ++_i) \
        __builtin_amdgcn_global_load_lds((const unsigned*)((const char*)(gbase) + (voff)[_i]), (PG8_LAS unsigned*)(lds + (bufoff) + ldsw + _i * 8192), 16, 0, 0); } while (0)
#define PG8_LDA(dst, b, h) do { _Pragma("unroll") for (int m = 0; m < 4; ++m) _Pragma("unroll") for (int k = 0; k < 2; ++k) dst[m][k] = *(const PG8_LAS bf16x8*)(lds + PG8_SA(b, h) + aoff + m * 2048 + k * 1024); } while (0)
#define PG8_LDB(dst, b, h) do { _Pragma("unroll") for (int n = 0; n < 2; ++n) _Pragma("unroll") for (int k = 0; k < 2; ++k) dst[n][k] = *(const PG8_LAS bf16x8*)(lds + PG8_SB(b, h) + boff + n * 2048 + k * 1024); } while (0)
#define PG8_MMA(ai, bj, At, Bt) do { __builtin_amdgcn_s_setprio(1); _Pragma("unroll") for (int m = 0; m < 4; ++m) _Pragma("unroll") for (int n = 0; n < 2; ++n) _Pragma("unroll") for (int k = 0; k < 2; ++k) \
        acc[ai][bj][m][n] = __builtin_amdgcn_mfma_f32_16x16x32_bf16(Bt[n][k], At[m][k], acc[ai][bj][m][n], 0, 0, 0); __builtin_amdgcn_s_setprio(0); } while (0)
#define PG8_WAIT_V(n) asm volatile("s_waitcnt vmcnt(" #n ")" ::: "memory")
#define PG8_WAIT_L(n) asm volatile("s_waitcnt lgkmcnt(" #n ")" ::: "memory")
#define PG8_BAR __builtin_amdgcn_s_barrier()
#define PG8_SCHED __builtin_amdgcn_sched_barrier(0)
    Unit cur, nxt; int ui = 0;
    if (!S.next(0, cur)) return;
    f32x4 acc[2][2][4][2];
#pragma unroll
    for (int a = 0; a < 2; ++a)
#pragma unroll
        for (int b = 0; b < 2; ++b)
#pragma unroll
            for (int m = 0; m < 4; ++m)
#pragma unroll
                for (int n = 0; n < 2; ++n) acc[a][b][m][n] = (f32x4){0.f, 0.f, 0.f, 0.f};
    bf16x8 At[4][2], B0[2][2], B1[2][2];
    const char* cA = cur.a; const char* cB = cur.b;
    S.a_ready(cur);
    if constexpr (SP2) {
        PG8_GROWS(gC, 0);
        PG8_STAGE(PG8_SB(0, 0), cB, voffB); PG8_STAGE(PG8_SB(0, 1), cB + hstepB, voffB); PG8_STAGE_A(PG8_SA(0, 0), cA, 0, false); PG8_STAGE_A(PG8_SA(0, 1), cA, 1, false);
        if (wr == 1) PG8_BAR;
        PG8_WAIT_V(2); PG8_BAR;
        PG8_STAGE(PG8_SB(1, 0), cB + kstep, voffB); PG8_STAGE_A(PG8_SA(1, 0), cA + kstep, 0, false); PG8_STAGE(PG8_SB(1, 1), cB + hstepB + kstep, voffB);
        PG8_WAIT_V(6); PG8_BAR;
    } else {
        PG8_STAGE(PG8_SB(0, 0), cB, voffB); PG8_STAGE(PG8_SA(0, 0), cA, voffA); PG8_STAGE(PG8_SB(0, 1), cB + hstepB, voffB); PG8_STAGE(PG8_SA(0, 1), cA + hstepA, voffA);
        if (wr == 1) PG8_BAR;
        PG8_WAIT_V(4); PG8_BAR;
        PG8_STAGE(PG8_SB(1, 0), cB + kstep, voffB); PG8_STAGE(PG8_SA(1, 0), cA + kstep, voffA); PG8_STAGE(PG8_SB(1, 1), cB + hstepB + kstep, voffB);
        PG8_WAIT_V(6); PG8_BAR;
    }
    for (;;) {
        const bool has_next = S.next(ui + 1, nxt);
        const char* nA = has_next ? nxt.a : cA; const char* nB = has_next ? nxt.b : cB;
        for (int t = 0; t < nt; t += 2) {
            const bool last = (t == nt - 2);
            const char* a1 = cA + (size_t)(t + 1) * kstep;
            const char* a2 = last ? nA : cA + (size_t)(t + 2) * kstep; const char* b2 = last ? nB : cB + (size_t)(t + 2) * kstep;
            const char* a3 = a2 + kstep; const char* b3 = b2 + kstep;
            if (last && has_next) S.a_ready(nxt);
            if constexpr (GATHER) { if (last) { if (has_next) { PG8_GROWS(gN, ui + 1); } else { _Pragma("unroll") for (int h_ = 0; h_ < 2; ++h_) _Pragma("unroll") for (int i_ = 0; i_ < 2; ++i_) gN[h_][i_] = gC[h_][i_]; } } }
            if constexpr (SP2) {
            PG8_LDB(B0, 0, 0); PG8_LDB(B1, 0, 1); PG8_SCHED; PG8_LDA(At, 0, 0); PG8_STAGE_A(PG8_SA(1, 1), a1, 1, false);
            PG8_WAIT_V(8); PG8_WAIT_L(0); PG8_BAR; PG8_MMA(0, 0, At, B0); PG8_MMA(0, 1, At, B1); PG8_BAR; PG8_SCHED;
            PG8_LDA(At, 0, 1); PG8_STAGE(PG8_SB(0, 0), b2, voffB); PG8_STAGE(PG8_SB(0, 1), b2 + hstepB, voffB); PG8_STAGE_A(PG8_SA(0, 0), a2, 0, last);
            PG8_WAIT_V(8); PG8_WAIT_L(0); PG8_BAR; PG8_MMA(1, 0, At, B0); PG8_MMA(1, 1, At, B1); PG8_BAR; PG8_SCHED;
            PG8_LDB(B0, 1, 0); PG8_LDB(B1, 1, 1); PG8_SCHED; PG8_LDA(At, 1, 0); PG8_STAGE_A(PG8_SA(0, 1), a2, 1, last);
            PG8_WAIT_V(8); PG8_WAIT_L(0); PG8_BAR; PG8_MMA(0, 0, At, B0); PG8_MMA(0, 1, At, B1); PG8_BAR; PG8_SCHED;
            PG8_LDA(At, 1, 1); PG8_STAGE(PG8_SB(1, 0), b3, voffB); PG8_STAGE(PG8_SB(1, 1), b3 + hstepB, voffB); PG8_STAGE_A(PG8_SA(1, 0), a3, 0, last);
            PG8_WAIT_V(8); PG8_WAIT_L(0); PG8_BAR; PG8_MMA(1, 0, At, B0); PG8_MMA(1, 1, At, B1); PG8_BAR; PG8_SCHED;
            } else {
            PG8_LDB(B0, 0, 0); PG8_SCHED; PG8_LDA(At, 0, 0); PG8_STAGE(PG8_SA(1, 1), a1 + hstepA, voffA);
            PG8_WAIT_L(8); PG8_BAR; PG8_WAIT_L(0); PG8_MMA(0, 0, At, B0); PG8_BAR; PG8_SCHED;
            PG8_LDB(B1, 0, 1); PG8_STAGE(PG8_SB(0, 0), b2, voffB);
            PG8_BAR; PG8_WAIT_L(0); PG8_MMA(0, 1, At, B1); PG8_BAR;
            PG8_LDA(At, 0, 1); PG8_STAGE(PG8_SA(0, 0), a2, voffA);
            PG8_BAR; PG8_WAIT_L(0); PG8_MMA(1, 0, At, B0); PG8_BAR; PG8_SCHED;
            PG8_STAGE(PG8_SB(0, 1), b2 + hstepB, voffB);
            PG8_WAIT_V(6); PG8_BAR; PG8_MMA(1, 1, At, B1); PG8_BAR;
            PG8_LDB(B0, 1, 0); PG8_SCHED; PG8_LDA(At, 1, 0); PG8_STAGE(PG8_SA(0, 1), a2 + hstepA, voffA);
            PG8_WAIT_L(8); PG8_BAR; PG8_WAIT_L(0); PG8_MMA(0, 0, At, B0); PG8_BAR; PG8_SCHED;
            PG8_LDB(B1, 1, 1); PG8_STAGE(PG8_SB(1, 0), b3, voffB);
            PG8_BAR; PG8_WAIT_L(0); PG8_MMA(0, 1, At, B1); PG8_BAR;
            PG8_LDA(At, 1, 1); PG8_STAGE(PG8_SA(1, 0), a3, voffA);
            PG8_BAR; PG8_WAIT_L(0); PG8_MMA(1, 0, At, B0); PG8_BAR; PG8_SCHED;
            PG8_STAGE(PG8_SB(1, 1), b3 + hstepB, voffB);
            PG8_WAIT_V(6); PG8_BAR; PG8_MMA(1, 1, At, B1); PG8_BAR;
            }
        }
        if constexpr (ALIGN_EPI) { if (wr == 0) PG8_BAR; }
        if constexpr (!Epi::AFTER_DRAIN) { E(acc, cur, wr, wc, fr, fq); S.done(cur); }
        if (!has_next) break;
#pragma unroll
        for (int a = 0; a < 2; ++a)
#pragma unroll
            for (int b = 0; b < 2; ++b)
#pragma unroll
                for (int m = 0; m < 4; ++m)
#pragma unroll
                    for (int n = 0; n < 2; ++n) acc[a][b][m][n] = (f32x4){0.f, 0.f, 0.f, 0.f};
        cur = nxt; cA = nA; cB = nB; ++ui;
        if constexpr (GATHER) { _Pragma("unroll") for (int h_ = 0; h_ < 2; ++h_) _Pragma("unroll") for (int i_ = 0; i_ < 2; ++i_) gC[h_][i_] = gN[h_][i_]; }
        if constexpr (ALIGN_EPI) { if (wr == 1) PG8_BAR; }
    }
    PG8_WAIT_V(0);
    if constexpr (!ALIGN_EPI) { if (wr == 0) PG8_BAR; }
    PG8_BAR;
    if constexpr (Epi::AFTER_DRAIN) { E.fused(acc, cur, wr, wc, fr, fq, lds, wid, lane); S.done(cur); }
#undef PG8_SA
#undef PG8_GROWS
#undef PG8_STAGE_A
#undef PG8_SB
#undef PG8_STAGE
#undef PG8_LDA
#undef PG8_LDB
#undef PG8_MMA
#undef PG8_WAIT_V
#undef PG8_WAIT_L
#undef PG8_BAR
#undef PG8_SCHED
}
}

namespace att {
constexpr int NW = 8, QBLK = 32, KVBLK = 64;
constexpr float THR = 8.f;
#define ATT_SBAR() __builtin_amdgcn_sched_barrier(0)
__device__ __forceinline__ int crow(int r, int hi) { return (r & 3) + 8 * (r >> 2) + 4 * hi; }
template <int D> __device__ __forceinline__ int kswz(int row, int colB) { return D == 128 ? row * 256 + (colB ^ ((row & 7) << 4)) : row * 128 + (colB ^ (((row >> 1) & 7) << 4)); }
template <int DV> __device__ __forceinline__ int v_st(int k, int c) { const int kk = (k & ~0xC) | ((k & 4) << 1) | ((k & 8) >> 1); return ((kk >> 3) * (DV / 32) + (c >> 5)) * 512 + ((kk & 7) * 32 + (c & 31)) * 2; }
__device__ __forceinline__ int v_rd_base(int lane) { return ((lane & 3) << 3) | (((lane >> 2) & 3) << 6) | (((lane >> 4) & 1) << 5) | (((lane >> 5) & 1) << 8); }
template <int DV> constexpr int v_rd_off(int d0, int ks, int half) { return d0 * 512 + ks * (DV / 32) * 1024 + half * (DV / 32) * 512; }
template <int OFF> __device__ __forceinline__ s16x4 tr_read(int vb) { s16x4 r; asm volatile("ds_read_b64_tr_b16 %0, %1 offset:%2" : "=&v"(r) : "v"(vb), "i"(OFF) : "memory"); return r; }

__device__ __forceinline__ void partialSM(f32x16& p0, f32x16& p1, float& m_reg, float& mn, float& alpha) {
    float pmax = p0[0];
#pragma unroll
    for (int r = 1; r < 16; ++r) pmax = fmaxf(pmax, p0[r]);
#pragma unroll
    for (int r = 0; r < 16; ++r) pmax = fmaxf(pmax, p1[r]);
    { auto rr = __builtin_amdgcn_permlane32_swap(__float_as_uint(pmax), __float_as_uint(pmax), false, false); pmax = fmaxf(__uint_as_float(rr[0]), __uint_as_float(rr[1])); }
    if (__builtin_expect(__all(pmax - m_reg <= THR), 1)) { mn = m_reg; alpha = 1.f; }
    else { mn = fmaxf(m_reg, pmax); alpha = __builtin_amdgcn_exp2f(m_reg - mn); m_reg = mn; }
#pragma unroll
    for (int r = 0; r < 16; ++r) { p0[r] -= mn; p1[r] -= mn; }
#pragma unroll
    for (int r = 0; r < 16; ++r) p0[r] = __builtin_amdgcn_exp2f(p0[r]);
}
__device__ __forceinline__ void finishSM(f32x16& p0, f32x16& p1, float alpha, float& l_reg, bf16x8& pa0, bf16x8& pa1, bf16x8& pa2, bf16x8& pa3) {
#pragma unroll
    for (int r = 0; r < 16; ++r) p1[r] = __builtin_amdgcn_exp2f(p1[r]);
    float ps = 0;
#pragma unroll
    for (int r = 0; r < 16; ++r) ps += p0[r];
#pragma unroll
    for (int r = 0; r < 16; ++r) ps += p1[r];
    { auto rr = __builtin_amdgcn_permlane32_swap(__float_as_uint(ps), __float_as_uint(ps), false, false); ps = __uint_as_float(rr[0]) + __uint_as_float(rr[1]); }
    l_reg = l_reg * alpha + ps;
#define ATT_PK4(P, BASE, OUT) do { unsigned a0 = cvt_pk_bf16(P[BASE + 0], P[BASE + 1]), a1 = cvt_pk_bf16(P[BASE + 2], P[BASE + 3]);   \
    unsigned b0 = cvt_pk_bf16(P[BASE + 4], P[BASE + 5]), b1 = cvt_pk_bf16(P[BASE + 6], P[BASE + 7]);                              \
    auto r0 = __builtin_amdgcn_permlane32_swap(a0, b0, false, false); auto r1 = __builtin_amdgcn_permlane32_swap(a1, b1, false, false); \
    u32x4 w = {r0[0], r1[0], r0[1], r1[1]}; OUT = *reinterpret_cast<bf16x8*>(&w); } while (0)
    ATT_PK4(p0, 0, pa0); ATT_PK4(p0, 8, pa1); ATT_PK4(p1, 0, pa2); ATT_PK4(p1, 8, pa3);
#undef ATT_PK4
}
template <int DQK> __device__ __forceinline__ void qkt(f32x16& p0, f32x16& p1, const char* Ks, const bf16x8* qr, int r32, int hi) {
    p0 = f32x16{}; p1 = f32x16{};
#pragma unroll
    for (int d0 = 0; d0 < DQK / 16; ++d0) { const int cb = (d0 * 16 + hi * 8) * 2;
        const bf16x8 b0 = *reinterpret_cast<const bf16x8*>(Ks + kswz<DQK>(r32, cb));
        const bf16x8 b1 = *reinterpret_cast<const bf16x8*>(Ks + kswz<DQK>(32 + r32, cb));
        p0 = __builtin_amdgcn_mfma_f32_32x32x16_bf16(b0, qr[d0], p0, 0, 0, 0);
        p1 = __builtin_amdgcn_mfma_f32_32x32x16_bf16(b1, qr[d0], p1, 0, 0, 0); }
}
template <int DV, int D0> __device__ __forceinline__ void pv_one(f32x16& od, int vb, bf16x8 pa0, bf16x8 pa1, bf16x8 pa2, bf16x8 pa3) {
    const s16x4 l0 = tr_read<v_rd_off<DV>(D0, 0, 0)>(vb), h0 = tr_read<v_rd_off<DV>(D0, 0, 1)>(vb), l1 = tr_read<v_rd_off<DV>(D0, 1, 0)>(vb), h1 = tr_read<v_rd_off<DV>(D0, 1, 1)>(vb);
    const s16x4 l2 = tr_read<v_rd_off<DV>(D0, 2, 0)>(vb), h2 = tr_read<v_rd_off<DV>(D0, 2, 1)>(vb), l3 = tr_read<v_rd_off<DV>(D0, 3, 0)>(vb), h3 = tr_read<v_rd_off<DV>(D0, 3, 1)>(vb);
    asm volatile("s_waitcnt lgkmcnt(0)" ::: "memory"); ATT_SBAR();
#define ATT_PK(L, H) (bf16x8){L[0], L[1], L[2], L[3], H[0], H[1], H[2], H[3]}
    od = __builtin_amdgcn_mfma_f32_32x32x16_bf16(pa0, ATT_PK(l0, h0), od, 0, 0, 0);
    od = __builtin_amdgcn_mfma_f32_32x32x16_bf16(pa1, ATT_PK(l1, h1), od, 0, 0, 0);
    od = __builtin_amdgcn_mfma_f32_32x32x16_bf16(pa2, ATT_PK(l2, h2), od, 0, 0, 0);
    od = __builtin_amdgcn_mfma_f32_32x32x16_bf16(pa3, ATT_PK(l3, h3), od, 0, 0, 0);
#undef ATT_PK
}
template <int DV> __device__ __forceinline__ void pv_all(f32x16 (&o)[DV / 32], int vb, bf16x8 pa0, bf16x8 pa1, bf16x8 pa2, bf16x8 pa3) {
    pv_one<DV, 0>(o[0], vb, pa0, pa1, pa2, pa3); pv_one<DV, 1>(o[1], vb, pa0, pa1, pa2, pa3);
    if constexpr (DV == 128) { pv_one<DV, 2>(o[2], vb, pa0, pa1, pa2, pa3); pv_one<DV, 3>(o[3], vb, pa0, pa1, pa2, pa3); }
}
template <int DQK, int DV> struct Lay { static constexpr int SHM_V = 64 * DV * 2, SHM_K = 64 * DQK * 2, OFF_V = 0, OFF_K = 2 * SHM_V, OFF_WS = OFF_K + 2 * SHM_K, OFF_STASH = OFF_WS + NW * 64 * 4; };

template <int DQK, int DV, int LDQ, int LDK, int LDV>
__device__ __forceinline__ void attn_pass(const bf16_t* __restrict__ Qb, const bf16_t* __restrict__ Kh, const bf16_t* __restrict__ Vh, int nkeys, char* lds, f32x16 (&o)[DV / 32], float (&rli)[16], int wv) {
    using L = Lay<DQK, DV>;
    constexpr int NLK = DQK / 64, NLV = DV / 64;
    int tid_ = wv * 64 + lane_id(); asm volatile("" : "+v"(tid_));
    const int tid = tid_, wid = tid >> 6, lane = tid & 63, r32 = lane & 31, hi = lane >> 5;
    char* V_lds = lds + L::OFF_V; char* K_lds = lds + L::OFF_K;
    float* ws = (float*)(lds + L::OFF_WS) + wid * 64; float* li_l = ws; float* al_l = ws + 32;
    float m_reg = -1e30f, l_reg = 0.f; bf16x8 qr[DQK / 16];
#pragma unroll
    for (int d = 0; d < DV / 32; ++d) o[d] = f32x16{};
    const bf16_t* Qw = Qb + (size_t)(wid * QBLK + r32) * LDQ + hi * 8;
#pragma unroll
    for (int d0 = 0; d0 < DQK / 16; ++d0) qr[d0] = *reinterpret_cast<const bf16x8*>(Qw + d0 * 16);
    const int krow = DQK == 128 ? (tid >> 4) : (tid >> 3), kcol = DQK == 128 ? (tid & 15) * 8 : (tid & 7) * 8;
    const int vrow = DV == 128 ? (tid >> 4) : (tid >> 3), vcol = DV == 128 ? (tid & 15) * 8 : (tid & 7) * 8;
    const int vb0 = (int)(uintptr_t)V_lds + v_rd_base(lane);
    bf16x8 vsE[NLV], ksE[NLK], vsO[NLV], ksO[NLK];
#define ATT_SLOAD(VS, KS, k0) do { _Pragma("unroll") for (int i_ = 0; i_ < NLV; ++i_) VS[i_] = *reinterpret_cast<const bf16x8*>(&Vh[(size_t)((k0) + vrow + 32 * i_) * LDV + vcol]); \
    _Pragma("unroll") for (int i_ = 0; i_ < NLK; ++i_) KS[i_] = *reinterpret_cast<const bf16x8*>(&Kh[(size_t)((k0) + krow + 32 * i_) * LDK + kcol]); } while (0)
#define ATT_SWRITE(b, VS, KS) do { _Pragma("unroll") for (int i_ = 0; i_ < NLV; ++i_) *(bf16x8*)(V_lds + (b) * L::SHM_V + v_st<DV>(vrow + 32 * i_, vcol)) = VS[i_]; \
    _Pragma("unroll") for (int i_ = 0; i_ < NLK; ++i_) *(bf16x8*)(K_lds + (b) * L::SHM_K + kswz<DQK>(krow + 32 * i_, kcol * 2)) = KS[i_]; } while (0)
#define ATT_SWAIT() do { if constexpr (NLK + NLV == 4) asm volatile("s_waitcnt vmcnt(4)" ::: "memory"); else if constexpr (NLK + NLV == 3) asm volatile("s_waitcnt vmcnt(3)" ::: "memory"); else asm volatile("s_waitcnt vmcnt(2)" ::: "memory"); } while (0)
#define ATT_RESC(a) do { if (__any((a) < 1.f)) { if (hi == 0) al_l[r32] = (a); asm volatile("s_waitcnt lgkmcnt(0)" ::: "memory"); \
    _Pragma("unroll") for (int d = 0; d < DV / 32; ++d) _Pragma("unroll") for (int r = 0; r < 16; ++r) o[d][r] *= al_l[crow(r, hi)]; } } while (0)
    f32x16 pA0, pA1, pB0, pB1; float mnA, mnB, alA, alB; bf16x8 pa0, pa1, pa2, pa3; const int NT = nkeys / KVBLK;
    __syncthreads();
    ATT_SLOAD(vsE, ksE, 0); asm volatile("s_waitcnt vmcnt(0)" ::: "memory"); ATT_SWRITE(0, vsE, ksE); __syncthreads();
    qkt<DQK>(pA0, pA1, K_lds, qr, r32, hi); partialSM(pA0, pA1, m_reg, mnA, alA);
    ATT_SLOAD(vsO, ksO, KVBLK); if (2 < NT) ATT_SLOAD(vsE, ksE, 2 * KVBLK);
    ATT_SWAIT(); ATT_SWRITE(1, vsO, ksO); __syncthreads();
    for (int j = 1; j + 1 < NT; j += 2) {
        ATT_SBAR(); qkt<DQK>(pB0, pB1, K_lds + L::SHM_K, qr, r32, hi);
        finishSM(pA0, pA1, alA, l_reg, pa0, pa1, pa2, pa3); ATT_SBAR();
        ATT_SLOAD(vsO, ksO, (j + 2) * KVBLK); ATT_SBAR();
        pv_all<DV>(o, vb0, pa0, pa1, pa2, pa3); partialSM(pB0, pB1, m_reg, mnB, alB);
        __syncthreads(); ATT_SWAIT(); ATT_SWRITE(0, vsE, ksE);
        ATT_RESC(alB); __syncthreads();
        ATT_SBAR(); qkt<DQK>(pA0, pA1, K_lds, qr, r32, hi);
        finishSM(pB0, pB1, alB, l_reg, pa0, pa1, pa2, pa3); ATT_SBAR();
        if (j + 3 < NT) ATT_SLOAD(vsE, ksE, (j + 3) * KVBLK); ATT_SBAR();
        pv_all<DV>(o, vb0 + L::SHM_V, pa0, pa1, pa2, pa3); partialSM(pA0, pA1, m_reg, mnA, alA);
        __syncthreads(); ATT_SWAIT(); ATT_SWRITE(1, vsO, ksO);
        ATT_RESC(alA); __syncthreads();
    }
    ATT_SBAR(); qkt<DQK>(pB0, pB1, K_lds + L::SHM_K, qr, r32, hi);
    finishSM(pA0, pA1, alA, l_reg, pa0, pa1, pa2, pa3); ATT_SBAR();
    pv_all<DV>(o, vb0, pa0, pa1, pa2, pa3); partialSM(pB0, pB1, m_reg, mnB, alB);
    __syncthreads(); ATT_RESC(alB);
    finishSM(pB0, pB1, alB, l_reg, pa0, pa1, pa2, pa3); ATT_SBAR();
    pv_all<DV>(o, vb0 + L::SHM_V, pa0, pa1, pa2, pa3);
    if (hi == 0) li_l[r32] = l_reg; asm volatile("s_waitcnt lgkmcnt(0)" ::: "memory");
#pragma unroll
    for (int r = 0; r < 16; ++r) rli[r] = __builtin_amdgcn_rcpf(li_l[crow(r, hi)]);
#undef ATT_SLOAD
#undef ATT_SWRITE
#undef ATT_SWAIT
#undef ATT_RESC
}
template <int DV, int LDO> __device__ __forceinline__ void store_o(bf16_t* Ob, const f32x16 (&o)[DV / 32], const float (&rli)[16], int wv) {
    int tid_ = wv * 64 + lane_id(); asm volatile("" : "+v"(tid_));
    const int tid = tid_, wid = tid >> 6, lane = tid & 63, r32 = lane & 31, hi = lane >> 5;
    bf16_t* Ow = Ob + (size_t)(wid * QBLK) * LDO;
#pragma unroll
    for (int r = 0; r < 16; ++r) { const int orow = crow(r, hi);
#pragma unroll
        for (int d0 = 0; d0 < DV / 32; ++d0) Ow[(size_t)orow * LDO + d0 * 32 + r32] = f2bf(o[d0][r] * rli[r]); }
}
__device__ __forceinline__ void unit_a(const bf16_t* PROJ, bf16_t* OBR, int b, int h, int qb, float lam, float lam_init, const float* subg, char* lds, int wv) {
    using L = Lay<64, 128>;
    int tid_ = wv * 64 + lane_id(); asm volatile("" : "+v"(tid_));
    const int tid = tid_, wid = tid >> 6, lane = tid & 63, r32 = lane & 31, hi = lane >> 5;
    const bf16_t* kv = PROJ + (size_t)b * SEQ * D_IN; const size_t qrow = (size_t)b * SEQ + qb * 256;
    unsigned* stash = (unsigned*)(lds + L::OFF_STASH) + wid * 2048 + lane;
    f32x16 o[4]; float rli[16];
#pragma unroll 1
    for (int c = 0; c < 2; ++c) {
        attn_pass<64, 128, D_IN, D_IN, D_IN>(PROJ + qrow * D_IN + C_AQ + h * 128 + c * 64, kv + C_AK + h * 128 + c * 64, kv + C_AV + h * 128, SEQ, lds, o, rli, wv);
        if (c == 0) {
#pragma unroll
            for (int d0 = 0; d0 < 4; ++d0)
#pragma unroll
                for (int r = 0; r < 16; r += 2) stash[(d0 * 8 + (r >> 1)) * 64] = cvt_pk_bf16(o[d0][r] * rli[r], o[d0][r + 1] * rli[r + 1]);
        }
    }
    asm volatile("s_waitcnt lgkmcnt(0)" ::: "memory");
    float ss[16];
#pragma unroll
    for (int r = 0; r < 16; ++r) ss[r] = 0.f;
#pragma unroll
    for (int d0 = 0; d0 < 4; ++d0)
#pragma unroll
        for (int r = 0; r < 16; r += 2) { const unsigned w = stash[(d0 * 8 + (r >> 1)) * 64];
            const float c0 = __uint_as_float(w << 16) - lam * o[d0][r] * rli[r], c1 = __uint_as_float(w & 0xffff0000u) - lam * o[d0][r + 1] * rli[r + 1];
            o[d0][r] = c0; o[d0][r + 1] = c1; ss[r] += c0 * c0; ss[r + 1] += c1 * c1; }
#pragma unroll
    for (int r = 0; r < 16; ++r) { float s = ss[r]; s += __shfl_xor(s, 1); s += __shfl_xor(s, 2); s += __shfl_xor(s, 4); s += __shfl_xor(s, 8); s += __shfl_xor(s, 16);
        ss[r] = rsqrtf(s * (1.f / 128.f) + EPS) * (1.f - lam_init); }
    bf16_t* Ow = OBR + (qrow + wid * QBLK) * OBR_W + h * 128;
#pragma unroll
    for (int d0 = 0; d0 < 4; ++d0) { const float g = subg[d0 * 32 + r32];
#pragma unroll
        for (int r = 0; r < 16; ++r) Ow[(size_t)crow(r, hi) * OBR_W + d0 * 32 + r32] = f2bf(o[d0][r] * ss[r] * g); }
}
__device__ __forceinline__ void unit_b(const bf16_t* PROJ, bf16_t* OBR, int b, int qh, int qb, char* lds, int wv) {
    const bf16_t* kv = PROJ + (size_t)b * SEQ * D_IN; const size_t qrow = (size_t)b * SEQ + qb * 256;
    f32x16 o[2]; float rli[16];
    attn_pass<64, 64, D_IN, D_IN, D_IN>(PROJ + qrow * D_IN + C_BQ + qh * 64, kv + C_BK + (qh >> 2) * 64, kv + C_BV + (qh >> 2) * 64, SEQ, lds, o, rli, wv);
    store_o<64, OBR_W>(OBR + qrow * OBR_W + 512 + qh * 64, o, rli, wv);
}
__device__ __forceinline__ void unit_c(const bf16_t* PROJ, const bf16_t* MEMKV, bf16_t* OBR, int b, int h, int qb, char* lds, int wv) {
    const bf16_t* kv = MEMKV + (size_t)b * MEM_LEN * 1024; const size_t qrow = (size_t)b * SEQ + qb * 256;
    f32x16 o[4]; float rli[16];
    attn_pass<128, 128, D_IN, 1024, 1024>(PROJ + qrow * D_IN + C_CQ + h * 128, kv + h * 128, kv + 512 + h * 128, MEM_LEN, lds, o, rli, wv);
    store_o<128, OBR_W>(OBR + qrow * OBR_W + 1024 + h * 128, o, rli, wv);
}
#undef ATT_SBAR
}

template <int NR>
__device__ __forceinline__ void rows_rmsnorm(const float* __restrict__ xbase, const float* __restrict__ g, bf16_t* __restrict__ obase, int row0, int lane) {
    f32x4 v[NR][4];
#pragma unroll
    for (int r = 0; r < NR; ++r)
#pragma unroll
        for (int j = 0; j < 4; ++j) v[r][j] = ((const f32x4*)(xbase + (size_t)(row0 + r) * DM))[lane + 64 * j];
    f32x4 gg[4];
#pragma unroll
    for (int j = 0; j < 4; ++j) gg[j] = ((const f32x4*)g)[lane + 64 * j];
#pragma unroll
    for (int r = 0; r < NR; ++r) { float s = 0.f;
#pragma unroll
        for (int j = 0; j < 4; ++j) s += v[r][j].x * v[r][j].x + v[r][j].y * v[r][j].y + v[r][j].z * v[r][j].z + v[r][j].w * v[r][j].w;
        const float rs = rsqrtf(wave_sum(s) * (1.f / DM) + EPS);
#pragma unroll
        for (int j = 0; j < 4; ++j) { u32x2 o; o.x = cvt_pk_bf16(v[r][j].x * rs * gg[j].x, v[r][j].y * rs * gg[j].y); o.y = cvt_pk_bf16(v[r][j].z * rs * gg[j].z, v[r][j].w * rs * gg[j].w);
            ((u32x2*)(obase + (size_t)(row0 + r) * DM))[lane + 64 * j] = o; } }
}
__device__ __forceinline__ void route_block(const float* __restrict__ X, const bf16_t* __restrict__ rt_tab, const float* __restrict__ brg, const float* __restrict__ bre, int* __restrict__ experts, float* __restrict__ weights,
                                            int* __restrict__ rank, unsigned* __restrict__ cnt, float* __restrict__ rstd, int* __restrict__ list, const float* __restrict__ g2, bf16_t* __restrict__ H2, int rb, const bf16x8 (&Bh)[3][4], const bf16x8 (&Bl)[3][4], LAS float* slab, int tid, int wave) {
    const int lane = tid & 63, r = lane & 15, kq = lane >> 4;
    LAS float* ssq = slab + 8 * 64 * 48; LAS float* rs_l = ssq + 8 * 64;
#pragma unroll 1
    for (int rt = 0; rt < 4; ++rt) {
        const float* xp = X + (size_t)(rb * 64 + rt * 16 + r) * DM + 128 * wave + 8 * kq;
        f32x4 acc[3]; float ss = 0.f;
#pragma unroll
        for (int t = 0; t < 3; ++t) acc[t] = (f32x4){0.f, 0.f, 0.f, 0.f};
#pragma unroll
        for (int sI = 0; sI < 4; ++sI) {
            const f32x4 a0 = *(const f32x4*)(xp + 32 * sI), a1 = *(const f32x4*)(xp + 32 * sI + 4);
            ss += (a0[0] * a0[0] + a0[1] * a0[1]) + (a0[2] * a0[2] + a0[3] * a0[3]) + (a1[0] * a1[0] + a1[1] * a1[1]) + (a1[2] * a1[2] + a1[3] * a1[3]);
            u32x4 hw, lw;
            hw.x = cvt_pk_bf16(a0[0], a0[1]); hw.y = cvt_pk_bf16(a0[2], a0[3]); hw.z = cvt_pk_bf16(a1[0], a1[1]); hw.w = cvt_pk_bf16(a1[2], a1[3]);
            lw.x = cvt_pk_bf16(a0[0] - __uint_as_float(hw.x << 16), a0[1] - __uint_as_float(hw.x & 0xffff0000u)); lw.y = cvt_pk_bf16(a0[2] - __uint_as_float(hw.y << 16), a0[3] - __uint_as_float(hw.y & 0xffff0000u));
            lw.z = cvt_pk_bf16(a1[0] - __uint_as_float(hw.z << 16), a1[1] - __uint_as_float(hw.z & 0xffff0000u)); lw.w = cvt_pk_bf16(a1[2] - __uint_as_float(hw.w << 16), a1[3] - __uint_as_float(hw.w & 0xffff0000u));
            const bf16x8 Ah = __builtin_bit_cast(bf16x8, hw), Al = __builtin_bit_cast(bf16x8, lw);
#pragma unroll
            for (int t = 0; t < 3; ++t) {
                acc[t] = __builtin_amdgcn_mfma_f32_16x16x32_bf16(Ah, Bh[t][sI], acc[t], 0, 0, 0);
                acc[t] = __builtin_amdgcn_mfma_f32_16x16x32_bf16(Al, Bh[t][sI], acc[t], 0, 0, 0);
                acc[t] = __builtin_amdgcn_mfma_f32_16x16x32_bf16(Ah, Bl[t][sI], acc[t], 0, 0, 0);
            }
        }
        ss += __shfl_xor(ss, 16); ss += __shfl_xor(ss, 32);
        if (kq == 0) ssq[wave * 64 + rt * 16 + r] = ss;
#pragma unroll
        for (int t = 0; t < 3; ++t)
#pragma unroll
            for (int e = 0; e < 4; ++e) slab[(wave * 64 + rt * 16 + 4 * kq + e) * 48 + 16 * t + r] = acc[t][e];
    }
    __syncthreads();
    if (tid < 64) {
        const int row = rb * 64 + tid;
        float lg[36]; float ss = 0.f;
#pragma unroll
        for (int c = 0; c < 36; ++c) lg[c] = 0.f;
#pragma unroll 1
        for (int w = 0; w < 8; ++w) { ss += ssq[w * 64 + tid];
#pragma unroll
            for (int c = 0; c < 36; ++c) lg[c] += slab[(w * 64 + tid) * 48 + c]; }
        const float rs = rsqrtf(ss * (1.f / DM) + EPS);
        rstd[row] = rs;
        int gi = 0; float gm = lg[0] * rs + brg[0];
#pragma unroll
        for (int i = 1; i < 4; ++i) { const float l = lg[i] * rs + brg[i]; if (l > gm) { gm = l; gi = i; } }
        float gs = 0.f;
#pragma unroll
        for (int i = 0; i < 4; ++i) gs += __expf(lg[i] * rs + brg[i] - gm);
        const float gp = 1.f / gs;
        float el[8];
#pragma unroll
        for (int i = 0; i < 8; ++i) el[i] = 0.f;
#pragma unroll
        for (int gq = 0; gq < 4; ++gq) if (gq == gi) {
#pragma unroll
            for (int i = 0; i < 8; ++i) el[i] = lg[4 + gq * 8 + i] * rs + bre[gq * 8 + i]; }
        int i0 = 0; float l0 = el[0];
#pragma unroll
        for (int i = 1; i < 8; ++i) if (el[i] > l0) { l0 = el[i]; i0 = i; }
        int i1 = -1; float l1 = -INFINITY;
#pragma unroll
        for (int i = 0; i < 8; ++i) if (i != i0 && el[i] > l1) { l1 = el[i]; i1 = i; }
        const float p1 = __expf(l1 - l0), inv = 1.f / (1.f + p1);
        const int e0 = gi * 8 + i0, e1 = gi * 8 + i1;
        experts[row * 2] = e0; experts[row * 2 + 1] = e1;
        weights[row * 2] = gp * inv; weights[row * 2 + 1] = gp * p1 * inv;
        LAS unsigned* lc = (LAS unsigned*)(rs_l + 64); LAS unsigned* gb = lc + 32;
        if (tid < 32) lc[tid] = 0u;
        asm volatile("s_waitcnt lgkmcnt(0)" ::: "memory");
        unsigned q0, q1; const unsigned one = 1u, a0_ = (unsigned)(uintptr_t)(lc + e0), a1_ = (unsigned)(uintptr_t)(lc + e1);
        asm volatile("ds_add_rtn_u32 %0, %1, %2\n\ts_waitcnt lgkmcnt(0)" : "=v"(q0) : "v"(a0_), "v"(one) : "memory");
        asm volatile("ds_add_rtn_u32 %0, %1, %2\n\ts_waitcnt lgkmcnt(0)" : "=v"(q1) : "v"(a1_), "v"(one) : "memory");
        if (tid < 32) { const unsigned n = lc[tid]; gb[tid] = n ? atomicAdd(cnt + 64 * tid, n) : 0u; }
        const int r0 = (int)(gb[e0] + q0), r1 = (int)(gb[e1] + q1);
        rank[row * 2] = r0; rank[row * 2 + 1] = r1;
        list[e0 * LCAP + r0] = row * 2; list[e1 * LCAP + r1] = row * 2 + 1;
        rs_l[tid] = rs;
    }
    __syncthreads();
#pragma unroll 1
    for (int rr = 0; rr < 8; rr += 4) {
        f32x4 v[4][4];
#pragma unroll
        for (int r = 0; r < 4; ++r)
#pragma unroll
            for (int j = 0; j < 4; ++j) v[r][j] = ((const f32x4*)(X + (size_t)(rb * 64 + wave * 8 + rr + r) * DM))[lane + 64 * j];
#pragma unroll
        for (int r = 0; r < 4; ++r) { const float rs = rs_l[wave * 8 + rr + r]; u32x2* dst = (u32x2*)(H2 + (size_t)(rb * 64 + wave * 8 + rr + r) * DM);
#pragma unroll
            for (int j = 0; j < 4; ++j) { const f32x4 gg = ((const f32x4*)g2)[lane + 64 * j];
                u32x2 o; o.x = cvt_pk_bf16(v[r][j].x * rs * gg.x, v[r][j].y * rs * gg.y); o.y = cvt_pk_bf16(v[r][j].z * rs * gg.z, v[r][j].w * rs * gg.w); dst[lane + 64 * j] = o; } }
    }
    __syncthreads();
}
__device__ __forceinline__ void moe_tables(const unsigned* cnt, volatile LAS int* mt, int tid) {
    if (tid == 0) { int off = 0, nt = 0;
#pragma unroll 1
        for (int e = 0; e < NEXP; ++e) { const int c = (int)__hip_atomic_load(cnt + 64 * e, __ATOMIC_RELAXED, __HIP_MEMORY_SCOPE_AGENT), t = (c + MOE_TILE - 1) / MOE_TILE;
            mt[e] = off; mt[32 + e] = c; mt[64 + e] = nt;
#pragma unroll 1
            for (int i = 0; i < t; ++i) mt[96 + nt + i] = e;
            nt += t; off += t * MOE_TILE; }
        mt[256] = nt; }
    __syncthreads();
}
__device__ __forceinline__ void moe_rowtabs(volatile LAS int* mt, const int* __restrict__ list, const float* __restrict__ weights, LAS unsigned* rowtab, LAS float* wtab, int bx, int G, int tid, int up) {
    const int ntiles = mt[256], rem = (ntiles * 4) % G;
#pragma unroll 1
    for (int i = 0; i < 4; ++i) { const long L = up ? (long)i * G + bx : (long)pg8::moe_down_unit(bx, i, rem, G); if (L >= (long)ntiles * 4) break;
        if (tid < 256) { const int tile = (int)(L >> 2), e = mt[96 + tile], q = (tile - mt[64 + e]) * 256 + tid; const bool valid = q < mt[32 + e];
            const int a = valid ? list[e * LCAP + q] : 0;
            if (up) rowtab[i * 256 + tid] = (unsigned)(a >> 1) * (unsigned)(DM * 2); else wtab[i * 256 + tid] = valid ? weights[a] : 0.f; } }
    __syncthreads();
}
template <int NR>
__device__ __forceinline__ void rows_combine_norm(float* __restrict__ X, const bf16_t* __restrict__ YB, const float* __restrict__ g, bf16_t* __restrict__ H, float* __restrict__ OUT, const int (&row)[NR], int lane, bool poison, const int (&d0)[NR], const int (&d1)[NR]) {
    f32x4 v[NR][4]; u32x2 ya[NR][4], yb[NR][4];
#pragma unroll
    for (int r = 0; r < NR; ++r)
#pragma unroll
        for (int j = 0; j < 4; ++j) { v[r][j] = ((const f32x4*)(X + (size_t)row[r] * DM))[lane + 64 * j];
            ya[r][j] = ((const u32x2*)(YB + (size_t)d0[r] * DM))[lane + 64 * j]; yb[r][j] = ((const u32x2*)(YB + (size_t)d1[r] * DM))[lane + 64 * j]; }
    f32x4 gg[4];
#pragma unroll
    for (int j = 0; j < 4; ++j) gg[j] = ((const f32x4*)g)[lane + 64 * j];
    float s[NR];
#pragma unroll
    for (int r = 0; r < NR; ++r) { s[r] = 0.f;
#pragma unroll
        for (int j = 0; j < 4; ++j) { const u32x2 a = ya[r][j], b = yb[r][j];
            v[r][j].x += __uint_as_float(a.x << 16) + __uint_as_float(b.x << 16); v[r][j].y += __uint_as_float(a.x & 0xffff0000u) + __uint_as_float(b.x & 0xffff0000u);
            v[r][j].z += __uint_as_float(a.y << 16) + __uint_as_float(b.y << 16); v[r][j].w += __uint_as_float(a.y & 0xffff0000u) + __uint_as_float(b.y & 0xffff0000u);
            s[r] += v[r][j].x * v[r][j].x + v[r][j].y * v[r][j].y + v[r][j].z * v[r][j].z + v[r][j].w * v[r][j].w; } }
#pragma unroll
    for (int r = 0; r < NR; ++r) {
        float rs = rsqrtf(wave_sum(s[r]) * (1.f / DM) + EPS);
        if (poison) rs = __builtin_nanf("");
#pragma unroll
        for (int j = 0; j < 4; ++j) {
            if (H) { ((f32x4*)(X + (size_t)row[r] * DM))[lane + 64 * j] = v[r][j];
                u32x2 o; o.x = cvt_pk_bf16(v[r][j].x * rs * gg[j].x, v[r][j].y * rs * gg[j].y); o.y = cvt_pk_bf16(v[r][j].z * rs * gg[j].z, v[r][j].w * rs * gg[j].w);
                ((u32x2*)(H + (size_t)row[r] * DM))[lane + 64 * j] = o; }
            else { f32x4 o; o.x = v[r][j].x * rs * gg[j].x; o.y = v[r][j].y * rs * gg[j].y; o.z = v[r][j].z * rs * gg[j].z; o.w = v[r][j].w * rs * gg[j].w; ((f32x4*)(OUT + (size_t)row[r] * DM))[lane + 64 * j] = o; }
        }
    }
}
struct TrItem { const float* src; bf16_t* dst; int ldw, K; };
template <int OFF> __device__ __forceinline__ unsigned long long karg64() { unsigned long long v; asm volatile("s_load_dwordx2 %0, %1, %2\n\ts_waitcnt lgkmcnt(0)" : "=s"(v) : "s"(__builtin_amdgcn_kernarg_segment_ptr()), "n"(OFF)); return v; }
__device__ __forceinline__ unsigned long long karg64d(int off) { unsigned long long v; asm volatile("s_load_dwordx2 %0, %1, %2\n\ts_waitcnt lgkmcnt(0)" : "=s"(v) : "s"(__builtin_amdgcn_kernarg_segment_ptr()), "s"(off)); return v; }
#define TR_IN(k) ((const float*)(const GAS float*)karg64d(8 * (k)))
__device__ __forceinline__ void tr_decode(int it, int lane, bf16_t* WB, const float*& sp, int& ldw, bf16_t*& dp, int& K) {
    const float* src; int segA, segB, kb, tb, dk0 = 0; bf16_t* dst;
    if (it < 28800) {
        const int l = it / 14400; int r = it % 14400; bf16_t* WBl = WB + (size_t)l * WB_LAYER;
        if (r < 1472) { kb = r / 92; tb = r % 92; const int pn = tb >> 2, bj = (tb >> 1) & 1, w0 = 2 * (tb & 1); src = TR_IN(5) + (size_t)l * DM * D_IN; ldw = D_IN; K = DM; segA = 256 * pn + 64 * w0 + 32 * bj; segB = segA + 64; dst = WBl + WB_IN; }
        else if (r < 1856) { r -= 1472; const int i = r >> 7; r &= 127; kb = r >> 4; tb = r & 15; src = TR_IN(13 + i) + (size_t)l * 512 * DM; ldw = DM; K = 512; segA = 64 * tb; segB = segA + 32; dst = WBl + WB_UP + (size_t)i * 1024 * 512; }
        else if (r < 2112) { r -= 1856; kb = r >> 4; tb = r & 15; src = TR_IN(16) + (size_t)l * DM * DM; ldw = DM; K = DM; segA = 64 * tb; segB = segA + 32; dst = WBl + WB_OUT; }
        else if (r < 10304) { r -= 2112; const int e = r >> 8; r &= 255; kb = r >> 4; tb = r & 15; const int pn = tb >> 2, sg = (tb >> 1) & 1, jb = tb & 1;
            src = TR_IN(sg ? 23 : 22) + (size_t)(l * NEXP + e) * DM * DEXP; ldw = DEXP; K = DM; segA = 128 * pn + 64 * jb; segB = segA + 32; dst = WBl + WB_GU + (size_t)e * 1024 * 1024; }
        else { r -= 10304; const int e = r >> 7; r &= 127; kb = r >> 4; tb = r & 15; src = TR_IN(24) + (size_t)(l * NEXP + e) * DEXP * DM; ldw = DM; K = DEXP; segA = 64 * tb; segB = segA + 32; dst = WBl + WB_DN + (size_t)e * 1024 * 512; }
    } else { const int r = it - 28800; kb = r >> 4; tb = r & 15; const int pn = tb >> 2, bj = (tb >> 1) & 1, w0 = 2 * (tb & 1); src = TR_IN(3); ldw = 1024; K = DM; segA = 256 * pn + 64 * w0 + 32 * bj; segB = segA + 64; dst = WB + WB_MEMKV; }
    const int q = lane & 15;
    sp = src + (size_t)(kb * 64 + (lane >> 4)) * ldw + (q < 8 ? segA + 4 * q : segB + 4 * (q - 8));
    dp = dst + (size_t)(64 * tb + (lane >> 3)) * K + dk0 + kb * 64 + 8 * (lane & 7);
}
__device__ __forceinline__ void tr_load(f32x4 (&v)[16], const float* sp, int ldw) {
#pragma unroll
    for (int i = 0; i < 16; ++i) v[i] = *(const f32x4*)(sp + (size_t)(4 * i) * ldw);
}
__device__ __forceinline__ void tr_store(const f32x4 (&v)[16], bf16_t* dp, int K, LAS float* scr, int lane) {
    const int q = lane & 15, kq = lane >> 4;
#pragma unroll
    for (int i = 0; i < 16; ++i) { LAS float* w = scr + (4 * i + kq) * 65 + 4 * q; w[0] = v[i][0]; w[1] = v[i][1]; w[2] = v[i][2]; w[3] = v[i][3]; }
    asm volatile("s_waitcnt lgkmcnt(0)" ::: "memory");
    const int c = lane & 7, n8 = lane >> 3;
#pragma unroll
    for (int j = 0; j < 8; ++j) { const LAS float* sI = scr + (8 * c) * 65 + n8 + 8 * j;
        u32x4 o; o.x = cvt_pk_bf16(sI[0 * 65], sI[1 * 65]); o.y = cvt_pk_bf16(sI[2 * 65], sI[3 * 65]); o.z = cvt_pk_bf16(sI[4 * 65], sI[5 * 65]); o.w = cvt_pk_bf16(sI[6 * 65], sI[7 * 65]);
        *(u32x4*)(dp + (size_t)(8 * j) * K) = o; }
    asm volatile("s_waitcnt lgkmcnt(0)" ::: "memory");
}

#define XB_TMO      128
#define XB_XCNT(j)  (256  + 64 * (j))
#define XB_XSUB(j)  (1280 + 64 * (j))
#define XB_XGEN(j)  (2304 + 64 * (j))
#define XB_TOP      3328
#define XB_TOPGEN   3392
#define XCD_BAR_WORDS 3456
#define XB_SPIN_CAP (1u << 18)

__device__ __forceinline__ unsigned xb_ld(unsigned* p)              { return __hip_atomic_load(p, __ATOMIC_RELAXED, __HIP_MEMORY_SCOPE_AGENT); }
__device__ __forceinline__ unsigned xb_add(unsigned* p, unsigned v) { return __hip_atomic_fetch_add(p, v, __ATOMIC_RELAXED, __HIP_MEMORY_SCOPE_AGENT); }
__device__ __forceinline__ unsigned xb_xcc_id() { return (unsigned)__builtin_amdgcn_s_getreg((3 << 11) | 20) & 0xFu; }
#define XB_SPIN(cond, bar) do { unsigned _sp = 0; while (cond) { __builtin_amdgcn_s_sleep(1); \
    if ((++_sp & 255u) == 0u) { if (xb_ld(&(bar)[XB_TMO])) break; if (_sp > XB_SPIN_CAP) { atomicAdd(&(bar)[XB_TMO], 1u); break; } } } } while (0)

struct XcdBarrier {
    unsigned* bar; unsigned x; unsigned w0;
    volatile LAS unsigned* st;
};

__device__ __forceinline__ XcdBarrier xcd_barrier_post(unsigned* bar, volatile LAS unsigned* st, unsigned is_wave0) {
    XcdBarrier b; b.bar = bar; b.x = xb_xcc_id(); b.st = st; b.w0 = is_wave0;
    if (is_wave0 && lane_id() == 0) (void)xb_add(&bar[XB_XCNT(b.x)], 1u);
    return b;
}
__device__ __forceinline__ void xcd_barrier_complete(unsigned* bar, unsigned x, unsigned& nloc, unsigned& nx) {
    const unsigned G = gridDim.x * gridDim.y * gridDim.z;
    unsigned sum, cnt, mine, sp = 0u;
    for (;;) {
        sum = 0u; cnt = 0u; mine = 0u;
#pragma unroll
        for (unsigned j = 0; j < 16; ++j) { const unsigned c = xb_ld(&bar[XB_XCNT(j)]); sum += c; cnt += (c > 0u) ? 1u : 0u; mine = (j == x) ? c : mine; }
        if (sum == G) break;
        __builtin_amdgcn_s_sleep(1);
        if ((++sp & 255u) == 0u) { if (xb_ld(&bar[XB_TMO])) break; if (sp > XB_SPIN_CAP) { atomicAdd(&bar[XB_TMO], 1u); break; } }
    }
    nloc = mine > 0u ? mine : 1u; nx = cnt > 0u ? cnt : 1u;
}

__device__ __forceinline__ void xcd_barrier(const XcdBarrier& b) {
    asm volatile("s_waitcnt vmcnt(0)" ::: "memory");
    __syncthreads();
    if (b.w0 && lane_id() == 0) {
        unsigned* bar = b.bar;
        __builtin_amdgcn_s_waitcnt(0);
        unsigned nloc = b.st[0], nx = b.st[1];
        if (nloc == 0u) { xcd_barrier_complete(bar, b.x, nloc, nx); b.st[0] = nloc; b.st[1] = nx; }
        const unsigned old = xb_add(&bar[XB_XSUB(b.x)], 1u);
        const unsigned gen = old / nloc;
        if (old + 1u == (gen + 1u) * nloc) {
            __builtin_amdgcn_fence(__ATOMIC_RELEASE, "agent");
            asm volatile("s_waitcnt vmcnt(0)" ::: "memory");
            const unsigned og = xb_add(&bar[XB_TOP], 1u);
            const unsigned tg = og / nx;
            if (og + 1u == (tg + 1u) * nx) xb_add(&bar[XB_TOPGEN], 1u);
            else XB_SPIN(xb_ld(&bar[XB_TOPGEN]) == tg, bar);
            __builtin_amdgcn_fence(__ATOMIC_ACQUIRE, "agent");
            xb_add(&bar[XB_XGEN(b.x)], 1u);
            asm volatile("s_waitcnt vmcnt(0)" ::: "memory");
        } else {
            XB_SPIN(xb_ld(&bar[XB_XGEN(b.x)]) == gen, bar);
            __builtin_amdgcn_fence(__ATOMIC_ACQUIRE, "agent");
            asm volatile("s_waitcnt vmcnt(0)" ::: "memory");
        }
    }
    __syncthreads();
}
constexpr int NWAVES = 8;
constexpr int RING_BYTES = 131072, LDSCTL_OFF = 135168, LDS_BYTES = 147456;
constexpr int CW_BAR = 4096, BAR_REGION = 4096;
static_assert(XCD_BAR_WORDS <= BAR_REGION && (CW_BAR + (N_PHASES + 1) * BAR_REGION) * 4 <= (int)MiB, "barrier regions inside the memset region");
static_assert(pg8::STAGE_BYTES <= RING_BYTES && att::Lay<64, 128>::OFF_STASH + 65536 <= RING_BYTES && att::Lay<128, 128>::OFF_WS + 2048 <= RING_BYTES, "LDS map");

struct Args { const float* in[26]; float* out; unsigned char* ws; int ph_lo, ph_hi, li, pad; };
#define KIN(k) ((const float*)(const GAS float*)karg64<8 * (k)>())
#define KOUT ((float*)(GAS float*)karg64<208>())
#define KWS ((unsigned char*)(GAS unsigned char*)karg64<216>())
static_assert(offsetof(Args, out) == 208 && offsetof(Args, ws) == 216 && offsetof(Args, ph_lo) == 224, "Args layout vs the kernarg offsets above");

__global__ void __launch_bounds__(NWAVES * 64, 2) mk_fwd(Args args) {
    extern __shared__ __attribute__((aligned(16))) unsigned char lds[];
    const int wave = __builtin_amdgcn_readfirstlane((int)threadIdx.x >> 6);
#define lane0 lane_id()
#define tid0 (wave * 64 + lane_id())
    const int G = gridDim.x, bx = blockIdx.x, vcu = (G % 8 == 0) ? (bx % 8) * (G / 8) + bx / 8 : bx;
    LAS unsigned char* ldsl = (LAS unsigned char*)lds;
    volatile LAS unsigned* MISC = (volatile LAS unsigned*)(ldsl + LDSCTL_OFF);
    for (int u = tid0; u < (LDS_BYTES - LDSCTL_OFF) / 4; u += NWAVES * 64) ((LAS unsigned*)(ldsl + LDSCTL_OFF))[u] = 0u;
    __syncthreads();
    XcdBarrier bar = xcd_barrier_post((unsigned*)(KWS + WS_CTL) + CW_BAR + args.li * BAR_REGION, MISC + 8, wave == 0 ? 1u : 0u);
#define P_WS unsigned char* ws = KWS; unsigned* ctl = (unsigned*)(ws + WS_CTL); (void)ctl
#define P_ACT bf16_t* MEMKV = (bf16_t*)(ws + WS_MEMKV); bf16_t* HM = (bf16_t*)(ws + WS_HM); bf16_t* PROJ = (bf16_t*)(ws + WS_PROJ); bf16_t* OBR = (bf16_t*)(ws + WS_OBR); bf16_t* HMEM = OBR; \
    bf16_t* BUF = (bf16_t*)(ws + WS_BUF); bf16_t* YB = (bf16_t*)(ws + WS_YB); bf16_t* HID = (bf16_t*)(ws + WS_HID); bf16_t* WB = (bf16_t*)(ws + WS_WB); const bf16_t* WBl = WB + (size_t)l_ * WB_LAYER; \
    (void)MEMKV; (void)HM; (void)PROJ; (void)OBR; (void)HMEM; (void)BUF; (void)YB; (void)HID; (void)WBl
#define P_ROUTE int* experts = (int*)(ws + WS_ROUTE + RT_EXP); float* weights = (float*)(ws + WS_ROUTE + RT_WGT); int* rank = (int*)(ws + WS_ROUTE + RT_RANK); float* rstd = (float*)(ws + WS_ROUTE + RT_RSTD); \
    (void)experts; (void)weights; (void)rank; (void)rstd
    const int gw = bx * NWAVES + wave, NGW = G * NWAVES;
    const int lo = args.ph_lo, hi = args.ph_hi;
#ifndef STAGE_MASK
#define STAGE_MASK 0x3FFu
#endif
#define IN(k) (lo <= (k) && (k) < hi)
#define ST(s) ((STAGE_MASK >> (s)) & 1u)
#ifndef REP_MASK
#define REP_MASK 0u
#endif
#define NREP(s) (((REP_MASK >> (s)) & 1u) ? 2 : 1)
#ifndef DBL_BAR
#define DBL_BAR 0
#endif
#define SEAM(k) do { if (IN(k) && IN((k) + 1)) { xcd_barrier(bar); if (DBL_BAR) xcd_barrier(bar); } } while (0)

    if (ST(0) && IN(0))
  for (int rep_ = 0; rep_ < NREP(0); ++rep_) {
        int lane = lane0, tid = tid0; asm volatile("" : "+v"(lane), "+v"(tid));
        constexpr int l_ = 0; P_WS; P_ACT;
        float* tab1 = (float*)(ws + WS_TAB); float* tab2 = tab1 + SEQ * 32 * 2;
        const float* x = KIN(0); const float* mem = KIN(1); const float* mem_g = KIN(2); const float* norm1_g = KIN(4); const float* norm2_g = KIN(17); const float* w_rg = KIN(18); const float* w_re = KIN(20);
        LAS float* scr = (LAS float*)(ldsl + wave * 16640);
        {   constexpr int NITEMS = 29056;
            f32x4 cur[16], nxt[16]; const float* sp; bf16_t* dp; int ldw, K; const float* sp2; bf16_t* dp2; int ldw2, K2;
            int it = gw;
            if (it < NITEMS) { tr_decode(it, lane, WB, sp, ldw, dp, K); tr_load(cur, sp, ldw); }
            for (; it < NITEMS; it += NGW) {
                const bool more = it + NGW < NITEMS;
                if (more) { tr_decode(it + NGW, lane, WB, sp2, ldw2, dp2, K2); tr_load(nxt, sp2, ldw2); }
                tr_store(cur, dp, K, scr, lane);
                if (more) {
#pragma unroll
                    for (int i = 0; i < 16; ++i) cur[i] = nxt[i];
                    dp = dp2; K = K2; }
            }
        }
        for (int idx = bx * (NWAVES * 64) + tid; idx < SEQ * 32; idx += G * NWAVES * 64) { const int pos = idx >> 5, i = idx & 31; float s, c;
            sincosf((float)pos * inv1d(i), &s, &c); tab1[idx * 2] = c; tab1[idx * 2 + 1] = s;
            sincosf(ang2d(pos, i), &s, &c); tab2[idx * 2] = c; tab2[idx * 2 + 1] = s; }
        for (int idx = bx * (NWAVES * 64) + tid; idx < DEPTH * 48 * 1024; idx += G * NWAVES * 64) { const int l = idx / (48 * 1024), c = (idx >> 10) % 48, k = idx & 1023;
            const float w = c < 4 ? w_rg[((size_t)l * DM + k) * 4 + c] : c < 36 ? w_re[((size_t)l * DM + k) * 32 + (c - 4)] : 0.f, v = w * norm2_g[l * DM + k];
            const bf16_t h = f2bf(v); bf16_t* t = WB + WB_RT + (size_t)l * 2 * 48 * 1024 + (size_t)c * 1024 + k; t[0] = h; t[48 * 1024] = f2bf(v - bf2f(h)); }
        for (int m = 4 * gw; m < M; m += 4 * NGW) rows_rmsnorm<4>(x, norm1_g, HM, m, lane);
        for (int m = gw; m < MM; m += NGW) rows_rmsnorm<1>(mem, mem_g, HMEM, m, lane);
    }
    SEAM(0);
#pragma unroll 1
    for (int l = 0; l < DEPTH; ++l) {
        const int pb = 1 + 9 * l, l_ = l;
        if (ST(1) && IN(pb + 0))
      for (int rep_ = 0; rep_ < NREP(1); ++rep_) {
            P_WS; P_ACT; float* tab1 = (float*)(ws + WS_TAB); float* tab2 = tab1 + SEQ * 32 * 2; const float* qn_g = KIN(11); const float* kn_g = KIN(12);
            pg8::Gemm g{DM, DM};
            pg8::SchedProj S{bx, G, 1472, l == 0 ? 1504 : 1472, (const char*)HM, (const char*)(WBl + WB_IN), (const char*)HMEM, (const char*)(WB + WB_MEMKV)};
            pg8::EpiProj E{PROJ, MEMKV, tab1, tab2, qn_g + l * 64, kn_g + l * 64};
            pg8::gemm_phase<pg8::EpiProj, pg8::SchedProj, true, true>(ldsl, g, S, E, wave);
        }
        SEAM(pb + 0);
        if (ST(2) && IN(pb + 1))
      for (int rep_ = 0; rep_ < NREP(2); ++rep_) {
            int lane = lane0; asm volatile("" : "+v"(lane));
            P_WS; P_ACT; const float* lq1 = KIN(6); const float* lk1 = KIN(7); const float* lq2 = KIN(8); const float* lk2 = KIN(9); const float* subln_g = KIN(10);
            const float lam_init = 0.8f - 0.6f * __expf(-0.3f * (float)l);
            const float lam = __expf(wave_sum(lq1[l * 64 + lane] * lk1[l * 64 + lane])) - __expf(wave_sum(lq2[l * 64 + lane] * lk2[l * 64 + lane])) + lam_init;
            for (int j = vcu; j < 256; j += G) {
#ifndef ATT_SKIP_A
                att::unit_a(PROJ, OBR, j >> 5, (j >> 3) & 3, j & 7, lam, lam_init, subln_g + l * 128, (char*)lds, wave);
#endif
#ifndef ATT_SKIP_B
#pragma unroll 1
                for (int t = 0; t < 2; ++t) { const int idx = 2 * j + t; att::unit_b(PROJ, OBR, idx >> 6, (idx >> 3) & 7, idx & 7, (char*)lds, wave); }
#endif
#ifndef ATT_SKIP_C
                att::unit_c(PROJ, MEMKV, OBR, j >> 5, (j >> 3) & 3, j & 7, (char*)lds, wave);
#endif
            }
            __syncthreads();
        }
        SEAM(pb + 1);
        if (ST(3) && IN(pb + 2))
      for (int rep_ = 0; rep_ < NREP(3); ++rep_) {
            P_WS; P_ACT;
            pg8::Gemm g{OBR_W, 512};
            pg8::SchedGate S{bx, G, (const char*)OBR, (const char*)(WBl + WB_UP)};
            pg8::EpiGate E{HM, PROJ};
            pg8::gemm_phase<pg8::EpiGate, pg8::SchedGate, true, true>(ldsl, g, S, E, wave);
        }
        SEAM(pb + 2);
        if (ST(4) && IN(pb + 3)) {
            P_WS; P_ACT; const float* x = KIN(0); float* X = KOUT;
            pg8::Gemm g{DM, DM};
            pg8::SchedPlain S{bx, G, M / 256, (const char*)HM, (const char*)(WBl + WB_OUT), (size_t)256 * DM * 2, (size_t)256 * DM * 2};
            pg8::EpiResid E{l == 0 ? x : X, X};
            pg8::gemm_phase<pg8::EpiResid, pg8::SchedPlain, true, true>(ldsl, g, S, E, wave);
        }
        SEAM(pb + 3);
        if (ST(5) && IN(pb + 4)) {
            int tid = tid0; asm volatile("" : "+v"(tid));
            const int lane = tid & 63;
            P_WS; P_ACT; P_ROUTE; float* X = KOUT; const float* b_rg = KIN(19); const float* b_re = KIN(21); const float* norm2_g = KIN(17);
            const bf16_t* tab = WB + WB_RT + (size_t)l * 2 * 48 * 1024 + (size_t)(lane & 15) * 1024 + 128 * wave + 8 * (lane >> 4);
            bf16x8 Bh[3][4], Bl[3][4];
#pragma unroll
            for (int t = 0; t < 3; ++t)
#pragma unroll
                for (int sI = 0; sI < 4; ++sI) { Bh[t][sI] = *(const bf16x8*)(tab + (size_t)t * 16 * 1024 + 32 * sI); Bl[t][sI] = *(const bf16x8*)(tab + (size_t)(48 + t * 16) * 1024 + 32 * sI); }
            for (int rb = bx; rb < M / 64; rb += G)
                route_block(X, tab, b_rg + l * 4, b_re + l * 32, experts, weights, rank, ctl + CW_CNT + 2048 * l, rstd, (int*)BUF, norm2_g + l * DM, HM, rb, Bh, Bl, (LAS float*)ldsl, tid, wave);
        }
        SEAM(pb + 4);
        volatile LAS int* mt = (volatile LAS int*)(ldsl + LDSCTL_OFF + 256);
        LAS unsigned* rowtab = (LAS unsigned*)(ldsl + LDSCTL_OFF + 2048); LAS float* wtab = (LAS float*)(ldsl + LDSCTL_OFF + 6144);
        if (ST(7) && IN(pb + 6)) {
            int tid = tid0; asm volatile("" : "+v"(tid));
            P_WS; P_ACT; P_ROUTE;
            moe_tables(ctl + CW_CNT + 2048 * l, mt, tid);
            moe_rowtabs(mt, (const int*)BUF, weights, rowtab, wtab, vcu, G, tid, 1);
            const int ntiles = __builtin_amdgcn_readfirstlane(mt[256]);
            pg8::Gemm g{DM, DM};
            pg8::SchedMoeUp S{vcu, G, ntiles, (const LAS int*)(ldsl + LDSCTL_OFF + 256 + 96 * 4), (const char*)HM, (const char*)(WBl + WB_GU), ctl + CW_TCNT + l * 160 * 64};
            pg8::EpiSilu E{HID};
            pg8::gemm_phase<pg8::EpiSilu, pg8::SchedMoeUp, true, true, true>(ldsl, g, S, E, wave, rowtab);
        }
        if (ST(8) && IN(pb + 7)) {
            int tid = tid0; asm volatile("" : "+v"(tid));
            P_WS; P_ACT; P_ROUTE;
            if (!(ST(7) && IN(pb + 6))) moe_tables(ctl + CW_CNT + 2048 * l, mt, tid);
            moe_rowtabs(mt, (const int*)BUF, weights, rowtab, wtab, vcu, G, tid, 0);
            const int ntiles = __builtin_amdgcn_readfirstlane(mt[256]);
            pg8::Gemm g{DEXP, DEXP};
            pg8::SchedMoeDown S{vcu, G, ntiles, (ntiles * 4) % G, wave, (const LAS int*)(ldsl + LDSCTL_OFF + 256 + 96 * 4), (const char*)HID, (const char*)(WBl + WB_DN), ctl + CW_TCNT + l * 160 * 64, ctl + CW_TMO};
            pg8::EpiRowScale E{YB, wtab};
            pg8::gemm_phase<pg8::EpiRowScale, pg8::SchedMoeDown, true, true>(ldsl, g, S, E, wave);
        }
        SEAM(pb + 7);
        if (ST(9) && IN(pb + 8)) {
            int lane = lane0; asm volatile("" : "+v"(lane));
            P_WS; P_ACT; P_ROUTE; float* X = KOUT; const float* norm1_g = KIN(4); const float* final_g = KIN(25);
            const bool last = (l == DEPTH - 1);
            const bool poison = last && ((__hip_atomic_load(ctl + CW_BAR + args.li * BAR_REGION + XB_TMO, __ATOMIC_RELAXED, __HIP_MEMORY_SCOPE_AGENT) | __hip_atomic_load(ctl + CW_TMO, __ATOMIC_RELAXED, __HIP_MEMORY_SCOPE_AGENT)) != 0u);
            if (!(ST(7) && IN(pb + 6)) && !(ST(8) && IN(pb + 7))) moe_tables(ctl + CW_CNT + 2048 * l, mt, tid0);
            static_assert(M % 4 == 0, "rows come in fours");
            for (int m = 4 * gw; m < M; m += 4 * NGW) {
                const u32x4 ex0 = *(const u32x4*)(experts + 2 * m), ex1 = *(const u32x4*)(experts + 2 * m + 4), rk0 = *(const u32x4*)(rank + 2 * m), rk1 = *(const u32x4*)(rank + 2 * m + 4);
                const int rows[4] = {m, m + 1, m + 2, m + 3};
                const int d0[4] = {mt[ex0.x] + (int)rk0.x, mt[ex0.z] + (int)rk0.z, mt[ex1.x] + (int)rk1.x, mt[ex1.z] + (int)rk1.z}, d1[4] = {mt[ex0.y] + (int)rk0.y, mt[ex0.w] + (int)rk0.w, mt[ex1.y] + (int)rk1.y, mt[ex1.w] + (int)rk1.w};
                rows_combine_norm<4>(X, YB, last ? final_g : norm1_g + (l + 1) * DM, last ? nullptr : HM, X, rows, lane, poison, d0, d1); }
        }
        SEAM(pb + 8);
    }
#undef IN
#undef SEAM
#undef lane0
#undef tid0
#undef P_WS
#undef P_ACT
#undef P_ROUTE
}

#ifndef FAST_MASK
#define FAST_MASK 0x7FFFFu
#endif
extern "C" void kernel_launch(void* const* d_in, const int* in_sizes, int n_in, void* d_out, int out_size, void* d_ws, size_t ws_size, hipStream_t stream) {
    if (n_in != 26 || out_size != M * DM || ws_size < WS_END) { fprintf(stderr, "kernel_launch: unexpected shapes n_in %d out %d ws %zu (need %zu)\n", n_in, out_size, ws_size, (size_t)WS_END); return; }
    static int grid = 0;
    if (grid == 0) {
        int dev = 0, cus = 0;
        if (hipGetDevice(&dev) != hipSuccess || hipDeviceGetAttribute(&cus, hipDeviceAttributeMultiprocessorCount, dev) != hipSuccess) { grid = -1; return; }
        if (hipFuncSetAttribute((const void*)mk_fwd, hipFuncAttributeMaxDynamicSharedMemorySize, LDS_BYTES) != hipSuccess) { fprintf(stderr, "kernel_launch: hipFuncSetAttribute failed\n"); grid = -1; return; }
        int per_cu = 0;
        if (hipOccupancyMaxActiveBlocksPerMultiprocessor(&per_cu, (const void*)mk_fwd, NWAVES * 64, LDS_BYTES) != hipSuccess || per_cu < 1) fprintf(stderr, "kernel_launch: occupancy query says %d\n", per_cu);
        (void)hipGetLastError();
        grid = cus;
    }
    if (grid < 0) return;
    const float* x = (const float*)d_in[0]; const float* mem = (const float*)d_in[1]; const float* mem_g = (const float*)d_in[2]; const float* w_memkv = (const float*)d_in[3];
    const float* norm1_g = (const float*)d_in[4]; const float* w_in = (const float*)d_in[5];
    const float* lq1 = (const float*)d_in[6]; const float* lk1 = (const float*)d_in[7]; const float* lq2 = (const float*)d_in[8]; const float* lk2 = (const float*)d_in[9];
    const float* subln_g = (const float*)d_in[10]; const float* qn_g = (const float*)d_in[11]; const float* kn_g = (const float*)d_in[12];
    const float* w_up[3] = {(const float*)d_in[13], (const float*)d_in[14], (const float*)d_in[15]}; const float* w_out = (const float*)d_in[16];
    const float* norm2_g = (const float*)d_in[17]; const float* w_rg = (const float*)d_in[18]; const float* b_rg = (const float*)d_in[19]; const float* w_re = (const float*)d_in[20]; const float* b_re = (const float*)d_in[21];
    const float* w_eg = (const float*)d_in[22]; const float* w_eu = (const float*)d_in[23]; const float* w_ed = (const float*)d_in[24]; const float* final_g = (const float*)d_in[25];
    unsigned char* ws = (unsigned char*)d_ws; float* X = (float*)d_out;
    unsigned* ctl = (unsigned*)(ws + WS_CTL);
    bf16_t* MEMKV = (bf16_t*)(ws + WS_MEMKV); bf16_t* HM = (bf16_t*)(ws + WS_HM); bf16_t* PROJ = (bf16_t*)(ws + WS_PROJ); bf16_t* OBR = (bf16_t*)(ws + WS_OBR);
    bf16_t* BUF = (bf16_t*)(ws + WS_BUF); bf16_t* YB = (bf16_t*)(ws + WS_YB); bf16_t* HID = (bf16_t*)(ws + WS_HID);
    int* experts = (int*)(ws + WS_ROUTE + RT_EXP); float* weights = (float*)(ws + WS_ROUTE + RT_WGT); int* rank = (int*)(ws + WS_ROUTE + RT_RANK); int* dest = (int*)(ws + WS_ROUTE + RT_DEST);
    float* roww = (float*)(ws + WS_ROUTE + RT_ROWW); int* tile_tab = (int*)(ws + WS_ROUTE + RT_TILE); float* rstd = (float*)(ws + WS_ROUTE + RT_RSTD);

    (void)hipMemsetAsync(ctl, 0, MiB, stream);
    unsigned mask = FAST_MASK; if (mask) mask |= 1u;
    Args a{};
    for (int i = 0; i < 26; ++i) a.in[i] = (const float*)d_in[i];
    a.out = X; a.ws = ws;
    int li = 0;
    for (int k = 0; k < N_PHASES;) {
        if ((mask >> k) & 1u) {
            int k2 = k; while (k2 < N_PHASES && ((mask >> k2) & 1u)) ++k2;
            a.ph_lo = k; a.ph_hi = k2; a.li = li++; a.pad = 0;
            hipLaunchKernelGGL(mk_fwd, dim3(grid), dim3(NWAVES * 64), LDS_BYTES, stream, a);
            k = k2; continue;
        }
        if (k == 0) {
            (void)hipMemcpyAsync(X, x, (size_t)M * DM * 4, hipMemcpyDeviceToDevice, stream);
            s_rmsnorm<<<MM / 4, 256, 0, stream>>>(mem, mem_g, OBR, MM);
            s_rmsnorm<<<M / 4, 256, 0, stream>>>(X, norm1_g, HM, M);
        } else {
            const int l = (k - 1) / 9, s = (k - 1) % 9; const float lam_init = 0.8f - 0.6f * expf(-0.3f * (float)l);
            switch (s) {
            case 0:
                if (l == 0) { SG p{}; p.A = OBR; p.lda = DM; p.W = w_memkv; p.ldw = 1024; p.K = DM; p.mode = MD_BF16; p.O = MEMKV; p.ldo = 1024; s_gemm<<<dim3(1024 / 64, MM / 64), 256, 0, stream>>>(p); }
                { SG p{}; p.A = HM; p.lda = DM; p.W = w_in + (size_t)l * DM * D_IN; p.ldw = D_IN; p.K = DM; p.mode = MD_PROJ; p.O = PROJ; p.ldo = D_IN; p.qg = qn_g + l * 64; p.kg = kn_g + l * 64;
                  s_gemm<<<dim3(D_IN / 64, M / 64), 256, 0, stream>>>(p); }
                break;
            case 1:
                s_attn_a<<<dim3(M / 4, 4), 256, 0, stream>>>(PROJ, OBR, lq1 + l * 64, lk1 + l * 64, lq2 + l * 64, lk2 + l * 64, subln_g + l * 128, lam_init);
                s_attn_b<<<dim3(M / 4, 8), 256, 0, stream>>>(PROJ, OBR);
                s_attn_c<<<dim3(M / 4, 4), 256, 0, stream>>>(PROJ, MEMKV, OBR);
                break;
            case 2:
                for (int i = 0; i < 3; ++i) { SG p{}; p.A = OBR + 512 * i; p.lda = OBR_W; p.W = w_up[i] + (size_t)l * 512 * DM; p.ldw = DM; p.K = 512; p.mode = MD_GATE; p.O = HM; p.ldo = DM; p.G = PROJ + C_G + 1024 * i; p.ldg = D_IN; p.first = (i == 0);
                    s_gemm<<<dim3(DM / 64, M / 64), 256, 0, stream>>>(p); }
                break;
            case 3:
                if (l == 0 && (mask & 1u)) (void)hipMemcpyAsync(X, x, (size_t)M * DM * 4, hipMemcpyDeviceToDevice, stream);
                { SG p{}; p.A = HM; p.lda = DM; p.W = w_out + (size_t)l * DM * DM; p.ldw = DM; p.K = DM; p.mode = MD_RESID; p.Xf = X; s_gemm<<<dim3(DM / 64, M / 64), 256, 0, stream>>>(p); }
                break;
            case 4:
                s_norm_route<<<M / 4, 256, 0, stream>>>(X, norm2_g + l * DM, HM, w_rg + (size_t)l * DM * 4, b_rg + l * 4, w_re + (size_t)l * DM * 32, b_re + l * 32, experts, weights, rank, ctl + 32 * l, rstd);
                break;
            case 5:
                s_dispatch<<<1, 64, 0, stream>>>(ctl + 32 * l, tile_tab);
                s_gather<<<M * 2 / 4, 256, 0, stream>>>(X, rstd, norm2_g + l * DM, experts, weights, rank, tile_tab, BUF, roww, dest);
                break;
            case 6:
                { SG p{}; p.A = BUF; p.lda = DM; p.W = w_eg + (size_t)l * NEXP * DM * DEXP; p.W2 = w_eu + (size_t)l * NEXP * DM * DEXP; p.ldw = DEXP; p.wstride = (size_t)DM * DEXP; p.tile_e = tile_tab; p.ntiles = tile_tab + 256;
                  p.K = DM; p.mode = MD_SILU; p.O = HID; p.ldo = DEXP; s_gemm<<<dim3(DEXP / 64, P_ROWS / 64), 256, 0, stream>>>(p); }
                break;
            case 7:
                { SG p{}; p.A = HID; p.lda = DEXP; p.W = w_ed + (size_t)l * NEXP * DEXP * DM; p.ldw = DM; p.wstride = (size_t)DEXP * DM; p.tile_e = tile_tab; p.ntiles = tile_tab + 256;
                  p.K = DEXP; p.mode = MD_ROWSCALE; p.O = YB; p.ldo = DM; p.roww = roww; s_gemm<<<dim3(DM / 64, P_ROWS / 64), 256, 0, stream>>>(p); }
                break;
            default:
                if (l + 1 < DEPTH) s_combine_norm<<<M / 4, 256, 0, stream>>>(X, YB, dest, norm1_g + (l + 1) * DM, HM, nullptr);
                else s_combine_norm<<<M / 4, 256, 0, stream>>>(X, YB, dest, final_g, nullptr, X);
                break;
            }
        }
        ++k;
    }
}
```

```cpp
#include <hip/hip_runtime.h>
#include <cstdint>
#include <cstdio>
#include <cmath>
#include <cstddef>

typedef unsigned short bf16_t;
typedef float f32x4 __attribute__((ext_vector_type(4)));
typedef unsigned u32x4 __attribute__((ext_vector_type(4)));
typedef unsigned u32x2 __attribute__((ext_vector_type(2)));

constexpr int BATCH = 8, SEQ = 2048, DM = 1024, DEPTH = 2, MEM_LEN = 256;
constexpr int M = BATCH * SEQ;
constexpr int MM = BATCH * MEM_LEN;
constexpr int D_IN = 5888;
constexpr int C_AQ = 0, C_AK = 512, C_AV = 1024, C_BQ = 1536, C_BK = 2048, C_BV = 2176, C_CQ = 2304, C_G = 2816;
constexpr int OBR_W = 1536;
constexpr int NEXP = 32, DEXP = 512;
constexpr int MOE_TILE = 256;
constexpr int P_ROWS = M * 2 + NEXP * MOE_TILE;
constexpr int MAX_TILES = P_ROWS / MOE_TILE;
constexpr float EPS = 1e-6f;
constexpr float LOG2E = 1.4426950408889634f;
constexpr float C2_64 = 0.125f * LOG2E;
constexpr float C2_128 = 0.08838834764831845f * LOG2E;

constexpr size_t MiB = 1u << 20;
constexpr size_t WS_CTL = 0;
constexpr size_t WS_ROUTE = 1 * MiB;
constexpr size_t WS_TAB = 2 * MiB;
constexpr size_t WS_MEMKV = 3 * MiB;
constexpr size_t WS_HM = 7 * MiB;
constexpr size_t WS_PROJ = 39 * MiB;
constexpr size_t WS_OBR = 223 * MiB;
constexpr size_t WS_WB = 271 * MiB;
constexpr size_t WS_END = 499 * MiB;
constexpr size_t WS_BUF = WS_PROJ;
constexpr size_t WS_YB = WS_PROJ + 80 * MiB;
constexpr size_t WS_HID = WS_OBR;
constexpr size_t RT_EXP = 0;
constexpr size_t RT_WGT = 128 * 1024;
constexpr size_t RT_RANK = 256 * 1024;
constexpr size_t RT_DEST = 384 * 1024;
constexpr size_t RT_ROWW = 512 * 1024;
constexpr size_t RT_TILE = 700 * 1024;
constexpr size_t RT_RSTD = 768 * 1024;
constexpr int CW_CNT = 163840;
constexpr int CW_TMO = 128;
constexpr int CW_TCNT = 131072;

__device__ __forceinline__ float bf2f(bf16_t v) { return __uint_as_float(((unsigned)v) << 16); }
__device__ __forceinline__ bf16_t f2bf(float f) { unsigned u = __float_as_uint(f); return (bf16_t)((u + 0x7fffu + ((u >> 16) & 1u)) >> 16); }
__device__ __forceinline__ float wave_sum(float v) {
#pragma unroll
    for (int o = 1; o < 64; o <<= 1) v += __shfl_xor(v, o);
    return v;
}
__device__ __forceinline__ float wave_max(float v) {
#pragma unroll
    for (int o = 1; o < 64; o <<= 1) v = fmaxf(v, __shfl_xor(v, o));
    return v;
}
__device__ __forceinline__ float inv1d(int i) { return exp2f(-(float)i * (13.287712379549449f / 32.f)); }
__device__ __forceinline__ float inv2d(int j) { return exp2f(-(float)j * (13.287712379549449f / 16.f)); }
__device__ __forceinline__ float ang2d(int pos, int i) { return i < 16 ? (float)(pos >> 6) * inv2d(i) : (float)(pos & 63) * inv2d(i - 16); }

__global__ __launch_bounds__(256) void s_rmsnorm(const float* __restrict__ X, const float* __restrict__ g, bf16_t* __restrict__ OUT, int rows) {
    const int lane = threadIdx.x & 63, row = blockIdx.x * 4 + (threadIdx.x >> 6);
    if (row >= rows) return;
    const f32x4* xr = (const f32x4*)(X + (size_t)row * DM);
    f32x4 v[4]; float s = 0.f;
#pragma unroll
    for (int j = 0; j < 4; ++j) { v[j] = xr[lane + 64 * j]; s += v[j].x * v[j].x + v[j].y * v[j].y + v[j].z * v[j].z + v[j].w * v[j].w; }
    const float rs = rsqrtf(wave_sum(s) * (1.f / DM) + EPS);
#pragma unroll
    for (int j = 0; j < 4; ++j) { const f32x4 gg = ((const f32x4*)g)[lane + 64 * j];
        u32x2 o; o.x = f2bf(v[j].x * rs * gg.x) | ((unsigned)f2bf(v[j].y * rs * gg.y) << 16); o.y = f2bf(v[j].z * rs * gg.z) | ((unsigned)f2bf(v[j].w * rs * gg.w) << 16);
        ((u32x2*)(OUT + (size_t)row * DM))[lane + 64 * j] = o; }
}

enum { MD_PROJ = 0, MD_BF16 = 1, MD_GATE = 2, MD_RESID = 3, MD_SILU = 4, MD_ROWSCALE = 5 };
struct SG {
    const bf16_t* A; int lda; const float* W; const float* W2; int ldw; size_t wstride;
    const int* tile_e; const int* ntiles;
    int K; int mode;
    bf16_t* O; int ldo;
    float* Xf;
    const bf16_t* G; int ldg; int first;
    const float* roww;
    const float* qg; const float* kg;
};
__global__ __launch_bounds__(256) void s_gemm(SG p) {
    __shared__ float As[16][68];
    __shared__ float Bs[16][68];
    __shared__ float B2s[16][68];
    __shared__ float Ct[64][65];
    __shared__ float Ct2[64][65];
    const int tid = threadIdx.x, tx = tid & 15, ty = tid >> 4;
    const int gc0 = blockIdx.x * 64, gr0 = blockIdx.y * 64;
    const float* W = p.W; const float* W2 = p.W2;
    if (p.tile_e) { const int t256 = blockIdx.y >> 2; if (t256 >= *p.ntiles) return; const int e = p.tile_e[t256]; W += (size_t)e * p.wstride; if (W2) W2 += (size_t)e * p.wstride; }
    float acc[4][4] = {}, acc2[4][4] = {};
    const int ar = tid >> 2, ak = (tid & 3) * 4;
    const int bk = tid >> 4, bn = (tid & 15) * 4;
    for (int k0 = 0; k0 < p.K; k0 += 16) {
        { const u32x2 a = *(const u32x2*)(p.A + (size_t)(gr0 + ar) * p.lda + k0 + ak);
          As[ak + 0][ar] = __uint_as_float(a.x << 16); As[ak + 1][ar] = __uint_as_float(a.x & 0xffff0000u);
          As[ak + 2][ar] = __uint_as_float(a.y << 16); As[ak + 3][ar] = __uint_as_float(a.y & 0xffff0000u); }
        { const f32x4 b = *(const f32x4*)(W + (size_t)(k0 + bk) * p.ldw + gc0 + bn); Bs[bk][bn] = b.x; Bs[bk][bn + 1] = b.y; Bs[bk][bn + 2] = b.z; Bs[bk][bn + 3] = b.w; }
        if (p.mode == MD_SILU) { const f32x4 b = *(const f32x4*)(W2 + (size_t)(k0 + bk) * p.ldw + gc0 + bn); B2s[bk][bn] = b.x; B2s[bk][bn + 1] = b.y; B2s[bk][bn + 2] = b.z; B2s[bk][bn + 3] = b.w; }
        __syncthreads();
#pragma unroll
        for (int k = 0; k < 16; ++k) {
            float a[4], b[4];
#pragma unroll
            for (int i = 0; i < 4; ++i) { a[i] = As[k][ty * 4 + i]; b[i] = Bs[k][tx * 4 + i]; }
#pragma unroll
            for (int i = 0; i < 4; ++i)
#pragma unroll
                for (int j = 0; j < 4; ++j) acc[i][j] += a[i] * b[j];
            if (p.mode == MD_SILU) {
#pragma unroll
                for (int i = 0; i < 4; ++i) b[i] = B2s[k][tx * 4 + i];
#pragma unroll
                for (int i = 0; i < 4; ++i)
#pragma unroll
                    for (int j = 0; j < 4; ++j) acc2[i][j] += a[i] * b[j];
            }
        }
        __syncthreads();
    }
#pragma unroll
    for (int i = 0; i < 4; ++i)
#pragma unroll
        for (int j = 0; j < 4; ++j) { Ct[ty * 4 + i][tx * 4 + j] = acc[i][j]; Ct2[ty * 4 + i][tx * 4 + j] = acc2[i][j]; }
    __syncthreads();
    const int r = tid >> 2, q = tid & 3; const int grow = gr0 + r;
    if (p.mode == MD_PROJ) {
        const int pos = grow & (SEQ - 1);
        bf16_t* orow = p.O + (size_t)grow * p.ldo + gc0;
        if (gc0 < C_AV) {
            const float sc = gc0 < C_AK ? C2_64 : 1.f;
            for (int j = 0; j < 8; ++j) { const int i = q * 8 + j; const float x1 = Ct[r][i], x2 = Ct[r][i + 32]; float s, c; sincosf((float)pos * inv1d(i), &s, &c);
                orow[i] = f2bf((x1 * c - x2 * s) * sc); orow[i + 32] = f2bf((x2 * c + x1 * s) * sc); }
        } else if ((gc0 >= C_BQ && gc0 < C_BV)) {
            const bool isq = gc0 < C_BK; const float* g = isq ? p.qg : p.kg; const float sc = isq ? C2_64 : 1.f;
            float ss = 0.f; for (int d = 0; d < 64; ++d) ss += Ct[r][d] * Ct[r][d];
            const float rs = rsqrtf(ss * (1.f / 64.f) + EPS);
            for (int j = 0; j < 8; ++j) { const int i = q * 8 + j; const float x1 = Ct[r][i] * rs * g[i], x2 = Ct[r][i + 32] * rs * g[i + 32]; float s, c; sincosf(ang2d(pos, i), &s, &c);
                orow[i] = f2bf((x1 * c - x2 * s) * sc); orow[i + 32] = f2bf((x2 * c + x1 * s) * sc); }
        } else if (gc0 >= C_G) {
            for (int j = 0; j < 16; ++j) { const int c = q * 16 + j; orow[c] = f2bf(1.f / (1.f + __expf(-Ct[r][c]))); }
        } else {
            const float sc = (gc0 >= C_CQ) ? C2_128 : 1.f;
            for (int j = 0; j < 16; ++j) { const int c = q * 16 + j; orow[c] = f2bf(Ct[r][c] * sc); }
        }
    } else if (p.mode == MD_BF16) {
        for (int j = 0; j < 16; ++j) { const int c = q * 16 + j; p.O[(size_t)grow * p.ldo + gc0 + c] = f2bf(Ct[r][c]); }
    } else if (p.mode == MD_GATE) {
        for (int j = 0; j < 16; ++j) { const int c = q * 16 + j; const float gv = bf2f(p.G[(size_t)grow * p.ldg + gc0 + c]);
            bf16_t* o = p.O + (size_t)grow * p.ldo + gc0 + c; const float prev = p.first ? 0.f : bf2f(*o); *o = f2bf(prev + gv * Ct[r][c]); }
    } else if (p.mode == MD_RESID) {
        for (int j = 0; j < 16; ++j) { const int c = q * 16 + j; p.Xf[(size_t)grow * DM + gc0 + c] += Ct[r][c]; }
    } else if (p.mode == MD_SILU) {
        for (int j = 0; j < 16; ++j) { const int c = q * 16 + j; const float gq = Ct[r][c], u = Ct2[r][c]; p.O[(size_t)grow * p.ldo + gc0 + c] = f2bf(gq / (1.f + __expf(-gq)) * u); }
    } else if (p.mode == MD_ROWSCALE) {
        const float w = p.roww[grow];
        for (int j = 0; j < 16; ++j) { const int c = q * 16 + j; p.O[(size_t)grow * p.ldo + gc0 + c] = f2bf(Ct[r][c] * w); }
    }
}

template <int DQK, int DV, int NKT>
__device__ __forceinline__ void attn_row(const bf16_t* q, const bf16_t* K, int ldk, const bf16_t* V, int ldv, float* qs, float* ps, int lane, float (&o)[2]) {
    for (int d = lane; d < DQK; d += 64) qs[d] = bf2f(q[d]);
    __syncthreads();
    float sc[NKT]; float m = -INFINITY;
#pragma unroll
    for (int i = 0; i < NKT; ++i) {
        const bf16_t* kr = K + (size_t)(i * 64 + lane) * ldk; float s = 0.f;
#pragma unroll
        for (int d0 = 0; d0 < DQK / 8; ++d0) { const u32x4 w = *(const u32x4*)(kr + d0 * 8);
            s += qs[d0 * 8 + 0] * __uint_as_float(w.x << 16) + qs[d0 * 8 + 1] * __uint_as_float(w.x & 0xffff0000u) + qs[d0 * 8 + 2] * __uint_as_float(w.y << 16) + qs[d0 * 8 + 3] * __uint_as_float(w.y & 0xffff0000u)
               + qs[d0 * 8 + 4] * __uint_as_float(w.z << 16) + qs[d0 * 8 + 5] * __uint_as_float(w.z & 0xffff0000u) + qs[d0 * 8 + 6] * __uint_as_float(w.w << 16) + qs[d0 * 8 + 7] * __uint_as_float(w.w & 0xffff0000u); }
        sc[i] = s; m = fmaxf(m, s);
    }
    m = wave_max(m); float l = 0.f;
#pragma unroll
    for (int i = 0; i < NKT; ++i) { const float pv = exp2f(sc[i] - m); l += pv; ps[i * 64 + lane] = pv; }
    l = wave_sum(l);
    __syncthreads();
    float a0 = 0.f, a1 = 0.f;
#pragma unroll 4
    for (int j = 0; j < NKT * 64; ++j) { const float pv = ps[j]; a0 += pv * bf2f(V[(size_t)j * ldv + lane]); if (DV == 128) a1 += pv * bf2f(V[(size_t)j * ldv + 64 + lane]); }
    o[0] = a0 / l; o[1] = a1 / l;
    __syncthreads();
}
__global__ __launch_bounds__(256) void s_attn_b(const bf16_t* __restrict__ PROJ, bf16_t* __restrict__ OBR) {
    __shared__ float qs_[4][128]; __shared__ float ps_[4][2048];
    const int w = threadIdx.x >> 6, lane = threadIdx.x & 63, row = blockIdx.x * 4 + w, qh = blockIdx.y, b = row / SEQ;
    const bf16_t* kv = PROJ + (size_t)b * SEQ * D_IN;
    float o[2];
    attn_row<64, 64, 32>(PROJ + (size_t)row * D_IN + C_BQ + qh * 64, kv + C_BK + (qh >> 2) * 64, D_IN, kv + C_BV + (qh >> 2) * 64, D_IN, qs_[w], ps_[w], lane, o);
    OBR[(size_t)row * OBR_W + 512 + qh * 64 + lane] = f2bf(o[0]);
}
__global__ __launch_bounds__(256) void s_attn_c(const bf16_t* __restrict__ PROJ, const bf16_t* __restrict__ MEMKV, bf16_t* __restrict__ OBR) {
    __shared__ float qs_[4][128]; __shared__ float ps_[4][256];
    const int w = threadIdx.x >> 6, lane = threadIdx.x & 63, row = blockIdx.x * 4 + w, h = blockIdx.y, b = row / SEQ;
    const bf16_t* kv = MEMKV + (size_t)b * MEM_LEN * 1024;
    float o[2];
    attn_row<128, 128, 4>(PROJ + (size_t)row * D_IN + C_CQ + h * 128, kv + h * 128, 1024, kv + 512 + h * 128, 1024, qs_[w], ps_[w], lane, o);
    OBR[(size_t)row * OBR_W + 1024 + h * 128 + lane] = f2bf(o[0]);
    OBR[(size_t)row * OBR_W + 1024 + h * 128 + 64 + lane] = f2bf(o[1]);
}
__global__ __launch_bounds__(256) void s_attn_a(const bf16_t* __restrict__ PROJ, bf16_t* __restrict__ OBR, const float* lq1, const float* lk1, const float* lq2, const float* lk2,
                                                const float* subg, float lam_init) {
    __shared__ float qs_[4][128]; __shared__ float ps_[4][2048];
    const int w = threadIdx.x >> 6, lane = threadIdx.x & 63, row = blockIdx.x * 4 + w, h = blockIdx.y, b = row / SEQ;
    const float lam = __expf(wave_sum(lq1[lane] * lk1[lane])) - __expf(wave_sum(lq2[lane] * lk2[lane])) + lam_init;
    const bf16_t* kv = PROJ + (size_t)b * SEQ * D_IN;
    float o0[2], o1[2];
    attn_row<64, 128, 32>(PROJ + (size_t)row * D_IN + C_AQ + h * 128, kv + C_AK + h * 128, D_IN, kv + C_AV + h * 128, D_IN, qs_[w], ps_[w], lane, o0);
    attn_row<64, 128, 32>(PROJ + (size_t)row * D_IN + C_AQ + h * 128 + 64, kv + C_AK + h * 128 + 64, D_IN, kv + C_AV + h * 128, D_IN, qs_[w], ps_[w], lane, o1);
    const float c0 = o0[0] - lam * o1[0], c1 = o0[1] - lam * o1[1];
    const float rs = rsqrtf(wave_sum(c0 * c0 + c1 * c1) * (1.f / 128.f) + EPS) * (1.f - lam_init);
    OBR[(size_t)row * OBR_W + h * 128 + lane] = f2bf(c0 * rs * subg[lane]);
    OBR[(size_t)row * OBR_W + h * 128 + 64 + lane] = f2bf(c1 * rs * subg[64 + lane]);
}

__global__ __launch_bounds__(256) void s_norm_route(const float* __restrict__ X, const float* __restrict__ g, bf16_t* __restrict__ H2, const float* __restrict__ wrg, const float* __restrict__ brg,
                                                    const float* __restrict__ wre, const float* __restrict__ bre, int* __restrict__ experts, float* __restrict__ weights, int* __restrict__ rank, unsigned* __restrict__ cnt, float* __restrict__ rstd) {
    const int lane = threadIdx.x & 63, row = blockIdx.x * 4 + (threadIdx.x >> 6);
    const f32x4* xr = (const f32x4*)(X + (size_t)row * DM);
    f32x4 v[4]; float s = 0.f;
#pragma unroll
    for (int j = 0; j < 4; ++j) { v[j] = xr[lane + 64 * j]; s += v[j].x * v[j].x + v[j].y * v[j].y + v[j].z * v[j].z + v[j].w * v[j].w; }
    const float rs = rsqrtf(wave_sum(s) * (1.f / DM) + EPS);
    float acc[36];
#pragma unroll
    for (int e = 0; e < 36; ++e) acc[e] = 0.f;
#pragma unroll
    for (int j = 0; j < 4; ++j) { const f32x4 gg = ((const f32x4*)g)[lane + 64 * j];
        float h[4] = {v[j].x * rs * gg.x, v[j].y * rs * gg.y, v[j].z * rs * gg.z, v[j].w * rs * gg.w};
        u32x2 o; o.x = f2bf(h[0]) | ((unsigned)f2bf(h[1]) << 16); o.y = f2bf(h[2]) | ((unsigned)f2bf(h[3]) << 16);
        ((u32x2*)(H2 + (size_t)row * DM))[lane + 64 * j] = o;
#pragma unroll
        for (int i = 0; i < 4; ++i) { const int k = (lane + 64 * j) * 4 + i;
            const f32x4 wg = *(const f32x4*)(wrg + (size_t)k * 4);
            acc[0] += h[i] * wg.x; acc[1] += h[i] * wg.y; acc[2] += h[i] * wg.z; acc[3] += h[i] * wg.w;
#pragma unroll
            for (int e4 = 0; e4 < 8; ++e4) { const f32x4 we = *(const f32x4*)(wre + (size_t)k * 32 + e4 * 4);
                acc[4 + e4 * 4 + 0] += h[i] * we.x; acc[4 + e4 * 4 + 1] += h[i] * we.y; acc[4 + e4 * 4 + 2] += h[i] * we.z; acc[4 + e4 * 4 + 3] += h[i] * we.w; }
        }
    }
#pragma unroll
    for (int e = 0; e < 36; ++e) acc[e] = wave_sum(acc[e]);
    if (lane == 0) {
        rstd[row] = rs;
        int gi = 0; float gm = acc[0] + brg[0];
        for (int i = 1; i < 4; ++i) { const float l = acc[i] + brg[i]; if (l > gm) { gm = l; gi = i; } }
        float gs = 0.f; for (int i = 0; i < 4; ++i) gs += __expf(acc[i] + brg[i] - gm);
        const float gp = 1.f / gs;
        float el[8];
#pragma unroll
        for (int i = 0; i < 8; ++i) el[i] = 0.f;
#pragma unroll
        for (int gq = 0; gq < 4; ++gq) if (gq == gi) {
#pragma unroll
            for (int i = 0; i < 8; ++i) el[i] = acc[4 + gq * 8 + i] + bre[gq * 8 + i]; }
        int i0 = 0; float l0 = el[0];
#pragma unroll
        for (int i = 1; i < 8; ++i) if (el[i] > l0) { l0 = el[i]; i0 = i; }
        int i1 = -1; float l1 = -INFINITY;
#pragma unroll
        for (int i = 0; i < 8; ++i) if (i != i0 && el[i] > l1) { l1 = el[i]; i1 = i; }
        const float p1 = __expf(l1 - l0), inv = 1.f / (1.f + p1);
        const int e0 = gi * 8 + i0, e1 = gi * 8 + i1;
        experts[row * 2] = e0; experts[row * 2 + 1] = e1;
        weights[row * 2] = gp * inv; weights[row * 2 + 1] = gp * p1 * inv;
        rank[row * 2] = (int)atomicAdd(cnt + e0, 1u); rank[row * 2 + 1] = (int)atomicAdd(cnt + e1, 1u);
    }
}
__global__ void s_dispatch(const unsigned* __restrict__ cnt, int* __restrict__ tile_tab) {
    if (threadIdx.x == 0) {
        int off = 0, nt = 0;
        for (int e = 0; e < NEXP; ++e) { const int c = (int)cnt[e], t = (c + MOE_TILE - 1) / MOE_TILE; tile_tab[260 + e] = off; for (int i = 0; i < t; ++i) tile_tab[nt++] = e; off += t * MOE_TILE; }
        tile_tab[256] = nt;
    }
}
__global__ __launch_bounds__(256) void s_gather(const float* __restrict__ X, const float* __restrict__ rstd, const float* __restrict__ g, const int* __restrict__ experts, const float* __restrict__ weights, const int* __restrict__ rank, const int* __restrict__ tile_tab,
                                                bf16_t* __restrict__ BUF, float* __restrict__ roww, int* __restrict__ dest) {
    const int lane = threadIdx.x & 63, a = blockIdx.x * 4 + (threadIdx.x >> 6);
    const int tok = a >> 1, e = experts[a], d = tile_tab[260 + e] + rank[a]; const float rs = rstd[tok];
    const f32x4* xr = (const f32x4*)(X + (size_t)tok * DM);
    for (int j = 0; j < 4; ++j) { const f32x4 v = xr[lane + 64 * j], gg = ((const f32x4*)g)[lane + 64 * j];
        u32x2 o; o.x = f2bf(v.x * rs * gg.x) | ((unsigned)f2bf(v.y * rs * gg.y) << 16); o.y = f2bf(v.z * rs * gg.z) | ((unsigned)f2bf(v.w * rs * gg.w) << 16);
        ((u32x2*)(BUF + (size_t)d * DM))[lane + 64 * j] = o; }
    if (lane == 0) { roww[d] = weights[a]; dest[a] = d; }
}
__global__ __launch_bounds__(256) void s_combine_norm(float* __restrict__ X, const bf16_t* __restrict__ YB, const int* __restrict__ dest, const float* __restrict__ g, bf16_t* __restrict__ H, float* __restrict__ OUT) {
    const int lane = threadIdx.x & 63, row = blockIdx.x * 4 + (threadIdx.x >> 6);
    const int d0 = dest[row * 2], d1 = dest[row * 2 + 1];
    f32x4* xr = (f32x4*)(X + (size_t)row * DM);
    f32x4 v[4]; float s = 0.f;
#pragma unroll
    for (int j = 0; j < 4; ++j) { v[j] = xr[lane + 64 * j];
        const u32x2 a = ((const u32x2*)(YB + (size_t)d0 * DM))[lane + 64 * j], b = ((const u32x2*)(YB + (size_t)d1 * DM))[lane + 64 * j];
        v[j].x += __uint_as_float(a.x << 16) + __uint_as_float(b.x << 16); v[j].y += __uint_as_float(a.x & 0xffff0000u) + __uint_as_float(b.x & 0xffff0000u);
        v[j].z += __uint_as_float(a.y << 16) + __uint_as_float(b.y << 16); v[j].w += __uint_as_float(a.y & 0xffff0000u) + __uint_as_float(b.y & 0xffff0000u);
        s += v[j].x * v[j].x + v[j].y * v[j].y + v[j].z * v[j].z + v[j].w * v[j].w; }
    const float rs = rsqrtf(wave_sum(s) * (1.f / DM) + EPS);
#pragma unroll
    for (int j = 0; j < 4; ++j) { const f32x4 gg = ((const f32x4*)g)[lane + 64 * j];
        if (H) { xr[lane + 64 * j] = v[j];
            u32x2 o; o.x = f2bf(v[j].x * rs * gg.x) | ((unsigned)f2bf(v[j].y * rs * gg.y) << 16); o.y = f2bf(v[j].z * rs * gg.z) | ((unsigned)f2bf(v[j].w * rs * gg.w) << 16);
            ((u32x2*)(H + (size_t)row * DM))[lane + 64 * j] = o; }
        else { f32x4 o; o.x = v[j].x * rs * gg.x; o.y = v[j].y * rs * gg.y; o.z = v[j].z * rs * gg.z; o.w = v[j].w * rs * gg.w; ((f32x4*)(OUT + (size_t)row * DM))[lane + 64 * j] = o; }
    }
}

#define LAS __attribute__((address_space(3)))
#define GAS __attribute__((address_space(1)))
typedef short bf16x8 __attribute__((ext_vector_type(8)));
typedef short s16x4 __attribute__((ext_vector_type(4)));
typedef float f32x16 __attribute__((ext_vector_type(16)));
typedef float f32x2 __attribute__((ext_vector_type(2)));

constexpr size_t WB_IN = 0, WB_UP = 6029312, WB_OUT = WB_UP + 1572864, WB_GU = WB_OUT + 1048576, WB_DN = WB_GU + 33554432, WB_LAYER = WB_DN + 16777216;
constexpr size_t WB_MEMKV = 2 * WB_LAYER;
constexpr size_t WB_RT = WB_MEMKV + 1048576;
static_assert(WS_WB + (WB_RT + 2 * 2 * 48 * 1024) * 2 <= WS_END, "weight copies fit");
constexpr int N_PHASES = 19;
constexpr int XP = 2048;
constexpr int LCAP = 16384;

__device__ __forceinline__ int lane_id() { int r; asm volatile("v_mbcnt_lo_u32_b32 %0, -1, 0\n\tv_mbcnt_hi_u32_b32 %0, -1, %0" : "=v"(r)); return r; }
__device__ __forceinline__ unsigned cvt_pk_bf16(float lo, float hi) { unsigned r; asm volatile("v_cvt_pk_bf16_f32 %0, %1, %2" : "=v"(r) : "v"(lo), "v"(hi)); return r; }
__device__ __forceinline__ float fast_sigmoid(float v) { return __builtin_amdgcn_rcpf(1.f + __builtin_amdgcn_exp2f(-v * LOG2E)); }

namespace pg8 {
#define PG8_LAS LAS
constexpr int BM = 256, BK = 64, HALF = 128, HTB = HALF * BK * 2, STAGE_BYTES = 8 * HTB, NXCD = 8, WGM = 8;
__host__ __device__ __forceinline__ int lds_byte(int r, int c) { const int st = (r >> 4) * 2 + (c >> 5), rr = r & 15, cc = c & 31, ob = rr * 64 + cc * 2; return st * 1024 + (ob ^ (((ob >> 9) & 1) << 5)); }
__host__ __device__ __forceinline__ void stage_rc(int b, int& R, int& C) { const int st = b / 1024, sb = b % 1024, swz = sb ^ (((sb >> 9) & 1) << 5); R = (st >> 1) * 16 + swz / 64; C = (st & 1) * 32 + (swz % 64) / 2; }
__host__ __device__ __forceinline__ int perm32(int rho) { const int n = rho >> 4, i = rho & 15; return 8 * (i >> 2) + 4 * n + (i & 3); }

struct Unit { int pm, pn, sub, ord; const char* a; const char* b; };
struct Gemm { int lda; int K; };
__device__ __forceinline__ void tile_order(int L, int nM, int nN, int& pm, int& pn) {
    const int nwg = nM * nN; int wgid = L; { const int q = nwg / NXCD, r = nwg % NXCD, xcd = wgid % NXCD, off = wgid / NXCD; wgid = (xcd < r ? xcd * (q + 1) : r * (q + 1) + (xcd - r) * q) + off; }
    const int nig = WGM * nN, gid = wgid / nig, fm = gid * WGM, gsz = (nM - fm) < WGM ? (nM - fm) : WGM;
    pm = fm + ((wgid % nig) % gsz); pn = (wgid % nig) / gsz;
}
__device__ __forceinline__ u32x4 pack8(const f32x4& v0, const f32x4& v1) { u32x4 w; w.x = cvt_pk_bf16(v0[0], v0[1]); w.y = cvt_pk_bf16(v0[2], v0[3]); w.z = cvt_pk_bf16(v1[0], v1[1]); w.w = cvt_pk_bf16(v1[2], v1[3]); return w; }
__device__ __forceinline__ void unpack8(const u32x4& w, f32x4& v0, f32x4& v1) {
    v0[0] = __uint_as_float(w.x << 16); v0[1] = __uint_as_float(w.x & 0xffff0000u); v0[2] = __uint_as_float(w.y << 16); v0[3] = __uint_as_float(w.y & 0xffff0000u);
    v1[0] = __uint_as_float(w.z << 16); v1[1] = __uint_as_float(w.z & 0xffff0000u); v1[2] = __uint_as_float(w.w << 16); v1[3] = __uint_as_float(w.w & 0xffff0000u); }

struct EpiProj {
    static constexpr bool PERM = true, AFTER_DRAIN = false;
    bf16_t* PROJ; bf16_t* MEMKV; const float* tab1; const float* tab2; const float* qg; const float* kg;
    __device__ __forceinline__ void operator()(const f32x4 (&acc)[2][2][4][2], const Unit& u, int wr, int wc, int fr, int fq) const {
        const int colt = u.pn * 256, dcol = colt + wc * 64 + fq * 8, row0 = u.pm * 256 + wr * 64 + fr;
        if (u.sub == 1) {
#pragma unroll
            for (int ai = 0; ai < 2; ++ai)
#pragma unroll
                for (int m = 0; m < 4; ++m) { bf16_t* rowp = MEMKV + (size_t)(row0 + ai * 128 + m * 16) * 1024 + dcol;
#pragma unroll
                    for (int bj = 0; bj < 2; ++bj) *(u32x4*)(rowp + bj * 32) = pack8(acc[ai][bj][m][0], acc[ai][bj][m][1]); }
            return;
        }
        int mode = 0; float sc = 1.f; const float* g = qg;
        if (colt < C_AV) { mode = 1; if (colt < C_AK) sc = C2_64; }
        else if (colt < C_BQ) mode = 0;
        else if (colt < C_BK) { mode = 2; sc = C2_64; }
        else if (colt < C_CQ) { if (wc < 2) { mode = 2; g = kg; } }
        else if (colt < C_G) sc = C2_128;
        else mode = 3;
        f32x4 gv[2][2];
        if (mode == 2) {
#pragma unroll
            for (int bj = 0; bj < 2; ++bj)
#pragma unroll
                for (int n = 0; n < 2; ++n) gv[bj][n] = *(const f32x4*)(g + bj * 32 + fq * 8 + n * 4);
        }
#pragma unroll
        for (int ai = 0; ai < 2; ++ai)
#pragma unroll
            for (int m = 0; m < 4; ++m) {
                const int row = row0 + ai * 128 + m * 16, pos = row & (SEQ - 1);
                f32x4 v[2][2] = {{acc[ai][0][m][0], acc[ai][0][m][1]}, {acc[ai][1][m][0], acc[ai][1][m][1]}};
                if (mode == 2) {
                    float ss = 0.f;
#pragma unroll
                    for (int bj = 0; bj < 2; ++bj)
#pragma unroll
                        for (int n = 0; n < 2; ++n) ss += (v[bj][n][0] * v[bj][n][0] + v[bj][n][1] * v[bj][n][1]) + (v[bj][n][2] * v[bj][n][2] + v[bj][n][3] * v[bj][n][3]);
                    ss += __shfl_xor(ss, 16); ss += __shfl_xor(ss, 32);
                    const float rs = rsqrtf(ss * (1.f / 64.f) + EPS);
#pragma unroll
                    for (int bj = 0; bj < 2; ++bj)
#pragma unroll
                        for (int n = 0; n < 2; ++n) v[bj][n] = v[bj][n] * rs * gv[bj][n];
                }
                if (mode == 1 || mode == 2) {
                    const float* tb = (mode == 1 ? tab1 : tab2) + ((size_t)pos * 32 + fq * 8) * 2;
#pragma unroll
                    for (int n = 0; n < 2; ++n) { const f32x4 t0 = *(const f32x4*)(tb + n * 8), t1 = *(const f32x4*)(tb + n * 8 + 4);
                        const float cs[4] = {t0[0], t0[2], t1[0], t1[2]}, sn[4] = {t0[1], t0[3], t1[1], t1[3]};
#pragma unroll
                        for (int e = 0; e < 4; ++e) { const float x1 = v[0][n][e], x2 = v[1][n][e]; v[0][n][e] = x1 * cs[e] - x2 * sn[e]; v[1][n][e] = x2 * cs[e] + x1 * sn[e]; } }
                }
                if (mode == 3) {
#pragma unroll
                    for (int bj = 0; bj < 2; ++bj)
#pragma unroll
                        for (int n = 0; n < 2; ++n)
#pragma unroll
                            for (int e = 0; e < 4; ++e) v[bj][n][e] = fast_sigmoid(v[bj][n][e]);
                }
                bf16_t* rowp = PROJ + (size_t)row * D_IN + dcol;
#pragma unroll
                for (int bj = 0; bj < 2; ++bj) *(u32x4*)(rowp + bj * 32) = pack8(v[bj][0] * sc, v[bj][1] * sc);
            }
    }
};
struct EpiGate {
    static constexpr bool PERM = true, AFTER_DRAIN = false;
    bf16_t* MERGED; const bf16_t* PROJ;
    __device__ __forceinline__ void operator()(const f32x4 (&acc)[2][2][4][2], const Unit& u, int wr, int wc, int fr, int fq) const {
        const int col0 = u.pn * 256 + wc * 32 + fq * 8, row0 = u.pm * 256 + wr * 64 + fr;
#pragma unroll
        for (int ai = 0; ai < 2; ++ai)
#pragma unroll
            for (int mp = 0; mp < 2; ++mp) {
                u32x4 gq[2][2], oq[2][2];
#pragma unroll
                for (int mi = 0; mi < 2; ++mi) { const int row = row0 + ai * 128 + (mp * 2 + mi) * 16;
                    const bf16_t* gp = PROJ + (size_t)row * D_IN + C_G + u.sub * 1024 + col0; const bf16_t* op = MERGED + (size_t)row * DM + col0;
#pragma unroll
                    for (int bj = 0; bj < 2; ++bj) { gq[mi][bj] = *(const u32x4*)(gp + bj * 128); if (u.sub != 0) oq[mi][bj] = *(const u32x4*)(op + bj * 128); else oq[mi][bj] = (u32x4){0u, 0u, 0u, 0u}; } }
                asm volatile("" ::: "memory");
#pragma unroll
                for (int mi = 0; mi < 2; ++mi) { const int m = mp * 2 + mi; bf16_t* op = MERGED + (size_t)(row0 + ai * 128 + m * 16) * DM + col0;
#pragma unroll
                    for (int bj = 0; bj < 2; ++bj) { f32x4 g0, g1, o0, o1; unpack8(gq[mi][bj], g0, g1); unpack8(oq[mi][bj], o0, o1);
                        o0 += g0 * acc[ai][bj][m][0]; o1 += g1 * acc[ai][bj][m][1];
                        *(u32x4*)(op + bj * 128) = pack8(o0, o1); } }
                asm volatile("" ::: "memory");
            }
    }
};
struct EpiResid {
    static constexpr bool PERM = true, AFTER_DRAIN = false;
    const float* Xf; bf16_t* XB; int first;
    __device__ __forceinline__ void operator()(const f32x4 (&acc)[2][2][4][2], const Unit& u, int wr, int wc, int fr, int fq) const {
        const int col0 = u.pn * 256 + wc * 32 + fq * 8, row0 = u.pm * 256 + wr * 64 + fr;
#pragma unroll
        for (int ai = 0; ai < 2; ++ai)
#pragma unroll
            for (int mp = 0; mp < 2; ++mp) {
                f32x4 xin[2][2][2];
                if (first) {
#pragma unroll
                    for (int mi = 0; mi < 2; ++mi) { const size_t off = (size_t)(row0 + ai * 128 + (mp * 2 + mi) * 16) * DM + col0;
#pragma unroll
                        for (int bj = 0; bj < 2; ++bj) { const f32x4* pi = (const f32x4*)(Xf + off + bj * 128); xin[mi][bj][0] = pi[0]; xin[mi][bj][1] = pi[1]; } }
                } else {
                    u32x4 xq[2][2];
#pragma unroll
                    for (int mi = 0; mi < 2; ++mi)
#pragma unroll
                        for (int bj = 0; bj < 2; ++bj) xq[mi][bj] = *(const u32x4*)(XB + (size_t)(row0 + ai * 128 + (mp * 2 + mi) * 16) * XP + col0 + bj * 128);
                    asm volatile("" ::: "memory");
#pragma unroll
                    for (int mi = 0; mi < 2; ++mi)
#pragma unroll
                        for (int bj = 0; bj < 2; ++bj) unpack8(xq[mi][bj], xin[mi][bj][0], xin[mi][bj][1]);
                }
                asm volatile("" ::: "memory");
#pragma unroll
                for (int mi = 0; mi < 2; ++mi) { const int m = mp * 2 + mi;
#pragma unroll
                    for (int bj = 0; bj < 2; ++bj) *(u32x4*)(XB + (size_t)(row0 + ai * 128 + m * 16) * XP + col0 + bj * 128) = pack8(xin[mi][bj][0] + acc[ai][bj][m][0], xin[mi][bj][1] + acc[ai][bj][m][1]); }
                asm volatile("" ::: "memory");
            }
    }
};
struct EpiSilu {
    static constexpr bool PERM = true, AFTER_DRAIN = false;
    bf16_t* HID;
    __device__ __forceinline__ void operator()(const f32x4 (&acc)[2][2][4][2], const Unit& u, int wr, int wc, int fr, int fq) const {
        const __amdgpu_buffer_rsrc_t rsrc = __builtin_amdgcn_make_buffer_rsrc((void*)HID, 0, P_ROWS * DEXP * 2, 0x00020000);
        const int col0 = u.pn * 128 + wc * 32 + fq * 8, row0 = u.pm * 256 + wr * 64 + fr;
#pragma unroll
        for (int ai = 0; ai < 2; ++ai)
#pragma unroll
            for (int m = 0; m < 4; ++m) { f32x4 h[2];
#pragma unroll
                for (int n = 0; n < 2; ++n)
#pragma unroll
                    for (int e = 0; e < 4; ++e) { const float gq = acc[ai][0][m][n][e]; h[n][e] = gq * fast_sigmoid(gq) * acc[ai][1][m][n][e]; }
                __builtin_amdgcn_raw_buffer_store_b128(pack8(h[0], h[1]), rsrc, ((row0 + ai * 128 + m * 16) * DEXP + col0) * 2, 0, 16); }
    }
};
struct EpiRowScale {
    static constexpr bool PERM = true, AFTER_DRAIN = false;
    bf16_t* YB; const PG8_LAS float* wtab;
    __device__ __forceinline__ void operator()(const f32x4 (&acc)[2][2][4][2], const Unit& u, int wr, int wc, int fr, int fq) const {
        const int col0 = u.pn * 256 + wc * 32 + fq * 8, rt0 = wr * 64 + fr;
#pragma unroll
        for (int ai = 0; ai < 2; ++ai)
#pragma unroll
            for (int m = 0; m < 4; ++m) { const int rt = rt0 + ai * 128 + m * 16; const float w = wtab[u.ord * 256 + rt]; bf16_t* op = YB + (size_t)(u.pm * 256 + rt) * DM + col0;
#pragma unroll
                for (int bj = 0; bj < 2; ++bj) *(u32x4*)(op + bj * 128) = pack8(acc[ai][bj][m][0] * w, acc[ai][bj][m][1] * w); }
    }
};
struct SchedProj {
    int c, G, nmain, ntotal; const char* A; const char* B; const char* Am; const char* Bm;
    __device__ __forceinline__ bool next(int i, Unit& u) const {
        const long L = (long)i * G + c; if (L >= ntotal) return false;
        u.ord = i;
        if (L < nmain) { tile_order((int)L, M / 256, D_IN / 256, u.pm, u.pn); u.sub = 0; u.a = A + (size_t)u.pm * (256 * DM * 2); u.b = B + (size_t)u.pn * (256 * DM * 2); }
        else { const int r = (int)L - nmain; u.pm = r >> 2; u.pn = r & 3; u.sub = 1; u.a = Am + (size_t)u.pm * (256 * DM * 2); u.b = Bm + (size_t)u.pn * (256 * DM * 2); }
        return true; }
    __device__ __forceinline__ void a_ready(const Unit&) const {}
    __device__ __forceinline__ void done(const Unit&) const {}
};
struct SchedGate {
    int c, G; const char* OBRp; const char* WUP;
    __device__ __forceinline__ bool next(int i, Unit& u) const {
        const int t = c + G * (i / 3); if (t >= 256) return false;
        tile_order(t, M / 256, 4, u.pm, u.pn); u.sub = i % 3; u.ord = i;
        u.a = OBRp + ((size_t)u.pm * 256 * OBR_W + 512 * u.sub) * 2; u.b = WUP + ((size_t)u.sub * 1024 * 512 + (size_t)u.pn * 256 * 512) * 2; return true; }
    __device__ __forceinline__ void a_ready(const Unit&) const {}
    __device__ __forceinline__ void done(const Unit&) const {}
};
struct SchedPlain {
    int c, G, nM; const char* A; const char* B; size_t a_tile, b_tile;
    __device__ __forceinline__ bool next(int i, Unit& u) const {
        const long L = (long)i * G + c; if (L >= (long)nM * 4) return false;
        tile_order((int)L, nM, 4, u.pm, u.pn); u.sub = 0; u.ord = i; u.a = A + (size_t)u.pm * a_tile; u.b = B + (size_t)u.pn * b_tile; return true; }
    __device__ __forceinline__ void a_ready(const Unit&) const {}
    __device__ __forceinline__ void done(const Unit&) const {}
};
struct SchedMoeUp {
    static constexpr size_t b_exp = (size_t)1024 * 1024 * 2, b_tile = (size_t)256 * DM * 2;
    int c, G, ntiles; const PG8_LAS int* tile_e; const char* A; const char* B; unsigned* tcnt;
    __device__ __forceinline__ bool next(int i, Unit& u) const {
        const long L = (long)i * G + c; if (L >= (long)ntiles * 4) return false;
        u.pm = (int)(L >> 2); u.pn = (int)(L & 3); u.sub = 0; u.ord = i; const int e = tile_e[u.pm];
        u.a = A; u.b = B + (size_t)e * b_exp + (size_t)u.pn * b_tile; return true; }
    __device__ __forceinline__ void a_ready(const Unit&) const {}
    __device__ __forceinline__ void done(const Unit& u) const {
        asm volatile("s_waitcnt vmcnt(0)" ::: "memory");
        if (lane_id() == 0) __hip_atomic_fetch_add(tcnt + 64 * u.pm, 1u, __ATOMIC_RELAXED, __HIP_MEMORY_SCOPE_AGENT);
    }
};
__device__ __forceinline__ int moe_down_unit(int c, int i, int rem, int G) {
    const int n0 = G - rem, n1 = rem;
    return c >= rem ? n0 * i + n1 * (i > 1 ? i - 1 : 0) + (c - rem) : n0 * (i + 2) + n1 * i + c;
}
struct SchedMoeDown {
    static constexpr size_t a_tile = (size_t)256 * DEXP * 2, b_exp = (size_t)1024 * 512 * 2, b_tile = (size_t)256 * DEXP * 2;
    int c, G, ntiles, rem, wv; const PG8_LAS int* tile_e; const char* A; const char* B; unsigned* tcnt; unsigned* tmo;
    __device__ __forceinline__ bool next(int i, Unit& u) const {
        const int j = moe_down_unit(c, i, rem, G); if (j >= ntiles * 4) return false;
        u.pm = j >> 2; u.pn = j & 3; u.sub = 0; u.ord = i; const int e = tile_e[u.pm];
        u.a = A + (size_t)u.pm * a_tile; u.b = B + (size_t)e * b_exp + (size_t)u.pn * b_tile; return true; }
    __device__ __forceinline__ void a_ready(const Unit& u) const {
        if (wv == 0) {
            unsigned polls = 0;
            while ((unsigned)__builtin_amdgcn_readfirstlane(__hip_atomic_load(tcnt + 64 * u.pm, __ATOMIC_RELAXED, __HIP_MEMORY_SCOPE_AGENT)) < 32u) {
                if (++polls > (1u << 20)) { if (lane_id() == 0) __hip_atomic_store(tmo, 1u, __ATOMIC_RELAXED, __HIP_MEMORY_SCOPE_AGENT); break; }
                __builtin_amdgcn_s_sleep(2); }
            __builtin_amdgcn_fence(__ATOMIC_ACQUIRE, "agent");
            asm volatile("s_waitcnt vmcnt(0)" ::: "memory");
        }
        asm volatile("" ::: "memory"); __builtin_amdgcn_s_barrier(); asm volatile("" ::: "memory");
    }
    __device__ __forceinline__ void done(const Unit&) const {}
};

template <class Epi, class Sched, bool ALIGN_EPI = false, bool SP2 = false, bool GATHER = false>
__device__ __forceinline__ void gemm_phase(PG8_LAS unsigned char* lds, const Gemm g, const Sched& S, const Epi& E, int wave_id, const PG8_LAS unsigned* rowtab = nullptr) {
    static_assert(!GATHER || SP2, "the gathered A path is written for the two-super-phase loop");
    int tid_ = wave_id * 64 + lane_id(); asm volatile("" : "+v"(tid_));
    const int tid = tid_, wid = __builtin_amdgcn_readfirstlane(tid >> 6), lane = tid & 63, wr = wid >> 2, wc = wid & 3, fr = lane & 15, fq = lane >> 4;
    const int K = g.K, nt = K / BK;
    unsigned voffA[2], voffB[2];
#pragma unroll
    for (int i = 0; i < 2; ++i) { int R, C; stage_rc(tid * 16 + i * 8192, R, C); const int Rb = Epi::PERM ? ((R & ~31) + perm32(R & 31)) : R;
        voffA[i] = (unsigned)(R * g.lda + C) * 2u; voffB[i] = (unsigned)(Rb * K + C) * 2u; }
    unsigned gC[2][2] = {{0u, 0u}, {0u, 0u}}, gN[2][2] = {{0u, 0u}, {0u, 0u}};
#define PG8_GROWS(dst, ord) do { if constexpr (GATHER) { _Pragma("unroll") for (int i_ = 0; i_ < 2; ++i_) { int R_, C_; stage_rc((wid * 64 + fq * 16 + fr) * 16 + i_ * 8192, R_, C_);     \
        _Pragma("unroll") for (int h_ = 0; h_ < 2; ++h_) dst[h_][i_] = rowtab[(ord) * 256 + h_ * 128 + R_] + (unsigned)C_ * 2u; } } } while (0)
#define PG8_STAGE_A(bufoff, base, h, use_next) do { if constexpr (GATHER) { unsigned vo_[2]; vo_[0] = (use_next) ? gN[h][0] : gC[h][0]; vo_[1] = (use_next) ? gN[h][1] : gC[h][1]; PG8_STAGE(bufoff, base, vo_); } \
        else { PG8_STAGE(bufoff, (base) + (h) * hstepA, voffA); } } while (0)
    const size_t kstep = (size_t)(BK * 2);
    const size_t hstepA = (size_t)HALF * g.lda * 2, hstepB = (size_t)HALF * K * 2;
    const unsigned ldsw = (unsigned)wid * 1024u;
    const int aoff = lds_byte(wr * 64 + fr, fq * 8), boff = lds_byte(wc * 32 + fr, fq * 8);
#define PG8_SA(b, h) (((b) * 2 + (h)) * HTB)
#define PG8_SB(b, h) ((4 + (b) * 2 + (h)) * HTB)
#define PG8_STAGE(bufoff, gbase, voff) do { _Pragma("unroll") for (int _i = 0; _i < 2; ++_i) \
        __builtin_amdgcn_global_load_lds((const unsigned*)((const char*)(gbase) + (voff)[_i]), (PG8_LAS unsigned*)(lds + (bufoff) + ldsw + _i * 8192), 16, 0, 0); } while (0)
#define PG8_LDA(dst, b, h) do { _Pragma("unroll") for (int m = 0; m < 4; ++m) _Pragma("unroll") for (int k = 0; k < 2; ++k) dst[m][k] = *(const PG8_LAS bf16x8*)(lds + PG8_SA(b, h) + aoff + m * 2048 + k * 1024); } while (0)
#define PG8_LDB(dst, b, h) do { _Pragma("unroll") for (int n = 0; n < 2; ++n) _Pragma("unroll") for (int k = 0; k < 2; ++k) dst[n][k] = *(const PG8_LAS bf16x8*)(lds + PG8_SB(b, h) + boff + n * 2048 + k * 1024); } while (0)
#define PG8_MMA(ai, bj, At, Bt) do { __builtin_amdgcn_s_setprio(1); _Pragma("unroll") for (int m = 0; m < 4; ++m) _Pragma("unroll") for (int n = 0; n < 2; ++n) _Pragma("unroll") for (int k = 0; k < 2; ++k) \
        acc[ai][bj][m][n] = __builtin_amdgcn_mfma_f32_16x16x32_bf16(Bt[n][k], At[m][k], acc[ai][bj][m][n], 0, 0, 0); __builtin_amdgcn_s_setprio(0); } while (0)
#define PG8_WAIT_V(n) asm volatile("s_waitcnt vmcnt(" #n ")" ::: "memory")
#define PG8_WAIT_L(n) asm volatile("s_waitcnt lgkmcnt(" #n ")" ::: "memory")
#define PG8_BAR __builtin_amdgcn_s_barrier()
#define PG8_SCHED __builtin_amdgcn_sched_barrier(0)
    Unit cur, nxt; int ui = 0;
    if (!S.next(0, cur)) return;
    f32x4 acc[2][2][4][2];
#pragma unroll
    for (int a = 0; a < 2; ++a)
#pragma unroll
        for (int b = 0; b < 2; ++b)
#pragma unroll
            for (int m = 0; m < 4; ++m)
#pragma unroll
                for (int n = 0; n < 2; ++n) acc[a][b][m][n] = (f32x4){0.f, 0.f, 0.f, 0.f};
    bf16x8 At[4][2], B0[2][2], B1[2][2];
    const char* cA = cur.a; const char* cB = cur.b;
    S.a_ready(cur);
    if constexpr (SP2) {
        PG8_GROWS(gC, 0);
        PG8_STAGE(PG8_SB(0, 0), cB, voffB); PG8_STAGE(PG8_SB(0, 1), cB + hstepB, voffB); PG8_STAGE_A(PG8_SA(0, 0), cA, 0, false); PG8_STAGE_A(PG8_SA(0, 1), cA, 1, false);
        if (wr == 1) PG8_BAR;
        PG8_WAIT_V(2); PG8_BAR;
        PG8_STAGE(PG8_SB(1, 0), cB + kstep, voffB); PG8_STAGE_A(PG8_SA(1, 0), cA + kstep, 0, false); PG8_STAGE(PG8_SB(1, 1), cB + hstepB + kstep, voffB);
        PG8_WAIT_V(6); PG8_BAR;
    } else {
        PG8_STAGE(PG8_SB(0, 0), cB, voffB); PG8_STAGE(PG8_SA(0, 0), cA, voffA); PG8_STAGE(PG8_SB(0, 1), cB + hstepB, voffB); PG8_STAGE(PG8_SA(0, 1), cA + hstepA, voffA);
        if (wr == 1) PG8_BAR;
        PG8_WAIT_V(4); PG8_BAR;
        PG8_STAGE(PG8_SB(1, 0), cB + kstep, voffB); PG8_STAGE(PG8_SA(1, 0), cA + kstep, voffA); PG8_STAGE(PG8_SB(1, 1), cB + hstepB + kstep, voffB);
        PG8_WAIT_V(6); PG8_BAR;
    }
    for (;;) {
        const bool has_next = S.next(ui + 1, nxt);
        const char* nA = has_next ? nxt.a : cA; const char* nB = has_next ? nxt.b : cB;
        for (int t = 0; t < nt; t += 2) {
            const bool last = (t == nt - 2);
            const char* a1 = cA + (size_t)(t + 1) * kstep;
            const char* a2 = last ? nA : cA + (size_t)(t + 2) * kstep; const char* b2 = last ? nB : cB + (size_t)(t + 2) * kstep;
            const char* a3 = a2 + kstep; const char* b3 = b2 + kstep;
            if (last && has_next) S.a_ready(nxt);
            if constexpr (GATHER) { if (last) { if (has_next) { PG8_GROWS(gN, ui + 1); } else { _Pragma("unroll") for (int h_ = 0; h_ < 2; ++h_) _Pragma("unroll") for (int i_ = 0; i_ < 2; ++i_) gN[h_][i_] = gC[h_][i_]; } } }
            if constexpr (SP2) {
            PG8_LDB(B0, 0, 0); PG8_LDB(B1, 0, 1); PG8_SCHED; PG8_LDA(At, 0, 0); PG8_STAGE_A(PG8_SA(1, 1), a1, 1, false);
            PG8_WAIT_V(8); PG8_WAIT_L(0); PG8_BAR; PG8_MMA(0, 0, At, B0); PG8_MMA(0, 1, At, B1); PG8_BAR; PG8_SCHED;
            PG8_LDA(At, 0, 1); PG8_STAGE(PG8_SB(0, 0), b2, voffB); PG8_STAGE(PG8_SB(0, 1), b2 + hstepB, voffB); PG8_STAGE_A(PG8_SA(0, 0), a2, 0, last);
            PG8_WAIT_V(8); PG8_WAIT_L(0); PG8_BAR; PG8_MMA(1, 0, At, B0); PG8_MMA(1, 1, At, B1); PG8_BAR; PG8_SCHED;
            PG8_LDB(B0, 1, 0); PG8_LDB(B1, 1, 1); PG8_SCHED; PG8_LDA(At, 1, 0); PG8_STAGE_A(PG8_SA(0, 1), a2, 1, last);
            PG8_WAIT_V(8); PG8_WAIT_L(0); PG8_BAR; PG8_MMA(0, 0, At, B0); PG8_MMA(0, 1, At, B1); PG8_BAR; PG8_SCHED;
            PG8_LDA(At, 1, 1); PG8_STAGE(PG8_SB(1, 0), b3, voffB); PG8_STAGE(PG8_SB(1, 1), b3 + hstepB, voffB); PG8_STAGE_A(PG8_SA(1, 0), a3, 0, last);
            PG8_WAIT_V(8); PG8_WAIT_L(0); PG8_BAR; PG8_MMA(1, 0, At, B0); PG8_MMA(1, 1, At, B1); PG8_BAR; PG8_SCHED;
            } else {
            PG8_LDB(B0, 0, 0); PG8_SCHED; PG8_LDA(At, 0, 0); PG8_STAGE(PG8_SA(1, 1), a1 + hstepA, voffA);
            PG8_WAIT_L(8); PG8_BAR; PG8_WAIT_L(0); PG8_MMA(0, 0, At, B0); PG8_BAR; PG8_SCHED;
            PG8_LDB(B1, 0, 1); PG8_STAGE(PG8_SB(0, 0), b2, voffB);
            PG8_BAR; PG8_WAIT_L(0); PG8_MMA(0, 1, At, B1); PG8_BAR;
            PG8_LDA(At, 0, 1); PG8_STAGE(PG8_SA(0, 0), a2, voffA);
            PG8_BAR; PG8_WAIT_L(0); PG8_MMA(1, 0, At, B0); PG8_BAR; PG8_SCHED;
            PG8_STAGE(PG8_SB(0, 1), b2 + hstepB, voffB);
            PG8_WAIT_V(6); PG8_BAR; PG8_MMA(1, 1, At, B1); PG8_BAR;
            PG8_LDB(B0, 1, 0); PG8_SCHED; PG8_LDA(At, 1, 0); PG8_STAGE(PG8_SA(0, 1), a2 + hstepA, voffA);
            PG8_WAIT_L(8); PG8_BAR; PG8_WAIT_L(0); PG8_MMA(0, 0, At, B0); PG8_BAR; PG8_SCHED;
            PG8_LDB(B1, 1, 1); PG8_STAGE(PG8_SB(1, 0), b3, voffB);
            PG8_BAR; PG8_WAIT_L(0); PG8_MMA(0, 1, At, B1); PG8_BAR;
            PG8_LDA(At, 1, 1); PG8_STAGE(PG8_SA(1, 0), a3, voffA);
            PG8_BAR; PG8_WAIT_L(0); PG8_MMA(1, 0, At, B0); PG8_BAR; PG8_SCHED;
            PG8_STAGE(PG8_SB(1, 1), b3 + hstepB, voffB);
            PG8_WAIT_V(6); PG8_BAR; PG8_MMA(1, 1, At, B1); PG8_BAR;
            }
        }
        if constexpr (ALIGN_EPI) { if (wr == 0) PG8_BAR; }
        if constexpr (!Epi::AFTER_DRAIN) { E(acc, cur, wr, wc, fr, fq); S.done(cur); }
        if (!has_next) break;
#pragma unroll
        for (int a = 0; a < 2; ++a)
#pragma unroll
            for (int b = 0; b < 2; ++b)
#pragma unroll
                for (int m = 0; m < 4; ++m)
#pragma unroll
                    for (int n = 0; n < 2; ++n) acc[a][b][m][n] = (f32x4){0.f, 0.f, 0.f, 0.f};
        cur = nxt; cA = nA; cB = nB; ++ui;
        if constexpr (GATHER) { _Pragma("unroll") for (int h_ = 0; h_ < 2; ++h_) _Pragma("unroll") for (int i_ = 0; i_ < 2; ++i_) gC[h_][i_] = gN[h_][i_]; }
        if constexpr (ALIGN_EPI) { if (wr == 1) PG8_BAR; }
    }
    PG8_WAIT_V(0);
    if constexpr (!ALIGN_EPI) { if (wr == 0) PG8_BAR; }
    PG8_BAR;
    if constexpr (Epi::AFTER_DRAIN) { E.fused(acc, cur, wr, wc, fr, fq, lds, wid, lane); S.done(cur); }
#undef PG8_SA
#undef PG8_GROWS
#undef PG8_STAGE_A
#undef PG8_SB
#undef PG8_STAGE
#undef PG8_LDA
#undef PG8_LDB
#undef PG8_MMA
#undef PG8_WAIT_V
#undef PG8_WAIT_L
#undef PG8_BAR
#undef PG8_SCHED
}
}

namespace att {
constexpr int NW = 8, QBLK = 32, KVBLK = 64;
constexpr float THR = 8.f;
#define ATT_SBAR() __builtin_amdgcn_sched_barrier(0)
__device__ __forceinline__ int crow(int r, int hi) { return (r & 3) + 8 * (r >> 2) + 4 * hi; }
template <int D> __device__ __forceinline__ int kswz(int row, int colB) { return D == 128 ? row * 256 + (colB ^ ((row & 7) << 4)) : row * 128 + (colB ^ (((row >> 1) & 7) << 4)); }
template <int DV> __device__ __forceinline__ int v_st(int k, int c) { const int kk = (k & ~0xC) | ((k & 4) << 1) | ((k & 8) >> 1); return ((kk >> 3) * (DV / 32) + (c >> 5)) * 512 + ((kk & 7) * 32 + (c & 31)) * 2; }
__device__ __forceinline__ int v_rd_base(int lane) { return ((lane & 3) << 3) | (((lane >> 2) & 3) << 6) | (((lane >> 4) & 1) << 5) | (((lane >> 5) & 1) << 8); }
template <int DV> constexpr int v_rd_off(int d0, int ks, int half) { return d0 * 512 + ks * (DV / 32) * 1024 + half * (DV / 32) * 512; }
template <int OFF> __device__ __forceinline__ s16x4 tr_read(int vb) { s16x4 r; asm volatile("ds_read_b64_tr_b16 %0, %1 offset:%2" : "=&v"(r) : "v"(vb), "i"(OFF) : "memory"); return r; }

__device__ __forceinline__ void partialSM(f32x16& p0, f32x16& p1, float& m_reg, float& mn, float& alpha) {
    float pmax = p0[0];
#pragma unroll
    for (int r = 1; r < 16; ++r) pmax = fmaxf(pmax, p0[r]);
#pragma unroll
    for (int r = 0; r < 16; ++r) pmax = fmaxf(pmax, p1[r]);
    { auto rr = __builtin_amdgcn_permlane32_swap(__float_as_uint(pmax), __float_as_uint(pmax), false, false); pmax = fmaxf(__uint_as_float(rr[0]), __uint_as_float(rr[1])); }
    if (__builtin_expect(__all(pmax - m_reg <= THR), 1)) { mn = m_reg; alpha = 1.f; }
    else { mn = fmaxf(m_reg, pmax); alpha = __builtin_amdgcn_exp2f(m_reg - mn); m_reg = mn; }
#pragma unroll
    for (int r = 0; r < 16; ++r) { p0[r] -= mn; p1[r] -= mn; }
#pragma unroll
    for (int r = 0; r < 16; ++r) p0[r] = __builtin_amdgcn_exp2f(p0[r]);
}
__device__ __forceinline__ void finishSM(f32x16& p0, f32x16& p1, float alpha, float& l_reg, bf16x8& pa0, bf16x8& pa1, bf16x8& pa2, bf16x8& pa3) {
#pragma unroll
    for (int r = 0; r < 16; ++r) p1[r] = __builtin_amdgcn_exp2f(p1[r]);
    float ps = 0;
#pragma unroll
    for (int r = 0; r < 16; ++r) ps += p0[r];
#pragma unroll
    for (int r = 0; r < 16; ++r) ps += p1[r];
    { auto rr = __builtin_amdgcn_permlane32_swap(__float_as_uint(ps), __float_as_uint(ps), false, false); ps = __uint_as_float(rr[0]) + __uint_as_float(rr[1]); }
    l_reg = l_reg * alpha + ps;
#define ATT_PK4(P, BASE, OUT) do { unsigned a0 = cvt_pk_bf16(P[BASE + 0], P[BASE + 1]), a1 = cvt_pk_bf16(P[BASE + 2], P[BASE + 3]);   \
    unsigned b0 = cvt_pk_bf16(P[BASE + 4], P[BASE + 5]), b1 = cvt_pk_bf16(P[BASE + 6], P[BASE + 7]);                              \
    auto r0 = __builtin_amdgcn_permlane32_swap(a0, b0, false, false); auto r1 = __builtin_amdgcn_permlane32_swap(a1, b1, false, false); \
    u32x4 w = {r0[0], r1[0], r0[1], r1[1]}; OUT = *reinterpret_cast<bf16x8*>(&w); } while (0)
    ATT_PK4(p0, 0, pa0); ATT_PK4(p0, 8, pa1); ATT_PK4(p1, 0, pa2); ATT_PK4(p1, 8, pa3);
#undef ATT_PK4
}
template <int DQK> __device__ __forceinline__ void qkt(f32x16& p0, f32x16& p1, const char* Ks, const bf16x8* qr, int r32, int hi) {
    p0 = f32x16{}; p1 = f32x16{};
#pragma unroll
    for (int d0 = 0; d0 < DQK / 16; ++d0) { const int cb = (d0 * 16 + hi * 8) * 2;
        const bf16x8 b0 = *reinterpret_cast<const bf16x8*>(Ks + kswz<DQK>(r32, cb));
        const bf16x8 b1 = *reinterpret_cast<const bf16x8*>(Ks + kswz<DQK>(32 + r32, cb));
        p0 = __builtin_amdgcn_mfma_f32_32x32x16_bf16(b0, qr[d0], p0, 0, 0, 0);
        p1 = __builtin_amdgcn_mfma_f32_32x32x16_bf16(b1, qr[d0], p1, 0, 0, 0); }
}
template <int DV, int D0> __device__ __forceinline__ void pv_one(f32x16& od, int vb, bf16x8 pa0, bf16x8 pa1, bf16x8 pa2, bf16x8 pa3) {
    const s16x4 l0 = tr_read<v_rd_off<DV>(D0, 0, 0)>(vb), h0 = tr_read<v_rd_off<DV>(D0, 0, 1)>(vb), l1 = tr_read<v_rd_off<DV>(D0, 1, 0)>(vb), h1 = tr_read<v_rd_off<DV>(D0, 1, 1)>(vb);
    const s16x4 l2 = tr_read<v_rd_off<DV>(D0, 2, 0)>(vb), h2 = tr_read<v_rd_off<DV>(D0, 2, 1)>(vb), l3 = tr_read<v_rd_off<DV>(D0, 3, 0)>(vb), h3 = tr_read<v_rd_off<DV>(D0, 3, 1)>(vb);
    asm volatile("s_waitcnt lgkmcnt(0)" ::: "memory"); ATT_SBAR();
#define ATT_PK(L, H) (bf16x8){L[0], L[1], L[2], L[3], H[0], H[1], H[2], H[3]}
    od = __builtin_amdgcn_mfma_f32_32x32x16_bf16(pa0, ATT_PK(l0, h0), od, 0, 0, 0);
    od = __builtin_amdgcn_mfma_f32_32x32x16_bf16(pa1, ATT_PK(l1, h1), od, 0, 0, 0);
    od = __builtin_amdgcn_mfma_f32_32x32x16_bf16(pa2, ATT_PK(l2, h2), od, 0, 0, 0);
    od = __builtin_amdgcn_mfma_f32_32x32x16_bf16(pa3, ATT_PK(l3, h3), od, 0, 0, 0);
#undef ATT_PK
}
template <int DV> __device__ __forceinline__ void pv_all(f32x16 (&o)[DV / 32], int vb, bf16x8 pa0, bf16x8 pa1, bf16x8 pa2, bf16x8 pa3) {
    pv_one<DV, 0>(o[0], vb, pa0, pa1, pa2, pa3); pv_one<DV, 1>(o[1], vb, pa0, pa1, pa2, pa3);
    if constexpr (DV == 128) { pv_one<DV, 2>(o[2], vb, pa0, pa1, pa2, pa3); pv_one<DV, 3>(o[3], vb, pa0, pa1, pa2, pa3); }
}
template <int DQK, int DV> struct Lay { static constexpr int SHM_V = 64 * DV * 2, SHM_K = 64 * DQK * 2, OFF_V = 0, OFF_K = 2 * SHM_V, OFF_WS = OFF_K + 2 * SHM_K, OFF_STASH = OFF_WS + NW * 64 * 4; };

template <int DQK, int DV, int LDQ, int LDK, int LDV>
__device__ __forceinline__ void attn_pass(const bf16_t* __restrict__ Qb, const bf16_t* __restrict__ Kh, const bf16_t* __restrict__ Vh, int nkeys, char* lds, f32x16 (&o)[DV / 32], float (&rli)[16], int wv) {
    using L = Lay<DQK, DV>;
    constexpr int NLK = DQK / 64, NLV = DV / 64;
    int tid_ = wv * 64 + lane_id(); asm volatile("" : "+v"(tid_));
    const int tid = tid_, wid = tid >> 6, lane = tid & 63, r32 = lane & 31, hi = lane >> 5;
    char* V_lds = lds + L::OFF_V; char* K_lds = lds + L::OFF_K;
    float* ws = (float*)(lds + L::OFF_WS) + wid * 64; float* li_l = ws; float* al_l = ws + 32;
    float m_reg = -1e30f, l_reg = 0.f; bf16x8 qr[DQK / 16];
#pragma unroll
    for (int d = 0; d < DV / 32; ++d) o[d] = f32x16{};
    const bf16_t* Qw = Qb + (size_t)(wid * QBLK + r32) * LDQ + hi * 8;
#pragma unroll
    for (int d0 = 0; d0 < DQK / 16; ++d0) qr[d0] = *reinterpret_cast<const bf16x8*>(Qw + d0 * 16);
    const int krow = DQK == 128 ? (tid >> 4) : (tid >> 3), kcol = DQK == 128 ? (tid & 15) * 8 : (tid & 7) * 8;
    const int vrow = DV == 128 ? (tid >> 4) : (tid >> 3), vcol = DV == 128 ? (tid & 15) * 8 : (tid & 7) * 8;
    const int vb0 = (int)(uintptr_t)V_lds + v_rd_base(lane);
    bf16x8 vsE[NLV], ksE[NLK], vsO[NLV], ksO[NLK];
#define ATT_SLOAD(VS, KS, k0) do { _Pragma("unroll") for (int i_ = 0; i_ < NLV; ++i_) VS[i_] = *reinterpret_cast<const bf16x8*>(&Vh[(size_t)((k0) + vrow + 32 * i_) * LDV + vcol]); \
    _Pragma("unroll") for (int i_ = 0; i_ < NLK; ++i_) KS[i_] = *reinterpret_cast<const bf16x8*>(&Kh[(size_t)((k0) + krow + 32 * i_) * LDK + kcol]); } while (0)
#define ATT_SWRITE(b, VS, KS) do { _Pragma("unroll") for (int i_ = 0; i_ < NLV; ++i_) *(bf16x8*)(V_lds + (b) * L::SHM_V + v_st<DV>(vrow + 32 * i_, vcol)) = VS[i_]; \
    _Pragma("unroll") for (int i_ = 0; i_ < NLK; ++i_) *(bf16x8*)(K_lds + (b) * L::SHM_K + kswz<DQK>(krow + 32 * i_, kcol * 2)) = KS[i_]; } while (0)
#define ATT_SWAIT() do { if constexpr (NLK + NLV == 4) asm volatile("s_waitcnt vmcnt(4)" ::: "memory"); else if constexpr (NLK + NLV == 3) asm volatile("s_waitcnt vmcnt(3)" ::: "memory"); else asm volatile("s_waitcnt vmcnt(2)" ::: "memory"); } while (0)
#define ATT_RESC(a) do { if (__any((a) < 1.f)) { if (hi == 0) al_l[r32] = (a); asm volatile("s_waitcnt lgkmcnt(0)" ::: "memory"); \
    _Pragma("unroll") for (int d = 0; d < DV / 32; ++d) _Pragma("unroll") for (int r = 0; r < 16; ++r) o[d][r] *= al_l[crow(r, hi)]; } } while (0)
    f32x16 pA0, pA1, pB0, pB1; float mnA, mnB, alA, alB; bf16x8 pa0, pa1, pa2, pa3; const int NT = nkeys / KVBLK;
    __syncthreads();
    ATT_SLOAD(vsE, ksE, 0); asm volatile("s_waitcnt vmcnt(0)" ::: "memory"); ATT_SWRITE(0, vsE, ksE); __syncthreads();
    qkt<DQK>(pA0, pA1, K_lds, qr, r32, hi); partialSM(pA0, pA1, m_reg, mnA, alA);
    ATT_SLOAD(vsO, ksO, KVBLK); if (2 < NT) ATT_SLOAD(vsE, ksE, 2 * KVBLK);
    ATT_SWAIT(); ATT_SWRITE(1, vsO, ksO); __syncthreads();
    for (int j = 1; j + 1 < NT; j += 2) {
        ATT_SBAR(); qkt<DQK>(pB0, pB1, K_lds + L::SHM_K, qr, r32, hi);
        finishSM(pA0, pA1, alA, l_reg, pa0, pa1, pa2, pa3); ATT_SBAR();
        ATT_SLOAD(vsO, ksO, (j + 2) * KVBLK); ATT_SBAR();
        pv_all<DV>(o, vb0, pa0, pa1, pa2, pa3); partialSM(pB0, pB1, m_reg, mnB, alB);
        __syncthreads(); ATT_SWAIT(); ATT_SWRITE(0, vsE, ksE);
        ATT_RESC(alB); __syncthreads();
        ATT_SBAR(); qkt<DQK>(pA0, pA1, K_lds, qr, r32, hi);
        finishSM(pB0, pB1, alB, l_reg, pa0, pa1, pa2, pa3); ATT_SBAR();
        if (j + 3 < NT) ATT_SLOAD(vsE, ksE, (j + 3) * KVBLK); ATT_SBAR();
        pv_all<DV>(o, vb0 + L::SHM_V, pa0, pa1, pa2, pa3); partialSM(pA0, pA1, m_reg, mnA, alA);
        __syncthreads(); ATT_SWAIT(); ATT_SWRITE(1, vsO, ksO);
        ATT_RESC(alA); __syncthreads();
    }
    ATT_SBAR(); qkt<DQK>(pB0, pB1, K_lds + L::SHM_K, qr, r32, hi);
    finishSM(pA0, pA1, alA, l_reg, pa0, pa1, pa2, pa3); ATT_SBAR();
    pv_all<DV>(o, vb0, pa0, pa1, pa2, pa3); partialSM(pB0, pB1, m_reg, mnB, alB);
    __syncthreads(); ATT_RESC(alB);
    finishSM(pB0, pB1, alB, l_reg, pa0, pa1, pa2, pa3); ATT_SBAR();
    pv_all<DV>(o, vb0 + L::SHM_V, pa0, pa1, pa2, pa3);
    if (hi == 0) li_l[r32] = l_reg; asm volatile("s_waitcnt lgkmcnt(0)" ::: "memory");
#pragma unroll
    for (int r = 0; r < 16; ++r) rli[r] = __builtin_amdgcn_rcpf(li_l[crow(r, hi)]);
#undef ATT_SLOAD
#undef ATT_SWRITE
#undef ATT_SWAIT
#undef ATT_RESC
}
template <int DV, int LDO> __device__ __forceinline__ void store_o(bf16_t* Ob, const f32x16 (&o)[DV / 32], const float (&rli)[16], int wv) {
    int tid_ = wv * 64 + lane_id(); asm volatile("" : "+v"(tid_));
    const int tid = tid_, wid = tid >> 6, lane = tid & 63, r32 = lane & 31, hi = lane >> 5;
    bf16_t* Ow = Ob + (size_t)(wid * QBLK) * LDO;
#pragma unroll
    for (int r = 0; r < 16; ++r) { const int orow = crow(r, hi);
#pragma unroll
        for (int d0 = 0; d0 < DV / 32; ++d0) Ow[(size_t)orow * LDO + d0 * 32 + r32] = f2bf(o[d0][r] * rli[r]); }
}
__device__ __forceinline__ void unit_a(const bf16_t* PROJ, bf16_t* OBR, int b, int h, int qb, float lam, float lam_init, const float* subg, char* lds, int wv) {
    using L = Lay<64, 128>;
    int tid_ = wv * 64 + lane_id(); asm volatile("" : "+v"(tid_));
    const int tid = tid_, wid = tid >> 6, lane = tid & 63, r32 = lane & 31, hi = lane >> 5;
    const bf16_t* kv = PROJ + (size_t)b * SEQ * D_IN; const size_t qrow = (size_t)b * SEQ + qb * 256;
    unsigned* stash = (unsigned*)(lds + L::OFF_STASH) + wid * 2048 + lane;
    f32x16 o[4]; float rli[16];
#pragma unroll 1
    for (int c = 0; c < 2; ++c) {
        attn_pass<64, 128, D_IN, D_IN, D_IN>(PROJ + qrow * D_IN + C_AQ + h * 128 + c * 64, kv + C_AK + h * 128 + c * 64, kv + C_AV + h * 128, SEQ, lds, o, rli, wv);
        if (c == 0) {
#pragma unroll
            for (int d0 = 0; d0 < 4; ++d0)
#pragma unroll
                for (int r = 0; r < 16; r += 2) stash[(d0 * 8 + (r >> 1)) * 64] = cvt_pk_bf16(o[d0][r] * rli[r], o[d0][r + 1] * rli[r + 1]);
        }
    }
    asm volatile("s_waitcnt lgkmcnt(0)" ::: "memory");
    float ss[16];
#pragma unroll
    for (int r = 0; r < 16; ++r) ss[r] = 0.f;
#pragma unroll
    for (int d0 = 0; d0 < 4; ++d0)
#pragma unroll
        for (int r = 0; r < 16; r += 2) { const unsigned w = stash[(d0 * 8 + (r >> 1)) * 64];
            const float c0 = __uint_as_float(w << 16) - lam * o[d0][r] * rli[r], c1 = __uint_as_float(w & 0xffff0000u) - lam * o[d0][r + 1] * rli[r + 1];
            o[d0][r] = c0; o[d0][r + 1] = c1; ss[r] += c0 * c0; ss[r + 1] += c1 * c1; }
#pragma unroll
    for (int r = 0; r < 16; ++r) { float s = ss[r]; s += __shfl_xor(s, 1); s += __shfl_xor(s, 2); s += __shfl_xor(s, 4); s += __shfl_xor(s, 8); s += __shfl_xor(s, 16);
        ss[r] = rsqrtf(s * (1.f / 128.f) + EPS) * (1.f - lam_init); }
    bf16_t* Ow = OBR + (qrow + wid * QBLK) * OBR_W + h * 128;
#pragma unroll
    for (int d0 = 0; d0 < 4; ++d0) { const float g = subg[d0 * 32 + r32];
#pragma unroll
        for (int r = 0; r < 16; ++r) Ow[(size_t)crow(r, hi) * OBR_W + d0 * 32 + r32] = f2bf(o[d0][r] * ss[r] * g); }
}
__device__ __forceinline__ void unit_b(const bf16_t* PROJ, bf16_t* OBR, int b, int qh, int qb, char* lds, int wv) {
    const bf16_t* kv = PROJ + (size_t)b * SEQ * D_IN; const size_t qrow = (size_t)b * SEQ + qb * 256;
    f32x16 o[2]; float rli[16];
    attn_pass<64, 64, D_IN, D_IN, D_IN>(PROJ + qrow * D_IN + C_BQ + qh * 64, kv + C_BK + (qh >> 2) * 64, kv + C_BV + (qh >> 2) * 64, SEQ, lds, o, rli, wv);
    store_o<64, OBR_W>(OBR + qrow * OBR_W + 512 + qh * 64, o, rli, wv);
}
__device__ __forceinline__ void unit_c(const bf16_t* PROJ, const bf16_t* MEMKV, bf16_t* OBR, int b, int h, int qb, char* lds, int wv) {
    const bf16_t* kv = MEMKV + (size_t)b * MEM_LEN * 1024; const size_t qrow = (size_t)b * SEQ + qb * 256;
    f32x16 o[4]; float rli[16];
    attn_pass<128, 128, D_IN, 1024, 1024>(PROJ + qrow * D_IN + C_CQ + h * 128, kv + h * 128, kv + 512 + h * 128, MEM_LEN, lds, o, rli, wv);
    store_o<128, OBR_W>(OBR + qrow * OBR_W + 1024 + h * 128, o, rli, wv);
}
#undef ATT_SBAR
}

template <int NR>
__device__ __forceinline__ void rows_rmsnorm(const float* __restrict__ xbase, const float* __restrict__ g, bf16_t* __restrict__ obase, int row0, int lane) {
    f32x4 v[NR][4];
#pragma unroll
    for (int r = 0; r < NR; ++r)
#pragma unroll
        for (int j = 0; j < 4; ++j) v[r][j] = ((const f32x4*)(xbase + (size_t)(row0 + r) * DM))[lane + 64 * j];
    f32x4 gg[4];
#pragma unroll
    for (int j = 0; j < 4; ++j) gg[j] = ((const f32x4*)g)[lane + 64 * j];
#pragma unroll
    for (int r = 0; r < NR; ++r) { float s = 0.f;
#pragma unroll
        for (int j = 0; j < 4; ++j) s += v[r][j].x * v[r][j].x + v[r][j].y * v[r][j].y + v[r][j].z * v[r][j].z + v[r][j].w * v[r][j].w;
        const float rs = rsqrtf(wave_sum(s) * (1.f / DM) + EPS);
#pragma unroll
        for (int j = 0; j < 4; ++j) { u32x2 o; o.x = cvt_pk_bf16(v[r][j].x * rs * gg[j].x, v[r][j].y * rs * gg[j].y); o.y = cvt_pk_bf16(v[r][j].z * rs * gg[j].z, v[r][j].w * rs * gg[j].w);
            ((u32x2*)(obase + (size_t)(row0 + r) * DM))[lane + 64 * j] = o; } }
}
__device__ __forceinline__ void route_block(const bf16_t* __restrict__ X, const bf16_t* __restrict__ rt_tab, const float* __restrict__ brg, const float* __restrict__ bre, int* __restrict__ experts, float* __restrict__ weights,
                                            int* __restrict__ rank, unsigned* __restrict__ cnt, float* __restrict__ rstd, int* __restrict__ list, const float* __restrict__ g2, bf16_t* __restrict__ H2, int rb, const bf16x8 (&Bh)[3][4], const bf16x8 (&Bl)[3][4], LAS float* slab, int tid, int wave) {
    const int lane = tid & 63, r = lane & 15, kq = lane >> 4;
    LAS float* ssq = slab + 8 * 64 * 48; LAS float* rs_l = ssq + 8 * 64;
#pragma unroll 1
    for (int rtp = 0; rtp < 2; ++rtp) {
        bf16x8 xa[2][4];
#pragma unroll
        for (int q = 0; q < 2; ++q) { const bf16_t* xp = X + (size_t)(rb * 64 + (rtp * 2 + q) * 16 + r) * XP + 128 * wave + 8 * kq;
#pragma unroll
            for (int sI = 0; sI < 4; ++sI) xa[q][sI] = *(const bf16x8*)(xp + 32 * sI); }
#pragma unroll
        for (int q = 0; q < 2; ++q) { const int rt = rtp * 2 + q;
            f32x4 acc[3]; float ss = 0.f;
#pragma unroll
            for (int t = 0; t < 3; ++t) acc[t] = (f32x4){0.f, 0.f, 0.f, 0.f};
#pragma unroll
            for (int sI = 0; sI < 4; ++sI) {
                const bf16x8 Ah = xa[q][sI]; f32x4 a0, a1; pg8::unpack8(__builtin_bit_cast(u32x4, Ah), a0, a1);
                ss += (a0[0] * a0[0] + a0[1] * a0[1]) + (a0[2] * a0[2] + a0[3] * a0[3]) + (a1[0] * a1[0] + a1[1] * a1[1]) + (a1[2] * a1[2] + a1[3] * a1[3]);
#pragma unroll
                for (int t = 0; t < 3; ++t) {
                    acc[t] = __builtin_amdgcn_mfma_f32_16x16x32_bf16(Ah, Bh[t][sI], acc[t], 0, 0, 0);
                    acc[t] = __builtin_amdgcn_mfma_f32_16x16x32_bf16(Ah, Bl[t][sI], acc[t], 0, 0, 0);
                }
            }
            ss += __shfl_xor(ss, 16); ss += __shfl_xor(ss, 32);
            if (kq == 0) ssq[wave * 64 + rt * 16 + r] = ss;
#pragma unroll
            for (int t = 0; t < 3; ++t)
#pragma unroll
                for (int e = 0; e < 4; ++e) slab[(wave * 64 + rt * 16 + 4 * kq + e) * 48 + 16 * t + r] = acc[t][e];
        }
    }
    __syncthreads();
    if (tid < 64) {
        const int row = rb * 64 + tid;
        float lg[36]; float ss = 0.f;
#pragma unroll
        for (int c = 0; c < 36; ++c) lg[c] = 0.f;
#pragma unroll 1
        for (int w = 0; w < 8; ++w) { ss += ssq[w * 64 + tid];
#pragma unroll
            for (int c = 0; c < 36; ++c) lg[c] += slab[(w * 64 + tid) * 48 + c]; }
        const float rs = rsqrtf(ss * (1.f / DM) + EPS);
        rstd[row] = rs;
        int gi = 0; float gm = lg[0] * rs + brg[0];
#pragma unroll
        for (int i = 1; i < 4; ++i) { const float l = lg[i] * rs + brg[i]; if (l > gm) { gm = l; gi = i; } }
        float gs = 0.f;
#pragma unroll
        for (int i = 0; i < 4; ++i) gs += __expf(lg[i] * rs + brg[i] - gm);
        const float gp = 1.f / gs;
        float el[8];
#pragma unroll
        for (int i = 0; i < 8; ++i) el[i] = 0.f;
#pragma unroll
        for (int gq = 0; gq < 4; ++gq) if (gq == gi) {
#pragma unroll
            for (int i = 0; i < 8; ++i) el[i] = lg[4 + gq * 8 + i] * rs + bre[gq * 8 + i]; }
        int i0 = 0; float l0 = el[0];
#pragma unroll
        for (int i = 1; i < 8; ++i) if (el[i] > l0) { l0 = el[i]; i0 = i; }
        int i1 = -1; float l1 = -INFINITY;
#pragma unroll
        for (int i = 0; i < 8; ++i) if (i != i0 && el[i] > l1) { l1 = el[i]; i1 = i; }
        const float p1 = __expf(l1 - l0), inv = 1.f / (1.f + p1);
        const int e0 = gi * 8 + i0, e1 = gi * 8 + i1;
        experts[row * 2] = e0; experts[row * 2 + 1] = e1;
        weights[row * 2] = gp * inv; weights[row * 2 + 1] = gp * p1 * inv;
        LAS unsigned* lc = (LAS unsigned*)(rs_l + 64); LAS unsigned* gb = lc + 32;
        if (tid < 32) lc[tid] = 0u;
        asm volatile("s_waitcnt lgkmcnt(0)" ::: "memory");
        unsigned q0, q1; const unsigned one = 1u, a0_ = (unsigned)(uintptr_t)(lc + e0), a1_ = (unsigned)(uintptr_t)(lc + e1);
        asm volatile("ds_add_rtn_u32 %0, %1, %2\n\ts_waitcnt lgkmcnt(0)" : "=v"(q0) : "v"(a0_), "v"(one) : "memory");
        asm volatile("ds_add_rtn_u32 %0, %1, %2\n\ts_waitcnt lgkmcnt(0)" : "=v"(q1) : "v"(a1_), "v"(one) : "memory");
        if (tid < 32) { const unsigned n = lc[tid]; gb[tid] = n ? atomicAdd(cnt + 64 * tid, n) : 0u; }
        const int r0 = (int)(gb[e0] + q0), r1 = (int)(gb[e1] + q1);
        rank[row * 2] = r0; rank[row * 2 + 1] = r1;
        list[e0 * LCAP + r0] = row * 2; list[e1 * LCAP + r1] = row * 2 + 1;
        rs_l[tid] = rs;
    }
    __syncthreads();
#pragma unroll 1
    for (int rr = 0; rr < 8; rr += 4) {
        u32x2 v[4][4];
#pragma unroll
        for (int r4 = 0; r4 < 4; ++r4)
#pragma unroll
            for (int j = 0; j < 4; ++j) v[r4][j] = ((const u32x2*)(X + (size_t)(rb * 64 + wave * 8 + rr + r4) * XP))[lane + 64 * j];
#pragma unroll
        for (int r4 = 0; r4 < 4; ++r4) { const float rs = rs_l[wave * 8 + rr + r4]; u32x2* dst = (u32x2*)(H2 + (size_t)(rb * 64 + wave * 8 + rr + r4) * DM);
#pragma unroll
            for (int j = 0; j < 4; ++j) { const f32x4 gg = ((const f32x4*)g2)[lane + 64 * j]; const u32x2 w = v[r4][j];
                u32x2 o; o.x = cvt_pk_bf16(__uint_as_float(w.x << 16) * rs * gg.x, __uint_as_float(w.x & 0xffff0000u) * rs * gg.y); o.y = cvt_pk_bf16(__uint_as_float(w.y << 16) * rs * gg.z, __uint_as_float(w.y & 0xffff0000u) * rs * gg.w); dst[lane + 64 * j] = o; } }
    }
    __syncthreads();
}
__device__ __forceinline__ void moe_tables(const unsigned* cnt, volatile LAS int* mt, int tid) {
    if (tid == 0) { int off = 0, nt = 0;
#pragma unroll 1
        for (int e = 0; e < NEXP; ++e) { const int c = (int)__hip_atomic_load(cnt + 64 * e, __ATOMIC_RELAXED, __HIP_MEMORY_SCOPE_AGENT), t = (c + MOE_TILE - 1) / MOE_TILE;
            mt[e] = off; mt[32 + e] = c; mt[64 + e] = nt;
#pragma unroll 1
            for (int i = 0; i < t; ++i) mt[96 + nt + i] = e;
            nt += t; off += t * MOE_TILE; }
        mt[256] = nt; }
    __syncthreads();
}
__device__ __forceinline__ void moe_rowtabs(volatile LAS int* mt, const int* __restrict__ list, const float* __restrict__ weights, LAS unsigned* rowtab, LAS float* wtab, int bx, int G, int tid, int up) {
    const int ntiles = mt[256], rem = (ntiles * 4) % G;
#pragma unroll 1
    for (int i = 0; i < 4; ++i) { const long L = up ? (long)i * G + bx : (long)pg8::moe_down_unit(bx, i, rem, G); if (L >= (long)ntiles * 4) break;
        if (tid < 256) { const int tile = (int)(L >> 2), e = mt[96 + tile], q = (tile - mt[64 + e]) * 256 + tid; const bool valid = q < mt[32 + e];
            const int a = valid ? list[e * LCAP + q] : 0;
            if (up) rowtab[i * 256 + tid] = (unsigned)(a >> 1) * (unsigned)(DM * 2); else wtab[i * 256 + tid] = valid ? weights[a] : 0.f; } }
    __syncthreads();
}
template <int NR>
__device__ __forceinline__ void rows_combine_norm(bf16_t* __restrict__ XB, const bf16_t* __restrict__ YB, const float* __restrict__ g, bf16_t* __restrict__ H, float* __restrict__ OUT, const int (&row)[NR], int lane, bool poison, const int (&d0)[NR], const int (&d1)[NR]) {
    u32x2 xq[NR][4], ya[NR][4], yb[NR][4];
#pragma unroll
    for (int r = 0; r < NR; ++r)
#pragma unroll
        for (int j = 0; j < 4; ++j) { xq[r][j] = ((const u32x2*)(XB + (size_t)row[r] * XP))[lane + 64 * j];
            ya[r][j] = ((const u32x2*)(YB + (size_t)d0[r] * DM))[lane + 64 * j]; yb[r][j] = ((const u32x2*)(YB + (size_t)d1[r] * DM))[lane + 64 * j]; }
    f32x4 gg[4];
#pragma unroll
    for (int j = 0; j < 4; ++j) gg[j] = ((const f32x4*)g)[lane + 64 * j];
    f32x4 v[NR][4]; float s[NR];
#pragma unroll
    for (int r = 0; r < NR; ++r) { s[r] = 0.f;
#pragma unroll
        for (int j = 0; j < 4; ++j) { const u32x2 x = xq[r][j], a = ya[r][j], b = yb[r][j];
            v[r][j].x = __uint_as_float(x.x << 16) + __uint_as_float(a.x << 16) + __uint_as_float(b.x << 16); v[r][j].y = __uint_as_float(x.x & 0xffff0000u) + __uint_as_float(a.x & 0xffff0000u) + __uint_as_float(b.x & 0xffff0000u);
            v[r][j].z = __uint_as_float(x.y << 16) + __uint_as_float(a.y << 16) + __uint_as_float(b.y << 16); v[r][j].w = __uint_as_float(x.y & 0xffff0000u) + __uint_as_float(a.y & 0xffff0000u) + __uint_as_float(b.y & 0xffff0000u);
            s[r] += v[r][j].x * v[r][j].x + v[r][j].y * v[r][j].y + v[r][j].z * v[r][j].z + v[r][j].w * v[r][j].w; } }
#pragma unroll
    for (int r = 0; r < NR; ++r) {
        float rs = rsqrtf(wave_sum(s[r]) * (1.f / DM) + EPS);
        if (poison) rs = __builtin_nanf("");
#pragma unroll
        for (int j = 0; j < 4; ++j) {
            if (H) { u32x2 xo; xo.x = cvt_pk_bf16(v[r][j].x, v[r][j].y); xo.y = cvt_pk_bf16(v[r][j].z, v[r][j].w); ((u32x2*)(XB + (size_t)row[r] * XP))[lane + 64 * j] = xo;
                u32x2 o; o.x = cvt_pk_bf16(v[r][j].x * rs * gg[j].x, v[r][j].y * rs * gg[j].y); o.y = cvt_pk_bf16(v[r][j].z * rs * gg[j].z, v[r][j].w * rs * gg[j].w);
                ((u32x2*)(H + (size_t)row[r] * DM))[lane + 64 * j] = o; }
            else { f32x4 o; o.x = v[r][j].x * rs * gg[j].x; o.y = v[r][j].y * rs * gg[j].y; o.z = v[r][j].z * rs * gg[j].z; o.w = v[r][j].w * rs * gg[j].w; ((f32x4*)(OUT + (size_t)row[r] * DM))[lane + 64 * j] = o; }
        }
    }
}
struct TrItem { const float* src; bf16_t* dst; int ldw, K; };
template <int OFF> __device__ __forceinline__ unsigned long long karg64() { unsigned long long v; asm volatile("s_load_dwordx2 %0, %1, %2\n\ts_waitcnt lgkmcnt(0)" : "=s"(v) : "s"(__builtin_amdgcn_kernarg_segment_ptr()), "n"(OFF)); return v; }
__device__ __forceinline__ unsigned long long karg64d(int off) { unsigned long long v; asm volatile("s_load_dwordx2 %0, %1, %2\n\ts_waitcnt lgkmcnt(0)" : "=s"(v) : "s"(__builtin_amdgcn_kernarg_segment_ptr()), "s"(off)); return v; }
#define TR_IN(k) ((const float*)(const GAS float*)karg64d(8 * (k)))
__device__ __forceinline__ void tr_decode(int it, int lane, bf16_t* WB, const float*& sp, int& ldw, bf16_t*& dp, int& K) {
    const float* src; int segA, segB, kb, tb, dk0 = 0; bf16_t* dst;
    if (it < 28800) {
        const int l = it / 14400; int r = it % 14400; bf16_t* WBl = WB + (size_t)l * WB_LAYER;
        if (r < 1472) { kb = r / 92; tb = r % 92; const int pn = tb >> 2, bj = (tb >> 1) & 1, w0 = 2 * (tb & 1); src = TR_IN(5) + (size_t)l * DM * D_IN; ldw = D_IN; K = DM; segA = 256 * pn + 64 * w0 + 32 * bj; segB = segA + 64; dst = WBl + WB_IN; }
        else if (r < 1856) { r -= 1472; const int i = r >> 7; r &= 127; kb = r >> 4; tb = r & 15; src = TR_IN(13 + i) + (size_t)l * 512 * DM; ldw = DM; K = 512; segA = 64 * tb; segB = segA + 32; dst = WBl + WB_UP + (size_t)i * 1024 * 512; }
        else if (r < 2112) { r -= 1856; kb = r >> 4; tb = r & 15; src = TR_IN(16) + (size_t)l * DM * DM; ldw = DM; K = DM; segA = 64 * tb; segB = segA + 32; dst = WBl + WB_OUT; }
        else if (r < 10304) { r -= 2112; const int e = r >> 8; r &= 255; kb = r >> 4; tb = r & 15; const int pn = tb >> 2, sg = (tb >> 1) & 1, jb = tb & 1;
            src = TR_IN(sg ? 23 : 22) + (size_t)(l * NEXP + e) * DM * DEXP; ldw = DEXP; K = DM; segA = 128 * pn + 64 * jb; segB = segA + 32; dst = WBl + WB_GU + (size_t)e * 1024 * 1024; }
        else { r -= 10304; const int e = r >> 7; r &= 127; kb = r >> 4; tb = r & 15; src = TR_IN(24) + (size_t)(l * NEXP + e) * DEXP * DM; ldw = DM; K = DEXP; segA = 64 * tb; segB = segA + 32; dst = WBl + WB_DN + (size_t)e * 1024 * 512; }
    } else { const int r = it - 28800; kb = r >> 4; tb = r & 15; const int pn = tb >> 2, bj = (tb >> 1) & 1, w0 = 2 * (tb & 1); src = TR_IN(3); ldw = 1024; K = DM; segA = 256 * pn + 64 * w0 + 32 * bj; segB = segA + 64; dst = WB + WB_MEMKV; }
    const int q = lane & 15;
    sp = src + (size_t)(kb * 64 + (lane >> 4)) * ldw + (q < 8 ? segA + 4 * q : segB + 4 * (q - 8));
    dp = dst + (size_t)(64 * tb + (lane >> 3)) * K + dk0 + kb * 64 + 8 * (lane & 7);
}
__device__ __forceinline__ void tr_load(f32x4 (&v)[16], const float* sp, int ldw) {
#pragma unroll
    for (int i = 0; i < 16; ++i) v[i] = *(const f32x4*)(sp + (size_t)(4 * i) * ldw);
}
__device__ __forceinline__ void tr_store(const f32x4 (&v)[16], bf16_t* dp, int K, LAS float* scr, int lane) {
    const int q = lane & 15, kq = lane >> 4;
#pragma unroll
    for (int i = 0; i < 16; ++i) { LAS float* w = scr + (4 * i + kq) * 65 + 4 * q; w[0] = v[i][0]; w[1] = v[i][1]; w[2] = v[i][2]; w[3] = v[i][3]; }
    asm volatile("s_waitcnt lgkmcnt(0)" ::: "memory");
    const int c = lane & 7, n8 = lane >> 3;
#pragma unroll
    for (int j = 0; j < 8; ++j) { const LAS float* sI = scr + (8 * c) * 65 + n8 + 8 * j;
        u32x4 o; o.x = cvt_pk_bf16(sI[0 * 65], sI[1 * 65]); o.y = cvt_pk_bf16(sI[2 * 65], sI[3 * 65]); o.z = cvt_pk_bf16(sI[4 * 65], sI[5 * 65]); o.w = cvt_pk_bf16(sI[6 * 65], sI[7 * 65]);
        *(u32x4*)(dp + (size_t)(8 * j) * K) = o; }
    asm volatile("s_waitcnt lgkmcnt(0)" ::: "memory");
}

#define XB_TMO      128
#define XB_XCNT(j)  (256  + 64 * (j))
#define XB_XSUB(j)  (1280 + 64 * (j))
#define XB_XGEN(j)  (2304 + 64 * (j))
#define XB_TOP      3328
#define XB_TOPGEN   3392
#define XCD_BAR_WORDS 3456
#define XB_SPIN_CAP (1u << 18)

__device__ __forceinline__ unsigned xb_ld(unsigned* p)              { return __hip_atomic_load(p, __ATOMIC_RELAXED, __HIP_MEMORY_SCOPE_AGENT); }
__device__ __forceinline__ unsigned xb_add(unsigned* p, unsigned v) { return __hip_atomic_fetch_add(p, v, __ATOMIC_RELAXED, __HIP_MEMORY_SCOPE_AGENT); }
__device__ __forceinline__ unsigned xb_xcc_id() { return (unsigned)__builtin_amdgcn_s_getreg((3 << 11) | 20) & 0xFu; }
#define XB_SPIN(cond, bar) do { unsigned _sp = 0; while (cond) { __builtin_amdgcn_s_sleep(1); \
    if ((++_sp & 255u) == 0u) { if (xb_ld(&(bar)[XB_TMO])) break; if (_sp > XB_SPIN_CAP) { atomicAdd(&(bar)[XB_TMO], 1u); break; } } } } while (0)

struct XcdBarrier {
    unsigned* bar; unsigned x; unsigned w0;
    volatile LAS unsigned* st;
};

__device__ __forceinline__ XcdBarrier xcd_barrier_post(unsigned* bar, volatile LAS unsigned* st, unsigned is_wave0) {
    XcdBarrier b; b.bar = bar; b.x = xb_xcc_id(); b.st = st; b.w0 = is_wave0;
    if (is_wave0 && lane_id() == 0) (void)xb_add(&bar[XB_XCNT(b.x)], 1u);
    return b;
}
__device__ __forceinline__ void xcd_barrier_complete(unsigned* bar, unsigned x, unsigned& nloc, unsigned& nx) {
    const unsigned G = gridDim.x * gridDim.y * gridDim.z;
    unsigned sum, cnt, mine, sp = 0u;
    for (;;) {
        sum = 0u; cnt = 0u; mine = 0u;
#pragma unroll
        for (unsigned j = 0; j < 16; ++j) { const unsigned c = xb_ld(&bar[XB_XCNT(j)]); sum += c; cnt += (c > 0u) ? 1u : 0u; mine = (j == x) ? c : mine; }
        if (sum == G) break;
        __builtin_amdgcn_s_sleep(1);
        if ((++sp & 255u) == 0u) { if (xb_ld(&bar[XB_TMO])) break; if (sp > XB_SPIN_CAP) { atomicAdd(&bar[XB_TMO], 1u); break; } }
    }
    nloc = mine > 0u ? mine : 1u; nx = cnt > 0u ? cnt : 1u;
}

__device__ __forceinline__ void xcd_barrier(const XcdBarrier& b) {
    asm volatile("s_waitcnt vmcnt(0)" ::: "memory");
    __syncthreads();
    if (b.w0 && lane_id() == 0) {
        unsigned* bar = b.bar;
        __builtin_amdgcn_s_waitcnt(0);
        unsigned nloc = b.st[0], nx = b.st[1];
        if (nloc == 0u) { xcd_barrier_complete(bar, b.x, nloc, nx); b.st[0] = nloc; b.st[1] = nx; }
        const unsigned old = xb_add(&bar[XB_XSUB(b.x)], 1u);
        const unsigned gen = old / nloc;
        if (old + 1u == (gen + 1u) * nloc) {
            __builtin_amdgcn_fence(__ATOMIC_RELEASE, "agent");
            asm volatile("s_waitcnt vmcnt(0)" ::: "memory");
            const unsigned og = xb_add(&bar[XB_TOP], 1u);
            const unsigned tg = og / nx;
            if (og + 1u == (tg + 1u) * nx) xb_add(&bar[XB_TOPGEN], 1u);
            else XB_SPIN(xb_ld(&bar[XB_TOPGEN]) == tg, bar);
            __builtin_amdgcn_fence(__ATOMIC_ACQUIRE, "agent");
            xb_add(&bar[XB_XGEN(b.x)], 1u);
            asm volatile("s_waitcnt vmcnt(0)" ::: "memory");
        } else {
            XB_SPIN(xb_ld(&bar[XB_XGEN(b.x)]) == gen, bar);
            __builtin_amdgcn_fence(__ATOMIC_ACQUIRE, "agent");
            asm volatile("s_waitcnt vmcnt(0)" ::: "memory");
        }
    }
    __syncthreads();
}
constexpr int NWAVES = 8;
constexpr int RING_BYTES = 131072, LDSCTL_OFF = 135168, LDS_BYTES = 147456;
constexpr int CW_BAR = 4096, BAR_REGION = 4096;
static_assert(XCD_BAR_WORDS <= BAR_REGION && (CW_BAR + (N_PHASES + 1) * BAR_REGION) * 4 <= (int)MiB, "barrier regions inside the memset region");
static_assert(pg8::STAGE_BYTES <= RING_BYTES && att::Lay<64, 128>::OFF_STASH + 65536 <= RING_BYTES && att::Lay<128, 128>::OFF_WS + 2048 <= RING_BYTES, "LDS map");

struct Args { const float* in[26]; float* out; unsigned char* ws; int ph_lo, ph_hi, li, pad; };
#define KIN(k) ((const float*)(const GAS float*)karg64<8 * (k)>())
#define KOUT ((float*)(GAS float*)karg64<208>())
#define KWS ((unsigned char*)(GAS unsigned char*)karg64<216>())
static_assert(offsetof(Args, out) == 208 && offsetof(Args, ws) == 216 && offsetof(Args, ph_lo) == 224, "Args layout vs the kernarg offsets above");

__global__ void __launch_bounds__(NWAVES * 64, 2) mk_fwd(Args args) {
    extern __shared__ __attribute__((aligned(16))) unsigned char lds[];
    const int wave = __builtin_amdgcn_readfirstlane((int)threadIdx.x >> 6);
#define lane0 lane_id()
#define tid0 (wave * 64 + lane_id())
    const int G = gridDim.x, bx = blockIdx.x, vcu = (G % 8 == 0) ? (bx % 8) * (G / 8) + bx / 8 : bx;
    LAS unsigned char* ldsl = (LAS unsigned char*)lds;
    volatile LAS unsigned* MISC = (volatile LAS unsigned*)(ldsl + LDSCTL_OFF);
    for (int u = tid0; u < (LDS_BYTES - LDSCTL_OFF) / 4; u += NWAVES * 64) ((LAS unsigned*)(ldsl + LDSCTL_OFF))[u] = 0u;
    __syncthreads();
    XcdBarrier bar = xcd_barrier_post((unsigned*)(KWS + WS_CTL) + CW_BAR + args.li * BAR_REGION, MISC + 8, wave == 0 ? 1u : 0u);
#define P_WS unsigned char* ws = KWS; unsigned* ctl = (unsigned*)(ws + WS_CTL); (void)ctl
#define P_ACT bf16_t* MEMKV = (bf16_t*)(ws + WS_MEMKV); bf16_t* HM = (bf16_t*)(ws + WS_HM); bf16_t* PROJ = (bf16_t*)(ws + WS_PROJ); bf16_t* OBR = (bf16_t*)(ws + WS_OBR); bf16_t* HMEM = OBR; \
    bf16_t* BUF = (bf16_t*)(ws + WS_BUF); bf16_t* YB = (bf16_t*)(ws + WS_YB); bf16_t* HID = (bf16_t*)(ws + WS_HID); bf16_t* WB = (bf16_t*)(ws + WS_WB); const bf16_t* WBl = WB + (size_t)l_ * WB_LAYER; \
    (void)MEMKV; (void)HM; (void)PROJ; (void)OBR; (void)HMEM; (void)BUF; (void)YB; (void)HID; (void)WBl
#define P_ROUTE int* experts = (int*)(ws + WS_ROUTE + RT_EXP); float* weights = (float*)(ws + WS_ROUTE + RT_WGT); int* rank = (int*)(ws + WS_ROUTE + RT_RANK); float* rstd = (float*)(ws + WS_ROUTE + RT_RSTD); \
    (void)experts; (void)weights; (void)rank; (void)rstd
    const int gw = bx * NWAVES + wave, NGW = G * NWAVES;
    const int lo = args.ph_lo, hi = args.ph_hi;
#ifndef STAGE_MASK
#define STAGE_MASK 0x3FFu
#endif
#define IN(k) (lo <= (k) && (k) < hi)
#define ST(s) ((STAGE_MASK >> (s)) & 1u)
#ifndef REP_MASK
#define REP_MASK 0u
#endif
#define NREP(s) (((REP_MASK >> (s)) & 1u) ? 2 : 1)
#ifndef DBL_BAR
#define DBL_BAR 0
#endif
#define SEAM(k) do { if (IN(k) && IN((k) + 1)) { xcd_barrier(bar); if (DBL_BAR) xcd_barrier(bar); } } while (0)

    if (ST(0) && IN(0))
  for (int rep_ = 0; rep_ < NREP(0); ++rep_) {
        int lane = lane0, tid = tid0; asm volatile("" : "+v"(lane), "+v"(tid));
        constexpr int l_ = 0; P_WS; P_ACT;
        float* tab1 = (float*)(ws + WS_TAB); float* tab2 = tab1 + SEQ * 32 * 2;
        const float* x = KIN(0); const float* mem = KIN(1); const float* mem_g = KIN(2); const float* norm1_g = KIN(4); const float* norm2_g = KIN(17); const float* w_rg = KIN(18); const float* w_re = KIN(20);
        LAS float* scr = (LAS float*)(ldsl + wave * 16640);
        {   constexpr int NITEMS = 29056;
            f32x4 cur[16], nxt[16]; const float* sp; bf16_t* dp; int ldw, K; const float* sp2; bf16_t* dp2; int ldw2, K2;
            int it = gw;
            if (it < NITEMS) { tr_decode(it, lane, WB, sp, ldw, dp, K); tr_load(cur, sp, ldw); }
            for (; it < NITEMS; it += NGW) {
                const bool more = it + NGW < NITEMS;
                if (more) { tr_decode(it + NGW, lane, WB, sp2, ldw2, dp2, K2); tr_load(nxt, sp2, ldw2); }
                tr_store(cur, dp, K, scr, lane);
                if (more) {
#pragma unroll
                    for (int i = 0; i < 16; ++i) cur[i] = nxt[i];
                    dp = dp2; K = K2; }
            }
        }
        for (int idx = bx * (NWAVES * 64) + tid; idx < SEQ * 32; idx += G * NWAVES * 64) { const int pos = idx >> 5, i = idx & 31; float s, c;
            sincosf((float)pos * inv1d(i), &s, &c); tab1[idx * 2] = c; tab1[idx * 2 + 1] = s;
            sincosf(ang2d(pos, i), &s, &c); tab2[idx * 2] = c; tab2[idx * 2 + 1] = s; }
        for (int idx = bx * (NWAVES * 64) + tid; idx < DEPTH * 48 * 1024; idx += G * NWAVES * 64) { const int l = idx / (48 * 1024), c = (idx >> 10) % 48, k = idx & 1023;
            const float w = c < 4 ? w_rg[((size_t)l * DM + k) * 4 + c] : c < 36 ? w_re[((size_t)l * DM + k) * 32 + (c - 4)] : 0.f, v = w * norm2_g[l * DM + k];
            const bf16_t h = f2bf(v); bf16_t* t = WB + WB_RT + (size_t)l * 2 * 48 * 1024 + (size_t)c * 1024 + k; t[0] = h; t[48 * 1024] = f2bf(v - bf2f(h)); }
        for (int m = 4 * gw; m < M; m += 4 * NGW) rows_rmsnorm<4>(x, norm1_g, HM, m, lane);
        for (int m = gw; m < MM; m += NGW) rows_rmsnorm<1>(mem, mem_g, HMEM, m, lane);
    }
    SEAM(0);
#pragma unroll 1
    for (int l = 0; l < DEPTH; ++l) {
        const int pb = 1 + 9 * l, l_ = l;
        if (ST(1) && IN(pb + 0))
      for (int rep_ = 0; rep_ < NREP(1); ++rep_) {
            P_WS; P_ACT; float* tab1 = (float*)(ws + WS_TAB); float* tab2 = tab1 + SEQ * 32 * 2; const float* qn_g = KIN(11); const float* kn_g = KIN(12);
            pg8::Gemm g{DM, DM};
            pg8::SchedProj S{bx, G, 1472, l == 0 ? 1504 : 1472, (const char*)HM, (const char*)(WBl + WB_IN), (const char*)HMEM, (const char*)(WB + WB_MEMKV)};
            pg8::EpiProj E{PROJ, MEMKV, tab1, tab2, qn_g + l * 64, kn_g + l * 64};
            pg8::gemm_phase<pg8::EpiProj, pg8::SchedProj, true, true>(ldsl, g, S, E, wave);
        }
        SEAM(pb + 0);
        if (ST(2) && IN(pb + 1))
      for (int rep_ = 0; rep_ < NREP(2); ++rep_) {
            int lane = lane0; asm volatile("" : "+v"(lane));
            P_WS; P_ACT; const float* lq1 = KIN(6); const float* lk1 = KIN(7); const float* lq2 = KIN(8); const float* lk2 = KIN(9); const float* subln_g = KIN(10);
            const float lam_init = 0.8f - 0.6f * __expf(-0.3f * (float)l);
            const float lam = __expf(wave_sum(lq1[l * 64 + lane] * lk1[l * 64 + lane])) - __expf(wave_sum(lq2[l * 64 + lane] * lk2[l * 64 + lane])) + lam_init;
            for (int j = vcu; j < 256; j += G) {
#ifndef ATT_SKIP_A
                att::unit_a(PROJ, OBR, j >> 5, (j >> 3) & 3, j & 7, lam, lam_init, subln_g + l * 128, (char*)lds, wave);
#endif
#ifndef ATT_SKIP_B
#pragma unroll 1
                for (int t = 0; t < 2; ++t) { const int idx = 2 * j + t; att::unit_b(PROJ, OBR, idx >> 6, (idx >> 3) & 7, idx & 7, (char*)lds, wave); }
#endif
#ifndef ATT_SKIP_C
                att::unit_c(PROJ, MEMKV, OBR, j >> 5, (j >> 3) & 3, j & 7, (char*)lds, wave);
#endif
            }
            __syncthreads();
        }
        SEAM(pb + 1);
        if (ST(3) && IN(pb + 2))
      for (int rep_ = 0; rep_ < NREP(3); ++rep_) {
            P_WS; P_ACT;
            pg8::Gemm g{OBR_W, 512};
            pg8::SchedGate S{bx, G, (const char*)OBR, (const char*)(WBl + WB_UP)};
            pg8::EpiGate E{HM, PROJ};
            pg8::gemm_phase<pg8::EpiGate, pg8::SchedGate, true, true>(ldsl, g, S, E, wave);
        }
        SEAM(pb + 2);
        if (ST(4) && IN(pb + 3)) {
            P_WS; P_ACT; const float* x = KIN(0); bf16_t* XB = (bf16_t*)KOUT;
            pg8::Gemm g{DM, DM};
            pg8::SchedPlain S{bx, G, M / 256, (const char*)HM, (const char*)(WBl + WB_OUT), (size_t)256 * DM * 2, (size_t)256 * DM * 2};
            pg8::EpiResid E{x, XB, l == 0 ? 1 : 0};
            pg8::gemm_phase<pg8::EpiResid, pg8::SchedPlain, true, true>(ldsl, g, S, E, wave);
        }
        SEAM(pb + 3);
        if (ST(5) && IN(pb + 4)) {
            int tid = tid0; asm volatile("" : "+v"(tid));
            const int lane = tid & 63;
            P_WS; P_ACT; P_ROUTE; const bf16_t* X = (const bf16_t*)KOUT; const float* b_rg = KIN(19); const float* b_re = KIN(21); const float* norm2_g = KIN(17);
            const bf16_t* tab = WB + WB_RT + (size_t)l * 2 * 48 * 1024 + (size_t)(lane & 15) * 1024 + 128 * wave + 8 * (lane >> 4);
            bf16x8 Bh[3][4], Bl[3][4];
#pragma unroll
            for (int t = 0; t < 3; ++t)
#pragma unroll
                for (int sI = 0; sI < 4; ++sI) { Bh[t][sI] = *(const bf16x8*)(tab + (size_t)t * 16 * 1024 + 32 * sI); Bl[t][sI] = *(const bf16x8*)(tab + (size_t)(48 + t * 16) * 1024 + 32 * sI); }
            for (int rb = bx; rb < M / 64; rb += G)
                route_block(X, tab, b_rg + l * 4, b_re + l * 32, experts, weights, rank, ctl + CW_CNT + 2048 * l, rstd, (int*)BUF, norm2_g + l * DM, HM, rb, Bh, Bl, (LAS float*)ldsl, tid, wave);
        }
        SEAM(pb + 4);
        volatile LAS int* mt = (volatile LAS int*)(ldsl + LDSCTL_OFF + 256);
        LAS unsigned* rowtab = (LAS unsigned*)(ldsl + LDSCTL_OFF + 2048); LAS float* wtab = (LAS float*)(ldsl + LDSCTL_OFF + 6144);
        if (ST(7) && IN(pb + 6)) {
            int tid = tid0; asm volatile("" : "+v"(tid));
            P_WS; P_ACT; P_ROUTE;
            moe_tables(ctl + CW_CNT + 2048 * l, mt, tid);
            moe_rowtabs(mt, (const int*)BUF, weights, rowtab, wtab, vcu, G, tid, 1);
            const int ntiles = __builtin_amdgcn_readfirstlane(mt[256]);
            pg8::Gemm g{DM, DM};
            pg8::SchedMoeUp S{vcu, G, ntiles, (const LAS int*)(ldsl + LDSCTL_OFF + 256 + 96 * 4), (const char*)HM, (const char*)(WBl + WB_GU), ctl + CW_TCNT + l * 160 * 64};
            pg8::EpiSilu E{HID};
            pg8::gemm_phase<pg8::EpiSilu, pg8::SchedMoeUp, true, true, true>(ldsl, g, S, E, wave, rowtab);
        }
        if (ST(8) && IN(pb + 7)) {
            int tid = tid0; asm volatile("" : "+v"(tid));
            P_WS; P_ACT; P_ROUTE;
            if (!(ST(7) && IN(pb + 6))) moe_tables(ctl + CW_CNT + 2048 * l, mt, tid);
            moe_rowtabs(mt, (const int*)BUF, weights, rowtab, wtab, vcu, G, tid, 0);
            const int ntiles = __builtin_amdgcn_readfirstlane(mt[256]);
            pg8::Gemm g{DEXP, DEXP};
            pg8::SchedMoeDown S{vcu, G, ntiles, (ntiles * 4) % G, wave, (const LAS int*)(ldsl + LDSCTL_OFF + 256 + 96 * 4), (const char*)HID, (const char*)(WBl + WB_DN), ctl + CW_TCNT + l * 160 * 64, ctl + CW_TMO};
            pg8::EpiRowScale E{YB, wtab};
            pg8::gemm_phase<pg8::EpiRowScale, pg8::SchedMoeDown, true, true>(ldsl, g, S, E, wave);
        }
        SEAM(pb + 7);
        if (ST(9) && IN(pb + 8)) {
            int lane = lane0; asm volatile("" : "+v"(lane));
            P_WS; P_ACT; P_ROUTE; float* OUTP = KOUT; bf16_t* XB = (bf16_t*)OUTP; const float* norm1_g = KIN(4); const float* final_g = KIN(25);
            const bool last = (l == DEPTH - 1);
            const bool poison = last && ((__hip_atomic_load(ctl + CW_BAR + args.li * BAR_REGION + XB_TMO, __ATOMIC_RELAXED, __HIP_MEMORY_SCOPE_AGENT) | __hip_atomic_load(ctl + CW_TMO, __ATOMIC_RELAXED, __HIP_MEMORY_SCOPE_AGENT)) != 0u);
            if (!(ST(7) && IN(pb + 6)) && !(ST(8) && IN(pb + 7))) moe_tables(ctl + CW_CNT + 2048 * l, mt, tid0);
            static_assert(M % 4 == 0, "rows come in fours");
            for (int m = 4 * gw; m < M; m += 4 * NGW) {
                const u32x4 ex0 = *(const u32x4*)(experts + 2 * m), ex1 = *(const u32x4*)(experts + 2 * m + 4), rk0 = *(const u32x4*)(rank + 2 * m), rk1 = *(const u32x4*)(rank + 2 * m + 4);
                const int rows[4] = {m, m + 1, m + 2, m + 3};
                const int d0[4] = {mt[ex0.x] + (int)rk0.x, mt[ex0.z] + (int)rk0.z, mt[ex1.x] + (int)rk1.x, mt[ex1.z] + (int)rk1.z}, d1[4] = {mt[ex0.y] + (int)rk0.y, mt[ex0.w] + (int)rk0.w, mt[ex1.y] + (int)rk1.y, mt[ex1.w] + (int)rk1.w};
                rows_combine_norm<4>(XB, YB, last ? final_g : norm1_g + (l + 1) * DM, last ? nullptr : HM, OUTP, rows, lane, poison, d0, d1); }
        }
        SEAM(pb + 8);
    }
#undef IN
#undef SEAM
#undef lane0
#undef tid0
#undef P_WS
#undef P_ACT
#undef P_ROUTE
}

#ifndef FAST_MASK
#define FAST_MASK 0x7FFFFu
#endif
extern "C" void kernel_launch(void* const* d_in, const int* in_sizes, int n_in, void* d_out, int out_size, void* d_ws, size_t ws_size, hipStream_t stream) {
    if (n_in != 26 || out_size != M * DM || ws_size < WS_END) { fprintf(stderr, "kernel_launch: unexpected shapes n_in %d out %d ws %zu (need %zu)\n", n_in, out_size, ws_size, (size_t)WS_END); return; }
    static int grid = 0;
    if (grid == 0) {
        int dev = 0, cus = 0;
        if (hipGetDevice(&dev) != hipSuccess || hipDeviceGetAttribute(&cus, hipDeviceAttributeMultiprocessorCount, dev) != hipSuccess) { grid = -1; return; }
        if (hipFuncSetAttribute((const void*)mk_fwd, hipFuncAttributeMaxDynamicSharedMemorySize, LDS_BYTES) != hipSuccess) { fprintf(stderr, "kernel_launch: hipFuncSetAttribute failed\n"); grid = -1; return; }
        int per_cu = 0;
        if (hipOccupancyMaxActiveBlocksPerMultiprocessor(&per_cu, (const void*)mk_fwd, NWAVES * 64, LDS_BYTES) != hipSuccess || per_cu < 1) fprintf(stderr, "kernel_launch: occupancy query says %d\n", per_cu);
        (void)hipGetLastError();
        grid = cus;
    }
    if (grid < 0) return;
    const float* x = (const float*)d_in[0]; const float* mem = (const float*)d_in[1]; const float* mem_g = (const float*)d_in[2]; const float* w_memkv = (const float*)d_in[3];
    const float* norm1_g = (const float*)d_in[4]; const float* w_in = (const float*)d_in[5];
    const float* lq1 = (const float*)d_in[6]; const float* lk1 = (const float*)d_in[7]; const float* lq2 = (const float*)d_in[8]; const float* lk2 = (const float*)d_in[9];
    const float* subln_g = (const float*)d_in[10]; const float* qn_g = (const float*)d_in[11]; const float* kn_g = (const float*)d_in[12];
    const float* w_up[3] = {(const float*)d_in[13], (const float*)d_in[14], (const float*)d_in[15]}; const float* w_out = (const float*)d_in[16];
    const float* norm2_g = (const float*)d_in[17]; const float* w_rg = (const float*)d_in[18]; const float* b_rg = (const float*)d_in[19]; const float* w_re = (const float*)d_in[20]; const float* b_re = (const float*)d_in[21];
    const float* w_eg = (const float*)d_in[22]; const float* w_eu = (const float*)d_in[23]; const float* w_ed = (const float*)d_in[24]; const float* final_g = (const float*)d_in[25];
    unsigned char* ws = (unsigned char*)d_ws; float* X = (float*)d_out;
    unsigned* ctl = (unsigned*)(ws + WS_CTL);
    bf16_t* MEMKV = (bf16_t*)(ws + WS_MEMKV); bf16_t* HM = (bf16_t*)(ws + WS_HM); bf16_t* PROJ = (bf16_t*)(ws + WS_PROJ); bf16_t* OBR = (bf16_t*)(ws + WS_OBR);
    bf16_t* BUF = (bf16_t*)(ws + WS_BUF); bf16_t* YB = (bf16_t*)(ws + WS_YB); bf16_t* HID = (bf16_t*)(ws + WS_HID);
    int* experts = (int*)(ws + WS_ROUTE + RT_EXP); float* weights = (float*)(ws + WS_ROUTE + RT_WGT); int* rank = (int*)(ws + WS_ROUTE + RT_RANK); int* dest = (int*)(ws + WS_ROUTE + RT_DEST);
    float* roww = (float*)(ws + WS_ROUTE + RT_ROWW); int* tile_tab = (int*)(ws + WS_ROUTE + RT_TILE); float* rstd = (float*)(ws + WS_ROUTE + RT_RSTD);

    (void)hipMemsetAsync(ctl, 0, MiB, stream);
    unsigned mask = FAST_MASK; if (mask) mask |= 1u;
    Args a{};
    for (int i = 0; i < 26; ++i) a.in[i] = (const float*)d_in[i];
    a.out = X; a.ws = ws;
    int li = 0;
    for (int k = 0; k < N_PHASES;) {
        if ((mask >> k) & 1u) {
            int k2 = k; while (k2 < N_PHASES && ((mask >> k2) & 1u)) ++k2;
            a.ph_lo = k; a.ph_hi = k2; a.li = li++; a.pad = 0;
            hipLaunchKernelGGL(mk_fwd, dim3(grid), dim3(NWAVES * 64), LDS_BYTES, stream, a);
            k = k2; continue;
        }
        if (k == 0) {
            (void)hipMemcpyAsync(X, x, (size_t)M * DM * 4, hipMemcpyDeviceToDevice, stream);
            s_rmsnorm<<<MM / 4, 256, 0, stream>>>(mem, mem_g, OBR, MM);
            s_rmsnorm<<<M / 4, 256, 0, stream>>>(X, norm1_g, HM, M);
        } else {
            const int l = (k - 1) / 9, s = (k - 1) % 9; const float lam_init = 0.8f - 0.6f * expf(-0.3f * (float)l);
            switch (s) {
            case 0:
                if (l == 0) { SG p{}; p.A = OBR; p.lda = DM; p.W = w_memkv; p.ldw = 1024; p.K = DM; p.mode = MD_BF16; p.O = MEMKV; p.ldo = 1024; s_gemm<<<dim3(1024 / 64, MM / 64), 256, 0, stream>>>(p); }
                { SG p{}; p.A = HM; p.lda = DM; p.W = w_in + (size_t)l * DM * D_IN; p.ldw = D_IN; p.K = DM; p.mode = MD_PROJ; p.O = PROJ; p.ldo = D_IN; p.qg = qn_g + l * 64; p.kg = kn_g + l * 64;
                  s_gemm<<<dim3(D_IN / 64, M / 64), 256, 0, stream>>>(p); }
                break;
            case 1:
                s_attn_a<<<dim3(M / 4, 4), 256, 0, stream>>>(PROJ, OBR, lq1 + l * 64, lk1 + l * 64, lq2 + l * 64, lk2 + l * 64, subln_g + l * 128, lam_init);
                s_attn_b<<<dim3(M / 4, 8), 256, 0, stream>>>(PROJ, OBR);
                s_attn_c<<<dim3(M / 4, 4), 256, 0, stream>>>(PROJ, MEMKV, OBR);
                break;
            case 2:
                for (int i = 0; i < 3; ++i) { SG p{}; p.A = OBR + 512 * i; p.lda = OBR_W; p.W = w_up[i] + (size_t)l * 512 * DM; p.ldw = DM; p.K = 512; p.mode = MD_GATE; p.O = HM; p.ldo = DM; p.G = PROJ + C_G + 1024 * i; p.ldg = D_IN; p.first = (i == 0);
                    s_gemm<<<dim3(DM / 64, M / 64), 256, 0, stream>>>(p); }
                break;
            case 3:
                if (l == 0 && (mask & 1u)) (void)hipMemcpyAsync(X, x, (size_t)M * DM * 4, hipMemcpyDeviceToDevice, stream);
                { SG p{}; p.A = HM; p.lda = DM; p.W = w_out + (size_t)l * DM * DM; p.ldw = DM; p.K = DM; p.mode = MD_RESID; p.Xf = X; s_gemm<<<dim3(DM / 64, M / 64), 256, 0, stream>>>(p); }
                break;
            case 4:
                s_norm_route<<<M / 4, 256, 0, stream>>>(X, norm2_g + l * DM, HM, w_rg + (size_t)l * DM * 4, b_rg + l * 4, w_re + (size_t)l * DM * 32, b_re + l * 32, experts, weights, rank, ctl + 32 * l, rstd);
                break;
            case 5:
                s_dispatch<<<1, 64, 0, stream>>>(ctl + 32 * l, tile_tab);
                s_gather<<<M * 2 / 4, 256, 0, stream>>>(X, rstd, norm2_g + l * DM, experts, weights, rank, tile_tab, BUF, roww, dest);
                break;
            case 6:
                { SG p{}; p.A = BUF; p.lda = DM; p.W = w_eg + (size_t)l * NEXP * DM * DEXP; p.W2 = w_eu + (size_t)l * NEXP * DM * DEXP; p.ldw = DEXP; p.wstride = (size_t)DM * DEXP; p.tile_e = tile_tab; p.ntiles = tile_tab + 256;
                  p.K = DM; p.mode = MD_SILU; p.O = HID; p.ldo = DEXP; s_gemm<<<dim3(DEXP / 64, P_ROWS / 64), 256, 0, stream>>>(p); }
                break;
            case 7:
                { SG p{}; p.A = HID; p.lda = DEXP; p.W = w_ed + (size_t)l * NEXP * DEXP * DM; p.ldw = DM; p.wstride = (size_t)DEXP * DM; p.tile_e = tile_tab; p.ntiles = tile_tab + 256;
                  p.K = DEXP; p.mode = MD_ROWSCALE; p.O = YB; p.ldo = DM; p.roww = roww; s_gemm<<<dim3(DM / 64, P_ROWS / 64), 256, 0, stream>>>(p); }
                break;
            default:
                if (l + 1 < DEPTH) s_combine_norm<<<M / 4, 256, 0, stream>>>(X, YB, dest, norm1_g + (l + 1) * DM, HM, nullptr);
                else s_combine_norm<<<M / 4, 256, 0, stream>>>(X, YB, dest, final_g, nullptr, X);
                break;
            }
        }
        ++k;
    }
}
```

```cpp
#include <hip/hip_runtime.h>
#include <cstdint>
#include <cstdio>
#include <cmath>
#include <cstddef>

typedef unsigned short bf16_t;
typedef float f32x4 __attribute__((ext_vector_type(4)));
typedef unsigned u32x4 __attribute__((ext_vector_type(4)));
typedef unsigned u32x2 __attribute__((ext_vector_type(2)));

constexpr int BATCH = 8, SEQ = 2048, DM = 1024, DEPTH = 2, MEM_LEN = 256;
constexpr int M = BATCH * SEQ;
constexpr int MM = BATCH * MEM_LEN;
constexpr int D_IN = 5888;
constexpr int C_AQ = 0, C_AK = 512, C_AV = 1024, C_BQ = 1536, C_BK = 2048, C_BV = 2176, C_CQ = 2304, C_G = 2816;
constexpr int OBR_W = 1536;
constexpr int NEXP = 32, DEXP = 512;
constexpr int MOE_TILE = 256;
constexpr int P_ROWS = M * 2 + NEXP * MOE_TILE;
constexpr int MAX_TILES = P_ROWS / MOE_TILE;
constexpr float EPS = 1e-6f;
constexpr float LOG2E = 1.4426950408889634f;
constexpr float C2_64 = 0.125f * LOG2E;
constexpr float C2_128 = 0.08838834764831845f * LOG2E;

constexpr size_t MiB = 1u << 20;
constexpr size_t WS_CTL = 0;
constexpr size_t WS_ROUTE = 1 * MiB;
constexpr size_t WS_TAB = 2 * MiB;
constexpr size_t WS_MEMKV = 3 * MiB;
constexpr size_t WS_HM = 7 * MiB;
constexpr size_t WS_PROJ = 39 * MiB;
constexpr size_t WS_OBR = 223 * MiB;
constexpr size_t WS_WB = 271 * MiB;
constexpr size_t WS_END = 499 * MiB;
constexpr size_t WS_BUF = WS_PROJ;
constexpr size_t WS_YB = WS_PROJ + 80 * MiB;
constexpr size_t WS_HID = WS_OBR;
constexpr size_t RT_EXP = 0;
constexpr size_t RT_WGT = 128 * 1024;
constexpr size_t RT_RANK = 256 * 1024;
constexpr size_t RT_DEST = 384 * 1024;
constexpr size_t RT_ROWW = 512 * 1024;
constexpr size_t RT_TILE = 700 * 1024;
constexpr size_t RT_RSTD = 768 * 1024;
constexpr int CW_CNT = 163840;
constexpr int CW_TMO = 128;
constexpr int CW_TCNT = 131072;

__device__ __forceinline__ float bf2f(bf16_t v) { return __uint_as_float(((unsigned)v) << 16); }
__device__ __forceinline__ bf16_t f2bf(float f) { unsigned u = __float_as_uint(f); return (bf16_t)((u + 0x7fffu + ((u >> 16) & 1u)) >> 16); }
__device__ __forceinline__ float wave_sum(float v) {
#pragma unroll
    for (int o = 1; o < 64; o <<= 1) v += __shfl_xor(v, o);
    return v;
}
__device__ __forceinline__ float wave_max(float v) {
#pragma unroll
    for (int o = 1; o < 64; o <<= 1) v = fmaxf(v, __shfl_xor(v, o));
    return v;
}
__device__ __forceinline__ float inv1d(int i) { return exp2f(-(float)i * (13.287712379549449f / 32.f)); }
__device__ __forceinline__ float inv2d(int j) { return exp2f(-(float)j * (13.287712379549449f / 16.f)); }
__device__ __forceinline__ float ang2d(int pos, int i) { return i < 16 ? (float)(pos >> 6) * inv2d(i) : (float)(pos & 63) * inv2d(i - 16); }

#define LAS __attribute__((address_space(3)))
#define GAS __attribute__((address_space(1)))
typedef short bf16x8 __attribute__((ext_vector_type(8)));
typedef short s16x4 __attribute__((ext_vector_type(4)));
typedef float f32x16 __attribute__((ext_vector_type(16)));
typedef float f32x2 __attribute__((ext_vector_type(2)));

constexpr size_t WB_IN = 0, WB_UP = 6029312, WB_OUT = WB_UP + 1572864, WB_GU = WB_OUT + 1048576, WB_DN = WB_GU + 33554432, WB_LAYER = WB_DN + 16777216;
constexpr size_t WB_MEMKV = 2 * WB_LAYER;
constexpr size_t WB_RT = WB_MEMKV + 1048576;
static_assert(WS_WB + (WB_RT + 2 * 2 * 48 * 1024) * 2 <= WS_END, "weight copies fit");
constexpr int N_PHASES = 19;
constexpr int XP = 2048;
constexpr int LCAP = 16384;

__device__ __forceinline__ int lane_id() { int r; asm volatile("v_mbcnt_lo_u32_b32 %0, -1, 0\n\tv_mbcnt_hi_u32_b32 %0, -1, %0" : "=v"(r)); return r; }
__device__ __forceinline__ unsigned cvt_pk_bf16(float lo, float hi) { unsigned r; asm volatile("v_cvt_pk_bf16_f32 %0, %1, %2" : "=v"(r) : "v"(lo), "v"(hi)); return r; }
__device__ __forceinline__ float fast_sigmoid(float v) { return __builtin_amdgcn_rcpf(1.f + __builtin_amdgcn_exp2f(-v * LOG2E)); }

namespace pg8 {
#define PG8_LAS LAS
constexpr int BM = 256, BK = 64, HALF = 128, HTB = HALF * BK * 2, STAGE_BYTES = 8 * HTB, NXCD = 8, WGM = 8;
__host__ __device__ __forceinline__ int lds_byte(int r, int c) { const int st = (r >> 4) * 2 + (c >> 5), rr = r & 15, cc = c & 31, ob = rr * 64 + cc * 2; return st * 1024 + (ob ^ (((ob >> 9) & 1) << 5)); }
__host__ __device__ __forceinline__ void stage_rc(int b, int& R, int& C) { const int st = b / 1024, sb = b % 1024, swz = sb ^ (((sb >> 9) & 1) << 5); R = (st >> 1) * 16 + swz / 64; C = (st & 1) * 32 + (swz % 64) / 2; }
__host__ __device__ __forceinline__ int perm32(int rho) { const int n = rho >> 4, i = rho & 15; return 8 * (i >> 2) + 4 * n + (i & 3); }

struct Unit { int pm, pn, sub, ord; const char* a; const char* b; };
struct Gemm { int lda; int K; };
__device__ __forceinline__ void tile_order(int L, int nM, int nN, int& pm, int& pn) {
    const int nwg = nM * nN; int wgid = L; { const int q = nwg / NXCD, r = nwg % NXCD, xcd = wgid % NXCD, off = wgid / NXCD; wgid = (xcd < r ? xcd * (q + 1) : r * (q + 1) + (xcd - r) * q) + off; }
    const int nig = WGM * nN, gid = wgid / nig, fm = gid * WGM, gsz = (nM - fm) < WGM ? (nM - fm) : WGM;
    pm = fm + ((wgid % nig) % gsz); pn = (wgid % nig) / gsz;
}
__device__ __forceinline__ u32x4 pack8(const f32x4& v0, const f32x4& v1) { u32x4 w; w.x = cvt_pk_bf16(v0[0], v0[1]); w.y = cvt_pk_bf16(v0[2], v0[3]); w.z = cvt_pk_bf16(v1[0], v1[1]); w.w = cvt_pk_bf16(v1[2], v1[3]); return w; }
__device__ __forceinline__ void unpack8(const u32x4& w, f32x4& v0, f32x4& v1) {
    v0[0] = __uint_as_float(w.x << 16); v0[1] = __uint_as_float(w.x & 0xffff0000u); v0[2] = __uint_as_float(w.y << 16); v0[3] = __uint_as_float(w.y & 0xffff0000u);
    v1[0] = __uint_as_float(w.z << 16); v1[1] = __uint_as_float(w.z & 0xffff0000u); v1[2] = __uint_as_float(w.w << 16); v1[3] = __uint_as_float(w.w & 0xffff0000u); }

struct EpiProj {
    static constexpr bool PERM = true, AFTER_DRAIN = false;
    bf16_t* PROJ; bf16_t* MEMKV; const float* tab1; const float* tab2; const float* qg; const float* kg;
    __device__ __forceinline__ void operator()(const f32x4 (&acc)[2][2][4][2], const Unit& u, int wr, int wc, int fr, int fq) const {
        const int colt = u.pn * 256, dcol = colt + wc * 64 + fq * 8, row0 = u.pm * 256 + wr * 64 + fr;
        if (u.sub == 1) {
#pragma unroll
            for (int ai = 0; ai < 2; ++ai)
#pragma unroll
                for (int m = 0; m < 4; ++m) { bf16_t* rowp = MEMKV + (size_t)(row0 + ai * 128 + m * 16) * 1024 + dcol;
#pragma unroll
                    for (int bj = 0; bj < 2; ++bj) *(u32x4*)(rowp + bj * 32) = pack8(acc[ai][bj][m][0], acc[ai][bj][m][1]); }
            return;
        }
        int mode = 0; float sc = 1.f; const float* g = qg;
        if (colt < C_AV) { mode = 1; if (colt < C_AK) sc = C2_64; }
        else if (colt < C_BQ) mode = 0;
        else if (colt < C_BK) { mode = 2; sc = C2_64; }
        else if (colt < C_CQ) { if (wc < 2) { mode = 2; g = kg; } }
        else if (colt < C_G) sc = C2_128;
        else mode = 3;
        f32x4 gv[2][2];
        if (mode == 2) {
#pragma unroll
            for (int bj = 0; bj < 2; ++bj)
#pragma unroll
                for (int n = 0; n < 2; ++n) gv[bj][n] = *(const f32x4*)(g + bj * 32 + fq * 8 + n * 4);
        }
#pragma unroll
        for (int ai = 0; ai < 2; ++ai)
#pragma unroll
            for (int m = 0; m < 4; ++m) {
                const int row = row0 + ai * 128 + m * 16, pos = row & (SEQ - 1);
                f32x4 v[2][2] = {{acc[ai][0][m][0], acc[ai][0][m][1]}, {acc[ai][1][m][0], acc[ai][1][m][1]}};
                if (mode == 2) {
                    float ss = 0.f;
#pragma unroll
                    for (int bj = 0; bj < 2; ++bj)
#pragma unroll
                        for (int n = 0; n < 2; ++n) ss += (v[bj][n][0] * v[bj][n][0] + v[bj][n][1] * v[bj][n][1]) + (v[bj][n][2] * v[bj][n][2] + v[bj][n][3] * v[bj][n][3]);
                    ss += __shfl_xor(ss, 16); ss += __shfl_xor(ss, 32);
                    const float rs = rsqrtf(ss * (1.f / 64.f) + EPS);
#pragma unroll
                    for (int bj = 0; bj < 2; ++bj)
#pragma unroll
                        for (int n = 0; n < 2; ++n) v[bj][n] = v[bj][n] * rs * gv[bj][n];
                }
                if (mode == 1 || mode == 2) {
                    const float* tb = (mode == 1 ? tab1 : tab2) + ((size_t)pos * 32 + fq * 8) * 2;
#pragma unroll
                    for (int n = 0; n < 2; ++n) { const f32x4 t0 = *(const f32x4*)(tb + n * 8), t1 = *(const f32x4*)(tb + n * 8 + 4);
                        const float cs[4] = {t0[0], t0[2], t1[0], t1[2]}, sn[4] = {t0[1], t0[3], t1[1], t1[3]};
#pragma unroll
                        for (int e = 0; e < 4; ++e) { const float x1 = v[0][n][e], x2 = v[1][n][e]; v[0][n][e] = x1 * cs[e] - x2 * sn[e]; v[1][n][e] = x2 * cs[e] + x1 * sn[e]; } }
                }
                if (mode == 3) {
#pragma unroll
                    for (int bj = 0; bj < 2; ++bj)
#pragma unroll
                        for (int n = 0; n < 2; ++n)
#pragma unroll
                            for (int e = 0; e < 4; ++e) v[bj][n][e] = fast_sigmoid(v[bj][n][e]);
                }
                bf16_t* rowp = PROJ + (size_t)row * D_IN + dcol;
#pragma unroll
                for (int bj = 0; bj < 2; ++bj) *(u32x4*)(rowp + bj * 32) = pack8(v[bj][0] * sc, v[bj][1] * sc);
            }
    }
};
struct EpiGate {
    static constexpr bool PERM = true, AFTER_DRAIN = false;
    bf16_t* MERGED; const bf16_t* PROJ;
    __device__ __forceinline__ void operator()(const f32x4 (&acc)[2][2][4][2], const Unit& u, int wr, int wc, int fr, int fq) const {
        const int col0 = u.pn * 256 + wc * 32 + fq * 8, row0 = u.pm * 256 + wr * 64 + fr;
#pragma unroll
        for (int ai = 0; ai < 2; ++ai)
#pragma unroll
            for (int mp = 0; mp < 2; ++mp) {
                u32x4 gq[2][2], oq[2][2];
#pragma unroll
                for (int mi = 0; mi < 2; ++mi) { const int row = row0 + ai * 128 + (mp * 2 + mi) * 16;
                    const bf16_t* gp = PROJ + (size_t)row * D_IN + C_G + u.sub * 1024 + col0; const bf16_t* op = MERGED + (size_t)row * DM + col0;
#pragma unroll
                    for (int bj = 0; bj < 2; ++bj) { gq[mi][bj] = *(const u32x4*)(gp + bj * 128); if (u.sub != 0) oq[mi][bj] = *(const u32x4*)(op + bj * 128); else oq[mi][bj] = (u32x4){0u, 0u, 0u, 0u}; } }
                asm volatile("" ::: "memory");
#pragma unroll
                for (int mi = 0; mi < 2; ++mi) { const int m = mp * 2 + mi; bf16_t* op = MERGED + (size_t)(row0 + ai * 128 + m * 16) * DM + col0;
#pragma unroll
                    for (int bj = 0; bj < 2; ++bj) { f32x4 g0, g1, o0, o1; unpack8(gq[mi][bj], g0, g1); unpack8(oq[mi][bj], o0, o1);
                        o0 += g0 * acc[ai][bj][m][0]; o1 += g1 * acc[ai][bj][m][1];
                        *(u32x4*)(op + bj * 128) = pack8(o0, o1); } }
                asm volatile("" ::: "memory");
            }
    }
};
struct EpiResid {
    static constexpr bool PERM = true, AFTER_DRAIN = false;
    const float* Xf; bf16_t* XB; int first;
    __device__ __forceinline__ void operator()(const f32x4 (&acc)[2][2][4][2], const Unit& u, int wr, int wc, int fr, int fq) const {
        const int col0 = u.pn * 256 + wc * 32 + fq * 8, row0 = u.pm * 256 + wr * 64 + fr;
#pragma unroll
        for (int ai = 0; ai < 2; ++ai)
#pragma unroll
            for (int mp = 0; mp < 2; ++mp) {
                f32x4 xin[2][2][2];
                if (first) {
#pragma unroll
                    for (int mi = 0; mi < 2; ++mi) { const size_t off = (size_t)(row0 + ai * 128 + (mp * 2 + mi) * 16) * DM + col0;
#pragma unroll
                        for (int bj = 0; bj < 2; ++bj) { const f32x4* pi = (const f32x4*)(Xf + off + bj * 128); xin[mi][bj][0] = pi[0]; xin[mi][bj][1] = pi[1]; } }
                } else {
                    u32x4 xq[2][2];
#pragma unroll
                    for (int mi = 0; mi < 2; ++mi)
#pragma unroll
                        for (int bj = 0; bj < 2; ++bj) xq[mi][bj] = *(const u32x4*)(XB + (size_t)(row0 + ai * 128 + (mp * 2 + mi) * 16) * XP + col0 + bj * 128);
                    asm volatile("" ::: "memory");
#pragma unroll
                    for (int mi = 0; mi < 2; ++mi)
#pragma unroll
                        for (int bj = 0; bj < 2; ++bj) unpack8(xq[mi][bj], xin[mi][bj][0], xin[mi][bj][1]);
                }
                asm volatile("" ::: "memory");
#pragma unroll
                for (int mi = 0; mi < 2; ++mi) { const int m = mp * 2 + mi;
#pragma unroll
                    for (int bj = 0; bj < 2; ++bj) *(u32x4*)(XB + (size_t)(row0 + ai * 128 + m * 16) * XP + col0 + bj * 128) = pack8(xin[mi][bj][0] + acc[ai][bj][m][0], xin[mi][bj][1] + acc[ai][bj][m][1]); }
                asm volatile("" ::: "memory");
            }
    }
};
struct EpiSilu {
    static constexpr bool PERM = true, AFTER_DRAIN = false;
    bf16_t* HID;
    __device__ __forceinline__ void operator()(const f32x4 (&acc)[2][2][4][2], const Unit& u, int wr, int wc, int fr, int fq) const {
        const __amdgpu_buffer_rsrc_t rsrc = __builtin_amdgcn_make_buffer_rsrc((void*)HID, 0, P_ROWS * DEXP * 2, 0x00020000);
        const int col0 = u.pn * 128 + wc * 32 + fq * 8, row0 = u.pm * 256 + wr * 64 + fr;
#pragma unroll
        for (int ai = 0; ai < 2; ++ai)
#pragma unroll
            for (int m = 0; m < 4; ++m) { f32x4 h[2];
#pragma unroll
                for (int n = 0; n < 2; ++n)
#pragma unroll
                    for (int e = 0; e < 4; ++e) { const float gq = acc[ai][0][m][n][e]; h[n][e] = gq * fast_sigmoid(gq) * acc[ai][1][m][n][e]; }
                __builtin_amdgcn_raw_buffer_store_b128(pack8(h[0], h[1]), rsrc, ((row0 + ai * 128 + m * 16) * DEXP + col0) * 2, 0, 16); }
    }
};
struct EpiRowScale {
    static constexpr bool PERM = true, AFTER_DRAIN = false;
    bf16_t* YB; const PG8_LAS float* wtab;
    __device__ __forceinline__ void operator()(const f32x4 (&acc)[2][2][4][2], const Unit& u, int wr, int wc, int fr, int fq) const {
        const int col0 = u.pn * 256 + wc * 32 + fq * 8, rt0 = wr * 64 + fr;
#pragma unroll
        for (int ai = 0; ai < 2; ++ai)
#pragma unroll
            for (int m = 0; m < 4; ++m) { const int rt = rt0 + ai * 128 + m * 16; const float w = wtab[u.ord * 256 + rt]; bf16_t* op = YB + (size_t)(u.pm * 256 + rt) * DM + col0;
#pragma unroll
                for (int bj = 0; bj < 2; ++bj) *(u32x4*)(op + bj * 128) = pack8(acc[ai][bj][m][0] * w, acc[ai][bj][m][1] * w); }
    }
};
struct SchedProj {
    int c, G, nmain, ntotal; const char* A; const char* B; const char* Am; const char* Bm;
    __device__ __forceinline__ bool next(int i, Unit& u) const {
        const long L = (long)i * G + c; if (L >= ntotal) return false;
        u.ord = i;
        if (L < nmain) { tile_order((int)L, M / 256, D_IN / 256, u.pm, u.pn); u.sub = 0; u.a = A + (size_t)u.pm * (256 * DM * 2); u.b = B + (size_t)u.pn * (256 * DM * 2); }
        else { const int r = (int)L - nmain; u.pm = r >> 2; u.pn = r & 3; u.sub = 1; u.a = Am + (size_t)u.pm * (256 * DM * 2); u.b = Bm + (size_t)u.pn * (256 * DM * 2); }
        return true; }
    __device__ __forceinline__ void a_ready(const Unit&) const {}
    __device__ __forceinline__ void done(const Unit&) const {}
};
struct SchedGate {
    int c, G; const char* OBRp; const char* WUP;
    __device__ __forceinline__ bool next(int i, Unit& u) const {
        const int t = c + G * (i / 3); if (t >= 256) return false;
        tile_order(t, M / 256, 4, u.pm, u.pn); u.sub = i % 3; u.ord = i;
        u.a = OBRp + ((size_t)u.pm * 256 * OBR_W + 512 * u.sub) * 2; u.b = WUP + ((size_t)u.sub * 1024 * 512 + (size_t)u.pn * 256 * 512) * 2; return true; }
    __device__ __forceinline__ void a_ready(const Unit&) const {}
    __device__ __forceinline__ void done(const Unit&) const {}
};
struct SchedPlain {
    int c, G, nM; const char* A; const char* B; size_t a_tile, b_tile;
    __device__ __forceinline__ bool next(int i, Unit& u) const {
        const long L = (long)i * G + c; if (L >= (long)nM * 4) return false;
        tile_order((int)L, nM, 4, u.pm, u.pn); u.sub = 0; u.ord = i; u.a = A + (size_t)u.pm * a_tile; u.b = B + (size_t)u.pn * b_tile; return true; }
    __device__ __forceinline__ void a_ready(const Unit&) const {}
    __device__ __forceinline__ void done(const Unit&) const {}
};
struct SchedMoeUp {
    static constexpr size_t b_exp = (size_t)1024 * 1024 * 2, b_tile = (size_t)256 * DM * 2;
    int c, G, ntiles; const PG8_LAS int* tile_e; const char* A; const char* B; unsigned* tcnt;
    __device__ __forceinline__ bool next(int i, Unit& u) const {
        const long L = (long)i * G + c; if (L >= (long)ntiles * 4) return false;
        u.pm = (int)(L >> 2); u.pn = (int)(L & 3); u.sub = 0; u.ord = i; const int e = tile_e[u.pm];
        u.a = A; u.b = B + (size_t)e * b_exp + (size_t)u.pn * b_tile; return true; }
    __device__ __forceinline__ void a_ready(const Unit&) const {}
    __device__ __forceinline__ void done(const Unit& u) const {
        asm volatile("s_waitcnt vmcnt(0)" ::: "memory");
        if (lane_id() == 0) __hip_atomic_fetch_add(tcnt + 64 * u.pm, 1u, __ATOMIC_RELAXED, __HIP_MEMORY_SCOPE_AGENT);
    }
};
__device__ __forceinline__ int moe_down_unit(int c, int i, int rem, int G) {
    const int n0 = G - rem, n1 = rem;
    return c >= rem ? n0 * i + n1 * (i > 1 ? i - 1 : 0) + (c - rem) : n0 * (i + 2) + n1 * i + c;
}
struct SchedMoeDown {
    static constexpr size_t a_tile = (size_t)256 * DEXP * 2, b_exp = (size_t)1024 * 512 * 2, b_tile = (size_t)256 * DEXP * 2;
    int c, G, ntiles, rem, wv; const PG8_LAS int* tile_e; const char* A; const char* B; unsigned* tcnt; unsigned* tmo;
    __device__ __forceinline__ bool next(int i, Unit& u) const {
        const int j = moe_down_unit(c, i, rem, G); if (j >= ntiles * 4) return false;
        u.pm = j >> 2; u.pn = j & 3; u.sub = 0; u.ord = i; const int e = tile_e[u.pm];
        u.a = A + (size_t)u.pm * a_tile; u.b = B + (size_t)e * b_exp + (size_t)u.pn * b_tile; return true; }
    __device__ __forceinline__ void a_ready(const Unit& u) const {
        if (wv == 0) {
            unsigned polls = 0;
            while ((unsigned)__builtin_amdgcn_readfirstlane(__hip_atomic_load(tcnt + 64 * u.pm, __ATOMIC_RELAXED, __HIP_MEMORY_SCOPE_AGENT)) < 32u) {
                if (++polls > (1u << 20)) { if (lane_id() == 0) __hip_atomic_store(tmo, 1u, __ATOMIC_RELAXED, __HIP_MEMORY_SCOPE_AGENT); break; }
                __builtin_amdgcn_s_sleep(2); }
            __builtin_amdgcn_fence(__ATOMIC_ACQUIRE, "agent");
            asm volatile("s_waitcnt vmcnt(0)" ::: "memory");
        }
        asm volatile("" ::: "memory"); __builtin_amdgcn_s_barrier(); asm volatile("" ::: "memory");
    }
    __device__ __forceinline__ void done(const Unit&) const {}
};

template <class Epi, class Sched, bool ALIGN_EPI = false, bool SP2 = false, bool GATHER = false>
__device__ __forceinline__ void gemm_phase(PG8_LAS unsigned char* lds, const Gemm g, const Sched& S, const Epi& E, int wave_id, const PG8_LAS unsigned* rowtab = nullptr) {
    static_assert(!GATHER || SP2, "the gathered A path is written for the two-super-phase loop");
    int tid_ = wave_id * 64 + lane_id(); asm volatile("" : "+v"(tid_));
    const int tid = tid_, wid = __builtin_amdgcn_readfirstlane(tid >> 6), lane = tid & 63, wr = wid >> 2, wc = wid & 3, fr = lane & 15, fq = lane >> 4;
    const int K = g.K, nt = K / BK;
    unsigned voffA[2], voffB[2];
#pragma unroll
    for (int i = 0; i < 2; ++i) { int R, C; stage_rc(tid * 16 + i * 8192, R, C); const int Rb = Epi::PERM ? ((R & ~31) + perm32(R & 31)) : R;
        voffA[i] = (unsigned)(R * g.lda + C) * 2u; voffB[i] = (unsigned)(Rb * K + C) * 2u; }
    unsigned gC[2][2] = {{0u, 0u}, {0u, 0u}}, gN[2][2] = {{0u, 0u}, {0u, 0u}};
#define PG8_GROWS(dst, ord) do { if constexpr (GATHER) { _Pragma("unroll") for (int i_ = 0; i_ < 2; ++i_) { int R_, C_; stage_rc((wid * 64 + fq * 16 + fr) * 16 + i_ * 8192, R_, C_);     \
        _Pragma("unroll") for (int h_ = 0; h_ < 2; ++h_) dst[h_][i_] = rowtab[(ord) * 256 + h_ * 128 + R_] + (unsigned)C_ * 2u; } } } while (0)
#define PG8_STAGE_A(bufoff, base, h, use_next) do { if constexpr (GATHER) { unsigned vo_[2]; vo_[0] = (use_next) ? gN[h][0] : gC[h][0]; vo_[1] = (use_next) ? gN[h][1] : gC[h][1]; PG8_STAGE(bufoff, base, vo_); } \
        else { PG8_STAGE(bufoff, (base) + (h) * hstepA, voffA); } } while (0)
    const size_t kstep = (size_t)(BK * 2);
    const size_t hstepA = (size_t)HALF * g.lda * 2, hstepB = (size_t)HALF * K * 2;
    const unsigned ldsw = (unsigned)wid * 1024u;
    const int aoff = lds_byte(wr * 64 + fr, fq * 8), boff = lds_byte(wc * 32 + fr, fq * 8);
#define PG8_SA(b, h) (((b) * 2 + (h)) * HTB)
#define PG8_SB(b, h) ((4 + (b) * 2 + (h)) * HTB)
#define PG8_STAGE(bufoff, gbase, voff) do { _Pragma("unroll") for (int _i = 0; _i < 2; ++_i) \
        __builtin_amdgcn_global_load_lds((const unsigned*)((const char*)(gbase) + (voff)[_i]), (PG8_LAS unsigned*)(lds + (bufoff) + ldsw + _i * 8192), 16, 0, 0); } while (0)
#define PG8_LDA(dst, b, h) do { _Pragma("unroll") for (int m = 0; m < 4; ++m) _Pragma("unroll") for (int k = 0; k < 2; ++k) dst[m][k] = *(const PG8_LAS bf16x8*)(lds + PG8_SA(b, h) + aoff + m * 2048 + k * 1024); } while (0)
#define PG8_LDB(dst, b, h) do { _Pragma("unroll") for (int n = 0; n < 2; ++n) _Pragma("unroll") for (int k = 0; k < 2; ++k) dst[n][k] = *(const PG8_LAS bf16x8*)(lds + PG8_SB(b, h) + boff + n * 2048 + k * 1024); } while (0)
#define PG8_MMA(ai, bj, At, Bt) do { __builtin_amdgcn_s_setprio(1); _Pragma("unroll") for (int m = 0; m < 4; ++m) _Pragma("unroll") for (int n = 0; n < 2; ++n) _Pragma("unroll") for (int k = 0; k < 2; ++k) \
        acc[ai][bj][m][n] = __builtin_amdgcn_mfma_f32_16x16x32_bf16(Bt[n][k], At[m][k], acc[ai][bj][m][n], 0, 0, 0); __builtin_amdgcn_s_setprio(0); } while (0)
#define PG8_WAIT_V(n) asm volatile("s_waitcnt vmcnt(" #n ")" ::: "memory")
#define PG8_WAIT_L(n) asm volatile("s_waitcnt lgkmcnt(" #n ")" ::: "memory")
#define PG8_BAR __builtin_amdgcn_s_barrier()
#define PG8_SCHED __builtin_amdgcn_sched_barrier(0)
    Unit cur, nxt; int ui = 0;
    if (!S.next(0, cur)) return;
    f32x4 acc[2][2][4][2];
#pragma unroll
    for (int a = 0; a < 2; ++a)
#pragma unroll
        for (int b = 0; b < 2; ++b)
#pragma unroll
            for (int m = 0; m < 4; ++m)
#pragma unroll
                for (int n = 0; n < 2; ++n) acc[a][b][m][n] = (f32x4){0.f, 0.f, 0.f, 0.f};
    bf16x8 At[4][2], B0[2][2], B1[2][2];
    const char* cA = cur.a; const char* cB = cur.b;
    S.a_ready(cur);
    if constexpr (SP2) {
        PG8_GROWS(gC, 0);
        PG8_STAGE(PG8_SB(0, 0), cB, voffB); PG8_STAGE(PG8_SB(0, 1), cB + hstepB, voffB); PG8_STAGE_A(PG8_SA(0, 0), cA, 0, false); PG8_STAGE_A(PG8_SA(0, 1), cA, 1, false);
        if (wr == 1) PG8_BAR;
        PG8_WAIT_V(2); PG8_BAR;
        PG8_STAGE(PG8_SB(1, 0), cB + kstep, voffB); PG8_STAGE_A(PG8_SA(1, 0), cA + kstep, 0, false); PG8_STAGE(PG8_SB(1, 1), cB + hstepB + kstep, voffB);
        PG8_WAIT_V(6); PG8_BAR;
    } else {
        PG8_STAGE(PG8_SB(0, 0), cB, voffB); PG8_STAGE(PG8_SA(0, 0), cA, voffA); PG8_STAGE(PG8_SB(0, 1), cB + hstepB, voffB); PG8_STAGE(PG8_SA(0, 1), cA + hstepA, voffA);
        if (wr == 1) PG8_BAR;
        PG8_WAIT_V(4); PG8_BAR;
        PG8_STAGE(PG8_SB(1, 0), cB + kstep, voffB); PG8_STAGE(PG8_SA(1, 0), cA + kstep, voffA); PG8_STAGE(PG8_SB(1, 1), cB + hstepB + kstep, voffB);
        PG8_WAIT_V(6); PG8_BAR;
    }
    for (;;) {
        const bool has_next = S.next(ui + 1, nxt);
        const char* nA = has_next ? nxt.a : cA; const char* nB = has_next ? nxt.b : cB;
        for (int t = 0; t < nt; t += 2) {
            const bool last = (t == nt - 2);
            const char* a1 = cA + (size_t)(t + 1) * kstep;
            const char* a2 = last ? nA : cA + (size_t)(t + 2) * kstep; const char* b2 = last ? nB : cB + (size_t)(t + 2) * kstep;
            const char* a3 = a2 + kstep; const char* b3 = b2 + kstep;
            if (last && has_next) S.a_ready(nxt);
            if constexpr (GATHER) { if (last) { if (has_next) { PG8_GROWS(gN, ui + 1); } else { _Pragma("unroll") for (int h_ = 0; h_ < 2; ++h_) _Pragma("unroll") for (int i_ = 0; i_ < 2; ++i_) gN[h_][i_] = gC[h_][i_]; } } }
            if constexpr (SP2) {
            PG8_LDB(B0, 0, 0); PG8_LDB(B1, 0, 1); PG8_SCHED; PG8_LDA(At, 0, 0); PG8_STAGE_A(PG8_SA(1, 1), a1, 1, false);
            PG8_WAIT_V(8); PG8_WAIT_L(0); PG8_BAR; PG8_MMA(0, 0, At, B0); PG8_MMA(0, 1, At, B1); PG8_BAR; PG8_SCHED;
            PG8_LDA(At, 0, 1); PG8_STAGE(PG8_SB(0, 0), b2, voffB); PG8_STAGE(PG8_SB(0, 1), b2 + hstepB, voffB); PG8_STAGE_A(PG8_SA(0, 0), a2, 0, last);
            PG8_WAIT_V(8); PG8_WAIT_L(0); PG8_BAR; PG8_MMA(1, 0, At, B0); PG8_MMA(1, 1, At, B1); PG8_BAR; PG8_SCHED;
            PG8_LDB(B0, 1, 0); PG8_LDB(B1, 1, 1); PG8_SCHED; PG8_LDA(At, 1, 0); PG8_STAGE_A(PG8_SA(0, 1), a2, 1, last);
            PG8_WAIT_V(8); PG8_WAIT_L(0); PG8_BAR; PG8_MMA(0, 0, At, B0); PG8_MMA(0, 1, At, B1); PG8_BAR; PG8_SCHED;
            PG8_LDA(At, 1, 1); PG8_STAGE(PG8_SB(1, 0), b3, voffB); PG8_STAGE(PG8_SB(1, 1), b3 + hstepB, voffB); PG8_STAGE_A(PG8_SA(1, 0), a3, 0, last);
            PG8_WAIT_V(8); PG8_WAIT_L(0); PG8_BAR; PG8_MMA(1, 0, At, B0); PG8_MMA(1, 1, At, B1); PG8_BAR; PG8_SCHED;
            } else {
            PG8_LDB(B0, 0, 0); PG8_SCHED; PG8_LDA(At, 0, 0); PG8_STAGE(PG8_SA(1, 1), a1 + hstepA, voffA);
            PG8_WAIT_L(8); PG8_BAR; PG8_WAIT_L(0); PG8_MMA(0, 0, At, B0); PG8_BAR; PG8_SCHED;
            PG8_LDB(B1, 0, 1); PG8_STAGE(PG8_SB(0, 0), b2, voffB);
            PG8_BAR; PG8_WAIT_L(0); PG8_MMA(0, 1, At, B1); PG8_BAR;
            PG8_LDA(At, 0, 1); PG8_STAGE(PG8_SA(0, 0), a2, voffA);
            PG8_BAR; PG8_WAIT_L(0); PG8_MMA(1, 0, At, B0); PG8_BAR; PG8_SCHED;
            PG8_STAGE(PG8_SB(0, 1), b2 + hstepB, voffB);
            PG8_WAIT_V(6); PG8_BAR; PG8_MMA(1, 1, At, B1); PG8_BAR;
            PG8_LDB(B0, 1, 0); PG8_SCHED; PG8_LDA(At, 1, 0); PG8_STAGE(PG8_SA(0, 1), a2 + hstepA, voffA);
            PG8_WAIT_L(8); PG8_BAR; PG8_WAIT_L(0); PG8_MMA(0, 0, At, B0); PG8_BAR; PG8_SCHED;
            PG8_LDB(B1, 1, 1); PG8_STAGE(PG8_SB(1, 0), b3, voffB);
            PG8_BAR; PG8_WAIT_L(0); PG8_MMA(0, 1, At, B1); PG8_BAR;
            PG8_LDA(At, 1, 1); PG8_STAGE(PG8_SA(1, 0), a3, voffA);
            PG8_BAR; PG8_WAIT_L(0); PG8_MMA(1, 0, At, B0); PG8_BAR; PG8_SCHED;
            PG8_STAGE(PG8_SB(1, 1), b3 + hstepB, voffB);
            PG8_WAIT_V(6); PG8_BAR; PG8_MMA(1, 1, At, B1); PG8_BAR;
            }
        }
        if constexpr (ALIGN_EPI) { if (wr == 0) PG8_BAR; }
        if constexpr (!Epi::AFTER_DRAIN) { E(acc, cur, wr, wc, fr, fq); S.done(cur); }
        if (!has_next) break;
#pragma unroll
        for (int a = 0; a < 2; ++a)
#pragma unroll
            for (int b = 0; b < 2; ++b)
#pragma unroll
                for (int m = 0; m < 4; ++m)
#pragma unroll
                    for (int n = 0; n < 2; ++n) acc[a][b][m][n] = (f32x4){0.f, 0.f, 0.f, 0.f};
        cur = nxt; cA = nA; cB = nB; ++ui;
        if constexpr (GATHER) { _Pragma("unroll") for (int h_ = 0; h_ < 2; ++h_) _Pragma("unroll") for (int i_ = 0; i_ < 2; ++i_) gC[h_][i_] = gN[h_][i_]; }
        if constexpr (ALIGN_EPI) { if (wr == 1) PG8_BAR; }
    }
    PG8_WAIT_V(0);
    if constexpr (!ALIGN_EPI) { if (wr == 0) PG8_BAR; }
    PG8_BAR;
    if constexpr (Epi::AFTER_DRAIN) { E.fused(acc, cur, wr, wc, fr, fq, lds, wid, lane); S.done(cur); }
#undef PG8_SA
#undef PG8_GROWS
#undef PG8_STAGE_A
#undef PG8_SB
#undef PG8_STAGE
#undef PG8_LDA
#undef PG8_LDB
#undef PG8_MMA
#undef PG8_WAIT_V
#undef PG8_WAIT_L
#undef PG8_BAR
#undef PG8_SCHED
}
}

namespace att {
constexpr int NW = 8, QBLK = 32, KVBLK = 64;
constexpr float THR = 8.f;
#define ATT_SBAR() __builtin_amdgcn_sched_barrier(0)
__device__ __forceinline__ int crow(int r, int hi) { return (r & 3) + 8 * (r >> 2) + 4 * hi; }
template <int D> __device__ __forceinline__ int kswz(int row, int colB) { return D == 128 ? row * 256 + (colB ^ ((row & 7) << 4)) : row * 128 + (colB ^ (((row >> 1) & 7) << 4)); }
template <int DV> __device__ __forceinline__ int v_st(int k, int c) { const int kk = (k & ~0xC) | ((k & 4) << 1) | ((k & 8) >> 1); return ((kk >> 3) * (DV / 32) + (c >> 5)) * 512 + ((kk & 7) * 32 + (c & 31)) * 2; }
__device__ __forceinline__ int v_rd_base(int lane) { return ((lane & 3) << 3) | (((lane >> 2) & 3) << 6) | (((lane >> 4) & 1) << 5) | (((lane >> 5) & 1) << 8); }
template <int DV> constexpr int v_rd_off(int d0, int ks, int half) { return d0 * 512 + ks * (DV / 32) * 1024 + half * (DV / 32) * 512; }
template <int OFF> __device__ __forceinline__ s16x4 tr_read(int vb) { s16x4 r; asm volatile("ds_read_b64_tr_b16 %0, %1 offset:%2" : "=&v"(r) : "v"(vb), "i"(OFF) : "memory"); return r; }

__device__ __forceinline__ void partialSM(f32x16& p0, f32x16& p1, float& m_reg, float& mn, float& alpha) {
    float pmax = p0[0];
#pragma unroll
    for (int r = 1; r < 16; ++r) pmax = fmaxf(pmax, p0[r]);
#pragma unroll
    for (int r = 0; r < 16; ++r) pmax = fmaxf(pmax, p1[r]);
    { auto rr = __builtin_amdgcn_permlane32_swap(__float_as_uint(pmax), __float_as_uint(pmax), false, false); pmax = fmaxf(__uint_as_float(rr[0]), __uint_as_float(rr[1])); }
    if (__builtin_expect(__all(pmax - m_reg <= THR), 1)) { mn = m_reg; alpha = 1.f; }
    else { mn = fmaxf(m_reg, pmax); alpha = __builtin_amdgcn_exp2f(m_reg - mn); m_reg = mn; }
#pragma unroll
    for (int r = 0; r < 16; ++r) { p0[r] -= mn; p1[r] -= mn; }
#pragma unroll
    for (int r = 0; r < 16; ++r) p0[r] = __builtin_amdgcn_exp2f(p0[r]);
}
__device__ __forceinline__ void finishSM(f32x16& p0, f32x16& p1, float alpha, float& l_reg, bf16x8& pa0, bf16x8& pa1, bf16x8& pa2, bf16x8& pa3) {
#pragma unroll
    for (int r = 0; r < 16; ++r) p1[r] = __builtin_amdgcn_exp2f(p1[r]);
    float ps = 0;
#pragma unroll
    for (int r = 0; r < 16; ++r) ps += p0[r];
#pragma unroll
    for (int r = 0; r < 16; ++r) ps += p1[r];
    { auto rr = __builtin_amdgcn_permlane32_swap(__float_as_uint(ps), __float_as_uint(ps), false, false); ps = __uint_as_float(rr[0]) + __uint_as_float(rr[1]); }
    l_reg = l_reg * alpha + ps;
#define ATT_PK4(P, BASE, OUT) do { unsigned a0 = cvt_pk_bf16(P[BASE + 0], P[BASE + 1]), a1 = cvt_pk_bf16(P[BASE + 2], P[BASE + 3]);   \
    unsigned b0 = cvt_pk_bf16(P[BASE + 4], P[BASE + 5]), b1 = cvt_pk_bf16(P[BASE + 6], P[BASE + 7]);                              \
    auto r0 = __builtin_amdgcn_permlane32_swap(a0, b0, false, false); auto r1 = __builtin_amdgcn_permlane32_swap(a1, b1, false, false); \
    u32x4 w = {r0[0], r1[0], r0[1], r1[1]}; OUT = *reinterpret_cast<bf16x8*>(&w); } while (0)
    ATT_PK4(p0, 0, pa0); ATT_PK4(p0, 8, pa1); ATT_PK4(p1, 0, pa2); ATT_PK4(p1, 8, pa3);
#undef ATT_PK4
}
template <int DQK> __device__ __forceinline__ void qkt(f32x16& p0, f32x16& p1, const char* Ks, const bf16x8* qr, int r32, int hi) {
    p0 = f32x16{}; p1 = f32x16{};
#pragma unroll
    for (int d0 = 0; d0 < DQK / 16; ++d0) { const int cb = (d0 * 16 + hi * 8) * 2;
        const bf16x8 b0 = *reinterpret_cast<const bf16x8*>(Ks + kswz<DQK>(r32, cb));
        const bf16x8 b1 = *reinterpret_cast<const bf16x8*>(Ks + kswz<DQK>(32 + r32, cb));
        p0 = __builtin_amdgcn_mfma_f32_32x32x16_bf16(b0, qr[d0], p0, 0, 0, 0);
        p1 = __builtin_amdgcn_mfma_f32_32x32x16_bf16(b1, qr[d0], p1, 0, 0, 0); }
}
template <int DV, int D0> __device__ __forceinline__ void pv_one(f32x16& od, int vb, bf16x8 pa0, bf16x8 pa1, bf16x8 pa2, bf16x8 pa3) {
    const s16x4 l0 = tr_read<v_rd_off<DV>(D0, 0, 0)>(vb), h0 = tr_read<v_rd_off<DV>(D0, 0, 1)>(vb), l1 = tr_read<v_rd_off<DV>(D0, 1, 0)>(vb), h1 = tr_read<v_rd_off<DV>(D0, 1, 1)>(vb);
    const s16x4 l2 = tr_read<v_rd_off<DV>(D0, 2, 0)>(vb), h2 = tr_read<v_rd_off<DV>(D0, 2, 1)>(vb), l3 = tr_read<v_rd_off<DV>(D0, 3, 0)>(vb), h3 = tr_read<v_rd_off<DV>(D0, 3, 1)>(vb);
    asm volatile("s_waitcnt lgkmcnt(0)" ::: "memory"); ATT_SBAR();
#define ATT_PK(L, H) (bf16x8){L[0], L[1], L[2], L[3], H[0], H[1], H[2], H[3]}
    od = __builtin_amdgcn_mfma_f32_32x32x16_bf16(pa0, ATT_PK(l0, h0), od, 0, 0, 0);
    od = __builtin_amdgcn_mfma_f32_32x32x16_bf16(pa1, ATT_PK(l1, h1), od, 0, 0, 0);
    od = __builtin_amdgcn_mfma_f32_32x32x16_bf16(pa2, ATT_PK(l2, h2), od, 0, 0, 0);
    od = __builtin_amdgcn_mfma_f32_32x32x16_bf16(pa3, ATT_PK(l3, h3), od, 0, 0, 0);
#undef ATT_PK
}
template <int DV> __device__ __forceinline__ void pv_all(f32x16 (&o)[DV / 32], int vb, bf16x8 pa0, bf16x8 pa1, bf16x8 pa2, bf16x8 pa3) {
    pv_one<DV, 0>(o[0], vb, pa0, pa1, pa2, pa3); pv_one<DV, 1>(o[1], vb, pa0, pa1, pa2, pa3);
    if constexpr (DV == 128) { pv_one<DV, 2>(o[2], vb, pa0, pa1, pa2, pa3); pv_one<DV, 3>(o[3], vb, pa0, pa1, pa2, pa3); }
}
template <int DQK, int DV> struct Lay { static constexpr int SHM_V = 64 * DV * 2, SHM_K = 64 * DQK * 2, OFF_V = 0, OFF_K = 2 * SHM_V, OFF_WS = OFF_K + 2 * SHM_K, OFF_STASH = OFF_WS + NW * 64 * 4; };

template <int DQK, int DV, int LDQ, int LDK, int LDV>
__device__ __forceinline__ void attn_pass(const bf16_t* __restrict__ Qb, const bf16_t* __restrict__ Kh, const bf16_t* __restrict__ Vh, int nkeys, char* lds, f32x16 (&o)[DV / 32], float (&rli)[16], int wv) {
    using L = Lay<DQK, DV>;
    constexpr int NLK = DQK / 64, NLV = DV / 64;
    int tid_ = wv * 64 + lane_id(); asm volatile("" : "+v"(tid_));
    const int tid = tid_, wid = tid >> 6, lane = tid & 63, r32 = lane & 31, hi = lane >> 5;
    char* V_lds = lds + L::OFF_V; char* K_lds = lds + L::OFF_K;
    float* ws = (float*)(lds + L::OFF_WS) + wid * 64; float* li_l = ws; float* al_l = ws + 32;
    float m_reg = -1e30f, l_reg = 0.f; bf16x8 qr[DQK / 16];
#pragma unroll
    for (int d = 0; d < DV / 32; ++d) o[d] = f32x16{};
    const bf16_t* Qw = Qb + (size_t)(wid * QBLK + r32) * LDQ + hi * 8;
#pragma unroll
    for (int d0 = 0; d0 < DQK / 16; ++d0) qr[d0] = *reinterpret_cast<const bf16x8*>(Qw + d0 * 16);
    const int krow = DQK == 128 ? (tid >> 4) : (tid >> 3), kcol = DQK == 128 ? (tid & 15) * 8 : (tid & 7) * 8;
    const int vrow = DV == 128 ? (tid >> 4) : (tid >> 3), vcol = DV == 128 ? (tid & 15) * 8 : (tid & 7) * 8;
    const int vb0 = (int)(uintptr_t)V_lds + v_rd_base(lane);
    bf16x8 vsE[NLV], ksE[NLK], vsO[NLV], ksO[NLK];
#define ATT_SLOAD(VS, KS, k0) do { _Pragma("unroll") for (int i_ = 0; i_ < NLV; ++i_) VS[i_] = *reinterpret_cast<const bf16x8*>(&Vh[(size_t)((k0) + vrow + 32 * i_) * LDV + vcol]); \
    _Pragma("unroll") for (int i_ = 0; i_ < NLK; ++i_) KS[i_] = *reinterpret_cast<const bf16x8*>(&Kh[(size_t)((k0) + krow + 32 * i_) * LDK + kcol]); } while (0)
#define ATT_SWRITE(b, VS, KS) do { _Pragma("unroll") for (int i_ = 0; i_ < NLV; ++i_) *(bf16x8*)(V_lds + (b) * L::SHM_V + v_st<DV>(vrow + 32 * i_, vcol)) = VS[i_]; \
    _Pragma("unroll") for (int i_ = 0; i_ < NLK; ++i_) *(bf16x8*)(K_lds + (b) * L::SHM_K + kswz<DQK>(krow + 32 * i_, kcol * 2)) = KS[i_]; } while (0)
#define ATT_SWAIT() do { if constexpr (NLK + NLV == 4) asm volatile("s_waitcnt vmcnt(4)" ::: "memory"); else if constexpr (NLK + NLV == 3) asm volatile("s_waitcnt vmcnt(3)" ::: "memory"); else asm volatile("s_waitcnt vmcnt(2)" ::: "memory"); } while (0)
#define ATT_RESC(a) do { if (__any((a) < 1.f)) { if (hi == 0) al_l[r32] = (a); asm volatile("s_waitcnt lgkmcnt(0)" ::: "memory"); \
    _Pragma("unroll") for (int d = 0; d < DV / 32; ++d) _Pragma("unroll") for (int r = 0; r < 16; ++r) o[d][r] *= al_l[crow(r, hi)]; } } while (0)
    f32x16 pA0, pA1, pB0, pB1; float mnA, mnB, alA, alB; bf16x8 pa0, pa1, pa2, pa3; const int NT = nkeys / KVBLK;
    __syncthreads();
    ATT_SLOAD(vsE, ksE, 0); asm volatile("s_waitcnt vmcnt(0)" ::: "memory"); ATT_SWRITE(0, vsE, ksE); __syncthreads();
    qkt<DQK>(pA0, pA1, K_lds, qr, r32, hi); partialSM(pA0, pA1, m_reg, mnA, alA);
    ATT_SLOAD(vsO, ksO, KVBLK); if (2 < NT) ATT_SLOAD(vsE, ksE, 2 * KVBLK);
    ATT_SWAIT(); ATT_SWRITE(1, vsO, ksO); __syncthreads();
    for (int j = 1; j + 1 < NT; j += 2) {
        ATT_SBAR(); qkt<DQK>(pB0, pB1, K_lds + L::SHM_K, qr, r32, hi);
        finishSM(pA0, pA1, alA, l_reg, pa0, pa1, pa2, pa3); ATT_SBAR();
        ATT_SLOAD(vsO, ksO, (j + 2) * KVBLK); ATT_SBAR();
        pv_all<DV>(o, vb0, pa0, pa1, pa2, pa3); partialSM(pB0, pB1, m_reg, mnB, alB);
        __syncthreads(); ATT_SWAIT(); ATT_SWRITE(0, vsE, ksE);
        ATT_RESC(alB); __syncthreads();
        ATT_SBAR(); qkt<DQK>(pA0, pA1, K_lds, qr, r32, hi);
        finishSM(pB0, pB1, alB, l_reg, pa0, pa1, pa2, pa3); ATT_SBAR();
        if (j + 3 < NT) ATT_SLOAD(vsE, ksE, (j + 3) * KVBLK); ATT_SBAR();
        pv_all<DV>(o, vb0 + L::SHM_V, pa0, pa1, pa2, pa3); partialSM(pA0, pA1, m_reg, mnA, alA);
        __syncthreads(); ATT_SWAIT(); ATT_SWRITE(1, vsO, ksO);
        ATT_RESC(alA); __syncthreads();
    }
    ATT_SBAR(); qkt<DQK>(pB0, pB1, K_lds + L::SHM_K, qr, r32, hi);
    finishSM(pA0, pA1, alA, l_reg, pa0, pa1, pa2, pa3); ATT_SBAR();
    pv_all<DV>(o, vb0, pa0, pa1, pa2, pa3); partialSM(pB0, pB1, m_reg, mnB, alB);
    __syncthreads(); ATT_RESC(alB);
    finishSM(pB0, pB1, alB, l_reg, pa0, pa1, pa2, pa3); ATT_SBAR();
    pv_all<DV>(o, vb0 + L::SHM_V, pa0, pa1, pa2, pa3);
    if (hi == 0) li_l[r32] = l_reg; asm volatile("s_waitcnt lgkmcnt(0)" ::: "memory");
#pragma unroll
    for (int r = 0; r < 16; ++r) rli[r] = __builtin_amdgcn_rcpf(li_l[crow(r, hi)]);
#undef ATT_SLOAD
#undef ATT_SWRITE
#undef ATT_SWAIT
#undef ATT_RESC
}
template <int DV, int LDO> __device__ __forceinline__ void store_o(bf16_t* Ob, const f32x16 (&o)[DV / 32], const float (&rli)[16], int wv) {
    int tid_ = wv * 64 + lane_id(); asm volatile("" : "+v"(tid_));
    const int tid = tid_, wid = tid >> 6, lane = tid & 63, r32 = lane & 31, hi = lane >> 5;
    bf16_t* Ow = Ob + (size_t)(wid * QBLK) * LDO;
#pragma unroll
    for (int r = 0; r < 16; ++r) { const int orow = crow(r, hi);
#pragma unroll
        for (int d0 = 0; d0 < DV / 32; ++d0) Ow[(size_t)orow * LDO + d0 * 32 + r32] = f2bf(o[d0][r] * rli[r]); }
}
__device__ __forceinline__ void unit_a(const bf16_t* PROJ, bf16_t* OBR, int b, int h, int qb, float lam, float lam_init, const float* subg, char* lds, int wv) {
    using L = Lay<64, 128>;
    int tid_ = wv * 64 + lane_id(); asm volatile("" : "+v"(tid_));
    const int tid = tid_, wid = tid >> 6, lane = tid & 63, r32 = lane & 31, hi = lane >> 5;
    const bf16_t* kv = PROJ + (size_t)b * SEQ * D_IN; const size_t qrow = (size_t)b * SEQ + qb * 256;
    unsigned* stash = (unsigned*)(lds + L::OFF_STASH) + wid * 2048 + lane;
    f32x16 o[4]; float rli[16];
#pragma unroll 1
    for (int c = 0; c < 2; ++c) {
        attn_pass<64, 128, D_IN, D_IN, D_IN>(PROJ + qrow * D_IN + C_AQ + h * 128 + c * 64, kv + C_AK + h * 128 + c * 64, kv + C_AV + h * 128, SEQ, lds, o, rli, wv);
        if (c == 0) {
#pragma unroll
            for (int d0 = 0; d0 < 4; ++d0)
#pragma unroll
                for (int r = 0; r < 16; r += 2) stash[(d0 * 8 + (r >> 1)) * 64] = cvt_pk_bf16(o[d0][r] * rli[r], o[d0][r + 1] * rli[r + 1]);
        }
    }
    asm volatile("s_waitcnt lgkmcnt(0)" ::: "memory");
    float ss[16];
#pragma unroll
    for (int r = 0; r < 16; ++r) ss[r] = 0.f;
#pragma unroll
    for (int d0 = 0; d0 < 4; ++d0)
#pragma unroll
        for (int r = 0; r < 16; r += 2) { const unsigned w = stash[(d0 * 8 + (r >> 1)) * 64];
            const float c0 = __uint_as_float(w << 16) - lam * o[d0][r] * rli[r], c1 = __uint_as_float(w & 0xffff0000u) - lam * o[d0][r + 1] * rli[r + 1];
            o[d0][r] = c0; o[d0][r + 1] = c1; ss[r] += c0 * c0; ss[r + 1] += c1 * c1; }
#pragma unroll
    for (int r = 0; r < 16; ++r) { float s = ss[r]; s += __shfl_xor(s, 1); s += __shfl_xor(s, 2); s += __shfl_xor(s, 4); s += __shfl_xor(s, 8); s += __shfl_xor(s, 16);
        ss[r] = rsqrtf(s * (1.f / 128.f) + EPS) * (1.f - lam_init); }
    bf16_t* Ow = OBR + (qrow + wid * QBLK) * OBR_W + h * 128;
#pragma unroll
    for (int d0 = 0; d0 < 4; ++d0) { const float g = subg[d0 * 32 + r32];
#pragma unroll
        for (int r = 0; r < 16; ++r) Ow[(size_t)crow(r, hi) * OBR_W + d0 * 32 + r32] = f2bf(o[d0][r] * ss[r] * g); }
}
__device__ __forceinline__ void unit_b(const bf16_t* PROJ, bf16_t* OBR, int b, int qh, int qb, char* lds, int wv) {
    const bf16_t* kv = PROJ + (size_t)b * SEQ * D_IN; const size_t qrow = (size_t)b * SEQ + qb * 256;
    f32x16 o[2]; float rli[16];
    attn_pass<64, 64, D_IN, D_IN, D_IN>(PROJ + qrow * D_IN + C_BQ + qh * 64, kv + C_BK + (qh >> 2) * 64, kv + C_BV + (qh >> 2) * 64, SEQ, lds, o, rli, wv);
    store_o<64, OBR_W>(OBR + qrow * OBR_W + 512 + qh * 64, o, rli, wv);
}
__device__ __forceinline__ void unit_c(const bf16_t* PROJ, const bf16_t* MEMKV, bf16_t* OBR, int b, int h, int qb, char* lds, int wv) {
    const bf16_t* kv = MEMKV + (size_t)b * MEM_LEN * 1024; const size_t qrow = (size_t)b * SEQ + qb * 256;
    f32x16 o[4]; float rli[16];
    attn_pass<128, 128, D_IN, 1024, 1024>(PROJ + qrow * D_IN + C_CQ + h * 128, kv + h * 128, kv + 512 + h * 128, MEM_LEN, lds, o, rli, wv);
    store_o<128, OBR_W>(OBR + qrow * OBR_W + 1024 + h * 128, o, rli, wv);
}
#undef ATT_SBAR
}

template <int NR>
__device__ __forceinline__ void rows_rmsnorm(const float* __restrict__ xbase, const float* __restrict__ g, bf16_t* __restrict__ obase, int row0, int lane) {
    f32x4 v[NR][4];
#pragma unroll
    for (int r = 0; r < NR; ++r)
#pragma unroll
        for (int j = 0; j < 4; ++j) v[r][j] = ((const f32x4*)(xbase + (size_t)(row0 + r) * DM))[lane + 64 * j];
    f32x4 gg[4];
#pragma unroll
    for (int j = 0; j < 4; ++j) gg[j] = ((const f32x4*)g)[lane + 64 * j];
#pragma unroll
    for (int r = 0; r < NR; ++r) { float s = 0.f;
#pragma unroll
        for (int j = 0; j < 4; ++j) s += v[r][j].x * v[r][j].x + v[r][j].y * v[r][j].y + v[r][j].z * v[r][j].z + v[r][j].w * v[r][j].w;
        const float rs = rsqrtf(wave_sum(s) * (1.f / DM) + EPS);
#pragma unroll
        for (int j = 0; j < 4; ++j) { u32x2 o; o.x = cvt_pk_bf16(v[r][j].x * rs * gg[j].x, v[r][j].y * rs * gg[j].y); o.y = cvt_pk_bf16(v[r][j].z * rs * gg[j].z, v[r][j].w * rs * gg[j].w);
            ((u32x2*)(obase + (size_t)(row0 + r) * DM))[lane + 64 * j] = o; } }
}
__device__ __forceinline__ void route_block(const bf16_t* __restrict__ X, const bf16_t* __restrict__ rt_tab, const float* __restrict__ brg, const float* __restrict__ bre, int* __restrict__ experts, float* __restrict__ weights,
                                            int* __restrict__ rank, unsigned* __restrict__ cnt, float* __restrict__ rstd, int* __restrict__ list, const float* __restrict__ g2, bf16_t* __restrict__ H2, int rb, const bf16x8 (&Bh)[3][4], const bf16x8 (&Bl)[3][4], LAS float* slab, int tid, int wave) {
    const int lane = tid & 63, r = lane & 15, kq = lane >> 4;
    LAS float* ssq = slab + 8 * 64 * 48; LAS float* rs_l = ssq + 8 * 64;
#pragma unroll 1
    for (int rtp = 0; rtp < 2; ++rtp) {
        bf16x8 xa[2][4];
#pragma unroll
        for (int q = 0; q < 2; ++q) { const bf16_t* xp = X + (size_t)(rb * 64 + (rtp * 2 + q) * 16 + r) * XP + 128 * wave + 8 * kq;
#pragma unroll
            for (int sI = 0; sI < 4; ++sI) xa[q][sI] = *(const bf16x8*)(xp + 32 * sI); }
#pragma unroll
        for (int q = 0; q < 2; ++q) { const int rt = rtp * 2 + q;
            f32x4 acc[3]; float ss = 0.f;
#pragma unroll
            for (int t = 0; t < 3; ++t) acc[t] = (f32x4){0.f, 0.f, 0.f, 0.f};
#pragma unroll
            for (int sI = 0; sI < 4; ++sI) {
                const bf16x8 Ah = xa[q][sI]; f32x4 a0, a1; pg8::unpack8(__builtin_bit_cast(u32x4, Ah), a0, a1);
                ss += (a0[0] * a0[0] + a0[1] * a0[1]) + (a0[2] * a0[2] + a0[3] * a0[3]) + (a1[0] * a1[0] + a1[1] * a1[1]) + (a1[2] * a1[2] + a1[3] * a1[3]);
#pragma unroll
                for (int t = 0; t < 3; ++t) {
                    acc[t] = __builtin_amdgcn_mfma_f32_16x16x32_bf16(Ah, Bh[t][sI], acc[t], 0, 0, 0);
                    acc[t] = __builtin_amdgcn_mfma_f32_16x16x32_bf16(Ah, Bl[t][sI], acc[t], 0, 0, 0);
                }
            }
            ss += __shfl_xor(ss, 16); ss += __shfl_xor(ss, 32);
            if (kq == 0) ssq[wave * 64 + rt * 16 + r] = ss;
#pragma unroll
            for (int t = 0; t < 3; ++t)
#pragma unroll
                for (int e = 0; e < 4; ++e) slab[(wave * 64 + rt * 16 + 4 * kq + e) * 48 + 16 * t + r] = acc[t][e];
        }
    }
    __syncthreads();
    if (tid < 64) {
        const int row = rb * 64 + tid;
        float lg[36]; float ss = 0.f;
#pragma unroll
        for (int c = 0; c < 36; ++c) lg[c] = 0.f;
#pragma unroll 1
        for (int w = 0; w < 8; ++w) { ss += ssq[w * 64 + tid];
#pragma unroll
            for (int c = 0; c < 36; ++c) lg[c] += slab[(w * 64 + tid) * 48 + c]; }
        const float rs = rsqrtf(ss * (1.f / DM) + EPS);
        rstd[row] = rs;
        int gi = 0; float gm = lg[0] * rs + brg[0];
#pragma unroll
        for (int i = 1; i < 4; ++i) { const float l = lg[i] * rs + brg[i]; if (l > gm) { gm = l; gi = i; } }
        float gs = 0.f;
#pragma unroll
        for (int i = 0; i < 4; ++i) gs += __expf(lg[i] * rs + brg[i] - gm);
        const float gp = 1.f / gs;
        float el[8];
#pragma unroll
        for (int i = 0; i < 8; ++i) el[i] = 0.f;
#pragma unroll
        for (int gq = 0; gq < 4; ++gq) if (gq == gi) {
#pragma unroll
            for (int i = 0; i < 8; ++i) el[i] = lg[4 + gq * 8 + i] * rs + bre[gq * 8 + i]; }
        int i0 = 0; float l0 = el[0];
#pragma unroll
        for (int i = 1; i < 8; ++i) if (el[i] > l0) { l0 = el[i]; i0 = i; }
        int i1 = -1; float l1 = -INFINITY;
#pragma unroll
        for (int i = 0; i < 8; ++i) if (i != i0 && el[i] > l1) { l1 = el[i]; i1 = i; }
        const float p1 = __expf(l1 - l0), inv = 1.f / (1.f + p1);
        const int e0 = gi * 8 + i0, e1 = gi * 8 + i1;
        experts[row * 2] = e0; experts[row * 2 + 1] = e1;
        weights[row * 2] = gp * inv; weights[row * 2 + 1] = gp * p1 * inv;
        LAS unsigned* lc = (LAS unsigned*)(rs_l + 64); LAS unsigned* gb = lc + 32;
        if (tid < 32) lc[tid] = 0u;
        asm volatile("s_waitcnt lgkmcnt(0)" ::: "memory");
        unsigned q0, q1; const unsigned one = 1u, a0_ = (unsigned)(uintptr_t)(lc + e0), a1_ = (unsigned)(uintptr_t)(lc + e1);
        asm volatile("ds_add_rtn_u32 %0, %1, %2\n\ts_waitcnt lgkmcnt(0)" : "=v"(q0) : "v"(a0_), "v"(one) : "memory");
        asm volatile("ds_add_rtn_u32 %0, %1, %2\n\ts_waitcnt lgkmcnt(0)" : "=v"(q1) : "v"(a1_), "v"(one) : "memory");
        if (tid < 32) { const unsigned n = lc[tid]; gb[tid] = n ? atomicAdd(cnt + 64 * tid, n) : 0u; }
        const int r0 = (int)(gb[e0] + q0), r1 = (int)(gb[e1] + q1);
        rank[row * 2] = r0; rank[row * 2 + 1] = r1;
        list[e0 * LCAP + r0] = row * 2; list[e1 * LCAP + r1] = row * 2 + 1;
        rs_l[tid] = rs;
    }
    __syncthreads();
#pragma unroll 1
    for (int rr = 0; rr < 8; rr += 4) {
        u32x2 v[4][4];
#pragma unroll
        for (int r4 = 0; r4 < 4; ++r4)
#pragma unroll
            for (int j = 0; j < 4; ++j) v[r4][j] = ((const u32x2*)(X + (size_t)(rb * 64 + wave * 8 + rr + r4) * XP))[lane + 64 * j];
#pragma unroll
        for (int r4 = 0; r4 < 4; ++r4) { const float rs = rs_l[wave * 8 + rr + r4]; u32x2* dst = (u32x2*)(H2 + (size_t)(rb * 64 + wave * 8 + rr + r4) * DM);
#pragma unroll
            for (int j = 0; j < 4; ++j) { const f32x4 gg = ((const f32x4*)g2)[lane + 64 * j]; const u32x2 w = v[r4][j];
                u32x2 o; o.x = cvt_pk_bf16(__uint_as_float(w.x << 16) * rs * gg.x, __uint_as_float(w.x & 0xffff0000u) * rs * gg.y); o.y = cvt_pk_bf16(__uint_as_float(w.y << 16) * rs * gg.z, __uint_as_float(w.y & 0xffff0000u) * rs * gg.w); dst[lane + 64 * j] = o; } }
    }
    __syncthreads();
}
__device__ __forceinline__ void moe_tables(const unsigned* cnt, volatile LAS int* mt, int tid) {
    if (tid == 0) { int off = 0, nt = 0;
#pragma unroll 1
        for (int e = 0; e < NEXP; ++e) { const int c = (int)__hip_atomic_load(cnt + 64 * e, __ATOMIC_RELAXED, __HIP_MEMORY_SCOPE_AGENT), t = (c + MOE_TILE - 1) / MOE_TILE;
            mt[e] = off; mt[32 + e] = c; mt[64 + e] = nt;
#pragma unroll 1
            for (int i = 0; i < t; ++i) mt[96 + nt + i] = e;
            nt += t; off += t * MOE_TILE; }
        mt[256] = nt; }
    __syncthreads();
}
__device__ __forceinline__ void moe_rowtabs(volatile LAS int* mt, const int* __restrict__ list, const float* __restrict__ weights, LAS unsigned* rowtab, LAS float* wtab, int bx, int G, int tid, int up) {
    const int ntiles = mt[256], rem = (ntiles * 4) % G;
#pragma unroll 1
    for (int i = 0; i < 4; ++i) { const long L = up ? (long)i * G + bx : (long)pg8::moe_down_unit(bx, i, rem, G); if (L >= (long)ntiles * 4) break;
        if (tid < 256) { const int tile = (int)(L >> 2), e = mt[96 + tile], q = (tile - mt[64 + e]) * 256 + tid; const bool valid = q < mt[32 + e];
            const int a = valid ? list[e * LCAP + q] : 0;
            if (up) rowtab[i * 256 + tid] = (unsigned)(a >> 1) * (unsigned)(DM * 2); else wtab[i * 256 + tid] = valid ? weights[a] : 0.f; } }
    __syncthreads();
}
template <int NR>
__device__ __forceinline__ void rows_combine_norm(bf16_t* __restrict__ XB, const bf16_t* __restrict__ YB, const float* __restrict__ g, bf16_t* __restrict__ H, float* __restrict__ OUT, const int (&row)[NR], int lane, bool poison, const int (&d0)[NR], const int (&d1)[NR]) {
    u32x2 xq[NR][4], ya[NR][4], yb[NR][4];
#pragma unroll
    for (int r = 0; r < NR; ++r)
#pragma unroll
        for (int j = 0; j < 4; ++j) { xq[r][j] = ((const u32x2*)(XB + (size_t)row[r] * XP))[lane + 64 * j];
            ya[r][j] = ((const u32x2*)(YB + (size_t)d0[r] * DM))[lane + 64 * j]; yb[r][j] = ((const u32x2*)(YB + (size_t)d1[r] * DM))[lane + 64 * j]; }
    f32x4 gg[4];
#pragma unroll
    for (int j = 0; j < 4; ++j) gg[j] = ((const f32x4*)g)[lane + 64 * j];
    f32x4 v[NR][4]; float s[NR];
#pragma unroll
    for (int r = 0; r < NR; ++r) { s[r] = 0.f;
#pragma unroll
        for (int j = 0; j < 4; ++j) { const u32x2 x = xq[r][j], a = ya[r][j], b = yb[r][j];
            v[r][j].x = __uint_as_float(x.x << 16) + __uint_as_float(a.x << 16) + __uint_as_float(b.x << 16); v[r][j].y = __uint_as_float(x.x & 0xffff0000u) + __uint_as_float(a.x & 0xffff0000u) + __uint_as_float(b.x & 0xffff0000u);
            v[r][j].z = __uint_as_float(x.y << 16) + __uint_as_float(a.y << 16) + __uint_as_float(b.y << 16); v[r][j].w = __uint_as_float(x.y & 0xffff0000u) + __uint_as_float(a.y & 0xffff0000u) + __uint_as_float(b.y & 0xffff0000u);
            s[r] += v[r][j].x * v[r][j].x + v[r][j].y * v[r][j].y + v[r][j].z * v[r][j].z + v[r][j].w * v[r][j].w; } }
#pragma unroll
    for (int r = 0; r < NR; ++r) {
        float rs = rsqrtf(wave_sum(s[r]) * (1.f / DM) + EPS);
        if (poison) rs = __builtin_nanf("");
#pragma unroll
        for (int j = 0; j < 4; ++j) {
            if (H) { u32x2 xo; xo.x = cvt_pk_bf16(v[r][j].x, v[r][j].y); xo.y = cvt_pk_bf16(v[r][j].z, v[r][j].w); ((u32x2*)(XB + (size_t)row[r] * XP))[lane + 64 * j] = xo;
                u32x2 o; o.x = cvt_pk_bf16(v[r][j].x * rs * gg[j].x, v[r][j].y * rs * gg[j].y); o.y = cvt_pk_bf16(v[r][j].z * rs * gg[j].z, v[r][j].w * rs * gg[j].w);
                ((u32x2*)(H + (size_t)row[r] * DM))[lane + 64 * j] = o; }
            else { f32x4 o; o.x = v[r][j].x * rs * gg[j].x; o.y = v[r][j].y * rs * gg[j].y; o.z = v[r][j].z * rs * gg[j].z; o.w = v[r][j].w * rs * gg[j].w; ((f32x4*)(OUT + (size_t)row[r] * DM))[lane + 64 * j] = o; }
        }
    }
}
struct TrItem { const float* src; bf16_t* dst; int ldw, K; };
template <int OFF> __device__ __forceinline__ unsigned long long karg64() { unsigned long long v; asm volatile("s_load_dwordx2 %0, %1, %2\n\ts_waitcnt lgkmcnt(0)" : "=s"(v) : "s"(__builtin_amdgcn_kernarg_segment_ptr()), "n"(OFF)); return v; }
__device__ __forceinline__ unsigned long long karg64d(int off) { unsigned long long v; asm volatile("s_load_dwordx2 %0, %1, %2\n\ts_waitcnt lgkmcnt(0)" : "=s"(v) : "s"(__builtin_amdgcn_kernarg_segment_ptr()), "s"(off)); return v; }
#define TR_IN(k) ((const float*)(const GAS float*)karg64d(8 * (k)))
__device__ __forceinline__ void tr_decode(int it, int lane, bf16_t* WB, const float*& sp, int& ldw, bf16_t*& dp, int& K) {
    const float* src; int segA, segB, kb, tb, dk0 = 0; bf16_t* dst;
    if (it < 28800) {
        const int l = it / 14400; int r = it % 14400; bf16_t* WBl = WB + (size_t)l * WB_LAYER;
        if (r < 1472) { kb = r / 92; tb = r % 92; const int pn = tb >> 2, bj = (tb >> 1) & 1, w0 = 2 * (tb & 1); src = TR_IN(5) + (size_t)l * DM * D_IN; ldw = D_IN; K = DM; segA = 256 * pn + 64 * w0 + 32 * bj; segB = segA + 64; dst = WBl + WB_IN; }
        else if (r < 1856) { r -= 1472; const int i = r >> 7; r &= 127; kb = r >> 4; tb = r & 15; src = TR_IN(13 + i) + (size_t)l * 512 * DM; ldw = DM; K = 512; segA = 64 * tb; segB = segA + 32; dst = WBl + WB_UP + (size_t)i * 1024 * 512; }
        else if (r < 2112) { r -= 1856; kb = r >> 4; tb = r & 15; src = TR_IN(16) + (size_t)l * DM * DM; ldw = DM; K = DM; segA = 64 * tb; segB = segA + 32; dst = WBl + WB_OUT; }
        else if (r < 10304) { r -= 2112; const int e = r >> 8; r &= 255; kb = r >> 4; tb = r & 15; const int pn = tb >> 2, sg = (tb >> 1) & 1, jb = tb & 1;
            src = TR_IN(sg ? 23 : 22) + (size_t)(l * NEXP + e) * DM * DEXP; ldw = DEXP; K = DM; segA = 128 * pn + 64 * jb; segB = segA + 32; dst = WBl + WB_GU + (size_t)e * 1024 * 1024; }
        else { r -= 10304; const int e = r >> 7; r &= 127; kb = r >> 4; tb = r & 15; src = TR_IN(24) + (size_t)(l * NEXP + e) * DEXP * DM; ldw = DM; K = DEXP; segA = 64 * tb; segB = segA + 32; dst = WBl + WB_DN + (size_t)e * 1024 * 512; }
    } else { const int r = it - 28800; kb = r >> 4; tb = r & 15; const int pn = tb >> 2, bj = (tb >> 1) & 1, w0 = 2 * (tb & 1); src = TR_IN(3); ldw = 1024; K = DM; segA = 256 * pn + 64 * w0 + 32 * bj; segB = segA + 64; dst = WB + WB_MEMKV; }
    const int q = lane & 15;
    sp = src + (size_t)(kb * 64 + (lane >> 4)) * ldw + (q < 8 ? segA + 4 * q : segB + 4 * (q - 8));
    dp = dst + (size_t)(64 * tb + (lane >> 3)) * K + dk0 + kb * 64 + 8 * (lane & 7);
}
__device__ __forceinline__ void tr_load(f32x4 (&v)[16], const float* sp, int ldw) {
#pragma unroll
    for (int i = 0; i < 16; ++i) v[i] = *(const f32x4*)(sp + (size_t)(4 * i) * ldw);
}
__device__ __forceinline__ void tr_store(const f32x4 (&v)[16], bf16_t* dp, int K, LAS float* scr, int lane) {
    const int q = lane & 15, kq = lane >> 4;
#pragma unroll
    for (int i = 0; i < 16; ++i) { LAS float* w = scr + (4 * i + kq) * 65 + 4 * q; w[0] = v[i][0]; w[1] = v[i][1]; w[2] = v[i][2]; w[3] = v[i][3]; }
    asm volatile("s_waitcnt lgkmcnt(0)" ::: "memory");
    const int c = lane & 7, n8 = lane >> 3;
#pragma unroll
    for (int j = 0; j < 8; ++j) { const LAS float* sI = scr + (8 * c) * 65 + n8 + 8 * j;
        u32x4 o; o.x = cvt_pk_bf16(sI[0 * 65], sI[1 * 65]); o.y = cvt_pk_bf16(sI[2 * 65], sI[3 * 65]); o.z = cvt_pk_bf16(sI[4 * 65], sI[5 * 65]); o.w = cvt_pk_bf16(sI[6 * 65], sI[7 * 65]);
        *(u32x4*)(dp + (size_t)(8 * j) * K) = o; }
    asm volatile("s_waitcnt lgkmcnt(0)" ::: "memory");
}

#define XB_TMO      128
#define XB_XCNT(j)  (256  + 64 * (j))
#define XB_XSUB(j)  (1280 + 64 * (j))
#define XB_XGEN(j)  (2304 + 64 * (j))
#define XB_TOP      3328
#define XB_TOPGEN   3392
#define XCD_BAR_WORDS 3456
#define XB_SPIN_CAP (1u << 18)

__device__ __forceinline__ unsigned xb_ld(unsigned* p)              { return __hip_atomic_load(p, __ATOMIC_RELAXED, __HIP_MEMORY_SCOPE_AGENT); }
__device__ __forceinline__ unsigned xb_add(unsigned* p, unsigned v) { return __hip_atomic_fetch_add(p, v, __ATOMIC_RELAXED, __HIP_MEMORY_SCOPE_AGENT); }
__device__ __forceinline__ unsigned xb_xcc_id() { return (unsigned)__builtin_amdgcn_s_getreg((3 << 11) | 20) & 0xFu; }
#define XB_SPIN(cond, bar) do { unsigned _sp = 0; while (cond) { __builtin_amdgcn_s_sleep(1); \
    if ((++_sp & 255u) == 0u) { if (xb_ld(&(bar)[XB_TMO])) break; if (_sp > XB_SPIN_CAP) { atomicAdd(&(bar)[XB_TMO], 1u); break; } } } } while (0)

struct XcdBarrier {
    unsigned* bar; unsigned x; unsigned w0;
    volatile LAS unsigned* st;
};

__device__ __forceinline__ XcdBarrier xcd_barrier_post(unsigned* bar, volatile LAS unsigned* st, unsigned is_wave0) {
    XcdBarrier b; b.bar = bar; b.x = xb_xcc_id(); b.st = st; b.w0 = is_wave0;
    if (is_wave0 && lane_id() == 0) (void)xb_add(&bar[XB_XCNT(b.x)], 1u);
    return b;
}
__device__ __forceinline__ void xcd_barrier_complete(unsigned* bar, unsigned x, unsigned& nloc, unsigned& nx) {
    const unsigned G = gridDim.x * gridDim.y * gridDim.z;
    unsigned sum, cnt, mine, sp = 0u;
    for (;;) {
        sum = 0u; cnt = 0u; mine = 0u;
#pragma unroll
        for (unsigned j = 0; j < 16; ++j) { const unsigned c = xb_ld(&bar[XB_XCNT(j)]); sum += c; cnt += (c > 0u) ? 1u : 0u; mine = (j == x) ? c : mine; }
        if (sum == G) break;
        __builtin_amdgcn_s_sleep(1);
        if ((++sp & 255u) == 0u) { if (xb_ld(&bar[XB_TMO])) break; if (sp > XB_SPIN_CAP) { atomicAdd(&bar[XB_TMO], 1u); break; } }
    }
    nloc = mine > 0u ? mine : 1u; nx = cnt > 0u ? cnt : 1u;
}

__device__ __forceinline__ void xcd_barrier(const XcdBarrier& b) {
    asm volatile("s_waitcnt vmcnt(0)" ::: "memory");
    __syncthreads();
    if (b.w0 && lane_id() == 0) {
        unsigned* bar = b.bar;
        __builtin_amdgcn_s_waitcnt(0);
        unsigned nloc = b.st[0], nx = b.st[1];
        if (nloc == 0u) { xcd_barrier_complete(bar, b.x, nloc, nx); b.st[0] = nloc; b.st[1] = nx; }
        const unsigned old = xb_add(&bar[XB_XSUB(b.x)], 1u);
        const unsigned gen = old / nloc;
        if (old + 1u == (gen + 1u) * nloc) {
            __builtin_amdgcn_fence(__ATOMIC_RELEASE, "agent");
            asm volatile("s_waitcnt vmcnt(0)" ::: "memory");
            const unsigned og = xb_add(&bar[XB_TOP], 1u);
            const unsigned tg = og / nx;
            if (og + 1u == (tg + 1u) * nx) xb_add(&bar[XB_TOPGEN], 1u);
            else XB_SPIN(xb_ld(&bar[XB_TOPGEN]) == tg, bar);
            __builtin_amdgcn_fence(__ATOMIC_ACQUIRE, "agent");
            xb_add(&bar[XB_XGEN(b.x)], 1u);
            asm volatile("s_waitcnt vmcnt(0)" ::: "memory");
        } else {
            XB_SPIN(xb_ld(&bar[XB_XGEN(b.x)]) == gen, bar);
            __builtin_amdgcn_fence(__ATOMIC_ACQUIRE, "agent");
            asm volatile("s_waitcnt vmcnt(0)" ::: "memory");
        }
    }
    __syncthreads();
}
constexpr int NWAVES = 8;
constexpr int RING_BYTES = 131072, LDSCTL_OFF = 135168, LDS_BYTES = 147456;
constexpr int CW_BAR = 4096, BAR_REGION = 4096;
static_assert(XCD_BAR_WORDS <= BAR_REGION && (CW_BAR + (N_PHASES + 1) * BAR_REGION) * 4 <= (int)MiB, "barrier regions inside the memset region");
static_assert(pg8::STAGE_BYTES <= RING_BYTES && att::Lay<64, 128>::OFF_STASH + 65536 <= RING_BYTES && att::Lay<128, 128>::OFF_WS + 2048 <= RING_BYTES, "LDS map");

struct Args { const float* in[26]; float* out; unsigned char* ws; int ph_lo, ph_hi, li, pad; };
#define KIN(k) ((const float*)(const GAS float*)karg64<8 * (k)>())
#define KOUT ((float*)(GAS float*)karg64<208>())
#define KWS ((unsigned char*)(GAS unsigned char*)karg64<216>())
static_assert(offsetof(Args, out) == 208 && offsetof(Args, ws) == 216 && offsetof(Args, ph_lo) == 224, "Args layout vs the kernarg offsets above");

__global__ void __launch_bounds__(NWAVES * 64, 2) mk_fwd(Args args) {
    extern __shared__ __attribute__((aligned(16))) unsigned char lds[];
    const int wave = __builtin_amdgcn_readfirstlane((int)threadIdx.x >> 6);
#define lane0 lane_id()
#define tid0 (wave * 64 + lane_id())
    const int G = gridDim.x, bx = blockIdx.x, vcu = (G % 8 == 0) ? (bx % 8) * (G / 8) + bx / 8 : bx;
    LAS unsigned char* ldsl = (LAS unsigned char*)lds;
    volatile LAS unsigned* MISC = (volatile LAS unsigned*)(ldsl + LDSCTL_OFF);
    for (int u = tid0; u < (LDS_BYTES - LDSCTL_OFF) / 4; u += NWAVES * 64) ((LAS unsigned*)(ldsl + LDSCTL_OFF))[u] = 0u;
    __syncthreads();
    XcdBarrier bar = xcd_barrier_post((unsigned*)(KWS + WS_CTL) + CW_BAR + args.li * BAR_REGION, MISC + 8, wave == 0 ? 1u : 0u);
#define P_WS unsigned char* ws = KWS; unsigned* ctl = (unsigned*)(ws + WS_CTL); (void)ctl
#define P_ACT bf16_t* MEMKV = (bf16_t*)(ws + WS_MEMKV); bf16_t* HM = (bf16_t*)(ws + WS_HM); bf16_t* PROJ = (bf16_t*)(ws + WS_PROJ); bf16_t* OBR = (bf16_t*)(ws + WS_OBR); bf16_t* HMEM = OBR; \
    bf16_t* BUF = (bf16_t*)(ws + WS_BUF); bf16_t* YB = (bf16_t*)(ws + WS_YB); bf16_t* HID = (bf16_t*)(ws + WS_HID); bf16_t* WB = (bf16_t*)(ws + WS_WB); const bf16_t* WBl = WB + (size_t)l_ * WB_LAYER; \
    (void)MEMKV; (void)HM; (void)PROJ; (void)OBR; (void)HMEM; (void)BUF; (void)YB; (void)HID; (void)WBl
#define P_ROUTE int* experts = (int*)(ws + WS_ROUTE + RT_EXP); float* weights = (float*)(ws + WS_ROUTE + RT_WGT); int* rank = (int*)(ws + WS_ROUTE + RT_RANK); float* rstd = (float*)(ws + WS_ROUTE + RT_RSTD); \
    (void)experts; (void)weights; (void)rank; (void)rstd
    const int gw = bx * NWAVES + wave, NGW = G * NWAVES;
    const int lo = args.ph_lo, hi = args.ph_hi;
#ifndef STAGE_MASK
#define STAGE_MASK 0x3FFu
#endif
#define IN(k) (lo <= (k) && (k) < hi)
#define ST(s) ((STAGE_MASK >> (s)) & 1u)
#ifndef REP_MASK
#define REP_MASK 0u
#endif
#define NREP(s) (((REP_MASK >> (s)) & 1u) ? 2 : 1)
#ifndef DBL_BAR
#define DBL_BAR 0
#endif
#define SEAM(k) do { if (IN(k) && IN((k) + 1)) { xcd_barrier(bar); if (DBL_BAR) xcd_barrier(bar); } } while (0)

    if (ST(0) && IN(0))
  for (int rep_ = 0; rep_ < NREP(0); ++rep_) {
        int lane = lane0, tid = tid0; asm volatile("" : "+v"(lane), "+v"(tid));
        constexpr int l_ = 0; P_WS; P_ACT;
        float* tab1 = (float*)(ws + WS_TAB); float* tab2 = tab1 + SEQ * 32 * 2;
        const float* x = KIN(0); const float* mem = KIN(1); const float* mem_g = KIN(2); const float* norm1_g = KIN(4); const float* norm2_g = KIN(17); const float* w_rg = KIN(18); const float* w_re = KIN(20);
        LAS float* scr = (LAS float*)(ldsl + wave * 16640);
        {   constexpr int NITEMS = 29056;
            f32x4 cur[16], nxt[16]; const float* sp; bf16_t* dp; int ldw, K; const float* sp2; bf16_t* dp2; int ldw2, K2;
            int it = gw;
            if (it < NITEMS) { tr_decode(it, lane, WB, sp, ldw, dp, K); tr_load(cur, sp, ldw); }
            for (; it < NITEMS; it += NGW) {
                const bool more = it + NGW < NITEMS;
                if (more) { tr_decode(it + NGW, lane, WB, sp2, ldw2, dp2, K2); tr_load(nxt, sp2, ldw2); }
                tr_store(cur, dp, K, scr, lane);
                if (more) {
#pragma unroll
                    for (int i = 0; i < 16; ++i) cur[i] = nxt[i];
                    dp = dp2; K = K2; }
            }
        }
        for (int idx = bx * (NWAVES * 64) + tid; idx < SEQ * 32; idx += G * NWAVES * 64) { const int pos = idx >> 5, i = idx & 31; float s, c;
            sincosf((float)pos * inv1d(i), &s, &c); tab1[idx * 2] = c; tab1[idx * 2 + 1] = s;
            sincosf(ang2d(pos, i), &s, &c); tab2[idx * 2] = c; tab2[idx * 2 + 1] = s; }
        for (int idx = bx * (NWAVES * 64) + tid; idx < DEPTH * 48 * 1024; idx += G * NWAVES * 64) { const int l = idx / (48 * 1024), c = (idx >> 10) % 48, k = idx & 1023;
            const float w = c < 4 ? w_rg[((size_t)l * DM + k) * 4 + c] : c < 36 ? w_re[((size_t)l * DM + k) * 32 + (c - 4)] : 0.f, v = w * norm2_g[l * DM + k];
            const bf16_t h = f2bf(v); bf16_t* t = WB + WB_RT + (size_t)l * 2 * 48 * 1024 + (size_t)c * 1024 + k; t[0] = h; t[48 * 1024] = f2bf(v - bf2f(h)); }
        for (int m = 4 * gw; m < M; m += 4 * NGW) rows_rmsnorm<4>(x, norm1_g, HM, m, lane);
        for (int m = gw; m < MM; m += NGW) rows_rmsnorm<1>(mem, mem_g, HMEM, m, lane);
    }
    SEAM(0);
#pragma unroll 1
    for (int l = 0; l < DEPTH; ++l) {
        const int pb = 1 + 9 * l, l_ = l;
        if (ST(1) && IN(pb + 0))
      for (int rep_ = 0; rep_ < NREP(1); ++rep_) {
            P_WS; P_ACT; float* tab1 = (float*)(ws + WS_TAB); float* tab2 = tab1 + SEQ * 32 * 2; const float* qn_g = KIN(11); const float* kn_g = KIN(12);
            pg8::Gemm g{DM, DM};
            pg8::SchedProj S{bx, G, 1472, l == 0 ? 1504 : 1472, (const char*)HM, (const char*)(WBl + WB_IN), (const char*)HMEM, (const char*)(WB + WB_MEMKV)};
            pg8::EpiProj E{PROJ, MEMKV, tab1, tab2, qn_g + l * 64, kn_g + l * 64};
            pg8::gemm_phase<pg8::EpiProj, pg8::SchedProj, true, true>(ldsl, g, S, E, wave);
        }
        SEAM(pb + 0);
        if (ST(2) && IN(pb + 1))
      for (int rep_ = 0; rep_ < NREP(2); ++rep_) {
            int lane = lane0; asm volatile("" : "+v"(lane));
            P_WS; P_ACT; const float* lq1 = KIN(6); const float* lk1 = KIN(7); const float* lq2 = KIN(8); const float* lk2 = KIN(9); const float* subln_g = KIN(10);
            const float lam_init = 0.8f - 0.6f * __expf(-0.3f * (float)l);
            const float lam = __expf(wave_sum(lq1[l * 64 + lane] * lk1[l * 64 + lane])) - __expf(wave_sum(lq2[l * 64 + lane] * lk2[l * 64 + lane])) + lam_init;
            for (int j = vcu; j < 256; j += G) {
#ifndef ATT_SKIP_A
                att::unit_a(PROJ, OBR, j >> 5, (j >> 3) & 3, j & 7, lam, lam_init, subln_g + l * 128, (char*)lds, wave);
#endif
#ifndef ATT_SKIP_B
#pragma unroll 1
                for (int t = 0; t < 2; ++t) { const int idx = 2 * j + t; att::unit_b(PROJ, OBR, idx >> 6, (idx >> 3) & 7, idx & 7, (char*)lds, wave); }
#endif
#ifndef ATT_SKIP_C
                att::unit_c(PROJ, MEMKV, OBR, j >> 5, (j >> 3) & 3, j & 7, (char*)lds, wave);
#endif
            }
            __syncthreads();
        }
        SEAM(pb + 1);
        if (ST(3) && IN(pb + 2))
      for (int rep_ = 0; rep_ < NREP(3); ++rep_) {
            P_WS; P_ACT;
            pg8::Gemm g{OBR_W, 512};
            pg8::SchedGate S{bx, G, (const char*)OBR, (const char*)(WBl + WB_UP)};
            pg8::EpiGate E{HM, PROJ};
            pg8::gemm_phase<pg8::EpiGate, pg8::SchedGate, true, true>(ldsl, g, S, E, wave);
        }
        SEAM(pb + 2);
        if (ST(4) && IN(pb + 3)) {
            P_WS; P_ACT; const float* x = KIN(0); bf16_t* XB = (bf16_t*)KOUT;
            pg8::Gemm g{DM, DM};
            pg8::SchedPlain S{bx, G, M / 256, (const char*)HM, (const char*)(WBl + WB_OUT), (size_t)256 * DM * 2, (size_t)256 * DM * 2};
            pg8::EpiResid E{x, XB, l == 0 ? 1 : 0};
            pg8::gemm_phase<pg8::EpiResid, pg8::SchedPlain, true, true>(ldsl, g, S, E, wave);
        }
        SEAM(pb + 3);
        if (ST(5) && IN(pb + 4)) {
            int tid = tid0; asm volatile("" : "+v"(tid));
            const int lane = tid & 63;
            P_WS; P_ACT; P_ROUTE; const bf16_t* X = (const bf16_t*)KOUT; const float* b_rg = KIN(19); const float* b_re = KIN(21); const float* norm2_g = KIN(17);
            const bf16_t* tab = WB + WB_RT + (size_t)l * 2 * 48 * 1024 + (size_t)(lane & 15) * 1024 + 128 * wave + 8 * (lane >> 4);
            bf16x8 Bh[3][4], Bl[3][4];
#pragma unroll
            for (int t = 0; t < 3; ++t)
#pragma unroll
                for (int sI = 0; sI < 4; ++sI) { Bh[t][sI] = *(const bf16x8*)(tab + (size_t)t * 16 * 1024 + 32 * sI); Bl[t][sI] = *(const bf16x8*)(tab + (size_t)(48 + t * 16) * 1024 + 32 * sI); }
            for (int rb = bx; rb < M / 64; rb += G)
                route_block(X, tab, b_rg + l * 4, b_re + l * 32, experts, weights, rank, ctl + CW_CNT + 2048 * l, rstd, (int*)BUF, norm2_g + l * DM, HM, rb, Bh, Bl, (LAS float*)ldsl, tid, wave);
        }
        SEAM(pb + 4);
        volatile LAS int* mt = (volatile LAS int*)(ldsl + LDSCTL_OFF + 256);
        LAS unsigned* rowtab = (LAS unsigned*)(ldsl + LDSCTL_OFF + 2048); LAS float* wtab = (LAS float*)(ldsl + LDSCTL_OFF + 6144);
        if (ST(7) && IN(pb + 6)) {
            int tid = tid0; asm volatile("" : "+v"(tid));
            P_WS; P_ACT; P_ROUTE;
            moe_tables(ctl + CW_CNT + 2048 * l, mt, tid);
            moe_rowtabs(mt, (const int*)BUF, weights, rowtab, wtab, vcu, G, tid, 1);
            const int ntiles = __builtin_amdgcn_readfirstlane(mt[256]);
            pg8::Gemm g{DM, DM};
            pg8::SchedMoeUp S{vcu, G, ntiles, (const LAS int*)(ldsl + LDSCTL_OFF + 256 + 96 * 4), (const char*)HM, (const char*)(WBl + WB_GU), ctl + CW_TCNT + l * 160 * 64};
            pg8::EpiSilu E{HID};
            pg8::gemm_phase<pg8::EpiSilu, pg8::SchedMoeUp, true, true, true>(ldsl, g, S, E, wave, rowtab);
        }
        if (ST(8) && IN(pb + 7)) {
            int tid = tid0; asm volatile("" : "+v"(tid));
            P_WS; P_ACT; P_ROUTE;
            if (!(ST(7) && IN(pb + 6))) moe_tables(ctl + CW_CNT + 2048 * l, mt, tid);
            moe_rowtabs(mt, (const int*)BUF, weights, rowtab, wtab, vcu, G, tid, 0);
            const int ntiles = __builtin_amdgcn_readfirstlane(mt[256]);
            pg8::Gemm g{DEXP, DEXP};
            pg8::SchedMoeDown S{vcu, G, ntiles, (ntiles * 4) % G, wave, (const LAS int*)(ldsl + LDSCTL_OFF + 256 + 96 * 4), (const char*)HID, (const char*)(WBl + WB_DN), ctl + CW_TCNT + l * 160 * 64, ctl + CW_TMO};
            pg8::EpiRowScale E{YB, wtab};
            pg8::gemm_phase<pg8::EpiRowScale, pg8::SchedMoeDown, true, true>(ldsl, g, S, E, wave);
        }
        SEAM(pb + 7);
        if (ST(9) && IN(pb + 8)) {
            int lane = lane0; asm volatile("" : "+v"(lane));
            P_WS; P_ACT; P_ROUTE; float* OUTP = KOUT; bf16_t* XB = (bf16_t*)OUTP; const float* norm1_g = KIN(4); const float* final_g = KIN(25);
            const bool last = (l == DEPTH - 1);
            const bool poison = last && ((__hip_atomic_load(ctl + CW_BAR + args.li * BAR_REGION + XB_TMO, __ATOMIC_RELAXED, __HIP_MEMORY_SCOPE_AGENT) | __hip_atomic_load(ctl + CW_TMO, __ATOMIC_RELAXED, __HIP_MEMORY_SCOPE_AGENT)) != 0u);
            if (!(ST(7) && IN(pb + 6)) && !(ST(8) && IN(pb + 7))) moe_tables(ctl + CW_CNT + 2048 * l, mt, tid0);
            static_assert(M % 4 == 0, "rows come in fours");
            for (int m = 4 * gw; m < M; m += 4 * NGW) {
                const u32x4 ex0 = *(const u32x4*)(experts + 2 * m), ex1 = *(const u32x4*)(experts + 2 * m + 4), rk0 = *(const u32x4*)(rank + 2 * m), rk1 = *(const u32x4*)(rank + 2 * m + 4);
                const int rows[4] = {m, m + 1, m + 2, m + 3};
                const int d0[4] = {mt[ex0.x] + (int)rk0.x, mt[ex0.z] + (int)rk0.z, mt[ex1.x] + (int)rk1.x, mt[ex1.z] + (int)rk1.z}, d1[4] = {mt[ex0.y] + (int)rk0.y, mt[ex0.w] + (int)rk0.w, mt[ex1.y] + (int)rk1.y, mt[ex1.w] + (int)rk1.w};
                rows_combine_norm<4>(XB, YB, last ? final_g : norm1_g + (l + 1) * DM, last ? nullptr : HM, OUTP, rows, lane, poison, d0, d1); }
        }
        SEAM(pb + 8);
    }
#undef IN
#undef SEAM
#undef lane0
#undef tid0
#undef P_WS
#undef P_ACT
#undef P_ROUTE
}

extern "C" void kernel_launch(void* const* d_in, const int* in_sizes, int n_in, void* d_out, int out_size, void* d_ws, size_t ws_size, hipStream_t stream) {
    if (n_in != 26 || in_sizes[0] != M * DM || out_size != M * DM || ws_size < WS_END) { fprintf(stderr, "kernel_launch: unexpected shapes n_in %d out %d ws %zu (need %zu)\n", n_in, out_size, ws_size, (size_t)WS_END); return; }
    static int grid = 0;
    if (grid == 0) {
        int dev = 0, cus = 0;
        if (hipGetDevice(&dev) != hipSuccess || hipDeviceGetAttribute(&cus, hipDeviceAttributeMultiprocessorCount, dev) != hipSuccess) { grid = -1; return; }
        if (hipFuncSetAttribute((const void*)mk_fwd, hipFuncAttributeMaxDynamicSharedMemorySize, LDS_BYTES) != hipSuccess) { fprintf(stderr, "kernel_launch: hipFuncSetAttribute failed\n"); grid = -1; return; }
        int per_cu = 0;
        if (hipOccupancyMaxActiveBlocksPerMultiprocessor(&per_cu, (const void*)mk_fwd, NWAVES * 64, LDS_BYTES) != hipSuccess || per_cu < 1) fprintf(stderr, "kernel_launch: occupancy query says %d\n", per_cu);
        (void)hipGetLastError();
        grid = cus;
    }
    if (grid < 0) return;
    (void)hipMemsetAsync((unsigned char*)d_ws + WS_CTL, 0, MiB, stream);
    Args a{};
    for (int i = 0; i < 26; ++i) a.in[i] = (const float*)d_in[i];
    a.out = (float*)d_out; a.ws = (unsigned char*)d_ws; a.ph_lo = 0; a.ph_hi = N_PHASES; a.li = 0; a.pad = 0;
    hipLaunchKernelGGL(mk_fwd, dim3(grid), dim3(NWAVES * 64), LDS_BYTES, stream, a);
}
```

```cpp
#include <hip/hip_runtime.h>
#include <cstdint>
#include <cstdio>
#include <cmath>
#include <cstddef>

typedef unsigned short bf16_t;
typedef float f32x4 __attribute__((ext_vector_type(4)));
typedef unsigned u32x4 __attribute__((ext_vector_type(4)));
typedef unsigned u32x2 __attribute__((ext_vector_type(2)));

constexpr int BATCH = 8, SEQ = 2048, DM = 1024, DEPTH = 2, MEM_LEN = 256;
constexpr int M = BATCH * SEQ;
constexpr int MM = BATCH * MEM_LEN;
constexpr int D_IN = 5888;
constexpr int C_AQ = 0, C_AK = 512, C_AV = 1024, C_BQ = 1536, C_BK = 2048, C_BV = 2176, C_CQ = 2304, C_G = 2816;
constexpr int OBR_W = 1536;
constexpr int NEXP = 32, DEXP = 512;
constexpr int MOE_TILE = 256;
constexpr int P_ROWS = M * 2 + NEXP * MOE_TILE;
constexpr int MAX_TILES = P_ROWS / MOE_TILE;
constexpr float EPS = 1e-6f;
constexpr float LOG2E = 1.4426950408889634f;
constexpr float C2_64 = 0.125f * LOG2E;
constexpr float C2_128 = 0.08838834764831845f * LOG2E;

constexpr size_t MiB = 1u << 20;
constexpr size_t WS_CTL = 0;
constexpr size_t WS_ROUTE = 1 * MiB;
constexpr size_t WS_TAB = 2 * MiB;
constexpr size_t WS_MEMKV = 3 * MiB;
constexpr size_t WS_HM = 7 * MiB;
constexpr size_t WS_PROJ = 39 * MiB;
constexpr size_t WS_OBR = 223 * MiB;
constexpr size_t WS_WB = 271 * MiB;
constexpr size_t WS_END = 499 * MiB;
constexpr size_t WS_BUF = WS_PROJ;
constexpr size_t WS_YB = WS_PROJ + 80 * MiB;
constexpr size_t WS_HID = WS_OBR;
constexpr size_t RT_EXP = 0;
constexpr size_t RT_WGT = 128 * 1024;
constexpr size_t RT_RANK = 256 * 1024;
constexpr size_t RT_DEST = 384 * 1024;
constexpr size_t RT_ROWW = 512 * 1024;
constexpr size_t RT_TILE = 700 * 1024;
constexpr size_t RT_RSTD = 768 * 1024;
constexpr int CW_CNT = 163840;
constexpr int CW_TMO = 128;
constexpr int CW_TCNT = 131072;

__device__ __forceinline__ float bf2f(bf16_t v) { return __uint_as_float(((unsigned)v) << 16); }
__device__ __forceinline__ bf16_t f2bf(float f) { unsigned u = __float_as_uint(f); return (bf16_t)((u + 0x7fffu + ((u >> 16) & 1u)) >> 16); }
__device__ __forceinline__ float wave_sum(float v) {
#pragma unroll
    for (int o = 1; o < 64; o <<= 1) v += __shfl_xor(v, o);
    return v;
}
__device__ __forceinline__ float wave_max(float v) {
#pragma unroll
    for (int o = 1; o < 64; o <<= 1) v = fmaxf(v, __shfl_xor(v, o));
    return v;
}
__device__ __forceinline__ float inv1d(int i) { return exp2f(-(float)i * (13.287712379549449f / 32.f)); }
__device__ __forceinline__ float inv2d(int j) { return exp2f(-(float)j * (13.287712379549449f / 16.f)); }
__device__ __forceinline__ float ang2d(int pos, int i) { return i < 16 ? (float)(pos >> 6) * inv2d(i) : (float)(pos & 63) * inv2d(i - 16); }

#define LAS __attribute__((address_space(3)))
#define GAS __attribute__((address_space(1)))
typedef short bf16x8 __attribute__((ext_vector_type(8)));
typedef short s16x4 __attribute__((ext_vector_type(4)));
typedef float f32x16 __attribute__((ext_vector_type(16)));
typedef float f32x2 __attribute__((ext_vector_type(2)));

constexpr size_t WB_IN = 0, WB_UP = 6029312, WB_OUT = WB_UP + 1572864, WB_GU = WB_OUT + 1048576, WB_DN = WB_GU + 33554432, WB_LAYER = WB_DN + 16777216;
constexpr size_t WB_MEMKV = 2 * WB_LAYER;
constexpr size_t WB_RT = WB_MEMKV + 1048576;
static_assert(WS_WB + (WB_RT + 2 * 2 * 48 * 1024) * 2 <= WS_END, "weight copies fit");
constexpr int N_PHASES = 19;
constexpr int XP = 2048;
constexpr int LCAP = 16384;

__device__ __forceinline__ int lane_id() { int r; asm volatile("v_mbcnt_lo_u32_b32 %0, -1, 0\n\tv_mbcnt_hi_u32_b32 %0, -1, %0" : "=v"(r)); return r; }
__device__ __forceinline__ unsigned cvt_pk_bf16(float lo, float hi) { unsigned r; asm volatile("v_cvt_pk_bf16_f32 %0, %1, %2" : "=v"(r) : "v"(lo), "v"(hi)); return r; }
__device__ __forceinline__ float fast_sigmoid(float v) { return __builtin_amdgcn_rcpf(1.f + __builtin_amdgcn_exp2f(-v * LOG2E)); }

namespace pg8 {
#define PG8_LAS LAS
constexpr int BM = 256, BK = 64, HALF = 128, HTB = HALF * BK * 2, STAGE_BYTES = 8 * HTB, NXCD = 8, WGM = 8;
__host__ __device__ __forceinline__ int lds_byte(int r, int c) { const int st = (r >> 4) * 2 + (c >> 5), rr = r & 15, cc = c & 31, ob = rr * 64 + cc * 2; return st * 1024 + (ob ^ (((ob >> 9) & 1) << 5)); }
__host__ __device__ __forceinline__ void stage_rc(int b, int& R, int& C) { const int st = b / 1024, sb = b % 1024, swz = sb ^ (((sb >> 9) & 1) << 5); R = (st >> 1) * 16 + swz / 64; C = (st & 1) * 32 + (swz % 64) / 2; }
__host__ __device__ __forceinline__ int perm32(int rho) { const int n = rho >> 4, i = rho & 15; return 8 * (i >> 2) + 4 * n + (i & 3); }

struct Unit { int pm, pn, sub, ord; const char* a; const char* b; };
struct Gemm { int lda; int K; };
__device__ __forceinline__ void tile_order(int L, int nM, int nN, int& pm, int& pn) {
    const int nwg = nM * nN; int wgid = L; { const int q = nwg / NXCD, r = nwg % NXCD, xcd = wgid % NXCD, off = wgid / NXCD; wgid = (xcd < r ? xcd * (q + 1) : r * (q + 1) + (xcd - r) * q) + off; }
    const int nig = WGM * nN, gid = wgid / nig, fm = gid * WGM, gsz = (nM - fm) < WGM ? (nM - fm) : WGM;
    pm = fm + ((wgid % nig) % gsz); pn = (wgid % nig) / gsz;
}
__device__ __forceinline__ u32x4 pack8(const f32x4& v0, const f32x4& v1) { u32x4 w; w.x = cvt_pk_bf16(v0[0], v0[1]); w.y = cvt_pk_bf16(v0[2], v0[3]); w.z = cvt_pk_bf16(v1[0], v1[1]); w.w = cvt_pk_bf16(v1[2], v1[3]); return w; }
__device__ __forceinline__ void unpack8(const u32x4& w, f32x4& v0, f32x4& v1) {
    v0[0] = __uint_as_float(w.x << 16); v0[1] = __uint_as_float(w.x & 0xffff0000u); v0[2] = __uint_as_float(w.y << 16); v0[3] = __uint_as_float(w.y & 0xffff0000u);
    v1[0] = __uint_as_float(w.z << 16); v1[1] = __uint_as_float(w.z & 0xffff0000u); v1[2] = __uint_as_float(w.w << 16); v1[3] = __uint_as_float(w.w & 0xffff0000u); }

struct EpiProj {
    static constexpr bool PERM = true, AFTER_DRAIN = false;
    bf16_t* PROJ; bf16_t* MEMKV; const float* tab1; const float* tab2; const float* qg; const float* kg;
    __device__ __forceinline__ void operator()(const f32x4 (&acc)[2][2][4][2], const Unit& u, int wr, int wc, int fr, int fq) const {
        const int colt = u.pn * 256, dcol = colt + wc * 64 + fq * 8, row0 = u.pm * 256 + wr * 64 + fr;
        if (u.sub == 1) {
#pragma unroll
            for (int ai = 0; ai < 2; ++ai)
#pragma unroll
                for (int m = 0; m < 4; ++m) { bf16_t* rowp = MEMKV + (size_t)(row0 + ai * 128 + m * 16) * 1024 + dcol;
#pragma unroll
                    for (int bj = 0; bj < 2; ++bj) *(u32x4*)(rowp + bj * 32) = pack8(acc[ai][bj][m][0], acc[ai][bj][m][1]); }
            return;
        }
        int mode = 0; float sc = 1.f; const float* g = qg;
        if (colt < C_AV) { mode = 1; if (colt < C_AK) sc = C2_64; }
        else if (colt < C_BQ) mode = 0;
        else if (colt < C_BK) { mode = 2; sc = C2_64; }
        else if (colt < C_CQ) { if (wc < 2) { mode = 2; g = kg; } }
        else if (colt < C_G) sc = C2_128;
        else mode = 3;
        f32x4 gv[2][2];
        if (mode == 2) {
#pragma unroll
            for (int bj = 0; bj < 2; ++bj)
#pragma unroll
                for (int n = 0; n < 2; ++n) gv[bj][n] = *(const f32x4*)(g + bj * 32 + fq * 8 + n * 4);
        }
#pragma unroll
        for (int ai = 0; ai < 2; ++ai)
#pragma unroll
            for (int m = 0; m < 4; ++m) {
                const int row = row0 + ai * 128 + m * 16, pos = row & (SEQ - 1);
                f32x4 v[2][2] = {{acc[ai][0][m][0], acc[ai][0][m][1]}, {acc[ai][1][m][0], acc[ai][1][m][1]}};
                if (mode == 2) {
                    float ss = 0.f;
#pragma unroll
                    for (int bj = 0; bj < 2; ++bj)
#pragma unroll
                        for (int n = 0; n < 2; ++n) ss += (v[bj][n][0] * v[bj][n][0] + v[bj][n][1] * v[bj][n][1]) + (v[bj][n][2] * v[bj][n][2] + v[bj][n][3] * v[bj][n][3]);
                    ss += __shfl_xor(ss, 16); ss += __shfl_xor(ss, 32);
                    const float rs = rsqrtf(ss * (1.f / 64.f) + EPS);
#pragma unroll
                    for (int bj = 0; bj < 2; ++bj)
#pragma unroll
                        for (int n = 0; n < 2; ++n) v[bj][n] = v[bj][n] * rs * gv[bj][n];
                }
                if (mode == 1 || mode == 2) {
                    const float* tb = (mode == 1 ? tab1 : tab2) + ((size_t)pos * 32 + fq * 8) * 2;
#pragma unroll
                    for (int n = 0; n < 2; ++n) { const f32x4 t0 = *(const f32x4*)(tb + n * 8), t1 = *(const f32x4*)(tb + n * 8 + 4);
                        const float cs[4] = {t0[0], t0[2], t1[0], t1[2]}, sn[4] = {t0[1], t0[3], t1[1], t1[3]};
#pragma unroll
                        for (int e = 0; e < 4; ++e) { const float x1 = v[0][n][e], x2 = v[1][n][e]; v[0][n][e] = x1 * cs[e] - x2 * sn[e]; v[1][n][e] = x2 * cs[e] + x1 * sn[e]; } }
                }
                if (mode == 3) {
#pragma unroll
                    for (int bj = 0; bj < 2; ++bj)
#pragma unroll
                        for (int n = 0; n < 2; ++n)
#pragma unroll
                            for (int e = 0; e < 4; ++e) v[bj][n][e] = fast_sigmoid(v[bj][n][e]);
                }
                bf16_t* rowp = PROJ + (size_t)row * D_IN + dcol;
#pragma unroll
                for (int bj = 0; bj < 2; ++bj) *(u32x4*)(rowp + bj * 32) = pack8(v[bj][0] * sc, v[bj][1] * sc);
            }
    }
};
struct EpiGate {
    static constexpr bool PERM = true, AFTER_DRAIN = false;
    bf16_t* MERGED; const bf16_t* PROJ;
    __device__ __forceinline__ void operator()(const f32x4 (&acc)[2][2][4][2], const Unit& u, int wr, int wc, int fr, int fq) const {
        const int col0 = u.pn * 256 + wc * 32 + fq * 8, row0 = u.pm * 256 + wr * 64 + fr;
#pragma unroll
        for (int ai = 0; ai < 2; ++ai)
#pragma unroll
            for (int mp = 0; mp < 2; ++mp) {
                u32x4 gq[2][2], oq[2][2];
#pragma unroll
                for (int mi = 0; mi < 2; ++mi) { const int row = row0 + ai * 128 + (mp * 2 + mi) * 16;
                    const bf16_t* gp = PROJ + (size_t)row * D_IN + C_G + u.sub * 1024 + col0; const bf16_t* op = MERGED + (size_t)row * DM + col0;
#pragma unroll
                    for (int bj = 0; bj < 2; ++bj) { gq[mi][bj] = *(const u32x4*)(gp + bj * 128); if (u.sub != 0) oq[mi][bj] = *(const u32x4*)(op + bj * 128); else oq[mi][bj] = (u32x4){0u, 0u, 0u, 0u}; } }
                asm volatile("" ::: "memory");
#pragma unroll
                for (int mi = 0; mi < 2; ++mi) { const int m = mp * 2 + mi; bf16_t* op = MERGED + (size_t)(row0 + ai * 128 + m * 16) * DM + col0;
#pragma unroll
                    for (int bj = 0; bj < 2; ++bj) { f32x4 g0, g1, o0, o1; unpack8(gq[mi][bj], g0, g1); unpack8(oq[mi][bj], o0, o1);
                        o0 += g0 * acc[ai][bj][m][0]; o1 += g1 * acc[ai][bj][m][1];
                        *(u32x4*)(op + bj * 128) = pack8(o0, o1); } }
                asm volatile("" ::: "memory");
            }
    }
};
struct EpiResid {
    static constexpr bool PERM = true, AFTER_DRAIN = false;
    const float* Xf; bf16_t* XB; int first;
    __device__ __forceinline__ void operator()(const f32x4 (&acc)[2][2][4][2], const Unit& u, int wr, int wc, int fr, int fq) const {
        const int col0 = u.pn * 256 + wc * 32 + fq * 8, row0 = u.pm * 256 + wr * 64 + fr;
#pragma unroll
        for (int ai = 0; ai < 2; ++ai)
#pragma unroll
            for (int mp = 0; mp < 2; ++mp) {
                f32x4 xin[2][2][2];
                if (first) {
#pragma unroll
                    for (int mi = 0; mi < 2; ++mi) { const size_t off = (size_t)(row0 + ai * 128 + (mp * 2 + mi) * 16) * DM + col0;
#pragma unroll
                        for (int bj = 0; bj < 2; ++bj) { const f32x4* pi = (const f32x4*)(Xf + off + bj * 128); xin[mi][bj][0] = pi[0]; xin[mi][bj][1] = pi[1]; } }
                } else {
                    u32x4 xq[2][2];
#pragma unroll
                    for (int mi = 0; mi < 2; ++mi)
#pragma unroll
                        for (int bj = 0; bj < 2; ++bj) xq[mi][bj] = *(const u32x4*)(XB + (size_t)(row0 + ai * 128 + (mp * 2 + mi) * 16) * XP + col0 + bj * 128);
                    asm volatile("" ::: "memory");
#pragma unroll
                    for (int mi = 0; mi < 2; ++mi)
#pragma unroll
                        for (int bj = 0; bj < 2; ++bj) unpack8(xq[mi][bj], xin[mi][bj][0], xin[mi][bj][1]);
                }
                asm volatile("" ::: "memory");
#pragma unroll
                for (int mi = 0; mi < 2; ++mi) { const int m = mp * 2 + mi;
#pragma unroll
                    for (int bj = 0; bj < 2; ++bj) *(u32x4*)(XB + (size_t)(row0 + ai * 128 + m * 16) * XP + col0 + bj * 128) = pack8(xin[mi][bj][0] + acc[ai][bj][m][0], xin[mi][bj][1] + acc[ai][bj][m][1]); }
                asm volatile("" ::: "memory");
            }
    }
};
struct EpiSilu {
    static constexpr bool PERM = true, AFTER_DRAIN = false;
    bf16_t* HID;
    __device__ __forceinline__ void operator()(const f32x4 (&acc)[2][2][4][2], const Unit& u, int wr, int wc, int fr, int fq) const {
        const __amdgpu_buffer_rsrc_t rsrc = __builtin_amdgcn_make_buffer_rsrc((void*)HID, 0, P_ROWS * DEXP * 2, 0x00020000);
        const int col0 = u.pn * 128 + wc * 32 + fq * 8, row0 = u.pm * 256 + wr * 64 + fr;
#pragma unroll
        for (int ai = 0; ai < 2; ++ai)
#pragma unroll
            for (int m = 0; m < 4; ++m) { f32x4 h[2];
#pragma unroll
                for (int n = 0; n < 2; ++n)
#pragma unroll
                    for (int e = 0; e < 4; ++e) { const float gq = acc[ai][0][m][n][e]; h[n][e] = gq * fast_sigmoid(gq) * acc[ai][1][m][n][e]; }
                __builtin_amdgcn_raw_buffer_store_b128(pack8(h[0], h[1]), rsrc, ((row0 + ai * 128 + m * 16) * DEXP + col0) * 2, 0, 16); }
    }
};
struct EpiRowScale {
    static constexpr bool PERM = true, AFTER_DRAIN = false;
    bf16_t* YB; const PG8_LAS float* wtab;
    __device__ __forceinline__ void operator()(const f32x4 (&acc)[2][2][4][2], const Unit& u, int wr, int wc, int fr, int fq) const {
        const int col0 = u.pn * 256 + wc * 32 + fq * 8, rt0 = wr * 64 + fr;
#pragma unroll
        for (int ai = 0; ai < 2; ++ai)
#pragma unroll
            for (int m = 0; m < 4; ++m) { const int rt = rt0 + ai * 128 + m * 16; const float w = wtab[u.ord * 256 + rt]; bf16_t* op = YB + (size_t)(u.pm * 256 + rt) * DM + col0;
#pragma unroll
                for (int bj = 0; bj < 2; ++bj) *(u32x4*)(op + bj * 128) = pack8(acc[ai][bj][m][0] * w, acc[ai][bj][m][1] * w); }
    }
};
struct SchedProj {
    int c, G, nmain, ntotal; const char* A; const char* B; const char* Am; const char* Bm;
    __device__ __forceinline__ bool next(int i, Unit& u) const {
        const long L = (long)i * G + c; if (L >= ntotal) return false;
        u.ord = i;
        if (L < nmain) { tile_order((int)L, M / 256, D_IN / 256, u.pm, u.pn); u.sub = 0; u.a = A + (size_t)u.pm * (256 * DM * 2); u.b = B + (size_t)u.pn * (256 * DM * 2); }
        else { const int r = (int)L - nmain; u.pm = r >> 2; u.pn = r & 3; u.sub = 1; u.a = Am + (size_t)u.pm * (256 * DM * 2); u.b = Bm + (size_t)u.pn * (256 * DM * 2); }
        return true; }
    __device__ __forceinline__ void a_ready(const Unit&) const {}
    __device__ __forceinline__ void done(const Unit&) const {}
};
struct SchedGate {
    int c, G; const char* OBRp; const char* WUP;
    __device__ __forceinline__ bool next(int i, Unit& u) const {
        const int t = c + G * (i / 3); if (t >= 256) return false;
        tile_order(t, M / 256, 4, u.pm, u.pn); u.sub = i % 3; u.ord = i;
        u.a = OBRp + ((size_t)u.pm * 256 * OBR_W + 512 * u.sub) * 2; u.b = WUP + ((size_t)u.sub * 1024 * 512 + (size_t)u.pn * 256 * 512) * 2; return true; }
    __device__ __forceinline__ void a_ready(const Unit&) const {}
    __device__ __forceinline__ void done(const Unit&) const {}
};
struct SchedPlain {
    int c, G, nM; const char* A; const char* B; size_t a_tile, b_tile;
    __device__ __forceinline__ bool next(int i, Unit& u) const {
        const long L = (long)i * G + c; if (L >= (long)nM * 4) return false;
        tile_order((int)L, nM, 4, u.pm, u.pn); u.sub = 0; u.ord = i; u.a = A + (size_t)u.pm * a_tile; u.b = B + (size_t)u.pn * b_tile; return true; }
    __device__ __forceinline__ void a_ready(const Unit&) const {}
    __device__ __forceinline__ void done(const Unit&) const {}
};
struct SchedMoeUp {
    static constexpr size_t b_exp = (size_t)1024 * 1024 * 2, b_tile = (size_t)256 * DM * 2;
    int c, G, ntiles; const PG8_LAS int* tile_e; const char* A; const char* B; unsigned* tcnt;
    __device__ __forceinline__ bool next(int i, Unit& u) const {
        const long L = (long)i * G + c; if (L >= (long)ntiles * 4) return false;
        u.pm = (int)(L >> 2); u.pn = (int)(L & 3); u.sub = 0; u.ord = i; const int e = tile_e[u.pm];
        u.a = A; u.b = B + (size_t)e * b_exp + (size_t)u.pn * b_tile; return true; }
    __device__ __forceinline__ void a_ready(const Unit&) const {}
    __device__ __forceinline__ void done(const Unit& u) const {
        asm volatile("s_waitcnt vmcnt(0)" ::: "memory");
        if (lane_id() == 0) __hip_atomic_fetch_add(tcnt + 64 * u.pm, 1u, __ATOMIC_RELAXED, __HIP_MEMORY_SCOPE_AGENT);
    }
};
__device__ __forceinline__ int moe_down_unit(int c, int i, int rem, int G) {
    const int n0 = G - rem, n1 = rem;
    return c >= rem ? n0 * i + n1 * (i > 1 ? i - 1 : 0) + (c - rem) : n0 * (i + 2) + n1 * i + c;
}
struct SchedMoeDown {
    static constexpr size_t a_tile = (size_t)256 * DEXP * 2, b_exp = (size_t)1024 * 512 * 2, b_tile = (size_t)256 * DEXP * 2;
    int c, G, ntiles, rem, wv; const PG8_LAS int* tile_e; const char* A; const char* B; unsigned* tcnt; unsigned* tmo;
    __device__ __forceinline__ bool next(int i, Unit& u) const {
        const int j = moe_down_unit(c, i, rem, G); if (j >= ntiles * 4) return false;
        u.pm = j >> 2; u.pn = j & 3; u.sub = 0; u.ord = i; const int e = tile_e[u.pm];
        u.a = A + (size_t)u.pm * a_tile; u.b = B + (size_t)e * b_exp + (size_t)u.pn * b_tile; return true; }
    __device__ __forceinline__ void a_ready(const Unit& u) const {
        if (wv == 0) {
            unsigned polls = 0;
            while ((unsigned)__builtin_amdgcn_readfirstlane(__hip_atomic_load(tcnt + 64 * u.pm, __ATOMIC_RELAXED, __HIP_MEMORY_SCOPE_AGENT)) < 32u) {
                if (++polls > (1u << 20)) { if (lane_id() == 0) __hip_atomic_store(tmo, 1u, __ATOMIC_RELAXED, __HIP_MEMORY_SCOPE_AGENT); break; }
                __builtin_amdgcn_s_sleep(2); }
            __builtin_amdgcn_fence(__ATOMIC_ACQUIRE, "agent");
            asm volatile("s_waitcnt vmcnt(0)" ::: "memory");
        }
        asm volatile("" ::: "memory"); __builtin_amdgcn_s_barrier(); asm volatile("" ::: "memory");
    }
    __device__ __forceinline__ void done(const Unit&) const {}
};

template <class Epi, class Sched, bool ALIGN_EPI = false, bool SP2 = false, bool GATHER = false>
__device__ __forceinline__ void gemm_phase(PG8_LAS unsigned char* lds, const Gemm g, const Sched& S, const Epi& E, int wave_id, const PG8_LAS unsigned* rowtab = nullptr) {
    static_assert(!GATHER || SP2, "the gathered A path is written for the two-super-phase loop");
    int tid_ = wave_id * 64 + lane_id(); asm volatile("" : "+v"(tid_));
    const int tid = tid_, wid = __builtin_amdgcn_readfirstlane(tid >> 6), lane = tid & 63, wr = wid >> 2, wc = wid & 3, fr = lane & 15, fq = lane >> 4;
    const int K = g.K, nt = K / BK;
    unsigned voffA[2], voffB[2];
#pragma unroll
    for (int i = 0; i < 2; ++i) { int R, C; stage_rc(tid * 16 + i * 8192, R, C); const int Rb = Epi::PERM ? ((R & ~31) + perm32(R & 31)) : R;
        voffA[i] = (unsigned)(R * g.lda + C) * 2u; voffB[i] = (unsigned)(Rb * K + C) * 2u; }
    unsigned gC[2][2] = {{0u, 0u}, {0u, 0u}}, gN[2][2] = {{0u, 0u}, {0u, 0u}};
#define PG8_GROWS(dst, ord) do { if constexpr (GATHER) { _Pragma("unroll") for (int i_ = 0; i_ < 2; ++i_) { int R_, C_; stage_rc((wid * 64 + fq * 16 + fr) * 16 + i_ * 8192, R_, C_);     \
        _Pragma("unroll") for (int h_ = 0; h_ < 2; ++h_) dst[h_][i_] = rowtab[(ord) * 256 + h_ * 128 + R_] + (unsigned)C_ * 2u; } } } while (0)
#define PG8_STAGE_A(bufoff, base, h, use_next) do { if constexpr (GATHER) { unsigned vo_[2]; vo_[0] = (use_next) ? gN[h][0] : gC[h][0]; vo_[1] = (use_next) ? gN[h][1] : gC[h][1]; PG8_STAGE(bufoff, base, vo_); } \
        else { PG8_STAGE(bufoff, (base) + (h) * hstepA, voffA); } } while (0)
    const size_t kstep = (size_t)(BK * 2);
    const size_t hstepA = (size_t)HALF * g.lda * 2, hstepB = (size_t)HALF * K * 2;
    const unsigned ldsw = (unsigned)wid * 1024u;
    const int aoff = lds_byte(wr * 64 + fr, fq * 8), boff = lds_byte(wc * 32 + fr, fq * 8);
#define PG8_SA(b, h) (((b) * 2 + (h)) * HTB)
#define PG8_SB(b, h) ((4 + (b) * 2 + (h)) * HTB)
#define PG8_STAGE(bufoff, gbase, voff) do { _Pragma("unroll") for (int _i = 0; _i < 2; ++_i) \
        __builtin_amdgcn_global_load_lds((const unsigned*)((const char*)(gbase) + (voff)[_i]), (PG8_LAS unsigned*)(lds + (bufoff) + ldsw + _i * 8192), 16, 0, 0); } while (0)
#define PG8_LDA(dst, b, h) do { _Pragma("unroll") for (int m = 0; m < 4; ++m) _Pragma("unroll") for (int k = 0; k < 2; ++k) dst[m][k] = *(const PG8_LAS bf16x8*)(lds + PG8_SA(b, h) + aoff + m * 2048 + k * 1024); } while (0)
#define PG8_LDB(dst, b, h) do { _Pragma("unroll") for (int n = 0; n < 2; ++n) _Pragma("unroll") for (int k = 0; k < 2; ++k) dst[n][k] = *(const PG8_LAS bf16x8*)(lds + PG8_SB(b, h) + boff + n * 2048 + k * 1024); } while (0)
#define PG8_MMA(ai, bj, At, Bt) do { __builtin_amdgcn_s_setprio(1); _Pragma("unroll") for (int m = 0; m < 4; ++m) _Pragma("unroll") for (int n = 0; n < 2; ++n) _Pragma("unroll") for (int k = 0; k < 2; ++k) \
        acc[ai][bj][m][n] = __builtin_amdgcn_mfma_f32_16x16x32_bf16(Bt[n][k], At[m][k], acc[ai][bj][m][n], 0, 0, 0); __builtin_amdgcn_s_setprio(0); } while (0)
#define PG8_WAIT_V(n) asm volatile("s_waitcnt vmcnt(" #n ")" ::: "memory")
#define PG8_WAIT_L(n) asm volatile("s_waitcnt lgkmcnt(" #n ")" ::: "memory")
#define PG8_BAR __builtin_amdgcn_s_barrier()
#define PG8_SCHED __builtin_amdgcn_sched_barrier(0)
    Unit cur, nxt; int ui = 0;
    if (!S.next(0, cur)) return;
    f32x4 acc[2][2][4][2];
#pragma unroll
    for (int a = 0; a < 2; ++a)
#pragma unroll
        for (int b = 0; b < 2; ++b)
#pragma unroll
            for (int m = 0; m < 4; ++m)
#pragma unroll
                for (int n = 0; n < 2; ++n) acc[a][b][m][n] = (f32x4){0.f, 0.f, 0.f, 0.f};
    bf16x8 At[4][2], B0[2][2], B1[2][2];
    const char* cA = cur.a; const char* cB = cur.b;
    S.a_ready(cur);
    if constexpr (SP2) {
        PG8_GROWS(gC, 0);
        PG8_STAGE(PG8_SB(0, 0), cB, voffB); PG8_STAGE(PG8_SB(0, 1), cB + hstepB, voffB); PG8_STAGE_A(PG8_SA(0, 0), cA, 0, false); PG8_STAGE_A(PG8_SA(0, 1), cA, 1, false);
        if (wr == 1) PG8_BAR;
        PG8_WAIT_V(2); PG8_BAR;
        PG8_STAGE(PG8_SB(1, 0), cB + kstep, voffB); PG8_STAGE_A(PG8_SA(1, 0), cA + kstep, 0, false); PG8_STAGE(PG8_SB(1, 1), cB + hstepB + kstep, voffB);
        PG8_WAIT_V(6); PG8_BAR;
    } else {
        PG8_STAGE(PG8_SB(0, 0), cB, voffB); PG8_STAGE(PG8_SA(0, 0), cA, voffA); PG8_STAGE(PG8_SB(0, 1), cB + hstepB, voffB); PG8_STAGE(PG8_SA(0, 1), cA + hstepA, voffA);
        if (wr == 1) PG8_BAR;
        PG8_WAIT_V(4); PG8_BAR;
        PG8_STAGE(PG8_SB(1, 0), cB + kstep, voffB); PG8_STAGE(PG8_SA(1, 0), cA + kstep, voffA); PG8_STAGE(PG8_SB(1, 1), cB + hstepB + kstep, voffB);
        PG8_WAIT_V(6); PG8_BAR;
    }
    for (;;) {
        const bool has_next = S.next(ui + 1, nxt);
        const char* nA = has_next ? nxt.a : cA; const char* nB = has_next ? nxt.b : cB;
        for (int t = 0; t < nt; t += 2) {
            const bool last = (t == nt - 2);
            const char* a1 = cA + (size_t)(t + 1) * kstep;
            const char* a2 = last ? nA : cA + (size_t)(t + 2) * kstep; const char* b2 = last ? nB : cB + (size_t)(t + 2) * kstep;
            const char* a3 = a2 + kstep; const char* b3 = b2 + kstep;
            if (last && has_next) S.a_ready(nxt);
            if constexpr (GATHER) { if (last) { if (has_next) { PG8_GROWS(gN, ui + 1); } else { _Pragma("unroll") for (int h_ = 0; h_ < 2; ++h_) _Pragma("unroll") for (int i_ = 0; i_ < 2; ++i_) gN[h_][i_] = gC[h_][i_]; } } }
            if constexpr (SP2) {
            PG8_LDB(B0, 0, 0); PG8_LDB(B1, 0, 1); PG8_SCHED; PG8_LDA(At, 0, 0); PG8_STAGE_A(PG8_SA(1, 1), a1, 1, false);
            PG8_WAIT_V(8); PG8_WAIT_L(0); PG8_BAR; PG8_MMA(0, 0, At, B0); PG8_MMA(0, 1, At, B1); PG8_BAR; PG8_SCHED;
            PG8_LDA(At, 0, 1); PG8_STAGE(PG8_SB(0, 0), b2, voffB); PG8_STAGE(PG8_SB(0, 1), b2 + hstepB, voffB); PG8_STAGE_A(PG8_SA(0, 0), a2, 0, last);
            PG8_WAIT_V(8); PG8_WAIT_L(0); PG8_BAR; PG8_MMA(1, 0, At, B0); PG8_MMA(1, 1, At, B1); PG8_BAR; PG8_SCHED;
            PG8_LDB(B0, 1, 0); PG8_LDB(B1, 1, 1); PG8_SCHED; PG8_LDA(At, 1, 0); PG8_STAGE_A(PG8_SA(0, 1), a2, 1, last);
            PG8_WAIT_V(8); PG8_WAIT_L(0); PG8_BAR; PG8_MMA(0, 0, At, B0); PG8_MMA(0, 1, At, B1); PG8_BAR; PG8_SCHED;
            PG8_LDA(At, 1, 1); PG8_STAGE(PG8_SB(1, 0), b3, voffB); PG8_STAGE(PG8_SB(1, 1), b3 + hstepB, voffB); PG8_STAGE_A(PG8_SA(1, 0), a3, 0, last);
            PG8_WAIT_V(8); PG8_WAIT_L(0); PG8_BAR; PG8_MMA(1, 0, At, B0); PG8_MMA(1, 1, At, B1); PG8_BAR; PG8_SCHED;
            } else {
            PG8_LDB(B0, 0, 0); PG8_SCHED; PG8_LDA(At, 0, 0); PG8_STAGE(PG8_SA(1, 1), a1 + hstepA, voffA);
            PG8_WAIT_L(8); PG8_BAR; PG8_WAIT_L(0); PG8_MMA(0, 0, At, B0); PG8_BAR; PG8_SCHED;
            PG8_LDB(B1, 0, 1); PG8_STAGE(PG8_SB(0, 0), b2, voffB);
            PG8_BAR; PG8_WAIT_L(0); PG8_MMA(0, 1, At, B1); PG8_BAR;
            PG8_LDA(At, 0, 1); PG8_STAGE(PG8_SA(0, 0), a2, voffA);
            PG8_BAR; PG8_WAIT_L(0); PG8_MMA(1, 0, At, B0); PG8_BAR; PG8_SCHED;
            PG8_STAGE(PG8_SB(0, 1), b2 + hstepB, voffB);
            PG8_WAIT_V(6); PG8_BAR; PG8_MMA(1, 1, At, B1); PG8_BAR;
            PG8_LDB(B0, 1, 0); PG8_SCHED; PG8_LDA(At, 1, 0); PG8_STAGE(PG8_SA(0, 1), a2 + hstepA, voffA);
            PG8_WAIT_L(8); PG8_BAR; PG8_WAIT_L(0); PG8_MMA(0, 0, At, B0); PG8_BAR; PG8_SCHED;
            PG8_LDB(B1, 1, 1); PG8_STAGE(PG8_SB(1, 0), b3, voffB);
            PG8_BAR; PG8_WAIT_L(0); PG8_MMA(0, 1, At, B1); PG8_BAR;
            PG8_LDA(At, 1, 1); PG8_STAGE(PG8_SA(1, 0), a3, voffA);
            PG8_BAR; PG8_WAIT_L(0); PG8_MMA(1, 0, At, B0); PG8_BAR; PG8_SCHED;
            PG8_STAGE(PG8_SB(1, 1), b3 + hstepB, voffB);
            PG8_WAIT_V(6); PG8_BAR; PG8_MMA(1, 1, At, B1); PG8_BAR;
            }
        }
        if constexpr (ALIGN_EPI) { if (wr == 0) PG8_BAR; }
        if constexpr (!Epi::AFTER_DRAIN) { E(acc, cur, wr, wc, fr, fq); S.done(cur); }
        if (!has_next) break;
#pragma unroll
        for (int a = 0; a < 2; ++a)
#pragma unroll
            for (int b = 0; b < 2; ++b)
#pragma unroll
                for (int m = 0; m < 4; ++m)
#pragma unroll
                    for (int n = 0; n < 2; ++n) acc[a][b][m][n] = (f32x4){0.f, 0.f, 0.f, 0.f};
        cur = nxt; cA = nA; cB = nB; ++ui;
        if constexpr (GATHER) { _Pragma("unroll") for (int h_ = 0; h_ < 2; ++h_) _Pragma("unroll") for (int i_ = 0; i_ < 2; ++i_) gC[h_][i_] = gN[h_][i_]; }
        if constexpr (ALIGN_EPI) { if (wr == 1) PG8_BAR; }
    }
    PG8_WAIT_V(0);
    if constexpr (!ALIGN_EPI) { if (wr == 0) PG8_BAR; }
    PG8_BAR;
    if constexpr (Epi::AFTER_DRAIN) { E.fused(acc, cur, wr, wc, fr, fq, lds, wid, lane); S.done(cur); }
#undef PG8_SA
#undef PG8_GROWS
#undef PG8_STAGE_A
#undef PG8_SB
#undef PG8_STAGE
#undef PG8_LDA
#undef PG8_LDB
#undef PG8_MMA
#undef PG8_WAIT_V
#undef PG8_WAIT_L
#undef PG8_BAR
#undef PG8_SCHED
}
}

namespace att {
constexpr int NW = 8, QBLK = 32, KVBLK = 64;
constexpr float THR = 8.f;
#define ATT_SBAR() __builtin_amdgcn_sched_barrier(0)
__device__ __forceinline__ int crow(int r, int hi) { return (r & 3) + 8 * (r >> 2) + 4 * hi; }
template <int D> __device__ __forceinline__ int kswz(int row, int colB) { return D == 128 ? row * 256 + (colB ^ ((row & 7) << 4)) : row * 128 + (colB ^ (((row >> 1) & 7) << 4)); }
template <int DV> __device__ __forceinline__ int v_st(int k, int c) { const int kk = (k & ~0xC) | ((k & 4) << 1) | ((k & 8) >> 1); return ((kk >> 3) * (DV / 32) + (c >> 5)) * 512 + ((kk & 7) * 32 + (c & 31)) * 2; }
__device__ __forceinline__ int v_rd_base(int lane) { return ((lane & 3) << 3) | (((lane >> 2) & 3) << 6) | (((lane >> 4) & 1) << 5) | (((lane >> 5) & 1) << 8); }
template <int DV> constexpr int v_rd_off(int d0, int ks, int half) { return d0 * 512 + ks * (DV / 32) * 1024 + half * (DV / 32) * 512; }
template <int OFF> __device__ __forceinline__ s16x4 tr_read(int vb) { s16x4 r; asm volatile("ds_read_b64_tr_b16 %0, %1 offset:%2" : "=&v"(r) : "v"(vb), "i"(OFF) : "memory"); return r; }

__device__ __forceinline__ void partialSM(f32x16& p0, f32x16& p1, float& m_reg, float& mn, float& alpha) {
    float pmax = p0[0];
#pragma unroll
    for (int r = 1; r < 16; ++r) pmax = fmaxf(pmax, p0[r]);
#pragma unroll
    for (int r = 0; r < 16; ++r) pmax = fmaxf(pmax, p1[r]);
    { auto rr = __builtin_amdgcn_permlane32_swap(__float_as_uint(pmax), __float_as_uint(pmax), false, false); pmax = fmaxf(__uint_as_float(rr[0]), __uint_as_float(rr[1])); }
    if (__builtin_expect(__all(pmax - m_reg <= THR), 1)) { mn = m_reg; alpha = 1.f; }
    else { mn = fmaxf(m_reg, pmax); alpha = __builtin_amdgcn_exp2f(m_reg - mn); m_reg = mn; }
#pragma unroll
    for (int r = 0; r < 16; ++r) { p0[r] -= mn; p1[r] -= mn; }
#pragma unroll
    for (int r = 0; r < 16; ++r) p0[r] = __builtin_amdgcn_exp2f(p0[r]);
}
__device__ __forceinline__ void finishSM(f32x16& p0, f32x16& p1, float alpha, float& l_reg, bf16x8& pa0, bf16x8& pa1, bf16x8& pa2, bf16x8& pa3) {
#pragma unroll
    for (int r = 0; r < 16; ++r) p1[r] = __builtin_amdgcn_exp2f(p1[r]);
    float ps = 0;
#pragma unroll
    for (int r = 0; r < 16; ++r) ps += p0[r];
#pragma unroll
    for (int r = 0; r < 16; ++r) ps += p1[r];
    { auto rr = __builtin_amdgcn_permlane32_swap(__float_as_uint(ps), __float_as_uint(ps), false, false); ps = __uint_as_float(rr[0]) + __uint_as_float(rr[1]); }
    l_reg = l_reg * alpha + ps;
#define ATT_PK4(P, BASE, OUT) do { unsigned a0 = cvt_pk_bf16(P[BASE + 0], P[BASE + 1]), a1 = cvt_pk_bf16(P[BASE + 2], P[BASE + 3]);   \
    unsigned b0 = cvt_pk_bf16(P[BASE + 4], P[BASE + 5]), b1 = cvt_pk_bf16(P[BASE + 6], P[BASE + 7]);                              \
    auto r0 = __builtin_amdgcn_permlane32_swap(a0, b0, false, false); auto r1 = __builtin_amdgcn_permlane32_swap(a1, b1, false, false); \
    u32x4 w = {r0[0], r1[0], r0[1], r1[1]}; OUT = *reinterpret_cast<bf16x8*>(&w); } while (0)
    ATT_PK4(p0, 0, pa0); ATT_PK4(p0, 8, pa1); ATT_PK4(p1, 0, pa2); ATT_PK4(p1, 8, pa3);
#undef ATT_PK4
}
template <int DQK> __device__ __forceinline__ void qkt(f32x16& p0, f32x16& p1, const char* Ks, const bf16x8* qr, int r32, int hi) {
    p0 = f32x16{}; p1 = f32x16{};
#pragma unroll
    for (int d0 = 0; d0 < DQK / 16; ++d0) { const int cb = (d0 * 16 + hi * 8) * 2;
        const bf16x8 b0 = *reinterpret_cast<const bf16x8*>(Ks + kswz<DQK>(r32, cb));
        const bf16x8 b1 = *reinterpret_cast<const bf16x8*>(Ks + kswz<DQK>(32 + r32, cb));
        p0 = __builtin_amdgcn_mfma_f32_32x32x16_bf16(b0, qr[d0], p0, 0, 0, 0);
        p1 = __builtin_amdgcn_mfma_f32_32x32x16_bf16(b1, qr[d0], p1, 0, 0, 0); }
}
template <int DV, int D0> __device__ __forceinline__ void pv_one(f32x16& od, int vb, bf16x8 pa0, bf16x8 pa1, bf16x8 pa2, bf16x8 pa3) {
    const s16x4 l0 = tr_read<v_rd_off<DV>(D0, 0, 0)>(vb), h0 = tr_read<v_rd_off<DV>(D0, 0, 1)>(vb), l1 = tr_read<v_rd_off<DV>(D0, 1, 0)>(vb), h1 = tr_read<v_rd_off<DV>(D0, 1, 1)>(vb);
    const s16x4 l2 = tr_read<v_rd_off<DV>(D0, 2, 0)>(vb), h2 = tr_read<v_rd_off<DV>(D0, 2, 1)>(vb), l3 = tr_read<v_rd_off<DV>(D0, 3, 0)>(vb), h3 = tr_read<v_rd_off<DV>(D0, 3, 1)>(vb);
    asm volatile("s_waitcnt lgkmcnt(0)" ::: "memory"); ATT_SBAR();
#define ATT_PK(L, H) (bf16x8){L[0], L[1], L[2], L[3], H[0], H[1], H[2], H[3]}
    od = __builtin_amdgcn_mfma_f32_32x32x16_bf16(pa0, ATT_PK(l0, h0), od, 0, 0, 0);
    od = __builtin_amdgcn_mfma_f32_32x32x16_bf16(pa1, ATT_PK(l1, h1), od, 0, 0, 0);
    od = __builtin_amdgcn_mfma_f32_32x32x16_bf16(pa2, ATT_PK(l2, h2), od, 0, 0, 0);
    od = __builtin_amdgcn_mfma_f32_32x32x16_bf16(pa3, ATT_PK(l3, h3), od, 0, 0, 0);
#undef ATT_PK
}
template <int DV> __device__ __forceinline__ void pv_all(f32x16 (&o)[DV / 32], int vb, bf16x8 pa0, bf16x8 pa1, bf16x8 pa2, bf16x8 pa3) {
    pv_one<DV, 0>(o[0], vb, pa0, pa1, pa2, pa3); pv_one<DV, 1>(o[1], vb, pa0, pa1, pa2, pa3);
    if constexpr (DV == 128) { pv_one<DV, 2>(o[2], vb, pa0, pa1, pa2, pa3); pv_one<DV, 3>(o[3], vb, pa0, pa1, pa2, pa3); }
}
template <int DQK, int DV> struct Lay { static constexpr int SHM_V = 64 * DV * 2, SHM_K = 64 * DQK * 2, OFF_V = 0, OFF_K = 2 * SHM_V, OFF_WS = OFF_K + 2 * SHM_K, OFF_STASH = OFF_WS + NW * 64 * 4; };

template <int DQK, int DV, int LDQ, int LDK, int LDV>
__device__ __forceinline__ void attn_pass(const bf16_t* __restrict__ Qb, const bf16_t* __restrict__ Kh, const bf16_t* __restrict__ Vh, int nkeys, char* lds, f32x16 (&o)[DV / 32], float (&rli)[16], int wv) {
    using L = Lay<DQK, DV>;
    constexpr int NLK = DQK / 64, NLV = DV / 64;
    int tid_ = wv * 64 + lane_id(); asm volatile("" : "+v"(tid_));
    const int tid = tid_, wid = tid >> 6, lane = tid & 63, r32 = lane & 31, hi = lane >> 5;
    char* V_lds = lds + L::OFF_V; char* K_lds = lds + L::OFF_K;
    float* ws = (float*)(lds + L::OFF_WS) + wid * 64; float* li_l = ws; float* al_l = ws + 32;
    float m_reg = -1e30f, l_reg = 0.f; bf16x8 qr[DQK / 16];
#pragma unroll
    for (int d = 0; d < DV / 32; ++d) o[d] = f32x16{};
    const bf16_t* Qw = Qb + (size_t)(wid * QBLK + r32) * LDQ + hi * 8;
#pragma unroll
    for (int d0 = 0; d0 < DQK / 16; ++d0) qr[d0] = *reinterpret_cast<const bf16x8*>(Qw + d0 * 16);
    const int krow = DQK == 128 ? (tid >> 4) : (tid >> 3), kcol = DQK == 128 ? (tid & 15) * 8 : (tid & 7) * 8;
    const int vrow = DV == 128 ? (tid >> 4) : (tid >> 3), vcol = DV == 128 ? (tid & 15) * 8 : (tid & 7) * 8;
    const int vb0 = (int)(uintptr_t)V_lds + v_rd_base(lane);
    bf16x8 vsE[NLV], ksE[NLK], vsO[NLV], ksO[NLK];
#define ATT_SLOAD(VS, KS, k0) do { _Pragma("unroll") for (int i_ = 0; i_ < NLV; ++i_) VS[i_] = *reinterpret_cast<const bf16x8*>(&Vh[(size_t)((k0) + vrow + 32 * i_) * LDV + vcol]); \
    _Pragma("unroll") for (int i_ = 0; i_ < NLK; ++i_) KS[i_] = *reinterpret_cast<const bf16x8*>(&Kh[(size_t)((k0) + krow + 32 * i_) * LDK + kcol]); } while (0)
#define ATT_SWRITE(b, VS, KS) do { _Pragma("unroll") for (int i_ = 0; i_ < NLV; ++i_) *(bf16x8*)(V_lds + (b) * L::SHM_V + v_st<DV>(vrow + 32 * i_, vcol)) = VS[i_]; \
    _Pragma("unroll") for (int i_ = 0; i_ < NLK; ++i_) *(bf16x8*)(K_lds + (b) * L::SHM_K + kswz<DQK>(krow + 32 * i_, kcol * 2)) = KS[i_]; } while (0)
#define ATT_SWAIT() do { if constexpr (NLK + NLV == 4) asm volatile("s_waitcnt vmcnt(4)" ::: "memory"); else if constexpr (NLK + NLV == 3) asm volatile("s_waitcnt vmcnt(3)" ::: "memory"); else asm volatile("s_waitcnt vmcnt(2)" ::: "memory"); } while (0)
#define ATT_RESC(a) do { if (__any((a) < 1.f)) { if (hi == 0) al_l[r32] = (a); asm volatile("s_waitcnt lgkmcnt(0)" ::: "memory"); \
    _Pragma("unroll") for (int d = 0; d < DV / 32; ++d) _Pragma("unroll") for (int r = 0; r < 16; ++r) o[d][r] *= al_l[crow(r, hi)]; } } while (0)
    f32x16 pA0, pA1, pB0, pB1; float mnA, mnB, alA, alB; bf16x8 pa0, pa1, pa2, pa3; const int NT = nkeys / KVBLK;
    __syncthreads();
    ATT_SLOAD(vsE, ksE, 0); asm volatile("s_waitcnt vmcnt(0)" ::: "memory"); ATT_SWRITE(0, vsE, ksE); __syncthreads();
    qkt<DQK>(pA0, pA1, K_lds, qr, r32, hi); partialSM(pA0, pA1, m_reg, mnA, alA);
    ATT_SLOAD(vsO, ksO, KVBLK); if (2 < NT) ATT_SLOAD(vsE, ksE, 2 * KVBLK);
    ATT_SWAIT(); ATT_SWRITE(1, vsO, ksO); __syncthreads();
    for (int j = 1; j + 1 < NT; j += 2) {
        ATT_SBAR(); qkt<DQK>(pB0, pB1, K_lds + L::SHM_K, qr, r32, hi);
        finishSM(pA0, pA1, alA, l_reg, pa0, pa1, pa2, pa3); ATT_SBAR();
        ATT_SLOAD(vsO, ksO, (j + 2) * KVBLK); ATT_SBAR();
        pv_all<DV>(o, vb0, pa0, pa1, pa2, pa3); partialSM(pB0, pB1, m_reg, mnB, alB);
        __syncthreads(); ATT_SWAIT(); ATT_SWRITE(0, vsE, ksE);
        ATT_RESC(alB); __syncthreads();
        ATT_SBAR(); qkt<DQK>(pA0, pA1, K_lds, qr, r32, hi);
        finishSM(pB0, pB1, alB, l_reg, pa0, pa1, pa2, pa3); ATT_SBAR();
        if (j + 3 < NT) ATT_SLOAD(vsE, ksE, (j + 3) * KVBLK); ATT_SBAR();
        pv_all<DV>(o, vb0 + L::SHM_V, pa0, pa1, pa2, pa3); partialSM(pA0, pA1, m_reg, mnA, alA);
        __syncthreads(); ATT_SWAIT(); ATT_SWRITE(1, vsO, ksO);
        ATT_RESC(alA); __syncthreads();
    }
    ATT_SBAR(); qkt<DQK>(pB0, pB1, K_lds + L::SHM_K, qr, r32, hi);
    finishSM(pA0, pA1, alA, l_reg, pa0, pa1, pa2, pa3); ATT_SBAR();
    pv_all<DV>(o, vb0, pa0, pa1, pa2, pa3); partialSM(pB0, pB1, m_reg, mnB, alB);
    __syncthreads(); ATT_RESC(alB);
    finishSM(pB0, pB1, alB, l_reg, pa0, pa1, pa2, pa3); ATT_SBAR();
    pv_all<DV>(o, vb0 + L::SHM_V, pa0, pa1, pa2, pa3);
    if (hi == 0) li_l[r32] = l_reg; asm volatile("s_waitcnt lgkmcnt(0)" ::: "memory");
#pragma unroll
    for (int r = 0; r < 16; ++r) rli[r] = __builtin_amdgcn_rcpf(li_l[crow(r, hi)]);
#undef ATT_SLOAD
#undef ATT_SWRITE
#undef ATT_SWAIT
#undef ATT_RESC
}
template <int DV, int LDO> __device__ __forceinline__ void store_o(bf16_t* Ob, const f32x16 (&o)[DV / 32], const float (&rli)[16], int wv) {
    int tid_ = wv * 64 + lane_id(); asm volatile("" : "+v"(tid_));
    const int tid = tid_, wid = tid >> 6, lane = tid & 63, r32 = lane & 31, hi = lane >> 5;
    bf16_t* Ow = Ob + (size_t)(wid * QBLK) * LDO;
#pragma unroll
    for (int r = 0; r < 16; ++r) { const int orow = crow(r, hi);
#pragma unroll
        for (int d0 = 0; d0 < DV / 32; ++d0) Ow[(size_t)orow * LDO + d0 * 32 + r32] = f2bf(o[d0][r] * rli[r]); }
}
__device__ __forceinline__ void unit_a(const bf16_t* PROJ, bf16_t* OBR, int b, int h, int qb, float lam, float lam_init, const float* subg, char* lds, int wv) {
    using L = Lay<64, 128>;
    int tid_ = wv * 64 + lane_id(); asm volatile("" : "+v"(tid_));
    const int tid = tid_, wid = tid >> 6, lane = tid & 63, r32 = lane & 31, hi = lane >> 5;
    const bf16_t* kv = PROJ + (size_t)b * SEQ * D_IN; const size_t qrow = (size_t)b * SEQ + qb * 256;
    unsigned* stash = (unsigned*)(lds + L::OFF_STASH) + wid * 2048 + lane;
    f32x16 o[4]; float rli[16];
#pragma unroll 1
    for (int c = 0; c < 2; ++c) {
        attn_pass<64, 128, D_IN, D_IN, D_IN>(PROJ + qrow * D_IN + C_AQ + h * 128 + c * 64, kv + C_AK + h * 128 + c * 64, kv + C_AV + h * 128, SEQ, lds, o, rli, wv);
        if (c == 0) {
#pragma unroll
            for (int d0 = 0; d0 < 4; ++d0)
#pragma unroll
                for (int r = 0; r < 16; r += 2) stash[(d0 * 8 + (r >> 1)) * 64] = cvt_pk_bf16(o[d0][r] * rli[r], o[d0][r + 1] * rli[r + 1]);
        }
    }
    asm volatile("s_waitcnt lgkmcnt(0)" ::: "memory");
    float ss[16];
#pragma unroll
    for (int r = 0; r < 16; ++r) ss[r] = 0.f;
#pragma unroll
    for (int d0 = 0; d0 < 4; ++d0)
#pragma unroll
        for (int r = 0; r < 16; r += 2) { const unsigned w = stash[(d0 * 8 + (r >> 1)) * 64];
            const float c0 = __uint_as_float(w << 16) - lam * o[d0][r] * rli[r], c1 = __uint_as_float(w & 0xffff0000u) - lam * o[d0][r + 1] * rli[r + 1];
            o[d0][r] = c0; o[d0][r + 1] = c1; ss[r] += c0 * c0; ss[r + 1] += c1 * c1; }
#pragma unroll
    for (int r = 0; r < 16; ++r) { float s = ss[r]; s += __shfl_xor(s, 1); s += __shfl_xor(s, 2); s += __shfl_xor(s, 4); s += __shfl_xor(s, 8); s += __shfl_xor(s, 16);
        ss[r] = rsqrtf(s * (1.f / 128.f) + EPS) * (1.f - lam_init); }
    bf16_t* Ow = OBR + (qrow + wid * QBLK) * OBR_W + h * 128;
#pragma unroll
    for (int d0 = 0; d0 < 4; ++d0) { const float g = subg[d0 * 32 + r32];
#pragma unroll
        for (int r = 0; r < 16; ++r) Ow[(size_t)crow(r, hi) * OBR_W + d0 * 32 + r32] = f2bf(o[d0][r] * ss[r] * g); }
}
__device__ __forceinline__ void unit_b(const bf16_t* PROJ, bf16_t* OBR, int b, int qh, int qb, char* lds, int wv) {
    const bf16_t* kv = PROJ + (size_t)b * SEQ * D_IN; const size_t qrow = (size_t)b * SEQ + qb * 256;
    f32x16 o[2]; float rli[16];
    attn_pass<64, 64, D_IN, D_IN, D_IN>(PROJ + qrow * D_IN + C_BQ + qh * 64, kv + C_BK + (qh >> 2) * 64, kv + C_BV + (qh >> 2) * 64, SEQ, lds, o, rli, wv);
    store_o<64, OBR_W>(OBR + qrow * OBR_W + 512 + qh * 64, o, rli, wv);
}
__device__ __forceinline__ void unit_c(const bf16_t* PROJ, const bf16_t* MEMKV, bf16_t* OBR, int b, int h, int qb, char* lds, int wv) {
    const bf16_t* kv = MEMKV + (size_t)b * MEM_LEN * 1024; const size_t qrow = (size_t)b * SEQ + qb * 256;
    f32x16 o[4]; float rli[16];
    attn_pass<128, 128, D_IN, 1024, 1024>(PROJ + qrow * D_IN + C_CQ + h * 128, kv + h * 128, kv + 512 + h * 128, MEM_LEN, lds, o, rli, wv);
    store_o<128, OBR_W>(OBR + qrow * OBR_W + 1024 + h * 128, o, rli, wv);
}
#undef ATT_SBAR
}

template <int NR>
__device__ __forceinline__ void rows_rmsnorm(const float* __restrict__ xbase, const float* __restrict__ g, bf16_t* __restrict__ obase, int row0, int lane) {
    f32x4 v[NR][4];
#pragma unroll
    for (int r = 0; r < NR; ++r)
#pragma unroll
        for (int j = 0; j < 4; ++j) v[r][j] = ((const f32x4*)(xbase + (size_t)(row0 + r) * DM))[lane + 64 * j];
    f32x4 gg[4];
#pragma unroll
    for (int j = 0; j < 4; ++j) gg[j] = ((const f32x4*)g)[lane + 64 * j];
#pragma unroll
    for (int r = 0; r < NR; ++r) { float s = 0.f;
#pragma unroll
        for (int j = 0; j < 4; ++j) s += v[r][j].x * v[r][j].x + v[r][j].y * v[r][j].y + v[r][j].z * v[r][j].z + v[r][j].w * v[r][j].w;
        const float rs = rsqrtf(wave_sum(s) * (1.f / DM) + EPS);
#pragma unroll
        for (int j = 0; j < 4; ++j) { u32x2 o; o.x = cvt_pk_bf16(v[r][j].x * rs * gg[j].x, v[r][j].y * rs * gg[j].y); o.y = cvt_pk_bf16(v[r][j].z * rs * gg[j].z, v[r][j].w * rs * gg[j].w);
            ((u32x2*)(obase + (size_t)(row0 + r) * DM))[lane + 64 * j] = o; } }
}
__device__ __forceinline__ void route_block(const bf16_t* __restrict__ X, const bf16_t* __restrict__ rt_tab, const float* __restrict__ brg, const float* __restrict__ bre, int* __restrict__ experts, float* __restrict__ weights,
                                            int* __restrict__ rank, unsigned* __restrict__ cnt, float* __restrict__ rstd, int* __restrict__ list, const float* __restrict__ g2, bf16_t* __restrict__ H2, int rb, const bf16x8 (&Bh)[3][4], const bf16x8 (&Bl)[3][4], LAS float* slab, int tid, int wave) {
    const int lane = tid & 63, r = lane & 15, kq = lane >> 4;
    LAS float* ssq = slab + 8 * 64 * 48; LAS float* rs_l = ssq + 8 * 64;
#pragma unroll 1
    for (int rtp = 0; rtp < 2; ++rtp) {
        bf16x8 xa[2][4];
#pragma unroll
        for (int q = 0; q < 2; ++q) { const bf16_t* xp = X + (size_t)(rb * 64 + (rtp * 2 + q) * 16 + r) * XP + 128 * wave + 8 * kq;
#pragma unroll
            for (int sI = 0; sI < 4; ++sI) xa[q][sI] = *(const bf16x8*)(xp + 32 * sI); }
#pragma unroll
        for (int q = 0; q < 2; ++q) { const int rt = rtp * 2 + q;
            f32x4 acc[3]; float ss = 0.f;
#pragma unroll
            for (int t = 0; t < 3; ++t) acc[t] = (f32x4){0.f, 0.f, 0.f, 0.f};
#pragma unroll
            for (int sI = 0; sI < 4; ++sI) {
                const bf16x8 Ah = xa[q][sI]; f32x4 a0, a1; pg8::unpack8(__builtin_bit_cast(u32x4, Ah), a0, a1);
                ss += (a0[0] * a0[0] + a0[1] * a0[1]) + (a0[2] * a0[2] + a0[3] * a0[3]) + (a1[0] * a1[0] + a1[1] * a1[1]) + (a1[2] * a1[2] + a1[3] * a1[3]);
#pragma unroll
                for (int t = 0; t < 3; ++t) {
                    acc[t] = __builtin_amdgcn_mfma_f32_16x16x32_bf16(Ah, Bh[t][sI], acc[t], 0, 0, 0);
                    acc[t] = __builtin_amdgcn_mfma_f32_16x16x32_bf16(Ah, Bl[t][sI], acc[t], 0, 0, 0);
                }
            }
            ss += __shfl_xor(ss, 16); ss += __shfl_xor(ss, 32);
            if (kq == 0) ssq[wave * 64 + rt * 16 + r] = ss;
#pragma unroll
            for (int t = 0; t < 3; ++t)
#pragma unroll
                for (int e = 0; e < 4; ++e) slab[(wave * 64 + rt * 16 + 4 * kq + e) * 48 + 16 * t + r] = acc[t][e];
        }
    }
    __syncthreads();
    if (tid < 64) {
        const int row = rb * 64 + tid;
        float lg[36]; float ss = 0.f;
#pragma unroll
        for (int c = 0; c < 36; ++c) lg[c] = 0.f;
#pragma unroll 1
        for (int w = 0; w < 8; ++w) { ss += ssq[w * 64 + tid];
#pragma unroll
            for (int c = 0; c < 36; ++c) lg[c] += slab[(w * 64 + tid) * 48 + c]; }
        const float rs = rsqrtf(ss * (1.f / DM) + EPS);
        rstd[row] = rs;
        int gi = 0; float gm = lg[0] * rs + brg[0];
#pragma unroll
        for (int i = 1; i < 4; ++i) { const float l = lg[i] * rs + brg[i]; if (l > gm) { gm = l; gi = i; } }
        float gs = 0.f;
#pragma unroll
        for (int i = 0; i < 4; ++i) gs += __expf(lg[i] * rs + brg[i] - gm);
        const float gp = 1.f / gs;
        float el[8];
#pragma unroll
        for (int i = 0; i < 8; ++i) el[i] = 0.f;
#pragma unroll
        for (int gq = 0; gq < 4; ++gq) if (gq == gi) {
#pragma unroll
            for (int i = 0; i < 8; ++i) el[i] = lg[4 + gq * 8 + i] * rs + bre[gq * 8 + i]; }
        int i0 = 0; float l0 = el[0];
#pragma unroll
        for (int i = 1; i < 8; ++i) if (el[i] > l0) { l0 = el[i]; i0 = i; }
        int i1 = -1; float l1 = -INFINITY;
#pragma unroll
        for (int i = 0; i < 8; ++i) if (i != i0 && el[i] > l1) { l1 = el[i]; i1 = i; }
        const float p1 = __expf(l1 - l0), inv = 1.f / (1.f + p1);
        const int e0 = gi * 8 + i0, e1 = gi * 8 + i1;
        experts[row * 2] = e0; experts[row * 2 + 1] = e1;
        weights[row * 2] = gp * inv; weights[row * 2 + 1] = gp * p1 * inv;
        LAS unsigned* lc = (LAS unsigned*)(rs_l + 64); LAS unsigned* gb = lc + 32;
        if (tid < 32) lc[tid] = 0u;
        asm volatile("s_waitcnt lgkmcnt(0)" ::: "memory");
        unsigned q0, q1; const unsigned one = 1u, a0_ = (unsigned)(uintptr_t)(lc + e0), a1_ = (unsigned)(uintptr_t)(lc + e1);
        asm volatile("ds_add_rtn_u32 %0, %1, %2\n\ts_waitcnt lgkmcnt(0)" : "=v"(q0) : "v"(a0_), "v"(one) : "memory");
        asm volatile("ds_add_rtn_u32 %0, %1, %2\n\ts_waitcnt lgkmcnt(0)" : "=v"(q1) : "v"(a1_), "v"(one) : "memory");
        if (tid < 32) { const unsigned n = lc[tid]; gb[tid] = n ? atomicAdd(cnt + 64 * tid, n) : 0u; }
        const int r0 = (int)(gb[e0] + q0), r1 = (int)(gb[e1] + q1);
        rank[row * 2] = r0; rank[row * 2 + 1] = r1;
        list[e0 * LCAP + r0] = row * 2; list[e1 * LCAP + r1] = row * 2 + 1;
        rs_l[tid] = rs;
    }
    __syncthreads();
#pragma unroll 1
    for (int rr = 0; rr < 8; rr += 4) {
        u32x2 v[4][4];
#pragma unroll
        for (int r4 = 0; r4 < 4; ++r4)
#pragma unroll
            for (int j = 0; j < 4; ++j) v[r4][j] = ((const u32x2*)(X + (size_t)(rb * 64 + wave * 8 + rr + r4) * XP))[lane + 64 * j];
#pragma unroll
        for (int r4 = 0; r4 < 4; ++r4) { const float rs = rs_l[wave * 8 + rr + r4]; u32x2* dst = (u32x2*)(H2 + (size_t)(rb * 64 + wave * 8 + rr + r4) * DM);
#pragma unroll
            for (int j = 0; j < 4; ++j) { const f32x4 gg = ((const f32x4*)g2)[lane + 64 * j]; const u32x2 w = v[r4][j];
                u32x2 o; o.x = cvt_pk_bf16(__uint_as_float(w.x << 16) * rs * gg.x, __uint_as_float(w.x & 0xffff0000u) * rs * gg.y); o.y = cvt_pk_bf16(__uint_as_float(w.y << 16) * rs * gg.z, __uint_as_float(w.y & 0xffff0000u) * rs * gg.w); dst[lane + 64 * j] = o; } }
    }
    __syncthreads();
}
__device__ __forceinline__ void moe_tables(const unsigned* cnt, volatile LAS int* mt, int tid) {
    if (tid == 0) { int off = 0, nt = 0;
#pragma unroll 1
        for (int e = 0; e < NEXP; ++e) { const int c = (int)__hip_atomic_load(cnt + 64 * e, __ATOMIC_RELAXED, __HIP_MEMORY_SCOPE_AGENT), t = (c + MOE_TILE - 1) / MOE_TILE;
            mt[e] = off; mt[32 + e] = c; mt[64 + e] = nt;
#pragma unroll 1
            for (int i = 0; i < t; ++i) mt[96 + nt + i] = e;
            nt += t; off += t * MOE_TILE; }
        mt[256] = nt; }
    __syncthreads();
}
__device__ __forceinline__ void moe_rowtabs(volatile LAS int* mt, const int* __restrict__ list, const float* __restrict__ weights, LAS unsigned* rowtab, LAS float* wtab, int bx, int G, int tid, int up) {
    const int ntiles = mt[256], rem = (ntiles * 4) % G;
#pragma unroll 1
    for (int i = 0; i < 4; ++i) { const long L = up ? (long)i * G + bx : (long)pg8::moe_down_unit(bx, i, rem, G); if (L >= (long)ntiles * 4) break;
        if (tid < 256) { const int tile = (int)(L >> 2), e = mt[96 + tile], q = (tile - mt[64 + e]) * 256 + tid; const bool valid = q < mt[32 + e];
            const int a = valid ? list[e * LCAP + q] : 0;
            if (up) rowtab[i * 256 + tid] = (unsigned)(a >> 1) * (unsigned)(DM * 2); else wtab[i * 256 + tid] = valid ? weights[a] : 0.f; } }
    __syncthreads();
}
template <int NR>
__device__ __forceinline__ void rows_combine_norm(bf16_t* __restrict__ XB, const bf16_t* __restrict__ YB, const float* __restrict__ g, bf16_t* __restrict__ H, float* __restrict__ OUT, const int (&row)[NR], int lane, bool poison, const int (&d0)[NR], const int (&d1)[NR]) {
    u32x2 xq[NR][4], ya[NR][4], yb[NR][4];
#pragma unroll
    for (int r = 0; r < NR; ++r)
#pragma unroll
        for (int j = 0; j < 4; ++j) { xq[r][j] = ((const u32x2*)(XB + (size_t)row[r] * XP))[lane + 64 * j];
            ya[r][j] = ((const u32x2*)(YB + (size_t)d0[r] * DM))[lane + 64 * j]; yb[r][j] = ((const u32x2*)(YB + (size_t)d1[r] * DM))[lane + 64 * j]; }
    f32x4 gg[4];
#pragma unroll
    for (int j = 0; j < 4; ++j) gg[j] = ((const f32x4*)g)[lane + 64 * j];
    f32x4 v[NR][4]; float s[NR];
#pragma unroll
    for (int r = 0; r < NR; ++r) { s[r] = 0.f;
#pragma unroll
        for (int j = 0; j < 4; ++j) { const u32x2 x = xq[r][j], a = ya[r][j], b = yb[r][j];
            v[r][j].x = __uint_as_float(x.x << 16) + __uint_as_float(a.x << 16) + __uint_as_float(b.x << 16); v[r][j].y = __uint_as_float(x.x & 0xffff0000u) + __uint_as_float(a.x & 0xffff0000u) + __uint_as_float(b.x & 0xffff0000u);
            v[r][j].z = __uint_as_float(x.y << 16) + __uint_as_float(a.y << 16) + __uint_as_float(b.y << 16); v[r][j].w = __uint_as_float(x.y & 0xffff0000u) + __uint_as_float(a.y & 0xffff0000u) + __uint_as_float(b.y & 0xffff0000u);
            s[r] += v[r][j].x * v[r][j].x + v[r][j].y * v[r][j].y + v[r][j].z * v[r][j].z + v[r][j].w * v[r][j].w; } }
#pragma unroll
    for (int r = 0; r < NR; ++r) {
        float rs = rsqrtf(wave_sum(s[r]) * (1.f / DM) + EPS);
        if (poison) rs = __builtin_nanf("");
#pragma unroll
        for (int j = 0; j < 4; ++j) {
            if (H) { u32x2 xo; xo.x = cvt_pk_bf16(v[r][j].x, v[r][j].y); xo.y = cvt_pk_bf16(v[r][j].z, v[r][j].w); ((u32x2*)(XB + (size_t)row[r] * XP))[lane + 64 * j] = xo;
                u32x2 o; o.x = cvt_pk_bf16(v[r][j].x * rs * gg[j].x, v[r][j].y * rs * gg[j].y); o.y = cvt_pk_bf16(v[r][j].z * rs * gg[j].z, v[r][j].w * rs * gg[j].w);
                ((u32x2*)(H + (size_t)row[r] * DM))[lane + 64 * j] = o; }
            else { f32x4 o; o.x = v[r][j].x * rs * gg[j].x; o.y = v[r][j].y * rs * gg[j].y; o.z = v[r][j].z * rs * gg[j].z; o.w = v[r][j].w * rs * gg[j].w; ((f32x4*)(OUT + (size_t)row[r] * DM))[lane + 64 * j] = o; }
        }
    }
}
struct TrItem { const float* src; bf16_t* dst; int ldw, K; };
template <int OFF> __device__ __forceinline__ unsigned long long karg64() { unsigned long long v; asm volatile("s_load_dwordx2 %0, %1, %2\n\ts_waitcnt lgkmcnt(0)" : "=s"(v) : "s"(__builtin_amdgcn_kernarg_segment_ptr()), "n"(OFF)); return v; }
__device__ __forceinline__ unsigned long long karg64d(int off) { unsigned long long v; asm volatile("s_load_dwordx2 %0, %1, %2\n\ts_waitcnt lgkmcnt(0)" : "=s"(v) : "s"(__builtin_amdgcn_kernarg_segment_ptr()), "s"(off)); return v; }
#define TR_IN(k) ((const float*)(const GAS float*)karg64d(8 * (k)))
__device__ __forceinline__ void tr_decode(int it, int lane, bf16_t* WB, const float*& sp, int& ldw, bf16_t*& dp, int& K) {
    const float* src; int segA, segB, kb, tb, dk0 = 0; bf16_t* dst;
    if (it < 28800) {
        const int l = it / 14400; int r = it % 14400; bf16_t* WBl = WB + (size_t)l * WB_LAYER;
        if (r < 1472) { kb = r / 92; tb = r % 92; const int pn = tb >> 2, bj = (tb >> 1) & 1, w0 = 2 * (tb & 1); src = TR_IN(5) + (size_t)l * DM * D_IN; ldw = D_IN; K = DM; segA = 256 * pn + 64 * w0 + 32 * bj; segB = segA + 64; dst = WBl + WB_IN; }
        else if (r < 1856) { r -= 1472; const int i = r >> 7; r &= 127; kb = r >> 4; tb = r & 15; src = TR_IN(13 + i) + (size_t)l * 512 * DM; ldw = DM; K = 512; segA = 64 * tb; segB = segA + 32; dst = WBl + WB_UP + (size_t)i * 1024 * 512; }
        else if (r < 2112) { r -= 1856; kb = r >> 4; tb = r & 15; src = TR_IN(16) + (size_t)l * DM * DM; ldw = DM; K = DM; segA = 64 * tb; segB = segA + 32; dst = WBl + WB_OUT; }
        else if (r < 10304) { r -= 2112; const int e = r >> 8; r &= 255; kb = r >> 4; tb = r & 15; const int pn = tb >> 2, sg = (tb >> 1) & 1, jb = tb & 1;
            src = TR_IN(sg ? 23 : 22) + (size_t)(l * NEXP + e) * DM * DEXP; ldw = DEXP; K = DM; segA = 128 * pn + 64 * jb; segB = segA + 32; dst = WBl + WB_GU + (size_t)e * 1024 * 1024; }
        else { r -= 10304; const int e = r >> 7; r &= 127; kb = r >> 4; tb = r & 15; src = TR_IN(24) + (size_t)(l * NEXP + e) * DEXP * DM; ldw = DM; K = DEXP; segA = 64 * tb; segB = segA + 32; dst = WBl + WB_DN + (size_t)e * 1024 * 512; }
    } else { const int r = it - 28800; kb = r >> 4; tb = r & 15; const int pn = tb >> 2, bj = (tb >> 1) & 1, w0 = 2 * (tb & 1); src = TR_IN(3); ldw = 1024; K = DM; segA = 256 * pn + 64 * w0 + 32 * bj; segB = segA + 64; dst = WB + WB_MEMKV; }
    const int q = lane & 15;
    sp = src + (size_t)(kb * 64 + (lane >> 4)) * ldw + (q < 8 ? segA + 4 * q : segB + 4 * (q - 8));
    dp = dst + (size_t)(64 * tb + (lane >> 3)) * K + dk0 + kb * 64 + 8 * (lane & 7);
}
__device__ __forceinline__ void tr_load(f32x4 (&v)[16], const float* sp, int ldw) {
#pragma unroll
    for (int i = 0; i < 16; ++i) v[i] = *(const f32x4*)(sp + (size_t)(4 * i) * ldw);
}
__device__ __forceinline__ void tr_store(const f32x4 (&v)[16], bf16_t* dp, int K, LAS float* scr, int lane) {
    const int q = lane & 15, kq = lane >> 4;
#pragma unroll
    for (int i = 0; i < 16; ++i) { LAS float* w = scr + (4 * i + kq) * 65 + 4 * q; w[0] = v[i][0]; w[1] = v[i][1]; w[2] = v[i][2]; w[3] = v[i][3]; }
    asm volatile("s_waitcnt lgkmcnt(0)" ::: "memory");
    const int c = lane & 7, n8 = lane >> 3;
#pragma unroll
    for (int j = 0; j < 8; ++j) { const LAS float* sI = scr + (8 * c) * 65 + n8 + 8 * j;
        u32x4 o; o.x = cvt_pk_bf16(sI[0 * 65], sI[1 * 65]); o.y = cvt_pk_bf16(sI[2 * 65], sI[3 * 65]); o.z = cvt_pk_bf16(sI[4 * 65], sI[5 * 65]); o.w = cvt_pk_bf16(sI[6 * 65], sI[7 * 65]);
        *(u32x4*)(dp + (size_t)(8 * j) * K) = o; }
    asm volatile("s_waitcnt lgkmcnt(0)" ::: "memory");
}

__device__ __forceinline__ int tr_item(int mode, int q) {
    return mode == 0 ? q : mode == 1 ? (q < 1472 ? q : q < 3584 ? q - 1472 + 14400 : q - 3584 + 28800) : mode == 2 ? q + 1472 : q + 16512; }
__device__ __forceinline__ void tr_run(int mode, int q0, int qend, int qstride, bf16_t* WB, LAS float* scr, int lane) {
    f32x4 ra[16], rb[16], rc[16]; const float* sp; int ldw; bf16_t* dpa; int Ka; bf16_t* dpb; int Kb; bf16_t* dpc; int Kc;
    if (q0 >= qend) return;
    const int qlast = q0 + ((qend - 1 - q0) / qstride) * qstride;
#define TR_LD(R, DP, KK, QQ) do { const int qn_ = (QQ) <= qlast ? (QQ) : qlast; tr_decode(tr_item(mode, qn_), lane, WB, sp, ldw, DP, KK); tr_load(R, sp, ldw); } while (0)
    int q = q0;
    TR_LD(ra, dpa, Ka, q); TR_LD(rb, dpb, Kb, q + qstride);
    for (;;) {
        TR_LD(rc, dpc, Kc, q + 2 * qstride); tr_store(ra, dpa, Ka, scr, lane); q += qstride; if (q > qlast) break;
        TR_LD(ra, dpa, Ka, q + 2 * qstride); tr_store(rb, dpb, Kb, scr, lane); q += qstride; if (q > qlast) break;
        TR_LD(rb, dpb, Kb, q + 2 * qstride); tr_store(rc, dpc, Kc, scr, lane); q += qstride; if (q > qlast) break;
    }
#undef TR_LD
}
#define XB_TMO      128
#define XB_XCNT(j)  (256  + 64 * (j))
#define XB_XSUB(j)  (1280 + 64 * (j))
#define XB_XGEN(j)  (2304 + 64 * (j))
#define XB_TOP      3328
#define XB_TOPGEN   3392
#define XCD_BAR_WORDS 3456
#define XB_SPIN_CAP (1u << 18)

__device__ __forceinline__ unsigned xb_ld(unsigned* p)              { return __hip_atomic_load(p, __ATOMIC_RELAXED, __HIP_MEMORY_SCOPE_AGENT); }
__device__ __forceinline__ unsigned xb_add(unsigned* p, unsigned v) { return __hip_atomic_fetch_add(p, v, __ATOMIC_RELAXED, __HIP_MEMORY_SCOPE_AGENT); }
__device__ __forceinline__ unsigned xb_xcc_id() { return (unsigned)__builtin_amdgcn_s_getreg((3 << 11) | 20) & 0xFu; }
#define XB_SPIN(cond, bar) do { unsigned _sp = 0; while (cond) { __builtin_amdgcn_s_sleep(1); \
    if ((++_sp & 255u) == 0u) { if (xb_ld(&(bar)[XB_TMO])) break; if (_sp > XB_SPIN_CAP) { atomicAdd(&(bar)[XB_TMO], 1u); break; } } } } while (0)

struct XcdBarrier {
    unsigned* bar; unsigned x; unsigned w0;
    volatile LAS unsigned* st;
};

__device__ __forceinline__ XcdBarrier xcd_barrier_post(unsigned* bar, volatile LAS unsigned* st, unsigned is_wave0) {
    XcdBarrier b; b.bar = bar; b.x = xb_xcc_id(); b.st = st; b.w0 = is_wave0;
    if (is_wave0 && lane_id() == 0) (void)xb_add(&bar[XB_XCNT(b.x)], 1u);
    return b;
}
__device__ __forceinline__ void xcd_barrier_complete(unsigned* bar, unsigned x, unsigned& nloc, unsigned& nx) {
    const unsigned G = gridDim.x * gridDim.y * gridDim.z;
    unsigned sum, cnt, mine, sp = 0u;
    for (;;) {
        sum = 0u; cnt = 0u; mine = 0u;
#pragma unroll
        for (unsigned j = 0; j < 16; ++j) { const unsigned c = xb_ld(&bar[XB_XCNT(j)]); sum += c; cnt += (c > 0u) ? 1u : 0u; mine = (j == x) ? c : mine; }
        if (sum == G) break;
        __builtin_amdgcn_s_sleep(1);
        if ((++sp & 255u) == 0u) { if (xb_ld(&bar[XB_TMO])) break; if (sp > XB_SPIN_CAP) { atomicAdd(&bar[XB_TMO], 1u); break; } }
    }
    nloc = mine > 0u ? mine : 1u; nx = cnt > 0u ? cnt : 1u;
}

__device__ __forceinline__ void xcd_barrier(const XcdBarrier& b) {
    asm volatile("s_waitcnt vmcnt(0)" ::: "memory");
    __syncthreads();
    if (b.w0 && lane_id() == 0) {
        unsigned* bar = b.bar;
        __builtin_amdgcn_s_waitcnt(0);
        unsigned nloc = b.st[0], nx = b.st[1];
        if (nloc == 0u) { xcd_barrier_complete(bar, b.x, nloc, nx); b.st[0] = nloc; b.st[1] = nx; }
        const unsigned old = xb_add(&bar[XB_XSUB(b.x)], 1u);
        const unsigned gen = old / nloc;
        if (old + 1u == (gen + 1u) * nloc) {
            __builtin_amdgcn_fence(__ATOMIC_RELEASE, "agent");
            asm volatile("s_waitcnt vmcnt(0)" ::: "memory");
            const unsigned og = xb_add(&bar[XB_TOP], 1u);
            const unsigned tg = og / nx;
            if (og + 1u == (tg + 1u) * nx) xb_add(&bar[XB_TOPGEN], 1u);
            else XB_SPIN(xb_ld(&bar[XB_TOPGEN]) == tg, bar);
            __builtin_amdgcn_fence(__ATOMIC_ACQUIRE, "agent");
            xb_add(&bar[XB_XGEN(b.x)], 1u);
            asm volatile("s_waitcnt vmcnt(0)" ::: "memory");
        } else {
            XB_SPIN(xb_ld(&bar[XB_XGEN(b.x)]) == gen, bar);
            __builtin_amdgcn_fence(__ATOMIC_ACQUIRE, "agent");
            asm volatile("s_waitcnt vmcnt(0)" ::: "memory");
        }
    }
    __syncthreads();
}
constexpr int NWAVES = 8;
constexpr int RING_BYTES = 131072, LDSCTL_OFF = 135168, LDS_BYTES = 147456;
constexpr int CW_BAR = 4096, BAR_REGION = 4096;
static_assert(XCD_BAR_WORDS <= BAR_REGION && (CW_BAR + (N_PHASES + 1) * BAR_REGION) * 4 <= (int)MiB, "barrier regions inside the memset region");
static_assert(pg8::STAGE_BYTES <= RING_BYTES && att::Lay<64, 128>::OFF_STASH + 65536 <= RING_BYTES && att::Lay<128, 128>::OFF_WS + 2048 <= RING_BYTES, "LDS map");

struct Args { const float* in[26]; float* out; unsigned char* ws; int ph_lo, ph_hi, li, pad; };
#define KIN(k) ((const float*)(const GAS float*)karg64<8 * (k)>())
#define KOUT ((float*)(GAS float*)karg64<208>())
#define KWS ((unsigned char*)(GAS unsigned char*)karg64<216>())
static_assert(offsetof(Args, out) == 208 && offsetof(Args, ws) == 216 && offsetof(Args, ph_lo) == 224, "Args layout vs the kernarg offsets above");

__global__ void __launch_bounds__(NWAVES * 64, 2) mk_fwd(Args args) {
    extern __shared__ __attribute__((aligned(16))) unsigned char lds[];
    const int wave = __builtin_amdgcn_readfirstlane((int)threadIdx.x >> 6);
#define lane0 lane_id()
#define tid0 (wave * 64 + lane_id())
    const int G = gridDim.x, bx = blockIdx.x, vcu = (G % 8 == 0) ? (bx % 8) * (G / 8) + bx / 8 : bx;
    constexpr int NCX = 4, NCV = 8 * NCX, NWK = 256 - NCV;
    const bool split = (G == 256); const int idx8 = bx >> 3, xcd8 = bx & 7;
    const bool conv = split && (idx8 >= 32 - NCX);
    const int wk = (idx8 << 3) | xcd8, cvw = ((((idx8 - (32 - NCX)) << 3) | xcd8) * NWAVES) + wave;
    LAS unsigned char* ldsl = (LAS unsigned char*)lds;
    volatile LAS unsigned* MISC = (volatile LAS unsigned*)(ldsl + LDSCTL_OFF);
    for (int u = tid0; u < (LDS_BYTES - LDSCTL_OFF) / 4; u += NWAVES * 64) ((LAS unsigned*)(ldsl + LDSCTL_OFF))[u] = 0u;
    __syncthreads();
    XcdBarrier bar = xcd_barrier_post((unsigned*)(KWS + WS_CTL) + CW_BAR + args.li * BAR_REGION, MISC + 8, wave == 0 ? 1u : 0u);
#define P_WS unsigned char* ws = KWS; unsigned* ctl = (unsigned*)(ws + WS_CTL); (void)ctl
#define P_ACT bf16_t* MEMKV = (bf16_t*)(ws + WS_MEMKV); bf16_t* HM = (bf16_t*)(ws + WS_HM); bf16_t* PROJ = (bf16_t*)(ws + WS_PROJ); bf16_t* OBR = (bf16_t*)(ws + WS_OBR); bf16_t* HMEM = OBR; \
    bf16_t* BUF = (bf16_t*)(ws + WS_BUF); bf16_t* YB = (bf16_t*)(ws + WS_YB); bf16_t* HID = (bf16_t*)(ws + WS_HID); bf16_t* WB = (bf16_t*)(ws + WS_WB); const bf16_t* WBl = WB + (size_t)l_ * WB_LAYER; \
    (void)MEMKV; (void)HM; (void)PROJ; (void)OBR; (void)HMEM; (void)BUF; (void)YB; (void)HID; (void)WBl
#define P_ROUTE int* experts = (int*)(ws + WS_ROUTE + RT_EXP); float* weights = (float*)(ws + WS_ROUTE + RT_WGT); int* rank = (int*)(ws + WS_ROUTE + RT_RANK); float* rstd = (float*)(ws + WS_ROUTE + RT_RSTD); \
    (void)experts; (void)weights; (void)rank; (void)rstd
    const int gw = bx * NWAVES + wave, NGW = G * NWAVES;
    const int lo = args.ph_lo, hi = args.ph_hi;
#ifndef STAGE_MASK
#define STAGE_MASK 0x3FFu
#endif
#define IN(k) (lo <= (k) && (k) < hi)
#define ST(s) ((STAGE_MASK >> (s)) & 1u)
#ifndef REP_MASK
#define REP_MASK 0u
#endif
#define NREP(s) (((REP_MASK >> (s)) & 1u) ? 2 : 1)
#ifndef DBL_BAR
#define DBL_BAR 0
#endif
#define SEAM(k) do { if (IN(k) && IN((k) + 1)) { xcd_barrier(bar); if (DBL_BAR) xcd_barrier(bar); } } while (0)

    if (ST(0) && IN(0))
  for (int rep_ = 0; rep_ < NREP(0); ++rep_) {
        int lane = lane0, tid = tid0; asm volatile("" : "+v"(lane), "+v"(tid));
        constexpr int l_ = 0; P_WS; P_ACT;
        float* tab1 = (float*)(ws + WS_TAB); float* tab2 = tab1 + SEQ * 32 * 2;
        const float* x = KIN(0); const float* mem = KIN(1); const float* mem_g = KIN(2); const float* norm1_g = KIN(4); const float* norm2_g = KIN(17); const float* w_rg = KIN(18); const float* w_re = KIN(20);
        LAS float* scr = (LAS float*)(ldsl + wave * 16640);
        tr_run(split ? 1 : 0, gw, split ? 3840 : 29056, NGW, WB, scr, lane);
        for (int idx = bx * (NWAVES * 64) + tid; idx < SEQ * 32; idx += G * NWAVES * 64) { const int pos = idx >> 5, i = idx & 31; float s, c;
            sincosf((float)pos * inv1d(i), &s, &c); tab1[idx * 2] = c; tab1[idx * 2 + 1] = s;
            sincosf(ang2d(pos, i), &s, &c); tab2[idx * 2] = c; tab2[idx * 2 + 1] = s; }
        for (int idx = bx * (NWAVES * 64) + tid; idx < DEPTH * 48 * 1024; idx += G * NWAVES * 64) { const int l = idx / (48 * 1024), c = (idx >> 10) % 48, k = idx & 1023;
            const float w = c < 4 ? w_rg[((size_t)l * DM + k) * 4 + c] : c < 36 ? w_re[((size_t)l * DM + k) * 32 + (c - 4)] : 0.f, v = w * norm2_g[l * DM + k];
            const bf16_t h = f2bf(v); bf16_t* t = WB + WB_RT + (size_t)l * 2 * 48 * 1024 + (size_t)c * 1024 + k; t[0] = h; t[48 * 1024] = f2bf(v - bf2f(h)); }
        for (int m = 4 * gw; m < M; m += 4 * NGW) rows_rmsnorm<4>(x, norm1_g, HM, m, lane);
        for (int m = gw; m < MM; m += NGW) rows_rmsnorm<1>(mem, mem_g, HMEM, m, lane);
    }
    SEAM(0);
#pragma unroll 1
    for (int l = 0; l < DEPTH; ++l) {
        const int pb = 1 + 9 * l, l_ = l;
        const bool l0s = split, cvt = split && conv;
        if (ST(1) && IN(pb + 0))
      for (int rep_ = 0; rep_ < NREP(1); ++rep_) {
            P_WS; P_ACT; float* tab1 = (float*)(ws + WS_TAB); float* tab2 = tab1 + SEQ * 32 * 2; const float* qn_g = KIN(11); const float* kn_g = KIN(12);
            pg8::Gemm g{DM, DM};
            pg8::SchedProj S{bx, G, 1472, l == 0 ? 1504 : 1472, (const char*)HM, (const char*)(WBl + WB_IN), (const char*)HMEM, (const char*)(WB + WB_MEMKV)};
            pg8::EpiProj E{PROJ, MEMKV, tab1, tab2, qn_g + l * 64, kn_g + l * 64};
            pg8::gemm_phase<pg8::EpiProj, pg8::SchedProj, true, true>(ldsl, g, S, E, wave);
        }
        SEAM(pb + 0);
        if (ST(2) && IN(pb + 1))
      for (int rep_ = 0; rep_ < NREP(2); ++rep_) {
            int lane = lane0; asm volatile("" : "+v"(lane));
            if (cvt) { P_WS; P_ACT; tr_run(2 + l, cvw, l == 0 ? 12928 : 12288, NCV * NWAVES, WB, (LAS float*)(ldsl + wave * 16640), lane); } else {
            P_WS; P_ACT; const float* lq1 = KIN(6); const float* lk1 = KIN(7); const float* lq2 = KIN(8); const float* lk2 = KIN(9); const float* subln_g = KIN(10);
            const float lam_init = 0.8f - 0.6f * __expf(-0.3f * (float)l);
            const float lam = __expf(wave_sum(lq1[l * 64 + lane] * lk1[l * 64 + lane])) - __expf(wave_sum(lq2[l * 64 + lane] * lk2[l * 64 + lane])) + lam_init;
            constexpr int NS = NWK - NCV, NB3 = 512 - 2 * NS, NCW = NS - NB3;
            static_assert(NB3 >= 0 && NB3 <= NS && NCW > 0, "attention deal");
            for (int jj = l0s ? 0 : vcu; jj < (l0s ? 1 : 256); jj += (l0s ? 1 : G)) {
                const int w = wk - NCV, wc_ = w - NB3;
                const int c_lo = l0s && wc_ >= 0 ? (wc_ * 256) / NCW : 0, c_hi = l0s && wc_ >= 0 ? ((wc_ + 1) * 256) / NCW : 0;
                const int na = l0s ? (wk < NCV ? 2 : 1) : 1, nb = l0s ? (wk < NCV ? 0 : (w < NB3 ? 3 : 2)) : 2, nc = l0s ? c_hi - c_lo : 1;
#pragma unroll 1
                for (int i = 0; i < na; ++i) { const int j = l0s ? (i == 0 ? wk : NWK + wk) : jj; att::unit_a(PROJ, OBR, j >> 5, (j >> 3) & 3, j & 7, lam, lam_init, subln_g + l * 128, (char*)lds, wave); }
#pragma unroll 1
                for (int i = 0; i < nb; ++i) { const int j = l0s ? (i < 2 ? 2 * w + i : 2 * NS + w) : 2 * jj + i; att::unit_b(PROJ, OBR, j >> 6, (j >> 3) & 7, j & 7, (char*)lds, wave); }
#pragma unroll 1
                for (int i = 0; i < nc; ++i) { const int j = l0s ? c_lo + i : jj; att::unit_c(PROJ, MEMKV, OBR, j >> 5, (j >> 3) & 3, j & 7, (char*)lds, wave); }
            }
            __syncthreads();
            }
        }
        SEAM(pb + 1);
        if (ST(3) && IN(pb + 2))
      for (int rep_ = 0; rep_ < NREP(3); ++rep_) {
            P_WS; P_ACT;
            pg8::Gemm g{OBR_W, 512};
            pg8::SchedGate S{bx, G, (const char*)OBR, (const char*)(WBl + WB_UP)};
            pg8::EpiGate E{HM, PROJ};
            pg8::gemm_phase<pg8::EpiGate, pg8::SchedGate, true, true>(ldsl, g, S, E, wave);
        }
        SEAM(pb + 2);
        if (ST(4) && IN(pb + 3)) {
            P_WS; P_ACT; const float* x = KIN(0); bf16_t* XB = (bf16_t*)KOUT;
            pg8::Gemm g{DM, DM};
            pg8::SchedPlain S{bx, G, M / 256, (const char*)HM, (const char*)(WBl + WB_OUT), (size_t)256 * DM * 2, (size_t)256 * DM * 2};
            pg8::EpiResid E{x, XB, l == 0 ? 1 : 0};
            pg8::gemm_phase<pg8::EpiResid, pg8::SchedPlain, true, true>(ldsl, g, S, E, wave);
        }
        SEAM(pb + 3);
        if (ST(5) && IN(pb + 4)) {
            int tid = tid0; asm volatile("" : "+v"(tid));
            const int lane = tid & 63;
            P_WS; P_ACT; P_ROUTE; const bf16_t* X = (const bf16_t*)KOUT; const float* b_rg = KIN(19); const float* b_re = KIN(21); const float* norm2_g = KIN(17);
            const bf16_t* tab = WB + WB_RT + (size_t)l * 2 * 48 * 1024 + (size_t)(lane & 15) * 1024 + 128 * wave + 8 * (lane >> 4);
            bf16x8 Bh[3][4], Bl[3][4];
#pragma unroll
            for (int t = 0; t < 3; ++t)
#pragma unroll
                for (int sI = 0; sI < 4; ++sI) { Bh[t][sI] = *(const bf16x8*)(tab + (size_t)t * 16 * 1024 + 32 * sI); Bl[t][sI] = *(const bf16x8*)(tab + (size_t)(48 + t * 16) * 1024 + 32 * sI); }
            for (int rb = bx; rb < M / 64; rb += G)
                route_block(X, tab, b_rg + l * 4, b_re + l * 32, experts, weights, rank, ctl + CW_CNT + 2048 * l, rstd, (int*)BUF, norm2_g + l * DM, HM, rb, Bh, Bl, (LAS float*)ldsl, tid, wave);
        }
        SEAM(pb + 4);
        volatile LAS int* mt = (volatile LAS int*)(ldsl + LDSCTL_OFF + 256);
        LAS unsigned* rowtab = (LAS unsigned*)(ldsl + LDSCTL_OFF + 2048); LAS float* wtab = (LAS float*)(ldsl + LDSCTL_OFF + 6144);
        if (ST(7) && IN(pb + 6)) {
            int tid = tid0; asm volatile("" : "+v"(tid));
            P_WS; P_ACT; P_ROUTE;
            moe_tables(ctl + CW_CNT + 2048 * l, mt, tid);
            moe_rowtabs(mt, (const int*)BUF, weights, rowtab, wtab, vcu, G, tid, 1);
            const int ntiles = __builtin_amdgcn_readfirstlane(mt[256]);
            pg8::Gemm g{DM, DM};
            pg8::SchedMoeUp S{vcu, G, ntiles, (const LAS int*)(ldsl + LDSCTL_OFF + 256 + 96 * 4), (const char*)HM, (const char*)(WBl + WB_GU), ctl + CW_TCNT + l * 160 * 64};
            pg8::EpiSilu E{HID};
            pg8::gemm_phase<pg8::EpiSilu, pg8::SchedMoeUp, true, true, true>(ldsl, g, S, E, wave, rowtab);
        }
        if (ST(8) && IN(pb + 7)) {
            int tid = tid0; asm volatile("" : "+v"(tid));
            P_WS; P_ACT; P_ROUTE;
            if (!(ST(7) && IN(pb + 6))) moe_tables(ctl + CW_CNT + 2048 * l, mt, tid);
            moe_rowtabs(mt, (const int*)BUF, weights, rowtab, wtab, vcu, G, tid, 0);
            const int ntiles = __builtin_amdgcn_readfirstlane(mt[256]);
            pg8::Gemm g{DEXP, DEXP};
            pg8::SchedMoeDown S{vcu, G, ntiles, (ntiles * 4) % G, wave, (const LAS int*)(ldsl + LDSCTL_OFF + 256 + 96 * 4), (const char*)HID, (const char*)(WBl + WB_DN), ctl + CW_TCNT + l * 160 * 64, ctl + CW_TMO};
            pg8::EpiRowScale E{YB, wtab};
            pg8::gemm_phase<pg8::EpiRowScale, pg8::SchedMoeDown, true, true>(ldsl, g, S, E, wave);
        }
        SEAM(pb + 7);
        if (ST(9) && IN(pb + 8)) {
            int lane = lane0; asm volatile("" : "+v"(lane));
            P_WS; P_ACT; P_ROUTE; float* OUTP = KOUT; bf16_t* XB = (bf16_t*)OUTP; const float* norm1_g = KIN(4); const float* final_g = KIN(25);
            const bool last = (l == DEPTH - 1);
            const bool poison = last && ((__hip_atomic_load(ctl + CW_BAR + args.li * BAR_REGION + XB_TMO, __ATOMIC_RELAXED, __HIP_MEMORY_SCOPE_AGENT) | __hip_atomic_load(ctl + CW_TMO, __ATOMIC_RELAXED, __HIP_MEMORY_SCOPE_AGENT)) != 0u);
            if (!(ST(7) && IN(pb + 6)) && !(ST(8) && IN(pb + 7))) moe_tables(ctl + CW_CNT + 2048 * l, mt, tid0);
            static_assert(M % 4 == 0, "rows come in fours");
            for (int m = 4 * gw; m < M; m += 4 * NGW) {
                const u32x4 ex0 = *(const u32x4*)(experts + 2 * m), ex1 = *(const u32x4*)(experts + 2 * m + 4), rk0 = *(const u32x4*)(rank + 2 * m), rk1 = *(const u32x4*)(rank + 2 * m + 4);
                const int rows[4] = {m, m + 1, m + 2, m + 3};
                const int d0[4] = {mt[ex0.x] + (int)rk0.x, mt[ex0.z] + (int)rk0.z, mt[ex1.x] + (int)rk1.x, mt[ex1.z] + (int)rk1.z}, d1[4] = {mt[ex0.y] + (int)rk0.y, mt[ex0.w] + (int)rk0.w, mt[ex1.y] + (int)rk1.y, mt[ex1.w] + (int)rk1.w};
                rows_combine_norm<4>(XB, YB, last ? final_g : norm1_g + (l + 1) * DM, last ? nullptr : HM, OUTP, rows, lane, poison, d0, d1); }
        }
        SEAM(pb + 8);
    }
#undef IN
#undef SEAM
#undef lane0
#undef tid0
#undef P_WS
#undef P_ACT
#undef P_ROUTE
}

extern "C" void kernel_launch(void* const* d_in, const int* in_sizes, int n_in, void* d_out, int out_size, void* d_ws, size_t ws_size, hipStream_t stream) {
    if (n_in != 26 || in_sizes[0] != M * DM || out_size != M * DM || ws_size < WS_END) { fprintf(stderr, "kernel_launch: unexpected shapes n_in %d out %d ws %zu (need %zu)\n", n_in, out_size, ws_size, (size_t)WS_END); return; }
    static int grid = 0;
    if (grid == 0) {
        int dev = 0, cus = 0;
        if (hipGetDevice(&dev) != hipSuccess || hipDeviceGetAttribute(&cus, hipDeviceAttributeMultiprocessorCount, dev) != hipSuccess) { grid = -1; return; }
        if (hipFuncSetAttribute((const void*)mk_fwd, hipFuncAttributeMaxDynamicSharedMemorySize, LDS_BYTES) != hipSuccess) { fprintf(stderr, "kernel_launch: hipFuncSetAttribute failed\n"); grid = -1; return; }
        int per_cu = 0;
        if (hipOccupancyMaxActiveBlocksPerMultiprocessor(&per_cu, (const void*)mk_fwd, NWAVES * 64, LDS_BYTES) != hipSuccess || per_cu < 1) fprintf(stderr, "kernel_launch: occupancy query says %d\n", per_cu);
        (void)hipGetLastError();
        grid = cus;
    }
    if (grid < 0) return;
    (void)hipMemsetAsync((unsigned char*)d_ws + WS_CTL, 0, MiB, stream);
    Args a{};
    for (int i = 0; i < 26; ++i) a.in[i] = (const float*)d_in[i];
    a.out = (float*)d_out; a.ws = (unsigned char*)d_ws; a.ph_lo = 0; a.ph_hi = N_PHASES; a.li = 0; a.pad = 0;
    hipLaunchKernelGGL(mk_fwd, dim3(grid), dim3(NWAVES * 64), LDS_BYTES, stream, a);
}
```

```cpp
#include <hip/hip_runtime.h>
#include <cstdint>
#include <cstdio>
#include <cmath>
#include <cstddef>

typedef unsigned short bf16_t;
typedef float f32x4 __attribute__((ext_vector_type(4)));
typedef unsigned u32x4 __attribute__((ext_vector_type(4)));
typedef unsigned u32x2 __attribute__((ext_vector_type(2)));

constexpr int BATCH = 8, SEQ = 2048, DM = 1024, DEPTH = 2, MEM_LEN = 256;
constexpr int M = BATCH * SEQ;
constexpr int MM = BATCH * MEM_LEN;
constexpr int D_IN = 5888;
constexpr int C_AQ = 0, C_AK = 512, C_AV = 1024, C_BQ = 1536, C_BK = 2048, C_BV = 2176, C_CQ = 2304, C_G = 2816;
constexpr int OBR_W = 1536;
constexpr int NEXP = 32, DEXP = 512;
constexpr int MOE_TILE = 256;
constexpr int P_ROWS = M * 2 + NEXP * MOE_TILE;
constexpr int MAX_TILES = P_ROWS / MOE_TILE;
constexpr float EPS = 1e-6f;
constexpr float LOG2E = 1.4426950408889634f;
constexpr float C2_64 = 0.125f * LOG2E;
constexpr float C2_128 = 0.08838834764831845f * LOG2E;

constexpr size_t MiB = 1u << 20;
constexpr size_t WS_CTL = 0;
constexpr size_t WS_ROUTE = 1 * MiB;
constexpr size_t WS_TAB = 2 * MiB;
constexpr size_t WS_MEMKV = 3 * MiB;
constexpr size_t WS_HM = 7 * MiB;
constexpr size_t WS_PROJ = 39 * MiB;
constexpr size_t WS_OBR = 223 * MiB;
constexpr size_t WS_WB = 271 * MiB;
constexpr size_t WS_END = 499 * MiB;
constexpr size_t WS_BUF = WS_PROJ;
constexpr size_t WS_YB = WS_PROJ + 80 * MiB;
constexpr size_t WS_HID = WS_OBR;
constexpr size_t RT_EXP = 0;
constexpr size_t RT_WGT = 128 * 1024;
constexpr size_t RT_RANK = 256 * 1024;
constexpr size_t RT_DEST = 384 * 1024;
constexpr size_t RT_ROWW = 512 * 1024;
constexpr size_t RT_TILE = 700 * 1024;
constexpr size_t RT_RSTD = 768 * 1024;
constexpr int CW_CNT = 163840;
constexpr int CW_TMO = 128;
constexpr int CW_TCNT = 131072;

__device__ __forceinline__ float bf2f(bf16_t v) { return __uint_as_float(((unsigned)v) << 16); }
__device__ __forceinline__ bf16_t f2bf(float f) { unsigned u = __float_as_uint(f); return (bf16_t)((u + 0x7fffu + ((u >> 16) & 1u)) >> 16); }
__device__ __forceinline__ float wave_sum(float v) {
#pragma unroll
    for (int o = 1; o < 64; o <<= 1) v += __shfl_xor(v, o);
    return v;
}
__device__ __forceinline__ float wave_max(float v) {
#pragma unroll
    for (int o = 1; o < 64; o <<= 1) v = fmaxf(v, __shfl_xor(v, o));
    return v;
}
__device__ __forceinline__ float inv1d(int i) { return exp2f(-(float)i * (13.287712379549449f / 32.f)); }
__device__ __forceinline__ float inv2d(int j) { return exp2f(-(float)j * (13.287712379549449f / 16.f)); }
__device__ __forceinline__ float ang2d(int pos, int i) { return i < 16 ? (float)(pos >> 6) * inv2d(i) : (float)(pos & 63) * inv2d(i - 16); }

#define LAS __attribute__((address_space(3)))
#define GAS __attribute__((address_space(1)))
typedef short bf16x8 __attribute__((ext_vector_type(8)));
typedef short s16x4 __attribute__((ext_vector_type(4)));
typedef float f32x16 __attribute__((ext_vector_type(16)));
typedef float f32x2 __attribute__((ext_vector_type(2)));

constexpr size_t WB_IN = 0, WB_UP = 6029312, WB_OUT = WB_UP + 1572864, WB_GU = WB_OUT + 1048576, WB_DN = WB_GU + 33554432, WB_LAYER = WB_DN + 16777216;
constexpr size_t WB_MEMKV = 2 * WB_LAYER;
constexpr size_t WB_RT = WB_MEMKV + 1048576;
static_assert(WS_WB + (WB_RT + 2 * 2 * 48 * 1024) * 2 <= WS_END, "weight copies fit");
constexpr int N_PHASES = 19;
constexpr int XP = 2048;
constexpr int LCAP = 16384;

__device__ __forceinline__ int lane_id() { int r; asm volatile("v_mbcnt_lo_u32_b32 %0, -1, 0\n\tv_mbcnt_hi_u32_b32 %0, -1, %0" : "=v"(r)); return r; }
__device__ __forceinline__ unsigned cvt_pk_bf16(float lo, float hi) { unsigned r; asm volatile("v_cvt_pk_bf16_f32 %0, %1, %2" : "=v"(r) : "v"(lo), "v"(hi)); return r; }
__device__ __forceinline__ float fast_sigmoid(float v) { return __builtin_amdgcn_rcpf(1.f + __builtin_amdgcn_exp2f(-v * LOG2E)); }

namespace pg8 {
#define PG8_LAS LAS
constexpr int BM = 256, BK = 64, HALF = 128, HTB = HALF * BK * 2, STAGE_BYTES = 8 * HTB, NXCD = 8, WGM = 8;
__host__ __device__ __forceinline__ int lds_byte(int r, int c) { const int st = (r >> 4) * 2 + (c >> 5), rr = r & 15, cc = c & 31, ob = rr * 64 + cc * 2; return st * 1024 + (ob ^ (((ob >> 9) & 1) << 5)); }
__host__ __device__ __forceinline__ void stage_rc(int b, int& R, int& C) { const int st = b / 1024, sb = b % 1024, swz = sb ^ (((sb >> 9) & 1) << 5); R = (st >> 1) * 16 + swz / 64; C = (st & 1) * 32 + (swz % 64) / 2; }
__host__ __device__ __forceinline__ int perm32(int rho) { const int n = rho >> 4, i = rho & 15; return 8 * (i >> 2) + 4 * n + (i & 3); }

struct Unit { int pm, pn, sub, ord; const char* a; const char* b; };
struct Gemm { int lda; int K; };
__device__ __forceinline__ void tile_order(int L, int nM, int nN, int& pm, int& pn) {
    const int nwg = nM * nN; int wgid = L; { const int q = nwg / NXCD, r = nwg % NXCD, xcd = wgid % NXCD, off = wgid / NXCD; wgid = (xcd < r ? xcd * (q + 1) : r * (q + 1) + (xcd - r) * q) + off; }
    const int nig = WGM * nN, gid = wgid / nig, fm = gid * WGM, gsz = (nM - fm) < WGM ? (nM - fm) : WGM;
    pm = fm + ((wgid % nig) % gsz); pn = (wgid % nig) / gsz;
}
__device__ __forceinline__ u32x4 pack8(const f32x4& v0, const f32x4& v1) { u32x4 w; w.x = cvt_pk_bf16(v0[0], v0[1]); w.y = cvt_pk_bf16(v0[2], v0[3]); w.z = cvt_pk_bf16(v1[0], v1[1]); w.w = cvt_pk_bf16(v1[2], v1[3]); return w; }
__device__ __forceinline__ void unpack8(const u32x4& w, f32x4& v0, f32x4& v1) {
    v0[0] = __uint_as_float(w.x << 16); v0[1] = __uint_as_float(w.x & 0xffff0000u); v0[2] = __uint_as_float(w.y << 16); v0[3] = __uint_as_float(w.y & 0xffff0000u);
    v1[0] = __uint_as_float(w.z << 16); v1[1] = __uint_as_float(w.z & 0xffff0000u); v1[2] = __uint_as_float(w.w << 16); v1[3] = __uint_as_float(w.w & 0xffff0000u); }

struct EpiProj {
    static constexpr bool PERM = true, AFTER_DRAIN = false;
    bf16_t* PROJ; bf16_t* MEMKV; const float* tab1; const float* tab2; const float* qg; const float* kg;
    __device__ __forceinline__ void operator()(const f32x4 (&acc)[2][2][4][2], const Unit& u, int wr, int wc, int fr, int fq) const {
        const int colt = u.pn * 256, dcol = colt + wc * 64 + fq * 8, row0 = u.pm * 256 + wr * 64 + fr;
        if (u.sub == 1) {
#pragma unroll
            for (int ai = 0; ai < 2; ++ai)
#pragma unroll
                for (int m = 0; m < 4; ++m) { bf16_t* rowp = MEMKV + (size_t)(row0 + ai * 128 + m * 16) * 1024 + dcol;
#pragma unroll
                    for (int bj = 0; bj < 2; ++bj) *(u32x4*)(rowp + bj * 32) = pack8(acc[ai][bj][m][0], acc[ai][bj][m][1]); }
            return;
        }
        int mode = 0; float sc = 1.f; const float* g = qg;
        if (colt < C_AV) { mode = 1; if (colt < C_AK) sc = C2_64; }
        else if (colt < C_BQ) mode = 0;
        else if (colt < C_BK) { mode = 2; sc = C2_64; }
        else if (colt < C_CQ) { if (wc < 2) { mode = 2; g = kg; } }
        else if (colt < C_G) sc = C2_128;
        else mode = 3;
        f32x4 gv[2][2];
        if (mode == 2) {
#pragma unroll
            for (int bj = 0; bj < 2; ++bj)
#pragma unroll
                for (int n = 0; n < 2; ++n) gv[bj][n] = *(const f32x4*)(g + bj * 32 + fq * 8 + n * 4);
        }
#pragma unroll
        for (int ai = 0; ai < 2; ++ai)
#pragma unroll
            for (int m = 0; m < 4; ++m) {
                const int row = row0 + ai * 128 + m * 16, pos = row & (SEQ - 1);
                f32x4 v[2][2] = {{acc[ai][0][m][0], acc[ai][0][m][1]}, {acc[ai][1][m][0], acc[ai][1][m][1]}};
                if (mode == 2) {
                    float ss = 0.f;
#pragma unroll
                    for (int bj = 0; bj < 2; ++bj)
#pragma unroll
                        for (int n = 0; n < 2; ++n) ss += (v[bj][n][0] * v[bj][n][0] + v[bj][n][1] * v[bj][n][1]) + (v[bj][n][2] * v[bj][n][2] + v[bj][n][3] * v[bj][n][3]);
                    ss += __shfl_xor(ss, 16); ss += __shfl_xor(ss, 32);
                    const float rs = rsqrtf(ss * (1.f / 64.f) + EPS);
#pragma unroll
                    for (int bj = 0; bj < 2; ++bj)
#pragma unroll
                        for (int n = 0; n < 2; ++n) v[bj][n] = v[bj][n] * rs * gv[bj][n];
                }
                if (mode == 1 || mode == 2) {
                    const float* tb = (mode == 1 ? tab1 : tab2) + ((size_t)pos * 32 + fq * 8) * 2;
#pragma unroll
                    for (int n = 0; n < 2; ++n) { const f32x4 t0 = *(const f32x4*)(tb + n * 8), t1 = *(const f32x4*)(tb + n * 8 + 4);
                        const float cs[4] = {t0[0], t0[2], t1[0], t1[2]}, sn[4] = {t0[1], t0[3], t1[1], t1[3]};
#pragma unroll
                        for (int e = 0; e < 4; ++e) { const float x1 = v[0][n][e], x2 = v[1][n][e]; v[0][n][e] = x1 * cs[e] - x2 * sn[e]; v[1][n][e] = x2 * cs[e] + x1 * sn[e]; } }
                }
                if (mode == 3) {
#pragma unroll
                    for (int bj = 0; bj < 2; ++bj)
#pragma unroll
                        for (int n = 0; n < 2; ++n)
#pragma unroll
                            for (int e = 0; e < 4; ++e) v[bj][n][e] = fast_sigmoid(v[bj][n][e]);
                }
                bf16_t* rowp = PROJ + (size_t)row * D_IN + dcol;
#pragma unroll
                for (int bj = 0; bj < 2; ++bj) *(u32x4*)(rowp + bj * 32) = pack8(v[bj][0] * sc, v[bj][1] * sc);
            }
    }
};
struct EpiGate {
    static constexpr bool PERM = true, AFTER_DRAIN = false;
    bf16_t* MERGED; const bf16_t* PROJ;
    __device__ __forceinline__ void operator()(const f32x4 (&acc)[2][2][4][2], const Unit& u, int wr, int wc, int fr, int fq) const {
        const int col0 = u.pn * 256 + wc * 32 + fq * 8, row0 = u.pm * 256 + wr * 64 + fr;
#pragma unroll
        for (int ai = 0; ai < 2; ++ai)
#pragma unroll
            for (int mp = 0; mp < 2; ++mp) {
                u32x4 gq[2][2], oq[2][2];
#pragma unroll
                for (int mi = 0; mi < 2; ++mi) { const int row = row0 + ai * 128 + (mp * 2 + mi) * 16;
                    const bf16_t* gp = PROJ + (size_t)row * D_IN + C_G + u.sub * 1024 + col0; const bf16_t* op = MERGED + (size_t)row * DM + col0;
#pragma unroll
                    for (int bj = 0; bj < 2; ++bj) { gq[mi][bj] = *(const u32x4*)(gp + bj * 128); if (u.sub != 0) oq[mi][bj] = *(const u32x4*)(op + bj * 128); else oq[mi][bj] = (u32x4){0u, 0u, 0u, 0u}; } }
                asm volatile("" ::: "memory");
#pragma unroll
                for (int mi = 0; mi < 2; ++mi) { const int m = mp * 2 + mi; bf16_t* op = MERGED + (size_t)(row0 + ai * 128 + m * 16) * DM + col0;
#pragma unroll
                    for (int bj = 0; bj < 2; ++bj) { f32x4 g0, g1, o0, o1; unpack8(gq[mi][bj], g0, g1); unpack8(oq[mi][bj], o0, o1);
                        o0 += g0 * acc[ai][bj][m][0]; o1 += g1 * acc[ai][bj][m][1];
                        *(u32x4*)(op + bj * 128) = pack8(o0, o1); } }
                asm volatile("" ::: "memory");
            }
    }
};
struct EpiResid {
    static constexpr bool PERM = true, AFTER_DRAIN = false;
    const float* Xf; bf16_t* XB; int first;
    __device__ __forceinline__ void operator()(const f32x4 (&acc)[2][2][4][2], const Unit& u, int wr, int wc, int fr, int fq) const {
        const int col0 = u.pn * 256 + wc * 32 + fq * 8, row0 = u.pm * 256 + wr * 64 + fr;
#pragma unroll
        for (int ai = 0; ai < 2; ++ai)
#pragma unroll
            for (int mp = 0; mp < 2; ++mp) {
                f32x4 xin[2][2][2];
                if (first) {
#pragma unroll
                    for (int mi = 0; mi < 2; ++mi) { const size_t off = (size_t)(row0 + ai * 128 + (mp * 2 + mi) * 16) * DM + col0;
#pragma unroll
                        for (int bj = 0; bj < 2; ++bj) { const f32x4* pi = (const f32x4*)(Xf + off + bj * 128); xin[mi][bj][0] = pi[0]; xin[mi][bj][1] = pi[1]; } }
                } else {
                    u32x4 xq[2][2];
#pragma unroll
                    for (int mi = 0; mi < 2; ++mi)
#pragma unroll
                        for (int bj = 0; bj < 2; ++bj) xq[mi][bj] = *(const u32x4*)(XB + (size_t)(row0 + ai * 128 + (mp * 2 + mi) * 16) * XP + col0 + bj * 128);
                    asm volatile("" ::: "memory");
#pragma unroll
                    for (int mi = 0; mi < 2; ++mi)
#pragma unroll
                        for (int bj = 0; bj < 2; ++bj) unpack8(xq[mi][bj], xin[mi][bj][0], xin[mi][bj][1]);
                }
                asm volatile("" ::: "memory");
#pragma unroll
                for (int mi = 0; mi < 2; ++mi) { const int m = mp * 2 + mi;
#pragma unroll
                    for (int bj = 0; bj < 2; ++bj) *(u32x4*)(XB + (size_t)(row0 + ai * 128 + m * 16) * XP + col0 + bj * 128) = pack8(xin[mi][bj][0] + acc[ai][bj][m][0], xin[mi][bj][1] + acc[ai][bj][m][1]); }
                asm volatile("" ::: "memory");
            }
    }
};
struct EpiSilu {
    static constexpr bool PERM = true, AFTER_DRAIN = false;
    bf16_t* HID;
    __device__ __forceinline__ void operator()(const f32x4 (&acc)[2][2][4][2], const Unit& u, int wr, int wc, int fr, int fq) const {
        const __amdgpu_buffer_rsrc_t rsrc = __builtin_amdgcn_make_buffer_rsrc((void*)HID, 0, P_ROWS * DEXP * 2, 0x00020000);
        const int col0 = u.pn * 128 + wc * 32 + fq * 8, row0 = u.pm * 256 + wr * 64 + fr;
#pragma unroll
        for (int ai = 0; ai < 2; ++ai)
#pragma unroll
            for (int m = 0; m < 4; ++m) { f32x4 h[2];
#pragma unroll
                for (int n = 0; n < 2; ++n)
#pragma unroll
                    for (int e = 0; e < 4; ++e) { const float gq = acc[ai][0][m][n][e]; h[n][e] = gq * fast_sigmoid(gq) * acc[ai][1][m][n][e]; }
                __builtin_amdgcn_raw_buffer_store_b128(pack8(h[0], h[1]), rsrc, ((row0 + ai * 128 + m * 16) * DEXP + col0) * 2, 0, 16); }
    }
};
struct EpiRowScale {
    static constexpr bool PERM = true, AFTER_DRAIN = false;
    bf16_t* YB; const PG8_LAS float* wtab;
    __device__ __forceinline__ void operator()(const f32x4 (&acc)[2][2][4][2], const Unit& u, int wr, int wc, int fr, int fq) const {
        const int col0 = u.pn * 256 + wc * 32 + fq * 8, rt0 = wr * 64 + fr;
#pragma unroll
        for (int ai = 0; ai < 2; ++ai)
#pragma unroll
            for (int m = 0; m < 4; ++m) { const int rt = rt0 + ai * 128 + m * 16; const float w = wtab[u.ord * 256 + rt]; bf16_t* op = YB + (size_t)(u.pm * 256 + rt) * DM + col0;
#pragma unroll
                for (int bj = 0; bj < 2; ++bj) *(u32x4*)(op + bj * 128) = pack8(acc[ai][bj][m][0] * w, acc[ai][bj][m][1] * w); }
    }
};
struct SchedProj {
    int c, G, nmain, ntotal; const char* A; const char* B; const char* Am; const char* Bm;
    __device__ __forceinline__ bool next(int i, Unit& u) const {
        const long L = (long)i * G + c; if (L >= ntotal) return false;
        u.ord = i;
        if (L < nmain) { tile_order((int)L, M / 256, D_IN / 256, u.pm, u.pn); u.sub = 0; u.a = A + (size_t)u.pm * (256 * DM * 2); u.b = B + (size_t)u.pn * (256 * DM * 2); }
        else { const int r = (int)L - nmain; u.pm = r >> 2; u.pn = r & 3; u.sub = 1; u.a = Am + (size_t)u.pm * (256 * DM * 2); u.b = Bm + (size_t)u.pn * (256 * DM * 2); }
        return true; }
    __device__ __forceinline__ void a_ready(const Unit&) const {}
    __device__ __forceinline__ void done(const Unit&) const {}
};
struct SchedGate {
    int c, G; const char* OBRp; const char* WUP;
    __device__ __forceinline__ bool next(int i, Unit& u) const {
        const int t = c + G * (i / 3); if (t >= 256) return false;
        tile_order(t, M / 256, 4, u.pm, u.pn); u.sub = i % 3; u.ord = i;
        u.a = OBRp + ((size_t)u.pm * 256 * OBR_W + 512 * u.sub) * 2; u.b = WUP + ((size_t)u.sub * 1024 * 512 + (size_t)u.pn * 256 * 512) * 2; return true; }
    __device__ __forceinline__ void a_ready(const Unit&) const {}
    __device__ __forceinline__ void done(const Unit&) const {}
};
struct SchedPlain {
    int c, G, nM; const char* A; const char* B; size_t a_tile, b_tile;
    __device__ __forceinline__ bool next(int i, Unit& u) const {
        const long L = (long)i * G + c; if (L >= (long)nM * 4) return false;
        tile_order((int)L, nM, 4, u.pm, u.pn); u.sub = 0; u.ord = i; u.a = A + (size_t)u.pm * a_tile; u.b = B + (size_t)u.pn * b_tile; return true; }
    __device__ __forceinline__ void a_ready(const Unit&) const {}
    __device__ __forceinline__ void done(const Unit&) const {}
};
struct SchedMoeUp {
    static constexpr size_t b_exp = (size_t)1024 * 1024 * 2, b_tile = (size_t)256 * DM * 2;
    int c, G, ntiles; const PG8_LAS int* tile_e; const char* A; const char* B; unsigned* tcnt;
    __device__ __forceinline__ bool next(int i, Unit& u) const {
        const long L = (long)i * G + c; if (L >= (long)ntiles * 4) return false;
        u.pm = (int)(L >> 2); u.pn = (int)(L & 3); u.sub = 0; u.ord = i; const int e = tile_e[u.pm];
        u.a = A; u.b = B + (size_t)e * b_exp + (size_t)u.pn * b_tile; return true; }
    __device__ __forceinline__ void a_ready(const Unit&) const {}
    __device__ __forceinline__ void done(const Unit& u) const {
        asm volatile("s_waitcnt vmcnt(0)" ::: "memory");
        if (lane_id() == 0) __hip_atomic_fetch_add(tcnt + 64 * u.pm, 1u, __ATOMIC_RELAXED, __HIP_MEMORY_SCOPE_AGENT);
    }
};
__device__ __forceinline__ int moe_down_unit(int c, int i, int rem, int G) {
    const int n0 = G - rem, n1 = rem;
    return c >= rem ? n0 * i + n1 * (i > 1 ? i - 1 : 0) + (c - rem) : n0 * (i + 2) + n1 * i + c;
}
struct SchedMoeDown {
    static constexpr size_t a_tile = (size_t)256 * DEXP * 2, b_exp = (size_t)1024 * 512 * 2, b_tile = (size_t)256 * DEXP * 2;
    int c, G, ntiles, rem, wv; const PG8_LAS int* tile_e; const char* A; const char* B; unsigned* tcnt; unsigned* tmo;
    __device__ __forceinline__ bool next(int i, Unit& u) const {
        const int j = moe_down_unit(c, i, rem, G); if (j >= ntiles * 4) return false;
        u.pm = j >> 2; u.pn = j & 3; u.sub = 0; u.ord = i; const int e = tile_e[u.pm];
        u.a = A + (size_t)u.pm * a_tile; u.b = B + (size_t)e * b_exp + (size_t)u.pn * b_tile; return true; }
    __device__ __forceinline__ void a_ready(const Unit& u) const {
        if (wv == 0) {
            unsigned polls = 0;
            while ((unsigned)__builtin_amdgcn_readfirstlane(__hip_atomic_load(tcnt + 64 * u.pm, __ATOMIC_RELAXED, __HIP_MEMORY_SCOPE_AGENT)) < 32u) {
                if (++polls > (1u << 20)) { if (lane_id() == 0) __hip_atomic_store(tmo, 1u, __ATOMIC_RELAXED, __HIP_MEMORY_SCOPE_AGENT); break; }
                __builtin_amdgcn_s_sleep(2); }
            __builtin_amdgcn_fence(__ATOMIC_ACQUIRE, "agent");
            asm volatile("s_waitcnt vmcnt(0)" ::: "memory");
        }
        asm volatile("" ::: "memory"); __builtin_amdgcn_s_barrier(); asm volatile("" ::: "memory");
    }
    __device__ __forceinline__ void done(const Unit&) const {}
};

template <class Epi, class Sched, bool ALIGN_EPI = false, bool SP2 = false, bool GATHER = false>
__device__ __forceinline__ void gemm_phase(PG8_LAS unsigned char* lds, const Gemm g, const Sched& S, const Epi& E, int wave_id, const PG8_LAS unsigned* rowtab = nullptr) {
    static_assert(!GATHER || SP2, "the gathered A path is written for the two-super-phase loop");
    int tid_ = wave_id * 64 + lane_id(); asm volatile("" : "+v"(tid_));
    const int tid = tid_, wid = __builtin_amdgcn_readfirstlane(tid >> 6), lane = tid & 63, wr = wid >> 2, wc = wid & 3, fr = lane & 15, fq = lane >> 4;
    const int K = g.K, nt = K / BK;
    unsigned voffA[2], voffB[2];
#pragma unroll
    for (int i = 0; i < 2; ++i) { int R, C; stage_rc(tid * 16 + i * 8192, R, C); const int Rb = Epi::PERM ? ((R & ~31) + perm32(R & 31)) : R;
        voffA[i] = (unsigned)(R * g.lda + C) * 2u; voffB[i] = (unsigned)(Rb * K + C) * 2u; }
    unsigned gC[2][2] = {{0u, 0u}, {0u, 0u}}, gN[2][2] = {{0u, 0u}, {0u, 0u}};
#define PG8_GROWS(dst, ord) do { if constexpr (GATHER) { _Pragma("unroll") for (int i_ = 0; i_ < 2; ++i_) { int R_, C_; stage_rc((wid * 64 + fq * 16 + fr) * 16 + i_ * 8192, R_, C_);     \
        _Pragma("unroll") for (int h_ = 0; h_ < 2; ++h_) dst[h_][i_] = rowtab[(ord) * 256 + h_ * 128 + R_] + (unsigned)C_ * 2u; } } } while (0)
#define PG8_STAGE_A(bufoff, base, h, use_next) do { if constexpr (GATHER) { unsigned vo_[2]; vo_[0] = (use_next) ? gN[h][0] : gC[h][0]; vo_[1] = (use_next) ? gN[h][1] : gC[h][1]; PG8_STAGE(bufoff, base, vo_); } \
        else { PG8_STAGE(bufoff, (base) + (h) * hstepA, voffA); } } while (0)
    const size_t kstep = (size_t)(BK * 2);
    const size_t hstepA = (size_t)HALF * g.lda * 2, hstepB = (size_t)HALF * K * 2;
    const unsigned ldsw = (unsigned)wid * 1024u;
    const int aoff = lds_byte(wr * 64 + fr, fq * 8), boff = lds_byte(wc * 32 + fr, fq * 8);
#define PG8_SA(b, h) (((b) * 2 + (h)) * HTB)
#define PG8_SB(b, h) ((4 + (b) * 2 + (h)) * HTB)
#define PG8_STAGE(bufoff, gbase, voff) do { _Pragma("unroll") for (int _i = 0; _i < 2; ++_i) \
        __builtin_amdgcn_global_load_lds((const unsigned*)((const char*)(gbase) + (voff)[_i]), (PG8_LAS unsigned*)(lds + (bufoff) + ldsw + _i * 8192), 16, 0, 0); } while (0)
#define PG8_LDA(dst, b, h) do { _Pragma("unroll") for (int m = 0; m < 4; ++m) _Pragma("unroll") for (int k = 0; k < 2; ++k) dst[m][k] = *(const PG8_LAS bf16x8*)(lds + PG8_SA(b, h) + aoff + m * 2048 + k * 1024); } while (0)
#define PG8_LDB(dst, b, h) do { _Pragma("unroll") for (int n = 0; n < 2; ++n) _Pragma("unroll") for (int k = 0; k < 2; ++k) dst[n][k] = *(const PG8_LAS bf16x8*)(lds + PG8_SB(b, h) + boff + n * 2048 + k * 1024); } while (0)
#define PG8_MMA(ai, bj, At, Bt) do { __builtin_amdgcn_s_setprio(1); _Pragma("unroll") for (int m = 0; m < 4; ++m) _Pragma("unroll") for (int n = 0; n < 2; ++n) _Pragma("unroll") for (int k = 0; k < 2; ++k) \
        acc[ai][bj][m][n] = __builtin_amdgcn_mfma_f32_16x16x32_bf16(Bt[n][k], At[m][k], acc[ai][bj][m][n], 0, 0, 0); __builtin_amdgcn_s_setprio(0); } while (0)
#define PG8_WAIT_V(n) asm volatile("s_waitcnt vmcnt(" #n ")" ::: "memory")
#define PG8_WAIT_L(n) asm volatile("s_waitcnt lgkmcnt(" #n ")" ::: "memory")
#define PG8_BAR __builtin_amdgcn_s_barrier()
#define PG8_SCHED __builtin_amdgcn_sched_barrier(0)
    Unit cur, nxt; int ui = 0;
    if (!S.next(0, cur)) return;
    f32x4 acc[2][2][4][2];
#pragma unroll
    for (int a = 0; a < 2; ++a)
#pragma unroll
        for (int b = 0; b < 2; ++b)
#pragma unroll
            for (int m = 0; m < 4; ++m)
#pragma unroll
                for (int n = 0; n < 2; ++n) acc[a][b][m][n] = (f32x4){0.f, 0.f, 0.f, 0.f};
    bf16x8 At[4][2], B0[2][2], B1[2][2];
    const char* cA = cur.a; const char* cB = cur.b;
    S.a_ready(cur);
    if constexpr (SP2) {
        PG8_GROWS(gC, 0);
        PG8_STAGE(PG8_SB(0, 0), cB, voffB); PG8_STAGE(PG8_SB(0, 1), cB + hstepB, voffB); PG8_STAGE_A(PG8_SA(0, 0), cA, 0, false); PG8_STAGE_A(PG8_SA(0, 1), cA, 1, false);
        if (wr == 1) PG8_BAR;
        PG8_WAIT_V(2); PG8_BAR;
        PG8_STAGE(PG8_SB(1, 0), cB + kstep, voffB); PG8_STAGE_A(PG8_SA(1, 0), cA + kstep, 0, false); PG8_STAGE(PG8_SB(1, 1), cB + hstepB + kstep, voffB);
        PG8_WAIT_V(6); PG8_BAR;
    } else {
        PG8_STAGE(PG8_SB(0, 0), cB, voffB); PG8_STAGE(PG8_SA(0, 0), cA, voffA); PG8_STAGE(PG8_SB(0, 1), cB + hstepB, voffB); PG8_STAGE(PG8_SA(0, 1), cA + hstepA, voffA);
        if (wr == 1) PG8_BAR;
        PG8_WAIT_V(4); PG8_BAR;
        PG8_STAGE(PG8_SB(1, 0), cB + kstep, voffB); PG8_STAGE(PG8_SA(1, 0), cA + kstep, voffA); PG8_STAGE(PG8_SB(1, 1), cB + hstepB + kstep, voffB);
        PG8_WAIT_V(6); PG8_BAR;
    }
    for (;;) {
        const bool has_next = S.next(ui + 1, nxt);
        const char* nA = has_next ? nxt.a : cA; const char* nB = has_next ? nxt.b : cB;
        for (int t = 0; t < nt; t += 2) {
            const bool last = (t == nt - 2);
            const char* a1 = cA + (size_t)(t + 1) * kstep;
            const char* a2 = last ? nA : cA + (size_t)(t + 2) * kstep; const char* b2 = last ? nB : cB + (size_t)(t + 2) * kstep;
            const char* a3 = a2 + kstep; const char* b3 = b2 + kstep;
            if (last && has_next) S.a_ready(nxt);
            if constexpr (GATHER) { if (last) { if (has_next) { PG8_GROWS(gN, ui + 1); } else { _Pragma("unroll") for (int h_ = 0; h_ < 2; ++h_) _Pragma("unroll") for (int i_ = 0; i_ < 2; ++i_) gN[h_][i_] = gC[h_][i_]; } } }
            if constexpr (SP2) {
            PG8_LDB(B0, 0, 0); PG8_LDB(B1, 0, 1); PG8_SCHED; PG8_LDA(At, 0, 0); PG8_STAGE_A(PG8_SA(1, 1), a1, 1, false);
            PG8_WAIT_V(8); PG8_WAIT_L(0); PG8_BAR; PG8_MMA(0, 0, At, B0); PG8_MMA(0, 1, At, B1); PG8_BAR; PG8_SCHED;
            PG8_LDA(At, 0, 1); PG8_STAGE(PG8_SB(0, 0), b2, voffB); PG8_STAGE(PG8_SB(0, 1), b2 + hstepB, voffB); PG8_STAGE_A(PG8_SA(0, 0), a2, 0, last);
            PG8_WAIT_V(8); PG8_WAIT_L(0); PG8_BAR; PG8_MMA(1, 0, At, B0); PG8_MMA(1, 1, At, B1); PG8_BAR; PG8_SCHED;
            PG8_LDB(B0, 1, 0); PG8_LDB(B1, 1, 1); PG8_SCHED; PG8_LDA(At, 1, 0); PG8_STAGE_A(PG8_SA(0, 1), a2, 1, last);
            PG8_WAIT_V(8); PG8_WAIT_L(0); PG8_BAR; PG8_MMA(0, 0, At, B0); PG8_MMA(0, 1, At, B1); PG8_BAR; PG8_SCHED;
            PG8_LDA(At, 1, 1); PG8_STAGE(PG8_SB(1, 0), b3, voffB); PG8_STAGE(PG8_SB(1, 1), b3 + hstepB, voffB); PG8_STAGE_A(PG8_SA(1, 0), a3, 0, last);
            PG8_WAIT_V(8); PG8_WAIT_L(0); PG8_BAR; PG8_MMA(1, 0, At, B0); PG8_MMA(1, 1, At, B1); PG8_BAR; PG8_SCHED;
            } else {
            PG8_LDB(B0, 0, 0); PG8_SCHED; PG8_LDA(At, 0, 0); PG8_STAGE(PG8_SA(1, 1), a1 + hstepA, voffA);
            PG8_WAIT_L(8); PG8_BAR; PG8_WAIT_L(0); PG8_MMA(0, 0, At, B0); PG8_BAR; PG8_SCHED;
            PG8_LDB(B1, 0, 1); PG8_STAGE(PG8_SB(0, 0), b2, voffB);
            PG8_BAR; PG8_WAIT_L(0); PG8_MMA(0, 1, At, B1); PG8_BAR;
            PG8_LDA(At, 0, 1); PG8_STAGE(PG8_SA(0, 0), a2, voffA);
            PG8_BAR; PG8_WAIT_L(0); PG8_MMA(1, 0, At, B0); PG8_BAR; PG8_SCHED;
            PG8_STAGE(PG8_SB(0, 1), b2 + hstepB, voffB);
            PG8_WAIT_V(6); PG8_BAR; PG8_MMA(1, 1, At, B1); PG8_BAR;
            PG8_LDB(B0, 1, 0); PG8_SCHED; PG8_LDA(At, 1, 0); PG8_STAGE(PG8_SA(0, 1), a2 + hstepA, voffA);
            PG8_WAIT_L(8); PG8_BAR; PG8_WAIT_L(0); PG8_MMA(0, 0, At, B0); PG8_BAR; PG8_SCHED;
            PG8_LDB(B1, 1, 1); PG8_STAGE(PG8_SB(1, 0), b3, voffB);
            PG8_BAR; PG8_WAIT_L(0); PG8_MMA(0, 1, At, B1); PG8_BAR;
            PG8_LDA(At, 1, 1); PG8_STAGE(PG8_SA(1, 0), a3, voffA);
            PG8_BAR; PG8_WAIT_L(0); PG8_MMA(1, 0, At, B0); PG8_BAR; PG8_SCHED;
            PG8_STAGE(PG8_SB(1, 1), b3 + hstepB, voffB);
            PG8_WAIT_V(6); PG8_BAR; PG8_MMA(1, 1, At, B1); PG8_BAR;
            }
        }
        if constexpr (ALIGN_EPI) { if (wr == 0) PG8_BAR; }
        if constexpr (!Epi::AFTER_DRAIN) { E(acc, cur, wr, wc, fr, fq); S.done(cur); }
        if (!has_next) break;
#pragma unroll
        for (int a = 0; a < 2; ++a)
#pragma unroll
            for (int b = 0; b < 2; ++b)
#pragma unroll
                for (int m = 0; m < 4; ++m)
#pragma unroll
                    for (int n = 0; n < 2; ++n) acc[a][b][m][n] = (f32x4){0.f, 0.f, 0.f, 0.f};
        cur = nxt; cA = nA; cB = nB; ++ui;
        if constexpr (GATHER) { _Pragma("unroll") for (int h_ = 0; h_ < 2; ++h_) _Pragma("unroll") for (int i_ = 0; i_ < 2; ++i_) gC[h_][i_] = gN[h_][i_]; }
        if constexpr (ALIGN_EPI) { if (wr == 1) PG8_BAR; }
    }
    PG8_WAIT_V(0);
    if constexpr (!ALIGN_EPI) { if (wr == 0) PG8_BAR; }
    PG8_BAR;
    if constexpr (Epi::AFTER_DRAIN) { E.fused(acc, cur, wr, wc, fr, fq, lds, wid, lane); S.done(cur); }
#undef PG8_SA
#undef PG8_GROWS
#undef PG8_STAGE_A
#undef PG8_SB
#undef PG8_STAGE
#undef PG8_LDA
#undef PG8_LDB
#undef PG8_MMA
#undef PG8_WAIT_V
#undef PG8_WAIT_L
#undef PG8_BAR
#undef PG8_SCHED
}
}

namespace att {
constexpr int NW = 8, QBLK = 32, KVBLK = 64;
constexpr float THR = 8.f;
#define ATT_SBAR() __builtin_amdgcn_sched_barrier(0)
__device__ __forceinline__ int crow(int r, int hi) { return (r & 3) + 8 * (r >> 2) + 4 * hi; }
template <int D> __device__ __forceinline__ int kswz(int row, int colB) { return D == 128 ? row * 256 + (colB ^ ((row & 7) << 4)) : row * 128 + (colB ^ (((row >> 1) & 7) << 4)); }
template <int DV> __device__ __forceinline__ int v_st(int k, int c) { const int kk = (k & ~0xC) | ((k & 4) << 1) | ((k & 8) >> 1); return ((kk >> 3) * (DV / 32) + (c >> 5)) * 512 + ((kk & 7) * 32 + (c & 31)) * 2; }
__device__ __forceinline__ int v_rd_base(int lane) { return ((lane & 3) << 3) | (((lane >> 2) & 3) << 6) | (((lane >> 4) & 1) << 5) | (((lane >> 5) & 1) << 8); }
template <int DV> constexpr int v_rd_off(int d0, int ks, int half) { return d0 * 512 + ks * (DV / 32) * 1024 + half * (DV / 32) * 512; }
template <int OFF> __device__ __forceinline__ s16x4 tr_read(int vb) { s16x4 r; asm volatile("ds_read_b64_tr_b16 %0, %1 offset:%2" : "=&v"(r) : "v"(vb), "i"(OFF) : "memory"); return r; }

__device__ __forceinline__ void partialSM(f32x16& p0, f32x16& p1, float& m_reg, float& mn, float& alpha) {
    float pmax = p0[0];
#pragma unroll
    for (int r = 1; r < 16; ++r) pmax = fmaxf(pmax, p0[r]);
#pragma unroll
    for (int r = 0; r < 16; ++r) pmax = fmaxf(pmax, p1[r]);
    { auto rr = __builtin_amdgcn_permlane32_swap(__float_as_uint(pmax), __float_as_uint(pmax), false, false); pmax = fmaxf(__uint_as_float(rr[0]), __uint_as_float(rr[1])); }
    if (__builtin_expect(__all(pmax - m_reg <= THR), 1)) { mn = m_reg; alpha = 1.f; }
    else { mn = fmaxf(m_reg, pmax); alpha = __builtin_amdgcn_exp2f(m_reg - mn); m_reg = mn; }
#pragma unroll
    for (int r = 0; r < 16; ++r) { p0[r] -= mn; p1[r] -= mn; }
#pragma unroll
    for (int r = 0; r < 16; ++r) p0[r] = __builtin_amdgcn_exp2f(p0[r]);
}
__device__ __forceinline__ void finishSM(f32x16& p0, f32x16& p1, float alpha, float& l_reg, bf16x8& pa0, bf16x8& pa1, bf16x8& pa2, bf16x8& pa3) {
#pragma unroll
    for (int r = 0; r < 16; ++r) p1[r] = __builtin_amdgcn_exp2f(p1[r]);
    float ps = 0;
#pragma unroll
    for (int r = 0; r < 16; ++r) ps += p0[r];
#pragma unroll
    for (int r = 0; r < 16; ++r) ps += p1[r];
    { auto rr = __builtin_amdgcn_permlane32_swap(__float_as_uint(ps), __float_as_uint(ps), false, false); ps = __uint_as_float(rr[0]) + __uint_as_float(rr[1]); }
    l_reg = l_reg * alpha + ps;
#define ATT_PK4(P, BASE, OUT) do { unsigned a0 = cvt_pk_bf16(P[BASE + 0], P[BASE + 1]), a1 = cvt_pk_bf16(P[BASE + 2], P[BASE + 3]);   \
    unsigned b0 = cvt_pk_bf16(P[BASE + 4], P[BASE + 5]), b1 = cvt_pk_bf16(P[BASE + 6], P[BASE + 7]);                              \
    auto r0 = __builtin_amdgcn_permlane32_swap(a0, b0, false, false); auto r1 = __builtin_amdgcn_permlane32_swap(a1, b1, false, false); \
    u32x4 w = {r0[0], r1[0], r0[1], r1[1]}; OUT = *reinterpret_cast<bf16x8*>(&w); } while (0)
    ATT_PK4(p0, 0, pa0); ATT_PK4(p0, 8, pa1); ATT_PK4(p1, 0, pa2); ATT_PK4(p1, 8, pa3);
#undef ATT_PK4
}
template <int DQK> __device__ __forceinline__ void qkt(f32x16& p0, f32x16& p1, const char* Ks, const bf16x8* qr, int r32, int hi) {
    p0 = f32x16{}; p1 = f32x16{};
#pragma unroll
    for (int d0 = 0; d0 < DQK / 16; ++d0) { const int cb = (d0 * 16 + hi * 8) * 2;
        const bf16x8 b0 = *reinterpret_cast<const bf16x8*>(Ks + kswz<DQK>(r32, cb));
        const bf16x8 b1 = *reinterpret_cast<const bf16x8*>(Ks + kswz<DQK>(32 + r32, cb));
        p0 = __builtin_amdgcn_mfma_f32_32x32x16_bf16(b0, qr[d0], p0, 0, 0, 0);
        p1 = __builtin_amdgcn_mfma_f32_32x32x16_bf16(b1, qr[d0], p1, 0, 0, 0); }
}
template <int DV, int D0> __device__ __forceinline__ void pv_one(f32x16& od, int vb, bf16x8 pa0, bf16x8 pa1, bf16x8 pa2, bf16x8 pa3) {
    const s16x4 l0 = tr_read<v_rd_off<DV>(D0, 0, 0)>(vb), h0 = tr_read<v_rd_off<DV>(D0, 0, 1)>(vb), l1 = tr_read<v_rd_off<DV>(D0, 1, 0)>(vb), h1 = tr_read<v_rd_off<DV>(D0, 1, 1)>(vb);
    const s16x4 l2 = tr_read<v_rd_off<DV>(D0, 2, 0)>(vb), h2 = tr_read<v_rd_off<DV>(D0, 2, 1)>(vb), l3 = tr_read<v_rd_off<DV>(D0, 3, 0)>(vb), h3 = tr_read<v_rd_off<DV>(D0, 3, 1)>(vb);
    asm volatile("s_waitcnt lgkmcnt(0)" ::: "memory"); ATT_SBAR();
#define ATT_PK(L, H) (bf16x8){L[0], L[1], L[2], L[3], H[0], H[1], H[2], H[3]}
    od = __builtin_amdgcn_mfma_f32_32x32x16_bf16(pa0, ATT_PK(l0, h0), od, 0, 0, 0);
    od = __builtin_amdgcn_mfma_f32_32x32x16_bf16(pa1, ATT_PK(l1, h1), od, 0, 0, 0);
    od = __builtin_amdgcn_mfma_f32_32x32x16_bf16(pa2, ATT_PK(l2, h2), od, 0, 0, 0);
    od = __builtin_amdgcn_mfma_f32_32x32x16_bf16(pa3, ATT_PK(l3, h3), od, 0, 0, 0);
#undef ATT_PK
}
template <int DV> __device__ __forceinline__ void pv_all(f32x16 (&o)[DV / 32], int vb, bf16x8 pa0, bf16x8 pa1, bf16x8 pa2, bf16x8 pa3) {
    pv_one<DV, 0>(o[0], vb, pa0, pa1, pa2, pa3); pv_one<DV, 1>(o[1], vb, pa0, pa1, pa2, pa3);
    if constexpr (DV == 128) { pv_one<DV, 2>(o[2], vb, pa0, pa1, pa2, pa3); pv_one<DV, 3>(o[3], vb, pa0, pa1, pa2, pa3); }
}
template <int DQK, int DV> struct Lay { static constexpr int SHM_V = 64 * DV * 2, SHM_K = 64 * DQK * 2, OFF_V = 0, OFF_K = 2 * SHM_V, OFF_WS = OFF_K + 2 * SHM_K, OFF_STASH = OFF_WS + NW * 64 * 4; };

template <int DQK, int DV, int LDQ, int LDK, int LDV>
__device__ __forceinline__ void attn_pass(const bf16_t* __restrict__ Qb, const bf16_t* __restrict__ Kh, const bf16_t* __restrict__ Vh, int nkeys, char* lds, f32x16 (&o)[DV / 32], float (&rli)[16], int wv) {
    using L = Lay<DQK, DV>;
    constexpr int NLK = DQK / 64, NLV = DV / 64;
    int tid_ = wv * 64 + lane_id(); asm volatile("" : "+v"(tid_));
    const int tid = tid_, wid = tid >> 6, lane = tid & 63, r32 = lane & 31, hi = lane >> 5;
    char* V_lds = lds + L::OFF_V; char* K_lds = lds + L::OFF_K;
    float* ws = (float*)(lds + L::OFF_WS) + wid * 64; float* li_l = ws; float* al_l = ws + 32;
    float m_reg = -1e30f, l_reg = 0.f; bf16x8 qr[DQK / 16];
#pragma unroll
    for (int d = 0; d < DV / 32; ++d) o[d] = f32x16{};
    const bf16_t* Qw = Qb + (size_t)(wid * QBLK + r32) * LDQ + hi * 8;
#pragma unroll
    for (int d0 = 0; d0 < DQK / 16; ++d0) qr[d0] = *reinterpret_cast<const bf16x8*>(Qw + d0 * 16);
    const int krow = DQK == 128 ? (tid >> 4) : (tid >> 3), kcol = DQK == 128 ? (tid & 15) * 8 : (tid & 7) * 8;
    const int vrow = DV == 128 ? (tid >> 4) : (tid >> 3), vcol = DV == 128 ? (tid & 15) * 8 : (tid & 7) * 8;
    const int vb0 = (int)(uintptr_t)V_lds + v_rd_base(lane);
    bf16x8 vsE[NLV], ksE[NLK], vsO[NLV], ksO[NLK];
#define ATT_SLOAD(VS, KS, k0) do { _Pragma("unroll") for (int i_ = 0; i_ < NLV; ++i_) VS[i_] = *reinterpret_cast<const bf16x8*>(&Vh[(size_t)((k0) + vrow + 32 * i_) * LDV + vcol]); \
    _Pragma("unroll") for (int i_ = 0; i_ < NLK; ++i_) KS[i_] = *reinterpret_cast<const bf16x8*>(&Kh[(size_t)((k0) + krow + 32 * i_) * LDK + kcol]); } while (0)
#define ATT_SWRITE(b, VS, KS) do { _Pragma("unroll") for (int i_ = 0; i_ < NLV; ++i_) *(bf16x8*)(V_lds + (b) * L::SHM_V + v_st<DV>(vrow + 32 * i_, vcol)) = VS[i_]; \
    _Pragma("unroll") for (int i_ = 0; i_ < NLK; ++i_) *(bf16x8*)(K_lds + (b) * L::SHM_K + kswz<DQK>(krow + 32 * i_, kcol * 2)) = KS[i_]; } while (0)
#define ATT_SWAIT() do { if constexpr (NLK + NLV == 4) asm volatile("s_waitcnt vmcnt(4)" ::: "memory"); else if constexpr (NLK + NLV == 3) asm volatile("s_waitcnt vmcnt(3)" ::: "memory"); else asm volatile("s_waitcnt vmcnt(2)" ::: "memory"); } while (0)
#define ATT_RESC(a) do { if (__any((a) < 1.f)) { if (hi == 0) al_l[r32] = (a); asm volatile("s_waitcnt lgkmcnt(0)" ::: "memory"); \
    _Pragma("unroll") for (int d = 0; d < DV / 32; ++d) _Pragma("unroll") for (int r = 0; r < 16; ++r) o[d][r] *= al_l[crow(r, hi)]; } } while (0)
    f32x16 pA0, pA1, pB0, pB1; float mnA, mnB, alA, alB; bf16x8 pa0, pa1, pa2, pa3; const int NT = nkeys / KVBLK;
    __syncthreads();
    ATT_SLOAD(vsE, ksE, 0); asm volatile("s_waitcnt vmcnt(0)" ::: "memory"); ATT_SWRITE(0, vsE, ksE); __syncthreads();
    qkt<DQK>(pA0, pA1, K_lds, qr, r32, hi); partialSM(pA0, pA1, m_reg, mnA, alA);
    ATT_SLOAD(vsO, ksO, KVBLK); if (2 < NT) ATT_SLOAD(vsE, ksE, 2 * KVBLK);
    ATT_SWAIT(); ATT_SWRITE(1, vsO, ksO); __syncthreads();
    for (int j = 1; j + 1 < NT; j += 2) {
        ATT_SBAR(); qkt<DQK>(pB0, pB1, K_lds + L::SHM_K, qr, r32, hi);
        finishSM(pA0, pA1, alA, l_reg, pa0, pa1, pa2, pa3); ATT_SBAR();
        ATT_SLOAD(vsO, ksO, (j + 2) * KVBLK); ATT_SBAR();
        pv_all<DV>(o, vb0, pa0, pa1, pa2, pa3); partialSM(pB0, pB1, m_reg, mnB, alB);
        __syncthreads(); ATT_SWAIT(); ATT_SWRITE(0, vsE, ksE);
        ATT_RESC(alB); __syncthreads();
        ATT_SBAR(); qkt<DQK>(pA0, pA1, K_lds, qr, r32, hi);
        finishSM(pB0, pB1, alB, l_reg, pa0, pa1, pa2, pa3); ATT_SBAR();
        if (j + 3 < NT) ATT_SLOAD(vsE, ksE, (j + 3) * KVBLK); ATT_SBAR();
        pv_all<DV>(o, vb0 + L::SHM_V, pa0, pa1, pa2, pa3); partialSM(pA0, pA1, m_reg, mnA, alA);
        __syncthreads(); ATT_SWAIT(); ATT_SWRITE(1, vsO, ksO);
        ATT_RESC(alA); __syncthreads();
    }
    ATT_SBAR(); qkt<DQK>(pB0, pB1, K_lds + L::SHM_K, qr, r32, hi);
    finishSM(pA0, pA1, alA, l_reg, pa0, pa1, pa2, pa3); ATT_SBAR();
    pv_all<DV>(o, vb0, pa0, pa1, pa2, pa3); partialSM(pB0, pB1, m_reg, mnB, alB);
    __syncthreads(); ATT_RESC(alB);
    finishSM(pB0, pB1, alB, l_reg, pa0, pa1, pa2, pa3); ATT_SBAR();
    pv_all<DV>(o, vb0 + L::SHM_V, pa0, pa1, pa2, pa3);
    if (hi == 0) li_l[r32] = l_reg; asm volatile("s_waitcnt lgkmcnt(0)" ::: "memory");
#pragma unroll
    for (int r = 0; r < 16; ++r) rli[r] = __builtin_amdgcn_rcpf(li_l[crow(r, hi)]);
#undef ATT_SLOAD
#undef ATT_SWRITE
#undef ATT_SWAIT
#undef ATT_RESC
}
template <int DV, int LDO> __device__ __forceinline__ void store_o(bf16_t* Ob, const f32x16 (&o)[DV / 32], const float (&rli)[16], int wv) {
    int tid_ = wv * 64 + lane_id(); asm volatile("" : "+v"(tid_));
    const int tid = tid_, wid = tid >> 6, lane = tid & 63, r32 = lane & 31, hi = lane >> 5;
    bf16_t* Ow = Ob + (size_t)(wid * QBLK) * LDO;
#pragma unroll
    for (int r = 0; r < 16; ++r) { const int orow = crow(r, hi);
#pragma unroll
        for (int d0 = 0; d0 < DV / 32; ++d0) Ow[(size_t)orow * LDO + d0 * 32 + r32] = f2bf(o[d0][r] * rli[r]); }
}
__device__ __forceinline__ void unit_a(const bf16_t* PROJ, bf16_t* OBR, int b, int h, int qb, float lam, float lam_init, const float* subg, char* lds, int wv) {
    using L = Lay<64, 128>;
    int tid_ = wv * 64 + lane_id(); asm volatile("" : "+v"(tid_));
    const int tid = tid_, wid = tid >> 6, lane = tid & 63, r32 = lane & 31, hi = lane >> 5;
    const bf16_t* kv = PROJ + (size_t)b * SEQ * D_IN; const size_t qrow = (size_t)b * SEQ + qb * 256;
    unsigned* stash = (unsigned*)(lds + L::OFF_STASH) + wid * 2048 + lane;
    f32x16 o[4]; float rli[16];
#pragma unroll 1
    for (int c = 0; c < 2; ++c) {
        attn_pass<64, 128, D_IN, D_IN, D_IN>(PROJ + qrow * D_IN + C_AQ + h * 128 + c * 64, kv + C_AK + h * 128 + c * 64, kv + C_AV + h * 128, SEQ, lds, o, rli, wv);
        if (c == 0) {
#pragma unroll
            for (int d0 = 0; d0 < 4; ++d0)
#pragma unroll
                for (int r = 0; r < 16; r += 2) stash[(d0 * 8 + (r >> 1)) * 64] = cvt_pk_bf16(o[d0][r] * rli[r], o[d0][r + 1] * rli[r + 1]);
        }
    }
    asm volatile("s_waitcnt lgkmcnt(0)" ::: "memory");
    float ss[16];
#pragma unroll
    for (int r = 0; r < 16; ++r) ss[r] = 0.f;
#pragma unroll
    for (int d0 = 0; d0 < 4; ++d0)
#pragma unroll
        for (int r = 0; r < 16; r += 2) { const unsigned w = stash[(d0 * 8 + (r >> 1)) * 64];
            const float c0 = __uint_as_float(w << 16) - lam * o[d0][r] * rli[r], c1 = __uint_as_float(w & 0xffff0000u) - lam * o[d0][r + 1] * rli[r + 1];
            o[d0][r] = c0; o[d0][r + 1] = c1; ss[r] += c0 * c0; ss[r + 1] += c1 * c1; }
#pragma unroll
    for (int r = 0; r < 16; ++r) { float s = ss[r]; s += __shfl_xor(s, 1); s += __shfl_xor(s, 2); s += __shfl_xor(s, 4); s += __shfl_xor(s, 8); s += __shfl_xor(s, 16);
        ss[r] = rsqrtf(s * (1.f / 128.f) + EPS) * (1.f - lam_init); }
    bf16_t* Ow = OBR + (qrow + wid * QBLK) * OBR_W + h * 128;
#pragma unroll
    for (int d0 = 0; d0 < 4; ++d0) { const float g = subg[d0 * 32 + r32];
#pragma unroll
        for (int r = 0; r < 16; ++r) Ow[(size_t)crow(r, hi) * OBR_W + d0 * 32 + r32] = f2bf(o[d0][r] * ss[r] * g); }
}
__device__ __forceinline__ void unit_b(const bf16_t* PROJ, bf16_t* OBR, int b, int qh, int qb, char* lds, int wv) {
    const bf16_t* kv = PROJ + (size_t)b * SEQ * D_IN; const size_t qrow = (size_t)b * SEQ + qb * 256;
    f32x16 o[2]; float rli[16];
    attn_pass<64, 64, D_IN, D_IN, D_IN>(PROJ + qrow * D_IN + C_BQ + qh * 64, kv + C_BK + (qh >> 2) * 64, kv + C_BV + (qh >> 2) * 64, SEQ, lds, o, rli, wv);
    store_o<64, OBR_W>(OBR + qrow * OBR_W + 512 + qh * 64, o, rli, wv);
}
__device__ __forceinline__ void unit_c(const bf16_t* PROJ, const bf16_t* MEMKV, bf16_t* OBR, int b, int h, int qb, char* lds, int wv) {
    const bf16_t* kv = MEMKV + (size_t)b * MEM_LEN * 1024; const size_t qrow = (size_t)b * SEQ + qb * 256;
    f32x16 o[4]; float rli[16];
    attn_pass<128, 128, D_IN, 1024, 1024>(PROJ + qrow * D_IN + C_CQ + h * 128, kv + h * 128, kv + 512 + h * 128, MEM_LEN, lds, o, rli, wv);
    store_o<128, OBR_W>(OBR + qrow * OBR_W + 1024 + h * 128, o, rli, wv);
}
#undef ATT_SBAR
}

template <int NR>
__device__ __forceinline__ void rows_rmsnorm(const float* __restrict__ xbase, const float* __restrict__ g, bf16_t* __restrict__ obase, int row0, int lane) {
    f32x4 v[NR][4];
#pragma unroll
    for (int r = 0; r < NR; ++r)
#pragma unroll
        for (int j = 0; j < 4; ++j) v[r][j] = ((const f32x4*)(xbase + (size_t)(row0 + r) * DM))[lane + 64 * j];
    f32x4 gg[4];
#pragma unroll
    for (int j = 0; j < 4; ++j) gg[j] = ((const f32x4*)g)[lane + 64 * j];
#pragma unroll
    for (int r = 0; r < NR; ++r) { float s = 0.f;
#pragma unroll
        for (int j = 0; j < 4; ++j) s += v[r][j].x * v[r][j].x + v[r][j].y * v[r][j].y + v[r][j].z * v[r][j].z + v[r][j].w * v[r][j].w;
        const float rs = rsqrtf(wave_sum(s) * (1.f / DM) + EPS);
#pragma unroll
        for (int j = 0; j < 4; ++j) { u32x2 o; o.x = cvt_pk_bf16(v[r][j].x * rs * gg[j].x, v[r][j].y * rs * gg[j].y); o.y = cvt_pk_bf16(v[r][j].z * rs * gg[j].z, v[r][j].w * rs * gg[j].w);
            ((u32x2*)(obase + (size_t)(row0 + r) * DM))[lane + 64 * j] = o; } }
}
__device__ __forceinline__ void route_block(const bf16_t* __restrict__ X, const bf16_t* __restrict__ rt_tab, const float* __restrict__ brg, const float* __restrict__ bre, int* __restrict__ experts, float* __restrict__ weights,
                                            int* __restrict__ rank, unsigned* __restrict__ cnt, float* __restrict__ rstd, int* __restrict__ list, const float* __restrict__ g2, bf16_t* __restrict__ H2, int rb, const bf16x8 (&Bh)[3][4], const bf16x8 (&Bl)[3][4], LAS float* slab, int tid, int wave) {
    const int lane = tid & 63, r = lane & 15, kq = lane >> 4;
    LAS float* ssq = slab + 8 * 64 * 48; LAS float* rs_l = ssq + 8 * 64;
#pragma unroll 1
    for (int rtp = 0; rtp < 2; ++rtp) {
        bf16x8 xa[2][4];
#pragma unroll
        for (int q = 0; q < 2; ++q) { const bf16_t* xp = X + (size_t)(rb * 64 + (rtp * 2 + q) * 16 + r) * XP + 128 * wave + 8 * kq;
#pragma unroll
            for (int sI = 0; sI < 4; ++sI) xa[q][sI] = *(const bf16x8*)(xp + 32 * sI); }
#pragma unroll
        for (int q = 0; q < 2; ++q) { const int rt = rtp * 2 + q;
            f32x4 acc[3]; float ss = 0.f;
#pragma unroll
            for (int t = 0; t < 3; ++t) acc[t] = (f32x4){0.f, 0.f, 0.f, 0.f};
#pragma unroll
            for (int sI = 0; sI < 4; ++sI) {
                const bf16x8 Ah = xa[q][sI]; f32x4 a0, a1; pg8::unpack8(__builtin_bit_cast(u32x4, Ah), a0, a1);
                ss += (a0[0] * a0[0] + a0[1] * a0[1]) + (a0[2] * a0[2] + a0[3] * a0[3]) + (a1[0] * a1[0] + a1[1] * a1[1]) + (a1[2] * a1[2] + a1[3] * a1[3]);
#pragma unroll
                for (int t = 0; t < 3; ++t) {
                    acc[t] = __builtin_amdgcn_mfma_f32_16x16x32_bf16(Ah, Bh[t][sI], acc[t], 0, 0, 0);
                    acc[t] = __builtin_amdgcn_mfma_f32_16x16x32_bf16(Ah, Bl[t][sI], acc[t], 0, 0, 0);
                }
            }
            ss += __shfl_xor(ss, 16); ss += __shfl_xor(ss, 32);
            if (kq == 0) ssq[wave * 64 + rt * 16 + r] = ss;
#pragma unroll
            for (int t = 0; t < 3; ++t)
#pragma unroll
                for (int e = 0; e < 4; ++e) slab[(wave * 64 + rt * 16 + 4 * kq + e) * 48 + 16 * t + r] = acc[t][e];
        }
    }
    __syncthreads();
    if (tid < 64) {
        const int row = rb * 64 + tid;
        float lg[36]; float ss = 0.f;
#pragma unroll
        for (int c = 0; c < 36; ++c) lg[c] = 0.f;
#pragma unroll 1
        for (int w = 0; w < 8; ++w) { ss += ssq[w * 64 + tid];
#pragma unroll
            for (int c = 0; c < 36; ++c) lg[c] += slab[(w * 64 + tid) * 48 + c]; }
        const float rs = rsqrtf(ss * (1.f / DM) + EPS);
        rstd[row] = rs;
        int gi = 0; float gm = lg[0] * rs + brg[0];
#pragma unroll
        for (int i = 1; i < 4; ++i) { const float l = lg[i] * rs + brg[i]; if (l > gm) { gm = l; gi = i; } }
        float gs = 0.f;
#pragma unroll
        for (int i = 0; i < 4; ++i) gs += __expf(lg[i] * rs + brg[i] - gm);
        const float gp = 1.f / gs;
        float el[8];
#pragma unroll
        for (int i = 0; i < 8; ++i) el[i] = 0.f;
#pragma unroll
        for (int gq = 0; gq < 4; ++gq) if (gq == gi) {
#pragma unroll
            for (int i = 0; i < 8; ++i) el[i] = lg[4 + gq * 8 + i] * rs + bre[gq * 8 + i]; }
        int i0 = 0; float l0 = el[0];
#pragma unroll
        for (int i = 1; i < 8; ++i) if (el[i] > l0) { l0 = el[i]; i0 = i; }
        int i1 = -1; float l1 = -INFINITY;
#pragma unroll
        for (int i = 0; i < 8; ++i) if (i != i0 && el[i] > l1) { l1 = el[i]; i1 = i; }
        const float p1 = __expf(l1 - l0), inv = 1.f / (1.f + p1);
        const int e0 = gi * 8 + i0, e1 = gi * 8 + i1;
        experts[row * 2] = e0; experts[row * 2 + 1] = e1;
        weights[row * 2] = gp * inv; weights[row * 2 + 1] = gp * p1 * inv;
        LAS unsigned* lc = (LAS unsigned*)(rs_l + 64); LAS unsigned* gb = lc + 32;
        if (tid < 32) lc[tid] = 0u;
        asm volatile("s_waitcnt lgkmcnt(0)" ::: "memory");
        unsigned q0, q1; const unsigned one = 1u, a0_ = (unsigned)(uintptr_t)(lc + e0), a1_ = (unsigned)(uintptr_t)(lc + e1);
        asm volatile("ds_add_rtn_u32 %0, %1, %2\n\ts_waitcnt lgkmcnt(0)" : "=v"(q0) : "v"(a0_), "v"(one) : "memory");
        asm volatile("ds_add_rtn_u32 %0, %1, %2\n\ts_waitcnt lgkmcnt(0)" : "=v"(q1) : "v"(a1_), "v"(one) : "memory");
        if (tid < 32) { const unsigned n = lc[tid]; gb[tid] = n ? atomicAdd(cnt + 64 * tid, n) : 0u; }
        const int r0 = (int)(gb[e0] + q0), r1 = (int)(gb[e1] + q1);
        rank[row * 2] = r0; rank[row * 2 + 1] = r1;
        list[e0 * LCAP + r0] = row * 2; list[e1 * LCAP + r1] = row * 2 + 1;
        rs_l[tid] = rs;
    }
    __syncthreads();
#pragma unroll 1
    for (int rr = 0; rr < 8; rr += 4) {
        u32x2 v[4][4];
#pragma unroll
        for (int r4 = 0; r4 < 4; ++r4)
#pragma unroll
            for (int j = 0; j < 4; ++j) v[r4][j] = ((const u32x2*)(X + (size_t)(rb * 64 + wave * 8 + rr + r4) * XP))[lane + 64 * j];
#pragma unroll
        for (int r4 = 0; r4 < 4; ++r4) { const float rs = rs_l[wave * 8 + rr + r4]; u32x2* dst = (u32x2*)(H2 + (size_t)(rb * 64 + wave * 8 + rr + r4) * DM);
#pragma unroll
            for (int j = 0; j < 4; ++j) { const f32x4 gg = ((const f32x4*)g2)[lane + 64 * j]; const u32x2 w = v[r4][j];
                u32x2 o; o.x = cvt_pk_bf16(__uint_as_float(w.x << 16) * rs * gg.x, __uint_as_float(w.x & 0xffff0000u) * rs * gg.y); o.y = cvt_pk_bf16(__uint_as_float(w.y << 16) * rs * gg.z, __uint_as_float(w.y & 0xffff0000u) * rs * gg.w); dst[lane + 64 * j] = o; } }
    }
    __syncthreads();
}
__device__ __forceinline__ void moe_tables(const unsigned* cnt, volatile LAS int* mt, int tid) {
    if (tid == 0) { int off = 0, nt = 0;
#pragma unroll 1
        for (int e = 0; e < NEXP; ++e) { const int c = (int)__hip_atomic_load(cnt + 64 * e, __ATOMIC_RELAXED, __HIP_MEMORY_SCOPE_AGENT), t = (c + MOE_TILE - 1) / MOE_TILE;
            mt[e] = off; mt[32 + e] = c; mt[64 + e] = nt;
#pragma unroll 1
            for (int i = 0; i < t; ++i) mt[96 + nt + i] = e;
            nt += t; off += t * MOE_TILE; }
        mt[256] = nt; }
    __syncthreads();
}
__device__ __forceinline__ void moe_rowtabs(volatile LAS int* mt, const int* __restrict__ list, const float* __restrict__ weights, LAS unsigned* rowtab, LAS float* wtab, int bx, int G, int tid, int up) {
    const int ntiles = mt[256], rem = (ntiles * 4) % G;
#pragma unroll 1
    for (int i = 0; i < 4; ++i) { const long L = up ? (long)i * G + bx : (long)pg8::moe_down_unit(bx, i, rem, G); if (L >= (long)ntiles * 4) break;
        if (tid < 256) { const int tile = (int)(L >> 2), e = mt[96 + tile], q = (tile - mt[64 + e]) * 256 + tid; const bool valid = q < mt[32 + e];
            const int a = valid ? list[e * LCAP + q] : 0;
            if (up) rowtab[i * 256 + tid] = (unsigned)(a >> 1) * (unsigned)(DM * 2); else wtab[i * 256 + tid] = valid ? weights[a] : 0.f; } }
    __syncthreads();
}
template <int NR>
__device__ __forceinline__ void rows_combine_norm(bf16_t* __restrict__ XB, const bf16_t* __restrict__ YB, const float* __restrict__ g, bf16_t* __restrict__ H, float* __restrict__ OUT, const int (&row)[NR], int lane, bool poison, const int (&d0)[NR], const int (&d1)[NR]) {
    u32x2 xq[NR][4], ya[NR][4], yb[NR][4];
#pragma unroll
    for (int r = 0; r < NR; ++r)
#pragma unroll
        for (int j = 0; j < 4; ++j) { xq[r][j] = ((const u32x2*)(XB + (size_t)row[r] * XP))[lane + 64 * j];
            ya[r][j] = ((const u32x2*)(YB + (size_t)d0[r] * DM))[lane + 64 * j]; yb[r][j] = ((const u32x2*)(YB + (size_t)d1[r] * DM))[lane + 64 * j]; }
    f32x4 gg[4];
#pragma unroll
    for (int j = 0; j < 4; ++j) gg[j] = ((const f32x4*)g)[lane + 64 * j];
    f32x4 v[NR][4]; float s[NR];
#pragma unroll
    for (int r = 0; r < NR; ++r) { s[r] = 0.f;
#pragma unroll
        for (int j = 0; j < 4; ++j) { const u32x2 x = xq[r][j], a = ya[r][j], b = yb[r][j];
            v[r][j].x = __uint_as_float(x.x << 16) + __uint_as_float(a.x << 16) + __uint_as_float(b.x << 16); v[r][j].y = __uint_as_float(x.x & 0xffff0000u) + __uint_as_float(a.x & 0xffff0000u) + __uint_as_float(b.x & 0xffff0000u);
            v[r][j].z = __uint_as_float(x.y << 16) + __uint_as_float(a.y << 16) + __uint_as_float(b.y << 16); v[r][j].w = __uint_as_float(x.y & 0xffff0000u) + __uint_as_float(a.y & 0xffff0000u) + __uint_as_float(b.y & 0xffff0000u);
            s[r] += v[r][j].x * v[r][j].x + v[r][j].y * v[r][j].y + v[r][j].z * v[r][j].z + v[r][j].w * v[r][j].w; } }
#pragma unroll
    for (int r = 0; r < NR; ++r) {
        float rs = rsqrtf(wave_sum(s[r]) * (1.f / DM) + EPS);
        if (poison) rs = __builtin_nanf("");
#pragma unroll
        for (int j = 0; j < 4; ++j) {
            if (H) { u32x2 xo; xo.x = cvt_pk_bf16(v[r][j].x, v[r][j].y); xo.y = cvt_pk_bf16(v[r][j].z, v[r][j].w); ((u32x2*)(XB + (size_t)row[r] * XP))[lane + 64 * j] = xo;
                u32x2 o; o.x = cvt_pk_bf16(v[r][j].x * rs * gg[j].x, v[r][j].y * rs * gg[j].y); o.y = cvt_pk_bf16(v[r][j].z * rs * gg[j].z, v[r][j].w * rs * gg[j].w);
                ((u32x2*)(H + (size_t)row[r] * DM))[lane + 64 * j] = o; }
            else { f32x4 o; o.x = v[r][j].x * rs * gg[j].x; o.y = v[r][j].y * rs * gg[j].y; o.z = v[r][j].z * rs * gg[j].z; o.w = v[r][j].w * rs * gg[j].w; ((f32x4*)(OUT + (size_t)row[r] * DM))[lane + 64 * j] = o; }
        }
    }
}
struct TrItem { const float* src; bf16_t* dst; int ldw, K; };
template <int OFF> __device__ __forceinline__ unsigned long long karg64() { unsigned long long v; asm volatile("s_load_dwordx2 %0, %1, %2\n\ts_waitcnt lgkmcnt(0)" : "=s"(v) : "s"(__builtin_amdgcn_kernarg_segment_ptr()), "n"(OFF)); return v; }
__device__ __forceinline__ unsigned long long karg64d(int off) { unsigned long long v; asm volatile("s_load_dwordx2 %0, %1, %2\n\ts_waitcnt lgkmcnt(0)" : "=s"(v) : "s"(__builtin_amdgcn_kernarg_segment_ptr()), "s"(off)); return v; }
#define TR_IN(k) ((const float*)(const GAS float*)karg64d(8 * (k)))
__device__ __forceinline__ void tr_decode(int it, int lane, bf16_t* WB, const float*& sp, int& ldw, bf16_t*& dp, int& K) {
    const float* src; int segA, segB, kb, tb, dk0 = 0; bf16_t* dst;
    if (it < 28800) {
        const int l = it / 14400; int r = it % 14400; bf16_t* WBl = WB + (size_t)l * WB_LAYER;
        if (r < 1472) { kb = r / 92; tb = r % 92; const int pn = tb >> 2, bj = (tb >> 1) & 1, w0 = 2 * (tb & 1); src = TR_IN(5) + (size_t)l * DM * D_IN; ldw = D_IN; K = DM; segA = 256 * pn + 64 * w0 + 32 * bj; segB = segA + 64; dst = WBl + WB_IN; }
        else if (r < 1856) { r -= 1472; const int i = r >> 7; r &= 127; kb = r >> 4; tb = r & 15; src = TR_IN(13 + i) + (size_t)l * 512 * DM; ldw = DM; K = 512; segA = 64 * tb; segB = segA + 32; dst = WBl + WB_UP + (size_t)i * 1024 * 512; }
        else if (r < 2112) { r -= 1856; kb = r >> 4; tb = r & 15; src = TR_IN(16) + (size_t)l * DM * DM; ldw = DM; K = DM; segA = 64 * tb; segB = segA + 32; dst = WBl + WB_OUT; }
        else if (r < 10304) { r -= 2112; const int e = r >> 8; r &= 255; kb = r >> 4; tb = r & 15; const int pn = tb >> 2, sg = (tb >> 1) & 1, jb = tb & 1;
            src = TR_IN(sg ? 23 : 22) + (size_t)(l * NEXP + e) * DM * DEXP; ldw = DEXP; K = DM; segA = 128 * pn + 64 * jb; segB = segA + 32; dst = WBl + WB_GU + (size_t)e * 1024 * 1024; }
        else { r -= 10304; const int e = r >> 7; r &= 127; kb = r >> 4; tb = r & 15; src = TR_IN(24) + (size_t)(l * NEXP + e) * DEXP * DM; ldw = DM; K = DEXP; segA = 64 * tb; segB = segA + 32; dst = WBl + WB_DN + (size_t)e * 1024 * 512; }
    } else { const int r = it - 28800; kb = r >> 4; tb = r & 15; const int pn = tb >> 2, bj = (tb >> 1) & 1, w0 = 2 * (tb & 1); src = TR_IN(3); ldw = 1024; K = DM; segA = 256 * pn + 64 * w0 + 32 * bj; segB = segA + 64; dst = WB + WB_MEMKV; }
    const int q = lane & 15;
    sp = src + (size_t)(kb * 64 + (lane >> 4)) * ldw + (q < 8 ? segA + 4 * q : segB + 4 * (q - 8));
    dp = dst + (size_t)(64 * tb + (lane >> 3)) * K + dk0 + kb * 64 + 8 * (lane & 7);
}
__device__ __forceinline__ void tr_load(f32x4 (&v)[16], const float* sp, int ldw) {
#pragma unroll
    for (int i = 0; i < 16; ++i) v[i] = *(const f32x4*)(sp + (size_t)(4 * i) * ldw);
}
__device__ __forceinline__ void tr_store(const f32x4 (&v)[16], bf16_t* dp, int K, LAS float* scr, int lane) {
    const int q = lane & 15, kq = lane >> 4;
#pragma unroll
    for (int i = 0; i < 16; ++i) { LAS float* w = scr + (4 * i + kq) * 65 + 4 * q; w[0] = v[i][0]; w[1] = v[i][1]; w[2] = v[i][2]; w[3] = v[i][3]; }
    asm volatile("s_waitcnt lgkmcnt(0)" ::: "memory");
    const int c = lane & 7, n8 = lane >> 3;
#pragma unroll
    for (int j = 0; j < 8; ++j) { const LAS float* sI = scr + (8 * c) * 65 + n8 + 8 * j;
        u32x4 o; o.x = cvt_pk_bf16(sI[0 * 65], sI[1 * 65]); o.y = cvt_pk_bf16(sI[2 * 65], sI[3 * 65]); o.z = cvt_pk_bf16(sI[4 * 65], sI[5 * 65]); o.w = cvt_pk_bf16(sI[6 * 65], sI[7 * 65]);
        *(u32x4*)(dp + (size_t)(8 * j) * K) = o; }
    asm volatile("s_waitcnt lgkmcnt(0)" ::: "memory");
}

__device__ __forceinline__ int tr_item(int mode, int q) {
    return mode == 0 ? q : mode == 1 ? (q < 1472 ? q : q < 3584 ? q - 1472 + 14400 : q - 3584 + 28800) : mode == 2 ? q + 1472 : q + 16512; }
__device__ __forceinline__ void tr_run(int mode, int q0, int qend, int qstride, bf16_t* WB, LAS float* scr, int lane) {
    f32x4 ra[16], rb[16], rc[16]; const float* sp; int ldw; bf16_t* dpa; int Ka; bf16_t* dpb; int Kb; bf16_t* dpc; int Kc;
    if (q0 >= qend) return;
    const int qlast = q0 + ((qend - 1 - q0) / qstride) * qstride;
#define TR_LD(R, DP, KK, QQ) do { const int qn_ = (QQ) <= qlast ? (QQ) : qlast; tr_decode(tr_item(mode, qn_), lane, WB, sp, ldw, DP, KK); tr_load(R, sp, ldw); } while (0)
    int q = q0;
    TR_LD(ra, dpa, Ka, q); TR_LD(rb, dpb, Kb, q + qstride);
    for (;;) {
        TR_LD(rc, dpc, Kc, q + 2 * qstride); tr_store(ra, dpa, Ka, scr, lane); q += qstride; if (q > qlast) break;
        TR_LD(ra, dpa, Ka, q + 2 * qstride); tr_store(rb, dpb, Kb, scr, lane); q += qstride; if (q > qlast) break;
        TR_LD(rb, dpb, Kb, q + 2 * qstride); tr_store(rc, dpc, Kc, scr, lane); q += qstride; if (q > qlast) break;
    }
#undef TR_LD
}
#define XB_TMO      128
#define XB_XCNT(j)  (256  + 64 * (j))
#define XB_XSUB(j)  (1280 + 64 * (j))
#define XB_XGEN(j)  (2304 + 64 * (j))
#define XB_TOP      3328
#define XB_TOPGEN   3392
#define XCD_BAR_WORDS 3456
#define XB_SPIN_CAP (1u << 18)

__device__ __forceinline__ unsigned xb_ld(unsigned* p)              { return __hip_atomic_load(p, __ATOMIC_RELAXED, __HIP_MEMORY_SCOPE_AGENT); }
__device__ __forceinline__ unsigned xb_add(unsigned* p, unsigned v) { return __hip_atomic_fetch_add(p, v, __ATOMIC_RELAXED, __HIP_MEMORY_SCOPE_AGENT); }
__device__ __forceinline__ unsigned xb_xcc_id() { return (unsigned)__builtin_amdgcn_s_getreg((3 << 11) | 20) & 0xFu; }
#define XB_SPIN(cond, bar) do { unsigned _sp = 0; while (cond) { __builtin_amdgcn_s_sleep(1); \
    if ((++_sp & 255u) == 0u) { if (xb_ld(&(bar)[XB_TMO])) break; if (_sp > XB_SPIN_CAP) { atomicAdd(&(bar)[XB_TMO], 1u); break; } } } } while (0)

struct XcdBarrier {
    unsigned* bar; unsigned x; unsigned w0;
    volatile LAS unsigned* st;
};

__device__ __forceinline__ XcdBarrier xcd_barrier_post(unsigned* bar, volatile LAS unsigned* st, unsigned is_wave0) {
    XcdBarrier b; b.bar = bar; b.x = xb_xcc_id(); b.st = st; b.w0 = is_wave0;
    if (is_wave0 && lane_id() == 0) (void)xb_add(&bar[XB_XCNT(b.x)], 1u);
    return b;
}
__device__ __forceinline__ void xcd_barrier_complete(unsigned* bar, unsigned x, unsigned& nloc, unsigned& nx) {
    const unsigned G = gridDim.x * gridDim.y * gridDim.z;
    unsigned sum, cnt, mine, sp = 0u;
    for (;;) {
        sum = 0u; cnt = 0u; mine = 0u;
#pragma unroll
        for (unsigned j = 0; j < 16; ++j) { const unsigned c = xb_ld(&bar[XB_XCNT(j)]); sum += c; cnt += (c > 0u) ? 1u : 0u; mine = (j == x) ? c : mine; }
        if (sum == G) break;
        __builtin_amdgcn_s_sleep(1);
        if ((++sp & 255u) == 0u) { if (xb_ld(&bar[XB_TMO])) break; if (sp > XB_SPIN_CAP) { atomicAdd(&bar[XB_TMO], 1u); break; } }
    }
    nloc = mine > 0u ? mine : 1u; nx = cnt > 0u ? cnt : 1u;
}

__device__ __forceinline__ void xcd_barrier(const XcdBarrier& b) {
    asm volatile("s_waitcnt vmcnt(0)" ::: "memory");
    __syncthreads();
    if (b.w0 && lane_id() == 0) {
        unsigned* bar = b.bar;
        __builtin_amdgcn_s_waitcnt(0);
        unsigned nloc = b.st[0], nx = b.st[1];
        if (nloc == 0u) { xcd_barrier_complete(bar, b.x, nloc, nx); b.st[0] = nloc; b.st[1] = nx; }
        const unsigned old = xb_add(&bar[XB_XSUB(b.x)], 1u);
        const unsigned gen = old / nloc;
        if (old + 1u == (gen + 1u) * nloc) {
            __builtin_amdgcn_fence(__ATOMIC_RELEASE, "agent");
            asm volatile("s_waitcnt vmcnt(0)" ::: "memory");
            const unsigned og = xb_add(&bar[XB_TOP], 1u);
            const unsigned tg = og / nx;
            if (og + 1u == (tg + 1u) * nx) xb_add(&bar[XB_TOPGEN], 1u);
            else XB_SPIN(xb_ld(&bar[XB_TOPGEN]) == tg, bar);
            __builtin_amdgcn_fence(__ATOMIC_ACQUIRE, "agent");
            xb_add(&bar[XB_XGEN(b.x)], 1u);
            asm volatile("s_waitcnt vmcnt(0)" ::: "memory");
        } else {
            XB_SPIN(xb_ld(&bar[XB_XGEN(b.x)]) == gen, bar);
            __builtin_amdgcn_fence(__ATOMIC_ACQUIRE, "agent");
            asm volatile("s_waitcnt vmcnt(0)" ::: "memory");
        }
    }
    __syncthreads();
}
constexpr int NWAVES = 8;
constexpr int RING_BYTES = 131072, LDSCTL_OFF = 135168, LDS_BYTES = 147456;
constexpr int CW_BAR = 4096, BAR_REGION = 4096;
static_assert(XCD_BAR_WORDS <= BAR_REGION && (CW_BAR + (N_PHASES + 1) * BAR_REGION) * 4 <= (int)MiB, "barrier regions inside the memset region");
static_assert(pg8::STAGE_BYTES <= RING_BYTES && att::Lay<64, 128>::OFF_STASH + 65536 <= RING_BYTES && att::Lay<128, 128>::OFF_WS + 2048 <= RING_BYTES, "LDS map");

struct Args { const float* in[26]; float* out; unsigned char* ws; int ph_lo, ph_hi, li, pad; };
#define KIN(k) ((const float*)(const GAS float*)karg64<8 * (k)>())
#define KOUT ((float*)(GAS float*)karg64<208>())
#define KWS ((unsigned char*)(GAS unsigned char*)karg64<216>())
static_assert(offsetof(Args, out) == 208 && offsetof(Args, ws) == 216 && offsetof(Args, ph_lo) == 224, "Args layout vs the kernarg offsets above");

__global__ void __launch_bounds__(NWAVES * 64, 2) mk_fwd(Args args) {
    extern __shared__ __attribute__((aligned(16))) unsigned char lds[];
    const int wave = __builtin_amdgcn_readfirstlane((int)threadIdx.x >> 6);
#define lane0 lane_id()
#define tid0 (wave * 64 + lane_id())
    const int G = gridDim.x, bx = blockIdx.x, vcu = (G % 8 == 0) ? (bx % 8) * (G / 8) + bx / 8 : bx;
    constexpr int NCX = 4, NCV = 8 * NCX, NWK = 256 - NCV;
    const bool split = (G == 256); const int idx8 = bx >> 3, xcd8 = bx & 7;
    const bool conv = split && (idx8 >= 32 - NCX);
    const int wk = (idx8 << 3) | xcd8, cvw = ((((idx8 - (32 - NCX)) << 3) | xcd8) * NWAVES) + wave;
    LAS unsigned char* ldsl = (LAS unsigned char*)lds;
    volatile LAS unsigned* MISC = (volatile LAS unsigned*)(ldsl + LDSCTL_OFF);
    for (int u = tid0; u < (LDS_BYTES - LDSCTL_OFF) / 4; u += NWAVES * 64) ((LAS unsigned*)(ldsl + LDSCTL_OFF))[u] = 0u;
    __syncthreads();
    XcdBarrier bar = xcd_barrier_post((unsigned*)(KWS + WS_CTL) + CW_BAR + args.li * BAR_REGION, MISC + 8, wave == 0 ? 1u : 0u);
#define P_WS unsigned char* ws = KWS; unsigned* ctl = (unsigned*)(ws + WS_CTL); (void)ctl
#define P_ACT bf16_t* MEMKV = (bf16_t*)(ws + WS_MEMKV); bf16_t* HM = (bf16_t*)(ws + WS_HM); bf16_t* PROJ = (bf16_t*)(ws + WS_PROJ); bf16_t* OBR = (bf16_t*)(ws + WS_OBR); bf16_t* HMEM = OBR; \
    bf16_t* BUF = (bf16_t*)(ws + WS_BUF); bf16_t* YB = (bf16_t*)(ws + WS_YB); bf16_t* HID = (bf16_t*)(ws + WS_HID); bf16_t* WB = (bf16_t*)(ws + WS_WB); const bf16_t* WBl = WB + (size_t)l_ * WB_LAYER; \
    (void)MEMKV; (void)HM; (void)PROJ; (void)OBR; (void)HMEM; (void)BUF; (void)YB; (void)HID; (void)WBl
#define P_ROUTE int* experts = (int*)(ws + WS_ROUTE + RT_EXP); float* weights = (float*)(ws + WS_ROUTE + RT_WGT); int* rank = (int*)(ws + WS_ROUTE + RT_RANK); float* rstd = (float*)(ws + WS_ROUTE + RT_RSTD); \
    (void)experts; (void)weights; (void)rank; (void)rstd
    const int gw = bx * NWAVES + wave, NGW = G * NWAVES;
    const int lo = args.ph_lo, hi = args.ph_hi;
#ifndef STAGE_MASK
#define STAGE_MASK 0x3FFu
#endif
#define IN(k) (lo <= (k) && (k) < hi)
#define ST(s) ((STAGE_MASK >> (s)) & 1u)
#ifndef REP_MASK
#define REP_MASK 0u
#endif
#define NREP(s) (((REP_MASK >> (s)) & 1u) ? 2 : 1)
#ifndef DBL_BAR
#define DBL_BAR 0
#endif
#define SEAM(k) do { if (IN(k) && IN((k) + 1)) { xcd_barrier(bar); if (DBL_BAR) xcd_barrier(bar); } } while (0)

    if (ST(0) && IN(0))
  for (int rep_ = 0; rep_ < NREP(0); ++rep_) {
        int lane = lane0, tid = tid0; asm volatile("" : "+v"(lane), "+v"(tid));
        constexpr int l_ = 0; P_WS; P_ACT;
        float* tab1 = (float*)(ws + WS_TAB); float* tab2 = tab1 + SEQ * 32 * 2;
        const float* x = KIN(0); const float* mem = KIN(1); const float* mem_g = KIN(2); const float* norm1_g = KIN(4); const float* norm2_g = KIN(17); const float* w_rg = KIN(18); const float* w_re = KIN(20);
        LAS float* scr = (LAS float*)(ldsl + wave * 16640);
        tr_run(split ? 1 : 0, gw, split ? 3840 : 29056, NGW, WB, scr, lane);
        for (int idx = bx * (NWAVES * 64) + tid; idx < SEQ * 32; idx += G * NWAVES * 64) { const int pos = idx >> 5, i = idx & 31; float s, c;
            sincosf((float)pos * inv1d(i), &s, &c); tab1[idx * 2] = c; tab1[idx * 2 + 1] = s;
            sincosf(ang2d(pos, i), &s, &c); tab2[idx * 2] = c; tab2[idx * 2 + 1] = s; }
        for (int idx = bx * (NWAVES * 64) + tid; idx < DEPTH * 48 * 1024; idx += G * NWAVES * 64) { const int l = idx / (48 * 1024), c = (idx >> 10) % 48, k = idx & 1023;
            const float w = c < 4 ? w_rg[((size_t)l * DM + k) * 4 + c] : c < 36 ? w_re[((size_t)l * DM + k) * 32 + (c - 4)] : 0.f, v = w * norm2_g[l * DM + k];
            const bf16_t h = f2bf(v); bf16_t* t = WB + WB_RT + (size_t)l * 2 * 48 * 1024 + (size_t)c * 1024 + k; t[0] = h; t[48 * 1024] = f2bf(v - bf2f(h)); }
        for (int m = 4 * gw; m < M; m += 4 * NGW) rows_rmsnorm<4>(x, norm1_g, HM, m, lane);
        for (int m = gw; m < MM; m += NGW) rows_rmsnorm<1>(mem, mem_g, HMEM, m, lane);
    }
    SEAM(0);
#pragma unroll 1
    for (int l = 0; l < DEPTH; ++l) {
        const int pb = 1 + 9 * l, l_ = l;
        const bool l0s = split, cvt = split && conv;
        if (ST(1) && IN(pb + 0))
      for (int rep_ = 0; rep_ < NREP(1); ++rep_) {
            P_WS; P_ACT; float* tab1 = (float*)(ws + WS_TAB); float* tab2 = tab1 + SEQ * 32 * 2; const float* qn_g = KIN(11); const float* kn_g = KIN(12);
            pg8::Gemm g{DM, DM};
            pg8::SchedProj S{bx, G, 1472, l == 0 ? 1504 : 1472, (const char*)HM, (const char*)(WBl + WB_IN), (const char*)HMEM, (const char*)(WB + WB_MEMKV)};
            pg8::EpiProj E{PROJ, MEMKV, tab1, tab2, qn_g + l * 64, kn_g + l * 64};
            pg8::gemm_phase<pg8::EpiProj, pg8::SchedProj, true, true>(ldsl, g, S, E, wave);
        }
        SEAM(pb + 0);
        if (ST(2) && IN(pb + 1))
      for (int rep_ = 0; rep_ < NREP(2); ++rep_) {
            int lane = lane0; asm volatile("" : "+v"(lane));
            if (cvt) { P_WS; P_ACT; tr_run(2 + l, cvw, l == 0 ? 12928 : 12288, NCV * NWAVES, WB, (LAS float*)(ldsl + wave * 16640), lane); } else {
            P_WS; P_ACT; const float* lq1 = KIN(6); const float* lk1 = KIN(7); const float* lq2 = KIN(8); const float* lk2 = KIN(9); const float* subln_g = KIN(10);
            const float lam_init = 0.8f - 0.6f * __expf(-0.3f * (float)l);
            const float lam = __expf(wave_sum(lq1[l * 64 + lane] * lk1[l * 64 + lane])) - __expf(wave_sum(lq2[l * 64 + lane] * lk2[l * 64 + lane])) + lam_init;
            constexpr int NS = NWK - NCV, NB3 = 512 - 2 * NS, NCW = NS - NB3;
            static_assert(NB3 >= 0 && NB3 <= NS && NCW > 0, "attention deal");
            for (int jj = l0s ? 0 : vcu; jj < (l0s ? 1 : 256); jj += (l0s ? 1 : G)) {
                const int w = wk - NCV, wc_ = w - NB3;
                const int c_lo = !l0s ? 0 : wk < NCV ? wk : wc_ >= 0 ? NCV + (wc_ * (256 - NCV)) / NCW : 0, c_hi = !l0s ? 0 : wk < NCV ? wk + 1 : wc_ >= 0 ? NCV + ((wc_ + 1) * (256 - NCV)) / NCW : 0;
                const int na = l0s ? (wk < NCV ? 2 : 1) : 1, nb = l0s ? (wk < NCV ? 0 : (w < NB3 ? 3 : 2)) : 2, nc = l0s ? c_hi - c_lo : 1;
#pragma unroll 1
                for (int i = 0; i < na; ++i) { const int j = l0s ? (i == 0 ? wk : NWK + wk) : jj; att::unit_a(PROJ, OBR, j >> 5, (j >> 3) & 3, j & 7, lam, lam_init, subln_g + l * 128, (char*)lds, wave); }
#pragma unroll 1
                for (int i = 0; i < nb; ++i) { const int j = l0s ? (i < 2 ? 2 * w + i : 2 * NS + w) : 2 * jj + i; att::unit_b(PROJ, OBR, j >> 6, (j >> 3) & 7, j & 7, (char*)lds, wave); }
#pragma unroll 1
                for (int i = 0; i < nc; ++i) { const int j = l0s ? c_lo + i : jj; att::unit_c(PROJ, MEMKV, OBR, j >> 5, (j >> 3) & 3, j & 7, (char*)lds, wave); }
            }
            __syncthreads();
            }
        }
        SEAM(pb + 1);
        if (ST(3) && IN(pb + 2))
      for (int rep_ = 0; rep_ < NREP(3); ++rep_) {
            P_WS; P_ACT;
            pg8::Gemm g{OBR_W, 512};
            pg8::SchedGate S{bx, G, (const char*)OBR, (const char*)(WBl + WB_UP)};
            pg8::EpiGate E{HM, PROJ};
            pg8::gemm_phase<pg8::EpiGate, pg8::SchedGate, true, true>(ldsl, g, S, E, wave);
        }
        SEAM(pb + 2);
        if (ST(4) && IN(pb + 3)) {
            P_WS; P_ACT; const float* x = KIN(0); bf16_t* XB = (bf16_t*)KOUT;
            pg8::Gemm g{DM, DM};
            pg8::SchedPlain S{bx, G, M / 256, (const char*)HM, (const char*)(WBl + WB_OUT), (size_t)256 * DM * 2, (size_t)256 * DM * 2};
            pg8::EpiResid E{x, XB, l == 0 ? 1 : 0};
            pg8::gemm_phase<pg8::EpiResid, pg8::SchedPlain, true, true>(ldsl, g, S, E, wave);
        }
        SEAM(pb + 3);
        if (ST(5) && IN(pb + 4)) {
            int tid = tid0; asm volatile("" : "+v"(tid));
            const int lane = tid & 63;
            P_WS; P_ACT; P_ROUTE; const bf16_t* X = (const bf16_t*)KOUT; const float* b_rg = KIN(19); const float* b_re = KIN(21); const float* norm2_g = KIN(17);
            const bf16_t* tab = WB + WB_RT + (size_t)l * 2 * 48 * 1024 + (size_t)(lane & 15) * 1024 + 128 * wave + 8 * (lane >> 4);
            bf16x8 Bh[3][4], Bl[3][4];
#pragma unroll
            for (int t = 0; t < 3; ++t)
#pragma unroll
                for (int sI = 0; sI < 4; ++sI) { Bh[t][sI] = *(const bf16x8*)(tab + (size_t)t * 16 * 1024 + 32 * sI); Bl[t][sI] = *(const bf16x8*)(tab + (size_t)(48 + t * 16) * 1024 + 32 * sI); }
            for (int rb = bx; rb < M / 64; rb += G)
                route_block(X, tab, b_rg + l * 4, b_re + l * 32, experts, weights, rank, ctl + CW_CNT + 2048 * l, rstd, (int*)BUF, norm2_g + l * DM, HM, rb, Bh, Bl, (LAS float*)ldsl, tid, wave);
        }
        SEAM(pb + 4);
        volatile LAS int* mt = (volatile LAS int*)(ldsl + LDSCTL_OFF + 256);
        LAS unsigned* rowtab = (LAS unsigned*)(ldsl + LDSCTL_OFF + 2048); LAS float* wtab = (LAS float*)(ldsl + LDSCTL_OFF + 6144);
        if (ST(7) && IN(pb + 6)) {
            int tid = tid0; asm volatile("" : "+v"(tid));
            P_WS; P_ACT; P_ROUTE;
            moe_tables(ctl + CW_CNT + 2048 * l, mt, tid);
            moe_rowtabs(mt, (const int*)BUF, weights, rowtab, wtab, vcu, G, tid, 1);
            const int ntiles = __builtin_amdgcn_readfirstlane(mt[256]);
            pg8::Gemm g{DM, DM};
            pg8::SchedMoeUp S{vcu, G, ntiles, (const LAS int*)(ldsl + LDSCTL_OFF + 256 + 96 * 4), (const char*)HM, (const char*)(WBl + WB_GU), ctl + CW_TCNT + l * 160 * 64};
            pg8::EpiSilu E{HID};
            pg8::gemm_phase<pg8::EpiSilu, pg8::SchedMoeUp, true, true, true>(ldsl, g, S, E, wave, rowtab);
        }
        if (ST(8) && IN(pb + 7)) {
            int tid = tid0; asm volatile("" : "+v"(tid));
            P_WS; P_ACT; P_ROUTE;
            if (!(ST(7) && IN(pb + 6))) moe_tables(ctl + CW_CNT + 2048 * l, mt, tid);
            moe_rowtabs(mt, (const int*)BUF, weights, rowtab, wtab, vcu, G, tid, 0);
            const int ntiles = __builtin_amdgcn_readfirstlane(mt[256]);
            pg8::Gemm g{DEXP, DEXP};
            pg8::SchedMoeDown S{vcu, G, ntiles, (ntiles * 4) % G, wave, (const LAS int*)(ldsl + LDSCTL_OFF + 256 + 96 * 4), (const char*)HID, (const char*)(WBl + WB_DN), ctl + CW_TCNT + l * 160 * 64, ctl + CW_TMO};
            pg8::EpiRowScale E{YB, wtab};
            pg8::gemm_phase<pg8::EpiRowScale, pg8::SchedMoeDown, true, true>(ldsl, g, S, E, wave);
        }
        SEAM(pb + 7);
        if (ST(9) && IN(pb + 8)) {
            int lane = lane0; asm volatile("" : "+v"(lane));
            P_WS; P_ACT; P_ROUTE; float* OUTP = KOUT; bf16_t* XB = (bf16_t*)OUTP; const float* norm1_g = KIN(4); const float* final_g = KIN(25);
            const bool last = (l == DEPTH - 1);
            const bool poison = last && ((__hip_atomic_load(ctl + CW_BAR + args.li * BAR_REGION + XB_TMO, __ATOMIC_RELAXED, __HIP_MEMORY_SCOPE_AGENT) | __hip_atomic_load(ctl + CW_TMO, __ATOMIC_RELAXED, __HIP_MEMORY_SCOPE_AGENT)) != 0u);
            if (!(ST(7) && IN(pb + 6)) && !(ST(8) && IN(pb + 7))) moe_tables(ctl + CW_CNT + 2048 * l, mt, tid0);
            static_assert(M % 4 == 0, "rows come in fours");
            for (int m = 4 * gw; m < M; m += 4 * NGW) {
                const u32x4 ex0 = *(const u32x4*)(experts + 2 * m), ex1 = *(const u32x4*)(experts + 2 * m + 4), rk0 = *(const u32x4*)(rank + 2 * m), rk1 = *(const u32x4*)(rank + 2 * m + 4);
                const int rows[4] = {m, m + 1, m + 2, m + 3};
                const int d0[4] = {mt[ex0.x] + (int)rk0.x, mt[ex0.z] + (int)rk0.z, mt[ex1.x] + (int)rk1.x, mt[ex1.z] + (int)rk1.z}, d1[4] = {mt[ex0.y] + (int)rk0.y, mt[ex0.w] + (int)rk0.w, mt[ex1.y] + (int)rk1.y, mt[ex1.w] + (int)rk1.w};
                rows_combine_norm<4>(XB, YB, last ? final_g : norm1_g + (l + 1) * DM, last ? nullptr : HM, OUTP, rows, lane, poison, d0, d1); }
        }
        SEAM(pb + 8);
    }
#undef IN
#undef SEAM
#undef lane0
#undef tid0
#undef P_WS
#undef P_ACT
#undef P_ROUTE
}

extern "C" void kernel_launch(void* const* d_in, const int* in_sizes, int n_in, void* d_out, int out_size, void* d_ws, size_t ws_size, hipStream_t stream) {
    if (n_in != 26 || in_sizes[0] != M * DM || out_size != M * DM || ws_size < WS_END) { fprintf(stderr, "kernel_launch: unexpected shapes n_in %d out %d ws %zu (need %zu)\n", n_in, out_size, ws_size, (size_t)WS_END); return; }
    static int grid = 0;
    if (grid == 0) {
        int dev = 0, cus = 0;
        if (hipGetDevice(&dev) != hipSuccess || hipDeviceGetAttribute(&cus, hipDeviceAttributeMultiprocessorCount, dev) != hipSuccess) { grid = -1; return; }
        if (hipFuncSetAttribute((const void*)mk_fwd, hipFuncAttributeMaxDynamicSharedMemorySize, LDS_BYTES) != hipSuccess) { fprintf(stderr, "kernel_launch: hipFuncSetAttribute failed\n"); grid = -1; return; }
        int per_cu = 0;
        if (hipOccupancyMaxActiveBlocksPerMultiprocessor(&per_cu, (const void*)mk_fwd, NWAVES * 64, LDS_BYTES) != hipSuccess || per_cu < 1) fprintf(stderr, "kernel_launch: occupancy query says %d\n", per_cu);
        (void)hipGetLastError();
        grid = cus;
    }
    if (grid < 0) return;
    (void)hipMemsetAsync((unsigned char*)d_ws + WS_CTL, 0, MiB, stream);
    Args a{};
    for (int i = 0; i < 26; ++i) a.in[i] = (const float*)d_in[i];
    a.out = (float*)d_out; a.ws = (unsigned char*)d_ws; a.ph_lo = 0; a.ph_hi = N_PHASES; a.li = 0; a.pad = 0;
    hipLaunchKernelGGL(mk_fwd, dim3(grid), dim3(NWAVES * 64), LDS_BYTES, stream, a);
}
```

```cpp
#include <hip/hip_runtime.h>
#include <cstdint>
#include <cstdio>
#include <cmath>
#include <cstddef>

typedef unsigned short bf16_t;
typedef float f32x4 __attribute__((ext_vector_type(4)));
typedef unsigned u32x4 __attribute__((ext_vector_type(4)));
typedef unsigned u32x2 __attribute__((ext_vector_type(2)));

constexpr int BATCH = 8, SEQ = 2048, DM = 1024, DEPTH = 2, MEM_LEN = 256;
constexpr int M = BATCH * SEQ;
constexpr int MM = BATCH * MEM_LEN;
constexpr int D_IN = 5888;
constexpr int C_AQ = 0, C_AK = 512, C_AV = 1024, C_BQ = 1536, C_BK = 2048, C_BV = 2176, C_CQ = 2304, C_G = 2816;
constexpr int OBR_W = 1536;
constexpr int NEXP = 32, DEXP = 512;
constexpr int MOE_TILE = 256;
constexpr int P_ROWS = M * 2 + NEXP * MOE_TILE;
constexpr int MAX_TILES = P_ROWS / MOE_TILE;
constexpr float EPS = 1e-6f;
constexpr float LOG2E = 1.4426950408889634f;
constexpr float C2_64 = 0.125f * LOG2E;
constexpr float C2_128 = 0.08838834764831845f * LOG2E;

constexpr size_t MiB = 1u << 20;
constexpr size_t WS_CTL = 0;
constexpr size_t WS_ROUTE = 1 * MiB;
constexpr size_t WS_TAB = 2 * MiB;
constexpr size_t WS_MEMKV = 3 * MiB;
constexpr size_t WS_HM = 7 * MiB;
constexpr size_t WS_PROJ = 39 * MiB;
constexpr size_t WS_OBR = 223 * MiB;
constexpr size_t WS_WB = 271 * MiB;
constexpr size_t WS_END = 499 * MiB;
constexpr size_t WS_BUF = WS_PROJ;
constexpr size_t WS_YB = WS_PROJ + 80 * MiB;
constexpr size_t WS_HID = WS_OBR;
constexpr size_t RT_EXP = 0;
constexpr size_t RT_WGT = 128 * 1024;
constexpr size_t RT_RANK = 256 * 1024;
constexpr size_t RT_DEST = 384 * 1024;
constexpr size_t RT_ROWW = 512 * 1024;
constexpr size_t RT_TILE = 700 * 1024;
constexpr size_t RT_RSTD1 = 896 * 1024;
constexpr size_t RT_RSTD = 768 * 1024;
constexpr int CW_CNT = 163840;
constexpr int CW_TMO = 128;
constexpr int CW_TCNT = 131072;

__device__ __forceinline__ float bf2f(bf16_t v) { return __uint_as_float(((unsigned)v) << 16); }
__device__ __forceinline__ bf16_t f2bf(float f) { unsigned u = __float_as_uint(f); return (bf16_t)((u + 0x7fffu + ((u >> 16) & 1u)) >> 16); }
template <int O> __device__ __forceinline__ float xlane(float v) { static_assert(O >= 1 && O < 32, "swizzle range"); return __int_as_float(__builtin_amdgcn_ds_swizzle(__float_as_int(v), (O << 10) | 0x1F)); }
__device__ __forceinline__ float half_sum(float v) { auto rr = __builtin_amdgcn_permlane32_swap(__float_as_uint(v), __float_as_uint(v), false, false); return __uint_as_float(rr[0]) + __uint_as_float(rr[1]); }
__device__ __forceinline__ float half_max(float v) { auto rr = __builtin_amdgcn_permlane32_swap(__float_as_uint(v), __float_as_uint(v), false, false); return fmaxf(__uint_as_float(rr[0]), __uint_as_float(rr[1])); }
__device__ __forceinline__ float wave_sum(float v) { v += xlane<1>(v); v += xlane<2>(v); v += xlane<4>(v); v += xlane<8>(v); v += xlane<16>(v); return half_sum(v); }
__device__ __forceinline__ float wave_max(float v) { v = fmaxf(v, xlane<1>(v)); v = fmaxf(v, xlane<2>(v)); v = fmaxf(v, xlane<4>(v)); v = fmaxf(v, xlane<8>(v)); v = fmaxf(v, xlane<16>(v)); return half_max(v); }
__device__ __forceinline__ float inv1d(int i) { return exp2f(-(float)i * (13.287712379549449f / 32.f)); }
__device__ __forceinline__ float inv2d(int j) { return exp2f(-(float)j * (13.287712379549449f / 16.f)); }
__device__ __forceinline__ float ang2d(int pos, int i) { return i < 16 ? (float)(pos >> 6) * inv2d(i) : (float)(pos & 63) * inv2d(i - 16); }

#define LAS __attribute__((address_space(3)))
#define GAS __attribute__((address_space(1)))
typedef short bf16x8 __attribute__((ext_vector_type(8)));
typedef short s16x4 __attribute__((ext_vector_type(4)));
typedef float f32x16 __attribute__((ext_vector_type(16)));
typedef float f32x2 __attribute__((ext_vector_type(2)));
typedef int i32x4 __attribute__((ext_vector_type(4)));
typedef int i32x8 __attribute__((ext_vector_type(8)));

constexpr size_t WB_IN = 0, WB_UP = 6029312, WB_OUT = WB_UP + 1572864, WB_GU = WB_OUT + 1048576, WB_DN = WB_GU + 33554432, WB_LAYER = WB_DN + 16777216;
constexpr size_t WB_MEMKV = 2 * WB_LAYER;
constexpr size_t WB_RT = WB_MEMKV + 1048576;
static_assert(WS_WB + (WB_RT + 2 * 2 * 48 * 1024) * 2 <= WS_END, "weight copies fit");
constexpr int N_PHASES = 19;
constexpr int XP = 2048;
constexpr int LCAP = 16384;

__device__ __forceinline__ int lane_id() { int r; asm volatile("v_mbcnt_lo_u32_b32 %0, -1, 0\n\tv_mbcnt_hi_u32_b32 %0, -1, %0" : "=v"(r)); return r; }
__device__ __forceinline__ unsigned cvt_pk_bf16(float lo, float hi) { unsigned r; asm volatile("v_cvt_pk_bf16_f32 %0, %1, %2" : "=v"(r) : "v"(lo), "v"(hi)); return r; }
__device__ __forceinline__ i32x8 cat8(const bf16x8& a, const bf16x8& b) { const i32x4 x = __builtin_bit_cast(i32x4, a), y = __builtin_bit_cast(i32x4, b); return __builtin_shufflevector(x, y, 0, 1, 2, 3, 4, 5, 6, 7); }
__device__ __forceinline__ u32x2 pack8_fp8(const f32x4& v0, const f32x4& v1) { int a = 0, b = 0; a = __builtin_amdgcn_cvt_pk_fp8_f32(v0[0], v0[1], a, false); a = __builtin_amdgcn_cvt_pk_fp8_f32(v0[2], v0[3], a, true);
    b = __builtin_amdgcn_cvt_pk_fp8_f32(v1[0], v1[1], b, false); b = __builtin_amdgcn_cvt_pk_fp8_f32(v1[2], v1[3], b, true); u32x2 r; r.x = (unsigned)a; r.y = (unsigned)b; return r; }
__device__ __forceinline__ unsigned pack4_fp8(const f32x4& v) { int a = 0; a = __builtin_amdgcn_cvt_pk_fp8_f32(v[0], v[1], a, false); a = __builtin_amdgcn_cvt_pk_fp8_f32(v[2], v[3], a, true); return (unsigned)a; }
__device__ __forceinline__ float fast_sigmoid(float v) { return __builtin_amdgcn_rcpf(1.f + __builtin_amdgcn_exp2f(-v * LOG2E)); }

namespace pg8 {
#define PG8_LAS LAS
constexpr int BM = 256, BK = 64, HALF = 128, HTB = HALF * BK * 2, STAGE_BYTES = 8 * HTB, NXCD = 8, WGM = 8;
__host__ __device__ __forceinline__ int lds_byte(int r, int c) { const int st = (r >> 4) * 2 + (c >> 5), rr = r & 15, cc = c & 31, ob = rr * 64 + cc * 2; return st * 1024 + (ob ^ (((ob >> 9) & 1) << 5)); }
__host__ __device__ __forceinline__ void stage_rc(int b, int& R, int& C) { const int st = b / 1024, sb = b % 1024, swz = sb ^ (((sb >> 9) & 1) << 5); R = (st >> 1) * 16 + swz / 64; C = (st & 1) * 32 + (swz % 64) / 2; }
__host__ __device__ __forceinline__ int perm32(int rho) { const int n = rho >> 4, i = rho & 15; return 8 * (i >> 2) + 4 * n + (i & 3); }

struct Unit { int pm, pn, sub, ord; const char* a; const char* b; };
struct Gemm { int lda; int K; int sw = 0x7F7F7F7F; };
__device__ __forceinline__ void tile_order(int L, int nM, int nN, int& pm, int& pn) {
    const int nwg = nM * nN; int wgid = L; { const int q = nwg / NXCD, r = nwg % NXCD, xcd = wgid % NXCD, off = wgid / NXCD; wgid = (xcd < r ? xcd * (q + 1) : r * (q + 1) + (xcd - r) * q) + off; }
    const int nig = WGM * nN, gid = wgid / nig, fm = gid * WGM, gsz = (nM - fm) < WGM ? (nM - fm) : WGM;
    pm = fm + ((wgid % nig) % gsz); pn = (wgid % nig) / gsz;
}
__device__ __forceinline__ u32x4 pack8(const f32x4& v0, const f32x4& v1) { u32x4 w; w.x = cvt_pk_bf16(v0[0], v0[1]); w.y = cvt_pk_bf16(v0[2], v0[3]); w.z = cvt_pk_bf16(v1[0], v1[1]); w.w = cvt_pk_bf16(v1[2], v1[3]); return w; }
__device__ __forceinline__ void unpack8(const u32x4& w, f32x4& v0, f32x4& v1) {
    v0[0] = __uint_as_float(w.x << 16); v0[1] = __uint_as_float(w.x & 0xffff0000u); v0[2] = __uint_as_float(w.y << 16); v0[3] = __uint_as_float(w.y & 0xffff0000u);
    v1[0] = __uint_as_float(w.z << 16); v1[1] = __uint_as_float(w.z & 0xffff0000u); v1[2] = __uint_as_float(w.w << 16); v1[3] = __uint_as_float(w.w & 0xffff0000u); }

__device__ __forceinline__ unsigned pack4_u8(const f32x4& v) {
    const unsigned a = (unsigned)__builtin_rintf(v[0] * 255.f), b = (unsigned)__builtin_rintf(v[1] * 255.f), c = (unsigned)__builtin_rintf(v[2] * 255.f), d = (unsigned)__builtin_rintf(v[3] * 255.f);
    return a | (b << 8) | (c << 16) | (d << 24); }
__device__ __forceinline__ void unpack8_u8(const u32x2& w, f32x4& v0, f32x4& v1) {
    constexpr float k = 1.f / 255.f;
    v0[0] = (float)(w.x & 0xffu) * k; v0[1] = (float)((w.x >> 8) & 0xffu) * k; v0[2] = (float)((w.x >> 16) & 0xffu) * k; v0[3] = (float)(w.x >> 24) * k;
    v1[0] = (float)(w.y & 0xffu) * k; v1[1] = (float)((w.y >> 8) & 0xffu) * k; v1[2] = (float)((w.y >> 16) & 0xffu) * k; v1[3] = (float)(w.y >> 24) * k; }
struct EpiProj {
    static constexpr bool PERM = true, AFTER_DRAIN = false, KHOOK = false;
    bf16_t* PROJ; bf16_t* MEMKV; const float* tab1; const float* tab2; const float* qg; const float* kg; const float* rstd1;
    __device__ __forceinline__ void operator()(const f32x4 (&acc)[2][2][4][2], const Unit& u, int wr, int wc, int fr, int fq) const {
        const int colt = u.pn * 256, dcol = colt + wc * 64 + fq * 8, row0 = u.pm * 256 + wr * 64 + fr;
        if (u.sub == 1) {
#pragma unroll
            for (int ai = 0; ai < 2; ++ai)
#pragma unroll
                for (int m = 0; m < 4; ++m) { bf16_t* rowp = MEMKV + (size_t)(row0 + ai * 128 + m * 16) * 1024 + dcol;
#pragma unroll
                    for (int bj = 0; bj < 2; ++bj) *(u32x4*)(rowp + bj * 32) = pack8(acc[ai][bj][m][0], acc[ai][bj][m][1]); }
            return;
        }
        int mode = 0; float sc = 1.f; const float* g = qg;
        if (colt < C_AV) { mode = 1; if (colt < C_AK) sc = C2_64; }
        else if (colt < C_BQ) mode = 0;
        else if (colt < C_BK) { mode = 2; sc = C2_64; }
        else if (colt < C_CQ) { if (wc < 2) { mode = 2; g = kg; } }
        else if (colt < C_G) sc = C2_128;
        else mode = 3;
        f32x4 gv[2][2];
        if (mode == 2) {
#pragma unroll
            for (int bj = 0; bj < 2; ++bj)
#pragma unroll
                for (int n = 0; n < 2; ++n) gv[bj][n] = *(const f32x4*)(g + bj * 32 + fq * 8 + n * 4);
        }
        float r1v[2][4];
#pragma unroll
        for (int ai = 0; ai < 2; ++ai)
#pragma unroll
            for (int m = 0; m < 4; ++m) r1v[ai][m] = rstd1[row0 + ai * 128 + m * 16];
        asm volatile("" ::: "memory");
#pragma unroll
        for (int ai = 0; ai < 2; ++ai)
#pragma unroll
            for (int m = 0; m < 4; ++m) {
                const int row = row0 + ai * 128 + m * 16, pos = row & (SEQ - 1);
                const float r1 = r1v[ai][m];
                f32x4 v[2][2] = {{acc[ai][0][m][0] * r1, acc[ai][0][m][1] * r1}, {acc[ai][1][m][0] * r1, acc[ai][1][m][1] * r1}};
                if (mode == 2) {
                    float ss = 0.f;
#pragma unroll
                    for (int bj = 0; bj < 2; ++bj)
#pragma unroll
                        for (int n = 0; n < 2; ++n) ss += (v[bj][n][0] * v[bj][n][0] + v[bj][n][1] * v[bj][n][1]) + (v[bj][n][2] * v[bj][n][2] + v[bj][n][3] * v[bj][n][3]);
                    ss += xlane<16>(ss); ss = half_sum(ss);
                    const float rs = rsqrtf(ss * (1.f / 64.f) + EPS);
#pragma unroll
                    for (int bj = 0; bj < 2; ++bj)
#pragma unroll
                        for (int n = 0; n < 2; ++n) v[bj][n] = v[bj][n] * rs * gv[bj][n];
                }
                if (mode == 1 || mode == 2) {
                    const float* tb = (mode == 1 ? tab1 : tab2) + ((size_t)pos * 32 + fq * 8) * 2;
#pragma unroll
                    for (int n = 0; n < 2; ++n) { const f32x4 t0 = *(const f32x4*)(tb + n * 8), t1 = *(const f32x4*)(tb + n * 8 + 4);
                        const float cs[4] = {t0[0], t0[2], t1[0], t1[2]}, sn[4] = {t0[1], t0[3], t1[1], t1[3]};
#pragma unroll
                        for (int e = 0; e < 4; ++e) { const float x1 = v[0][n][e], x2 = v[1][n][e]; v[0][n][e] = x1 * cs[e] - x2 * sn[e]; v[1][n][e] = x2 * cs[e] + x1 * sn[e]; } }
                }
                if (mode == 3) {
#pragma unroll
                    for (int bj = 0; bj < 2; ++bj)
#pragma unroll
                        for (int n = 0; n < 2; ++n)
#pragma unroll
                            for (int e = 0; e < 4; ++e) v[bj][n][e] = fast_sigmoid(v[bj][n][e]);
                }
                if (mode == 3) {
                    u32x4 w; w.x = pack4_u8(v[0][0]); w.y = pack4_u8(v[0][1]); w.z = pack4_u8(v[1][0]); w.w = pack4_u8(v[1][1]);
                    *(u32x4*)((unsigned char*)(PROJ + (size_t)row * D_IN + C_G) + (colt - C_G) + wc * 64 + fq * 16) = w;
                } else {
                bf16_t* rowp = PROJ + (size_t)row * D_IN + dcol;
#pragma unroll
                for (int bj = 0; bj < 2; ++bj) *(u32x4*)(rowp + bj * 32) = pack8(v[bj][0] * sc, v[bj][1] * sc);
                }
            }
    }
};
struct EpiGate {
    static constexpr bool PERM = true, AFTER_DRAIN = false, KHOOK = true;
    bf16_t* MERGED; const bf16_t* PROJ;
    __device__ __forceinline__ static void ug(const u32x2& w, f32x4& v0, f32x4& v1) {
        unpack8_u8(w, v0, v1);
#pragma unroll
        for (int e = 0; e < 4; ++e) { v0[e] = fmaxf(v0[e], 0.5f / 255.f); v1[e] = fmaxf(v1[e], 0.5f / 255.f); } }
    __device__ __forceinline__ void khook(f32x4 (&acc)[2][2][4][2], const Unit& u, int t, int wr, int wc, int fr, int fq) const {
        int row0 = u.pm * 256 + wr * 64 + fr; asm volatile("" : "+v"(row0));
        const int seg = (t >> 3) - 1, col0 = u.pn * 256 + wc * 32 + fq * 8;
#pragma unroll
        for (int ai = 0; ai < 2; ++ai) {
            u32x2 ga[4][2], gb[4][2];
#pragma unroll
            for (int m = 0; m < 4; ++m) { const unsigned char* gp = (const unsigned char*)(PROJ + (size_t)(row0 + ai * 128 + m * 16) * D_IN + C_G) + seg * 1024 + col0;
#pragma unroll
                for (int bj = 0; bj < 2; ++bj) { ga[m][bj] = *(const u32x2*)(gp + bj * 128); gb[m][bj] = *(const u32x2*)(gp + 1024 + bj * 128); } }
            asm volatile("" ::: "memory");
#pragma unroll
            for (int m = 0; m < 4; ++m)
#pragma unroll
                for (int bj = 0; bj < 2; ++bj) { f32x4 a0, a1, b0, b1; ug(ga[m][bj], a0, a1); ug(gb[m][bj], b0, b1);
#pragma unroll
                    for (int e = 0; e < 4; ++e) { acc[ai][bj][m][0][e] *= a0[e] * __builtin_amdgcn_rcpf(b0[e]); acc[ai][bj][m][1][e] *= a1[e] * __builtin_amdgcn_rcpf(b1[e]); } }
            asm volatile("" ::: "memory");
        }
    }
    __device__ __forceinline__ void operator()(const f32x4 (&acc)[2][2][4][2], const Unit& u, int wr, int wc, int fr, int fq) const {
        const int col0 = u.pn * 256 + wc * 32 + fq * 8, row0 = u.pm * 256 + wr * 64 + fr;
#pragma unroll
        for (int ai = 0; ai < 2; ++ai) {
            u32x2 gq[4][2];
#pragma unroll
            for (int m = 0; m < 4; ++m) { const unsigned char* gp = (const unsigned char*)(PROJ + (size_t)(row0 + ai * 128 + m * 16) * D_IN + C_G) + 2 * 1024 + col0;
#pragma unroll
                for (int bj = 0; bj < 2; ++bj) gq[m][bj] = *(const u32x2*)(gp + bj * 128); }
            asm volatile("" ::: "memory");
#pragma unroll
            for (int m = 0; m < 4; ++m) { bf16_t* op = MERGED + (size_t)(row0 + ai * 128 + m * 16) * DM + col0;
#pragma unroll
                for (int bj = 0; bj < 2; ++bj) { f32x4 g0, g1; ug(gq[m][bj], g0, g1); *(u32x4*)(op + bj * 128) = pack8(g0 * acc[ai][bj][m][0], g1 * acc[ai][bj][m][1]); } }
            asm volatile("" ::: "memory");
        }
    }
};
struct EpiResid {
    static constexpr bool PERM = true, AFTER_DRAIN = false, KHOOK = false;
    bf16_t* XB;
    __device__ __forceinline__ void operator()(const f32x4 (&acc)[2][2][4][2], const Unit& u, int wr, int wc, int fr, int fq) const {
        const int col0 = u.pn * 256 + wc * 32 + fq * 8, row0 = u.pm * 256 + wr * 64 + fr;
#pragma unroll
        for (int ai = 0; ai < 2; ++ai)
#pragma unroll
            for (int mp = 0; mp < 2; ++mp) {
                u32x4 xq[2][2];
#pragma unroll
                for (int mi = 0; mi < 2; ++mi)
#pragma unroll
                    for (int bj = 0; bj < 2; ++bj) xq[mi][bj] = *(const u32x4*)(XB + (size_t)(row0 + ai * 128 + (mp * 2 + mi) * 16) * XP + col0 + bj * 128);
                asm volatile("" ::: "memory");
#pragma unroll
                for (int mi = 0; mi < 2; ++mi) { const int m = mp * 2 + mi;
#pragma unroll
                    for (int bj = 0; bj < 2; ++bj) { f32x4 x0, x1; unpack8(xq[mi][bj], x0, x1);
                        *(u32x4*)(XB + (size_t)(row0 + ai * 128 + m * 16) * XP + col0 + bj * 128) = pack8(x0 + acc[ai][bj][m][0], x1 + acc[ai][bj][m][1]); } }
                asm volatile("" ::: "memory");
            }
    }
};
constexpr float HID_SCALE = 4.f;
struct EpiSilu {
    static constexpr bool PERM = true, AFTER_DRAIN = false, KHOOK = false;
    unsigned char* HID; const PG8_LAS float* rtab;
    __device__ __forceinline__ void operator()(const f32x4 (&acc)[2][2][4][2], const Unit& u, int wr, int wc, int fr, int fq) const {
        const __amdgpu_buffer_rsrc_t rsrc = __builtin_amdgcn_make_buffer_rsrc((void*)HID, 0, P_ROWS * DEXP, 0x00020000);
        const int col0 = u.pn * 128 + wc * 32 + fq * 8, row0 = u.pm * 256 + wr * 64 + fr;
#pragma unroll
        for (int ai = 0; ai < 2; ++ai)
#pragma unroll
            for (int m = 0; m < 4; ++m) { f32x4 h[2]; const float r = rtab[u.ord * 256 + wr * 64 + fr + ai * 128 + m * 16];
#pragma unroll
                for (int n = 0; n < 2; ++n)
#pragma unroll
                    for (int e = 0; e < 4; ++e) { const float gq = acc[ai][0][m][n][e] * r; h[n][e] = gq * fast_sigmoid(gq) * (acc[ai][1][m][n][e] * (r * HID_SCALE)); }
                __builtin_amdgcn_raw_buffer_store_b64(pack8_fp8(h[0], h[1]), rsrc, (row0 + ai * 128 + m * 16) * DEXP + col0, 0, 16); }
    }
};
struct EpiRowScale {
    static constexpr bool PERM = true, AFTER_DRAIN = false, KHOOK = false;
    unsigned char* YB; const PG8_LAS float* wtab;
    __device__ __forceinline__ void operator()(const f32x4 (&acc)[2][2][4][2], const Unit& u, int wr, int wc, int fr, int fq) const {
        const int col0 = u.pn * 256 + wc * 64 + fq * 16, rt0 = wr * 64 + fr;
#pragma unroll
        for (int ai = 0; ai < 2; ++ai)
#pragma unroll
            for (int m = 0; m < 4; ++m) { const int rt = rt0 + ai * 128 + m * 16; const float w = wtab[u.ord * 256 + rt];
                if (w >= 0.f) {
                    u32x4 o; o.x = pack4_fp8(acc[ai][0][m][0] * w); o.y = pack4_fp8(acc[ai][0][m][1] * w); o.z = pack4_fp8(acc[ai][1][m][0] * w); o.w = pack4_fp8(acc[ai][1][m][1] * w);
                    *(u32x4*)(YB + (size_t)(u.pm * 256 + rt) * DM + col0) = o; } }
    }
};
constexpr int NPT = C_G / 256, NGT = (D_IN - C_G) / 256;
struct SchedProj {
    int c, G, nmain, ntotal; const char* A; const char* B; const char* Am; const char* Bm;
    __device__ __forceinline__ bool next(int i, Unit& u) const {
        const long L = (long)i * G + c; if (L >= ntotal) return false;
        u.ord = i;
        if (L < nmain) { tile_order((int)L, M / 256, NPT, u.pm, u.pn); u.sub = 0; u.a = A + (size_t)u.pm * (256 * XP * 2); u.b = B + (size_t)u.pn * (256 * DM * 2); }
        else { const int r = (int)L - nmain; u.pm = r >> 2; u.pn = r & 3; u.sub = 1; u.a = Am + (size_t)u.pm * (256 * XP * 2); u.b = Bm + (size_t)u.pn * (256 * DM * 2); }
        return true; }
    __device__ __forceinline__ void a_ready(const Unit&) const {}
    __device__ __forceinline__ void done(const Unit&) const {}
};
struct SchedGate8 {
    int c, G, kh; const char* A; const char* B;
    __device__ __forceinline__ bool next(int i, Unit& u) const {
        long L;
        if (G == 256) { const int k = c >> 3, nl = 32 - kh, k3 = 96 - 4 * nl - 2 * kh, nf = k < k3 ? 3 : k < kh ? 2 : 4, st = k < k3 ? 3 * k : k < kh ? 3 * k3 + 2 * (k - k3) : 3 * k3 + 2 * (kh - k3) + 4 * (k - kh);
            if (i >= nf) return false; L = 8 * (st + i) + (c & 7); }
        else { L = (long)i * G + c; if (L >= (M / 256) * NGT) return false; }
        tile_order((int)L, M / 256, NGT, u.pm, u.pn); u.sub = 0; u.ord = i; u.a = A + (size_t)u.pm * (256 * DM); u.b = B + (size_t)u.pn * (256 * DM); u.pn += NPT; return true; }
    __device__ __forceinline__ void a_ready(const Unit&) const {}
    __device__ __forceinline__ void done(const Unit&) const {}
};
struct EpiSig {
    static constexpr bool PERM = true, AFTER_DRAIN = false, KHOOK = false;
    bf16_t* PROJ; const float* rstd1;
    __device__ __forceinline__ void operator()(const f32x4 (&acc)[2][2][4][2], const Unit& u, int wr, int wc, int fr, int fq) const {
        const int colt = u.pn * 256, row0 = u.pm * 256 + wr * 64 + fr;
        float r1v[2][4];
#pragma unroll
        for (int ai = 0; ai < 2; ++ai)
#pragma unroll
            for (int m = 0; m < 4; ++m) r1v[ai][m] = rstd1[row0 + ai * 128 + m * 16];
        asm volatile("" ::: "memory");
#pragma unroll
        for (int ai = 0; ai < 2; ++ai)
#pragma unroll
            for (int m = 0; m < 4; ++m) { const int row = row0 + ai * 128 + m * 16; const float r1 = r1v[ai][m]; u32x4 w;
#pragma unroll
                for (int bj = 0; bj < 2; ++bj)
#pragma unroll
                    for (int n = 0; n < 2; ++n) { f32x4 v;
#pragma unroll
                        for (int e = 0; e < 4; ++e) v[e] = fast_sigmoid(acc[ai][bj][m][n][e] * r1);
                        w[bj * 2 + n] = pack4_u8(v); }
                *(u32x4*)((unsigned char*)(PROJ + (size_t)row * D_IN + C_G) + (colt - C_G) + wc * 64 + fq * 16) = w; }
    }
};
struct SchedPlain {
    int c, G, nM; const char* A; const char* B; size_t a_tile, b_tile;
    __device__ __forceinline__ bool next(int i, Unit& u) const {
        const long L = (long)i * G + c; if (L >= (long)nM * 4) return false;
        tile_order((int)L, nM, 4, u.pm, u.pn); u.sub = 0; u.ord = i; u.a = A + (size_t)u.pm * a_tile; u.b = B + (size_t)u.pn * b_tile; return true; }
    __device__ __forceinline__ void a_ready(const Unit&) const {}
    __device__ __forceinline__ void done(const Unit&) const {}
};
struct SchedMoeUp {
    static constexpr size_t b_exp = (size_t)1024 * 1024, b_tile = (size_t)256 * DM;
    int c, G, ntiles; const PG8_LAS int* tile_e; const char* A; const char* B; unsigned* tcnt;
    __device__ __forceinline__ bool next(int i, Unit& u) const {
        const long L = (long)i * G + c; if (L >= (long)ntiles * 4) return false;
        u.pm = (int)(L >> 2); u.pn = (int)(L & 3); u.sub = 0; u.ord = i; const int e = tile_e[u.pm];
        u.a = A; u.b = B + (size_t)e * b_exp + (size_t)u.pn * b_tile; return true; }
    __device__ __forceinline__ void a_ready(const Unit&) const {}
    __device__ __forceinline__ void done(const Unit& u) const {
        asm volatile("s_waitcnt vmcnt(0)" ::: "memory");
        if (lane_id() == 0) __hip_atomic_fetch_add(tcnt + 64 * u.pm, 1u, __ATOMIC_RELAXED, __HIP_MEMORY_SCOPE_AGENT);
    }
};
__device__ __forceinline__ int moe_down_unit(int c, int i, int rem, int G) {
    const int n0 = G - rem, n1 = rem;
    return c >= rem ? n0 * i + n1 * (i > 1 ? i - 1 : 0) + (c - rem) : n0 * (i + 2) + n1 * i + c;
}
struct SchedMoeDown {
    static constexpr size_t a_tile = (size_t)256 * DEXP, b_exp = (size_t)1024 * 512, b_tile = (size_t)256 * DEXP;
    int c, G, ntiles, rem, wv; const PG8_LAS int* tile_e; const char* A; const char* B; unsigned* tcnt; unsigned* tmo;
    __device__ __forceinline__ bool next(int i, Unit& u) const {
        const int j = moe_down_unit(c, i, rem, G); if (j >= ntiles * 4) return false;
        u.pm = j >> 2; u.pn = j & 3; u.sub = 0; u.ord = i; const int e = tile_e[u.pm];
        u.a = A + (size_t)u.pm * a_tile; u.b = B + (size_t)e * b_exp + (size_t)u.pn * b_tile; return true; }
    __device__ __forceinline__ void a_ready(const Unit& u) const {
        if (wv == 0) {
            unsigned polls = 0;
            while ((unsigned)__builtin_amdgcn_readfirstlane(__hip_atomic_load(tcnt + 64 * u.pm, __ATOMIC_RELAXED, __HIP_MEMORY_SCOPE_AGENT)) < 32u) {
                if (++polls > (1u << 20)) { if (lane_id() == 0) __hip_atomic_store(tmo, 1u, __ATOMIC_RELAXED, __HIP_MEMORY_SCOPE_AGENT); break; }
                __builtin_amdgcn_s_sleep(2); }
            __builtin_amdgcn_fence(__ATOMIC_ACQUIRE, "agent");
            asm volatile("s_waitcnt vmcnt(0)" ::: "memory");
        }
        asm volatile("" ::: "memory"); __builtin_amdgcn_s_barrier(); asm volatile("" ::: "memory");
    }
    __device__ __forceinline__ void done(const Unit&) const {}
};

template <class Epi, class Sched, bool ALIGN_EPI = false, bool SP2 = false, bool GATHER = false, bool F8 = false>
__device__ __forceinline__ void gemm_phase(PG8_LAS unsigned char* lds, const Gemm g, const Sched& S, const Epi& E, int wave_id, const PG8_LAS unsigned* rowtab = nullptr) {
    static_assert(!GATHER || SP2, "the gathered A path is written for the two-super-phase loop");
    int tid_ = wave_id * 64 + lane_id(); asm volatile("" : "+v"(tid_));
    const int tid = tid_, wid = __builtin_amdgcn_readfirstlane(tid >> 6), lane = tid & 63, wr = wid >> 2, wc = wid & 3, fr = lane & 15, fq = lane >> 4;
    int K_ = g.K; if constexpr (F8) asm volatile("" : "+s"(K_));
    const int K = K_, nt = K / BK;
    int sc8v = g.sw; if constexpr (F8) asm volatile("" : "+v"(sc8v));
    unsigned voffA[2], voffB[2];
#pragma unroll
    for (int i = 0; i < 2; ++i) { int R, C; stage_rc(tid * 16 + i * 8192, R, C); const int Rb = Epi::PERM ? ((R & ~31) + perm32(R & 31)) : R;
        voffA[i] = (unsigned)(R * g.lda + C) * 2u; voffB[i] = (unsigned)(Rb * K + C) * 2u; }
    unsigned gC[2][2] = {{0u, 0u}, {0u, 0u}}, gN[2][2] = {{0u, 0u}, {0u, 0u}};
#define PG8_GROWS(dst, ord) do { if constexpr (GATHER) { _Pragma("unroll") for (int i_ = 0; i_ < 2; ++i_) { int R_, C_; stage_rc((wid * 64 + fq * 16 + fr) * 16 + i_ * 8192, R_, C_);     \
        _Pragma("unroll") for (int h_ = 0; h_ < 2; ++h_) dst[h_][i_] = rowtab[(ord) * 256 + h_ * 128 + R_] + (unsigned)C_ * 2u; } } } while (0)
#define PG8_STAGE_A(bufoff, base, h, use_next) do { if constexpr (GATHER) { unsigned vo_[2]; vo_[0] = (use_next) ? gN[h][0] : gC[h][0]; vo_[1] = (use_next) ? gN[h][1] : gC[h][1]; PG8_STAGE(bufoff, base, vo_); } \
        else { PG8_STAGE(bufoff, (base) + (h) * hstepA, voffA); } } while (0)
    const size_t kstep = (size_t)(BK * 2);
    const size_t hstepA = (size_t)HALF * g.lda * 2, hstepB = (size_t)HALF * K * 2;
    const unsigned ldsw = (unsigned)wid * 1024u;
    const int aoff = lds_byte(wr * 64 + fr, fq * 8), boff = lds_byte(wc * 32 + fr, fq * 8);
#define PG8_SA(b, h) (((b) * 2 + (h)) * HTB)
#define PG8_SB(b, h) ((4 + (b) * 2 + (h)) * HTB)
#define PG8_STAGE(bufoff, gbase, voff) do { _Pragma("unroll") for (int _i = 0; _i < 2; ++_i) \
        __builtin_amdgcn_global_load_lds((const unsigned*)((const char*)(gbase) + (voff)[_i]), (PG8_LAS unsigned*)(lds + (bufoff) + ldsw + _i * 8192), 16, 0, 0); } while (0)
#define PG8_LDA(dst, b, h) do { _Pragma("unroll") for (int m = 0; m < 4; ++m) _Pragma("unroll") for (int k = 0; k < 2; ++k) dst[m][k] = *(const PG8_LAS bf16x8*)(lds + PG8_SA(b, h) + aoff + m * 2048 + k * 1024); } while (0)
#define PG8_LDB(dst, b, h) do { _Pragma("unroll") for (int n = 0; n < 2; ++n) _Pragma("unroll") for (int k = 0; k < 2; ++k) dst[n][k] = *(const PG8_LAS bf16x8*)(lds + PG8_SB(b, h) + boff + n * 2048 + k * 1024); } while (0)
#define PG8_MMA(ai, bj, At, Bt) do { __builtin_amdgcn_s_setprio(1); _Pragma("unroll") for (int m = 0; m < 4; ++m) _Pragma("unroll") for (int n = 0; n < 2; ++n) { \
        if constexpr (F8) asm volatile("v_mfma_scale_f32_16x16x128_f8f6f4 %0, %1, %2, %0, %3, %3 op_sel_hi:[0,0,0]" : "+v"(acc[ai][bj][m][n]) : "v"(cat8(Bt[n][0], Bt[n][1])), "v"(cat8(At[m][0], At[m][1])), "v"(sc8v));     \
        else { _Pragma("unroll") for (int k = 0; k < 2; ++k) acc[ai][bj][m][n] = __builtin_amdgcn_mfma_f32_16x16x32_bf16(Bt[n][k], At[m][k], acc[ai][bj][m][n], 0, 0, 0); } } __builtin_amdgcn_s_setprio(0); } while (0)
#define PG8_WAIT_V(n) asm volatile("s_waitcnt vmcnt(" #n ")" ::: "memory")
#define PG8_WAIT_L(n) asm volatile("s_waitcnt lgkmcnt(" #n ")" ::: "memory")
#define PG8_BAR __builtin_amdgcn_s_barrier()
#define PG8_SCHED __builtin_amdgcn_sched_barrier(0)
    Unit cur, nxt; int ui = 0;
    if (!S.next(0, cur)) return;
    f32x4 acc[2][2][4][2];
#pragma unroll
    for (int a = 0; a < 2; ++a)
#pragma unroll
        for (int b = 0; b < 2; ++b)
#pragma unroll
            for (int m = 0; m < 4; ++m)
#pragma unroll
                for (int n = 0; n < 2; ++n) acc[a][b][m][n] = (f32x4){0.f, 0.f, 0.f, 0.f};
    bf16x8 At[4][2], B0[2][2], B1[2][2];
    const char* cA = cur.a; const char* cB = cur.b;
    S.a_ready(cur);
    if constexpr (SP2) {
        PG8_GROWS(gC, 0);
        PG8_STAGE(PG8_SB(0, 0), cB, voffB); PG8_STAGE(PG8_SB(0, 1), cB + hstepB, voffB); PG8_STAGE_A(PG8_SA(0, 0), cA, 0, false); PG8_STAGE_A(PG8_SA(0, 1), cA, 1, false);
        if (wr == 1) PG8_BAR;
        PG8_WAIT_V(2); PG8_BAR;
        PG8_STAGE(PG8_SB(1, 0), cB + kstep, voffB); PG8_STAGE_A(PG8_SA(1, 0), cA + kstep, 0, false); PG8_STAGE(PG8_SB(1, 1), cB + hstepB + kstep, voffB);
        PG8_WAIT_V(6); PG8_BAR;
    } else {
        PG8_STAGE(PG8_SB(0, 0), cB, voffB); PG8_STAGE(PG8_SA(0, 0), cA, voffA); PG8_STAGE(PG8_SB(0, 1), cB + hstepB, voffB); PG8_STAGE(PG8_SA(0, 1), cA + hstepA, voffA);
        if (wr == 1) PG8_BAR;
        PG8_WAIT_V(4); PG8_BAR;
        PG8_STAGE(PG8_SB(1, 0), cB + kstep, voffB); PG8_STAGE(PG8_SA(1, 0), cA + kstep, voffA); PG8_STAGE(PG8_SB(1, 1), cB + hstepB + kstep, voffB);
        PG8_WAIT_V(6); PG8_BAR;
    }
    for (;;) {
        const bool has_next = S.next(ui + 1, nxt);
        const char* nA = has_next ? nxt.a : cA; const char* nB = has_next ? nxt.b : cB;
        for (int t = 0; t < nt; t += 2) {
            if constexpr (Epi::KHOOK) { if (t == 8 || t == 16) E.khook(acc, cur, t, wr, wc, fr, fq); }
            const bool last = (t == nt - 2);
            const char* a1 = cA + (size_t)(t + 1) * kstep;
            const char* a2 = last ? nA : cA + (size_t)(t + 2) * kstep; const char* b2 = last ? nB : cB + (size_t)(t + 2) * kstep;
            const char* a3 = a2 + kstep; const char* b3 = b2 + kstep;
            if (last && has_next) S.a_ready(nxt);
            if constexpr (GATHER) { if (last) { if (has_next) { PG8_GROWS(gN, ui + 1); } else { _Pragma("unroll") for (int h_ = 0; h_ < 2; ++h_) _Pragma("unroll") for (int i_ = 0; i_ < 2; ++i_) gN[h_][i_] = gC[h_][i_]; } } }
            if constexpr (SP2) {
            PG8_LDB(B0, 0, 0); PG8_LDB(B1, 0, 1); PG8_SCHED; PG8_LDA(At, 0, 0); PG8_STAGE_A(PG8_SA(1, 1), a1, 1, false);
            PG8_WAIT_V(8); PG8_WAIT_L(0); PG8_BAR; PG8_MMA(0, 0, At, B0); PG8_MMA(0, 1, At, B1); PG8_BAR; PG8_SCHED;
            PG8_LDA(At, 0, 1); PG8_STAGE(PG8_SB(0, 0), b2, voffB); PG8_STAGE(PG8_SB(0, 1), b2 + hstepB, voffB); PG8_STAGE_A(PG8_SA(0, 0), a2, 0, last);
            PG8_WAIT_V(8); PG8_WAIT_L(0); PG8_BAR; PG8_MMA(1, 0, At, B0); PG8_MMA(1, 1, At, B1); PG8_BAR; PG8_SCHED;
            PG8_LDB(B0, 1, 0); PG8_LDB(B1, 1, 1); PG8_SCHED; PG8_LDA(At, 1, 0); PG8_STAGE_A(PG8_SA(0, 1), a2, 1, last);
            PG8_WAIT_V(8); PG8_WAIT_L(0); PG8_BAR; PG8_MMA(0, 0, At, B0); PG8_MMA(0, 1, At, B1); PG8_BAR; PG8_SCHED;
            PG8_LDA(At, 1, 1); PG8_STAGE(PG8_SB(1, 0), b3, voffB); PG8_STAGE(PG8_SB(1, 1), b3 + hstepB, voffB); PG8_STAGE_A(PG8_SA(1, 0), a3, 0, last);
            PG8_WAIT_V(8); PG8_WAIT_L(0); PG8_BAR; PG8_MMA(1, 0, At, B0); PG8_MMA(1, 1, At, B1); PG8_BAR; PG8_SCHED;
            } else {
            PG8_LDB(B0, 0, 0); PG8_SCHED; PG8_LDA(At, 0, 0); PG8_STAGE(PG8_SA(1, 1), a1 + hstepA, voffA);
            PG8_WAIT_L(8); PG8_BAR; PG8_WAIT_L(0); PG8_MMA(0, 0, At, B0); PG8_BAR; PG8_SCHED;
            PG8_LDB(B1, 0, 1); PG8_STAGE(PG8_SB(0, 0), b2, voffB);
            PG8_BAR; PG8_WAIT_L(0); PG8_MMA(0, 1, At, B1); PG8_BAR;
            PG8_LDA(At, 0, 1); PG8_STAGE(PG8_SA(0, 0), a2, voffA);
            PG8_BAR; PG8_WAIT_L(0); PG8_MMA(1, 0, At, B0); PG8_BAR; PG8_SCHED;
            PG8_STAGE(PG8_SB(0, 1), b2 + hstepB, voffB);
            PG8_WAIT_V(6); PG8_BAR; PG8_MMA(1, 1, At, B1); PG8_BAR;
            PG8_LDB(B0, 1, 0); PG8_SCHED; PG8_LDA(At, 1, 0); PG8_STAGE(PG8_SA(0, 1), a2 + hstepA, voffA);
            PG8_WAIT_L(8); PG8_BAR; PG8_WAIT_L(0); PG8_MMA(0, 0, At, B0); PG8_BAR; PG8_SCHED;
            PG8_LDB(B1, 1, 1); PG8_STAGE(PG8_SB(1, 0), b3, voffB);
            PG8_BAR; PG8_WAIT_L(0); PG8_MMA(0, 1, At, B1); PG8_BAR;
            PG8_LDA(At, 1, 1); PG8_STAGE(PG8_SA(1, 0), a3, voffA);
            PG8_BAR; PG8_WAIT_L(0); PG8_MMA(1, 0, At, B0); PG8_BAR; PG8_SCHED;
            PG8_STAGE(PG8_SB(1, 1), b3 + hstepB, voffB);
            PG8_WAIT_V(6); PG8_BAR; PG8_MMA(1, 1, At, B1); PG8_BAR;
            }
        }
        if constexpr (ALIGN_EPI) { if (wr == 0) PG8_BAR; }
        if constexpr (!Epi::AFTER_DRAIN) {
            if constexpr (F8) { asm volatile("s_nop 15\n\ts_nop 15" ::: "memory");
                const int le_ = lane_id(); E(acc, cur, wr, wc, le_ & 15, le_ >> 4); }
            else E(acc, cur, wr, wc, fr, fq);
            S.done(cur); }
        if (!has_next) break;
#pragma unroll
        for (int a = 0; a < 2; ++a)
#pragma unroll
            for (int b = 0; b < 2; ++b)
#pragma unroll
                for (int m = 0; m < 4; ++m)
#pragma unroll
                    for (int n = 0; n < 2; ++n) acc[a][b][m][n] = (f32x4){0.f, 0.f, 0.f, 0.f};
        cur = nxt; cA = nA; cB = nB; ++ui;
        if constexpr (GATHER) { _Pragma("unroll") for (int h_ = 0; h_ < 2; ++h_) _Pragma("unroll") for (int i_ = 0; i_ < 2; ++i_) gC[h_][i_] = gN[h_][i_]; }
        if constexpr (ALIGN_EPI) { if (wr == 1) PG8_BAR; }
    }
    PG8_WAIT_V(0);
    if constexpr (!ALIGN_EPI) { if (wr == 0) PG8_BAR; }
    PG8_BAR;
    if constexpr (Epi::AFTER_DRAIN) { E.fused(acc, cur, wr, wc, fr, fq, lds, wid, lane); S.done(cur); }
#undef PG8_SA
#undef PG8_GROWS
#undef PG8_STAGE_A
#undef PG8_SB
#undef PG8_STAGE
#undef PG8_LDA
#undef PG8_LDB
#undef PG8_MMA
#undef PG8_WAIT_V
#undef PG8_WAIT_L
#undef PG8_BAR
#undef PG8_SCHED
}
}

namespace att {
constexpr int NW = 8, QBLK = 32, KVBLK = 64;
constexpr float THR = 8.f;
#define ATT_SBAR() __builtin_amdgcn_sched_barrier(0)
__device__ __forceinline__ int crow(int r, int hi) { return (r & 3) + 8 * (r >> 2) + 4 * hi; }
template <int D> __device__ __forceinline__ int kswz(int row, int colB) { return D == 128 ? row * 256 + (colB ^ ((row & 7) << 4)) : row * 128 + (colB ^ (((row >> 1) & 7) << 4)); }
template <int DV> __device__ __forceinline__ int v_st(int k, int c) { const int kk = (k & ~0xC) | ((k & 4) << 1) | ((k & 8) >> 1); return ((kk >> 3) * (DV / 32) + (c >> 5)) * 512 + ((kk & 7) * 32 + (c & 31)) * 2; }
__device__ __forceinline__ int v_rd_base(int lane) { return ((lane & 3) << 3) | (((lane >> 2) & 3) << 6) | (((lane >> 4) & 1) << 5) | (((lane >> 5) & 1) << 8); }
template <int DV> constexpr int v_rd_off(int d0, int ks, int half) { return d0 * 512 + ks * (DV / 32) * 1024 + half * (DV / 32) * 512; }
template <int OFF> __device__ __forceinline__ s16x4 tr_read(int vb) { s16x4 r; asm volatile("ds_read_b64_tr_b16 %0, %1 offset:%2" : "=&v"(r) : "v"(vb), "i"(OFF) : "memory"); return r; }

__device__ __forceinline__ void partialSM(f32x16& p0, f32x16& p1, float& m_reg, float& mn, float& alpha) {
    float pmax = p0[0];
#pragma unroll
    for (int r = 1; r < 16; ++r) pmax = fmaxf(pmax, p0[r]);
#pragma unroll
    for (int r = 0; r < 16; ++r) pmax = fmaxf(pmax, p1[r]);
    { auto rr = __builtin_amdgcn_permlane32_swap(__float_as_uint(pmax), __float_as_uint(pmax), false, false); pmax = fmaxf(__uint_as_float(rr[0]), __uint_as_float(rr[1])); }
    if (__builtin_expect(__all(pmax - m_reg <= THR), 1)) { mn = m_reg; alpha = 1.f; }
    else { mn = fmaxf(m_reg, pmax); alpha = __builtin_amdgcn_exp2f(m_reg - mn); m_reg = mn; }
#pragma unroll
    for (int r = 0; r < 16; ++r) { p0[r] -= mn; p1[r] -= mn; }
#pragma unroll
    for (int r = 0; r < 16; ++r) p0[r] = __builtin_amdgcn_exp2f(p0[r]);
}
__device__ __forceinline__ void finishSM(f32x16& p0, f32x16& p1, float alpha, float& l_reg, bf16x8& pa0, bf16x8& pa1, bf16x8& pa2, bf16x8& pa3) {
#pragma unroll
    for (int r = 0; r < 16; ++r) p1[r] = __builtin_amdgcn_exp2f(p1[r]);
    float ps = 0;
#pragma unroll
    for (int r = 0; r < 16; ++r) ps += p0[r];
#pragma unroll
    for (int r = 0; r < 16; ++r) ps += p1[r];
    { auto rr = __builtin_amdgcn_permlane32_swap(__float_as_uint(ps), __float_as_uint(ps), false, false); ps = __uint_as_float(rr[0]) + __uint_as_float(rr[1]); }
    l_reg = l_reg * alpha + ps;
#define ATT_PK4(P, BASE, OUT) do { unsigned a0 = cvt_pk_bf16(P[BASE + 0], P[BASE + 1]), a1 = cvt_pk_bf16(P[BASE + 2], P[BASE + 3]);   \
    unsigned b0 = cvt_pk_bf16(P[BASE + 4], P[BASE + 5]), b1 = cvt_pk_bf16(P[BASE + 6], P[BASE + 7]);                              \
    auto r0 = __builtin_amdgcn_permlane32_swap(a0, b0, false, false); auto r1 = __builtin_amdgcn_permlane32_swap(a1, b1, false, false); \
    u32x4 w = {r0[0], r1[0], r0[1], r1[1]}; OUT = *reinterpret_cast<bf16x8*>(&w); } while (0)
    ATT_PK4(p0, 0, pa0); ATT_PK4(p0, 8, pa1); ATT_PK4(p1, 0, pa2); ATT_PK4(p1, 8, pa3);
#undef ATT_PK4
}
template <int DQK> __device__ __forceinline__ void qkt(f32x16& p0, f32x16& p1, const char* Ks, const bf16x8* qr, int r32, int hi) {
    p0 = f32x16{}; p1 = f32x16{};
#pragma unroll
    for (int d0 = 0; d0 < DQK / 16; ++d0) { const int cb = (d0 * 16 + hi * 8) * 2;
        const bf16x8 b0 = *reinterpret_cast<const bf16x8*>(Ks + kswz<DQK>(r32, cb));
        const bf16x8 b1 = *reinterpret_cast<const bf16x8*>(Ks + kswz<DQK>(32 + r32, cb));
        p0 = __builtin_amdgcn_mfma_f32_32x32x16_bf16(b0, qr[d0], p0, 0, 0, 0);
        p1 = __builtin_amdgcn_mfma_f32_32x32x16_bf16(b1, qr[d0], p1, 0, 0, 0); }
}
template <int DV, int D0> __device__ __forceinline__ void pv_one(f32x16& od, int vb, bf16x8 pa0, bf16x8 pa1, bf16x8 pa2, bf16x8 pa3) {
    const s16x4 l0 = tr_read<v_rd_off<DV>(D0, 0, 0)>(vb), h0 = tr_read<v_rd_off<DV>(D0, 0, 1)>(vb), l1 = tr_read<v_rd_off<DV>(D0, 1, 0)>(vb), h1 = tr_read<v_rd_off<DV>(D0, 1, 1)>(vb);
    const s16x4 l2 = tr_read<v_rd_off<DV>(D0, 2, 0)>(vb), h2 = tr_read<v_rd_off<DV>(D0, 2, 1)>(vb), l3 = tr_read<v_rd_off<DV>(D0, 3, 0)>(vb), h3 = tr_read<v_rd_off<DV>(D0, 3, 1)>(vb);
    asm volatile("s_waitcnt lgkmcnt(0)" ::: "memory"); ATT_SBAR();
#define ATT_PK(L, H) (bf16x8){L[0], L[1], L[2], L[3], H[0], H[1], H[2], H[3]}
    od = __builtin_amdgcn_mfma_f32_32x32x16_bf16(pa0, ATT_PK(l0, h0), od, 0, 0, 0);
    od = __builtin_amdgcn_mfma_f32_32x32x16_bf16(pa1, ATT_PK(l1, h1), od, 0, 0, 0);
    od = __builtin_amdgcn_mfma_f32_32x32x16_bf16(pa2, ATT_PK(l2, h2), od, 0, 0, 0);
    od = __builtin_amdgcn_mfma_f32_32x32x16_bf16(pa3, ATT_PK(l3, h3), od, 0, 0, 0);
#undef ATT_PK
}
template <int DV> __device__ __forceinline__ void pv_all(f32x16 (&o)[DV / 32], int vb, bf16x8 pa0, bf16x8 pa1, bf16x8 pa2, bf16x8 pa3) {
    pv_one<DV, 0>(o[0], vb, pa0, pa1, pa2, pa3); pv_one<DV, 1>(o[1], vb, pa0, pa1, pa2, pa3);
    if constexpr (DV == 128) { pv_one<DV, 2>(o[2], vb, pa0, pa1, pa2, pa3); pv_one<DV, 3>(o[3], vb, pa0, pa1, pa2, pa3); }
}
template <int DQK, int DV> struct Lay { static constexpr int SHM_V = 64 * DV * 2, SHM_K = 64 * DQK * 2, OFF_V = 0, OFF_K = 2 * SHM_V, OFF_WS = OFF_K + 2 * SHM_K, OFF_STASH = OFF_WS + NW * 64 * 4; };

template <int DQK, int DV, int LDQ, int LDK, int LDV>
__device__ __forceinline__ void attn_pass(const bf16_t* __restrict__ Qb, const bf16_t* __restrict__ Kh, const bf16_t* __restrict__ Vh, int nkeys, char* lds, f32x16 (&o)[DV / 32], float (&rli)[16], int wv) {
    using L = Lay<DQK, DV>;
    constexpr int NLK = DQK / 64, NLV = DV / 64;
    int tid_ = wv * 64 + lane_id(); asm volatile("" : "+v"(tid_));
    const int tid = tid_, wid = tid >> 6, lane = tid & 63, r32 = lane & 31, hi = lane >> 5;
    char* V_lds = lds + L::OFF_V; char* K_lds = lds + L::OFF_K;
    float* ws = (float*)(lds + L::OFF_WS) + wid * 64; float* li_l = ws; float* al_l = ws + 32;
    float m_reg = -1e30f, l_reg = 0.f; bf16x8 qr[DQK / 16];
#pragma unroll
    for (int d = 0; d < DV / 32; ++d) o[d] = f32x16{};
    const bf16_t* Qw = Qb + (size_t)(wid * QBLK + r32) * LDQ + hi * 8;
#pragma unroll
    for (int d0 = 0; d0 < DQK / 16; ++d0) qr[d0] = *reinterpret_cast<const bf16x8*>(Qw + d0 * 16);
    const int krow = DQK == 128 ? (tid >> 4) : (tid >> 3), kcol = DQK == 128 ? (tid & 15) * 8 : (tid & 7) * 8;
    const int vrow = DV == 128 ? (tid >> 4) : (tid >> 3), vcol = DV == 128 ? (tid & 15) * 8 : (tid & 7) * 8;
    const int vb0 = (int)(uintptr_t)V_lds + v_rd_base(lane);
    bf16x8 vsE[NLV], ksE[NLK], vsO[NLV], ksO[NLK];
#define ATT_SLOAD(VS, KS, k0) do { _Pragma("unroll") for (int i_ = 0; i_ < NLV; ++i_) VS[i_] = *reinterpret_cast<const bf16x8*>(&Vh[(size_t)((k0) + vrow + 32 * i_) * LDV + vcol]); \
    _Pragma("unroll") for (int i_ = 0; i_ < NLK; ++i_) KS[i_] = *reinterpret_cast<const bf16x8*>(&Kh[(size_t)((k0) + krow + 32 * i_) * LDK + kcol]); } while (0)
#define ATT_SWRITE(b, VS, KS) do { _Pragma("unroll") for (int i_ = 0; i_ < NLV; ++i_) *(bf16x8*)(V_lds + (b) * L::SHM_V + v_st<DV>(vrow + 32 * i_, vcol)) = VS[i_]; \
    _Pragma("unroll") for (int i_ = 0; i_ < NLK; ++i_) *(bf16x8*)(K_lds + (b) * L::SHM_K + kswz<DQK>(krow + 32 * i_, kcol * 2)) = KS[i_]; } while (0)
#define ATT_SWAIT() do { if constexpr (NLK + NLV == 4) asm volatile("s_waitcnt vmcnt(4)" ::: "memory"); else if constexpr (NLK + NLV == 3) asm volatile("s_waitcnt vmcnt(3)" ::: "memory"); else asm volatile("s_waitcnt vmcnt(2)" ::: "memory"); } while (0)
#define ATT_RESC(a) do { if (__any((a) < 1.f)) { if (hi == 0) al_l[r32] = (a); asm volatile("s_waitcnt lgkmcnt(0)" ::: "memory"); \
    _Pragma("unroll") for (int d = 0; d < DV / 32; ++d) _Pragma("unroll") for (int r = 0; r < 16; ++r) o[d][r] *= al_l[crow(r, hi)]; } } while (0)
    f32x16 pA0, pA1, pB0, pB1; float mnA, mnB, alA, alB; bf16x8 pa0, pa1, pa2, pa3; const int NT = nkeys / KVBLK;
    __syncthreads();
    ATT_SLOAD(vsE, ksE, 0); asm volatile("s_waitcnt vmcnt(0)" ::: "memory"); ATT_SWRITE(0, vsE, ksE); __syncthreads();
    qkt<DQK>(pA0, pA1, K_lds, qr, r32, hi); partialSM(pA0, pA1, m_reg, mnA, alA);
    ATT_SLOAD(vsO, ksO, KVBLK); if (2 < NT) ATT_SLOAD(vsE, ksE, 2 * KVBLK);
    ATT_SWAIT(); ATT_SWRITE(1, vsO, ksO); __syncthreads();
    for (int j = 1; j + 1 < NT; j += 2) {
        ATT_SBAR(); qkt<DQK>(pB0, pB1, K_lds + L::SHM_K, qr, r32, hi);
        finishSM(pA0, pA1, alA, l_reg, pa0, pa1, pa2, pa3); ATT_SBAR();
        ATT_SLOAD(vsO, ksO, (j + 2) * KVBLK); ATT_SBAR();
        pv_all<DV>(o, vb0, pa0, pa1, pa2, pa3); partialSM(pB0, pB1, m_reg, mnB, alB);
        __syncthreads(); ATT_SWAIT(); ATT_SWRITE(0, vsE, ksE);
        ATT_RESC(alB); __syncthreads();
        ATT_SBAR(); qkt<DQK>(pA0, pA1, K_lds, qr, r32, hi);
        finishSM(pB0, pB1, alB, l_reg, pa0, pa1, pa2, pa3); ATT_SBAR();
        if (j + 3 < NT) ATT_SLOAD(vsE, ksE, (j + 3) * KVBLK); ATT_SBAR();
        pv_all<DV>(o, vb0 + L::SHM_V, pa0, pa1, pa2, pa3); partialSM(pA0, pA1, m_reg, mnA, alA);
        __syncthreads(); ATT_SWAIT(); ATT_SWRITE(1, vsO, ksO);
        ATT_RESC(alA); __syncthreads();
    }
    ATT_SBAR(); qkt<DQK>(pB0, pB1, K_lds + L::SHM_K, qr, r32, hi);
    finishSM(pA0, pA1, alA, l_reg, pa0, pa1, pa2, pa3); ATT_SBAR();
    pv_all<DV>(o, vb0, pa0, pa1, pa2, pa3); partialSM(pB0, pB1, m_reg, mnB, alB);
    __syncthreads(); ATT_RESC(alB);
    finishSM(pB0, pB1, alB, l_reg, pa0, pa1, pa2, pa3); ATT_SBAR();
    pv_all<DV>(o, vb0 + L::SHM_V, pa0, pa1, pa2, pa3);
    if (hi == 0) li_l[r32] = l_reg; asm volatile("s_waitcnt lgkmcnt(0)" ::: "memory");
#pragma unroll
    for (int r = 0; r < 16; ++r) rli[r] = __builtin_amdgcn_rcpf(li_l[crow(r, hi)]);
#undef ATT_SLOAD
#undef ATT_SWRITE
#undef ATT_SWAIT
#undef ATT_RESC
}
template <int DV, int LDO> __device__ __forceinline__ void store_o(bf16_t* Ob, const f32x16 (&o)[DV / 32], const float (&rli)[16], int wv) {
    int tid_ = wv * 64 + lane_id(); asm volatile("" : "+v"(tid_));
    const int tid = tid_, wid = tid >> 6, lane = tid & 63, r32 = lane & 31, hi = lane >> 5;
    bf16_t* Ow = Ob + (size_t)(wid * QBLK) * LDO;
#pragma unroll
    for (int r = 0; r < 16; ++r) { const int orow = crow(r, hi);
#pragma unroll
        for (int d0 = 0; d0 < DV / 32; ++d0) Ow[(size_t)orow * LDO + d0 * 32 + r32] = f2bf(o[d0][r] * rli[r]); }
}
__device__ __forceinline__ void unit_a(const bf16_t* PROJ, bf16_t* OBR, int b, int h, int qb, float lam, float lam_init, const float* subg, char* lds, int wv) {
    using L = Lay<64, 128>;
    int tid_ = wv * 64 + lane_id(); asm volatile("" : "+v"(tid_));
    const int tid = tid_, wid = tid >> 6, lane = tid & 63, r32 = lane & 31, hi = lane >> 5;
    const bf16_t* kv = PROJ + (size_t)b * SEQ * D_IN; const size_t qrow = (size_t)b * SEQ + qb * 256;
    unsigned* stash = (unsigned*)(lds + L::OFF_STASH) + wid * 2048 + lane;
    f32x16 o[4]; float rli[16];
#pragma unroll 1
    for (int c = 0; c < 2; ++c) {
        attn_pass<64, 128, D_IN, D_IN, D_IN>(PROJ + qrow * D_IN + C_AQ + h * 128 + c * 64, kv + C_AK + h * 128 + c * 64, kv + C_AV + h * 128, SEQ, lds, o, rli, wv);
        if (c == 0) {
#pragma unroll
            for (int d0 = 0; d0 < 4; ++d0)
#pragma unroll
                for (int r = 0; r < 16; r += 2) stash[(d0 * 8 + (r >> 1)) * 64] = cvt_pk_bf16(o[d0][r] * rli[r], o[d0][r + 1] * rli[r + 1]);
        }
    }
    asm volatile("s_waitcnt lgkmcnt(0)" ::: "memory");
    float ss[16];
#pragma unroll
    for (int r = 0; r < 16; ++r) ss[r] = 0.f;
#pragma unroll
    for (int d0 = 0; d0 < 4; ++d0)
#pragma unroll
        for (int r = 0; r < 16; r += 2) { const unsigned w = stash[(d0 * 8 + (r >> 1)) * 64];
            const float c0 = __uint_as_float(w << 16) - lam * o[d0][r] * rli[r], c1 = __uint_as_float(w & 0xffff0000u) - lam * o[d0][r + 1] * rli[r + 1];
            o[d0][r] = c0; o[d0][r + 1] = c1; ss[r] += c0 * c0; ss[r + 1] += c1 * c1; }
#pragma unroll
    for (int r = 0; r < 16; ++r) { float s = ss[r]; s += xlane<1>(s); s += xlane<2>(s); s += xlane<4>(s); s += xlane<8>(s); s += xlane<16>(s);
        ss[r] = rsqrtf(s * (1.f / 128.f) + EPS) * (1.f - lam_init); }
    bf16_t* Ow = OBR + (qrow + wid * QBLK) * OBR_W + h * 128;
#pragma unroll
    for (int d0 = 0; d0 < 4; ++d0) { const float g = subg[d0 * 32 + r32];
#pragma unroll
        for (int r = 0; r < 16; ++r) Ow[(size_t)crow(r, hi) * OBR_W + d0 * 32 + r32] = f2bf(o[d0][r] * ss[r] * g); }
}
__device__ __forceinline__ void unit_b(const bf16_t* PROJ, bf16_t* OBR, int b, int qh, int qb, char* lds, int wv);
__device__ __forceinline__ void unit_c(const bf16_t* PROJ, const bf16_t* MEMKV, bf16_t* OBR, int b, int h, int qb, char* lds, int wv) {
    const bf16_t* kv = MEMKV + (size_t)b * MEM_LEN * 1024; const size_t qrow = (size_t)b * SEQ + qb * 256;
    f32x16 o[4]; float rli[16];
    attn_pass<128, 128, D_IN, 1024, 1024>(PROJ + qrow * D_IN + C_CQ + h * 128, kv + h * 128, kv + 512 + h * 128, MEM_LEN, lds, o, rli, wv);
    store_o<128, OBR_W>(OBR + qrow * OBR_W + 1024 + h * 128, o, rli, wv);
}
#undef ATT_SBAR
}

#include <hip/hip_bf16.h>
namespace attd {
using bf16=__hip_bfloat16;
using bf16x8=__attribute__((ext_vector_type(8)))short;
using s16x4=__attribute__((ext_vector_type(4)))short;
using f32x16=__attribute__((ext_vector_type(16)))float;
using u32x4=__attribute__((ext_vector_type(4)))unsigned;
constexpr int D=64;
constexpr int NW=8,QBLK=32,QB=QBLK*NW,KVBLK=64;
__device__ __forceinline__ int crow(int r,int hi){return (r&3)+8*(r>>2)+4*hi;}
#define SBAR() __builtin_amdgcn_sched_barrier(0)
__device__ __forceinline__ void cmask(f32x16&p0,f32x16&p1,int jb,int qrel,int hi){
  const float NEG=-INFINITY; int kb=64*jb+4*hi;
  #pragma unroll
  for(int r=0;r<16;++r){int kv=kb+(r&3)+8*(r>>2); if(kv>qrel)p0[r]=NEG; if(kv+32>qrel)p1[r]=NEG;}
}

constexpr int NSLOT=3, SLOTB=8192;
constexpr int LDS_K=0, LDS_V=NSLOT*SLOTB, LDS_WS=2*NSLOT*SLOTB, LDS_OST=LDS_WS+NW*64*4, LDS_BYTES=LDS_OST+NW*4096;
constexpr float C2=0.125f*1.4426950408889634f;
__device__ __forceinline__ void glds16(const void*gsrc,unsigned lds_dst){unsigned keep;
  asm volatile("s_mov_b32 %0, m0\n\ts_mov_b32 m0, %2\n\ts_nop 0\n\tglobal_load_lds_dwordx4 %1, off\n\ts_mov_b32 m0, %0":"=&s"(keep):"v"(gsrc),"s"(lds_dst):"memory");}
__device__ __forceinline__ float max3f(float a,float b,float c){float r;asm("v_max3_f32 %0, %1, %2, %3":"=v"(r):"v"(a),"v"(b),"v"(c));return r;}
__device__ __forceinline__ float max2f(float a,float b){float r;asm("v_max_f32_e32 %0, %1, %2":"=v"(r):"v"(a),"v"(b));return r;}
__device__ __forceinline__ float fadd_s(float a,float b){float r;asm("v_add_f32_e32 %0, %1, %2":"=v"(r):"v"(a),"v"(b));return r;}
__device__ __forceinline__ float fsub_s(float a,float b){float r;asm("v_sub_f32_e32 %0, %1, %2":"=v"(r):"v"(a),"v"(b));return r;}
typedef float f32x2_t __attribute__((ext_vector_type(2))); typedef __bf16 bf16x2_t __attribute__((ext_vector_type(2)));
__device__ __forceinline__ unsigned cvtpk_s(float lo,float hi){f32x2_t v={lo,hi};bf16x2_t b=__builtin_convertvector(v,bf16x2_t);return __builtin_bit_cast(unsigned,b);}
#define WAIT_BAR(N) asm volatile("s_waitcnt vmcnt(" #N ") lgkmcnt(0)\n\ts_barrier":::"memory")

__device__ __forceinline__ void qkt(f32x16&p0,f32x16&p1,const char*Kslot,const bf16x8*qr,const f32x16&negm,int r32,int hi){
  const char*kb=Kslot+hi*1024+r32*16;
  #pragma unroll
  for(int d0=0;d0<4;++d0){
    const bf16x8 b0=*reinterpret_cast<const bf16x8*>(kb+d0*2048);
    const bf16x8 b1=*reinterpret_cast<const bf16x8*>(kb+d0*2048+512);
    if(d0==0){p0=__builtin_amdgcn_mfma_f32_32x32x16_bf16(b0,qr[0],negm,0,0,0);p1=__builtin_amdgcn_mfma_f32_32x32x16_bf16(b1,qr[0],negm,0,0,0);}
    else{p0=__builtin_amdgcn_mfma_f32_32x32x16_bf16(b0,qr[d0],p0,0,0,0);p1=__builtin_amdgcn_mfma_f32_32x32x16_bf16(b1,qr[d0],p1,0,0,0);}}
}
typedef __attribute__((address_space(3))) const char* lds_cptr;
typedef short v4i16_t __attribute__((ext_vector_type(4)));
__device__ __forceinline__ void kload8(bf16x8*kf,lds_cptr kp){
  kf[0]=*(const __attribute__((address_space(3))) bf16x8*)(kp);      kf[1]=*(const __attribute__((address_space(3))) bf16x8*)(kp+512);
  kf[2]=*(const __attribute__((address_space(3))) bf16x8*)(kp+2048); kf[3]=*(const __attribute__((address_space(3))) bf16x8*)(kp+2560);
  kf[4]=*(const __attribute__((address_space(3))) bf16x8*)(kp+4096); kf[5]=*(const __attribute__((address_space(3))) bf16x8*)(kp+4608);
  kf[6]=*(const __attribute__((address_space(3))) bf16x8*)(kp+6144); kf[7]=*(const __attribute__((address_space(3))) bf16x8*)(kp+6656);
}
__device__ __forceinline__ void kload2(bf16x8*kf,lds_cptr kp,int j){ kf[2*j]=*(const __attribute__((address_space(3))) bf16x8*)(kp+j*2048); kf[2*j+1]=*(const __attribute__((address_space(3))) bf16x8*)(kp+j*2048+512); }
__device__ __forceinline__ s16x4 vtr(lds_cptr p){ return __builtin_bit_cast(s16x4,__builtin_amdgcn_ds_read_tr16_b64_v4i16((__attribute__((address_space(3))) v4i16_t*)p)); }
__device__ __forceinline__ float rowmax(const f32x16&p0,const f32x16&p1){
  float a=max3f(p0[0],p0[1],p1[0]),b=max3f(p0[2],p0[3],p1[1]);a=max3f(a,p1[2],p1[3]);
  #pragma unroll
  for(int r=4;r<16;r+=4){a=max3f(a,p0[r],p0[r+1]);b=max3f(b,p0[r+2],p0[r+3]);a=max3f(a,p1[r],p1[r+1]);b=max3f(b,p1[r+2],p1[r+3]);}
  const float m=max2f(a,b);
  auto rr=__builtin_amdgcn_permlane32_swap(__float_as_uint(m),__float_as_uint(m),false,false);
  return max2f(__uint_as_float(rr[0]),__uint_as_float(rr[1]));
}
__device__ __forceinline__ void pv(f32x16*o,int vb,bf16x8 pa0,bf16x8 pa1,bf16x8 pa2,bf16x8 pa3){
  #pragma unroll
  for(int d0=0;d0<2;++d0){s16x4 lo[4],hi[4];
    #pragma unroll
    for(int ks=0;ks<4;++ks){
      asm volatile("ds_read_b64_tr_b16 %0,%1 offset:%c2":"=&v"(lo[ks]):"v"(vb),"i"(d0*4096+ks*1024):"memory");
      asm volatile("ds_read_b64_tr_b16 %0,%1 offset:%c2":"=&v"(hi[ks]):"v"(vb),"i"(d0*4096+ks*1024+512):"memory");}
    asm volatile("s_waitcnt lgkmcnt(0)":::"memory");SBAR();
    #define PK(k) (bf16x8){lo[k][0],lo[k][1],lo[k][2],lo[k][3],hi[k][0],hi[k][1],hi[k][2],hi[k][3]}
    o[d0]=__builtin_amdgcn_mfma_f32_32x32x16_bf16(pa0,PK(0),o[d0],0,0,0);
    o[d0]=__builtin_amdgcn_mfma_f32_32x32x16_bf16(pa1,PK(1),o[d0],0,0,0);
    o[d0]=__builtin_amdgcn_mfma_f32_32x32x16_bf16(pa2,PK(2),o[d0],0,0,0);
    o[d0]=__builtin_amdgcn_mfma_f32_32x32x16_bf16(pa3,PK(3),o[d0],0,0,0);
    #undef PK
  }
}

#ifndef ATTN_STORE16
#define ATTN_STORE16(p,v) (*(u32x4*)(p)=(v))
#endif
template<int THRL,int QP,int KP,int OP> __device__ __forceinline__ void attn_unit(const bf16*Qb,const bf16*__restrict__ Kh,const bf16*__restrict__ Vh,bf16*Ob,int nkeys,char*shm,int wv){
  int tid_=wv*64+lane_id(); asm volatile("":"+v"(tid_)); const int tid=tid_,lane=tid&63,r32=lane&31,hi=lane>>5; const int wid=wv;
  constexpr int DM=KP;
  const bf16*Qw=Qb+(long)(wid*QBLK)*QP;
  const unsigned lds0=(unsigned)(uintptr_t)shm;
  float*wsf=(float*)(shm+LDS_WS)+wid*64;
  const bf16*ksrc=Kh+(long)lane*DM+wid*8;
  const bf16*vsrc=Vh+(long)(16*(wid&3)+(lane>>2))*DM+(wid>>2)*32+(lane&3)*8;
  const unsigned kdst=lds0+LDS_K+wid*1024, vdst=lds0+LDS_V+wid*1024;
  #define DMA_K(t,slot) glds16(ksrc+(long)(t)*KVBLK*DM,(unsigned)__builtin_amdgcn_readfirstlane(kdst+(slot)))
  #define DMA_V(t,slot) glds16(vsrc+(long)(t)*KVBLK*DM,(unsigned)__builtin_amdgcn_readfirstlane(vdst+(slot)))
  const int vb0=(int)(lds0+LDS_V)+((lane>>4)&1)*32+(lane&3)*8+(4*hi+((lane&15)>>2))*64;
  const char*Kbase=shm+LDS_K; bf16x8 kf[8];
  const lds_cptr shm3=(lds_cptr)shm; const lds_cptr kp0=shm3+LDS_K+hi*1024+r32*16; const lds_cptr vp0=shm3+LDS_V+((lane>>4)&1)*32+(lane&3)*8+(4*hi+((lane&15)>>2))*64;
  const int NT=nkeys/KVBLK;
  DMA_K(0,0);DMA_V(0,0);DMA_K(1,SLOTB);
  bf16x8 qr[4];
  #pragma unroll
  for(int d0=0;d0<4;++d0)qr[d0]=*reinterpret_cast<const bf16x8*>(&Qw[(long)r32*QP+d0*16+hi*8]);
  float mhat=0.f,l_reg=0.f;f32x16 o[2],negm;
  #pragma unroll
  for(int r=0;r<16;++r){asm volatile("v_mov_b32 %0, 0":"=v"(o[0][r]));asm volatile("v_mov_b32 %0, 0":"=v"(o[1][r]));asm volatile("v_mov_b32 %0, 0":"=v"(negm[r]));}
  #define CMASK(P0,P1,t) do{}while(0)
  bool resc=false;
  #define START(P0,P1) do{ const float rm=rowmax(P0,P1); resc=false; \
    { const float dl=rm; mhat=fadd_s(mhat,dl); \
      _Pragma("unroll") for(int r=0;r<16;++r){P0[r]=fsub_s(P0[r],dl);P1[r]=fsub_s(P1[r],dl);} \
      _Pragma("unroll") for(int r=0;r<16;++r)negm[r]=-mhat; asm volatile("":"+v"(negm)); } \
    _Pragma("unroll") for(int r=0;r<16;++r)P0[r]=__builtin_amdgcn_exp2f(P0[r]); }while(0)
  #define RESC() do{ if(resc){ asm volatile("s_waitcnt lgkmcnt(0)":::"memory"); \
      _Pragma("unroll") for(int d_=0;d_<2;++d_) _Pragma("unroll") for(int r=0;r<16;++r)o[d_][r]*=wsf[crow(r,hi)]; } }while(0)
  f32x16 pA0,pA1,pB0,pB1;
  int sl_prev=0,sl_cur=0,sl_next=SLOTB;
  #define ROT() do{sl_prev=sl_cur;sl_cur=sl_next;sl_next=(sl_next==(NSLOT-1)*SLOTB)?0:sl_next+SLOTB;}while(0)
  DMA_K(2,2*SLOTB);
  WAIT_BAR(3);
  qkt(pA0,pA1,Kbase,qr,negm,r32,hi);asm volatile("s_nop 15\n\ts_nop 7":"+v"(pA0),"+v"(pA1));CMASK(pA0,pA1,0);
  START(pA0,pA1);
  _Pragma("unroll") for(int r=0;r<16;++r)pA1[r]=__builtin_amdgcn_exp2f(pA1[r]);
  WAIT_BAR(0);
  DMA_K(3,0);DMA_V(1,SLOTB);
  ROT();
  kload8(kf,kp0+sl_cur);
  WAIT_BAR(2);
  s16x4 vlo[8],vhi[8]; u32x4 pw0,pw1,pw2,pw3;
  #define PKW(P,B) cvtpk_s(P[B],P[B+1])
  #define PAF(k) __builtin_bit_cast(bf16x8,pw##k)
  #define VFR(i) (bf16x8){vlo[i][0],vlo[i][1],vlo[i][2],vlo[i][3],vhi[i][0],vhi[i][1],vhi[i][2],vhi[i][3]}
  #define PIN(x) asm volatile("":"+v"(x))
  #define MX3(a,b,c) __builtin_fmaxf(__builtin_fmaxf((a),(b)),(c))
  #define GAPA(MF,A0,A1,A2,A3,W0,W1,PW) do{ MF; sacc+=A0; sacc+=A1; sacc+=A2; sacc+=A3; PIN(sacc); W0; W1; PIN(PW); SBAR(); }while(0)
  #define EX(v) __builtin_amdgcn_exp2f(v)
  #define GAPB(MF,X,B) do{ MF; X[B]=EX(X[B]); X[B+1]=EX(X[B+1]); X[B+2]=EX(X[B+2]); X[B+3]=EX(X[B+3]); PIN(X); SBAR(); }while(0)
  #define VRD(i) do{ vlo[i]=vtr(vp_+(((i)>>2)*4096+((i)&3)*1024)); vhi[i]=vtr(vp_+(((i)>>2)*4096+((i)&3)*1024+512)); }while(0)
  #define KRD(G,j) do{ if(G){ kload2(kf,kp0+sl_next,j); SBAR(); } }while(0)
  #define STEP(C0,C1,P0,P1,t,GK,GV,GL) do{ SBAR(); \
    const lds_cptr vp_=vp0+sl_prev; \
    VRD(0); SBAR(); float sacc=(P0[0]+P0[1]); \
    GAPA(C0=__builtin_amdgcn_mfma_f32_32x32x16_bf16(kf[0],qr[0],negm,0,0,0), P0[2],P0[3],P0[4],P0[5],     pw0[0]=PKW(P0,0), pw0[1]=PKW(P0,2), pw0); \
    VRD(4); SBAR(); GAPA(C1=__builtin_amdgcn_mfma_f32_32x32x16_bf16(kf[1],qr[0],negm,0,0,0), P0[6],P0[7],P0[8],P0[9],     pw0[2]=PKW(P0,4), pw0[3]=PKW(P0,6), pw0); \
    VRD(1); SBAR(); GAPA(C0=__builtin_amdgcn_mfma_f32_32x32x16_bf16(kf[2],qr[1],C0,0,0,0),   P0[10],P0[11],P0[12],P0[13], pw1[0]=PKW(P0,8), pw1[1]=PKW(P0,10), pw1); \
    VRD(5); SBAR(); GAPA(C1=__builtin_amdgcn_mfma_f32_32x32x16_bf16(kf[3],qr[1],C1,0,0,0),   P0[14],P0[15],P1[0],P1[1],   pw1[2]=PKW(P0,12),pw1[3]=PKW(P0,14), pw1); \
    VRD(2); SBAR(); GAPA(C0=__builtin_amdgcn_mfma_f32_32x32x16_bf16(kf[4],qr[2],C0,0,0,0),   P1[2],P1[3],P1[4],P1[5],     pw2[0]=PKW(P1,0), pw2[1]=PKW(P1,2), pw2); \
    VRD(6); SBAR(); GAPA(C1=__builtin_amdgcn_mfma_f32_32x32x16_bf16(kf[5],qr[2],C1,0,0,0),   P1[6],P1[7],P1[8],P1[9],     pw2[2]=PKW(P1,4), pw2[3]=PKW(P1,6), pw2); \
    VRD(3); SBAR(); GAPA(C0=__builtin_amdgcn_mfma_f32_32x32x16_bf16(kf[6],qr[3],C0,0,0,0),   P1[10],P1[11],P1[12],P1[13], pw3[0]=PKW(P1,8), pw3[1]=PKW(P1,10), pw3); \
    VRD(7); SBAR(); GAPA(C1=__builtin_amdgcn_mfma_f32_32x32x16_bf16(kf[7],qr[3],C1,0,0,0),   P1[14],P1[15],0.f,0.f,       pw3[2]=PKW(P1,12),pw3[3]=PKW(P1,14), pw3); \
    l_reg+=sacc; \
    if(GK){DMA_K((t)+3,sl_cur);} if(GV){DMA_V((t)+1,sl_next);} \
    CMASK(C0,C1,t); \
    { float a=MX3(C0[0],C0[1],C1[0]),b=MX3(C0[2],C0[3],C1[1]); a=MX3(a,C1[2],C1[3]); \
      _Pragma("unroll") for(int r=4;r<16;r+=4){a=MX3(a,C0[r],C0[r+1]);b=MX3(b,C0[r+2],C0[r+3]);a=MX3(a,C1[r],C1[r+1]);b=MX3(b,C1[r+2],C1[r+3]);} \
      float rm=__builtin_fmaxf(a,b); { auto rr=__builtin_amdgcn_permlane32_swap(__float_as_uint(rm),__float_as_uint(rm),false,false); rm=__builtin_fmaxf(__uint_as_float(rr[0]),__uint_as_float(rr[1])); } \
      resc=false; \
      if(__builtin_expect(__any(rm>(float)THRL),0)){ const float dl=__builtin_fmaxf(rm,0.f); mhat+=dl; \
        _Pragma("unroll") for(int r=0;r<16;++r){C0[r]-=dl;C1[r]-=dl;} \
        _Pragma("unroll") for(int r=0;r<16;++r)negm[r]=-mhat; asm volatile("":"+v"(negm)); \
        const float f=__builtin_amdgcn_exp2f(-dl); l_reg*=f; if(hi==0)wsf[r32]=f; resc=true; } } \
    SBAR(); \
    GAPB(o[0]=__builtin_amdgcn_mfma_f32_32x32x16_bf16(PAF(0),VFR(0),o[0],0,0,0), C0,0); \
    GAPB(o[1]=__builtin_amdgcn_mfma_f32_32x32x16_bf16(PAF(0),VFR(4),o[1],0,0,0), C0,4); \
    KRD(GL,0); GAPB(o[0]=__builtin_amdgcn_mfma_f32_32x32x16_bf16(PAF(1),VFR(1),o[0],0,0,0), C0,8); \
    KRD(GL,1); GAPB(o[1]=__builtin_amdgcn_mfma_f32_32x32x16_bf16(PAF(1),VFR(5),o[1],0,0,0), C0,12); \
    KRD(GL,2); GAPB(o[0]=__builtin_amdgcn_mfma_f32_32x32x16_bf16(PAF(2),VFR(2),o[0],0,0,0), C1,0); \
    KRD(GL,3); GAPB(o[1]=__builtin_amdgcn_mfma_f32_32x32x16_bf16(PAF(2),VFR(6),o[1],0,0,0), C1,4); \
    GAPB(o[0]=__builtin_amdgcn_mfma_f32_32x32x16_bf16(PAF(3),VFR(3),o[0],0,0,0), C1,8); \
    GAPB(o[1]=__builtin_amdgcn_mfma_f32_32x32x16_bf16(PAF(3),VFR(7),o[1],0,0,0), C1,12); \
    }while(0)
  int t=1;
  #undef CMASK
  #define CMASK(P0,P1,t) do{}while(0)
  for(;t+5<NT;t+=2){
    STEP(pB0,pB1,pA0,pA1,t,true,true,true);     WAIT_BAR(2); RESC(); ROT();
    STEP(pA0,pA1,pB0,pB1,t+1,true,true,true);   WAIT_BAR(2); RESC(); ROT();
  }
  #undef CMASK
  #define CMASK(P0,P1,t) do{}while(0)
  #define ENDW(tt) do{ if((tt)+3<NT){WAIT_BAR(2);} else if((tt)+2<NT){WAIT_BAR(1);} else {WAIT_BAR(0);} }while(0)
  for(;t+1<NT;t+=2){
    STEP(pB0,pB1,pA0,pA1,t,(t+3<NT),(t+1<NT),(t+1<NT));       ENDW(t);   RESC(); ROT();
    STEP(pA0,pA1,pB0,pB1,t+1,(t+4<NT),(t+2<NT),(t+2<NT));     ENDW(t+1); RESC(); ROT();
  }
  STEP(pB0,pB1,pA0,pA1,NT-1,false,false,false); RESC();
  { float sacc=pB0[0]+pB0[1]; _Pragma("unroll") for(int r=2;r<16;++r)sacc+=pB0[r]; _Pragma("unroll") for(int r=0;r<16;++r)sacc+=pB1[r]; l_reg+=sacc;
    pw0=(u32x4){PKW(pB0,0),PKW(pB0,2),PKW(pB0,4),PKW(pB0,6)};pw1=(u32x4){PKW(pB0,8),PKW(pB0,10),PKW(pB0,12),PKW(pB0,14)};pw2=(u32x4){PKW(pB1,0),PKW(pB1,2),PKW(pB1,4),PKW(pB1,6)};pw3=(u32x4){PKW(pB1,8),PKW(pB1,10),PKW(pB1,12),PKW(pB1,14)};
    SBAR(); pv(o,vb0+sl_cur,PAF(0),PAF(1),PAF(2),PAF(3)); }
  #undef PKW
  #undef PAF
  #undef VFR
  #undef PIN
  #undef MX3
  #undef GAPA
  #undef GAPB
  #undef EX
  #undef VRD
  #undef KRD
  #undef STEP
  #undef ENDW
  {auto rr=__builtin_amdgcn_permlane32_swap(__float_as_uint(l_reg),__float_as_uint(l_reg),false,false);l_reg=__uint_as_float(rr[0])+__uint_as_float(rr[1]);}
  if(hi==0)wsf[32+r32]=l_reg;asm volatile("s_waitcnt lgkmcnt(0)":::"memory");
  float rli[16];
  #pragma unroll
  for(int r=0;r<16;++r)rli[r]=__builtin_amdgcn_rcpf(wsf[32+crow(r,hi)]);
  bf16*Ow=Ob+(long)(wid*QBLK)*OP;
  { bf16*stg=(bf16*)(shm+LDS_OST)+wid*2048;
    #pragma unroll
    for(int r=0;r<16;++r){const int orow=crow(r,hi);
      #pragma unroll
      for(int d0=0;d0<2;++d0)stg[orow*64+d0*32+r32]=__float2bfloat16(o[d0][r]*rli[r]);}
    asm volatile("s_waitcnt lgkmcnt(0)":::"memory");
    #pragma unroll
    for(int i=0;i<4;++i){const int row=i*8+(lane>>3),ch=lane&7; const u32x4 v=*(const u32x4*)(stg+row*64+ch*8); ATTN_STORE16(Ow+(long)row*OP+ch*8,v);} }
  asm volatile("s_waitcnt lgkmcnt(0)\n\ts_barrier":::"memory");
  #undef DMA_K
  #undef DMA_V
  #undef CMASK
  #undef START
  #undef RESC
  #undef ROT
}
constexpr int ATTN_LDS_BYTES=LDS_BYTES;
#undef SBAR
#undef WAIT_BAR
}
namespace att {
__device__ __forceinline__ void unit_b(const bf16_t* PROJ, bf16_t* OBR, int b, int qh, int qb, char* lds, int wv) {
    const bf16_t* kv = PROJ + (size_t)b * SEQ * D_IN; const size_t qrow = (size_t)b * SEQ + qb * 256;
    __syncthreads();
    attd::attn_unit<8, D_IN, D_IN, OBR_W>((const attd::bf16*)(PROJ + qrow * D_IN + C_BQ + qh * 64), (const attd::bf16*)(kv + C_BK + (qh >> 2) * 64), (const attd::bf16*)(kv + C_BV + (qh >> 2) * 64),
                                          (attd::bf16*)(OBR + qrow * OBR_W + 512 + qh * 64), SEQ, lds, wv);
}
}
template <int NR, bool NORM>
__device__ __forceinline__ void rows_in(const float* __restrict__ xbase, const float* __restrict__ g, bf16_t* __restrict__ obase, float* __restrict__ rstd_out, int row0, int lane, unsigned char* __restrict__ xq = nullptr) {
    f32x4 v[NR][4];
#pragma unroll
    for (int r = 0; r < NR; ++r)
#pragma unroll
        for (int j = 0; j < 4; ++j) v[r][j] = ((const f32x4*)(xbase + (size_t)(row0 + r) * DM))[lane + 64 * j];
    f32x4 gg[4];
#pragma unroll
    for (int j = 0; j < 4; ++j) gg[j] = NORM ? ((const f32x4*)g)[lane + 64 * j] : (f32x4){1.f, 1.f, 1.f, 1.f};
#pragma unroll
    for (int r = 0; r < NR; ++r) { float s = 0.f;
#pragma unroll
        for (int j = 0; j < 4; ++j) s += v[r][j].x * v[r][j].x + v[r][j].y * v[r][j].y + v[r][j].z * v[r][j].z + v[r][j].w * v[r][j].w;
        const float rs0 = rsqrtf(wave_sum(s) * (1.f / DM) + EPS), rs = NORM ? rs0 : 1.f;
        if (!NORM && lane == 0) rstd_out[row0 + r] = rs0;
#pragma unroll
        for (int j = 0; j < 4; ++j) { u32x2 o; o.x = cvt_pk_bf16(v[r][j].x * rs * gg[j].x, v[r][j].y * rs * gg[j].y); o.y = cvt_pk_bf16(v[r][j].z * rs * gg[j].z, v[r][j].w * rs * gg[j].w);
            ((u32x2*)(obase + (size_t)(row0 + r) * XP))[lane + 64 * j] = o;
            if (!NORM) ((unsigned*)(xq + (size_t)(row0 + r) * DM))[lane + 64 * j] = pack4_fp8(v[r][j]); } }
}
__device__ __forceinline__ void route_block(const bf16_t* __restrict__ X, const bf16_t* __restrict__ rt_tab, const float* __restrict__ brg, const float* __restrict__ bre, int* __restrict__ experts, float* __restrict__ weights,
                                            int* __restrict__ rank, unsigned* __restrict__ cnt, float* __restrict__ rstd, int* __restrict__ list, const float* __restrict__ g2, unsigned char* __restrict__ XQ, int rb, const bf16x8 (&Bh)[3][4], const bf16x8 (&Bl)[3][4], LAS float* slab, int tid, int wave) {
    const int lane = tid & 63, r = lane & 15, kq = lane >> 4;
    LAS float* ssq = slab + 8 * 64 * 48; LAS float* rs_l = ssq + 8 * 64;
#pragma unroll 1
    for (int rtp = 0; rtp < 2; ++rtp) {
        bf16x8 xa[2][4];
#pragma unroll
        for (int q = 0; q < 2; ++q) { const bf16_t* xp = X + (size_t)(rb * 64 + (rtp * 2 + q) * 16 + r) * XP + 128 * wave + 8 * kq;
#pragma unroll
            for (int sI = 0; sI < 4; ++sI) xa[q][sI] = *(const bf16x8*)(xp + 32 * sI); }
        f32x4 gq[4][2];
#pragma unroll
        for (int sI = 0; sI < 4; ++sI) { gq[sI][0] = *(const f32x4*)(g2 + 128 * wave + 32 * sI + 8 * kq); gq[sI][1] = *(const f32x4*)(g2 + 128 * wave + 32 * sI + 8 * kq + 4); }
#pragma unroll
        for (int q = 0; q < 2; ++q) { const int rt = rtp * 2 + q;
            f32x4 acc[3]; float ss = 0.f;
#pragma unroll
            for (int t = 0; t < 3; ++t) acc[t] = (f32x4){0.f, 0.f, 0.f, 0.f};
#pragma unroll
            for (int sI = 0; sI < 4; ++sI) {
                const bf16x8 Ah = xa[q][sI]; f32x4 a0, a1; pg8::unpack8(__builtin_bit_cast(u32x4, Ah), a0, a1);
                ss += (a0[0] * a0[0] + a0[1] * a0[1]) + (a0[2] * a0[2] + a0[3] * a0[3]) + (a1[0] * a1[0] + a1[1] * a1[1]) + (a1[2] * a1[2] + a1[3] * a1[3]);
                *(u32x2*)(XQ + (size_t)(rb * 64 + rt * 16 + r) * DM + 128 * wave + 32 * sI + 8 * kq) = pack8_fp8(a0 * gq[sI][0], a1 * gq[sI][1]);
#pragma unroll
                for (int t = 0; t < 3; ++t) {
                    acc[t] = __builtin_amdgcn_mfma_f32_16x16x32_bf16(Ah, Bh[t][sI], acc[t], 0, 0, 0);
                    acc[t] = __builtin_amdgcn_mfma_f32_16x16x32_bf16(Ah, Bl[t][sI], acc[t], 0, 0, 0);
                }
            }
            ss += xlane<16>(ss); ss = half_sum(ss);
            if (kq == 0) ssq[wave * 64 + rt * 16 + r] = ss;
#pragma unroll
            for (int t = 0; t < 3; ++t)
#pragma unroll
                for (int e = 0; e < 4; ++e) slab[(wave * 64 + rt * 16 + 4 * kq + e) * 48 + 16 * t + r] = acc[t][e];
        }
    }
    __syncthreads();
    if (tid < 64) {
        const int row = rb * 64 + tid;
        float lg[36]; float ss = 0.f;
#pragma unroll
        for (int c = 0; c < 36; ++c) lg[c] = 0.f;
#pragma unroll 1
        for (int w = 0; w < 8; ++w) { ss += ssq[w * 64 + tid];
#pragma unroll
            for (int c = 0; c < 36; ++c) lg[c] += slab[(w * 64 + tid) * 48 + c]; }
        const float rs = rsqrtf(ss * (1.f / DM) + EPS);
        rstd[row] = rs;
        int gi = 0; float gm = lg[0] * rs + brg[0];
#pragma unroll
        for (int i = 1; i < 4; ++i) { const float l = lg[i] * rs + brg[i]; if (l > gm) { gm = l; gi = i; } }
        float gs = 0.f;
#pragma unroll
        for (int i = 0; i < 4; ++i) gs += __expf(lg[i] * rs + brg[i] - gm);
        const float gp = 1.f / gs;
        float el[8];
#pragma unroll
        for (int i = 0; i < 8; ++i) el[i] = 0.f;
#pragma unroll
        for (int gq = 0; gq < 4; ++gq) if (gq == gi) {
#pragma unroll
            for (int i = 0; i < 8; ++i) el[i] = lg[4 + gq * 8 + i] * rs + bre[gq * 8 + i]; }
        int i0 = 0; float l0 = el[0];
#pragma unroll
        for (int i = 1; i < 8; ++i) if (el[i] > l0) { l0 = el[i]; i0 = i; }
        int i1 = -1; float l1 = -INFINITY;
#pragma unroll
        for (int i = 0; i < 8; ++i) if (i != i0 && el[i] > l1) { l1 = el[i]; i1 = i; }
        const float p1 = __expf(l1 - l0), inv = 1.f / (1.f + p1);
        const int e0 = gi * 8 + i0, e1 = gi * 8 + i1;
        experts[row * 2] = e0; experts[row * 2 + 1] = e1;
        weights[row * 2] = gp * inv; weights[row * 2 + 1] = gp * p1 * inv;
        LAS unsigned* lc = (LAS unsigned*)(rs_l + 64); LAS unsigned* gb = lc + 32;
        if (tid < 32) lc[tid] = 0u;
        asm volatile("s_waitcnt lgkmcnt(0)" ::: "memory");
        unsigned q0, q1; const unsigned one = 1u, a0_ = (unsigned)(uintptr_t)(lc + e0), a1_ = (unsigned)(uintptr_t)(lc + e1);
        asm volatile("ds_add_rtn_u32 %0, %1, %2\n\ts_waitcnt lgkmcnt(0)" : "=v"(q0) : "v"(a0_), "v"(one) : "memory");
        asm volatile("ds_add_rtn_u32 %0, %1, %2\n\ts_waitcnt lgkmcnt(0)" : "=v"(q1) : "v"(a1_), "v"(one) : "memory");
        if (tid < 32) { const unsigned n = lc[tid]; gb[tid] = n ? atomicAdd(cnt + 64 * tid, n) : 0u; }
        const int r0 = (int)(gb[e0] + q0), r1 = (int)(gb[e1] + q1);
        rank[row * 2] = r0; rank[row * 2 + 1] = r1;
        list[e0 * LCAP + r0] = row * 2; list[e1 * LCAP + r1] = row * 2 + 1;
        rs_l[tid] = rs;
    }
    __syncthreads();
}
__device__ __forceinline__ void moe_tables(const unsigned* cnt, volatile LAS int* mt, int tid) {
    if (tid < 64) {
        if (tid < 32) mt[32 + tid] = (int)__hip_atomic_load(cnt + 64 * tid, __ATOMIC_RELAXED, __HIP_MEMORY_SCOPE_AGENT);
        asm volatile("s_waitcnt vmcnt(0) lgkmcnt(0)" ::: "memory");
        if (tid == 0) { int off = 0, nt = 0;
#pragma unroll 1
            for (int e = 0; e < NEXP; ++e) { const int c = mt[32 + e], t = (c + MOE_TILE - 1) / MOE_TILE;
                mt[e] = off; mt[64 + e] = nt;
#pragma unroll 1
                for (int i = 0; i < t; ++i) mt[96 + nt + i] = e;
                nt += t; off += t * MOE_TILE; }
            mt[256] = nt; }
    }
    __syncthreads();
}
__device__ __forceinline__ void moe_rowtabs(volatile LAS int* mt, const int* __restrict__ list, const float* __restrict__ weights, const float* __restrict__ rstd, LAS unsigned* rowtab, LAS float* wtab, int bx, int G, int tid, int up) {
    const int ntiles = mt[256], rem = (ntiles * 4) % G;
#pragma unroll 1
    for (int i = 0; i < 4; ++i) { const long L = up ? (long)i * G + bx : (long)pg8::moe_down_unit(bx, i, rem, G); if (L >= (long)ntiles * 4) break;
        if (tid < 256) { const int tile = (int)(L >> 2), e = mt[96 + tile], q = (tile - mt[64 + e]) * 256 + tid; const bool valid = q < mt[32 + e];
            const int a = valid ? list[e * LCAP + q] : 0;
            if (up) { rowtab[i * 256 + tid] = (unsigned)(a >> 1) * (unsigned)DM; wtab[i * 256 + tid] = valid ? rstd[a >> 1] : 0.f; }
            else wtab[i * 256 + tid] = valid ? weights[a] : -1.f; } }
    __syncthreads();
}
template <int NR>
__device__ __forceinline__ void rows_combine_norm(bf16_t* __restrict__ XB, const unsigned char* __restrict__ YB, const float* __restrict__ g, float* __restrict__ RS, float* __restrict__ OUT, const int (&row)[NR], int lane, bool poison, const int (&d0)[NR], const int (&d1)[NR], unsigned char* __restrict__ XQ) {
    u32x2 xq[NR][4]; unsigned ya[NR][4], yb[NR][4];
#pragma unroll
    for (int r = 0; r < NR; ++r)
#pragma unroll
        for (int j = 0; j < 4; ++j) { xq[r][j] = ((const u32x2*)(XB + (size_t)row[r] * XP))[lane + 64 * j];
            ya[r][j] = ((const unsigned*)(YB + (size_t)d0[r] * DM))[lane + 64 * j]; yb[r][j] = ((const unsigned*)(YB + (size_t)d1[r] * DM))[lane + 64 * j]; }
    f32x4 gg[4];
#pragma unroll
    for (int j = 0; j < 4; ++j) gg[j] = ((const f32x4*)g)[lane + 64 * j];
    f32x4 v[NR][4]; float s[NR];
#pragma unroll
    for (int r = 0; r < NR; ++r) { s[r] = 0.f;
#pragma unroll
        for (int j = 0; j < 4; ++j) { const u32x2 x = xq[r][j]; constexpr float ys = 1.f / 64.f;
            const f32x2 a0 = __builtin_amdgcn_cvt_pk_f32_fp8((int)ya[r][j], false), a1 = __builtin_amdgcn_cvt_pk_f32_fp8((int)ya[r][j], true), b0 = __builtin_amdgcn_cvt_pk_f32_fp8((int)yb[r][j], false), b1 = __builtin_amdgcn_cvt_pk_f32_fp8((int)yb[r][j], true);
            v[r][j].x = __uint_as_float(x.x << 16) + (a0[0] + b0[0]) * ys; v[r][j].y = __uint_as_float(x.x & 0xffff0000u) + (a0[1] + b0[1]) * ys;
            v[r][j].z = __uint_as_float(x.y << 16) + (a1[0] + b1[0]) * ys; v[r][j].w = __uint_as_float(x.y & 0xffff0000u) + (a1[1] + b1[1]) * ys;
            s[r] += v[r][j].x * v[r][j].x + v[r][j].y * v[r][j].y + v[r][j].z * v[r][j].z + v[r][j].w * v[r][j].w; } }
#pragma unroll
    for (int r = 0; r < NR; ++r) {
        float rs = rsqrtf(wave_sum(s[r]) * (1.f / DM) + EPS);
        if (poison) rs = __builtin_nanf("");
        if (RS && lane == 0) RS[row[r]] = rs;
#pragma unroll
        for (int j = 0; j < 4; ++j) {
            if (RS) { u32x2 xo; xo.x = cvt_pk_bf16(v[r][j].x, v[r][j].y); xo.y = cvt_pk_bf16(v[r][j].z, v[r][j].w); ((u32x2*)(XB + (size_t)row[r] * XP))[lane + 64 * j] = xo; ((unsigned*)(XQ + (size_t)row[r] * DM))[lane + 64 * j] = pack4_fp8(v[r][j]); }
            else { f32x4 o; o.x = v[r][j].x * rs * gg[j].x; o.y = v[r][j].y * rs * gg[j].y; o.z = v[r][j].z * rs * gg[j].z; o.w = v[r][j].w * rs * gg[j].w; ((f32x4*)(OUT + (size_t)row[r] * DM))[lane + 64 * j] = o; }
        }
    }
}
constexpr float W8_SCALE = 64.f;
struct TrItem { const float* src; bf16_t* dst; int ldw, K; };
template <int OFF> __device__ __forceinline__ unsigned long long karg64() { unsigned long long v; asm volatile("s_load_dwordx2 %0, %1, %2\n\ts_waitcnt lgkmcnt(0)" : "=s"(v) : "s"(__builtin_amdgcn_kernarg_segment_ptr()), "n"(OFF)); return v; }
__device__ __forceinline__ unsigned long long karg64d(int off) { unsigned long long v; asm volatile("s_load_dwordx2 %0, %1, %2\n\ts_waitcnt lgkmcnt(0)" : "=s"(v) : "s"(__builtin_amdgcn_kernarg_segment_ptr()), "s"(off)); return v; }
#define TR_IN(k) ((const float*)(const GAS float*)karg64d(8 * (k)))
__device__ __forceinline__ void tr_decode(int it, int lane, bf16_t* WB, const float*& sp, int& ldw, bf16_t*& dp, int& K, int& gofs) {
    const float* src; int segA, segB, kb, tb, dk0 = 0, gate = 0, gu = 0, f8 = 0; bf16_t* dst;
    if (it < 28800) {
        const int l = it / 14400; int r = it % 14400; bf16_t* WBl = WB + (size_t)l * WB_LAYER;
        if (r < 1472) { gu = 1; kb = r / 92; tb = r % 92; const int pn = tb >> 2, bj = (tb >> 1) & 1, w0 = 2 * (tb & 1); src = TR_IN(5) + (size_t)l * DM * D_IN; ldw = D_IN; K = DM; segA = 256 * pn + 64 * w0 + 32 * bj; segB = segA + 64; dst = WBl + WB_IN;
            if (pn >= C_G / 256) { gate = 1; f8 = 1; dst += (size_t)C_G * 512; segA = 256 * pn + 64 * w0 + 8 * bj; segB = segA + 64; } }
        else if (r < 1856) { r -= 1472; const int i = r >> 7; r &= 127; kb = r >> 4; tb = r & 15; src = TR_IN(13 + i) + (size_t)l * 512 * DM; ldw = DM; K = 1536; dk0 = 512 * i; segA = 64 * tb; segB = segA + 32; dst = WBl + WB_UP; }
        else if (r < 2112) { r -= 1856; kb = r >> 4; tb = r & 15; src = TR_IN(16) + (size_t)l * DM * DM; ldw = DM; K = DM; segA = 64 * tb; segB = segA + 32; dst = WBl + WB_OUT; }
        else if (r < 10304) { r -= 2112; const int e = r >> 8; r &= 255; kb = r >> 4; tb = r & 15; const int pn = tb >> 2, sg = (tb >> 1) & 1, jb = tb & 1;
            src = TR_IN(sg ? 23 : 22) + (size_t)(l * NEXP + e) * DM * DEXP; ldw = DEXP; K = DM; f8 = 1; segA = 128 * pn + 64 * jb; segB = segA + 32; dst = WBl + WB_GU + (size_t)e * 512 * 1024; }
        else { r -= 10304; const int e = r >> 7; r &= 127; kb = r >> 4; tb = r & 15; src = TR_IN(24) + (size_t)(l * NEXP + e) * DEXP * DM; ldw = DM; K = DEXP; f8 = 1; gate = 1; { const int pn = tb >> 2, bj = (tb >> 1) & 1, w0 = 2 * (tb & 1); segA = 256 * pn + 64 * w0 + 8 * bj; segB = segA + 64; } dst = WBl + WB_DN + (size_t)e * 512 * 512; }
    } else { const int r = it - 28800; kb = r >> 4; tb = r & 15; const int pn = tb >> 2, bj = (tb >> 1) & 1, w0 = 2 * (tb & 1); src = TR_IN(3); ldw = 1024; K = DM; segA = 256 * pn + 64 * w0 + 32 * bj; segB = segA + 64; dst = WB + WB_MEMKV; }
    const int q = lane & 15;
    const int q7 = q & 7, seg = q < 8 ? segA : segB;
    sp = src + (size_t)(kb * 64 + (lane >> 4)) * ldw + seg + (gate ? 16 * (q7 >> 1) + 4 * (q7 & 1) : 4 * q7);
    dp = dst + (((size_t)(64 * tb + (lane >> 3)) * K + dk0 + kb * 64 + 8 * (lane & 7)) >> f8);
    K |= f8 << 18;
    gofs = gu ? kb * 64 + (lane >> 4) : -1;
}
__device__ __forceinline__ void tr_load(f32x4 (&v)[16], const float* sp, int ldw) {
#pragma unroll
    for (int i = 0; i < 16; ++i) v[i] = *(const f32x4*)(sp + (size_t)(4 * i) * ldw);
}
__device__ __forceinline__ void tr_store(const f32x4 (&v)[16], bf16_t* dp, int K, LAS float* scr, int lane, int gofs, const LAS float* gt) {
    const int q = lane & 15, kq = lane >> 4; const int f8 = K >> 18; K &= 0x3FFFF;
#pragma unroll
    for (int i = 0; i < 16; ++i) *(LAS f32x4*)(scr + (4 * i + kq) * 64 + ((q ^ (2 * (i >> 1))) << 2)) = v[i];
    const int c = lane & 7, n8 = lane >> 3;
    f32x4 g0 = {1.f, 1.f, 1.f, 1.f}, g1 = g0;
    if (gofs >= 0) { const LAS float* gp = gt + (gofs - kq) + 8 * c; g0 = *(const LAS f32x4*)gp; g1 = *(const LAS f32x4*)(gp + 4); }
    if (f8) { g0 = g0 * W8_SCALE; g1 = g1 * W8_SCALE; }
    asm volatile("s_waitcnt lgkmcnt(0)" ::: "memory");
    const LAS float* sB = scr + (8 * c) * 64;
    if (f8) {
#pragma unroll
        for (int j = 0; j < 8; ++j) { const LAS float* sI = sB + ((n8 + 8 * j) ^ (8 * c));
            const f32x4 v0 = {sI[0 * 64] * g0[0], sI[1 * 64] * g0[1], sI[2 * 64] * g0[2], sI[3 * 64] * g0[3]}, v1 = {sI[4 * 64] * g1[0], sI[5 * 64] * g1[1], sI[6 * 64] * g1[2], sI[7 * 64] * g1[3]};
            *(u32x2*)((unsigned char*)dp + (size_t)(8 * j) * K) = pack8_fp8(v0, v1); }
    } else
#pragma unroll
    for (int j = 0; j < 8; ++j) { const LAS float* sI = sB + ((n8 + 8 * j) ^ (8 * c));
        u32x4 o; o.x = cvt_pk_bf16(sI[0 * 64] * g0[0], sI[1 * 64] * g0[1]); o.y = cvt_pk_bf16(sI[2 * 64] * g0[2], sI[3 * 64] * g0[3]); o.z = cvt_pk_bf16(sI[4 * 64] * g1[0], sI[5 * 64] * g1[1]); o.w = cvt_pk_bf16(sI[6 * 64] * g1[2], sI[7 * 64] * g1[3]);
        *(u32x4*)(dp + (size_t)(8 * j) * K) = o; }
    asm volatile("s_waitcnt lgkmcnt(0)" ::: "memory");
}

__device__ __forceinline__ int tr_item(int mode, int q) {
    return mode == 1 ? (q < 1472 ? q : q - 1472 + 28800) : mode == 4 ? q + 14400 : mode == 2 ? q + 1472 : q + 16512; }
__device__ __forceinline__ void tr_run(int mode, int q0, int qend, int qstride, bf16_t* WB, LAS float* scr, int lane, const float* gains, LAS float* gt) {
    __syncthreads();
    if (gains) {
#pragma unroll
        for (int j = 0; j < 16; ++j) gt[lane + 64 * j] = gains[lane + 64 * j];
        asm volatile("s_waitcnt lgkmcnt(0)" ::: "memory"); }
    f32x4 ra[16], rb[16], rc[16]; const float* sp; int ldw; unsigned da, ma, db, mb, dc, mc;
    if (q0 >= qend) return;
    const int qlast = q0 + ((qend - 1 - q0) / qstride) * qstride;
#define TR_LD(R, DD, MM, QQ) do { const int qn_ = (QQ) <= qlast ? (QQ) : qlast; bf16_t* dp_; int K_, g_; tr_decode(tr_item(mode, qn_), lane, WB, sp, ldw, dp_, K_, g_); \
        DD = (unsigned)(dp_ - WB); MM = ((unsigned)K_ << 12) | (unsigned)(g_ + 1); tr_load(R, sp, ldw); } while (0)
#define TR_ST(R, DD, MM) tr_store(R, WB + DD, (int)(MM >> 12), scr, lane, (int)(MM & 4095u) - 1, gt)
    int q = q0;
    TR_LD(ra, da, ma, q); TR_LD(rb, db, mb, q + qstride);
    for (;;) {
        TR_LD(rc, dc, mc, q + 2 * qstride); TR_ST(ra, da, ma); q += qstride; if (q > qlast) break;
        TR_LD(ra, da, ma, q + 2 * qstride); TR_ST(rb, db, mb); q += qstride; if (q > qlast) break;
        TR_LD(rb, db, mb, q + 2 * qstride); TR_ST(rc, dc, mc); q += qstride; if (q > qlast) break;
    }
#undef TR_ST
#undef TR_LD
}
#define XB_TMO      128
#define XB_XCNT(j)  (256  + 64 * (j))
#define XB_XSUB(j)  (1280 + 64 * (j))
#define XB_XGEN(j)  (2304 + 64 * (j))
#define XB_TOP      3328
#define XB_TOPGEN   3392
#define XCD_BAR_WORDS 3456
#define XB_SPIN_CAP (1u << 18)

__device__ __forceinline__ unsigned xb_ld(unsigned* p)              { return __hip_atomic_load(p, __ATOMIC_RELAXED, __HIP_MEMORY_SCOPE_AGENT); }
__device__ __forceinline__ unsigned xb_add(unsigned* p, unsigned v) { return __hip_atomic_fetch_add(p, v, __ATOMIC_RELAXED, __HIP_MEMORY_SCOPE_AGENT); }
__device__ __forceinline__ unsigned xb_xcc_id() { return (unsigned)__builtin_amdgcn_s_getreg((3 << 11) | 20) & 0xFu; }
#define XB_SPIN(cond, bar) do { unsigned _sp = 0; while (cond) { __builtin_amdgcn_s_sleep(1); \
    if ((++_sp & 255u) == 0u) { if (xb_ld(&(bar)[XB_TMO])) break; if (_sp > XB_SPIN_CAP) { atomicAdd(&(bar)[XB_TMO], 1u); break; } } } } while (0)

struct XcdBarrier {
    unsigned* bar; unsigned x; unsigned w0;
    volatile LAS unsigned* st;
};

__device__ __forceinline__ XcdBarrier xcd_barrier_post(unsigned* bar, volatile LAS unsigned* st, unsigned is_wave0) {
    XcdBarrier b; b.bar = bar; b.x = xb_xcc_id(); b.st = st; b.w0 = is_wave0;
    if (is_wave0 && lane_id() == 0) (void)xb_add(&bar[XB_XCNT(b.x)], 1u);
    return b;
}
__device__ __forceinline__ void xcd_barrier_complete(unsigned* bar, unsigned x, unsigned& nloc, unsigned& nx) {
    const unsigned G = gridDim.x * gridDim.y * gridDim.z;
    unsigned sum, cnt, mine, sp = 0u;
    for (;;) {
        sum = 0u; cnt = 0u; mine = 0u;
#pragma unroll
        for (unsigned j = 0; j < 16; ++j) { const unsigned c = xb_ld(&bar[XB_XCNT(j)]); sum += c; cnt += (c > 0u) ? 1u : 0u; mine = (j == x) ? c : mine; }
        if (sum == G) break;
        __builtin_amdgcn_s_sleep(1);
        if ((++sp & 255u) == 0u) { if (xb_ld(&bar[XB_TMO])) break; if (sp > XB_SPIN_CAP) { atomicAdd(&bar[XB_TMO], 1u); break; } }
    }
    nloc = mine > 0u ? mine : 1u; nx = cnt > 0u ? cnt : 1u;
}

__device__ __forceinline__ void xcd_barrier(const XcdBarrier& b) {
    asm volatile("s_waitcnt vmcnt(0)" ::: "memory");
    __syncthreads();
    if (b.w0 && lane_id() == 0) {
        unsigned* bar = b.bar;
        __builtin_amdgcn_s_waitcnt(0);
        unsigned nloc = b.st[0], nx = b.st[1];
        if (nloc == 0u) { xcd_barrier_complete(bar, b.x, nloc, nx); b.st[0] = nloc; b.st[1] = nx; }
        const unsigned old = xb_add(&bar[XB_XSUB(b.x)], 1u);
        const unsigned gen = old / nloc;
        if (old + 1u == (gen + 1u) * nloc) {
            __builtin_amdgcn_fence(__ATOMIC_RELEASE, "agent");
            asm volatile("s_waitcnt vmcnt(0)" ::: "memory");
            const unsigned og = xb_add(&bar[XB_TOP], 1u);
            const unsigned tg = og / nx;
            if (og + 1u == (tg + 1u) * nx) xb_add(&bar[XB_TOPGEN], 1u);
            else XB_SPIN(xb_ld(&bar[XB_TOPGEN]) == tg, bar);
            __builtin_amdgcn_fence(__ATOMIC_ACQUIRE, "agent");
            xb_add(&bar[XB_XGEN(b.x)], 1u);
            asm volatile("s_waitcnt vmcnt(0)" ::: "memory");
        } else {
            XB_SPIN(xb_ld(&bar[XB_XGEN(b.x)]) == gen, bar);
            __builtin_amdgcn_fence(__ATOMIC_ACQUIRE, "agent");
            asm volatile("s_waitcnt vmcnt(0)" ::: "memory");
        }
    }
    __syncthreads();
}
constexpr int NWAVES = 8;
constexpr int RING_BYTES = 131072, GT_OFF = 133120  , LDSCTL_OFF = 137216, LDS_BYTES = 147456;
constexpr int CW_BAR = 4096, BAR_REGION = 4096;
static_assert(XCD_BAR_WORDS <= BAR_REGION && (CW_BAR + (N_PHASES + 1) * BAR_REGION) * 4 <= (int)MiB, "barrier regions inside the memset region");
static_assert(pg8::STAGE_BYTES <= RING_BYTES && att::Lay<64, 128>::OFF_STASH + 65536 <= RING_BYTES && att::Lay<128, 128>::OFF_WS + 2048 <= RING_BYTES && LDSCTL_OFF + 10240 <= LDS_BYTES, "LDS map");

struct Args { const float* in[26]; float* out; unsigned char* ws; int ph_lo, ph_hi, li, pad; };
#define KIN(k) ((const float*)(const GAS float*)karg64<8 * (k)>())
#define KOUT ((float*)(GAS float*)karg64<208>())
#define KWS ((unsigned char*)(GAS unsigned char*)karg64<216>())
static_assert(offsetof(Args, out) == 208 && offsetof(Args, ws) == 216 && offsetof(Args, ph_lo) == 224, "Args layout vs the kernarg offsets above");

__global__ void __launch_bounds__(NWAVES * 64, 2) mk_fwd(Args args) {
    extern __shared__ __attribute__((aligned(16))) unsigned char lds[];
    asm volatile("s_setreg_imm32_b32 hwreg(HW_REG_MODE, 23, 1), 1");
    const int wave = __builtin_amdgcn_readfirstlane((int)threadIdx.x >> 6);
#define lane0 lane_id()
#define tid0 (wave * 64 + lane_id())
    const int G = gridDim.x, bx = blockIdx.x, vcu = (G % 8 == 0) ? (bx % 8) * (G / 8) + bx / 8 : bx;
    constexpr int NCX = 4, NCV = 8 * NCX, NWK = 256 - NCV;
    const bool split = (G == 256); const int idx8 = bx >> 3, xcd8 = bx & 7;
    const bool conv = split && (idx8 >= 32 - NCX);
    const int wk = (idx8 << 3) | xcd8, cvw = ((((idx8 - (32 - NCX)) << 3) | xcd8) * NWAVES) + wave;
    LAS unsigned char* ldsl = (LAS unsigned char*)lds;
    volatile LAS unsigned* MISC = (volatile LAS unsigned*)(ldsl + LDSCTL_OFF);
    for (int u = tid0; u < (LDS_BYTES - LDSCTL_OFF) / 4; u += NWAVES * 64) ((LAS unsigned*)(ldsl + LDSCTL_OFF))[u] = 0u;
    __syncthreads();
    XcdBarrier bar = xcd_barrier_post((unsigned*)(KWS + WS_CTL) + CW_BAR + args.li * BAR_REGION, MISC + 8, wave == 0 ? 1u : 0u);
#define P_WS unsigned char* ws = KWS; unsigned* ctl = (unsigned*)(ws + WS_CTL); (void)ctl
#define P_ACT bf16_t* MEMKV = (bf16_t*)(ws + WS_MEMKV); bf16_t* HM = (bf16_t*)(ws + WS_HM); bf16_t* PROJ = (bf16_t*)(ws + WS_PROJ); bf16_t* OBR = (bf16_t*)(ws + WS_OBR); bf16_t* HMEM = OBR; \
    bf16_t* BUF = (bf16_t*)(ws + WS_BUF); bf16_t* YB = (bf16_t*)(ws + WS_YB); bf16_t* HID = (bf16_t*)(ws + WS_HID); bf16_t* WB = (bf16_t*)(ws + WS_WB); const bf16_t* WBl = WB + (size_t)l_ * WB_LAYER; \
    (void)MEMKV; (void)HM; (void)PROJ; (void)OBR; (void)HMEM; (void)BUF; (void)YB; (void)HID; (void)WBl
#define P_ROUTE int* experts = (int*)(ws + WS_ROUTE + RT_EXP); float* weights = (float*)(ws + WS_ROUTE + RT_WGT); int* rank = (int*)(ws + WS_ROUTE + RT_RANK); float* rstd = (float*)(ws + WS_ROUTE + RT_RSTD); \
    (void)experts; (void)weights; (void)rank; (void)rstd
    const int gw = bx * NWAVES + wave, NGW = G * NWAVES;
    const int lo = args.ph_lo, hi = args.ph_hi;
#ifndef STAGE_MASK
#define STAGE_MASK 0x3FFu
#endif
#define IN(k) (lo <= (k) && (k) < hi)
#define ST(s) ((STAGE_MASK >> (s)) & 1u)
#ifndef REP_MASK
#define REP_MASK 0u
#endif
#define NREP(s) (((REP_MASK >> (s)) & 1u) ? 2 : 1)
#ifndef REP_A
#define REP_A 1
#endif
#ifndef REP_B
#define REP_B 1
#endif
#ifndef DBL_BAR
#define DBL_BAR 0
#endif
#define SEAM(k) do { if (IN(k) && IN((k) + 1)) { xcd_barrier(bar); if (DBL_BAR) xcd_barrier(bar); } } while (0)

    if (ST(0) && IN(0))
  for (int rep_ = 0; rep_ < NREP(0); ++rep_) {
        int lane = lane0, tid = tid0; asm volatile("" : "+v"(lane), "+v"(tid));
        constexpr int l_ = 0; P_WS; P_ACT;
        float* tab1 = (float*)(ws + WS_TAB); float* tab2 = tab1 + SEQ * 32 * 2;
        const float* x = KIN(0); const float* mem = KIN(1); const float* mem_g = KIN(2); const float* norm1_g = KIN(4); const float* norm2_g = KIN(17); const float* w_rg = KIN(18); const float* w_re = KIN(20);
        LAS float* scr = (LAS float*)(ldsl + wave * 16640);
#pragma unroll 1
        for (int ci = 0; ci < (split ? 2 : 4); ++ci) {
            const int md = ci == 0 ? 1 : ci == 1 ? 4 : ci;
            tr_run(md, gw, md == 1 ? 1728 : md == 4 ? 2112 : md == 2 ? 12928 : 12288, NGW, WB, scr, lane, md == 1 ? norm1_g : md == 4 ? norm1_g + DM : nullptr, (LAS float*)(ldsl + GT_OFF)); }
        tid = tid0; lane = lane0; asm volatile("" : "+v"(lane), "+v"(tid));
        for (int idx = bx * (NWAVES * 64) + tid; idx < SEQ * 32; idx += G * NWAVES * 64) { const int pos = idx >> 5, i = idx & 31; float s, c;
            sincosf((float)pos * inv1d(i), &s, &c); tab1[idx * 2] = c; tab1[idx * 2 + 1] = s;
            sincosf(ang2d(pos, i), &s, &c); tab2[idx * 2] = c; tab2[idx * 2 + 1] = s; }
        for (int idx = bx * (NWAVES * 64) + tid; idx < DEPTH * 48 * 1024; idx += G * NWAVES * 64) { const int l = idx / (48 * 1024), c = (idx >> 10) % 48, k = idx & 1023;
            const float w = c < 4 ? w_rg[((size_t)l * DM + k) * 4 + c] : c < 36 ? w_re[((size_t)l * DM + k) * 32 + (c - 4)] : 0.f, v = w * norm2_g[l * DM + k];
            const bf16_t h = f2bf(v); bf16_t* t = WB + WB_RT + (size_t)l * 2 * 48 * 1024 + (size_t)c * 1024 + k; t[0] = h; t[48 * 1024] = f2bf(v - bf2f(h)); }
        for (int m = 4 * gw; m < M; m += 4 * NGW) rows_in<4, false>(x, nullptr, (bf16_t*)KOUT, (float*)(ws + WS_ROUTE + RT_RSTD1), m, lane, (unsigned char*)HM);
        for (int m = gw; m < MM; m += NGW) rows_in<1, true>(mem, mem_g, HMEM, nullptr, m, lane);
    }
    SEAM(0);
#pragma unroll 1
    for (int l = 0; l < DEPTH; ++l) {
        const int pb = 1 + 9 * l, l_ = l;
        const bool l0s = false;
        if (ST(1) && IN(pb + 0))
      for (int rep_ = 0; rep_ < NREP(1); ++rep_) {
            P_WS; P_ACT; float* tab1 = (float*)(ws + WS_TAB); float* tab2 = tab1 + SEQ * 32 * 2; const float* qn_g = KIN(11); const float* kn_g = KIN(12);
            constexpr int NMAIN = (M / 256) * pg8::NPT;
            for (int rA_ = 0; rA_ < REP_A; ++rA_)
            { pg8::Gemm g{XP, DM};
              pg8::SchedProj S{bx, G, NMAIN, l == 0 ? NMAIN + 32 : NMAIN, (const char*)KOUT, (const char*)(WBl + WB_IN), (const char*)HMEM, (const char*)(WB + WB_MEMKV)};
              pg8::EpiProj E{PROJ, MEMKV, tab1, tab2, qn_g + l * 64, kn_g + l * 64, (const float*)(ws + WS_ROUTE + RT_RSTD1)};
              pg8::gemm_phase<pg8::EpiProj, pg8::SchedProj, true, true>(ldsl, g, S, E, wave); }
            for (int rB_ = 0; rB_ < REP_B; ++rB_)
            { pg8::Gemm g{DM / 2, DM / 2, 0x7C7C7C7C};
              pg8::SchedGate8 S{bx, G, l == 0 ? 28 : 24, (const char*)HM, (const char*)(WBl + WB_IN) + (size_t)C_G * 2048};
              pg8::EpiSig E{PROJ, (const float*)(ws + WS_ROUTE + RT_RSTD1)};
              pg8::gemm_phase<pg8::EpiSig, pg8::SchedGate8, true, true, false, true>(ldsl, g, S, E, wave); }
        }
        SEAM(pb + 0);
        if (ST(2) && IN(pb + 1))
      for (int rep_ = 0; rep_ < NREP(2); ++rep_) {
            if (split) {
            P_WS; P_ACT; const float* lq1 = KIN(6); const float* lk1 = KIN(7); const float* lq2 = KIN(8); const float* lk2 = KIN(9); const float* subln_g = KIN(10); const float* norm2_g = KIN(17);
            const float lam_init = 0.8f - 0.6f * __expf(-0.3f * (float)l);
            float lam; { int lane = lane0; asm volatile("" : "+v"(lane)); lam = __expf(wave_sum(lq1[l * 64 + lane] * lk1[l * 64 + lane])) - __expf(wave_sum(lq2[l * 64 + lane] * lk2[l * 64 + lane])) + lam_init; }
            const int slot = idx8 & 3, j = vcu;
#pragma unroll 1
            for (int st = 0; st < 4; ++st) {
                int wv_ = wave; asm volatile("" : "+s"(wv_));
                if (st == slot) { int lane = wv_ * 0 + lane0; asm volatile("" : "+v"(lane)); tr_run(2 + l, bx * NWAVES + wv_, l == 0 ? 12928 : 12288, NGW, WB, (LAS float*)(ldsl + wv_ * 16640), lane, nullptr, (LAS float*)(ldsl + GT_OFF)); }
                if (st == 0) att::unit_a(PROJ, OBR, j >> 5, (j >> 3) & 3, j & 7, lam, lam_init, subln_g + l * 128, (char*)lds, wv_);
                else if (st == 1) {
#pragma unroll 1
                    for (int i = 0; i < 2; ++i) { const int jb = 2 * j + i; att::unit_b(PROJ, OBR, jb >> 6, (jb >> 3) & 7, jb & 7, (char*)lds, wv_); } }
                else if (st == 2) att::unit_c(PROJ, MEMKV, OBR, j >> 5, (j >> 3) & 3, j & 7, (char*)lds, wv_);
            }
            __syncthreads();
            } else {
            const int lane = lane0;
            P_WS; P_ACT; const float* lq1 = KIN(6); const float* lk1 = KIN(7); const float* lq2 = KIN(8); const float* lk2 = KIN(9); const float* subln_g = KIN(10);
            const float lam_init = 0.8f - 0.6f * __expf(-0.3f * (float)l);
            const float lam = __expf(wave_sum(lq1[l * 64 + lane] * lk1[l * 64 + lane])) - __expf(wave_sum(lq2[l * 64 + lane] * lk2[l * 64 + lane])) + lam_init;
            constexpr int NS = NWK - NCV, NB3 = 512 - 2 * NS, NCW = NS - NB3;
            static_assert(NB3 >= 0 && NB3 <= NS && NCW > 0 && NB3 / 2 + 3 * NCW == 256, "attention deal");
            for (int jj = l0s ? 0 : vcu; jj < (l0s ? 1 : 256); jj += (l0s ? 1 : G)) {
                const int w = wk - NCV, wc_ = w - NB3;
                const int c_lo = !l0s || wk < NCV ? 0 : w < NB3 ? (w >> 1) : NB3 / 2 + 3 * wc_, c_hi = !l0s || wk < NCV ? 0 : w < NB3 ? (w >> 1) + (w & 1) : NB3 / 2 + 3 * wc_ + 3;
                const int na = l0s ? (wk < NCV ? 2 : 1) : 1, nb = l0s ? (wk < NCV ? 0 : (w < NB3 ? 3 : 2)) : 2, nc = l0s ? c_hi - c_lo : 1;
#pragma unroll 1
                for (int i = 0; i < na; ++i) { const int j = l0s ? (i == 0 ? wk : NWK + wk) : jj; att::unit_a(PROJ, OBR, j >> 5, (j >> 3) & 3, j & 7, lam, lam_init, subln_g + l * 128, (char*)lds, wave); }
#pragma unroll 1
                for (int i = 0; i < nb; ++i) { const int j = l0s ? (i < 2 ? 2 * w + i : 2 * NS + w) : 2 * jj + i; att::unit_b(PROJ, OBR, j >> 6, (j >> 3) & 7, j & 7, (char*)lds, wave); }
#pragma unroll 1
                for (int i = 0; i < nc; ++i) { const int j = l0s ? c_lo + i : jj; att::unit_c(PROJ, MEMKV, OBR, j >> 5, (j >> 3) & 3, j & 7, (char*)lds, wave); }
            }
            __syncthreads();
            }
        }
        SEAM(pb + 1);
        if (ST(3) && IN(pb + 2))
      for (int rep_ = 0; rep_ < NREP(3); ++rep_) {
            P_WS; P_ACT;
            pg8::Gemm g{OBR_W, OBR_W};
            pg8::SchedPlain S{bx, G, M / 256, (const char*)OBR, (const char*)(WBl + WB_UP), (size_t)256 * OBR_W * 2, (size_t)256 * OBR_W * 2};
            pg8::EpiGate E{HM, PROJ};
            pg8::gemm_phase<pg8::EpiGate, pg8::SchedPlain, true, true>(ldsl, g, S, E, wave);
        }
        SEAM(pb + 2);
        if (ST(4) && IN(pb + 3)) {
            P_WS; P_ACT; bf16_t* XB = (bf16_t*)KOUT;
            pg8::Gemm g{DM, DM};
            pg8::SchedPlain S{bx, G, M / 256, (const char*)HM, (const char*)(WBl + WB_OUT), (size_t)256 * DM * 2, (size_t)256 * DM * 2};
            pg8::EpiResid E{XB};
            pg8::gemm_phase<pg8::EpiResid, pg8::SchedPlain, true, true>(ldsl, g, S, E, wave);
        }
        SEAM(pb + 3);
        if (ST(5) && IN(pb + 4)) {
            int tid = tid0; asm volatile("" : "+v"(tid));
            const int lane = tid & 63;
            P_WS; P_ACT; P_ROUTE; const bf16_t* X = (const bf16_t*)KOUT; const float* b_rg = KIN(19); const float* b_re = KIN(21); const float* norm2_g = KIN(17);
            const bf16_t* tab = WB + WB_RT + (size_t)l * 2 * 48 * 1024 + (size_t)(lane & 15) * 1024 + 128 * wave + 8 * (lane >> 4);
            bf16x8 Bh[3][4], Bl[3][4];
#pragma unroll
            for (int t = 0; t < 3; ++t)
#pragma unroll
                for (int sI = 0; sI < 4; ++sI) { Bh[t][sI] = *(const bf16x8*)(tab + (size_t)t * 16 * 1024 + 32 * sI); Bl[t][sI] = *(const bf16x8*)(tab + (size_t)(48 + t * 16) * 1024 + 32 * sI); }
            for (int rb = bx; rb < M / 64; rb += G)
                route_block(X, tab, b_rg + l * 4, b_re + l * 32, experts, weights, rank, ctl + CW_CNT + 2048 * l, rstd, (int*)BUF, norm2_g + l * DM, (unsigned char*)HM, rb, Bh, Bl, (LAS float*)ldsl, tid, wave);
        }
        SEAM(pb + 4);
        volatile LAS int* mt = (volatile LAS int*)(ldsl + LDSCTL_OFF + 256);
        LAS unsigned* rowtab = (LAS unsigned*)(ldsl + LDSCTL_OFF + 2048); LAS float* wtab = (LAS float*)(ldsl + LDSCTL_OFF + 6144);
        if (ST(7) && IN(pb + 6)) {
            int tid = tid0; asm volatile("" : "+v"(tid));
            P_WS; P_ACT; P_ROUTE;
            moe_tables(ctl + CW_CNT + 2048 * l, mt, tid);
            moe_rowtabs(mt, (const int*)BUF, weights, rstd, rowtab, wtab, vcu, G, tid, 1);
            const int ntiles = __builtin_amdgcn_readfirstlane(mt[256]);
            pg8::Gemm g{DM / 2, DM / 2, 0x7C7C7C7C};
            pg8::SchedMoeUp S{vcu, G, ntiles, (const LAS int*)(ldsl + LDSCTL_OFF + 256 + 96 * 4), (const char*)HM, (const char*)(WBl + WB_GU), ctl + CW_TCNT + l * 160 * 64};
            pg8::EpiSilu E{(unsigned char*)HID, wtab};
            pg8::gemm_phase<pg8::EpiSilu, pg8::SchedMoeUp, true, true, true, true>(ldsl, g, S, E, wave, rowtab);
        }
        if (ST(8) && IN(pb + 7)) {
            int tid = tid0; asm volatile("" : "+v"(tid));
            P_WS; P_ACT; P_ROUTE;
            if (!(ST(7) && IN(pb + 6))) moe_tables(ctl + CW_CNT + 2048 * l, mt, tid);
            moe_rowtabs(mt, (const int*)BUF, weights, rstd, rowtab, wtab, vcu, G, tid, 0);
            const int ntiles = __builtin_amdgcn_readfirstlane(mt[256]);
            pg8::Gemm g{DEXP / 2, DEXP / 2, 0x7E7E7E7E};
            pg8::SchedMoeDown S{vcu, G, ntiles, (ntiles * 4) % G, wave, (const LAS int*)(ldsl + LDSCTL_OFF + 256 + 96 * 4), (const char*)HID, (const char*)(WBl + WB_DN), ctl + CW_TCNT + l * 160 * 64, ctl + CW_TMO};
            pg8::EpiRowScale E{(unsigned char*)YB, wtab};
            pg8::gemm_phase<pg8::EpiRowScale, pg8::SchedMoeDown, true, true, false, true>(ldsl, g, S, E, wave);
        }
        SEAM(pb + 7);
        if (ST(9) && IN(pb + 8)) {
            int lane = lane0; asm volatile("" : "+v"(lane));
            P_WS; P_ACT; P_ROUTE; float* OUTP = KOUT; bf16_t* XB = (bf16_t*)OUTP; const float* norm1_g = KIN(4); const float* final_g = KIN(25);
            const bool last = (l == DEPTH - 1);
            const bool poison = last && ((__hip_atomic_load(ctl + CW_BAR + args.li * BAR_REGION + XB_TMO, __ATOMIC_RELAXED, __HIP_MEMORY_SCOPE_AGENT) | __hip_atomic_load(ctl + CW_TMO, __ATOMIC_RELAXED, __HIP_MEMORY_SCOPE_AGENT)) != 0u);
            if (!(ST(7) && IN(pb + 6)) && !(ST(8) && IN(pb + 7))) moe_tables(ctl + CW_CNT + 2048 * l, mt, tid0);
            static_assert(M % 4 == 0, "rows come in fours");
            for (int m = 4 * gw; m < M; m += 4 * NGW) {
                const u32x4 ex0 = *(const u32x4*)(experts + 2 * m), ex1 = *(const u32x4*)(experts + 2 * m + 4), rk0 = *(const u32x4*)(rank + 2 * m), rk1 = *(const u32x4*)(rank + 2 * m + 4);
                const int rows[4] = {m, m + 1, m + 2, m + 3};
                const int d0[4] = {mt[ex0.x] + (int)rk0.x, mt[ex0.z] + (int)rk0.z, mt[ex1.x] + (int)rk1.x, mt[ex1.z] + (int)rk1.z}, d1[4] = {mt[ex0.y] + (int)rk0.y, mt[ex0.w] + (int)rk0.w, mt[ex1.y] + (int)rk1.y, mt[ex1.w] + (int)rk1.w};
                rows_combine_norm<4>(XB, (const unsigned char*)YB, final_g, last ? nullptr : (float*)(ws + WS_ROUTE + RT_RSTD1), OUTP, rows, lane, poison, d0, d1, (unsigned char*)HM); }
        }
        SEAM(pb + 8);
    }
#undef IN
#undef SEAM
#undef lane0
#undef tid0
#undef P_WS
#undef P_ACT
#undef P_ROUTE
}

extern "C" void kernel_launch(void* const* d_in, const int* in_sizes, int n_in, void* d_out, int out_size, void* d_ws, size_t ws_size, hipStream_t stream) {
    if (n_in != 26 || in_sizes[0] != M * DM || out_size != M * DM || ws_size < WS_END) { fprintf(stderr, "kernel_launch: unexpected shapes n_in %d out %d ws %zu (need %zu)\n", n_in, out_size, ws_size, (size_t)WS_END); return; }
    static int grid = 0;
    if (grid == 0) {
        int dev = 0, cus = 0;
        if (hipGetDevice(&dev) != hipSuccess || hipDeviceGetAttribute(&cus, hipDeviceAttributeMultiprocessorCount, dev) != hipSuccess) { grid = -1; return; }
        if (hipFuncSetAttribute((const void*)mk_fwd, hipFuncAttributeMaxDynamicSharedMemorySize, LDS_BYTES) != hipSuccess) { fprintf(stderr, "kernel_launch: hipFuncSetAttribute failed\n"); grid = -1; return; }
        int per_cu = 0;
        if (hipOccupancyMaxActiveBlocksPerMultiprocessor(&per_cu, (const void*)mk_fwd, NWAVES * 64, LDS_BYTES) != hipSuccess || per_cu < 1) fprintf(stderr, "kernel_launch: occupancy query says %d\n", per_cu);
        (void)hipGetLastError();
        grid = cus;
    }
    if (grid < 0) return;
    (void)hipMemsetAsync((unsigned char*)d_ws + WS_CTL, 0, MiB, stream);
    Args a{};
    for (int i = 0; i < 26; ++i) a.in[i] = (const float*)d_in[i];
    a.out = (float*)d_out; a.ws = (unsigned char*)d_ws; a.ph_lo = 0; a.ph_hi = N_PHASES; a.li = 0; a.pad = 0;
    hipLaunchKernelGGL(mk_fwd, dim3(grid), dim3(NWAVES * 64), LDS_BYTES, stream, a);
}
```

```cpp
#include <hip/hip_runtime.h>
#include <cstdint>
#include <cstdio>
#include <cmath>
#include <cstddef>

typedef unsigned short bf16_t;
typedef float f32x4 __attribute__((ext_vector_type(4)));
typedef unsigned u32x4 __attribute__((ext_vector_type(4)));
typedef unsigned u32x2 __attribute__((ext_vector_type(2)));

constexpr int BATCH = 8, SEQ = 2048, DM = 1024, DEPTH = 2, MEM_LEN = 256;
constexpr int M = BATCH * SEQ;
constexpr int MM = BATCH * MEM_LEN;
constexpr int D_IN = 5888;
constexpr int C_AQ = 0, C_AK = 512, C_AV = 1024, C_BQ = 1536, C_BK = 2048, C_BV = 2176, C_CQ = 2304, C_G = 2816;
constexpr int OBR_W = 1536;
constexpr int NEXP = 32, DEXP = 512;
constexpr int MOE_TILE = 256;
constexpr int P_ROWS = M * 2 + NEXP * MOE_TILE;
constexpr int MAX_TILES = P_ROWS / MOE_TILE;
constexpr float EPS = 1e-6f;
constexpr float LOG2E = 1.4426950408889634f;
constexpr float C2_64 = 0.125f * LOG2E;
constexpr float C2_128 = 0.08838834764831845f * LOG2E;

constexpr size_t MiB = 1u << 20;
constexpr size_t WS_CTL = 0;
constexpr size_t WS_ROUTE = 1 * MiB;
constexpr size_t WS_TAB = 2 * MiB;
constexpr size_t WS_MEMKV = 3 * MiB;
constexpr size_t WS_HM = 7 * MiB;
constexpr size_t WS_PROJ = 39 * MiB;
constexpr size_t WS_OBR = 223 * MiB;
constexpr size_t WS_WB = 271 * MiB;
constexpr size_t WS_END = 499 * MiB;
constexpr size_t WS_BUF = WS_PROJ;
constexpr size_t WS_YB = WS_PROJ + 80 * MiB;
constexpr size_t WS_HID = WS_OBR;
constexpr size_t RT_EXP = 0;
constexpr size_t RT_WGT = 128 * 1024;
constexpr size_t RT_RANK = 256 * 1024;
constexpr size_t RT_DEST = 384 * 1024;
constexpr size_t RT_ROWW = 512 * 1024;
constexpr size_t RT_TILE = 700 * 1024;
constexpr size_t RT_RSTD1 = 896 * 1024;
constexpr size_t RT_RSTD = 768 * 1024;
constexpr int CW_CNT = 163840;
constexpr int CW_TMO = 128;
constexpr int CW_TCNT = 131072;

__device__ __forceinline__ float bf2f(bf16_t v) { return __uint_as_float(((unsigned)v) << 16); }
__device__ __forceinline__ bf16_t f2bf(float f) { unsigned u = __float_as_uint(f); return (bf16_t)((u + 0x7fffu + ((u >> 16) & 1u)) >> 16); }
template <int O> __device__ __forceinline__ float xlane(float v) { static_assert(O >= 1 && O < 32, "swizzle range"); return __int_as_float(__builtin_amdgcn_ds_swizzle(__float_as_int(v), (O << 10) | 0x1F)); }
__device__ __forceinline__ float half_sum(float v) { auto rr = __builtin_amdgcn_permlane32_swap(__float_as_uint(v), __float_as_uint(v), false, false); return __uint_as_float(rr[0]) + __uint_as_float(rr[1]); }
__device__ __forceinline__ float half_max(float v) { auto rr = __builtin_amdgcn_permlane32_swap(__float_as_uint(v), __float_as_uint(v), false, false); return fmaxf(__uint_as_float(rr[0]), __uint_as_float(rr[1])); }
__device__ __forceinline__ float wave_sum(float v) { v += xlane<1>(v); v += xlane<2>(v); v += xlane<4>(v); v += xlane<8>(v); v += xlane<16>(v); return half_sum(v); }
__device__ __forceinline__ float wave_max(float v) { v = fmaxf(v, xlane<1>(v)); v = fmaxf(v, xlane<2>(v)); v = fmaxf(v, xlane<4>(v)); v = fmaxf(v, xlane<8>(v)); v = fmaxf(v, xlane<16>(v)); return half_max(v); }
__device__ __forceinline__ float inv1d(int i) { return exp2f(-(float)i * (13.287712379549449f / 32.f)); }
__device__ __forceinline__ float inv2d(int j) { return exp2f(-(float)j * (13.287712379549449f / 16.f)); }
__device__ __forceinline__ float ang2d(int pos, int i) { return i < 16 ? (float)(pos >> 6) * inv2d(i) : (float)(pos & 63) * inv2d(i - 16); }

#define LAS __attribute__((address_space(3)))
#define GAS __attribute__((address_space(1)))
typedef short bf16x8 __attribute__((ext_vector_type(8)));
typedef short s16x4 __attribute__((ext_vector_type(4)));
typedef float f32x16 __attribute__((ext_vector_type(16)));
typedef float f32x2 __attribute__((ext_vector_type(2)));
typedef int i32x4 __attribute__((ext_vector_type(4)));
typedef int i32x8 __attribute__((ext_vector_type(8)));

constexpr size_t WB_IN = 0, WB_UP = 6029312, WB_OUT = WB_UP + 1572864, WB_GU = WB_OUT + 1048576, WB_DN = WB_GU + 33554432, WB_LAYER = WB_DN + 16777216;
constexpr size_t WB_MEMKV = 2 * WB_LAYER;
constexpr size_t WB_RT = WB_MEMKV + 1048576;
static_assert(WS_WB + (WB_RT + 2 * 2 * 48 * 1024) * 2 <= WS_END, "weight copies fit");
constexpr int N_PHASES = 19;
constexpr int XP = 2048;
constexpr int LCAP = 16384;

__device__ __forceinline__ int lane_id() { int r; asm volatile("v_mbcnt_lo_u32_b32 %0, -1, 0\n\tv_mbcnt_hi_u32_b32 %0, -1, %0" : "=v"(r)); return r; }
__device__ __forceinline__ unsigned cvt_pk_bf16(float lo, float hi) { unsigned r; asm volatile("v_cvt_pk_bf16_f32 %0, %1, %2" : "=v"(r) : "v"(lo), "v"(hi)); return r; }
__device__ __forceinline__ i32x8 cat8(const bf16x8& a, const bf16x8& b) { const i32x4 x = __builtin_bit_cast(i32x4, a), y = __builtin_bit_cast(i32x4, b); return __builtin_shufflevector(x, y, 0, 1, 2, 3, 4, 5, 6, 7); }
__device__ __forceinline__ u32x2 pack8_fp8(const f32x4& v0, const f32x4& v1) { int a = 0, b = 0; a = __builtin_amdgcn_cvt_pk_fp8_f32(v0[0], v0[1], a, false); a = __builtin_amdgcn_cvt_pk_fp8_f32(v0[2], v0[3], a, true);
    b = __builtin_amdgcn_cvt_pk_fp8_f32(v1[0], v1[1], b, false); b = __builtin_amdgcn_cvt_pk_fp8_f32(v1[2], v1[3], b, true); u32x2 r; r.x = (unsigned)a; r.y = (unsigned)b; return r; }
__device__ __forceinline__ unsigned pack4_fp8(const f32x4& v) { int a = 0; a = __builtin_amdgcn_cvt_pk_fp8_f32(v[0], v[1], a, false); a = __builtin_amdgcn_cvt_pk_fp8_f32(v[2], v[3], a, true); return (unsigned)a; }
__device__ __forceinline__ float fast_sigmoid(float v) { return __builtin_amdgcn_rcpf(1.f + __builtin_amdgcn_exp2f(-v * LOG2E)); }

namespace pg8 {
#define PG8_LAS LAS
constexpr int BM = 256, BK = 64, HALF = 128, HTB = HALF * BK * 2, STAGE_BYTES = 8 * HTB, NXCD = 8, WGM = 8;
__host__ __device__ __forceinline__ int lds_byte(int r, int c) { const int st = (r >> 4) * 2 + (c >> 5), rr = r & 15, cc = c & 31, ob = rr * 64 + cc * 2; return st * 1024 + (ob ^ (((ob >> 9) & 1) << 5)); }
__host__ __device__ __forceinline__ void stage_rc(int b, int& R, int& C) { const int st = b / 1024, sb = b % 1024, swz = sb ^ (((sb >> 9) & 1) << 5); R = (st >> 1) * 16 + swz / 64; C = (st & 1) * 32 + (swz % 64) / 2; }
__host__ __device__ __forceinline__ int perm32(int rho) { const int n = rho >> 4, i = rho & 15; return 8 * (i >> 2) + 4 * n + (i & 3); }

struct Unit { int pm, pn, sub, ord; const char* a; const char* b; };
struct Gemm { int lda; int K; int sw = 0x7F7F7F7F; };
__device__ __forceinline__ void tile_order(int L, int nM, int nN, int& pm, int& pn) {
    const int nwg = nM * nN; int wgid = L; { const int q = nwg / NXCD, r = nwg % NXCD, xcd = wgid % NXCD, off = wgid / NXCD; wgid = (xcd < r ? xcd * (q + 1) : r * (q + 1) + (xcd - r) * q) + off; }
    const int nig = WGM * nN, gid = wgid / nig, fm = gid * WGM, gsz = (nM - fm) < WGM ? (nM - fm) : WGM;
    pm = fm + ((wgid % nig) % gsz); pn = (wgid % nig) / gsz;
}
__device__ __forceinline__ u32x4 pack8(const f32x4& v0, const f32x4& v1) { u32x4 w; w.x = cvt_pk_bf16(v0[0], v0[1]); w.y = cvt_pk_bf16(v0[2], v0[3]); w.z = cvt_pk_bf16(v1[0], v1[1]); w.w = cvt_pk_bf16(v1[2], v1[3]); return w; }
__device__ __forceinline__ void unpack8(const u32x4& w, f32x4& v0, f32x4& v1) {
    v0[0] = __uint_as_float(w.x << 16); v0[1] = __uint_as_float(w.x & 0xffff0000u); v0[2] = __uint_as_float(w.y << 16); v0[3] = __uint_as_float(w.y & 0xffff0000u);
    v1[0] = __uint_as_float(w.z << 16); v1[1] = __uint_as_float(w.z & 0xffff0000u); v1[2] = __uint_as_float(w.w << 16); v1[3] = __uint_as_float(w.w & 0xffff0000u); }

__device__ __forceinline__ unsigned pack4_u8(const f32x4& v) {
    const unsigned a = (unsigned)__builtin_rintf(v[0] * 255.f), b = (unsigned)__builtin_rintf(v[1] * 255.f), c = (unsigned)__builtin_rintf(v[2] * 255.f), d = (unsigned)__builtin_rintf(v[3] * 255.f);
    return a | (b << 8) | (c << 16) | (d << 24); }
__device__ __forceinline__ void unpack8_u8(const u32x2& w, f32x4& v0, f32x4& v1) {
    constexpr float k = 1.f / 255.f;
    v0[0] = (float)(w.x & 0xffu) * k; v0[1] = (float)((w.x >> 8) & 0xffu) * k; v0[2] = (float)((w.x >> 16) & 0xffu) * k; v0[3] = (float)(w.x >> 24) * k;
    v1[0] = (float)(w.y & 0xffu) * k; v1[1] = (float)((w.y >> 8) & 0xffu) * k; v1[2] = (float)((w.y >> 16) & 0xffu) * k; v1[3] = (float)(w.y >> 24) * k; }
struct EpiProj {
    static constexpr bool PERM = true, AFTER_DRAIN = false, KHOOK = false;
    bf16_t* PROJ; bf16_t* MEMKV; const float* tab1; const float* tab2; const float* qg; const float* kg; const float* rstd1;
    __device__ __forceinline__ void operator()(const f32x4 (&acc)[2][2][4][2], const Unit& u, int wr, int wc, int fr, int fq) const {
        const int colt = u.pn * 256, dcol = colt + wc * 64 + fq * 8, row0 = u.pm * 256 + wr * 64 + fr;
        if (u.sub == 1) {
#pragma unroll
            for (int ai = 0; ai < 2; ++ai)
#pragma unroll
                for (int m = 0; m < 4; ++m) { bf16_t* rowp = MEMKV + (size_t)(row0 + ai * 128 + m * 16) * 1024 + dcol;
#pragma unroll
                    for (int bj = 0; bj < 2; ++bj) *(u32x4*)(rowp + bj * 32) = pack8(acc[ai][bj][m][0], acc[ai][bj][m][1]); }
            return;
        }
        int mode = 0; float sc = 1.f; const float* g = qg;
        if (colt < C_AV) { mode = 1; if (colt < C_AK) sc = C2_64; }
        else if (colt < C_BQ) mode = 0;
        else if (colt < C_BK) { mode = 2; sc = C2_64; }
        else if (colt < C_CQ) { if (wc < 2) { mode = 2; g = kg; } }
        else if (colt < C_G) sc = C2_128;
        else mode = 3;
        f32x4 gv[2][2];
        if (mode == 2) {
#pragma unroll
            for (int bj = 0; bj < 2; ++bj)
#pragma unroll
                for (int n = 0; n < 2; ++n) gv[bj][n] = *(const f32x4*)(g + bj * 32 + fq * 8 + n * 4);
        }
        float r1v[2][4];
#pragma unroll
        for (int ai = 0; ai < 2; ++ai)
#pragma unroll
            for (int m = 0; m < 4; ++m) r1v[ai][m] = rstd1[row0 + ai * 128 + m * 16];
        asm volatile("" ::: "memory");
#pragma unroll
        for (int ai = 0; ai < 2; ++ai)
#pragma unroll
            for (int m = 0; m < 4; ++m) {
                const int row = row0 + ai * 128 + m * 16, pos = row & (SEQ - 1);
                const float r1 = r1v[ai][m];
                f32x4 v[2][2] = {{acc[ai][0][m][0] * r1, acc[ai][0][m][1] * r1}, {acc[ai][1][m][0] * r1, acc[ai][1][m][1] * r1}};
                if (mode == 2) {
                    float ss = 0.f;
#pragma unroll
                    for (int bj = 0; bj < 2; ++bj)
#pragma unroll
                        for (int n = 0; n < 2; ++n) ss += (v[bj][n][0] * v[bj][n][0] + v[bj][n][1] * v[bj][n][1]) + (v[bj][n][2] * v[bj][n][2] + v[bj][n][3] * v[bj][n][3]);
                    ss += xlane<16>(ss); ss = half_sum(ss);
                    const float rs = rsqrtf(ss * (1.f / 64.f) + EPS);
#pragma unroll
                    for (int bj = 0; bj < 2; ++bj)
#pragma unroll
                        for (int n = 0; n < 2; ++n) v[bj][n] = v[bj][n] * rs * gv[bj][n];
                }
                if (mode == 1 || mode == 2) {
                    const float* tb = (mode == 1 ? tab1 : tab2) + ((size_t)pos * 32 + fq * 8) * 2;
#pragma unroll
                    for (int n = 0; n < 2; ++n) { const f32x4 t0 = *(const f32x4*)(tb + n * 8), t1 = *(const f32x4*)(tb + n * 8 + 4);
                        const float cs[4] = {t0[0], t0[2], t1[0], t1[2]}, sn[4] = {t0[1], t0[3], t1[1], t1[3]};
#pragma unroll
                        for (int e = 0; e < 4; ++e) { const float x1 = v[0][n][e], x2 = v[1][n][e]; v[0][n][e] = x1 * cs[e] - x2 * sn[e]; v[1][n][e] = x2 * cs[e] + x1 * sn[e]; } }
                }
                if (mode == 3) {
#pragma unroll
                    for (int bj = 0; bj < 2; ++bj)
#pragma unroll
                        for (int n = 0; n < 2; ++n)
#pragma unroll
                            for (int e = 0; e < 4; ++e) v[bj][n][e] = fast_sigmoid(v[bj][n][e]);
                }
                if (mode == 3) {
                    u32x4 w; w.x = pack4_u8(v[0][0]); w.y = pack4_u8(v[0][1]); w.z = pack4_u8(v[1][0]); w.w = pack4_u8(v[1][1]);
                    *(u32x4*)((unsigned char*)(PROJ + (size_t)row * D_IN + C_G) + (colt - C_G) + wc * 64 + fq * 16) = w;
                } else {
                bf16_t* rowp = PROJ + (size_t)row * D_IN + dcol;
#pragma unroll
                for (int bj = 0; bj < 2; ++bj) *(u32x4*)(rowp + bj * 32) = pack8(v[bj][0] * sc, v[bj][1] * sc);
                }
            }
    }
};
struct EpiGate {
    static constexpr bool PERM = true, AFTER_DRAIN = false, KHOOK = true;
    bf16_t* MERGED; const bf16_t* PROJ;
    __device__ __forceinline__ static void ug(const u32x2& w, f32x4& v0, f32x4& v1) {
        unpack8_u8(w, v0, v1);
#pragma unroll
        for (int e = 0; e < 4; ++e) { v0[e] = fmaxf(v0[e], 0.5f / 255.f); v1[e] = fmaxf(v1[e], 0.5f / 255.f); } }
    __device__ __forceinline__ void khook(f32x4 (&acc)[2][2][4][2], const Unit& u, int t, int wr, int wc, int fr, int fq) const {
        int row0 = u.pm * 256 + wr * 64 + fr; asm volatile("" : "+v"(row0));
        const int seg = (t >> 3) - 1, col0 = u.pn * 256 + wc * 32 + fq * 8;
#pragma unroll
        for (int ai = 0; ai < 2; ++ai) {
            u32x2 ga[4][2], gb[4][2];
#pragma unroll
            for (int m = 0; m < 4; ++m) { const unsigned char* gp = (const unsigned char*)(PROJ + (size_t)(row0 + ai * 128 + m * 16) * D_IN + C_G) + seg * 1024 + col0;
#pragma unroll
                for (int bj = 0; bj < 2; ++bj) { ga[m][bj] = *(const u32x2*)(gp + bj * 128); gb[m][bj] = *(const u32x2*)(gp + 1024 + bj * 128); } }
            asm volatile("" ::: "memory");
#pragma unroll
            for (int m = 0; m < 4; ++m)
#pragma unroll
                for (int bj = 0; bj < 2; ++bj) { f32x4 a0, a1, b0, b1; ug(ga[m][bj], a0, a1); ug(gb[m][bj], b0, b1);
#pragma unroll
                    for (int e = 0; e < 4; ++e) { acc[ai][bj][m][0][e] *= a0[e] * __builtin_amdgcn_rcpf(b0[e]); acc[ai][bj][m][1][e] *= a1[e] * __builtin_amdgcn_rcpf(b1[e]); } }
            asm volatile("" ::: "memory");
        }
    }
    __device__ __forceinline__ void operator()(const f32x4 (&acc)[2][2][4][2], const Unit& u, int wr, int wc, int fr, int fq) const {
        const int col0 = u.pn * 256 + wc * 32 + fq * 8, row0 = u.pm * 256 + wr * 64 + fr;
#pragma unroll
        for (int ai = 0; ai < 2; ++ai) {
            u32x2 gq[4][2];
#pragma unroll
            for (int m = 0; m < 4; ++m) { const unsigned char* gp = (const unsigned char*)(PROJ + (size_t)(row0 + ai * 128 + m * 16) * D_IN + C_G) + 2 * 1024 + col0;
#pragma unroll
                for (int bj = 0; bj < 2; ++bj) gq[m][bj] = *(const u32x2*)(gp + bj * 128); }
            asm volatile("" ::: "memory");
#pragma unroll
            for (int m = 0; m < 4; ++m) { bf16_t* op = MERGED + (size_t)(row0 + ai * 128 + m * 16) * DM + col0;
#pragma unroll
                for (int bj = 0; bj < 2; ++bj) { f32x4 g0, g1; ug(gq[m][bj], g0, g1); *(u32x4*)(op + bj * 128) = pack8(g0 * acc[ai][bj][m][0], g1 * acc[ai][bj][m][1]); } }
            asm volatile("" ::: "memory");
        }
    }
};
struct EpiResid {
    static constexpr bool PERM = true, AFTER_DRAIN = false, KHOOK = false;
    bf16_t* XB;
    __device__ __forceinline__ void operator()(const f32x4 (&acc)[2][2][4][2], const Unit& u, int wr, int wc, int fr, int fq) const {
        const int col0 = u.pn * 256 + wc * 32 + fq * 8, row0 = u.pm * 256 + wr * 64 + fr;
#pragma unroll
        for (int ai = 0; ai < 2; ++ai)
#pragma unroll
            for (int mp = 0; mp < 2; ++mp) {
                u32x4 xq[2][2];
#pragma unroll
                for (int mi = 0; mi < 2; ++mi)
#pragma unroll
                    for (int bj = 0; bj < 2; ++bj) xq[mi][bj] = *(const u32x4*)(XB + (size_t)(row0 + ai * 128 + (mp * 2 + mi) * 16) * XP + col0 + bj * 128);
                asm volatile("" ::: "memory");
#pragma unroll
                for (int mi = 0; mi < 2; ++mi) { const int m = mp * 2 + mi;
#pragma unroll
                    for (int bj = 0; bj < 2; ++bj) { f32x4 x0, x1; unpack8(xq[mi][bj], x0, x1);
                        *(u32x4*)(XB + (size_t)(row0 + ai * 128 + m * 16) * XP + col0 + bj * 128) = pack8(x0 + acc[ai][bj][m][0], x1 + acc[ai][bj][m][1]); } }
                asm volatile("" ::: "memory");
            }
    }
};
constexpr float HID_SCALE = 4.f;
struct EpiSilu {
    static constexpr bool PERM = true, AFTER_DRAIN = false, KHOOK = false;
    unsigned char* HID; const PG8_LAS float* rtab;
    __device__ __forceinline__ void operator()(const f32x4 (&acc)[2][2][4][2], const Unit& u, int wr, int wc, int fr, int fq) const {
        const __amdgpu_buffer_rsrc_t rsrc = __builtin_amdgcn_make_buffer_rsrc((void*)HID, 0, P_ROWS * DEXP, 0x00020000);
        const int col0 = u.pn * 128 + wc * 32 + fq * 8, row0 = u.pm * 256 + wr * 64 + fr;
#pragma unroll
        for (int ai = 0; ai < 2; ++ai)
#pragma unroll
            for (int m = 0; m < 4; ++m) { f32x4 h[2]; const float r = rtab[u.ord * 256 + wr * 64 + fr + ai * 128 + m * 16];
#pragma unroll
                for (int n = 0; n < 2; ++n)
#pragma unroll
                    for (int e = 0; e < 4; ++e) { const float gq = acc[ai][0][m][n][e] * r; h[n][e] = gq * fast_sigmoid(gq) * (acc[ai][1][m][n][e] * (r * HID_SCALE)); }
                __builtin_amdgcn_raw_buffer_store_b64(pack8_fp8(h[0], h[1]), rsrc, (row0 + ai * 128 + m * 16) * DEXP + col0, 0, 16); }
    }
};
struct EpiRowScale {
    static constexpr bool PERM = true, AFTER_DRAIN = false, KHOOK = false;
    unsigned char* YB; const PG8_LAS float* wtab;
    __device__ __forceinline__ void operator()(const f32x4 (&acc)[2][2][4][2], const Unit& u, int wr, int wc, int fr, int fq) const {
        const int col0 = u.pn * 256 + wc * 64 + fq * 16, rt0 = wr * 64 + fr;
#pragma unroll
        for (int ai = 0; ai < 2; ++ai)
#pragma unroll
            for (int m = 0; m < 4; ++m) { const int rt = rt0 + ai * 128 + m * 16; const float w = wtab[u.ord * 256 + rt];
                if (w >= 0.f) {
                    u32x4 o; o.x = pack4_fp8(acc[ai][0][m][0] * w); o.y = pack4_fp8(acc[ai][0][m][1] * w); o.z = pack4_fp8(acc[ai][1][m][0] * w); o.w = pack4_fp8(acc[ai][1][m][1] * w);
                    *(u32x4*)(YB + (size_t)(u.pm * 256 + rt) * DM + col0) = o; } }
    }
};
constexpr int NPT = C_G / 256, NGT = (D_IN - C_G) / 256;
struct SchedProj {
    int c, G, nmain, ntotal; const char* A; const char* B; const char* Am; const char* Bm;
    __device__ __forceinline__ bool next(int i, Unit& u) const {
        const long L = (long)i * G + c; if (L >= ntotal) return false;
        u.ord = i;
        if (L < nmain) { tile_order((int)L, M / 256, NPT, u.pm, u.pn); u.sub = 0; u.a = A + (size_t)u.pm * (256 * XP * 2); u.b = B + (size_t)u.pn * (256 * DM * 2); }
        else { const int r = (int)L - nmain; u.pm = r >> 2; u.pn = r & 3; u.sub = 1; u.a = Am + (size_t)u.pm * (256 * XP * 2); u.b = Bm + (size_t)u.pn * (256 * DM * 2); }
        return true; }
    __device__ __forceinline__ void a_ready(const Unit&) const {}
    __device__ __forceinline__ void done(const Unit&) const {}
};
struct SchedGate8 {
    int c, G, kh; const char* A; const char* B;
    __device__ __forceinline__ bool next(int i, Unit& u) const {
        long L;
        if (G == 256) { const int k = c >> 3, nl = 32 - kh, k3 = 96 - 4 * nl - 2 * kh, nf = k < k3 ? 3 : k < kh ? 2 : 4, st = k < k3 ? 3 * k : k < kh ? 3 * k3 + 2 * (k - k3) : 3 * k3 + 2 * (kh - k3) + 4 * (k - kh);
            if (i >= nf) return false; L = 8 * (st + i) + (c & 7); }
        else { L = (long)i * G + c; if (L >= (M / 256) * NGT) return false; }
        tile_order((int)L, M / 256, NGT, u.pm, u.pn); u.sub = 0; u.ord = i; u.a = A + (size_t)u.pm * (256 * DM); u.b = B + (size_t)u.pn * (256 * DM); u.pn += NPT; return true; }
    __device__ __forceinline__ void a_ready(const Unit&) const {}
    __device__ __forceinline__ void done(const Unit&) const {}
};
struct EpiSig {
    static constexpr bool PERM = true, AFTER_DRAIN = false, KHOOK = false;
    bf16_t* PROJ; const float* rstd1;
    __device__ __forceinline__ void operator()(const f32x4 (&acc)[2][2][4][2], const Unit& u, int wr, int wc, int fr, int fq) const {
        const int colt = u.pn * 256, row0 = u.pm * 256 + wr * 64 + fr;
        float r1v[2][4];
#pragma unroll
        for (int ai = 0; ai < 2; ++ai)
#pragma unroll
            for (int m = 0; m < 4; ++m) r1v[ai][m] = rstd1[row0 + ai * 128 + m * 16];
        asm volatile("" ::: "memory");
#pragma unroll
        for (int ai = 0; ai < 2; ++ai)
#pragma unroll
            for (int m = 0; m < 4; ++m) { const int row = row0 + ai * 128 + m * 16; const float r1 = r1v[ai][m]; u32x4 w;
#pragma unroll
                for (int bj = 0; bj < 2; ++bj)
#pragma unroll
                    for (int n = 0; n < 2; ++n) { f32x4 v;
#pragma unroll
                        for (int e = 0; e < 4; ++e) v[e] = fast_sigmoid(acc[ai][bj][m][n][e] * r1);
                        w[bj * 2 + n] = pack4_u8(v); }
                *(u32x4*)((unsigned char*)(PROJ + (size_t)row * D_IN + C_G) + (colt - C_G) + wc * 64 + fq * 16) = w; }
    }
};
struct SchedPlain {
    int c, G, nM; const char* A; const char* B; size_t a_tile, b_tile;
    __device__ __forceinline__ bool next(int i, Unit& u) const {
        const long L = (long)i * G + c; if (L >= (long)nM * 4) return false;
        tile_order((int)L, nM, 4, u.pm, u.pn); u.sub = 0; u.ord = i; u.a = A + (size_t)u.pm * a_tile; u.b = B + (size_t)u.pn * b_tile; return true; }
    __device__ __forceinline__ void a_ready(const Unit&) const {}
    __device__ __forceinline__ void done(const Unit&) const {}
};
struct SchedMoeUp {
    static constexpr size_t b_exp = (size_t)1024 * 1024, b_tile = (size_t)256 * DM;
    int c, G, ntiles; const PG8_LAS int* tile_e; const char* A; const char* B; unsigned* tcnt;
    __device__ __forceinline__ bool next(int i, Unit& u) const {
        const long L = (long)i * G + c; if (L >= (long)ntiles * 4) return false;
        u.pm = (int)(L >> 2); u.pn = (int)(L & 3); u.sub = 0; u.ord = i; const int e = tile_e[u.pm];
        u.a = A; u.b = B + (size_t)e * b_exp + (size_t)u.pn * b_tile; return true; }
    __device__ __forceinline__ void a_ready(const Unit&) const {}
    __device__ __forceinline__ void done(const Unit& u) const {
        asm volatile("s_waitcnt vmcnt(0)" ::: "memory");
        if (lane_id() == 0) __hip_atomic_fetch_add(tcnt + 64 * u.pm, 1u, __ATOMIC_RELAXED, __HIP_MEMORY_SCOPE_AGENT);
    }
};
__device__ __forceinline__ int moe_down_unit(int c, int i, int rem, int G) {
    const int n0 = G - rem, n1 = rem;
    return c >= rem ? n0 * i + n1 * (i > 1 ? i - 1 : 0) + (c - rem) : n0 * (i + 2) + n1 * i + c;
}
struct SchedMoeDown {
    static constexpr size_t a_tile = (size_t)256 * DEXP, b_exp = (size_t)1024 * 512, b_tile = (size_t)256 * DEXP;
    int c, G, ntiles, rem, wv; const PG8_LAS int* tile_e; const char* A; const char* B; unsigned* tcnt; unsigned* tmo;
    __device__ __forceinline__ bool next(int i, Unit& u) const {
        const int j = moe_down_unit(c, i, rem, G); if (j >= ntiles * 4) return false;
        u.pm = j >> 2; u.pn = j & 3; u.sub = 0; u.ord = i; const int e = tile_e[u.pm];
        u.a = A + (size_t)u.pm * a_tile; u.b = B + (size_t)e * b_exp + (size_t)u.pn * b_tile; return true; }
    __device__ __forceinline__ void a_ready(const Unit& u) const {
        if (wv == 0) {
            unsigned polls = 0;
            while ((unsigned)__builtin_amdgcn_readfirstlane(__hip_atomic_load(tcnt + 64 * u.pm, __ATOMIC_RELAXED, __HIP_MEMORY_SCOPE_AGENT)) < 32u) {
                if (++polls > (1u << 20)) { if (lane_id() == 0) __hip_atomic_store(tmo, 1u, __ATOMIC_RELAXED, __HIP_MEMORY_SCOPE_AGENT); break; }
                __builtin_amdgcn_s_sleep(2); }
            __builtin_amdgcn_fence(__ATOMIC_ACQUIRE, "agent");
            asm volatile("s_waitcnt vmcnt(0)" ::: "memory");
        }
        asm volatile("" ::: "memory"); __builtin_amdgcn_s_barrier(); asm volatile("" ::: "memory");
    }
    __device__ __forceinline__ void done(const Unit&) const {}
};

template <class Epi, class Sched, bool ALIGN_EPI = false, bool SP2 = false, bool GATHER = false, bool F8 = false>
__device__ __forceinline__ void gemm_phase(PG8_LAS unsigned char* lds, const Gemm g, const Sched& S, const Epi& E, int wave_id, const PG8_LAS unsigned* rowtab = nullptr) {
    static_assert(!GATHER || SP2, "the gathered A path is written for the two-super-phase loop");
    int tid_ = wave_id * 64 + lane_id(); asm volatile("" : "+v"(tid_));
    const int tid = tid_, wid = __builtin_amdgcn_readfirstlane(tid >> 6), lane = tid & 63, wr = wid >> 2, wc = wid & 3, fr = lane & 15, fq = lane >> 4;
    int K_ = g.K; if constexpr (F8) asm volatile("" : "+s"(K_));
    const int K = K_, nt = K / BK;
    int sc8v = g.sw; if constexpr (F8) asm volatile("" : "+v"(sc8v));
    unsigned voffA[2], voffB[2];
#pragma unroll
    for (int i = 0; i < 2; ++i) { int R, C; stage_rc(tid * 16 + i * 8192, R, C); const int Rb = Epi::PERM ? ((R & ~31) + perm32(R & 31)) : R;
        voffA[i] = (unsigned)(R * g.lda + C) * 2u; voffB[i] = (unsigned)(Rb * K + C) * 2u; }
    unsigned gC[2][2] = {{0u, 0u}, {0u, 0u}}, gN[2][2] = {{0u, 0u}, {0u, 0u}};
#define PG8_GROWS(dst, ord) do { if constexpr (GATHER) { _Pragma("unroll") for (int i_ = 0; i_ < 2; ++i_) { int R_, C_; stage_rc((wid * 64 + fq * 16 + fr) * 16 + i_ * 8192, R_, C_);     \
        _Pragma("unroll") for (int h_ = 0; h_ < 2; ++h_) dst[h_][i_] = rowtab[(ord) * 256 + h_ * 128 + R_] + (unsigned)C_ * 2u; } } } while (0)
#define PG8_STAGE_A(bufoff, base, h, use_next) do { if constexpr (GATHER) { unsigned vo_[2]; vo_[0] = (use_next) ? gN[h][0] : gC[h][0]; vo_[1] = (use_next) ? gN[h][1] : gC[h][1]; PG8_STAGE(bufoff, base, vo_); } \
        else { PG8_STAGE(bufoff, (base) + (h) * hstepA, voffA); } } while (0)
    const size_t kstep = (size_t)(BK * 2);
    const size_t hstepA = (size_t)HALF * g.lda * 2, hstepB = (size_t)HALF * K * 2;
    const unsigned ldsw = (unsigned)wid * 1024u;
    const int aoff = lds_byte(wr * 64 + fr, fq * 8), boff = lds_byte(wc * 32 + fr, fq * 8);
#define PG8_SA(b, h) (((b) * 2 + (h)) * HTB)
#define PG8_SB(b, h) ((4 + (b) * 2 + (h)) * HTB)
#define PG8_STAGE(bufoff, gbase, voff) do { _Pragma("unroll") for (int _i = 0; _i < 2; ++_i) \
        __builtin_amdgcn_global_load_lds((const unsigned*)((const char*)(gbase) + (voff)[_i]), (PG8_LAS unsigned*)(lds + (bufoff) + ldsw + _i * 8192), 16, 0, 0); } while (0)
#define PG8_LDA(dst, b, h) do { _Pragma("unroll") for (int m = 0; m < 4; ++m) _Pragma("unroll") for (int k = 0; k < 2; ++k) dst[m][k] = *(const PG8_LAS bf16x8*)(lds + PG8_SA(b, h) + aoff + m * 2048 + k * 1024); } while (0)
#define PG8_LDB(dst, b, h) do { _Pragma("unroll") for (int n = 0; n < 2; ++n) _Pragma("unroll") for (int k = 0; k < 2; ++k) dst[n][k] = *(const PG8_LAS bf16x8*)(lds + PG8_SB(b, h) + boff + n * 2048 + k * 1024); } while (0)
#define PG8_MMA(ai, bj, At, Bt) do { __builtin_amdgcn_s_setprio(1); _Pragma("unroll") for (int m = 0; m < 4; ++m) _Pragma("unroll") for (int n = 0; n < 2; ++n) { \
        if constexpr (F8) asm volatile("v_mfma_scale_f32_16x16x128_f8f6f4 %0, %1, %2, %0, %3, %3 op_sel_hi:[0,0,0]" : "+v"(acc[ai][bj][m][n]) : "v"(cat8(Bt[n][0], Bt[n][1])), "v"(cat8(At[m][0], At[m][1])), "v"(sc8v));     \
        else { _Pragma("unroll") for (int k = 0; k < 2; ++k) acc[ai][bj][m][n] = __builtin_amdgcn_mfma_f32_16x16x32_bf16(Bt[n][k], At[m][k], acc[ai][bj][m][n], 0, 0, 0); } } __builtin_amdgcn_s_setprio(0); } while (0)
#define PG8_WAIT_V(n) asm volatile("s_waitcnt vmcnt(" #n ")" ::: "memory")
#define PG8_WAIT_L(n) asm volatile("s_waitcnt lgkmcnt(" #n ")" ::: "memory")
#define PG8_BAR __builtin_amdgcn_s_barrier()
#define PG8_SCHED __builtin_amdgcn_sched_barrier(0)
    Unit cur, nxt; int ui = 0;
    if (!S.next(0, cur)) return;
    f32x4 acc[2][2][4][2];
#pragma unroll
    for (int a = 0; a < 2; ++a)
#pragma unroll
        for (int b = 0; b < 2; ++b)
#pragma unroll
            for (int m = 0; m < 4; ++m)
#pragma unroll
                for (int n = 0; n < 2; ++n) acc[a][b][m][n] = (f32x4){0.f, 0.f, 0.f, 0.f};
    bf16x8 At[4][2], B0[2][2], B1[2][2];
    const char* cA = cur.a; const char* cB = cur.b;
    S.a_ready(cur);
    if constexpr (SP2) {
        PG8_GROWS(gC, 0);
        PG8_STAGE(PG8_SB(0, 0), cB, voffB); PG8_STAGE(PG8_SB(0, 1), cB + hstepB, voffB); PG8_STAGE_A(PG8_SA(0, 0), cA, 0, false); PG8_STAGE_A(PG8_SA(0, 1), cA, 1, false);
        if (wr == 1) PG8_BAR;
        PG8_WAIT_V(2); PG8_BAR;
        PG8_STAGE(PG8_SB(1, 0), cB + kstep, voffB); PG8_STAGE_A(PG8_SA(1, 0), cA + kstep, 0, false); PG8_STAGE(PG8_SB(1, 1), cB + hstepB + kstep, voffB);
        PG8_WAIT_V(6); PG8_BAR;
    } else {
        PG8_STAGE(PG8_SB(0, 0), cB, voffB); PG8_STAGE(PG8_SA(0, 0), cA, voffA); PG8_STAGE(PG8_SB(0, 1), cB + hstepB, voffB); PG8_STAGE(PG8_SA(0, 1), cA + hstepA, voffA);
        if (wr == 1) PG8_BAR;
        PG8_WAIT_V(4); PG8_BAR;
        PG8_STAGE(PG8_SB(1, 0), cB + kstep, voffB); PG8_STAGE(PG8_SA(1, 0), cA + kstep, voffA); PG8_STAGE(PG8_SB(1, 1), cB + hstepB + kstep, voffB);
        PG8_WAIT_V(6); PG8_BAR;
    }
    for (;;) {
        const bool has_next = S.next(ui + 1, nxt);
        const char* nA = has_next ? nxt.a : cA; const char* nB = has_next ? nxt.b : cB;
        for (int t = 0; t < nt; t += 2) {
            if constexpr (Epi::KHOOK) { if (t == 8 || t == 16) E.khook(acc, cur, t, wr, wc, fr, fq); }
            const bool last = (t == nt - 2);
            const char* a1 = cA + (size_t)(t + 1) * kstep;
            const char* a2 = last ? nA : cA + (size_t)(t + 2) * kstep; const char* b2 = last ? nB : cB + (size_t)(t + 2) * kstep;
            const char* a3 = a2 + kstep; const char* b3 = b2 + kstep;
            if (last && has_next) S.a_ready(nxt);
            if constexpr (GATHER) { if (last) { if (has_next) { PG8_GROWS(gN, ui + 1); } else { _Pragma("unroll") for (int h_ = 0; h_ < 2; ++h_) _Pragma("unroll") for (int i_ = 0; i_ < 2; ++i_) gN[h_][i_] = gC[h_][i_]; } } }
            if constexpr (SP2) {
            PG8_LDB(B0, 0, 0); PG8_LDB(B1, 0, 1); PG8_SCHED; PG8_LDA(At, 0, 0); PG8_STAGE_A(PG8_SA(1, 1), a1, 1, false);
            PG8_WAIT_V(8); PG8_WAIT_L(0); PG8_BAR; PG8_MMA(0, 0, At, B0); PG8_MMA(0, 1, At, B1); PG8_BAR; PG8_SCHED;
            PG8_LDA(At, 0, 1); PG8_STAGE(PG8_SB(0, 0), b2, voffB); PG8_STAGE(PG8_SB(0, 1), b2 + hstepB, voffB); PG8_STAGE_A(PG8_SA(0, 0), a2, 0, last);
            PG8_WAIT_V(8); PG8_WAIT_L(0); PG8_BAR; PG8_MMA(1, 0, At, B0); PG8_MMA(1, 1, At, B1); PG8_BAR; PG8_SCHED;
            PG8_LDB(B0, 1, 0); PG8_LDB(B1, 1, 1); PG8_SCHED; PG8_LDA(At, 1, 0); PG8_STAGE_A(PG8_SA(0, 1), a2, 1, last);
            PG8_WAIT_V(8); PG8_WAIT_L(0); PG8_BAR; PG8_MMA(0, 0, At, B0); PG8_MMA(0, 1, At, B1); PG8_BAR; PG8_SCHED;
            PG8_LDA(At, 1, 1); PG8_STAGE(PG8_SB(1, 0), b3, voffB); PG8_STAGE(PG8_SB(1, 1), b3 + hstepB, voffB); PG8_STAGE_A(PG8_SA(1, 0), a3, 0, last);
            PG8_WAIT_V(8); PG8_WAIT_L(0); PG8_BAR; PG8_MMA(1, 0, At, B0); PG8_MMA(1, 1, At, B1); PG8_BAR; PG8_SCHED;
            } else {
            PG8_LDB(B0, 0, 0); PG8_SCHED; PG8_LDA(At, 0, 0); PG8_STAGE(PG8_SA(1, 1), a1 + hstepA, voffA);
            PG8_WAIT_L(8); PG8_BAR; PG8_WAIT_L(0); PG8_MMA(0, 0, At, B0); PG8_BAR; PG8_SCHED;
            PG8_LDB(B1, 0, 1); PG8_STAGE(PG8_SB(0, 0), b2, voffB);
            PG8_BAR; PG8_WAIT_L(0); PG8_MMA(0, 1, At, B1); PG8_BAR;
            PG8_LDA(At, 0, 1); PG8_STAGE(PG8_SA(0, 0), a2, voffA);
            PG8_BAR; PG8_WAIT_L(0); PG8_MMA(1, 0, At, B0); PG8_BAR; PG8_SCHED;
            PG8_STAGE(PG8_SB(0, 1), b2 + hstepB, voffB);
            PG8_WAIT_V(6); PG8_BAR; PG8_MMA(1, 1, At, B1); PG8_BAR;
            PG8_LDB(B0, 1, 0); PG8_SCHED; PG8_LDA(At, 1, 0); PG8_STAGE(PG8_SA(0, 1), a2 + hstepA, voffA);
            PG8_WAIT_L(8); PG8_BAR; PG8_WAIT_L(0); PG8_MMA(0, 0, At, B0); PG8_BAR; PG8_SCHED;
            PG8_LDB(B1, 1, 1); PG8_STAGE(PG8_SB(1, 0), b3, voffB);
            PG8_BAR; PG8_WAIT_L(0); PG8_MMA(0, 1, At, B1); PG8_BAR;
            PG8_LDA(At, 1, 1); PG8_STAGE(PG8_SA(1, 0), a3, voffA);
            PG8_BAR; PG8_WAIT_L(0); PG8_MMA(1, 0, At, B0); PG8_BAR; PG8_SCHED;
            PG8_STAGE(PG8_SB(1, 1), b3 + hstepB, voffB);
            PG8_WAIT_V(6); PG8_BAR; PG8_MMA(1, 1, At, B1); PG8_BAR;
            }
        }
        if constexpr (ALIGN_EPI) { if (wr == 0) PG8_BAR; }
        if constexpr (!Epi::AFTER_DRAIN) {
            if constexpr (F8) { asm volatile("s_nop 15\n\ts_nop 15" ::: "memory");
                const int le_ = lane_id(); E(acc, cur, wr, wc, le_ & 15, le_ >> 4); }
            else E(acc, cur, wr, wc, fr, fq);
            S.done(cur); }
        if (!has_next) break;
#pragma unroll
        for (int a = 0; a < 2; ++a)
#pragma unroll
            for (int b = 0; b < 2; ++b)
#pragma unroll
                for (int m = 0; m < 4; ++m)
#pragma unroll
                    for (int n = 0; n < 2; ++n) acc[a][b][m][n] = (f32x4){0.f, 0.f, 0.f, 0.f};
        cur = nxt; cA = nA; cB = nB; ++ui;
        if constexpr (GATHER) { _Pragma("unroll") for (int h_ = 0; h_ < 2; ++h_) _Pragma("unroll") for (int i_ = 0; i_ < 2; ++i_) gC[h_][i_] = gN[h_][i_]; }
        if constexpr (ALIGN_EPI) { if (wr == 1) PG8_BAR; }
    }
    PG8_WAIT_V(0);
    if constexpr (!ALIGN_EPI) { if (wr == 0) PG8_BAR; }
    PG8_BAR;
    if constexpr (Epi::AFTER_DRAIN) { E.fused(acc, cur, wr, wc, fr, fq, lds, wid, lane); S.done(cur); }
#undef PG8_SA
#undef PG8_GROWS
#undef PG8_STAGE_A
#undef PG8_SB
#undef PG8_STAGE
#undef PG8_LDA
#undef PG8_LDB
#undef PG8_MMA
#undef PG8_WAIT_V
#undef PG8_WAIT_L
#undef PG8_BAR
#undef PG8_SCHED
}
}

namespace att {
constexpr int NW = 8, QBLK = 32, KVBLK = 64;
constexpr float THR = 8.f;
#define ATT_SBAR() __builtin_amdgcn_sched_barrier(0)
__device__ __forceinline__ int crow(int r, int hi) { return (r & 3) + 8 * (r >> 2) + 4 * hi; }
template <int D> __device__ __forceinline__ int kswz(int row, int colB) { return D == 128 ? row * 256 + (colB ^ ((row & 7) << 4)) : row * 128 + (colB ^ (((row >> 1) & 7) << 4)); }
template <int DV> __device__ __forceinline__ int v_st(int k, int c) { const int kk = (k & ~0xC) | ((k & 4) << 1) | ((k & 8) >> 1); return ((kk >> 3) * (DV / 32) + (c >> 5)) * 512 + ((kk & 7) * 32 + (c & 31)) * 2; }
__device__ __forceinline__ int v_rd_base(int lane) { return ((lane & 3) << 3) | (((lane >> 2) & 3) << 6) | (((lane >> 4) & 1) << 5) | (((lane >> 5) & 1) << 8); }
template <int DV> constexpr int v_rd_off(int d0, int ks, int half) { return d0 * 512 + ks * (DV / 32) * 1024 + half * (DV / 32) * 512; }
template <int OFF> __device__ __forceinline__ s16x4 tr_read(int vb) { s16x4 r; asm volatile("ds_read_b64_tr_b16 %0, %1 offset:%2" : "=&v"(r) : "v"(vb), "i"(OFF) : "memory"); return r; }

template <bool FIRST> __device__ __forceinline__ void partialSM(f32x16& p0, f32x16& p1, float& m_reg, float& alpha, f32x16& negm) {
    float pmax = p0[0];
#pragma unroll
    for (int r = 1; r < 16; ++r) pmax = fmaxf(pmax, p0[r]);
#pragma unroll
    for (int r = 0; r < 16; ++r) pmax = fmaxf(pmax, p1[r]);
    { auto rr = __builtin_amdgcn_permlane32_swap(__float_as_uint(pmax), __float_as_uint(pmax), false, false); pmax = fmaxf(__uint_as_float(rr[0]), __uint_as_float(rr[1])); }
    alpha = 1.f;
    if (FIRST || !__builtin_expect(__all(pmax <= THR), 1)) {
        const float dl = FIRST ? pmax : fmaxf(pmax, 0.f);
        if (!FIRST) alpha = __builtin_amdgcn_exp2f(-dl);
        m_reg += dl;
#pragma unroll
        for (int r = 0; r < 16; ++r) { p0[r] -= dl; p1[r] -= dl; negm[r] = -m_reg; }
    }
#pragma unroll
    for (int r = 0; r < 16; ++r) p0[r] = __builtin_amdgcn_exp2f(p0[r]);
}
__device__ __forceinline__ void finishSM(f32x16& p0, f32x16& p1, float alpha, float& l_reg, bf16x8& pa0, bf16x8& pa1, bf16x8& pa2, bf16x8& pa3) {
#pragma unroll
    for (int r = 0; r < 16; ++r) p1[r] = __builtin_amdgcn_exp2f(p1[r]);
    float ps = 0;
#pragma unroll
    for (int r = 0; r < 16; ++r) ps += p0[r];
#pragma unroll
    for (int r = 0; r < 16; ++r) ps += p1[r];
    { auto rr = __builtin_amdgcn_permlane32_swap(__float_as_uint(ps), __float_as_uint(ps), false, false); ps = __uint_as_float(rr[0]) + __uint_as_float(rr[1]); }
    l_reg = l_reg * alpha + ps;
#define ATT_PK4(P, BASE, OUT) do { unsigned a0 = cvt_pk_bf16(P[BASE + 0], P[BASE + 1]), a1 = cvt_pk_bf16(P[BASE + 2], P[BASE + 3]);   \
    unsigned b0 = cvt_pk_bf16(P[BASE + 4], P[BASE + 5]), b1 = cvt_pk_bf16(P[BASE + 6], P[BASE + 7]);                              \
    auto r0 = __builtin_amdgcn_permlane32_swap(a0, b0, false, false); auto r1 = __builtin_amdgcn_permlane32_swap(a1, b1, false, false); \
    u32x4 w = {r0[0], r1[0], r0[1], r1[1]}; OUT = *reinterpret_cast<bf16x8*>(&w); } while (0)
    ATT_PK4(p0, 0, pa0); ATT_PK4(p0, 8, pa1); ATT_PK4(p1, 0, pa2); ATT_PK4(p1, 8, pa3);
#undef ATT_PK4
}
template <int DQK> __device__ __forceinline__ void qkt(f32x16& p0, f32x16& p1, const char* Ks, const bf16x8* qr, const f32x16& negm, int r32, int hi) {
#pragma unroll
    for (int d0 = 0; d0 < DQK / 16; ++d0) { const int cb = (d0 * 16 + hi * 8) * 2;
        const bf16x8 b0 = *reinterpret_cast<const bf16x8*>(Ks + kswz<DQK>(r32, cb));
        const bf16x8 b1 = *reinterpret_cast<const bf16x8*>(Ks + kswz<DQK>(32 + r32, cb));
        p0 = __builtin_amdgcn_mfma_f32_32x32x16_bf16(b0, qr[d0], d0 == 0 ? negm : p0, 0, 0, 0);
        p1 = __builtin_amdgcn_mfma_f32_32x32x16_bf16(b1, qr[d0], d0 == 0 ? negm : p1, 0, 0, 0); }
}
template <int DV, int D0> __device__ __forceinline__ void pv_one(f32x16& od, int vb, bf16x8 pa0, bf16x8 pa1, bf16x8 pa2, bf16x8 pa3) {
    const s16x4 l0 = tr_read<v_rd_off<DV>(D0, 0, 0)>(vb), h0 = tr_read<v_rd_off<DV>(D0, 0, 1)>(vb), l1 = tr_read<v_rd_off<DV>(D0, 1, 0)>(vb), h1 = tr_read<v_rd_off<DV>(D0, 1, 1)>(vb);
    const s16x4 l2 = tr_read<v_rd_off<DV>(D0, 2, 0)>(vb), h2 = tr_read<v_rd_off<DV>(D0, 2, 1)>(vb), l3 = tr_read<v_rd_off<DV>(D0, 3, 0)>(vb), h3 = tr_read<v_rd_off<DV>(D0, 3, 1)>(vb);
    asm volatile("s_waitcnt lgkmcnt(0)" ::: "memory"); ATT_SBAR();
#define ATT_PK(L, H) (bf16x8){L[0], L[1], L[2], L[3], H[0], H[1], H[2], H[3]}
    od = __builtin_amdgcn_mfma_f32_32x32x16_bf16(pa0, ATT_PK(l0, h0), od, 0, 0, 0);
    od = __builtin_amdgcn_mfma_f32_32x32x16_bf16(pa1, ATT_PK(l1, h1), od, 0, 0, 0);
    od = __builtin_amdgcn_mfma_f32_32x32x16_bf16(pa2, ATT_PK(l2, h2), od, 0, 0, 0);
    od = __builtin_amdgcn_mfma_f32_32x32x16_bf16(pa3, ATT_PK(l3, h3), od, 0, 0, 0);
#undef ATT_PK
}
template <int DV> __device__ __forceinline__ void pv_all(f32x16 (&o)[DV / 32], int vb, bf16x8 pa0, bf16x8 pa1, bf16x8 pa2, bf16x8 pa3) {
    pv_one<DV, 0>(o[0], vb, pa0, pa1, pa2, pa3); pv_one<DV, 1>(o[1], vb, pa0, pa1, pa2, pa3);
    if constexpr (DV == 128) { pv_one<DV, 2>(o[2], vb, pa0, pa1, pa2, pa3); pv_one<DV, 3>(o[3], vb, pa0, pa1, pa2, pa3); }
}
template <int DQK, int DV> struct Lay { static constexpr int SHM_V = 64 * DV * 2, SHM_K = 64 * DQK * 2, OFF_V = 0, OFF_K = 2 * SHM_V, OFF_WS = OFF_K + 2 * SHM_K, OFF_STASH = OFF_WS + NW * 64 * 4; };

template <int DQK, int DV, int LDQ, int LDK, int LDV>
__device__ __forceinline__ void attn_pass(const bf16_t* __restrict__ Qb, const bf16_t* __restrict__ Kh, const bf16_t* __restrict__ Vh, int nkeys, char* lds, f32x16 (&o)[DV / 32], float (&rli)[16], int wv) {
    using L = Lay<DQK, DV>;
    constexpr int NLK = DQK / 64, NLV = DV / 64;
    int tid_ = wv * 64 + lane_id(); asm volatile("" : "+v"(tid_));
    const int tid = tid_, wid = tid >> 6, lane = tid & 63, r32 = lane & 31, hi = lane >> 5;
    char* V_lds = lds + L::OFF_V; char* K_lds = lds + L::OFF_K;
    float* ws = (float*)(lds + L::OFF_WS) + wid * 64; float* li_l = ws; float* al_l = ws + 32;
    float m_reg = 0.f, l_reg = 0.f; bf16x8 qr[DQK / 16]; f32x16 negm;
#pragma unroll
    for (int r = 0; r < 16; ++r) asm volatile("v_mov_b32 %0, 0" : "=v"(negm[r]));
#pragma unroll
    for (int d = 0; d < DV / 32; ++d) o[d] = f32x16{};
    const bf16_t* Qw = Qb + (size_t)(wid * QBLK + r32) * LDQ + hi * 8;
#pragma unroll
    for (int d0 = 0; d0 < DQK / 16; ++d0) qr[d0] = *reinterpret_cast<const bf16x8*>(Qw + d0 * 16);
    const int krow = DQK == 128 ? (tid >> 4) : (tid >> 3), kcol = DQK == 128 ? (tid & 15) * 8 : (tid & 7) * 8;
    const int vrow = DV == 128 ? (tid >> 4) : (tid >> 3), vcol = DV == 128 ? (tid & 15) * 8 : (tid & 7) * 8;
    const int vb0 = (int)(uintptr_t)V_lds + v_rd_base(lane);
    bf16x8 vsE[NLV], ksE[NLK], vsO[NLV], ksO[NLK];
#define ATT_SLOAD(VS, KS, k0) do { _Pragma("unroll") for (int i_ = 0; i_ < NLV; ++i_) VS[i_] = *reinterpret_cast<const bf16x8*>(&Vh[(size_t)((k0) + vrow + 32 * i_) * LDV + vcol]); \
    _Pragma("unroll") for (int i_ = 0; i_ < NLK; ++i_) KS[i_] = *reinterpret_cast<const bf16x8*>(&Kh[(size_t)((k0) + krow + 32 * i_) * LDK + kcol]); } while (0)
#define ATT_SWRITE(b, VS, KS) do { _Pragma("unroll") for (int i_ = 0; i_ < NLV; ++i_) *(bf16x8*)(V_lds + (b) * L::SHM_V + v_st<DV>(vrow + 32 * i_, vcol)) = VS[i_]; \
    _Pragma("unroll") for (int i_ = 0; i_ < NLK; ++i_) *(bf16x8*)(K_lds + (b) * L::SHM_K + kswz<DQK>(krow + 32 * i_, kcol * 2)) = KS[i_]; } while (0)
#define ATT_SWAIT() do { if constexpr (NLK + NLV == 4) asm volatile("s_waitcnt vmcnt(4)" ::: "memory"); else if constexpr (NLK + NLV == 3) asm volatile("s_waitcnt vmcnt(3)" ::: "memory"); else asm volatile("s_waitcnt vmcnt(2)" ::: "memory"); } while (0)
#define ATT_RESC(a) do { if (__any((a) < 1.f)) { if (hi == 0) al_l[r32] = (a); asm volatile("s_waitcnt lgkmcnt(0)" ::: "memory"); \
    _Pragma("unroll") for (int d = 0; d < DV / 32; ++d) _Pragma("unroll") for (int r = 0; r < 16; ++r) o[d][r] *= al_l[crow(r, hi)]; } } while (0)
    f32x16 pA0, pA1, pB0, pB1; float alA, alB; bf16x8 pa0, pa1, pa2, pa3; const int NT = nkeys / KVBLK;
    __syncthreads();
    ATT_SLOAD(vsE, ksE, 0); asm volatile("s_waitcnt vmcnt(0)" ::: "memory"); ATT_SWRITE(0, vsE, ksE); __syncthreads();
    qkt<DQK>(pA0, pA1, K_lds, qr, negm, r32, hi); partialSM<true>(pA0, pA1, m_reg, alA, negm);
    ATT_SLOAD(vsO, ksO, KVBLK); if (2 < NT) ATT_SLOAD(vsE, ksE, 2 * KVBLK);
    ATT_SWAIT(); ATT_SWRITE(1, vsO, ksO); __syncthreads();
    for (int j = 1; j + 1 < NT; j += 2) {
        ATT_SBAR(); qkt<DQK>(pB0, pB1, K_lds + L::SHM_K, qr, negm, r32, hi);
        finishSM(pA0, pA1, alA, l_reg, pa0, pa1, pa2, pa3); ATT_SBAR();
        ATT_SLOAD(vsO, ksO, (j + 2) * KVBLK); ATT_SBAR();
        pv_all<DV>(o, vb0, pa0, pa1, pa2, pa3); partialSM<false>(pB0, pB1, m_reg, alB, negm);
        __syncthreads(); ATT_SWAIT(); ATT_SWRITE(0, vsE, ksE);
        ATT_RESC(alB); __syncthreads();
        ATT_SBAR(); qkt<DQK>(pA0, pA1, K_lds, qr, negm, r32, hi);
        finishSM(pB0, pB1, alB, l_reg, pa0, pa1, pa2, pa3); ATT_SBAR();
        if (j + 3 < NT) ATT_SLOAD(vsE, ksE, (j + 3) * KVBLK); ATT_SBAR();
        pv_all<DV>(o, vb0 + L::SHM_V, pa0, pa1, pa2, pa3); partialSM<false>(pA0, pA1, m_reg, alA, negm);
        __syncthreads(); ATT_SWAIT(); ATT_SWRITE(1, vsO, ksO);
        ATT_RESC(alA); __syncthreads();
    }
    ATT_SBAR(); qkt<DQK>(pB0, pB1, K_lds + L::SHM_K, qr, negm, r32, hi);
    finishSM(pA0, pA1, alA, l_reg, pa0, pa1, pa2, pa3); ATT_SBAR();
    pv_all<DV>(o, vb0, pa0, pa1, pa2, pa3); partialSM<false>(pB0, pB1, m_reg, alB, negm);
    __syncthreads(); ATT_RESC(alB);
    finishSM(pB0, pB1, alB, l_reg, pa0, pa1, pa2, pa3); ATT_SBAR();
    pv_all<DV>(o, vb0 + L::SHM_V, pa0, pa1, pa2, pa3);
    if (hi == 0) li_l[r32] = l_reg; asm volatile("s_waitcnt lgkmcnt(0)" ::: "memory");
#pragma unroll
    for (int r = 0; r < 16; ++r) rli[r] = __builtin_amdgcn_rcpf(li_l[crow(r, hi)]);
#undef ATT_SLOAD
#undef ATT_SWRITE
#undef ATT_SWAIT
#undef ATT_RESC
}
template <int DV, int LDO> __device__ __forceinline__ void store_o(bf16_t* Ob, const f32x16 (&o)[DV / 32], const float (&rli)[16], int wv) {
    int tid_ = wv * 64 + lane_id(); asm volatile("" : "+v"(tid_));
    const int tid = tid_, wid = tid >> 6, lane = tid & 63, r32 = lane & 31, hi = lane >> 5;
    bf16_t* Ow = Ob + (size_t)(wid * QBLK) * LDO;
#pragma unroll
    for (int r = 0; r < 16; ++r) { const int orow = crow(r, hi);
#pragma unroll
        for (int d0 = 0; d0 < DV / 32; ++d0) Ow[(size_t)orow * LDO + d0 * 32 + r32] = f2bf(o[d0][r] * rli[r]); }
}
__device__ __forceinline__ void unit_a(const bf16_t* PROJ, bf16_t* OBR, int b, int h, int qb, const LAS float* lamp, const float* subg, char* lds, int wv) {
    using L = Lay<64, 128>;
    int tid_ = wv * 64 + lane_id(); asm volatile("" : "+v"(tid_));
    const int tid = tid_, wid = tid >> 6, lane = tid & 63, r32 = lane & 31, hi = lane >> 5;
    const bf16_t* kv = PROJ + (size_t)b * SEQ * D_IN; const size_t qrow = (size_t)b * SEQ + qb * 256;
    unsigned* stash = (unsigned*)(lds + L::OFF_STASH) + wid * 2048 + lane;
    f32x16 o[4]; float rli[16];
#pragma unroll 1
    for (int c = 0; c < 2; ++c) {
        attn_pass<64, 128, D_IN, D_IN, D_IN>(PROJ + qrow * D_IN + C_AQ + h * 128 + c * 64, kv + C_AK + h * 128 + c * 64, kv + C_AV + h * 128, SEQ, lds, o, rli, wv);
        if (c == 0) {
#pragma unroll
            for (int d0 = 0; d0 < 4; ++d0)
#pragma unroll
                for (int r = 0; r < 16; r += 2) stash[(d0 * 8 + (r >> 1)) * 64] = cvt_pk_bf16(o[d0][r] * rli[r], o[d0][r + 1] * rli[r + 1]);
        }
    }
    const float lam = lamp[0], lam_init = lamp[1];
    asm volatile("s_waitcnt lgkmcnt(0)" ::: "memory");
    float ss[16];
#pragma unroll
    for (int r = 0; r < 16; ++r) ss[r] = 0.f;
#pragma unroll
    for (int d0 = 0; d0 < 4; ++d0)
#pragma unroll
        for (int r = 0; r < 16; r += 2) { const unsigned w = stash[(d0 * 8 + (r >> 1)) * 64];
            const float c0 = __uint_as_float(w << 16) - lam * o[d0][r] * rli[r], c1 = __uint_as_float(w & 0xffff0000u) - lam * o[d0][r + 1] * rli[r + 1];
            o[d0][r] = c0; o[d0][r + 1] = c1; ss[r] += c0 * c0; ss[r + 1] += c1 * c1; }
#pragma unroll
    for (int r = 0; r < 16; ++r) { float s = ss[r]; s += xlane<1>(s); s += xlane<2>(s); s += xlane<4>(s); s += xlane<8>(s); s += xlane<16>(s);
        ss[r] = rsqrtf(s * (1.f / 128.f) + EPS) * (1.f - lam_init); }
    bf16_t* Ow = OBR + (qrow + wid * QBLK) * OBR_W + h * 128;
#pragma unroll
    for (int d0 = 0; d0 < 4; ++d0) { const float g = subg[d0 * 32 + r32];
#pragma unroll
        for (int r = 0; r < 16; ++r) Ow[(size_t)crow(r, hi) * OBR_W + d0 * 32 + r32] = f2bf(o[d0][r] * ss[r] * g); }
}
__device__ __forceinline__ void unit_b(const bf16_t* PROJ, bf16_t* OBR, int b, int qh, int qb, char* lds, int wv);
__device__ __forceinline__ void unit_c(const bf16_t* PROJ, const bf16_t* MEMKV, bf16_t* OBR, int b, int h, int qb, char* lds, int wv) {
    const bf16_t* kv = MEMKV + (size_t)b * MEM_LEN * 1024; const size_t qrow = (size_t)b * SEQ + qb * 256;
    f32x16 o[4]; float rli[16];
    attn_pass<128, 128, D_IN, 1024, 1024>(PROJ + qrow * D_IN + C_CQ + h * 128, kv + h * 128, kv + 512 + h * 128, MEM_LEN, lds, o, rli, wv);
    store_o<128, OBR_W>(OBR + qrow * OBR_W + 1024 + h * 128, o, rli, wv);
}
#undef ATT_SBAR
}

#include <hip/hip_bf16.h>
namespace attd {
using bf16=__hip_bfloat16;
using bf16x8=__attribute__((ext_vector_type(8)))short;
using s16x4=__attribute__((ext_vector_type(4)))short;
using f32x16=__attribute__((ext_vector_type(16)))float;
using u32x4=__attribute__((ext_vector_type(4)))unsigned;
constexpr int D=64;
constexpr int NW=8,QBLK=32,QB=QBLK*NW,KVBLK=64;
__device__ __forceinline__ int crow(int r,int hi){return (r&3)+8*(r>>2)+4*hi;}
#define SBAR() __builtin_amdgcn_sched_barrier(0)
__device__ __forceinline__ void cmask(f32x16&p0,f32x16&p1,int jb,int qrel,int hi){
  const float NEG=-INFINITY; int kb=64*jb+4*hi;
  #pragma unroll
  for(int r=0;r<16;++r){int kv=kb+(r&3)+8*(r>>2); if(kv>qrel)p0[r]=NEG; if(kv+32>qrel)p1[r]=NEG;}
}

constexpr int NSLOT=3, SLOTB=8192;
constexpr int LDS_K=0, LDS_V=NSLOT*SLOTB, LDS_WS=2*NSLOT*SLOTB, LDS_OST=LDS_WS+NW*64*4, LDS_BYTES=LDS_OST+NW*4096;
constexpr float C2=0.125f*1.4426950408889634f;
__device__ __forceinline__ void glds16(const void*gsrc,unsigned lds_dst){unsigned keep;
  asm volatile("s_mov_b32 %0, m0\n\ts_mov_b32 m0, %2\n\ts_nop 0\n\tglobal_load_lds_dwordx4 %1, off\n\ts_mov_b32 m0, %0":"=&s"(keep):"v"(gsrc),"s"(lds_dst):"memory");}
__device__ __forceinline__ float max3f(float a,float b,float c){float r;asm("v_max3_f32 %0, %1, %2, %3":"=v"(r):"v"(a),"v"(b),"v"(c));return r;}
__device__ __forceinline__ float max2f(float a,float b){float r;asm("v_max_f32_e32 %0, %1, %2":"=v"(r):"v"(a),"v"(b));return r;}
__device__ __forceinline__ float fadd_s(float a,float b){float r;asm("v_add_f32_e32 %0, %1, %2":"=v"(r):"v"(a),"v"(b));return r;}
__device__ __forceinline__ float fsub_s(float a,float b){float r;asm("v_sub_f32_e32 %0, %1, %2":"=v"(r):"v"(a),"v"(b));return r;}
typedef float f32x2_t __attribute__((ext_vector_type(2))); typedef __bf16 bf16x2_t __attribute__((ext_vector_type(2)));
__device__ __forceinline__ unsigned cvtpk_s(float lo,float hi){f32x2_t v={lo,hi};bf16x2_t b=__builtin_convertvector(v,bf16x2_t);return __builtin_bit_cast(unsigned,b);}
#define WAIT_BAR(N) asm volatile("s_waitcnt vmcnt(" #N ") lgkmcnt(0)\n\ts_barrier":::"memory")

__device__ __forceinline__ void qkt(f32x16&p0,f32x16&p1,const char*Kslot,const bf16x8*qr,const f32x16&negm,int r32,int hi){
  const char*kb=Kslot+hi*1024+r32*16;
  #pragma unroll
  for(int d0=0;d0<4;++d0){
    const bf16x8 b0=*reinterpret_cast<const bf16x8*>(kb+d0*2048);
    const bf16x8 b1=*reinterpret_cast<const bf16x8*>(kb+d0*2048+512);
    if(d0==0){p0=__builtin_amdgcn_mfma_f32_32x32x16_bf16(b0,qr[0],negm,0,0,0);p1=__builtin_amdgcn_mfma_f32_32x32x16_bf16(b1,qr[0],negm,0,0,0);}
    else{p0=__builtin_amdgcn_mfma_f32_32x32x16_bf16(b0,qr[d0],p0,0,0,0);p1=__builtin_amdgcn_mfma_f32_32x32x16_bf16(b1,qr[d0],p1,0,0,0);}}
}
typedef __attribute__((address_space(3))) const char* lds_cptr;
typedef short v4i16_t __attribute__((ext_vector_type(4)));
__device__ __forceinline__ void kload8(bf16x8*kf,lds_cptr kp){
  kf[0]=*(const __attribute__((address_space(3))) bf16x8*)(kp);      kf[1]=*(const __attribute__((address_space(3))) bf16x8*)(kp+512);
  kf[2]=*(const __attribute__((address_space(3))) bf16x8*)(kp+2048); kf[3]=*(const __attribute__((address_space(3))) bf16x8*)(kp+2560);
  kf[4]=*(const __attribute__((address_space(3))) bf16x8*)(kp+4096); kf[5]=*(const __attribute__((address_space(3))) bf16x8*)(kp+4608);
  kf[6]=*(const __attribute__((address_space(3))) bf16x8*)(kp+6144); kf[7]=*(const __attribute__((address_space(3))) bf16x8*)(kp+6656);
}
__device__ __forceinline__ void kload2(bf16x8*kf,lds_cptr kp,int j){ kf[2*j]=*(const __attribute__((address_space(3))) bf16x8*)(kp+j*2048); kf[2*j+1]=*(const __attribute__((address_space(3))) bf16x8*)(kp+j*2048+512); }
__device__ __forceinline__ s16x4 vtr(lds_cptr p){ return __builtin_bit_cast(s16x4,__builtin_amdgcn_ds_read_tr16_b64_v4i16((__attribute__((address_space(3))) v4i16_t*)p)); }
__device__ __forceinline__ float rowmax(const f32x16&p0,const f32x16&p1){
  float a=max3f(p0[0],p0[1],p1[0]),b=max3f(p0[2],p0[3],p1[1]);a=max3f(a,p1[2],p1[3]);
  #pragma unroll
  for(int r=4;r<16;r+=4){a=max3f(a,p0[r],p0[r+1]);b=max3f(b,p0[r+2],p0[r+3]);a=max3f(a,p1[r],p1[r+1]);b=max3f(b,p1[r+2],p1[r+3]);}
  const float m=max2f(a,b);
  auto rr=__builtin_amdgcn_permlane32_swap(__float_as_uint(m),__float_as_uint(m),false,false);
  return max2f(__uint_as_float(rr[0]),__uint_as_float(rr[1]));
}
__device__ __forceinline__ void pv(f32x16*o,int vb,bf16x8 pa0,bf16x8 pa1,bf16x8 pa2,bf16x8 pa3){
  #pragma unroll
  for(int d0=0;d0<2;++d0){s16x4 lo[4],hi[4];
    #pragma unroll
    for(int ks=0;ks<4;++ks){
      asm volatile("ds_read_b64_tr_b16 %0,%1 offset:%c2":"=&v"(lo[ks]):"v"(vb),"i"(d0*4096+ks*1024):"memory");
      asm volatile("ds_read_b64_tr_b16 %0,%1 offset:%c2":"=&v"(hi[ks]):"v"(vb),"i"(d0*4096+ks*1024+512):"memory");}
    asm volatile("s_waitcnt lgkmcnt(0)":::"memory");SBAR();
    #define PK(k) (bf16x8){lo[k][0],lo[k][1],lo[k][2],lo[k][3],hi[k][0],hi[k][1],hi[k][2],hi[k][3]}
    o[d0]=__builtin_amdgcn_mfma_f32_32x32x16_bf16(pa0,PK(0),o[d0],0,0,0);
    o[d0]=__builtin_amdgcn_mfma_f32_32x32x16_bf16(pa1,PK(1),o[d0],0,0,0);
    o[d0]=__builtin_amdgcn_mfma_f32_32x32x16_bf16(pa2,PK(2),o[d0],0,0,0);
    o[d0]=__builtin_amdgcn_mfma_f32_32x32x16_bf16(pa3,PK(3),o[d0],0,0,0);
    #undef PK
  }
}

#ifndef ATTN_STORE16
#define ATTN_STORE16(p,v) (*(u32x4*)(p)=(v))
#endif
template<int THRL,int QP,int KP,int OP> __device__ __forceinline__ void attn_unit(const bf16*Qb,const bf16*__restrict__ Kh,const bf16*__restrict__ Vh,bf16*Ob,int nkeys,char*shm,int wv){
  int tid_=wv*64+lane_id(); asm volatile("":"+v"(tid_)); const int tid=tid_,lane=tid&63,r32=lane&31,hi=lane>>5; const int wid=wv;
  constexpr int DM=KP;
  const bf16*Qw=Qb+(long)(wid*QBLK)*QP;
  const unsigned lds0=(unsigned)(uintptr_t)shm;
  float*wsf=(float*)(shm+LDS_WS)+wid*64;
  const bf16*ksrc=Kh+(long)lane*DM+wid*8;
  const bf16*vsrc=Vh+(long)(16*(wid&3)+(lane>>2))*DM+(wid>>2)*32+(lane&3)*8;
  const unsigned kdst=lds0+LDS_K+wid*1024, vdst=lds0+LDS_V+wid*1024;
  #define DMA_K(t,slot) glds16(ksrc+(long)(t)*KVBLK*DM,(unsigned)__builtin_amdgcn_readfirstlane(kdst+(slot)))
  #define DMA_V(t,slot) glds16(vsrc+(long)(t)*KVBLK*DM,(unsigned)__builtin_amdgcn_readfirstlane(vdst+(slot)))
  const int vb0=(int)(lds0+LDS_V)+((lane>>4)&1)*32+(lane&3)*8+(4*hi+((lane&15)>>2))*64;
  const char*Kbase=shm+LDS_K; bf16x8 kf[8];
  const lds_cptr shm3=(lds_cptr)shm; const lds_cptr kp0=shm3+LDS_K+hi*1024+r32*16; const lds_cptr vp0=shm3+LDS_V+((lane>>4)&1)*32+(lane&3)*8+(4*hi+((lane&15)>>2))*64;
  const int NT=nkeys/KVBLK;
  DMA_K(0,0);DMA_V(0,0);DMA_K(1,SLOTB);
  bf16x8 qr[4];
  #pragma unroll
  for(int d0=0;d0<4;++d0)qr[d0]=*reinterpret_cast<const bf16x8*>(&Qw[(long)r32*QP+d0*16+hi*8]);
  float mhat=0.f,l_reg=0.f;f32x16 o[2],negm;
  #pragma unroll
  for(int r=0;r<16;++r){asm volatile("v_mov_b32 %0, 0":"=v"(o[0][r]));asm volatile("v_mov_b32 %0, 0":"=v"(o[1][r]));asm volatile("v_mov_b32 %0, 0":"=v"(negm[r]));}
  #define CMASK(P0,P1,t) do{}while(0)
  bool resc=false;
  #define START(P0,P1) do{ const float rm=rowmax(P0,P1); resc=false; \
    { const float dl=rm; mhat=fadd_s(mhat,dl); \
      _Pragma("unroll") for(int r=0;r<16;++r){P0[r]=fsub_s(P0[r],dl);P1[r]=fsub_s(P1[r],dl);} \
      _Pragma("unroll") for(int r=0;r<16;++r)negm[r]=-mhat; asm volatile("":"+v"(negm)); } \
    _Pragma("unroll") for(int r=0;r<16;++r)P0[r]=__builtin_amdgcn_exp2f(P0[r]); }while(0)
  #define RESC() do{ if(resc){ asm volatile("s_waitcnt lgkmcnt(0)":::"memory"); \
      _Pragma("unroll") for(int d_=0;d_<2;++d_) _Pragma("unroll") for(int r=0;r<16;++r)o[d_][r]*=wsf[crow(r,hi)]; } }while(0)
  f32x16 pA0,pA1,pB0,pB1;
  int sl_prev=0,sl_cur=0,sl_next=SLOTB;
  #define ROT() do{sl_prev=sl_cur;sl_cur=sl_next;sl_next=(sl_next==(NSLOT-1)*SLOTB)?0:sl_next+SLOTB;}while(0)
  DMA_K(2,2*SLOTB);
  WAIT_BAR(3);
  qkt(pA0,pA1,Kbase,qr,negm,r32,hi);asm volatile("s_nop 15\n\ts_nop 7":"+v"(pA0),"+v"(pA1));CMASK(pA0,pA1,0);
  START(pA0,pA1);
  _Pragma("unroll") for(int r=0;r<16;++r)pA1[r]=__builtin_amdgcn_exp2f(pA1[r]);
  WAIT_BAR(0);
  DMA_K(3,0);DMA_V(1,SLOTB);
  ROT();
  kload8(kf,kp0+sl_cur);
  WAIT_BAR(2);
  s16x4 vlo[8],vhi[8]; u32x4 pw0,pw1,pw2,pw3;
  #define PKW(P,B) cvtpk_s(P[B],P[B+1])
  #define PAF(k) __builtin_bit_cast(bf16x8,pw##k)
  #define VFR(i) (bf16x8){vlo[i][0],vlo[i][1],vlo[i][2],vlo[i][3],vhi[i][0],vhi[i][1],vhi[i][2],vhi[i][3]}
  #define PIN(x) asm volatile("":"+v"(x))
  #define MX3(a,b,c) __builtin_fmaxf(__builtin_fmaxf((a),(b)),(c))
  #define GAPA(MF,A0,A1,A2,A3,W0,W1,PW) do{ MF; sacc+=A0; sacc+=A1; sacc+=A2; sacc+=A3; PIN(sacc); W0; W1; PIN(PW); SBAR(); }while(0)
  #define EX(v) __builtin_amdgcn_exp2f(v)
  #define GAPB(MF,X,B) do{ MF; X[B]=EX(X[B]); X[B+1]=EX(X[B+1]); X[B+2]=EX(X[B+2]); X[B+3]=EX(X[B+3]); PIN(X); SBAR(); }while(0)
  #define VRD(i) do{ vlo[i]=vtr(vp_+(((i)>>2)*4096+((i)&3)*1024)); vhi[i]=vtr(vp_+(((i)>>2)*4096+((i)&3)*1024+512)); }while(0)
  #define KRD(G,j) do{ if(G){ kload2(kf,kp0+sl_next,j); SBAR(); } }while(0)
  #define STEP(C0,C1,P0,P1,t,GK,GV,GL) do{ SBAR(); \
    const lds_cptr vp_=vp0+sl_prev; \
    VRD(0); SBAR(); float sacc=(P0[0]+P0[1]); \
    GAPA(C0=__builtin_amdgcn_mfma_f32_32x32x16_bf16(kf[0],qr[0],negm,0,0,0), P0[2],P0[3],P0[4],P0[5],     pw0[0]=PKW(P0,0), pw0[1]=PKW(P0,2), pw0); \
    VRD(4); SBAR(); GAPA(C1=__builtin_amdgcn_mfma_f32_32x32x16_bf16(kf[1],qr[0],negm,0,0,0), P0[6],P0[7],P0[8],P0[9],     pw0[2]=PKW(P0,4), pw0[3]=PKW(P0,6), pw0); \
    VRD(1); SBAR(); GAPA(C0=__builtin_amdgcn_mfma_f32_32x32x16_bf16(kf[2],qr[1],C0,0,0,0),   P0[10],P0[11],P0[12],P0[13], pw1[0]=PKW(P0,8), pw1[1]=PKW(P0,10), pw1); \
    VRD(5); SBAR(); GAPA(C1=__builtin_amdgcn_mfma_f32_32x32x16_bf16(kf[3],qr[1],C1,0,0,0),   P0[14],P0[15],P1[0],P1[1],   pw1[2]=PKW(P0,12),pw1[3]=PKW(P0,14), pw1); \
    VRD(2); SBAR(); GAPA(C0=__builtin_amdgcn_mfma_f32_32x32x16_bf16(kf[4],qr[2],C0,0,0,0),   P1[2],P1[3],P1[4],P1[5],     pw2[0]=PKW(P1,0), pw2[1]=PKW(P1,2), pw2); \
    VRD(6); SBAR(); GAPA(C1=__builtin_amdgcn_mfma_f32_32x32x16_bf16(kf[5],qr[2],C1,0,0,0),   P1[6],P1[7],P1[8],P1[9],     pw2[2]=PKW(P1,4), pw2[3]=PKW(P1,6), pw2); \
    VRD(3); SBAR(); GAPA(C0=__builtin_amdgcn_mfma_f32_32x32x16_bf16(kf[6],qr[3],C0,0,0,0),   P1[10],P1[11],P1[12],P1[13], pw3[0]=PKW(P1,8), pw3[1]=PKW(P1,10), pw3); \
    VRD(7); SBAR(); GAPA(C1=__builtin_amdgcn_mfma_f32_32x32x16_bf16(kf[7],qr[3],C1,0,0,0),   P1[14],P1[15],0.f,0.f,       pw3[2]=PKW(P1,12),pw3[3]=PKW(P1,14), pw3); \
    l_reg+=sacc; \
    if(GK){DMA_K((t)+3,sl_cur);} if(GV){DMA_V((t)+1,sl_next);} \
    CMASK(C0,C1,t); \
    { float a=MX3(C0[0],C0[1],C1[0]),b=MX3(C0[2],C0[3],C1[1]); a=MX3(a,C1[2],C1[3]); \
      _Pragma("unroll") for(int r=4;r<16;r+=4){a=MX3(a,C0[r],C0[r+1]);b=MX3(b,C0[r+2],C0[r+3]);a=MX3(a,C1[r],C1[r+1]);b=MX3(b,C1[r+2],C1[r+3]);} \
      float rm=__builtin_fmaxf(a,b); { auto rr=__builtin_amdgcn_permlane32_swap(__float_as_uint(rm),__float_as_uint(rm),false,false); rm=__builtin_fmaxf(__uint_as_float(rr[0]),__uint_as_float(rr[1])); } \
      resc=false; \
      if(__builtin_expect(__any(rm>(float)THRL),0)){ const float dl=__builtin_fmaxf(rm,0.f); mhat+=dl; \
        _Pragma("unroll") for(int r=0;r<16;++r){C0[r]-=dl;C1[r]-=dl;} \
        _Pragma("unroll") for(int r=0;r<16;++r)negm[r]=-mhat; asm volatile("":"+v"(negm)); \
        const float f=__builtin_amdgcn_exp2f(-dl); l_reg*=f; if(hi==0)wsf[r32]=f; resc=true; } } \
    SBAR(); \
    GAPB(o[0]=__builtin_amdgcn_mfma_f32_32x32x16_bf16(PAF(0),VFR(0),o[0],0,0,0), C0,0); \
    GAPB(o[1]=__builtin_amdgcn_mfma_f32_32x32x16_bf16(PAF(0),VFR(4),o[1],0,0,0), C0,4); \
    KRD(GL,0); GAPB(o[0]=__builtin_amdgcn_mfma_f32_32x32x16_bf16(PAF(1),VFR(1),o[0],0,0,0), C0,8); \
    KRD(GL,1); GAPB(o[1]=__builtin_amdgcn_mfma_f32_32x32x16_bf16(PAF(1),VFR(5),o[1],0,0,0), C0,12); \
    KRD(GL,2); GAPB(o[0]=__builtin_amdgcn_mfma_f32_32x32x16_bf16(PAF(2),VFR(2),o[0],0,0,0), C1,0); \
    KRD(GL,3); GAPB(o[1]=__builtin_amdgcn_mfma_f32_32x32x16_bf16(PAF(2),VFR(6),o[1],0,0,0), C1,4); \
    GAPB(o[0]=__builtin_amdgcn_mfma_f32_32x32x16_bf16(PAF(3),VFR(3),o[0],0,0,0), C1,8); \
    GAPB(o[1]=__builtin_amdgcn_mfma_f32_32x32x16_bf16(PAF(3),VFR(7),o[1],0,0,0), C1,12); \
    }while(0)
  int t=1;
  #undef CMASK
  #define CMASK(P0,P1,t) do{}while(0)
  for(;t+5<NT;t+=2){
    STEP(pB0,pB1,pA0,pA1,t,true,true,true);     WAIT_BAR(2); RESC(); ROT();
    STEP(pA0,pA1,pB0,pB1,t+1,true,true,true);   WAIT_BAR(2); RESC(); ROT();
  }
  #undef CMASK
  #define CMASK(P0,P1,t) do{}while(0)
  #define ENDW(tt) do{ if((tt)+3<NT){WAIT_BAR(2);} else if((tt)+2<NT){WAIT_BAR(1);} else {WAIT_BAR(0);} }while(0)
  for(;t+1<NT;t+=2){
    STEP(pB0,pB1,pA0,pA1,t,(t+3<NT),(t+1<NT),(t+1<NT));       ENDW(t);   RESC(); ROT();
    STEP(pA0,pA1,pB0,pB1,t+1,(t+4<NT),(t+2<NT),(t+2<NT));     ENDW(t+1); RESC(); ROT();
  }
  STEP(pB0,pB1,pA0,pA1,NT-1,false,false,false); RESC();
  { float sacc=pB0[0]+pB0[1]; _Pragma("unroll") for(int r=2;r<16;++r)sacc+=pB0[r]; _Pragma("unroll") for(int r=0;r<16;++r)sacc+=pB1[r]; l_reg+=sacc;
    pw0=(u32x4){PKW(pB0,0),PKW(pB0,2),PKW(pB0,4),PKW(pB0,6)};pw1=(u32x4){PKW(pB0,8),PKW(pB0,10),PKW(pB0,12),PKW(pB0,14)};pw2=(u32x4){PKW(pB1,0),PKW(pB1,2),PKW(pB1,4),PKW(pB1,6)};pw3=(u32x4){PKW(pB1,8),PKW(pB1,10),PKW(pB1,12),PKW(pB1,14)};
    SBAR(); pv(o,vb0+sl_cur,PAF(0),PAF(1),PAF(2),PAF(3)); }
  #undef PKW
  #undef PAF
  #undef VFR
  #undef PIN
  #undef MX3
  #undef GAPA
  #undef GAPB
  #undef EX
  #undef VRD
  #undef KRD
  #undef STEP
  #undef ENDW
  {auto rr=__builtin_amdgcn_permlane32_swap(__float_as_uint(l_reg),__float_as_uint(l_reg),false,false);l_reg=__uint_as_float(rr[0])+__uint_as_float(rr[1]);}
  if(hi==0)wsf[32+r32]=l_reg;asm volatile("s_waitcnt lgkmcnt(0)":::"memory");
  float rli[16];
  #pragma unroll
  for(int r=0;r<16;++r)rli[r]=__builtin_amdgcn_rcpf(wsf[32+crow(r,hi)]);
  bf16*Ow=Ob+(long)(wid*QBLK)*OP;
  { bf16*stg=(bf16*)(shm+LDS_OST)+wid*2048;
    #pragma unroll
    for(int r=0;r<16;++r){const int orow=crow(r,hi);
      #pragma unroll
      for(int d0=0;d0<2;++d0)stg[orow*64+d0*32+r32]=__float2bfloat16(o[d0][r]*rli[r]);}
    asm volatile("s_waitcnt lgkmcnt(0)":::"memory");
    #pragma unroll
    for(int i=0;i<4;++i){const int row=i*8+(lane>>3),ch=lane&7; const u32x4 v=*(const u32x4*)(stg+row*64+ch*8); ATTN_STORE16(Ow+(long)row*OP+ch*8,v);} }
  asm volatile("s_waitcnt lgkmcnt(0)\n\ts_barrier":::"memory");
  #undef DMA_K
  #undef DMA_V
  #undef CMASK
  #undef START
  #undef RESC
  #undef ROT
}
constexpr int ATTN_LDS_BYTES=LDS_BYTES;
#undef SBAR
#undef WAIT_BAR
}
namespace att {
__device__ __forceinline__ void unit_b(const bf16_t* PROJ, bf16_t* OBR, int b, int qh, int qb, char* lds, int wv) {
    const bf16_t* kv = PROJ + (size_t)b * SEQ * D_IN; const size_t qrow = (size_t)b * SEQ + qb * 256;
    __syncthreads();
    attd::attn_unit<8, D_IN, D_IN, OBR_W>((const attd::bf16*)(PROJ + qrow * D_IN + C_BQ + qh * 64), (const attd::bf16*)(kv + C_BK + (qh >> 2) * 64), (const attd::bf16*)(kv + C_BV + (qh >> 2) * 64),
                                          (attd::bf16*)(OBR + qrow * OBR_W + 512 + qh * 64), SEQ, lds, wv);
}
}
template <int NR, bool NORM>
__device__ __forceinline__ void rows_in(const float* __restrict__ xbase, const float* __restrict__ g, bf16_t* __restrict__ obase, float* __restrict__ rstd_out, int row0, int lane, unsigned char* __restrict__ xq = nullptr) {
    f32x4 v[NR][4];
#pragma unroll
    for (int r = 0; r < NR; ++r)
#pragma unroll
        for (int j = 0; j < 4; ++j) v[r][j] = ((const f32x4*)(xbase + (size_t)(row0 + r) * DM))[lane + 64 * j];
    f32x4 gg[4];
#pragma unroll
    for (int j = 0; j < 4; ++j) gg[j] = NORM ? ((const f32x4*)g)[lane + 64 * j] : (f32x4){1.f, 1.f, 1.f, 1.f};
#pragma unroll
    for (int r = 0; r < NR; ++r) { float s = 0.f;
#pragma unroll
        for (int j = 0; j < 4; ++j) s += v[r][j].x * v[r][j].x + v[r][j].y * v[r][j].y + v[r][j].z * v[r][j].z + v[r][j].w * v[r][j].w;
        const float rs0 = rsqrtf(wave_sum(s) * (1.f / DM) + EPS), rs = NORM ? rs0 : 1.f;
        if (!NORM && lane == 0) rstd_out[row0 + r] = rs0;
#pragma unroll
        for (int j = 0; j < 4; ++j) { u32x2 o; o.x = cvt_pk_bf16(v[r][j].x * rs * gg[j].x, v[r][j].y * rs * gg[j].y); o.y = cvt_pk_bf16(v[r][j].z * rs * gg[j].z, v[r][j].w * rs * gg[j].w);
            ((u32x2*)(obase + (size_t)(row0 + r) * XP))[lane + 64 * j] = o;
            if (!NORM) ((unsigned*)(xq + (size_t)(row0 + r) * DM))[lane + 64 * j] = pack4_fp8(v[r][j]); } }
}
__device__ __forceinline__ void route_block(const bf16_t* __restrict__ X, const bf16_t* __restrict__ rt_tab, const float* __restrict__ brg, const float* __restrict__ bre, int* __restrict__ experts, float* __restrict__ weights,
                                            int* __restrict__ rank, unsigned* __restrict__ cnt, float* __restrict__ rstd, int* __restrict__ list, const float* __restrict__ g2, unsigned char* __restrict__ XQ, int rb, const bf16x8 (&Bh)[3][4], const bf16x8 (&Bl)[3][4], LAS float* slab, int tid, int wave) {
    const int lane = tid & 63, r = lane & 15, kq = lane >> 4;
    LAS float* ssq = slab + 8 * 64 * 48; LAS float* rs_l = ssq + 8 * 64;
#pragma unroll 1
    for (int rtp = 0; rtp < 2; ++rtp) {
        bf16x8 xa[2][4];
#pragma unroll
        for (int q = 0; q < 2; ++q) { const bf16_t* xp = X + (size_t)(rb * 64 + (rtp * 2 + q) * 16 + r) * XP + 128 * wave + 8 * kq;
#pragma unroll
            for (int sI = 0; sI < 4; ++sI) xa[q][sI] = *(const bf16x8*)(xp + 32 * sI); }
        f32x4 gq[4][2];
#pragma unroll
        for (int sI = 0; sI < 4; ++sI) { gq[sI][0] = *(const f32x4*)(g2 + 128 * wave + 32 * sI + 8 * kq); gq[sI][1] = *(const f32x4*)(g2 + 128 * wave + 32 * sI + 8 * kq + 4); }
#pragma unroll
        for (int q = 0; q < 2; ++q) { const int rt = rtp * 2 + q;
            f32x4 acc[3]; float ss = 0.f;
#pragma unroll
            for (int t = 0; t < 3; ++t) acc[t] = (f32x4){0.f, 0.f, 0.f, 0.f};
#pragma unroll
            for (int sI = 0; sI < 4; ++sI) {
                const bf16x8 Ah = xa[q][sI]; f32x4 a0, a1; pg8::unpack8(__builtin_bit_cast(u32x4, Ah), a0, a1);
                ss += (a0[0] * a0[0] + a0[1] * a0[1]) + (a0[2] * a0[2] + a0[3] * a0[3]) + (a1[0] * a1[0] + a1[1] * a1[1]) + (a1[2] * a1[2] + a1[3] * a1[3]);
                *(u32x2*)(XQ + (size_t)(rb * 64 + rt * 16 + r) * DM + 128 * wave + 32 * sI + 8 * kq) = pack8_fp8(a0 * gq[sI][0], a1 * gq[sI][1]);
#pragma unroll
                for (int t = 0; t < 3; ++t) {
                    acc[t] = __builtin_amdgcn_mfma_f32_16x16x32_bf16(Ah, Bh[t][sI], acc[t], 0, 0, 0);
                    acc[t] = __builtin_amdgcn_mfma_f32_16x16x32_bf16(Ah, Bl[t][sI], acc[t], 0, 0, 0);
                }
            }
            ss += xlane<16>(ss); ss = half_sum(ss);
            if (kq == 0) ssq[wave * 64 + rt * 16 + r] = ss;
#pragma unroll
            for (int t = 0; t < 3; ++t)
#pragma unroll
                for (int e = 0; e < 4; ++e) slab[(wave * 64 + rt * 16 + 4 * kq + e) * 48 + 16 * t + r] = acc[t][e];
        }
    }
    __syncthreads();
    if (tid < 64) {
        const int row = rb * 64 + tid;
        float lg[36]; float ss = 0.f;
#pragma unroll
        for (int c = 0; c < 36; ++c) lg[c] = 0.f;
#pragma unroll 1
        for (int w = 0; w < 8; ++w) { ss += ssq[w * 64 + tid];
#pragma unroll
            for (int c = 0; c < 36; ++c) lg[c] += slab[(w * 64 + tid) * 48 + c]; }
        const float rs = rsqrtf(ss * (1.f / DM) + EPS);
        rstd[row] = rs;
        int gi = 0; float gm = lg[0] * rs + brg[0];
#pragma unroll
        for (int i = 1; i < 4; ++i) { const float l = lg[i] * rs + brg[i]; if (l > gm) { gm = l; gi = i; } }
        float gs = 0.f;
#pragma unroll
        for (int i = 0; i < 4; ++i) gs += __expf(lg[i] * rs + brg[i] - gm);
        const float gp = 1.f / gs;
        float el[8];
#pragma unroll
        for (int i = 0; i < 8; ++i) el[i] = 0.f;
#pragma unroll
        for (int gq = 0; gq < 4; ++gq) if (gq == gi) {
#pragma unroll
            for (int i = 0; i < 8; ++i) el[i] = lg[4 + gq * 8 + i] * rs + bre[gq * 8 + i]; }
        int i0 = 0; float l0 = el[0];
#pragma unroll
        for (int i = 1; i < 8; ++i) if (el[i] > l0) { l0 = el[i]; i0 = i; }
        int i1 = -1; float l1 = -INFINITY;
#pragma unroll
        for (int i = 0; i < 8; ++i) if (i != i0 && el[i] > l1) { l1 = el[i]; i1 = i; }
        const float p1 = __expf(l1 - l0), inv = 1.f / (1.f + p1);
        const int e0 = gi * 8 + i0, e1 = gi * 8 + i1;
        experts[row * 2] = e0; experts[row * 2 + 1] = e1;
        weights[row * 2] = gp * inv; weights[row * 2 + 1] = gp * p1 * inv;
        LAS unsigned* lc = (LAS unsigned*)(rs_l + 64); LAS unsigned* gb = lc + 32;
        if (tid < 32) lc[tid] = 0u;
        asm volatile("s_waitcnt lgkmcnt(0)" ::: "memory");
        unsigned q0, q1; const unsigned one = 1u, a0_ = (unsigned)(uintptr_t)(lc + e0), a1_ = (unsigned)(uintptr_t)(lc + e1);
        asm volatile("ds_add_rtn_u32 %0, %1, %2\n\ts_waitcnt lgkmcnt(0)" : "=v"(q0) : "v"(a0_), "v"(one) : "memory");
        asm volatile("ds_add_rtn_u32 %0, %1, %2\n\ts_waitcnt lgkmcnt(0)" : "=v"(q1) : "v"(a1_), "v"(one) : "memory");
        if (tid < 32) { const unsigned n = lc[tid]; gb[tid] = n ? atomicAdd(cnt + 64 * tid, n) : 0u; }
        const int r0 = (int)(gb[e0] + q0), r1 = (int)(gb[e1] + q1);
        rank[row * 2] = r0; rank[row * 2 + 1] = r1;
        list[e0 * LCAP + r0] = row * 2; list[e1 * LCAP + r1] = row * 2 + 1;
        rs_l[tid] = rs;
    }
    __syncthreads();
}
__device__ __forceinline__ void moe_tables(const unsigned* cnt, volatile LAS int* mt, int tid) {
    if (tid < 64) {
        if (tid < 32) mt[32 + tid] = (int)__hip_atomic_load(cnt + 64 * tid, __ATOMIC_RELAXED, __HIP_MEMORY_SCOPE_AGENT);
        asm volatile("s_waitcnt vmcnt(0) lgkmcnt(0)" ::: "memory");
        if (tid == 0) { int off = 0, nt = 0;
#pragma unroll 1
            for (int e = 0; e < NEXP; ++e) { const int c = mt[32 + e], t = (c + MOE_TILE - 1) / MOE_TILE;
                mt[e] = off; mt[64 + e] = nt;
#pragma unroll 1
                for (int i = 0; i < t; ++i) mt[96 + nt + i] = e;
                nt += t; off += t * MOE_TILE; }
            mt[256] = nt; }
    }
    __syncthreads();
}
__device__ __forceinline__ void moe_rowtabs(volatile LAS int* mt, const int* __restrict__ list, const float* __restrict__ weights, const float* __restrict__ rstd, LAS unsigned* rowtab, LAS float* wtab, int bx, int G, int tid, int up) {
    const int ntiles = mt[256], rem = (ntiles * 4) % G;
#pragma unroll 1
    for (int i = 0; i < 4; ++i) { const long L = up ? (long)i * G + bx : (long)pg8::moe_down_unit(bx, i, rem, G); if (L >= (long)ntiles * 4) break;
        if (tid < 256) { const int tile = (int)(L >> 2), e = mt[96 + tile], q = (tile - mt[64 + e]) * 256 + tid; const bool valid = q < mt[32 + e];
            const int a = valid ? list[e * LCAP + q] : 0;
            if (up) { rowtab[i * 256 + tid] = (unsigned)(a >> 1) * (unsigned)DM; wtab[i * 256 + tid] = valid ? rstd[a >> 1] : 0.f; }
            else wtab[i * 256 + tid] = valid ? weights[a] : -1.f; } }
    __syncthreads();
}
template <int NR>
__device__ __forceinline__ void rows_combine_norm(bf16_t* __restrict__ XB, const unsigned char* __restrict__ YB, const float* __restrict__ g, float* __restrict__ RS, float* __restrict__ OUT, const int (&row)[NR], int lane, bool poison, const int (&d0)[NR], const int (&d1)[NR], unsigned char* __restrict__ XQ) {
    u32x2 xq[NR][4]; unsigned ya[NR][4], yb[NR][4];
#pragma unroll
    for (int r = 0; r < NR; ++r)
#pragma unroll
        for (int j = 0; j < 4; ++j) { xq[r][j] = ((const u32x2*)(XB + (size_t)row[r] * XP))[lane + 64 * j];
            ya[r][j] = ((const unsigned*)(YB + (size_t)d0[r] * DM))[lane + 64 * j]; yb[r][j] = ((const unsigned*)(YB + (size_t)d1[r] * DM))[lane + 64 * j]; }
    f32x4 gg[4];
#pragma unroll
    for (int j = 0; j < 4; ++j) gg[j] = ((const f32x4*)g)[lane + 64 * j];
    f32x4 v[NR][4]; float s[NR];
#pragma unroll
    for (int r = 0; r < NR; ++r) { s[r] = 0.f;
#pragma unroll
        for (int j = 0; j < 4; ++j) { const u32x2 x = xq[r][j]; constexpr float ys = 1.f / 64.f;
            const f32x2 a0 = __builtin_amdgcn_cvt_pk_f32_fp8((int)ya[r][j], false), a1 = __builtin_amdgcn_cvt_pk_f32_fp8((int)ya[r][j], true), b0 = __builtin_amdgcn_cvt_pk_f32_fp8((int)yb[r][j], false), b1 = __builtin_amdgcn_cvt_pk_f32_fp8((int)yb[r][j], true);
            v[r][j].x = __uint_as_float(x.x << 16) + (a0[0] + b0[0]) * ys; v[r][j].y = __uint_as_float(x.x & 0xffff0000u) + (a0[1] + b0[1]) * ys;
            v[r][j].z = __uint_as_float(x.y << 16) + (a1[0] + b1[0]) * ys; v[r][j].w = __uint_as_float(x.y & 0xffff0000u) + (a1[1] + b1[1]) * ys;
            s[r] += v[r][j].x * v[r][j].x + v[r][j].y * v[r][j].y + v[r][j].z * v[r][j].z + v[r][j].w * v[r][j].w; } }
#pragma unroll
    for (int r = 0; r < NR; ++r) {
        float rs = rsqrtf(wave_sum(s[r]) * (1.f / DM) + EPS);
        if (poison) rs = __builtin_nanf("");
        if (RS && lane == 0) RS[row[r]] = rs;
#pragma unroll
        for (int j = 0; j < 4; ++j) {
            if (RS) { u32x2 xo; xo.x = cvt_pk_bf16(v[r][j].x, v[r][j].y); xo.y = cvt_pk_bf16(v[r][j].z, v[r][j].w); ((u32x2*)(XB + (size_t)row[r] * XP))[lane + 64 * j] = xo; ((unsigned*)(XQ + (size_t)row[r] * DM))[lane + 64 * j] = pack4_fp8(v[r][j]); }
            else { f32x4 o; o.x = v[r][j].x * rs * gg[j].x; o.y = v[r][j].y * rs * gg[j].y; o.z = v[r][j].z * rs * gg[j].z; o.w = v[r][j].w * rs * gg[j].w; ((f32x4*)(OUT + (size_t)row[r] * DM))[lane + 64 * j] = o; }
        }
    }
}
constexpr float W8_SCALE = 64.f;
struct TrItem { const float* src; bf16_t* dst; int ldw, K; };
template <int OFF> __device__ __forceinline__ unsigned long long karg64() { unsigned long long v; asm volatile("s_load_dwordx2 %0, %1, %2\n\ts_waitcnt lgkmcnt(0)" : "=s"(v) : "s"(__builtin_amdgcn_kernarg_segment_ptr()), "n"(OFF)); return v; }
__device__ __forceinline__ unsigned long long karg64d(int off) { unsigned long long v; asm volatile("s_load_dwordx2 %0, %1, %2\n\ts_waitcnt lgkmcnt(0)" : "=s"(v) : "s"(__builtin_amdgcn_kernarg_segment_ptr()), "s"(off)); return v; }
#define TR_IN(k) ((const float*)(const GAS float*)karg64d(8 * (k)))
__device__ __forceinline__ void tr_decode(int it, int lane, bf16_t* WB, const float*& sp, int& ldw, bf16_t*& dp, int& K, int& gofs) {
    const float* src; int segA, segB, kb, tb, dk0 = 0, gate = 0, gu = 0, f8 = 0; bf16_t* dst;
    if (it < 28800) {
        const int l = it / 14400; int r = it % 14400; bf16_t* WBl = WB + (size_t)l * WB_LAYER;
        if (r < 1472) { gu = 1; kb = r / 92; tb = r % 92; const int pn = tb >> 2, bj = (tb >> 1) & 1, w0 = 2 * (tb & 1); src = TR_IN(5) + (size_t)l * DM * D_IN; ldw = D_IN; K = DM; segA = 256 * pn + 64 * w0 + 32 * bj; segB = segA + 64; dst = WBl + WB_IN;
            if (pn >= C_G / 256) { gate = 1; f8 = 1; dst += (size_t)C_G * 512; segA = 256 * pn + 64 * w0 + 8 * bj; segB = segA + 64; } }
        else if (r < 1856) { r -= 1472; const int i = r >> 7; r &= 127; kb = r >> 4; tb = r & 15; src = TR_IN(13 + i) + (size_t)l * 512 * DM; ldw = DM; K = 1536; dk0 = 512 * i; segA = 64 * tb; segB = segA + 32; dst = WBl + WB_UP; }
        else if (r < 2112) { r -= 1856; kb = r >> 4; tb = r & 15; src = TR_IN(16) + (size_t)l * DM * DM; ldw = DM; K = DM; segA = 64 * tb; segB = segA + 32; dst = WBl + WB_OUT; }
        else if (r < 10304) { r -= 2112; const int e = r >> 8; r &= 255; kb = r >> 4; tb = r & 15; const int pn = tb >> 2, sg = (tb >> 1) & 1, jb = tb & 1;
            src = TR_IN(sg ? 23 : 22) + (size_t)(l * NEXP + e) * DM * DEXP; ldw = DEXP; K = DM; f8 = 1; segA = 128 * pn + 64 * jb; segB = segA + 32; dst = WBl + WB_GU + (size_t)e * 512 * 1024; }
        else { r -= 10304; const int e = r >> 7; r &= 127; kb = r >> 4; tb = r & 15; src = TR_IN(24) + (size_t)(l * NEXP + e) * DEXP * DM; ldw = DM; K = DEXP; f8 = 1; gate = 1; { const int pn = tb >> 2, bj = (tb >> 1) & 1, w0 = 2 * (tb & 1); segA = 256 * pn + 64 * w0 + 8 * bj; segB = segA + 64; } dst = WBl + WB_DN + (size_t)e * 512 * 512; }
    } else { const int r = it - 28800; kb = r >> 4; tb = r & 15; const int pn = tb >> 2, bj = (tb >> 1) & 1, w0 = 2 * (tb & 1); src = TR_IN(3); ldw = 1024; K = DM; segA = 256 * pn + 64 * w0 + 32 * bj; segB = segA + 64; dst = WB + WB_MEMKV; }
    const int q = lane & 15;
    const int q7 = q & 7, seg = q < 8 ? segA : segB;
    sp = src + (size_t)(kb * 64 + (lane >> 4)) * ldw + seg + (gate ? 16 * (q7 >> 1) + 4 * (q7 & 1) : 4 * q7);
    dp = dst + (((size_t)(64 * tb + (lane >> 3)) * K + dk0 + kb * 64 + 8 * (lane & 7)) >> f8);
    K |= f8 << 18;
    gofs = gu ? kb * 64 + (lane >> 4) : -1;
}
__device__ __forceinline__ void tr_load(f32x4 (&v)[16], const float* sp, int ldw) {
#pragma unroll
    for (int i = 0; i < 16; ++i) v[i] = *(const f32x4*)(sp + (size_t)(4 * i) * ldw);
}
__device__ __forceinline__ void tr_store(const f32x4 (&v)[16], bf16_t* dp, int K, LAS float* scr, int lane, int gofs, const LAS float* gt) {
    const int q = lane & 15, kq = lane >> 4; const int f8 = K >> 18; K &= 0x3FFFF;
#pragma unroll
    for (int i = 0; i < 16; ++i) *(LAS f32x4*)(scr + (4 * i + kq) * 64 + ((q ^ (2 * (i >> 1))) << 2)) = v[i];
    const int c = lane & 7, n8 = lane >> 3;
    f32x4 g0 = {1.f, 1.f, 1.f, 1.f}, g1 = g0;
    if (gofs >= 0) { const LAS float* gp = gt + (gofs - kq) + 8 * c; g0 = *(const LAS f32x4*)gp; g1 = *(const LAS f32x4*)(gp + 4); }
    if (f8) { g0 = g0 * W8_SCALE; g1 = g1 * W8_SCALE; }
    asm volatile("s_waitcnt lgkmcnt(0)" ::: "memory");
    const LAS float* sB = scr + (8 * c) * 64;
    if (f8) {
#pragma unroll
        for (int j = 0; j < 8; ++j) { const LAS float* sI = sB + ((n8 + 8 * j) ^ (8 * c));
            const f32x4 v0 = {sI[0 * 64] * g0[0], sI[1 * 64] * g0[1], sI[2 * 64] * g0[2], sI[3 * 64] * g0[3]}, v1 = {sI[4 * 64] * g1[0], sI[5 * 64] * g1[1], sI[6 * 64] * g1[2], sI[7 * 64] * g1[3]};
            *(u32x2*)((unsigned char*)dp + (size_t)(8 * j) * K) = pack8_fp8(v0, v1); }
    } else
#pragma unroll
    for (int j = 0; j < 8; ++j) { const LAS float* sI = sB + ((n8 + 8 * j) ^ (8 * c));
        u32x4 o; o.x = cvt_pk_bf16(sI[0 * 64] * g0[0], sI[1 * 64] * g0[1]); o.y = cvt_pk_bf16(sI[2 * 64] * g0[2], sI[3 * 64] * g0[3]); o.z = cvt_pk_bf16(sI[4 * 64] * g1[0], sI[5 * 64] * g1[1]); o.w = cvt_pk_bf16(sI[6 * 64] * g1[2], sI[7 * 64] * g1[3]);
        *(u32x4*)(dp + (size_t)(8 * j) * K) = o; }
    asm volatile("s_waitcnt lgkmcnt(0)" ::: "memory");
}

__device__ __forceinline__ int tr_item(int mode, int q) {
    return mode == 1 ? (q < 1472 ? q : q - 1472 + 28800) : mode == 4 ? q + 14400 : mode == 2 ? q + 1472 : q + 16512; }
__device__ __forceinline__ void tr_run(int mode, int q0, int qend, int qstride, bf16_t* WB, LAS float* scr, int lane, const float* gains, LAS float* gt) {
    __syncthreads();
    if (gains) {
#pragma unroll
        for (int j = 0; j < 16; ++j) gt[lane + 64 * j] = gains[lane + 64 * j];
        asm volatile("s_waitcnt lgkmcnt(0)" ::: "memory"); }
    f32x4 ra[16], rb[16], rc[16]; const float* sp; int ldw; unsigned da, ma, db, mb, dc, mc;
    if (q0 >= qend) return;
    const int qlast = q0 + ((qend - 1 - q0) / qstride) * qstride;
#define TR_LD(R, DD, MM, QQ) do { const int qn_ = (QQ) <= qlast ? (QQ) : qlast; bf16_t* dp_; int K_, g_; tr_decode(tr_item(mode, qn_), lane, WB, sp, ldw, dp_, K_, g_); \
        DD = (unsigned)(dp_ - WB); MM = ((unsigned)K_ << 12) | (unsigned)(g_ + 1); tr_load(R, sp, ldw); } while (0)
#define TR_ST(R, DD, MM) tr_store(R, WB + DD, (int)(MM >> 12), scr, lane, (int)(MM & 4095u) - 1, gt)
    int q = q0;
    TR_LD(ra, da, ma, q); TR_LD(rb, db, mb, q + qstride);
    for (;;) {
        TR_LD(rc, dc, mc, q + 2 * qstride); TR_ST(ra, da, ma); q += qstride; if (q > qlast) break;
        TR_LD(ra, da, ma, q + 2 * qstride); TR_ST(rb, db, mb); q += qstride; if (q > qlast) break;
        TR_LD(rb, db, mb, q + 2 * qstride); TR_ST(rc, dc, mc); q += qstride; if (q > qlast) break;
    }
#undef TR_ST
#undef TR_LD
}
#define XB_TMO      128
#define XB_XCNT(j)  (256  + 64 * (j))
#define XB_XSUB(j)  (1280 + 64 * (j))
#define XB_XGEN(j)  (2304 + 64 * (j))
#define XB_TOP      3328
#define XB_TOPGEN   3392
#define XCD_BAR_WORDS 3456
#define XB_SPIN_CAP (1u << 18)

__device__ __forceinline__ unsigned xb_ld(unsigned* p)              { return __hip_atomic_load(p, __ATOMIC_RELAXED, __HIP_MEMORY_SCOPE_AGENT); }
__device__ __forceinline__ unsigned xb_add(unsigned* p, unsigned v) { return __hip_atomic_fetch_add(p, v, __ATOMIC_RELAXED, __HIP_MEMORY_SCOPE_AGENT); }
__device__ __forceinline__ unsigned xb_xcc_id() { return (unsigned)__builtin_amdgcn_s_getreg((3 << 11) | 20) & 0xFu; }
#define XB_SPIN(cond, bar) do { unsigned _sp = 0; while (cond) { __builtin_amdgcn_s_sleep(1); \
    if ((++_sp & 255u) == 0u) { if (xb_ld(&(bar)[XB_TMO])) break; if (_sp > XB_SPIN_CAP) { atomicAdd(&(bar)[XB_TMO], 1u); break; } } } } while (0)

struct XcdBarrier {
    unsigned* bar; unsigned x; unsigned w0;
    volatile LAS unsigned* st;
};

__device__ __forceinline__ XcdBarrier xcd_barrier_post(unsigned* bar, volatile LAS unsigned* st, unsigned is_wave0) {
    XcdBarrier b; b.bar = bar; b.x = xb_xcc_id(); b.st = st; b.w0 = is_wave0;
    if (is_wave0 && lane_id() == 0) (void)xb_add(&bar[XB_XCNT(b.x)], 1u);
    return b;
}
__device__ __forceinline__ void xcd_barrier_complete(unsigned* bar, unsigned x, unsigned& nloc, unsigned& nx) {
    const unsigned G = gridDim.x * gridDim.y * gridDim.z;
    unsigned sum, cnt, mine, sp = 0u;
    for (;;) {
        sum = 0u; cnt = 0u; mine = 0u;
#pragma unroll
        for (unsigned j = 0; j < 16; ++j) { const unsigned c = xb_ld(&bar[XB_XCNT(j)]); sum += c; cnt += (c > 0u) ? 1u : 0u; mine = (j == x) ? c : mine; }
        if (sum == G) break;
        __builtin_amdgcn_s_sleep(1);
        if ((++sp & 255u) == 0u) { if (xb_ld(&bar[XB_TMO])) break; if (sp > XB_SPIN_CAP) { atomicAdd(&bar[XB_TMO], 1u); break; } }
    }
    nloc = mine > 0u ? mine : 1u; nx = cnt > 0u ? cnt : 1u;
}

__device__ __forceinline__ void xcd_barrier(const XcdBarrier& b) {
    asm volatile("s_waitcnt vmcnt(0)" ::: "memory");
    __syncthreads();
    if (b.w0 && lane_id() == 0) {
        unsigned* bar = b.bar;
        __builtin_amdgcn_s_waitcnt(0);
        unsigned nloc = b.st[0], nx = b.st[1];
        if (nloc == 0u) { xcd_barrier_complete(bar, b.x, nloc, nx); b.st[0] = nloc; b.st[1] = nx; }
        const unsigned old = xb_add(&bar[XB_XSUB(b.x)], 1u);
        const unsigned gen = old / nloc;
        if (old + 1u == (gen + 1u) * nloc) {
            __builtin_amdgcn_fence(__ATOMIC_RELEASE, "agent");
            asm volatile("s_waitcnt vmcnt(0)" ::: "memory");
            const unsigned og = xb_add(&bar[XB_TOP], 1u);
            const unsigned tg = og / nx;
            if (og + 1u == (tg + 1u) * nx) xb_add(&bar[XB_TOPGEN], 1u);
            else XB_SPIN(xb_ld(&bar[XB_TOPGEN]) == tg, bar);
            __builtin_amdgcn_fence(__ATOMIC_ACQUIRE, "agent");
            xb_add(&bar[XB_XGEN(b.x)], 1u);
            asm volatile("s_waitcnt vmcnt(0)" ::: "memory");
        } else {
            XB_SPIN(xb_ld(&bar[XB_XGEN(b.x)]) == gen, bar);
            __builtin_amdgcn_fence(__ATOMIC_ACQUIRE, "agent");
            asm volatile("s_waitcnt vmcnt(0)" ::: "memory");
        }
    }
    __syncthreads();
}
constexpr int NWAVES = 8;
constexpr int RING_BYTES = 131072, GT_OFF = 133120  , LDSCTL_OFF = 137216, LDS_BYTES = 147456;
constexpr int CW_BAR = 4096, BAR_REGION = 4096;
static_assert(XCD_BAR_WORDS <= BAR_REGION && (CW_BAR + (N_PHASES + 1) * BAR_REGION) * 4 <= (int)MiB, "barrier regions inside the memset region");
static_assert(pg8::STAGE_BYTES <= RING_BYTES && att::Lay<64, 128>::OFF_STASH + 65536 <= RING_BYTES && att::Lay<128, 128>::OFF_WS + 2048 <= RING_BYTES && LDSCTL_OFF + 10240 <= LDS_BYTES, "LDS map");

struct Args { const float* in[26]; float* out; unsigned char* ws; int ph_lo, ph_hi, li, pad; };
#define KIN(k) ((const float*)(const GAS float*)karg64<8 * (k)>())
#define KOUT ((float*)(GAS float*)karg64<208>())
#define KWS ((unsigned char*)(GAS unsigned char*)karg64<216>())
static_assert(offsetof(Args, out) == 208 && offsetof(Args, ws) == 216 && offsetof(Args, ph_lo) == 224, "Args layout vs the kernarg offsets above");

__global__ void __launch_bounds__(NWAVES * 64, 2) mk_fwd(Args args) {
    extern __shared__ __attribute__((aligned(16))) unsigned char lds[];
    asm volatile("s_setreg_imm32_b32 hwreg(HW_REG_MODE, 23, 1), 1");
    const int wave = __builtin_amdgcn_readfirstlane((int)threadIdx.x >> 6);
#define lane0 lane_id()
#define tid0 (wave * 64 + lane_id())
    const int G = gridDim.x, bx = blockIdx.x, vcu = (G % 8 == 0) ? (bx % 8) * (G / 8) + bx / 8 : bx;
    constexpr int NCX = 4, NCV = 8 * NCX, NWK = 256 - NCV;
    const bool split = (G == 256); const int idx8 = bx >> 3, xcd8 = bx & 7;
    const bool conv = split && (idx8 >= 32 - NCX);
    const int wk = (idx8 << 3) | xcd8, cvw = ((((idx8 - (32 - NCX)) << 3) | xcd8) * NWAVES) + wave;
    LAS unsigned char* ldsl = (LAS unsigned char*)lds;
    volatile LAS unsigned* MISC = (volatile LAS unsigned*)(ldsl + LDSCTL_OFF);
    for (int u = tid0; u < (LDS_BYTES - LDSCTL_OFF) / 4; u += NWAVES * 64) ((LAS unsigned*)(ldsl + LDSCTL_OFF))[u] = 0u;
    __syncthreads();
    XcdBarrier bar = xcd_barrier_post((unsigned*)(KWS + WS_CTL) + CW_BAR + args.li * BAR_REGION, MISC + 8, wave == 0 ? 1u : 0u);
#define P_WS unsigned char* ws = KWS; unsigned* ctl = (unsigned*)(ws + WS_CTL); (void)ctl
#define P_ACT bf16_t* MEMKV = (bf16_t*)(ws + WS_MEMKV); bf16_t* HM = (bf16_t*)(ws + WS_HM); bf16_t* PROJ = (bf16_t*)(ws + WS_PROJ); bf16_t* OBR = (bf16_t*)(ws + WS_OBR); bf16_t* HMEM = OBR; \
    bf16_t* BUF = (bf16_t*)(ws + WS_BUF); bf16_t* YB = (bf16_t*)(ws + WS_YB); bf16_t* HID = (bf16_t*)(ws + WS_HID); bf16_t* WB = (bf16_t*)(ws + WS_WB); const bf16_t* WBl = WB + (size_t)l_ * WB_LAYER; \
    (void)MEMKV; (void)HM; (void)PROJ; (void)OBR; (void)HMEM; (void)BUF; (void)YB; (void)HID; (void)WBl
#define P_ROUTE int* experts = (int*)(ws + WS_ROUTE + RT_EXP); float* weights = (float*)(ws + WS_ROUTE + RT_WGT); int* rank = (int*)(ws + WS_ROUTE + RT_RANK); float* rstd = (float*)(ws + WS_ROUTE + RT_RSTD); \
    (void)experts; (void)weights; (void)rank; (void)rstd
    const int gw = bx * NWAVES + wave, NGW = G * NWAVES;
    const int lo = args.ph_lo, hi = args.ph_hi;
#ifndef STAGE_MASK
#define STAGE_MASK 0x3FFu
#endif
#define IN(k) (lo <= (k) && (k) < hi)
#define ST(s) ((STAGE_MASK >> (s)) & 1u)
#ifndef REP_MASK
#define REP_MASK 0u
#endif
#define NREP(s) (((REP_MASK >> (s)) & 1u) ? 2 : 1)
#ifndef REP_A
#define REP_A 1
#endif
#ifndef REP_B
#define REP_B 1
#endif
#ifndef DBL_BAR
#define DBL_BAR 0
#endif
#define SEAM(k) do { if (IN(k) && IN((k) + 1)) { xcd_barrier(bar); if (DBL_BAR) xcd_barrier(bar); } } while (0)

    if (ST(0) && IN(0))
  for (int rep_ = 0; rep_ < NREP(0); ++rep_) {
        int lane = lane0, tid = tid0; asm volatile("" : "+v"(lane), "+v"(tid));
        constexpr int l_ = 0; P_WS; P_ACT;
        float* tab1 = (float*)(ws + WS_TAB); float* tab2 = tab1 + SEQ * 32 * 2;
        const float* x = KIN(0); const float* mem = KIN(1); const float* mem_g = KIN(2); const float* norm1_g = KIN(4); const float* norm2_g = KIN(17); const float* w_rg = KIN(18); const float* w_re = KIN(20);
        LAS float* scr = (LAS float*)(ldsl + wave * 16640);
#pragma unroll 1
        for (int ci = 0; ci < (split ? 2 : 4); ++ci) {
            const int md = ci == 0 ? 1 : ci == 1 ? 4 : ci;
            tr_run(md, gw, md == 1 ? 1728 : md == 4 ? 2112 : md == 2 ? 12928 : 12288, NGW, WB, scr, lane, md == 1 ? norm1_g : md == 4 ? norm1_g + DM : nullptr, (LAS float*)(ldsl + GT_OFF)); }
        tid = tid0; lane = lane0; asm volatile("" : "+v"(lane), "+v"(tid));
        for (int idx = bx * (NWAVES * 64) + tid; idx < SEQ * 32; idx += G * NWAVES * 64) { const int pos = idx >> 5, i = idx & 31; float s, c;
            sincosf((float)pos * inv1d(i), &s, &c); tab1[idx * 2] = c; tab1[idx * 2 + 1] = s;
            sincosf(ang2d(pos, i), &s, &c); tab2[idx * 2] = c; tab2[idx * 2 + 1] = s; }
        for (int idx = bx * (NWAVES * 64) + tid; idx < DEPTH * 48 * 1024; idx += G * NWAVES * 64) { const int l = idx / (48 * 1024), c = (idx >> 10) % 48, k = idx & 1023;
            const float w = c < 4 ? w_rg[((size_t)l * DM + k) * 4 + c] : c < 36 ? w_re[((size_t)l * DM + k) * 32 + (c - 4)] : 0.f, v = w * norm2_g[l * DM + k];
            const bf16_t h = f2bf(v); bf16_t* t = WB + WB_RT + (size_t)l * 2 * 48 * 1024 + (size_t)c * 1024 + k; t[0] = h; t[48 * 1024] = f2bf(v - bf2f(h)); }
        for (int m = 4 * gw; m < M; m += 4 * NGW) rows_in<4, false>(x, nullptr, (bf16_t*)KOUT, (float*)(ws + WS_ROUTE + RT_RSTD1), m, lane, (unsigned char*)HM);
        for (int m = gw; m < MM; m += NGW) rows_in<1, true>(mem, mem_g, HMEM, nullptr, m, lane);
    }
    SEAM(0);
#pragma unroll 1
    for (int l = 0; l < DEPTH; ++l) {
        const int pb = 1 + 9 * l, l_ = l;
        const bool l0s = false;
        if (ST(1) && IN(pb + 0))
      for (int rep_ = 0; rep_ < NREP(1); ++rep_) {
            P_WS; P_ACT; float* tab1 = (float*)(ws + WS_TAB); float* tab2 = tab1 + SEQ * 32 * 2; const float* qn_g = KIN(11); const float* kn_g = KIN(12);
            constexpr int NMAIN = (M / 256) * pg8::NPT;
            for (int rA_ = 0; rA_ < REP_A; ++rA_)
            { pg8::Gemm g{XP, DM};
              pg8::SchedProj S{bx, G, NMAIN, l == 0 ? NMAIN + 32 : NMAIN, (const char*)KOUT, (const char*)(WBl + WB_IN), (const char*)HMEM, (const char*)(WB + WB_MEMKV)};
              pg8::EpiProj E{PROJ, MEMKV, tab1, tab2, qn_g + l * 64, kn_g + l * 64, (const float*)(ws + WS_ROUTE + RT_RSTD1)};
              pg8::gemm_phase<pg8::EpiProj, pg8::SchedProj, true, true>(ldsl, g, S, E, wave); }
            for (int rB_ = 0; rB_ < REP_B; ++rB_)
            { pg8::Gemm g{DM / 2, DM / 2, 0x7C7C7C7C};
              pg8::SchedGate8 S{bx, G, l == 0 ? 28 : 24, (const char*)HM, (const char*)(WBl + WB_IN) + (size_t)C_G * 2048};
              pg8::EpiSig E{PROJ, (const float*)(ws + WS_ROUTE + RT_RSTD1)};
              pg8::gemm_phase<pg8::EpiSig, pg8::SchedGate8, true, true, false, true>(ldsl, g, S, E, wave); }
        }
        SEAM(pb + 0);
        if (ST(2) && IN(pb + 1))
      for (int rep_ = 0; rep_ < NREP(2); ++rep_) {
            LAS float* lamp = (LAS float*)(ldsl + LDSCTL_OFF + 128);
            if (split) {
            P_WS; P_ACT; const float* lq1 = KIN(6); const float* lk1 = KIN(7); const float* lq2 = KIN(8); const float* lk2 = KIN(9); const float* subln_g = KIN(10); const float* norm2_g = KIN(17);
            { int lane = lane0; asm volatile("" : "+v"(lane)); const float li_ = 0.8f - 0.6f * __expf(-0.3f * (float)l);
              const float lam_ = __expf(wave_sum(lq1[l * 64 + lane] * lk1[l * 64 + lane])) - __expf(wave_sum(lq2[l * 64 + lane] * lk2[l * 64 + lane])) + li_; lamp[0] = lam_; lamp[1] = li_; }
            const int slot = idx8 & 3, j = vcu;
#pragma unroll 1
            for (int st = 0; st < 4; ++st) {
                int wv_ = wave; asm volatile("" : "+s"(wv_));
                if (st == slot) { int lane = wv_ * 0 + lane0; asm volatile("" : "+v"(lane)); tr_run(2 + l, bx * NWAVES + wv_, l == 0 ? 12928 : 12288, NGW, WB, (LAS float*)(ldsl + wv_ * 16640), lane, nullptr, (LAS float*)(ldsl + GT_OFF)); }
                if (st == 0) att::unit_a(PROJ, OBR, j >> 5, (j >> 3) & 3, j & 7, lamp, subln_g + l * 128, (char*)lds, wv_);
                else if (st == 1) {
#pragma unroll 1
                    for (int i = 0; i < 2; ++i) { const int jb = 2 * j + i; att::unit_b(PROJ, OBR, jb >> 6, (jb >> 3) & 7, jb & 7, (char*)lds, wv_); } }
                else if (st == 2) att::unit_c(PROJ, MEMKV, OBR, j >> 5, (j >> 3) & 3, j & 7, (char*)lds, wv_);
            }
            __syncthreads();
            } else {
            const int lane = lane0;
            P_WS; P_ACT; const float* lq1 = KIN(6); const float* lk1 = KIN(7); const float* lq2 = KIN(8); const float* lk2 = KIN(9); const float* subln_g = KIN(10);
            { const float li_ = 0.8f - 0.6f * __expf(-0.3f * (float)l); lamp[0] = __expf(wave_sum(lq1[l * 64 + lane] * lk1[l * 64 + lane])) - __expf(wave_sum(lq2[l * 64 + lane] * lk2[l * 64 + lane])) + li_; lamp[1] = li_; }
            constexpr int NS = NWK - NCV, NB3 = 512 - 2 * NS, NCW = NS - NB3;
            static_assert(NB3 >= 0 && NB3 <= NS && NCW > 0 && NB3 / 2 + 3 * NCW == 256, "attention deal");
            for (int jj = l0s ? 0 : vcu; jj < (l0s ? 1 : 256); jj += (l0s ? 1 : G)) {
                const int w = wk - NCV, wc_ = w - NB3;
                const int c_lo = !l0s || wk < NCV ? 0 : w < NB3 ? (w >> 1) : NB3 / 2 + 3 * wc_, c_hi = !l0s || wk < NCV ? 0 : w < NB3 ? (w >> 1) + (w & 1) : NB3 / 2 + 3 * wc_ + 3;
                const int na = l0s ? (wk < NCV ? 2 : 1) : 1, nb = l0s ? (wk < NCV ? 0 : (w < NB3 ? 3 : 2)) : 2, nc = l0s ? c_hi - c_lo : 1;
#pragma unroll 1
                for (int i = 0; i < na; ++i) { const int j = l0s ? (i == 0 ? wk : NWK + wk) : jj; att::unit_a(PROJ, OBR, j >> 5, (j >> 3) & 3, j & 7, lamp, subln_g + l * 128, (char*)lds, wave); }
#pragma unroll 1
                for (int i = 0; i < nb; ++i) { const int j = l0s ? (i < 2 ? 2 * w + i : 2 * NS + w) : 2 * jj + i; att::unit_b(PROJ, OBR, j >> 6, (j >> 3) & 7, j & 7, (char*)lds, wave); }
#pragma unroll 1
                for (int i = 0; i < nc; ++i) { const int j = l0s ? c_lo + i : jj; att::unit_c(PROJ, MEMKV, OBR, j >> 5, (j >> 3) & 3, j & 7, (char*)lds, wave); }
            }
            __syncthreads();
            }
        }
        SEAM(pb + 1);
        if (ST(3) && IN(pb + 2))
      for (int rep_ = 0; rep_ < NREP(3); ++rep_) {
            P_WS; P_ACT;
            pg8::Gemm g{OBR_W, OBR_W};
            pg8::SchedPlain S{bx, G, M / 256, (const char*)OBR, (const char*)(WBl + WB_UP), (size_t)256 * OBR_W * 2, (size_t)256 * OBR_W * 2};
            pg8::EpiGate E{HM, PROJ};
            pg8::gemm_phase<pg8::EpiGate, pg8::SchedPlain, true, true>(ldsl, g, S, E, wave);
        }
        SEAM(pb + 2);
        if (ST(4) && IN(pb + 3)) {
            P_WS; P_ACT; bf16_t* XB = (bf16_t*)KOUT;
            pg8::Gemm g{DM, DM};
            pg8::SchedPlain S{bx, G, M / 256, (const char*)HM, (const char*)(WBl + WB_OUT), (size_t)256 * DM * 2, (size_t)256 * DM * 2};
            pg8::EpiResid E{XB};
            pg8::gemm_phase<pg8::EpiResid, pg8::SchedPlain, true, true>(ldsl, g, S, E, wave);
        }
        SEAM(pb + 3);
        if (ST(5) && IN(pb + 4)) {
            int tid = tid0; asm volatile("" : "+v"(tid));
            const int lane = tid & 63;
            P_WS; P_ACT; P_ROUTE; const bf16_t* X = (const bf16_t*)KOUT; const float* b_rg = KIN(19); const float* b_re = KIN(21); const float* norm2_g = KIN(17);
            const bf16_t* tab = WB + WB_RT + (size_t)l * 2 * 48 * 1024 + (size_t)(lane & 15) * 1024 + 128 * wave + 8 * (lane >> 4);
            bf16x8 Bh[3][4], Bl[3][4];
#pragma unroll
            for (int t = 0; t < 3; ++t)
#pragma unroll
                for (int sI = 0; sI < 4; ++sI) { Bh[t][sI] = *(const bf16x8*)(tab + (size_t)t * 16 * 1024 + 32 * sI); Bl[t][sI] = *(const bf16x8*)(tab + (size_t)(48 + t * 16) * 1024 + 32 * sI); }
            for (int rb = bx; rb < M / 64; rb += G)
                route_block(X, tab, b_rg + l * 4, b_re + l * 32, experts, weights, rank, ctl + CW_CNT + 2048 * l, rstd, (int*)BUF, norm2_g + l * DM, (unsigned char*)HM, rb, Bh, Bl, (LAS float*)ldsl, tid, wave);
        }
        SEAM(pb + 4);
        volatile LAS int* mt = (volatile LAS int*)(ldsl + LDSCTL_OFF + 256);
        LAS unsigned* rowtab = (LAS unsigned*)(ldsl + LDSCTL_OFF + 2048); LAS float* wtab = (LAS float*)(ldsl + LDSCTL_OFF + 6144);
        if (ST(7) && IN(pb + 6)) {
            int tid = tid0; asm volatile("" : "+v"(tid));
            P_WS; P_ACT; P_ROUTE;
            moe_tables(ctl + CW_CNT + 2048 * l, mt, tid);
            moe_rowtabs(mt, (const int*)BUF, weights, rstd, rowtab, wtab, vcu, G, tid, 1);
            const int ntiles = __builtin_amdgcn_readfirstlane(mt[256]);
            pg8::Gemm g{DM / 2, DM / 2, 0x7C7C7C7C};
            pg8::SchedMoeUp S{vcu, G, ntiles, (const LAS int*)(ldsl + LDSCTL_OFF + 256 + 96 * 4), (const char*)HM, (const char*)(WBl + WB_GU), ctl + CW_TCNT + l * 160 * 64};
            pg8::EpiSilu E{(unsigned char*)HID, wtab};
            pg8::gemm_phase<pg8::EpiSilu, pg8::SchedMoeUp, true, true, true, true>(ldsl, g, S, E, wave, rowtab);
        }
        if (ST(8) && IN(pb + 7)) {
            int tid = tid0; asm volatile("" : "+v"(tid));
            P_WS; P_ACT; P_ROUTE;
            if (!(ST(7) && IN(pb + 6))) moe_tables(ctl + CW_CNT + 2048 * l, mt, tid);
            moe_rowtabs(mt, (const int*)BUF, weights, rstd, rowtab, wtab, vcu, G, tid, 0);
            const int ntiles = __builtin_amdgcn_readfirstlane(mt[256]);
            pg8::Gemm g{DEXP / 2, DEXP / 2, 0x7E7E7E7E};
            pg8::SchedMoeDown S{vcu, G, ntiles, (ntiles * 4) % G, wave, (const LAS int*)(ldsl + LDSCTL_OFF + 256 + 96 * 4), (const char*)HID, (const char*)(WBl + WB_DN), ctl + CW_TCNT + l * 160 * 64, ctl + CW_TMO};
            pg8::EpiRowScale E{(unsigned char*)YB, wtab};
            pg8::gemm_phase<pg8::EpiRowScale, pg8::SchedMoeDown, true, true, false, true>(ldsl, g, S, E, wave);
        }
        SEAM(pb + 7);
        if (ST(9) && IN(pb + 8)) {
            int lane = lane0; asm volatile("" : "+v"(lane));
            P_WS; P_ACT; P_ROUTE; float* OUTP = KOUT; bf16_t* XB = (bf16_t*)OUTP; const float* norm1_g = KIN(4); const float* final_g = KIN(25);
            const bool last = (l == DEPTH - 1);
            const bool poison = last && ((__hip_atomic_load(ctl + CW_BAR + args.li * BAR_REGION + XB_TMO, __ATOMIC_RELAXED, __HIP_MEMORY_SCOPE_AGENT) | __hip_atomic_load(ctl + CW_TMO, __ATOMIC_RELAXED, __HIP_MEMORY_SCOPE_AGENT)) != 0u);
            if (!(ST(7) && IN(pb + 6)) && !(ST(8) && IN(pb + 7))) moe_tables(ctl + CW_CNT + 2048 * l, mt, tid0);
            static_assert(M % 4 == 0, "rows come in fours");
            for (int m = 4 * gw; m < M; m += 4 * NGW) {
                const u32x4 ex0 = *(const u32x4*)(experts + 2 * m), ex1 = *(const u32x4*)(experts + 2 * m + 4), rk0 = *(const u32x4*)(rank + 2 * m), rk1 = *(const u32x4*)(rank + 2 * m + 4);
                const int rows[4] = {m, m + 1, m + 2, m + 3};
                const int d0[4] = {mt[ex0.x] + (int)rk0.x, mt[ex0.z] + (int)rk0.z, mt[ex1.x] + (int)rk1.x, mt[ex1.z] + (int)rk1.z}, d1[4] = {mt[ex0.y] + (int)rk0.y, mt[ex0.w] + (int)rk0.w, mt[ex1.y] + (int)rk1.y, mt[ex1.w] + (int)rk1.w};
                rows_combine_norm<4>(XB, (const unsigned char*)YB, final_g, last ? nullptr : (float*)(ws + WS_ROUTE + RT_RSTD1), OUTP, rows, lane, poison, d0, d1, (unsigned char*)HM); }
        }
        SEAM(pb + 8);
    }
#undef IN
#undef SEAM
#undef lane0
#undef tid0
#undef P_WS
#undef P_ACT
#undef P_ROUTE
}

extern "C" void kernel_launch(void* const* d_in, const int* in_sizes, int n_in, void* d_out, int out_size, void* d_ws, size_t ws_size, hipStream_t stream) {
    if (n_in != 26 || in_sizes[0] != M * DM || out_size != M * DM || ws_size < WS_END) { fprintf(stderr, "kernel_launch: unexpected shapes n_in %d out %d ws %zu (need %zu)\n", n_in, out_size, ws_size, (size_t)WS_END); return; }
    static int grid = 0;
    if (grid == 0) {
        int dev = 0, cus = 0;
        if (hipGetDevice(&dev) != hipSuccess || hipDeviceGetAttribute(&cus, hipDeviceAttributeMultiprocessorCount, dev) != hipSuccess) { grid = -1; return; }
        if (hipFuncSetAttribute((const void*)mk_fwd, hipFuncAttributeMaxDynamicSharedMemorySize, LDS_BYTES) != hipSuccess) { fprintf(stderr, "kernel_launch: hipFuncSetAttribute failed\n"); grid = -1; return; }
        int per_cu = 0;
        if (hipOccupancyMaxActiveBlocksPerMultiprocessor(&per_cu, (const void*)mk_fwd, NWAVES * 64, LDS_BYTES) != hipSuccess || per_cu < 1) fprintf(stderr, "kernel_launch: occupancy query says %d\n", per_cu);
        (void)hipGetLastError();
        grid = cus;
    }
    if (grid < 0) return;
    (void)hipMemsetAsync((unsigned char*)d_ws + WS_CTL, 0, MiB, stream);
    Args a{};
    for (int i = 0; i < 26; ++i) a.in[i] = (const float*)d_in[i];
    a.out = (float*)d_out; a.ws = (unsigned char*)d_ws; a.ph_lo = 0; a.ph_hi = N_PHASES; a.li = 0; a.pad = 0;
    hipLaunchKernelGGL(mk_fwd, dim3(grid), dim3(NWAVES * 64), LDS_BYTES, stream, a);
}
```

```cpp
#include <hip/hip_runtime.h>
#include <cstdint>
#include <cstdio>
#include <cmath>
#include <cstddef>

typedef unsigned short bf16_t;
typedef float f32x4 __attribute__((ext_vector_type(4)));
typedef unsigned u32x4 __attribute__((ext_vector_type(4)));
typedef unsigned u32x2 __attribute__((ext_vector_type(2)));

constexpr int BATCH = 8, SEQ = 2048, DM = 1024, DEPTH = 2, MEM_LEN = 256;
constexpr int M = BATCH * SEQ;
constexpr int MM = BATCH * MEM_LEN;
constexpr int D_IN = 5888;
constexpr int C_AQ = 0, C_AK = 512, C_AV = 1024, C_BQ = 1536, C_BK = 2048, C_BV = 2176, C_CQ = 2304, C_G = 2816;
constexpr int OBR_W = 1536;
constexpr int NEXP = 32, DEXP = 512;
constexpr int MOE_TILE = 256;
constexpr int P_ROWS = M * 2 + NEXP * MOE_TILE;
constexpr int MAX_TILES = P_ROWS / MOE_TILE;
constexpr float EPS = 1e-6f;
constexpr float LOG2E = 1.4426950408889634f;
constexpr float C2_64 = 0.125f * LOG2E;
constexpr float C2_128 = 0.08838834764831845f * LOG2E;

constexpr size_t MiB = 1u << 20;
constexpr size_t WS_CTL = 0;
constexpr size_t WS_ROUTE = 1 * MiB;
constexpr size_t WS_TAB = 2 * MiB;
constexpr size_t WS_MEMKV = 3 * MiB;
constexpr size_t WS_HM = 7 * MiB;
constexpr size_t WS_PROJ = 39 * MiB;
constexpr size_t WS_OBR = 223 * MiB;
constexpr size_t WS_WB = 271 * MiB;
constexpr size_t WS_END = 499 * MiB;
constexpr size_t WS_BUF = WS_PROJ;
constexpr size_t WS_YB = WS_PROJ + 80 * MiB;
constexpr size_t WS_HID = WS_OBR;
constexpr size_t RT_EXP = 0;
constexpr size_t RT_WGT = 128 * 1024;
constexpr size_t RT_RANK = 256 * 1024;
constexpr size_t RT_DEST = 384 * 1024;
constexpr size_t RT_ROWW = 512 * 1024;
constexpr size_t RT_TILE = 700 * 1024;
constexpr size_t RT_RSTD1 = 896 * 1024;
constexpr size_t RT_RSTD = 768 * 1024;
constexpr int CW_CNT = 163840;
constexpr int CW_TMO = 128;
constexpr int CW_TCNT = 131072;

__device__ __forceinline__ float bf2f(bf16_t v) { return __uint_as_float(((unsigned)v) << 16); }
__device__ __forceinline__ bf16_t f2bf(float f) { unsigned u = __float_as_uint(f); return (bf16_t)((u + 0x7fffu + ((u >> 16) & 1u)) >> 16); }
template <int O> __device__ __forceinline__ float xlane(float v) { static_assert(O >= 1 && O < 32, "swizzle range"); return __int_as_float(__builtin_amdgcn_ds_swizzle(__float_as_int(v), (O << 10) | 0x1F)); }
__device__ __forceinline__ float half_sum(float v) { auto rr = __builtin_amdgcn_permlane32_swap(__float_as_uint(v), __float_as_uint(v), false, false); return __uint_as_float(rr[0]) + __uint_as_float(rr[1]); }
__device__ __forceinline__ float half_max(float v) { auto rr = __builtin_amdgcn_permlane32_swap(__float_as_uint(v), __float_as_uint(v), false, false); return fmaxf(__uint_as_float(rr[0]), __uint_as_float(rr[1])); }
__device__ __forceinline__ float wave_sum(float v) { v += xlane<1>(v); v += xlane<2>(v); v += xlane<4>(v); v += xlane<8>(v); v += xlane<16>(v); return half_sum(v); }
__device__ __forceinline__ float wave_max(float v) { v = fmaxf(v, xlane<1>(v)); v = fmaxf(v, xlane<2>(v)); v = fmaxf(v, xlane<4>(v)); v = fmaxf(v, xlane<8>(v)); v = fmaxf(v, xlane<16>(v)); return half_max(v); }
__device__ __forceinline__ float inv1d(int i) { return exp2f(-(float)i * (13.287712379549449f / 32.f)); }
__device__ __forceinline__ float inv2d(int j) { return exp2f(-(float)j * (13.287712379549449f / 16.f)); }
__device__ __forceinline__ float ang2d(int pos, int i) { return i < 16 ? (float)(pos >> 6) * inv2d(i) : (float)(pos & 63) * inv2d(i - 16); }

#define LAS __attribute__((address_space(3)))
#define GAS __attribute__((address_space(1)))
typedef short bf16x8 __attribute__((ext_vector_type(8)));
typedef short s16x4 __attribute__((ext_vector_type(4)));
typedef float f32x16 __attribute__((ext_vector_type(16)));
typedef float f32x2 __attribute__((ext_vector_type(2)));
typedef int i32x4 __attribute__((ext_vector_type(4)));
typedef int i32x8 __attribute__((ext_vector_type(8)));

constexpr size_t WB_IN = 0, WB_UP = 6029312, WB_OUT = WB_UP + 1572864, WB_GU = WB_OUT + 1048576, WB_DN = WB_GU + 33554432, WB_LAYER = WB_DN + 16777216;
constexpr size_t WB_MEMKV = 2 * WB_LAYER;
constexpr size_t WB_RT = WB_MEMKV + 1048576;
static_assert(WS_WB + (WB_RT + 2 * 2 * 48 * 1024) * 2 <= WS_END, "weight copies fit");
constexpr int N_PHASES = 19;
constexpr int XP = 2048;
constexpr int LCAP = 16384;

__device__ __forceinline__ int lane_id() { int r; asm volatile("v_mbcnt_lo_u32_b32 %0, -1, 0\n\tv_mbcnt_hi_u32_b32 %0, -1, %0" : "=v"(r)); return r; }
__device__ __forceinline__ unsigned cvt_pk_bf16(float lo, float hi) { unsigned r; asm volatile("v_cvt_pk_bf16_f32 %0, %1, %2" : "=v"(r) : "v"(lo), "v"(hi)); return r; }
__device__ __forceinline__ i32x8 cat8(const bf16x8& a, const bf16x8& b) { const i32x4 x = __builtin_bit_cast(i32x4, a), y = __builtin_bit_cast(i32x4, b); return __builtin_shufflevector(x, y, 0, 1, 2, 3, 4, 5, 6, 7); }
__device__ __forceinline__ u32x2 pack8_fp8(const f32x4& v0, const f32x4& v1) { int a = 0, b = 0; a = __builtin_amdgcn_cvt_pk_fp8_f32(v0[0], v0[1], a, false); a = __builtin_amdgcn_cvt_pk_fp8_f32(v0[2], v0[3], a, true);
    b = __builtin_amdgcn_cvt_pk_fp8_f32(v1[0], v1[1], b, false); b = __builtin_amdgcn_cvt_pk_fp8_f32(v1[2], v1[3], b, true); u32x2 r; r.x = (unsigned)a; r.y = (unsigned)b; return r; }
__device__ __forceinline__ unsigned pack4_fp8(const f32x4& v) { int a = 0; a = __builtin_amdgcn_cvt_pk_fp8_f32(v[0], v[1], a, false); a = __builtin_amdgcn_cvt_pk_fp8_f32(v[2], v[3], a, true); return (unsigned)a; }
__device__ __forceinline__ float fast_sigmoid(float v) { return __builtin_amdgcn_rcpf(1.f + __builtin_amdgcn_exp2f(-v * LOG2E)); }

namespace pg8 {
#define PG8_LAS LAS
constexpr int BM = 256, BK = 64, HALF = 128, HTB = HALF * BK * 2, STAGE_BYTES = 8 * HTB, NXCD = 8, WGM = 8;
__host__ __device__ __forceinline__ int lds_byte(int r, int c) { const int st = (r >> 4) * 2 + (c >> 5), rr = r & 15, cc = c & 31, ob = rr * 64 + cc * 2; return st * 1024 + (ob ^ (((ob >> 9) & 1) << 5)); }
__host__ __device__ __forceinline__ void stage_rc(int b, int& R, int& C) { const int st = b / 1024, sb = b % 1024, swz = sb ^ (((sb >> 9) & 1) << 5); R = (st >> 1) * 16 + swz / 64; C = (st & 1) * 32 + (swz % 64) / 2; }
__host__ __device__ __forceinline__ int perm32(int rho) { const int n = rho >> 4, i = rho & 15; return 8 * (i >> 2) + 4 * n + (i & 3); }

struct Unit { int pm, pn, sub, ord; const char* a; const char* b; };
struct Gemm { int lda; int K; int sw = 0x7F7F7F7F; };
__device__ __forceinline__ void tile_order(int L, int nM, int nN, int& pm, int& pn) {
    const int nwg = nM * nN; int wgid = L; { const int q = nwg / NXCD, r = nwg % NXCD, xcd = wgid % NXCD, off = wgid / NXCD; wgid = (xcd < r ? xcd * (q + 1) : r * (q + 1) + (xcd - r) * q) + off; }
    const int nig = WGM * nN, gid = wgid / nig, fm = gid * WGM, gsz = (nM - fm) < WGM ? (nM - fm) : WGM;
    pm = fm + ((wgid % nig) % gsz); pn = (wgid % nig) / gsz;
}
__device__ __forceinline__ u32x4 pack8(const f32x4& v0, const f32x4& v1) { u32x4 w; w.x = cvt_pk_bf16(v0[0], v0[1]); w.y = cvt_pk_bf16(v0[2], v0[3]); w.z = cvt_pk_bf16(v1[0], v1[1]); w.w = cvt_pk_bf16(v1[2], v1[3]); return w; }
__device__ __forceinline__ void unpack8(const u32x4& w, f32x4& v0, f32x4& v1) {
    v0[0] = __uint_as_float(w.x << 16); v0[1] = __uint_as_float(w.x & 0xffff0000u); v0[2] = __uint_as_float(w.y << 16); v0[3] = __uint_as_float(w.y & 0xffff0000u);
    v1[0] = __uint_as_float(w.z << 16); v1[1] = __uint_as_float(w.z & 0xffff0000u); v1[2] = __uint_as_float(w.w << 16); v1[3] = __uint_as_float(w.w & 0xffff0000u); }

__device__ __forceinline__ unsigned pack4_u8(const f32x4& v) {
    const unsigned a = (unsigned)__builtin_rintf(v[0] * 255.f), b = (unsigned)__builtin_rintf(v[1] * 255.f), c = (unsigned)__builtin_rintf(v[2] * 255.f), d = (unsigned)__builtin_rintf(v[3] * 255.f);
    return a | (b << 8) | (c << 16) | (d << 24); }
__device__ __forceinline__ void unpack8_u8(const u32x2& w, f32x4& v0, f32x4& v1) {
    constexpr float k = 1.f / 255.f;
    v0[0] = (float)(w.x & 0xffu) * k; v0[1] = (float)((w.x >> 8) & 0xffu) * k; v0[2] = (float)((w.x >> 16) & 0xffu) * k; v0[3] = (float)(w.x >> 24) * k;
    v1[0] = (float)(w.y & 0xffu) * k; v1[1] = (float)((w.y >> 8) & 0xffu) * k; v1[2] = (float)((w.y >> 16) & 0xffu) * k; v1[3] = (float)(w.y >> 24) * k; }
struct EpiProj {
    static constexpr bool PERM = true, AFTER_DRAIN = false, KHOOK = false;
    bf16_t* PROJ; bf16_t* MEMKV; const float* tab1; const float* tab2; const float* qg; const float* kg; const float* rstd1;
    __device__ __forceinline__ void operator()(const f32x4 (&acc)[2][2][4][2], const Unit& u, int wr, int wc, int fr, int fq) const {
        const int colt = u.pn * 256, dcol = colt + wc * 64 + fq * 8, row0 = u.pm * 256 + wr * 64 + fr;
        if (u.sub == 1) {
#pragma unroll
            for (int ai = 0; ai < 2; ++ai)
#pragma unroll
                for (int m = 0; m < 4; ++m) { bf16_t* rowp = MEMKV + (size_t)(row0 + ai * 128 + m * 16) * 1024 + dcol;
#pragma unroll
                    for (int bj = 0; bj < 2; ++bj) *(u32x4*)(rowp + bj * 32) = pack8(acc[ai][bj][m][0], acc[ai][bj][m][1]); }
            return;
        }
        int mode = 0; float sc = 1.f; const float* g = qg;
        if (colt < C_AV) { mode = 1; if (colt < C_AK) sc = C2_64; }
        else if (colt < C_BQ) mode = 0;
        else if (colt < C_BK) { mode = 2; sc = C2_64; }
        else if (colt < C_CQ) { if (wc < 2) { mode = 2; g = kg; } }
        else if (colt < C_G) sc = C2_128;
        else mode = 3;
        f32x4 gv[2][2];
        if (mode == 2) {
#pragma unroll
            for (int bj = 0; bj < 2; ++bj)
#pragma unroll
                for (int n = 0; n < 2; ++n) gv[bj][n] = *(const f32x4*)(g + bj * 32 + fq * 8 + n * 4);
        }
        float r1v[2][4];
#pragma unroll
        for (int ai = 0; ai < 2; ++ai)
#pragma unroll
            for (int m = 0; m < 4; ++m) r1v[ai][m] = rstd1[row0 + ai * 128 + m * 16];
        asm volatile("" ::: "memory");
#pragma unroll
        for (int ai = 0; ai < 2; ++ai)
#pragma unroll
            for (int m = 0; m < 4; ++m) {
                const int row = row0 + ai * 128 + m * 16, pos = row & (SEQ - 1);
                const float r1 = r1v[ai][m];
                f32x4 v[2][2] = {{acc[ai][0][m][0] * r1, acc[ai][0][m][1] * r1}, {acc[ai][1][m][0] * r1, acc[ai][1][m][1] * r1}};
                if (mode == 2) {
                    float ss = 0.f;
#pragma unroll
                    for (int bj = 0; bj < 2; ++bj)
#pragma unroll
                        for (int n = 0; n < 2; ++n) ss += (v[bj][n][0] * v[bj][n][0] + v[bj][n][1] * v[bj][n][1]) + (v[bj][n][2] * v[bj][n][2] + v[bj][n][3] * v[bj][n][3]);
                    ss += xlane<16>(ss); ss = half_sum(ss);
                    const float rs = rsqrtf(ss * (1.f / 64.f) + EPS);
#pragma unroll
                    for (int bj = 0; bj < 2; ++bj)
#pragma unroll
                        for (int n = 0; n < 2; ++n) v[bj][n] = v[bj][n] * rs * gv[bj][n];
                }
                if (mode == 1 || mode == 2) {
                    const float* tb = (mode == 1 ? tab1 : tab2) + ((size_t)pos * 32 + fq * 8) * 2;
#pragma unroll
                    for (int n = 0; n < 2; ++n) { const f32x4 t0 = *(const f32x4*)(tb + n * 8), t1 = *(const f32x4*)(tb + n * 8 + 4);
                        const float cs[4] = {t0[0], t0[2], t1[0], t1[2]}, sn[4] = {t0[1], t0[3], t1[1], t1[3]};
#pragma unroll
                        for (int e = 0; e < 4; ++e) { const float x1 = v[0][n][e], x2 = v[1][n][e]; v[0][n][e] = x1 * cs[e] - x2 * sn[e]; v[1][n][e] = x2 * cs[e] + x1 * sn[e]; } }
                }
                if (mode == 3) {
#pragma unroll
                    for (int bj = 0; bj < 2; ++bj)
#pragma unroll
                        for (int n = 0; n < 2; ++n)
#pragma unroll
                            for (int e = 0; e < 4; ++e) v[bj][n][e] = fast_sigmoid(v[bj][n][e]);
                }
                if (mode == 3) {
                    u32x4 w; w.x = pack4_u8(v[0][0]); w.y = pack4_u8(v[0][1]); w.z = pack4_u8(v[1][0]); w.w = pack4_u8(v[1][1]);
                    *(u32x4*)((unsigned char*)(PROJ + (size_t)row * D_IN + C_G) + (colt - C_G) + wc * 64 + fq * 16) = w;
                } else {
                bf16_t* rowp = PROJ + (size_t)row * D_IN + dcol;
#pragma unroll
                for (int bj = 0; bj < 2; ++bj) *(u32x4*)(rowp + bj * 32) = pack8(v[bj][0] * sc, v[bj][1] * sc);
                }
            }
    }
};
struct EpiGate {
    static constexpr bool PERM = true, AFTER_DRAIN = false, KHOOK = true;
    bf16_t* MERGED; const bf16_t* PROJ;
    __device__ __forceinline__ static void ug(const u32x2& w, f32x4& v0, f32x4& v1) {
        unpack8_u8(w, v0, v1);
#pragma unroll
        for (int e = 0; e < 4; ++e) { v0[e] = fmaxf(v0[e], 0.5f / 255.f); v1[e] = fmaxf(v1[e], 0.5f / 255.f); } }
    __device__ __forceinline__ void khook(f32x4 (&acc)[2][2][4][2], const Unit& u, int t, int wr, int wc, int fr, int fq) const {
        int row0 = u.pm * 256 + wr * 64 + fr; asm volatile("" : "+v"(row0));
        const int seg = (t >> 3) - 1, col0 = u.pn * 256 + wc * 32 + fq * 8;
#pragma unroll
        for (int ai = 0; ai < 2; ++ai) {
            u32x2 ga[4][2], gb[4][2];
#pragma unroll
            for (int m = 0; m < 4; ++m) { const unsigned char* gp = (const unsigned char*)(PROJ + (size_t)(row0 + ai * 128 + m * 16) * D_IN + C_G) + seg * 1024 + col0;
#pragma unroll
                for (int bj = 0; bj < 2; ++bj) { ga[m][bj] = *(const u32x2*)(gp + bj * 128); gb[m][bj] = *(const u32x2*)(gp + 1024 + bj * 128); } }
            asm volatile("" ::: "memory");
#pragma unroll
            for (int m = 0; m < 4; ++m)
#pragma unroll
                for (int bj = 0; bj < 2; ++bj) { f32x4 a0, a1, b0, b1; ug(ga[m][bj], a0, a1); ug(gb[m][bj], b0, b1);
#pragma unroll
                    for (int e = 0; e < 4; ++e) { acc[ai][bj][m][0][e] *= a0[e] * __builtin_amdgcn_rcpf(b0[e]); acc[ai][bj][m][1][e] *= a1[e] * __builtin_amdgcn_rcpf(b1[e]); } }
            asm volatile("" ::: "memory");
        }
    }
    __device__ __forceinline__ void operator()(const f32x4 (&acc)[2][2][4][2], const Unit& u, int wr, int wc, int fr, int fq) const {
        const int col0 = u.pn * 256 + wc * 32 + fq * 8, row0 = u.pm * 256 + wr * 64 + fr;
#pragma unroll
        for (int ai = 0; ai < 2; ++ai) {
            u32x2 gq[4][2];
#pragma unroll
            for (int m = 0; m < 4; ++m) { const unsigned char* gp = (const unsigned char*)(PROJ + (size_t)(row0 + ai * 128 + m * 16) * D_IN + C_G) + 2 * 1024 + col0;
#pragma unroll
                for (int bj = 0; bj < 2; ++bj) gq[m][bj] = *(const u32x2*)(gp + bj * 128); }
            asm volatile("" ::: "memory");
#pragma unroll
            for (int m = 0; m < 4; ++m) { bf16_t* op = MERGED + (size_t)(row0 + ai * 128 + m * 16) * DM + col0;
#pragma unroll
                for (int bj = 0; bj < 2; ++bj) { f32x4 g0, g1; ug(gq[m][bj], g0, g1); *(u32x4*)(op + bj * 128) = pack8(g0 * acc[ai][bj][m][0], g1 * acc[ai][bj][m][1]); } }
            asm volatile("" ::: "memory");
        }
    }
};
struct EpiResid {
    static constexpr bool PERM = true, AFTER_DRAIN = false, KHOOK = false;
    bf16_t* XB;
    __device__ __forceinline__ void operator()(const f32x4 (&acc)[2][2][4][2], const Unit& u, int wr, int wc, int fr, int fq) const {
        const int col0 = u.pn * 256 + wc * 32 + fq * 8, row0 = u.pm * 256 + wr * 64 + fr;
#pragma unroll
        for (int ai = 0; ai < 2; ++ai)
#pragma unroll
            for (int mp = 0; mp < 2; ++mp) {
                u32x4 xq[2][2];
#pragma unroll
                for (int mi = 0; mi < 2; ++mi)
#pragma unroll
                    for (int bj = 0; bj < 2; ++bj) xq[mi][bj] = *(const u32x4*)(XB + (size_t)(row0 + ai * 128 + (mp * 2 + mi) * 16) * XP + col0 + bj * 128);
                asm volatile("" ::: "memory");
#pragma unroll
                for (int mi = 0; mi < 2; ++mi) { const int m = mp * 2 + mi;
#pragma unroll
                    for (int bj = 0; bj < 2; ++bj) { f32x4 x0, x1; unpack8(xq[mi][bj], x0, x1);
                        *(u32x4*)(XB + (size_t)(row0 + ai * 128 + m * 16) * XP + col0 + bj * 128) = pack8(x0 + acc[ai][bj][m][0], x1 + acc[ai][bj][m][1]); } }
                asm volatile("" ::: "memory");
            }
    }
};
constexpr float HID_SCALE = 4.f;
struct EpiSilu {
    static constexpr bool PERM = true, AFTER_DRAIN = false, KHOOK = false;
    unsigned char* HID; const PG8_LAS float* rtab;
    __device__ __forceinline__ void operator()(const f32x4 (&acc)[2][2][4][2], const Unit& u, int wr, int wc, int fr, int fq) const {
        const __amdgpu_buffer_rsrc_t rsrc = __builtin_amdgcn_make_buffer_rsrc((void*)HID, 0, P_ROWS * DEXP, 0x00020000);
        const int col0 = u.pn * 128 + wc * 32 + fq * 8, row0 = u.pm * 256 + wr * 64 + fr;
#pragma unroll
        for (int ai = 0; ai < 2; ++ai)
#pragma unroll
            for (int m = 0; m < 4; ++m) { f32x4 h[2]; const float r = rtab[u.ord * 256 + wr * 64 + fr + ai * 128 + m * 16];
#pragma unroll
                for (int n = 0; n < 2; ++n)
#pragma unroll
                    for (int e = 0; e < 4; ++e) { const float gq = acc[ai][0][m][n][e] * r; h[n][e] = gq * fast_sigmoid(gq) * (acc[ai][1][m][n][e] * (r * HID_SCALE)); }
                __builtin_amdgcn_raw_buffer_store_b64(pack8_fp8(h[0], h[1]), rsrc, (row0 + ai * 128 + m * 16) * DEXP + col0, 0, 16); }
    }
};
struct EpiRowScale {
    static constexpr bool PERM = true, AFTER_DRAIN = false, KHOOK = false;
    unsigned char* YB; const PG8_LAS float* wtab;
    __device__ __forceinline__ void operator()(const f32x4 (&acc)[2][2][4][2], const Unit& u, int wr, int wc, int fr, int fq) const {
        const int col0 = u.pn * 256 + wc * 64 + fq * 16, rt0 = wr * 64 + fr;
#pragma unroll
        for (int ai = 0; ai < 2; ++ai)
#pragma unroll
            for (int m = 0; m < 4; ++m) { const int rt = rt0 + ai * 128 + m * 16; const float w = wtab[u.ord * 256 + rt];
                if (w >= 0.f) {
                    u32x4 o; o.x = pack4_fp8(acc[ai][0][m][0] * w); o.y = pack4_fp8(acc[ai][0][m][1] * w); o.z = pack4_fp8(acc[ai][1][m][0] * w); o.w = pack4_fp8(acc[ai][1][m][1] * w);
                    *(u32x4*)(YB + (size_t)(u.pm * 256 + rt) * DM + col0) = o; } }
    }
};
constexpr int NPT = C_G / 256, NGT = (D_IN - C_G) / 256;
struct SchedProj {
    int c, G, nmain, ntotal; const char* A; const char* B; const char* Am; const char* Bm;
    __device__ __forceinline__ bool next(int i, Unit& u) const {
        const long L = (long)i * G + c; if (L >= ntotal) return false;
        u.ord = i;
        if (L < nmain) { tile_order((int)L, M / 256, NPT, u.pm, u.pn); u.sub = 0; u.a = A + (size_t)u.pm * (256 * XP * 2); u.b = B + (size_t)u.pn * (256 * DM * 2); }
        else { const int r = (int)L - nmain; u.pm = r >> 2; u.pn = r & 3; u.sub = 1; u.a = Am + (size_t)u.pm * (256 * XP * 2); u.b = Bm + (size_t)u.pn * (256 * DM * 2); }
        return true; }
    __device__ __forceinline__ void a_ready(const Unit&) const {}
    __device__ __forceinline__ void done(const Unit&) const {}
};
struct SchedGate8 {
    int c, G, kh; const char* A; const char* B;
    __device__ __forceinline__ bool next(int i, Unit& u) const {
        long L;
        if (G == 256) { const int k = c >> 3, nl = 32 - kh, k3 = 96 - 4 * nl - 2 * kh, nf = k < k3 ? 3 : k < kh ? 2 : 4, st = k < k3 ? 3 * k : k < kh ? 3 * k3 + 2 * (k - k3) : 3 * k3 + 2 * (kh - k3) + 4 * (k - kh);
            if (i >= nf) return false; L = 8 * (st + i) + (c & 7); }
        else { L = (long)i * G + c; if (L >= (M / 256) * NGT) return false; }
        tile_order((int)L, M / 256, NGT, u.pm, u.pn); u.sub = 0; u.ord = i; u.a = A + (size_t)u.pm * (256 * DM); u.b = B + (size_t)u.pn * (256 * DM); u.pn += NPT; return true; }
    __device__ __forceinline__ void a_ready(const Unit&) const {}
    __device__ __forceinline__ void done(const Unit&) const {}
};
struct EpiSig {
    static constexpr bool PERM = true, AFTER_DRAIN = false, KHOOK = false;
    bf16_t* PROJ; const float* rstd1;
    __device__ __forceinline__ void operator()(const f32x4 (&acc)[2][2][4][2], const Unit& u, int wr, int wc, int fr, int fq) const {
        const int colt = u.pn * 256, row0 = u.pm * 256 + wr * 64 + fr;
        float r1v[2][4];
#pragma unroll
        for (int ai = 0; ai < 2; ++ai)
#pragma unroll
            for (int m = 0; m < 4; ++m) r1v[ai][m] = rstd1[row0 + ai * 128 + m * 16];
        asm volatile("" ::: "memory");
#pragma unroll
        for (int ai = 0; ai < 2; ++ai)
#pragma unroll
            for (int m = 0; m < 4; ++m) { const int row = row0 + ai * 128 + m * 16; const float r1 = r1v[ai][m]; u32x4 w;
#pragma unroll
                for (int bj = 0; bj < 2; ++bj)
#pragma unroll
                    for (int n = 0; n < 2; ++n) { f32x4 v;
#pragma unroll
                        for (int e = 0; e < 4; ++e) v[e] = fast_sigmoid(acc[ai][bj][m][n][e] * r1);
                        w[bj * 2 + n] = pack4_u8(v); }
                *(u32x4*)((unsigned char*)(PROJ + (size_t)row * D_IN + C_G) + (colt - C_G) + wc * 64 + fq * 16) = w; }
    }
};
struct SchedPlain {
    int c, G, nM; const char* A; const char* B; size_t a_tile, b_tile;
    __device__ __forceinline__ bool next(int i, Unit& u) const {
        const long L = (long)i * G + c; if (L >= (long)nM * 4) return false;
        tile_order((int)L, nM, 4, u.pm, u.pn); u.sub = 0; u.ord = i; u.a = A + (size_t)u.pm * a_tile; u.b = B + (size_t)u.pn * b_tile; return true; }
    __device__ __forceinline__ void a_ready(const Unit&) const {}
    __device__ __forceinline__ void done(const Unit&) const {}
};
struct SchedMoeUp {
    static constexpr size_t b_exp = (size_t)1024 * 1024, b_tile = (size_t)256 * DM;
    int c, G, ntiles; const PG8_LAS int* tile_e; const char* A; const char* B; unsigned* tcnt;
    __device__ __forceinline__ bool next(int i, Unit& u) const {
        const long L = (long)i * G + c; if (L >= (long)ntiles * 4) return false;
        u.pm = (int)(L >> 2); u.pn = (int)(L & 3); u.sub = 0; u.ord = i; const int e = tile_e[u.pm];
        u.a = A; u.b = B + (size_t)e * b_exp + (size_t)u.pn * b_tile; return true; }
    __device__ __forceinline__ void a_ready(const Unit&) const {}
    __device__ __forceinline__ void done(const Unit& u) const {
        asm volatile("s_waitcnt vmcnt(0)" ::: "memory");
        if (lane_id() == 0) __hip_atomic_fetch_add(tcnt + 64 * u.pm, 1u, __ATOMIC_RELAXED, __HIP_MEMORY_SCOPE_AGENT);
    }
};
__device__ __forceinline__ int moe_down_unit(int c, int i, int rem, int G) {
    const int n0 = G - rem, n1 = rem;
    return c >= rem ? n0 * i + n1 * (i > 1 ? i - 1 : 0) + (c - rem) : n0 * (i + 2) + n1 * i + c;
}
struct SchedMoeDown {
    static constexpr size_t a_tile = (size_t)256 * DEXP, b_exp = (size_t)1024 * 512, b_tile = (size_t)256 * DEXP;
    int c, G, ntiles, rem, wv; const PG8_LAS int* tile_e; const char* A; const char* B; unsigned* tcnt; unsigned* tmo;
    __device__ __forceinline__ bool next(int i, Unit& u) const {
        const int j = moe_down_unit(c, i, rem, G); if (j >= ntiles * 4) return false;
        u.pm = j >> 2; u.pn = j & 3; u.sub = 0; u.ord = i; const int e = tile_e[u.pm];
        u.a = A + (size_t)u.pm * a_tile; u.b = B + (size_t)e * b_exp + (size_t)u.pn * b_tile; return true; }
    __device__ __forceinline__ void a_ready(const Unit& u) const {
        if (wv == 0) {
            unsigned polls = 0;
            while ((unsigned)__builtin_amdgcn_readfirstlane(__hip_atomic_load(tcnt + 64 * u.pm, __ATOMIC_RELAXED, __HIP_MEMORY_SCOPE_AGENT)) < 32u) {
                if (++polls > (1u << 20)) { if (lane_id() == 0) __hip_atomic_store(tmo, 1u, __ATOMIC_RELAXED, __HIP_MEMORY_SCOPE_AGENT); break; }
                __builtin_amdgcn_s_sleep(2); }
            __builtin_amdgcn_fence(__ATOMIC_ACQUIRE, "agent");
            asm volatile("s_waitcnt vmcnt(0)" ::: "memory");
        }
        asm volatile("" ::: "memory"); __builtin_amdgcn_s_barrier(); asm volatile("" ::: "memory");
    }
    __device__ __forceinline__ void done(const Unit&) const {}
};

template <class Epi, class Sched, bool ALIGN_EPI = false, bool SP2 = false, bool GATHER = false, bool F8 = false>
__device__ __forceinline__ void gemm_phase(PG8_LAS unsigned char* lds, const Gemm g, const Sched& S, const Epi& E, int wave_id, const PG8_LAS unsigned* rowtab = nullptr) {
    static_assert(!GATHER || SP2, "the gathered A path is written for the two-super-phase loop");
    int tid_ = wave_id * 64 + lane_id(); asm volatile("" : "+v"(tid_));
    const int tid = tid_, wid = __builtin_amdgcn_readfirstlane(tid >> 6), lane = tid & 63, wr = wid >> 2, wc = wid & 3, fr = lane & 15, fq = lane >> 4;
    int K_ = g.K; if constexpr (F8) asm volatile("" : "+s"(K_));
    const int K = K_, nt = K / BK;
    int sc8v = g.sw; if constexpr (F8) asm volatile("" : "+v"(sc8v));
    unsigned voffA[2], voffB[2];
#pragma unroll
    for (int i = 0; i < 2; ++i) { int R, C; stage_rc(tid * 16 + i * 8192, R, C); const int Rb = Epi::PERM ? ((R & ~31) + perm32(R & 31)) : R;
        voffA[i] = (unsigned)(R * g.lda + C) * 2u; voffB[i] = (unsigned)(Rb * K + C) * 2u; }
    unsigned gC[2][2] = {{0u, 0u}, {0u, 0u}}, gN[2][2] = {{0u, 0u}, {0u, 0u}};
#define PG8_GROWS(dst, ord) do { if constexpr (GATHER) { _Pragma("unroll") for (int i_ = 0; i_ < 2; ++i_) { int R_, C_; stage_rc((wid * 64 + fq * 16 + fr) * 16 + i_ * 8192, R_, C_);     \
        _Pragma("unroll") for (int h_ = 0; h_ < 2; ++h_) dst[h_][i_] = rowtab[(ord) * 256 + h_ * 128 + R_] + (unsigned)C_ * 2u; } } } while (0)
#define PG8_STAGE_A(bufoff, base, h, use_next) do { if constexpr (GATHER) { unsigned vo_[2]; vo_[0] = (use_next) ? gN[h][0] : gC[h][0]; vo_[1] = (use_next) ? gN[h][1] : gC[h][1]; PG8_STAGE(bufoff, base, vo_); } \
        else { PG8_STAGE(bufoff, (base) + (h) * hstepA, voffA); } } while (0)
    const size_t kstep = (size_t)(BK * 2);
    const size_t hstepA = (size_t)HALF * g.lda * 2, hstepB = (size_t)HALF * K * 2;
    const unsigned ldsw = (unsigned)wid * 1024u;
    const int aoff = lds_byte(wr * 64 + fr, fq * 8), boff = lds_byte(wc * 32 + fr, fq * 8);
#define PG8_SA(b, h) (((b) * 2 + (h)) * HTB)
#define PG8_SB(b, h) ((4 + (b) * 2 + (h)) * HTB)
#define PG8_STAGE(bufoff, gbase, voff) do { _Pragma("unroll") for (int _i = 0; _i < 2; ++_i) \
        __builtin_amdgcn_global_load_lds((const unsigned*)((const char*)(gbase) + (voff)[_i]), (PG8_LAS unsigned*)(lds + (bufoff) + ldsw + _i * 8192), 16, 0, 0); } while (0)
#define PG8_LDA(dst, b, h) do { _Pragma("unroll") for (int m = 0; m < 4; ++m) _Pragma("unroll") for (int k = 0; k < 2; ++k) dst[m][k] = *(const PG8_LAS bf16x8*)(lds + PG8_SA(b, h) + aoff + m * 2048 + k * 1024); } while (0)
#define PG8_LDB(dst, b, h) do { _Pragma("unroll") for (int n = 0; n < 2; ++n) _Pragma("unroll") for (int k = 0; k < 2; ++k) dst[n][k] = *(const PG8_LAS bf16x8*)(lds + PG8_SB(b, h) + boff + n * 2048 + k * 1024); } while (0)
#define PG8_MMA(ai, bj, At, Bt) do { __builtin_amdgcn_s_setprio(1); _Pragma("unroll") for (int m = 0; m < 4; ++m) _Pragma("unroll") for (int n = 0; n < 2; ++n) { \
        if constexpr (F8) asm volatile("v_mfma_scale_f32_16x16x128_f8f6f4 %0, %1, %2, %0, %3, %3 op_sel_hi:[0,0,0]" : "+v"(acc[ai][bj][m][n]) : "v"(cat8(Bt[n][0], Bt[n][1])), "v"(cat8(At[m][0], At[m][1])), "v"(sc8v));     \
        else { _Pragma("unroll") for (int k = 0; k < 2; ++k) acc[ai][bj][m][n] = __builtin_amdgcn_mfma_f32_16x16x32_bf16(Bt[n][k], At[m][k], acc[ai][bj][m][n], 0, 0, 0); } } __builtin_amdgcn_s_setprio(0); } while (0)
#define PG8_WAIT_V(n) asm volatile("s_waitcnt vmcnt(" #n ")" ::: "memory")
#define PG8_WAIT_L(n) asm volatile("s_waitcnt lgkmcnt(" #n ")" ::: "memory")
#define PG8_BAR __builtin_amdgcn_s_barrier()
#define PG8_SCHED __builtin_amdgcn_sched_barrier(0)
    Unit cur, nxt; int ui = 0;
    if (!S.next(0, cur)) return;
    f32x4 acc[2][2][4][2];
#pragma unroll
    for (int a = 0; a < 2; ++a)
#pragma unroll
        for (int b = 0; b < 2; ++b)
#pragma unroll
            for (int m = 0; m < 4; ++m)
#pragma unroll
                for (int n = 0; n < 2; ++n) acc[a][b][m][n] = (f32x4){0.f, 0.f, 0.f, 0.f};
    bf16x8 At[4][2], B0[2][2], B1[2][2];
    const char* cA = cur.a; const char* cB = cur.b;
    S.a_ready(cur);
    if constexpr (SP2) {
        PG8_GROWS(gC, 0);
        PG8_STAGE(PG8_SB(0, 0), cB, voffB); PG8_STAGE(PG8_SB(0, 1), cB + hstepB, voffB); PG8_STAGE_A(PG8_SA(0, 0), cA, 0, false); PG8_STAGE_A(PG8_SA(0, 1), cA, 1, false);
        if (wr == 1) PG8_BAR;
        PG8_WAIT_V(2); PG8_BAR;
        PG8_STAGE(PG8_SB(1, 0), cB + kstep, voffB); PG8_STAGE_A(PG8_SA(1, 0), cA + kstep, 0, false); PG8_STAGE(PG8_SB(1, 1), cB + hstepB + kstep, voffB);
        PG8_WAIT_V(6); PG8_BAR;
    } else {
        PG8_STAGE(PG8_SB(0, 0), cB, voffB); PG8_STAGE(PG8_SA(0, 0), cA, voffA); PG8_STAGE(PG8_SB(0, 1), cB + hstepB, voffB); PG8_STAGE(PG8_SA(0, 1), cA + hstepA, voffA);
        if (wr == 1) PG8_BAR;
        PG8_WAIT_V(4); PG8_BAR;
        PG8_STAGE(PG8_SB(1, 0), cB + kstep, voffB); PG8_STAGE(PG8_SA(1, 0), cA + kstep, voffA); PG8_STAGE(PG8_SB(1, 1), cB + hstepB + kstep, voffB);
        PG8_WAIT_V(6); PG8_BAR;
    }
    for (;;) {
        const bool has_next = S.next(ui + 1, nxt);
        const char* nA = has_next ? nxt.a : cA; const char* nB = has_next ? nxt.b : cB;
        for (int t = 0; t < nt; t += 2) {
            if constexpr (Epi::KHOOK) { if (t == 8 || t == 16) E.khook(acc, cur, t, wr, wc, fr, fq); }
            const bool last = (t == nt - 2);
            const char* a1 = cA + (size_t)(t + 1) * kstep;
            const char* a2 = last ? nA : cA + (size_t)(t + 2) * kstep; const char* b2 = last ? nB : cB + (size_t)(t + 2) * kstep;
            const char* a3 = a2 + kstep; const char* b3 = b2 + kstep;
            if (last && has_next) S.a_ready(nxt);
            if constexpr (GATHER) { if (last) { if (has_next) { PG8_GROWS(gN, ui + 1); } else { _Pragma("unroll") for (int h_ = 0; h_ < 2; ++h_) _Pragma("unroll") for (int i_ = 0; i_ < 2; ++i_) gN[h_][i_] = gC[h_][i_]; } } }
            if constexpr (SP2) {
            PG8_LDB(B0, 0, 0); PG8_LDB(B1, 0, 1); PG8_SCHED; PG8_LDA(At, 0, 0); PG8_STAGE_A(PG8_SA(1, 1), a1, 1, false);
            PG8_WAIT_V(8); PG8_WAIT_L(0); PG8_BAR; PG8_MMA(0, 0, At, B0); PG8_MMA(0, 1, At, B1); PG8_BAR; PG8_SCHED;
            PG8_LDA(At, 0, 1); PG8_STAGE(PG8_SB(0, 0), b2, voffB); PG8_STAGE(PG8_SB(0, 1), b2 + hstepB, voffB); PG8_STAGE_A(PG8_SA(0, 0), a2, 0, last);
            PG8_WAIT_V(8); PG8_WAIT_L(0); PG8_BAR; PG8_MMA(1, 0, At, B0); PG8_MMA(1, 1, At, B1); PG8_BAR; PG8_SCHED;
            PG8_LDB(B0, 1, 0); PG8_LDB(B1, 1, 1); PG8_SCHED; PG8_LDA(At, 1, 0); PG8_STAGE_A(PG8_SA(0, 1), a2, 1, last);
            PG8_WAIT_V(8); PG8_WAIT_L(0); PG8_BAR; PG8_MMA(0, 0, At, B0); PG8_MMA(0, 1, At, B1); PG8_BAR; PG8_SCHED;
            PG8_LDA(At, 1, 1); PG8_STAGE(PG8_SB(1, 0), b3, voffB); PG8_STAGE(PG8_SB(1, 1), b3 + hstepB, voffB); PG8_STAGE_A(PG8_SA(1, 0), a3, 0, last);
            PG8_WAIT_V(8); PG8_WAIT_L(0); PG8_BAR; PG8_MMA(1, 0, At, B0); PG8_MMA(1, 1, At, B1); PG8_BAR; PG8_SCHED;
            } else {
            PG8_LDB(B0, 0, 0); PG8_SCHED; PG8_LDA(At, 0, 0); PG8_STAGE(PG8_SA(1, 1), a1 + hstepA, voffA);
            PG8_WAIT_L(8); PG8_BAR; PG8_WAIT_L(0); PG8_MMA(0, 0, At, B0); PG8_BAR; PG8_SCHED;
            PG8_LDB(B1, 0, 1); PG8_STAGE(PG8_SB(0, 0), b2, voffB);
            PG8_BAR; PG8_WAIT_L(0); PG8_MMA(0, 1, At, B1); PG8_BAR;
            PG8_LDA(At, 0, 1); PG8_STAGE(PG8_SA(0, 0), a2, voffA);
            PG8_BAR; PG8_WAIT_L(0); PG8_MMA(1, 0, At, B0); PG8_BAR; PG8_SCHED;
            PG8_STAGE(PG8_SB(0, 1), b2 + hstepB, voffB);
            PG8_WAIT_V(6); PG8_BAR; PG8_MMA(1, 1, At, B1); PG8_BAR;
            PG8_LDB(B0, 1, 0); PG8_SCHED; PG8_LDA(At, 1, 0); PG8_STAGE(PG8_SA(0, 1), a2 + hstepA, voffA);
            PG8_WAIT_L(8); PG8_BAR; PG8_WAIT_L(0); PG8_MMA(0, 0, At, B0); PG8_BAR; PG8_SCHED;
            PG8_LDB(B1, 1, 1); PG8_STAGE(PG8_SB(1, 0), b3, voffB);
            PG8_BAR; PG8_WAIT_L(0); PG8_MMA(0, 1, At, B1); PG8_BAR;
            PG8_LDA(At, 1, 1); PG8_STAGE(PG8_SA(1, 0), a3, voffA);
            PG8_BAR; PG8_WAIT_L(0); PG8_MMA(1, 0, At, B0); PG8_BAR; PG8_SCHED;
            PG8_STAGE(PG8_SB(1, 1), b3 + hstepB, voffB);
            PG8_WAIT_V(6); PG8_BAR; PG8_MMA(1, 1, At, B1); PG8_BAR;
            }
        }
        if constexpr (ALIGN_EPI) { if (wr == 0) PG8_BAR; }
        if constexpr (!Epi::AFTER_DRAIN) {
            if constexpr (F8) { asm volatile("s_nop 15\n\ts_nop 15" ::: "memory");
                const int le_ = lane_id(); E(acc, cur, wr, wc, le_ & 15, le_ >> 4); }
            else E(acc, cur, wr, wc, fr, fq);
            S.done(cur); }
        if (!has_next) break;
#pragma unroll
        for (int a = 0; a < 2; ++a)
#pragma unroll
            for (int b = 0; b < 2; ++b)
#pragma unroll
                for (int m = 0; m < 4; ++m)
#pragma unroll
                    for (int n = 0; n < 2; ++n) acc[a][b][m][n] = (f32x4){0.f, 0.f, 0.f, 0.f};
        cur = nxt; cA = nA; cB = nB; ++ui;
        if constexpr (GATHER) { _Pragma("unroll") for (int h_ = 0; h_ < 2; ++h_) _Pragma("unroll") for (int i_ = 0; i_ < 2; ++i_) gC[h_][i_] = gN[h_][i_]; }
        if constexpr (ALIGN_EPI) { if (wr == 1) PG8_BAR; }
    }
    PG8_WAIT_V(0);
    if constexpr (!ALIGN_EPI) { if (wr == 0) PG8_BAR; }
    PG8_BAR;
    if constexpr (Epi::AFTER_DRAIN) { E.fused(acc, cur, wr, wc, fr, fq, lds, wid, lane); S.done(cur); }
#undef PG8_SA
#undef PG8_GROWS
#undef PG8_STAGE_A
#undef PG8_SB
#undef PG8_STAGE
#undef PG8_LDA
#undef PG8_LDB
#undef PG8_MMA
#undef PG8_WAIT_V
#undef PG8_WAIT_L
#undef PG8_BAR
#undef PG8_SCHED
}
}

namespace att {
constexpr int NW = 8, QBLK = 32, KVBLK = 64;
constexpr float THR = 8.f;
#define ATT_SBAR() __builtin_amdgcn_sched_barrier(0)
__device__ __forceinline__ int crow(int r, int hi) { return (r & 3) + 8 * (r >> 2) + 4 * hi; }
template <int D> __device__ __forceinline__ int kswz(int row, int colB) { return D == 128 ? row * 256 + (colB ^ ((row & 7) << 4)) : row * 128 + (colB ^ (((row >> 1) & 7) << 4)); }
template <int DV> __device__ __forceinline__ int v_st(int k, int c) { const int kk = (k & ~0xC) | ((k & 4) << 1) | ((k & 8) >> 1); return ((kk >> 3) * (DV / 32) + (c >> 5)) * 512 + ((kk & 7) * 32 + (c & 31)) * 2; }
__device__ __forceinline__ int v_rd_base(int lane) { return ((lane & 3) << 3) | (((lane >> 2) & 3) << 6) | (((lane >> 4) & 1) << 5) | (((lane >> 5) & 1) << 8); }
template <int DV> constexpr int v_rd_off(int d0, int ks, int half) { return d0 * 512 + ks * (DV / 32) * 1024 + half * (DV / 32) * 512; }
template <int OFF> __device__ __forceinline__ s16x4 tr_read(int vb) { s16x4 r; asm volatile("ds_read_b64_tr_b16 %0, %1 offset:%2" : "=&v"(r) : "v"(vb), "i"(OFF) : "memory"); return r; }

template <bool FIRST> __device__ __forceinline__ void partialSM(f32x16& p0, f32x16& p1, float& m_reg, float& alpha, f32x16& negm) {
    float pmax = p0[0];
#pragma unroll
    for (int r = 1; r < 16; ++r) pmax = fmaxf(pmax, p0[r]);
#pragma unroll
    for (int r = 0; r < 16; ++r) pmax = fmaxf(pmax, p1[r]);
    { auto rr = __builtin_amdgcn_permlane32_swap(__float_as_uint(pmax), __float_as_uint(pmax), false, false); pmax = fmaxf(__uint_as_float(rr[0]), __uint_as_float(rr[1])); }
    alpha = 1.f;
    if (FIRST || !__builtin_expect(__all(pmax <= THR), 1)) {
        const float dl = FIRST ? pmax : fmaxf(pmax, 0.f);
        if (!FIRST) alpha = __builtin_amdgcn_exp2f(-dl);
        m_reg += dl;
#pragma unroll
        for (int r = 0; r < 16; ++r) { p0[r] -= dl; p1[r] -= dl; negm[r] = -m_reg; }
    }
#pragma unroll
    for (int r = 0; r < 16; ++r) p0[r] = __builtin_amdgcn_exp2f(p0[r]);
}
__device__ __forceinline__ void finishSM(f32x16& p0, f32x16& p1, float alpha, float& l_reg, bf16x8& pa0, bf16x8& pa1, bf16x8& pa2, bf16x8& pa3) {
#pragma unroll
    for (int r = 0; r < 16; ++r) p1[r] = __builtin_amdgcn_exp2f(p1[r]);
    f32x2 ps2 = {p0[0] + p1[0], p0[1] + p1[1]};
#pragma unroll
    for (int r = 2; r < 16; r += 2) { ps2 += (f32x2){p0[r], p0[r + 1]}; ps2 += (f32x2){p1[r], p1[r + 1]}; }
    float ps = ps2[0] + ps2[1];
    { auto rr = __builtin_amdgcn_permlane32_swap(__float_as_uint(ps), __float_as_uint(ps), false, false); ps = __uint_as_float(rr[0]) + __uint_as_float(rr[1]); }
    l_reg = l_reg * alpha + ps;
#define ATT_PK4(P, BASE, OUT) do { unsigned a0 = cvt_pk_bf16(P[BASE + 0], P[BASE + 1]), a1 = cvt_pk_bf16(P[BASE + 2], P[BASE + 3]);   \
    unsigned b0 = cvt_pk_bf16(P[BASE + 4], P[BASE + 5]), b1 = cvt_pk_bf16(P[BASE + 6], P[BASE + 7]);                              \
    auto r0 = __builtin_amdgcn_permlane32_swap(a0, b0, false, false); auto r1 = __builtin_amdgcn_permlane32_swap(a1, b1, false, false); \
    u32x4 w = {r0[0], r1[0], r0[1], r1[1]}; OUT = *reinterpret_cast<bf16x8*>(&w); } while (0)
    ATT_PK4(p0, 0, pa0); ATT_PK4(p0, 8, pa1); ATT_PK4(p1, 0, pa2); ATT_PK4(p1, 8, pa3);
#undef ATT_PK4
}
template <int DQK> __device__ __forceinline__ void qkt(f32x16& p0, f32x16& p1, const char* Ks, const bf16x8* qr, const f32x16& negm, int r32, int hi) {
#pragma unroll
    for (int d0 = 0; d0 < DQK / 16; ++d0) { const int cb = (d0 * 16 + hi * 8) * 2;
        const bf16x8 b0 = *reinterpret_cast<const bf16x8*>(Ks + kswz<DQK>(r32, cb));
        const bf16x8 b1 = *reinterpret_cast<const bf16x8*>(Ks + kswz<DQK>(32 + r32, cb));
        p0 = __builtin_amdgcn_mfma_f32_32x32x16_bf16(b0, qr[d0], d0 == 0 ? negm : p0, 0, 0, 0);
        p1 = __builtin_amdgcn_mfma_f32_32x32x16_bf16(b1, qr[d0], d0 == 0 ? negm : p1, 0, 0, 0); }
}
template <int DV, int D0> __device__ __forceinline__ void pv_one(f32x16& od, int vb, bf16x8 pa0, bf16x8 pa1, bf16x8 pa2, bf16x8 pa3) {
    const s16x4 l0 = tr_read<v_rd_off<DV>(D0, 0, 0)>(vb), h0 = tr_read<v_rd_off<DV>(D0, 0, 1)>(vb), l1 = tr_read<v_rd_off<DV>(D0, 1, 0)>(vb), h1 = tr_read<v_rd_off<DV>(D0, 1, 1)>(vb);
    const s16x4 l2 = tr_read<v_rd_off<DV>(D0, 2, 0)>(vb), h2 = tr_read<v_rd_off<DV>(D0, 2, 1)>(vb), l3 = tr_read<v_rd_off<DV>(D0, 3, 0)>(vb), h3 = tr_read<v_rd_off<DV>(D0, 3, 1)>(vb);
    asm volatile("s_waitcnt lgkmcnt(0)" ::: "memory"); ATT_SBAR();
#define ATT_PK(L, H) (bf16x8){L[0], L[1], L[2], L[3], H[0], H[1], H[2], H[3]}
    od = __builtin_amdgcn_mfma_f32_32x32x16_bf16(pa0, ATT_PK(l0, h0), od, 0, 0, 0);
    od = __builtin_amdgcn_mfma_f32_32x32x16_bf16(pa1, ATT_PK(l1, h1), od, 0, 0, 0);
    od = __builtin_amdgcn_mfma_f32_32x32x16_bf16(pa2, ATT_PK(l2, h2), od, 0, 0, 0);
    od = __builtin_amdgcn_mfma_f32_32x32x16_bf16(pa3, ATT_PK(l3, h3), od, 0, 0, 0);
#undef ATT_PK
}
template <int DV> __device__ __forceinline__ void pv_all(f32x16 (&o)[DV / 32], int vb, bf16x8 pa0, bf16x8 pa1, bf16x8 pa2, bf16x8 pa3) {
    pv_one<DV, 0>(o[0], vb, pa0, pa1, pa2, pa3); pv_one<DV, 1>(o[1], vb, pa0, pa1, pa2, pa3);
    if constexpr (DV == 128) { pv_one<DV, 2>(o[2], vb, pa0, pa1, pa2, pa3); pv_one<DV, 3>(o[3], vb, pa0, pa1, pa2, pa3); }
}
template <int DQK, int DV> struct Lay { static constexpr int SHM_V = 64 * DV * 2, SHM_K = 64 * DQK * 2, OFF_V = 0, OFF_K = 2 * SHM_V, OFF_WS = OFF_K + 2 * SHM_K, OFF_STASH = OFF_WS + NW * 64 * 4; };

template <int DQK, int DV, int LDQ, int LDK, int LDV>
__device__ __forceinline__ void attn_pass(const bf16_t* __restrict__ Qb, const bf16_t* __restrict__ Kh, const bf16_t* __restrict__ Vh, int nkeys, char* lds, f32x16 (&o)[DV / 32], float (&rli)[16], int wv) {
    using L = Lay<DQK, DV>;
    constexpr int NLK = DQK / 64, NLV = DV / 64;
    int tid_ = wv * 64 + lane_id(); asm volatile("" : "+v"(tid_));
    const int tid = tid_, wid = tid >> 6, lane = tid & 63, r32 = lane & 31, hi = lane >> 5;
    char* V_lds = lds + L::OFF_V; char* K_lds = lds + L::OFF_K;
    float* ws = (float*)(lds + L::OFF_WS) + wid * 64; float* li_l = ws; float* al_l = ws + 32;
    float m_reg = 0.f, l_reg = 0.f; bf16x8 qr[DQK / 16]; f32x16 negm;
#pragma unroll
    for (int r = 0; r < 16; ++r) asm volatile("v_mov_b32 %0, 0" : "=v"(negm[r]));
#pragma unroll
    for (int d = 0; d < DV / 32; ++d) o[d] = f32x16{};
    const bf16_t* Qw = Qb + (size_t)(wid * QBLK + r32) * LDQ + hi * 8;
#pragma unroll
    for (int d0 = 0; d0 < DQK / 16; ++d0) qr[d0] = *reinterpret_cast<const bf16x8*>(Qw + d0 * 16);
    const int krow = DQK == 128 ? (tid >> 4) : (tid >> 3), kcol = DQK == 128 ? (tid & 15) * 8 : (tid & 7) * 8;
    const int vrow = DV == 128 ? (tid >> 4) : (tid >> 3), vcol = DV == 128 ? (tid & 15) * 8 : (tid & 7) * 8;
    const int vb0 = (int)(uintptr_t)V_lds + v_rd_base(lane);
    bf16x8 vsE[NLV], ksE[NLK], vsO[NLV], ksO[NLK];
#define ATT_SLOAD(VS, KS, k0) do { _Pragma("unroll") for (int i_ = 0; i_ < NLV; ++i_) VS[i_] = *reinterpret_cast<const bf16x8*>(&Vh[(size_t)((k0) + vrow + 32 * i_) * LDV + vcol]); \
    _Pragma("unroll") for (int i_ = 0; i_ < NLK; ++i_) KS[i_] = *reinterpret_cast<const bf16x8*>(&Kh[(size_t)((k0) + krow + 32 * i_) * LDK + kcol]); } while (0)
#define ATT_SWRITE(b, VS, KS) do { _Pragma("unroll") for (int i_ = 0; i_ < NLV; ++i_) *(bf16x8*)(V_lds + (b) * L::SHM_V + v_st<DV>(vrow + 32 * i_, vcol)) = VS[i_]; \
    _Pragma("unroll") for (int i_ = 0; i_ < NLK; ++i_) *(bf16x8*)(K_lds + (b) * L::SHM_K + kswz<DQK>(krow + 32 * i_, kcol * 2)) = KS[i_]; } while (0)
#define ATT_SWAIT() do { if constexpr (NLK + NLV == 4) asm volatile("s_waitcnt vmcnt(4)" ::: "memory"); else if constexpr (NLK + NLV == 3) asm volatile("s_waitcnt vmcnt(3)" ::: "memory"); else asm volatile("s_waitcnt vmcnt(2)" ::: "memory"); } while (0)
#define ATT_RESC(a) do { if (__any((a) < 1.f)) { if (hi == 0) al_l[r32] = (a); asm volatile("s_waitcnt lgkmcnt(0)" ::: "memory"); \
    _Pragma("unroll") for (int d = 0; d < DV / 32; ++d) _Pragma("unroll") for (int r = 0; r < 16; ++r) o[d][r] *= al_l[crow(r, hi)]; } } while (0)
    f32x16 pA0, pA1, pB0, pB1; float alA, alB; bf16x8 pa0, pa1, pa2, pa3; const int NT = nkeys / KVBLK;
    __syncthreads();
    ATT_SLOAD(vsE, ksE, 0); asm volatile("s_waitcnt vmcnt(0)" ::: "memory"); ATT_SWRITE(0, vsE, ksE); __syncthreads();
    qkt<DQK>(pA0, pA1, K_lds, qr, negm, r32, hi); partialSM<true>(pA0, pA1, m_reg, alA, negm);
    ATT_SLOAD(vsO, ksO, KVBLK); if (2 < NT) ATT_SLOAD(vsE, ksE, 2 * KVBLK);
    ATT_SWAIT(); ATT_SWRITE(1, vsO, ksO); __syncthreads();
    for (int j = 1; j + 1 < NT; j += 2) {
        ATT_SBAR(); qkt<DQK>(pB0, pB1, K_lds + L::SHM_K, qr, negm, r32, hi);
        finishSM(pA0, pA1, alA, l_reg, pa0, pa1, pa2, pa3); ATT_SBAR();
        ATT_SLOAD(vsO, ksO, (j + 2) * KVBLK); ATT_SBAR();
        pv_all<DV>(o, vb0, pa0, pa1, pa2, pa3); partialSM<false>(pB0, pB1, m_reg, alB, negm);
        __syncthreads(); ATT_SWAIT(); ATT_SWRITE(0, vsE, ksE);
        ATT_RESC(alB); __syncthreads();
        ATT_SBAR(); qkt<DQK>(pA0, pA1, K_lds, qr, negm, r32, hi);
        finishSM(pB0, pB1, alB, l_reg, pa0, pa1, pa2, pa3); ATT_SBAR();
        if (j + 3 < NT) ATT_SLOAD(vsE, ksE, (j + 3) * KVBLK); ATT_SBAR();
        pv_all<DV>(o, vb0 + L::SHM_V, pa0, pa1, pa2, pa3); partialSM<false>(pA0, pA1, m_reg, alA, negm);
        __syncthreads(); ATT_SWAIT(); ATT_SWRITE(1, vsO, ksO);
        ATT_RESC(alA); __syncthreads();
    }
    ATT_SBAR(); qkt<DQK>(pB0, pB1, K_lds + L::SHM_K, qr, negm, r32, hi);
    finishSM(pA0, pA1, alA, l_reg, pa0, pa1, pa2, pa3); ATT_SBAR();
    pv_all<DV>(o, vb0, pa0, pa1, pa2, pa3); partialSM<false>(pB0, pB1, m_reg, alB, negm);
    __syncthreads(); ATT_RESC(alB);
    finishSM(pB0, pB1, alB, l_reg, pa0, pa1, pa2, pa3); ATT_SBAR();
    pv_all<DV>(o, vb0 + L::SHM_V, pa0, pa1, pa2, pa3);
    if (hi == 0) li_l[r32] = l_reg; asm volatile("s_waitcnt lgkmcnt(0)" ::: "memory");
#pragma unroll
    for (int r = 0; r < 16; ++r) rli[r] = __builtin_amdgcn_rcpf(li_l[crow(r, hi)]);
#undef ATT_SLOAD
#undef ATT_SWRITE
#undef ATT_SWAIT
#undef ATT_RESC
}
template <int DV, int LDO> __device__ __forceinline__ void store_o(bf16_t* Ob, const f32x16 (&o)[DV / 32], const float (&rli)[16], int wv) {
    int tid_ = wv * 64 + lane_id(); asm volatile("" : "+v"(tid_));
    const int tid = tid_, wid = tid >> 6, lane = tid & 63, r32 = lane & 31, hi = lane >> 5;
    bf16_t* Ow = Ob + (size_t)(wid * QBLK) * LDO;
#pragma unroll
    for (int r = 0; r < 16; ++r) { const int orow = crow(r, hi);
#pragma unroll
        for (int d0 = 0; d0 < DV / 32; ++d0) Ow[(size_t)orow * LDO + d0 * 32 + r32] = f2bf(o[d0][r] * rli[r]); }
}
__device__ __forceinline__ void unit_a(const bf16_t* PROJ, bf16_t* OBR, int b, int h, int qb, const LAS float* lamp, const float* subg, char* lds, int wv) {
    using L = Lay<64, 128>;
    int tid_ = wv * 64 + lane_id(); asm volatile("" : "+v"(tid_));
    const int tid = tid_, wid = tid >> 6, lane = tid & 63, r32 = lane & 31, hi = lane >> 5;
    const bf16_t* kv = PROJ + (size_t)b * SEQ * D_IN; const size_t qrow = (size_t)b * SEQ + qb * 256;
    unsigned* stash = (unsigned*)(lds + L::OFF_STASH) + wid * 2048 + lane;
    f32x16 o[4]; float rli[16];
#pragma unroll 1
    for (int c = 0; c < 2; ++c) {
        attn_pass<64, 128, D_IN, D_IN, D_IN>(PROJ + qrow * D_IN + C_AQ + h * 128 + c * 64, kv + C_AK + h * 128 + c * 64, kv + C_AV + h * 128, SEQ, lds, o, rli, wv);
        if (c == 0) {
#pragma unroll
            for (int d0 = 0; d0 < 4; ++d0)
#pragma unroll
                for (int r = 0; r < 16; r += 2) stash[(d0 * 8 + (r >> 1)) * 64] = cvt_pk_bf16(o[d0][r] * rli[r], o[d0][r + 1] * rli[r + 1]);
        }
    }
    const float lam = lamp[0], lam_init = lamp[1];
    asm volatile("s_waitcnt lgkmcnt(0)" ::: "memory");
    float ss[16];
#pragma unroll
    for (int r = 0; r < 16; ++r) ss[r] = 0.f;
#pragma unroll
    for (int d0 = 0; d0 < 4; ++d0)
#pragma unroll
        for (int r = 0; r < 16; r += 2) { const unsigned w = stash[(d0 * 8 + (r >> 1)) * 64];
            const float c0 = __uint_as_float(w << 16) - lam * o[d0][r] * rli[r], c1 = __uint_as_float(w & 0xffff0000u) - lam * o[d0][r + 1] * rli[r + 1];
            o[d0][r] = c0; o[d0][r + 1] = c1; ss[r] += c0 * c0; ss[r + 1] += c1 * c1; }
#pragma unroll
    for (int r = 0; r < 16; ++r) { float s = ss[r]; s += xlane<1>(s); s += xlane<2>(s); s += xlane<4>(s); s += xlane<8>(s); s += xlane<16>(s);
        ss[r] = rsqrtf(s * (1.f / 128.f) + EPS) * (1.f - lam_init); }
    bf16_t* Ow = OBR + (qrow + wid * QBLK) * OBR_W + h * 128;
#pragma unroll
    for (int d0 = 0; d0 < 4; ++d0) { const float g = subg[d0 * 32 + r32];
#pragma unroll
        for (int r = 0; r < 16; ++r) Ow[(size_t)crow(r, hi) * OBR_W + d0 * 32 + r32] = f2bf(o[d0][r] * ss[r] * g); }
}
__device__ __forceinline__ void unit_b(const bf16_t* PROJ, bf16_t* OBR, int b, int qh, int qb, char* lds, int wv);
__device__ __forceinline__ void unit_c(const bf16_t* PROJ, const bf16_t* MEMKV, bf16_t* OBR, int b, int h, int qb, char* lds, int wv) {
    const bf16_t* kv = MEMKV + (size_t)b * MEM_LEN * 1024; const size_t qrow = (size_t)b * SEQ + qb * 256;
    f32x16 o[4]; float rli[16];
    attn_pass<128, 128, D_IN, 1024, 1024>(PROJ + qrow * D_IN + C_CQ + h * 128, kv + h * 128, kv + 512 + h * 128, MEM_LEN, lds, o, rli, wv);
    store_o<128, OBR_W>(OBR + qrow * OBR_W + 1024 + h * 128, o, rli, wv);
}
#undef ATT_SBAR
}

#include <hip/hip_bf16.h>
namespace attd {
using bf16=__hip_bfloat16;
using bf16x8=__attribute__((ext_vector_type(8)))short;
using s16x4=__attribute__((ext_vector_type(4)))short;
using f32x16=__attribute__((ext_vector_type(16)))float;
using u32x4=__attribute__((ext_vector_type(4)))unsigned;
constexpr int D=64;
constexpr int NW=8,QBLK=32,QB=QBLK*NW,KVBLK=64;
__device__ __forceinline__ int crow(int r,int hi){return (r&3)+8*(r>>2)+4*hi;}
#define SBAR() __builtin_amdgcn_sched_barrier(0)
__device__ __forceinline__ void cmask(f32x16&p0,f32x16&p1,int jb,int qrel,int hi){
  const float NEG=-INFINITY; int kb=64*jb+4*hi;
  #pragma unroll
  for(int r=0;r<16;++r){int kv=kb+(r&3)+8*(r>>2); if(kv>qrel)p0[r]=NEG; if(kv+32>qrel)p1[r]=NEG;}
}

constexpr int NSLOT=3, SLOTB=8192;
constexpr int LDS_K=0, LDS_V=NSLOT*SLOTB, LDS_WS=2*NSLOT*SLOTB, LDS_OST=LDS_WS+NW*64*4, LDS_BYTES=LDS_OST+NW*4096;
constexpr float C2=0.125f*1.4426950408889634f;
__device__ __forceinline__ void glds16(const void*gsrc,unsigned lds_dst){unsigned keep;
  asm volatile("s_mov_b32 %0, m0\n\ts_mov_b32 m0, %2\n\ts_nop 0\n\tglobal_load_lds_dwordx4 %1, off\n\ts_mov_b32 m0, %0":"=&s"(keep):"v"(gsrc),"s"(lds_dst):"memory");}
__device__ __forceinline__ float max3f(float a,float b,float c){float r;asm("v_max3_f32 %0, %1, %2, %3":"=v"(r):"v"(a),"v"(b),"v"(c));return r;}
__device__ __forceinline__ float max2f(float a,float b){float r;asm("v_max_f32_e32 %0, %1, %2":"=v"(r):"v"(a),"v"(b));return r;}
__device__ __forceinline__ float fadd_s(float a,float b){float r;asm("v_add_f32_e32 %0, %1, %2":"=v"(r):"v"(a),"v"(b));return r;}
__device__ __forceinline__ float fsub_s(float a,float b){float r;asm("v_sub_f32_e32 %0, %1, %2":"=v"(r):"v"(a),"v"(b));return r;}
typedef float f32x2_t __attribute__((ext_vector_type(2))); typedef __bf16 bf16x2_t __attribute__((ext_vector_type(2)));
__device__ __forceinline__ unsigned cvtpk_s(float lo,float hi){f32x2_t v={lo,hi};bf16x2_t b=__builtin_convertvector(v,bf16x2_t);return __builtin_bit_cast(unsigned,b);}
#define WAIT_BAR(N) asm volatile("s_waitcnt vmcnt(" #N ") lgkmcnt(0)\n\ts_barrier":::"memory")

__device__ __forceinline__ void qkt(f32x16&p0,f32x16&p1,const char*Kslot,const bf16x8*qr,const f32x16&negm,int r32,int hi){
  const char*kb=Kslot+hi*1024+r32*16;
  #pragma unroll
  for(int d0=0;d0<4;++d0){
    const bf16x8 b0=*reinterpret_cast<const bf16x8*>(kb+d0*2048);
    const bf16x8 b1=*reinterpret_cast<const bf16x8*>(kb+d0*2048+512);
    if(d0==0){p0=__builtin_amdgcn_mfma_f32_32x32x16_bf16(b0,qr[0],negm,0,0,0);p1=__builtin_amdgcn_mfma_f32_32x32x16_bf16(b1,qr[0],negm,0,0,0);}
    else{p0=__builtin_amdgcn_mfma_f32_32x32x16_bf16(b0,qr[d0],p0,0,0,0);p1=__builtin_amdgcn_mfma_f32_32x32x16_bf16(b1,qr[d0],p1,0,0,0);}}
}
typedef __attribute__((address_space(3))) const char* lds_cptr;
typedef short v4i16_t __attribute__((ext_vector_type(4)));
__device__ __forceinline__ void kload8(bf16x8*kf,lds_cptr kp){
  kf[0]=*(const __attribute__((address_space(3))) bf16x8*)(kp);      kf[1]=*(const __attribute__((address_space(3))) bf16x8*)(kp+512);
  kf[2]=*(const __attribute__((address_space(3))) bf16x8*)(kp+2048); kf[3]=*(const __attribute__((address_space(3))) bf16x8*)(kp+2560);
  kf[4]=*(const __attribute__((address_space(3))) bf16x8*)(kp+4096); kf[5]=*(const __attribute__((address_space(3))) bf16x8*)(kp+4608);
  kf[6]=*(const __attribute__((address_space(3))) bf16x8*)(kp+6144); kf[7]=*(const __attribute__((address_space(3))) bf16x8*)(kp+6656);
}
__device__ __forceinline__ void kload2(bf16x8*kf,lds_cptr kp,int j){ kf[2*j]=*(const __attribute__((address_space(3))) bf16x8*)(kp+j*2048); kf[2*j+1]=*(const __attribute__((address_space(3))) bf16x8*)(kp+j*2048+512); }
__device__ __forceinline__ s16x4 vtr(lds_cptr p){ return __builtin_bit_cast(s16x4,__builtin_amdgcn_ds_read_tr16_b64_v4i16((__attribute__((address_space(3))) v4i16_t*)p)); }
__device__ __forceinline__ float rowmax(const f32x16&p0,const f32x16&p1){
  float a=max3f(p0[0],p0[1],p1[0]),b=max3f(p0[2],p0[3],p1[1]);a=max3f(a,p1[2],p1[3]);
  #pragma unroll
  for(int r=4;r<16;r+=4){a=max3f(a,p0[r],p0[r+1]);b=max3f(b,p0[r+2],p0[r+3]);a=max3f(a,p1[r],p1[r+1]);b=max3f(b,p1[r+2],p1[r+3]);}
  const float m=max2f(a,b);
  auto rr=__builtin_amdgcn_permlane32_swap(__float_as_uint(m),__float_as_uint(m),false,false);
  return max2f(__uint_as_float(rr[0]),__uint_as_float(rr[1]));
}
__device__ __forceinline__ void pv(f32x16*o,int vb,bf16x8 pa0,bf16x8 pa1,bf16x8 pa2,bf16x8 pa3){
  #pragma unroll
  for(int d0=0;d0<2;++d0){s16x4 lo[4],hi[4];
    #pragma unroll
    for(int ks=0;ks<4;++ks){
      asm volatile("ds_read_b64_tr_b16 %0,%1 offset:%c2":"=&v"(lo[ks]):"v"(vb),"i"(d0*4096+ks*1024):"memory");
      asm volatile("ds_read_b64_tr_b16 %0,%1 offset:%c2":"=&v"(hi[ks]):"v"(vb),"i"(d0*4096+ks*1024+512):"memory");}
    asm volatile("s_waitcnt lgkmcnt(0)":::"memory");SBAR();
    #define PK(k) (bf16x8){lo[k][0],lo[k][1],lo[k][2],lo[k][3],hi[k][0],hi[k][1],hi[k][2],hi[k][3]}
    o[d0]=__builtin_amdgcn_mfma_f32_32x32x16_bf16(pa0,PK(0),o[d0],0,0,0);
    o[d0]=__builtin_amdgcn_mfma_f32_32x32x16_bf16(pa1,PK(1),o[d0],0,0,0);
    o[d0]=__builtin_amdgcn_mfma_f32_32x32x16_bf16(pa2,PK(2),o[d0],0,0,0);
    o[d0]=__builtin_amdgcn_mfma_f32_32x32x16_bf16(pa3,PK(3),o[d0],0,0,0);
    #undef PK
  }
}

#ifndef ATTN_STORE16
#define ATTN_STORE16(p,v) (*(u32x4*)(p)=(v))
#endif
template<int THRL,int QP,int KP,int OP> __device__ __forceinline__ void attn_unit(const bf16*Qb,const bf16*__restrict__ Kh,const bf16*__restrict__ Vh,bf16*Ob,int nkeys,char*shm,int wv){
  int tid_=wv*64+lane_id(); asm volatile("":"+v"(tid_)); const int tid=tid_,lane=tid&63,r32=lane&31,hi=lane>>5; const int wid=wv;
  constexpr int DM=KP;
  const bf16*Qw=Qb+(long)(wid*QBLK)*QP;
  const unsigned lds0=(unsigned)(uintptr_t)shm;
  float*wsf=(float*)(shm+LDS_WS)+wid*64;
  const bf16*ksrc=Kh+(long)lane*DM+wid*8;
  const bf16*vsrc=Vh+(long)(16*(wid&3)+(lane>>2))*DM+(wid>>2)*32+(lane&3)*8;
  const unsigned kdst=lds0+LDS_K+wid*1024, vdst=lds0+LDS_V+wid*1024;
  #define DMA_K(t,slot) glds16(ksrc+(long)(t)*KVBLK*DM,(unsigned)__builtin_amdgcn_readfirstlane(kdst+(slot)))
  #define DMA_V(t,slot) glds16(vsrc+(long)(t)*KVBLK*DM,(unsigned)__builtin_amdgcn_readfirstlane(vdst+(slot)))
  const int vb0=(int)(lds0+LDS_V)+((lane>>4)&1)*32+(lane&3)*8+(4*hi+((lane&15)>>2))*64;
  const char*Kbase=shm+LDS_K; bf16x8 kf[8];
  const lds_cptr shm3=(lds_cptr)shm; const lds_cptr kp0=shm3+LDS_K+hi*1024+r32*16; const lds_cptr vp0=shm3+LDS_V+((lane>>4)&1)*32+(lane&3)*8+(4*hi+((lane&15)>>2))*64;
  const int NT=nkeys/KVBLK;
  DMA_K(0,0);DMA_V(0,0);DMA_K(1,SLOTB);
  bf16x8 qr[4];
  #pragma unroll
  for(int d0=0;d0<4;++d0)qr[d0]=*reinterpret_cast<const bf16x8*>(&Qw[(long)r32*QP+d0*16+hi*8]);
  float mhat=0.f,l_reg=0.f;f32x16 o[2],negm;
  #pragma unroll
  for(int r=0;r<16;++r){asm volatile("v_mov_b32 %0, 0":"=v"(o[0][r]));asm volatile("v_mov_b32 %0, 0":"=v"(o[1][r]));asm volatile("v_mov_b32 %0, 0":"=v"(negm[r]));}
  #define CMASK(P0,P1,t) do{}while(0)
  bool resc=false;
  #define START(P0,P1) do{ const float rm=rowmax(P0,P1); resc=false; \
    { const float dl=rm; mhat=fadd_s(mhat,dl); \
      _Pragma("unroll") for(int r=0;r<16;++r){P0[r]=fsub_s(P0[r],dl);P1[r]=fsub_s(P1[r],dl);} \
      _Pragma("unroll") for(int r=0;r<16;++r)negm[r]=-mhat; asm volatile("":"+v"(negm)); } \
    _Pragma("unroll") for(int r=0;r<16;++r)P0[r]=__builtin_amdgcn_exp2f(P0[r]); }while(0)
  #define RESC() do{ if(resc){ asm volatile("s_waitcnt lgkmcnt(0)":::"memory"); \
      _Pragma("unroll") for(int d_=0;d_<2;++d_) _Pragma("unroll") for(int r=0;r<16;++r)o[d_][r]*=wsf[crow(r,hi)]; } }while(0)
  f32x16 pA0,pA1,pB0,pB1;
  int sl_prev=0,sl_cur=0,sl_next=SLOTB;
  #define ROT() do{sl_prev=sl_cur;sl_cur=sl_next;sl_next=(sl_next==(NSLOT-1)*SLOTB)?0:sl_next+SLOTB;}while(0)
  DMA_K(2,2*SLOTB);
  WAIT_BAR(3);
  qkt(pA0,pA1,Kbase,qr,negm,r32,hi);asm volatile("s_nop 15\n\ts_nop 7":"+v"(pA0),"+v"(pA1));CMASK(pA0,pA1,0);
  START(pA0,pA1);
  _Pragma("unroll") for(int r=0;r<16;++r)pA1[r]=__builtin_amdgcn_exp2f(pA1[r]);
  WAIT_BAR(0);
  DMA_K(3,0);DMA_V(1,SLOTB);
  ROT();
  kload8(kf,kp0+sl_cur);
  WAIT_BAR(2);
  s16x4 vlo[8],vhi[8]; u32x4 pw0,pw1,pw2,pw3;
  #define PKW(P,B) cvtpk_s(P[B],P[B+1])
  #define PAF(k) __builtin_bit_cast(bf16x8,pw##k)
  #define VFR(i) (bf16x8){vlo[i][0],vlo[i][1],vlo[i][2],vlo[i][3],vhi[i][0],vhi[i][1],vhi[i][2],vhi[i][3]}
  #define PIN(x) asm volatile("":"+v"(x))
  #define MX3(a,b,c) __builtin_fmaxf(__builtin_fmaxf((a),(b)),(c))
  #define GAPA(MF,A0,A1,A2,A3,W0,W1,PW) do{ MF; sacc+=A0; sacc+=A1; sacc+=A2; sacc+=A3; PIN(sacc); W0; W1; PIN(PW); SBAR(); }while(0)
  #define EX(v) __builtin_amdgcn_exp2f(v)
  #define GAPB(MF,X,B) do{ MF; X[B]=EX(X[B]); X[B+1]=EX(X[B+1]); X[B+2]=EX(X[B+2]); X[B+3]=EX(X[B+3]); PIN(X); SBAR(); }while(0)
  #define VRD(i) do{ vlo[i]=vtr(vp_+(((i)>>2)*4096+((i)&3)*1024)); vhi[i]=vtr(vp_+(((i)>>2)*4096+((i)&3)*1024+512)); }while(0)
  #define KRD(G,j) do{ if(G){ kload2(kf,kp0+sl_next,j); SBAR(); } }while(0)
  #define STEP(C0,C1,P0,P1,t,GK,GV,GL) do{ SBAR(); \
    const lds_cptr vp_=vp0+sl_prev; \
    VRD(0); SBAR(); float sacc=(P0[0]+P0[1]); \
    GAPA(C0=__builtin_amdgcn_mfma_f32_32x32x16_bf16(kf[0],qr[0],negm,0,0,0), P0[2],P0[3],P0[4],P0[5],     pw0[0]=PKW(P0,0), pw0[1]=PKW(P0,2), pw0); \
    VRD(4); SBAR(); GAPA(C1=__builtin_amdgcn_mfma_f32_32x32x16_bf16(kf[1],qr[0],negm,0,0,0), P0[6],P0[7],P0[8],P0[9],     pw0[2]=PKW(P0,4), pw0[3]=PKW(P0,6), pw0); \
    VRD(1); SBAR(); GAPA(C0=__builtin_amdgcn_mfma_f32_32x32x16_bf16(kf[2],qr[1],C0,0,0,0),   P0[10],P0[11],P0[12],P0[13], pw1[0]=PKW(P0,8), pw1[1]=PKW(P0,10), pw1); \
    VRD(5); SBAR(); GAPA(C1=__builtin_amdgcn_mfma_f32_32x32x16_bf16(kf[3],qr[1],C1,0,0,0),   P0[14],P0[15],P1[0],P1[1],   pw1[2]=PKW(P0,12),pw1[3]=PKW(P0,14), pw1); \
    VRD(2); SBAR(); GAPA(C0=__builtin_amdgcn_mfma_f32_32x32x16_bf16(kf[4],qr[2],C0,0,0,0),   P1[2],P1[3],P1[4],P1[5],     pw2[0]=PKW(P1,0), pw2[1]=PKW(P1,2), pw2); \
    VRD(6); SBAR(); GAPA(C1=__builtin_amdgcn_mfma_f32_32x32x16_bf16(kf[5],qr[2],C1,0,0,0),   P1[6],P1[7],P1[8],P1[9],     pw2[2]=PKW(P1,4), pw2[3]=PKW(P1,6), pw2); \
    VRD(3); SBAR(); GAPA(C0=__builtin_amdgcn_mfma_f32_32x32x16_bf16(kf[6],qr[3],C0,0,0,0),   P1[10],P1[11],P1[12],P1[13], pw3[0]=PKW(P1,8), pw3[1]=PKW(P1,10), pw3); \
    VRD(7); SBAR(); GAPA(C1=__builtin_amdgcn_mfma_f32_32x32x16_bf16(kf[7],qr[3],C1,0,0,0),   P1[14],P1[15],0.f,0.f,       pw3[2]=PKW(P1,12),pw3[3]=PKW(P1,14), pw3); \
    l_reg+=sacc; \
    if(GK){DMA_K((t)+3,sl_cur);} if(GV){DMA_V((t)+1,sl_next);} \
    CMASK(C0,C1,t); \
    { float a=MX3(C0[0],C0[1],C1[0]),b=MX3(C0[2],C0[3],C1[1]); a=MX3(a,C1[2],C1[3]); \
      _Pragma("unroll") for(int r=4;r<16;r+=4){a=MX3(a,C0[r],C0[r+1]);b=MX3(b,C0[r+2],C0[r+3]);a=MX3(a,C1[r],C1[r+1]);b=MX3(b,C1[r+2],C1[r+3]);} \
      float rm=__builtin_fmaxf(a,b); { auto rr=__builtin_amdgcn_permlane32_swap(__float_as_uint(rm),__float_as_uint(rm),false,false); rm=__builtin_fmaxf(__uint_as_float(rr[0]),__uint_as_float(rr[1])); } \
      resc=false; \
      if(__builtin_expect(__any(rm>(float)THRL),0)){ const float dl=__builtin_fmaxf(rm,0.f); mhat+=dl; \
        _Pragma("unroll") for(int r=0;r<16;++r){C0[r]-=dl;C1[r]-=dl;} \
        _Pragma("unroll") for(int r=0;r<16;++r)negm[r]=-mhat; asm volatile("":"+v"(negm)); \
        const float f=__builtin_amdgcn_exp2f(-dl); l_reg*=f; if(hi==0)wsf[r32]=f; resc=true; } } \
    SBAR(); \
    GAPB(o[0]=__builtin_amdgcn_mfma_f32_32x32x16_bf16(PAF(0),VFR(0),o[0],0,0,0), C0,0); \
    GAPB(o[1]=__builtin_amdgcn_mfma_f32_32x32x16_bf16(PAF(0),VFR(4),o[1],0,0,0), C0,4); \
    KRD(GL,0); GAPB(o[0]=__builtin_amdgcn_mfma_f32_32x32x16_bf16(PAF(1),VFR(1),o[0],0,0,0), C0,8); \
    KRD(GL,1); GAPB(o[1]=__builtin_amdgcn_mfma_f32_32x32x16_bf16(PAF(1),VFR(5),o[1],0,0,0), C0,12); \
    KRD(GL,2); GAPB(o[0]=__builtin_amdgcn_mfma_f32_32x32x16_bf16(PAF(2),VFR(2),o[0],0,0,0), C1,0); \
    KRD(GL,3); GAPB(o[1]=__builtin_amdgcn_mfma_f32_32x32x16_bf16(PAF(2),VFR(6),o[1],0,0,0), C1,4); \
    GAPB(o[0]=__builtin_amdgcn_mfma_f32_32x32x16_bf16(PAF(3),VFR(3),o[0],0,0,0), C1,8); \
    GAPB(o[1]=__builtin_amdgcn_mfma_f32_32x32x16_bf16(PAF(3),VFR(7),o[1],0,0,0), C1,12); \
    }while(0)
  int t=1;
  #undef CMASK
  #define CMASK(P0,P1,t) do{}while(0)
  for(;t+5<NT;t+=2){
    STEP(pB0,pB1,pA0,pA1,t,true,true,true);     WAIT_BAR(2); RESC(); ROT();
    STEP(pA0,pA1,pB0,pB1,t+1,true,true,true);   WAIT_BAR(2); RESC(); ROT();
  }
  #undef CMASK
  #define CMASK(P0,P1,t) do{}while(0)
  #define ENDW(tt) do{ if((tt)+3<NT){WAIT_BAR(2);} else if((tt)+2<NT){WAIT_BAR(1);} else {WAIT_BAR(0);} }while(0)
  for(;t+1<NT;t+=2){
    STEP(pB0,pB1,pA0,pA1,t,(t+3<NT),(t+1<NT),(t+1<NT));       ENDW(t);   RESC(); ROT();
    STEP(pA0,pA1,pB0,pB1,t+1,(t+4<NT),(t+2<NT),(t+2<NT));     ENDW(t+1); RESC(); ROT();
  }
  STEP(pB0,pB1,pA0,pA1,NT-1,false,false,false); RESC();
  { float sacc=pB0[0]+pB0[1]; _Pragma("unroll") for(int r=2;r<16;++r)sacc+=pB0[r]; _Pragma("unroll") for(int r=0;r<16;++r)sacc+=pB1[r]; l_reg+=sacc;
    pw0=(u32x4){PKW(pB0,0),PKW(pB0,2),PKW(pB0,4),PKW(pB0,6)};pw1=(u32x4){PKW(pB0,8),PKW(pB0,10),PKW(pB0,12),PKW(pB0,14)};pw2=(u32x4){PKW(pB1,0),PKW(pB1,2),PKW(pB1,4),PKW(pB1,6)};pw3=(u32x4){PKW(pB1,8),PKW(pB1,10),PKW(pB1,12),PKW(pB1,14)};
    SBAR(); pv(o,vb0+sl_cur,PAF(0),PAF(1),PAF(2),PAF(3)); }
  #undef PKW
  #undef PAF
  #undef VFR
  #undef PIN
  #undef MX3
  #undef GAPA
  #undef GAPB
  #undef EX
  #undef VRD
  #undef KRD
  #undef STEP
  #undef ENDW
  {auto rr=__builtin_amdgcn_permlane32_swap(__float_as_uint(l_reg),__float_as_uint(l_reg),false,false);l_reg=__uint_as_float(rr[0])+__uint_as_float(rr[1]);}
  if(hi==0)wsf[32+r32]=l_reg;asm volatile("s_waitcnt lgkmcnt(0)":::"memory");
  float rli[16];
  #pragma unroll
  for(int r=0;r<16;++r)rli[r]=__builtin_amdgcn_rcpf(wsf[32+crow(r,hi)]);
  bf16*Ow=Ob+(long)(wid*QBLK)*OP;
  { bf16*stg=(bf16*)(shm+LDS_OST)+wid*2048;
    #pragma unroll
    for(int r=0;r<16;++r){const int orow=crow(r,hi);
      #pragma unroll
      for(int d0=0;d0<2;++d0)stg[orow*64+d0*32+r32]=__float2bfloat16(o[d0][r]*rli[r]);}
    asm volatile("s_waitcnt lgkmcnt(0)":::"memory");
    #pragma unroll
    for(int i=0;i<4;++i){const int row=i*8+(lane>>3),ch=lane&7; const u32x4 v=*(const u32x4*)(stg+row*64+ch*8); ATTN_STORE16(Ow+(long)row*OP+ch*8,v);} }
  asm volatile("s_waitcnt lgkmcnt(0)\n\ts_barrier":::"memory");
  #undef DMA_K
  #undef DMA_V
  #undef CMASK
  #undef START
  #undef RESC
  #undef ROT
}
constexpr int ATTN_LDS_BYTES=LDS_BYTES;
#undef SBAR
#undef WAIT_BAR
}
namespace att {
__device__ __forceinline__ void unit_b(const bf16_t* PROJ, bf16_t* OBR, int b, int qh, int qb, char* lds, int wv) {
    const bf16_t* kv = PROJ + (size_t)b * SEQ * D_IN; const size_t qrow = (size_t)b * SEQ + qb * 256;
    __syncthreads();
    attd::attn_unit<8, D_IN, D_IN, OBR_W>((const attd::bf16*)(PROJ + qrow * D_IN + C_BQ + qh * 64), (const attd::bf16*)(kv + C_BK + (qh >> 2) * 64), (const attd::bf16*)(kv + C_BV + (qh >> 2) * 64),
                                          (attd::bf16*)(OBR + qrow * OBR_W + 512 + qh * 64), SEQ, lds, wv);
}
}
template <int NR, bool NORM>
__device__ __forceinline__ void rows_in(const float* __restrict__ xbase, const float* __restrict__ g, bf16_t* __restrict__ obase, float* __restrict__ rstd_out, int row0, int lane, unsigned char* __restrict__ xq = nullptr) {
    f32x4 v[NR][4];
#pragma unroll
    for (int r = 0; r < NR; ++r)
#pragma unroll
        for (int j = 0; j < 4; ++j) v[r][j] = ((const f32x4*)(xbase + (size_t)(row0 + r) * DM))[lane + 64 * j];
    f32x4 gg[4];
#pragma unroll
    for (int j = 0; j < 4; ++j) gg[j] = NORM ? ((const f32x4*)g)[lane + 64 * j] : (f32x4){1.f, 1.f, 1.f, 1.f};
#pragma unroll
    for (int r = 0; r < NR; ++r) { float s = 0.f;
#pragma unroll
        for (int j = 0; j < 4; ++j) s += v[r][j].x * v[r][j].x + v[r][j].y * v[r][j].y + v[r][j].z * v[r][j].z + v[r][j].w * v[r][j].w;
        const float rs0 = rsqrtf(wave_sum(s) * (1.f / DM) + EPS), rs = NORM ? rs0 : 1.f;
        if (!NORM && lane == 0) rstd_out[row0 + r] = rs0;
#pragma unroll
        for (int j = 0; j < 4; ++j) { u32x2 o; o.x = cvt_pk_bf16(v[r][j].x * rs * gg[j].x, v[r][j].y * rs * gg[j].y); o.y = cvt_pk_bf16(v[r][j].z * rs * gg[j].z, v[r][j].w * rs * gg[j].w);
            ((u32x2*)(obase + (size_t)(row0 + r) * XP))[lane + 64 * j] = o;
            if (!NORM) ((unsigned*)(xq + (size_t)(row0 + r) * DM))[lane + 64 * j] = pack4_fp8(v[r][j]); } }
}
__device__ __forceinline__ void route_block(const bf16_t* __restrict__ X, const bf16_t* __restrict__ rt_tab, const float* __restrict__ brg, const float* __restrict__ bre, int* __restrict__ experts, float* __restrict__ weights,
                                            int* __restrict__ rank, unsigned* __restrict__ cnt, float* __restrict__ rstd, int* __restrict__ list, const float* __restrict__ g2, unsigned char* __restrict__ XQ, int rb, const bf16x8 (&Bh)[3][4], const bf16x8 (&Bl)[3][4], LAS float* slab, int tid, int wave) {
    const int lane = tid & 63, r = lane & 15, kq = lane >> 4;
    LAS float* ssq = slab + 8 * 64 * 48; LAS float* rs_l = ssq + 8 * 64;
#pragma unroll 1
    for (int rtp = 0; rtp < 2; ++rtp) {
        bf16x8 xa[2][4];
#pragma unroll
        for (int q = 0; q < 2; ++q) { const bf16_t* xp = X + (size_t)(rb * 64 + (rtp * 2 + q) * 16 + r) * XP + 128 * wave + 8 * kq;
#pragma unroll
            for (int sI = 0; sI < 4; ++sI) xa[q][sI] = *(const bf16x8*)(xp + 32 * sI); }
        f32x4 gq[4][2];
#pragma unroll
        for (int sI = 0; sI < 4; ++sI) { gq[sI][0] = *(const f32x4*)(g2 + 128 * wave + 32 * sI + 8 * kq); gq[sI][1] = *(const f32x4*)(g2 + 128 * wave + 32 * sI + 8 * kq + 4); }
#pragma unroll
        for (int q = 0; q < 2; ++q) { const int rt = rtp * 2 + q;
            f32x4 acc[3]; float ss = 0.f;
#pragma unroll
            for (int t = 0; t < 3; ++t) acc[t] = (f32x4){0.f, 0.f, 0.f, 0.f};
#pragma unroll
            for (int sI = 0; sI < 4; ++sI) {
                const bf16x8 Ah = xa[q][sI]; f32x4 a0, a1; pg8::unpack8(__builtin_bit_cast(u32x4, Ah), a0, a1);
                ss += (a0[0] * a0[0] + a0[1] * a0[1]) + (a0[2] * a0[2] + a0[3] * a0[3]) + (a1[0] * a1[0] + a1[1] * a1[1]) + (a1[2] * a1[2] + a1[3] * a1[3]);
                *(u32x2*)(XQ + (size_t)(rb * 64 + rt * 16 + r) * DM + 128 * wave + 32 * sI + 8 * kq) = pack8_fp8(a0 * gq[sI][0], a1 * gq[sI][1]);
#pragma unroll
                for (int t = 0; t < 3; ++t) {
                    acc[t] = __builtin_amdgcn_mfma_f32_16x16x32_bf16(Ah, Bh[t][sI], acc[t], 0, 0, 0);
                    acc[t] = __builtin_amdgcn_mfma_f32_16x16x32_bf16(Ah, Bl[t][sI], acc[t], 0, 0, 0);
                }
            }
            ss += xlane<16>(ss); ss = half_sum(ss);
            if (kq == 0) ssq[wave * 64 + rt * 16 + r] = ss;
#pragma unroll
            for (int t = 0; t < 3; ++t)
#pragma unroll
                for (int e = 0; e < 4; ++e) slab[(wave * 64 + rt * 16 + 4 * kq + e) * 48 + 16 * t + r] = acc[t][e];
        }
    }
    __syncthreads();
    if (tid < 64) {
        const int row = rb * 64 + tid;
        float lg[36]; float ss = 0.f;
#pragma unroll
        for (int c = 0; c < 36; ++c) lg[c] = 0.f;
#pragma unroll 1
        for (int w = 0; w < 8; ++w) { ss += ssq[w * 64 + tid];
#pragma unroll
            for (int c = 0; c < 36; ++c) lg[c] += slab[(w * 64 + tid) * 48 + c]; }
        const float rs = rsqrtf(ss * (1.f / DM) + EPS);
        rstd[row] = rs;
        int gi = 0; float gm = lg[0] * rs + brg[0];
#pragma unroll
        for (int i = 1; i < 4; ++i) { const float l = lg[i] * rs + brg[i]; if (l > gm) { gm = l; gi = i; } }
        float gs = 0.f;
#pragma unroll
        for (int i = 0; i < 4; ++i) gs += __expf(lg[i] * rs + brg[i] - gm);
        const float gp = 1.f / gs;
        float el[8];
#pragma unroll
        for (int i = 0; i < 8; ++i) el[i] = 0.f;
#pragma unroll
        for (int gq = 0; gq < 4; ++gq) if (gq == gi) {
#pragma unroll
            for (int i = 0; i < 8; ++i) el[i] = lg[4 + gq * 8 + i] * rs + bre[gq * 8 + i]; }
        int i0 = 0; float l0 = el[0];
#pragma unroll
        for (int i = 1; i < 8; ++i) if (el[i] > l0) { l0 = el[i]; i0 = i; }
        int i1 = -1; float l1 = -INFINITY;
#pragma unroll
        for (int i = 0; i < 8; ++i) if (i != i0 && el[i] > l1) { l1 = el[i]; i1 = i; }
        const float p1 = __expf(l1 - l0), inv = 1.f / (1.f + p1);
        const int e0 = gi * 8 + i0, e1 = gi * 8 + i1;
        experts[row * 2] = e0; experts[row * 2 + 1] = e1;
        weights[row * 2] = gp * inv; weights[row * 2 + 1] = gp * p1 * inv;
        LAS unsigned* lc = (LAS unsigned*)(rs_l + 64); LAS unsigned* gb = lc + 32;
        if (tid < 32) lc[tid] = 0u;
        asm volatile("s_waitcnt lgkmcnt(0)" ::: "memory");
        unsigned q0, q1; const unsigned one = 1u, a0_ = (unsigned)(uintptr_t)(lc + e0), a1_ = (unsigned)(uintptr_t)(lc + e1);
        asm volatile("ds_add_rtn_u32 %0, %1, %2\n\ts_waitcnt lgkmcnt(0)" : "=v"(q0) : "v"(a0_), "v"(one) : "memory");
        asm volatile("ds_add_rtn_u32 %0, %1, %2\n\ts_waitcnt lgkmcnt(0)" : "=v"(q1) : "v"(a1_), "v"(one) : "memory");
        if (tid < 32) { const unsigned n = lc[tid]; gb[tid] = n ? atomicAdd(cnt + 64 * tid, n) : 0u; }
        const int r0 = (int)(gb[e0] + q0), r1 = (int)(gb[e1] + q1);
        rank[row * 2] = r0; rank[row * 2 + 1] = r1;
        list[e0 * LCAP + r0] = row * 2; list[e1 * LCAP + r1] = row * 2 + 1;
        rs_l[tid] = rs;
    }
    __syncthreads();
}
__device__ __forceinline__ void moe_tables(const unsigned* cnt, volatile LAS int* mt, int tid) {
    if (tid < 64) {
        if (tid < 32) mt[32 + tid] = (int)__hip_atomic_load(cnt + 64 * tid, __ATOMIC_RELAXED, __HIP_MEMORY_SCOPE_AGENT);
        asm volatile("s_waitcnt vmcnt(0) lgkmcnt(0)" ::: "memory");
        if (tid == 0) { int off = 0, nt = 0;
#pragma unroll 1
            for (int e = 0; e < NEXP; ++e) { const int c = mt[32 + e], t = (c + MOE_TILE - 1) / MOE_TILE;
                mt[e] = off; mt[64 + e] = nt;
#pragma unroll 1
                for (int i = 0; i < t; ++i) mt[96 + nt + i] = e;
                nt += t; off += t * MOE_TILE; }
            mt[256] = nt; }
    }
    __syncthreads();
}
__device__ __forceinline__ void moe_rowtabs(volatile LAS int* mt, const int* __restrict__ list, const float* __restrict__ weights, const float* __restrict__ rstd, LAS unsigned* rowtab, LAS float* wtab, int bx, int G, int tid, int up) {
    const int ntiles = mt[256], rem = (ntiles * 4) % G;
#pragma unroll 1
    for (int i = 0; i < 4; ++i) { const long L = up ? (long)i * G + bx : (long)pg8::moe_down_unit(bx, i, rem, G); if (L >= (long)ntiles * 4) break;
        if (tid < 256) { const int tile = (int)(L >> 2), e = mt[96 + tile], q = (tile - mt[64 + e]) * 256 + tid; const bool valid = q < mt[32 + e];
            const int a = valid ? list[e * LCAP + q] : 0;
            if (up) { rowtab[i * 256 + tid] = (unsigned)(a >> 1) * (unsigned)DM; wtab[i * 256 + tid] = valid ? rstd[a >> 1] : 0.f; }
            else wtab[i * 256 + tid] = valid ? weights[a] : -1.f; } }
    __syncthreads();
}
template <int NR>
__device__ __forceinline__ void rows_combine_norm(bf16_t* __restrict__ XB, const unsigned char* __restrict__ YB, const float* __restrict__ g, float* __restrict__ RS, float* __restrict__ OUT, const int (&row)[NR], int lane, bool poison, const int (&d0)[NR], const int (&d1)[NR], unsigned char* __restrict__ XQ) {
    u32x2 xq[NR][4]; unsigned ya[NR][4], yb[NR][4];
#pragma unroll
    for (int r = 0; r < NR; ++r)
#pragma unroll
        for (int j = 0; j < 4; ++j) { xq[r][j] = ((const u32x2*)(XB + (size_t)row[r] * XP))[lane + 64 * j];
            ya[r][j] = ((const unsigned*)(YB + (size_t)d0[r] * DM))[lane + 64 * j]; yb[r][j] = ((const unsigned*)(YB + (size_t)d1[r] * DM))[lane + 64 * j]; }
    f32x4 gg[4];
#pragma unroll
    for (int j = 0; j < 4; ++j) gg[j] = ((const f32x4*)g)[lane + 64 * j];
    f32x4 v[NR][4]; float s[NR];
#pragma unroll
    for (int r = 0; r < NR; ++r) { s[r] = 0.f;
#pragma unroll
        for (int j = 0; j < 4; ++j) { const u32x2 x = xq[r][j]; constexpr float ys = 1.f / 64.f;
            const f32x2 a0 = __builtin_amdgcn_cvt_pk_f32_fp8((int)ya[r][j], false), a1 = __builtin_amdgcn_cvt_pk_f32_fp8((int)ya[r][j], true), b0 = __builtin_amdgcn_cvt_pk_f32_fp8((int)yb[r][j], false), b1 = __builtin_amdgcn_cvt_pk_f32_fp8((int)yb[r][j], true);
            v[r][j].x = __uint_as_float(x.x << 16) + (a0[0] + b0[0]) * ys; v[r][j].y = __uint_as_float(x.x & 0xffff0000u) + (a0[1] + b0[1]) * ys;
            v[r][j].z = __uint_as_float(x.y << 16) + (a1[0] + b1[0]) * ys; v[r][j].w = __uint_as_float(x.y & 0xffff0000u) + (a1[1] + b1[1]) * ys;
            s[r] += v[r][j].x * v[r][j].x + v[r][j].y * v[r][j].y + v[r][j].z * v[r][j].z + v[r][j].w * v[r][j].w; } }
#pragma unroll
    for (int r = 0; r < NR; ++r) {
        float rs = rsqrtf(wave_sum(s[r]) * (1.f / DM) + EPS);
        if (poison) rs = __builtin_nanf("");
        if (RS && lane == 0) RS[row[r]] = rs;
#pragma unroll
        for (int j = 0; j < 4; ++j) {
            if (RS) { u32x2 xo; xo.x = cvt_pk_bf16(v[r][j].x, v[r][j].y); xo.y = cvt_pk_bf16(v[r][j].z, v[r][j].w); ((u32x2*)(XB + (size_t)row[r] * XP))[lane + 64 * j] = xo; ((unsigned*)(XQ + (size_t)row[r] * DM))[lane + 64 * j] = pack4_fp8(v[r][j]); }
            else { f32x4 o; o.x = v[r][j].x * rs * gg[j].x; o.y = v[r][j].y * rs * gg[j].y; o.z = v[r][j].z * rs * gg[j].z; o.w = v[r][j].w * rs * gg[j].w; ((f32x4*)(OUT + (size_t)row[r] * DM))[lane + 64 * j] = o; }
        }
    }
}
constexpr float W8_SCALE = 64.f;
struct TrItem { const float* src; bf16_t* dst; int ldw, K; };
template <int OFF> __device__ __forceinline__ unsigned long long karg64() { unsigned long long v; asm volatile("s_load_dwordx2 %0, %1, %2\n\ts_waitcnt lgkmcnt(0)" : "=s"(v) : "s"(__builtin_amdgcn_kernarg_segment_ptr()), "n"(OFF)); return v; }
__device__ __forceinline__ unsigned long long karg64d(int off) { unsigned long long v; asm volatile("s_load_dwordx2 %0, %1, %2\n\ts_waitcnt lgkmcnt(0)" : "=s"(v) : "s"(__builtin_amdgcn_kernarg_segment_ptr()), "s"(off)); return v; }
#define TR_IN(k) ((const float*)(const GAS float*)karg64d(8 * (k)))
__device__ __forceinline__ void tr_decode(int it, int lane, bf16_t* WB, const float*& sp, int& ldw, bf16_t*& dp, int& K, int& gofs) {
    const float* src; int segA, segB, kb, tb, dk0 = 0, gate = 0, gu = 0, f8 = 0; bf16_t* dst;
    if (it < 28800) {
        const int l = it / 14400; int r = it % 14400; bf16_t* WBl = WB + (size_t)l * WB_LAYER;
        if (r < 1472) { gu = 1; kb = r / 92; tb = r % 92; const int pn = tb >> 2, bj = (tb >> 1) & 1, w0 = 2 * (tb & 1); src = TR_IN(5) + (size_t)l * DM * D_IN; ldw = D_IN; K = DM; segA = 256 * pn + 64 * w0 + 32 * bj; segB = segA + 64; dst = WBl + WB_IN;
            if (pn >= C_G / 256) { gate = 1; f8 = 1; dst += (size_t)C_G * 512; segA = 256 * pn + 64 * w0 + 8 * bj; segB = segA + 64; } }
        else if (r < 1856) { r -= 1472; const int i = r >> 7; r &= 127; kb = r >> 4; tb = r & 15; src = TR_IN(13 + i) + (size_t)l * 512 * DM; ldw = DM; K = 1536; dk0 = 512 * i; segA = 64 * tb; segB = segA + 32; dst = WBl + WB_UP; }
        else if (r < 2112) { r -= 1856; kb = r >> 4; tb = r & 15; src = TR_IN(16) + (size_t)l * DM * DM; ldw = DM; K = DM; segA = 64 * tb; segB = segA + 32; dst = WBl + WB_OUT; }
        else if (r < 10304) { r -= 2112; const int e = r >> 8; r &= 255; kb = r >> 4; tb = r & 15; const int pn = tb >> 2, sg = (tb >> 1) & 1, jb = tb & 1;
            src = TR_IN(sg ? 23 : 22) + (size_t)(l * NEXP + e) * DM * DEXP; ldw = DEXP; K = DM; f8 = 1; segA = 128 * pn + 64 * jb; segB = segA + 32; dst = WBl + WB_GU + (size_t)e * 512 * 1024; }
        else { r -= 10304; const int e = r >> 7; r &= 127; kb = r >> 4; tb = r & 15; src = TR_IN(24) + (size_t)(l * NEXP + e) * DEXP * DM; ldw = DM; K = DEXP; f8 = 1; gate = 1; { const int pn = tb >> 2, bj = (tb >> 1) & 1, w0 = 2 * (tb & 1); segA = 256 * pn + 64 * w0 + 8 * bj; segB = segA + 64; } dst = WBl + WB_DN + (size_t)e * 512 * 512; }
    } else { const int r = it - 28800; kb = r >> 4; tb = r & 15; const int pn = tb >> 2, bj = (tb >> 1) & 1, w0 = 2 * (tb & 1); src = TR_IN(3); ldw = 1024; K = DM; segA = 256 * pn + 64 * w0 + 32 * bj; segB = segA + 64; dst = WB + WB_MEMKV; }
    const int q = lane & 15;
    const int q7 = q & 7, seg = q < 8 ? segA : segB;
    sp = src + (size_t)(kb * 64 + (lane >> 4)) * ldw + seg + (gate ? 16 * (q7 >> 1) + 4 * (q7 & 1) : 4 * q7);
    dp = dst + (((size_t)(64 * tb + (lane >> 3)) * K + dk0 + kb * 64 + 8 * (lane & 7)) >> f8);
    K |= f8 << 18;
    gofs = gu ? kb * 64 + (lane >> 4) : -1;
}
__device__ __forceinline__ void tr_load(f32x4 (&v)[16], const float* sp, int ldw) {
#pragma unroll
    for (int i = 0; i < 16; ++i) v[i] = *(const f32x4*)(sp + (size_t)(4 * i) * ldw);
}
__device__ __forceinline__ void tr_store(const f32x4 (&v)[16], bf16_t* dp, int K, LAS float* scr, int lane, int gofs, const LAS float* gt) {
    const int q = lane & 15, kq = lane >> 4; const int f8 = K >> 18; K &= 0x3FFFF;
#pragma unroll
    for (int i = 0; i < 16; ++i) *(LAS f32x4*)(scr + (4 * i + kq) * 64 + ((q ^ (2 * (i >> 1))) << 2)) = v[i];
    const int c = lane & 7, n8 = lane >> 3;
    f32x4 g0 = {1.f, 1.f, 1.f, 1.f}, g1 = g0;
    if (gofs >= 0) { const LAS float* gp = gt + (gofs - kq) + 8 * c; g0 = *(const LAS f32x4*)gp; g1 = *(const LAS f32x4*)(gp + 4); }
    if (f8) { g0 = g0 * W8_SCALE; g1 = g1 * W8_SCALE; }
    asm volatile("s_waitcnt lgkmcnt(0)" ::: "memory");
    const LAS float* sB = scr + (8 * c) * 64;
    if (f8) {
#pragma unroll
        for (int j = 0; j < 8; ++j) { const LAS float* sI = sB + ((n8 + 8 * j) ^ (8 * c));
            const f32x4 v0 = {sI[0 * 64] * g0[0], sI[1 * 64] * g0[1], sI[2 * 64] * g0[2], sI[3 * 64] * g0[3]}, v1 = {sI[4 * 64] * g1[0], sI[5 * 64] * g1[1], sI[6 * 64] * g1[2], sI[7 * 64] * g1[3]};
            *(u32x2*)((unsigned char*)dp + (size_t)(8 * j) * K) = pack8_fp8(v0, v1); }
    } else
#pragma unroll
    for (int j = 0; j < 8; ++j) { const LAS float* sI = sB + ((n8 + 8 * j) ^ (8 * c));
        u32x4 o; o.x = cvt_pk_bf16(sI[0 * 64] * g0[0], sI[1 * 64] * g0[1]); o.y = cvt_pk_bf16(sI[2 * 64] * g0[2], sI[3 * 64] * g0[3]); o.z = cvt_pk_bf16(sI[4 * 64] * g1[0], sI[5 * 64] * g1[1]); o.w = cvt_pk_bf16(sI[6 * 64] * g1[2], sI[7 * 64] * g1[3]);
        *(u32x4*)(dp + (size_t)(8 * j) * K) = o; }
    asm volatile("s_waitcnt lgkmcnt(0)" ::: "memory");
}

__device__ __forceinline__ int tr_item(int mode, int q) {
    return mode == 1 ? (q < 1472 ? q : q - 1472 + 28800) : mode == 4 ? q + 14400 : mode == 2 ? q + 1472 : q + 16512; }
__device__ __forceinline__ void tr_run(int mode, int q0, int qend, int qstride, bf16_t* WB, LAS float* scr, int lane, const float* gains, LAS float* gt) {
    __syncthreads();
    if (gains) {
#pragma unroll
        for (int j = 0; j < 16; ++j) gt[lane + 64 * j] = gains[lane + 64 * j];
        asm volatile("s_waitcnt lgkmcnt(0)" ::: "memory"); }
    f32x4 ra[16], rb[16], rc[16]; const float* sp; int ldw; unsigned da, ma, db, mb, dc, mc;
    if (q0 >= qend) return;
    const int qlast = q0 + ((qend - 1 - q0) / qstride) * qstride;
#define TR_LD(R, DD, MM, QQ) do { const int qn_ = (QQ) <= qlast ? (QQ) : qlast; bf16_t* dp_; int K_, g_; tr_decode(tr_item(mode, qn_), lane, WB, sp, ldw, dp_, K_, g_); \
        DD = (unsigned)(dp_ - WB); MM = ((unsigned)K_ << 12) | (unsigned)(g_ + 1); tr_load(R, sp, ldw); } while (0)
#define TR_ST(R, DD, MM) tr_store(R, WB + DD, (int)(MM >> 12), scr, lane, (int)(MM & 4095u) - 1, gt)
    int q = q0;
    TR_LD(ra, da, ma, q); TR_LD(rb, db, mb, q + qstride);
    for (;;) {
        TR_LD(rc, dc, mc, q + 2 * qstride); TR_ST(ra, da, ma); q += qstride; if (q > qlast) break;
        TR_LD(ra, da, ma, q + 2 * qstride); TR_ST(rb, db, mb); q += qstride; if (q > qlast) break;
        TR_LD(rb, db, mb, q + 2 * qstride); TR_ST(rc, dc, mc); q += qstride; if (q > qlast) break;
    }
#undef TR_ST
#undef TR_LD
}
#define XB_TMO      128
#define XB_XCNT(j)  (256  + 64 * (j))
#define XB_XSUB(j)  (1280 + 64 * (j))
#define XB_XGEN(j)  (2304 + 64 * (j))
#define XB_TOP      3328
#define XB_TOPGEN   3392
#define XCD_BAR_WORDS 3456
#define XB_SPIN_CAP (1u << 18)

__device__ __forceinline__ unsigned xb_ld(unsigned* p)              { return __hip_atomic_load(p, __ATOMIC_RELAXED, __HIP_MEMORY_SCOPE_AGENT); }
__device__ __forceinline__ unsigned xb_add(unsigned* p, unsigned v) { return __hip_atomic_fetch_add(p, v, __ATOMIC_RELAXED, __HIP_MEMORY_SCOPE_AGENT); }
__device__ __forceinline__ unsigned xb_xcc_id() { return (unsigned)__builtin_amdgcn_s_getreg((3 << 11) | 20) & 0xFu; }
#define XB_SPIN(cond, bar) do { unsigned _sp = 0; while (cond) { __builtin_amdgcn_s_sleep(1); \
    if ((++_sp & 255u) == 0u) { if (xb_ld(&(bar)[XB_TMO])) break; if (_sp > XB_SPIN_CAP) { atomicAdd(&(bar)[XB_TMO], 1u); break; } } } } while (0)

struct XcdBarrier {
    unsigned* bar; unsigned x; unsigned w0;
    volatile LAS unsigned* st;
};

__device__ __forceinline__ XcdBarrier xcd_barrier_post(unsigned* bar, volatile LAS unsigned* st, unsigned is_wave0) {
    XcdBarrier b; b.bar = bar; b.x = xb_xcc_id(); b.st = st; b.w0 = is_wave0;
    if (is_wave0 && lane_id() == 0) (void)xb_add(&bar[XB_XCNT(b.x)], 1u);
    return b;
}
__device__ __forceinline__ void xcd_barrier_complete(unsigned* bar, unsigned x, unsigned& nloc, unsigned& nx) {
    const unsigned G = gridDim.x * gridDim.y * gridDim.z;
    unsigned sum, cnt, mine, sp = 0u;
    for (;;) {
        sum = 0u; cnt = 0u; mine = 0u;
#pragma unroll
        for (unsigned j = 0; j < 16; ++j) { const unsigned c = xb_ld(&bar[XB_XCNT(j)]); sum += c; cnt += (c > 0u) ? 1u : 0u; mine = (j == x) ? c : mine; }
        if (sum == G) break;
        __builtin_amdgcn_s_sleep(1);
        if ((++sp & 255u) == 0u) { if (xb_ld(&bar[XB_TMO])) break; if (sp > XB_SPIN_CAP) { atomicAdd(&bar[XB_TMO], 1u); break; } }
    }
    nloc = mine > 0u ? mine : 1u; nx = cnt > 0u ? cnt : 1u;
}

__device__ __forceinline__ void xcd_barrier(const XcdBarrier& b) {
    asm volatile("s_waitcnt vmcnt(0)" ::: "memory");
    __syncthreads();
    if (b.w0 && lane_id() == 0) {
        unsigned* bar = b.bar;
        __builtin_amdgcn_s_waitcnt(0);
        unsigned nloc = b.st[0], nx = b.st[1];
        if (nloc == 0u) { xcd_barrier_complete(bar, b.x, nloc, nx); b.st[0] = nloc; b.st[1] = nx; }
        const unsigned old = xb_add(&bar[XB_XSUB(b.x)], 1u);
        const unsigned gen = old / nloc;
        if (old + 1u == (gen + 1u) * nloc) {
            __builtin_amdgcn_fence(__ATOMIC_RELEASE, "agent");
            asm volatile("s_waitcnt vmcnt(0)" ::: "memory");
            const unsigned og = xb_add(&bar[XB_TOP], 1u);
            const unsigned tg = og / nx;
            if (og + 1u == (tg + 1u) * nx) xb_add(&bar[XB_TOPGEN], 1u);
            else XB_SPIN(xb_ld(&bar[XB_TOPGEN]) == tg, bar);
            __builtin_amdgcn_fence(__ATOMIC_ACQUIRE, "agent");
            xb_add(&bar[XB_XGEN(b.x)], 1u);
            asm volatile("s_waitcnt vmcnt(0)" ::: "memory");
        } else {
            XB_SPIN(xb_ld(&bar[XB_XGEN(b.x)]) == gen, bar);
            __builtin_amdgcn_fence(__ATOMIC_ACQUIRE, "agent");
            asm volatile("s_waitcnt vmcnt(0)" ::: "memory");
        }
    }
    __syncthreads();
}
constexpr int NWAVES = 8;
constexpr int RING_BYTES = 131072, GT_OFF = 133120  , LDSCTL_OFF = 137216, LDS_BYTES = 147456;
constexpr int CW_BAR = 4096, BAR_REGION = 4096;
static_assert(XCD_BAR_WORDS <= BAR_REGION && (CW_BAR + (N_PHASES + 1) * BAR_REGION) * 4 <= (int)MiB, "barrier regions inside the memset region");
static_assert(pg8::STAGE_BYTES <= RING_BYTES && att::Lay<64, 128>::OFF_STASH + 65536 <= RING_BYTES && att::Lay<128, 128>::OFF_WS + 2048 <= RING_BYTES && LDSCTL_OFF + 10240 <= LDS_BYTES, "LDS map");

struct Args { const float* in[26]; float* out; unsigned char* ws; int ph_lo, ph_hi, li, pad; };
#define KIN(k) ((const float*)(const GAS float*)karg64<8 * (k)>())
#define KOUT ((float*)(GAS float*)karg64<208>())
#define KWS ((unsigned char*)(GAS unsigned char*)karg64<216>())
static_assert(offsetof(Args, out) == 208 && offsetof(Args, ws) == 216 && offsetof(Args, ph_lo) == 224, "Args layout vs the kernarg offsets above");

__global__ void __launch_bounds__(NWAVES * 64, 2) mk_fwd(Args args) {
    extern __shared__ __attribute__((aligned(16))) unsigned char lds[];
    asm volatile("s_setreg_imm32_b32 hwreg(HW_REG_MODE, 23, 1), 1");
    const int wave = __builtin_amdgcn_readfirstlane((int)threadIdx.x >> 6);
#define lane0 lane_id()
#define tid0 (wave * 64 + lane_id())
    const int G = gridDim.x, bx = blockIdx.x, vcu = (G % 8 == 0) ? (bx % 8) * (G / 8) + bx / 8 : bx;
    constexpr int NCX = 4, NCV = 8 * NCX, NWK = 256 - NCV;
    const bool split = (G == 256); const int idx8 = bx >> 3, xcd8 = bx & 7;
    const bool conv = split && (idx8 >= 32 - NCX);
    const int wk = (idx8 << 3) | xcd8, cvw = ((((idx8 - (32 - NCX)) << 3) | xcd8) * NWAVES) + wave;
    LAS unsigned char* ldsl = (LAS unsigned char*)lds;
    volatile LAS unsigned* MISC = (volatile LAS unsigned*)(ldsl + LDSCTL_OFF);
    for (int u = tid0; u < (LDS_BYTES - LDSCTL_OFF) / 4; u += NWAVES * 64) ((LAS unsigned*)(ldsl + LDSCTL_OFF))[u] = 0u;
    __syncthreads();
    XcdBarrier bar = xcd_barrier_post((unsigned*)(KWS + WS_CTL) + CW_BAR + args.li * BAR_REGION, MISC + 8, wave == 0 ? 1u : 0u);
#define P_WS unsigned char* ws = KWS; unsigned* ctl = (unsigned*)(ws + WS_CTL); (void)ctl
#define P_ACT bf16_t* MEMKV = (bf16_t*)(ws + WS_MEMKV); bf16_t* HM = (bf16_t*)(ws + WS_HM); bf16_t* PROJ = (bf16_t*)(ws + WS_PROJ); bf16_t* OBR = (bf16_t*)(ws + WS_OBR); bf16_t* HMEM = OBR; \
    bf16_t* BUF = (bf16_t*)(ws + WS_BUF); bf16_t* YB = (bf16_t*)(ws + WS_YB); bf16_t* HID = (bf16_t*)(ws + WS_HID); bf16_t* WB = (bf16_t*)(ws + WS_WB); const bf16_t* WBl = WB + (size_t)l_ * WB_LAYER; \
    (void)MEMKV; (void)HM; (void)PROJ; (void)OBR; (void)HMEM; (void)BUF; (void)YB; (void)HID; (void)WBl
#define P_ROUTE int* experts = (int*)(ws + WS_ROUTE + RT_EXP); float* weights = (float*)(ws + WS_ROUTE + RT_WGT); int* rank = (int*)(ws + WS_ROUTE + RT_RANK); float* rstd = (float*)(ws + WS_ROUTE + RT_RSTD); \
    (void)experts; (void)weights; (void)rank; (void)rstd
    const int gw = bx * NWAVES + wave, NGW = G * NWAVES;
    const int lo = args.ph_lo, hi = args.ph_hi;
#ifndef STAGE_MASK
#define STAGE_MASK 0x3FFu
#endif
#define IN(k) (lo <= (k) && (k) < hi)
#define ST(s) ((STAGE_MASK >> (s)) & 1u)
#ifndef REP_MASK
#define REP_MASK 0u
#endif
#define NREP(s) (((REP_MASK >> (s)) & 1u) ? 2 : 1)
#ifndef REP_A
#define REP_A 1
#endif
#ifndef REP_B
#define REP_B 1
#endif
#ifndef DBL_BAR
#define DBL_BAR 0
#endif
#define SEAM(k) do { if (IN(k) && IN((k) + 1)) { xcd_barrier(bar); if (DBL_BAR) xcd_barrier(bar); } } while (0)

    if (ST(0) && IN(0))
  for (int rep_ = 0; rep_ < NREP(0); ++rep_) {
        int lane = lane0, tid = tid0; asm volatile("" : "+v"(lane), "+v"(tid));
        constexpr int l_ = 0; P_WS; P_ACT;
        float* tab1 = (float*)(ws + WS_TAB); float* tab2 = tab1 + SEQ * 32 * 2;
        const float* x = KIN(0); const float* mem = KIN(1); const float* mem_g = KIN(2); const float* norm1_g = KIN(4); const float* norm2_g = KIN(17); const float* w_rg = KIN(18); const float* w_re = KIN(20);
        LAS float* scr = (LAS float*)(ldsl + wave * 16640);
#pragma unroll 1
        for (int ci = 0; ci < (split ? 2 : 4); ++ci) {
            const int md = ci == 0 ? 1 : ci == 1 ? 4 : ci;
            tr_run(md, gw, md == 1 ? 1728 : md == 4 ? 2112 : md == 2 ? 12928 : 12288, NGW, WB, scr, lane, md == 1 ? norm1_g : md == 4 ? norm1_g + DM : nullptr, (LAS float*)(ldsl + GT_OFF)); }
        tid = tid0; lane = lane0; asm volatile("" : "+v"(lane), "+v"(tid));
        for (int idx = bx * (NWAVES * 64) + tid; idx < SEQ * 32; idx += G * NWAVES * 64) { const int pos = idx >> 5, i = idx & 31; float s, c;
            sincosf((float)pos * inv1d(i), &s, &c); tab1[idx * 2] = c; tab1[idx * 2 + 1] = s;
            sincosf(ang2d(pos, i), &s, &c); tab2[idx * 2] = c; tab2[idx * 2 + 1] = s; }
        for (int idx = bx * (NWAVES * 64) + tid; idx < DEPTH * 48 * 1024; idx += G * NWAVES * 64) { const int l = idx / (48 * 1024), c = (idx >> 10) % 48, k = idx & 1023;
            const float w = c < 4 ? w_rg[((size_t)l * DM + k) * 4 + c] : c < 36 ? w_re[((size_t)l * DM + k) * 32 + (c - 4)] : 0.f, v = w * norm2_g[l * DM + k];
            const bf16_t h = f2bf(v); bf16_t* t = WB + WB_RT + (size_t)l * 2 * 48 * 1024 + (size_t)c * 1024 + k; t[0] = h; t[48 * 1024] = f2bf(v - bf2f(h)); }
        for (int m = 4 * gw; m < M; m += 4 * NGW) rows_in<4, false>(x, nullptr, (bf16_t*)KOUT, (float*)(ws + WS_ROUTE + RT_RSTD1), m, lane, (unsigned char*)HM);
        for (int m = gw; m < MM; m += NGW) rows_in<1, true>(mem, mem_g, HMEM, nullptr, m, lane);
    }
    SEAM(0);
#pragma unroll 1
    for (int l = 0; l < DEPTH; ++l) {
        const int pb = 1 + 9 * l, l_ = l;
        const bool l0s = false;
        if (ST(1) && IN(pb + 0))
      for (int rep_ = 0; rep_ < NREP(1); ++rep_) {
            P_WS; P_ACT; float* tab1 = (float*)(ws + WS_TAB); float* tab2 = tab1 + SEQ * 32 * 2; const float* qn_g = KIN(11); const float* kn_g = KIN(12);
            constexpr int NMAIN = (M / 256) * pg8::NPT;
            for (int rA_ = 0; rA_ < REP_A; ++rA_)
            { pg8::Gemm g{XP, DM};
              pg8::SchedProj S{bx, G, NMAIN, l == 0 ? NMAIN + 32 : NMAIN, (const char*)KOUT, (const char*)(WBl + WB_IN), (const char*)HMEM, (const char*)(WB + WB_MEMKV)};
              pg8::EpiProj E{PROJ, MEMKV, tab1, tab2, qn_g + l * 64, kn_g + l * 64, (const float*)(ws + WS_ROUTE + RT_RSTD1)};
              pg8::gemm_phase<pg8::EpiProj, pg8::SchedProj, true, true>(ldsl, g, S, E, wave); }
            for (int rB_ = 0; rB_ < REP_B; ++rB_)
            { pg8::Gemm g{DM / 2, DM / 2, 0x7C7C7C7C};
              pg8::SchedGate8 S{bx, G, l == 0 ? 28 : 24, (const char*)HM, (const char*)(WBl + WB_IN) + (size_t)C_G * 2048};
              pg8::EpiSig E{PROJ, (const float*)(ws + WS_ROUTE + RT_RSTD1)};
              pg8::gemm_phase<pg8::EpiSig, pg8::SchedGate8, true, true, false, true>(ldsl, g, S, E, wave); }
        }
        SEAM(pb + 0);
        if (ST(2) && IN(pb + 1))
      for (int rep_ = 0; rep_ < NREP(2); ++rep_) {
            LAS float* lamp = (LAS float*)(ldsl + LDSCTL_OFF + 128);
            if (split) {
            P_WS; P_ACT; const float* lq1 = KIN(6); const float* lk1 = KIN(7); const float* lq2 = KIN(8); const float* lk2 = KIN(9); const float* subln_g = KIN(10); const float* norm2_g = KIN(17);
            { int lane = lane0; asm volatile("" : "+v"(lane)); const float li_ = 0.8f - 0.6f * __expf(-0.3f * (float)l);
              const float lam_ = __expf(wave_sum(lq1[l * 64 + lane] * lk1[l * 64 + lane])) - __expf(wave_sum(lq2[l * 64 + lane] * lk2[l * 64 + lane])) + li_; lamp[0] = lam_; lamp[1] = li_; }
            const int slot = idx8 & 3, j = vcu;
#pragma unroll 1
            for (int st = 0; st < 4; ++st) {
                int wv_ = wave; asm volatile("" : "+s"(wv_));
                if (st == slot) { int lane = wv_ * 0 + lane0; asm volatile("" : "+v"(lane)); tr_run(2 + l, bx * NWAVES + wv_, l == 0 ? 12928 : 12288, NGW, WB, (LAS float*)(ldsl + wv_ * 16640), lane, nullptr, (LAS float*)(ldsl + GT_OFF)); }
                if (st == 0) att::unit_a(PROJ, OBR, j >> 5, (j >> 3) & 3, j & 7, lamp, subln_g + l * 128, (char*)lds, wv_);
                else if (st == 1) {
#pragma unroll 1
                    for (int i = 0; i < 2; ++i) { const int jb = 2 * j + i; att::unit_b(PROJ, OBR, jb >> 6, (jb >> 3) & 7, jb & 7, (char*)lds, wv_); } }
                else if (st == 2) att::unit_c(PROJ, MEMKV, OBR, j >> 5, (j >> 3) & 3, j & 7, (char*)lds, wv_);
            }
            __syncthreads();
            } else {
            const int lane = lane0;
            P_WS; P_ACT; const float* lq1 = KIN(6); const float* lk1 = KIN(7); const float* lq2 = KIN(8); const float* lk2 = KIN(9); const float* subln_g = KIN(10);
            { const float li_ = 0.8f - 0.6f * __expf(-0.3f * (float)l); lamp[0] = __expf(wave_sum(lq1[l * 64 + lane] * lk1[l * 64 + lane])) - __expf(wave_sum(lq2[l * 64 + lane] * lk2[l * 64 + lane])) + li_; lamp[1] = li_; }
            constexpr int NS = NWK - NCV, NB3 = 512 - 2 * NS, NCW = NS - NB3;
            static_assert(NB3 >= 0 && NB3 <= NS && NCW > 0 && NB3 / 2 + 3 * NCW == 256, "attention deal");
            for (int jj = l0s ? 0 : vcu; jj < (l0s ? 1 : 256); jj += (l0s ? 1 : G)) {
                const int w = wk - NCV, wc_ = w - NB3;
                const int c_lo = !l0s || wk < NCV ? 0 : w < NB3 ? (w >> 1) : NB3 / 2 + 3 * wc_, c_hi = !l0s || wk < NCV ? 0 : w < NB3 ? (w >> 1) + (w & 1) : NB3 / 2 + 3 * wc_ + 3;
                const int na = l0s ? (wk < NCV ? 2 : 1) : 1, nb = l0s ? (wk < NCV ? 0 : (w < NB3 ? 3 : 2)) : 2, nc = l0s ? c_hi - c_lo : 1;
#pragma unroll 1
                for (int i = 0; i < na; ++i) { const int j = l0s ? (i == 0 ? wk : NWK + wk) : jj; att::unit_a(PROJ, OBR, j >> 5, (j >> 3) & 3, j & 7, lamp, subln_g + l * 128, (char*)lds, wave); }
#pragma unroll 1
                for (int i = 0; i < nb; ++i) { const int j = l0s ? (i < 2 ? 2 * w + i : 2 * NS + w) : 2 * jj + i; att::unit_b(PROJ, OBR, j >> 6, (j >> 3) & 7, j & 7, (char*)lds, wave); }
#pragma unroll 1
                for (int i = 0; i < nc; ++i) { const int j = l0s ? c_lo + i : jj; att::unit_c(PROJ, MEMKV, OBR, j >> 5, (j >> 3) & 3, j & 7, (char*)lds, wave); }
            }
            __syncthreads();
            }
        }
        SEAM(pb + 1);
        if (ST(3) && IN(pb + 2))
      for (int rep_ = 0; rep_ < NREP(3); ++rep_) {
            P_WS; P_ACT;
            pg8::Gemm g{OBR_W, OBR_W};
            pg8::SchedPlain S{bx, G, M / 256, (const char*)OBR, (const char*)(WBl + WB_UP), (size_t)256 * OBR_W * 2, (size_t)256 * OBR_W * 2};
            pg8::EpiGate E{HM, PROJ};
            pg8::gemm_phase<pg8::EpiGate, pg8::SchedPlain, true, true>(ldsl, g, S, E, wave);
        }
        SEAM(pb + 2);
        if (ST(4) && IN(pb + 3)) {
            P_WS; P_ACT; bf16_t* XB = (bf16_t*)KOUT;
            pg8::Gemm g{DM, DM};
            pg8::SchedPlain S{bx, G, M / 256, (const char*)HM, (const char*)(WBl + WB_OUT), (size_t)256 * DM * 2, (size_t)256 * DM * 2};
            pg8::EpiResid E{XB};
            pg8::gemm_phase<pg8::EpiResid, pg8::SchedPlain, true, true>(ldsl, g, S, E, wave);
        }
        SEAM(pb + 3);
        if (ST(5) && IN(pb + 4)) {
            int tid = tid0; asm volatile("" : "+v"(tid));
            const int lane = tid & 63;
            P_WS; P_ACT; P_ROUTE; const bf16_t* X = (const bf16_t*)KOUT; const float* b_rg = KIN(19); const float* b_re = KIN(21); const float* norm2_g = KIN(17);
            const bf16_t* tab = WB + WB_RT + (size_t)l * 2 * 48 * 1024 + (size_t)(lane & 15) * 1024 + 128 * wave + 8 * (lane >> 4);
            bf16x8 Bh[3][4], Bl[3][4];
#pragma unroll
            for (int t = 0; t < 3; ++t)
#pragma unroll
                for (int sI = 0; sI < 4; ++sI) { Bh[t][sI] = *(const bf16x8*)(tab + (size_t)t * 16 * 1024 + 32 * sI); Bl[t][sI] = *(const bf16x8*)(tab + (size_t)(48 + t * 16) * 1024 + 32 * sI); }
            for (int rb = bx; rb < M / 64; rb += G)
                route_block(X, tab, b_rg + l * 4, b_re + l * 32, experts, weights, rank, ctl + CW_CNT + 2048 * l, rstd, (int*)BUF, norm2_g + l * DM, (unsigned char*)HM, rb, Bh, Bl, (LAS float*)ldsl, tid, wave);
        }
        SEAM(pb + 4);
        volatile LAS int* mt = (volatile LAS int*)(ldsl + LDSCTL_OFF + 256);
        LAS unsigned* rowtab = (LAS unsigned*)(ldsl + LDSCTL_OFF + 2048); LAS float* wtab = (LAS float*)(ldsl + LDSCTL_OFF + 6144);
        if (ST(7) && IN(pb + 6)) {
            int tid = tid0; asm volatile("" : "+v"(tid));
            P_WS; P_ACT; P_ROUTE;
            moe_tables(ctl + CW_CNT + 2048 * l, mt, tid);
            moe_rowtabs(mt, (const int*)BUF, weights, rstd, rowtab, wtab, vcu, G, tid, 1);
            const int ntiles = __builtin_amdgcn_readfirstlane(mt[256]);
            pg8::Gemm g{DM / 2, DM / 2, 0x7C7C7C7C};
            pg8::SchedMoeUp S{vcu, G, ntiles, (const LAS int*)(ldsl + LDSCTL_OFF + 256 + 96 * 4), (const char*)HM, (const char*)(WBl + WB_GU), ctl + CW_TCNT + l * 160 * 64};
            pg8::EpiSilu E{(unsigned char*)HID, wtab};
            pg8::gemm_phase<pg8::EpiSilu, pg8::SchedMoeUp, true, true, true, true>(ldsl, g, S, E, wave, rowtab);
        }
        if (ST(8) && IN(pb + 7)) {
            int tid = tid0; asm volatile("" : "+v"(tid));
            P_WS; P_ACT; P_ROUTE;
            if (!(ST(7) && IN(pb + 6))) moe_tables(ctl + CW_CNT + 2048 * l, mt, tid);
            moe_rowtabs(mt, (const int*)BUF, weights, rstd, rowtab, wtab, vcu, G, tid, 0);
            const int ntiles = __builtin_amdgcn_readfirstlane(mt[256]);
            pg8::Gemm g{DEXP / 2, DEXP / 2, 0x7E7E7E7E};
            pg8::SchedMoeDown S{vcu, G, ntiles, (ntiles * 4) % G, wave, (const LAS int*)(ldsl + LDSCTL_OFF + 256 + 96 * 4), (const char*)HID, (const char*)(WBl + WB_DN), ctl + CW_TCNT + l * 160 * 64, ctl + CW_TMO};
            pg8::EpiRowScale E{(unsigned char*)YB, wtab};
            pg8::gemm_phase<pg8::EpiRowScale, pg8::SchedMoeDown, true, true, false, true>(ldsl, g, S, E, wave);
        }
        SEAM(pb + 7);
        if (ST(9) && IN(pb + 8)) {
            int lane = lane0; asm volatile("" : "+v"(lane));
            P_WS; P_ACT; P_ROUTE; float* OUTP = KOUT; bf16_t* XB = (bf16_t*)OUTP; const float* norm1_g = KIN(4); const float* final_g = KIN(25);
            const bool last = (l == DEPTH - 1);
            const bool poison = last && ((__hip_atomic_load(ctl + CW_BAR + args.li * BAR_REGION + XB_TMO, __ATOMIC_RELAXED, __HIP_MEMORY_SCOPE_AGENT) | __hip_atomic_load(ctl + CW_TMO, __ATOMIC_RELAXED, __HIP_MEMORY_SCOPE_AGENT)) != 0u);
            if (!(ST(7) && IN(pb + 6)) && !(ST(8) && IN(pb + 7))) moe_tables(ctl + CW_CNT + 2048 * l, mt, tid0);
            static_assert(M % 4 == 0, "rows come in fours");
            for (int m = 4 * gw; m < M; m += 4 * NGW) {
                const u32x4 ex0 = *(const u32x4*)(experts + 2 * m), ex1 = *(const u32x4*)(experts + 2 * m + 4), rk0 = *(const u32x4*)(rank + 2 * m), rk1 = *(const u32x4*)(rank + 2 * m + 4);
                const int rows[4] = {m, m + 1, m + 2, m + 3};
                const int d0[4] = {mt[ex0.x] + (int)rk0.x, mt[ex0.z] + (int)rk0.z, mt[ex1.x] + (int)rk1.x, mt[ex1.z] + (int)rk1.z}, d1[4] = {mt[ex0.y] + (int)rk0.y, mt[ex0.w] + (int)rk0.w, mt[ex1.y] + (int)rk1.y, mt[ex1.w] + (int)rk1.w};
                rows_combine_norm<4>(XB, (const unsigned char*)YB, final_g, last ? nullptr : (float*)(ws + WS_ROUTE + RT_RSTD1), OUTP, rows, lane, poison, d0, d1, (unsigned char*)HM); }
        }
        SEAM(pb + 8);
    }
#undef IN
#undef SEAM
#undef lane0
#undef tid0
#undef P_WS
#undef P_ACT
#undef P_ROUTE
}

extern "C" void kernel_launch(void* const* d_in, const int* in_sizes, int n_in, void* d_out, int out_size, void* d_ws, size_t ws_size, hipStream_t stream) {
    if (n_in != 26 || in_sizes[0] != M * DM || out_size != M * DM || ws_size < WS_END) { fprintf(stderr, "kernel_launch: unexpected shapes n_in %d out %d ws %zu (need %zu)\n", n_in, out_size, ws_size, (size_t)WS_END); return; }
    static int grid = 0;
    if (grid == 0) {
        int dev = 0, cus = 0;
        if (hipGetDevice(&dev) != hipSuccess || hipDeviceGetAttribute(&cus, hipDeviceAttributeMultiprocessorCount, dev) != hipSuccess) { grid = -1; return; }
        if (hipFuncSetAttribute((const void*)mk_fwd, hipFuncAttributeMaxDynamicSharedMemorySize, LDS_BYTES) != hipSuccess) { fprintf(stderr, "kernel_launch: hipFuncSetAttribute failed\n"); grid = -1; return; }
        int per_cu = 0;
        if (hipOccupancyMaxActiveBlocksPerMultiprocessor(&per_cu, (const void*)mk_fwd, NWAVES * 64, LDS_BYTES) != hipSuccess || per_cu < 1) fprintf(stderr, "kernel_launch: occupancy query says %d\n", per_cu);
        (void)hipGetLastError();
        grid = cus;
    }
    if (grid < 0) return;
    (void)hipMemsetAsync((unsigned char*)d_ws + WS_CTL, 0, MiB, stream);
    Args a{};
    for (int i = 0; i < 26; ++i) a.in[i] = (const float*)d_in[i];
    a.out = (float*)d_out; a.ws = (unsigned char*)d_ws; a.ph_lo = 0; a.ph_hi = N_PHASES; a.li = 0; a.pad = 0;
    hipLaunchKernelGGL(mk_fwd, dim3(grid), dim3(NWAVES * 64), LDS_BYTES, stream, a);
}
```

```cpp
#include <hip/hip_runtime.h>
#include <cstdint>
#include <cstdio>
#include <cmath>
#include <cstddef>

typedef unsigned short bf16_t;
typedef float f32x4 __attribute__((ext_vector_type(4)));
typedef unsigned u32x4 __attribute__((ext_vector_type(4)));
typedef unsigned u32x2 __attribute__((ext_vector_type(2)));

constexpr int BATCH = 8, SEQ = 2048, DM = 1024, DEPTH = 2, MEM_LEN = 256;
constexpr int M = BATCH * SEQ;
constexpr int MM = BATCH * MEM_LEN;
constexpr int D_IN = 5888;
constexpr int C_AQ = 0, C_AK = 512, C_AV = 1024, C_BQ = 1536, C_BK = 2048, C_BV = 2176, C_CQ = 2304, C_G = 2816;
constexpr int OBR_W = 1536;
constexpr int NEXP = 32, DEXP = 512;
constexpr int MOE_TILE = 256;
constexpr int P_ROWS = M * 2 + NEXP * MOE_TILE;
constexpr int MAX_TILES = P_ROWS / MOE_TILE;
constexpr float EPS = 1e-6f;
constexpr float LOG2E = 1.4426950408889634f;
constexpr float C2_64 = 0.125f * LOG2E;
constexpr float C2_128 = 0.08838834764831845f * LOG2E;

constexpr size_t MiB = 1u << 20;
constexpr size_t WS_CTL = 0;
constexpr size_t WS_ROUTE = 1 * MiB;
constexpr size_t WS_TAB = 2 * MiB;
constexpr size_t WS_MEMKV = 3 * MiB;
constexpr size_t WS_HM = 7 * MiB;
constexpr size_t WS_PROJ = 39 * MiB;
constexpr size_t WS_OBR = 223 * MiB;
constexpr size_t WS_WB = 271 * MiB;
constexpr size_t WS_END = 499 * MiB;
constexpr size_t WS_BUF = WS_PROJ;
constexpr size_t WS_YB = WS_PROJ + 80 * MiB;
constexpr size_t WS_HID = WS_OBR;
constexpr size_t RT_EXP = 0;
constexpr size_t RT_WGT = 128 * 1024;
constexpr size_t RT_RANK = 256 * 1024;
constexpr size_t RT_DEST = 384 * 1024;
constexpr size_t RT_ROWW = 512 * 1024;
constexpr size_t RT_TILE = 700 * 1024;
constexpr size_t RT_RSTD1 = 896 * 1024;
constexpr size_t RT_RSTD = 768 * 1024;
constexpr int CW_CNT = 163840;
constexpr int CW_TMO = 128;
constexpr int CW_TCNT = 131072;

__device__ __forceinline__ float bf2f(bf16_t v) { return __uint_as_float(((unsigned)v) << 16); }
__device__ __forceinline__ bf16_t f2bf(float f) { unsigned u = __float_as_uint(f); return (bf16_t)((u + 0x7fffu + ((u >> 16) & 1u)) >> 16); }
template <int O> __device__ __forceinline__ float xlane(float v) { static_assert(O >= 1 && O < 32, "swizzle range"); return __int_as_float(__builtin_amdgcn_ds_swizzle(__float_as_int(v), (O << 10) | 0x1F)); }
__device__ __forceinline__ float half_sum(float v) { auto rr = __builtin_amdgcn_permlane32_swap(__float_as_uint(v), __float_as_uint(v), false, false); return __uint_as_float(rr[0]) + __uint_as_float(rr[1]); }
__device__ __forceinline__ float half_max(float v) { auto rr = __builtin_amdgcn_permlane32_swap(__float_as_uint(v), __float_as_uint(v), false, false); return fmaxf(__uint_as_float(rr[0]), __uint_as_float(rr[1])); }
__device__ __forceinline__ float wave_sum(float v) { v += xlane<1>(v); v += xlane<2>(v); v += xlane<4>(v); v += xlane<8>(v); v += xlane<16>(v); return half_sum(v); }
__device__ __forceinline__ float wave_max(float v) { v = fmaxf(v, xlane<1>(v)); v = fmaxf(v, xlane<2>(v)); v = fmaxf(v, xlane<4>(v)); v = fmaxf(v, xlane<8>(v)); v = fmaxf(v, xlane<16>(v)); return half_max(v); }
__device__ __forceinline__ float inv1d(int i) { return exp2f(-(float)i * (13.287712379549449f / 32.f)); }
__device__ __forceinline__ float inv2d(int j) { return exp2f(-(float)j * (13.287712379549449f / 16.f)); }
__device__ __forceinline__ float ang2d(int pos, int i) { return i < 16 ? (float)(pos >> 6) * inv2d(i) : (float)(pos & 63) * inv2d(i - 16); }

#define LAS __attribute__((address_space(3)))
#define GAS __attribute__((address_space(1)))
typedef short bf16x8 __attribute__((ext_vector_type(8)));
typedef short s16x4 __attribute__((ext_vector_type(4)));
typedef float f32x16 __attribute__((ext_vector_type(16)));
typedef float f32x2 __attribute__((ext_vector_type(2)));
typedef int i32x4 __attribute__((ext_vector_type(4)));
typedef int i32x8 __attribute__((ext_vector_type(8)));

constexpr size_t WB_IN = 0, WB_UP = 6029312, WB_OUT = WB_UP + 1572864, WB_GU = WB_OUT + 1048576, WB_DN = WB_GU + 33554432, WB_LAYER = WB_DN + 16777216;
constexpr size_t WB_MEMKV = 2 * WB_LAYER;
constexpr size_t WB_RT = WB_MEMKV + 1048576;
static_assert(WS_WB + (WB_RT + 2 * 2 * 48 * 1024) * 2 <= WS_END, "weight copies fit");
constexpr int N_PHASES = 19;
constexpr int XP = 2048;
constexpr int LCAP = 16384;

__device__ __forceinline__ int lane_id() { int r; asm volatile("v_mbcnt_lo_u32_b32 %0, -1, 0\n\tv_mbcnt_hi_u32_b32 %0, -1, %0" : "=v"(r)); return r; }
__device__ __forceinline__ unsigned cvt_pk_bf16(float lo, float hi) { unsigned r; asm volatile("v_cvt_pk_bf16_f32 %0, %1, %2" : "=v"(r) : "v"(lo), "v"(hi)); return r; }
__device__ __forceinline__ i32x8 cat8(const bf16x8& a, const bf16x8& b) { const i32x4 x = __builtin_bit_cast(i32x4, a), y = __builtin_bit_cast(i32x4, b); return __builtin_shufflevector(x, y, 0, 1, 2, 3, 4, 5, 6, 7); }
__device__ __forceinline__ u32x2 pack8_fp8(const f32x4& v0, const f32x4& v1) { int a = 0, b = 0; a = __builtin_amdgcn_cvt_pk_fp8_f32(v0[0], v0[1], a, false); a = __builtin_amdgcn_cvt_pk_fp8_f32(v0[2], v0[3], a, true);
    b = __builtin_amdgcn_cvt_pk_fp8_f32(v1[0], v1[1], b, false); b = __builtin_amdgcn_cvt_pk_fp8_f32(v1[2], v1[3], b, true); u32x2 r; r.x = (unsigned)a; r.y = (unsigned)b; return r; }
__device__ __forceinline__ unsigned pack4_fp8(const f32x4& v) { int a = 0; a = __builtin_amdgcn_cvt_pk_fp8_f32(v[0], v[1], a, false); a = __builtin_amdgcn_cvt_pk_fp8_f32(v[2], v[3], a, true); return (unsigned)a; }
__device__ __forceinline__ float fast_sigmoid(float v) { return __builtin_amdgcn_rcpf(1.f + __builtin_amdgcn_exp2f(-v * LOG2E)); }

namespace pg8 {
#define PG8_LAS LAS
constexpr int BM = 256, BK = 64, HALF = 128, HTB = HALF * BK * 2, STAGE_BYTES = 8 * HTB, NXCD = 8, WGM = 8;
__host__ __device__ __forceinline__ int lds_byte(int r, int c) { const int st = (r >> 4) * 2 + (c >> 5), rr = r & 15, cc = c & 31, ob = rr * 64 + cc * 2; return st * 1024 + (ob ^ (((ob >> 9) & 1) << 5)); }
__host__ __device__ __forceinline__ void stage_rc(int b, int& R, int& C) { const int st = b / 1024, sb = b % 1024, swz = sb ^ (((sb >> 9) & 1) << 5); R = (st >> 1) * 16 + swz / 64; C = (st & 1) * 32 + (swz % 64) / 2; }
__host__ __device__ __forceinline__ int perm32(int rho) { const int n = rho >> 4, i = rho & 15; return 8 * (i >> 2) + 4 * n + (i & 3); }

struct Unit { int pm, pn, sub, ord; const char* a; const char* b; };
struct Gemm { int lda; int K; int sw = 0x7F7F7F7F; };
__device__ __forceinline__ void tile_order(int L, int nM, int nN, int& pm, int& pn) {
    const int nwg = nM * nN; int wgid = L; { const int q = nwg / NXCD, r = nwg % NXCD, xcd = wgid % NXCD, off = wgid / NXCD; wgid = (xcd < r ? xcd * (q + 1) : r * (q + 1) + (xcd - r) * q) + off; }
    const int nig = WGM * nN, gid = wgid / nig, fm = gid * WGM, gsz = (nM - fm) < WGM ? (nM - fm) : WGM;
    pm = fm + ((wgid % nig) % gsz); pn = (wgid % nig) / gsz;
}
__device__ __forceinline__ u32x4 pack8(const f32x4& v0, const f32x4& v1) { u32x4 w; w.x = cvt_pk_bf16(v0[0], v0[1]); w.y = cvt_pk_bf16(v0[2], v0[3]); w.z = cvt_pk_bf16(v1[0], v1[1]); w.w = cvt_pk_bf16(v1[2], v1[3]); return w; }
__device__ __forceinline__ void unpack8(const u32x4& w, f32x4& v0, f32x4& v1) {
    v0[0] = __uint_as_float(w.x << 16); v0[1] = __uint_as_float(w.x & 0xffff0000u); v0[2] = __uint_as_float(w.y << 16); v0[3] = __uint_as_float(w.y & 0xffff0000u);
    v1[0] = __uint_as_float(w.z << 16); v1[1] = __uint_as_float(w.z & 0xffff0000u); v1[2] = __uint_as_float(w.w << 16); v1[3] = __uint_as_float(w.w & 0xffff0000u); }

__device__ __forceinline__ unsigned pack4_u8(const f32x4& v) {
    const unsigned a = (unsigned)__builtin_rintf(v[0] * 255.f), b = (unsigned)__builtin_rintf(v[1] * 255.f), c = (unsigned)__builtin_rintf(v[2] * 255.f), d = (unsigned)__builtin_rintf(v[3] * 255.f);
    return a | (b << 8) | (c << 16) | (d << 24); }
__device__ __forceinline__ void unpack8_u8(const u32x2& w, f32x4& v0, f32x4& v1) {
    constexpr float k = 1.f / 255.f;
    v0[0] = (float)(w.x & 0xffu) * k; v0[1] = (float)((w.x >> 8) & 0xffu) * k; v0[2] = (float)((w.x >> 16) & 0xffu) * k; v0[3] = (float)(w.x >> 24) * k;
    v1[0] = (float)(w.y & 0xffu) * k; v1[1] = (float)((w.y >> 8) & 0xffu) * k; v1[2] = (float)((w.y >> 16) & 0xffu) * k; v1[3] = (float)(w.y >> 24) * k; }
struct EpiProj {
    static constexpr bool PERM = true, AFTER_DRAIN = false, KHOOK = false;
    bf16_t* PROJ; bf16_t* MEMKV; const float* tab1; const float* tab2; const float* qg; const float* kg; const float* rstd1;
    __device__ __forceinline__ void operator()(const f32x4 (&acc)[2][2][4][2], const Unit& u, int wr, int wc, int fr, int fq) const {
        const int colt = u.pn * 256, dcol = colt + wc * 64 + fq * 8, row0 = u.pm * 256 + wr * 64 + fr;
        if (u.sub == 1) {
#pragma unroll
            for (int ai = 0; ai < 2; ++ai)
#pragma unroll
                for (int m = 0; m < 4; ++m) { bf16_t* rowp = MEMKV + (size_t)(row0 + ai * 128 + m * 16) * 1024 + dcol;
#pragma unroll
                    for (int bj = 0; bj < 2; ++bj) *(u32x4*)(rowp + bj * 32) = pack8(acc[ai][bj][m][0], acc[ai][bj][m][1]); }
            return;
        }
        int mode = 0; float sc = 1.f; const float* g = qg;
        if (colt < C_AV) { mode = 1; if (colt < C_AK) sc = C2_64; }
        else if (colt < C_BQ) mode = 0;
        else if (colt < C_BK) { mode = 2; sc = C2_64; }
        else if (colt < C_CQ) { if (wc < 2) { mode = 2; g = kg; } }
        else if (colt < C_G) sc = C2_128;
        else mode = 3;
        f32x4 gv[2][2];
        if (mode == 2) {
#pragma unroll
            for (int bj = 0; bj < 2; ++bj)
#pragma unroll
                for (int n = 0; n < 2; ++n) gv[bj][n] = *(const f32x4*)(g + bj * 32 + fq * 8 + n * 4);
        }
        float frq[2][4]; const bool rope = (mode == 1 || mode == 2);
        if (rope) {
#pragma unroll
            for (int n = 0; n < 2; ++n)
#pragma unroll
                for (int e = 0; e < 4; ++e) { const int i = fq * 8 + n * 4 + e;
                    frq[n][e] = (mode == 1 ? inv1d(i) : inv2d(i & 15)) * 0.15915494309189535f; }
        }
        float r1v[2][4];
#pragma unroll
        for (int ai = 0; ai < 2; ++ai)
#pragma unroll
            for (int m = 0; m < 4; ++m) r1v[ai][m] = rstd1[row0 + ai * 128 + m * 16];
        asm volatile("" ::: "memory");
#pragma unroll
        for (int ai = 0; ai < 2; ++ai)
#pragma unroll
            for (int m = 0; m < 4; ++m) {
                const int row = row0 + ai * 128 + m * 16, pos = row & (SEQ - 1);
                const float r1 = r1v[ai][m];
                f32x4 v[2][2] = {{acc[ai][0][m][0] * r1, acc[ai][0][m][1] * r1}, {acc[ai][1][m][0] * r1, acc[ai][1][m][1] * r1}};
                if (mode == 2) {
                    float ss = 0.f;
#pragma unroll
                    for (int bj = 0; bj < 2; ++bj)
#pragma unroll
                        for (int n = 0; n < 2; ++n) ss += (v[bj][n][0] * v[bj][n][0] + v[bj][n][1] * v[bj][n][1]) + (v[bj][n][2] * v[bj][n][2] + v[bj][n][3] * v[bj][n][3]);
                    ss += xlane<16>(ss); ss = half_sum(ss);
                    const float rs = rsqrtf(ss * (1.f / 64.f) + EPS);
#pragma unroll
                    for (int bj = 0; bj < 2; ++bj)
#pragma unroll
                        for (int n = 0; n < 2; ++n) v[bj][n] = v[bj][n] * rs * gv[bj][n];
                }
                if (rope) {
                    const float pe = (float)(mode == 1 ? pos : (fq < 2 ? (pos >> 6) : (pos & 63)));
#pragma unroll
                    for (int n = 0; n < 2; ++n)
#pragma unroll
                        for (int e = 0; e < 4; ++e) { const float rev = __builtin_amdgcn_fractf(pe * frq[n][e]), cs = __builtin_amdgcn_cosf(rev), sn = __builtin_amdgcn_sinf(rev);
                            const float x1 = v[0][n][e], x2 = v[1][n][e]; v[0][n][e] = x1 * cs - x2 * sn; v[1][n][e] = x2 * cs + x1 * sn; }
                }
                if (mode == 3) {
#pragma unroll
                    for (int bj = 0; bj < 2; ++bj)
#pragma unroll
                        for (int n = 0; n < 2; ++n)
#pragma unroll
                            for (int e = 0; e < 4; ++e) v[bj][n][e] = fast_sigmoid(v[bj][n][e]);
                }
                if (mode == 3) {
                    u32x4 w; w.x = pack4_u8(v[0][0]); w.y = pack4_u8(v[0][1]); w.z = pack4_u8(v[1][0]); w.w = pack4_u8(v[1][1]);
                    *(u32x4*)((unsigned char*)(PROJ + (size_t)row * D_IN + C_G) + (colt - C_G) + wc * 64 + fq * 16) = w;
                } else {
                bf16_t* rowp = PROJ + (size_t)row * D_IN + dcol;
#pragma unroll
                for (int bj = 0; bj < 2; ++bj) *(u32x4*)(rowp + bj * 32) = pack8(v[bj][0] * sc, v[bj][1] * sc);
                }
            }
    }
};
struct EpiGate {
    static constexpr bool PERM = true, AFTER_DRAIN = false, KHOOK = true;
    bf16_t* MERGED; const bf16_t* PROJ;
    __device__ __forceinline__ static void ug(const u32x2& w, f32x4& v0, f32x4& v1) {
        unpack8_u8(w, v0, v1);
#pragma unroll
        for (int e = 0; e < 4; ++e) { v0[e] = fmaxf(v0[e], 0.5f / 255.f); v1[e] = fmaxf(v1[e], 0.5f / 255.f); } }
    __device__ __forceinline__ void khook(f32x4 (&acc)[2][2][4][2], const Unit& u, int t, int wr, int wc, int fr, int fq) const {
        int row0 = u.pm * 256 + wr * 64 + fr; asm volatile("" : "+v"(row0));
        const int seg = (t >> 3) - 1, col0 = u.pn * 256 + wc * 32 + fq * 8;
#pragma unroll
        for (int ai = 0; ai < 2; ++ai) {
            u32x2 ga[4][2], gb[4][2];
#pragma unroll
            for (int m = 0; m < 4; ++m) { const unsigned char* gp = (const unsigned char*)(PROJ + (size_t)(row0 + ai * 128 + m * 16) * D_IN + C_G) + seg * 1024 + col0;
#pragma unroll
                for (int bj = 0; bj < 2; ++bj) { ga[m][bj] = *(const u32x2*)(gp + bj * 128); gb[m][bj] = *(const u32x2*)(gp + 1024 + bj * 128); } }
            asm volatile("" ::: "memory");
#pragma unroll
            for (int m = 0; m < 4; ++m)
#pragma unroll
                for (int bj = 0; bj < 2; ++bj) { f32x4 a0, a1, b0, b1; ug(ga[m][bj], a0, a1); ug(gb[m][bj], b0, b1);
#pragma unroll
                    for (int e = 0; e < 4; ++e) { acc[ai][bj][m][0][e] *= a0[e] * __builtin_amdgcn_rcpf(b0[e]); acc[ai][bj][m][1][e] *= a1[e] * __builtin_amdgcn_rcpf(b1[e]); } }
            asm volatile("" ::: "memory");
        }
    }
    __device__ __forceinline__ void operator()(const f32x4 (&acc)[2][2][4][2], const Unit& u, int wr, int wc, int fr, int fq) const {
        const int col0 = u.pn * 256 + wc * 32 + fq * 8, row0 = u.pm * 256 + wr * 64 + fr;
#pragma unroll
        for (int ai = 0; ai < 2; ++ai) {
            u32x2 gq[4][2];
#pragma unroll
            for (int m = 0; m < 4; ++m) { const unsigned char* gp = (const unsigned char*)(PROJ + (size_t)(row0 + ai * 128 + m * 16) * D_IN + C_G) + 2 * 1024 + col0;
#pragma unroll
                for (int bj = 0; bj < 2; ++bj) gq[m][bj] = *(const u32x2*)(gp + bj * 128); }
            asm volatile("" ::: "memory");
#pragma unroll
            for (int m = 0; m < 4; ++m) { bf16_t* op = MERGED + (size_t)(row0 + ai * 128 + m * 16) * DM + col0;
#pragma unroll
                for (int bj = 0; bj < 2; ++bj) { f32x4 g0, g1; ug(gq[m][bj], g0, g1); *(u32x4*)(op + bj * 128) = pack8(g0 * acc[ai][bj][m][0], g1 * acc[ai][bj][m][1]); } }
            asm volatile("" ::: "memory");
        }
    }
};
struct EpiResid {
    static constexpr bool PERM = true, AFTER_DRAIN = false, KHOOK = false;
    bf16_t* XB;
    __device__ __forceinline__ void operator()(const f32x4 (&acc)[2][2][4][2], const Unit& u, int wr, int wc, int fr, int fq) const {
        const int col0 = u.pn * 256 + wc * 32 + fq * 8, row0 = u.pm * 256 + wr * 64 + fr;
#pragma unroll
        for (int ai = 0; ai < 2; ++ai)
#pragma unroll
            for (int mp = 0; mp < 2; ++mp) {
                u32x4 xq[2][2];
#pragma unroll
                for (int mi = 0; mi < 2; ++mi)
#pragma unroll
                    for (int bj = 0; bj < 2; ++bj) xq[mi][bj] = *(const u32x4*)(XB + (size_t)(row0 + ai * 128 + (mp * 2 + mi) * 16) * XP + col0 + bj * 128);
                asm volatile("" ::: "memory");
#pragma unroll
                for (int mi = 0; mi < 2; ++mi) { const int m = mp * 2 + mi;
#pragma unroll
                    for (int bj = 0; bj < 2; ++bj) { f32x4 x0, x1; unpack8(xq[mi][bj], x0, x1);
                        *(u32x4*)(XB + (size_t)(row0 + ai * 128 + m * 16) * XP + col0 + bj * 128) = pack8(x0 + acc[ai][bj][m][0], x1 + acc[ai][bj][m][1]); } }
                asm volatile("" ::: "memory");
            }
    }
};
constexpr float HID_SCALE = 4.f;
struct EpiSilu {
    static constexpr bool PERM = true, AFTER_DRAIN = false, KHOOK = false;
    unsigned char* HID; const PG8_LAS float* rtab;
    __device__ __forceinline__ void operator()(const f32x4 (&acc)[2][2][4][2], const Unit& u, int wr, int wc, int fr, int fq) const {
        const __amdgpu_buffer_rsrc_t rsrc = __builtin_amdgcn_make_buffer_rsrc((void*)HID, 0, P_ROWS * DEXP, 0x00020000);
        const int col0 = u.pn * 128 + wc * 32 + fq * 8, row0 = u.pm * 256 + wr * 64 + fr;
#pragma unroll
        for (int ai = 0; ai < 2; ++ai)
#pragma unroll
            for (int m = 0; m < 4; ++m) { f32x4 h[2]; const float r = rtab[u.ord * 256 + wr * 64 + fr + ai * 128 + m * 16];
#pragma unroll
                for (int n = 0; n < 2; ++n)
#pragma unroll
                    for (int e = 0; e < 4; ++e) { const float gq = acc[ai][0][m][n][e] * r; h[n][e] = gq * fast_sigmoid(gq) * (acc[ai][1][m][n][e] * (r * HID_SCALE)); }
                __builtin_amdgcn_raw_buffer_store_b64(pack8_fp8(h[0], h[1]), rsrc, (row0 + ai * 128 + m * 16) * DEXP + col0, 0, 16); }
    }
};
struct EpiRowScale {
    static constexpr bool PERM = true, AFTER_DRAIN = false, KHOOK = false;
    unsigned char* YB; const PG8_LAS float* wtab;
    __device__ __forceinline__ void operator()(const f32x4 (&acc)[2][2][4][2], const Unit& u, int wr, int wc, int fr, int fq) const {
        const int col0 = u.pn * 256 + wc * 64 + fq * 16, rt0 = wr * 64 + fr;
#pragma unroll
        for (int ai = 0; ai < 2; ++ai)
#pragma unroll
            for (int m = 0; m < 4; ++m) { const int rt = rt0 + ai * 128 + m * 16; const float w = wtab[u.ord * 256 + rt];
                if (w >= 0.f) {
                    u32x4 o; o.x = pack4_fp8(acc[ai][0][m][0] * w); o.y = pack4_fp8(acc[ai][0][m][1] * w); o.z = pack4_fp8(acc[ai][1][m][0] * w); o.w = pack4_fp8(acc[ai][1][m][1] * w);
                    *(u32x4*)(YB + (size_t)(u.pm * 256 + rt) * DM + col0) = o; } }
    }
};
constexpr int NPT = C_G / 256, NGT = (D_IN - C_G) / 256;
struct SchedProj {
    int c, G, nmain, ntotal; const char* A; const char* B; const char* Am; const char* Bm;
    __device__ __forceinline__ bool next(int i, Unit& u) const {
        const long L = (long)i * G + c; if (L >= ntotal) return false;
        u.ord = i;
        if (L < nmain) { tile_order((int)L, M / 256, NPT, u.pm, u.pn); u.sub = 0; u.a = A + (size_t)u.pm * (256 * XP * 2); u.b = B + (size_t)u.pn * (256 * DM * 2); }
        else { const int r = (int)L - nmain; u.pm = r >> 2; u.pn = r & 3; u.sub = 1; u.a = Am + (size_t)u.pm * (256 * XP * 2); u.b = Bm + (size_t)u.pn * (256 * DM * 2); }
        return true; }
    __device__ __forceinline__ void a_ready(const Unit&) const {}
    __device__ __forceinline__ void done(const Unit&) const {}
};
struct SchedGate8 {
    int c, G, kh; const char* A; const char* B;
    __device__ __forceinline__ bool next(int i, Unit& u) const {
        long L;
        if (G == 256) { const int k = c >> 3, nl = 32 - kh, k3 = 96 - 4 * nl - 2 * kh, nf = k < k3 ? 3 : k < kh ? 2 : 4, st = k < k3 ? 3 * k : k < kh ? 3 * k3 + 2 * (k - k3) : 3 * k3 + 2 * (kh - k3) + 4 * (k - kh);
            if (i >= nf) return false; L = 8 * (st + i) + (c & 7); }
        else { L = (long)i * G + c; if (L >= (M / 256) * NGT) return false; }
        tile_order((int)L, M / 256, NGT, u.pm, u.pn); u.sub = 0; u.ord = i; u.a = A + (size_t)u.pm * (256 * DM); u.b = B + (size_t)u.pn * (256 * DM); u.pn += NPT; return true; }
    __device__ __forceinline__ void a_ready(const Unit&) const {}
    __device__ __forceinline__ void done(const Unit&) const {}
};
struct EpiSig {
    static constexpr bool PERM = true, AFTER_DRAIN = false, KHOOK = false;
    bf16_t* PROJ; const float* rstd1;
    __device__ __forceinline__ void operator()(const f32x4 (&acc)[2][2][4][2], const Unit& u, int wr, int wc, int fr, int fq) const {
        const int colt = u.pn * 256, row0 = u.pm * 256 + wr * 64 + fr;
        float r1v[2][4];
#pragma unroll
        for (int ai = 0; ai < 2; ++ai)
#pragma unroll
            for (int m = 0; m < 4; ++m) r1v[ai][m] = rstd1[row0 + ai * 128 + m * 16];
        asm volatile("" ::: "memory");
#pragma unroll
        for (int ai = 0; ai < 2; ++ai)
#pragma unroll
            for (int m = 0; m < 4; ++m) { const int row = row0 + ai * 128 + m * 16; const float r1 = r1v[ai][m]; u32x4 w;
#pragma unroll
                for (int bj = 0; bj < 2; ++bj)
#pragma unroll
                    for (int n = 0; n < 2; ++n) { f32x4 v;
#pragma unroll
                        for (int e = 0; e < 4; ++e) v[e] = fast_sigmoid(acc[ai][bj][m][n][e] * r1);
                        w[bj * 2 + n] = pack4_u8(v); }
                *(u32x4*)((unsigned char*)(PROJ + (size_t)row * D_IN + C_G) + (colt - C_G) + wc * 64 + fq * 16) = w; }
    }
};
struct SchedPlain {
    int c, G, nM; const char* A; const char* B; size_t a_tile, b_tile;
    __device__ __forceinline__ bool next(int i, Unit& u) const {
        const long L = (long)i * G + c; if (L >= (long)nM * 4) return false;
        tile_order((int)L, nM, 4, u.pm, u.pn); u.sub = 0; u.ord = i; u.a = A + (size_t)u.pm * a_tile; u.b = B + (size_t)u.pn * b_tile; return true; }
    __device__ __forceinline__ void a_ready(const Unit&) const {}
    __device__ __forceinline__ void done(const Unit&) const {}
};
struct SchedMoeUp {
    static constexpr size_t b_exp = (size_t)1024 * 1024, b_tile = (size_t)256 * DM;
    int c, G, ntiles; const PG8_LAS int* tile_e; const char* A; const char* B; unsigned* tcnt;
    __device__ __forceinline__ bool next(int i, Unit& u) const {
        const long L = (long)i * G + c; if (L >= (long)ntiles * 4) return false;
        u.pm = (int)(L >> 2); u.pn = (int)(L & 3); u.sub = 0; u.ord = i; const int e = tile_e[u.pm];
        u.a = A; u.b = B + (size_t)e * b_exp + (size_t)u.pn * b_tile; return true; }
    __device__ __forceinline__ void a_ready(const Unit&) const {}
    __device__ __forceinline__ void done(const Unit& u) const {
        asm volatile("s_waitcnt vmcnt(0)" ::: "memory");
        if (lane_id() == 0) __hip_atomic_fetch_add(tcnt + 64 * u.pm, 1u, __ATOMIC_RELAXED, __HIP_MEMORY_SCOPE_AGENT);
    }
};
__device__ __forceinline__ int moe_down_unit(int c, int i, int rem, int G) {
    const int n0 = G - rem, n1 = rem;
    return c >= rem ? n0 * i + n1 * (i > 1 ? i - 1 : 0) + (c - rem) : n0 * (i + 2) + n1 * i + c;
}
struct SchedMoeDown {
    static constexpr size_t a_tile = (size_t)256 * DEXP, b_exp = (size_t)1024 * 512, b_tile = (size_t)256 * DEXP;
    int c, G, ntiles, rem, wv; const PG8_LAS int* tile_e; const char* A; const char* B; unsigned* tcnt; unsigned* tmo;
    __device__ __forceinline__ bool next(int i, Unit& u) const {
        const int j = moe_down_unit(c, i, rem, G); if (j >= ntiles * 4) return false;
        u.pm = j >> 2; u.pn = j & 3; u.sub = 0; u.ord = i; const int e = tile_e[u.pm];
        u.a = A + (size_t)u.pm * a_tile; u.b = B + (size_t)e * b_exp + (size_t)u.pn * b_tile; return true; }
    __device__ __forceinline__ void a_ready(const Unit& u) const {
        if (wv == 0) {
            unsigned polls = 0;
            while ((unsigned)__builtin_amdgcn_readfirstlane(__hip_atomic_load(tcnt + 64 * u.pm, __ATOMIC_RELAXED, __HIP_MEMORY_SCOPE_AGENT)) < 32u) {
                if (++polls > (1u << 20)) { if (lane_id() == 0) __hip_atomic_store(tmo, 1u, __ATOMIC_RELAXED, __HIP_MEMORY_SCOPE_AGENT); break; }
                __builtin_amdgcn_s_sleep(2); }
            __builtin_amdgcn_fence(__ATOMIC_ACQUIRE, "agent");
            asm volatile("s_waitcnt vmcnt(0)" ::: "memory");
        }
        asm volatile("" ::: "memory"); __builtin_amdgcn_s_barrier(); asm volatile("" ::: "memory");
    }
    __device__ __forceinline__ void done(const Unit&) const {}
};

template <class Epi, class Sched, bool ALIGN_EPI = false, bool SP2 = false, bool GATHER = false, bool F8 = false>
__device__ __forceinline__ void gemm_phase(PG8_LAS unsigned char* lds, const Gemm g, const Sched& S, const Epi& E, int wave_id, const PG8_LAS unsigned* rowtab = nullptr) {
    static_assert(!GATHER || SP2, "the gathered A path is written for the two-super-phase loop");
    int tid_ = wave_id * 64 + lane_id(); asm volatile("" : "+v"(tid_));
    const int tid = tid_, wid = __builtin_amdgcn_readfirstlane(tid >> 6), lane = tid & 63, wr = wid >> 2, wc = wid & 3, fr = lane & 15, fq = lane >> 4;
    int K_ = g.K; if constexpr (F8) asm volatile("" : "+s"(K_));
    const int K = K_, nt = K / BK;
    int sc8v = g.sw; if constexpr (F8) asm volatile("" : "+v"(sc8v));
    unsigned voffA[2], voffB[2];
#pragma unroll
    for (int i = 0; i < 2; ++i) { int R, C; stage_rc(tid * 16 + i * 8192, R, C); const int Rb = Epi::PERM ? ((R & ~31) + perm32(R & 31)) : R;
        voffA[i] = (unsigned)(R * g.lda + C) * 2u; voffB[i] = (unsigned)(Rb * K + C) * 2u; }
    unsigned gC[2][2] = {{0u, 0u}, {0u, 0u}}, gN[2][2] = {{0u, 0u}, {0u, 0u}};
#define PG8_GROWS(dst, ord) do { if constexpr (GATHER) { _Pragma("unroll") for (int i_ = 0; i_ < 2; ++i_) { int R_, C_; stage_rc((wid * 64 + fq * 16 + fr) * 16 + i_ * 8192, R_, C_);     \
        _Pragma("unroll") for (int h_ = 0; h_ < 2; ++h_) dst[h_][i_] = rowtab[(ord) * 256 + h_ * 128 + R_] + (unsigned)C_ * 2u; } } } while (0)
#define PG8_STAGE_A(bufoff, base, h, use_next) do { if constexpr (GATHER) { unsigned vo_[2]; vo_[0] = (use_next) ? gN[h][0] : gC[h][0]; vo_[1] = (use_next) ? gN[h][1] : gC[h][1]; PG8_STAGE(bufoff, base, vo_); } \
        else { PG8_STAGE(bufoff, (base) + (h) * hstepA, voffA); } } while (0)
    const size_t kstep = (size_t)(BK * 2);
    const size_t hstepA = (size_t)HALF * g.lda * 2, hstepB = (size_t)HALF * K * 2;
    const unsigned ldsw = (unsigned)wid * 1024u;
    const int aoff = lds_byte(wr * 64 + fr, fq * 8), boff = lds_byte(wc * 32 + fr, fq * 8);
#define PG8_SA(b, h) (((b) * 2 + (h)) * HTB)
#define PG8_SB(b, h) ((4 + (b) * 2 + (h)) * HTB)
#define PG8_STAGE(bufoff, gbase, voff) do { _Pragma("unroll") for (int _i = 0; _i < 2; ++_i) \
        __builtin_amdgcn_global_load_lds((const unsigned*)((const char*)(gbase) + (voff)[_i]), (PG8_LAS unsigned*)(lds + (bufoff) + ldsw + _i * 8192), 16, 0, 0); } while (0)
#define PG8_LDA(dst, b, h) do { _Pragma("unroll") for (int m = 0; m < 4; ++m) _Pragma("unroll") for (int k = 0; k < 2; ++k) dst[m][k] = *(const PG8_LAS bf16x8*)(lds + PG8_SA(b, h) + aoff + m * 2048 + k * 1024); } while (0)
#define PG8_LDB(dst, b, h) do { _Pragma("unroll") for (int n = 0; n < 2; ++n) _Pragma("unroll") for (int k = 0; k < 2; ++k) dst[n][k] = *(const PG8_LAS bf16x8*)(lds + PG8_SB(b, h) + boff + n * 2048 + k * 1024); } while (0)
#define PG8_MMA(ai, bj, At, Bt) do { __builtin_amdgcn_s_setprio(1); _Pragma("unroll") for (int m = 0; m < 4; ++m) _Pragma("unroll") for (int n = 0; n < 2; ++n) { \
        if constexpr (F8) asm volatile("v_mfma_scale_f32_16x16x128_f8f6f4 %0, %1, %2, %0, %3, %3 op_sel_hi:[0,0,0]" : "+v"(acc[ai][bj][m][n]) : "v"(cat8(Bt[n][0], Bt[n][1])), "v"(cat8(At[m][0], At[m][1])), "v"(sc8v));     \
        else { _Pragma("unroll") for (int k = 0; k < 2; ++k) acc[ai][bj][m][n] = __builtin_amdgcn_mfma_f32_16x16x32_bf16(Bt[n][k], At[m][k], acc[ai][bj][m][n], 0, 0, 0); } } __builtin_amdgcn_s_setprio(0); } while (0)
#define PG8_WAIT_V(n) asm volatile("s_waitcnt vmcnt(" #n ")" ::: "memory")
#define PG8_WAIT_L(n) asm volatile("s_waitcnt lgkmcnt(" #n ")" ::: "memory")
#define PG8_BAR __builtin_amdgcn_s_barrier()
#define PG8_SCHED __builtin_amdgcn_sched_barrier(0)
    Unit cur, nxt; int ui = 0;
    if (!S.next(0, cur)) return;
    f32x4 acc[2][2][4][2];
#pragma unroll
    for (int a = 0; a < 2; ++a)
#pragma unroll
        for (int b = 0; b < 2; ++b)
#pragma unroll
            for (int m = 0; m < 4; ++m)
#pragma unroll
                for (int n = 0; n < 2; ++n) acc[a][b][m][n] = (f32x4){0.f, 0.f, 0.f, 0.f};
    bf16x8 At[4][2], B0[2][2], B1[2][2];
    const char* cA = cur.a; const char* cB = cur.b;
    S.a_ready(cur);
    if constexpr (SP2) {
        PG8_GROWS(gC, 0);
        PG8_STAGE(PG8_SB(0, 0), cB, voffB); PG8_STAGE(PG8_SB(0, 1), cB + hstepB, voffB); PG8_STAGE_A(PG8_SA(0, 0), cA, 0, false); PG8_STAGE_A(PG8_SA(0, 1), cA, 1, false);
        if (wr == 1) PG8_BAR;
        PG8_WAIT_V(2); PG8_BAR;
        PG8_STAGE(PG8_SB(1, 0), cB + kstep, voffB); PG8_STAGE_A(PG8_SA(1, 0), cA + kstep, 0, false); PG8_STAGE(PG8_SB(1, 1), cB + hstepB + kstep, voffB);
        PG8_WAIT_V(6); PG8_BAR;
    } else {
        PG8_STAGE(PG8_SB(0, 0), cB, voffB); PG8_STAGE(PG8_SA(0, 0), cA, voffA); PG8_STAGE(PG8_SB(0, 1), cB + hstepB, voffB); PG8_STAGE(PG8_SA(0, 1), cA + hstepA, voffA);
        if (wr == 1) PG8_BAR;
        PG8_WAIT_V(4); PG8_BAR;
        PG8_STAGE(PG8_SB(1, 0), cB + kstep, voffB); PG8_STAGE(PG8_SA(1, 0), cA + kstep, voffA); PG8_STAGE(PG8_SB(1, 1), cB + hstepB + kstep, voffB);
        PG8_WAIT_V(6); PG8_BAR;
    }
    for (;;) {
        const bool has_next = S.next(ui + 1, nxt);
        const char* nA = has_next ? nxt.a : cA; const char* nB = has_next ? nxt.b : cB;
        for (int t = 0; t < nt; t += 2) {
            if constexpr (Epi::KHOOK) { if (t == 8 || t == 16) E.khook(acc, cur, t, wr, wc, fr, fq); }
            const bool last = (t == nt - 2);
            const char* a1 = cA + (size_t)(t + 1) * kstep;
            const char* a2 = last ? nA : cA + (size_t)(t + 2) * kstep; const char* b2 = last ? nB : cB + (size_t)(t + 2) * kstep;
            const char* a3 = a2 + kstep; const char* b3 = b2 + kstep;
            if (last && has_next) S.a_ready(nxt);
            if constexpr (GATHER) { if (last) { if (has_next) { PG8_GROWS(gN, ui + 1); } else { _Pragma("unroll") for (int h_ = 0; h_ < 2; ++h_) _Pragma("unroll") for (int i_ = 0; i_ < 2; ++i_) gN[h_][i_] = gC[h_][i_]; } } }
            if constexpr (SP2) {
            PG8_LDB(B0, 0, 0); PG8_LDB(B1, 0, 1); PG8_SCHED; PG8_LDA(At, 0, 0); PG8_STAGE_A(PG8_SA(1, 1), a1, 1, false);
            PG8_WAIT_V(8); PG8_WAIT_L(0); PG8_BAR; PG8_MMA(0, 0, At, B0); PG8_MMA(0, 1, At, B1); PG8_BAR; PG8_SCHED;
            PG8_LDA(At, 0, 1); PG8_STAGE(PG8_SB(0, 0), b2, voffB); PG8_STAGE(PG8_SB(0, 1), b2 + hstepB, voffB); PG8_STAGE_A(PG8_SA(0, 0), a2, 0, last);
            PG8_WAIT_V(8); PG8_WAIT_L(0); PG8_BAR; PG8_MMA(1, 0, At, B0); PG8_MMA(1, 1, At, B1); PG8_BAR; PG8_SCHED;
            PG8_LDB(B0, 1, 0); PG8_LDB(B1, 1, 1); PG8_SCHED; PG8_LDA(At, 1, 0); PG8_STAGE_A(PG8_SA(0, 1), a2, 1, last);
            PG8_WAIT_V(8); PG8_WAIT_L(0); PG8_BAR; PG8_MMA(0, 0, At, B0); PG8_MMA(0, 1, At, B1); PG8_BAR; PG8_SCHED;
            PG8_LDA(At, 1, 1); PG8_STAGE(PG8_SB(1, 0), b3, voffB); PG8_STAGE(PG8_SB(1, 1), b3 + hstepB, voffB); PG8_STAGE_A(PG8_SA(1, 0), a3, 0, last);
            PG8_WAIT_V(8); PG8_WAIT_L(0); PG8_BAR; PG8_MMA(1, 0, At, B0); PG8_MMA(1, 1, At, B1); PG8_BAR; PG8_SCHED;
            } else {
            PG8_LDB(B0, 0, 0); PG8_SCHED; PG8_LDA(At, 0, 0); PG8_STAGE(PG8_SA(1, 1), a1 + hstepA, voffA);
            PG8_WAIT_L(8); PG8_BAR; PG8_WAIT_L(0); PG8_MMA(0, 0, At, B0); PG8_BAR; PG8_SCHED;
            PG8_LDB(B1, 0, 1); PG8_STAGE(PG8_SB(0, 0), b2, voffB);
            PG8_BAR; PG8_WAIT_L(0); PG8_MMA(0, 1, At, B1); PG8_BAR;
            PG8_LDA(At, 0, 1); PG8_STAGE(PG8_SA(0, 0), a2, voffA);
            PG8_BAR; PG8_WAIT_L(0); PG8_MMA(1, 0, At, B0); PG8_BAR; PG8_SCHED;
            PG8_STAGE(PG8_SB(0, 1), b2 + hstepB, voffB);
            PG8_WAIT_V(6); PG8_BAR; PG8_MMA(1, 1, At, B1); PG8_BAR;
            PG8_LDB(B0, 1, 0); PG8_SCHED; PG8_LDA(At, 1, 0); PG8_STAGE(PG8_SA(0, 1), a2 + hstepA, voffA);
            PG8_WAIT_L(8); PG8_BAR; PG8_WAIT_L(0); PG8_MMA(0, 0, At, B0); PG8_BAR; PG8_SCHED;
            PG8_LDB(B1, 1, 1); PG8_STAGE(PG8_SB(1, 0), b3, voffB);
            PG8_BAR; PG8_WAIT_L(0); PG8_MMA(0, 1, At, B1); PG8_BAR;
            PG8_LDA(At, 1, 1); PG8_STAGE(PG8_SA(1, 0), a3, voffA);
            PG8_BAR; PG8_WAIT_L(0); PG8_MMA(1, 0, At, B0); PG8_BAR; PG8_SCHED;
            PG8_STAGE(PG8_SB(1, 1), b3 + hstepB, voffB);
            PG8_WAIT_V(6); PG8_BAR; PG8_MMA(1, 1, At, B1); PG8_BAR;
            }
        }
        if constexpr (ALIGN_EPI) { if (wr == 0) PG8_BAR; }
        if constexpr (!Epi::AFTER_DRAIN) {
            if constexpr (F8) { asm volatile("s_nop 15\n\ts_nop 15" ::: "memory");
                const int le_ = lane_id(); E(acc, cur, wr, wc, le_ & 15, le_ >> 4); }
            else E(acc, cur, wr, wc, fr, fq);
            S.done(cur); }
        if (!has_next) break;
#pragma unroll
        for (int a = 0; a < 2; ++a)
#pragma unroll
            for (int b = 0; b < 2; ++b)
#pragma unroll
                for (int m = 0; m < 4; ++m)
#pragma unroll
                    for (int n = 0; n < 2; ++n) acc[a][b][m][n] = (f32x4){0.f, 0.f, 0.f, 0.f};
        cur = nxt; cA = nA; cB = nB; ++ui;
        if constexpr (GATHER) { _Pragma("unroll") for (int h_ = 0; h_ < 2; ++h_) _Pragma("unroll") for (int i_ = 0; i_ < 2; ++i_) gC[h_][i_] = gN[h_][i_]; }
        if constexpr (ALIGN_EPI) { if (wr == 1) PG8_BAR; }
    }
    PG8_WAIT_V(0);
    if constexpr (!ALIGN_EPI) { if (wr == 0) PG8_BAR; }
    PG8_BAR;
    if constexpr (Epi::AFTER_DRAIN) { E.fused(acc, cur, wr, wc, fr, fq, lds, wid, lane); S.done(cur); }
#undef PG8_SA
#undef PG8_GROWS
#undef PG8_STAGE_A
#undef PG8_SB
#undef PG8_STAGE
#undef PG8_LDA
#undef PG8_LDB
#undef PG8_MMA
#undef PG8_WAIT_V
#undef PG8_WAIT_L
#undef PG8_BAR
#undef PG8_SCHED
}
}

namespace att {
constexpr int NW = 8, QBLK = 32, KVBLK = 64;
constexpr float THR = 8.f;
#define ATT_SBAR() __builtin_amdgcn_sched_barrier(0)
__device__ __forceinline__ int crow(int r, int hi) { return (r & 3) + 8 * (r >> 2) + 4 * hi; }
template <int D> __device__ __forceinline__ int kswz(int row, int colB) { return D == 128 ? row * 256 + (colB ^ ((row & 7) << 4)) : row * 128 + (colB ^ (((row >> 1) & 7) << 4)); }
template <int DV> __device__ __forceinline__ int v_st(int k, int c) { const int kk = (k & ~0xC) | ((k & 4) << 1) | ((k & 8) >> 1); return ((kk >> 3) * (DV / 32) + (c >> 5)) * 512 + ((kk & 7) * 32 + (c & 31)) * 2; }
__device__ __forceinline__ int v_rd_base(int lane) { return ((lane & 3) << 3) | (((lane >> 2) & 3) << 6) | (((lane >> 4) & 1) << 5) | (((lane >> 5) & 1) << 8); }
template <int DV> constexpr int v_rd_off(int d0, int ks, int half) { return d0 * 512 + ks * (DV / 32) * 1024 + half * (DV / 32) * 512; }
template <int OFF> __device__ __forceinline__ s16x4 tr_read(int vb) { s16x4 r; asm volatile("ds_read_b64_tr_b16 %0, %1 offset:%2" : "=&v"(r) : "v"(vb), "i"(OFF) : "memory"); return r; }

template <bool FIRST> __device__ __forceinline__ void partialSM(f32x16& p0, f32x16& p1, float& m_reg, float& alpha, f32x16& negm) {
    float pmax = p0[0];
#pragma unroll
    for (int r = 1; r < 16; ++r) pmax = fmaxf(pmax, p0[r]);
#pragma unroll
    for (int r = 0; r < 16; ++r) pmax = fmaxf(pmax, p1[r]);
    { auto rr = __builtin_amdgcn_permlane32_swap(__float_as_uint(pmax), __float_as_uint(pmax), false, false); pmax = fmaxf(__uint_as_float(rr[0]), __uint_as_float(rr[1])); }
    alpha = 1.f;
    if (FIRST || !__builtin_expect(__all(pmax <= THR), 1)) {
        const float dl = FIRST ? pmax : fmaxf(pmax, 0.f);
        if (!FIRST) alpha = __builtin_amdgcn_exp2f(-dl);
        m_reg += dl;
#pragma unroll
        for (int r = 0; r < 16; ++r) { p0[r] -= dl; p1[r] -= dl; negm[r] = -m_reg; }
    }
#pragma unroll
    for (int r = 0; r < 16; ++r) p0[r] = __builtin_amdgcn_exp2f(p0[r]);
}
__device__ __forceinline__ void finishSM(f32x16& p0, f32x16& p1, float alpha, float& l_reg, bf16x8& pa0, bf16x8& pa1, bf16x8& pa2, bf16x8& pa3) {
#pragma unroll
    for (int r = 0; r < 16; ++r) p1[r] = __builtin_amdgcn_exp2f(p1[r]);
    f32x2 ps2 = {p0[0] + p1[0], p0[1] + p1[1]};
#pragma unroll
    for (int r = 2; r < 16; r += 2) { ps2 += (f32x2){p0[r], p0[r + 1]}; ps2 += (f32x2){p1[r], p1[r + 1]}; }
    float ps = ps2[0] + ps2[1];
    { auto rr = __builtin_amdgcn_permlane32_swap(__float_as_uint(ps), __float_as_uint(ps), false, false); ps = __uint_as_float(rr[0]) + __uint_as_float(rr[1]); }
    l_reg = l_reg * alpha + ps;
#define ATT_PK4(P, BASE, OUT) do { unsigned a0 = cvt_pk_bf16(P[BASE + 0], P[BASE + 1]), a1 = cvt_pk_bf16(P[BASE + 2], P[BASE + 3]);   \
    unsigned b0 = cvt_pk_bf16(P[BASE + 4], P[BASE + 5]), b1 = cvt_pk_bf16(P[BASE + 6], P[BASE + 7]);                              \
    auto r0 = __builtin_amdgcn_permlane32_swap(a0, b0, false, false); auto r1 = __builtin_amdgcn_permlane32_swap(a1, b1, false, false); \
    u32x4 w = {r0[0], r1[0], r0[1], r1[1]}; OUT = *reinterpret_cast<bf16x8*>(&w); } while (0)
    ATT_PK4(p0, 0, pa0); ATT_PK4(p0, 8, pa1); ATT_PK4(p1, 0, pa2); ATT_PK4(p1, 8, pa3);
#undef ATT_PK4
}
template <int DQK> __device__ __forceinline__ void qkt(f32x16& p0, f32x16& p1, const char* Ks, const bf16x8* qr, const f32x16& negm, int r32, int hi) {
#pragma unroll
    for (int d0 = 0; d0 < DQK / 16; ++d0) { const int cb = (d0 * 16 + hi * 8) * 2;
        const bf16x8 b0 = *reinterpret_cast<const bf16x8*>(Ks + kswz<DQK>(r32, cb));
        const bf16x8 b1 = *reinterpret_cast<const bf16x8*>(Ks + kswz<DQK>(32 + r32, cb));
        p0 = __builtin_amdgcn_mfma_f32_32x32x16_bf16(b0, qr[d0], d0 == 0 ? negm : p0, 0, 0, 0);
        p1 = __builtin_amdgcn_mfma_f32_32x32x16_bf16(b1, qr[d0], d0 == 0 ? negm : p1, 0, 0, 0); }
}
template <int DV, int D0> __device__ __forceinline__ void pv_one(f32x16& od, int vb, bf16x8 pa0, bf16x8 pa1, bf16x8 pa2, bf16x8 pa3) {
    const s16x4 l0 = tr_read<v_rd_off<DV>(D0, 0, 0)>(vb), h0 = tr_read<v_rd_off<DV>(D0, 0, 1)>(vb), l1 = tr_read<v_rd_off<DV>(D0, 1, 0)>(vb), h1 = tr_read<v_rd_off<DV>(D0, 1, 1)>(vb);
    const s16x4 l2 = tr_read<v_rd_off<DV>(D0, 2, 0)>(vb), h2 = tr_read<v_rd_off<DV>(D0, 2, 1)>(vb), l3 = tr_read<v_rd_off<DV>(D0, 3, 0)>(vb), h3 = tr_read<v_rd_off<DV>(D0, 3, 1)>(vb);
    asm volatile("s_waitcnt lgkmcnt(0)" ::: "memory"); ATT_SBAR();
#define ATT_PK(L, H) (bf16x8){L[0], L[1], L[2], L[3], H[0], H[1], H[2], H[3]}
    od = __builtin_amdgcn_mfma_f32_32x32x16_bf16(pa0, ATT_PK(l0, h0), od, 0, 0, 0);
    od = __builtin_amdgcn_mfma_f32_32x32x16_bf16(pa1, ATT_PK(l1, h1), od, 0, 0, 0);
    od = __builtin_amdgcn_mfma_f32_32x32x16_bf16(pa2, ATT_PK(l2, h2), od, 0, 0, 0);
    od = __builtin_amdgcn_mfma_f32_32x32x16_bf16(pa3, ATT_PK(l3, h3), od, 0, 0, 0);
#undef ATT_PK
}
template <int DV> __device__ __forceinline__ void pv_all(f32x16 (&o)[DV / 32], int vb, bf16x8 pa0, bf16x8 pa1, bf16x8 pa2, bf16x8 pa3) {
    pv_one<DV, 0>(o[0], vb, pa0, pa1, pa2, pa3); pv_one<DV, 1>(o[1], vb, pa0, pa1, pa2, pa3);
    if constexpr (DV == 128) { pv_one<DV, 2>(o[2], vb, pa0, pa1, pa2, pa3); pv_one<DV, 3>(o[3], vb, pa0, pa1, pa2, pa3); }
}
template <int DQK, int DV> struct Lay { static constexpr int SHM_V = 64 * DV * 2, SHM_K = 64 * DQK * 2, OFF_V = 0, OFF_K = 2 * SHM_V, OFF_WS = OFF_K + 2 * SHM_K, OFF_STASH = OFF_WS + NW * 64 * 4; };

template <int DQK, int DV, int LDQ, int LDK, int LDV>
__device__ __forceinline__ void attn_pass(const bf16_t* __restrict__ Qb, const bf16_t* __restrict__ Kh, const bf16_t* __restrict__ Vh, int nkeys, char* lds, f32x16 (&o)[DV / 32], float (&rli)[16], int wv) {
    using L = Lay<DQK, DV>;
    constexpr int NLK = DQK / 64, NLV = DV / 64;
    int tid_ = wv * 64 + lane_id(); asm volatile("" : "+v"(tid_));
    const int tid = tid_, wid = tid >> 6, lane = tid & 63, r32 = lane & 31, hi = lane >> 5;
    char* V_lds = lds + L::OFF_V; char* K_lds = lds + L::OFF_K;
    float* ws = (float*)(lds + L::OFF_WS) + wid * 64; float* li_l = ws; float* al_l = ws + 32;
    float m_reg = 0.f, l_reg = 0.f; bf16x8 qr[DQK / 16]; f32x16 negm;
#pragma unroll
    for (int r = 0; r < 16; ++r) asm volatile("v_mov_b32 %0, 0" : "=v"(negm[r]));
#pragma unroll
    for (int d = 0; d < DV / 32; ++d) o[d] = f32x16{};
    const bf16_t* Qw = Qb + (size_t)(wid * QBLK + r32) * LDQ + hi * 8;
#pragma unroll
    for (int d0 = 0; d0 < DQK / 16; ++d0) qr[d0] = *reinterpret_cast<const bf16x8*>(Qw + d0 * 16);
    const int krow = DQK == 128 ? (tid >> 4) : (tid >> 3), kcol = DQK == 128 ? (tid & 15) * 8 : (tid & 7) * 8;
    const int vrow = DV == 128 ? (tid >> 4) : (tid >> 3), vcol = DV == 128 ? (tid & 15) * 8 : (tid & 7) * 8;
    const int vb0 = (int)(uintptr_t)V_lds + v_rd_base(lane);
    bf16x8 vsE[NLV], ksE[NLK], vsO[NLV], ksO[NLK];
#define ATT_SLOAD(VS, KS, k0) do { _Pragma("unroll") for (int i_ = 0; i_ < NLV; ++i_) VS[i_] = *reinterpret_cast<const bf16x8*>(&Vh[(size_t)((k0) + vrow + 32 * i_) * LDV + vcol]); \
    _Pragma("unroll") for (int i_ = 0; i_ < NLK; ++i_) KS[i_] = *reinterpret_cast<const bf16x8*>(&Kh[(size_t)((k0) + krow + 32 * i_) * LDK + kcol]); } while (0)
#define ATT_SWRITE(b, VS, KS) do { _Pragma("unroll") for (int i_ = 0; i_ < NLV; ++i_) *(bf16x8*)(V_lds + (b) * L::SHM_V + v_st<DV>(vrow + 32 * i_, vcol)) = VS[i_]; \
    _Pragma("unroll") for (int i_ = 0; i_ < NLK; ++i_) *(bf16x8*)(K_lds + (b) * L::SHM_K + kswz<DQK>(krow + 32 * i_, kcol * 2)) = KS[i_]; } while (0)
#define ATT_SWAIT() do { if constexpr (NLK + NLV == 4) asm volatile("s_waitcnt vmcnt(4)" ::: "memory"); else if constexpr (NLK + NLV == 3) asm volatile("s_waitcnt vmcnt(3)" ::: "memory"); else asm volatile("s_waitcnt vmcnt(2)" ::: "memory"); } while (0)
#define ATT_RESC(a) do { if (__any((a) < 1.f)) { if (hi == 0) al_l[r32] = (a); asm volatile("s_waitcnt lgkmcnt(0)" ::: "memory"); \
    _Pragma("unroll") for (int d = 0; d < DV / 32; ++d) _Pragma("unroll") for (int r = 0; r < 16; ++r) o[d][r] *= al_l[crow(r, hi)]; } } while (0)
    f32x16 pA0, pA1, pB0, pB1; float alA, alB; bf16x8 pa0, pa1, pa2, pa3; const int NT = nkeys / KVBLK;
    __syncthreads();
    ATT_SLOAD(vsE, ksE, 0); asm volatile("s_waitcnt vmcnt(0)" ::: "memory"); ATT_SWRITE(0, vsE, ksE); __syncthreads();
    qkt<DQK>(pA0, pA1, K_lds, qr, negm, r32, hi); partialSM<true>(pA0, pA1, m_reg, alA, negm);
    ATT_SLOAD(vsO, ksO, KVBLK); if (2 < NT) ATT_SLOAD(vsE, ksE, 2 * KVBLK);
    ATT_SWAIT(); ATT_SWRITE(1, vsO, ksO); __syncthreads();
    for (int j = 1; j + 1 < NT; j += 2) {
        ATT_SBAR(); qkt<DQK>(pB0, pB1, K_lds + L::SHM_K, qr, negm, r32, hi);
        finishSM(pA0, pA1, alA, l_reg, pa0, pa1, pa2, pa3); ATT_SBAR();
        ATT_SLOAD(vsO, ksO, (j + 2) * KVBLK); ATT_SBAR();
        pv_all<DV>(o, vb0, pa0, pa1, pa2, pa3); partialSM<false>(pB0, pB1, m_reg, alB, negm);
        __syncthreads(); ATT_SWAIT(); ATT_SWRITE(0, vsE, ksE);
        ATT_RESC(alB); __syncthreads();
        ATT_SBAR(); qkt<DQK>(pA0, pA1, K_lds, qr, negm, r32, hi);
        finishSM(pB0, pB1, alB, l_reg, pa0, pa1, pa2, pa3); ATT_SBAR();
        if (j + 3 < NT) ATT_SLOAD(vsE, ksE, (j + 3) * KVBLK); ATT_SBAR();
        pv_all<DV>(o, vb0 + L::SHM_V, pa0, pa1, pa2, pa3); partialSM<false>(pA0, pA1, m_reg, alA, negm);
        __syncthreads(); ATT_SWAIT(); ATT_SWRITE(1, vsO, ksO);
        ATT_RESC(alA); __syncthreads();
    }
    ATT_SBAR(); qkt<DQK>(pB0, pB1, K_lds + L::SHM_K, qr, negm, r32, hi);
    finishSM(pA0, pA1, alA, l_reg, pa0, pa1, pa2, pa3); ATT_SBAR();
    pv_all<DV>(o, vb0, pa0, pa1, pa2, pa3); partialSM<false>(pB0, pB1, m_reg, alB, negm);
    __syncthreads(); ATT_RESC(alB);
    finishSM(pB0, pB1, alB, l_reg, pa0, pa1, pa2, pa3); ATT_SBAR();
    pv_all<DV>(o, vb0 + L::SHM_V, pa0, pa1, pa2, pa3);
    if (hi == 0) li_l[r32] = l_reg; asm volatile("s_waitcnt lgkmcnt(0)" ::: "memory");
#pragma unroll
    for (int r = 0; r < 16; ++r) rli[r] = __builtin_amdgcn_rcpf(li_l[crow(r, hi)]);
#undef ATT_SLOAD
#undef ATT_SWRITE
#undef ATT_SWAIT
#undef ATT_RESC
}
template <int DV, int LDO> __device__ __forceinline__ void store_o(bf16_t* Ob, const f32x16 (&o)[DV / 32], const float (&rli)[16], int wv) {
    int tid_ = wv * 64 + lane_id(); asm volatile("" : "+v"(tid_));
    const int tid = tid_, wid = tid >> 6, lane = tid & 63, r32 = lane & 31, hi = lane >> 5;
    bf16_t* Ow = Ob + (size_t)(wid * QBLK) * LDO;
#pragma unroll
    for (int r = 0; r < 16; ++r) { const int orow = crow(r, hi);
#pragma unroll
        for (int d0 = 0; d0 < DV / 32; ++d0) Ow[(size_t)orow * LDO + d0 * 32 + r32] = f2bf(o[d0][r] * rli[r]); }
}
__device__ __forceinline__ void unit_a(const bf16_t* PROJ, bf16_t* OBR, int b, int h, int qb, const LAS float* lamp, const float* subg, char* lds, int wv) {
    using L = Lay<64, 128>;
    int tid_ = wv * 64 + lane_id(); asm volatile("" : "+v"(tid_));
    const int tid = tid_, wid = tid >> 6, lane = tid & 63, r32 = lane & 31, hi = lane >> 5;
    const bf16_t* kv = PROJ + (size_t)b * SEQ * D_IN; const size_t qrow = (size_t)b * SEQ + qb * 256;
    unsigned* stash = (unsigned*)(lds + L::OFF_STASH) + wid * 2048 + lane;
    f32x16 o[4]; float rli[16];
#pragma unroll 1
    for (int c = 0; c < 2; ++c) {
        attn_pass<64, 128, D_IN, D_IN, D_IN>(PROJ + qrow * D_IN + C_AQ + h * 128 + c * 64, kv + C_AK + h * 128 + c * 64, kv + C_AV + h * 128, SEQ, lds, o, rli, wv);
        if (c == 0) {
#pragma unroll
            for (int d0 = 0; d0 < 4; ++d0)
#pragma unroll
                for (int r = 0; r < 16; r += 2) stash[(d0 * 8 + (r >> 1)) * 64] = cvt_pk_bf16(o[d0][r] * rli[r], o[d0][r + 1] * rli[r + 1]);
        }
    }
    const float lam = lamp[0], lam_init = lamp[1];
    asm volatile("s_waitcnt lgkmcnt(0)" ::: "memory");
    float ss[16];
#pragma unroll
    for (int r = 0; r < 16; ++r) ss[r] = 0.f;
#pragma unroll
    for (int d0 = 0; d0 < 4; ++d0)
#pragma unroll
        for (int r = 0; r < 16; r += 2) { const unsigned w = stash[(d0 * 8 + (r >> 1)) * 64];
            const float c0 = __uint_as_float(w << 16) - lam * o[d0][r] * rli[r], c1 = __uint_as_float(w & 0xffff0000u) - lam * o[d0][r + 1] * rli[r + 1];
            o[d0][r] = c0; o[d0][r + 1] = c1; ss[r] += c0 * c0; ss[r + 1] += c1 * c1; }
#pragma unroll
    for (int r = 0; r < 16; ++r) { float s = ss[r]; s += xlane<1>(s); s += xlane<2>(s); s += xlane<4>(s); s += xlane<8>(s); s += xlane<16>(s);
        ss[r] = rsqrtf(s * (1.f / 128.f) + EPS) * (1.f - lam_init); }
    bf16_t* Ow = OBR + (qrow + wid * QBLK) * OBR_W + h * 128;
#pragma unroll
    for (int d0 = 0; d0 < 4; ++d0) { const float g = subg[d0 * 32 + r32];
#pragma unroll
        for (int r = 0; r < 16; ++r) Ow[(size_t)crow(r, hi) * OBR_W + d0 * 32 + r32] = f2bf(o[d0][r] * ss[r] * g); }
}
__device__ __forceinline__ void unit_b(const bf16_t* PROJ, bf16_t* OBR, int b, int qh, int qb, char* lds, int wv);
__device__ __forceinline__ void unit_c(const bf16_t* PROJ, const bf16_t* MEMKV, bf16_t* OBR, int b, int h, int qb, char* lds, int wv) {
    const bf16_t* kv = MEMKV + (size_t)b * MEM_LEN * 1024; const size_t qrow = (size_t)b * SEQ + qb * 256;
    f32x16 o[4]; float rli[16];
    attn_pass<128, 128, D_IN, 1024, 1024>(PROJ + qrow * D_IN + C_CQ + h * 128, kv + h * 128, kv + 512 + h * 128, MEM_LEN, lds, o, rli, wv);
    store_o<128, OBR_W>(OBR + qrow * OBR_W + 1024 + h * 128, o, rli, wv);
}
#undef ATT_SBAR
}

#include <hip/hip_bf16.h>
namespace attd {
using bf16=__hip_bfloat16;
using bf16x8=__attribute__((ext_vector_type(8)))short;
using s16x4=__attribute__((ext_vector_type(4)))short;
using f32x16=__attribute__((ext_vector_type(16)))float;
using u32x4=__attribute__((ext_vector_type(4)))unsigned;
constexpr int D=64;
constexpr int NW=8,QBLK=32,QB=QBLK*NW,KVBLK=64;
__device__ __forceinline__ int crow(int r,int hi){return (r&3)+8*(r>>2)+4*hi;}
#define SBAR() __builtin_amdgcn_sched_barrier(0)
__device__ __forceinline__ void cmask(f32x16&p0,f32x16&p1,int jb,int qrel,int hi){
  const float NEG=-INFINITY; int kb=64*jb+4*hi;
  #pragma unroll
  for(int r=0;r<16;++r){int kv=kb+(r&3)+8*(r>>2); if(kv>qrel)p0[r]=NEG; if(kv+32>qrel)p1[r]=NEG;}
}

constexpr int NSLOT=3, SLOTB=8192;
constexpr int LDS_K=0, LDS_V=NSLOT*SLOTB, LDS_WS=2*NSLOT*SLOTB, LDS_OST=LDS_WS+NW*64*4, LDS_BYTES=LDS_OST+NW*4096;
constexpr float C2=0.125f*1.4426950408889634f;
__device__ __forceinline__ void glds16(const void*gsrc,unsigned lds_dst){unsigned keep;
  asm volatile("s_mov_b32 %0, m0\n\ts_mov_b32 m0, %2\n\ts_nop 0\n\tglobal_load_lds_dwordx4 %1, off\n\ts_mov_b32 m0, %0":"=&s"(keep):"v"(gsrc),"s"(lds_dst):"memory");}
__device__ __forceinline__ float max3f(float a,float b,float c){float r;asm("v_max3_f32 %0, %1, %2, %3":"=v"(r):"v"(a),"v"(b),"v"(c));return r;}
__device__ __forceinline__ float max2f(float a,float b){float r;asm("v_max_f32_e32 %0, %1, %2":"=v"(r):"v"(a),"v"(b));return r;}
__device__ __forceinline__ float fadd_s(float a,float b){float r;asm("v_add_f32_e32 %0, %1, %2":"=v"(r):"v"(a),"v"(b));return r;}
__device__ __forceinline__ float fsub_s(float a,float b){float r;asm("v_sub_f32_e32 %0, %1, %2":"=v"(r):"v"(a),"v"(b));return r;}
typedef float f32x2_t __attribute__((ext_vector_type(2))); typedef __bf16 bf16x2_t __attribute__((ext_vector_type(2)));
__device__ __forceinline__ unsigned cvtpk_s(float lo,float hi){f32x2_t v={lo,hi};bf16x2_t b=__builtin_convertvector(v,bf16x2_t);return __builtin_bit_cast(unsigned,b);}
#define WAIT_BAR(N) asm volatile("s_waitcnt vmcnt(" #N ") lgkmcnt(0)\n\ts_barrier":::"memory")

__device__ __forceinline__ void qkt(f32x16&p0,f32x16&p1,const char*Kslot,const bf16x8*qr,const f32x16&negm,int r32,int hi){
  const char*kb=Kslot+hi*1024+r32*16;
  #pragma unroll
  for(int d0=0;d0<4;++d0){
    const bf16x8 b0=*reinterpret_cast<const bf16x8*>(kb+d0*2048);
    const bf16x8 b1=*reinterpret_cast<const bf16x8*>(kb+d0*2048+512);
    if(d0==0){p0=__builtin_amdgcn_mfma_f32_32x32x16_bf16(b0,qr[0],negm,0,0,0);p1=__builtin_amdgcn_mfma_f32_32x32x16_bf16(b1,qr[0],negm,0,0,0);}
    else{p0=__builtin_amdgcn_mfma_f32_32x32x16_bf16(b0,qr[d0],p0,0,0,0);p1=__builtin_amdgcn_mfma_f32_32x32x16_bf16(b1,qr[d0],p1,0,0,0);}}
}
typedef __attribute__((address_space(3))) const char* lds_cptr;
typedef short v4i16_t __attribute__((ext_vector_type(4)));
__device__ __forceinline__ void kload8(bf16x8*kf,lds_cptr kp){
  kf[0]=*(const __attribute__((address_space(3))) bf16x8*)(kp);      kf[1]=*(const __attribute__((address_space(3))) bf16x8*)(kp+512);
  kf[2]=*(const __attribute__((address_space(3))) bf16x8*)(kp+2048); kf[3]=*(const __attribute__((address_space(3))) bf16x8*)(kp+2560);
  kf[4]=*(const __attribute__((address_space(3))) bf16x8*)(kp+4096); kf[5]=*(const __attribute__((address_space(3))) bf16x8*)(kp+4608);
  kf[6]=*(const __attribute__((address_space(3))) bf16x8*)(kp+6144); kf[7]=*(const __attribute__((address_space(3))) bf16x8*)(kp+6656);
}
__device__ __forceinline__ void kload2(bf16x8*kf,lds_cptr kp,int j){ kf[2*j]=*(const __attribute__((address_space(3))) bf16x8*)(kp+j*2048); kf[2*j+1]=*(const __attribute__((address_space(3))) bf16x8*)(kp+j*2048+512); }
__device__ __forceinline__ s16x4 vtr(lds_cptr p){ return __builtin_bit_cast(s16x4,__builtin_amdgcn_ds_read_tr16_b64_v4i16((__attribute__((address_space(3))) v4i16_t*)p)); }
__device__ __forceinline__ float rowmax(const f32x16&p0,const f32x16&p1){
  float a=max3f(p0[0],p0[1],p1[0]),b=max3f(p0[2],p0[3],p1[1]);a=max3f(a,p1[2],p1[3]);
  #pragma unroll
  for(int r=4;r<16;r+=4){a=max3f(a,p0[r],p0[r+1]);b=max3f(b,p0[r+2],p0[r+3]);a=max3f(a,p1[r],p1[r+1]);b=max3f(b,p1[r+2],p1[r+3]);}
  const float m=max2f(a,b);
  auto rr=__builtin_amdgcn_permlane32_swap(__float_as_uint(m),__float_as_uint(m),false,false);
  return max2f(__uint_as_float(rr[0]),__uint_as_float(rr[1]));
}
__device__ __forceinline__ void pv(f32x16*o,int vb,bf16x8 pa0,bf16x8 pa1,bf16x8 pa2,bf16x8 pa3){
  #pragma unroll
  for(int d0=0;d0<2;++d0){s16x4 lo[4],hi[4];
    #pragma unroll
    for(int ks=0;ks<4;++ks){
      asm volatile("ds_read_b64_tr_b16 %0,%1 offset:%c2":"=&v"(lo[ks]):"v"(vb),"i"(d0*4096+ks*1024):"memory");
      asm volatile("ds_read_b64_tr_b16 %0,%1 offset:%c2":"=&v"(hi[ks]):"v"(vb),"i"(d0*4096+ks*1024+512):"memory");}
    asm volatile("s_waitcnt lgkmcnt(0)":::"memory");SBAR();
    #define PK(k) (bf16x8){lo[k][0],lo[k][1],lo[k][2],lo[k][3],hi[k][0],hi[k][1],hi[k][2],hi[k][3]}
    o[d0]=__builtin_amdgcn_mfma_f32_32x32x16_bf16(pa0,PK(0),o[d0],0,0,0);
    o[d0]=__builtin_amdgcn_mfma_f32_32x32x16_bf16(pa1,PK(1),o[d0],0,0,0);
    o[d0]=__builtin_amdgcn_mfma_f32_32x32x16_bf16(pa2,PK(2),o[d0],0,0,0);
    o[d0]=__builtin_amdgcn_mfma_f32_32x32x16_bf16(pa3,PK(3),o[d0],0,0,0);
    #undef PK
  }
}

#ifndef ATTN_STORE16
#define ATTN_STORE16(p,v) (*(u32x4*)(p)=(v))
#endif
template<int THRL,int QP,int KP,int OP> __device__ __forceinline__ void attn_unit(const bf16*Qb,const bf16*__restrict__ Kh,const bf16*__restrict__ Vh,bf16*Ob,int nkeys,char*shm,int wv){
  int tid_=wv*64+lane_id(); asm volatile("":"+v"(tid_)); const int tid=tid_,lane=tid&63,r32=lane&31,hi=lane>>5; const int wid=wv;
  constexpr int DM=KP;
  const bf16*Qw=Qb+(long)(wid*QBLK)*QP;
  const unsigned lds0=(unsigned)(uintptr_t)shm;
  float*wsf=(float*)(shm+LDS_WS)+wid*64;
  const bf16*ksrc=Kh+(long)lane*DM+wid*8;
  const bf16*vsrc=Vh+(long)(16*(wid&3)+(lane>>2))*DM+(wid>>2)*32+(lane&3)*8;
  const unsigned kdst=lds0+LDS_K+wid*1024, vdst=lds0+LDS_V+wid*1024;
  #define DMA_K(t,slot) glds16(ksrc+(long)(t)*KVBLK*DM,(unsigned)__builtin_amdgcn_readfirstlane(kdst+(slot)))
  #define DMA_V(t,slot) glds16(vsrc+(long)(t)*KVBLK*DM,(unsigned)__builtin_amdgcn_readfirstlane(vdst+(slot)))
  const int vb0=(int)(lds0+LDS_V)+((lane>>4)&1)*32+(lane&3)*8+(4*hi+((lane&15)>>2))*64;
  const char*Kbase=shm+LDS_K; bf16x8 kf[8];
  const lds_cptr shm3=(lds_cptr)shm; const lds_cptr kp0=shm3+LDS_K+hi*1024+r32*16; const lds_cptr vp0=shm3+LDS_V+((lane>>4)&1)*32+(lane&3)*8+(4*hi+((lane&15)>>2))*64;
  const int NT=nkeys/KVBLK;
  DMA_K(0,0);DMA_V(0,0);DMA_K(1,SLOTB);
  bf16x8 qr[4];
  #pragma unroll
  for(int d0=0;d0<4;++d0)qr[d0]=*reinterpret_cast<const bf16x8*>(&Qw[(long)r32*QP+d0*16+hi*8]);
  float mhat=0.f,l_reg=0.f;f32x16 o[2],negm;
  #pragma unroll
  for(int r=0;r<16;++r){asm volatile("v_mov_b32 %0, 0":"=v"(o[0][r]));asm volatile("v_mov_b32 %0, 0":"=v"(o[1][r]));asm volatile("v_mov_b32 %0, 0":"=v"(negm[r]));}
  #define CMASK(P0,P1,t) do{}while(0)
  bool resc=false;
  #define START(P0,P1) do{ const float rm=rowmax(P0,P1); resc=false; \
    { const float dl=rm; mhat=fadd_s(mhat,dl); \
      _Pragma("unroll") for(int r=0;r<16;++r){P0[r]=fsub_s(P0[r],dl);P1[r]=fsub_s(P1[r],dl);} \
      _Pragma("unroll") for(int r=0;r<16;++r)negm[r]=-mhat; asm volatile("":"+v"(negm)); } \
    _Pragma("unroll") for(int r=0;r<16;++r)P0[r]=__builtin_amdgcn_exp2f(P0[r]); }while(0)
  #define RESC() do{ if(resc){ asm volatile("s_waitcnt lgkmcnt(0)":::"memory"); \
      _Pragma("unroll") for(int d_=0;d_<2;++d_) _Pragma("unroll") for(int r=0;r<16;++r)o[d_][r]*=wsf[crow(r,hi)]; } }while(0)
  f32x16 pA0,pA1,pB0,pB1;
  int sl_prev=0,sl_cur=0,sl_next=SLOTB;
  #define ROT() do{sl_prev=sl_cur;sl_cur=sl_next;sl_next=(sl_next==(NSLOT-1)*SLOTB)?0:sl_next+SLOTB;}while(0)
  DMA_K(2,2*SLOTB);
  WAIT_BAR(3);
  qkt(pA0,pA1,Kbase,qr,negm,r32,hi);asm volatile("s_nop 15\n\ts_nop 7":"+v"(pA0),"+v"(pA1));CMASK(pA0,pA1,0);
  START(pA0,pA1);
  _Pragma("unroll") for(int r=0;r<16;++r)pA1[r]=__builtin_amdgcn_exp2f(pA1[r]);
  WAIT_BAR(0);
  DMA_K(3,0);DMA_V(1,SLOTB);
  ROT();
  kload8(kf,kp0+sl_cur);
  WAIT_BAR(2);
  s16x4 vlo[8],vhi[8]; u32x4 pw0,pw1,pw2,pw3;
  #define PKW(P,B) cvtpk_s(P[B],P[B+1])
  #define PAF(k) __builtin_bit_cast(bf16x8,pw##k)
  #define VFR(i) (bf16x8){vlo[i][0],vlo[i][1],vlo[i][2],vlo[i][3],vhi[i][0],vhi[i][1],vhi[i][2],vhi[i][3]}
  #define PIN(x) asm volatile("":"+v"(x))
  #define MX3(a,b,c) __builtin_fmaxf(__builtin_fmaxf((a),(b)),(c))
  #define GAPA(MF,A0,A1,A2,A3,W0,W1,PW) do{ MF; sacc+=A0; sacc+=A1; sacc+=A2; sacc+=A3; PIN(sacc); W0; W1; PIN(PW); SBAR(); }while(0)
  #define EX(v) __builtin_amdgcn_exp2f(v)
  #define GAPB(MF,X,B) do{ MF; X[B]=EX(X[B]); X[B+1]=EX(X[B+1]); X[B+2]=EX(X[B+2]); X[B+3]=EX(X[B+3]); PIN(X); SBAR(); }while(0)
  #define VRD(i) do{ vlo[i]=vtr(vp_+(((i)>>2)*4096+((i)&3)*1024)); vhi[i]=vtr(vp_+(((i)>>2)*4096+((i)&3)*1024+512)); }while(0)
  #define KRD(G,j) do{ if(G){ kload2(kf,kp0+sl_next,j); SBAR(); } }while(0)
  #define STEP(C0,C1,P0,P1,t,GK,GV,GL) do{ SBAR(); \
    const lds_cptr vp_=vp0+sl_prev; \
    VRD(0); SBAR(); float sacc=(P0[0]+P0[1]); \
    GAPA(C0=__builtin_amdgcn_mfma_f32_32x32x16_bf16(kf[0],qr[0],negm,0,0,0), P0[2],P0[3],P0[4],P0[5],     pw0[0]=PKW(P0,0), pw0[1]=PKW(P0,2), pw0); \
    VRD(4); SBAR(); GAPA(C1=__builtin_amdgcn_mfma_f32_32x32x16_bf16(kf[1],qr[0],negm,0,0,0), P0[6],P0[7],P0[8],P0[9],     pw0[2]=PKW(P0,4), pw0[3]=PKW(P0,6), pw0); \
    VRD(1); SBAR(); GAPA(C0=__builtin_amdgcn_mfma_f32_32x32x16_bf16(kf[2],qr[1],C0,0,0,0),   P0[10],P0[11],P0[12],P0[13], pw1[0]=PKW(P0,8), pw1[1]=PKW(P0,10), pw1); \
    VRD(5); SBAR(); GAPA(C1=__builtin_amdgcn_mfma_f32_32x32x16_bf16(kf[3],qr[1],C1,0,0,0),   P0[14],P0[15],P1[0],P1[1],   pw1[2]=PKW(P0,12),pw1[3]=PKW(P0,14), pw1); \
    VRD(2); SBAR(); GAPA(C0=__builtin_amdgcn_mfma_f32_32x32x16_bf16(kf[4],qr[2],C0,0,0,0),   P1[2],P1[3],P1[4],P1[5],     pw2[0]=PKW(P1,0), pw2[1]=PKW(P1,2), pw2); \
    VRD(6); SBAR(); GAPA(C1=__builtin_amdgcn_mfma_f32_32x32x16_bf16(kf[5],qr[2],C1,0,0,0),   P1[6],P1[7],P1[8],P1[9],     pw2[2]=PKW(P1,4), pw2[3]=PKW(P1,6), pw2); \
    VRD(3); SBAR(); GAPA(C0=__builtin_amdgcn_mfma_f32_32x32x16_bf16(kf[6],qr[3],C0,0,0,0),   P1[10],P1[11],P1[12],P1[13], pw3[0]=PKW(P1,8), pw3[1]=PKW(P1,10), pw3); \
    VRD(7); SBAR(); GAPA(C1=__builtin_amdgcn_mfma_f32_32x32x16_bf16(kf[7],qr[3],C1,0,0,0),   P1[14],P1[15],0.f,0.f,       pw3[2]=PKW(P1,12),pw3[3]=PKW(P1,14), pw3); \
    l_reg+=sacc; \
    if(GK){DMA_K((t)+3,sl_cur);} if(GV){DMA_V((t)+1,sl_next);} \
    CMASK(C0,C1,t); \
    { float a=MX3(C0[0],C0[1],C1[0]),b=MX3(C0[2],C0[3],C1[1]); a=MX3(a,C1[2],C1[3]); \
      _Pragma("unroll") for(int r=4;r<16;r+=4){a=MX3(a,C0[r],C0[r+1]);b=MX3(b,C0[r+2],C0[r+3]);a=MX3(a,C1[r],C1[r+1]);b=MX3(b,C1[r+2],C1[r+3]);} \
      float rm=__builtin_fmaxf(a,b); { auto rr=__builtin_amdgcn_permlane32_swap(__float_as_uint(rm),__float_as_uint(rm),false,false); rm=__builtin_fmaxf(__uint_as_float(rr[0]),__uint_as_float(rr[1])); } \
      resc=false; \
      if(__builtin_expect(__any(rm>(float)THRL),0)){ const float dl=__builtin_fmaxf(rm,0.f); mhat+=dl; \
        _Pragma("unroll") for(int r=0;r<16;++r){C0[r]-=dl;C1[r]-=dl;} \
        _Pragma("unroll") for(int r=0;r<16;++r)negm[r]=-mhat; asm volatile("":"+v"(negm)); \
        const float f=__builtin_amdgcn_exp2f(-dl); l_reg*=f; if(hi==0)wsf[r32]=f; resc=true; } } \
    SBAR(); \
    GAPB(o[0]=__builtin_amdgcn_mfma_f32_32x32x16_bf16(PAF(0),VFR(0),o[0],0,0,0), C0,0); \
    GAPB(o[1]=__builtin_amdgcn_mfma_f32_32x32x16_bf16(PAF(0),VFR(4),o[1],0,0,0), C0,4); \
    KRD(GL,0); GAPB(o[0]=__builtin_amdgcn_mfma_f32_32x32x16_bf16(PAF(1),VFR(1),o[0],0,0,0), C0,8); \
    KRD(GL,1); GAPB(o[1]=__builtin_amdgcn_mfma_f32_32x32x16_bf16(PAF(1),VFR(5),o[1],0,0,0), C0,12); \
    KRD(GL,2); GAPB(o[0]=__builtin_amdgcn_mfma_f32_32x32x16_bf16(PAF(2),VFR(2),o[0],0,0,0), C1,0); \
    KRD(GL,3); GAPB(o[1]=__builtin_amdgcn_mfma_f32_32x32x16_bf16(PAF(2),VFR(6),o[1],0,0,0), C1,4); \
    GAPB(o[0]=__builtin_amdgcn_mfma_f32_32x32x16_bf16(PAF(3),VFR(3),o[0],0,0,0), C1,8); \
    GAPB(o[1]=__builtin_amdgcn_mfma_f32_32x32x16_bf16(PAF(3),VFR(7),o[1],0,0,0), C1,12); \
    }while(0)
  int t=1;
  #undef CMASK
  #define CMASK(P0,P1,t) do{}while(0)
  for(;t+5<NT;t+=2){
    STEP(pB0,pB1,pA0,pA1,t,true,true,true);     WAIT_BAR(2); RESC(); ROT();
    STEP(pA0,pA1,pB0,pB1,t+1,true,true,true);   WAIT_BAR(2); RESC(); ROT();
  }
  #undef CMASK
  #define CMASK(P0,P1,t) do{}while(0)
  #define ENDW(tt) do{ if((tt)+3<NT){WAIT_BAR(2);} else if((tt)+2<NT){WAIT_BAR(1);} else {WAIT_BAR(0);} }while(0)
  for(;t+1<NT;t+=2){
    STEP(pB0,pB1,pA0,pA1,t,(t+3<NT),(t+1<NT),(t+1<NT));       ENDW(t);   RESC(); ROT();
    STEP(pA0,pA1,pB0,pB1,t+1,(t+4<NT),(t+2<NT),(t+2<NT));     ENDW(t+1); RESC(); ROT();
  }
  STEP(pB0,pB1,pA0,pA1,NT-1,false,false,false); RESC();
  { float sacc=pB0[0]+pB0[1]; _Pragma("unroll") for(int r=2;r<16;++r)sacc+=pB0[r]; _Pragma("unroll") for(int r=0;r<16;++r)sacc+=pB1[r]; l_reg+=sacc;
    pw0=(u32x4){PKW(pB0,0),PKW(pB0,2),PKW(pB0,4),PKW(pB0,6)};pw1=(u32x4){PKW(pB0,8),PKW(pB0,10),PKW(pB0,12),PKW(pB0,14)};pw2=(u32x4){PKW(pB1,0),PKW(pB1,2),PKW(pB1,4),PKW(pB1,6)};pw3=(u32x4){PKW(pB1,8),PKW(pB1,10),PKW(pB1,12),PKW(pB1,14)};
    SBAR(); pv(o,vb0+sl_cur,PAF(0),PAF(1),PAF(2),PAF(3)); }
  #undef PKW
  #undef PAF
  #undef VFR
  #undef PIN
  #undef MX3
  #undef GAPA
  #undef GAPB
  #undef EX
  #undef VRD
  #undef KRD
  #undef STEP
  #undef ENDW
  {auto rr=__builtin_amdgcn_permlane32_swap(__float_as_uint(l_reg),__float_as_uint(l_reg),false,false);l_reg=__uint_as_float(rr[0])+__uint_as_float(rr[1]);}
  if(hi==0)wsf[32+r32]=l_reg;asm volatile("s_waitcnt lgkmcnt(0)":::"memory");
  float rli[16];
  #pragma unroll
  for(int r=0;r<16;++r)rli[r]=__builtin_amdgcn_rcpf(wsf[32+crow(r,hi)]);
  bf16*Ow=Ob+(long)(wid*QBLK)*OP;
  { bf16*stg=(bf16*)(shm+LDS_OST)+wid*2048;
    #pragma unroll
    for(int r=0;r<16;++r){const int orow=crow(r,hi);
      #pragma unroll
      for(int d0=0;d0<2;++d0)stg[orow*64+d0*32+r32]=__float2bfloat16(o[d0][r]*rli[r]);}
    asm volatile("s_waitcnt lgkmcnt(0)":::"memory");
    #pragma unroll
    for(int i=0;i<4;++i){const int row=i*8+(lane>>3),ch=lane&7; const u32x4 v=*(const u32x4*)(stg+row*64+ch*8); ATTN_STORE16(Ow+(long)row*OP+ch*8,v);} }
  asm volatile("s_waitcnt lgkmcnt(0)\n\ts_barrier":::"memory");
  #undef DMA_K
  #undef DMA_V
  #undef CMASK
  #undef START
  #undef RESC
  #undef ROT
}
constexpr int ATTN_LDS_BYTES=LDS_BYTES;
#undef SBAR
#undef WAIT_BAR
}
namespace att {
__device__ __forceinline__ void unit_b(const bf16_t* PROJ, bf16_t* OBR, int b, int qh, int qb, char* lds, int wv) {
    const bf16_t* kv = PROJ + (size_t)b * SEQ * D_IN; const size_t qrow = (size_t)b * SEQ + qb * 256;
    __syncthreads();
    attd::attn_unit<8, D_IN, D_IN, OBR_W>((const attd::bf16*)(PROJ + qrow * D_IN + C_BQ + qh * 64), (const attd::bf16*)(kv + C_BK + (qh >> 2) * 64), (const attd::bf16*)(kv + C_BV + (qh >> 2) * 64),
                                          (attd::bf16*)(OBR + qrow * OBR_W + 512 + qh * 64), SEQ, lds, wv);
}
}
template <int NR, bool NORM>
__device__ __forceinline__ void rows_in(const float* __restrict__ xbase, const float* __restrict__ g, bf16_t* __restrict__ obase, float* __restrict__ rstd_out, int row0, int lane, unsigned char* __restrict__ xq = nullptr) {
    f32x4 v[NR][4];
#pragma unroll
    for (int r = 0; r < NR; ++r)
#pragma unroll
        for (int j = 0; j < 4; ++j) v[r][j] = ((const f32x4*)(xbase + (size_t)(row0 + r) * DM))[lane + 64 * j];
    f32x4 gg[4];
#pragma unroll
    for (int j = 0; j < 4; ++j) gg[j] = NORM ? ((const f32x4*)g)[lane + 64 * j] : (f32x4){1.f, 1.f, 1.f, 1.f};
#pragma unroll
    for (int r = 0; r < NR; ++r) { float s = 0.f;
#pragma unroll
        for (int j = 0; j < 4; ++j) s += v[r][j].x * v[r][j].x + v[r][j].y * v[r][j].y + v[r][j].z * v[r][j].z + v[r][j].w * v[r][j].w;
        const float rs0 = rsqrtf(wave_sum(s) * (1.f / DM) + EPS), rs = NORM ? rs0 : 1.f;
        if (!NORM && lane == 0) rstd_out[row0 + r] = rs0;
#pragma unroll
        for (int j = 0; j < 4; ++j) { u32x2 o; o.x = cvt_pk_bf16(v[r][j].x * rs * gg[j].x, v[r][j].y * rs * gg[j].y); o.y = cvt_pk_bf16(v[r][j].z * rs * gg[j].z, v[r][j].w * rs * gg[j].w);
            ((u32x2*)(obase + (size_t)(row0 + r) * XP))[lane + 64 * j] = o;
            if (!NORM) ((unsigned*)(xq + (size_t)(row0 + r) * DM))[lane + 64 * j] = pack4_fp8(v[r][j]); } }
}
__device__ __forceinline__ void route_block(const bf16_t* __restrict__ X, const bf16_t* __restrict__ rt_tab, const float* __restrict__ brg, const float* __restrict__ bre, int* __restrict__ experts, float* __restrict__ weights,
                                            int* __restrict__ rank, unsigned* __restrict__ cnt, float* __restrict__ rstd, int* __restrict__ list, const float* __restrict__ g2, unsigned char* __restrict__ XQ, int rb, const bf16x8 (&Bh)[3][4], const bf16x8 (&Bl)[3][4], LAS float* slab, int tid, int wave) {
    const int lane = tid & 63, r = lane & 15, kq = lane >> 4;
    LAS float* ssq = slab + 8 * 64 * 48; LAS float* rs_l = ssq + 8 * 64;
#pragma unroll 1
    for (int rtp = 0; rtp < 2; ++rtp) {
        bf16x8 xa[2][4];
#pragma unroll
        for (int q = 0; q < 2; ++q) { const bf16_t* xp = X + (size_t)(rb * 64 + (rtp * 2 + q) * 16 + r) * XP + 128 * wave + 8 * kq;
#pragma unroll
            for (int sI = 0; sI < 4; ++sI) xa[q][sI] = *(const bf16x8*)(xp + 32 * sI); }
        f32x4 gq[4][2];
#pragma unroll
        for (int sI = 0; sI < 4; ++sI) { gq[sI][0] = *(const f32x4*)(g2 + 128 * wave + 32 * sI + 8 * kq); gq[sI][1] = *(const f32x4*)(g2 + 128 * wave + 32 * sI + 8 * kq + 4); }
#pragma unroll
        for (int q = 0; q < 2; ++q) { const int rt = rtp * 2 + q;
            f32x4 acc[3]; float ss = 0.f;
#pragma unroll
            for (int t = 0; t < 3; ++t) acc[t] = (f32x4){0.f, 0.f, 0.f, 0.f};
#pragma unroll
            for (int sI = 0; sI < 4; ++sI) {
                const bf16x8 Ah = xa[q][sI]; f32x4 a0, a1; pg8::unpack8(__builtin_bit_cast(u32x4, Ah), a0, a1);
                ss += (a0[0] * a0[0] + a0[1] * a0[1]) + (a0[2] * a0[2] + a0[3] * a0[3]) + (a1[0] * a1[0] + a1[1] * a1[1]) + (a1[2] * a1[2] + a1[3] * a1[3]);
                *(u32x2*)(XQ + (size_t)(rb * 64 + rt * 16 + r) * DM + 128 * wave + 32 * sI + 8 * kq) = pack8_fp8(a0 * gq[sI][0], a1 * gq[sI][1]);
#pragma unroll
                for (int t = 0; t < 3; ++t) {
                    acc[t] = __builtin_amdgcn_mfma_f32_16x16x32_bf16(Ah, Bh[t][sI], acc[t], 0, 0, 0);
                    acc[t] = __builtin_amdgcn_mfma_f32_16x16x32_bf16(Ah, Bl[t][sI], acc[t], 0, 0, 0);
                }
            }
            ss += xlane<16>(ss); ss = half_sum(ss);
            if (kq == 0) ssq[wave * 64 + rt * 16 + r] = ss;
#pragma unroll
            for (int t = 0; t < 3; ++t)
#pragma unroll
                for (int e = 0; e < 4; ++e) slab[(wave * 64 + rt * 16 + 4 * kq + e) * 48 + 16 * t + r] = acc[t][e];
        }
    }
    __syncthreads();
    if (tid < 64) {
        const int row = rb * 64 + tid;
        float lg[36]; float ss = 0.f;
#pragma unroll
        for (int c = 0; c < 36; ++c) lg[c] = 0.f;
#pragma unroll 1
        for (int w = 0; w < 8; ++w) { ss += ssq[w * 64 + tid];
#pragma unroll
            for (int c = 0; c < 36; ++c) lg[c] += slab[(w * 64 + tid) * 48 + c]; }
        const float rs = rsqrtf(ss * (1.f / DM) + EPS);
        rstd[row] = rs;
        int gi = 0; float gm = lg[0] * rs + brg[0];
#pragma unroll
        for (int i = 1; i < 4; ++i) { const float l = lg[i] * rs + brg[i]; if (l > gm) { gm = l; gi = i; } }
        float gs = 0.f;
#pragma unroll
        for (int i = 0; i < 4; ++i) gs += __expf(lg[i] * rs + brg[i] - gm);
        const float gp = 1.f / gs;
        float el[8];
#pragma unroll
        for (int i = 0; i < 8; ++i) el[i] = 0.f;
#pragma unroll
        for (int gq = 0; gq < 4; ++gq) if (gq == gi) {
#pragma unroll
            for (int i = 0; i < 8; ++i) el[i] = lg[4 + gq * 8 + i] * rs + bre[gq * 8 + i]; }
        int i0 = 0; float l0 = el[0];
#pragma unroll
        for (int i = 1; i < 8; ++i) if (el[i] > l0) { l0 = el[i]; i0 = i; }
        int i1 = -1; float l1 = -INFINITY;
#pragma unroll
        for (int i = 0; i < 8; ++i) if (i != i0 && el[i] > l1) { l1 = el[i]; i1 = i; }
        const float p1 = __expf(l1 - l0), inv = 1.f / (1.f + p1);
        const int e0 = gi * 8 + i0, e1 = gi * 8 + i1;
        experts[row * 2] = e0; experts[row * 2 + 1] = e1;
        weights[row * 2] = gp * inv; weights[row * 2 + 1] = gp * p1 * inv;
        LAS unsigned* lc = (LAS unsigned*)(rs_l + 64); LAS unsigned* gb = lc + 32;
        if (tid < 32) lc[tid] = 0u;
        asm volatile("s_waitcnt lgkmcnt(0)" ::: "memory");
        unsigned q0, q1; const unsigned one = 1u, a0_ = (unsigned)(uintptr_t)(lc + e0), a1_ = (unsigned)(uintptr_t)(lc + e1);
        asm volatile("ds_add_rtn_u32 %0, %1, %2\n\ts_waitcnt lgkmcnt(0)" : "=v"(q0) : "v"(a0_), "v"(one) : "memory");
        asm volatile("ds_add_rtn_u32 %0, %1, %2\n\ts_waitcnt lgkmcnt(0)" : "=v"(q1) : "v"(a1_), "v"(one) : "memory");
        if (tid < 32) { const unsigned n = lc[tid]; gb[tid] = n ? atomicAdd(cnt + 64 * tid, n) : 0u; }
        const int r0 = (int)(gb[e0] + q0), r1 = (int)(gb[e1] + q1);
        rank[row * 2] = r0; rank[row * 2 + 1] = r1;
        list[e0 * LCAP + r0] = row * 2; list[e1 * LCAP + r1] = row * 2 + 1;
        rs_l[tid] = rs;
    }
    __syncthreads();
}
__device__ __forceinline__ void moe_tables(const unsigned* cnt, volatile LAS int* mt, int tid) {
    if (tid < 64) {
        if (tid < 32) mt[32 + tid] = (int)__hip_atomic_load(cnt + 64 * tid, __ATOMIC_RELAXED, __HIP_MEMORY_SCOPE_AGENT);
        asm volatile("s_waitcnt vmcnt(0) lgkmcnt(0)" ::: "memory");
        if (tid == 0) { int off = 0, nt = 0;
#pragma unroll 1
            for (int e = 0; e < NEXP; ++e) { const int c = mt[32 + e], t = (c + MOE_TILE - 1) / MOE_TILE;
                mt[e] = off; mt[64 + e] = nt;
#pragma unroll 1
                for (int i = 0; i < t; ++i) mt[96 + nt + i] = e;
                nt += t; off += t * MOE_TILE; }
            mt[256] = nt; }
    }
    __syncthreads();
}
__device__ __forceinline__ void moe_rowtabs(volatile LAS int* mt, const int* __restrict__ list, const float* __restrict__ weights, const float* __restrict__ rstd, LAS unsigned* rowtab, LAS float* wtab, int bx, int G, int tid, int up) {
    const int ntiles = mt[256], rem = (ntiles * 4) % G;
#pragma unroll 1
    for (int i = 0; i < 4; ++i) { const long L = up ? (long)i * G + bx : (long)pg8::moe_down_unit(bx, i, rem, G); if (L >= (long)ntiles * 4) break;
        if (tid < 256) { const int tile = (int)(L >> 2), e = mt[96 + tile], q = (tile - mt[64 + e]) * 256 + tid; const bool valid = q < mt[32 + e];
            const int a = valid ? list[e * LCAP + q] : 0;
            if (up) { rowtab[i * 256 + tid] = (unsigned)(a >> 1) * (unsigned)DM; wtab[i * 256 + tid] = valid ? rstd[a >> 1] : 0.f; }
            else wtab[i * 256 + tid] = valid ? weights[a] : -1.f; } }
    __syncthreads();
}
template <int NR>
__device__ __forceinline__ void rows_combine_norm(bf16_t* __restrict__ XB, const unsigned char* __restrict__ YB, const float* __restrict__ g, float* __restrict__ RS, float* __restrict__ OUT, const int (&row)[NR], int lane, bool poison, const int (&d0)[NR], const int (&d1)[NR], unsigned char* __restrict__ XQ) {
    u32x2 xq[NR][4]; unsigned ya[NR][4], yb[NR][4];
#pragma unroll
    for (int r = 0; r < NR; ++r)
#pragma unroll
        for (int j = 0; j < 4; ++j) { xq[r][j] = ((const u32x2*)(XB + (size_t)row[r] * XP))[lane + 64 * j];
            ya[r][j] = ((const unsigned*)(YB + (size_t)d0[r] * DM))[lane + 64 * j]; yb[r][j] = ((const unsigned*)(YB + (size_t)d1[r] * DM))[lane + 64 * j]; }
    f32x4 gg[4];
#pragma unroll
    for (int j = 0; j < 4; ++j) gg[j] = ((const f32x4*)g)[lane + 64 * j];
    f32x4 v[NR][4]; float s[NR];
#pragma unroll
    for (int r = 0; r < NR; ++r) { s[r] = 0.f;
#pragma unroll
        for (int j = 0; j < 4; ++j) { const u32x2 x = xq[r][j]; constexpr float ys = 1.f / 64.f;
            const f32x2 a0 = __builtin_amdgcn_cvt_pk_f32_fp8((int)ya[r][j], false), a1 = __builtin_amdgcn_cvt_pk_f32_fp8((int)ya[r][j], true), b0 = __builtin_amdgcn_cvt_pk_f32_fp8((int)yb[r][j], false), b1 = __builtin_amdgcn_cvt_pk_f32_fp8((int)yb[r][j], true);
            v[r][j].x = __uint_as_float(x.x << 16) + (a0[0] + b0[0]) * ys; v[r][j].y = __uint_as_float(x.x & 0xffff0000u) + (a0[1] + b0[1]) * ys;
            v[r][j].z = __uint_as_float(x.y << 16) + (a1[0] + b1[0]) * ys; v[r][j].w = __uint_as_float(x.y & 0xffff0000u) + (a1[1] + b1[1]) * ys;
            s[r] += v[r][j].x * v[r][j].x + v[r][j].y * v[r][j].y + v[r][j].z * v[r][j].z + v[r][j].w * v[r][j].w; } }
#pragma unroll
    for (int r = 0; r < NR; ++r) {
        float rs = rsqrtf(wave_sum(s[r]) * (1.f / DM) + EPS);
        if (poison) rs = __builtin_nanf("");
        if (RS && lane == 0) RS[row[r]] = rs;
#pragma unroll
        for (int j = 0; j < 4; ++j) {
            if (RS) { u32x2 xo; xo.x = cvt_pk_bf16(v[r][j].x, v[r][j].y); xo.y = cvt_pk_bf16(v[r][j].z, v[r][j].w); ((u32x2*)(XB + (size_t)row[r] * XP))[lane + 64 * j] = xo; ((unsigned*)(XQ + (size_t)row[r] * DM))[lane + 64 * j] = pack4_fp8(v[r][j]); }
            else { f32x4 o; o.x = v[r][j].x * rs * gg[j].x; o.y = v[r][j].y * rs * gg[j].y; o.z = v[r][j].z * rs * gg[j].z; o.w = v[r][j].w * rs * gg[j].w; ((f32x4*)(OUT + (size_t)row[r] * DM))[lane + 64 * j] = o; }
        }
    }
}
constexpr float W8_SCALE = 64.f;
struct TrItem { const float* src; bf16_t* dst; int ldw, K; };
template <int OFF> __device__ __forceinline__ unsigned long long karg64() { unsigned long long v; asm volatile("s_load_dwordx2 %0, %1, %2\n\ts_waitcnt lgkmcnt(0)" : "=s"(v) : "s"(__builtin_amdgcn_kernarg_segment_ptr()), "n"(OFF)); return v; }
__device__ __forceinline__ unsigned long long karg64d(int off) { unsigned long long v; asm volatile("s_load_dwordx2 %0, %1, %2\n\ts_waitcnt lgkmcnt(0)" : "=s"(v) : "s"(__builtin_amdgcn_kernarg_segment_ptr()), "s"(off)); return v; }
#define TR_IN(k) ((const float*)(const GAS float*)karg64d(8 * (k)))
__device__ __forceinline__ void tr_decode(int it, int lane, bf16_t* WB, const float*& sp, int& ldw, bf16_t*& dp, int& K, int& gofs) {
    const float* src; int segA, segB, kb, tb, dk0 = 0, gate = 0, gu = 0, f8 = 0; bf16_t* dst;
    if (it < 28800) {
        const int l = it / 14400; int r = it % 14400; bf16_t* WBl = WB + (size_t)l * WB_LAYER;
        if (r < 1472) { gu = 1; kb = r / 92; tb = r % 92; const int pn = tb >> 2, bj = (tb >> 1) & 1, w0 = 2 * (tb & 1); src = TR_IN(5) + (size_t)l * DM * D_IN; ldw = D_IN; K = DM; segA = 256 * pn + 64 * w0 + 32 * bj; segB = segA + 64; dst = WBl + WB_IN;
            if (pn >= C_G / 256) { gate = 1; f8 = 1; dst += (size_t)C_G * 512; segA = 256 * pn + 64 * w0 + 8 * bj; segB = segA + 64; } }
        else if (r < 1856) { r -= 1472; const int i = r >> 7; r &= 127; kb = r >> 4; tb = r & 15; src = TR_IN(13 + i) + (size_t)l * 512 * DM; ldw = DM; K = 1536; dk0 = 512 * i; segA = 64 * tb; segB = segA + 32; dst = WBl + WB_UP; }
        else if (r < 2112) { r -= 1856; kb = r >> 4; tb = r & 15; src = TR_IN(16) + (size_t)l * DM * DM; ldw = DM; K = DM; segA = 64 * tb; segB = segA + 32; dst = WBl + WB_OUT; }
        else if (r < 10304) { r -= 2112; const int e = r >> 8; r &= 255; kb = r >> 4; tb = r & 15; const int pn = tb >> 2, sg = (tb >> 1) & 1, jb = tb & 1;
            src = TR_IN(sg ? 23 : 22) + (size_t)(l * NEXP + e) * DM * DEXP; ldw = DEXP; K = DM; f8 = 1; segA = 128 * pn + 64 * jb; segB = segA + 32; dst = WBl + WB_GU + (size_t)e * 512 * 1024; }
        else { r -= 10304; const int e = r >> 7; r &= 127; kb = r >> 4; tb = r & 15; src = TR_IN(24) + (size_t)(l * NEXP + e) * DEXP * DM; ldw = DM; K = DEXP; f8 = 1; gate = 1; { const int pn = tb >> 2, bj = (tb >> 1) & 1, w0 = 2 * (tb & 1); segA = 256 * pn + 64 * w0 + 8 * bj; segB = segA + 64; } dst = WBl + WB_DN + (size_t)e * 512 * 512; }
    } else { const int r = it - 28800; kb = r >> 4; tb = r & 15; const int pn = tb >> 2, bj = (tb >> 1) & 1, w0 = 2 * (tb & 1); src = TR_IN(3); ldw = 1024; K = DM; segA = 256 * pn + 64 * w0 + 32 * bj; segB = segA + 64; dst = WB + WB_MEMKV; }
    const int q = lane & 15;
    const int q7 = q & 7, seg = q < 8 ? segA : segB;
    sp = src + (size_t)(kb * 64 + (lane >> 4)) * ldw + seg + (gate ? 16 * (q7 >> 1) + 4 * (q7 & 1) : 4 * q7);
    dp = dst + (((size_t)(64 * tb + (lane >> 3)) * K + dk0 + kb * 64 + 8 * (lane & 7)) >> f8);
    K |= f8 << 18;
    gofs = gu ? kb * 64 + (lane >> 4) : -1;
}
__device__ __forceinline__ void tr_load(f32x4 (&v)[16], const float* sp, int ldw) {
#pragma unroll
    for (int i = 0; i < 16; ++i) v[i] = *(const f32x4*)(sp + (size_t)(4 * i) * ldw);
}
__device__ __forceinline__ void tr_store(const f32x4 (&v)[16], bf16_t* dp, int K, LAS float* scr, int lane, int gofs, const LAS float* gt) {
    const int q = lane & 15, kq = lane >> 4; const int f8 = K >> 18; K &= 0x3FFFF;
#pragma unroll
    for (int i = 0; i < 16; ++i) *(LAS f32x4*)(scr + (4 * i + kq) * 64 + ((q ^ (2 * (i >> 1))) << 2)) = v[i];
    const int c = lane & 7, n8 = lane >> 3;
    f32x4 g0 = {1.f, 1.f, 1.f, 1.f}, g1 = g0;
    if (gofs >= 0) { const LAS float* gp = gt + (gofs - kq) + 8 * c; g0 = *(const LAS f32x4*)gp; g1 = *(const LAS f32x4*)(gp + 4); }
    if (f8) { g0 = g0 * W8_SCALE; g1 = g1 * W8_SCALE; }
    asm volatile("s_waitcnt lgkmcnt(0)" ::: "memory");
    const LAS float* sB = scr + (8 * c) * 64;
    if (f8) {
#pragma unroll
        for (int j = 0; j < 8; ++j) { const LAS float* sI = sB + ((n8 + 8 * j) ^ (8 * c));
            const f32x4 v0 = {sI[0 * 64] * g0[0], sI[1 * 64] * g0[1], sI[2 * 64] * g0[2], sI[3 * 64] * g0[3]}, v1 = {sI[4 * 64] * g1[0], sI[5 * 64] * g1[1], sI[6 * 64] * g1[2], sI[7 * 64] * g1[3]};
            *(u32x2*)((unsigned char*)dp + (size_t)(8 * j) * K) = pack8_fp8(v0, v1); }
    } else
#pragma unroll
    for (int j = 0; j < 8; ++j) { const LAS float* sI = sB + ((n8 + 8 * j) ^ (8 * c));
        u32x4 o; o.x = cvt_pk_bf16(sI[0 * 64] * g0[0], sI[1 * 64] * g0[1]); o.y = cvt_pk_bf16(sI[2 * 64] * g0[2], sI[3 * 64] * g0[3]); o.z = cvt_pk_bf16(sI[4 * 64] * g1[0], sI[5 * 64] * g1[1]); o.w = cvt_pk_bf16(sI[6 * 64] * g1[2], sI[7 * 64] * g1[3]);
        *(u32x4*)(dp + (size_t)(8 * j) * K) = o; }
    asm volatile("s_waitcnt lgkmcnt(0)" ::: "memory");
}

__device__ __forceinline__ int tr_item(int mode, int q) {
    return mode == 1 ? (q < 1472 ? q : q - 1472 + 28800) : mode == 4 ? q + 14400 : mode == 2 ? q + 1472 : q + 16512; }
__device__ __forceinline__ void tr_run(int mode, int q0, int qend, int qstride, bf16_t* WB, LAS float* scr, int lane, const float* gains, LAS float* gt) {
    __syncthreads();
    if (gains) {
#pragma unroll
        for (int j = 0; j < 16; ++j) gt[lane + 64 * j] = gains[lane + 64 * j];
        asm volatile("s_waitcnt lgkmcnt(0)" ::: "memory"); }
    f32x4 ra[16], rb[16], rc[16]; const float* sp; int ldw; unsigned da, ma, db, mb, dc, mc;
    if (q0 >= qend) return;
    const int qlast = q0 + ((qend - 1 - q0) / qstride) * qstride;
#define TR_LD(R, DD, MM, QQ) do { const int qn_ = (QQ) <= qlast ? (QQ) : qlast; bf16_t* dp_; int K_, g_; tr_decode(tr_item(mode, qn_), lane, WB, sp, ldw, dp_, K_, g_); \
        DD = (unsigned)(dp_ - WB); MM = ((unsigned)K_ << 12) | (unsigned)(g_ + 1); tr_load(R, sp, ldw); } while (0)
#define TR_ST(R, DD, MM) tr_store(R, WB + DD, (int)(MM >> 12), scr, lane, (int)(MM & 4095u) - 1, gt)
    int q = q0;
    TR_LD(ra, da, ma, q); TR_LD(rb, db, mb, q + qstride);
    for (;;) {
        TR_LD(rc, dc, mc, q + 2 * qstride); TR_ST(ra, da, ma); q += qstride; if (q > qlast) break;
        TR_LD(ra, da, ma, q + 2 * qstride); TR_ST(rb, db, mb); q += qstride; if (q > qlast) break;
        TR_LD(rb, db, mb, q + 2 * qstride); TR_ST(rc, dc, mc); q += qstride; if (q > qlast) break;
    }
#undef TR_ST
#undef TR_LD
}
#define XB_TMO      128
#define XB_XCNT(j)  (256  + 64 * (j))
#define XB_XSUB(j)  (1280 + 64 * (j))
#define XB_XGEN(j)  (2304 + 64 * (j))
#define XB_TOP      3328
#define XB_TOPGEN   3392
#define XCD_BAR_WORDS 3456
#define XB_SPIN_CAP (1u << 18)

__device__ __forceinline__ unsigned xb_ld(unsigned* p)              { return __hip_atomic_load(p, __ATOMIC_RELAXED, __HIP_MEMORY_SCOPE_AGENT); }
__device__ __forceinline__ unsigned xb_add(unsigned* p, unsigned v) { return __hip_atomic_fetch_add(p, v, __ATOMIC_RELAXED, __HIP_MEMORY_SCOPE_AGENT); }
__device__ __forceinline__ unsigned xb_xcc_id() { return (unsigned)__builtin_amdgcn_s_getreg((3 << 11) | 20) & 0xFu; }
#define XB_SPIN(cond, bar) do { unsigned _sp = 0; while (cond) { __builtin_amdgcn_s_sleep(1); \
    if ((++_sp & 255u) == 0u) { if (xb_ld(&(bar)[XB_TMO])) break; if (_sp > XB_SPIN_CAP) { atomicAdd(&(bar)[XB_TMO], 1u); break; } } } } while (0)

struct XcdBarrier {
    unsigned* bar; unsigned x; unsigned w0;
    volatile LAS unsigned* st;
};

__device__ __forceinline__ XcdBarrier xcd_barrier_post(unsigned* bar, volatile LAS unsigned* st, unsigned is_wave0) {
    XcdBarrier b; b.bar = bar; b.x = xb_xcc_id(); b.st = st; b.w0 = is_wave0;
    if (is_wave0 && lane_id() == 0) (void)xb_add(&bar[XB_XCNT(b.x)], 1u);
    return b;
}
__device__ __forceinline__ void xcd_barrier_complete(unsigned* bar, unsigned x, unsigned& nloc, unsigned& nx) {
    const unsigned G = gridDim.x * gridDim.y * gridDim.z;
    unsigned sum, cnt, mine, sp = 0u;
    for (;;) {
        sum = 0u; cnt = 0u; mine = 0u;
#pragma unroll
        for (unsigned j = 0; j < 16; ++j) { const unsigned c = xb_ld(&bar[XB_XCNT(j)]); sum += c; cnt += (c > 0u) ? 1u : 0u; mine = (j == x) ? c : mine; }
        if (sum == G) break;
        __builtin_amdgcn_s_sleep(1);
        if ((++sp & 255u) == 0u) { if (xb_ld(&bar[XB_TMO])) break; if (sp > XB_SPIN_CAP) { atomicAdd(&bar[XB_TMO], 1u); break; } }
    }
    nloc = mine > 0u ? mine : 1u; nx = cnt > 0u ? cnt : 1u;
}

__device__ __forceinline__ void xcd_barrier(const XcdBarrier& b) {
    asm volatile("s_waitcnt vmcnt(0)" ::: "memory");
    __syncthreads();
    if (b.w0 && lane_id() == 0) {
        unsigned* bar = b.bar;
        __builtin_amdgcn_s_waitcnt(0);
        unsigned nloc = b.st[0], nx = b.st[1];
        if (nloc == 0u) { xcd_barrier_complete(bar, b.x, nloc, nx); b.st[0] = nloc; b.st[1] = nx; }
        const unsigned old = xb_add(&bar[XB_XSUB(b.x)], 1u);
        const unsigned gen = old / nloc;
        if (old + 1u == (gen + 1u) * nloc) {
            __builtin_amdgcn_fence(__ATOMIC_RELEASE, "agent");
            asm volatile("s_waitcnt vmcnt(0)" ::: "memory");
            const unsigned og = xb_add(&bar[XB_TOP], 1u);
            const unsigned tg = og / nx;
            if (og + 1u == (tg + 1u) * nx) xb_add(&bar[XB_TOPGEN], 1u);
            else XB_SPIN(xb_ld(&bar[XB_TOPGEN]) == tg, bar);
            __builtin_amdgcn_fence(__ATOMIC_ACQUIRE, "agent");
            xb_add(&bar[XB_XGEN(b.x)], 1u);
            asm volatile("s_waitcnt vmcnt(0)" ::: "memory");
        } else {
            XB_SPIN(xb_ld(&bar[XB_XGEN(b.x)]) == gen, bar);
            __builtin_amdgcn_fence(__ATOMIC_ACQUIRE, "agent");
            asm volatile("s_waitcnt vmcnt(0)" ::: "memory");
        }
    }
    __syncthreads();
}
constexpr int NWAVES = 8;
constexpr int RING_BYTES = 131072, GT_OFF = 133120  , LDSCTL_OFF = 137216, LDS_BYTES = 147456;
constexpr int CW_BAR = 4096, BAR_REGION = 4096;
static_assert(XCD_BAR_WORDS <= BAR_REGION && (CW_BAR + (N_PHASES + 1) * BAR_REGION) * 4 <= (int)MiB, "barrier regions inside the memset region");
static_assert(pg8::STAGE_BYTES <= RING_BYTES && att::Lay<64, 128>::OFF_STASH + 65536 <= RING_BYTES && att::Lay<128, 128>::OFF_WS + 2048 <= RING_BYTES && LDSCTL_OFF + 10240 <= LDS_BYTES, "LDS map");

struct Args { const float* in[26]; float* out; unsigned char* ws; int ph_lo, ph_hi, li, pad; };
#define KIN(k) ((const float*)(const GAS float*)karg64<8 * (k)>())
#define KOUT ((float*)(GAS float*)karg64<208>())
#define KWS ((unsigned char*)(GAS unsigned char*)karg64<216>())
static_assert(offsetof(Args, out) == 208 && offsetof(Args, ws) == 216 && offsetof(Args, ph_lo) == 224, "Args layout vs the kernarg offsets above");

__global__ void __launch_bounds__(NWAVES * 64, 2) mk_fwd(Args args) {
    extern __shared__ __attribute__((aligned(16))) unsigned char lds[];
    asm volatile("s_setreg_imm32_b32 hwreg(HW_REG_MODE, 23, 1), 1");
    const int wave = __builtin_amdgcn_readfirstlane((int)threadIdx.x >> 6);
#define lane0 lane_id()
#define tid0 (wave * 64 + lane_id())
    const int G = gridDim.x, bx = blockIdx.x, vcu = (G % 8 == 0) ? (bx % 8) * (G / 8) + bx / 8 : bx;
    constexpr int NCX = 4, NCV = 8 * NCX, NWK = 256 - NCV;
    const bool split = (G == 256); const int idx8 = bx >> 3, xcd8 = bx & 7;
    const bool conv = split && (idx8 >= 32 - NCX);
    const int wk = (idx8 << 3) | xcd8, cvw = ((((idx8 - (32 - NCX)) << 3) | xcd8) * NWAVES) + wave;
    LAS unsigned char* ldsl = (LAS unsigned char*)lds;
    volatile LAS unsigned* MISC = (volatile LAS unsigned*)(ldsl + LDSCTL_OFF);
    for (int u = tid0; u < (LDS_BYTES - LDSCTL_OFF) / 4; u += NWAVES * 64) ((LAS unsigned*)(ldsl + LDSCTL_OFF))[u] = 0u;
    __syncthreads();
    XcdBarrier bar = xcd_barrier_post((unsigned*)(KWS + WS_CTL) + CW_BAR + args.li * BAR_REGION, MISC + 8, wave == 0 ? 1u : 0u);
#define P_WS unsigned char* ws = KWS; unsigned* ctl = (unsigned*)(ws + WS_CTL); (void)ctl
#define P_ACT bf16_t* MEMKV = (bf16_t*)(ws + WS_MEMKV); bf16_t* HM = (bf16_t*)(ws + WS_HM); bf16_t* PROJ = (bf16_t*)(ws + WS_PROJ); bf16_t* OBR = (bf16_t*)(ws + WS_OBR); bf16_t* HMEM = OBR; \
    bf16_t* BUF = (bf16_t*)(ws + WS_BUF); bf16_t* YB = (bf16_t*)(ws + WS_YB); bf16_t* HID = (bf16_t*)(ws + WS_HID); bf16_t* WB = (bf16_t*)(ws + WS_WB); const bf16_t* WBl = WB + (size_t)l_ * WB_LAYER; \
    (void)MEMKV; (void)HM; (void)PROJ; (void)OBR; (void)HMEM; (void)BUF; (void)YB; (void)HID; (void)WBl
#define P_ROUTE int* experts = (int*)(ws + WS_ROUTE + RT_EXP); float* weights = (float*)(ws + WS_ROUTE + RT_WGT); int* rank = (int*)(ws + WS_ROUTE + RT_RANK); float* rstd = (float*)(ws + WS_ROUTE + RT_RSTD); \
    (void)experts; (void)weights; (void)rank; (void)rstd
    const int gw = bx * NWAVES + wave, NGW = G * NWAVES;
    const int lo = args.ph_lo, hi = args.ph_hi;
#ifndef STAGE_MASK
#define STAGE_MASK 0x3FFu
#endif
#define IN(k) (lo <= (k) && (k) < hi)
#define ST(s) ((STAGE_MASK >> (s)) & 1u)
#ifndef REP_MASK
#define REP_MASK 0u
#endif
#define NREP(s) (((REP_MASK >> (s)) & 1u) ? 2 : 1)
#ifndef REP_A
#define REP_A 1
#endif
#ifndef REP_B
#define REP_B 1
#endif
#ifndef DBL_BAR
#define DBL_BAR 0
#endif
#define SEAM(k) do { if (IN(k) && IN((k) + 1)) { xcd_barrier(bar); if (DBL_BAR) xcd_barrier(bar); } } while (0)

    if (ST(0) && IN(0))
  for (int rep_ = 0; rep_ < NREP(0); ++rep_) {
        int lane = lane0, tid = tid0; asm volatile("" : "+v"(lane), "+v"(tid));
        constexpr int l_ = 0; P_WS; P_ACT;
        float* tab1 = (float*)(ws + WS_TAB); float* tab2 = tab1 + SEQ * 32 * 2;
        const float* x = KIN(0); const float* mem = KIN(1); const float* mem_g = KIN(2); const float* norm1_g = KIN(4); const float* norm2_g = KIN(17); const float* w_rg = KIN(18); const float* w_re = KIN(20);
        LAS float* scr = (LAS float*)(ldsl + wave * 16640);
#pragma unroll 1
        for (int ci = 0; ci < (split ? 2 : 4); ++ci) {
            const int md = ci == 0 ? 1 : ci == 1 ? 4 : ci;
            tr_run(md, gw, md == 1 ? 1728 : md == 4 ? 2112 : md == 2 ? 12928 : 12288, NGW, WB, scr, lane, md == 1 ? norm1_g : md == 4 ? norm1_g + DM : nullptr, (LAS float*)(ldsl + GT_OFF)); }
        tid = tid0; lane = lane0; asm volatile("" : "+v"(lane), "+v"(tid));
        for (int idx = bx * (NWAVES * 64) + tid; idx < DEPTH * 48 * 1024; idx += G * NWAVES * 64) { const int l = idx / (48 * 1024), c = (idx >> 10) % 48, k = idx & 1023;
            const float w = c < 4 ? w_rg[((size_t)l * DM + k) * 4 + c] : c < 36 ? w_re[((size_t)l * DM + k) * 32 + (c - 4)] : 0.f, v = w * norm2_g[l * DM + k];
            const bf16_t h = f2bf(v); bf16_t* t = WB + WB_RT + (size_t)l * 2 * 48 * 1024 + (size_t)c * 1024 + k; t[0] = h; t[48 * 1024] = f2bf(v - bf2f(h)); }
        for (int m = 4 * gw; m < M; m += 4 * NGW) rows_in<4, false>(x, nullptr, (bf16_t*)KOUT, (float*)(ws + WS_ROUTE + RT_RSTD1), m, lane, (unsigned char*)HM);
        for (int m = gw; m < MM; m += NGW) rows_in<1, true>(mem, mem_g, HMEM, nullptr, m, lane);
    }
    SEAM(0);
#pragma unroll 1
    for (int l = 0; l < DEPTH; ++l) {
        const int pb = 1 + 9 * l, l_ = l;
        const bool l0s = false;
        if (ST(1) && IN(pb + 0))
      for (int rep_ = 0; rep_ < NREP(1); ++rep_) {
            P_WS; P_ACT; float* tab1 = (float*)(ws + WS_TAB); float* tab2 = tab1 + SEQ * 32 * 2; const float* qn_g = KIN(11); const float* kn_g = KIN(12);
            constexpr int NMAIN = (M / 256) * pg8::NPT;
            for (int rA_ = 0; rA_ < REP_A; ++rA_)
            { pg8::Gemm g{XP, DM};
              pg8::SchedProj S{bx, G, NMAIN, l == 0 ? NMAIN + 32 : NMAIN, (const char*)KOUT, (const char*)(WBl + WB_IN), (const char*)HMEM, (const char*)(WB + WB_MEMKV)};
              pg8::EpiProj E{PROJ, MEMKV, tab1, tab2, qn_g + l * 64, kn_g + l * 64, (const float*)(ws + WS_ROUTE + RT_RSTD1)};
              pg8::gemm_phase<pg8::EpiProj, pg8::SchedProj, true, true>(ldsl, g, S, E, wave); }
            for (int rB_ = 0; rB_ < REP_B; ++rB_)
            { pg8::Gemm g{DM / 2, DM / 2, 0x7C7C7C7C};
              pg8::SchedGate8 S{bx, G, l == 0 ? 28 : 24, (const char*)HM, (const char*)(WBl + WB_IN) + (size_t)C_G * 2048};
              pg8::EpiSig E{PROJ, (const float*)(ws + WS_ROUTE + RT_RSTD1)};
              pg8::gemm_phase<pg8::EpiSig, pg8::SchedGate8, true, true, false, true>(ldsl, g, S, E, wave); }
        }
        SEAM(pb + 0);
        if (ST(2) && IN(pb + 1))
      for (int rep_ = 0; rep_ < NREP(2); ++rep_) {
            LAS float* lamp = (LAS float*)(ldsl + LDSCTL_OFF + 128);
            if (split) {
            P_WS; P_ACT; const float* lq1 = KIN(6); const float* lk1 = KIN(7); const float* lq2 = KIN(8); const float* lk2 = KIN(9); const float* subln_g = KIN(10); const float* norm2_g = KIN(17);
            { int lane = lane0; asm volatile("" : "+v"(lane)); const float li_ = 0.8f - 0.6f * __expf(-0.3f * (float)l);
              const float lam_ = __expf(wave_sum(lq1[l * 64 + lane] * lk1[l * 64 + lane])) - __expf(wave_sum(lq2[l * 64 + lane] * lk2[l * 64 + lane])) + li_; lamp[0] = lam_; lamp[1] = li_; }
            const int slot = idx8 & 3, j = vcu;
#pragma unroll 1
            for (int st = 0; st < 4; ++st) {
                int wv_ = wave; asm volatile("" : "+s"(wv_));
                if (st == slot) { int lane = wv_ * 0 + lane0; asm volatile("" : "+v"(lane)); tr_run(2 + l, bx * NWAVES + wv_, l == 0 ? 12928 : 12288, NGW, WB, (LAS float*)(ldsl + wv_ * 16640), lane, nullptr, (LAS float*)(ldsl + GT_OFF)); }
                if (st == 0) att::unit_a(PROJ, OBR, j >> 5, (j >> 3) & 3, j & 7, lamp, subln_g + l * 128, (char*)lds, wv_);
                else if (st == 1) {
#pragma unroll 1
                    for (int i = 0; i < 2; ++i) { const int jb = 2 * j + i; att::unit_b(PROJ, OBR, jb >> 6, (jb >> 3) & 7, jb & 7, (char*)lds, wv_); } }
                else if (st == 2) att::unit_c(PROJ, MEMKV, OBR, j >> 5, (j >> 3) & 3, j & 7, (char*)lds, wv_);
            }
            __syncthreads();
            } else {
            const int lane = lane0;
            P_WS; P_ACT; const float* lq1 = KIN(6); const float* lk1 = KIN(7); const float* lq2 = KIN(8); const float* lk2 = KIN(9); const float* subln_g = KIN(10);
            { const float li_ = 0.8f - 0.6f * __expf(-0.3f * (float)l); lamp[0] = __expf(wave_sum(lq1[l * 64 + lane] * lk1[l * 64 + lane])) - __expf(wave_sum(lq2[l * 64 + lane] * lk2[l * 64 + lane])) + li_; lamp[1] = li_; }
            constexpr int NS = NWK - NCV, NB3 = 512 - 2 * NS, NCW = NS - NB3;
            static_assert(NB3 >= 0 && NB3 <= NS && NCW > 0 && NB3 / 2 + 3 * NCW == 256, "attention deal");
            for (int jj = l0s ? 0 : vcu; jj < (l0s ? 1 : 256); jj += (l0s ? 1 : G)) {
                const int w = wk - NCV, wc_ = w - NB3;
                const int c_lo = !l0s || wk < NCV ? 0 : w < NB3 ? (w >> 1) : NB3 / 2 + 3 * wc_, c_hi = !l0s || wk < NCV ? 0 : w < NB3 ? (w >> 1) + (w & 1) : NB3 / 2 + 3 * wc_ + 3;
                const int na = l0s ? (wk < NCV ? 2 : 1) : 1, nb = l0s ? (wk < NCV ? 0 : (w < NB3 ? 3 : 2)) : 2, nc = l0s ? c_hi - c_lo : 1;
#pragma unroll 1
                for (int i = 0; i < na; ++i) { const int j = l0s ? (i == 0 ? wk : NWK + wk) : jj; att::unit_a(PROJ, OBR, j >> 5, (j >> 3) & 3, j & 7, lamp, subln_g + l * 128, (char*)lds, wave); }
#pragma unroll 1
                for (int i = 0; i < nb; ++i) { const int j = l0s ? (i < 2 ? 2 * w + i : 2 * NS + w) : 2 * jj + i; att::unit_b(PROJ, OBR, j >> 6, (j >> 3) & 7, j & 7, (char*)lds, wave); }
#pragma unroll 1
                for (int i = 0; i < nc; ++i) { const int j = l0s ? c_lo + i : jj; att::unit_c(PROJ, MEMKV, OBR, j >> 5, (j >> 3) & 3, j & 7, (char*)lds, wave); }
            }
            __syncthreads();
            }
        }
        SEAM(pb + 1);
        if (ST(3) && IN(pb + 2))
      for (int rep_ = 0; rep_ < NREP(3); ++rep_) {
            P_WS; P_ACT;
            pg8::Gemm g{OBR_W, OBR_W};
            pg8::SchedPlain S{bx, G, M / 256, (const char*)OBR, (const char*)(WBl + WB_UP), (size_t)256 * OBR_W * 2, (size_t)256 * OBR_W * 2};
            pg8::EpiGate E{HM, PROJ};
            pg8::gemm_phase<pg8::EpiGate, pg8::SchedPlain, true, true>(ldsl, g, S, E, wave);
        }
        SEAM(pb + 2);
        if (ST(4) && IN(pb + 3)) {
            P_WS; P_ACT; bf16_t* XB = (bf16_t*)KOUT;
            pg8::Gemm g{DM, DM};
            pg8::SchedPlain S{bx, G, M / 256, (const char*)HM, (const char*)(WBl + WB_OUT), (size_t)256 * DM * 2, (size_t)256 * DM * 2};
            pg8::EpiResid E{XB};
            pg8::gemm_phase<pg8::EpiResid, pg8::SchedPlain, true, true>(ldsl, g, S, E, wave);
        }
        SEAM(pb + 3);
        if (ST(5) && IN(pb + 4)) {
            int tid = tid0; asm volatile("" : "+v"(tid));
            const int lane = tid & 63;
            P_WS; P_ACT; P_ROUTE; const bf16_t* X = (const bf16_t*)KOUT; const float* b_rg = KIN(19); const float* b_re = KIN(21); const float* norm2_g = KIN(17);
            const bf16_t* tab = WB + WB_RT + (size_t)l * 2 * 48 * 1024 + (size_t)(lane & 15) * 1024 + 128 * wave + 8 * (lane >> 4);
            bf16x8 Bh[3][4], Bl[3][4];
#pragma unroll
            for (int t = 0; t < 3; ++t)
#pragma unroll
                for (int sI = 0; sI < 4; ++sI) { Bh[t][sI] = *(const bf16x8*)(tab + (size_t)t * 16 * 1024 + 32 * sI); Bl[t][sI] = *(const bf16x8*)(tab + (size_t)(48 + t * 16) * 1024 + 32 * sI); }
            for (int rb = bx; rb < M / 64; rb += G)
                route_block(X, tab, b_rg + l * 4, b_re + l * 32, experts, weights, rank, ctl + CW_CNT + 2048 * l, rstd, (int*)BUF, norm2_g + l * DM, (unsigned char*)HM, rb, Bh, Bl, (LAS float*)ldsl, tid, wave);
        }
        SEAM(pb + 4);
        volatile LAS int* mt = (volatile LAS int*)(ldsl + LDSCTL_OFF + 256);
        LAS unsigned* rowtab = (LAS unsigned*)(ldsl + LDSCTL_OFF + 2048); LAS float* wtab = (LAS float*)(ldsl + LDSCTL_OFF + 6144);
        if (ST(7) && IN(pb + 6)) {
            int tid = tid0; asm volatile("" : "+v"(tid));
            P_WS; P_ACT; P_ROUTE;
            moe_tables(ctl + CW_CNT + 2048 * l, mt, tid);
            moe_rowtabs(mt, (const int*)BUF, weights, rstd, rowtab, wtab, vcu, G, tid, 1);
            const int ntiles = __builtin_amdgcn_readfirstlane(mt[256]);
            pg8::Gemm g{DM / 2, DM / 2, 0x7C7C7C7C};
            pg8::SchedMoeUp S{vcu, G, ntiles, (const LAS int*)(ldsl + LDSCTL_OFF + 256 + 96 * 4), (const char*)HM, (const char*)(WBl + WB_GU), ctl + CW_TCNT + l * 160 * 64};
            pg8::EpiSilu E{(unsigned char*)HID, wtab};
            pg8::gemm_phase<pg8::EpiSilu, pg8::SchedMoeUp, true, true, true, true>(ldsl, g, S, E, wave, rowtab);
        }
        if (ST(8) && IN(pb + 7)) {
            int tid = tid0; asm volatile("" : "+v"(tid));
            P_WS; P_ACT; P_ROUTE;
            if (!(ST(7) && IN(pb + 6))) moe_tables(ctl + CW_CNT + 2048 * l, mt, tid);
            moe_rowtabs(mt, (const int*)BUF, weights, rstd, rowtab, wtab, vcu, G, tid, 0);
            const int ntiles = __builtin_amdgcn_readfirstlane(mt[256]);
            pg8::Gemm g{DEXP / 2, DEXP / 2, 0x7E7E7E7E};
            pg8::SchedMoeDown S{vcu, G, ntiles, (ntiles * 4) % G, wave, (const LAS int*)(ldsl + LDSCTL_OFF + 256 + 96 * 4), (const char*)HID, (const char*)(WBl + WB_DN), ctl + CW_TCNT + l * 160 * 64, ctl + CW_TMO};
            pg8::EpiRowScale E{(unsigned char*)YB, wtab};
            pg8::gemm_phase<pg8::EpiRowScale, pg8::SchedMoeDown, true, true, false, true>(ldsl, g, S, E, wave);
        }
        SEAM(pb + 7);
        if (ST(9) && IN(pb + 8)) {
            int lane = lane0; asm volatile("" : "+v"(lane));
            P_WS; P_ACT; P_ROUTE; float* OUTP = KOUT; bf16_t* XB = (bf16_t*)OUTP; const float* norm1_g = KIN(4); const float* final_g = KIN(25);
            const bool last = (l == DEPTH - 1);
            const bool poison = last && ((__hip_atomic_load(ctl + CW_BAR + args.li * BAR_REGION + XB_TMO, __ATOMIC_RELAXED, __HIP_MEMORY_SCOPE_AGENT) | __hip_atomic_load(ctl + CW_TMO, __ATOMIC_RELAXED, __HIP_MEMORY_SCOPE_AGENT)) != 0u);
            if (!(ST(7) && IN(pb + 6)) && !(ST(8) && IN(pb + 7))) moe_tables(ctl + CW_CNT + 2048 * l, mt, tid0);
            static_assert(M % 4 == 0, "rows come in fours");
            for (int m = 4 * gw; m < M; m += 4 * NGW) {
                const u32x4 ex0 = *(const u32x4*)(experts + 2 * m), ex1 = *(const u32x4*)(experts + 2 * m + 4), rk0 = *(const u32x4*)(rank + 2 * m), rk1 = *(const u32x4*)(rank + 2 * m + 4);
                const int rows[4] = {m, m + 1, m + 2, m + 3};
                const int d0[4] = {mt[ex0.x] + (int)rk0.x, mt[ex0.z] + (int)rk0.z, mt[ex1.x] + (int)rk1.x, mt[ex1.z] + (int)rk1.z}, d1[4] = {mt[ex0.y] + (int)rk0.y, mt[ex0.w] + (int)rk0.w, mt[ex1.y] + (int)rk1.y, mt[ex1.w] + (int)rk1.w};
                rows_combine_norm<4>(XB, (const unsigned char*)YB, final_g, last ? nullptr : (float*)(ws + WS_ROUTE + RT_RSTD1), OUTP, rows, lane, poison, d0, d1, (unsigned char*)HM); }
        }
        SEAM(pb + 8);
    }
#undef IN
#undef SEAM
#undef lane0
#undef tid0
#undef P_WS
#undef P_ACT
#undef P_ROUTE
}

extern "C" void kernel_launch(void* const* d_in, const int* in_sizes, int n_in, void* d_out, int out_size, void* d_ws, size_t ws_size, hipStream_t stream) {
    if (n_in != 26 || in_sizes[0] != M * DM || out_size != M * DM || ws_size < WS_END) { fprintf(stderr, "kernel_launch: unexpected shapes n_in %d out %d ws %zu (need %zu)\n", n_in, out_size, ws_size, (size_t)WS_END); return; }
    static int grid = 0;
    if (grid == 0) {
        int dev = 0, cus = 0;
        if (hipGetDevice(&dev) != hipSuccess || hipDeviceGetAttribute(&cus, hipDeviceAttributeMultiprocessorCount, dev) != hipSuccess) { grid = -1; return; }
        if (hipFuncSetAttribute((const void*)mk_fwd, hipFuncAttributeMaxDynamicSharedMemorySize, LDS_BYTES) != hipSuccess) { fprintf(stderr, "kernel_launch: hipFuncSetAttribute failed\n"); grid = -1; return; }
        int per_cu = 0;
        if (hipOccupancyMaxActiveBlocksPerMultiprocessor(&per_cu, (const void*)mk_fwd, NWAVES * 64, LDS_BYTES) != hipSuccess || per_cu < 1) fprintf(stderr, "kernel_launch: occupancy query says %d\n", per_cu);
        (void)hipGetLastError();
        grid = cus;
    }
    if (grid < 0) return;
    (void)hipMemsetAsync((unsigned char*)d_ws + WS_CTL, 0, MiB, stream);
    Args a{};
    for (int i = 0; i < 26; ++i) a.in[i] = (const float*)d_in[i];
    a.out = (float*)d_out; a.ws = (unsigned char*)d_ws; a.ph_lo = 0; a.ph_hi = N_PHASES; a.li = 0; a.pad = 0;
    hipLaunchKernelGGL(mk_fwd, dim3(grid), dim3(NWAVES * 64), LDS_BYTES, stream, a);
}
```

```cpp
#include <hip/hip_runtime.h>
#include <cstdint>
#include <cstdio>
#include <cmath>
#include <cstddef>

typedef unsigned short bf16_t;
typedef float f32x4 __attribute__((ext_vector_type(4)));
typedef unsigned u32x4 __attribute__((ext_vector_type(4)));
typedef unsigned u32x2 __attribute__((ext_vector_type(2)));

constexpr int BATCH = 8, SEQ = 2048, DM = 1024, DEPTH = 2, MEM_LEN = 256;
constexpr int M = BATCH * SEQ;
constexpr int MM = BATCH * MEM_LEN;
constexpr int D_IN = 5888;
constexpr int C_AQ = 0, C_AK = 512, C_AV = 1024, C_BQ = 1536, C_BK = 2048, C_BV = 2176, C_CQ = 2304, C_G = 2816;
constexpr int OBR_W = 1536;
constexpr int NEXP = 32, DEXP = 512;
constexpr int MOE_TILE = 256;
constexpr int P_ROWS = M * 2 + NEXP * MOE_TILE;
constexpr int MAX_TILES = P_ROWS / MOE_TILE;
constexpr float EPS = 1e-6f;
constexpr float LOG2E = 1.4426950408889634f;
constexpr float C2_64 = 0.125f * LOG2E;
constexpr float C2_128 = 0.08838834764831845f * LOG2E;

constexpr size_t MiB = 1u << 20;
constexpr size_t WS_CTL = 0;
constexpr size_t WS_ROUTE = 1 * MiB;
constexpr size_t WS_TAB = 2 * MiB;
constexpr size_t WS_MEMKV = 3 * MiB;
constexpr size_t WS_HM = 7 * MiB;
constexpr size_t WS_PROJ = 39 * MiB;
constexpr size_t WS_OBR = 223 * MiB;
constexpr size_t WS_WB = 271 * MiB;
constexpr size_t WS_LIST = 499 * MiB;
constexpr size_t WS_END = 501 * MiB;
constexpr size_t WS_BUF = WS_PROJ;
constexpr size_t WS_YB = WS_PROJ + 80 * MiB;
constexpr size_t WS_HID = WS_OBR;
constexpr size_t RT_EXP = 0;
constexpr size_t RT_WGT = 128 * 1024;
constexpr size_t RT_RANK = 256 * 1024;
constexpr size_t RT_DEST = 384 * 1024;
constexpr size_t RT_ROWW = 512 * 1024;
constexpr size_t RT_TILE = 700 * 1024;
constexpr size_t RT_RSTD1 = 896 * 1024;
constexpr size_t RT_RSTD = 768 * 1024;
constexpr int CW_CNT = 163840;
constexpr int CW_TMO = 128;
constexpr int CW_TCNT = 131072;

__device__ __forceinline__ float bf2f(bf16_t v) { return __uint_as_float(((unsigned)v) << 16); }
__device__ __forceinline__ bf16_t f2bf(float f) { unsigned u = __float_as_uint(f); return (bf16_t)((u + 0x7fffu + ((u >> 16) & 1u)) >> 16); }
template <int O> __device__ __forceinline__ float xlane(float v) { static_assert(O >= 1 && O < 32, "swizzle range"); return __int_as_float(__builtin_amdgcn_ds_swizzle(__float_as_int(v), (O << 10) | 0x1F)); }
__device__ __forceinline__ float half_sum(float v) { auto rr = __builtin_amdgcn_permlane32_swap(__float_as_uint(v), __float_as_uint(v), false, false); return __uint_as_float(rr[0]) + __uint_as_float(rr[1]); }
__device__ __forceinline__ float half_max(float v) { auto rr = __builtin_amdgcn_permlane32_swap(__float_as_uint(v), __float_as_uint(v), false, false); return fmaxf(__uint_as_float(rr[0]), __uint_as_float(rr[1])); }
__device__ __forceinline__ float wave_sum(float v) { v += xlane<1>(v); v += xlane<2>(v); v += xlane<4>(v); v += xlane<8>(v); v += xlane<16>(v); return half_sum(v); }
__device__ __forceinline__ float wave_max(float v) { v = fmaxf(v, xlane<1>(v)); v = fmaxf(v, xlane<2>(v)); v = fmaxf(v, xlane<4>(v)); v = fmaxf(v, xlane<8>(v)); v = fmaxf(v, xlane<16>(v)); return half_max(v); }
__device__ __forceinline__ float inv1d(int i) { return exp2f(-(float)i * (13.287712379549449f / 32.f)); }
__device__ __forceinline__ float inv2d(int j) { return exp2f(-(float)j * (13.287712379549449f / 16.f)); }
__device__ __forceinline__ float ang2d(int pos, int i) { return i < 16 ? (float)(pos >> 6) * inv2d(i) : (float)(pos & 63) * inv2d(i - 16); }

#define LAS __attribute__((address_space(3)))
#define GAS __attribute__((address_space(1)))
typedef short bf16x8 __attribute__((ext_vector_type(8)));
typedef short s16x4 __attribute__((ext_vector_type(4)));
typedef float f32x16 __attribute__((ext_vector_type(16)));
typedef float f32x2 __attribute__((ext_vector_type(2)));
typedef int i32x4 __attribute__((ext_vector_type(4)));
typedef int i32x8 __attribute__((ext_vector_type(8)));

constexpr size_t WB_IN = 0, WB_UP = 6029312, WB_OUT = WB_UP + 1572864, WB_GU = WB_OUT + 1048576, WB_DN = WB_GU + 33554432, WB_LAYER = WB_DN + 16777216;
constexpr size_t WB_MEMKV = 2 * WB_LAYER;
constexpr size_t WB_RT = WB_MEMKV + 1048576;
static_assert(WS_WB + (WB_RT + 2 * 2 * 48 * 1024) * 2 <= WS_END, "weight copies fit");
constexpr int N_PHASES = 19;
constexpr int XP = 2048;
constexpr int LCAP = 16384;

__device__ __forceinline__ int lane_id() { int r; asm volatile("v_mbcnt_lo_u32_b32 %0, -1, 0\n\tv_mbcnt_hi_u32_b32 %0, -1, %0" : "=v"(r)); return r; }
__device__ __forceinline__ unsigned cvt_pk_bf16(float lo, float hi) { unsigned r; asm volatile("v_cvt_pk_bf16_f32 %0, %1, %2" : "=v"(r) : "v"(lo), "v"(hi)); return r; }
__device__ __forceinline__ i32x8 cat8(const bf16x8& a, const bf16x8& b) { const i32x4 x = __builtin_bit_cast(i32x4, a), y = __builtin_bit_cast(i32x4, b); return __builtin_shufflevector(x, y, 0, 1, 2, 3, 4, 5, 6, 7); }
__device__ __forceinline__ u32x2 pack8_fp8(const f32x4& v0, const f32x4& v1) { int a = 0, b = 0; a = __builtin_amdgcn_cvt_pk_fp8_f32(v0[0], v0[1], a, false); a = __builtin_amdgcn_cvt_pk_fp8_f32(v0[2], v0[3], a, true);
    b = __builtin_amdgcn_cvt_pk_fp8_f32(v1[0], v1[1], b, false); b = __builtin_amdgcn_cvt_pk_fp8_f32(v1[2], v1[3], b, true); u32x2 r; r.x = (unsigned)a; r.y = (unsigned)b; return r; }
__device__ __forceinline__ unsigned pack4_fp8(const f32x4& v) { int a = 0; a = __builtin_amdgcn_cvt_pk_fp8_f32(v[0], v[1], a, false); a = __builtin_amdgcn_cvt_pk_fp8_f32(v[2], v[3], a, true); return (unsigned)a; }
__device__ __forceinline__ float fast_sigmoid(float v) { return __builtin_amdgcn_rcpf(1.f + __builtin_amdgcn_exp2f(-v * LOG2E)); }

namespace pg8 {
#define PG8_LAS LAS
constexpr int BM = 256, BK = 64, HALF = 128, HTB = HALF * BK * 2, STAGE_BYTES = 8 * HTB, NXCD = 8, WGM = 8;
__host__ __device__ __forceinline__ int lds_byte(int r, int c) { const int st = (r >> 4) * 2 + (c >> 5), rr = r & 15, cc = c & 31, ob = rr * 64 + cc * 2; return st * 1024 + (ob ^ (((ob >> 9) & 1) << 5)); }
__host__ __device__ __forceinline__ void stage_rc(int b, int& R, int& C) { const int st = b / 1024, sb = b % 1024, swz = sb ^ (((sb >> 9) & 1) << 5); R = (st >> 1) * 16 + swz / 64; C = (st & 1) * 32 + (swz % 64) / 2; }
__host__ __device__ __forceinline__ int perm32(int rho) { const int n = rho >> 4, i = rho & 15; return 8 * (i >> 2) + 4 * n + (i & 3); }

struct Unit { int pm, pn, sub, ord; const char* a; const char* b; };
struct Gemm { int lda; int K; int sw = 0x7F7F7F7F; };
__device__ __forceinline__ void tile_order(int L, int nM, int nN, int& pm, int& pn) {
    const int nwg = nM * nN; int wgid = L; { const int q = nwg / NXCD, r = nwg % NXCD, xcd = wgid % NXCD, off = wgid / NXCD; wgid = (xcd < r ? xcd * (q + 1) : r * (q + 1) + (xcd - r) * q) + off; }
    const int nig = WGM * nN, gid = wgid / nig, fm = gid * WGM, gsz = (nM - fm) < WGM ? (nM - fm) : WGM;
    pm = fm + ((wgid % nig) % gsz); pn = (wgid % nig) / gsz;
}
__device__ __forceinline__ u32x4 pack8(const f32x4& v0, const f32x4& v1) { u32x4 w; w.x = cvt_pk_bf16(v0[0], v0[1]); w.y = cvt_pk_bf16(v0[2], v0[3]); w.z = cvt_pk_bf16(v1[0], v1[1]); w.w = cvt_pk_bf16(v1[2], v1[3]); return w; }
__device__ __forceinline__ void unpack8(const u32x4& w, f32x4& v0, f32x4& v1) {
    v0[0] = __uint_as_float(w.x << 16); v0[1] = __uint_as_float(w.x & 0xffff0000u); v0[2] = __uint_as_float(w.y << 16); v0[3] = __uint_as_float(w.y & 0xffff0000u);
    v1[0] = __uint_as_float(w.z << 16); v1[1] = __uint_as_float(w.z & 0xffff0000u); v1[2] = __uint_as_float(w.w << 16); v1[3] = __uint_as_float(w.w & 0xffff0000u); }

__device__ __forceinline__ unsigned pack4_u8(const f32x4& v) {
    const unsigned a = (unsigned)fmaxf(__builtin_rintf(v[0] * 255.f), 1.f), b = (unsigned)fmaxf(__builtin_rintf(v[1] * 255.f), 1.f), c = (unsigned)fmaxf(__builtin_rintf(v[2] * 255.f), 1.f), d = (unsigned)fmaxf(__builtin_rintf(v[3] * 255.f), 1.f);
    return a | (b << 8) | (c << 16) | (d << 24); }
__device__ __forceinline__ void unpack8_raw(const u32x2& w, f32x4& v0, f32x4& v1) {
    v0[0] = (float)(w.x & 0xffu); v0[1] = (float)((w.x >> 8) & 0xffu); v0[2] = (float)((w.x >> 16) & 0xffu); v0[3] = (float)(w.x >> 24);
    v1[0] = (float)(w.y & 0xffu); v1[1] = (float)((w.y >> 8) & 0xffu); v1[2] = (float)((w.y >> 16) & 0xffu); v1[3] = (float)(w.y >> 24); }
__device__ __forceinline__ void unpack8_u8(const u32x2& w, f32x4& v0, f32x4& v1) {
    constexpr float k = 1.f / 255.f;
    v0[0] = (float)(w.x & 0xffu) * k; v0[1] = (float)((w.x >> 8) & 0xffu) * k; v0[2] = (float)((w.x >> 16) & 0xffu) * k; v0[3] = (float)(w.x >> 24) * k;
    v1[0] = (float)(w.y & 0xffu) * k; v1[1] = (float)((w.y >> 8) & 0xffu) * k; v1[2] = (float)((w.y >> 16) & 0xffu) * k; v1[3] = (float)(w.y >> 24) * k; }
struct EpiProj {
    static constexpr bool PERM = true, AFTER_DRAIN = false, KHOOK = false;
    bf16_t* PROJ; bf16_t* MEMKV; const float* tab1; const float* tab2; const float* qg; const float* kg; const float* rstd1;
    __device__ __forceinline__ void operator()(const f32x4 (&acc)[2][2][4][2], const Unit& u, int wr, int wc, int fr, int fq) const {
        const int colt = u.pn * 256, dcol = colt + wc * 64 + fq * 8, row0 = u.pm * 256 + wr * 64 + fr;
        if (u.sub == 1) {
#pragma unroll
            for (int ai = 0; ai < 2; ++ai)
#pragma unroll
                for (int m = 0; m < 4; ++m) { bf16_t* rowp = MEMKV + (size_t)(row0 + ai * 128 + m * 16) * 1024 + dcol;
#pragma unroll
                    for (int bj = 0; bj < 2; ++bj) *(u32x4*)(rowp + bj * 32) = pack8(acc[ai][bj][m][0], acc[ai][bj][m][1]); }
            return;
        }
        int mode = 0; float sc = 1.f; const float* g = qg;
        if (colt < C_AV) { mode = 1; if (colt < C_AK) sc = C2_64; }
        else if (colt < C_BQ) mode = 0;
        else if (colt < C_BK) { mode = 2; sc = C2_64; }
        else if (colt < C_CQ) { if (wc < 2) { mode = 2; g = kg; } }
        else if (colt < C_G) sc = C2_128;
        else mode = 3;
        f32x4 gv[2][2];
        if (mode == 2) {
#pragma unroll
            for (int bj = 0; bj < 2; ++bj)
#pragma unroll
                for (int n = 0; n < 2; ++n) gv[bj][n] = *(const f32x4*)(g + bj * 32 + fq * 8 + n * 4);
        }
        float frq[2][4]; const bool rope = (mode == 1 || mode == 2);
        if (rope) {
#pragma unroll
            for (int n = 0; n < 2; ++n)
#pragma unroll
                for (int e = 0; e < 4; ++e) { const int i = fq * 8 + n * 4 + e;
                    frq[n][e] = (mode == 1 ? inv1d(i) : inv2d(i & 15)) * 0.15915494309189535f; }
        }
        float r1v[2][4];
#pragma unroll
        for (int ai = 0; ai < 2; ++ai)
#pragma unroll
            for (int m = 0; m < 4; ++m) r1v[ai][m] = rstd1[row0 + ai * 128 + m * 16];
        asm volatile("" ::: "memory");
#pragma unroll
        for (int ai = 0; ai < 2; ++ai)
#pragma unroll
            for (int m = 0; m < 4; ++m) {
                const int row = row0 + ai * 128 + m * 16, pos = row & (SEQ - 1);
                const float r1 = r1v[ai][m];
                f32x4 v[2][2] = {{acc[ai][0][m][0] * r1, acc[ai][0][m][1] * r1}, {acc[ai][1][m][0] * r1, acc[ai][1][m][1] * r1}};
                if (mode == 2) {
                    float ss = 0.f;
#pragma unroll
                    for (int bj = 0; bj < 2; ++bj)
#pragma unroll
                        for (int n = 0; n < 2; ++n) ss += (v[bj][n][0] * v[bj][n][0] + v[bj][n][1] * v[bj][n][1]) + (v[bj][n][2] * v[bj][n][2] + v[bj][n][3] * v[bj][n][3]);
                    ss += xlane<16>(ss); ss = half_sum(ss);
                    const float rs = rsqrtf(ss * (1.f / 64.f) + EPS);
#pragma unroll
                    for (int bj = 0; bj < 2; ++bj)
#pragma unroll
                        for (int n = 0; n < 2; ++n) v[bj][n] = v[bj][n] * rs * gv[bj][n];
                }
                if (rope) {
                    const float pe = (float)(mode == 1 ? pos : (fq < 2 ? (pos >> 6) : (pos & 63)));
#pragma unroll
                    for (int n = 0; n < 2; ++n)
#pragma unroll
                        for (int e = 0; e < 4; ++e) { const float rev = __builtin_amdgcn_fractf(pe * frq[n][e]), cs = __builtin_amdgcn_cosf(rev), sn = __builtin_amdgcn_sinf(rev);
                            const float x1 = v[0][n][e], x2 = v[1][n][e]; v[0][n][e] = x1 * cs - x2 * sn; v[1][n][e] = x2 * cs + x1 * sn; }
                }
                if (mode == 3) {
#pragma unroll
                    for (int bj = 0; bj < 2; ++bj)
#pragma unroll
                        for (int n = 0; n < 2; ++n)
#pragma unroll
                            for (int e = 0; e < 4; ++e) v[bj][n][e] = fast_sigmoid(v[bj][n][e]);
                }
                if (mode == 3) {
                    u32x4 w; w.x = pack4_u8(v[0][0]); w.y = pack4_u8(v[0][1]); w.z = pack4_u8(v[1][0]); w.w = pack4_u8(v[1][1]);
                    *(u32x4*)((unsigned char*)(PROJ + (size_t)row * D_IN + C_G) + (colt - C_G) + wc * 64 + fq * 16) = w;
                } else {
                bf16_t* rowp = PROJ + (size_t)row * D_IN + dcol;
#pragma unroll
                for (int bj = 0; bj < 2; ++bj) *(u32x4*)(rowp + bj * 32) = pack8(v[bj][0] * sc, v[bj][1] * sc);
                }
            }
    }
};
struct EpiGate {
    static constexpr bool PERM = true, AFTER_DRAIN = false, KHOOK = true;
    bf16_t* MERGED; const bf16_t* PROJ;
    __device__ __forceinline__ static void ug(const u32x2& w, f32x4& v0, f32x4& v1) { unpack8_u8(w, v0, v1); }
    __device__ __forceinline__ static f32x4 raw4(unsigned w) { return (f32x4){(float)(w & 0xffu), (float)((w >> 8) & 0xffu), (float)((w >> 16) & 0xffu), (float)(w >> 24)}; }
    __device__ __forceinline__ void khook(f32x4 (&acc)[2][2][4][2], const Unit& u, int t, int wr, int wc, int fr, int fq) const {
        int row0 = u.pm * 256 + wr * 64 + fr; asm volatile("" : "+v"(row0));
        const int seg = (t >> 3) - 1, col16 = u.pn * 256 + wc * 64 + fq * 16;
#pragma unroll
        for (int ai = 0; ai < 2; ++ai) {
            u32x4 ga[4], gb[4];
#pragma unroll
            for (int m = 0; m < 4; ++m) { const unsigned char* gp = (const unsigned char*)(PROJ + (size_t)(row0 + ai * 128 + m * 16) * D_IN + C_G) + seg * 1024 + col16;
                ga[m] = *(const u32x4*)gp; gb[m] = *(const u32x4*)(gp + 1024); }
            asm volatile("" ::: "memory");
#pragma unroll
            for (int m = 0; m < 4; ++m)
#pragma unroll
                for (int bj = 0; bj < 2; ++bj)
#pragma unroll
                    for (int n = 0; n < 2; ++n) { const f32x4 a = raw4(ga[m][2 * bj + n]), b = raw4(gb[m][2 * bj + n]);
#pragma unroll
                        for (int e = 0; e < 4; ++e) acc[ai][bj][m][n][e] *= a[e] * __builtin_amdgcn_rcpf(b[e]); }
            asm volatile("" ::: "memory");
        }
    }
    __device__ __forceinline__ void operator()(const f32x4 (&acc)[2][2][4][2], const Unit& u, int wr, int wc, int fr, int fq) const {
        const int col16 = u.pn * 256 + wc * 64 + fq * 16, row0 = u.pm * 256 + wr * 64 + fr;
#pragma unroll
        for (int ai = 0; ai < 2; ++ai) {
            u32x4 gq[4];
#pragma unroll
            for (int m = 0; m < 4; ++m) gq[m] = *(const u32x4*)((const unsigned char*)(PROJ + (size_t)(row0 + ai * 128 + m * 16) * D_IN + C_G) + 2 * 1024 + col16);
            asm volatile("" ::: "memory");
#pragma unroll
            for (int m = 0; m < 4; ++m) { unsigned char* op = (unsigned char*)MERGED + (size_t)(row0 + ai * 128 + m * 16) * DM + col16; u32x4 o;
#pragma unroll
                for (int bj = 0; bj < 2; ++bj) { const f32x4 g0 = raw4(gq[m][2 * bj]) * (16.f / 255.f), g1 = raw4(gq[m][2 * bj + 1]) * (16.f / 255.f);
                    o[2 * bj] = pack4_fp8(g0 * acc[ai][bj][m][0]); o[2 * bj + 1] = pack4_fp8(g1 * acc[ai][bj][m][1]); }
                *(u32x4*)op = o; }
            asm volatile("" ::: "memory");
        }
    }
};
struct EpiResid {
    static constexpr bool PERM = true, AFTER_DRAIN = false, KHOOK = false;
    bf16_t* XB;
    __device__ __forceinline__ void operator()(const f32x4 (&acc)[2][2][4][2], const Unit& u, int wr, int wc, int fr, int fq) const {
        const int col0 = u.pn * 256 + wc * 32 + fq * 8, row0 = u.pm * 256 + wr * 64 + fr;
#pragma unroll
        for (int ai = 0; ai < 2; ++ai)
#pragma unroll
            for (int mp = 0; mp < 2; ++mp) {
                u32x4 xq[2][2];
#pragma unroll
                for (int mi = 0; mi < 2; ++mi)
#pragma unroll
                    for (int bj = 0; bj < 2; ++bj) xq[mi][bj] = *(const u32x4*)(XB + (size_t)(row0 + ai * 128 + (mp * 2 + mi) * 16) * XP + col0 + bj * 128);
                asm volatile("" ::: "memory");
#pragma unroll
                for (int mi = 0; mi < 2; ++mi) { const int m = mp * 2 + mi;
#pragma unroll
                    for (int bj = 0; bj < 2; ++bj) { f32x4 x0, x1; unpack8(xq[mi][bj], x0, x1);
                        *(u32x4*)(XB + (size_t)(row0 + ai * 128 + m * 16) * XP + col0 + bj * 128) = pack8(x0 + acc[ai][bj][m][0], x1 + acc[ai][bj][m][1]); } }
                asm volatile("" ::: "memory");
            }
    }
};
constexpr float HID_SCALE = 4.f;
struct EpiSilu {
    static constexpr bool PERM = true, AFTER_DRAIN = false, KHOOK = false;
    unsigned char* HID; const PG8_LAS float* rtab;
    __device__ __forceinline__ void operator()(const f32x4 (&acc)[2][2][4][2], const Unit& u, int wr, int wc, int fr, int fq) const {
        const __amdgpu_buffer_rsrc_t rsrc = __builtin_amdgcn_make_buffer_rsrc((void*)HID, 0, P_ROWS * DEXP, 0x00020000);
        const int col0 = u.pn * 128 + wc * 32 + fq * 8, row0 = u.pm * 256 + wr * 64 + fr;
#pragma unroll
        for (int ai = 0; ai < 2; ++ai)
#pragma unroll
            for (int m = 0; m < 4; ++m) { f32x4 h[2]; const float r = rtab[u.ord * 256 + wr * 64 + fr + ai * 128 + m * 16], rn = -r * LOG2E, rr4 = r * r * HID_SCALE;
                f32x2 ex[2][2];
#pragma unroll
                for (int n = 0; n < 2; ++n)
#pragma unroll
                    for (int q = 0; q < 2; ++q) { const f32x2 g2 = {acc[ai][0][m][n][2 * q], acc[ai][0][m][n][2 * q + 1]}; ex[n][q] = g2 * rn; }
#pragma unroll
                for (int n = 0; n < 2; ++n)
#pragma unroll
                    for (int q = 0; q < 2; ++q) { ex[n][q][0] = __builtin_amdgcn_exp2f(ex[n][q][0]); ex[n][q][1] = __builtin_amdgcn_exp2f(ex[n][q][1]); }
#pragma unroll
                for (int n = 0; n < 2; ++n)
#pragma unroll
                    for (int q = 0; q < 2; ++q) ex[n][q] = ex[n][q] + 1.f;
#pragma unroll
                for (int n = 0; n < 2; ++n)
#pragma unroll
                    for (int q = 0; q < 2; ++q) { ex[n][q][0] = __builtin_amdgcn_rcpf(ex[n][q][0]); ex[n][q][1] = __builtin_amdgcn_rcpf(ex[n][q][1]); }
#pragma unroll
                for (int n = 0; n < 2; ++n)
#pragma unroll
                    for (int q = 0; q < 2; ++q) { const f32x2 g2 = {acc[ai][0][m][n][2 * q], acc[ai][0][m][n][2 * q + 1]}, u2 = {acc[ai][1][m][n][2 * q], acc[ai][1][m][n][2 * q + 1]};
                        const f32x2 hh = (g2 * ex[n][q]) * (u2 * rr4);
                        h[n][2 * q] = hh[0]; h[n][2 * q + 1] = hh[1]; }
                __builtin_amdgcn_raw_buffer_store_b64(pack8_fp8(h[0], h[1]), rsrc, (row0 + ai * 128 + m * 16) * DEXP + col0, 0, 16); }
    }
};
struct EpiRowScale {
    static constexpr bool PERM = true, AFTER_DRAIN = false, KHOOK = false;
    unsigned char* YB; const PG8_LAS float* wtab;
    __device__ __forceinline__ void operator()(const f32x4 (&acc)[2][2][4][2], const Unit& u, int wr, int wc, int fr, int fq) const {
        const int col0 = u.pn * 256 + wc * 64 + fq * 16, rt0 = wr * 64 + fr;
#pragma unroll
        for (int ai = 0; ai < 2; ++ai)
#pragma unroll
            for (int m = 0; m < 4; ++m) { const int rt = rt0 + ai * 128 + m * 16; const float w = wtab[u.ord * 256 + rt];
                if (w >= 0.f) {
                    u32x4 o; o.x = pack4_fp8(acc[ai][0][m][0] * w); o.y = pack4_fp8(acc[ai][0][m][1] * w); o.z = pack4_fp8(acc[ai][1][m][0] * w); o.w = pack4_fp8(acc[ai][1][m][1] * w);
                    *(u32x4*)(YB + (size_t)(u.pm * 256 + rt) * DM + col0) = o; } }
    }
};
constexpr int NPT = C_G / 256, NGT = (D_IN - C_G) / 256;
struct SchedProj {
    int c, G, nmain, ntotal; const char* A; const char* B; const char* Am; const char* Bm;
    __device__ __forceinline__ bool next(int i, Unit& u) const {
        const long L = (long)i * G + c; if (L >= ntotal) return false;
        u.ord = i;
        if (L < nmain) { tile_order((int)L, M / 256, NPT, u.pm, u.pn); u.sub = 0; u.a = A + (size_t)u.pm * (256 * XP * 2); u.b = B + (size_t)u.pn * (256 * DM * 2); }
        else { const int r = (int)L - nmain; u.pm = r >> 2; u.pn = r & 3; u.sub = 1; u.a = Am + (size_t)u.pm * (256 * XP * 2); u.b = Bm + (size_t)u.pn * (256 * DM * 2); }
        return true; }
    __device__ __forceinline__ void a_ready(const Unit&) const {}
    __device__ __forceinline__ void done(const Unit&) const {}
};
struct SchedGate8 {
    int c, G, kh; const char* A; const char* B;
    __device__ __forceinline__ bool next(int i, Unit& u) const {
        long L;
        if (G == 256) { const int k = c >> 3, nl = 32 - kh, k3 = 96 - 4 * nl - 2 * kh, nf = k < k3 ? 3 : k < kh ? 2 : 4, st = k < k3 ? 3 * k : k < kh ? 3 * k3 + 2 * (k - k3) : 3 * k3 + 2 * (kh - k3) + 4 * (k - kh);
            if (i >= nf) return false; L = 8 * (st + i) + (c & 7); }
        else { L = (long)i * G + c; if (L >= (M / 256) * NGT) return false; }
        tile_order((int)L, M / 256, NGT, u.pm, u.pn); u.sub = 0; u.ord = i; u.a = A + (size_t)u.pm * (256 * DM); u.b = B + (size_t)u.pn * (256 * DM); u.pn += NPT; return true; }
    __device__ __forceinline__ void a_ready(const Unit&) const {}
    __device__ __forceinline__ void done(const Unit&) const {}
};
struct EpiSig {
    static constexpr bool PERM = true, AFTER_DRAIN = false, KHOOK = false;
    bf16_t* PROJ; const float* rstd1;
    __device__ __forceinline__ void operator()(const f32x4 (&acc)[2][2][4][2], const Unit& u, int wr, int wc, int fr, int fq) const {
        const int colt = u.pn * 256, row0 = u.pm * 256 + wr * 64 + fr;
        float r1v[2][4];
#pragma unroll
        for (int ai = 0; ai < 2; ++ai)
#pragma unroll
            for (int m = 0; m < 4; ++m) r1v[ai][m] = rstd1[row0 + ai * 128 + m * 16];
        asm volatile("" ::: "memory");
#pragma unroll
        for (int ai = 0; ai < 2; ++ai)
#pragma unroll
            for (int m = 0; m < 4; ++m) { const int row = row0 + ai * 128 + m * 16; const float r1n = -r1v[ai][m] * LOG2E; u32x4 w;
                f32x2 t[2][2][2];
#pragma unroll
                for (int bj = 0; bj < 2; ++bj)
#pragma unroll
                    for (int n = 0; n < 2; ++n)
#pragma unroll
                        for (int h = 0; h < 2; ++h) { const f32x2 a2 = {acc[ai][bj][m][n][2 * h], acc[ai][bj][m][n][2 * h + 1]}; t[bj][n][h] = a2 * r1n + (-7.994353436858858f); }
#pragma unroll
                for (int bj = 0; bj < 2; ++bj)
#pragma unroll
                    for (int n = 0; n < 2; ++n)
#pragma unroll
                        for (int h = 0; h < 2; ++h) { t[bj][n][h][0] = __builtin_amdgcn_fmed3f(__builtin_amdgcn_exp2f(t[bj][n][h][0]), 0.f, 1.f); t[bj][n][h][1] = __builtin_amdgcn_fmed3f(__builtin_amdgcn_exp2f(t[bj][n][h][1]), 0.f, 1.f); }
#pragma unroll
                for (int bj = 0; bj < 2; ++bj)
#pragma unroll
                    for (int n = 0; n < 2; ++n)
#pragma unroll
                        for (int h = 0; h < 2; ++h) t[bj][n][h] = t[bj][n][h] + (1.f / 255.f);
#pragma unroll
                for (int bj = 0; bj < 2; ++bj)
#pragma unroll
                    for (int n = 0; n < 2; ++n)
#pragma unroll
                        for (int h = 0; h < 2; ++h) { t[bj][n][h][0] = __builtin_amdgcn_rcpf(t[bj][n][h][0]); t[bj][n][h][1] = __builtin_amdgcn_rcpf(t[bj][n][h][1]); }
#pragma unroll
                for (int bj = 0; bj < 2; ++bj)
#pragma unroll
                    for (int n = 0; n < 2; ++n) { unsigned pk = 0u;
#pragma unroll
                        for (int h = 0; h < 2; ++h) { pk = __builtin_amdgcn_cvt_pk_u8_f32(t[bj][n][h][0], 2 * h, pk); pk = __builtin_amdgcn_cvt_pk_u8_f32(t[bj][n][h][1], 2 * h + 1, pk); }
                        w[bj * 2 + n] = pk; }
                *(u32x4*)((unsigned char*)(PROJ + (size_t)row * D_IN + C_G) + (colt - C_G) + wc * 64 + fq * 16) = w; }
    }
};
struct SchedPlain {
    int c, G, nM; const char* A; const char* B; size_t a_tile, b_tile;
    __device__ __forceinline__ bool next(int i, Unit& u) const {
        const long L = (long)i * G + c; if (L >= (long)nM * 4) return false;
        tile_order((int)L, nM, 4, u.pm, u.pn); u.sub = 0; u.ord = i; u.a = A + (size_t)u.pm * a_tile; u.b = B + (size_t)u.pn * b_tile; return true; }
    __device__ __forceinline__ void a_ready(const Unit&) const {}
    __device__ __forceinline__ void done(const Unit&) const {}
};
struct SchedMoeUp {
    static constexpr size_t b_exp = (size_t)1024 * 1024, b_tile = (size_t)256 * DM;
    int c, G, ntiles; const PG8_LAS int* tile_e; const char* A; const char* B; unsigned* tcnt;
    __device__ __forceinline__ bool next(int i, Unit& u) const {
        const long L = (long)i * G + c; if (L >= (long)ntiles * 4) return false;
        u.pm = (int)(L >> 2); u.pn = (int)(L & 3); u.sub = 0; u.ord = i; const int e = tile_e[u.pm];
        u.a = A; u.b = B + (size_t)e * b_exp + (size_t)u.pn * b_tile; return true; }
    __device__ __forceinline__ void a_ready(const Unit&) const {}
    __device__ __forceinline__ void done(const Unit& u) const {
        asm volatile("s_waitcnt vmcnt(0)" ::: "memory");
        if (lane_id() == 0) __hip_atomic_fetch_add(tcnt + 64 * u.pm, 1u, __ATOMIC_RELAXED, __HIP_MEMORY_SCOPE_AGENT);
    }
};
__device__ __forceinline__ int moe_down_unit(int c, int i, int rem, int G) {
    const int n0 = G - rem, n1 = rem;
    return c >= rem ? n0 * i + n1 * (i > 1 ? i - 1 : 0) + (c - rem) : n0 * (i + 2) + n1 * i + c;
}
struct SchedMoeDown {
    static constexpr size_t a_tile = (size_t)256 * DEXP, b_exp = (size_t)1024 * 512, b_tile = (size_t)256 * DEXP;
    int c, G, ntiles, rem, wv; const PG8_LAS int* tile_e; const char* A; const char* B; unsigned* tcnt; unsigned* tmo;
    __device__ __forceinline__ bool next(int i, Unit& u) const {
        const int j = moe_down_unit(c, i, rem, G); if (j >= ntiles * 4) return false;
        u.pm = j >> 2; u.pn = j & 3; u.sub = 0; u.ord = i; const int e = tile_e[u.pm];
        u.a = A + (size_t)u.pm * a_tile; u.b = B + (size_t)e * b_exp + (size_t)u.pn * b_tile; return true; }
    __device__ __forceinline__ void a_ready(const Unit& u) const {
        if (wv == 0) {
            unsigned polls = 0;
            while ((unsigned)__builtin_amdgcn_readfirstlane(__hip_atomic_load(tcnt + 64 * u.pm, __ATOMIC_RELAXED, __HIP_MEMORY_SCOPE_AGENT)) < 32u) {
                if (++polls > (1u << 20)) { if (lane_id() == 0) __hip_atomic_store(tmo, 1u, __ATOMIC_RELAXED, __HIP_MEMORY_SCOPE_AGENT); break; }
                __builtin_amdgcn_s_sleep(2); }
            __builtin_amdgcn_fence(__ATOMIC_ACQUIRE, "agent");
            asm volatile("s_waitcnt vmcnt(0)" ::: "memory");
        }
        asm volatile("" ::: "memory"); __builtin_amdgcn_s_barrier(); asm volatile("" ::: "memory");
    }
    __device__ __forceinline__ void done(const Unit&) const {}
};

template <class Epi, class Sched, bool ALIGN_EPI = false, bool SP2 = false, bool GATHER = false, bool F8 = false>
__device__ __forceinline__ void gemm_phase(PG8_LAS unsigned char* lds, const Gemm g, const Sched& S, const Epi& E, int wave_id, const PG8_LAS unsigned* rowtab = nullptr) {
    static_assert(!GATHER || SP2, "the gathered A path is written for the two-super-phase loop");
    int tid_ = wave_id * 64 + lane_id(); asm volatile("" : "+v"(tid_));
    const int tid = tid_, wid = __builtin_amdgcn_readfirstlane(tid >> 6), lane = tid & 63, wr = wid >> 2, wc = wid & 3, fr = lane & 15, fq = lane >> 4;
    int K_ = g.K; if constexpr (F8) asm volatile("" : "+s"(K_));
    const int K = K_, nt = K / BK;
    int sc8v = g.sw; if constexpr (F8) asm volatile("" : "+v"(sc8v));
    unsigned voffA[2], voffB[2];
#pragma unroll
    for (int i = 0; i < 2; ++i) { int R, C; stage_rc(tid * 16 + i * 8192, R, C); const int Rb = Epi::PERM ? ((R & ~31) + perm32(R & 31)) : R;
        voffA[i] = (unsigned)(R * g.lda + C) * 2u; voffB[i] = (unsigned)(Rb * K + C) * 2u; }
    unsigned gC[2][2] = {{0u, 0u}, {0u, 0u}}, gN[2][2] = {{0u, 0u}, {0u, 0u}};
#define PG8_GROWS(dst, ord) do { if constexpr (GATHER) { _Pragma("unroll") for (int i_ = 0; i_ < 2; ++i_) { int R_, C_; stage_rc((wid * 64 + fq * 16 + fr) * 16 + i_ * 8192, R_, C_);     \
        _Pragma("unroll") for (int h_ = 0; h_ < 2; ++h_) dst[h_][i_] = rowtab[(ord) * 256 + h_ * 128 + R_] + (unsigned)C_ * 2u; } } } while (0)
#define PG8_STAGE_A(bufoff, base, h, use_next) do { if constexpr (GATHER) { unsigned vo_[2]; vo_[0] = (use_next) ? gN[h][0] : gC[h][0]; vo_[1] = (use_next) ? gN[h][1] : gC[h][1]; PG8_STAGE(bufoff, base, vo_); } \
        else { PG8_STAGE(bufoff, (base) + (h) * hstepA, voffA); } } while (0)
    const size_t kstep = (size_t)(BK * 2);
    const size_t hstepA = (size_t)HALF * g.lda * 2, hstepB = (size_t)HALF * K * 2;
    const unsigned ldsw = (unsigned)wid * 1024u;
    const int aoff = lds_byte(wr * 64 + fr, fq * 8), boff = lds_byte(wc * 32 + fr, fq * 8);
#define PG8_SA(b, h) (((b) * 2 + (h)) * HTB)
#define PG8_SB(b, h) ((4 + (b) * 2 + (h)) * HTB)
#define PG8_STAGE(bufoff, gbase, voff) do { _Pragma("unroll") for (int _i = 0; _i < 2; ++_i) \
        __builtin_amdgcn_global_load_lds((const unsigned*)((const char*)(gbase) + (voff)[_i]), (PG8_LAS unsigned*)(lds + (bufoff) + ldsw + _i * 8192), 16, 0, 0); } while (0)
#define PG8_LDA(dst, b, h) do { _Pragma("unroll") for (int m = 0; m < 4; ++m) _Pragma("unroll") for (int k = 0; k < 2; ++k) dst[m][k] = *(const PG8_LAS bf16x8*)(lds + PG8_SA(b, h) + aoff + m * 2048 + k * 1024); } while (0)
#define PG8_LDB(dst, b, h) do { _Pragma("unroll") for (int n = 0; n < 2; ++n) _Pragma("unroll") for (int k = 0; k < 2; ++k) dst[n][k] = *(const PG8_LAS bf16x8*)(lds + PG8_SB(b, h) + boff + n * 2048 + k * 1024); } while (0)
#define PG8_MMA(ai, bj, At, Bt) do { __builtin_amdgcn_s_setprio(1); _Pragma("unroll") for (int m = 0; m < 4; ++m) _Pragma("unroll") for (int n = 0; n < 2; ++n) { \
        if constexpr (F8) asm volatile("v_mfma_scale_f32_16x16x128_f8f6f4 %0, %1, %2, %0, %3, %3 op_sel_hi:[0,0,0]" : "+v"(acc[ai][bj][m][n]) : "v"(cat8(Bt[n][0], Bt[n][1])), "v"(cat8(At[m][0], At[m][1])), "v"(sc8v));     \
        else { _Pragma("unroll") for (int k = 0; k < 2; ++k) acc[ai][bj][m][n] = __builtin_amdgcn_mfma_f32_16x16x32_bf16(Bt[n][k], At[m][k], acc[ai][bj][m][n], 0, 0, 0); } } __builtin_amdgcn_s_setprio(0); } while (0)
#define PG8_WAIT_V(n) asm volatile("s_waitcnt vmcnt(" #n ")" ::: "memory")
#define PG8_WAIT_L(n) asm volatile("s_waitcnt lgkmcnt(" #n ")" ::: "memory")
#define PG8_BAR __builtin_amdgcn_s_barrier()
#define PG8_SCHED __builtin_amdgcn_sched_barrier(0)
    Unit cur, nxt; int ui = 0;
    if (!S.next(0, cur)) return;
    f32x4 acc[2][2][4][2];
#pragma unroll
    for (int a = 0; a < 2; ++a)
#pragma unroll
        for (int b = 0; b < 2; ++b)
#pragma unroll
            for (int m = 0; m < 4; ++m)
#pragma unroll
                for (int n = 0; n < 2; ++n) acc[a][b][m][n] = (f32x4){0.f, 0.f, 0.f, 0.f};
    bf16x8 At[4][2], B0[2][2], B1[2][2];
    const char* cA = cur.a; const char* cB = cur.b;
    S.a_ready(cur);
    if constexpr (SP2) {
        PG8_GROWS(gC, 0);
        PG8_STAGE(PG8_SB(0, 0), cB, voffB); PG8_STAGE(PG8_SB(0, 1), cB + hstepB, voffB); PG8_STAGE_A(PG8_SA(0, 0), cA, 0, false); PG8_STAGE_A(PG8_SA(0, 1), cA, 1, false);
        if (wr == 1) PG8_BAR;
        PG8_WAIT_V(2); PG8_BAR;
        PG8_STAGE(PG8_SB(1, 0), cB + kstep, voffB); PG8_STAGE_A(PG8_SA(1, 0), cA + kstep, 0, false); PG8_STAGE(PG8_SB(1, 1), cB + hstepB + kstep, voffB);
        PG8_WAIT_V(6); PG8_BAR;
    } else {
        PG8_STAGE(PG8_SB(0, 0), cB, voffB); PG8_STAGE(PG8_SA(0, 0), cA, voffA); PG8_STAGE(PG8_SB(0, 1), cB + hstepB, voffB); PG8_STAGE(PG8_SA(0, 1), cA + hstepA, voffA);
        if (wr == 1) PG8_BAR;
        PG8_WAIT_V(4); PG8_BAR;
        PG8_STAGE(PG8_SB(1, 0), cB + kstep, voffB); PG8_STAGE(PG8_SA(1, 0), cA + kstep, voffA); PG8_STAGE(PG8_SB(1, 1), cB + hstepB + kstep, voffB);
        PG8_WAIT_V(6); PG8_BAR;
    }
    for (;;) {
        const bool has_next = S.next(ui + 1, nxt);
        const char* nA = has_next ? nxt.a : cA; const char* nB = has_next ? nxt.b : cB;
        for (int t = 0; t < nt; t += 2) {
            if constexpr (Epi::KHOOK) { if (t == 8 || t == 16) E.khook(acc, cur, t, wr, wc, fr, fq); }
            const bool last = (t == nt - 2);
            const char* a1 = cA + (size_t)(t + 1) * kstep;
            const char* a2 = last ? nA : cA + (size_t)(t + 2) * kstep; const char* b2 = last ? nB : cB + (size_t)(t + 2) * kstep;
            const char* a3 = a2 + kstep; const char* b3 = b2 + kstep;
            if (last && has_next) S.a_ready(nxt);
            if constexpr (GATHER) { if (last) { if (has_next) { PG8_GROWS(gN, ui + 1); } else { _Pragma("unroll") for (int h_ = 0; h_ < 2; ++h_) _Pragma("unroll") for (int i_ = 0; i_ < 2; ++i_) gN[h_][i_] = gC[h_][i_]; } } }
            if constexpr (SP2) {
            PG8_LDB(B0, 0, 0); PG8_LDB(B1, 0, 1); PG8_SCHED; PG8_LDA(At, 0, 0); PG8_STAGE_A(PG8_SA(1, 1), a1, 1, false);
            PG8_WAIT_V(8); PG8_WAIT_L(0); PG8_BAR; PG8_MMA(0, 0, At, B0); PG8_MMA(0, 1, At, B1); PG8_BAR; PG8_SCHED;
            PG8_LDA(At, 0, 1); PG8_STAGE(PG8_SB(0, 0), b2, voffB); PG8_STAGE(PG8_SB(0, 1), b2 + hstepB, voffB); PG8_STAGE_A(PG8_SA(0, 0), a2, 0, last);
            PG8_WAIT_V(8); PG8_WAIT_L(0); PG8_BAR; PG8_MMA(1, 0, At, B0); PG8_MMA(1, 1, At, B1); PG8_BAR; PG8_SCHED;
            PG8_LDB(B0, 1, 0); PG8_LDB(B1, 1, 1); PG8_SCHED; PG8_LDA(At, 1, 0); PG8_STAGE_A(PG8_SA(0, 1), a2, 1, last);
            PG8_WAIT_V(8); PG8_WAIT_L(0); PG8_BAR; PG8_MMA(0, 0, At, B0); PG8_MMA(0, 1, At, B1); PG8_BAR; PG8_SCHED;
            PG8_LDA(At, 1, 1); PG8_STAGE(PG8_SB(1, 0), b3, voffB); PG8_STAGE(PG8_SB(1, 1), b3 + hstepB, voffB); PG8_STAGE_A(PG8_SA(1, 0), a3, 0, last);
            PG8_WAIT_V(8); PG8_WAIT_L(0); PG8_BAR; PG8_MMA(1, 0, At, B0); PG8_MMA(1, 1, At, B1); PG8_BAR; PG8_SCHED;
            } else {
            PG8_LDB(B0, 0, 0); PG8_SCHED; PG8_LDA(At, 0, 0); PG8_STAGE(PG8_SA(1, 1), a1 + hstepA, voffA);
            PG8_WAIT_L(8); PG8_BAR; PG8_WAIT_L(0); PG8_MMA(0, 0, At, B0); PG8_BAR; PG8_SCHED;
            PG8_LDB(B1, 0, 1); PG8_STAGE(PG8_SB(0, 0), b2, voffB);
            PG8_BAR; PG8_WAIT_L(0); PG8_MMA(0, 1, At, B1); PG8_BAR;
            PG8_LDA(At, 0, 1); PG8_STAGE(PG8_SA(0, 0), a2, voffA);
            PG8_BAR; PG8_WAIT_L(0); PG8_MMA(1, 0, At, B0); PG8_BAR; PG8_SCHED;
            PG8_STAGE(PG8_SB(0, 1), b2 + hstepB, voffB);
            PG8_WAIT_V(6); PG8_BAR; PG8_MMA(1, 1, At, B1); PG8_BAR;
            PG8_LDB(B0, 1, 0); PG8_SCHED; PG8_LDA(At, 1, 0); PG8_STAGE(PG8_SA(0, 1), a2 + hstepA, voffA);
            PG8_WAIT_L(8); PG8_BAR; PG8_WAIT_L(0); PG8_MMA(0, 0, At, B0); PG8_BAR; PG8_SCHED;
            PG8_LDB(B1, 1, 1); PG8_STAGE(PG8_SB(1, 0), b3, voffB);
            PG8_BAR; PG8_WAIT_L(0); PG8_MMA(0, 1, At, B1); PG8_BAR;
            PG8_LDA(At, 1, 1); PG8_STAGE(PG8_SA(1, 0), a3, voffA);
            PG8_BAR; PG8_WAIT_L(0); PG8_MMA(1, 0, At, B0); PG8_BAR; PG8_SCHED;
            PG8_STAGE(PG8_SB(1, 1), b3 + hstepB, voffB);
            PG8_WAIT_V(6); PG8_BAR; PG8_MMA(1, 1, At, B1); PG8_BAR;
            }
        }
        if constexpr (ALIGN_EPI) { if (wr == 0) PG8_BAR; }
        if constexpr (!Epi::AFTER_DRAIN) {
            if constexpr (F8) { asm volatile("s_nop 15\n\ts_nop 15" ::: "memory");
                const int le_ = lane_id(); E(acc, cur, wr, wc, le_ & 15, le_ >> 4); }
            else E(acc, cur, wr, wc, fr, fq);
            S.done(cur); }
        if (!has_next) break;
#pragma unroll
        for (int a = 0; a < 2; ++a)
#pragma unroll
            for (int b = 0; b < 2; ++b)
#pragma unroll
                for (int m = 0; m < 4; ++m)
#pragma unroll
                    for (int n = 0; n < 2; ++n) acc[a][b][m][n] = (f32x4){0.f, 0.f, 0.f, 0.f};
        cur = nxt; cA = nA; cB = nB; ++ui;
        if constexpr (GATHER) { _Pragma("unroll") for (int h_ = 0; h_ < 2; ++h_) _Pragma("unroll") for (int i_ = 0; i_ < 2; ++i_) gC[h_][i_] = gN[h_][i_]; }
        if constexpr (ALIGN_EPI) { if (wr == 1) PG8_BAR; }
    }
    PG8_WAIT_V(0);
    if constexpr (!ALIGN_EPI) { if (wr == 0) PG8_BAR; }
    PG8_BAR;
    if constexpr (Epi::AFTER_DRAIN) { E.fused(acc, cur, wr, wc, fr, fq, lds, wid, lane); S.done(cur); }
#undef PG8_SA
#undef PG8_GROWS
#undef PG8_STAGE_A
#undef PG8_SB
#undef PG8_STAGE
#undef PG8_LDA
#undef PG8_LDB
#undef PG8_MMA
#undef PG8_WAIT_V
#undef PG8_WAIT_L
#undef PG8_BAR
#undef PG8_SCHED
}
}

namespace att {
constexpr int NW = 8, QBLK = 32, KVBLK = 64;
constexpr float THR = 8.f;
#define ATT_SBAR() __builtin_amdgcn_sched_barrier(0)
__device__ __forceinline__ int crow(int r, int hi) { return (r & 3) + 8 * (r >> 2) + 4 * hi; }
template <int D> __device__ __forceinline__ int kswz(int row, int colB) { return D == 128 ? row * 256 + (colB ^ ((row & 7) << 4)) : row * 128 + (colB ^ (((row >> 1) & 7) << 4)); }
template <int DV> __device__ __forceinline__ int v_st(int k, int c) { const int kk = (k & ~0xC) | ((k & 4) << 1) | ((k & 8) >> 1); return ((kk >> 3) * (DV / 32) + (c >> 5)) * 512 + ((kk & 7) * 32 + (c & 31)) * 2; }
__device__ __forceinline__ int v_rd_base(int lane) { return ((lane & 3) << 3) | (((lane >> 2) & 3) << 6) | (((lane >> 4) & 1) << 5) | (((lane >> 5) & 1) << 8); }
template <int DV> constexpr int v_rd_off(int d0, int ks, int half) { return d0 * 512 + ks * (DV / 32) * 1024 + half * (DV / 32) * 512; }
template <int OFF> __device__ __forceinline__ s16x4 tr_read(int vb) { s16x4 r; asm volatile("ds_read_b64_tr_b16 %0, %1 offset:%2" : "=&v"(r) : "v"(vb), "i"(OFF) : "memory"); return r; }

template <bool FIRST> __device__ __forceinline__ void partialSM(f32x16& p0, f32x16& p1, float& m_reg, float& alpha, f32x16& negm) {
    float pmax = p0[0];
#pragma unroll
    for (int r = 1; r < 16; ++r) pmax = fmaxf(pmax, p0[r]);
#pragma unroll
    for (int r = 0; r < 16; ++r) pmax = fmaxf(pmax, p1[r]);
    { auto rr = __builtin_amdgcn_permlane32_swap(__float_as_uint(pmax), __float_as_uint(pmax), false, false); pmax = fmaxf(__uint_as_float(rr[0]), __uint_as_float(rr[1])); }
    alpha = 1.f;
    if (FIRST || !__builtin_expect(__all(pmax <= THR), 1)) {
        const float dl = FIRST ? pmax : fmaxf(pmax, 0.f);
        if (!FIRST) alpha = __builtin_amdgcn_exp2f(-dl);
        m_reg += dl;
#pragma unroll
        for (int r = 0; r < 16; ++r) { p0[r] -= dl; p1[r] -= dl; negm[r] = -m_reg; }
    }
#pragma unroll
    for (int r = 0; r < 16; ++r) p0[r] = __builtin_amdgcn_exp2f(p0[r]);
}
__device__ __forceinline__ void finishSM(f32x16& p0, f32x16& p1, float alpha, float& l_reg, bf16x8& pa0, bf16x8& pa1, bf16x8& pa2, bf16x8& pa3) {
#pragma unroll
    for (int r = 0; r < 16; ++r) p1[r] = __builtin_amdgcn_exp2f(p1[r]);
    f32x2 sa = (f32x2){p0[0], p0[1]} + (f32x2){p1[0], p1[1]}, sb = (f32x2){p0[2], p0[3]} + (f32x2){p1[2], p1[3]}, sc = (f32x2){p0[4], p0[5]} + (f32x2){p1[4], p1[5]}, sd = (f32x2){p0[6], p0[7]} + (f32x2){p1[6], p1[7]};
    sa += (f32x2){p0[8], p0[9]}; sb += (f32x2){p0[10], p0[11]}; sc += (f32x2){p0[12], p0[13]}; sd += (f32x2){p0[14], p0[15]};
    sa += (f32x2){p1[8], p1[9]}; sb += (f32x2){p1[10], p1[11]}; sc += (f32x2){p1[12], p1[13]}; sd += (f32x2){p1[14], p1[15]};
    sa += sb; sc += sd; sa += sc;
    float ps = sa[0] + sa[1];
    { auto rr = __builtin_amdgcn_permlane32_swap(__float_as_uint(ps), __float_as_uint(ps), false, false); ps = __uint_as_float(rr[0]) + __uint_as_float(rr[1]); }
    l_reg = l_reg * alpha + ps;
#define ATT_PK4(P, BASE, OUT) do { unsigned a0 = cvt_pk_bf16(P[BASE + 0], P[BASE + 1]), a1 = cvt_pk_bf16(P[BASE + 2], P[BASE + 3]);   \
    unsigned b0 = cvt_pk_bf16(P[BASE + 4], P[BASE + 5]), b1 = cvt_pk_bf16(P[BASE + 6], P[BASE + 7]);                              \
    auto r0 = __builtin_amdgcn_permlane32_swap(a0, b0, false, false); auto r1 = __builtin_amdgcn_permlane32_swap(a1, b1, false, false); \
    u32x4 w = {r0[0], r1[0], r0[1], r1[1]}; OUT = *reinterpret_cast<bf16x8*>(&w); } while (0)
    ATT_PK4(p0, 0, pa0); ATT_PK4(p0, 8, pa1); ATT_PK4(p1, 0, pa2); ATT_PK4(p1, 8, pa3);
#undef ATT_PK4
}
template <int DQK> __device__ __forceinline__ void qkt(f32x16& p0, f32x16& p1, const char* Ks, const bf16x8* qr, const f32x16& negm, int r32, int hi) {
#pragma unroll
    for (int d0 = 0; d0 < DQK / 16; ++d0) { const int cb = (d0 * 16 + hi * 8) * 2;
        const bf16x8 b0 = *reinterpret_cast<const bf16x8*>(Ks + kswz<DQK>(r32, cb));
        const bf16x8 b1 = *reinterpret_cast<const bf16x8*>(Ks + kswz<DQK>(32 + r32, cb));
        p0 = __builtin_amdgcn_mfma_f32_32x32x16_bf16(b0, qr[d0], d0 == 0 ? negm : p0, 0, 0, 0);
        p1 = __builtin_amdgcn_mfma_f32_32x32x16_bf16(b1, qr[d0], d0 == 0 ? negm : p1, 0, 0, 0); }
}
template <int DV, int D0> __device__ __forceinline__ void pv_one(f32x16& od, int vb, bf16x8 pa0, bf16x8 pa1, bf16x8 pa2, bf16x8 pa3) {
    const s16x4 l0 = tr_read<v_rd_off<DV>(D0, 0, 0)>(vb), h0 = tr_read<v_rd_off<DV>(D0, 0, 1)>(vb), l1 = tr_read<v_rd_off<DV>(D0, 1, 0)>(vb), h1 = tr_read<v_rd_off<DV>(D0, 1, 1)>(vb);
    const s16x4 l2 = tr_read<v_rd_off<DV>(D0, 2, 0)>(vb), h2 = tr_read<v_rd_off<DV>(D0, 2, 1)>(vb), l3 = tr_read<v_rd_off<DV>(D0, 3, 0)>(vb), h3 = tr_read<v_rd_off<DV>(D0, 3, 1)>(vb);
    asm volatile("s_waitcnt lgkmcnt(0)" ::: "memory"); ATT_SBAR();
#define ATT_PK(L, H) (bf16x8){L[0], L[1], L[2], L[3], H[0], H[1], H[2], H[3]}
    od = __builtin_amdgcn_mfma_f32_32x32x16_bf16(pa0, ATT_PK(l0, h0), od, 0, 0, 0);
    od = __builtin_amdgcn_mfma_f32_32x32x16_bf16(pa1, ATT_PK(l1, h1), od, 0, 0, 0);
    od = __builtin_amdgcn_mfma_f32_32x32x16_bf16(pa2, ATT_PK(l2, h2), od, 0, 0, 0);
    od = __builtin_amdgcn_mfma_f32_32x32x16_bf16(pa3, ATT_PK(l3, h3), od, 0, 0, 0);
#undef ATT_PK
}
template <int DV> __device__ __forceinline__ void pv_all(f32x16 (&o)[DV / 32], int vb, bf16x8 pa0, bf16x8 pa1, bf16x8 pa2, bf16x8 pa3) {
    pv_one<DV, 0>(o[0], vb, pa0, pa1, pa2, pa3); pv_one<DV, 1>(o[1], vb, pa0, pa1, pa2, pa3);
    if constexpr (DV == 128) { pv_one<DV, 2>(o[2], vb, pa0, pa1, pa2, pa3); pv_one<DV, 3>(o[3], vb, pa0, pa1, pa2, pa3); }
}
template <int DQK, int DV> struct Lay { static constexpr int SHM_V = 64 * DV * 2, SHM_K = 64 * DQK * 2, OFF_V = 0, OFF_K = 2 * SHM_V, OFF_WS = OFF_K + 2 * SHM_K, OFF_STASH = OFF_WS + NW * 64 * 4; };

template <int DQK, int DV, int LDQ, int LDK, int LDV>
__device__ __forceinline__ void attn_pass(const bf16_t* __restrict__ Qb, const bf16_t* __restrict__ Kh, const bf16_t* __restrict__ Vh, int nkeys, char* lds, f32x16 (&o)[DV / 32], float (&rli)[16], int wv) {
    using L = Lay<DQK, DV>;
    constexpr int NLK = DQK / 64, NLV = DV / 64;
    int tid_ = wv * 64 + lane_id(); asm volatile("" : "+v"(tid_));
    const int tid = tid_, wid = tid >> 6, lane = tid & 63, r32 = lane & 31, hi = lane >> 5;
    char* V_lds = lds + L::OFF_V; char* K_lds = lds + L::OFF_K;
    float* ws = (float*)(lds + L::OFF_WS) + wid * 64; float* li_l = ws; float* al_l = ws + 32;
    float m_reg = 0.f, l_reg = 0.f; bf16x8 qr[DQK / 16]; f32x16 negm;
#pragma unroll
    for (int r = 0; r < 16; ++r) asm volatile("v_mov_b32 %0, 0" : "=v"(negm[r]));
#pragma unroll
    for (int d = 0; d < DV / 32; ++d) o[d] = f32x16{};
    const bf16_t* Qw = Qb + (size_t)(wid * QBLK + r32) * LDQ + hi * 8;
#pragma unroll
    for (int d0 = 0; d0 < DQK / 16; ++d0) qr[d0] = *reinterpret_cast<const bf16x8*>(Qw + d0 * 16);
    const int krow = DQK == 128 ? (tid >> 4) : (tid >> 3), kcol = DQK == 128 ? (tid & 15) * 8 : (tid & 7) * 8;
    const int vrow = DV == 128 ? (tid >> 4) : (tid >> 3), vcol = DV == 128 ? (tid & 15) * 8 : (tid & 7) * 8;
    const int vb0 = (int)(uintptr_t)V_lds + v_rd_base(lane);
    bf16x8 vsE[NLV], ksE[NLK], vsO[NLV], ksO[NLK];
    const int NT = nkeys / KVBLK;
#define ATT_LOADK(KS, kt) do { const int k0_ = ((kt) < NT ? (kt) : NT - 1) * KVBLK; _Pragma("unroll") for (int i_ = 0; i_ < NLK; ++i_) KS[i_] = *reinterpret_cast<const bf16x8*>(&Kh[(size_t)(k0_ + krow + 32 * i_) * LDK + kcol]); } while (0)
#define ATT_LOADV(VS, vt) do { const int k0_ = ((vt) < NT ? (vt) : NT - 1) * KVBLK; _Pragma("unroll") for (int i_ = 0; i_ < NLV; ++i_) VS[i_] = *reinterpret_cast<const bf16x8*>(&Vh[(size_t)(k0_ + vrow + 32 * i_) * LDV + vcol]); } while (0)
#define ATT_WRITEK(b, KS) do { _Pragma("unroll") for (int i_ = 0; i_ < NLK; ++i_) *(bf16x8*)(K_lds + (b) * L::SHM_K + kswz<DQK>(krow + 32 * i_, kcol * 2)) = KS[i_]; } while (0)
#define ATT_WRITEV(b, VS) do { _Pragma("unroll") for (int i_ = 0; i_ < NLV; ++i_) *(bf16x8*)(V_lds + (b) * L::SHM_V + v_st<DV>(vrow + 32 * i_, vcol)) = VS[i_]; } while (0)
#define ATT_SWAIT() do { if constexpr (NLK + NLV == 4) asm volatile("s_waitcnt vmcnt(4)" ::: "memory"); else if constexpr (NLK + NLV == 3) asm volatile("s_waitcnt vmcnt(3)" ::: "memory"); else asm volatile("s_waitcnt vmcnt(2)" ::: "memory"); } while (0)
#define ATT_RESC(a) do { if (__any((a) < 1.f)) { if (hi == 0) al_l[r32] = (a); asm volatile("s_waitcnt lgkmcnt(0)" ::: "memory"); \
    _Pragma("unroll") for (int d = 0; d < DV / 32; ++d) _Pragma("unroll") for (int r = 0; r < 16; ++r) o[d][r] *= al_l[crow(r, hi)]; } } while (0)
    f32x16 pA0, pA1, pB0, pB1; float alA, alB; bf16x8 pa0, pa1, pa2, pa3;
    __syncthreads();
    ATT_LOADK(ksO, 0); ATT_LOADK(ksE, 1); ATT_LOADV(vsE, 0);
    ATT_SWAIT(); ATT_WRITEK(0, ksO);
    ATT_LOADK(ksO, 2); ATT_LOADV(vsO, 1);
    __syncthreads();
    ATT_SWAIT(); ATT_WRITEK(1, ksE); ATT_WRITEV(0, vsE);
    qkt<DQK>(pA0, pA1, K_lds, qr, negm, r32, hi); ATT_SBAR();
    ATT_LOADK(ksE, 3); ATT_LOADV(vsE, 2); ATT_SBAR();
    partialSM<true>(pA0, pA1, m_reg, alA, negm);
    __syncthreads();
    for (int h = 1; h + 1 < NT; h += 2) {
        ATT_SWAIT(); ATT_WRITEK(0, ksO); ATT_WRITEV(1, vsO);
        ATT_SBAR(); qkt<DQK>(pB0, pB1, K_lds + L::SHM_K, qr, negm, r32, hi);
        finishSM(pA0, pA1, alA, l_reg, pa0, pa1, pa2, pa3); ATT_SBAR();
        ATT_LOADK(ksO, h + 3); ATT_LOADV(vsO, h + 2); ATT_SBAR();
        pv_all<DV>(o, vb0, pa0, pa1, pa2, pa3); partialSM<false>(pB0, pB1, m_reg, alB, negm);
        ATT_RESC(alB); __syncthreads();
        ATT_SWAIT(); ATT_WRITEK(1, ksE); ATT_WRITEV(0, vsE);
        ATT_SBAR(); qkt<DQK>(pA0, pA1, K_lds, qr, negm, r32, hi);
        finishSM(pB0, pB1, alB, l_reg, pa0, pa1, pa2, pa3); ATT_SBAR();
        ATT_LOADK(ksE, h + 4); ATT_LOADV(vsE, h + 3); ATT_SBAR();
        pv_all<DV>(o, vb0 + L::SHM_V, pa0, pa1, pa2, pa3); partialSM<false>(pA0, pA1, m_reg, alA, negm);
        ATT_RESC(alA); __syncthreads();
    }
    ATT_SWAIT(); ATT_WRITEV(1, vsO);
    ATT_SBAR(); qkt<DQK>(pB0, pB1, K_lds + L::SHM_K, qr, negm, r32, hi);
    finishSM(pA0, pA1, alA, l_reg, pa0, pa1, pa2, pa3); ATT_SBAR();
    pv_all<DV>(o, vb0, pa0, pa1, pa2, pa3); partialSM<false>(pB0, pB1, m_reg, alB, negm);
    ATT_RESC(alB); __syncthreads();
    finishSM(pB0, pB1, alB, l_reg, pa0, pa1, pa2, pa3); ATT_SBAR();
    pv_all<DV>(o, vb0 + L::SHM_V, pa0, pa1, pa2, pa3);
    asm volatile("s_waitcnt vmcnt(0)" ::: "memory");
    if (hi == 0) li_l[r32] = l_reg; asm volatile("s_waitcnt lgkmcnt(0)" ::: "memory");
#pragma unroll
    for (int r = 0; r < 16; ++r) rli[r] = __builtin_amdgcn_rcpf(li_l[crow(r, hi)]);
#undef ATT_LOADK
#undef ATT_LOADV
#undef ATT_WRITEK
#undef ATT_WRITEV
#undef ATT_SWAIT
#undef ATT_RESC
}
template <int DV, int LDO> __device__ __forceinline__ void store_o(bf16_t* Ob, const f32x16 (&o)[DV / 32], const float (&rli)[16], int wv) {
    int tid_ = wv * 64 + lane_id(); asm volatile("" : "+v"(tid_));
    const int tid = tid_, wid = tid >> 6, lane = tid & 63, r32 = lane & 31, hi = lane >> 5;
    bf16_t* Ow = Ob + (size_t)(wid * QBLK) * LDO;
#pragma unroll
    for (int r = 0; r < 16; ++r) { const int orow = crow(r, hi);
#pragma unroll
        for (int d0 = 0; d0 < DV / 32; ++d0) Ow[(size_t)orow * LDO + d0 * 32 + r32] = f2bf(o[d0][r] * rli[r]); }
}
__device__ __forceinline__ void unit_a(const bf16_t* PROJ, bf16_t* OBR, int b, int h, int qb, const LAS float* lamp, const float* subg, char* lds, int wv) {
    using L = Lay<64, 128>;
    int tid_ = wv * 64 + lane_id(); asm volatile("" : "+v"(tid_));
    const int tid = tid_, wid = tid >> 6, lane = tid & 63, r32 = lane & 31, hi = lane >> 5;
    const bf16_t* kv = PROJ + (size_t)b * SEQ * D_IN; const size_t qrow = (size_t)b * SEQ + qb * 256;
    unsigned* stash = (unsigned*)(lds + L::OFF_STASH) + wid * 2048 + lane;
    f32x16 o[4]; float rli[16];
#pragma unroll 1
    for (int c = 0; c < 2; ++c) {
        attn_pass<64, 128, D_IN, D_IN, D_IN>(PROJ + qrow * D_IN + C_AQ + h * 128 + c * 64, kv + C_AK + h * 128 + c * 64, kv + C_AV + h * 128, SEQ, lds, o, rli, wv);
        if (c == 0) {
#pragma unroll
            for (int d0 = 0; d0 < 4; ++d0)
#pragma unroll
                for (int r = 0; r < 16; r += 2) stash[(d0 * 8 + (r >> 1)) * 64] = cvt_pk_bf16(o[d0][r] * rli[r], o[d0][r + 1] * rli[r + 1]);
        }
    }
    const float lam = lamp[0], lam_init = lamp[1];
    asm volatile("s_waitcnt lgkmcnt(0)" ::: "memory");
    float ss[16];
#pragma unroll
    for (int r = 0; r < 16; ++r) ss[r] = 0.f;
#pragma unroll
    for (int d0 = 0; d0 < 4; ++d0)
#pragma unroll
        for (int r = 0; r < 16; r += 2) { const unsigned w = stash[(d0 * 8 + (r >> 1)) * 64];
            const float c0 = __uint_as_float(w << 16) - lam * o[d0][r] * rli[r], c1 = __uint_as_float(w & 0xffff0000u) - lam * o[d0][r + 1] * rli[r + 1];
            o[d0][r] = c0; o[d0][r + 1] = c1; ss[r] += c0 * c0; ss[r + 1] += c1 * c1; }
#pragma unroll
    for (int r = 0; r < 16; ++r) { float s = ss[r]; s += xlane<1>(s); s += xlane<2>(s); s += xlane<4>(s); s += xlane<8>(s); s += xlane<16>(s);
        ss[r] = rsqrtf(s * (1.f / 128.f) + EPS) * (1.f - lam_init); }
    bf16_t* Ow = OBR + (qrow + wid * QBLK) * OBR_W + h * 128;
#pragma unroll
    for (int d0 = 0; d0 < 4; ++d0) { const float g = subg[d0 * 32 + r32];
#pragma unroll
        for (int r = 0; r < 16; ++r) Ow[(size_t)crow(r, hi) * OBR_W + d0 * 32 + r32] = f2bf(o[d0][r] * ss[r] * g); }
}
__device__ __forceinline__ void unit_b(const bf16_t* PROJ, bf16_t* OBR, int b, int qh, int qb, char* lds, int wv);
__device__ __forceinline__ void unit_c(const bf16_t* PROJ, const bf16_t* MEMKV, bf16_t* OBR, int b, int h, int qb, char* lds, int wv) {
    const bf16_t* kv = MEMKV + (size_t)b * MEM_LEN * 1024; const size_t qrow = (size_t)b * SEQ + qb * 256;
    f32x16 o[4]; float rli[16];
    attn_pass<128, 128, D_IN, 1024, 1024>(PROJ + qrow * D_IN + C_CQ + h * 128, kv + h * 128, kv + 512 + h * 128, MEM_LEN, lds, o, rli, wv);
    store_o<128, OBR_W>(OBR + qrow * OBR_W + 1024 + h * 128, o, rli, wv);
}
#undef ATT_SBAR
}

#include <hip/hip_bf16.h>
namespace attd {
using bf16=__hip_bfloat16;
using bf16x8=__attribute__((ext_vector_type(8)))short;
using s16x4=__attribute__((ext_vector_type(4)))short;
using f32x16=__attribute__((ext_vector_type(16)))float;
using u32x4=__attribute__((ext_vector_type(4)))unsigned;
constexpr int D=64;
constexpr int NW=8,QBLK=32,QB=QBLK*NW,KVBLK=64;
__device__ __forceinline__ int crow(int r,int hi){return (r&3)+8*(r>>2)+4*hi;}
#define SBAR() __builtin_amdgcn_sched_barrier(0)
__device__ __forceinline__ void cmask(f32x16&p0,f32x16&p1,int jb,int qrel,int hi){
  const float NEG=-INFINITY; int kb=64*jb+4*hi;
  #pragma unroll
  for(int r=0;r<16;++r){int kv=kb+(r&3)+8*(r>>2); if(kv>qrel)p0[r]=NEG; if(kv+32>qrel)p1[r]=NEG;}
}

constexpr int NSLOT=3, SLOTB=8192;
constexpr int LDS_K=0, LDS_V=NSLOT*SLOTB, LDS_WS=2*NSLOT*SLOTB, LDS_OST=LDS_WS+NW*64*4, LDS_BYTES=LDS_OST+NW*4096;
constexpr float C2=0.125f*1.4426950408889634f;
__device__ __forceinline__ void glds16(const void*gsrc,unsigned lds_dst){unsigned keep;
  asm volatile("s_mov_b32 %0, m0\n\ts_mov_b32 m0, %2\n\ts_nop 0\n\tglobal_load_lds_dwordx4 %1, off\n\ts_mov_b32 m0, %0":"=&s"(keep):"v"(gsrc),"s"(lds_dst):"memory");}
__device__ __forceinline__ float max3f(float a,float b,float c){float r;asm("v_max3_f32 %0, %1, %2, %3":"=v"(r):"v"(a),"v"(b),"v"(c));return r;}
__device__ __forceinline__ float max2f(float a,float b){float r;asm("v_max_f32_e32 %0, %1, %2":"=v"(r):"v"(a),"v"(b));return r;}
__device__ __forceinline__ float fadd_s(float a,float b){float r;asm("v_add_f32_e32 %0, %1, %2":"=v"(r):"v"(a),"v"(b));return r;}
__device__ __forceinline__ float fsub_s(float a,float b){float r;asm("v_sub_f32_e32 %0, %1, %2":"=v"(r):"v"(a),"v"(b));return r;}
typedef float f32x2_t __attribute__((ext_vector_type(2))); typedef __bf16 bf16x2_t __attribute__((ext_vector_type(2)));
__device__ __forceinline__ unsigned cvtpk_s(float lo,float hi){f32x2_t v={lo,hi};bf16x2_t b=__builtin_convertvector(v,bf16x2_t);return __builtin_bit_cast(unsigned,b);}
#define WAIT_BAR(N) asm volatile("s_waitcnt vmcnt(" #N ") lgkmcnt(0)\n\ts_barrier":::"memory")

__device__ __forceinline__ void qkt(f32x16&p0,f32x16&p1,const char*Kslot,const bf16x8*qr,const f32x16&negm,int r32,int hi){
  const char*kb=Kslot+hi*1024+r32*16;
  #pragma unroll
  for(int d0=0;d0<4;++d0){
    const bf16x8 b0=*reinterpret_cast<const bf16x8*>(kb+d0*2048);
    const bf16x8 b1=*reinterpret_cast<const bf16x8*>(kb+d0*2048+512);
    if(d0==0){p0=__builtin_amdgcn_mfma_f32_32x32x16_bf16(b0,qr[0],negm,0,0,0);p1=__builtin_amdgcn_mfma_f32_32x32x16_bf16(b1,qr[0],negm,0,0,0);}
    else{p0=__builtin_amdgcn_mfma_f32_32x32x16_bf16(b0,qr[d0],p0,0,0,0);p1=__builtin_amdgcn_mfma_f32_32x32x16_bf16(b1,qr[d0],p1,0,0,0);}}
}
typedef __attribute__((address_space(3))) const char* lds_cptr;
typedef short v4i16_t __attribute__((ext_vector_type(4)));
__device__ __forceinline__ void kload8(bf16x8*kf,lds_cptr kp){
  kf[0]=*(const __attribute__((address_space(3))) bf16x8*)(kp);      kf[1]=*(const __attribute__((address_space(3))) bf16x8*)(kp+512);
  kf[2]=*(const __attribute__((address_space(3))) bf16x8*)(kp+2048); kf[3]=*(const __attribute__((address_space(3))) bf16x8*)(kp+2560);
  kf[4]=*(const __attribute__((address_space(3))) bf16x8*)(kp+4096); kf[5]=*(const __attribute__((address_space(3))) bf16x8*)(kp+4608);
  kf[6]=*(const __attribute__((address_space(3))) bf16x8*)(kp+6144); kf[7]=*(const __attribute__((address_space(3))) bf16x8*)(kp+6656);
}
__device__ __forceinline__ void kload2(bf16x8*kf,lds_cptr kp,int j){ kf[2*j]=*(const __attribute__((address_space(3))) bf16x8*)(kp+j*2048); kf[2*j+1]=*(const __attribute__((address_space(3))) bf16x8*)(kp+j*2048+512); }
__device__ __forceinline__ s16x4 vtr(lds_cptr p){ return __builtin_bit_cast(s16x4,__builtin_amdgcn_ds_read_tr16_b64_v4i16((__attribute__((address_space(3))) v4i16_t*)p)); }
__device__ __forceinline__ float rowmax(const f32x16&p0,const f32x16&p1){
  float a=max3f(p0[0],p0[1],p1[0]),b=max3f(p0[2],p0[3],p1[1]);a=max3f(a,p1[2],p1[3]);
  #pragma unroll
  for(int r=4;r<16;r+=4){a=max3f(a,p0[r],p0[r+1]);b=max3f(b,p0[r+2],p0[r+3]);a=max3f(a,p1[r],p1[r+1]);b=max3f(b,p1[r+2],p1[r+3]);}
  const float m=max2f(a,b);
  auto rr=__builtin_amdgcn_permlane32_swap(__float_as_uint(m),__float_as_uint(m),false,false);
  return max2f(__uint_as_float(rr[0]),__uint_as_float(rr[1]));
}
__device__ __forceinline__ void pv(f32x16*o,int vb,bf16x8 pa0,bf16x8 pa1,bf16x8 pa2,bf16x8 pa3){
  #pragma unroll
  for(int d0=0;d0<2;++d0){s16x4 lo[4],hi[4];
    #pragma unroll
    for(int ks=0;ks<4;++ks){
      asm volatile("ds_read_b64_tr_b16 %0,%1 offset:%c2":"=&v"(lo[ks]):"v"(vb),"i"(d0*4096+ks*1024):"memory");
      asm volatile("ds_read_b64_tr_b16 %0,%1 offset:%c2":"=&v"(hi[ks]):"v"(vb),"i"(d0*4096+ks*1024+512):"memory");}
    asm volatile("s_waitcnt lgkmcnt(0)":::"memory");SBAR();
    #define PK(k) (bf16x8){lo[k][0],lo[k][1],lo[k][2],lo[k][3],hi[k][0],hi[k][1],hi[k][2],hi[k][3]}
    o[d0]=__builtin_amdgcn_mfma_f32_32x32x16_bf16(pa0,PK(0),o[d0],0,0,0);
    o[d0]=__builtin_amdgcn_mfma_f32_32x32x16_bf16(pa1,PK(1),o[d0],0,0,0);
    o[d0]=__builtin_amdgcn_mfma_f32_32x32x16_bf16(pa2,PK(2),o[d0],0,0,0);
    o[d0]=__builtin_amdgcn_mfma_f32_32x32x16_bf16(pa3,PK(3),o[d0],0,0,0);
    #undef PK
  }
}

#ifndef ATTN_STORE16
#define ATTN_STORE16(p,v) (*(u32x4*)(p)=(v))
#endif
template<int THRL,int QP,int KP,int OP> __device__ __forceinline__ void attn_unit(const bf16*Qb,const bf16*__restrict__ Kh,const bf16*__restrict__ Vh,bf16*Ob,int nkeys,char*shm,int wv){
  int tid_=wv*64+lane_id(); asm volatile("":"+v"(tid_)); const int tid=tid_,lane=tid&63,r32=lane&31,hi=lane>>5; const int wid=wv;
  constexpr int DM=KP;
  const bf16*Qw=Qb+(long)(wid*QBLK)*QP;
  const unsigned lds0=(unsigned)(uintptr_t)shm;
  float*wsf=(float*)(shm+LDS_WS)+wid*64;
  const bf16*ksrc=Kh+(long)lane*DM+wid*8;
  const bf16*vsrc=Vh+(long)(16*(wid&3)+(lane>>2))*DM+(wid>>2)*32+(lane&3)*8;
  const unsigned kdst=lds0+LDS_K+wid*1024, vdst=lds0+LDS_V+wid*1024;
  #define DMA_K(t,slot) glds16(ksrc+(long)(t)*KVBLK*DM,(unsigned)__builtin_amdgcn_readfirstlane(kdst+(slot)))
  #define DMA_V(t,slot) glds16(vsrc+(long)(t)*KVBLK*DM,(unsigned)__builtin_amdgcn_readfirstlane(vdst+(slot)))
  const int vb0=(int)(lds0+LDS_V)+((lane>>4)&1)*32+(lane&3)*8+(4*hi+((lane&15)>>2))*64;
  const char*Kbase=shm+LDS_K; bf16x8 kf[8];
  const lds_cptr shm3=(lds_cptr)shm; const lds_cptr kp0=shm3+LDS_K+hi*1024+r32*16; const lds_cptr vp0=shm3+LDS_V+((lane>>4)&1)*32+(lane&3)*8+(4*hi+((lane&15)>>2))*64;
  const int NT=nkeys/KVBLK;
  DMA_K(0,0);DMA_V(0,0);DMA_K(1,SLOTB);
  bf16x8 qr[4];
  #pragma unroll
  for(int d0=0;d0<4;++d0)qr[d0]=*reinterpret_cast<const bf16x8*>(&Qw[(long)r32*QP+d0*16+hi*8]);
  float mhat=0.f,l_reg=0.f;f32x16 o[2],negm;
  #pragma unroll
  for(int r=0;r<16;++r){asm volatile("v_mov_b32 %0, 0":"=v"(o[0][r]));asm volatile("v_mov_b32 %0, 0":"=v"(o[1][r]));asm volatile("v_mov_b32 %0, 0":"=v"(negm[r]));}
  #define CMASK(P0,P1,t) do{}while(0)
  bool resc=false;
  #define START(P0,P1) do{ const float rm=rowmax(P0,P1); resc=false; \
    { const float dl=rm; mhat=fadd_s(mhat,dl); \
      _Pragma("unroll") for(int r=0;r<16;++r){P0[r]=fsub_s(P0[r],dl);P1[r]=fsub_s(P1[r],dl);} \
      _Pragma("unroll") for(int r=0;r<16;++r)negm[r]=-mhat; asm volatile("":"+v"(negm)); } \
    _Pragma("unroll") for(int r=0;r<16;++r)P0[r]=__builtin_amdgcn_exp2f(P0[r]); }while(0)
  #define RESC() do{ if(resc){ asm volatile("s_waitcnt lgkmcnt(0)":::"memory"); \
      _Pragma("unroll") for(int d_=0;d_<2;++d_) _Pragma("unroll") for(int r=0;r<16;++r)o[d_][r]*=wsf[crow(r,hi)]; } }while(0)
  f32x16 pA0,pA1,pB0,pB1;
  int sl_prev=0,sl_cur=0,sl_next=SLOTB;
  #define ROT() do{sl_prev=sl_cur;sl_cur=sl_next;sl_next=(sl_next==(NSLOT-1)*SLOTB)?0:sl_next+SLOTB;}while(0)
  DMA_K(2,2*SLOTB);
  WAIT_BAR(3);
  qkt(pA0,pA1,Kbase,qr,negm,r32,hi);asm volatile("s_nop 15\n\ts_nop 7":"+v"(pA0),"+v"(pA1));CMASK(pA0,pA1,0);
  START(pA0,pA1);
  _Pragma("unroll") for(int r=0;r<16;++r)pA1[r]=__builtin_amdgcn_exp2f(pA1[r]);
  WAIT_BAR(0);
  DMA_K(3,0);DMA_V(1,SLOTB);
  ROT();
  kload8(kf,kp0+sl_cur);
  WAIT_BAR(2);
  s16x4 vlo[8],vhi[8]; u32x4 pw0,pw1,pw2,pw3;
  #define PKW(P,B) cvtpk_s(P[B],P[B+1])
  #define PAF(k) __builtin_bit_cast(bf16x8,pw##k)
  #define VFR(i) (bf16x8){vlo[i][0],vlo[i][1],vlo[i][2],vlo[i][3],vhi[i][0],vhi[i][1],vhi[i][2],vhi[i][3]}
  #define PIN(x) asm volatile("":"+v"(x))
  #define MX3(a,b,c) __builtin_fmaxf(__builtin_fmaxf((a),(b)),(c))
  #define GAPA(MF,A0,A1,A2,A3,W0,W1,PW) do{ MF; sacc+=A0; sacc+=A1; sacc+=A2; sacc+=A3; PIN(sacc); W0; W1; PIN(PW); SBAR(); }while(0)
  #define EX(v) __builtin_amdgcn_exp2f(v)
  #define GAPB(MF,X,B) do{ MF; X[B]=EX(X[B]); X[B+1]=EX(X[B+1]); X[B+2]=EX(X[B+2]); X[B+3]=EX(X[B+3]); PIN(X); SBAR(); }while(0)
  #define VRD(i) do{ vlo[i]=vtr(vp_+(((i)>>2)*4096+((i)&3)*1024)); vhi[i]=vtr(vp_+(((i)>>2)*4096+((i)&3)*1024+512)); }while(0)
  #define KRD(G,j) do{ if(G){ kload2(kf,kp0+sl_next,j); SBAR(); } }while(0)
  #define STEP(C0,C1,P0,P1,t,GK,GV,GL) do{ SBAR(); \
    const lds_cptr vp_=vp0+sl_prev; \
    VRD(0); SBAR(); float sacc=(P0[0]+P0[1]); \
    GAPA(C0=__builtin_amdgcn_mfma_f32_32x32x16_bf16(kf[0],qr[0],negm,0,0,0), P0[2],P0[3],P0[4],P0[5],     pw0[0]=PKW(P0,0), pw0[1]=PKW(P0,2), pw0); \
    VRD(4); SBAR(); GAPA(C1=__builtin_amdgcn_mfma_f32_32x32x16_bf16(kf[1],qr[0],negm,0,0,0), P0[6],P0[7],P0[8],P0[9],     pw0[2]=PKW(P0,4), pw0[3]=PKW(P0,6), pw0); \
    VRD(1); SBAR(); GAPA(C0=__builtin_amdgcn_mfma_f32_32x32x16_bf16(kf[2],qr[1],C0,0,0,0),   P0[10],P0[11],P0[12],P0[13], pw1[0]=PKW(P0,8), pw1[1]=PKW(P0,10), pw1); \
    VRD(5); SBAR(); GAPA(C1=__builtin_amdgcn_mfma_f32_32x32x16_bf16(kf[3],qr[1],C1,0,0,0),   P0[14],P0[15],P1[0],P1[1],   pw1[2]=PKW(P0,12),pw1[3]=PKW(P0,14), pw1); \
    VRD(2); SBAR(); GAPA(C0=__builtin_amdgcn_mfma_f32_32x32x16_bf16(kf[4],qr[2],C0,0,0,0),   P1[2],P1[3],P1[4],P1[5],     pw2[0]=PKW(P1,0), pw2[1]=PKW(P1,2), pw2); \
    VRD(6); SBAR(); GAPA(C1=__builtin_amdgcn_mfma_f32_32x32x16_bf16(kf[5],qr[2],C1,0,0,0),   P1[6],P1[7],P1[8],P1[9],     pw2[2]=PKW(P1,4), pw2[3]=PKW(P1,6), pw2); \
    VRD(3); SBAR(); GAPA(C0=__builtin_amdgcn_mfma_f32_32x32x16_bf16(kf[6],qr[3],C0,0,0,0),   P1[10],P1[11],P1[12],P1[13], pw3[0]=PKW(P1,8), pw3[1]=PKW(P1,10), pw3); \
    VRD(7); SBAR(); GAPA(C1=__builtin_amdgcn_mfma_f32_32x32x16_bf16(kf[7],qr[3],C1,0,0,0),   P1[14],P1[15],0.f,0.f,       pw3[2]=PKW(P1,12),pw3[3]=PKW(P1,14), pw3); \
    l_reg+=sacc; \
    if(GK){DMA_K((t)+3,sl_cur);} if(GV){DMA_V((t)+1,sl_next);} \
    CMASK(C0,C1,t); \
    { float a=MX3(C0[0],C0[1],C1[0]),b=MX3(C0[2],C0[3],C1[1]); a=MX3(a,C1[2],C1[3]); \
      _Pragma("unroll") for(int r=4;r<16;r+=4){a=MX3(a,C0[r],C0[r+1]);b=MX3(b,C0[r+2],C0[r+3]);a=MX3(a,C1[r],C1[r+1]);b=MX3(b,C1[r+2],C1[r+3]);} \
      float rm=__builtin_fmaxf(a,b); { auto rr=__builtin_amdgcn_permlane32_swap(__float_as_uint(rm),__float_as_uint(rm),false,false); rm=__builtin_fmaxf(__uint_as_float(rr[0]),__uint_as_float(rr[1])); } \
      resc=false; \
      if(__builtin_expect(__any(rm>(float)THRL),0)){ const float dl=__builtin_fmaxf(rm,0.f); mhat+=dl; \
        _Pragma("unroll") for(int r=0;r<16;++r){C0[r]-=dl;C1[r]-=dl;} \
        _Pragma("unroll") for(int r=0;r<16;++r)negm[r]=-mhat; asm volatile("":"+v"(negm)); \
        const float f=__builtin_amdgcn_exp2f(-dl); l_reg*=f; if(hi==0)wsf[r32]=f; resc=true; } } \
    SBAR(); \
    GAPB(o[0]=__builtin_amdgcn_mfma_f32_32x32x16_bf16(PAF(0),VFR(0),o[0],0,0,0), C0,0); \
    GAPB(o[1]=__builtin_amdgcn_mfma_f32_32x32x16_bf16(PAF(0),VFR(4),o[1],0,0,0), C0,4); \
    KRD(GL,0); GAPB(o[0]=__builtin_amdgcn_mfma_f32_32x32x16_bf16(PAF(1),VFR(1),o[0],0,0,0), C0,8); \
    KRD(GL,1); GAPB(o[1]=__builtin_amdgcn_mfma_f32_32x32x16_bf16(PAF(1),VFR(5),o[1],0,0,0), C0,12); \
    KRD(GL,2); GAPB(o[0]=__builtin_amdgcn_mfma_f32_32x32x16_bf16(PAF(2),VFR(2),o[0],0,0,0), C1,0); \
    KRD(GL,3); GAPB(o[1]=__builtin_amdgcn_mfma_f32_32x32x16_bf16(PAF(2),VFR(6),o[1],0,0,0), C1,4); \
    GAPB(o[0]=__builtin_amdgcn_mfma_f32_32x32x16_bf16(PAF(3),VFR(3),o[0],0,0,0), C1,8); \
    GAPB(o[1]=__builtin_amdgcn_mfma_f32_32x32x16_bf16(PAF(3),VFR(7),o[1],0,0,0), C1,12); \
    }while(0)
  int t=1;
  #undef CMASK
  #define CMASK(P0,P1,t) do{}while(0)
  for(;t+5<NT;t+=2){
    STEP(pB0,pB1,pA0,pA1,t,true,true,true);     WAIT_BAR(2); RESC(); ROT();
    STEP(pA0,pA1,pB0,pB1,t+1,true,true,true);   WAIT_BAR(2); RESC(); ROT();
  }
  #undef CMASK
  #define CMASK(P0,P1,t) do{}while(0)
  #define ENDW(tt) do{ if((tt)+3<NT){WAIT_BAR(2);} else if((tt)+2<NT){WAIT_BAR(1);} else {WAIT_BAR(0);} }while(0)
  for(;t+1<NT;t+=2){
    STEP(pB0,pB1,pA0,pA1,t,(t+3<NT),(t+1<NT),(t+1<NT));       ENDW(t);   RESC(); ROT();
    STEP(pA0,pA1,pB0,pB1,t+1,(t+4<NT),(t+2<NT),(t+2<NT));     ENDW(t+1); RESC(); ROT();
  }
  STEP(pB0,pB1,pA0,pA1,NT-1,false,false,false); RESC();
  { float sacc=pB0[0]+pB0[1]; _Pragma("unroll") for(int r=2;r<16;++r)sacc+=pB0[r]; _Pragma("unroll") for(int r=0;r<16;++r)sacc+=pB1[r]; l_reg+=sacc;
    pw0=(u32x4){PKW(pB0,0),PKW(pB0,2),PKW(pB0,4),PKW(pB0,6)};pw1=(u32x4){PKW(pB0,8),PKW(pB0,10),PKW(pB0,12),PKW(pB0,14)};pw2=(u32x4){PKW(pB1,0),PKW(pB1,2),PKW(pB1,4),PKW(pB1,6)};pw3=(u32x4){PKW(pB1,8),PKW(pB1,10),PKW(pB1,12),PKW(pB1,14)};
    SBAR(); pv(o,vb0+sl_cur,PAF(0),PAF(1),PAF(2),PAF(3)); }
  #undef PKW
  #undef PAF
  #undef VFR
  #undef PIN
  #undef MX3
  #undef GAPA
  #undef GAPB
  #undef EX
  #undef VRD
  #undef KRD
  #undef STEP
  #undef ENDW
  {auto rr=__builtin_amdgcn_permlane32_swap(__float_as_uint(l_reg),__float_as_uint(l_reg),false,false);l_reg=__uint_as_float(rr[0])+__uint_as_float(rr[1]);}
  if(hi==0)wsf[32+r32]=l_reg;asm volatile("s_waitcnt lgkmcnt(0)":::"memory");
  float rli[16];
  #pragma unroll
  for(int r=0;r<16;++r)rli[r]=__builtin_amdgcn_rcpf(wsf[32+crow(r,hi)]);
  bf16*Ow=Ob+(long)(wid*QBLK)*OP;
  { bf16*stg=(bf16*)(shm+LDS_OST)+wid*2048;
    #pragma unroll
    for(int r=0;r<16;++r){const int orow=crow(r,hi);
      #pragma unroll
      for(int d0=0;d0<2;++d0)stg[orow*64+d0*32+r32]=__float2bfloat16(o[d0][r]*rli[r]);}
    asm volatile("s_waitcnt lgkmcnt(0)":::"memory");
    #pragma unroll
    for(int i=0;i<4;++i){const int row=i*8+(lane>>3),ch=lane&7; const u32x4 v=*(const u32x4*)(stg+row*64+ch*8); ATTN_STORE16(Ow+(long)row*OP+ch*8,v);} }
  asm volatile("s_waitcnt lgkmcnt(0)\n\ts_barrier":::"memory");
  #undef DMA_K
  #undef DMA_V
  #undef CMASK
  #undef START
  #undef RESC
  #undef ROT
}
constexpr int ATTN_LDS_BYTES=LDS_BYTES;
#undef SBAR
#undef WAIT_BAR
}
namespace att {
__device__ __forceinline__ void unit_b(const bf16_t* PROJ, bf16_t* OBR, int b, int qh, int qb, char* lds, int wv) {
    const bf16_t* kv = PROJ + (size_t)b * SEQ * D_IN; const size_t qrow = (size_t)b * SEQ + qb * 256;
    __syncthreads();
    attd::attn_unit<8, D_IN, D_IN, OBR_W>((const attd::bf16*)(PROJ + qrow * D_IN + C_BQ + qh * 64), (const attd::bf16*)(kv + C_BK + (qh >> 2) * 64), (const attd::bf16*)(kv + C_BV + (qh >> 2) * 64),
                                          (attd::bf16*)(OBR + qrow * OBR_W + 512 + qh * 64), SEQ, lds, wv);
}
}
template <int NR, bool NORM>
__device__ __forceinline__ void rows_in(const float* __restrict__ xbase, const float* __restrict__ g, bf16_t* __restrict__ obase, float* __restrict__ rstd_out, int row0, int lane, unsigned char* __restrict__ xq = nullptr) {
    f32x4 v[NR][4];
#pragma unroll
    for (int r = 0; r < NR; ++r)
#pragma unroll
        for (int j = 0; j < 4; ++j) v[r][j] = ((const f32x4*)(xbase + (size_t)(row0 + r) * DM))[lane + 64 * j];
    f32x4 gg[4];
#pragma unroll
    for (int j = 0; j < 4; ++j) gg[j] = NORM ? ((const f32x4*)g)[lane + 64 * j] : (f32x4){1.f, 1.f, 1.f, 1.f};
#pragma unroll
    for (int r = 0; r < NR; ++r) { float s = 0.f;
#pragma unroll
        for (int j = 0; j < 4; ++j) s += v[r][j].x * v[r][j].x + v[r][j].y * v[r][j].y + v[r][j].z * v[r][j].z + v[r][j].w * v[r][j].w;
        const float rs0 = rsqrtf(wave_sum(s) * (1.f / DM) + EPS), rs = NORM ? rs0 : 1.f;
        if (!NORM && lane == 0) rstd_out[row0 + r] = rs0;
#pragma unroll
        for (int j = 0; j < 4; ++j) { u32x2 o; o.x = cvt_pk_bf16(v[r][j].x * rs * gg[j].x, v[r][j].y * rs * gg[j].y); o.y = cvt_pk_bf16(v[r][j].z * rs * gg[j].z, v[r][j].w * rs * gg[j].w);
            ((u32x2*)(obase + (size_t)(row0 + r) * XP))[lane + 64 * j] = o;
            if (!NORM) ((unsigned*)(xq + (size_t)(row0 + r) * DM))[lane + 64 * j] = pack4_fp8(v[r][j]); } }
}
__device__ __forceinline__ void route_block(const bf16_t* __restrict__ X, const bf16_t* __restrict__ rt_tab, const float* __restrict__ brg, const float* __restrict__ bre, int* __restrict__ experts, float* __restrict__ weights,
                                            int* __restrict__ rank, unsigned* __restrict__ cnt, float* __restrict__ rstd, int* __restrict__ list, const float* __restrict__ g2, unsigned char* __restrict__ XQ, int rb, const bf16x8 (&Bh)[3][4], const bf16x8 (&Bl)[3][4], LAS float* slab, int tid, int wave) {
    const int lane = tid & 63, r = lane & 15, kq = lane >> 4;
    LAS float* ssq = slab + 8 * 64 * 48; LAS float* rs_l = ssq + 8 * 64;
    {
        bf16x8 xa[4][4];
#pragma unroll
        for (int q = 0; q < 4; ++q) { const bf16_t* xp = X + (size_t)(rb * 64 + q * 16 + r) * XP + 128 * wave + 8 * kq;
#pragma unroll
            for (int sI = 0; sI < 4; ++sI) xa[q][sI] = *(const bf16x8*)(xp + 32 * sI); }
        f32x4 gq[4][2];
#pragma unroll
        for (int sI = 0; sI < 4; ++sI) { gq[sI][0] = *(const f32x4*)(g2 + 128 * wave + 32 * sI + 8 * kq); gq[sI][1] = *(const f32x4*)(g2 + 128 * wave + 32 * sI + 8 * kq + 4); }
#pragma unroll
        for (int q = 0; q < 4; ++q) { const int rt = q;
            f32x4 acc[3]; float ss = 0.f;
#pragma unroll
            for (int t = 0; t < 3; ++t) acc[t] = (f32x4){0.f, 0.f, 0.f, 0.f};
#pragma unroll
            for (int sI = 0; sI < 4; ++sI) {
                const bf16x8 Ah = xa[q][sI]; f32x4 a0, a1; pg8::unpack8(__builtin_bit_cast(u32x4, Ah), a0, a1);
                ss += (a0[0] * a0[0] + a0[1] * a0[1]) + (a0[2] * a0[2] + a0[3] * a0[3]) + (a1[0] * a1[0] + a1[1] * a1[1]) + (a1[2] * a1[2] + a1[3] * a1[3]);
                *(u32x2*)(XQ + (size_t)(rb * 64 + rt * 16 + r) * DM + 128 * wave + 32 * sI + 8 * kq) = pack8_fp8(a0 * gq[sI][0], a1 * gq[sI][1]);
#pragma unroll
                for (int t = 0; t < 3; ++t) {
                    acc[t] = __builtin_amdgcn_mfma_f32_16x16x32_bf16(Ah, Bh[t][sI], acc[t], 0, 0, 0);
                    acc[t] = __builtin_amdgcn_mfma_f32_16x16x32_bf16(Ah, Bl[t][sI], acc[t], 0, 0, 0);
                }
            }
            ss += xlane<16>(ss); ss = half_sum(ss);
            if (kq == 0) ssq[wave * 64 + rt * 16 + r] = ss;
#pragma unroll
            for (int t = 0; t < 3; ++t)
#pragma unroll
                for (int e = 0; e < 4; ++e) slab[(wave * 64 + rt * 16 + 4 * kq + e) * 48 + 16 * t + r] = acc[t][e];
        }
    }
    __syncthreads();
    if (tid < 64) {
        const int row = rb * 64 + tid;
        float lg[36]; float ss = 0.f;
#pragma unroll
        for (int c = 0; c < 36; ++c) lg[c] = 0.f;
#pragma unroll 1
        for (int w = 0; w < 8; ++w) { ss += ssq[w * 64 + tid];
#pragma unroll
            for (int c = 0; c < 36; ++c) lg[c] += slab[(w * 64 + tid) * 48 + c]; }
        const float rs = rsqrtf(ss * (1.f / DM) + EPS);
        rstd[row] = rs;
        int gi = 0; float gm = lg[0] * rs + brg[0];
#pragma unroll
        for (int i = 1; i < 4; ++i) { const float l = lg[i] * rs + brg[i]; if (l > gm) { gm = l; gi = i; } }
        float gs = 0.f;
#pragma unroll
        for (int i = 0; i < 4; ++i) gs += __expf(lg[i] * rs + brg[i] - gm);
        const float gp = 1.f / gs;
        float el[8];
#pragma unroll
        for (int i = 0; i < 8; ++i) el[i] = 0.f;
#pragma unroll
        for (int gq = 0; gq < 4; ++gq) if (gq == gi) {
#pragma unroll
            for (int i = 0; i < 8; ++i) el[i] = lg[4 + gq * 8 + i] * rs + bre[gq * 8 + i]; }
        int i0 = 0; float l0 = el[0];
#pragma unroll
        for (int i = 1; i < 8; ++i) if (el[i] > l0) { l0 = el[i]; i0 = i; }
        int i1 = -1; float l1 = -INFINITY;
#pragma unroll
        for (int i = 0; i < 8; ++i) if (i != i0 && el[i] > l1) { l1 = el[i]; i1 = i; }
        const float p1 = __expf(l1 - l0), inv = 1.f / (1.f + p1);
        const int e0 = gi * 8 + i0, e1 = gi * 8 + i1;
        experts[row * 2] = e0; experts[row * 2 + 1] = e1;
        weights[row * 2] = gp * inv; weights[row * 2 + 1] = gp * p1 * inv;
        LAS unsigned* lc = (LAS unsigned*)(rs_l + 64); LAS unsigned* gb = lc + 32;
        if (tid < 32) lc[tid] = 0u;
        asm volatile("s_waitcnt lgkmcnt(0)" ::: "memory");
        unsigned q0, q1; const unsigned one = 1u, a0_ = (unsigned)(uintptr_t)(lc + e0), a1_ = (unsigned)(uintptr_t)(lc + e1);
        asm volatile("ds_add_rtn_u32 %0, %1, %2\n\ts_waitcnt lgkmcnt(0)" : "=v"(q0) : "v"(a0_), "v"(one) : "memory");
        asm volatile("ds_add_rtn_u32 %0, %1, %2\n\ts_waitcnt lgkmcnt(0)" : "=v"(q1) : "v"(a1_), "v"(one) : "memory");
        if (tid < 32) { const unsigned n = lc[tid]; gb[tid] = n ? atomicAdd(cnt + 64 * tid, n) : 0u; }
        const int r0 = (int)(gb[e0] + q0), r1 = (int)(gb[e1] + q1);
        rank[row * 2] = r0; rank[row * 2 + 1] = r1;
        list[e0 * LCAP + r0] = row * 2; list[e1 * LCAP + r1] = row * 2 + 1;
        rs_l[tid] = rs;
    }
    __syncthreads();
}
__device__ __forceinline__ void moe_tables(const unsigned* cnt, volatile LAS int* mt, int tid) {
    if (tid < 32) {
        const int c = (int)__hip_atomic_load(cnt + 64 * tid, __ATOMIC_RELAXED, __HIP_MEMORY_SCOPE_AGENT), t = (c + MOE_TILE - 1) / MOE_TILE;
        mt[32 + tid] = c; mt[288 + tid] = t;
        asm volatile("s_waitcnt vmcnt(0) lgkmcnt(0)" ::: "memory");
        int nt = 0;
#pragma unroll
        for (int j = 0; j < 31; ++j) { const int tj = mt[288 + j]; nt += j < tid ? tj : 0; }
        mt[tid] = nt * MOE_TILE; mt[64 + tid] = nt;
#pragma unroll 1
        for (int i = 0; i < t; ++i) mt[96 + nt + i] = tid;
        if (tid == 31) mt[256] = nt + t;
    }
    __syncthreads();
}
__device__ __forceinline__ void moe_rowtabs(volatile LAS int* mt, const int* __restrict__ list, const float* __restrict__ weights, const float* __restrict__ rstd, LAS unsigned* rowtab, LAS float* wtab, int bx, int G, int tid, int up) {
    const int ntiles = mt[256], rem = (ntiles * 4) % G, t = tid & 255, h = tid >> 8;
    int a[2]; bool have[2], valid[2];
#pragma unroll
    for (int k = 0; k < 2; ++k) { const int i = h + 2 * k; const long L = up ? (long)i * G + bx : (long)pg8::moe_down_unit(bx, i, rem, G); have[k] = L < (long)ntiles * 4; a[k] = 0; valid[k] = false;
        if (have[k]) { const int tile = (int)(L >> 2), e = mt[96 + tile], q = (tile - mt[64 + e]) * 256 + t; valid[k] = q < mt[32 + e]; if (valid[k]) a[k] = list[e * LCAP + q]; } }
    float v[2];
#pragma unroll
    for (int k = 0; k < 2; ++k) v[k] = valid[k] ? (up ? rstd[a[k] >> 1] : weights[a[k]]) : (up ? 0.f : -1.f);
#pragma unroll
    for (int k = 0; k < 2; ++k) if (have[k]) { const int i = h + 2 * k; if (up) rowtab[i * 256 + t] = (unsigned)(a[k] >> 1) * (unsigned)DM; wtab[i * 256 + t] = v[k]; }
    __syncthreads();
}
template <int NR>
__device__ __forceinline__ void rows_combine_norm(bf16_t* __restrict__ XB, const unsigned char* __restrict__ YB, const float* __restrict__ g, float* __restrict__ RS, float* __restrict__ OUT, const int (&row)[NR], int lane, bool poison, const int (&d0)[NR], const int (&d1)[NR], unsigned char* __restrict__ XQ) {
    u32x2 xq[NR][4]; unsigned ya[NR][4], yb[NR][4];
#pragma unroll
    for (int r = 0; r < NR; ++r)
#pragma unroll
        for (int j = 0; j < 4; ++j) { xq[r][j] = ((const u32x2*)(XB + (size_t)row[r] * XP))[lane + 64 * j];
            ya[r][j] = ((const unsigned*)(YB + (size_t)d0[r] * DM))[lane + 64 * j]; yb[r][j] = ((const unsigned*)(YB + (size_t)d1[r] * DM))[lane + 64 * j]; }
    f32x4 gg[4];
#pragma unroll
    for (int j = 0; j < 4; ++j) gg[j] = ((const f32x4*)g)[lane + 64 * j];
    f32x4 v[NR][4]; float s[NR];
#pragma unroll
    for (int r = 0; r < NR; ++r) { s[r] = 0.f;
#pragma unroll
        for (int j = 0; j < 4; ++j) { const u32x2 x = xq[r][j]; constexpr float ys = 1.f / 64.f;
            const f32x2 a0 = __builtin_amdgcn_cvt_pk_f32_fp8((int)ya[r][j], false), a1 = __builtin_amdgcn_cvt_pk_f32_fp8((int)ya[r][j], true), b0 = __builtin_amdgcn_cvt_pk_f32_fp8((int)yb[r][j], false), b1 = __builtin_amdgcn_cvt_pk_f32_fp8((int)yb[r][j], true);
            v[r][j].x = __uint_as_float(x.x << 16) + (a0[0] + b0[0]) * ys; v[r][j].y = __uint_as_float(x.x & 0xffff0000u) + (a0[1] + b0[1]) * ys;
            v[r][j].z = __uint_as_float(x.y << 16) + (a1[0] + b1[0]) * ys; v[r][j].w = __uint_as_float(x.y & 0xffff0000u) + (a1[1] + b1[1]) * ys;
            s[r] += v[r][j].x * v[r][j].x + v[r][j].y * v[r][j].y + v[r][j].z * v[r][j].z + v[r][j].w * v[r][j].w; } }
#pragma unroll
    for (int r = 0; r < NR; ++r) {
        float rs = rsqrtf(wave_sum(s[r]) * (1.f / DM) + EPS);
        if (poison) rs = __builtin_nanf("");
        if (RS && lane == 0) RS[row[r]] = rs;
#pragma unroll
        for (int j = 0; j < 4; ++j) {
            if (RS) { u32x2 xo; xo.x = cvt_pk_bf16(v[r][j].x, v[r][j].y); xo.y = cvt_pk_bf16(v[r][j].z, v[r][j].w); ((u32x2*)(XB + (size_t)row[r] * XP))[lane + 64 * j] = xo; ((unsigned*)(XQ + (size_t)row[r] * DM))[lane + 64 * j] = pack4_fp8(v[r][j]); }
            else { f32x4 o; o.x = v[r][j].x * rs * gg[j].x; o.y = v[r][j].y * rs * gg[j].y; o.z = v[r][j].z * rs * gg[j].z; o.w = v[r][j].w * rs * gg[j].w; ((f32x4*)(OUT + (size_t)row[r] * DM))[lane + 64 * j] = o; }
        }
    }
}
constexpr float W8_SCALE = 64.f;
struct TrItem { const float* src; bf16_t* dst; int ldw, K; };
template <int OFF> __device__ __forceinline__ unsigned long long karg64() { unsigned long long v; asm volatile("s_load_dwordx2 %0, %1, %2\n\ts_waitcnt lgkmcnt(0)" : "=s"(v) : "s"(__builtin_amdgcn_kernarg_segment_ptr()), "n"(OFF)); return v; }
__device__ __forceinline__ unsigned long long karg64d(int off) { unsigned long long v; asm volatile("s_load_dwordx2 %0, %1, %2\n\ts_waitcnt lgkmcnt(0)" : "=s"(v) : "s"(__builtin_amdgcn_kernarg_segment_ptr()), "s"(off)); return v; }
#define TR_IN(k) ((const float*)(const GAS float*)karg64d(8 * (k)))
__device__ __forceinline__ void tr_decode(int it, int lane, bf16_t* WB, const float*& sp, int& ldw, bf16_t*& dp, int& K, int& gofs) {
    const float* src; int segA, segB, kb, tb, dk0 = 0, gate = 0, gu = 0, f8 = 0; bf16_t* dst;
    if (it < 28800) {
        const int l = it / 14400; int r = it % 14400; bf16_t* WBl = WB + (size_t)l * WB_LAYER;
        if (r < 1472) { gu = 1; kb = r / 92; tb = r % 92; const int pn = tb >> 2, bj = (tb >> 1) & 1, w0 = 2 * (tb & 1); src = TR_IN(5) + (size_t)l * DM * D_IN; ldw = D_IN; K = DM; segA = 256 * pn + 64 * w0 + 32 * bj; segB = segA + 64; dst = WBl + WB_IN;
            if (pn >= C_G / 256) { gate = 1; f8 = 1; dst += (size_t)C_G * 512; segA = 256 * pn + 64 * w0 + 8 * bj; segB = segA + 64; } }
        else if (r < 1856) { r -= 1472; const int i = r >> 7; r &= 127; kb = r >> 4; tb = r & 15; src = TR_IN(13 + i) + (size_t)l * 512 * DM; ldw = DM; K = 1536; dk0 = 512 * i; gate = 1; { const int pn = tb >> 2, bj = (tb >> 1) & 1, w0 = 2 * (tb & 1); segA = 256 * pn + 64 * w0 + 8 * bj; segB = segA + 64; } dst = WBl + WB_UP; }
        else if (r < 2112) { r -= 1856; kb = r >> 4; tb = r & 15; src = TR_IN(16) + (size_t)l * DM * DM; ldw = DM; K = DM; f8 = 1; segA = 64 * tb; segB = segA + 32; dst = WBl + WB_OUT; }
        else if (r < 10304) { r -= 2112; const int e = r >> 8; r &= 255; kb = r >> 4; tb = r & 15; const int pn = tb >> 2, sg = (tb >> 1) & 1, jb = tb & 1;
            src = TR_IN(sg ? 23 : 22) + (size_t)(l * NEXP + e) * DM * DEXP; ldw = DEXP; K = DM; f8 = 1; segA = 128 * pn + 64 * jb; segB = segA + 32; dst = WBl + WB_GU + (size_t)e * 512 * 1024; }
        else { r -= 10304; const int e = r >> 7; r &= 127; kb = r >> 4; tb = r & 15; src = TR_IN(24) + (size_t)(l * NEXP + e) * DEXP * DM; ldw = DM; K = DEXP; f8 = 1; gate = 1; { const int pn = tb >> 2, bj = (tb >> 1) & 1, w0 = 2 * (tb & 1); segA = 256 * pn + 64 * w0 + 8 * bj; segB = segA + 64; } dst = WBl + WB_DN + (size_t)e * 512 * 512; }
    } else { const int r = it - 28800; kb = r >> 4; tb = r & 15; const int pn = tb >> 2, bj = (tb >> 1) & 1, w0 = 2 * (tb & 1); src = TR_IN(3); ldw = 1024; K = DM; segA = 256 * pn + 64 * w0 + 32 * bj; segB = segA + 64; dst = WB + WB_MEMKV; }
    const int q = lane & 15;
    const int q7 = q & 7, seg = q < 8 ? segA : segB;
    sp = src + (size_t)(kb * 64 + (lane >> 4)) * ldw + seg + (gate ? 16 * (q7 >> 1) + 4 * (q7 & 1) : 4 * q7);
    dp = dst + (((size_t)(64 * tb + (lane >> 3)) * K + dk0 + kb * 64 + 8 * (lane & 7)) >> f8);
    K |= f8 << 18;
    gofs = gu ? kb * 64 + (lane >> 4) : -1;
}
__device__ __forceinline__ void tr_load(f32x4 (&v)[16], const float* sp, int ldw) {
#pragma unroll
    for (int i = 0; i < 16; ++i) v[i] = *(const f32x4*)(sp + (size_t)(4 * i) * ldw);
}
__device__ __forceinline__ void tr_store(const f32x4 (&v)[16], bf16_t* dp, int K, LAS float* scr, int lane, int gofs, const LAS float* gt) {
    const int q = lane & 15, kq = lane >> 4; const int f8 = K >> 18; K &= 0x3FFFF;
#pragma unroll
    for (int i = 0; i < 16; ++i) *(LAS f32x4*)(scr + (4 * i + kq) * 64 + ((q ^ (2 * (i >> 1))) << 2)) = v[i];
    const int c = lane & 7, n8 = lane >> 3;
    f32x4 g0 = {1.f, 1.f, 1.f, 1.f}, g1 = g0;
    if (gofs >= 0) { const LAS float* gp = gt + (gofs - kq) + 8 * c; g0 = *(const LAS f32x4*)gp; g1 = *(const LAS f32x4*)(gp + 4); }
    if (f8) { g0 = g0 * W8_SCALE; g1 = g1 * W8_SCALE; }
    asm volatile("s_waitcnt lgkmcnt(0)" ::: "memory");
    const LAS float* sB = scr + (8 * c) * 64;
    if (f8) {
#pragma unroll
        for (int j = 0; j < 8; ++j) { const LAS float* sI = sB + ((n8 + 8 * j) ^ (8 * c));
            const f32x4 v0 = {sI[0 * 64] * g0[0], sI[1 * 64] * g0[1], sI[2 * 64] * g0[2], sI[3 * 64] * g0[3]}, v1 = {sI[4 * 64] * g1[0], sI[5 * 64] * g1[1], sI[6 * 64] * g1[2], sI[7 * 64] * g1[3]};
            *(u32x2*)((unsigned char*)dp + (size_t)(8 * j) * K) = pack8_fp8(v0, v1); }
    } else
#pragma unroll
    for (int j = 0; j < 8; ++j) { const LAS float* sI = sB + ((n8 + 8 * j) ^ (8 * c));
        u32x4 o; o.x = cvt_pk_bf16(sI[0 * 64] * g0[0], sI[1 * 64] * g0[1]); o.y = cvt_pk_bf16(sI[2 * 64] * g0[2], sI[3 * 64] * g0[3]); o.z = cvt_pk_bf16(sI[4 * 64] * g1[0], sI[5 * 64] * g1[1]); o.w = cvt_pk_bf16(sI[6 * 64] * g1[2], sI[7 * 64] * g1[3]);
        *(u32x4*)(dp + (size_t)(8 * j) * K) = o; }
    asm volatile("s_waitcnt lgkmcnt(0)" ::: "memory");
}

__device__ __forceinline__ int tr_item(int mode, int q) {
    return mode == 1 ? (q < 2112 ? q : q - 2112 + 28800) : mode == 4 ? q + 14400 : mode == 2 ? q + 2112 : q + 16512; }
__device__ __forceinline__ void tr_run(int mode, int q0, int qend, int qstride, bf16_t* WB, LAS float* scr, int lane, const float* gains, LAS float* gt) {
    __syncthreads();
    if (gains) {
#pragma unroll
        for (int j = 0; j < 16; ++j) gt[lane + 64 * j] = gains[lane + 64 * j];
        asm volatile("s_waitcnt lgkmcnt(0)" ::: "memory"); }
    f32x4 ra[16], rb[16], rc[16]; const float* sp; int ldw; unsigned da, ma, db, mb, dc, mc;
    if (q0 >= qend) return;
    const int qlast = q0 + ((qend - 1 - q0) / qstride) * qstride;
#define TR_LD(R, DD, MM, QQ) do { const int qn_ = (QQ) <= qlast ? (QQ) : qlast; bf16_t* dp_; int K_, g_; tr_decode(tr_item(mode, qn_), lane, WB, sp, ldw, dp_, K_, g_); \
        DD = (unsigned)(dp_ - WB); MM = ((unsigned)K_ << 12) | (unsigned)(g_ + 1); tr_load(R, sp, ldw); } while (0)
#define TR_ST(R, DD, MM) tr_store(R, WB + DD, (int)(MM >> 12), scr, lane, (int)(MM & 4095u) - 1, gt)
    int q = q0;
    TR_LD(ra, da, ma, q); TR_LD(rb, db, mb, q + qstride);
    for (;;) {
        TR_LD(rc, dc, mc, q + 2 * qstride); TR_ST(ra, da, ma); q += qstride; if (q > qlast) break;
        TR_LD(ra, da, ma, q + 2 * qstride); TR_ST(rb, db, mb); q += qstride; if (q > qlast) break;
        TR_LD(rb, db, mb, q + 2 * qstride); TR_ST(rc, dc, mc); q += qstride; if (q > qlast) break;
    }
#undef TR_ST
#undef TR_LD
}
#define XB_TMO      128
#define XB_XCNT(j)  (256  + 64 * (j))
#define XB_XSUB(j)  (1280 + 64 * (j))
#define XB_XGEN(j)  (2304 + 64 * (j))
#define XB_TOP      3328
#define XB_TOPGEN   3392
#define XB_GRP(g)   (3456 + 64 * (g))
#define XCD_BAR_WORDS 3968
#define XB_SPIN_CAP (1u << 18)

__device__ __forceinline__ unsigned xb_ld(unsigned* p)              { return __hip_atomic_load(p, __ATOMIC_RELAXED, __HIP_MEMORY_SCOPE_AGENT); }
__device__ __forceinline__ unsigned xb_add(unsigned* p, unsigned v) { return __hip_atomic_fetch_add(p, v, __ATOMIC_RELAXED, __HIP_MEMORY_SCOPE_AGENT); }
__device__ __forceinline__ unsigned xb_xcc_id() { return (unsigned)__builtin_amdgcn_s_getreg((3 << 11) | 20) & 0xFu; }
#define XB_SPIN(cond, bar) do { unsigned _sp = 0; while (cond) { __builtin_amdgcn_s_sleep(1); \
    if ((++_sp & 255u) == 0u) { if (xb_ld(&(bar)[XB_TMO])) break; if (_sp > XB_SPIN_CAP) { atomicAdd(&(bar)[XB_TMO], 1u); break; } } } } while (0)

struct XcdBarrier {
    unsigned* bar; unsigned x; unsigned w0;
    volatile LAS unsigned* st;
};

__device__ __forceinline__ XcdBarrier xcd_barrier_post(unsigned* bar, volatile LAS unsigned* st, unsigned is_wave0) {
    XcdBarrier b; b.bar = bar; b.x = xb_xcc_id(); b.st = st; b.w0 = is_wave0;
    if (is_wave0 && lane_id() == 0) { (void)xb_add(&bar[XB_XCNT(b.x)], 1u); (void)__hip_atomic_fetch_or(&bar[XB_GRP(blockIdx.x & 7u)], 1u << b.x, __ATOMIC_RELAXED, __HIP_MEMORY_SCOPE_AGENT); }
    return b;
}
__device__ __forceinline__ void xcd_barrier_complete(unsigned* bar, unsigned x, unsigned& nloc, unsigned& nx) {
    const unsigned G = gridDim.x * gridDim.y * gridDim.z;
    unsigned sum, cnt, mine, sp = 0u;
    for (;;) {
        sum = 0u; cnt = 0u; mine = 0u;
#pragma unroll
        for (unsigned j = 0; j < 16; ++j) { const unsigned c = xb_ld(&bar[XB_XCNT(j)]); sum += c; cnt += (c > 0u) ? 1u : 0u; mine = (j == x) ? c : mine; }
        if (sum == G) break;
        __builtin_amdgcn_s_sleep(1);
        if ((++sp & 255u) == 0u) { if (xb_ld(&bar[XB_TMO])) break; if (sp > XB_SPIN_CAP) { atomicAdd(&bar[XB_TMO], 1u); break; } }
    }
    nloc = mine > 0u ? mine : 1u; nx = cnt > 0u ? cnt : 1u;
}

__device__ __forceinline__ void xcd_barrier(const XcdBarrier& b) {
    asm volatile("s_waitcnt vmcnt(0)" ::: "memory");
    __syncthreads();
    if (b.w0 && lane_id() == 0) {
        unsigned* bar = b.bar;
        __builtin_amdgcn_s_waitcnt(0);
        unsigned nloc = b.st[0], nx = b.st[1];
        if (nloc == 0u) { xcd_barrier_complete(bar, b.x, nloc, nx); b.st[0] = nloc; b.st[1] = nx; }
        const unsigned old = xb_add(&bar[XB_XSUB(b.x)], 1u);
        const unsigned gen = old / nloc;
        if (old + 1u == (gen + 1u) * nloc) {
            __builtin_amdgcn_fence(__ATOMIC_RELEASE, "agent");
            asm volatile("s_waitcnt vmcnt(0)" ::: "memory");
            const unsigned og = xb_add(&bar[XB_TOP], 1u);
            const unsigned tg = og / nx;
            if (og + 1u == (tg + 1u) * nx) xb_add(&bar[XB_TOPGEN], 1u);
            else XB_SPIN(xb_ld(&bar[XB_TOPGEN]) == tg, bar);
            __builtin_amdgcn_fence(__ATOMIC_ACQUIRE, "agent");
            xb_add(&bar[XB_XGEN(b.x)], 1u);
            asm volatile("s_waitcnt vmcnt(0)" ::: "memory");
        } else {
            XB_SPIN(xb_ld(&bar[XB_XGEN(b.x)]) == gen, bar);
            __builtin_amdgcn_fence(__ATOMIC_ACQUIRE, "agent");
            asm volatile("s_waitcnt vmcnt(0)" ::: "memory");
        }
        if (b.st[2] == 0u) {
            unsigned ok = (gridDim.x == 256u && nloc == 32u && nx == 8u) ? 1u : 0u;
#pragma unroll
            for (unsigned g = 0; g < 8; ++g) { const unsigned m = xb_ld(&bar[XB_GRP(g)]); ok &= (m != 0u && (m & (m - 1u)) == 0u) ? 1u : 0u; }
            b.st[2] = ok ? 2u : 1u; }
    }
    __syncthreads();
}
__device__ __forceinline__ void xcd_barrier_local(const XcdBarrier& b) {
    if (b.st[2] != 2u) { xcd_barrier(b); return; }
    asm volatile("s_waitcnt vmcnt(0)" ::: "memory");
    __syncthreads();
    if (b.w0 && lane_id() == 0) {
        unsigned* bar = b.bar;
        __builtin_amdgcn_s_waitcnt(0);
        const unsigned nloc = b.st[0];
        const unsigned old = xb_add(&bar[XB_XSUB(b.x)], 1u), gen = old / nloc;
        if (old + 1u == (gen + 1u) * nloc) xb_add(&bar[XB_XGEN(b.x)], 1u);
        else XB_SPIN(xb_ld(&bar[XB_XGEN(b.x)]) == gen, bar);
        __builtin_amdgcn_fence(__ATOMIC_ACQUIRE, "agent");
        asm volatile("s_waitcnt vmcnt(0)" ::: "memory");
    }
    __syncthreads();
}
constexpr int NWAVES = 8;
constexpr int RING_BYTES = 131072, GT_OFF = 133120  , LDSCTL_OFF = 137216, LDS_BYTES = 147456;
constexpr int CW_BAR = 4096, BAR_REGION = 4096;
static_assert(XCD_BAR_WORDS <= BAR_REGION && (CW_BAR + (N_PHASES + 1) * BAR_REGION) * 4 <= (int)MiB, "barrier regions inside the memset region");
static_assert(pg8::STAGE_BYTES <= RING_BYTES && att::Lay<64, 128>::OFF_STASH + 65536 <= RING_BYTES && att::Lay<128, 128>::OFF_WS + 2048 <= RING_BYTES && LDSCTL_OFF + 10240 <= LDS_BYTES, "LDS map");

struct Args { const float* in[26]; float* out; unsigned char* ws; int ph_lo, ph_hi, li, pad; };
#define KIN(k) ((const float*)(const GAS float*)karg64<8 * (k)>())
#define KOUT ((float*)(GAS float*)karg64<208>())
#define KWS ((unsigned char*)(GAS unsigned char*)karg64<216>())
static_assert(offsetof(Args, out) == 208 && offsetof(Args, ws) == 216 && offsetof(Args, ph_lo) == 224, "Args layout vs the kernarg offsets above");

__global__ void __launch_bounds__(NWAVES * 64, 2) mk_fwd(Args args) {
    extern __shared__ __attribute__((aligned(16))) unsigned char lds[];
    asm volatile("s_setreg_imm32_b32 hwreg(HW_REG_MODE, 23, 1), 1");
    const int wave = __builtin_amdgcn_readfirstlane((int)threadIdx.x >> 6);
#define lane0 lane_id()
#define tid0 (wave * 64 + lane_id())
    const int G = gridDim.x, bx = blockIdx.x, vcu = (G % 8 == 0) ? (bx % 8) * (G / 8) + bx / 8 : bx;
    constexpr int NCX = 4, NCV = 8 * NCX, NWK = 256 - NCV;
    const bool split = (G == 256); const int idx8 = bx >> 3, xcd8 = bx & 7;
    const bool conv = split && (idx8 >= 32 - NCX);
    const int wk = (idx8 << 3) | xcd8, cvw = ((((idx8 - (32 - NCX)) << 3) | xcd8) * NWAVES) + wave;
    LAS unsigned char* ldsl = (LAS unsigned char*)lds;
    volatile LAS unsigned* MISC = (volatile LAS unsigned*)(ldsl + LDSCTL_OFF);
    for (int u = tid0; u < (LDS_BYTES - LDSCTL_OFF) / 4; u += NWAVES * 64) ((LAS unsigned*)(ldsl + LDSCTL_OFF))[u] = 0u;
    __syncthreads();
    XcdBarrier bar = xcd_barrier_post((unsigned*)(KWS + WS_CTL) + CW_BAR + args.li * BAR_REGION, MISC + 8, wave == 0 ? 1u : 0u);
#define P_WS unsigned char* ws = KWS; unsigned* ctl = (unsigned*)(ws + WS_CTL); (void)ctl
#define P_ACT bf16_t* MEMKV = (bf16_t*)(ws + WS_MEMKV); bf16_t* HM = (bf16_t*)(ws + WS_HM); bf16_t* PROJ = (bf16_t*)(ws + WS_PROJ); bf16_t* OBR = (bf16_t*)(ws + WS_OBR); bf16_t* HMEM = OBR; \
    bf16_t* BUF = (bf16_t*)(ws + WS_BUF); bf16_t* YB = (bf16_t*)(ws + WS_YB); bf16_t* HID = (bf16_t*)(ws + WS_HID); bf16_t* WB = (bf16_t*)(ws + WS_WB); const bf16_t* WBl = WB + (size_t)l_ * WB_LAYER; \
    (void)MEMKV; (void)HM; (void)PROJ; (void)OBR; (void)HMEM; (void)BUF; (void)YB; (void)HID; (void)WBl
#define P_ROUTE int* experts = (int*)(ws + WS_ROUTE + RT_EXP); float* weights = (float*)(ws + WS_ROUTE + RT_WGT); int* rank = (int*)(ws + WS_ROUTE + RT_RANK); float* rstd = (float*)(ws + WS_ROUTE + RT_RSTD); \
    (void)experts; (void)weights; (void)rank; (void)rstd
    const int gw = bx * NWAVES + wave, NGW = G * NWAVES;
    const int lo = args.ph_lo, hi = args.ph_hi;
#ifndef STAGE_MASK
#define STAGE_MASK 0x3FFu
#endif
#define IN(k) (lo <= (k) && (k) < hi)
#define ST(s) ((STAGE_MASK >> (s)) & 1u)
#ifndef REP_MASK
#define REP_MASK 0u
#endif
#define NREP(s) (((REP_MASK >> (s)) & 1u) ? 2 : 1)
#ifndef REP_A
#define REP_A 1
#endif
#ifndef REP_B
#define REP_B 1
#endif
#ifndef DBL_BAR
#define DBL_BAR 0
#endif
#define SEAM(k) do { if (IN(k) && IN((k) + 1)) { xcd_barrier(bar); if (DBL_BAR) xcd_barrier(bar); } } while (0)
#define SEAM_L(k) do { if (IN(k) && IN((k) + 1)) { xcd_barrier_local(bar); } } while (0)

    if (ST(0) && IN(0))
  for (int rep_ = 0; rep_ < NREP(0); ++rep_) {
        int lane = lane0, tid = tid0; asm volatile("" : "+v"(lane), "+v"(tid));
        constexpr int l_ = 0; P_WS; P_ACT;
        float* tab1 = (float*)(ws + WS_TAB); float* tab2 = tab1 + SEQ * 32 * 2;
        const float* x = KIN(0); const float* mem = KIN(1); const float* mem_g = KIN(2); const float* norm1_g = KIN(4); const float* norm2_g = KIN(17); const float* w_rg = KIN(18); const float* w_re = KIN(20);
        LAS float* scr = (LAS float*)(ldsl + wave * 16640);
#pragma unroll 1
        for (int ci = 0; ci < (split ? 2 : 4); ++ci) {
            const int md = ci == 0 ? 1 : ci == 1 ? 4 : ci;
            tr_run(md, md == 4 && split ? (gw + 320) % NGW : gw  , md == 1 ? 2368 : md == 4 ? 2112 : 12288, NGW, WB, scr, lane, md == 1 ? norm1_g : md == 4 ? norm1_g + DM : nullptr, (LAS float*)(ldsl + GT_OFF)); }
        tid = tid0; lane = lane0; asm volatile("" : "+v"(lane), "+v"(tid));
        for (int idx = bx * (NWAVES * 64) + tid; idx < DEPTH * 48 * 1024; idx += G * NWAVES * 64) { const int l = idx / (48 * 1024), c = (idx >> 10) % 48, k = idx & 1023;
            const float w = c < 4 ? w_rg[((size_t)l * DM + k) * 4 + c] : c < 36 ? w_re[((size_t)l * DM + k) * 32 + (c - 4)] : 0.f, v = w * norm2_g[l * DM + k];
            const bf16_t h = f2bf(v); bf16_t* t = WB + WB_RT + (size_t)l * 2 * 48 * 1024 + (size_t)c * 1024 + k; t[0] = h; t[48 * 1024] = f2bf(v - bf2f(h)); }
        for (int m = 4 * gw; m < M; m += 4 * NGW) rows_in<4, false>(x, nullptr, (bf16_t*)KOUT, (float*)(ws + WS_ROUTE + RT_RSTD1), m, lane, (unsigned char*)HM);
        for (int m = gw; m < MM; m += NGW) rows_in<1, true>(mem, mem_g, HMEM, nullptr, m, lane);
    }
    SEAM(0);
#pragma unroll 1
    for (int l = 0; l < DEPTH; ++l) {
        const int pb = 1 + 9 * l, l_ = l;
        const bool l0s = false;
        if (ST(1) && IN(pb + 0))
      for (int rep_ = 0; rep_ < NREP(1); ++rep_) {
            P_WS; P_ACT; float* tab1 = (float*)(ws + WS_TAB); float* tab2 = tab1 + SEQ * 32 * 2; const float* qn_g = KIN(11); const float* kn_g = KIN(12);
            constexpr int NMAIN = (M / 256) * pg8::NPT;
            for (int rA_ = 0; rA_ < REP_A; ++rA_)
            { pg8::Gemm g{XP, DM};
              pg8::SchedProj S{bx, G, NMAIN, l == 0 ? NMAIN + 32 : NMAIN, (const char*)KOUT, (const char*)(WBl + WB_IN), (const char*)HMEM, (const char*)(WB + WB_MEMKV)};
              pg8::EpiProj E{PROJ, MEMKV, tab1, tab2, qn_g + l * 64, kn_g + l * 64, (const float*)(ws + WS_ROUTE + RT_RSTD1)};
              pg8::gemm_phase<pg8::EpiProj, pg8::SchedProj, true, true>(ldsl, g, S, E, wave); }
            for (int rB_ = 0; rB_ < REP_B; ++rB_)
            { pg8::Gemm g{DM / 2, DM / 2, 0x7C7C7C7C};
              pg8::SchedGate8 S{bx, G, l == 0 ? 28 : 24, (const char*)HM, (const char*)(WBl + WB_IN) + (size_t)C_G * 2048};
              pg8::EpiSig E{PROJ, (const float*)(ws + WS_ROUTE + RT_RSTD1)};
              pg8::gemm_phase<pg8::EpiSig, pg8::SchedGate8, true, true, false, true>(ldsl, g, S, E, wave); }
        }
        if (l == 0) SEAM(pb + 0); else SEAM_L(pb + 0);
        if (ST(2) && IN(pb + 1))
      for (int rep_ = 0; rep_ < NREP(2); ++rep_) {
            LAS float* lamp = (LAS float*)(ldsl + LDSCTL_OFF + 128);
            if (split) {
            P_WS; P_ACT; const float* lq1 = KIN(6); const float* lk1 = KIN(7); const float* lq2 = KIN(8); const float* lk2 = KIN(9); const float* subln_g = KIN(10); const float* norm2_g = KIN(17);
            { int lane = lane0; asm volatile("" : "+v"(lane)); const float li_ = 0.8f - 0.6f * __expf(-0.3f * (float)l);
              const float lam_ = __expf(wave_sum(lq1[l * 64 + lane] * lk1[l * 64 + lane])) - __expf(wave_sum(lq2[l * 64 + lane] * lk2[l * 64 + lane])) + li_; lamp[0] = lam_; lamp[1] = li_; }
            const int slot = idx8 & 3, j = vcu;
#pragma unroll 1
            for (int st = 0; st < 4; ++st) {
                int wv_ = wave; asm volatile("" : "+s"(wv_));
                if (st == slot) { int lane = wv_ * 0 + lane0; asm volatile("" : "+v"(lane)); tr_run(2 + l, bx * NWAVES + wv_, 12288, NGW, WB, (LAS float*)(ldsl + wv_ * 16640), lane, nullptr, (LAS float*)(ldsl + GT_OFF)); }
                if (st == 0) att::unit_a(PROJ, OBR, j >> 5, (j >> 3) & 3, j & 7, lamp, subln_g + l * 128, (char*)lds, wv_);
                else if (st == 1) {
#pragma unroll 1
                    for (int i = 0; i < 2; ++i) { const int jb = 2 * j + i; att::unit_b(PROJ, OBR, jb >> 6, (jb >> 3) & 7, jb & 7, (char*)lds, wv_); } }
                else if (st == 2) att::unit_c(PROJ, MEMKV, OBR, j >> 5, (j >> 3) & 3, j & 7, (char*)lds, wv_);
            }
            __syncthreads();
            } else {
            const int lane = lane0;
            P_WS; P_ACT; const float* lq1 = KIN(6); const float* lk1 = KIN(7); const float* lq2 = KIN(8); const float* lk2 = KIN(9); const float* subln_g = KIN(10);
            { const float li_ = 0.8f - 0.6f * __expf(-0.3f * (float)l); lamp[0] = __expf(wave_sum(lq1[l * 64 + lane] * lk1[l * 64 + lane])) - __expf(wave_sum(lq2[l * 64 + lane] * lk2[l * 64 + lane])) + li_; lamp[1] = li_; }
            constexpr int NS = NWK - NCV, NB3 = 512 - 2 * NS, NCW = NS - NB3;
            static_assert(NB3 >= 0 && NB3 <= NS && NCW > 0 && NB3 / 2 + 3 * NCW == 256, "attention deal");
            for (int jj = l0s ? 0 : vcu; jj < (l0s ? 1 : 256); jj += (l0s ? 1 : G)) {
                const int w = wk - NCV, wc_ = w - NB3;
                const int c_lo = !l0s || wk < NCV ? 0 : w < NB3 ? (w >> 1) : NB3 / 2 + 3 * wc_, c_hi = !l0s || wk < NCV ? 0 : w < NB3 ? (w >> 1) + (w & 1) : NB3 / 2 + 3 * wc_ + 3;
                const int na = l0s ? (wk < NCV ? 2 : 1) : 1, nb = l0s ? (wk < NCV ? 0 : (w < NB3 ? 3 : 2)) : 2, nc = l0s ? c_hi - c_lo : 1;
#pragma unroll 1
                for (int i = 0; i < na; ++i) { const int j = l0s ? (i == 0 ? wk : NWK + wk) : jj; att::unit_a(PROJ, OBR, j >> 5, (j >> 3) & 3, j & 7, lamp, subln_g + l * 128, (char*)lds, wave); }
#pragma unroll 1
                for (int i = 0; i < nb; ++i) { const int j = l0s ? (i < 2 ? 2 * w + i : 2 * NS + w) : 2 * jj + i; att::unit_b(PROJ, OBR, j >> 6, (j >> 3) & 7, j & 7, (char*)lds, wave); }
#pragma unroll 1
                for (int i = 0; i < nc; ++i) { const int j = l0s ? c_lo + i : jj; att::unit_c(PROJ, MEMKV, OBR, j >> 5, (j >> 3) & 3, j & 7, (char*)lds, wave); }
            }
            __syncthreads();
            }
        }
        SEAM_L(pb + 1);
        if (ST(3) && IN(pb + 2))
      for (int rep_ = 0; rep_ < NREP(3); ++rep_) {
            P_WS; P_ACT;
            pg8::Gemm g{OBR_W, OBR_W};
            pg8::SchedPlain S{bx, G, M / 256, (const char*)OBR, (const char*)(WBl + WB_UP), (size_t)256 * OBR_W * 2, (size_t)256 * OBR_W * 2};
            pg8::EpiGate E{HM, PROJ};
            pg8::gemm_phase<pg8::EpiGate, pg8::SchedPlain, true, true>(ldsl, g, S, E, wave);
        }
        SEAM_L(pb + 2);
        if (ST(4) && IN(pb + 3)) {
            P_WS; P_ACT; bf16_t* XB = (bf16_t*)KOUT;
            pg8::Gemm g{DM / 2, DM / 2, 0x7A7A7A7A};
            pg8::SchedPlain S{bx, G, M / 256, (const char*)HM, (const char*)(WBl + WB_OUT), (size_t)256 * DM, (size_t)256 * DM};
            pg8::EpiResid E{XB};
            pg8::gemm_phase<pg8::EpiResid, pg8::SchedPlain, true, true, false, true>(ldsl, g, S, E, wave);
        }
        SEAM_L(pb + 3);
        if (ST(5) && IN(pb + 4)) {
            int tid = tid0; asm volatile("" : "+v"(tid));
            const int lane = tid & 63;
            P_WS; P_ACT; P_ROUTE; const bf16_t* X = (const bf16_t*)KOUT; const float* b_rg = KIN(19); const float* b_re = KIN(21); const float* norm2_g = KIN(17);
            const bf16_t* tab = WB + WB_RT + (size_t)l * 2 * 48 * 1024 + (size_t)(lane & 15) * 1024 + 128 * wave + 8 * (lane >> 4);
            bf16x8 Bh[3][4], Bl[3][4];
#pragma unroll
            for (int t = 0; t < 3; ++t)
#pragma unroll
                for (int sI = 0; sI < 4; ++sI) { Bh[t][sI] = *(const bf16x8*)(tab + (size_t)t * 16 * 1024 + 32 * sI); Bl[t][sI] = *(const bf16x8*)(tab + (size_t)(48 + t * 16) * 1024 + 32 * sI); }
            for (int rb = vcu; rb < M / 64; rb += G)
                route_block(X, tab, b_rg + l * 4, b_re + l * 32, experts, weights, rank, ctl + CW_CNT + 2048 * l, rstd, (int*)(ws + WS_LIST), norm2_g + l * DM, (unsigned char*)HM, rb, Bh, Bl, (LAS float*)ldsl, tid, wave);
        }
        SEAM(pb + 4);
        volatile LAS int* mt = (volatile LAS int*)(ldsl + LDSCTL_OFF + 256);
        LAS unsigned* rowtab = (LAS unsigned*)(ldsl + LDSCTL_OFF + 2048); LAS float* wtab = (LAS float*)(ldsl + LDSCTL_OFF + 6144);
        if (ST(7) && IN(pb + 6)) {
            int tid = tid0; asm volatile("" : "+v"(tid));
            P_WS; P_ACT; P_ROUTE;
            moe_tables(ctl + CW_CNT + 2048 * l, mt, tid);
            moe_rowtabs(mt, (const int*)(ws + WS_LIST), weights, rstd, rowtab, wtab, vcu, G, tid, 1);
            const int ntiles = __builtin_amdgcn_readfirstlane(mt[256]);
            pg8::Gemm g{DM / 2, DM / 2, 0x7C7C7C7C};
            pg8::SchedMoeUp S{vcu, G, ntiles, (const LAS int*)(ldsl + LDSCTL_OFF + 256 + 96 * 4), (const char*)HM, (const char*)(WBl + WB_GU), ctl + CW_TCNT + l * 160 * 64};
            pg8::EpiSilu E{(unsigned char*)HID, wtab};
            pg8::gemm_phase<pg8::EpiSilu, pg8::SchedMoeUp, true, true, true, true>(ldsl, g, S, E, wave, rowtab);
        }
        if (ST(8) && IN(pb + 7)) {
            int tid = tid0; asm volatile("" : "+v"(tid));
            P_WS; P_ACT; P_ROUTE;
            if (!(ST(7) && IN(pb + 6))) moe_tables(ctl + CW_CNT + 2048 * l, mt, tid);
            moe_rowtabs(mt, (const int*)(ws + WS_LIST), weights, rstd, rowtab, wtab, vcu, G, tid, 0);
            const int ntiles = __builtin_amdgcn_readfirstlane(mt[256]);
            pg8::Gemm g{DEXP / 2, DEXP / 2, 0x7E7E7E7E};
            pg8::SchedMoeDown S{vcu, G, ntiles, (ntiles * 4) % G, wave, (const LAS int*)(ldsl + LDSCTL_OFF + 256 + 96 * 4), (const char*)HID, (const char*)(WBl + WB_DN), ctl + CW_TCNT + l * 160 * 64, ctl + CW_TMO};
            pg8::EpiRowScale E{(unsigned char*)YB, wtab};
            pg8::gemm_phase<pg8::EpiRowScale, pg8::SchedMoeDown, true, true, false, true>(ldsl, g, S, E, wave);
        }
        SEAM(pb + 7);
        if (ST(9) && IN(pb + 8)) {
            int lane = lane0; asm volatile("" : "+v"(lane));
            P_WS; P_ACT; P_ROUTE; float* OUTP = KOUT; bf16_t* XB = (bf16_t*)OUTP; const float* norm1_g = KIN(4); const float* final_g = KIN(25);
            const bool last = (l == DEPTH - 1);
            const bool poison = last && ((__hip_atomic_load(ctl + CW_BAR + args.li * BAR_REGION + XB_TMO, __ATOMIC_RELAXED, __HIP_MEMORY_SCOPE_AGENT) | __hip_atomic_load(ctl + CW_TMO, __ATOMIC_RELAXED, __HIP_MEMORY_SCOPE_AGENT)) != 0u);
            if (!(ST(7) && IN(pb + 6)) && !(ST(8) && IN(pb + 7))) moe_tables(ctl + CW_CNT + 2048 * l, mt, tid0);
            static_assert(M % 4 == 0, "rows come in fours");
            for (int m = 4 * gw; m < M; m += 4 * NGW) {
                const u32x4 ex0 = *(const u32x4*)(experts + 2 * m), ex1 = *(const u32x4*)(experts + 2 * m + 4), rk0 = *(const u32x4*)(rank + 2 * m), rk1 = *(const u32x4*)(rank + 2 * m + 4);
                const int rows[4] = {m, m + 1, m + 2, m + 3};
                const int d0[4] = {mt[ex0.x] + (int)rk0.x, mt[ex0.z] + (int)rk0.z, mt[ex1.x] + (int)rk1.x, mt[ex1.z] + (int)rk1.z}, d1[4] = {mt[ex0.y] + (int)rk0.y, mt[ex0.w] + (int)rk0.w, mt[ex1.y] + (int)rk1.y, mt[ex1.w] + (int)rk1.w};
                rows_combine_norm<4>(XB, (const unsigned char*)YB, final_g, last ? nullptr : (float*)(ws + WS_ROUTE + RT_RSTD1), OUTP, rows, lane, poison, d0, d1, (unsigned char*)HM); }
        }
        SEAM(pb + 8);
    }
#undef IN
#undef SEAM
#undef lane0
#undef tid0
#undef P_WS
#undef P_ACT
#undef P_ROUTE
}

extern "C" void kernel_launch(void* const* d_in, const int* in_sizes, int n_in, void* d_out, int out_size, void* d_ws, size_t ws_size, hipStream_t stream) {
    if (n_in != 26 || in_sizes[0] != M * DM || out_size != M * DM || ws_size < WS_END) { fprintf(stderr, "kernel_launch: unexpected shapes n_in %d out %d ws %zu (need %zu)\n", n_in, out_size, ws_size, (size_t)WS_END); return; }
    static int grid = 0;
    if (grid == 0) {
        int dev = 0, cus = 0;
        if (hipGetDevice(&dev) != hipSuccess || hipDeviceGetAttribute(&cus, hipDeviceAttributeMultiprocessorCount, dev) != hipSuccess) { grid = -1; return; }
        if (hipFuncSetAttribute((const void*)mk_fwd, hipFuncAttributeMaxDynamicSharedMemorySize, LDS_BYTES) != hipSuccess) { fprintf(stderr, "kernel_launch: hipFuncSetAttribute failed\n"); grid = -1; return; }
        int per_cu = 0;
        if (hipOccupancyMaxActiveBlocksPerMultiprocessor(&per_cu, (const void*)mk_fwd, NWAVES * 64, LDS_BYTES) != hipSuccess || per_cu < 1) fprintf(stderr, "kernel_launch: occupancy query says %d\n", per_cu);
        (void)hipGetLastError();
        grid = cus;
    }
    if (grid < 0) return;
    (void)hipMemsetAsync((unsigned char*)d_ws + WS_CTL, 0, MiB, stream);
    Args a{};
    for (int i = 0; i < 26; ++i) a.in[i] = (const float*)d_in[i];
    a.out = (float*)d_out; a.ws = (unsigned char*)d_ws; a.ph_lo = 0; a.ph_hi = N_PHASES; a.li = 0; a.pad = 0;
    hipLaunchKernelGGL(mk_fwd, dim3(grid), dim3(NWAVES * 64), LDS_BYTES, stream, a);
}
```
